# Optimizing an MI355X kernel written in HIP

```python
import jax, jax.numpy as jnp
from jax import lax
import numpy as np

D_MODEL = 2048
BATCH = 1
SEQ = 8192
DEPTH = 2

CHUNK = 64
N_MEM = 256
NORM_EPS = 1e-6
GN_EPS = 64e-5

RWKV_WIDTH = D_MODEL // 2
RWKV_HEAD_DIM = 64
RWKV_HEADS = RWKV_WIDTH // RWKV_HEAD_DIM
DECAY_LORA = 96
AAA_LORA = 96
GATE_LORA = 256
MLSTM_WIDTH = D_MODEL // 2
MLSTM_HEAD_DIM = 256
MLSTM_HEADS = MLSTM_WIDTH // MLSTM_HEAD_DIM
MLSTM_CONV = 4
FOX_WIDTH = D_MODEL
FOX_HEAD_DIM = 128
FOX_HEADS = FOX_WIDTH // FOX_HEAD_DIM
Q_BLOCK = 128
XATTN_HEADS = 4
XATTN_HEAD_DIM = D_MODEL // XATTN_HEADS
D_FF = 11 * D_MODEL // 4
N_EXPERTS = 8
TOP_K = 2
N_EVEN = (DEPTH + 1) // 2
N_ODD = DEPTH // 2

A_SIZES = (RWKV_WIDTH, RWKV_WIDTH, RWKV_WIDTH, DECAY_LORA, AAA_LORA, GATE_LORA)
B_SIZES = (2 * MLSTM_WIDTH, MLSTM_WIDTH, MLSTM_WIDTH, 2 * MLSTM_HEADS)
A_COLS = sum(A_SIZES)
B_COLS = sum(B_SIZES)
FOX_SIZES = (FOX_WIDTH, FOX_WIDTH, FOX_WIDTH, FOX_WIDTH, FOX_HEADS)
FOX_COLS = sum(FOX_SIZES)

kernel_name = "hybrid_rwkv7_mlstm_fox_moe_trunk"


def _split(t, sizes):
    offsets = [int(o) for o in np.cumsum(sizes)[:-1]]
    return jnp.split(t, offsets, axis=-1)


def _rmsnorm(x, g, eps=NORM_EPS):
    xf = x.astype(jnp.float32)
    y = xf * lax.rsqrt(jnp.mean(xf * xf, axis=-1, keepdims=True) + eps)
    return (y * g).astype(x.dtype)


def _token_shift(p, mu):
    prev = jnp.pad(p, ((0, 0), (1, 0), (0, 0)))[:, :-1]
    return p + (prev - p) * mu


def _causal_conv(x, w):
    width, ch = w.shape
    return lax.conv_general_dilated(x, w[:, None, :].astype(x.dtype), window_strides=(1,),
                                    padding=[(width - 1, 0)],
                                    dimension_numbers=('NWC', 'WIO', 'NWC'),
                                    feature_group_count=ch)


def _rwkv7_time_mix(r, k, v, w_lo, a_lo, g_lo, w0, w_up, a0, a_up, g_up, k_k, k_a, r_k, ln_g, ln_b):
    bsz, seq, width = r.shape
    f32 = jnp.float32
    log_w = -jax.nn.softplus(-(w0 + jnp.tanh(w_lo) @ w_up)) - 0.5
    decay = jnp.exp(-jnp.exp(log_w.astype(f32)))
    a = jax.nn.sigmoid(a0 + a_lo @ a_up).astype(f32)
    g = jax.nn.sigmoid(g_lo) @ g_up
    heads = lambda t: t.astype(f32).reshape(bsz, seq, RWKV_HEADS, RWKV_HEAD_DIM)
    kk = heads(k * k_k)
    kk = kk / jnp.maximum(jnp.sqrt(jnp.sum(kk * kk, axis=-1, keepdims=True)), 1e-12)
    k_mod = heads(k.astype(f32) * (1.0 + (a - 1.0) * k_a))
    rh, vh, wh, ah = heads(r), heads(v), heads(decay), heads(a)
    b = kk * ah

    def step(state, inp):
        r_t, w_t, k_t, v_t, kk_t, b_t = inp
        sa = jnp.einsum('bhvk,bhk->bhv', state, kk_t)
        state = (state * w_t[:, :, None, :] - sa[..., None] * b_t[:, :, None, :]
                 + v_t[..., None] * k_t[:, :, None, :])
        return state, jnp.einsum('bhvk,bhk->bhv', state, r_t)

    s0 = jnp.zeros((bsz, RWKV_HEADS, RWKV_HEAD_DIM, RWKV_HEAD_DIM), f32)
    xs = tuple(jnp.moveaxis(t, 1, 0) for t in (rh, wh, k_mod, vh, kk, b))
    _, y = lax.scan(step, s0, xs)
    y = jnp.moveaxis(y, 0, 1)
    mean = jnp.mean(y, axis=-1, keepdims=True)
    var = jnp.mean(jnp.square(y - mean), axis=-1, keepdims=True)
    y = ((y - mean) * lax.rsqrt(var + GN_EPS)).reshape(bsz, seq, width) * ln_g + ln_b
    bonus = jnp.sum(rh * k_mod * r_k.reshape(RWKV_HEADS, RWKV_HEAD_DIM), axis=-1, keepdims=True) * vh
    y = y + bonus.reshape(bsz, seq, width)
    return (y * g).astype(r.dtype)


def _mlstm_chunkwise(q, k, v, i_pre, f_pre):
    bsz, seq, nh, dh = q.shape
    n_chunks = seq // CHUNK

    def chunks(t):
        t = t.reshape((bsz, n_chunks, CHUNK) + t.shape[2:])
        return jnp.moveaxis(t, (1, 2), (0, 3))

    qc, kc, vc = chunks(q * dh ** -0.5), chunks(k), chunks(v)
    b_cum = jnp.cumsum(chunks(jax.nn.log_sigmoid(f_pre)), axis=-1)
    ig = chunks(i_pre)
    causal = jnp.tril(jnp.ones((CHUNK, CHUNK), dtype=bool))

    def step(carry, inp):
        c_mat, n_vec, m = carry
        q_c, k_c, v_c, b_c, i_c = inp
        d_mat = jnp.where(causal, b_c[..., :, None] - b_c[..., None, :] + i_c[..., None, :], -jnp.inf)
        inter = b_c + m[..., None]
        m_row = jnp.maximum(inter, jnp.max(d_mat, axis=-1))
        w_inter = jnp.exp(inter - m_row)
        s = jnp.einsum('bhld,bhsd->bhls', q_c, k_c) * jnp.exp(d_mat - m_row[..., None])
        num = (jnp.einsum('bhls,bhsd->bhld', s, v_c)
               + w_inter[..., None] * jnp.einsum('bhvk,bhlk->bhlv', c_mat, q_c))
        den = jnp.sum(s, axis=-1) + w_inter * jnp.einsum('bhk,bhlk->bhl', n_vec, q_c)
        h = num / jnp.maximum(jnp.abs(den), jnp.exp(-m_row))[..., None]
        b_last = b_c[..., -1]
        d_state = b_last[..., None] - b_c + i_c
        m_new = jnp.maximum(b_last + m, jnp.max(d_state, axis=-1))
        w_state = jnp.exp(d_state - m_new[..., None])
        w_carry = jnp.exp(b_last + m - m_new)
        c_mat = w_carry[..., None, None] * c_mat + jnp.einsum('bhs,bhsv,bhsk->bhvk', w_state, v_c, k_c)
        n_vec = w_carry[..., None] * n_vec + jnp.einsum('bhs,bhsk->bhk', w_state, k_c)
        return (c_mat, n_vec, m_new), h

    init = (jnp.zeros((bsz, nh, dh, dh), jnp.float32), jnp.zeros((bsz, nh, dh), jnp.float32),
            jnp.zeros((bsz, nh), jnp.float32))
    _, h = lax.scan(step, init, (qc, kc, vc, b_cum, ig))
    return jnp.moveaxis(h, (0, 3), (1, 2)).reshape(bsz, seq, nh, dh)


def _rwkv_mlstm_mixer(h, w_in, mu, w0, w_up, a0, a_up, g_up, k_k, k_a, r_k, ln_g, ln_b,
                      conv_qk, b_if, mh_g, w_out):
    bsz, seq, _ = h.shape
    f32 = jnp.float32
    proj = h @ w_in
    p_a, p_b = proj[..., :A_COLS], proj[..., A_COLS:]
    r, k, v, w_lo, a_lo, g_lo = _split(_token_shift(p_a, mu), A_SIZES)
    y_a = _rwkv7_time_mix(r, k, v, w_lo, a_lo, g_lo, w0, w_up, a0, a_up, g_up, k_k, k_a, r_k, ln_g, ln_b)
    qk, v_b, o_b, gates = _split(p_b, B_SIZES)
    qk = jax.nn.silu(_causal_conv(qk, conv_qk))
    q_b, k_b = qk[..., :MLSTM_WIDTH], qk[..., MLSTM_WIDTH:]
    gates = (gates + b_if).astype(f32)
    i_pre, f_pre = gates[..., :MLSTM_HEADS], gates[..., MLSTM_HEADS:]
    heads = lambda t: t.astype(f32).reshape(bsz, seq, MLSTM_HEADS, MLSTM_HEAD_DIM)
    h_b = _mlstm_chunkwise(heads(q_b), heads(k_b), heads(v_b), i_pre, f_pre)
    h_b = _rmsnorm(h_b, mh_g.reshape(MLSTM_HEADS, MLSTM_HEAD_DIM)).reshape(bsz, seq, MLSTM_WIDTH)
    y_b = (h_b * jax.nn.sigmoid(o_b.astype(f32))).astype(h.dtype)
    return jnp.concatenate([y_a, y_b], axis=-1) @ w_out


def _fox_attention(h, w_in, b_f, qn_g, kn_g, w_out):
    bsz, seq, _ = h.shape
    f32 = jnp.float32
    q, k, v, g, f_pre = _split(h @ w_in, FOX_SIZES)
    split_heads = lambda t: t.reshape(bsz, seq, FOX_HEADS, FOX_HEAD_DIM)
    q = _rmsnorm(split_heads(q), qn_g).transpose(0, 2, 1, 3)
    k = _rmsnorm(split_heads(k), kn_g).transpose(0, 2, 1, 3)
    v = split_heads(v).transpose(0, 2, 1, 3)
    log_f = jax.nn.log_sigmoid((f_pre + b_f).astype(f32))
    cum = jnp.cumsum(log_f, axis=1).transpose(0, 2, 1)
    scale = FOX_HEAD_DIM ** -0.5
    q_pos = jnp.arange(Q_BLOCK)
    outs = []
    for blk in range(seq // Q_BLOCK):
        q0 = blk * Q_BLOCK
        k_end = q0 + Q_BLOCK
        logits = jnp.einsum('bhqd,bhkd->bhqk', q[:, :, q0:k_end], k[:, :, :k_end]).astype(f32) * scale
        logits = logits + cum[:, :, q0:k_end, None] - cum[:, :, None, :k_end]
        mask = (q0 + q_pos)[:, None] >= jnp.arange(k_end)[None, :]
        probs = jax.nn.softmax(jnp.where(mask, logits, -jnp.inf), axis=-1)
        outs.append(jnp.einsum('bhqk,bhkd->bhqd', probs.astype(v.dtype), v[:, :, :k_end]))
    o = jnp.concatenate(outs, axis=2).transpose(0, 2, 1, 3).reshape(bsz, seq, FOX_WIDTH)
    return (o * jax.nn.sigmoid(g)) @ w_out


def _cross_attention(h, mem_n, wq, wkv, wo):
    bsz, seq, _ = h.shape
    n_mem = mem_n.shape[1]
    q = (h @ wq).reshape(bsz, seq, XATTN_HEADS, XATTN_HEAD_DIM)
    k, v = jnp.split(mem_n @ wkv, 2, axis=-1)
    k = k.reshape(bsz, n_mem, XATTN_HEADS, XATTN_HEAD_DIM)
    v = v.reshape(bsz, n_mem, XATTN_HEADS, XATTN_HEAD_DIM)
    logits = jnp.einsum('bthd,bmhd->bhtm', q, k).astype(jnp.float32) * XATTN_HEAD_DIM ** -0.5
    probs = jax.nn.softmax(logits, axis=-1)
    o = jnp.einsum('bhtm,bmhd->bthd', probs.astype(v.dtype), v).reshape(bsz, seq, D_MODEL)
    return o @ wo


def _swiglu(h, w_gate, w_up, w_down):
    return (jax.nn.silu(h @ w_gate) * (h @ w_up)) @ w_down


def _moe_swiglu(h, w_router, w_gate, w_up, w_down):
    logits = (h @ w_router).astype(jnp.float32)
    top_val, top_idx = lax.top_k(logits, TOP_K)
    gates = jax.nn.softmax(top_val, axis=-1)
    combine = jnp.einsum('btk,btke->bte', gates,
                         jax.nn.one_hot(top_idx, N_EXPERTS, dtype=jnp.float32)).astype(h.dtype)
    out = jnp.zeros_like(h)
    for e in range(N_EXPERTS):
        out = out + combine[..., e:e + 1] * _swiglu(h, w_gate[e], w_up[e], w_down[e])
    return out


def setup_inputs(seed: int = 0) -> dict:
    key = jax.random.key(seed)
    ks = iter(jax.random.split(key, 48))
    f32 = jnp.float32
    D = D_MODEL
    out_scale = (3 * DEPTH) ** -0.5

    def normal(shape, scale):
        return jax.random.normal(next(ks), shape, f32) * scale

    def uniform(shape, lo, hi):
        return jax.random.uniform(next(ks), shape, f32, lo, hi)

    def gain(shape):
        return 1.0 + normal(shape, 0.02)

    inp = {}
    inp['x'] = normal((BATCH, SEQ, D), 1.0)
    inp['mem'] = normal((BATCH, N_MEM, D), 1.0)
    inp['mem_norm_g'] = gain((D,))
    inp['final_norm_g'] = gain((D,))
    inp['norm_mix_g'] = gain((DEPTH, D))
    inp['norm_xattn_g'] = gain((DEPTH, D))
    inp['norm_ffn_g'] = gain((DEPTH, D))
    inp['xa_wq'] = normal((DEPTH, D, D), D ** -0.5)
    inp['xa_wkv'] = normal((DEPTH, D, 2 * D), D ** -0.5)
    inp['xa_wo'] = normal((DEPTH, D, D), D ** -0.5 * out_scale)
    inp['ab_w_in'] = normal((N_EVEN, D, A_COLS + B_COLS), D ** -0.5)
    inp['ab_mu'] = uniform((N_EVEN, A_COLS), 0.0, 1.0)
    inp['rw_w0'] = uniform((N_EVEN, RWKV_WIDTH), -6.0, -1.0)
    inp['rw_w_up'] = normal((N_EVEN, DECAY_LORA, RWKV_WIDTH), 0.1 * DECAY_LORA ** -0.5)
    inp['rw_a0'] = normal((N_EVEN, RWKV_WIDTH), 0.1)
    inp['rw_a_up'] = normal((N_EVEN, AAA_LORA, RWKV_WIDTH), 0.1 * AAA_LORA ** -0.5)
    inp['rw_g_up'] = normal((N_EVEN, GATE_LORA, RWKV_WIDTH), GATE_LORA ** -0.5)
    inp['rw_k_k'] = 0.85 + normal((N_EVEN, RWKV_WIDTH), 0.02)
    inp['rw_k_a'] = gain((N_EVEN, RWKV_WIDTH))
    inp['rw_r_k'] = normal((N_EVEN, RWKV_WIDTH), 0.1)
    inp['rw_ln_g'] = gain((N_EVEN, RWKV_WIDTH))
    inp['rw_ln_b'] = normal((N_EVEN, RWKV_WIDTH), 0.02)
    inp['ml_conv'] = normal((N_EVEN, MLSTM_CONV, 2 * MLSTM_WIDTH), MLSTM_CONV ** -0.5)
    inp['ml_b_if'] = jnp.concatenate([normal((N_EVEN, MLSTM_HEADS), 0.1),
                                      uniform((N_EVEN, MLSTM_HEADS), 3.0, 6.0)], axis=-1)
    inp['ml_norm_g'] = gain((N_EVEN, MLSTM_WIDTH))
    inp['ab_w_out'] = normal((N_EVEN, D, D), D ** -0.5 * out_scale)
    inp['ffn_w_gate'] = normal((N_EVEN, D, D_FF), D ** -0.5)
    inp['ffn_w_up'] = normal((N_EVEN, D, D_FF), D ** -0.5)
    inp['ffn_w_down'] = normal((N_EVEN, D_FF, D), D_FF ** -0.5 * out_scale)
    inp['fox_w_in'] = normal((N_ODD, D, FOX_COLS), D ** -0.5)
    inp['fox_b_f'] = uniform((N_ODD, FOX_HEADS), 3.0, 6.0)
    inp['fox_qn_g'] = gain((N_ODD, FOX_HEAD_DIM))
    inp['fox_kn_g'] = gain((N_ODD, FOX_HEAD_DIM))
    inp['fox_w_out'] = normal((N_ODD, D, D), D ** -0.5 * out_scale)
    inp['moe_router'] = normal((N_ODD, D, N_EXPERTS), D ** -0.5)
    inp['moe_w_gate'] = normal((N_ODD, N_EXPERTS, D, D_FF), D ** -0.5)
    inp['moe_w_up'] = normal((N_ODD, N_EXPERTS, D, D_FF), D ** -0.5)
    inp['moe_w_down'] = normal((N_ODD, N_EXPERTS, D_FF, D), D_FF ** -0.5 * out_scale)
    return inp


def reference(x, mem, mem_norm_g, final_norm_g, norm_mix_g, norm_xattn_g, norm_ffn_g,
              xa_wq, xa_wkv, xa_wo,
              ab_w_in, ab_mu, rw_w0, rw_w_up, rw_a0, rw_a_up, rw_g_up, rw_k_k, rw_k_a, rw_r_k,
              rw_ln_g, rw_ln_b, ml_conv, ml_b_if, ml_norm_g, ab_w_out,
              ffn_w_gate, ffn_w_up, ffn_w_down,
              fox_w_in, fox_b_f, fox_qn_g, fox_kn_g, fox_w_out,
              moe_router, moe_w_gate, moe_w_up, moe_w_down):
    mem_n = _rmsnorm(mem, mem_norm_g)
    for layer in range(DEPTH):
        j = layer // 2
        h = _rmsnorm(x, norm_mix_g[layer])
        if layer % 2 == 0:
            x = x + _rwkv_mlstm_mixer(h, ab_w_in[j], ab_mu[j], rw_w0[j], rw_w_up[j], rw_a0[j], rw_a_up[j],
                                      rw_g_up[j], rw_k_k[j], rw_k_a[j], rw_r_k[j], rw_ln_g[j], rw_ln_b[j],
                                      ml_conv[j], ml_b_if[j], ml_norm_g[j], ab_w_out[j])
        else:
            x = x + _fox_attention(h, fox_w_in[j], fox_b_f[j], fox_qn_g[j], fox_kn_g[j], fox_w_out[j])
        x = x + _cross_attention(_rmsnorm(x, norm_xattn_g[layer]), mem_n,
                                 xa_wq[layer], xa_wkv[layer], xa_wo[layer])
        h = _rmsnorm(x, norm_ffn_g[layer])
        if layer % 2 == 0:
            x = x + _swiglu(h, ffn_w_gate[j], ffn_w_up[j], ffn_w_down[j])
        else:
            x = x + _moe_swiglu(h, moe_router[j], moe_w_gate[j], moe_w_up[j], moe_w_down[j])
    return _rmsnorm(x, final_norm_g)
```

```cpp
#include <hip/hip_runtime.h>
#include <cstdio>
#include <cstdint>

#define GAS __attribute__((address_space(1)))
#define LAS __attribute__((address_space(3)))
typedef unsigned short bf16;
typedef short bf16x8 __attribute__((ext_vector_type(8)));
typedef short s16x4 __attribute__((ext_vector_type(4)));
typedef float f32x2 __attribute__((ext_vector_type(2)));
typedef float f32x4 __attribute__((ext_vector_type(4)));
typedef float f32x16 __attribute__((ext_vector_type(16)));
typedef unsigned u32x2 __attribute__((ext_vector_type(2)));
typedef unsigned u32x4 __attribute__((ext_vector_type(4)));

constexpr int T = 8192, D = 2048, NMEM = 256, DFF = 5632, NEXP = 8;
constexpr int A_COLS = 3520, AB_COLS = 7624, AB_PAD = 7680;
constexpr int FOX_LD = 8208;
constexpr int NH_R = 16, NH_M = 4, NH_F = 16;
constexpr int MOE_ROWS = 72 * 256;

__device__ __forceinline__ float bf2f(unsigned b) { return __uint_as_float(b << 16); }
__device__ __forceinline__ unsigned cvt_pk_bf16(float lo, float hi) { unsigned r; asm volatile("v_cvt_pk_bf16_f32 %0, %1, %2" : "=v"(r) : "v"(lo), "v"(hi)); return r; }
__device__ __forceinline__ bf16 f2bf(float f) { return (bf16)(cvt_pk_bf16(f, 0.f) & 0xffffu); }
__device__ __forceinline__ float wave_sum(float v) {
#pragma unroll
    for (int o = 1; o < 64; o <<= 1) v += __shfl_xor(v, o);
    return v;
}
__device__ __forceinline__ float wave_max(float v) {
#pragma unroll
    for (int o = 1; o < 64; o <<= 1) v = fmaxf(v, __shfl_xor(v, o));
    return v;
}
__device__ __forceinline__ float sigmoidf_(float x) { return 1.0f / (1.0f + __expf(-x)); }
__device__ __forceinline__ float logsigmoidf_(float x) { return fminf(x, 0.f) - log1pf(__expf(-fabsf(x))); }

namespace pg8 {
#define PG8_LAS __attribute__((address_space(3)))
typedef unsigned short bf16_t;
constexpr int BM = 256, BK = 64, HALF = 128, HTB = HALF * BK * 2  , STAGE_BYTES = 8 * HTB, NXCD = 8, WGM = 8;

__host__ __device__ __forceinline__ int lds_byte(int r, int c) { const int st = (r >> 4) * 2 + (c >> 5), rr = r & 15, cc = c & 31, ob = rr * 64 + cc * 2; return st * 1024 + (ob ^ (((ob >> 9) & 1) << 5)); }
__host__ __device__ __forceinline__ void stage_rc(int b, int& R, int& C) { const int st = b / 1024, sb = b % 1024, swz = sb ^ (((sb >> 9) & 1) << 5); R = (st >> 1) * 16 + swz / 64; C = (st & 1) * 32 + (swz % 64) / 2; }
__host__ __device__ __forceinline__ int perm32(int rho) { const int n = rho >> 4, i = rho & 15; return 8 * (i >> 2) + 4 * n + (i & 3); }

struct Unit { const char* a; const char* b; int pm, pn, aux, pad; };
struct Gemm { int lda, ldb, K; };

__device__ __forceinline__ bool static_tile(int i, int G, int c, int nM, int nN, int& pm, int& pn) {
    const int nwg = nM * nN; const long L = (long)i * G + c; if (L >= nwg) return false;
    int wgid = (int)L; { const int q = nwg / NXCD, r = nwg % NXCD, xcd = wgid % NXCD, off = wgid / NXCD; wgid = (xcd < r ? xcd * (q + 1) : r * (q + 1) + (xcd - r) * q) + off; }
    const int nig = WGM * nN, gid = wgid / nig, fm = gid * WGM, gsz = (nM - fm) < WGM ? (nM - fm) : WGM;
    pm = fm + ((wgid % nig) % gsz); pn = (wgid % nig) / gsz; return true;
}
struct PlainOrder {
    const bf16_t* A; const bf16_t* Bt; int lda, ldb, nM, nN, G, c;
    __device__ __forceinline__ bool next(int i, Unit& u) const {
        int pm, pn; if (!static_tile(i, G, c, nM, nN, pm, pn)) return false;
        u.pm = pm; u.pn = pn; u.aux = 0; u.pad = 0; u.a = (const char*)(A + (size_t)pm * BM * lda); u.b = (const char*)(Bt + (size_t)pn * BM * ldb); return true;
    }
};

struct EpiF32 {
    static constexpr bool PERM = false;
    float* C; int ldc; int aux_cols; float scale;
    __device__ __forceinline__ void operator()(const f32x4 (&acc)[2][2][4][2], const Unit& u, int wr, int wc, int fr, int fq) const {
        const int row0 = u.pm * BM + wr * 64 + fr, col0 = u.pn * BM + u.aux * aux_cols + wc * 32 + 4 * fq;
#pragma unroll
        for (int ai = 0; ai < 2; ++ai)
#pragma unroll
            for (int m = 0; m < 4; ++m) { float* rowp = C + (size_t)(row0 + ai * HALF + m * 16) * ldc + col0;
#pragma unroll
                for (int bj = 0; bj < 2; ++bj)
#pragma unroll
                    for (int n = 0; n < 2; ++n) *(f32x4*)(rowp + bj * HALF + n * 16) = acc[ai][bj][m][n] * scale; }
    }
};
struct EpiResid {
    static constexpr bool PERM = false;
    const float* base; float* out; int ldc;
    __device__ __forceinline__ void operator()(const f32x4 (&acc)[2][2][4][2], const Unit& u, int wr, int wc, int fr, int fq) const {
        const int row0 = u.pm * BM + wr * 64 + fr, col0 = u.pn * BM + wc * 32 + 4 * fq;
#pragma unroll
        for (int ai = 0; ai < 2; ++ai)
#pragma unroll
            for (int m = 0; m < 4; ++m) { const size_t off = (size_t)(row0 + ai * HALF + m * 16) * ldc + col0;
#pragma unroll
                for (int bj = 0; bj < 2; ++bj)
#pragma unroll
                    for (int n = 0; n < 2; ++n) { const f32x4 b = *(const f32x4*)(base + off + bj * HALF + n * 16); *(f32x4*)(out + off + bj * HALF + n * 16) = b + acc[ai][bj][m][n]; } }
    }
};
struct EpiBf16 {
    static constexpr bool PERM = true;
    bf16_t* O; int ldc; float* side; int side_pn;
    __device__ __forceinline__ void operator()(const f32x4 (&acc)[2][2][4][2], const Unit& u, int wr, int wc, int fr, int fq) const {
        const int row0 = u.pm * BM + wr * 64 + fr, col0 = u.pn * BM + wc * 32 + 8 * fq;
#pragma unroll
        for (int ai = 0; ai < 2; ++ai)
#pragma unroll
            for (int m = 0; m < 4; ++m) { bf16_t* rowp = O + (size_t)(row0 + ai * HALF + m * 16) * ldc + col0;
#pragma unroll
                for (int bj = 0; bj < 2; ++bj) { const f32x4 v0 = acc[ai][bj][m][0], v1 = acc[ai][bj][m][1];
                    u32x4 w; w.x = cvt_pk_bf16(v0[0], v0[1]); w.y = cvt_pk_bf16(v0[2], v0[3]); w.z = cvt_pk_bf16(v1[0], v1[1]); w.w = cvt_pk_bf16(v1[2], v1[3]);
                    *(u32x4*)(rowp + bj * HALF) = w; } }
        if (side != nullptr && u.pn == side_pn) {
#pragma unroll
            for (int ai = 0; ai < 2; ++ai)
#pragma unroll
                for (int m = 0; m < 4; ++m) { float* rowp = side + (size_t)(row0 + ai * HALF + m * 16) * 256 + wc * 32 + 8 * fq;
#pragma unroll
                    for (int bj = 0; bj < 2; ++bj) { *(f32x4*)(rowp + bj * HALF) = acc[ai][bj][m][0]; *(f32x4*)(rowp + bj * HALF + 4) = acc[ai][bj][m][1]; } }
        }
    }
};
struct EpiSwiGLU {
    static constexpr bool PERM = true;
    bf16_t* O; int ldc;
    __device__ __forceinline__ void operator()(const f32x4 (&acc)[2][2][4][2], const Unit& u, int wr, int wc, int fr, int fq) const {
        const int row0 = u.pm * BM + wr * 64 + fr, col0 = u.pn * HALF + wc * 32 + 8 * fq;
#pragma unroll
        for (int ai = 0; ai < 2; ++ai)
#pragma unroll
            for (int m = 0; m < 4; ++m) { bf16_t* rowp = O + (size_t)(row0 + ai * HALF + m * 16) * ldc + col0;
                float o[8];
#pragma unroll
                for (int n = 0; n < 2; ++n)
#pragma unroll
                    for (int j = 0; j < 4; ++j) { const float g = acc[ai][0][m][n][j], up = acc[ai][1][m][n][j];
                        o[n * 4 + j] = g * __builtin_amdgcn_rcpf(1.0f + __builtin_amdgcn_exp2f(-1.4426950408889634f * g)) * up; }
                u32x4 w; w.x = cvt_pk_bf16(o[0], o[1]); w.y = cvt_pk_bf16(o[2], o[3]); w.z = cvt_pk_bf16(o[4], o[5]); w.w = cvt_pk_bf16(o[6], o[7]);
                *(u32x4*)rowp = w; }
    }
};

template <class Epi, class Sched, bool ALIGN_EPI>
__device__ __forceinline__ void gemm_phase(PG8_LAS unsigned char* lds, const Gemm g, const Sched& S, const Epi& E) {
    const int tid = threadIdx.x, wid = __builtin_amdgcn_readfirstlane(tid >> 6), lane = tid & 63, wr = wid >> 2, wc = wid & 3, fr = lane & 15, fq = lane >> 4;
    const int K = g.K, nt = K / BK;
    unsigned voffA[2], voffB[2];
#pragma unroll
    for (int i = 0; i < 2; ++i) { int R, C; stage_rc(tid * 16 + i * 8192, R, C); const int Rb = Epi::PERM ? ((R & ~31) + perm32(R & 31)) : R;
        voffA[i] = (unsigned)(R * g.lda + C) * 2u; voffB[i] = (unsigned)(Rb * g.ldb + C) * 2u; }
    const size_t kstep = (size_t)(BK * 2);
    const size_t hstepA = (size_t)HALF * g.lda * 2, hstepB = (size_t)HALF * g.ldb * 2;
    const unsigned ldsw = (unsigned)wid * 1024u;
    const int aoff = lds_byte(wr * 64 + fr, fq * 8), boff = lds_byte(wc * 32 + fr, fq * 8);
#define PG8_SA(b, h) (((b) * 2 + (h)) * HTB)
#define PG8_SB(b, h) ((4 + (b) * 2 + (h)) * HTB)
#define PG8_STAGE(bufoff, gbase, voff) do { _Pragma("unroll") for (int _i = 0; _i < 2; ++_i) \
        __builtin_amdgcn_global_load_lds((const unsigned*)((const char*)(gbase) + (voff)[_i]), (PG8_LAS unsigned*)(lds + (bufoff) + ldsw + _i * 8192), 16, 0, 0); } while (0)
#define PG8_LDA(dst, b, h) do { _Pragma("unroll") for (int m = 0; m < 4; ++m) _Pragma("unroll") for (int k = 0; k < 2; ++k) dst[m][k] = *(const PG8_LAS bf16x8*)(lds + PG8_SA(b, h) + aoff + m * 2048 + k * 1024); } while (0)
#define PG8_LDB(dst, b, h) do { _Pragma("unroll") for (int n = 0; n < 2; ++n) _Pragma("unroll") for (int k = 0; k < 2; ++k) dst[n][k] = *(const PG8_LAS bf16x8*)(lds + PG8_SB(b, h) + boff + n * 2048 + k * 1024); } while (0)
#define PG8_MMA(ai, bj, At, Bt) do { __builtin_amdgcn_s_setprio(1); _Pragma("unroll") for (int m = 0; m < 4; ++m) _Pragma("unroll") for (int n = 0; n < 2; ++n) _Pragma("unroll") for (int k = 0; k < 2; ++k) \
        acc[ai][bj][m][n] = __builtin_amdgcn_mfma_f32_16x16x32_bf16(Bt[n][k], At[m][k], acc[ai][bj][m][n], 0, 0, 0); __builtin_amdgcn_s_setprio(0); } while (0)
#define PG8_WAIT_V(n) asm volatile("s_waitcnt vmcnt(" #n ")" ::: "memory")
#define PG8_WAIT_L(n) asm volatile("s_waitcnt lgkmcnt(" #n ")" ::: "memory")
#define PG8_BAR __builtin_amdgcn_s_barrier()
#define PG8_SCHED __builtin_amdgcn_sched_barrier(0)
    Unit cur, nxt; int ui = 0;
    if (!S.next(0, cur)) return;
    f32x4 acc[2][2][4][2];
#pragma unroll
    for (int a = 0; a < 2; ++a)
#pragma unroll
        for (int b = 0; b < 2; ++b)
#pragma unroll
            for (int m = 0; m < 4; ++m)
#pragma unroll
                for (int n = 0; n < 2; ++n) acc[a][b][m][n] = (f32x4){0.f, 0.f, 0.f, 0.f};
    bf16x8 At[4][2], B0[2][2], B1[2][2];
    const char* cA = cur.a; const char* cB = cur.b;
    PG8_STAGE(PG8_SB(0, 0), cB, voffB); PG8_STAGE(PG8_SB(0, 1), cB + hstepB, voffB); PG8_STAGE(PG8_SA(0, 0), cA, voffA); PG8_STAGE(PG8_SA(0, 1), cA + hstepA, voffA);
    if (wr == 1) PG8_BAR;
    PG8_WAIT_V(2); PG8_BAR;
    PG8_STAGE(PG8_SB(1, 0), cB + kstep, voffB); PG8_STAGE(PG8_SA(1, 0), cA + kstep, voffA); PG8_STAGE(PG8_SB(1, 1), cB + hstepB + kstep, voffB);
    PG8_WAIT_V(6); PG8_BAR;
    for (;;) {
        const bool has_next = S.next(ui + 1, nxt);
        const char* nA = has_next ? nxt.a : cA; const char* nB = has_next ? nxt.b : cB;
        for (int t = 0; t < nt; t += 2) {
            const bool last = (t == nt - 2);
            const char* a1 = cA + (size_t)(t + 1) * kstep;
            const char* a2 = last ? nA : cA + (size_t)(t + 2) * kstep; const char* b2 = last ? nB : cB + (size_t)(t + 2) * kstep;
            const char* a3 = a2 + kstep; const char* b3 = b2 + kstep;
            PG8_LDB(B0, 0, 0); PG8_LDB(B1, 0, 1); PG8_SCHED; PG8_LDA(At, 0, 0); PG8_STAGE(PG8_SA(1, 1), a1 + hstepA, voffA);
            PG8_WAIT_V(8); PG8_WAIT_L(0); PG8_BAR; PG8_MMA(0, 0, At, B0); PG8_MMA(0, 1, At, B1); PG8_BAR; PG8_SCHED;
            PG8_LDA(At, 0, 1); PG8_STAGE(PG8_SB(0, 0), b2, voffB); PG8_STAGE(PG8_SB(0, 1), b2 + hstepB, voffB); PG8_STAGE(PG8_SA(0, 0), a2, voffA);
            PG8_WAIT_V(8); PG8_WAIT_L(0); PG8_BAR; PG8_MMA(1, 0, At, B0); PG8_MMA(1, 1, At, B1); PG8_BAR; PG8_SCHED;
            PG8_LDB(B0, 1, 0); PG8_LDB(B1, 1, 1); PG8_SCHED; PG8_LDA(At, 1, 0); PG8_STAGE(PG8_SA(0, 1), a2 + hstepA, voffA);
            PG8_WAIT_V(8); PG8_WAIT_L(0); PG8_BAR; PG8_MMA(0, 0, At, B0); PG8_MMA(0, 1, At, B1); PG8_BAR; PG8_SCHED;
            PG8_LDA(At, 1, 1); PG8_STAGE(PG8_SB(1, 0), b3, voffB); PG8_STAGE(PG8_SB(1, 1), b3 + hstepB, voffB); PG8_STAGE(PG8_SA(1, 0), a3, voffA);
            PG8_WAIT_V(8); PG8_WAIT_L(0); PG8_BAR; PG8_MMA(1, 0, At, B0); PG8_MMA(1, 1, At, B1); PG8_BAR; PG8_SCHED;
        }
        if constexpr (ALIGN_EPI) { if (wr == 0) PG8_BAR; }
        E(acc, cur, wr, wc, fr, fq);
        if (!has_next) break;
#pragma unroll
        for (int a = 0; a < 2; ++a)
#pragma unroll
            for (int b = 0; b < 2; ++b)
#pragma unroll
                for (int m = 0; m < 4; ++m)
#pragma unroll
                    for (int n = 0; n < 2; ++n) acc[a][b][m][n] = (f32x4){0.f, 0.f, 0.f, 0.f};
        cur = nxt; cA = nA; cB = nB; ++ui;
        if constexpr (ALIGN_EPI) { if (wr == 1) PG8_BAR; }
    }
    PG8_WAIT_V(0);
    if constexpr (!ALIGN_EPI) { if (wr == 0) PG8_BAR; }
    PG8_BAR;
#undef PG8_SA
#undef PG8_SB
#undef PG8_STAGE
#undef PG8_LDA
#undef PG8_LDB
#undef PG8_MMA
#undef PG8_WAIT_V
#undef PG8_WAIT_L
#undef PG8_BAR
#undef PG8_SCHED
}
}

namespace fox {
constexpr int D = 128, LDQ = 8192, LDO = 2048;
constexpr float SCALE = 0.08838834764831845f;
constexpr float THR2 = 8.f * 1.4426950408889634f;
constexpr int NW = 8, QBLK = 32, KVBLK = 64, QB = NW * QBLK;
constexpr int SHM_V = KVBLK * D * 2, SHM_K = KVBLK * D * 2;
constexpr int BIAS_OFF = 2 * SHM_V + 2 * SHM_K + NW * 64 * 4;
constexpr int LDS_BYTES = BIAS_OFF + 8192 * 4;

#define KSWZ(row, colB) ((row) * 256 + ((colB) ^ (((row) & 7) << 4)))
#define SBAR() __builtin_amdgcn_sched_barrier(0)
__device__ __forceinline__ int v_st(int k, int c) { const int kk = (k & ~0xC) | ((k & 4) << 1) | ((k & 8) >> 1); return ((kk >> 3) * 4 + (c >> 5)) * 512 + ((kk & 7) * 32 + (c & 31)) * 2; }
__device__ __forceinline__ int v_rd_base(int lane) { return ((lane & 3) << 3) | (((lane >> 2) & 3) << 6) | (((lane >> 4) & 1) << 5) | (((lane >> 5) & 1) << 8); }
constexpr int v_rd_off(int d0, int ks, int half) { return d0 * 512 + ks * 4096 + half * 2048; }
__device__ __forceinline__ int crow(int r, int hi) { return (r & 3) + 8 * (r >> 2) + 4 * hi; }
__device__ __forceinline__ unsigned cvtpk(float lo, float hi) { unsigned r; asm volatile("v_cvt_pk_bf16_f32 %0, %1, %2" : "=v"(r) : "v"(lo), "v"(hi)); return r; }
__device__ __forceinline__ bf16x8 load8(const bf16* p) { return *reinterpret_cast<const bf16x8*>(p); }
__device__ __forceinline__ void mask_tile(f32x16& p0, f32x16& p1, int dq) {
    const float NEG = -__builtin_inff();
#pragma unroll
    for (int r = 0; r < 16; ++r) {
        const int c = (r & 3) + 8 * (r >> 2);
        if (dq - c < 0) p0[r] = NEG;
        if (dq - c - 32 < 0) p1[r] = NEG;
    }
}
__device__ __forceinline__ void partialSM(f32x16& p0, f32x16& p1, float& m_reg, float& mn, float& alpha, const float* bl) {
    constexpr float C2 = 1.4426950408889634f * SCALE;
#pragma unroll
    for (int a = 0; a < 4; ++a) {
#ifdef FOX_NOBIAS
        const f32x4 b0 = {0,0,0,0}, b1 = {0,0,0,0};
#else
        const f32x4 b0 = *(const f32x4*)(bl + 8 * a), b1 = *(const f32x4*)(bl + 32 + 8 * a);
#endif

#pragma unroll
        for (int i = 0; i < 4; ++i) { p0[4 * a + i] = fmaf(p0[4 * a + i], C2, b0[i]); p1[4 * a + i] = fmaf(p1[4 * a + i], C2, b1[i]); }
        SBAR(); }
    float pmax = p0[0]; for (int r = 1; r < 16; ++r) pmax = fmaxf(pmax, p0[r]); for (int r = 0; r < 16; ++r) pmax = fmaxf(pmax, p1[r]);
    { auto rr = __builtin_amdgcn_permlane32_swap(__float_as_uint(pmax), __float_as_uint(pmax), false, false);
      pmax = fmaxf(__uint_as_float(rr[0]), __uint_as_float(rr[1])); }
    if (__builtin_expect(__all((pmax - m_reg) <= THR2), 1)) { mn = m_reg; alpha = 1.f; }
    else { mn = fmaxf(m_reg, pmax); alpha = __builtin_amdgcn_exp2f(m_reg - mn); m_reg = mn; }
    for (int r = 0; r < 16; ++r) p0[r] = p0[r] - mn; for (int r = 0; r < 16; ++r) p1[r] = p1[r] - mn;
    for (int r = 0; r < 16; ++r) p0[r] = __builtin_amdgcn_exp2f(p0[r]);
}
__device__ __forceinline__ void finishSM(f32x16& p0, f32x16& p1, float alpha, float& l_reg, bf16x8& pa0, bf16x8& pa1, bf16x8& pa2, bf16x8& pa3) {
    for (int r = 0; r < 16; ++r) p1[r] = __builtin_amdgcn_exp2f(p1[r]);
    float ps = 0; for (int r = 0; r < 16; ++r) ps += p0[r]; for (int r = 0; r < 16; ++r) ps += p1[r];
    { auto rr = __builtin_amdgcn_permlane32_swap(__float_as_uint(ps), __float_as_uint(ps), false, false);
      ps = __uint_as_float(rr[0]) + __uint_as_float(rr[1]); }
    l_reg = l_reg * alpha + ps;
#define PK4(P, B_, OUT) do { unsigned a0 = cvtpk(P[B_+0], P[B_+1]), a1 = cvtpk(P[B_+2], P[B_+3]);                          \
        unsigned b0 = cvtpk(P[B_+4], P[B_+5]), b1 = cvtpk(P[B_+6], P[B_+7]);                                             \
        auto r0 = __builtin_amdgcn_permlane32_swap(a0, b0, false, false); auto r1 = __builtin_amdgcn_permlane32_swap(a1, b1, false, false); \
        u32x4 w = {r0[0], r1[0], r0[1], r1[1]}; OUT = *reinterpret_cast<bf16x8*>(&w); } while (0)
    PK4(p0, 0, pa0); PK4(p0, 8, pa1); PK4(p1, 0, pa2); PK4(p1, 8, pa3);
#undef PK4
}
template <int KB>
__device__ __forceinline__ void qkt(f32x16& p0, f32x16& p1, const char* K_lds, int r32, int hi, const bf16x8* qr) {
    p0 = f32x16{}; p1 = f32x16{};
    const char* kb[4];
#pragma unroll
    for (int dd = 0; dd < 4; ++dd) kb[dd] = K_lds + KB * SHM_K + KSWZ(r32, (dd * 16 + hi * 8) * 2);
#pragma unroll
    for (int d0 = 0; d0 < 8; ++d0) { const char* a = kb[d0 & 3] + (d0 >> 2) * 128;
        bf16x8 b0 = *reinterpret_cast<const bf16x8*>(a);
        bf16x8 b1 = *reinterpret_cast<const bf16x8*>(a + 32 * 256);
        p0 = __builtin_amdgcn_mfma_f32_32x32x16_bf16(b0, qr[d0], p0, 0, 0, 0);
        p1 = __builtin_amdgcn_mfma_f32_32x32x16_bf16(b1, qr[d0], p1, 0, 0, 0); }
}
template <int VB>
__device__ __forceinline__ void pv_tile(f32x16* o, int vb0, bf16x8 pa0, bf16x8 pa1, bf16x8 pa2, bf16x8 pa3) {
#define TRRD(dst, off) asm volatile("ds_read_b64_tr_b16 %0, %1 offset:%2" : "=&v"(dst) : "v"(vb0), "i"(off) : "memory")
#define PV_D0(d0) do { s16x4 l0, l1, l2, l3, h0, h1, h2, h3; constexpr int b_ = VB * SHM_V + v_rd_off(d0, 0, 0); \
        TRRD(l0, b_); TRRD(h0, b_ + 2048); TRRD(l1, b_ + 4096); TRRD(h1, b_ + 6144); TRRD(l2, b_ + 8192); TRRD(h2, b_ + 10240); TRRD(l3, b_ + 12288); TRRD(h3, b_ + 14336); \
        asm volatile("s_waitcnt lgkmcnt(0)" ::: "memory"); SBAR();   \
        o[d0] = __builtin_amdgcn_mfma_f32_32x32x16_bf16(pa0, (bf16x8){l0[0], l0[1], l0[2], l0[3], h0[0], h0[1], h0[2], h0[3]}, o[d0], 0, 0, 0);   \
        o[d0] = __builtin_amdgcn_mfma_f32_32x32x16_bf16(pa1, (bf16x8){l1[0], l1[1], l1[2], l1[3], h1[0], h1[1], h1[2], h1[3]}, o[d0], 0, 0, 0);   \
        o[d0] = __builtin_amdgcn_mfma_f32_32x32x16_bf16(pa2, (bf16x8){l2[0], l2[1], l2[2], l2[3], h2[0], h2[1], h2[2], h2[3]}, o[d0], 0, 0, 0);   \
        o[d0] = __builtin_amdgcn_mfma_f32_32x32x16_bf16(pa3, (bf16x8){l3[0], l3[1], l3[2], l3[3], h3[0], h3[1], h3[2], h3[3]}, o[d0], 0, 0, 0); } while (0)
    PV_D0(0); PV_D0(1); PV_D0(2); PV_D0(3);
#undef PV_D0
#undef TRRD
}

struct BlockRef { const bf16* Q; const bf16* K; const bf16* V; const bf16* G; bf16* O; int P0; };
struct Seam { bf16x8 qr[8]; bf16x8 st_v0, st_v1, st_k0, st_k1; };
#define LD8(base, boff) (*reinterpret_cast<const bf16x8*>((const char*)(base) + (boff)))
#define VMW() asm volatile("s_waitcnt vmcnt(0)" ::: "memory")
#define VMWN(n) asm volatile("s_waitcnt vmcnt(%0)" :: "i"(n) : "memory")
#define SLOAD_H(Kp, Vp, k0) do { const char* kb__ = (const char*)(Kp) + (size_t)(k0) * (LDQ * 2); const char* vb__ = (const char*)(Vp) + (size_t)(k0) * (LDQ * 2); \
                         S.st_v0 = LD8(vb__, kvoff); S.st_v1 = LD8(vb__, kvoff + 32u * LDQ * 2u);              \
                         S.st_k0 = LD8(kb__, kvoff); S.st_k1 = LD8(kb__, kvoff + 32u * LDQ * 2u); } while (0)
#define SWRITE_HK(bf) do { *(bf16x8*)(K_lds + (bf) * SHM_K + kws) = S.st_k0; *(bf16x8*)(K_lds + (bf) * SHM_K + kws + 32 * 256) = S.st_k1; } while (0)
#define SWRITE_HV(bf) do { *(bf16x8*)(V_lds + (bf) * SHM_V + vst0) = S.st_v0; *(bf16x8*)(V_lds + (bf) * SHM_V + vst1) = S.st_v1; } while (0)
#define SWRITE_H(bf) do { SWRITE_HV(bf); SWRITE_HK(bf); } while (0)
__device__ __forceinline__ void prime(const BlockRef& cur, char* lds, Seam& S) {
    const int tid = threadIdx.x, wid = __builtin_amdgcn_readfirstlane(tid >> 6), lane = tid & 63, r32 = lane & 31, hi = lane >> 5;
    const int sr = tid >> 4, sc = (tid & 15) * 8, kws = KSWZ(sr, sc * 2); char* K_lds = lds + 2 * SHM_V;
    const unsigned kvoff = (unsigned)(sr * LDQ + sc) * 2u, qoff = (unsigned)((wid * QBLK + r32) * LDQ + hi * 8) * 2u;
    for (int d0 = 0; d0 < 8; ++d0) S.qr[d0] = LD8(cur.Q, qoff + d0 * 32);
    SLOAD_H(cur.K, cur.V, 0); VMW(); SWRITE_HK(0);
    __syncthreads();
}
__device__ __forceinline__ void block(const BlockRef& cur, const BlockRef& nxt, char* lds, Seam& S) {
    const int tid = threadIdx.x, wid = __builtin_amdgcn_readfirstlane(tid >> 6), lane = tid & 63, r32 = lane & 31, hi = lane >> 5;
    const int NT = (cur.P0 + QB - 1) / KVBLK + 1;
    const int qlo = cur.P0 + wid * QBLK, qm = qlo + r32 - 4 * hi;
    char* V_lds = lds; char* K_lds = lds + 2 * SHM_V;
    float* ws = (float*)(lds + 2 * SHM_V + 2 * SHM_K) + wid * 64; float* li_l = ws, * al_l = ws + 32;
    const float* biasl = (const float*)(lds + BIAS_OFF) + 4 * hi;
    float m_reg = -1e30f, l_reg = 0; f32x16 o[4] = {};
    const int sr = tid >> 4, sc = (tid & 15) * 8, vst0 = v_st(sr, sc), vst1 = v_st(32 + sr, sc), kws = KSWZ(sr, sc * 2);
    const unsigned kvoff = (unsigned)(sr * LDQ + sc) * 2u;
    const int vb0 = (int)(uintptr_t)V_lds + v_rd_base(lane);
    const bf16* Kh = cur.K; const bf16* Vh = cur.V;
#define RESC(a) do { if (__any((a) < 1.f)) { if (hi == 0) al_l[r32] = (a); asm volatile("s_waitcnt lgkmcnt(0)" ::: "memory");              \
                     for (int d_ = 0; d_ < 4; ++d_) for (int r = 0; r < 16; ++r) o[d_][r] *= al_l[crow(r, hi)]; } } while (0)
#define KBASE(t) ((t) * KVBLK)
#define MASKT(P0_, P1_, t) do { const int kb_ = KBASE(t); if (kb_ + KVBLK - 1 > qlo) mask_tile(P0_, P1_, qm - kb_); } while (0)
    constexpr int NQL = 8;
#define SEAM_K0() do { VMWN(NQL); SWRITE_HK(0); SBAR(); } while (0)
    f32x16 pA0, pA1, pB0, pB1; float mnA, mnB, alA, alB; bf16x8 pa0, pa1, pa2, pa3;
    SWRITE_HV(0); SBAR();
    if (NT > 1) { SLOAD_H(Kh, Vh, KBASE(1)); }
    SBAR(); qkt<0>(pA0, pA1, K_lds, r32, hi, S.qr);
    MASKT(pA0, pA1, 0); partialSM(pA0, pA1, m_reg, mnA, alA, biasl + KBASE(0));
    if (NT > 1) { VMW(); SWRITE_H(1); }
    __syncthreads();
#define HALF_STEP(PX0, PX1, mnX, alX, PY0, PY1, alY, t, KB, VB, SB) do {                                                      \
        SBAR(); qkt<KB>(PX0, PX1, K_lds, r32, hi, S.qr);                                                                      \
        finishSM(PY0, PY1, alY, l_reg, pa0, pa1, pa2, pa3); SBAR();                                                           \
        if ((t) + 1 < NT) { SLOAD_H(Kh, Vh, KBASE((t) + 1)); SBAR(); }                                                        \
        pv_tile<VB>(o, vb0, pa0, pa1, pa2, pa3); MASKT(PX0, PX1, (t)); partialSM(PX0, PX1, m_reg, mnX, alX, biasl + KBASE(t)); \
        __syncthreads();                                                                                                      \
        if ((t) + 1 < NT) { VMW(); SWRITE_H(SB); }                                                                            \
        RESC(alX); __syncthreads(); } while (0)
    for (int t = 1; t + 1 < NT; t += 2) {
        HALF_STEP(pB0, pB1, mnB, alB, pA0, pA1, alA, t, 1, 0, 0);
        HALF_STEP(pA0, pA1, mnA, alA, pB0, pB1, alB, t + 1, 0, 1, 1);
    }
    const bool even = (NT & 1) == 0;
    if (even) { SBAR(); qkt<1>(pB0, pB1, K_lds, r32, hi, S.qr); SBAR(); }
    SLOAD_H(nxt.K, nxt.V, 0); SBAR();
    { unsigned qoff = (unsigned)((wid * QBLK + r32) * LDQ + hi * 8) * 2u; asm volatile("" : "+v"(qoff));
#pragma unroll
      for (int d0 = 0; d0 < 8; ++d0) S.qr[d0] = LD8(nxt.Q, qoff + d0 * 32); }
    SBAR();
    finishSM(pA0, pA1, alA, l_reg, pa0, pa1, pa2, pa3); SBAR();
    pv_tile<0>(o, vb0, pa0, pa1, pa2, pa3);
    if (even) { MASKT(pB0, pB1, NT - 1); partialSM(pB0, pB1, m_reg, mnB, alB, biasl + KBASE(NT - 1)); __syncthreads(); RESC(alB);
        finishSM(pB0, pB1, alB, l_reg, pa0, pa1, pa2, pa3); SBAR(); pv_tile<1>(o, vb0, pa0, pa1, pa2, pa3); }
    SBAR(); SEAM_K0();
    if (hi == 0) li_l[r32] = l_reg; asm volatile("s_waitcnt lgkmcnt(0)" ::: "memory");
    float rli[16];
#pragma unroll
    for (int r = 0; r < 16; ++r) rli[r] = __builtin_amdgcn_rcpf(li_l[crow(r, hi)]);
    unsigned ooff = (unsigned)((wid * QBLK + 4 * hi) * LDO + r32) * 2u, goff = (unsigned)((wid * QBLK + 4 * hi) * LDQ + r32) * 2u;
    asm volatile("" : "+v"(ooff), "+v"(goff));
#pragma unroll
    for (int r = 0; r < 16; ++r) { const unsigned rr = (unsigned)((r & 3) + 8 * (r >> 2));
#pragma unroll
        for (int d0 = 0; d0 < 4; ++d0) {
#ifdef FOX_NOGATE
            const float gv = 0.f;
#else
            const float gv = bf2f(*(const bf16*)((const char*)cur.G + (goff + rr * (LDQ * 2u) + d0 * 64u)));
#endif

            const float v = o[d0][r] * rli[r] * (1.0f / (1.0f + __expf(-gv)));
            const float vn = __shfl_xor(v, 1);
            if ((r32 & 1) == 0) *(unsigned*)((char*)cur.O + (ooff + rr * (LDO * 2u) + d0 * 64u)) = cvtpk(v, vn); } }
    __syncthreads();
#undef RESC
#undef KBASE
#undef MASKT
#undef SEAM_K0
#undef HALF_STEP
}
#undef LD8
#undef VMW
#undef VMWN
#undef SLOAD_H
#undef SWRITE_HK
#undef SWRITE_HV
#undef SWRITE_H
#undef KSWZ
#undef SBAR
}

constexpr int NWAVES = 8;
constexpr size_t MiB = 1u << 20;
constexpr size_t WS_CTL = 0, CTL_ZERO_BYTES = 1 * MiB;
constexpr size_t WS_MEMN = 1 * MiB;
constexpr size_t WS_KMEM = 2 * MiB;
constexpr size_t WS_VTMEM = 4 * MiB;
constexpr size_t WS_SMALL = 6 * MiB;
constexpr size_t SM_BONUS = 0;
constexpr size_t SM_FPRE = 512 * 1024;
constexpr size_t SM_BIASL2 = 1024 * 1024;
constexpr size_t SM_BCUM = 1536 * 1024;
constexpr size_t SM_IG = SM_BCUM + 128 * 1024;
constexpr size_t SM_WSTATE = SM_IG + 128 * 1024;
constexpr size_t SM_CHBL = SM_WSTATE + 128 * 1024;
constexpr size_t SM_CHMD = SM_CHBL + 4096;
constexpr size_t SM_MSEQ = SM_CHMD + 4096;
constexpr size_t SM_WCARRY = SM_MSEQ + 4096;
constexpr size_t SM_TOPI = 2048 * 1024;
constexpr size_t SM_TOPG = SM_TOPI + 64 * 1024;
constexpr size_t SM_SLOT = SM_TOPG + 64 * 1024;
constexpr size_t SM_BLKCNT = SM_SLOT + 64 * 1024;
constexpr size_t SM_TILEE = SM_BLKCNT + 8192;
constexpr size_t SM_NU = 3 * 1024 * 1024;
constexpr size_t WS_X = 16 * MiB;
constexpr size_t WS_XN = 80 * MiB;
constexpr size_t WS_W_XQ = 112 * MiB, WS_W_XKV = 128 * MiB, WS_W_XO = 160 * MiB, WS_W_ABIN = 176 * MiB, WS_W_LORA = 206 * MiB, WS_W_ABOUT = 209 * MiB,
                 WS_W_FFNGU = 217 * MiB, WS_W_FFND = 261 * MiB, WS_W_FOXIN = 283 * MiB, WS_W_FOXOUT = 315 * MiB, WS_W_MOEGU = 323 * MiB, WS_W_MOED = 675 * MiB;
constexpr size_t WS_R = 851 * MiB;
constexpr size_t R_PROJ = WS_R + 0 * MiB;
constexpr size_t R_GATES32 = WS_R + 120 * MiB;
constexpr size_t R_LORAIN = WS_R + 128 * MiB;
constexpr size_t R_LORAOUT = WS_R + 136 * MiB;
constexpr size_t R_SC = WS_R + 232 * MiB;
constexpr size_t SC_STRIDE = 32 * MiB;
constexpr size_t R_Y = WS_R + 424 * MiB;
constexpr size_t R_QB = WS_R + 456 * MiB, R_KB = WS_R + 472 * MiB, R_VB = WS_R + 488 * MiB;
constexpr size_t R_U = WS_R + 504 * MiB;
constexpr size_t R_YCAT = WS_R + 568 * MiB;
constexpr size_t R_XQ = WS_R + 0 * MiB;
constexpr size_t R_XS = WS_R + 32 * MiB;
constexpr size_t R_XP = WS_R + 64 * MiB;
constexpr size_t R_XO = WS_R + 80 * MiB;
constexpr size_t R_ACT = WS_R + 112 * MiB;
constexpr size_t R_QKVG = WS_R + 200 * MiB;
constexpr size_t R_ATTO = WS_R + 328 * MiB;
constexpr size_t R_AG = WS_R + 0 * MiB;
constexpr size_t R_ACTG = WS_R + 72 * MiB;
constexpr size_t R_YG = WS_R + 270 * MiB;
constexpr size_t WS_END = WS_R + 600 * MiB;
static_assert(R_YG + (size_t)MOE_ROWS * D * 4 <= WS_END && R_ACTG + (size_t)MOE_ROWS * DFF * 2 <= R_YG && R_YCAT + (size_t)T * D * 2 <= WS_END, "ws map");
static_assert(WS_W_MOED + (size_t)NEXP * D * DFF * 2 <= WS_R && WS_W_MOEGU + (size_t)NEXP * 2 * DFF * D * 2 <= WS_W_MOED, "ws map (weights)");
constexpr int CW_BAR = 4096;

constexpr int RING_OFF = 0, RING_BYTES = 131072;
constexpr int LDSCTL_OFF = RING_BYTES, MISC_OFF = LDSCTL_OFF + 320;
constexpr int LDS_BYTES = 147456;

typedef GAS unsigned gu32;
#define RLX_AGENT __ATOMIC_RELAXED, __HIP_MEMORY_SCOPE_AGENT
#define LDS_WAIT() asm volatile("s_waitcnt lgkmcnt(0)" ::: "memory")
#define VM_WAIT() asm volatile("s_waitcnt vmcnt(0)" ::: "memory")

#define XB_TMO      128
#define XB_XCNT(j)  (256  + 64 * (j))
#define XB_XSUB(j)  (1280 + 64 * (j))
#define XB_XGEN(j)  (2304 + 64 * (j))
#define XB_TOP      3328
#define XB_TOPGEN   3392
#define XCD_BAR_WORDS 3456
#define XB_SPIN_CAP (1u << 18)
__device__ __forceinline__ unsigned xb_ld(unsigned* p)              { return __hip_atomic_load(p, __ATOMIC_RELAXED, __HIP_MEMORY_SCOPE_AGENT); }
__device__ __forceinline__ unsigned xb_add(unsigned* p, unsigned v) { return __hip_atomic_fetch_add(p, v, __ATOMIC_RELAXED, __HIP_MEMORY_SCOPE_AGENT); }
__device__ __forceinline__ unsigned xb_xcc_id() { return (unsigned)__builtin_amdgcn_s_getreg((3 << 11) | 20) & 0xFu; }
#define XB_SPIN(cond, bar) do { unsigned _sp = 0; while (cond) { __builtin_amdgcn_s_sleep(1); \
    if ((++_sp & 255u) == 0u) { if (xb_ld(&(bar)[XB_TMO])) break; if (_sp > XB_SPIN_CAP) { atomicAdd(&(bar)[XB_TMO], 1u); break; } } } } while (0)
struct XcdBarrier { unsigned* bar; unsigned x; volatile LAS unsigned* st; };
__device__ __forceinline__ XcdBarrier xcd_barrier_post(unsigned* bar, volatile LAS unsigned* st) {
    XcdBarrier b; b.bar = bar; b.x = xb_xcc_id(); b.st = st;
    if (threadIdx.x == 0) (void)xb_add(&bar[XB_XCNT(b.x)], 1u);
    return b;
}
__device__ __forceinline__ void xcd_barrier_complete(unsigned* bar, unsigned x, unsigned& nloc, unsigned& nx) {
    const unsigned G = gridDim.x * gridDim.y * gridDim.z;
    unsigned sum, cnt, mine, sp = 0u;
    for (;;) {
        sum = 0u; cnt = 0u; mine = 0u;
#pragma unroll
        for (unsigned j = 0; j < 16; ++j) { const unsigned c = xb_ld(&bar[XB_XCNT(j)]); sum += c; cnt += (c > 0u) ? 1u : 0u; mine = (j == x) ? c : mine; }
        if (sum == G) break;
        __builtin_amdgcn_s_sleep(1);
        if ((++sp & 255u) == 0u) { if (xb_ld(&bar[XB_TMO])) break; if (sp > XB_SPIN_CAP) { atomicAdd(&bar[XB_TMO], 1u); break; } }
    }
    nloc = mine > 0u ? mine : 1u; nx = cnt > 0u ? cnt : 1u;
}
__device__ __forceinline__ void xcd_barrier(const XcdBarrier& b) {
    asm volatile("s_waitcnt vmcnt(0)" ::: "memory");
    __syncthreads();
    if (threadIdx.x == 0) {
        unsigned* bar = b.bar;
        __builtin_amdgcn_s_waitcnt(0);
        unsigned nloc = b.st[0], nx = b.st[1];
        if (nloc == 0u) { xcd_barrier_complete(bar, b.x, nloc, nx); b.st[0] = nloc; b.st[1] = nx; }
        const unsigned old = xb_add(&bar[XB_XSUB(b.x)], 1u);
        const unsigned gen = old / nloc;
        if (old + 1u == (gen + 1u) * nloc) {
            __builtin_amdgcn_fence(__ATOMIC_RELEASE, "agent");
            asm volatile("s_waitcnt vmcnt(0)" ::: "memory");
            const unsigned og = xb_add(&bar[XB_TOP], 1u);
            const unsigned tg = og / nx;
            if (og + 1u == (tg + 1u) * nx) xb_add(&bar[XB_TOPGEN], 1u);
            else XB_SPIN(xb_ld(&bar[XB_TOPGEN]) == tg, bar);
            __builtin_amdgcn_fence(__ATOMIC_ACQUIRE, "agent");
            xb_add(&bar[XB_XGEN(b.x)], 1u);
            asm volatile("s_waitcnt vmcnt(0)" ::: "memory");
        } else {
            XB_SPIN(xb_ld(&bar[XB_XGEN(b.x)]) == gen, bar);
            __builtin_amdgcn_fence(__ATOMIC_ACQUIRE, "agent");
            asm volatile("s_waitcnt vmcnt(0)" ::: "memory");
        }
    }
    __syncthreads();
}

struct Frame {
    LAS unsigned char* lds; unsigned char* ldsg;
    unsigned char* ws; const float* const* in; float* out;
    int tid, lane, wave, vcu, G, gw, NGW;
};

enum InIdx { I_X = 0, I_MEM, I_MEMG, I_FING, I_NMIXG, I_NXAG, I_NFFNG, I_XWQ, I_XWKV, I_XWO, I_ABWIN, I_ABMU, I_RWW0, I_RWWUP, I_RWA0, I_RWAUP, I_RWGUP, I_RWKK, I_RWKA, I_RWRK,
             I_RWLNG, I_RWLNB, I_MLCONV, I_MLBIF, I_MLNG, I_ABWOUT, I_FFG, I_FFU, I_FFD, I_FOXWIN, I_FOXBF, I_FOXQG, I_FOXKG, I_FOXWOUT, I_ROUTER, I_MOEG, I_MOEU, I_MOED, N_IN };
struct Args { const float* in[N_IN]; float* out; unsigned char* ws; int ph_lo, ph_hi; };
static_assert(sizeof(Args) == (N_IN + 2) * 8 + 8, "Args has no padding");

#define WSP(T_, off) ((T_*)(F.ws + (off)))

__device__ __forceinline__ void rms_row(const float* xrow, const float* g, bf16* orow, int lane, f32x4 (&y)[8]) {
    const f32x4* xr = (const f32x4*)xrow + lane; const f32x4* gr = (const f32x4*)g + lane;
    float s = 0.f;
#pragma unroll
    for (int j = 0; j < 8; ++j) { y[j] = xr[64 * j]; s += (y[j][0] * y[j][0] + y[j][1] * y[j][1]) + (y[j][2] * y[j][2] + y[j][3] * y[j][3]); }
    const float r = 1.0f / sqrtf(wave_sum(s) * (1.0f / D) + 1e-6f);
#pragma unroll
    for (int j = 0; j < 8; ++j) { const f32x4 gv = gr[64 * j]; y[j] = y[j] * r * gv; }
    if (orow) { u32x2* o8 = (u32x2*)orow + lane;
#pragma unroll
        for (int j = 0; j < 8; ++j) { u32x2 w; w.x = cvt_pk_bf16(y[j][0], y[j][1]); w.y = cvt_pk_bf16(y[j][2], y[j][3]); o8[64 * j] = w; } }
}
__device__ __forceinline__ void norm_phase(const Frame& F, const float* X, const float* g, bf16* XN, int nrows) {
    for (int t = F.gw; t < nrows; t += F.NGW) { f32x4 y[8]; rms_row(X + (size_t)t * D, g, XN + (size_t)t * D, F.lane, y); }
}
template <int NC>
__device__ __forceinline__ void stage_skinny(const Frame& F, const float* W, int ldw, int c0, LAS float* Ws) {
    for (int i = F.tid; i < D * NC; i += NWAVES * 64) { const int e = i / NC, c = i % NC; Ws[c * D + e] = W[(size_t)e * ldw + c0 + c]; }
}
template <int NC>
__device__ __forceinline__ void skinny_dot(const f32x4 (&y)[8], const LAS float* Ws, int lane, float (&out)[NC]) {
#pragma unroll
    for (int c = 0; c < NC; ++c) { float s = 0.f;
#pragma unroll
        for (int j = 0; j < 8; ++j) { const f32x4 w = *(const LAS f32x4*)(Ws + c * D + 256 * j + 4 * lane); s += (y[j][0] * w[0] + y[j][1] * w[1]) + (y[j][2] * w[2] + y[j][3] * w[3]); }
        out[c] = wave_sum(s); }
}

__device__ __forceinline__ void transpose_item(const float* W, int ldw, int k0, int n0, int nvalid, bf16* WT0  , int K, LAS float* scr, int lane) {
#pragma unroll 8
    for (int i = 0; i < 32; ++i) { const int kk = 2 * i + (lane >> 5), n = lane & 31; scr[kk * 33 + n] = (n < nvalid) ? W[(size_t)(k0 + kk) * ldw + n0 + n] : 0.f; }
    LDS_WAIT(); asm volatile("" ::: "memory");
    const int c = lane & 7;
#pragma unroll
    for (int j = 0; j < 4; ++j) { const int n = (lane >> 3) + 8 * j; const LAS float* s = scr + (8 * c) * 33 + n;
        u32x4 o; o.x = cvt_pk_bf16(s[0 * 33], s[1 * 33]); o.y = cvt_pk_bf16(s[2 * 33], s[3 * 33]); o.z = cvt_pk_bf16(s[4 * 33], s[5 * 33]); o.w = cvt_pk_bf16(s[6 * 33], s[7 * 33]);
        if (n < nvalid) *(u32x4*)(WT0 + (size_t)n * K + k0 + 8 * c) = o; }
    LDS_WAIT(); asm volatile("" ::: "memory");
}
__device__ __forceinline__ void transpose_matrix(const Frame& F, const float* W, int ldw, int K, int N, bf16* WT, int mode, int& it0, LAS float* scr) {
    const int nblk = (N + 31) / 32, nitems = (K / 64) * nblk;
    int first = F.gw - (it0 % F.NGW); if (first < 0) first += F.NGW;
    for (int r = first; r < nitems; r += F.NGW) {
        const int kb = r / nblk, nb = r % nblk, n0 = 32 * nb; const int nvalid = (N - n0) < 32 ? (N - n0) : 32;
        const int drow = mode == 0 ? n0 : ((n0 >> 7) * 256 + (n0 & 127) + (mode == 2 ? 128 : 0));
        transpose_item(W, ldw, 64 * kb, n0, nvalid, WT + (size_t)drow * K, K, scr, F.lane);
    }
    it0 += nitems;
}
__device__ __forceinline__ void p_convert(const Frame& F, const Args& A) {
    LAS float* scr = (LAS float*)(F.lds + RING_OFF + F.wave * 16384);
    int it0 = 0;
    for (int l = 0; l < 2; ++l) {
        transpose_matrix(F, A.in[I_XWQ] + (size_t)l * D * D, D, D, D, WSP(bf16, WS_W_XQ) + (size_t)l * D * D, 0, it0, scr);
        transpose_matrix(F, A.in[I_XWKV] + (size_t)l * D * 2 * D, 2 * D, D, 2 * D, WSP(bf16, WS_W_XKV) + (size_t)l * 2 * D * D, 0, it0, scr);
        transpose_matrix(F, A.in[I_XWO] + (size_t)l * D * D, D, D, D, WSP(bf16, WS_W_XO) + (size_t)l * D * D, 0, it0, scr);
    }
    transpose_matrix(F, A.in[I_ABWIN], AB_COLS, D, AB_COLS, WSP(bf16, WS_W_ABIN), 0, it0, scr);
    transpose_matrix(F, A.in[I_ABWOUT], D, D, D, WSP(bf16, WS_W_ABOUT), 0, it0, scr);
    transpose_matrix(F, A.in[I_FFG], DFF, D, DFF, WSP(bf16, WS_W_FFNGU), 1, it0, scr);
    transpose_matrix(F, A.in[I_FFU], DFF, D, DFF, WSP(bf16, WS_W_FFNGU), 2, it0, scr);
    transpose_matrix(F, A.in[I_FFD], D, DFF, D, WSP(bf16, WS_W_FFND), 0, it0, scr);
    transpose_matrix(F, A.in[I_FOXWIN], FOX_LD, D, 8192, WSP(bf16, WS_W_FOXIN), 0, it0, scr);
    transpose_matrix(F, A.in[I_FOXWOUT], D, D, D, WSP(bf16, WS_W_FOXOUT), 0, it0, scr);
    for (int e = 0; e < NEXP; ++e) {
        transpose_matrix(F, A.in[I_MOEG] + (size_t)e * D * DFF, DFF, D, DFF, WSP(bf16, WS_W_MOEGU) + (size_t)e * 2 * DFF * D, 1, it0, scr);
        transpose_matrix(F, A.in[I_MOEU] + (size_t)e * D * DFF, DFF, D, DFF, WSP(bf16, WS_W_MOEGU) + (size_t)e * 2 * DFF * D, 2, it0, scr);
        transpose_matrix(F, A.in[I_MOED] + (size_t)e * DFF * D, D, DFF, D, WSP(bf16, WS_W_MOED) + (size_t)e * D * DFF, 0, it0, scr);
    }
    const int gt = F.gw * 64 + F.lane, NGT = F.NGW * 64;
    { u32x4* z = (u32x4*)(WSP(bf16, WS_W_ABIN) + (size_t)AB_COLS * D); const int n16 = (AB_PAD - AB_COLS) * D * 2 / 16;
      for (int i = gt; i < n16; i += NGT) z[i] = (u32x4){0u, 0u, 0u, 0u}; }
    { bf16* WL = WSP(bf16, WS_W_LORA); const float* wup = A.in[I_RWWUP]; const float* aup = A.in[I_RWAUP]; const float* gup = A.in[I_RWGUP];
      for (int i = gt; i < 3072 * 64; i += NGT) { const int n = i >> 6, k8 = (i & 63) * 8; const int sec = n >> 10, nn = n & 1023; float v[8];
#pragma unroll
          for (int j = 0; j < 8; ++j) { const int k = k8 + j; float x = 0.f;
              if (sec == 0) { if (k < 96) x = wup[(size_t)k * 1024 + nn]; }
              else if (sec == 1) { if (k >= 96 && k < 192) x = aup[(size_t)(k - 96) * 1024 + nn]; }
              else { if (k >= 192 && k < 448) x = gup[(size_t)(k - 192) * 1024 + nn]; }
              v[j] = x; }
          u32x4 o; o.x = cvt_pk_bf16(v[0], v[1]); o.y = cvt_pk_bf16(v[2], v[3]); o.z = cvt_pk_bf16(v[4], v[5]); o.w = cvt_pk_bf16(v[6], v[7]);
          *(u32x4*)(WL + (size_t)n * 512 + k8) = o; } }
    norm_phase(F, A.in[I_MEM], A.in[I_MEMG], WSP(bf16, WS_MEMN), NMEM);
    norm_phase(F, A.in[I_X], A.in[I_NMIXG], WSP(bf16, WS_XN), T);
}

struct KvOrder {
    const bf16* memn; const bf16* wkv; int c;
    __device__ __forceinline__ bool next(int i, pg8::Unit& u) const {
        if (i != 0 || c >= 32) return false;
        const int l = c >> 4, kind = (c >> 3) & 1, idx = c & 7; const bf16* w = wkv + (size_t)l * 2 * D * D;
        if (kind == 0) { u.a = (const char*)memn; u.b = (const char*)(w + (size_t)idx * 256 * D); u.pm = 0; u.pn = idx; }
        else { u.a = (const char*)(w + (size_t)(D + idx * 256) * D); u.b = (const char*)memn; u.pm = idx; u.pn = 0; }
        u.aux = l * 2 + kind; u.pad = 0; return true;
    }
};
struct EpiKv {
    static constexpr bool PERM = true;
    bf16* kmem; bf16* vtmem;
    __device__ __forceinline__ void operator()(const f32x4 (&acc)[2][2][4][2], const pg8::Unit& u, int wr, int wc, int fr, int fq) const {
        const int l = u.aux >> 1, kind = u.aux & 1;
        pg8::EpiBf16 E{kind == 0 ? kmem + (size_t)l * NMEM * D : vtmem + (size_t)l * D * NMEM, kind == 0 ? D : NMEM, nullptr, -1};
        E(acc, u, wr, wc, fr, fq);
    }
};

__device__ __forceinline__ void p_prepa(const Frame& F, const Args& A) {
    const bf16* PROJ = WSP(bf16, R_PROJ); const float* mu = A.in[I_ABMU]; const float* convw = A.in[I_MLCONV];
    bf16* LIN = WSP(bf16, R_LORAIN); bf16* QB = WSP(bf16, R_QB); bf16* KB = WSP(bf16, R_KB); bf16* VB = WSP(bf16, R_VB);
    const int lane = F.lane;
    for (int t = F.gw; t < T; t += F.NGW) {
        const bf16* p0 = PROJ + (size_t)t * AB_PAD;
#pragma unroll
        for (int i = 0; i < 7; ++i) { const int cc = lane + 64 * i, c = 3072 + cc; const float p = bf2f(p0[c]); const float pp = t > 0 ? bf2f(p0[c - AB_PAD]) : 0.f;
            const float s = p + (pp - p) * mu[c]; float o;
            if (cc < 96) o = tanhf(s); else if (cc < 192) o = s; else o = sigmoidf_(s);
            LIN[(size_t)t * 512 + cc] = f2bf(o); }
        LIN[(size_t)t * 512 + 448 + lane] = 0;
#pragma unroll
        for (int i = 0; i < 4; ++i) { const int c = 8 * lane + 512 * i; float acc[8];
#pragma unroll
            for (int j = 0; j < 8; ++j) acc[j] = 0.f;
#pragma unroll
            for (int tap = 0; tap < 4; ++tap) { const int tt = t - 3 + tap; if (tt >= 0) {
                const bf16x8 v = *(const bf16x8*)(PROJ + (size_t)tt * AB_PAD + A_COLS + c); const f32x4 w0 = *(const f32x4*)(convw + tap * 2048 + c), w1 = *(const f32x4*)(convw + tap * 2048 + c + 4);
#pragma unroll
                for (int j = 0; j < 4; ++j) { acc[j] += bf2f((unsigned short)v[j]) * w0[j]; acc[4 + j] += bf2f((unsigned short)v[4 + j]) * w1[j]; } } }
            const float sc = c < 1024 ? 0.0625f : 1.0f; float o[8];
#pragma unroll
            for (int j = 0; j < 8; ++j) o[j] = acc[j] * sigmoidf_(acc[j]) * sc;
            u32x4 w; w.x = cvt_pk_bf16(o[0], o[1]); w.y = cvt_pk_bf16(o[2], o[3]); w.z = cvt_pk_bf16(o[4], o[5]); w.w = cvt_pk_bf16(o[6], o[7]);
            if (c < 1024) *(u32x4*)(QB + (size_t)t * 1024 + c) = w; else *(u32x4*)(KB + (size_t)t * 1024 + c - 1024) = w; }
#pragma unroll
        for (int i = 0; i < 2; ++i) { const int c = 8 * lane + 512 * i; *(u32x4*)(VB + (size_t)t * 1024 + c) = *(const u32x4*)(p0 + 5568 + c); }
    }
    const float* G32 = WSP(float, R_GATES32); const float* bif = A.in[I_MLBIF];
    float* BCUM = WSP(float, WS_SMALL + SM_BCUM); float* IG = WSP(float, WS_SMALL + SM_IG); float* CHBL = WSP(float, WS_SMALL + SM_CHBL); float* CHMD = WSP(float, WS_SMALL + SM_CHMD);
    for (int u = F.gw; u < NH_M * 128; u += F.NGW) { const int h = u >> 7, c = u & 127, t = 64 * c + lane;
        const float ig = G32[(size_t)t * 256 + 192 + h] + bif[h], fg = G32[(size_t)t * 256 + 196 + h] + bif[4 + h];
        float b = logsigmoidf_(fg);
#pragma unroll
        for (int o = 1; o < 64; o <<= 1) { const float x = __shfl_up(b, o); if (lane >= o) b += x; }
        const float bl = __shfl(b, 63); const float md = wave_max(bl - b + ig);
        BCUM[h * T + t] = b; IG[h * T + t] = ig;
        if (lane == 0) { CHBL[u] = bl; CHMD[u] = md; } }
}

__device__ __forceinline__ void p_prepb(const Frame& F, const Args& A) {
    const bf16* PROJ = WSP(bf16, R_PROJ); const float* LOUT = WSP(float, R_LORAOUT); const float* mu = A.in[I_ABMU];
    const float* w0 = A.in[I_RWW0]; const float* a0 = A.in[I_RWA0]; const float* kk_ = A.in[I_RWKK]; const float* ka_ = A.in[I_RWKA]; const float* rk_ = A.in[I_RWRK];
    float* SR = WSP(float, R_SC); float* SW = WSP(float, R_SC + SC_STRIDE); float* SKM = WSP(float, R_SC + 2 * SC_STRIDE); float* SV = WSP(float, R_SC + 3 * SC_STRIDE);
    float* SKK = WSP(float, R_SC + 4 * SC_STRIDE); float* SB = WSP(float, R_SC + 5 * SC_STRIDE); float* BONUS = WSP(float, WS_SMALL + SM_BONUS);
    const int lane = F.lane;
    for (int t = F.gw; t < T; t += F.NGW) {
        const bf16* p0 = PROJ + (size_t)t * AB_PAD; const float* lo = LOUT + (size_t)t * 3072;
        for (int h = 0; h < NH_R; ++h) { const int c = 64 * h + lane;
            float r = bf2f(p0[c]), k = bf2f(p0[1024 + c]), v = bf2f(p0[2048 + c]);
            if (t > 0) { const float pr = bf2f(p0[c - AB_PAD]), pk = bf2f(p0[1024 + c - AB_PAD]), pv = bf2f(p0[2048 + c - AB_PAD]);
                r += (pr - r) * mu[c]; k += (pk - k) * mu[1024 + c]; v += (pv - v) * mu[2048 + c]; }
            else { r -= r * mu[c]; k -= k * mu[1024 + c]; v -= v * mu[2048 + c]; }
            const float w = __expf(-0.6065306597126334f * sigmoidf_(lo[c] + w0[c]));
            const float a = sigmoidf_(a0[c] + lo[1024 + c]);
            float kk = k * kk_[c]; const float nrm = sqrtf(wave_sum(kk * kk)); kk = kk / fmaxf(nrm, 1e-12f);
            const float km = k * (1.0f + (a - 1.0f) * ka_[c]);
            const float bon = wave_sum(r * km * rk_[c]);
            const size_t o = (size_t)t * 1024 + c;
            SR[o] = r; SW[o] = w; SKM[o] = km; SV[o] = v; SKK[o] = kk; SB[o] = kk * a;
            if (lane == 0) BONUS[t * 16 + h] = bon; }
    }
    if (F.gw < NH_M) { const int h = F.gw;
        const float* BCUM = WSP(float, WS_SMALL + SM_BCUM); const float* IG = WSP(float, WS_SMALL + SM_IG); const float* CHBL = WSP(float, WS_SMALL + SM_CHBL); const float* CHMD = WSP(float, WS_SMALL + SM_CHMD);
        float* MSEQ = WSP(float, WS_SMALL + SM_MSEQ); float* WCARRY = WSP(float, WS_SMALL + SM_WCARRY); float* WSTATE = WSP(float, WS_SMALL + SM_WSTATE);
        const float bl0 = CHBL[h * 128 + lane], bl1 = CHBL[h * 128 + 64 + lane], md0 = CHMD[h * 128 + lane], md1 = CHMD[h * 128 + 64 + lane];
        float m = 0.f, mine_in0 = 0.f, mine_in1 = 0.f, mine_out0 = 0.f, mine_out1 = 0.f;
#pragma unroll
        for (int c = 0; c < 128; ++c) { const float bl = __shfl(c < 64 ? bl0 : bl1, c & 63), md = __shfl(c < 64 ? md0 : md1, c & 63);
            const float mn = fmaxf(bl + m, md);
            if ((c & 63) == lane) { if (c < 64) { mine_in0 = m; mine_out0 = mn; } else { mine_in1 = m; mine_out1 = mn; } }
            m = mn; }
        MSEQ[h * 128 + lane] = mine_in0; MSEQ[h * 128 + 64 + lane] = mine_in1;
        WCARRY[h * 128 + lane] = __expf(bl0 + mine_in0 - mine_out0); WCARRY[h * 128 + 64 + lane] = __expf(bl1 + mine_in1 - mine_out1);
        for (int c = 0; c < 128; ++c) { const float bl = __shfl(c < 64 ? bl0 : bl1, c & 63), mo = __shfl(c < 64 ? mine_out0 : mine_out1, c & 63); const int t = 64 * c + lane;
            WSTATE[h * T + t] = __expf(bl - BCUM[h * T + t] + IG[h * T + t] - mo); }
    }
}

__device__ __forceinline__ float row16_sum(float x) {
    x += __builtin_bit_cast(float, __builtin_amdgcn_update_dpp(0, __builtin_bit_cast(int, x), 0xB1, 0xF, 0xF, true));
    x += __builtin_bit_cast(float, __builtin_amdgcn_update_dpp(0, __builtin_bit_cast(int, x), 0x4E, 0xF, 0xF, true));
    x += __builtin_bit_cast(float, __builtin_amdgcn_update_dpp(0, __builtin_bit_cast(int, x), 0x141, 0xF, 0xF, true));
    x += __builtin_bit_cast(float, __builtin_amdgcn_update_dpp(0, __builtin_bit_cast(int, x), 0x140, 0xF, 0xF, true));
    return x;
}
constexpr int SCH = 32;
constexpr int SC_VEC = SCH * 256;
constexpr int SC_BUF = 5 * SC_VEC + 1024;
__device__ __forceinline__ void p_scan(const Frame& F) {
    if (F.wave != 0) return;
    const int b = blockIdx.x, head = (b & 7) * 2 + ((b >> 3) & 1), rg = b >> 4, lane = F.lane, row = lane >> 4, j = lane & 15;
    const float* SR = WSP(float, R_SC); const float* SW = WSP(float, R_SC + SC_STRIDE); const float* SKM = WSP(float, R_SC + 2 * SC_STRIDE); const float* SV = WSP(float, R_SC + 3 * SC_STRIDE);
    const float* SKK = WSP(float, R_SC + 4 * SC_STRIDE); const float* SB = WSP(float, R_SC + 5 * SC_STRIDE); float* Y = WSP(float, R_Y);
    LAS unsigned char* lds = F.lds + RING_OFF;
    const size_t goff = (size_t)(lane >> 4) * 1024 + head * 64 + (lane & 15) * 4;
    f32x4 S = {0.f, 0.f, 0.f, 0.f};
#define SC_ISSUE(c_, buf_) do { const size_t t0_ = (size_t)(c_) * SCH * 1024; LAS unsigned char* d_ = lds + (buf_) * SC_BUF; \
        _Pragma("unroll") for (int q = 0; q < SCH / 4; ++q) { const size_t o_ = t0_ + (size_t)q * 4096 + goff; \
            __builtin_amdgcn_global_load_lds((const unsigned*)(SKK + o_), (LAS unsigned*)(d_ + 0 * SC_VEC + q * 1024), 16, 0, 0); \
            __builtin_amdgcn_global_load_lds((const unsigned*)(SW  + o_), (LAS unsigned*)(d_ + 1 * SC_VEC + q * 1024), 16, 0, 0); \
            __builtin_amdgcn_global_load_lds((const unsigned*)(SB  + o_), (LAS unsigned*)(d_ + 2 * SC_VEC + q * 1024), 16, 0, 0); \
            __builtin_amdgcn_global_load_lds((const unsigned*)(SKM + o_), (LAS unsigned*)(d_ + 3 * SC_VEC + q * 1024), 16, 0, 0); \
            __builtin_amdgcn_global_load_lds((const unsigned*)(SR  + o_), (LAS unsigned*)(d_ + 4 * SC_VEC + q * 1024), 16, 0, 0); } \
        { int ts_ = (c_) * SCH + lane; ts_ = ts_ < T ? ts_ : T - 1; \
          __builtin_amdgcn_global_load_lds((const unsigned*)(SV + (size_t)ts_ * 1024 + head * 64 + rg * 4), (LAS unsigned*)(d_ + 5 * SC_VEC), 16, 0, 0); } } while (0)
    SC_ISSUE(0, 0);
    for (int c = 0; c < T / SCH; ++c) {
        const int buf = c & 1;
        if (c == 0) asm volatile("s_waitcnt vmcnt(0)" ::: "memory"); else asm volatile("s_waitcnt vmcnt(32)" ::: "memory");
        if (c + 1 < T / SCH) SC_ISSUE(c + 1, buf ^ 1);
        const LAS unsigned char* d = lds + buf * SC_BUF;
#pragma unroll 8
        for (int s = 0; s < SCH; ++s) {
            const f32x4 kk = *(const LAS f32x4*)(d + 0 * SC_VEC + s * 256 + j * 16), w = *(const LAS f32x4*)(d + 1 * SC_VEC + s * 256 + j * 16), bb = *(const LAS f32x4*)(d + 2 * SC_VEC + s * 256 + j * 16);
            const f32x4 km = *(const LAS f32x4*)(d + 3 * SC_VEC + s * 256 + j * 16), r = *(const LAS f32x4*)(d + 4 * SC_VEC + s * 256 + j * 16);
            const float v = *(const LAS float*)(d + 5 * SC_VEC + s * 16 + row * 4);
            const float sa = row16_sum((S[0] * kk[0] + S[1] * kk[1]) + (S[2] * kk[2] + S[3] * kk[3]));
            S = S * w + (km * v - bb * sa);
            const float y = row16_sum((S[0] * r[0] + S[1] * r[1]) + (S[2] * r[2] + S[3] * r[3]));
            if (j == 0) Y[(size_t)(c * SCH + s) * 1024 + head * 64 + rg * 4 + row] = y;
        }
    }
    asm volatile("s_waitcnt vmcnt(0)" ::: "memory");
#undef SC_ISSUE
}

__device__ __forceinline__ void p_rwkv_post(const Frame& F, const Args& A) {
    const float* Y = WSP(float, R_Y); const float* SV = WSP(float, R_SC + 3 * SC_STRIDE); const float* LOUT = WSP(float, R_LORAOUT); const float* BONUS = WSP(float, WS_SMALL + SM_BONUS);
    const float* lng = A.in[I_RWLNG]; const float* lnb = A.in[I_RWLNB]; bf16* YCAT = WSP(bf16, R_YCAT); const int lane = F.lane;
    for (int t = F.gw; t < T; t += F.NGW)
        for (int h = 0; h < NH_R; ++h) { const int c = 64 * h + lane; const float y = Y[(size_t)t * 1024 + c];
            const float mean = wave_sum(y) * (1.0f / 64.0f), d = y - mean, var = wave_sum(d * d) * (1.0f / 64.0f);
            float o = d * (1.0f / sqrtf(var + 64e-5f)) * lng[c] + lnb[c] + BONUS[t * 16 + h] * SV[(size_t)t * 1024 + c];
            o *= LOUT[(size_t)t * 3072 + 2048 + c];
            YCAT[(size_t)t * D + c] = f2bf(o); }
}

constexpr int ML_P = 264;
__device__ __forceinline__ void ml_stage_chunk(const Frame& F, const bf16* src  , int h, int c, LAS bf16* dst) {
    for (int i = F.tid; i < 64 * 32; i += NWAVES * 64) { const int s = i >> 5, ch = i & 31;
        *(LAS u32x4*)(dst + s * ML_P + 8 * ch) = *(const u32x4*)(src + (size_t)(64 * c + s) * 1024 + 256 * h + 8 * ch); }
}
__device__ __forceinline__ void p_mlu(const Frame& F) {
    const bf16* KB = WSP(bf16, R_KB); const bf16* VB = WSP(bf16, R_VB); const float* WSTATE = WSP(float, WS_SMALL + SM_WSTATE);
    bf16* U = WSP(bf16, R_U); float* NU = WSP(float, WS_SMALL + SM_NU);
    LAS bf16* Ks = (LAS bf16*)(F.lds + RING_OFF); LAS bf16* Vs = Ks + 64 * ML_P; LAS float* wst = (LAS float*)(Vs + 64 * ML_P);
    const int lane = F.lane, r = lane & 31, hg = lane >> 5, w = F.wave;
    for (int L = F.vcu; L < NH_M * 128; L += F.G) { const int h = L >> 7, c = L & 127;
        __syncthreads();
        ml_stage_chunk(F, KB, h, c, Ks); ml_stage_chunk(F, VB, h, c, Vs);
        if (F.tid < 64) wst[F.tid] = WSTATE[h * T + 64 * c + F.tid];
        __syncthreads();
        f32x16 acc[8];
#pragma unroll
        for (int nt = 0; nt < 8; ++nt) acc[nt] = f32x16{};
#pragma unroll
        for (int ks = 0; ks < 4; ++ks) { bf16x8 a; float av[8];
#pragma unroll
            for (int jj = 0; jj < 8; ++jj) { const int s = 16 * ks + 8 * hg + jj; av[jj] = bf2f(Vs[s * ML_P + 32 * w + r]) * wst[s]; }
            { u32x4 p; p.x = cvt_pk_bf16(av[0], av[1]); p.y = cvt_pk_bf16(av[2], av[3]); p.z = cvt_pk_bf16(av[4], av[5]); p.w = cvt_pk_bf16(av[6], av[7]); a = __builtin_bit_cast(bf16x8, p); }
#pragma unroll
            for (int nt = 0; nt < 8; ++nt) { bf16x8 b;
#pragma unroll
                for (int jj = 0; jj < 8; ++jj) b[jj] = (short)Ks[(16 * ks + 8 * hg + jj) * ML_P + 32 * nt + r];
                acc[nt] = __builtin_amdgcn_mfma_f32_32x32x16_bf16(a, b, acc[nt], 0, 0, 0); } }
        bf16* Uo = U + ((size_t)(h * 128 + c) * 256 + 32 * w) * 256;
#pragma unroll
        for (int nt = 0; nt < 8; ++nt)
#pragma unroll
            for (int q = 0; q < 16; ++q) { const int vl = (q & 3) + 8 * (q >> 2) + 4 * hg; Uo[(size_t)vl * 256 + 32 * nt + r] = f2bf(acc[nt][q]); }
        if (F.tid < 256) { float s = 0.f;
            for (int ss = 0; ss < 64; ++ss) s += wst[ss] * bf2f(Ks[ss * ML_P + F.tid]);
            NU[(size_t)(h * 128 + c) * 256 + F.tid] = s; }
    }
}
__device__ __forceinline__ void p_mlscan(const Frame& F) {
    bf16* U = WSP(bf16, R_U); float* NU = WSP(float, WS_SMALL + SM_NU); const float* WCARRY = WSP(float, WS_SMALL + SM_WCARRY);
    const int gt = F.gw * 64 + F.lane, NGT = F.NGW * 64;
    for (int it = gt; it < NH_M * 65536 / 4; it += NGT) { const int h = it >> 14, e = (it & 16383) * 4;
        float C0 = 0.f, C1 = 0.f, C2 = 0.f, C3 = 0.f; bf16* p = U + (size_t)h * 128 * 65536 + e;
#pragma unroll 4
        for (int c = 0; c < 128; ++c) { const u32x2 u = *(const u32x2*)(p + (size_t)c * 65536); const float wc = WCARRY[h * 128 + c];
            u32x2 o; o.x = cvt_pk_bf16(C0, C1); o.y = cvt_pk_bf16(C2, C3); *(u32x2*)(p + (size_t)c * 65536) = o;
            C0 = wc * C0 + bf2f(u.x & 0xffffu); C1 = wc * C1 + bf2f(u.x >> 16); C2 = wc * C2 + bf2f(u.y & 0xffffu); C3 = wc * C3 + bf2f(u.y >> 16); } }
    for (int it = gt; it < NH_M * 256; it += NGT) { const int h = it >> 8, k = it & 255; float n = 0.f; float* p = NU + (size_t)h * 128 * 256 + k;
        for (int c = 0; c < 128; ++c) { const float u = p[c * 256]; p[c * 256] = n; n = WCARRY[h * 128 + c] * n + u; } }
}
__device__ __forceinline__ void p_mlout(const Frame& F, const Args& A) {
    const bf16* QB = WSP(bf16, R_QB); const bf16* KB = WSP(bf16, R_KB); const bf16* VB = WSP(bf16, R_VB); const bf16* CS = WSP(bf16, R_U); const float* NC = WSP(float, WS_SMALL + SM_NU);
    const float* BCUM = WSP(float, WS_SMALL + SM_BCUM); const float* IG = WSP(float, WS_SMALL + SM_IG); const float* MSEQ = WSP(float, WS_SMALL + SM_MSEQ);
    const bf16* PROJ = WSP(bf16, R_PROJ); const float* mhg = A.in[I_MLNG]; bf16* YCAT = WSP(bf16, R_YCAT);
    LAS bf16* Qs = (LAS bf16*)(F.lds + RING_OFF); LAS bf16* Ks = Qs + 64 * ML_P; LAS bf16* Vs = Ks + 64 * ML_P; LAS bf16* Ss = Vs + 64 * ML_P;
    LAS float* fa = (LAS float*)(Ss + 64 * 72); LAS float* bch = fa; LAS float* ich = fa + 64; LAS float* mrow = fa + 128; LAS float* wint = fa + 192; LAS float* rsum = fa + 256  ;
    LAS float* nq = fa + 384; LAS float* nvec = fa + 448  ; LAS float* Hs = (LAS float*)(F.lds + RING_OFF);
    const int lane = F.lane, r = lane & 31, hg = lane >> 5, w = F.wave;
    for (int L = F.vcu; L < NH_M * 128; L += F.G) { const int h = L >> 7, c = L & 127;
        __syncthreads();
        ml_stage_chunk(F, QB, h, c, Qs); ml_stage_chunk(F, KB, h, c, Ks); ml_stage_chunk(F, VB, h, c, Vs);
        if (F.tid < 64) { bch[F.tid] = BCUM[h * T + 64 * c + F.tid]; ich[F.tid] = IG[h * T + 64 * c + F.tid]; }
        if (F.tid < 256) nvec[F.tid] = NC[(size_t)(h * 128 + c) * 256 + F.tid];
        const float mc = MSEQ[h * 128 + c];
        __syncthreads();
        if (w == 0) { float g = ich[lane] - bch[lane];
#pragma unroll
            for (int o = 1; o < 64; o <<= 1) { const float x = __shfl_up(g, o); if (lane >= o) g = fmaxf(g, x); }
            const float mr = bch[lane] + fmaxf(mc, g); mrow[lane] = mr; wint[lane] = __expf(bch[lane] + mc - mr); }
        if (w == 1) { float s = 0.f;
            for (int k = 0; k < 256; ++k) s += nvec[k] * bf2f(Qs[lane * ML_P + k]);
            nq[lane] = s; }
        __syncthreads();
        if (w < 4) { const int st = w & 1, lt = w >> 1; f32x16 acc = f32x16{};
#pragma unroll
            for (int ks = 0; ks < 16; ++ks) { const bf16x8 a = *(const LAS bf16x8*)(Ks + (32 * st + r) * ML_P + 16 * ks + 8 * hg), b = *(const LAS bf16x8*)(Qs + (32 * lt + r) * ML_P + 16 * ks + 8 * hg);
                acc = __builtin_amdgcn_mfma_f32_32x32x16_bf16(a, b, acc, 0, 0, 0); }
            const int l = 32 * lt + r; const float bl_ = bch[l], mr = mrow[l]; float rs = 0.f;
#pragma unroll
            for (int g4 = 0; g4 < 4; ++g4) { float v4[4];
#pragma unroll
                for (int i = 0; i < 4; ++i) { const int s = 32 * st + 8 * g4 + 4 * hg + i; const float d = bl_ - bch[s] + ich[s] - mr;
                    v4[i] = (s <= l) ? acc[4 * g4 + i] * __expf(d) : 0.f; rs += v4[i]; }
                u32x2 p; p.x = cvt_pk_bf16(v4[0], v4[1]); p.y = cvt_pk_bf16(v4[2], v4[3]);
                *(LAS u32x2*)(Ss + l * 72 + 32 * st + 8 * g4 + 4 * hg) = p; }
            rs += __shfl_xor(rs, 32);
            if (hg == 0) rsum[st * 64 + l] = rs; }
        __syncthreads();
        const int lt = w & 1, vg = w >> 1; f32x16 ai[2], aa[2]; ai[0] = f32x16{}; ai[1] = f32x16{}; aa[0] = f32x16{}; aa[1] = f32x16{};
        const bf16* Cb = CS + (size_t)(h * 128 + c) * 65536;
#pragma unroll 4
        for (int ks = 0; ks < 16; ++ks) { const bf16x8 a = *(const LAS bf16x8*)(Qs + (32 * lt + r) * ML_P + 16 * ks + 8 * hg);
#pragma unroll
            for (int jt = 0; jt < 2; ++jt) { const bf16x8 b = *(const bf16x8*)(Cb + (size_t)(64 * vg + 32 * jt + r) * 256 + 16 * ks + 8 * hg);
                ai[jt] = __builtin_amdgcn_mfma_f32_32x32x16_bf16(a, b, ai[jt], 0, 0, 0); } }
#pragma unroll
        for (int ks = 0; ks < 4; ++ks) { const bf16x8 a = *(const LAS bf16x8*)(Ss + (32 * lt + r) * 72 + 16 * ks + 8 * hg);
#pragma unroll
            for (int jt = 0; jt < 2; ++jt) { bf16x8 b;
#pragma unroll
                for (int jj = 0; jj < 8; ++jj) b[jj] = (short)Vs[(16 * ks + 8 * hg + jj) * ML_P + 64 * vg + 32 * jt + r];
                aa[jt] = __builtin_amdgcn_mfma_f32_32x32x16_bf16(a, b, aa[jt], 0, 0, 0); } }
        __syncthreads();
#pragma unroll
        for (int q = 0; q < 16; ++q) { const int l = 32 * lt + (q & 3) + 8 * (q >> 2) + 4 * hg; const float wi = wint[l];
            const float den = rsum[l] + rsum[64 + l] + wi * nq[l]; const float dn = 1.0f / fmaxf(fabsf(den), __expf(-mrow[l]));
#pragma unroll
            for (int jt = 0; jt < 2; ++jt) Hs[l * 260 + 64 * vg + 32 * jt + r] = (aa[jt][q] + wi * ai[jt][q]) * dn; }
        __syncthreads();
        for (int i = 0; i < 8; ++i) { const int l = 8 * w + i, t = 64 * c + l; const f32x4 hv = *(const LAS f32x4*)(Hs + l * 260 + 4 * lane);
            const float ss = wave_sum((hv[0] * hv[0] + hv[1] * hv[1]) + (hv[2] * hv[2] + hv[3] * hv[3])); const float rn = 1.0f / sqrtf(ss * (1.0f / 256.0f) + 1e-6f);
            const f32x4 g = *(const f32x4*)(mhg + 256 * h + 4 * lane); const u32x2 ob = *(const u32x2*)(PROJ + (size_t)t * AB_PAD + 6592 + 256 * h + 4 * lane);
            const float o0 = hv[0] * rn * g[0] * sigmoidf_(bf2f(ob.x & 0xffffu)), o1 = hv[1] * rn * g[1] * sigmoidf_(bf2f(ob.x >> 16));
            const float o2 = hv[2] * rn * g[2] * sigmoidf_(bf2f(ob.y & 0xffffu)), o3 = hv[3] * rn * g[3] * sigmoidf_(bf2f(ob.y >> 16));
            u32x2 p; p.x = cvt_pk_bf16(o0, o1); p.y = cvt_pk_bf16(o2, o3);
            *(u32x2*)(YCAT + (size_t)t * D + 1024 + 256 * h + 4 * lane) = p; }
    }
}

struct XsOrder {
    const bf16* XQ; const bf16* KM; int G, c;
    __device__ __forceinline__ bool next(int i, pg8::Unit& u) const {
        const int L = i * G + c; if (L >= 32 * 4) return false;
        const int pm = L >> 2, hd = L & 3; u.pm = pm; u.pn = 0; u.aux = hd; u.pad = 0;
        u.a = (const char*)(XQ + (size_t)pm * 256 * D + 512 * hd); u.b = (const char*)(KM + 512 * hd); return true;
    }
};
struct XpvOrder {
    const bf16* XP; const bf16* VT; int G, c;
    __device__ __forceinline__ bool next(int i, pg8::Unit& u) const {
        int pm, pn; if (!pg8::static_tile(i, G, c, 32, 8, pm, pn)) return false;
        u.pm = pm; u.pn = pn; u.aux = 0; u.pad = 0;
        u.a = (const char*)(XP + (size_t)pm * 256 * 1024 + 256 * (pn >> 1)); u.b = (const char*)(VT + (size_t)pn * 256 * NMEM); return true;
    }
};
__device__ __forceinline__ void p_xsoftmax(const Frame& F) {
    const float* XS = WSP(float, R_XS); bf16* XP = WSP(bf16, R_XP); const int lane = F.lane;
    for (int t = F.gw; t < T; t += F.NGW)
#pragma unroll
        for (int hd = 0; hd < 4; ++hd) { const f32x4 s = *(const f32x4*)(XS + (size_t)t * 1024 + 256 * hd + 4 * lane);
            const float m = wave_max(fmaxf(fmaxf(s[0], s[1]), fmaxf(s[2], s[3])));
            const float e0 = __expf(s[0] - m), e1 = __expf(s[1] - m), e2 = __expf(s[2] - m), e3 = __expf(s[3] - m);
            const float inv = 1.0f / wave_sum((e0 + e1) + (e2 + e3));
            u32x2 p; p.x = cvt_pk_bf16(e0 * inv, e1 * inv); p.y = cvt_pk_bf16(e2 * inv, e3 * inv);
            *(u32x2*)(XP + (size_t)t * 1024 + 256 * hd + 4 * lane) = p; }
}

__device__ __forceinline__ void p_norm_fpre(const Frame& F, const Args& A) {
    LAS float* Ws = (LAS float*)(F.lds + RING_OFF);
    stage_skinny<16>(F, A.in[I_FOXWIN], FOX_LD, 8192, Ws);
    __syncthreads();
    const float* X = WSP(float, WS_X); bf16* XN = WSP(bf16, WS_XN); float* FPRE = WSP(float, WS_SMALL + SM_FPRE); const float* g = A.in[I_NMIXG] + D;
    for (int t = F.gw; t < T; t += F.NGW) { f32x4 y[8]; rms_row(X + (size_t)t * D, g, XN + (size_t)t * D, F.lane, y);
        float o[16]; skinny_dot<16>(y, Ws, F.lane, o);
        if (F.lane < 16) { float v = o[0];
#pragma unroll
            for (int c = 1; c < 16; ++c) v = (F.lane == c) ? o[c] : v;
            FPRE[t * 16 + F.lane] = v; } }
    __syncthreads();
}
__device__ __forceinline__ void p_foxprep(const Frame& F, const Args& A) {
    bf16* QKVG = WSP(bf16, R_QKVG); const float* qg = A.in[I_FOXQG]; const float* kg = A.in[I_FOXKG]; const int lane = F.lane;
    for (int it = F.gw; it < 2 * T; it += F.NGW) { const int t = it >> 1, sec = it & 1; const float* gg = sec ? kg : qg; const float g0 = gg[2 * lane], g1 = gg[2 * lane + 1];
        unsigned* row = (unsigned*)(QKVG + (size_t)t * 8192 + sec * 2048) + lane;
#pragma unroll 4
        for (int h = 0; h < NH_F; ++h) { const unsigned u = row[64 * h]; const float a = bf2f(u & 0xffffu), b = bf2f(u >> 16);
            const float rn = 1.0f / sqrtf(wave_sum(a * a + b * b) * (1.0f / 128.0f) + 1e-6f);
            row[64 * h] = cvt_pk_bf16(a * rn * g0, b * rn * g1); } }
    if (F.gw < NH_F) { const int h = F.gw; const float* FPRE = WSP(float, WS_SMALL + SM_FPRE); float* BL = WSP(float, WS_SMALL + SM_BIASL2); const float bf = A.in[I_FOXBF][h];
        float carry = 0.f;
        for (int c0 = 0; c0 < 128; c0 += 16) { float v[16];
#pragma unroll
            for (int i = 0; i < 16; ++i) v[i] = FPRE[(size_t)(64 * (c0 + i) + lane) * 16 + h];
#pragma unroll
            for (int i = 0; i < 16; ++i) { float b = logsigmoidf_(v[i] + bf);
#pragma unroll
                for (int o = 1; o < 64; o <<= 1) { const float x = __shfl_up(b, o); if (lane >= o) b += x; }
                b += carry; BL[h * T + 64 * (c0 + i) + lane] = -1.4426950408889634f * b; carry = __shfl(b, 63); } } }
}
__device__ __forceinline__ void p_foxattn(const Frame& F) {
    const bf16* QKVG = WSP(bf16, R_QKVG); bf16* ATTO = WSP(bf16, R_ATTO); const float* BL = WSP(float, WS_SMALL + SM_BIASL2);
    char* lds = (char*)F.ldsg + RING_OFF;
    for (int L = F.vcu; L < 256; L += F.G) { const int h = L >> 4, x = L & 15;
        __syncthreads();
        { float* bl = (float*)(lds + fox::BIAS_OFF); for (int i = F.tid; i < T / 4; i += NWAVES * 64) *(f32x4*)(bl + 4 * i) = *(const f32x4*)(BL + (size_t)h * T + 4 * i); }
        fox::BlockRef b0, b1; const int q0 = x, q1 = 31 - x;
        b0.Q = QKVG + (size_t)q0 * 256 * 8192 + 128 * h; b0.K = QKVG + 2048 + 128 * h; b0.V = QKVG + 4096 + 128 * h; b0.G = QKVG + (size_t)q0 * 256 * 8192 + 6144 + 128 * h;
        b0.O = ATTO + (size_t)q0 * 256 * D + 128 * h; b0.P0 = q0 * 256;
        b1 = b0; b1.Q = QKVG + (size_t)q1 * 256 * 8192 + 128 * h; b1.G = QKVG + (size_t)q1 * 256 * 8192 + 6144 + 128 * h; b1.O = ATTO + (size_t)q1 * 256 * D + 128 * h; b1.P0 = q1 * 256;
        fox::Seam S;
        fox::prime(b0, lds, S);
#ifdef FOX_LOOP
        for (int pass = 0; pass < 2; ++pass) { fox::block(b0, b1, lds, S); b0 = b1; }
#else
        fox::block(b0, b1, lds, S);
        fox::block(b1, b1, lds, S);
#endif
    }
}

__device__ __forceinline__ void p_norm_route(const Frame& F, const Args& A) {
    LAS float* Ws = (LAS float*)(F.lds + RING_OFF); LAS int* cnt = (LAS int*)(F.lds + RING_OFF + 8 * D * 4);
    stage_skinny<8>(F, A.in[I_ROUTER], NEXP, 0, Ws);
    if (F.tid < 8) cnt[F.tid] = 0;
    __syncthreads();
    const float* X = WSP(float, WS_X); bf16* XN = WSP(bf16, WS_XN); const float* g = A.in[I_NFFNG] + D;
    int* TOPI = WSP(int, WS_SMALL + SM_TOPI); float* TOPG = WSP(float, WS_SMALL + SM_TOPG); int* BLKCNT = WSP(int, WS_SMALL + SM_BLKCNT);
    const int b = blockIdx.x;
    for (int i = 0; i < 4; ++i) { const int t = 32 * b + 4 * F.wave + i; f32x4 y[8]; rms_row(X + (size_t)t * D, g, XN + (size_t)t * D, F.lane, y);
        float o[8]; skinny_dot<8>(y, Ws, F.lane, o);
        int i1 = 0; float v1 = o[0];
#pragma unroll
        for (int e = 1; e < 8; ++e) if (o[e] > v1) { v1 = o[e]; i1 = e; }
        int i2 = -1; float v2 = -__builtin_inff();
#pragma unroll
        for (int e = 0; e < 8; ++e) if (e != i1 && o[e] > v2) { v2 = o[e]; i2 = e; }
        const float e2 = __expf(v2 - v1), g1 = 1.0f / (1.0f + e2), g2 = e2 * g1;
        if (F.lane == 0) { TOPI[2 * t] = i1; TOPI[2 * t + 1] = i2; TOPG[2 * t] = g1; TOPG[2 * t + 1] = g2; __hip_atomic_fetch_add(&cnt[i1], 1, __ATOMIC_RELAXED, __HIP_MEMORY_SCOPE_WORKGROUP); __hip_atomic_fetch_add(&cnt[i2], 1, __ATOMIC_RELAXED, __HIP_MEMORY_SCOPE_WORKGROUP); } }
    __syncthreads();
    if (F.tid < 8) BLKCNT[b * 8 + F.tid] = cnt[F.tid];
}
__device__ __forceinline__ void p_route2(const Frame& F) {
    LAS int* sh = (LAS int*)(F.lds + RING_OFF);
    const int* BLKCNT = WSP(int, WS_SMALL + SM_BLKCNT); const int* TOPI = WSP(int, WS_SMALL + SM_TOPI); int* SLOT = WSP(int, WS_SMALL + SM_SLOT); int* TILEE = WSP(int, WS_SMALL + SM_TILEE);
    const bf16* XN = WSP(bf16, WS_XN); bf16* AG = WSP(bf16, R_AG); const int b = blockIdx.x;
    __syncthreads();
    if (F.tid < 8) { int tot = 0, pre = 0; for (int bb = 0; bb < 256; ++bb) { const int v = BLKCNT[bb * 8 + F.tid]; if (bb < b) pre += v; tot += v; } sh[F.tid] = tot; sh[8 + F.tid] = pre; }
    __syncthreads();
    if (F.tid == 0) { int off = 0, nt = 0; for (int e = 0; e < 8; ++e) { sh[16 + e] = off; const int n = (sh[e] + 255) >> 8; if (b == 0) for (int i = 0; i < n; ++i) TILEE[1 + nt + i] = e; nt += n; off += n * 256; } if (b == 0) TILEE[0] = nt; }
    __syncthreads();
    if (F.wave == 0) { const int t = 32 * b + (F.lane >> 1), e = TOPI[2 * t + (F.lane & 1)]; int rank = 0;
#pragma unroll
        for (int ee = 0; ee < 8; ++ee) { const unsigned long long m = __ballot(e == ee); if (e == ee) rank = __popcll(m & ((1ull << F.lane) - 1ull)); }
        const int slot = sh[16 + e] + sh[8 + e] + rank; SLOT[2 * t + (F.lane & 1)] = slot; sh[32 + F.lane] = slot; }
    __syncthreads();
    for (int p = F.wave; p < 64; p += NWAVES) { const int t = 32 * b + (p >> 1), slot = sh[32 + p]; const u32x4* src = (const u32x4*)(XN + (size_t)t * D); u32x4* dst = (u32x4*)(AG + (size_t)slot * D);
#pragma unroll
        for (int j = 0; j < 4; ++j) dst[F.lane + 64 * j] = src[F.lane + 64 * j]; }
}
struct MoeOrder {
    const bf16* Arows; const bf16* W; const int* tilee; int lda, nN; size_t wstride; int G, c;
    __device__ __forceinline__ bool next(int i, pg8::Unit& u) const {
        const int nt = tilee[0]; const long L = (long)i * G + c; if (L >= (long)nt * nN) return false;
        const int ti = (int)(L / nN), pn = (int)(L % nN), e = tilee[1 + ti];
        u.pm = ti; u.pn = pn; u.aux = e; u.pad = 0; u.a = (const char*)(Arows + (size_t)ti * 256 * lda); u.b = (const char*)(W + (size_t)e * wstride + (size_t)pn * 256 * lda); return true;
    }
};
__device__ __forceinline__ void p_final(const Frame& F, const Args& A) {
    const float* X = WSP(float, WS_X); const float* YG = WSP(float, R_YG); const int* SLOT = WSP(int, WS_SMALL + SM_SLOT); const float* TOPG = WSP(float, WS_SMALL + SM_TOPG);
    const float* g = A.in[I_FING]; const int lane = F.lane;
    for (int t = F.gw; t < T; t += F.NGW) { const int s1 = SLOT[2 * t], s2 = SLOT[2 * t + 1]; const float g1 = TOPG[2 * t], g2 = TOPG[2 * t + 1];
        const f32x4* xr = (const f32x4*)(X + (size_t)t * D) + lane; const f32x4* y1 = (const f32x4*)(YG + (size_t)s1 * D) + lane; const f32x4* y2 = (const f32x4*)(YG + (size_t)s2 * D) + lane;
        f32x4 v[8]; float s = 0.f;
#pragma unroll
        for (int j = 0; j < 8; ++j) { v[j] = xr[64 * j] + (y1[64 * j] * g1 + y2[64 * j] * g2); s += (v[j][0] * v[j][0] + v[j][1] * v[j][1]) + (v[j][2] * v[j][2] + v[j][3] * v[j][3]); }
        const float r = 1.0f / sqrtf(wave_sum(s) * (1.0f / D) + 1e-6f); f32x4* o = (f32x4*)(A.out + (size_t)t * D) + lane;
#pragma unroll
        for (int j = 0; j < 8; ++j) o[64 * j] = v[j] * r * ((const f32x4*)g)[lane + 64 * j]; }
}

enum Phase { PH_CONV = 0, PH_KV, PH_INPROJ0, PH_PREPA, PH_LORA, PH_PREPB, PH_SCAN, PH_MLU, PH_MLSCAN, PH_MLOUT, PH_OUTPROJ0,
             PH_NORMX0, PH_XQ0, PH_XS0, PH_XSM0, PH_XPV0, PH_XO0, PH_NORMF0, PH_FFNGU, PH_FFND,
             PH_NORMM1, PH_FOXIN, PH_FOXPREP, PH_FOXATT, PH_FOXOUT,
             PH_NORMX1, PH_XQ1, PH_XS1, PH_XSM1, PH_XPV1, PH_XO1, PH_NORMF1, PH_ROUTE2, PH_MOEGU, PH_MOED, PH_FINAL, N_PHASES };

__global__ void __launch_bounds__(NWAVES * 64, 2) trunk_fwd(Args A) {
    extern __shared__ __attribute__((aligned(16))) unsigned char lds[];
    Frame F;
    F.lds = (LAS unsigned char*)lds; F.ldsg = lds; F.ws = A.ws;
    F.tid = threadIdx.x; F.lane = F.tid & 63; F.wave = __builtin_amdgcn_readfirstlane(F.tid >> 6);
    F.G = gridDim.x; { const int bx = blockIdx.x; F.vcu = (F.G % 8 == 0) ? (bx % 8) * (F.G / 8) + bx / 8 : bx; }
    F.gw = F.vcu * NWAVES + F.wave; F.NGW = F.G * NWAVES;
    volatile LAS unsigned* MISC = (volatile LAS unsigned*)(F.lds + MISC_OFF);
    for (int u = F.tid; u < (LDS_BYTES - LDSCTL_OFF) / 4; u += NWAVES * 64) ((LAS unsigned*)(F.lds + LDSCTL_OFF))[u] = 0u;
    __syncthreads();
    const int lo = A.ph_lo, hi = A.ph_hi;
    const bool multi = (hi - lo) > 1;
    XcdBarrier bar; bar.bar = (unsigned*)(A.ws + WS_CTL) + CW_BAR; bar.x = 0; bar.st = nullptr;
    if (multi) bar = xcd_barrier_post((unsigned*)(A.ws + WS_CTL) + CW_BAR, MISC + 8);
#ifndef PH_ENABLE
#define PH_ENABLE 0xFFFFFFFFFFFFFFFFull
#endif
#define IN(k) ((((PH_ENABLE) >> (k)) & 1ull) && lo <= (k) && (k) < hi)
#define SEAM(k) do { if (IN(k) && IN((k) + 1)) xcd_barrier(bar); } while (0)
    LAS unsigned char* ring = F.lds + RING_OFF;
    const int cb = (int)blockIdx.x;

    if (IN(PH_CONV)) { p_convert(F, A); } SEAM(PH_CONV);
    if (IN(PH_KV)) { KvOrder S{WSP(bf16, WS_MEMN), WSP(bf16, WS_W_XKV), cb}; EpiKv E{WSP(bf16, WS_KMEM), WSP(bf16, WS_VTMEM)};
        pg8::gemm_phase<EpiKv, KvOrder, false>(ring, pg8::Gemm{D, D, D}, S, E); } SEAM(PH_KV);
    if (IN(PH_INPROJ0)) { pg8::PlainOrder S{WSP(bf16, WS_XN), WSP(bf16, WS_W_ABIN), D, D, 32, AB_PAD / 256, F.G, cb}; pg8::EpiBf16 E{WSP(bf16, R_PROJ), AB_PAD, WSP(float, R_GATES32), 29};
        pg8::gemm_phase<pg8::EpiBf16, pg8::PlainOrder, true>(ring, pg8::Gemm{D, D, D}, S, E); } SEAM(PH_INPROJ0);
    if (IN(PH_PREPA)) { p_prepa(F, A); } SEAM(PH_PREPA);
    if (IN(PH_LORA)) { pg8::PlainOrder S{WSP(bf16, R_LORAIN), WSP(bf16, WS_W_LORA), 512, 512, 32, 12, F.G, cb}; pg8::EpiF32 E{WSP(float, R_LORAOUT), 3072, 0, 1.0f};
        pg8::gemm_phase<pg8::EpiF32, pg8::PlainOrder, true>(ring, pg8::Gemm{512, 512, 512}, S, E); } SEAM(PH_LORA);
    if (IN(PH_PREPB)) { p_prepb(F, A); } SEAM(PH_PREPB);
    if (IN(PH_SCAN)) { p_scan(F); } SEAM(PH_SCAN);
    if (IN(PH_MLU)) { p_mlu(F); } SEAM(PH_MLU);
    if (IN(PH_MLSCAN)) { p_mlscan(F); p_rwkv_post(F, A); } SEAM(PH_MLSCAN);
    if (IN(PH_MLOUT)) { p_mlout(F, A); } SEAM(PH_MLOUT);
    if (IN(PH_OUTPROJ0)) { pg8::PlainOrder S{WSP(bf16, R_YCAT), WSP(bf16, WS_W_ABOUT), D, D, 32, 8, F.G, cb}; pg8::EpiResid E{A.in[I_X], WSP(float, WS_X), D};
        pg8::gemm_phase<pg8::EpiResid, pg8::PlainOrder, false>(ring, pg8::Gemm{D, D, D}, S, E); } SEAM(PH_OUTPROJ0);
#define XATTN(l, P_NORM, P_Q, P_S, P_SM, P_PV, P_O) \
    if (IN(P_NORM)) { norm_phase(F, WSP(float, WS_X), A.in[I_NXAG] + (l) * D, WSP(bf16, WS_XN), T); } SEAM(P_NORM); \
    if (IN(P_Q)) { pg8::PlainOrder S{WSP(bf16, WS_XN), WSP(bf16, WS_W_XQ) + (size_t)(l) * D * D, D, D, 32, 8, F.G, cb}; pg8::EpiBf16 E{WSP(bf16, R_XQ), D, nullptr, -1}; \
        pg8::gemm_phase<pg8::EpiBf16, pg8::PlainOrder, false>(ring, pg8::Gemm{D, D, D}, S, E); } SEAM(P_Q); \
    if (IN(P_S)) { XsOrder S{WSP(bf16, R_XQ), WSP(bf16, WS_KMEM) + (size_t)(l) * NMEM * D, F.G, cb}; pg8::EpiF32 E{WSP(float, R_XS), 1024, 256, 0.044194173824159216f}; \
        pg8::gemm_phase<pg8::EpiF32, XsOrder, false>(ring, pg8::Gemm{D, D, 512}, S, E); } SEAM(P_S); \
    if (IN(P_SM)) { p_xsoftmax(F); } SEAM(P_SM); \
    if (IN(P_PV)) { XpvOrder S{WSP(bf16, R_XP), WSP(bf16, WS_VTMEM) + (size_t)(l) * D * NMEM, F.G, cb}; pg8::EpiBf16 E{WSP(bf16, R_XO), D, nullptr, -1}; \
        pg8::gemm_phase<pg8::EpiBf16, XpvOrder, false>(ring, pg8::Gemm{1024, NMEM, 256}, S, E); } SEAM(P_PV); \
    if (IN(P_O)) { pg8::PlainOrder S{WSP(bf16, R_XO), WSP(bf16, WS_W_XO) + (size_t)(l) * D * D, D, D, 32, 8, F.G, cb}; pg8::EpiResid E{WSP(float, WS_X), WSP(float, WS_X), D}; \
        pg8::gemm_phase<pg8::EpiResid, pg8::PlainOrder, false>(ring, pg8::Gemm{D, D, D}, S, E); } SEAM(P_O);

    XATTN(0, PH_NORMX0, PH_XQ0, PH_XS0, PH_XSM0, PH_XPV0, PH_XO0)
    if (IN(PH_NORMF0)) { norm_phase(F, WSP(float, WS_X), A.in[I_NFFNG], WSP(bf16, WS_XN), T); } SEAM(PH_NORMF0);
    if (IN(PH_FFNGU)) { pg8::PlainOrder S{WSP(bf16, WS_XN), WSP(bf16, WS_W_FFNGU), D, D, 32, 44, F.G, cb}; pg8::EpiSwiGLU E{WSP(bf16, R_ACT), DFF};
        pg8::gemm_phase<pg8::EpiSwiGLU, pg8::PlainOrder, true>(ring, pg8::Gemm{D, D, D}, S, E); } SEAM(PH_FFNGU);
    if (IN(PH_FFND)) { pg8::PlainOrder S{WSP(bf16, R_ACT), WSP(bf16, WS_W_FFND), DFF, DFF, 32, 8, F.G, cb}; pg8::EpiResid E{WSP(float, WS_X), WSP(float, WS_X), D};
        pg8::gemm_phase<pg8::EpiResid, pg8::PlainOrder, false>(ring, pg8::Gemm{DFF, DFF, DFF}, S, E); } SEAM(PH_FFND);
    if (IN(PH_NORMM1)) { p_norm_fpre(F, A); } SEAM(PH_NORMM1);
    if (IN(PH_FOXIN)) { pg8::PlainOrder S{WSP(bf16, WS_XN), WSP(bf16, WS_W_FOXIN), D, D, 32, 32, F.G, cb}; pg8::EpiBf16 E{WSP(bf16, R_QKVG), 8192, nullptr, -1};
        pg8::gemm_phase<pg8::EpiBf16, pg8::PlainOrder, true>(ring, pg8::Gemm{D, D, D}, S, E); } SEAM(PH_FOXIN);
    if (IN(PH_FOXPREP)) { p_foxprep(F, A); } SEAM(PH_FOXPREP);
    if (IN(PH_FOXATT)) { p_foxattn(F); } SEAM(PH_FOXATT);
    if (IN(PH_FOXOUT)) { pg8::PlainOrder S{WSP(bf16, R_ATTO), WSP(bf16, WS_W_FOXOUT), D, D, 32, 8, F.G, cb}; pg8::EpiResid E{WSP(float, WS_X), WSP(float, WS_X), D};
        pg8::gemm_phase<pg8::EpiResid, pg8::PlainOrder, false>(ring, pg8::Gemm{D, D, D}, S, E); } SEAM(PH_FOXOUT);
    XATTN(1, PH_NORMX1, PH_XQ1, PH_XS1, PH_XSM1, PH_XPV1, PH_XO1)
    if (IN(PH_NORMF1)) { p_norm_route(F, A); } SEAM(PH_NORMF1);
    if (IN(PH_ROUTE2)) { p_route2(F); } SEAM(PH_ROUTE2);
    if (IN(PH_MOEGU)) { MoeOrder S{WSP(bf16, R_AG), WSP(bf16, WS_W_MOEGU), WSP(int, WS_SMALL + SM_TILEE), D, 44, (size_t)2 * DFF * D, F.G, cb}; pg8::EpiSwiGLU E{WSP(bf16, R_ACTG), DFF};
        pg8::gemm_phase<pg8::EpiSwiGLU, MoeOrder, true>(ring, pg8::Gemm{D, D, D}, S, E); } SEAM(PH_MOEGU);
    if (IN(PH_MOED)) { MoeOrder S{WSP(bf16, R_ACTG), WSP(bf16, WS_W_MOED), WSP(int, WS_SMALL + SM_TILEE), DFF, 8, (size_t)D * DFF, F.G, cb}; pg8::EpiF32 E{WSP(float, R_YG), D, 0, 1.0f};
        pg8::gemm_phase<pg8::EpiF32, MoeOrder, true>(ring, pg8::Gemm{DFF, DFF, DFF}, S, E); } SEAM(PH_MOED);
    if (IN(PH_FINAL)) { p_final(F, A); }
#undef XATTN
#undef IN
#undef SEAM
}

#ifndef MK_ONE_LAUNCH
#define MK_ONE_LAUNCH 0
#endif
extern "C" void kernel_launch(void* const* d_in, const int* in_sizes, int n_in, void* d_out, int out_size, void* d_ws, size_t ws_size, hipStream_t stream) {
    static int ready = 0;
    if (ready == 0) {
        if (n_in != N_IN || in_sizes[0] != T * D || out_size != T * D || ws_size < WS_END) {
            fprintf(stderr, "kernel_launch: built for %d inputs, x/out of %d floats, >= %zu bytes of workspace; got n_in %d, in0 %d, out %d, ws %zu; nothing launched\n", N_IN, T * D, (size_t)WS_END, n_in, n_in > 0 ? in_sizes[0] : -1, out_size, ws_size);
            ready = -1; return; }
        if (hipFuncSetAttribute((const void*)trunk_fwd, hipFuncAttributeMaxDynamicSharedMemorySize, LDS_BYTES) != hipSuccess) { fprintf(stderr, "kernel_launch: hipFuncSetAttribute failed\n"); ready = -1; return; }
        int per_cu = 0;
        if (hipOccupancyMaxActiveBlocksPerMultiprocessor(&per_cu, (const void*)trunk_fwd, NWAVES * 64, LDS_BYTES) != hipSuccess || per_cu < 1)
            fprintf(stderr, "kernel_launch: note: occupancy query reports %d workgroups per CU\n", per_cu);
        (void)hipGetLastError();
        ready = 1;
    }
    if (ready < 0) return;
    const int grid = 256;
    if (hipMemsetAsync((char*)d_ws + WS_CTL, 0, CTL_ZERO_BYTES, stream) != hipSuccess) { fprintf(stderr, "kernel_launch: hipMemsetAsync failed\n"); return; }
    Args a{};
    for (int i = 0; i < N_IN; ++i) a.in[i] = (const float*)d_in[i];
    a.out = (float*)d_out; a.ws = (unsigned char*)d_ws;
#if MK_ONE_LAUNCH
    a.ph_lo = 0; a.ph_hi = N_PHASES;
    hipLaunchKernelGGL(trunk_fwd, dim3(grid), dim3(NWAVES * 64), LDS_BYTES, stream, a);
#else
    for (int p = 0; p < N_PHASES; ++p) { a.ph_lo = p; a.ph_hi = p + 1;
        hipLaunchKernelGGL(trunk_fwd, dim3(grid), dim3(NWAVES * 64), LDS_BYTES, stream, a); }
#endif
    const hipError_t le = hipPeekAtLastError();
    if (le != hipSuccess) fprintf(stderr, "kernel_launch: launch failed: %s\n", hipGetErrorName(le));
}
```

```cpp
#include <hip/hip_runtime.h>
#include <cstdio>
#include <cstdint>

#define GAS __attribute__((address_space(1)))
#define LAS __attribute__((address_space(3)))
typedef unsigned short bf16;
typedef short bf16x8 __attribute__((ext_vector_type(8)));
typedef short s16x4 __attribute__((ext_vector_type(4)));
typedef float f32x2 __attribute__((ext_vector_type(2)));
typedef float f32x4 __attribute__((ext_vector_type(4)));
typedef float f32x16 __attribute__((ext_vector_type(16)));
typedef unsigned u32x2 __attribute__((ext_vector_type(2)));
typedef unsigned u32x4 __attribute__((ext_vector_type(4)));

constexpr int T = 8192, D = 2048, NMEM = 256, DFF = 5632, NEXP = 8;
constexpr int A_COLS = 3520, AB_COLS = 7624, AB_PAD = 7680;
constexpr int FOX_LD = 8208;
constexpr int NH_R = 16, NH_M = 4, NH_F = 16;
constexpr int MOE_ROWS = 72 * 256;

__device__ __forceinline__ float bf2f(unsigned b) { return __uint_as_float(b << 16); }
__device__ __forceinline__ unsigned cvt_pk_bf16(float lo, float hi) { unsigned r; asm volatile("v_cvt_pk_bf16_f32 %0, %1, %2" : "=v"(r) : "v"(lo), "v"(hi)); return r; }
__device__ __forceinline__ bf16 f2bf(float f) { return (bf16)(cvt_pk_bf16(f, 0.f) & 0xffffu); }
__device__ __forceinline__ float wave_sum(float v) {
#pragma unroll
    for (int o = 1; o < 64; o <<= 1) v += __shfl_xor(v, o);
    return v;
}
__device__ __forceinline__ float wave_max(float v) {
#pragma unroll
    for (int o = 1; o < 64; o <<= 1) v = fmaxf(v, __shfl_xor(v, o));
    return v;
}
__device__ __forceinline__ float sigmoidf_(float x) { return 1.0f / (1.0f + __expf(-x)); }
__device__ __forceinline__ float logsigmoidf_(float x) { return fminf(x, 0.f) - log1pf(__expf(-fabsf(x))); }

namespace pg8 {
#define PG8_LAS __attribute__((address_space(3)))
typedef unsigned short bf16_t;
constexpr int BM = 256, BK = 64, HALF = 128, HTB = HALF * BK * 2  , STAGE_BYTES = 8 * HTB, NXCD = 8, WGM = 8;

__host__ __device__ __forceinline__ int lds_byte(int r, int c) { const int st = (r >> 4) * 2 + (c >> 5), rr = r & 15, cc = c & 31, ob = rr * 64 + cc * 2; return st * 1024 + (ob ^ (((ob >> 9) & 1) << 5)); }
__host__ __device__ __forceinline__ void stage_rc(int b, int& R, int& C) { const int st = b / 1024, sb = b % 1024, swz = sb ^ (((sb >> 9) & 1) << 5); R = (st >> 1) * 16 + swz / 64; C = (st & 1) * 32 + (swz % 64) / 2; }
__host__ __device__ __forceinline__ int perm32(int rho) { const int n = rho >> 4, i = rho & 15; return 8 * (i >> 2) + 4 * n + (i & 3); }

struct Unit { const char* a; const char* b; int pm, pn, aux, pad; };
struct Gemm { int lda, ldb, K; };

__device__ __forceinline__ bool static_tile(int i, int G, int c, int nM, int nN, int& pm, int& pn) {
    const int nwg = nM * nN; const long L = (long)i * G + c; if (L >= nwg) return false;
    int wgid = (int)L; { const int q = nwg / NXCD, r = nwg % NXCD, xcd = wgid % NXCD, off = wgid / NXCD; wgid = (xcd < r ? xcd * (q + 1) : r * (q + 1) + (xcd - r) * q) + off; }
    const int nig = WGM * nN, gid = wgid / nig, fm = gid * WGM, gsz = (nM - fm) < WGM ? (nM - fm) : WGM;
    pm = fm + ((wgid % nig) % gsz); pn = (wgid % nig) / gsz; return true;
}
struct PlainOrder {
    const bf16_t* A; const bf16_t* Bt; int lda, ldb, nM, nN, G, c;
    __device__ __forceinline__ bool next(int i, Unit& u) const {
        int pm, pn; if (!static_tile(i, G, c, nM, nN, pm, pn)) return false;
        u.pm = pm; u.pn = pn; u.aux = 0; u.pad = 0; u.a = (const char*)(A + (size_t)pm * BM * lda); u.b = (const char*)(Bt + (size_t)pn * BM * ldb); return true;
    }
};

struct EpiF32 {
    static constexpr bool PERM = false;
    float* C; int ldc; int aux_cols; float scale;
    __device__ __forceinline__ void operator()(const f32x4 (&acc)[2][2][4][2], const Unit& u, int wr, int wc, int fr, int fq) const {
        const int row0 = u.pm * BM + wr * 64 + fr, col0 = u.pn * BM + u.aux * aux_cols + wc * 32 + 4 * fq;
#pragma unroll
        for (int ai = 0; ai < 2; ++ai)
#pragma unroll
            for (int m = 0; m < 4; ++m) { float* rowp = C + (size_t)(row0 + ai * HALF + m * 16) * ldc + col0;
#pragma unroll
                for (int bj = 0; bj < 2; ++bj)
#pragma unroll
                    for (int n = 0; n < 2; ++n) *(f32x4*)(rowp + bj * HALF + n * 16) = acc[ai][bj][m][n] * scale; }
    }
};
struct EpiResid {
    static constexpr bool PERM = false;
    const float* base; float* out; int ldc;
    __device__ __forceinline__ void operator()(const f32x4 (&acc)[2][2][4][2], const Unit& u, int wr, int wc, int fr, int fq) const {
        const int row0 = u.pm * BM + wr * 64 + fr, col0 = u.pn * BM + wc * 32 + 4 * fq;
#pragma unroll
        for (int ai = 0; ai < 2; ++ai)
#pragma unroll
            for (int m = 0; m < 4; ++m) { const size_t off = (size_t)(row0 + ai * HALF + m * 16) * ldc + col0;
#pragma unroll
                for (int bj = 0; bj < 2; ++bj)
#pragma unroll
                    for (int n = 0; n < 2; ++n) { const f32x4 b = *(const f32x4*)(base + off + bj * HALF + n * 16); *(f32x4*)(out + off + bj * HALF + n * 16) = b + acc[ai][bj][m][n]; } }
    }
};
struct EpiBf16 {
    static constexpr bool PERM = true;
    bf16_t* O; int ldc; float* side; int side_pn;
    __device__ __forceinline__ void operator()(const f32x4 (&acc)[2][2][4][2], const Unit& u, int wr, int wc, int fr, int fq) const {
        const int row0 = u.pm * BM + wr * 64 + fr, col0 = u.pn * BM + wc * 32 + 8 * fq;
#pragma unroll
        for (int ai = 0; ai < 2; ++ai)
#pragma unroll
            for (int m = 0; m < 4; ++m) { bf16_t* rowp = O + (size_t)(row0 + ai * HALF + m * 16) * ldc + col0;
#pragma unroll
                for (int bj = 0; bj < 2; ++bj) { const f32x4 v0 = acc[ai][bj][m][0], v1 = acc[ai][bj][m][1];
                    u32x4 w; w.x = cvt_pk_bf16(v0[0], v0[1]); w.y = cvt_pk_bf16(v0[2], v0[3]); w.z = cvt_pk_bf16(v1[0], v1[1]); w.w = cvt_pk_bf16(v1[2], v1[3]);
                    *(u32x4*)(rowp + bj * HALF) = w; } }
        if (side != nullptr && u.pn == side_pn) {
#pragma unroll
            for (int ai = 0; ai < 2; ++ai)
#pragma unroll
                for (int m = 0; m < 4; ++m) { float* rowp = side + (size_t)(row0 + ai * HALF + m * 16) * 256 + wc * 32 + 8 * fq;
#pragma unroll
                    for (int bj = 0; bj < 2; ++bj) { *(f32x4*)(rowp + bj * HALF) = acc[ai][bj][m][0]; *(f32x4*)(rowp + bj * HALF + 4) = acc[ai][bj][m][1]; } }
        }
    }
};
struct EpiSwiGLU {
    static constexpr bool PERM = true;
    bf16_t* O; int ldc;
    __device__ __forceinline__ void operator()(const f32x4 (&acc)[2][2][4][2], const Unit& u, int wr, int wc, int fr, int fq) const {
        const int row0 = u.pm * BM + wr * 64 + fr, col0 = u.pn * HALF + wc * 32 + 8 * fq;
#pragma unroll
        for (int ai = 0; ai < 2; ++ai)
#pragma unroll
            for (int m = 0; m < 4; ++m) { bf16_t* rowp = O + (size_t)(row0 + ai * HALF + m * 16) * ldc + col0;
                float o[8];
#pragma unroll
                for (int n = 0; n < 2; ++n)
#pragma unroll
                    for (int j = 0; j < 4; ++j) { const float g = acc[ai][0][m][n][j], up = acc[ai][1][m][n][j];
                        o[n * 4 + j] = g * __builtin_amdgcn_rcpf(1.0f + __builtin_amdgcn_exp2f(-1.4426950408889634f * g)) * up; }
                u32x4 w; w.x = cvt_pk_bf16(o[0], o[1]); w.y = cvt_pk_bf16(o[2], o[3]); w.z = cvt_pk_bf16(o[4], o[5]); w.w = cvt_pk_bf16(o[6], o[7]);
                *(u32x4*)rowp = w; }
    }
};

template <class Epi, class Sched, bool ALIGN_EPI>
__device__ __forceinline__ void gemm_phase(PG8_LAS unsigned char* lds, const Gemm g, const Sched& S, const Epi& E) {
    const int tid = threadIdx.x, wid = __builtin_amdgcn_readfirstlane(tid >> 6), lane = tid & 63, wr = wid >> 2, wc = wid & 3, fr = lane & 15, fq = lane >> 4;
    const int K = g.K, nt = K / BK;
    unsigned voffA[2], voffB[2];
#pragma unroll
    for (int i = 0; i < 2; ++i) { int R, C; stage_rc(tid * 16 + i * 8192, R, C); const int Rb = Epi::PERM ? ((R & ~31) + perm32(R & 31)) : R;
        voffA[i] = (unsigned)(R * g.lda + C) * 2u; voffB[i] = (unsigned)(Rb * g.ldb + C) * 2u; }
    const size_t kstep = (size_t)(BK * 2);
    const size_t hstepA = (size_t)HALF * g.lda * 2, hstepB = (size_t)HALF * g.ldb * 2;
    const unsigned ldsw = (unsigned)wid * 1024u;
    const int aoff = lds_byte(wr * 64 + fr, fq * 8), boff = lds_byte(wc * 32 + fr, fq * 8);
#define PG8_SA(b, h) (((b) * 2 + (h)) * HTB)
#define PG8_SB(b, h) ((4 + (b) * 2 + (h)) * HTB)
#define PG8_STAGE(bufoff, gbase, voff) do { _Pragma("unroll") for (int _i = 0; _i < 2; ++_i) \
        __builtin_amdgcn_global_load_lds((const unsigned*)((const char*)(gbase) + (voff)[_i]), (PG8_LAS unsigned*)(lds + (bufoff) + ldsw + _i * 8192), 16, 0, 0); } while (0)
#define PG8_LDA(dst, b, h) do { _Pragma("unroll") for (int m = 0; m < 4; ++m) _Pragma("unroll") for (int k = 0; k < 2; ++k) dst[m][k] = *(const PG8_LAS bf16x8*)(lds + PG8_SA(b, h) + aoff + m * 2048 + k * 1024); } while (0)
#define PG8_LDB(dst, b, h) do { _Pragma("unroll") for (int n = 0; n < 2; ++n) _Pragma("unroll") for (int k = 0; k < 2; ++k) dst[n][k] = *(const PG8_LAS bf16x8*)(lds + PG8_SB(b, h) + boff + n * 2048 + k * 1024); } while (0)
#define PG8_MMA(ai, bj, At, Bt) do { __builtin_amdgcn_s_setprio(1); _Pragma("unroll") for (int m = 0; m < 4; ++m) _Pragma("unroll") for (int n = 0; n < 2; ++n) _Pragma("unroll") for (int k = 0; k < 2; ++k) \
        acc[ai][bj][m][n] = __builtin_amdgcn_mfma_f32_16x16x32_bf16(Bt[n][k], At[m][k], acc[ai][bj][m][n], 0, 0, 0); __builtin_amdgcn_s_setprio(0); } while (0)
#define PG8_WAIT_V(n) asm volatile("s_waitcnt vmcnt(" #n ")" ::: "memory")
#define PG8_WAIT_L(n) asm volatile("s_waitcnt lgkmcnt(" #n ")" ::: "memory")
#define PG8_BAR __builtin_amdgcn_s_barrier()
#define PG8_SCHED __builtin_amdgcn_sched_barrier(0)
    Unit cur, nxt; int ui = 0;
    if (!S.next(0, cur)) return;
    f32x4 acc[2][2][4][2];
#pragma unroll
    for (int a = 0; a < 2; ++a)
#pragma unroll
        for (int b = 0; b < 2; ++b)
#pragma unroll
            for (int m = 0; m < 4; ++m)
#pragma unroll
                for (int n = 0; n < 2; ++n) acc[a][b][m][n] = (f32x4){0.f, 0.f, 0.f, 0.f};
    bf16x8 At[4][2], B0[2][2], B1[2][2];
    const char* cA = cur.a; const char* cB = cur.b;
    PG8_STAGE(PG8_SB(0, 0), cB, voffB); PG8_STAGE(PG8_SB(0, 1), cB + hstepB, voffB); PG8_STAGE(PG8_SA(0, 0), cA, voffA); PG8_STAGE(PG8_SA(0, 1), cA + hstepA, voffA);
    if (wr == 1) PG8_BAR;
    PG8_WAIT_V(2); PG8_BAR;
    PG8_STAGE(PG8_SB(1, 0), cB + kstep, voffB); PG8_STAGE(PG8_SA(1, 0), cA + kstep, voffA); PG8_STAGE(PG8_SB(1, 1), cB + hstepB + kstep, voffB);
    PG8_WAIT_V(6); PG8_BAR;
    for (;;) {
        const bool has_next = S.next(ui + 1, nxt);
        const char* nA = has_next ? nxt.a : cA; const char* nB = has_next ? nxt.b : cB;
        for (int t = 0; t < nt; t += 2) {
            const bool last = (t == nt - 2);
            const char* a1 = cA + (size_t)(t + 1) * kstep;
            const char* a2 = last ? nA : cA + (size_t)(t + 2) * kstep; const char* b2 = last ? nB : cB + (size_t)(t + 2) * kstep;
            const char* a3 = a2 + kstep; const char* b3 = b2 + kstep;
            PG8_LDB(B0, 0, 0); PG8_LDB(B1, 0, 1); PG8_SCHED; PG8_LDA(At, 0, 0); PG8_STAGE(PG8_SA(1, 1), a1 + hstepA, voffA);
            PG8_WAIT_V(8); PG8_WAIT_L(0); PG8_BAR; PG8_MMA(0, 0, At, B0); PG8_MMA(0, 1, At, B1); PG8_BAR; PG8_SCHED;
            PG8_LDA(At, 0, 1); PG8_STAGE(PG8_SB(0, 0), b2, voffB); PG8_STAGE(PG8_SB(0, 1), b2 + hstepB, voffB); PG8_STAGE(PG8_SA(0, 0), a2, voffA);
            PG8_WAIT_V(8); PG8_WAIT_L(0); PG8_BAR; PG8_MMA(1, 0, At, B0); PG8_MMA(1, 1, At, B1); PG8_BAR; PG8_SCHED;
            PG8_LDB(B0, 1, 0); PG8_LDB(B1, 1, 1); PG8_SCHED; PG8_LDA(At, 1, 0); PG8_STAGE(PG8_SA(0, 1), a2 + hstepA, voffA);
            PG8_WAIT_V(8); PG8_WAIT_L(0); PG8_BAR; PG8_MMA(0, 0, At, B0); PG8_MMA(0, 1, At, B1); PG8_BAR; PG8_SCHED;
            PG8_LDA(At, 1, 1); PG8_STAGE(PG8_SB(1, 0), b3, voffB); PG8_STAGE(PG8_SB(1, 1), b3 + hstepB, voffB); PG8_STAGE(PG8_SA(1, 0), a3, voffA);
            PG8_WAIT_V(8); PG8_WAIT_L(0); PG8_BAR; PG8_MMA(1, 0, At, B0); PG8_MMA(1, 1, At, B1); PG8_BAR; PG8_SCHED;
        }
        if constexpr (ALIGN_EPI) { if (wr == 0) PG8_BAR; }
        E(acc, cur, wr, wc, fr, fq);
        if (!has_next) break;
#pragma unroll
        for (int a = 0; a < 2; ++a)
#pragma unroll
            for (int b = 0; b < 2; ++b)
#pragma unroll
                for (int m = 0; m < 4; ++m)
#pragma unroll
                    for (int n = 0; n < 2; ++n) acc[a][b][m][n] = (f32x4){0.f, 0.f, 0.f, 0.f};
        cur = nxt; cA = nA; cB = nB; ++ui;
        if constexpr (ALIGN_EPI) { if (wr == 1) PG8_BAR; }
    }
    PG8_WAIT_V(0);
    if constexpr (!ALIGN_EPI) { if (wr == 0) PG8_BAR; }
    PG8_BAR;
#undef PG8_SA
#undef PG8_SB
#undef PG8_STAGE
#undef PG8_LDA
#undef PG8_LDB
#undef PG8_MMA
#undef PG8_WAIT_V
#undef PG8_WAIT_L
#undef PG8_BAR
#undef PG8_SCHED
}
}

namespace fox {
constexpr int D = 128, LDQ = 8192, LDO = 2048;
constexpr float SCALE = 0.08838834764831845f;
constexpr float THR2 = 8.f * 1.4426950408889634f;
constexpr int NW = 8, QBLK = 32, KVBLK = 64, QB = NW * QBLK;
constexpr int SHM_V = KVBLK * D * 2, SHM_K = KVBLK * D * 2;
constexpr int BIAS_OFF = 2 * SHM_V + 2 * SHM_K + NW * 64 * 4;
constexpr int LDS_BYTES = BIAS_OFF + 8192 * 4;

#define KSWZ(row, colB) ((row) * 256 + ((colB) ^ (((row) & 7) << 4)))
#define SBAR() __builtin_amdgcn_sched_barrier(0)
__device__ __forceinline__ int v_st(int k, int c) { const int kk = (k & ~0xC) | ((k & 4) << 1) | ((k & 8) >> 1); return ((kk >> 3) * 4 + (c >> 5)) * 512 + ((kk & 7) * 32 + (c & 31)) * 2; }
__device__ __forceinline__ int v_rd_base(int lane) { return ((lane & 3) << 3) | (((lane >> 2) & 3) << 6) | (((lane >> 4) & 1) << 5) | (((lane >> 5) & 1) << 8); }
constexpr int v_rd_off(int d0, int ks, int half) { return d0 * 512 + ks * 4096 + half * 2048; }
__device__ __forceinline__ int crow(int r, int hi) { return (r & 3) + 8 * (r >> 2) + 4 * hi; }
__device__ __forceinline__ unsigned cvtpk(float lo, float hi) { unsigned r; asm volatile("v_cvt_pk_bf16_f32 %0, %1, %2" : "=v"(r) : "v"(lo), "v"(hi)); return r; }
__device__ __forceinline__ bf16x8 load8(const bf16* p) { return *reinterpret_cast<const bf16x8*>(p); }
__device__ __forceinline__ void mask_tile(f32x16& p0, f32x16& p1, int dq) {
    const float NEG = -__builtin_inff();
#pragma unroll
    for (int r = 0; r < 16; ++r) {
        const int c = (r & 3) + 8 * (r >> 2);
        if (dq - c < 0) p0[r] = NEG;
        if (dq - c - 32 < 0) p1[r] = NEG;
    }
}
__device__ __forceinline__ void partialSM(f32x16& p0, f32x16& p1, float& m_reg, float& mn, float& alpha, const float* bl) {
    constexpr float C2 = 1.4426950408889634f * SCALE;
#pragma unroll
    for (int a = 0; a < 4; ++a) {
#ifdef FOX_NOBIAS
        const f32x4 b0 = {0,0,0,0}, b1 = {0,0,0,0};
#else
        const f32x4 b0 = *(const f32x4*)(bl + 8 * a), b1 = *(const f32x4*)(bl + 32 + 8 * a);
#endif

#pragma unroll
        for (int i = 0; i < 4; ++i) { p0[4 * a + i] = fmaf(p0[4 * a + i], C2, b0[i]); p1[4 * a + i] = fmaf(p1[4 * a + i], C2, b1[i]); }
        SBAR(); }
    float pmax = p0[0]; for (int r = 1; r < 16; ++r) pmax = fmaxf(pmax, p0[r]); for (int r = 0; r < 16; ++r) pmax = fmaxf(pmax, p1[r]);
    { auto rr = __builtin_amdgcn_permlane32_swap(__float_as_uint(pmax), __float_as_uint(pmax), false, false);
      pmax = fmaxf(__uint_as_float(rr[0]), __uint_as_float(rr[1])); }
    if (__builtin_expect(__all((pmax - m_reg) <= THR2), 1)) { mn = m_reg; alpha = 1.f; }
    else { mn = fmaxf(m_reg, pmax); alpha = __builtin_amdgcn_exp2f(m_reg - mn); m_reg = mn; }
    for (int r = 0; r < 16; ++r) p0[r] = p0[r] - mn; for (int r = 0; r < 16; ++r) p1[r] = p1[r] - mn;
    for (int r = 0; r < 16; ++r) p0[r] = __builtin_amdgcn_exp2f(p0[r]);
}
__device__ __forceinline__ void finishSM(f32x16& p0, f32x16& p1, float alpha, float& l_reg, bf16x8& pa0, bf16x8& pa1, bf16x8& pa2, bf16x8& pa3) {
    for (int r = 0; r < 16; ++r) p1[r] = __builtin_amdgcn_exp2f(p1[r]);
    float ps = 0; for (int r = 0; r < 16; ++r) ps += p0[r]; for (int r = 0; r < 16; ++r) ps += p1[r];
    { auto rr = __builtin_amdgcn_permlane32_swap(__float_as_uint(ps), __float_as_uint(ps), false, false);
      ps = __uint_as_float(rr[0]) + __uint_as_float(rr[1]); }
    l_reg = l_reg * alpha + ps;
#define PK4(P, B_, OUT) do { unsigned a0 = cvtpk(P[B_+0], P[B_+1]), a1 = cvtpk(P[B_+2], P[B_+3]);                          \
        unsigned b0 = cvtpk(P[B_+4], P[B_+5]), b1 = cvtpk(P[B_+6], P[B_+7]);                                             \
        auto r0 = __builtin_amdgcn_permlane32_swap(a0, b0, false, false); auto r1 = __builtin_amdgcn_permlane32_swap(a1, b1, false, false); \
        u32x4 w = {r0[0], r1[0], r0[1], r1[1]}; OUT = *reinterpret_cast<bf16x8*>(&w); } while (0)
    PK4(p0, 0, pa0); PK4(p0, 8, pa1); PK4(p1, 0, pa2); PK4(p1, 8, pa3);
#undef PK4
}
template <int KB>
__device__ __forceinline__ void qkt(f32x16& p0, f32x16& p1, const char* K_lds, int r32, int hi, const bf16x8* qr) {
    p0 = f32x16{}; p1 = f32x16{};
    const char* kb[4];
#pragma unroll
    for (int dd = 0; dd < 4; ++dd) kb[dd] = K_lds + KB * SHM_K + KSWZ(r32, (dd * 16 + hi * 8) * 2);
#pragma unroll
    for (int d0 = 0; d0 < 8; ++d0) { const char* a = kb[d0 & 3] + (d0 >> 2) * 128;
        bf16x8 b0 = *reinterpret_cast<const bf16x8*>(a);
        bf16x8 b1 = *reinterpret_cast<const bf16x8*>(a + 32 * 256);
        p0 = __builtin_amdgcn_mfma_f32_32x32x16_bf16(b0, qr[d0], p0, 0, 0, 0);
        p1 = __builtin_amdgcn_mfma_f32_32x32x16_bf16(b1, qr[d0], p1, 0, 0, 0); }
}
template <int VB>
__device__ __forceinline__ void pv_tile(f32x16* o, int vb0, bf16x8 pa0, bf16x8 pa1, bf16x8 pa2, bf16x8 pa3) {
#define TRRD(dst, off) asm volatile("ds_read_b64_tr_b16 %0, %1 offset:%2" : "=&v"(dst) : "v"(vb0), "i"(off) : "memory")
#define PV_D0(d0) do { s16x4 l0, l1, l2, l3, h0, h1, h2, h3; constexpr int b_ = VB * SHM_V + v_rd_off(d0, 0, 0); \
        TRRD(l0, b_); TRRD(h0, b_ + 2048); TRRD(l1, b_ + 4096); TRRD(h1, b_ + 6144); TRRD(l2, b_ + 8192); TRRD(h2, b_ + 10240); TRRD(l3, b_ + 12288); TRRD(h3, b_ + 14336); \
        asm volatile("s_waitcnt lgkmcnt(0)" ::: "memory"); SBAR();   \
        o[d0] = __builtin_amdgcn_mfma_f32_32x32x16_bf16(pa0, (bf16x8){l0[0], l0[1], l0[2], l0[3], h0[0], h0[1], h0[2], h0[3]}, o[d0], 0, 0, 0);   \
        o[d0] = __builtin_amdgcn_mfma_f32_32x32x16_bf16(pa1, (bf16x8){l1[0], l1[1], l1[2], l1[3], h1[0], h1[1], h1[2], h1[3]}, o[d0], 0, 0, 0);   \
        o[d0] = __builtin_amdgcn_mfma_f32_32x32x16_bf16(pa2, (bf16x8){l2[0], l2[1], l2[2], l2[3], h2[0], h2[1], h2[2], h2[3]}, o[d0], 0, 0, 0);   \
        o[d0] = __builtin_amdgcn_mfma_f32_32x32x16_bf16(pa3, (bf16x8){l3[0], l3[1], l3[2], l3[3], h3[0], h3[1], h3[2], h3[3]}, o[d0], 0, 0, 0); } while (0)
    PV_D0(0); PV_D0(1); PV_D0(2); PV_D0(3);
#undef PV_D0
#undef TRRD
}

struct BlockRef { const bf16* Q; const bf16* K; const bf16* V; const bf16* G; bf16* O; int P0; };
struct Seam { bf16x8 qr[8]; bf16x8 st_v0, st_v1, st_k0, st_k1; };
#define LD8(base, boff) (*reinterpret_cast<const bf16x8*>((const char*)(base) + (boff)))
#define VMW() asm volatile("s_waitcnt vmcnt(0)" ::: "memory")
#define VMWN(n) asm volatile("s_waitcnt vmcnt(%0)" :: "i"(n) : "memory")
#define SLOAD_H(Kp, Vp, k0) do { const char* kb__ = (const char*)(Kp) + (size_t)(k0) * (LDQ * 2); const char* vb__ = (const char*)(Vp) + (size_t)(k0) * (LDQ * 2); \
                         S.st_v0 = LD8(vb__, kvoff); S.st_v1 = LD8(vb__, kvoff + 32u * LDQ * 2u);              \
                         S.st_k0 = LD8(kb__, kvoff); S.st_k1 = LD8(kb__, kvoff + 32u * LDQ * 2u); } while (0)
#define SWRITE_HK(bf) do { *(bf16x8*)(K_lds + (bf) * SHM_K + kws) = S.st_k0; *(bf16x8*)(K_lds + (bf) * SHM_K + kws + 32 * 256) = S.st_k1; } while (0)
#define SWRITE_HV(bf) do { *(bf16x8*)(V_lds + (bf) * SHM_V + vst0) = S.st_v0; *(bf16x8*)(V_lds + (bf) * SHM_V + vst1) = S.st_v1; } while (0)
#define SWRITE_H(bf) do { SWRITE_HV(bf); SWRITE_HK(bf); } while (0)
__device__ __forceinline__ void prime(const BlockRef& cur, char* lds, Seam& S) {
    const int tid = threadIdx.x, wid = __builtin_amdgcn_readfirstlane(tid >> 6), lane = tid & 63, r32 = lane & 31, hi = lane >> 5;
    const int sr = tid >> 4, sc = (tid & 15) * 8, kws = KSWZ(sr, sc * 2); char* K_lds = lds + 2 * SHM_V;
    const unsigned kvoff = (unsigned)(sr * LDQ + sc) * 2u, qoff = (unsigned)((wid * QBLK + r32) * LDQ + hi * 8) * 2u;
    for (int d0 = 0; d0 < 8; ++d0) S.qr[d0] = LD8(cur.Q, qoff + d0 * 32);
    SLOAD_H(cur.K, cur.V, 0); VMW(); SWRITE_HK(0);
    __syncthreads();
}
__device__ __forceinline__ void block(const BlockRef& cur, const BlockRef& nxt, char* lds, Seam& S) {
    const int tid = threadIdx.x, wid = __builtin_amdgcn_readfirstlane(tid >> 6), lane = tid & 63, r32 = lane & 31, hi = lane >> 5;
    const int NT = (cur.P0 + QB - 1) / KVBLK + 1;
    const int qlo = cur.P0 + wid * QBLK, qm = qlo + r32 - 4 * hi;
    char* V_lds = lds; char* K_lds = lds + 2 * SHM_V;
    float* ws = (float*)(lds + 2 * SHM_V + 2 * SHM_K) + wid * 64; float* li_l = ws, * al_l = ws + 32;
    const float* biasl = (const float*)(lds + BIAS_OFF) + 4 * hi;
    float m_reg = -1e30f, l_reg = 0; f32x16 o[4] = {};
    const int sr = tid >> 4, sc = (tid & 15) * 8, vst0 = v_st(sr, sc), vst1 = v_st(32 + sr, sc), kws = KSWZ(sr, sc * 2);
    const unsigned kvoff = (unsigned)(sr * LDQ + sc) * 2u;
    const int vb0 = (int)(uintptr_t)V_lds + v_rd_base(lane);
    const bf16* Kh = cur.K; const bf16* Vh = cur.V;
#define RESC(a) do { if (__any((a) < 1.f)) { if (hi == 0) al_l[r32] = (a); asm volatile("s_waitcnt lgkmcnt(0)" ::: "memory");              \
                     for (int d_ = 0; d_ < 4; ++d_) for (int r = 0; r < 16; ++r) o[d_][r] *= al_l[crow(r, hi)]; } } while (0)
#define KBASE(t) ((t) * KVBLK)
#define MASKT(P0_, P1_, t) do { const int kb_ = KBASE(t); if (kb_ + KVBLK - 1 > qlo) mask_tile(P0_, P1_, qm - kb_); } while (0)
    constexpr int NQL = 8;
#define SEAM_K0() do { VMWN(NQL); SWRITE_HK(0); SBAR(); } while (0)
    f32x16 pA0, pA1, pB0, pB1; float mnA, mnB, alA, alB; bf16x8 pa0, pa1, pa2, pa3;
    SWRITE_HV(0); SBAR();
    if (NT > 1) { SLOAD_H(Kh, Vh, KBASE(1)); }
    SBAR(); qkt<0>(pA0, pA1, K_lds, r32, hi, S.qr);
    MASKT(pA0, pA1, 0); partialSM(pA0, pA1, m_reg, mnA, alA, biasl + KBASE(0));
    if (NT > 1) { VMW(); SWRITE_H(1); }
    __syncthreads();
#define HALF_STEP(PX0, PX1, mnX, alX, PY0, PY1, alY, t, KB, VB, SB) do {                                                      \
        SBAR(); qkt<KB>(PX0, PX1, K_lds, r32, hi, S.qr);                                                                      \
        finishSM(PY0, PY1, alY, l_reg, pa0, pa1, pa2, pa3); SBAR();                                                           \
        if ((t) + 1 < NT) { SLOAD_H(Kh, Vh, KBASE((t) + 1)); SBAR(); }                                                        \
        pv_tile<VB>(o, vb0, pa0, pa1, pa2, pa3); MASKT(PX0, PX1, (t)); partialSM(PX0, PX1, m_reg, mnX, alX, biasl + KBASE(t)); \
        __syncthreads();                                                                                                      \
        if ((t) + 1 < NT) { VMW(); SWRITE_H(SB); }                                                                            \
        RESC(alX); __syncthreads(); } while (0)
    for (int t = 1; t + 1 < NT; t += 2) {
        HALF_STEP(pB0, pB1, mnB, alB, pA0, pA1, alA, t, 1, 0, 0);
        HALF_STEP(pA0, pA1, mnA, alA, pB0, pB1, alB, t + 1, 0, 1, 1);
    }
    const bool even = (NT & 1) == 0;
    if (even) { SBAR(); qkt<1>(pB0, pB1, K_lds, r32, hi, S.qr); SBAR(); }
    SLOAD_H(nxt.K, nxt.V, 0); SBAR();
    { unsigned qoff = (unsigned)((wid * QBLK + r32) * LDQ + hi * 8) * 2u; asm volatile("" : "+v"(qoff));
#pragma unroll
      for (int d0 = 0; d0 < 8; ++d0) S.qr[d0] = LD8(nxt.Q, qoff + d0 * 32); }
    SBAR();
    finishSM(pA0, pA1, alA, l_reg, pa0, pa1, pa2, pa3); SBAR();
    pv_tile<0>(o, vb0, pa0, pa1, pa2, pa3);
    if (even) { MASKT(pB0, pB1, NT - 1); partialSM(pB0, pB1, m_reg, mnB, alB, biasl + KBASE(NT - 1)); __syncthreads(); RESC(alB);
        finishSM(pB0, pB1, alB, l_reg, pa0, pa1, pa2, pa3); SBAR(); pv_tile<1>(o, vb0, pa0, pa1, pa2, pa3); }
    SBAR(); SEAM_K0();
    if (hi == 0) li_l[r32] = l_reg; asm volatile("s_waitcnt lgkmcnt(0)" ::: "memory");
    float rli[16];
#pragma unroll
    for (int r = 0; r < 16; ++r) rli[r] = __builtin_amdgcn_rcpf(li_l[crow(r, hi)]);
    unsigned ooff = (unsigned)((wid * QBLK + 4 * hi) * LDO + r32) * 2u, goff = (unsigned)((wid * QBLK + 4 * hi) * LDQ + r32) * 2u;
    asm volatile("" : "+v"(ooff), "+v"(goff));
#pragma unroll
    for (int r = 0; r < 16; ++r) { const unsigned rr = (unsigned)((r & 3) + 8 * (r >> 2));
#pragma unroll
        for (int d0 = 0; d0 < 4; ++d0) {
#ifdef FOX_NOGATE
            const float gv = 0.f;
#else
            const float gv = bf2f(*(const bf16*)((const char*)cur.G + (goff + rr * (LDQ * 2u) + d0 * 64u)));
#endif

            const float v = o[d0][r] * rli[r] * (1.0f / (1.0f + __expf(-gv)));
            const float vn = __shfl_xor(v, 1);
            if ((r32 & 1) == 0) *(unsigned*)((char*)cur.O + (ooff + rr * (LDO * 2u) + d0 * 64u)) = cvtpk(v, vn); } }
    __syncthreads();
#undef RESC
#undef KBASE
#undef MASKT
#undef SEAM_K0
#undef HALF_STEP
}
#undef LD8
#undef VMW
#undef VMWN
#undef SLOAD_H
#undef SWRITE_HK
#undef SWRITE_HV
#undef SWRITE_H
#undef KSWZ
#undef SBAR
}

constexpr int NWAVES = 8;
constexpr size_t MiB = 1u << 20;
constexpr size_t WS_CTL = 0, CTL_ZERO_BYTES = 1 * MiB;
constexpr size_t WS_MEMN = 1 * MiB;
constexpr size_t WS_KMEM = 2 * MiB;
constexpr size_t WS_VTMEM = 4 * MiB;
constexpr size_t WS_SMALL = 6 * MiB;
constexpr size_t SM_BONUS = 0;
constexpr size_t SM_FPRE = 512 * 1024;
constexpr size_t SM_BIASL2 = 1024 * 1024;
constexpr size_t SM_BCUM = 1536 * 1024;
constexpr size_t SM_IG = SM_BCUM + 128 * 1024;
constexpr size_t SM_WSTATE = SM_IG + 128 * 1024;
constexpr size_t SM_CHBL = SM_WSTATE + 128 * 1024;
constexpr size_t SM_CHMD = SM_CHBL + 4096;
constexpr size_t SM_MSEQ = SM_CHMD + 4096;
constexpr size_t SM_WCARRY = SM_MSEQ + 4096;
constexpr size_t SM_TOPI = 2048 * 1024;
constexpr size_t SM_TOPG = SM_TOPI + 64 * 1024;
constexpr size_t SM_SLOT = SM_TOPG + 64 * 1024;
constexpr size_t SM_BLKCNT = SM_SLOT + 64 * 1024;
constexpr size_t SM_TILEE = SM_BLKCNT + 8192;
constexpr size_t SM_NU = 3 * 1024 * 1024;
constexpr size_t WS_X = 16 * MiB;
constexpr size_t WS_XN = 80 * MiB;
constexpr size_t WS_W_XQ = 112 * MiB, WS_W_XKV = 128 * MiB, WS_W_XO = 160 * MiB, WS_W_ABIN = 176 * MiB, WS_W_LORA = 206 * MiB, WS_W_ABOUT = 209 * MiB,
                 WS_W_FFNGU = 217 * MiB, WS_W_FFND = 261 * MiB, WS_W_FOXIN = 283 * MiB, WS_W_FOXOUT = 315 * MiB, WS_W_MOEGU = 323 * MiB, WS_W_MOED = 675 * MiB;
constexpr size_t WS_R = 851 * MiB;
constexpr size_t R_PROJ = WS_R + 0 * MiB;
constexpr size_t R_GATES32 = WS_R + 120 * MiB;
constexpr size_t R_LORAIN = WS_R + 128 * MiB;
constexpr size_t R_LORAOUT = WS_R + 136 * MiB;
constexpr size_t R_SC = WS_R + 232 * MiB;
constexpr size_t SC_STRIDE = 32 * MiB;
constexpr size_t R_Y = WS_R + 424 * MiB;
constexpr size_t R_QB = WS_R + 456 * MiB, R_KB = WS_R + 472 * MiB, R_VB = WS_R + 488 * MiB;
constexpr size_t R_U = WS_R + 504 * MiB;
constexpr size_t R_YCAT = WS_R + 568 * MiB;
constexpr size_t R_XQ = WS_R + 0 * MiB;
constexpr size_t R_XS = WS_R + 32 * MiB;
constexpr size_t R_XP = WS_R + 64 * MiB;
constexpr size_t R_XO = WS_R + 80 * MiB;
constexpr size_t R_ACT = WS_R + 112 * MiB;
constexpr size_t R_QKVG = WS_R + 200 * MiB;
constexpr size_t R_ATTO = WS_R + 328 * MiB;
constexpr size_t R_AG = WS_R + 0 * MiB;
constexpr size_t R_ACTG = WS_R + 72 * MiB;
constexpr size_t R_YG = WS_R + 270 * MiB;
constexpr size_t WS_END = WS_R + 600 * MiB;
static_assert(R_YG + (size_t)MOE_ROWS * D * 4 <= WS_END && R_ACTG + (size_t)MOE_ROWS * DFF * 2 <= R_YG && R_YCAT + (size_t)T * D * 2 <= WS_END, "ws map");
static_assert(WS_W_MOED + (size_t)NEXP * D * DFF * 2 <= WS_R && WS_W_MOEGU + (size_t)NEXP * 2 * DFF * D * 2 <= WS_W_MOED, "ws map (weights)");
constexpr int CW_BAR = 4096;

constexpr int RING_OFF = 0, RING_BYTES = 131072;
constexpr int LDSCTL_OFF = RING_BYTES, MISC_OFF = LDSCTL_OFF + 320;
constexpr int LDS_BYTES = 147456;

typedef GAS unsigned gu32;
#define RLX_AGENT __ATOMIC_RELAXED, __HIP_MEMORY_SCOPE_AGENT
#define LDS_WAIT() asm volatile("s_waitcnt lgkmcnt(0)" ::: "memory")
#define VM_WAIT() asm volatile("s_waitcnt vmcnt(0)" ::: "memory")

#define XB_TMO      128
#define XB_XCNT(j)  (256  + 64 * (j))
#define XB_XSUB(j)  (1280 + 64 * (j))
#define XB_XGEN(j)  (2304 + 64 * (j))
#define XB_TOP      3328
#define XB_TOPGEN   3392
#define XCD_BAR_WORDS 3456
#define XB_SPIN_CAP (1u << 18)
__device__ __forceinline__ unsigned xb_ld(unsigned* p)              { return __hip_atomic_load(p, __ATOMIC_RELAXED, __HIP_MEMORY_SCOPE_AGENT); }
__device__ __forceinline__ unsigned xb_add(unsigned* p, unsigned v) { return __hip_atomic_fetch_add(p, v, __ATOMIC_RELAXED, __HIP_MEMORY_SCOPE_AGENT); }
__device__ __forceinline__ unsigned xb_xcc_id() { return (unsigned)__builtin_amdgcn_s_getreg((3 << 11) | 20) & 0xFu; }
#define XB_SPIN(cond, bar) do { unsigned _sp = 0; while (cond) { __builtin_amdgcn_s_sleep(1); \
    if ((++_sp & 255u) == 0u) { if (xb_ld(&(bar)[XB_TMO])) break; if (_sp > XB_SPIN_CAP) { atomicAdd(&(bar)[XB_TMO], 1u); break; } } } } while (0)
struct XcdBarrier { unsigned* bar; unsigned x; volatile LAS unsigned* st; };
__device__ __forceinline__ XcdBarrier xcd_barrier_post(unsigned* bar, volatile LAS unsigned* st) {
    XcdBarrier b; b.bar = bar; b.x = xb_xcc_id(); b.st = st;
    if (threadIdx.x == 0) (void)xb_add(&bar[XB_XCNT(b.x)], 1u);
    return b;
}
__device__ __forceinline__ void xcd_barrier_complete(unsigned* bar, unsigned x, unsigned& nloc, unsigned& nx) {
    const unsigned G = gridDim.x * gridDim.y * gridDim.z;
    unsigned sum, cnt, mine, sp = 0u;
    for (;;) {
        sum = 0u; cnt = 0u; mine = 0u;
#pragma unroll
        for (unsigned j = 0; j < 16; ++j) { const unsigned c = xb_ld(&bar[XB_XCNT(j)]); sum += c; cnt += (c > 0u) ? 1u : 0u; mine = (j == x) ? c : mine; }
        if (sum == G) break;
        __builtin_amdgcn_s_sleep(1);
        if ((++sp & 255u) == 0u) { if (xb_ld(&bar[XB_TMO])) break; if (sp > XB_SPIN_CAP) { atomicAdd(&bar[XB_TMO], 1u); break; } }
    }
    nloc = mine > 0u ? mine : 1u; nx = cnt > 0u ? cnt : 1u;
}
__device__ __forceinline__ void xcd_barrier(const XcdBarrier& b) {
    asm volatile("s_waitcnt vmcnt(0)" ::: "memory");
    __syncthreads();
    if (threadIdx.x == 0) {
        unsigned* bar = b.bar;
        __builtin_amdgcn_s_waitcnt(0);
        unsigned nloc = b.st[0], nx = b.st[1];
        if (nloc == 0u) { xcd_barrier_complete(bar, b.x, nloc, nx); b.st[0] = nloc; b.st[1] = nx; }
        const unsigned old = xb_add(&bar[XB_XSUB(b.x)], 1u);
        const unsigned gen = old / nloc;
        if (old + 1u == (gen + 1u) * nloc) {
            __builtin_amdgcn_fence(__ATOMIC_RELEASE, "agent");
            asm volatile("s_waitcnt vmcnt(0)" ::: "memory");
            const unsigned og = xb_add(&bar[XB_TOP], 1u);
            const unsigned tg = og / nx;
            if (og + 1u == (tg + 1u) * nx) xb_add(&bar[XB_TOPGEN], 1u);
            else XB_SPIN(xb_ld(&bar[XB_TOPGEN]) == tg, bar);
            __builtin_amdgcn_fence(__ATOMIC_ACQUIRE, "agent");
            xb_add(&bar[XB_XGEN(b.x)], 1u);
            asm volatile("s_waitcnt vmcnt(0)" ::: "memory");
        } else {
            XB_SPIN(xb_ld(&bar[XB_XGEN(b.x)]) == gen, bar);
            __builtin_amdgcn_fence(__ATOMIC_ACQUIRE, "agent");
            asm volatile("s_waitcnt vmcnt(0)" ::: "memory");
        }
    }
    __syncthreads();
}

struct Frame {
    LAS unsigned char* lds; unsigned char* ldsg;
    unsigned char* ws; const float* const* in; float* out;
    int tid, lane, wave, vcu, G, gw, NGW;
};

enum InIdx { I_X = 0, I_MEM, I_MEMG, I_FING, I_NMIXG, I_NXAG, I_NFFNG, I_XWQ, I_XWKV, I_XWO, I_ABWIN, I_ABMU, I_RWW0, I_RWWUP, I_RWA0, I_RWAUP, I_RWGUP, I_RWKK, I_RWKA, I_RWRK,
             I_RWLNG, I_RWLNB, I_MLCONV, I_MLBIF, I_MLNG, I_ABWOUT, I_FFG, I_FFU, I_FFD, I_FOXWIN, I_FOXBF, I_FOXQG, I_FOXKG, I_FOXWOUT, I_ROUTER, I_MOEG, I_MOEU, I_MOED, N_IN };
struct Args { const float* in[N_IN]; float* out; unsigned char* ws; int ph_lo, ph_hi; };
static_assert(sizeof(Args) == (N_IN + 2) * 8 + 8, "Args has no padding");

#define WSP(T_, off) ((T_*)(F.ws + (off)))

__device__ __forceinline__ void rms_row(const float* xrow, const float* g, bf16* orow, int lane, f32x4 (&y)[8]) {
    const f32x4* xr = (const f32x4*)xrow + lane; const f32x4* gr = (const f32x4*)g + lane;
    float s = 0.f;
#pragma unroll
    for (int j = 0; j < 8; ++j) { y[j] = xr[64 * j]; s += (y[j][0] * y[j][0] + y[j][1] * y[j][1]) + (y[j][2] * y[j][2] + y[j][3] * y[j][3]); }
    const float r = 1.0f / sqrtf(wave_sum(s) * (1.0f / D) + 1e-6f);
#pragma unroll
    for (int j = 0; j < 8; ++j) { const f32x4 gv = gr[64 * j]; y[j] = y[j] * r * gv; }
    if (orow) { u32x2* o8 = (u32x2*)orow + lane;
#pragma unroll
        for (int j = 0; j < 8; ++j) { u32x2 w; w.x = cvt_pk_bf16(y[j][0], y[j][1]); w.y = cvt_pk_bf16(y[j][2], y[j][3]); o8[64 * j] = w; } }
}
__device__ __forceinline__ void norm_phase(const Frame& F, const float* X, const float* g, bf16* XN, int nrows) {
    for (int t = F.gw; t < nrows; t += F.NGW) { f32x4 y[8]; rms_row(X + (size_t)t * D, g, XN + (size_t)t * D, F.lane, y); }
}
template <int NC>
__device__ __forceinline__ void stage_skinny(const Frame& F, const float* W, int ldw, int c0, LAS float* Ws) {
    for (int i = F.tid; i < D * NC; i += NWAVES * 64) { const int e = i / NC, c = i % NC; Ws[c * D + e] = W[(size_t)e * ldw + c0 + c]; }
}
template <int NC>
__device__ __forceinline__ void skinny_dot(const f32x4 (&y)[8], const LAS float* Ws, int lane, float (&out)[NC]) {
#pragma unroll
    for (int c = 0; c < NC; ++c) { float s = 0.f;
#pragma unroll
        for (int j = 0; j < 8; ++j) { const f32x4 w = *(const LAS f32x4*)(Ws + c * D + 256 * j + 4 * lane); s += (y[j][0] * w[0] + y[j][1] * w[1]) + (y[j][2] * w[2] + y[j][3] * w[3]); }
        out[c] = wave_sum(s); }
}

__device__ __forceinline__ void transpose_item(const float* W, int ldw, int k0, int n0, int nvalid, bf16* WT0  , int K, LAS float* scr, int lane) {
#pragma unroll 8
    for (int i = 0; i < 32; ++i) { const int kk = 2 * i + (lane >> 5), n = lane & 31; scr[kk * 33 + n] = (n < nvalid) ? W[(size_t)(k0 + kk) * ldw + n0 + n] : 0.f; }
    LDS_WAIT(); asm volatile("" ::: "memory");
    const int c = lane & 7;
#pragma unroll
    for (int j = 0; j < 4; ++j) { const int n = (lane >> 3) + 8 * j; const LAS float* s = scr + (8 * c) * 33 + n;
        u32x4 o; o.x = cvt_pk_bf16(s[0 * 33], s[1 * 33]); o.y = cvt_pk_bf16(s[2 * 33], s[3 * 33]); o.z = cvt_pk_bf16(s[4 * 33], s[5 * 33]); o.w = cvt_pk_bf16(s[6 * 33], s[7 * 33]);
        if (n < nvalid) *(u32x4*)(WT0 + (size_t)n * K + k0 + 8 * c) = o; }
    LDS_WAIT(); asm volatile("" ::: "memory");
}
__device__ __forceinline__ void transpose_matrix(const Frame& F, const float* W, int ldw, int K, int N, bf16* WT, int mode, int& it0, LAS float* scr) {
    const int nblk = (N + 31) / 32, nitems = (K / 64) * nblk;
    int first = F.gw - (it0 % F.NGW); if (first < 0) first += F.NGW;
    for (int r = first; r < nitems; r += F.NGW) {
        const int kb = r / nblk, nb = r % nblk, n0 = 32 * nb; const int nvalid = (N - n0) < 32 ? (N - n0) : 32;
        const int drow = mode == 0 ? n0 : ((n0 >> 7) * 256 + (n0 & 127) + (mode == 2 ? 128 : 0));
        transpose_item(W, ldw, 64 * kb, n0, nvalid, WT + (size_t)drow * K, K, scr, F.lane);
    }
    it0 += nitems;
}
__device__ __forceinline__ void p_convert(const Frame& F, const Args& A) {
    LAS float* scr = (LAS float*)(F.lds + RING_OFF + F.wave * 16384);
    int it0 = 0;
    for (int l = 0; l < 2; ++l) {
        transpose_matrix(F, A.in[I_XWQ] + (size_t)l * D * D, D, D, D, WSP(bf16, WS_W_XQ) + (size_t)l * D * D, 0, it0, scr);
        transpose_matrix(F, A.in[I_XWKV] + (size_t)l * D * 2 * D, 2 * D, D, 2 * D, WSP(bf16, WS_W_XKV) + (size_t)l * 2 * D * D, 0, it0, scr);
        transpose_matrix(F, A.in[I_XWO] + (size_t)l * D * D, D, D, D, WSP(bf16, WS_W_XO) + (size_t)l * D * D, 0, it0, scr);
    }
    transpose_matrix(F, A.in[I_ABWIN], AB_COLS, D, AB_COLS, WSP(bf16, WS_W_ABIN), 0, it0, scr);
    transpose_matrix(F, A.in[I_ABWOUT], D, D, D, WSP(bf16, WS_W_ABOUT), 0, it0, scr);
    transpose_matrix(F, A.in[I_FFG], DFF, D, DFF, WSP(bf16, WS_W_FFNGU), 1, it0, scr);
    transpose_matrix(F, A.in[I_FFU], DFF, D, DFF, WSP(bf16, WS_W_FFNGU), 2, it0, scr);
    transpose_matrix(F, A.in[I_FFD], D, DFF, D, WSP(bf16, WS_W_FFND), 0, it0, scr);
    transpose_matrix(F, A.in[I_FOXWIN], FOX_LD, D, 8192, WSP(bf16, WS_W_FOXIN), 0, it0, scr);
    transpose_matrix(F, A.in[I_FOXWOUT], D, D, D, WSP(bf16, WS_W_FOXOUT), 0, it0, scr);
    for (int e = 0; e < NEXP; ++e) {
        transpose_matrix(F, A.in[I_MOEG] + (size_t)e * D * DFF, DFF, D, DFF, WSP(bf16, WS_W_MOEGU) + (size_t)e * 2 * DFF * D, 1, it0, scr);
        transpose_matrix(F, A.in[I_MOEU] + (size_t)e * D * DFF, DFF, D, DFF, WSP(bf16, WS_W_MOEGU) + (size_t)e * 2 * DFF * D, 2, it0, scr);
        transpose_matrix(F, A.in[I_MOED] + (size_t)e * DFF * D, D, DFF, D, WSP(bf16, WS_W_MOED) + (size_t)e * D * DFF, 0, it0, scr);
    }
    const int gt = F.gw * 64 + F.lane, NGT = F.NGW * 64;
    { u32x4* z = (u32x4*)(WSP(bf16, WS_W_ABIN) + (size_t)AB_COLS * D); const int n16 = (AB_PAD - AB_COLS) * D * 2 / 16;
      for (int i = gt; i < n16; i += NGT) z[i] = (u32x4){0u, 0u, 0u, 0u}; }
    { bf16* WL = WSP(bf16, WS_W_LORA); const float* wup = A.in[I_RWWUP]; const float* aup = A.in[I_RWAUP]; const float* gup = A.in[I_RWGUP];
      for (int i = gt; i < 3072 * 64; i += NGT) { const int n = i >> 6, k8 = (i & 63) * 8; const int sec = n >> 10, nn = n & 1023; float v[8];
#pragma unroll
          for (int j = 0; j < 8; ++j) { const int k = k8 + j; float x = 0.f;
              if (sec == 0) { if (k < 96) x = wup[(size_t)k * 1024 + nn]; }
              else if (sec == 1) { if (k >= 96 && k < 192) x = aup[(size_t)(k - 96) * 1024 + nn]; }
              else { if (k >= 192 && k < 448) x = gup[(size_t)(k - 192) * 1024 + nn]; }
              v[j] = x; }
          u32x4 o; o.x = cvt_pk_bf16(v[0], v[1]); o.y = cvt_pk_bf16(v[2], v[3]); o.z = cvt_pk_bf16(v[4], v[5]); o.w = cvt_pk_bf16(v[6], v[7]);
          *(u32x4*)(WL + (size_t)n * 512 + k8) = o; } }
    norm_phase(F, A.in[I_MEM], A.in[I_MEMG], WSP(bf16, WS_MEMN), NMEM);
    norm_phase(F, A.in[I_X], A.in[I_NMIXG], WSP(bf16, WS_XN), T);
}

struct KvOrder {
    const bf16* memn; const bf16* wkv; int c;
    __device__ __forceinline__ bool next(int i, pg8::Unit& u) const {
        if (i != 0 || c >= 32) return false;
        const int l = c >> 4, kind = (c >> 3) & 1, idx = c & 7; const bf16* w = wkv + (size_t)l * 2 * D * D;
        if (kind == 0) { u.a = (const char*)memn; u.b = (const char*)(w + (size_t)idx * 256 * D); u.pm = 0; u.pn = idx; }
        else { u.a = (const char*)(w + (size_t)(D + idx * 256) * D); u.b = (const char*)memn; u.pm = idx; u.pn = 0; }
        u.aux = l * 2 + kind; u.pad = 0; return true;
    }
};
struct EpiKv {
    static constexpr bool PERM = true;
    bf16* kmem; bf16* vtmem;
    __device__ __forceinline__ void operator()(const f32x4 (&acc)[2][2][4][2], const pg8::Unit& u, int wr, int wc, int fr, int fq) const {
        const int l = u.aux >> 1, kind = u.aux & 1;
        pg8::EpiBf16 E{kind == 0 ? kmem + (size_t)l * NMEM * D : vtmem + (size_t)l * D * NMEM, kind == 0 ? D : NMEM, nullptr, -1};
        E(acc, u, wr, wc, fr, fq);
    }
};

__device__ __forceinline__ void p_prepa(const Frame& F, const Args& A) {
    const bf16* PROJ = WSP(bf16, R_PROJ); const float* mu = A.in[I_ABMU]; const float* convw = A.in[I_MLCONV];
    bf16* LIN = WSP(bf16, R_LORAIN); bf16* QB = WSP(bf16, R_QB); bf16* KB = WSP(bf16, R_KB); bf16* VB = WSP(bf16, R_VB);
    const int lane = F.lane;
    for (int t = F.gw; t < T; t += F.NGW) {
        const bf16* p0 = PROJ + (size_t)t * AB_PAD;
#pragma unroll
        for (int i = 0; i < 7; ++i) { const int cc = lane + 64 * i, c = 3072 + cc; const float p = bf2f(p0[c]); const float pp = t > 0 ? bf2f(p0[c - AB_PAD]) : 0.f;
            const float s = p + (pp - p) * mu[c]; float o;
            if (cc < 96) o = tanhf(s); else if (cc < 192) o = s; else o = sigmoidf_(s);
            LIN[(size_t)t * 512 + cc] = f2bf(o); }
        LIN[(size_t)t * 512 + 448 + lane] = 0;
#pragma unroll
        for (int i = 0; i < 4; ++i) { const int c = 8 * lane + 512 * i; float acc[8];
#pragma unroll
            for (int j = 0; j < 8; ++j) acc[j] = 0.f;
#pragma unroll
            for (int tap = 0; tap < 4; ++tap) { const int tt = t - 3 + tap; if (tt >= 0) {
                const bf16x8 v = *(const bf16x8*)(PROJ + (size_t)tt * AB_PAD + A_COLS + c); const f32x4 w0 = *(const f32x4*)(convw + tap * 2048 + c), w1 = *(const f32x4*)(convw + tap * 2048 + c + 4);
#pragma unroll
                for (int j = 0; j < 4; ++j) { acc[j] += bf2f((unsigned short)v[j]) * w0[j]; acc[4 + j] += bf2f((unsigned short)v[4 + j]) * w1[j]; } } }
            const float sc = c < 1024 ? 0.0625f : 1.0f; float o[8];
#pragma unroll
            for (int j = 0; j < 8; ++j) o[j] = acc[j] * sigmoidf_(acc[j]) * sc;
            u32x4 w; w.x = cvt_pk_bf16(o[0], o[1]); w.y = cvt_pk_bf16(o[2], o[3]); w.z = cvt_pk_bf16(o[4], o[5]); w.w = cvt_pk_bf16(o[6], o[7]);
            if (c < 1024) *(u32x4*)(QB + (size_t)t * 1024 + c) = w; else *(u32x4*)(KB + (size_t)t * 1024 + c - 1024) = w; }
#pragma unroll
        for (int i = 0; i < 2; ++i) { const int c = 8 * lane + 512 * i; *(u32x4*)(VB + (size_t)t * 1024 + c) = *(const u32x4*)(p0 + 5568 + c); }
    }
    const float* G32 = WSP(float, R_GATES32); const float* bif = A.in[I_MLBIF];
    float* BCUM = WSP(float, WS_SMALL + SM_BCUM); float* IG = WSP(float, WS_SMALL + SM_IG); float* CHBL = WSP(float, WS_SMALL + SM_CHBL); float* CHMD = WSP(float, WS_SMALL + SM_CHMD);
    for (int u = F.gw; u < NH_M * 128; u += F.NGW) { const int h = u >> 7, c = u & 127, t = 64 * c + lane;
        const float ig = G32[(size_t)t * 256 + 192 + h] + bif[h], fg = G32[(size_t)t * 256 + 196 + h] + bif[4 + h];
        float b = logsigmoidf_(fg);
#pragma unroll
        for (int o = 1; o < 64; o <<= 1) { const float x = __shfl_up(b, o); if (lane >= o) b += x; }
        const float bl = __shfl(b, 63); const float md = wave_max(bl - b + ig);
        BCUM[h * T + t] = b; IG[h * T + t] = ig;
        if (lane == 0) { CHBL[u] = bl; CHMD[u] = md; } }
}

__device__ __forceinline__ void p_prepb(const Frame& F, const Args& A) {
    const bf16* PROJ = WSP(bf16, R_PROJ); const float* LOUT = WSP(float, R_LORAOUT); const float* mu = A.in[I_ABMU];
    const float* w0 = A.in[I_RWW0]; const float* a0 = A.in[I_RWA0]; const float* kk_ = A.in[I_RWKK]; const float* ka_ = A.in[I_RWKA]; const float* rk_ = A.in[I_RWRK];
    float* SR = WSP(float, R_SC); float* SW = WSP(float, R_SC + SC_STRIDE); float* SKM = WSP(float, R_SC + 2 * SC_STRIDE); float* SV = WSP(float, R_SC + 3 * SC_STRIDE);
    float* SKK = WSP(float, R_SC + 4 * SC_STRIDE); float* SB = WSP(float, R_SC + 5 * SC_STRIDE); float* BONUS = WSP(float, WS_SMALL + SM_BONUS);
    const int lane = F.lane;
    for (int t = F.gw; t < T; t += F.NGW) {
        const bf16* p0 = PROJ + (size_t)t * AB_PAD; const float* lo = LOUT + (size_t)t * 3072;
        for (int h = 0; h < NH_R; ++h) { const int c = 64 * h + lane;
            float r = bf2f(p0[c]), k = bf2f(p0[1024 + c]), v = bf2f(p0[2048 + c]);
            if (t > 0) { const float pr = bf2f(p0[c - AB_PAD]), pk = bf2f(p0[1024 + c - AB_PAD]), pv = bf2f(p0[2048 + c - AB_PAD]);
                r += (pr - r) * mu[c]; k += (pk - k) * mu[1024 + c]; v += (pv - v) * mu[2048 + c]; }
            else { r -= r * mu[c]; k -= k * mu[1024 + c]; v -= v * mu[2048 + c]; }
            const float w = __expf(-0.6065306597126334f * sigmoidf_(lo[c] + w0[c]));
            const float a = sigmoidf_(a0[c] + lo[1024 + c]);
            float kk = k * kk_[c]; const float nrm = sqrtf(wave_sum(kk * kk)); kk = kk / fmaxf(nrm, 1e-12f);
            const float km = k * (1.0f + (a - 1.0f) * ka_[c]);
            const float bon = wave_sum(r * km * rk_[c]);
            const size_t o = (size_t)t * 1024 + c;
            SR[o] = r; SW[o] = w; SKM[o] = km; SV[o] = v; SKK[o] = kk; SB[o] = kk * a;
            if (lane == 0) BONUS[t * 16 + h] = bon; }
    }
    if (F.gw < NH_M) { const int h = F.gw;
        const float* BCUM = WSP(float, WS_SMALL + SM_BCUM); const float* IG = WSP(float, WS_SMALL + SM_IG); const float* CHBL = WSP(float, WS_SMALL + SM_CHBL); const float* CHMD = WSP(float, WS_SMALL + SM_CHMD);
        float* MSEQ = WSP(float, WS_SMALL + SM_MSEQ); float* WCARRY = WSP(float, WS_SMALL + SM_WCARRY); float* WSTATE = WSP(float, WS_SMALL + SM_WSTATE);
        const float bl0 = CHBL[h * 128 + lane], bl1 = CHBL[h * 128 + 64 + lane], md0 = CHMD[h * 128 + lane], md1 = CHMD[h * 128 + 64 + lane];
        float m = 0.f, mine_in0 = 0.f, mine_in1 = 0.f, mine_out0 = 0.f, mine_out1 = 0.f;
#pragma unroll
        for (int c = 0; c < 128; ++c) { const float bl = __shfl(c < 64 ? bl0 : bl1, c & 63), md = __shfl(c < 64 ? md0 : md1, c & 63);
            const float mn = fmaxf(bl + m, md);
            if ((c & 63) == lane) { if (c < 64) { mine_in0 = m; mine_out0 = mn; } else { mine_in1 = m; mine_out1 = mn; } }
            m = mn; }
        MSEQ[h * 128 + lane] = mine_in0; MSEQ[h * 128 + 64 + lane] = mine_in1;
        WCARRY[h * 128 + lane] = __expf(bl0 + mine_in0 - mine_out0); WCARRY[h * 128 + 64 + lane] = __expf(bl1 + mine_in1 - mine_out1);
        for (int c = 0; c < 128; ++c) { const float bl = __shfl(c < 64 ? bl0 : bl1, c & 63), mo = __shfl(c < 64 ? mine_out0 : mine_out1, c & 63); const int t = 64 * c + lane;
            WSTATE[h * T + t] = __expf(bl - BCUM[h * T + t] + IG[h * T + t] - mo); }
    }
}

__device__ __forceinline__ float row16_sum(float x) {
    x += __builtin_bit_cast(float, __builtin_amdgcn_update_dpp(0, __builtin_bit_cast(int, x), 0xB1, 0xF, 0xF, true));
    x += __builtin_bit_cast(float, __builtin_amdgcn_update_dpp(0, __builtin_bit_cast(int, x), 0x4E, 0xF, 0xF, true));
    x += __builtin_bit_cast(float, __builtin_amdgcn_update_dpp(0, __builtin_bit_cast(int, x), 0x141, 0xF, 0xF, true));
    x += __builtin_bit_cast(float, __builtin_amdgcn_update_dpp(0, __builtin_bit_cast(int, x), 0x140, 0xF, 0xF, true));
    return x;
}
constexpr int SCH = 32;
constexpr int SC_VEC = SCH * 256;
constexpr int SC_BUF = 5 * SC_VEC + 1024;
__device__ __forceinline__ void p_scan(const Frame& F) {
    if (F.wave != 0) return;
    const int b = blockIdx.x, head = (b & 7) * 2 + ((b >> 3) & 1), rg = b >> 4, lane = F.lane, row = lane >> 4, j = lane & 15;
    const float* SR = WSP(float, R_SC); const float* SW = WSP(float, R_SC + SC_STRIDE); const float* SKM = WSP(float, R_SC + 2 * SC_STRIDE); const float* SV = WSP(float, R_SC + 3 * SC_STRIDE);
    const float* SKK = WSP(float, R_SC + 4 * SC_STRIDE); const float* SB = WSP(float, R_SC + 5 * SC_STRIDE); float* Y = WSP(float, R_Y);
    LAS unsigned char* lds = F.lds + RING_OFF;
    const size_t goff = (size_t)(lane >> 4) * 1024 + head * 64 + (lane & 15) * 4;
    f32x4 S = {0.f, 0.f, 0.f, 0.f};
#define SC_ISSUE(c_, buf_) do { const size_t t0_ = (size_t)(c_) * SCH * 1024; LAS unsigned char* d_ = lds + (buf_) * SC_BUF; \
        _Pragma("unroll") for (int q = 0; q < SCH / 4; ++q) { const size_t o_ = t0_ + (size_t)q * 4096 + goff; \
            __builtin_amdgcn_global_load_lds((const unsigned*)(SKK + o_), (LAS unsigned*)(d_ + 0 * SC_VEC + q * 1024), 16, 0, 0); \
            __builtin_amdgcn_global_load_lds((const unsigned*)(SW  + o_), (LAS unsigned*)(d_ + 1 * SC_VEC + q * 1024), 16, 0, 0); \
            __builtin_amdgcn_global_load_lds((const unsigned*)(SB  + o_), (LAS unsigned*)(d_ + 2 * SC_VEC + q * 1024), 16, 0, 0); \
            __builtin_amdgcn_global_load_lds((const unsigned*)(SKM + o_), (LAS unsigned*)(d_ + 3 * SC_VEC + q * 1024), 16, 0, 0); \
            __builtin_amdgcn_global_load_lds((const unsigned*)(SR  + o_), (LAS unsigned*)(d_ + 4 * SC_VEC + q * 1024), 16, 0, 0); } \
        { int ts_ = (c_) * SCH + lane; ts_ = ts_ < T ? ts_ : T - 1; \
          __builtin_amdgcn_global_load_lds((const unsigned*)(SV + (size_t)ts_ * 1024 + head * 64 + rg * 4), (LAS unsigned*)(d_ + 5 * SC_VEC), 16, 0, 0); } } while (0)
    SC_ISSUE(0, 0);
    for (int c = 0; c < T / SCH; ++c) {
        const int buf = c & 1;
        if (c == 0) asm volatile("s_waitcnt vmcnt(0)" ::: "memory"); else asm volatile("s_waitcnt vmcnt(32)" ::: "memory");
        if (c + 1 < T / SCH) SC_ISSUE(c + 1, buf ^ 1);
        const LAS unsigned char* d = lds + buf * SC_BUF;
#pragma unroll 8
        for (int s = 0; s < SCH; ++s) {
            const f32x4 kk = *(const LAS f32x4*)(d + 0 * SC_VEC + s * 256 + j * 16), w = *(const LAS f32x4*)(d + 1 * SC_VEC + s * 256 + j * 16), bb = *(const LAS f32x4*)(d + 2 * SC_VEC + s * 256 + j * 16);
            const f32x4 km = *(const LAS f32x4*)(d + 3 * SC_VEC + s * 256 + j * 16), r = *(const LAS f32x4*)(d + 4 * SC_VEC + s * 256 + j * 16);
            const float v = *(const LAS float*)(d + 5 * SC_VEC + s * 16 + row * 4);
            const float sa = row16_sum((S[0] * kk[0] + S[1] * kk[1]) + (S[2] * kk[2] + S[3] * kk[3]));
            S = S * w + (km * v - bb * sa);
            const float y = row16_sum((S[0] * r[0] + S[1] * r[1]) + (S[2] * r[2] + S[3] * r[3]));
            if (j == 0) Y[(size_t)(c * SCH + s) * 1024 + head * 64 + rg * 4 + row] = y;
        }
    }
    asm volatile("s_waitcnt vmcnt(0)" ::: "memory");
#undef SC_ISSUE
}

__device__ __forceinline__ void p_rwkv_post(const Frame& F, const Args& A) {
    const float* Y = WSP(float, R_Y); const float* SV = WSP(float, R_SC + 3 * SC_STRIDE); const float* LOUT = WSP(float, R_LORAOUT); const float* BONUS = WSP(float, WS_SMALL + SM_BONUS);
    const float* lng = A.in[I_RWLNG]; const float* lnb = A.in[I_RWLNB]; bf16* YCAT = WSP(bf16, R_YCAT); const int lane = F.lane;
    for (int t = F.gw; t < T; t += F.NGW)
        for (int h = 0; h < NH_R; ++h) { const int c = 64 * h + lane; const float y = Y[(size_t)t * 1024 + c];
            const float mean = wave_sum(y) * (1.0f / 64.0f), d = y - mean, var = wave_sum(d * d) * (1.0f / 64.0f);
            float o = d * (1.0f / sqrtf(var + 64e-5f)) * lng[c] + lnb[c] + BONUS[t * 16 + h] * SV[(size_t)t * 1024 + c];
            o *= LOUT[(size_t)t * 3072 + 2048 + c];
            YCAT[(size_t)t * D + c] = f2bf(o); }
}

constexpr int ML_P = 264;
__device__ __forceinline__ void ml_stage_chunk(const Frame& F, const bf16* src  , int h, int c, LAS bf16* dst) {
    for (int i = F.tid; i < 64 * 32; i += NWAVES * 64) { const int s = i >> 5, ch = i & 31;
        *(LAS u32x4*)(dst + s * ML_P + 8 * ch) = *(const u32x4*)(src + (size_t)(64 * c + s) * 1024 + 256 * h + 8 * ch); }
}
__device__ __forceinline__ void p_mlu(const Frame& F) {
    const bf16* KB = WSP(bf16, R_KB); const bf16* VB = WSP(bf16, R_VB); const float* WSTATE = WSP(float, WS_SMALL + SM_WSTATE);
    bf16* U = WSP(bf16, R_U); float* NU = WSP(float, WS_SMALL + SM_NU);
    LAS bf16* Ks = (LAS bf16*)(F.lds + RING_OFF); LAS bf16* Vs = Ks + 64 * ML_P; LAS float* wst = (LAS float*)(Vs + 64 * ML_P);
    const int lane = F.lane, r = lane & 31, hg = lane >> 5, w = F.wave;
    for (int L = F.vcu; L < NH_M * 128; L += F.G) { const int h = L >> 7, c = L & 127;
        __syncthreads();
        ml_stage_chunk(F, KB, h, c, Ks); ml_stage_chunk(F, VB, h, c, Vs);
        if (F.tid < 64) wst[F.tid] = WSTATE[h * T + 64 * c + F.tid];
        __syncthreads();
        f32x16 acc[8];
#pragma unroll
        for (int nt = 0; nt < 8; ++nt) acc[nt] = f32x16{};
#pragma unroll
        for (int ks = 0; ks < 4; ++ks) { bf16x8 a; float av[8];
#pragma unroll
            for (int jj = 0; jj < 8; ++jj) { const int s = 16 * ks + 8 * hg + jj; av[jj] = bf2f(Vs[s * ML_P + 32 * w + r]) * wst[s]; }
            { u32x4 p; p.x = cvt_pk_bf16(av[0], av[1]); p.y = cvt_pk_bf16(av[2], av[3]); p.z = cvt_pk_bf16(av[4], av[5]); p.w = cvt_pk_bf16(av[6], av[7]); a = __builtin_bit_cast(bf16x8, p); }
#pragma unroll
            for (int nt = 0; nt < 8; ++nt) { bf16x8 b;
#pragma unroll
                for (int jj = 0; jj < 8; ++jj) b[jj] = (short)Ks[(16 * ks + 8 * hg + jj) * ML_P + 32 * nt + r];
                acc[nt] = __builtin_amdgcn_mfma_f32_32x32x16_bf16(a, b, acc[nt], 0, 0, 0); } }
        bf16* Uo = U + ((size_t)(h * 128 + c) * 256 + 32 * w) * 256;
#pragma unroll
        for (int nt = 0; nt < 8; ++nt)
#pragma unroll
            for (int q = 0; q < 16; ++q) { const int vl = (q & 3) + 8 * (q >> 2) + 4 * hg; Uo[(size_t)vl * 256 + 32 * nt + r] = f2bf(acc[nt][q]); }
        if (F.tid < 256) { float s = 0.f;
            for (int ss = 0; ss < 64; ++ss) s += wst[ss] * bf2f(Ks[ss * ML_P + F.tid]);
            NU[(size_t)(h * 128 + c) * 256 + F.tid] = s; }
    }
}
__device__ __forceinline__ void p_mlscan(const Frame& F) {
    bf16* U = WSP(bf16, R_U); float* NU = WSP(float, WS_SMALL + SM_NU); const float* WCARRY = WSP(float, WS_SMALL + SM_WCARRY);
    const int gt = F.gw * 64 + F.lane, NGT = F.NGW * 64;
    for (int it = gt; it < NH_M * 65536 / 4; it += NGT) { const int h = it >> 14, e = (it & 16383) * 4;
        float C0 = 0.f, C1 = 0.f, C2 = 0.f, C3 = 0.f; bf16* p = U + (size_t)h * 128 * 65536 + e;
#pragma unroll 4
        for (int c = 0; c < 128; ++c) { const u32x2 u = *(const u32x2*)(p + (size_t)c * 65536); const float wc = WCARRY[h * 128 + c];
            u32x2 o; o.x = cvt_pk_bf16(C0, C1); o.y = cvt_pk_bf16(C2, C3); *(u32x2*)(p + (size_t)c * 65536) = o;
            C0 = wc * C0 + bf2f(u.x & 0xffffu); C1 = wc * C1 + bf2f(u.x >> 16); C2 = wc * C2 + bf2f(u.y & 0xffffu); C3 = wc * C3 + bf2f(u.y >> 16); } }
    for (int it = gt; it < NH_M * 256; it += NGT) { const int h = it >> 8, k = it & 255; float n = 0.f; float* p = NU + (size_t)h * 128 * 256 + k;
        for (int c = 0; c < 128; ++c) { const float u = p[c * 256]; p[c * 256] = n; n = WCARRY[h * 128 + c] * n + u; } }
}
__device__ __forceinline__ void p_mlout(const Frame& F, const Args& A) {
    const bf16* QB = WSP(bf16, R_QB); const bf16* KB = WSP(bf16, R_KB); const bf16* VB = WSP(bf16, R_VB); const bf16* CS = WSP(bf16, R_U); const float* NC = WSP(float, WS_SMALL + SM_NU);
    const float* BCUM = WSP(float, WS_SMALL + SM_BCUM); const float* IG = WSP(float, WS_SMALL + SM_IG); const float* MSEQ = WSP(float, WS_SMALL + SM_MSEQ);
    const bf16* PROJ = WSP(bf16, R_PROJ); const float* mhg = A.in[I_MLNG]; bf16* YCAT = WSP(bf16, R_YCAT);
    LAS bf16* Qs = (LAS bf16*)(F.lds + RING_OFF); LAS bf16* Ks = Qs + 64 * ML_P; LAS bf16* Vs = Ks + 64 * ML_P; LAS bf16* Ss = Vs + 64 * ML_P;
    LAS float* fa = (LAS float*)(Ss + 64 * 72); LAS float* bch = fa; LAS float* ich = fa + 64; LAS float* mrow = fa + 128; LAS float* wint = fa + 192; LAS float* rsum = fa + 256  ;
    LAS float* nq = fa + 384; LAS float* nvec = fa + 448  ; LAS float* Hs = (LAS float*)(F.lds + RING_OFF);
    const int lane = F.lane, r = lane & 31, hg = lane >> 5, w = F.wave;
    for (int L = F.vcu; L < NH_M * 128; L += F.G) { const int h = L >> 7, c = L & 127;
        __syncthreads();
        ml_stage_chunk(F, QB, h, c, Qs); ml_stage_chunk(F, KB, h, c, Ks); ml_stage_chunk(F, VB, h, c, Vs);
        if (F.tid < 64) { bch[F.tid] = BCUM[h * T + 64 * c + F.tid]; ich[F.tid] = IG[h * T + 64 * c + F.tid]; }
        if (F.tid < 256) nvec[F.tid] = NC[(size_t)(h * 128 + c) * 256 + F.tid];
        const float mc = MSEQ[h * 128 + c];
        __syncthreads();
        if (w == 0) { float g = ich[lane] - bch[lane];
#pragma unroll
            for (int o = 1; o < 64; o <<= 1) { const float x = __shfl_up(g, o); if (lane >= o) g = fmaxf(g, x); }
            const float mr = bch[lane] + fmaxf(mc, g); mrow[lane] = mr; wint[lane] = __expf(bch[lane] + mc - mr); }
        if (w == 1) { float s = 0.f;
            for (int k = 0; k < 256; ++k) s += nvec[k] * bf2f(Qs[lane * ML_P + k]);
            nq[lane] = s; }
        __syncthreads();
        if (w < 4) { const int st = w & 1, lt = w >> 1; f32x16 acc = f32x16{};
#pragma unroll
            for (int ks = 0; ks < 16; ++ks) { const bf16x8 a = *(const LAS bf16x8*)(Ks + (32 * st + r) * ML_P + 16 * ks + 8 * hg), b = *(const LAS bf16x8*)(Qs + (32 * lt + r) * ML_P + 16 * ks + 8 * hg);
                acc = __builtin_amdgcn_mfma_f32_32x32x16_bf16(a, b, acc, 0, 0, 0); }
            const int l = 32 * lt + r; const float bl_ = bch[l], mr = mrow[l]; float rs = 0.f;
#pragma unroll
            for (int g4 = 0; g4 < 4; ++g4) { float v4[4];
#pragma unroll
                for (int i = 0; i < 4; ++i) { const int s = 32 * st + 8 * g4 + 4 * hg + i; const float d = bl_ - bch[s] + ich[s] - mr;
                    v4[i] = (s <= l) ? acc[4 * g4 + i] * __expf(d) : 0.f; rs += v4[i]; }
                u32x2 p; p.x = cvt_pk_bf16(v4[0], v4[1]); p.y = cvt_pk_bf16(v4[2], v4[3]);
                *(LAS u32x2*)(Ss + l * 72 + 32 * st + 8 * g4 + 4 * hg) = p; }
            rs += __shfl_xor(rs, 32);
            if (hg == 0) rsum[st * 64 + l] = rs; }
        __syncthreads();
        const int lt = w & 1, vg = w >> 1; f32x16 ai[2], aa[2]; ai[0] = f32x16{}; ai[1] = f32x16{}; aa[0] = f32x16{}; aa[1] = f32x16{};
        const bf16* Cb = CS + (size_t)(h * 128 + c) * 65536;
#pragma unroll 4
        for (int ks = 0; ks < 16; ++ks) { const bf16x8 a = *(const LAS bf16x8*)(Qs + (32 * lt + r) * ML_P + 16 * ks + 8 * hg);
#pragma unroll
            for (int jt = 0; jt < 2; ++jt) { const bf16x8 b = *(const bf16x8*)(Cb + (size_t)(64 * vg + 32 * jt + r) * 256 + 16 * ks + 8 * hg);
                ai[jt] = __builtin_amdgcn_mfma_f32_32x32x16_bf16(a, b, ai[jt], 0, 0, 0); } }
#pragma unroll
        for (int ks = 0; ks < 4; ++ks) { const bf16x8 a = *(const LAS bf16x8*)(Ss + (32 * lt + r) * 72 + 16 * ks + 8 * hg);
#pragma unroll
            for (int jt = 0; jt < 2; ++jt) { bf16x8 b;
#pragma unroll
                for (int jj = 0; jj < 8; ++jj) b[jj] = (short)Vs[(16 * ks + 8 * hg + jj) * ML_P + 64 * vg + 32 * jt + r];
                aa[jt] = __builtin_amdgcn_mfma_f32_32x32x16_bf16(a, b, aa[jt], 0, 0, 0); } }
        __syncthreads();
#pragma unroll
        for (int q = 0; q < 16; ++q) { const int l = 32 * lt + (q & 3) + 8 * (q >> 2) + 4 * hg; const float wi = wint[l];
            const float den = rsum[l] + rsum[64 + l] + wi * nq[l]; const float dn = 1.0f / fmaxf(fabsf(den), __expf(-mrow[l]));
#pragma unroll
            for (int jt = 0; jt < 2; ++jt) Hs[l * 260 + 64 * vg + 32 * jt + r] = (aa[jt][q] + wi * ai[jt][q]) * dn; }
        __syncthreads();
        for (int i = 0; i < 8; ++i) { const int l = 8 * w + i, t = 64 * c + l; const f32x4 hv = *(const LAS f32x4*)(Hs + l * 260 + 4 * lane);
            const float ss = wave_sum((hv[0] * hv[0] + hv[1] * hv[1]) + (hv[2] * hv[2] + hv[3] * hv[3])); const float rn = 1.0f / sqrtf(ss * (1.0f / 256.0f) + 1e-6f);
            const f32x4 g = *(const f32x4*)(mhg + 256 * h + 4 * lane); const u32x2 ob = *(const u32x2*)(PROJ + (size_t)t * AB_PAD + 6592 + 256 * h + 4 * lane);
            const float o0 = hv[0] * rn * g[0] * sigmoidf_(bf2f(ob.x & 0xffffu)), o1 = hv[1] * rn * g[1] * sigmoidf_(bf2f(ob.x >> 16));
            const float o2 = hv[2] * rn * g[2] * sigmoidf_(bf2f(ob.y & 0xffffu)), o3 = hv[3] * rn * g[3] * sigmoidf_(bf2f(ob.y >> 16));
            u32x2 p; p.x = cvt_pk_bf16(o0, o1); p.y = cvt_pk_bf16(o2, o3);
            *(u32x2*)(YCAT + (size_t)t * D + 1024 + 256 * h + 4 * lane) = p; }
    }
}

struct XsOrder {
    const bf16* XQ; const bf16* KM; int G, c;
    __device__ __forceinline__ bool next(int i, pg8::Unit& u) const {
        const int L = i * G + c; if (L >= 32 * 4) return false;
        const int pm = L >> 2, hd = L & 3; u.pm = pm; u.pn = 0; u.aux = hd; u.pad = 0;
        u.a = (const char*)(XQ + (size_t)pm * 256 * D + 512 * hd); u.b = (const char*)(KM + 512 * hd); return true;
    }
};
struct XpvOrder {
    const bf16* XP; const bf16* VT; int G, c;
    __device__ __forceinline__ bool next(int i, pg8::Unit& u) const {
        int pm, pn; if (!pg8::static_tile(i, G, c, 32, 8, pm, pn)) return false;
        u.pm = pm; u.pn = pn; u.aux = 0; u.pad = 0;
        u.a = (const char*)(XP + (size_t)pm * 256 * 1024 + 256 * (pn >> 1)); u.b = (const char*)(VT + (size_t)pn * 256 * NMEM); return true;
    }
};
__device__ __forceinline__ void p_xsoftmax(const Frame& F) {
    const float* XS = WSP(float, R_XS); bf16* XP = WSP(bf16, R_XP); const int lane = F.lane;
    for (int t = F.gw; t < T; t += F.NGW)
#pragma unroll
        for (int hd = 0; hd < 4; ++hd) { const f32x4 s = *(const f32x4*)(XS + (size_t)t * 1024 + 256 * hd + 4 * lane);
            const float m = wave_max(fmaxf(fmaxf(s[0], s[1]), fmaxf(s[2], s[3])));
            const float e0 = __expf(s[0] - m), e1 = __expf(s[1] - m), e2 = __expf(s[2] - m), e3 = __expf(s[3] - m);
            const float inv = 1.0f / wave_sum((e0 + e1) + (e2 + e3));
            u32x2 p; p.x = cvt_pk_bf16(e0 * inv, e1 * inv); p.y = cvt_pk_bf16(e2 * inv, e3 * inv);
            *(u32x2*)(XP + (size_t)t * 1024 + 256 * hd + 4 * lane) = p; }
}

__device__ __forceinline__ void p_norm_fpre(const Frame& F, const Args& A) {
    LAS float* Ws = (LAS float*)(F.lds + RING_OFF);
    stage_skinny<16>(F, A.in[I_FOXWIN], FOX_LD, 8192, Ws);
    __syncthreads();
    const float* X = WSP(float, WS_X); bf16* XN = WSP(bf16, WS_XN); float* FPRE = WSP(float, WS_SMALL + SM_FPRE); const float* g = A.in[I_NMIXG] + D;
    for (int t = F.gw; t < T; t += F.NGW) { f32x4 y[8]; rms_row(X + (size_t)t * D, g, XN + (size_t)t * D, F.lane, y);
        float o[16]; skinny_dot<16>(y, Ws, F.lane, o);
        if (F.lane < 16) { float v = o[0];
#pragma unroll
            for (int c = 1; c < 16; ++c) v = (F.lane == c) ? o[c] : v;
            FPRE[t * 16 + F.lane] = v; } }
    __syncthreads();
}
__device__ __forceinline__ void p_foxprep(const Frame& F, const Args& A) {
    bf16* QKVG = WSP(bf16, R_QKVG); const float* qg = A.in[I_FOXQG]; const float* kg = A.in[I_FOXKG]; const int lane = F.lane;
    for (int it = F.gw; it < 2 * T; it += F.NGW) { const int t = it >> 1, sec = it & 1; const float* gg = sec ? kg : qg; const float g0 = gg[2 * lane], g1 = gg[2 * lane + 1];
        unsigned* row = (unsigned*)(QKVG + (size_t)t * 8192 + sec * 2048) + lane;
#pragma unroll 4
        for (int h = 0; h < NH_F; ++h) { const unsigned u = row[64 * h]; const float a = bf2f(u & 0xffffu), b = bf2f(u >> 16);
            const float rn = 1.0f / sqrtf(wave_sum(a * a + b * b) * (1.0f / 128.0f) + 1e-6f);
            row[64 * h] = cvt_pk_bf16(a * rn * g0, b * rn * g1); } }
    if (F.gw < NH_F) { const int h = F.gw; const float* FPRE = WSP(float, WS_SMALL + SM_FPRE); float* BL = WSP(float, WS_SMALL + SM_BIASL2); const float bf = A.in[I_FOXBF][h];
        float carry = 0.f;
        for (int c0 = 0; c0 < 128; c0 += 16) { float v[16];
#pragma unroll
            for (int i = 0; i < 16; ++i) v[i] = FPRE[(size_t)(64 * (c0 + i) + lane) * 16 + h];
#pragma unroll
            for (int i = 0; i < 16; ++i) { float b = logsigmoidf_(v[i] + bf);
#pragma unroll
                for (int o = 1; o < 64; o <<= 1) { const float x = __shfl_up(b, o); if (lane >= o) b += x; }
                b += carry; BL[h * T + 64 * (c0 + i) + lane] = -1.4426950408889634f * b; carry = __shfl(b, 63); } } }
}
__device__ __forceinline__ void p_foxattn(const Frame& F) {
    const bf16* QKVG = WSP(bf16, R_QKVG); bf16* ATTO = WSP(bf16, R_ATTO); const float* BL = WSP(float, WS_SMALL + SM_BIASL2);
    char* lds = (char*)F.ldsg + RING_OFF;
    for (int L = F.vcu; L < 256; L += F.G) { const int h = L >> 4, x = L & 15;
        __syncthreads();
        { float* bl = (float*)(lds + fox::BIAS_OFF); for (int i = F.tid; i < T / 4; i += NWAVES * 64) *(f32x4*)(bl + 4 * i) = *(const f32x4*)(BL + (size_t)h * T + 4 * i); }
        fox::BlockRef b0, b1; const int q0 = x, q1 = 31 - x;
        b0.Q = QKVG + (size_t)q0 * 256 * 8192 + 128 * h; b0.K = QKVG + 2048 + 128 * h; b0.V = QKVG + 4096 + 128 * h; b0.G = QKVG + (size_t)q0 * 256 * 8192 + 6144 + 128 * h;
        b0.O = ATTO + (size_t)q0 * 256 * D + 128 * h; b0.P0 = q0 * 256;
        b1 = b0; b1.Q = QKVG + (size_t)q1 * 256 * 8192 + 128 * h; b1.G = QKVG + (size_t)q1 * 256 * 8192 + 6144 + 128 * h; b1.O = ATTO + (size_t)q1 * 256 * D + 128 * h; b1.P0 = q1 * 256;
        fox::Seam S;
        fox::prime(b0, lds, S);
#ifdef FOX_LOOP
        for (int pass = 0; pass < 2; ++pass) { fox::block(b0, b1, lds, S); b0 = b1; }
#else
        fox::block(b0, b1, lds, S);
        fox::block(b1, b1, lds, S);
#endif
    }
}

__device__ __forceinline__ void p_norm_route(const Frame& F, const Args& A) {
    LAS float* Ws = (LAS float*)(F.lds + RING_OFF); LAS int* cnt = (LAS int*)(F.lds + RING_OFF + 8 * D * 4);
    stage_skinny<8>(F, A.in[I_ROUTER], NEXP, 0, Ws);
    if (F.tid < 8) cnt[F.tid] = 0;
    __syncthreads();
    const float* X = WSP(float, WS_X); bf16* XN = WSP(bf16, WS_XN); const float* g = A.in[I_NFFNG] + D;
    int* TOPI = WSP(int, WS_SMALL + SM_TOPI); float* TOPG = WSP(float, WS_SMALL + SM_TOPG); int* BLKCNT = WSP(int, WS_SMALL + SM_BLKCNT);
    const int b = blockIdx.x;
    for (int i = 0; i < 4; ++i) { const int t = 32 * b + 4 * F.wave + i; f32x4 y[8]; rms_row(X + (size_t)t * D, g, XN + (size_t)t * D, F.lane, y);
        float o[8]; skinny_dot<8>(y, Ws, F.lane, o);
        int i1 = 0; float v1 = o[0];
#pragma unroll
        for (int e = 1; e < 8; ++e) if (o[e] > v1) { v1 = o[e]; i1 = e; }
        int i2 = -1; float v2 = -__builtin_inff();
#pragma unroll
        for (int e = 0; e < 8; ++e) if (e != i1 && o[e] > v2) { v2 = o[e]; i2 = e; }
        const float e2 = __expf(v2 - v1), g1 = 1.0f / (1.0f + e2), g2 = e2 * g1;
        if (F.lane == 0) { TOPI[2 * t] = i1; TOPI[2 * t + 1] = i2; TOPG[2 * t] = g1; TOPG[2 * t + 1] = g2; __hip_atomic_fetch_add(&cnt[i1], 1, __ATOMIC_RELAXED, __HIP_MEMORY_SCOPE_WORKGROUP); __hip_atomic_fetch_add(&cnt[i2], 1, __ATOMIC_RELAXED, __HIP_MEMORY_SCOPE_WORKGROUP); } }
    __syncthreads();
    if (F.tid < 8) BLKCNT[b * 8 + F.tid] = cnt[F.tid];
}
__device__ __forceinline__ void p_route2(const Frame& F) {
    LAS int* sh = (LAS int*)(F.lds + RING_OFF);
    const int* BLKCNT = WSP(int, WS_SMALL + SM_BLKCNT); const int* TOPI = WSP(int, WS_SMALL + SM_TOPI); int* SLOT = WSP(int, WS_SMALL + SM_SLOT); int* TILEE = WSP(int, WS_SMALL + SM_TILEE);
    const bf16* XN = WSP(bf16, WS_XN); bf16* AG = WSP(bf16, R_AG); const int b = blockIdx.x;
    __syncthreads();
    if (F.tid < 8) { int tot = 0, pre = 0; for (int bb = 0; bb < 256; ++bb) { const int v = BLKCNT[bb * 8 + F.tid]; if (bb < b) pre += v; tot += v; } sh[F.tid] = tot; sh[8 + F.tid] = pre; }
    __syncthreads();
    if (F.tid == 0) { int off = 0, nt = 0; for (int e = 0; e < 8; ++e) { sh[16 + e] = off; const int n = (sh[e] + 255) >> 8; if (b == 0) for (int i = 0; i < n; ++i) TILEE[1 + nt + i] = e; nt += n; off += n * 256; } if (b == 0) TILEE[0] = nt; }
    __syncthreads();
    if (F.wave == 0) { const int t = 32 * b + (F.lane >> 1), e = TOPI[2 * t + (F.lane & 1)]; int rank = 0;
#pragma unroll
        for (int ee = 0; ee < 8; ++ee) { const unsigned long long m = __ballot(e == ee); if (e == ee) rank = __popcll(m & ((1ull << F.lane) - 1ull)); }
        const int slot = sh[16 + e] + sh[8 + e] + rank; SLOT[2 * t + (F.lane & 1)] = slot; sh[32 + F.lane] = slot; }
    __syncthreads();
    for (int p = F.wave; p < 64; p += NWAVES) { const int t = 32 * b + (p >> 1), slot = sh[32 + p]; const u32x4* src = (const u32x4*)(XN + (size_t)t * D); u32x4* dst = (u32x4*)(AG + (size_t)slot * D);
#pragma unroll
        for (int j = 0; j < 4; ++j) dst[F.lane + 64 * j] = src[F.lane + 64 * j]; }
}
struct MoeOrder {
    const bf16* Arows; const bf16* W; const int* tilee; int lda, nN; size_t wstride; int G, c;
    __device__ __forceinline__ bool next(int i, pg8::Unit& u) const {
        const int nt = tilee[0]; const long L = (long)i * G + c; if (L >= (long)nt * nN) return false;
        const int ti = (int)(L / nN), pn = (int)(L % nN), e = tilee[1 + ti];
        u.pm = ti; u.pn = pn; u.aux = e; u.pad = 0; u.a = (const char*)(Arows + (size_t)ti * 256 * lda); u.b = (const char*)(W + (size_t)e * wstride + (size_t)pn * 256 * lda); return true;
    }
};
__device__ __forceinline__ void p_final(const Frame& F, const Args& A) {
    const float* X = WSP(float, WS_X); const float* YG = WSP(float, R_YG); const int* SLOT = WSP(int, WS_SMALL + SM_SLOT); const float* TOPG = WSP(float, WS_SMALL + SM_TOPG);
    const float* g = A.in[I_FING]; const int lane = F.lane;
    for (int t = F.gw; t < T; t += F.NGW) { const int s1 = SLOT[2 * t], s2 = SLOT[2 * t + 1]; const float g1 = TOPG[2 * t], g2 = TOPG[2 * t + 1];
        const f32x4* xr = (const f32x4*)(X + (size_t)t * D) + lane; const f32x4* y1 = (const f32x4*)(YG + (size_t)s1 * D) + lane; const f32x4* y2 = (const f32x4*)(YG + (size_t)s2 * D) + lane;
        f32x4 v[8]; float s = 0.f;
#pragma unroll
        for (int j = 0; j < 8; ++j) { v[j] = xr[64 * j] + (y1[64 * j] * g1 + y2[64 * j] * g2); s += (v[j][0] * v[j][0] + v[j][1] * v[j][1]) + (v[j][2] * v[j][2] + v[j][3] * v[j][3]); }
        const float r = 1.0f / sqrtf(wave_sum(s) * (1.0f / D) + 1e-6f); f32x4* o = (f32x4*)(A.out + (size_t)t * D) + lane;
#pragma unroll
        for (int j = 0; j < 8; ++j) o[64 * j] = v[j] * r * ((const f32x4*)g)[lane + 64 * j]; }
}

enum Phase { PH_CONV = 0, PH_KV, PH_INPROJ0, PH_PREPA, PH_LORA, PH_PREPB, PH_SCAN, PH_MLU, PH_MLSCAN, PH_MLOUT, PH_OUTPROJ0,
             PH_NORMX0, PH_XQ0, PH_XS0, PH_XSM0, PH_XPV0, PH_XO0, PH_NORMF0, PH_FFNGU, PH_FFND,
             PH_NORMM1, PH_FOXIN, PH_FOXPREP, PH_FOXATT, PH_FOXOUT,
             PH_NORMX1, PH_XQ1, PH_XS1, PH_XSM1, PH_XPV1, PH_XO1, PH_NORMF1, PH_ROUTE2, PH_MOEGU, PH_MOED, PH_FINAL, N_PHASES };

__global__ void __launch_bounds__(NWAVES * 64, 2) trunk_fwd(Args A) {
    extern __shared__ __attribute__((aligned(16))) unsigned char lds[];
    Frame F;
    F.lds = (LAS unsigned char*)lds; F.ldsg = lds; F.ws = A.ws;
    F.tid = threadIdx.x; F.lane = F.tid & 63; F.wave = __builtin_amdgcn_readfirstlane(F.tid >> 6);
    F.G = gridDim.x; { const int bx = blockIdx.x; F.vcu = (F.G % 8 == 0) ? (bx % 8) * (F.G / 8) + bx / 8 : bx; }
    F.gw = F.vcu * NWAVES + F.wave; F.NGW = F.G * NWAVES;
    volatile LAS unsigned* MISC = (volatile LAS unsigned*)(F.lds + MISC_OFF);
    for (int u = F.tid; u < (LDS_BYTES - LDSCTL_OFF) / 4; u += NWAVES * 64) ((LAS unsigned*)(F.lds + LDSCTL_OFF))[u] = 0u;
    __syncthreads();
    const int lo = A.ph_lo, hi = A.ph_hi;
    const bool multi = (hi - lo) > 1;
    XcdBarrier bar; bar.bar = (unsigned*)(A.ws + WS_CTL) + CW_BAR; bar.x = 0; bar.st = nullptr;
    if (multi) bar = xcd_barrier_post((unsigned*)(A.ws + WS_CTL) + CW_BAR, MISC + 8);
#ifndef PH_ENABLE
#define PH_ENABLE 0xFFFFFFFFFFFFFFFFull
#endif
#define IN(k) ((((PH_ENABLE) >> (k)) & 1ull) && lo <= (k) && (k) < hi)
#define SEAM(k) do { if (IN(k) && IN((k) + 1)) xcd_barrier(bar); } while (0)
    LAS unsigned char* ring = F.lds + RING_OFF;
    const int cb = (int)blockIdx.x;

    if (IN(PH_CONV)) { p_convert(F, A); } SEAM(PH_CONV);
    if (IN(PH_KV)) { KvOrder S{WSP(bf16, WS_MEMN), WSP(bf16, WS_W_XKV), cb}; EpiKv E{WSP(bf16, WS_KMEM), WSP(bf16, WS_VTMEM)};
        pg8::gemm_phase<EpiKv, KvOrder, false>(ring, pg8::Gemm{D, D, D}, S, E); } SEAM(PH_KV);
    if (IN(PH_INPROJ0)) { pg8::PlainOrder S{WSP(bf16, WS_XN), WSP(bf16, WS_W_ABIN), D, D, 32, AB_PAD / 256, F.G, cb}; pg8::EpiBf16 E{WSP(bf16, R_PROJ), AB_PAD, WSP(float, R_GATES32), 29};
        pg8::gemm_phase<pg8::EpiBf16, pg8::PlainOrder, true>(ring, pg8::Gemm{D, D, D}, S, E); } SEAM(PH_INPROJ0);
    if (IN(PH_PREPA)) { p_prepa(F, A); } SEAM(PH_PREPA);
    if (IN(PH_LORA)) { pg8::PlainOrder S{WSP(bf16, R_LORAIN), WSP(bf16, WS_W_LORA), 512, 512, 32, 12, F.G, cb}; pg8::EpiF32 E{WSP(float, R_LORAOUT), 3072, 0, 1.0f};
        pg8::gemm_phase<pg8::EpiF32, pg8::PlainOrder, true>(ring, pg8::Gemm{512, 512, 512}, S, E); } SEAM(PH_LORA);
    if (IN(PH_PREPB)) { p_prepb(F, A); } SEAM(PH_PREPB);
    if (IN(PH_SCAN)) { p_scan(F); } SEAM(PH_SCAN);
    if (IN(PH_MLU)) { p_mlu(F); } SEAM(PH_MLU);
    if (IN(PH_MLSCAN)) { p_mlscan(F); p_rwkv_post(F, A); } SEAM(PH_MLSCAN);
    if (IN(PH_MLOUT)) { p_mlout(F, A); } SEAM(PH_MLOUT);
    if (IN(PH_OUTPROJ0)) { pg8::PlainOrder S{WSP(bf16, R_YCAT), WSP(bf16, WS_W_ABOUT), D, D, 32, 8, F.G, cb}; pg8::EpiResid E{A.in[I_X], WSP(float, WS_X), D};
        pg8::gemm_phase<pg8::EpiResid, pg8::PlainOrder, false>(ring, pg8::Gemm{D, D, D}, S, E); } SEAM(PH_OUTPROJ0);
#define XATTN(l, P_NORM, P_Q, P_S, P_SM, P_PV, P_O) \
    if (IN(P_NORM)) { norm_phase(F, WSP(float, WS_X), A.in[I_NXAG] + (l) * D, WSP(bf16, WS_XN), T); } SEAM(P_NORM); \
    if (IN(P_Q)) { pg8::PlainOrder S{WSP(bf16, WS_XN), WSP(bf16, WS_W_XQ) + (size_t)(l) * D * D, D, D, 32, 8, F.G, cb}; pg8::EpiBf16 E{WSP(bf16, R_XQ), D, nullptr, -1}; \
        pg8::gemm_phase<pg8::EpiBf16, pg8::PlainOrder, false>(ring, pg8::Gemm{D, D, D}, S, E); } SEAM(P_Q); \
    if (IN(P_S)) { XsOrder S{WSP(bf16, R_XQ), WSP(bf16, WS_KMEM) + (size_t)(l) * NMEM * D, F.G, cb}; pg8::EpiF32 E{WSP(float, R_XS), 1024, 256, 0.044194173824159216f}; \
        pg8::gemm_phase<pg8::EpiF32, XsOrder, false>(ring, pg8::Gemm{D, D, 512}, S, E); } SEAM(P_S); \
    if (IN(P_SM)) { p_xsoftmax(F); } SEAM(P_SM); \
    if (IN(P_PV)) { XpvOrder S{WSP(bf16, R_XP), WSP(bf16, WS_VTMEM) + (size_t)(l) * D * NMEM, F.G, cb}; pg8::EpiBf16 E{WSP(bf16, R_XO), D, nullptr, -1}; \
        pg8::gemm_phase<pg8::EpiBf16, XpvOrder, false>(ring, pg8::Gemm{1024, NMEM, 256}, S, E); } SEAM(P_PV); \
    if (IN(P_O)) { pg8::PlainOrder S{WSP(bf16, R_XO), WSP(bf16, WS_W_XO) + (size_t)(l) * D * D, D, D, 32, 8, F.G, cb}; pg8::EpiResid E{WSP(float, WS_X), WSP(float, WS_X), D}; \
        pg8::gemm_phase<pg8::EpiResid, pg8::PlainOrder, false>(ring, pg8::Gemm{D, D, D}, S, E); } SEAM(P_O);

    XATTN(0, PH_NORMX0, PH_XQ0, PH_XS0, PH_XSM0, PH_XPV0, PH_XO0)
    if (IN(PH_NORMF0)) { norm_phase(F, WSP(float, WS_X), A.in[I_NFFNG], WSP(bf16, WS_XN), T); } SEAM(PH_NORMF0);
    if (IN(PH_FFNGU)) { pg8::PlainOrder S{WSP(bf16, WS_XN), WSP(bf16, WS_W_FFNGU), D, D, 32, 44, F.G, cb}; pg8::EpiSwiGLU E{WSP(bf16, R_ACT), DFF};
        pg8::gemm_phase<pg8::EpiSwiGLU, pg8::PlainOrder, true>(ring, pg8::Gemm{D, D, D}, S, E); } SEAM(PH_FFNGU);
    if (IN(PH_FFND)) { pg8::PlainOrder S{WSP(bf16, R_ACT), WSP(bf16, WS_W_FFND), DFF, DFF, 32, 8, F.G, cb}; pg8::EpiResid E{WSP(float, WS_X), WSP(float, WS_X), D};
        pg8::gemm_phase<pg8::EpiResid, pg8::PlainOrder, false>(ring, pg8::Gemm{DFF, DFF, DFF}, S, E); } SEAM(PH_FFND);
    if (IN(PH_NORMM1)) { p_norm_fpre(F, A); } SEAM(PH_NORMM1);
    if (IN(PH_FOXIN)) { pg8::PlainOrder S{WSP(bf16, WS_XN), WSP(bf16, WS_W_FOXIN), D, D, 32, 32, F.G, cb}; pg8::EpiBf16 E{WSP(bf16, R_QKVG), 8192, nullptr, -1};
        pg8::gemm_phase<pg8::EpiBf16, pg8::PlainOrder, true>(ring, pg8::Gemm{D, D, D}, S, E); } SEAM(PH_FOXIN);
    if (IN(PH_FOXPREP)) { p_foxprep(F, A); } SEAM(PH_FOXPREP);
    if (IN(PH_FOXATT)) { p_foxattn(F); } SEAM(PH_FOXATT);
    if (IN(PH_FOXOUT)) { pg8::PlainOrder S{WSP(bf16, R_ATTO), WSP(bf16, WS_W_FOXOUT), D, D, 32, 8, F.G, cb}; pg8::EpiResid E{WSP(float, WS_X), WSP(float, WS_X), D};
        pg8::gemm_phase<pg8::EpiResid, pg8::PlainOrder, false>(ring, pg8::Gemm{D, D, D}, S, E); } SEAM(PH_FOXOUT);
    XATTN(1, PH_NORMX1, PH_XQ1, PH_XS1, PH_XSM1, PH_XPV1, PH_XO1)
    if (IN(PH_NORMF1)) { p_norm_route(F, A); } SEAM(PH_NORMF1);
    if (IN(PH_ROUTE2)) { p_route2(F); } SEAM(PH_ROUTE2);
    if (IN(PH_MOEGU)) { MoeOrder S{WSP(bf16, R_AG), WSP(bf16, WS_W_MOEGU), WSP(int, WS_SMALL + SM_TILEE), D, 44, (size_t)2 * DFF * D, F.G, cb}; pg8::EpiSwiGLU E{WSP(bf16, R_ACTG), DFF};
        pg8::gemm_phase<pg8::EpiSwiGLU, MoeOrder, true>(ring, pg8::Gemm{D, D, D}, S, E); } SEAM(PH_MOEGU);
    if (IN(PH_MOED)) { MoeOrder S{WSP(bf16, R_ACTG), WSP(bf16, WS_W_MOED), WSP(int, WS_SMALL + SM_TILEE), DFF, 8, (size_t)D * DFF, F.G, cb}; pg8::EpiF32 E{WSP(float, R_YG), D, 0, 1.0f};
        pg8::gemm_phase<pg8::EpiF32, MoeOrder, true>(ring, pg8::Gemm{DFF, DFF, DFF}, S, E); } SEAM(PH_MOED);
    if (IN(PH_FINAL)) { p_final(F, A); }
#undef XATTN
#undef IN
#undef SEAM
}

#ifndef MK_ONE_LAUNCH
#define MK_ONE_LAUNCH 1
#endif
extern "C" void kernel_launch(void* const* d_in, const int* in_sizes, int n_in, void* d_out, int out_size, void* d_ws, size_t ws_size, hipStream_t stream) {
    static int ready = 0;
    if (ready == 0) {
        if (n_in != N_IN || in_sizes[0] != T * D || out_size != T * D || ws_size < WS_END) {
            fprintf(stderr, "kernel_launch: built for %d inputs, x/out of %d floats, >= %zu bytes of workspace; got n_in %d, in0 %d, out %d, ws %zu; nothing launched\n", N_IN, T * D, (size_t)WS_END, n_in, n_in > 0 ? in_sizes[0] : -1, out_size, ws_size);
            ready = -1; return; }
        if (hipFuncSetAttribute((const void*)trunk_fwd, hipFuncAttributeMaxDynamicSharedMemorySize, LDS_BYTES) != hipSuccess) { fprintf(stderr, "kernel_launch: hipFuncSetAttribute failed\n"); ready = -1; return; }
        int per_cu = 0;
        if (hipOccupancyMaxActiveBlocksPerMultiprocessor(&per_cu, (const void*)trunk_fwd, NWAVES * 64, LDS_BYTES) != hipSuccess || per_cu < 1)
            fprintf(stderr, "kernel_launch: note: occupancy query reports %d workgroups per CU\n", per_cu);
        (void)hipGetLastError();
        ready = 1;
    }
    if (ready < 0) return;
    const int grid = 256;
    if (hipMemsetAsync((char*)d_ws + WS_CTL, 0, CTL_ZERO_BYTES, stream) != hipSuccess) { fprintf(stderr, "kernel_launch: hipMemsetAsync failed\n"); return; }
    Args a{};
    for (int i = 0; i < N_IN; ++i) a.in[i] = (const float*)d_in[i];
    a.out = (float*)d_out; a.ws = (unsigned char*)d_ws;
#if MK_ONE_LAUNCH
    a.ph_lo = 0; a.ph_hi = N_PHASES;
    hipLaunchKernelGGL(trunk_fwd, dim3(grid), dim3(NWAVES * 64), LDS_BYTES, stream, a);
#else
    for (int p = 0; p < N_PHASES; ++p) { a.ph_lo = p; a.ph_hi = p + 1;
        hipLaunchKernelGGL(trunk_fwd, dim3(grid), dim3(NWAVES * 64), LDS_BYTES, stream, a); }
#endif
    const hipError_t le = hipPeekAtLastError();
    if (le != hipSuccess) fprintf(stderr, "kernel_launch: launch failed: %s\n", hipGetErrorName(le));
}
```

```cpp
#include <hip/hip_runtime.h>
#include <cstdio>
#include <cstdint>

#define GAS __attribute__((address_space(1)))
#define LAS __attribute__((address_space(3)))
typedef unsigned short bf16;
typedef short bf16x8 __attribute__((ext_vector_type(8)));
typedef short s16x4 __attribute__((ext_vector_type(4)));
typedef float f32x2 __attribute__((ext_vector_type(2)));
typedef float f32x4 __attribute__((ext_vector_type(4)));
typedef float f32x16 __attribute__((ext_vector_type(16)));
typedef unsigned u32x2 __attribute__((ext_vector_type(2)));
typedef unsigned u32x4 __attribute__((ext_vector_type(4)));

constexpr int T = 8192, D = 2048, NMEM = 256, DFF = 5632, NEXP = 8;
constexpr int A_COLS = 3520, AB_COLS = 7624, AB_PAD = 7680;
constexpr int FOX_LD = 8208;
constexpr int NH_R = 16, NH_M = 4, NH_F = 16;
constexpr int MOE_ROWS = 72 * 256;

__device__ __forceinline__ float bf2f(unsigned b) { return __uint_as_float(b << 16); }
__device__ __forceinline__ unsigned cvt_pk_bf16(float lo, float hi) { unsigned r; asm volatile("v_cvt_pk_bf16_f32 %0, %1, %2" : "=v"(r) : "v"(lo), "v"(hi)); return r; }
__device__ __forceinline__ bf16 f2bf(float f) { return (bf16)(cvt_pk_bf16(f, 0.f) & 0xffffu); }
__device__ __forceinline__ float wave_sum(float v) {
#pragma unroll
    for (int o = 1; o < 64; o <<= 1) v += __shfl_xor(v, o);
    return v;
}
__device__ __forceinline__ float wave_max(float v) {
#pragma unroll
    for (int o = 1; o < 64; o <<= 1) v = fmaxf(v, __shfl_xor(v, o));
    return v;
}
__device__ __forceinline__ float sigmoidf_(float x) { return 1.0f / (1.0f + __expf(-x)); }
__device__ __forceinline__ float logsigmoidf_(float x) { return fminf(x, 0.f) - log1pf(__expf(-fabsf(x))); }

namespace pg8 {
#define PG8_LAS __attribute__((address_space(3)))
typedef unsigned short bf16_t;
constexpr int BM = 256, BK = 64, HALF = 128, HTB = HALF * BK * 2  , STAGE_BYTES = 8 * HTB, NXCD = 8, WGM = 8;

__host__ __device__ __forceinline__ int lds_byte(int r, int c) { const int st = (r >> 4) * 2 + (c >> 5), rr = r & 15, cc = c & 31, ob = rr * 64 + cc * 2; return st * 1024 + (ob ^ (((ob >> 9) & 1) << 5)); }
__host__ __device__ __forceinline__ void stage_rc(int b, int& R, int& C) { const int st = b / 1024, sb = b % 1024, swz = sb ^ (((sb >> 9) & 1) << 5); R = (st >> 1) * 16 + swz / 64; C = (st & 1) * 32 + (swz % 64) / 2; }
__host__ __device__ __forceinline__ int perm32(int rho) { const int n = rho >> 4, i = rho & 15; return 8 * (i >> 2) + 4 * n + (i & 3); }

struct Unit { const char* a; const char* b; int pm, pn, aux, pad; };
struct Gemm { int lda, ldb, K; };

__device__ __forceinline__ bool static_tile(int i, int G, int c, int nM, int nN, int& pm, int& pn) {
    const int nwg = nM * nN; const long L = (long)i * G + c; if (L >= nwg) return false;
    int wgid = (int)L; { const int q = nwg / NXCD, r = nwg % NXCD, xcd = wgid % NXCD, off = wgid / NXCD; wgid = (xcd < r ? xcd * (q + 1) : r * (q + 1) + (xcd - r) * q) + off; }
    const int nig = WGM * nN, gid = wgid / nig, fm = gid * WGM, gsz = (nM - fm) < WGM ? (nM - fm) : WGM;
    pm = fm + ((wgid % nig) % gsz); pn = (wgid % nig) / gsz; return true;
}
struct PlainOrder {
    const bf16_t* A; const bf16_t* Bt; int lda, ldb, nM, nN, G, c;
    __device__ __forceinline__ bool next(int i, Unit& u) const {
        int pm, pn; if (!static_tile(i, G, c, nM, nN, pm, pn)) return false;
        u.pm = pm; u.pn = pn; u.aux = 0; u.pad = 0; u.a = (const char*)(A + (size_t)pm * BM * lda); u.b = (const char*)(Bt + (size_t)pn * BM * ldb); return true;
    }
};

struct EpiF32 {
    static constexpr bool PERM = false;
    float* C; int ldc; int aux_cols; float scale;
    __device__ __forceinline__ void operator()(const f32x4 (&acc)[2][2][4][2], const Unit& u, int wr, int wc, int fr, int fq) const {
        const int row0 = u.pm * BM + wr * 64 + fr, col0 = u.pn * BM + u.aux * aux_cols + wc * 32 + 4 * fq;
#pragma unroll
        for (int ai = 0; ai < 2; ++ai)
#pragma unroll
            for (int m = 0; m < 4; ++m) { float* rowp = C + (size_t)(row0 + ai * HALF + m * 16) * ldc + col0;
#pragma unroll
                for (int bj = 0; bj < 2; ++bj)
#pragma unroll
                    for (int n = 0; n < 2; ++n) *(f32x4*)(rowp + bj * HALF + n * 16) = acc[ai][bj][m][n] * scale; }
    }
};
struct EpiResid {
    static constexpr bool PERM = false;
    const float* base; float* out; int ldc;
    __device__ __forceinline__ void operator()(const f32x4 (&acc)[2][2][4][2], const Unit& u, int wr, int wc, int fr, int fq) const {
        const int row0 = u.pm * BM + wr * 64 + fr, col0 = u.pn * BM + wc * 32 + 4 * fq;
#pragma unroll
        for (int ai = 0; ai < 2; ++ai)
#pragma unroll
            for (int m = 0; m < 4; ++m) { const size_t off = (size_t)(row0 + ai * HALF + m * 16) * ldc + col0;
#pragma unroll
                for (int bj = 0; bj < 2; ++bj)
#pragma unroll
                    for (int n = 0; n < 2; ++n) { const f32x4 b = *(const f32x4*)(base + off + bj * HALF + n * 16); *(f32x4*)(out + off + bj * HALF + n * 16) = b + acc[ai][bj][m][n]; } }
    }
};
struct EpiBf16 {
    static constexpr bool PERM = true;
    bf16_t* O; int ldc; float* side; int side_pn;
    __device__ __forceinline__ void operator()(const f32x4 (&acc)[2][2][4][2], const Unit& u, int wr, int wc, int fr, int fq) const {
        const int row0 = u.pm * BM + wr * 64 + fr, col0 = u.pn * BM + wc * 32 + 8 * fq;
#pragma unroll
        for (int ai = 0; ai < 2; ++ai)
#pragma unroll
            for (int m = 0; m < 4; ++m) { bf16_t* rowp = O + (size_t)(row0 + ai * HALF + m * 16) * ldc + col0;
#pragma unroll
                for (int bj = 0; bj < 2; ++bj) { const f32x4 v0 = acc[ai][bj][m][0], v1 = acc[ai][bj][m][1];
                    u32x4 w; w.x = cvt_pk_bf16(v0[0], v0[1]); w.y = cvt_pk_bf16(v0[2], v0[3]); w.z = cvt_pk_bf16(v1[0], v1[1]); w.w = cvt_pk_bf16(v1[2], v1[3]);
                    *(u32x4*)(rowp + bj * HALF) = w; } }
        if (side != nullptr && u.pn == side_pn) {
#pragma unroll
            for (int ai = 0; ai < 2; ++ai)
#pragma unroll
                for (int m = 0; m < 4; ++m) { float* rowp = side + (size_t)(row0 + ai * HALF + m * 16) * 256 + wc * 32 + 8 * fq;
#pragma unroll
                    for (int bj = 0; bj < 2; ++bj) { *(f32x4*)(rowp + bj * HALF) = acc[ai][bj][m][0]; *(f32x4*)(rowp + bj * HALF + 4) = acc[ai][bj][m][1]; } }
        }
    }
};
struct EpiSwiGLU {
    static constexpr bool PERM = true;
    bf16_t* O; int ldc;
    __device__ __forceinline__ void operator()(const f32x4 (&acc)[2][2][4][2], const Unit& u, int wr, int wc, int fr, int fq) const {
        const int row0 = u.pm * BM + wr * 64 + fr, col0 = u.pn * HALF + wc * 32 + 8 * fq;
#pragma unroll
        for (int ai = 0; ai < 2; ++ai)
#pragma unroll
            for (int m = 0; m < 4; ++m) { bf16_t* rowp = O + (size_t)(row0 + ai * HALF + m * 16) * ldc + col0;
                float o[8];
#pragma unroll
                for (int n = 0; n < 2; ++n)
#pragma unroll
                    for (int j = 0; j < 4; ++j) { const float g = acc[ai][0][m][n][j], up = acc[ai][1][m][n][j];
                        o[n * 4 + j] = g * __builtin_amdgcn_rcpf(1.0f + __builtin_amdgcn_exp2f(-1.4426950408889634f * g)) * up; }
                u32x4 w; w.x = cvt_pk_bf16(o[0], o[1]); w.y = cvt_pk_bf16(o[2], o[3]); w.z = cvt_pk_bf16(o[4], o[5]); w.w = cvt_pk_bf16(o[6], o[7]);
                *(u32x4*)rowp = w; }
    }
};

template <class Epi, class Sched, bool ALIGN_EPI>
__device__ __forceinline__ void gemm_phase(PG8_LAS unsigned char* lds, const Gemm g, const Sched& S, const Epi& E) {
    const int tid = threadIdx.x, wid = __builtin_amdgcn_readfirstlane(tid >> 6), lane = tid & 63, wr = wid >> 2, wc = wid & 3, fr = lane & 15, fq = lane >> 4;
    const int K = g.K, nt = K / BK;
    unsigned voffA[2], voffB[2];
#pragma unroll
    for (int i = 0; i < 2; ++i) { int R, C; stage_rc(tid * 16 + i * 8192, R, C); const int Rb = Epi::PERM ? ((R & ~31) + perm32(R & 31)) : R;
        voffA[i] = (unsigned)(R * g.lda + C) * 2u; voffB[i] = (unsigned)(Rb * g.ldb + C) * 2u; }
    const size_t kstep = (size_t)(BK * 2);
    const size_t hstepA = (size_t)HALF * g.lda * 2, hstepB = (size_t)HALF * g.ldb * 2;
    const unsigned ldsw = (unsigned)wid * 1024u;
    const int aoff = lds_byte(wr * 64 + fr, fq * 8), boff = lds_byte(wc * 32 + fr, fq * 8);
#define PG8_SA(b, h) (((b) * 2 + (h)) * HTB)
#define PG8_SB(b, h) ((4 + (b) * 2 + (h)) * HTB)
#define PG8_STAGE(bufoff, gbase, voff) do { _Pragma("unroll") for (int _i = 0; _i < 2; ++_i) \
        __builtin_amdgcn_global_load_lds((const unsigned*)((const char*)(gbase) + (voff)[_i]), (PG8_LAS unsigned*)(lds + (bufoff) + ldsw + _i * 8192), 16, 0, 0); } while (0)
#define PG8_LDA(dst, b, h) do { _Pragma("unroll") for (int m = 0; m < 4; ++m) _Pragma("unroll") for (int k = 0; k < 2; ++k) dst[m][k] = *(const PG8_LAS bf16x8*)(lds + PG8_SA(b, h) + aoff + m * 2048 + k * 1024); } while (0)
#define PG8_LDB(dst, b, h) do { _Pragma("unroll") for (int n = 0; n < 2; ++n) _Pragma("unroll") for (int k = 0; k < 2; ++k) dst[n][k] = *(const PG8_LAS bf16x8*)(lds + PG8_SB(b, h) + boff + n * 2048 + k * 1024); } while (0)
#define PG8_MMA(ai, bj, At, Bt) do { __builtin_amdgcn_s_setprio(1); _Pragma("unroll") for (int m = 0; m < 4; ++m) _Pragma("unroll") for (int n = 0; n < 2; ++n) _Pragma("unroll") for (int k = 0; k < 2; ++k) \
        acc[ai][bj][m][n] = __builtin_amdgcn_mfma_f32_16x16x32_bf16(Bt[n][k], At[m][k], acc[ai][bj][m][n], 0, 0, 0); __builtin_amdgcn_s_setprio(0); } while (0)
#define PG8_WAIT_V(n) asm volatile("s_waitcnt vmcnt(" #n ")" ::: "memory")
#define PG8_WAIT_L(n) asm volatile("s_waitcnt lgkmcnt(" #n ")" ::: "memory")
#define PG8_BAR __builtin_amdgcn_s_barrier()
#define PG8_SCHED __builtin_amdgcn_sched_barrier(0)
    Unit cur, nxt; int ui = 0;
    if (!S.next(0, cur)) return;
    f32x4 acc[2][2][4][2];
#pragma unroll
    for (int a = 0; a < 2; ++a)
#pragma unroll
        for (int b = 0; b < 2; ++b)
#pragma unroll
            for (int m = 0; m < 4; ++m)
#pragma unroll
                for (int n = 0; n < 2; ++n) acc[a][b][m][n] = (f32x4){0.f, 0.f, 0.f, 0.f};
    bf16x8 At[4][2], B0[2][2], B1[2][2];
    const char* cA = cur.a; const char* cB = cur.b;
    PG8_STAGE(PG8_SB(0, 0), cB, voffB); PG8_STAGE(PG8_SB(0, 1), cB + hstepB, voffB); PG8_STAGE(PG8_SA(0, 0), cA, voffA); PG8_STAGE(PG8_SA(0, 1), cA + hstepA, voffA);
    if (wr == 1) PG8_BAR;
    PG8_WAIT_V(2); PG8_BAR;
    PG8_STAGE(PG8_SB(1, 0), cB + kstep, voffB); PG8_STAGE(PG8_SA(1, 0), cA + kstep, voffA); PG8_STAGE(PG8_SB(1, 1), cB + hstepB + kstep, voffB);
    PG8_WAIT_V(6); PG8_BAR;
    for (;;) {
        const bool has_next = S.next(ui + 1, nxt);
        const char* nA = has_next ? nxt.a : cA; const char* nB = has_next ? nxt.b : cB;
        for (int t = 0; t < nt; t += 2) {
            const bool last = (t == nt - 2);
            const char* a1 = cA + (size_t)(t + 1) * kstep;
            const char* a2 = last ? nA : cA + (size_t)(t + 2) * kstep; const char* b2 = last ? nB : cB + (size_t)(t + 2) * kstep;
            const char* a3 = a2 + kstep; const char* b3 = b2 + kstep;
            PG8_LDB(B0, 0, 0); PG8_LDB(B1, 0, 1); PG8_SCHED; PG8_LDA(At, 0, 0); PG8_STAGE(PG8_SA(1, 1), a1 + hstepA, voffA);
            PG8_WAIT_V(8); PG8_WAIT_L(0); PG8_BAR; PG8_MMA(0, 0, At, B0); PG8_MMA(0, 1, At, B1); PG8_BAR; PG8_SCHED;
            PG8_LDA(At, 0, 1); PG8_STAGE(PG8_SB(0, 0), b2, voffB); PG8_STAGE(PG8_SB(0, 1), b2 + hstepB, voffB); PG8_STAGE(PG8_SA(0, 0), a2, voffA);
            PG8_WAIT_V(8); PG8_WAIT_L(0); PG8_BAR; PG8_MMA(1, 0, At, B0); PG8_MMA(1, 1, At, B1); PG8_BAR; PG8_SCHED;
            PG8_LDB(B0, 1, 0); PG8_LDB(B1, 1, 1); PG8_SCHED; PG8_LDA(At, 1, 0); PG8_STAGE(PG8_SA(0, 1), a2 + hstepA, voffA);
            PG8_WAIT_V(8); PG8_WAIT_L(0); PG8_BAR; PG8_MMA(0, 0, At, B0); PG8_MMA(0, 1, At, B1); PG8_BAR; PG8_SCHED;
            PG8_LDA(At, 1, 1); PG8_STAGE(PG8_SB(1, 0), b3, voffB); PG8_STAGE(PG8_SB(1, 1), b3 + hstepB, voffB); PG8_STAGE(PG8_SA(1, 0), a3, voffA);
            PG8_WAIT_V(8); PG8_WAIT_L(0); PG8_BAR; PG8_MMA(1, 0, At, B0); PG8_MMA(1, 1, At, B1); PG8_BAR; PG8_SCHED;
        }
        if constexpr (ALIGN_EPI) { if (wr == 0) PG8_BAR; }
        E(acc, cur, wr, wc, fr, fq);
        if (!has_next) break;
#pragma unroll
        for (int a = 0; a < 2; ++a)
#pragma unroll
            for (int b = 0; b < 2; ++b)
#pragma unroll
                for (int m = 0; m < 4; ++m)
#pragma unroll
                    for (int n = 0; n < 2; ++n) acc[a][b][m][n] = (f32x4){0.f, 0.f, 0.f, 0.f};
        cur = nxt; cA = nA; cB = nB; ++ui;
        if constexpr (ALIGN_EPI) { if (wr == 1) PG8_BAR; }
    }
    PG8_WAIT_V(0);
    if constexpr (!ALIGN_EPI) { if (wr == 0) PG8_BAR; }
    PG8_BAR;
#undef PG8_SA
#undef PG8_SB
#undef PG8_STAGE
#undef PG8_LDA
#undef PG8_LDB
#undef PG8_MMA
#undef PG8_WAIT_V
#undef PG8_WAIT_L
#undef PG8_BAR
#undef PG8_SCHED
}
}

namespace fox {
constexpr int D = 128, LDQ = 8192, LDO = 2048;
constexpr float SCALE = 0.08838834764831845f;
constexpr float THR2 = 8.f * 1.4426950408889634f;
constexpr int NW = 8, QBLK = 32, KVBLK = 64, QB = NW * QBLK;
constexpr int SHM_V = KVBLK * D * 2, SHM_K = KVBLK * D * 2;
constexpr int BIAS_OFF = 2 * SHM_V + 2 * SHM_K + NW * 64 * 4;
constexpr int LDS_BYTES = BIAS_OFF + 8192 * 4;

#define KSWZ(row, colB) ((row) * 256 + ((colB) ^ (((row) & 7) << 4)))
#define SBAR() __builtin_amdgcn_sched_barrier(0)
__device__ __forceinline__ int v_st(int k, int c) { const int kk = (k & ~0xC) | ((k & 4) << 1) | ((k & 8) >> 1); return ((kk >> 3) * 4 + (c >> 5)) * 512 + ((kk & 7) * 32 + (c & 31)) * 2; }
__device__ __forceinline__ int v_rd_base(int lane) { return ((lane & 3) << 3) | (((lane >> 2) & 3) << 6) | (((lane >> 4) & 1) << 5) | (((lane >> 5) & 1) << 8); }
constexpr int v_rd_off(int d0, int ks, int half) { return d0 * 512 + ks * 4096 + half * 2048; }
__device__ __forceinline__ int crow(int r, int hi) { return (r & 3) + 8 * (r >> 2) + 4 * hi; }
__device__ __forceinline__ unsigned cvtpk(float lo, float hi) { unsigned r; asm volatile("v_cvt_pk_bf16_f32 %0, %1, %2" : "=v"(r) : "v"(lo), "v"(hi)); return r; }
__device__ __forceinline__ bf16x8 load8(const bf16* p) { return *reinterpret_cast<const bf16x8*>(p); }
__device__ __forceinline__ void mask_tile(f32x16& p0, f32x16& p1, int dq) {
    const float NEG = -__builtin_inff();
#pragma unroll
    for (int r = 0; r < 16; ++r) {
        const int c = (r & 3) + 8 * (r >> 2);
        if (dq - c < 0) p0[r] = NEG;
        if (dq - c - 32 < 0) p1[r] = NEG;
    }
}
__device__ __forceinline__ void partialSM(f32x16& p0, f32x16& p1, float& m_reg, float& mn, float& alpha, const float* bl) {
    constexpr float C2 = 1.4426950408889634f * SCALE;
#pragma unroll
    for (int a = 0; a < 4; ++a) {
#ifdef FOX_NOBIAS
        const f32x4 b0 = {0,0,0,0}, b1 = {0,0,0,0};
#else
        const f32x4 b0 = *(const f32x4*)(bl + 8 * a), b1 = *(const f32x4*)(bl + 32 + 8 * a);
#endif

#pragma unroll
        for (int i = 0; i < 4; ++i) { p0[4 * a + i] = fmaf(p0[4 * a + i], C2, b0[i]); p1[4 * a + i] = fmaf(p1[4 * a + i], C2, b1[i]); }
        SBAR(); }
    float pmax = p0[0]; for (int r = 1; r < 16; ++r) pmax = fmaxf(pmax, p0[r]); for (int r = 0; r < 16; ++r) pmax = fmaxf(pmax, p1[r]);
    { auto rr = __builtin_amdgcn_permlane32_swap(__float_as_uint(pmax), __float_as_uint(pmax), false, false);
      pmax = fmaxf(__uint_as_float(rr[0]), __uint_as_float(rr[1])); }
    if (__builtin_expect(__all((pmax - m_reg) <= THR2), 1)) { mn = m_reg; alpha = 1.f; }
    else { mn = fmaxf(m_reg, pmax); alpha = __builtin_amdgcn_exp2f(m_reg - mn); m_reg = mn; }
    for (int r = 0; r < 16; ++r) p0[r] = p0[r] - mn; for (int r = 0; r < 16; ++r) p1[r] = p1[r] - mn;
    for (int r = 0; r < 16; ++r) p0[r] = __builtin_amdgcn_exp2f(p0[r]);
}
__device__ __forceinline__ void finishSM(f32x16& p0, f32x16& p1, float alpha, float& l_reg, bf16x8& pa0, bf16x8& pa1, bf16x8& pa2, bf16x8& pa3) {
    for (int r = 0; r < 16; ++r) p1[r] = __builtin_amdgcn_exp2f(p1[r]);
    float ps = 0; for (int r = 0; r < 16; ++r) ps += p0[r]; for (int r = 0; r < 16; ++r) ps += p1[r];
    { auto rr = __builtin_amdgcn_permlane32_swap(__float_as_uint(ps), __float_as_uint(ps), false, false);
      ps = __uint_as_float(rr[0]) + __uint_as_float(rr[1]); }
    l_reg = l_reg * alpha + ps;
#define PK4(P, B_, OUT) do { unsigned a0 = cvtpk(P[B_+0], P[B_+1]), a1 = cvtpk(P[B_+2], P[B_+3]);                          \
        unsigned b0 = cvtpk(P[B_+4], P[B_+5]), b1 = cvtpk(P[B_+6], P[B_+7]);                                             \
        auto r0 = __builtin_amdgcn_permlane32_swap(a0, b0, false, false); auto r1 = __builtin_amdgcn_permlane32_swap(a1, b1, false, false); \
        u32x4 w = {r0[0], r1[0], r0[1], r1[1]}; OUT = *reinterpret_cast<bf16x8*>(&w); } while (0)
    PK4(p0, 0, pa0); PK4(p0, 8, pa1); PK4(p1, 0, pa2); PK4(p1, 8, pa3);
#undef PK4
}
template <int KB>
__device__ __forceinline__ void qkt(f32x16& p0, f32x16& p1, const char* K_lds, int r32, int hi, const bf16x8* qr) {
    p0 = f32x16{}; p1 = f32x16{};
    const char* kb[4];
#pragma unroll
    for (int dd = 0; dd < 4; ++dd) kb[dd] = K_lds + KB * SHM_K + KSWZ(r32, (dd * 16 + hi * 8) * 2);
#pragma unroll
    for (int d0 = 0; d0 < 8; ++d0) { const char* a = kb[d0 & 3] + (d0 >> 2) * 128;
        bf16x8 b0 = *reinterpret_cast<const bf16x8*>(a);
        bf16x8 b1 = *reinterpret_cast<const bf16x8*>(a + 32 * 256);
        p0 = __builtin_amdgcn_mfma_f32_32x32x16_bf16(b0, qr[d0], p0, 0, 0, 0);
        p1 = __builtin_amdgcn_mfma_f32_32x32x16_bf16(b1, qr[d0], p1, 0, 0, 0); }
}
template <int VB>
__device__ __forceinline__ void pv_tile(f32x16* o, int vb0, bf16x8 pa0, bf16x8 pa1, bf16x8 pa2, bf16x8 pa3) {
#define TRRD(dst, off) asm volatile("ds_read_b64_tr_b16 %0, %1 offset:%2" : "=&v"(dst) : "v"(vb0), "i"(off) : "memory")
#define PV_D0(d0) do { s16x4 l0, l1, l2, l3, h0, h1, h2, h3; constexpr int b_ = VB * SHM_V + v_rd_off(d0, 0, 0); \
        TRRD(l0, b_); TRRD(h0, b_ + 2048); TRRD(l1, b_ + 4096); TRRD(h1, b_ + 6144); TRRD(l2, b_ + 8192); TRRD(h2, b_ + 10240); TRRD(l3, b_ + 12288); TRRD(h3, b_ + 14336); \
        asm volatile("s_waitcnt lgkmcnt(0)" ::: "memory"); SBAR();   \
        o[d0] = __builtin_amdgcn_mfma_f32_32x32x16_bf16(pa0, (bf16x8){l0[0], l0[1], l0[2], l0[3], h0[0], h0[1], h0[2], h0[3]}, o[d0], 0, 0, 0);   \
        o[d0] = __builtin_amdgcn_mfma_f32_32x32x16_bf16(pa1, (bf16x8){l1[0], l1[1], l1[2], l1[3], h1[0], h1[1], h1[2], h1[3]}, o[d0], 0, 0, 0);   \
        o[d0] = __builtin_amdgcn_mfma_f32_32x32x16_bf16(pa2, (bf16x8){l2[0], l2[1], l2[2], l2[3], h2[0], h2[1], h2[2], h2[3]}, o[d0], 0, 0, 0);   \
        o[d0] = __builtin_amdgcn_mfma_f32_32x32x16_bf16(pa3, (bf16x8){l3[0], l3[1], l3[2], l3[3], h3[0], h3[1], h3[2], h3[3]}, o[d0], 0, 0, 0); } while (0)
    PV_D0(0); PV_D0(1); PV_D0(2); PV_D0(3);
#undef PV_D0
#undef TRRD
}

struct BlockRef { const bf16* Q; const bf16* K; const bf16* V; const bf16* G; bf16* O; int P0; };
struct Seam { bf16x8 qr[8]; bf16x8 st_v0, st_v1, st_k0, st_k1; };
#define LD8(base, boff) (*reinterpret_cast<const bf16x8*>((const char*)(base) + (boff)))
#define VMW() asm volatile("s_waitcnt vmcnt(0)" ::: "memory")
#define VMWN(n) asm volatile("s_waitcnt vmcnt(%0)" :: "i"(n) : "memory")
#define SLOAD_H(Kp, Vp, k0) do { const char* kb__ = (const char*)(Kp) + (size_t)(k0) * (LDQ * 2); const char* vb__ = (const char*)(Vp) + (size_t)(k0) * (LDQ * 2); \
                         S.st_v0 = LD8(vb__, kvoff); S.st_v1 = LD8(vb__, kvoff + 32u * LDQ * 2u);              \
                         S.st_k0 = LD8(kb__, kvoff); S.st_k1 = LD8(kb__, kvoff + 32u * LDQ * 2u); } while (0)
#define SWRITE_HK(bf) do { *(bf16x8*)(K_lds + (bf) * SHM_K + kws) = S.st_k0; *(bf16x8*)(K_lds + (bf) * SHM_K + kws + 32 * 256) = S.st_k1; } while (0)
#define SWRITE_HV(bf) do { *(bf16x8*)(V_lds + (bf) * SHM_V + vst0) = S.st_v0; *(bf16x8*)(V_lds + (bf) * SHM_V + vst1) = S.st_v1; } while (0)
#define SWRITE_H(bf) do { SWRITE_HV(bf); SWRITE_HK(bf); } while (0)
__device__ __forceinline__ void prime(const BlockRef& cur, char* lds, Seam& S) {
    const int tid = threadIdx.x, wid = __builtin_amdgcn_readfirstlane(tid >> 6), lane = tid & 63, r32 = lane & 31, hi = lane >> 5;
    const int sr = tid >> 4, sc = (tid & 15) * 8, kws = KSWZ(sr, sc * 2); char* K_lds = lds + 2 * SHM_V;
    const unsigned kvoff = (unsigned)(sr * LDQ + sc) * 2u, qoff = (unsigned)((wid * QBLK + r32) * LDQ + hi * 8) * 2u;
    for (int d0 = 0; d0 < 8; ++d0) S.qr[d0] = LD8(cur.Q, qoff + d0 * 32);
    SLOAD_H(cur.K, cur.V, 0); VMW(); SWRITE_HK(0);
    __syncthreads();
}
__device__ __forceinline__ void block(const BlockRef& cur, const BlockRef& nxt, char* lds, Seam& S) {
    const int tid = threadIdx.x, wid = __builtin_amdgcn_readfirstlane(tid >> 6), lane = tid & 63, r32 = lane & 31, hi = lane >> 5;
    const int NT = (cur.P0 + QB - 1) / KVBLK + 1;
    const int qlo = cur.P0 + wid * QBLK, qm = qlo + r32 - 4 * hi;
    char* V_lds = lds; char* K_lds = lds + 2 * SHM_V;
    float* ws = (float*)(lds + 2 * SHM_V + 2 * SHM_K) + wid * 64; float* li_l = ws, * al_l = ws + 32;
    const float* biasl = (const float*)(lds + BIAS_OFF) + 4 * hi;
    float m_reg = -1e30f, l_reg = 0; f32x16 o[4] = {};
    const int sr = tid >> 4, sc = (tid & 15) * 8, vst0 = v_st(sr, sc), vst1 = v_st(32 + sr, sc), kws = KSWZ(sr, sc * 2);
    const unsigned kvoff = (unsigned)(sr * LDQ + sc) * 2u;
    const int vb0 = (int)(uintptr_t)V_lds + v_rd_base(lane);
    const bf16* Kh = cur.K; const bf16* Vh = cur.V;
#define RESC(a) do { if (__any((a) < 1.f)) { if (hi == 0) al_l[r32] = (a); asm volatile("s_waitcnt lgkmcnt(0)" ::: "memory");              \
                     for (int d_ = 0; d_ < 4; ++d_) for (int r = 0; r < 16; ++r) o[d_][r] *= al_l[crow(r, hi)]; } } while (0)
#define KBASE(t) ((t) * KVBLK)
#define MASKT(P0_, P1_, t) do { const int kb_ = KBASE(t); if (kb_ + KVBLK - 1 > qlo) mask_tile(P0_, P1_, qm - kb_); } while (0)
    constexpr int NQL = 8;
#define SEAM_K0() do { VMWN(NQL); SWRITE_HK(0); SBAR(); } while (0)
    f32x16 pA0, pA1, pB0, pB1; float mnA, mnB, alA, alB; bf16x8 pa0, pa1, pa2, pa3;
    SWRITE_HV(0); SBAR();
    if (NT > 1) { SLOAD_H(Kh, Vh, KBASE(1)); }
    SBAR(); qkt<0>(pA0, pA1, K_lds, r32, hi, S.qr);
    MASKT(pA0, pA1, 0); partialSM(pA0, pA1, m_reg, mnA, alA, biasl + KBASE(0));
    if (NT > 1) { VMW(); SWRITE_H(1); }
    __syncthreads();
#define HALF_STEP(PX0, PX1, mnX, alX, PY0, PY1, alY, t, KB, VB, SB) do {                                                      \
        SBAR(); qkt<KB>(PX0, PX1, K_lds, r32, hi, S.qr);                                                                      \
        finishSM(PY0, PY1, alY, l_reg, pa0, pa1, pa2, pa3); SBAR();                                                           \
        if ((t) + 1 < NT) { SLOAD_H(Kh, Vh, KBASE((t) + 1)); SBAR(); }                                                        \
        pv_tile<VB>(o, vb0, pa0, pa1, pa2, pa3); MASKT(PX0, PX1, (t)); partialSM(PX0, PX1, m_reg, mnX, alX, biasl + KBASE(t)); \
        __syncthreads();                                                                                                      \
        if ((t) + 1 < NT) { VMW(); SWRITE_H(SB); }                                                                            \
        RESC(alX); __syncthreads(); } while (0)
    for (int t = 1; t + 1 < NT; t += 2) {
        HALF_STEP(pB0, pB1, mnB, alB, pA0, pA1, alA, t, 1, 0, 0);
        HALF_STEP(pA0, pA1, mnA, alA, pB0, pB1, alB, t + 1, 0, 1, 1);
    }
    const bool even = (NT & 1) == 0;
    if (even) { SBAR(); qkt<1>(pB0, pB1, K_lds, r32, hi, S.qr); SBAR(); }
    SLOAD_H(nxt.K, nxt.V, 0); SBAR();
    { unsigned qoff = (unsigned)((wid * QBLK + r32) * LDQ + hi * 8) * 2u; asm volatile("" : "+v"(qoff));
#pragma unroll
      for (int d0 = 0; d0 < 8; ++d0) S.qr[d0] = LD8(nxt.Q, qoff + d0 * 32); }
    SBAR();
    finishSM(pA0, pA1, alA, l_reg, pa0, pa1, pa2, pa3); SBAR();
    pv_tile<0>(o, vb0, pa0, pa1, pa2, pa3);
    if (even) { MASKT(pB0, pB1, NT - 1); partialSM(pB0, pB1, m_reg, mnB, alB, biasl + KBASE(NT - 1)); __syncthreads(); RESC(alB);
        finishSM(pB0, pB1, alB, l_reg, pa0, pa1, pa2, pa3); SBAR(); pv_tile<1>(o, vb0, pa0, pa1, pa2, pa3); }
    SBAR(); SEAM_K0();
    if (hi == 0) li_l[r32] = l_reg; asm volatile("s_waitcnt lgkmcnt(0)" ::: "memory");
    float rli[16];
#pragma unroll
    for (int r = 0; r < 16; ++r) rli[r] = __builtin_amdgcn_rcpf(li_l[crow(r, hi)]);
    unsigned ooff = (unsigned)((wid * QBLK + 4 * hi) * LDO + r32) * 2u, goff = (unsigned)((wid * QBLK + 4 * hi) * LDQ + r32) * 2u;
    asm volatile("" : "+v"(ooff), "+v"(goff));
#pragma unroll
    for (int r = 0; r < 16; ++r) { const unsigned rr = (unsigned)((r & 3) + 8 * (r >> 2));
#pragma unroll
        for (int d0 = 0; d0 < 4; ++d0) {
#ifdef FOX_NOGATE
            const float gv = 0.f;
#else
            const float gv = bf2f(*(const bf16*)((const char*)cur.G + (goff + rr * (LDQ * 2u) + d0 * 64u)));
#endif

            const float v = o[d0][r] * rli[r] * (1.0f / (1.0f + __expf(-gv)));
            const float vn = __shfl_xor(v, 1);
            if ((r32 & 1) == 0) *(unsigned*)((char*)cur.O + (ooff + rr * (LDO * 2u) + d0 * 64u)) = cvtpk(v, vn); } }
    __syncthreads();
#undef RESC
#undef KBASE
#undef MASKT
#undef SEAM_K0
#undef HALF_STEP
}
#undef LD8
#undef VMW
#undef VMWN
#undef SLOAD_H
#undef SWRITE_HK
#undef SWRITE_HV
#undef SWRITE_H
#undef KSWZ
#undef SBAR
}

constexpr int NWAVES = 8;
constexpr size_t MiB = 1u << 20;
constexpr size_t WS_CTL = 0, CTL_ZERO_BYTES = 1 * MiB;
constexpr size_t WS_MEMN = 1 * MiB;
constexpr size_t WS_KMEM = 2 * MiB;
constexpr size_t WS_VTMEM = 4 * MiB;
constexpr size_t WS_SMALL = 6 * MiB;
constexpr size_t SM_BONUS = 0;
constexpr size_t SM_FPRE = 512 * 1024;
constexpr size_t SM_BIASL2 = 1024 * 1024;
constexpr size_t SM_BCUM = 1536 * 1024;
constexpr size_t SM_IG = SM_BCUM + 128 * 1024;
constexpr size_t SM_WSTATE = SM_IG + 128 * 1024;
constexpr size_t SM_CHBL = SM_WSTATE + 128 * 1024;
constexpr size_t SM_CHMD = SM_CHBL + 4096;
constexpr size_t SM_MSEQ = SM_CHMD + 4096;
constexpr size_t SM_WCARRY = SM_MSEQ + 4096;
constexpr size_t SM_TOPI = 2048 * 1024;
constexpr size_t SM_TOPG = SM_TOPI + 64 * 1024;
constexpr size_t SM_SLOT = SM_TOPG + 64 * 1024;
constexpr size_t SM_BLKCNT = SM_SLOT + 64 * 1024;
constexpr size_t SM_TILEE = SM_BLKCNT + 8192;
constexpr size_t SM_NU = 3 * 1024 * 1024;
constexpr size_t WS_X = 16 * MiB;
constexpr size_t WS_XN = 80 * MiB;
constexpr size_t WS_W_XQ = 112 * MiB, WS_W_XKV = 128 * MiB, WS_W_XO = 160 * MiB, WS_W_ABIN = 176 * MiB, WS_W_LORA = 206 * MiB, WS_W_ABOUT = 209 * MiB,
                 WS_W_FFNGU = 217 * MiB, WS_W_FFND = 261 * MiB, WS_W_FOXIN = 283 * MiB, WS_W_FOXOUT = 315 * MiB, WS_W_MOEGU = 323 * MiB, WS_W_MOED = 675 * MiB;
constexpr size_t WS_R = 851 * MiB;
constexpr size_t R_PROJ = WS_R + 0 * MiB;
constexpr size_t R_GATES32 = WS_R + 120 * MiB;
constexpr size_t R_LORAIN = WS_R + 128 * MiB;
constexpr size_t R_LORAOUT = WS_R + 136 * MiB;
constexpr size_t R_SC = WS_R + 232 * MiB;
constexpr size_t SC_STRIDE = 32 * MiB;
constexpr size_t R_Y = WS_R + 424 * MiB;
constexpr size_t R_QB = WS_R + 456 * MiB, R_KB = WS_R + 472 * MiB, R_VB = WS_R + 488 * MiB;
constexpr size_t R_U = WS_R + 504 * MiB;
constexpr size_t R_YCAT = WS_R + 568 * MiB;
constexpr size_t R_XQ = WS_R + 0 * MiB;
constexpr size_t R_XS = WS_R + 32 * MiB;
constexpr size_t R_XP = WS_R + 64 * MiB;
constexpr size_t R_XO = WS_R + 80 * MiB;
constexpr size_t R_ACT = WS_R + 112 * MiB;
constexpr size_t R_QKVG = WS_R + 200 * MiB;
constexpr size_t R_ATTO = WS_R + 328 * MiB;
constexpr size_t R_AG = WS_R + 0 * MiB;
constexpr size_t R_ACTG = WS_R + 72 * MiB;
constexpr size_t R_YG = WS_R + 270 * MiB;
constexpr size_t WS_END = WS_R + 600 * MiB;
static_assert(R_YG + (size_t)MOE_ROWS * D * 4 <= WS_END && R_ACTG + (size_t)MOE_ROWS * DFF * 2 <= R_YG && R_YCAT + (size_t)T * D * 2 <= WS_END, "ws map");
static_assert(WS_W_MOED + (size_t)NEXP * D * DFF * 2 <= WS_R && WS_W_MOEGU + (size_t)NEXP * 2 * DFF * D * 2 <= WS_W_MOED, "ws map (weights)");
constexpr int CW_BAR = 4096;

constexpr int RING_OFF = 0, RING_BYTES = 131072;
constexpr int LDSCTL_OFF = RING_BYTES, MISC_OFF = LDSCTL_OFF + 320;
constexpr int LDS_BYTES = 147456;

typedef GAS unsigned gu32;
#define RLX_AGENT __ATOMIC_RELAXED, __HIP_MEMORY_SCOPE_AGENT
#define LDS_WAIT() asm volatile("s_waitcnt lgkmcnt(0)" ::: "memory")
#define VM_WAIT() asm volatile("s_waitcnt vmcnt(0)" ::: "memory")

#define XB_TMO      128
#define XB_XCNT(j)  (256  + 64 * (j))
#define XB_XSUB(j)  (1280 + 64 * (j))
#define XB_XGEN(j)  (2304 + 64 * (j))
#define XB_TOP      3328
#define XB_TOPGEN   3392
#define XCD_BAR_WORDS 3456
#define XB_SPIN_CAP (1u << 18)
__device__ __forceinline__ unsigned xb_ld(unsigned* p)              { return __hip_atomic_load(p, __ATOMIC_RELAXED, __HIP_MEMORY_SCOPE_AGENT); }
__device__ __forceinline__ unsigned xb_add(unsigned* p, unsigned v) { return __hip_atomic_fetch_add(p, v, __ATOMIC_RELAXED, __HIP_MEMORY_SCOPE_AGENT); }
__device__ __forceinline__ unsigned xb_xcc_id() { return (unsigned)__builtin_amdgcn_s_getreg((3 << 11) | 20) & 0xFu; }
#define XB_SPIN(cond, bar) do { unsigned _sp = 0; while (cond) { __builtin_amdgcn_s_sleep(1); \
    if ((++_sp & 255u) == 0u) { if (xb_ld(&(bar)[XB_TMO])) break; if (_sp > XB_SPIN_CAP) { atomicAdd(&(bar)[XB_TMO], 1u); break; } } } } while (0)
struct XcdBarrier { unsigned* bar; unsigned x; volatile LAS unsigned* st; };
__device__ __forceinline__ XcdBarrier xcd_barrier_post(unsigned* bar, volatile LAS unsigned* st) {
    XcdBarrier b; b.bar = bar; b.x = xb_xcc_id(); b.st = st;
    if (threadIdx.x == 0) (void)xb_add(&bar[XB_XCNT(b.x)], 1u);
    return b;
}
__device__ __forceinline__ void xcd_barrier_complete(unsigned* bar, unsigned x, unsigned& nloc, unsigned& nx) {
    const unsigned G = gridDim.x * gridDim.y * gridDim.z;
    unsigned sum, cnt, mine, sp = 0u;
    for (;;) {
        sum = 0u; cnt = 0u; mine = 0u;
#pragma unroll
        for (unsigned j = 0; j < 16; ++j) { const unsigned c = xb_ld(&bar[XB_XCNT(j)]); sum += c; cnt += (c > 0u) ? 1u : 0u; mine = (j == x) ? c : mine; }
        if (sum == G) break;
        __builtin_amdgcn_s_sleep(1);
        if ((++sp & 255u) == 0u) { if (xb_ld(&bar[XB_TMO])) break; if (sp > XB_SPIN_CAP) { atomicAdd(&bar[XB_TMO], 1u); break; } }
    }
    nloc = mine > 0u ? mine : 1u; nx = cnt > 0u ? cnt : 1u;
}
__device__ __forceinline__ void xcd_barrier(const XcdBarrier& b) {
    asm volatile("s_waitcnt vmcnt(0)" ::: "memory");
    __syncthreads();
    if (threadIdx.x == 0) {
        unsigned* bar = b.bar;
        __builtin_amdgcn_s_waitcnt(0);
        unsigned nloc = b.st[0], nx = b.st[1];
        if (nloc == 0u) { xcd_barrier_complete(bar, b.x, nloc, nx); b.st[0] = nloc; b.st[1] = nx; }
        const unsigned old = xb_add(&bar[XB_XSUB(b.x)], 1u);
        const unsigned gen = old / nloc;
        if (old + 1u == (gen + 1u) * nloc) {
            __builtin_amdgcn_fence(__ATOMIC_RELEASE, "agent");
            asm volatile("s_waitcnt vmcnt(0)" ::: "memory");
            const unsigned og = xb_add(&bar[XB_TOP], 1u);
            const unsigned tg = og / nx;
            if (og + 1u == (tg + 1u) * nx) xb_add(&bar[XB_TOPGEN], 1u);
            else XB_SPIN(xb_ld(&bar[XB_TOPGEN]) == tg, bar);
            __builtin_amdgcn_fence(__ATOMIC_ACQUIRE, "agent");
            xb_add(&bar[XB_XGEN(b.x)], 1u);
            asm volatile("s_waitcnt vmcnt(0)" ::: "memory");
        } else {
            XB_SPIN(xb_ld(&bar[XB_XGEN(b.x)]) == gen, bar);
            __builtin_amdgcn_fence(__ATOMIC_ACQUIRE, "agent");
            asm volatile("s_waitcnt vmcnt(0)" ::: "memory");
        }
    }
    __syncthreads();
}

struct Frame {
    LAS unsigned char* lds; unsigned char* ldsg;
    unsigned char* ws; const float* const* in; float* out;
    int tid, lane, wave, vcu, G, gw, NGW;
};

enum InIdx { I_X = 0, I_MEM, I_MEMG, I_FING, I_NMIXG, I_NXAG, I_NFFNG, I_XWQ, I_XWKV, I_XWO, I_ABWIN, I_ABMU, I_RWW0, I_RWWUP, I_RWA0, I_RWAUP, I_RWGUP, I_RWKK, I_RWKA, I_RWRK,
             I_RWLNG, I_RWLNB, I_MLCONV, I_MLBIF, I_MLNG, I_ABWOUT, I_FFG, I_FFU, I_FFD, I_FOXWIN, I_FOXBF, I_FOXQG, I_FOXKG, I_FOXWOUT, I_ROUTER, I_MOEG, I_MOEU, I_MOED, N_IN };
struct Args { const float* in[N_IN]; float* out; unsigned char* ws; int ph_lo, ph_hi; };
static_assert(sizeof(Args) == (N_IN + 2) * 8 + 8, "Args has no padding");

#define WSP(T_, off) ((T_*)(F.ws + (off)))

__device__ __forceinline__ void rms_row(const float* xrow, const float* g, bf16* orow, int lane, f32x4 (&y)[8]) {
    const f32x4* xr = (const f32x4*)xrow + lane; const f32x4* gr = (const f32x4*)g + lane;
    float s = 0.f;
#pragma unroll
    for (int j = 0; j < 8; ++j) { y[j] = xr[64 * j]; s += (y[j][0] * y[j][0] + y[j][1] * y[j][1]) + (y[j][2] * y[j][2] + y[j][3] * y[j][3]); }
    const float r = 1.0f / sqrtf(wave_sum(s) * (1.0f / D) + 1e-6f);
#pragma unroll
    for (int j = 0; j < 8; ++j) { const f32x4 gv = gr[64 * j]; y[j] = y[j] * r * gv; }
    if (orow) { u32x2* o8 = (u32x2*)orow + lane;
#pragma unroll
        for (int j = 0; j < 8; ++j) { u32x2 w; w.x = cvt_pk_bf16(y[j][0], y[j][1]); w.y = cvt_pk_bf16(y[j][2], y[j][3]); o8[64 * j] = w; } }
}
__device__ __forceinline__ void norm_phase(const Frame& F, const float* X, const float* g, bf16* XN, int nrows) {
    for (int t = F.gw; t < nrows; t += F.NGW) { f32x4 y[8]; rms_row(X + (size_t)t * D, g, XN + (size_t)t * D, F.lane, y); }
}
template <int NC>
__device__ __forceinline__ void stage_skinny(const Frame& F, const float* W, int ldw, int c0, LAS float* Ws) {
    for (int i = F.tid; i < D * NC; i += NWAVES * 64) { const int e = i / NC, c = i % NC; Ws[c * D + e] = W[(size_t)e * ldw + c0 + c]; }
}
template <int NC>
__device__ __forceinline__ void skinny_dot(const f32x4 (&y)[8], const LAS float* Ws, int lane, float (&out)[NC]) {
#pragma unroll
    for (int c = 0; c < NC; ++c) { float s = 0.f;
#pragma unroll
        for (int j = 0; j < 8; ++j) { const f32x4 w = *(const LAS f32x4*)(Ws + c * D + 256 * j + 4 * lane); s += (y[j][0] * w[0] + y[j][1] * w[1]) + (y[j][2] * w[2] + y[j][3] * w[3]); }
        out[c] = wave_sum(s); }
}

__device__ __forceinline__ void transpose_item(const float* W, int ldw, int k0, int n0, int nvalid, bf16* WT0  , int K, LAS float* scr, int lane) {
#pragma unroll 8
    for (int i = 0; i < 32; ++i) { const int kk = 2 * i + (lane >> 5), n = lane & 31; scr[kk * 33 + n] = (n < nvalid) ? W[(size_t)(k0 + kk) * ldw + n0 + n] : 0.f; }
    LDS_WAIT(); asm volatile("" ::: "memory");
    const int c = lane & 7;
#pragma unroll
    for (int j = 0; j < 4; ++j) { const int n = (lane >> 3) + 8 * j; const LAS float* s = scr + (8 * c) * 33 + n;
        u32x4 o; o.x = cvt_pk_bf16(s[0 * 33], s[1 * 33]); o.y = cvt_pk_bf16(s[2 * 33], s[3 * 33]); o.z = cvt_pk_bf16(s[4 * 33], s[5 * 33]); o.w = cvt_pk_bf16(s[6 * 33], s[7 * 33]);
        if (n < nvalid) *(u32x4*)(WT0 + (size_t)n * K + k0 + 8 * c) = o; }
    LDS_WAIT(); asm volatile("" ::: "memory");
}
__device__ __forceinline__ void transpose_matrix(const Frame& F, int gw, int NGW, const float* W, int ldw, int K, int N, bf16* WT, int mode, int& it0, LAS float* scr) {
    const int nblk = (N + 31) / 32, nitems = (K / 64) * nblk;
    int first = gw - (it0 % NGW); if (first < 0) first += NGW;
    for (int r = first; r < nitems; r += NGW) {
        const int kb = r / nblk, nb = r % nblk, n0 = 32 * nb; const int nvalid = (N - n0) < 32 ? (N - n0) : 32;
        const int drow = mode == 0 ? n0 : ((n0 >> 7) * 256 + (n0 & 127) + (mode == 2 ? 128 : 0));
        transpose_item(W, ldw, 64 * kb, n0, nvalid, WT + (size_t)drow * K, K, scr, F.lane);
    }
    it0 += nitems;
}
__device__ __forceinline__ void p_convert_early(const Frame& F, const Args& A) {
    LAS float* scr = (LAS float*)(F.lds + RING_OFF + F.wave * 16384);
    int it0 = 0;
    for (int l = 0; l < 2; ++l)
        transpose_matrix(F, F.gw, F.NGW, A.in[I_XWKV] + (size_t)l * D * 2 * D, 2 * D, D, 2 * D, WSP(bf16, WS_W_XKV) + (size_t)l * 2 * D * D, 0, it0, scr);
    transpose_matrix(F, F.gw, F.NGW, A.in[I_ABWIN], AB_COLS, D, AB_COLS, WSP(bf16, WS_W_ABIN), 0, it0, scr);
    const int gt = F.gw * 64 + F.lane, NGT = F.NGW * 64;
    { u32x4* z = (u32x4*)(WSP(bf16, WS_W_ABIN) + (size_t)AB_COLS * D); const int n16 = (AB_PAD - AB_COLS) * D * 2 / 16;
      for (int i = gt; i < n16; i += NGT) z[i] = (u32x4){0u, 0u, 0u, 0u}; }
    { bf16* WL = WSP(bf16, WS_W_LORA); const float* wup = A.in[I_RWWUP]; const float* aup = A.in[I_RWAUP]; const float* gup = A.in[I_RWGUP];
      for (int i = gt; i < 3072 * 64; i += NGT) { const int n = i >> 6, k8 = (i & 63) * 8; const int sec = n >> 10, nn = n & 1023; float v[8];
#pragma unroll
          for (int j = 0; j < 8; ++j) { const int k = k8 + j; float x = 0.f;
              if (sec == 0) { if (k < 96) x = wup[(size_t)k * 1024 + nn]; }
              else if (sec == 1) { if (k >= 96 && k < 192) x = aup[(size_t)(k - 96) * 1024 + nn]; }
              else { if (k >= 192 && k < 448) x = gup[(size_t)(k - 192) * 1024 + nn]; }
              v[j] = x; }
          u32x4 o; o.x = cvt_pk_bf16(v[0], v[1]); o.y = cvt_pk_bf16(v[2], v[3]); o.z = cvt_pk_bf16(v[4], v[5]); o.w = cvt_pk_bf16(v[6], v[7]);
          *(u32x4*)(WL + (size_t)n * 512 + k8) = o; } }
    norm_phase(F, A.in[I_MEM], A.in[I_MEMG], WSP(bf16, WS_MEMN), NMEM);
    norm_phase(F, A.in[I_X], A.in[I_NMIXG], WSP(bf16, WS_XN), T);
}
__device__ __forceinline__ void p_convert_late(const Frame& F, const Args& A, int gw, int NGW, LAS float* scr) {
    int it0 = 0;
    transpose_matrix(F, gw, NGW, A.in[I_ABWOUT], D, D, D, WSP(bf16, WS_W_ABOUT), 0, it0, scr);
    for (int l = 0; l < 2; ++l) {
        transpose_matrix(F, gw, NGW, A.in[I_XWQ] + (size_t)l * D * D, D, D, D, WSP(bf16, WS_W_XQ) + (size_t)l * D * D, 0, it0, scr);
        transpose_matrix(F, gw, NGW, A.in[I_XWO] + (size_t)l * D * D, D, D, D, WSP(bf16, WS_W_XO) + (size_t)l * D * D, 0, it0, scr);
    }
    transpose_matrix(F, gw, NGW, A.in[I_FFG], DFF, D, DFF, WSP(bf16, WS_W_FFNGU), 1, it0, scr);
    transpose_matrix(F, gw, NGW, A.in[I_FFU], DFF, D, DFF, WSP(bf16, WS_W_FFNGU), 2, it0, scr);
    transpose_matrix(F, gw, NGW, A.in[I_FFD], D, DFF, D, WSP(bf16, WS_W_FFND), 0, it0, scr);
    transpose_matrix(F, gw, NGW, A.in[I_FOXWIN], FOX_LD, D, 8192, WSP(bf16, WS_W_FOXIN), 0, it0, scr);
    transpose_matrix(F, gw, NGW, A.in[I_FOXWOUT], D, D, D, WSP(bf16, WS_W_FOXOUT), 0, it0, scr);
    for (int e = 0; e < NEXP; ++e) {
        transpose_matrix(F, gw, NGW, A.in[I_MOEG] + (size_t)e * D * DFF, DFF, D, DFF, WSP(bf16, WS_W_MOEGU) + (size_t)e * 2 * DFF * D, 1, it0, scr);
        transpose_matrix(F, gw, NGW, A.in[I_MOEU] + (size_t)e * D * DFF, DFF, D, DFF, WSP(bf16, WS_W_MOEGU) + (size_t)e * 2 * DFF * D, 2, it0, scr);
        transpose_matrix(F, gw, NGW, A.in[I_MOED] + (size_t)e * DFF * D, D, DFF, D, WSP(bf16, WS_W_MOED) + (size_t)e * D * DFF, 0, it0, scr);
    }
}

struct InprojKvOrder {
    const bf16* xn; const bf16* wabin; const bf16* memn; const bf16* wkv; int G, c;
    __device__ __forceinline__ bool next(int i, pg8::Unit& u) const {
        const int L = i * G + c; u.pad = 0;
        if (L < 32 * (AB_PAD / 256)) { int pm, pn; pg8::static_tile(i, G, c, 32, AB_PAD / 256, pm, pn); u.pm = pm; u.pn = pn; u.aux = -1;
            u.a = (const char*)(xn + (size_t)pm * 256 * D); u.b = (const char*)(wabin + (size_t)pn * 256 * D); return true; }
        const int j = L - 32 * (AB_PAD / 256); if (j >= 32) return false;
        const int l = j >> 4, kind = (j >> 3) & 1, idx = j & 7; const bf16* w = wkv + (size_t)l * 2 * D * D;
        if (kind == 0) { u.a = (const char*)memn; u.b = (const char*)(w + (size_t)idx * 256 * D); u.pm = 0; u.pn = idx; }
        else { u.a = (const char*)(w + (size_t)(D + idx * 256) * D); u.b = (const char*)memn; u.pm = idx; u.pn = 0; }
        u.aux = l * 2 + kind; return true;
    }
};
struct EpiInprojKv {
    static constexpr bool PERM = true;
    bf16* proj; float* gates32; bf16* kmem; bf16* vtmem;
    __device__ __forceinline__ void operator()(const f32x4 (&acc)[2][2][4][2], const pg8::Unit& u, int wr, int wc, int fr, int fq) const {
        if (u.aux < 0) { pg8::EpiBf16 E{proj, AB_PAD, gates32, 29}; E(acc, u, wr, wc, fr, fq); }
        else { const int l = u.aux >> 1, kind = u.aux & 1;
            pg8::EpiBf16 E{kind == 0 ? kmem + (size_t)l * NMEM * D : vtmem + (size_t)l * D * NMEM, kind == 0 ? D : NMEM, nullptr, -1};
            E(acc, u, wr, wc, fr, fq); }
    }
};

__device__ __forceinline__ void p_prepa(const Frame& F, const Args& A) {
    const bf16* PROJ = WSP(bf16, R_PROJ); const float* mu = A.in[I_ABMU]; const float* convw = A.in[I_MLCONV];
    bf16* LIN = WSP(bf16, R_LORAIN); bf16* QB = WSP(bf16, R_QB); bf16* KB = WSP(bf16, R_KB); bf16* VB = WSP(bf16, R_VB);
    const int lane = F.lane;
    for (int t = F.gw; t < T; t += F.NGW) {
        const bf16* p0 = PROJ + (size_t)t * AB_PAD;
#pragma unroll
        for (int i = 0; i < 7; ++i) { const int cc = lane + 64 * i, c = 3072 + cc; const float p = bf2f(p0[c]); const float pp = t > 0 ? bf2f(p0[c - AB_PAD]) : 0.f;
            const float s = p + (pp - p) * mu[c]; float o;
            if (cc < 96) o = tanhf(s); else if (cc < 192) o = s; else o = sigmoidf_(s);
            LIN[(size_t)t * 512 + cc] = f2bf(o); }
        LIN[(size_t)t * 512 + 448 + lane] = 0;
#pragma unroll
        for (int i = 0; i < 4; ++i) { const int c = 8 * lane + 512 * i; float acc[8];
#pragma unroll
            for (int j = 0; j < 8; ++j) acc[j] = 0.f;
#pragma unroll
            for (int tap = 0; tap < 4; ++tap) { const int tt = t - 3 + tap; if (tt >= 0) {
                const bf16x8 v = *(const bf16x8*)(PROJ + (size_t)tt * AB_PAD + A_COLS + c); const f32x4 w0 = *(const f32x4*)(convw + tap * 2048 + c), w1 = *(const f32x4*)(convw + tap * 2048 + c + 4);
#pragma unroll
                for (int j = 0; j < 4; ++j) { acc[j] += bf2f((unsigned short)v[j]) * w0[j]; acc[4 + j] += bf2f((unsigned short)v[4 + j]) * w1[j]; } } }
            const float sc = c < 1024 ? 0.0625f : 1.0f; float o[8];
#pragma unroll
            for (int j = 0; j < 8; ++j) o[j] = acc[j] * sigmoidf_(acc[j]) * sc;
            u32x4 w; w.x = cvt_pk_bf16(o[0], o[1]); w.y = cvt_pk_bf16(o[2], o[3]); w.z = cvt_pk_bf16(o[4], o[5]); w.w = cvt_pk_bf16(o[6], o[7]);
            if (c < 1024) *(u32x4*)(QB + (size_t)t * 1024 + c) = w; else *(u32x4*)(KB + (size_t)t * 1024 + c - 1024) = w; }
#pragma unroll
        for (int i = 0; i < 2; ++i) { const int c = 8 * lane + 512 * i; *(u32x4*)(VB + (size_t)t * 1024 + c) = *(const u32x4*)(p0 + 5568 + c); }
    }
    const float* G32 = WSP(float, R_GATES32); const float* bif = A.in[I_MLBIF];
    float* BCUM = WSP(float, WS_SMALL + SM_BCUM); float* IG = WSP(float, WS_SMALL + SM_IG); float* CHBL = WSP(float, WS_SMALL + SM_CHBL); float* CHMD = WSP(float, WS_SMALL + SM_CHMD);
    for (int u = F.gw; u < NH_M * 128; u += F.NGW) { const int h = u >> 7, c = u & 127, t = 64 * c + lane;
        const float ig = G32[(size_t)t * 256 + 192 + h] + bif[h], fg = G32[(size_t)t * 256 + 196 + h] + bif[4 + h];
        float b = logsigmoidf_(fg);
#pragma unroll
        for (int o = 1; o < 64; o <<= 1) { const float x = __shfl_up(b, o); if (lane >= o) b += x; }
        const float bl = __shfl(b, 63); const float md = wave_max(bl - b + ig);
        BCUM[h * T + t] = b; IG[h * T + t] = ig;
        if (lane == 0) { CHBL[u] = bl; CHMD[u] = md; } }
}

__device__ __forceinline__ void p_prepb(const Frame& F, const Args& A) {
    const bf16* PROJ = WSP(bf16, R_PROJ); const float* LOUT = WSP(float, R_LORAOUT); const float* mu = A.in[I_ABMU];
    const float* w0 = A.in[I_RWW0]; const float* a0 = A.in[I_RWA0]; const float* kk_ = A.in[I_RWKK]; const float* ka_ = A.in[I_RWKA]; const float* rk_ = A.in[I_RWRK];
    float* SR = WSP(float, R_SC); float* SW = WSP(float, R_SC + SC_STRIDE); float* SKM = WSP(float, R_SC + 2 * SC_STRIDE); float* SV = WSP(float, R_SC + 3 * SC_STRIDE);
    float* SKK = WSP(float, R_SC + 4 * SC_STRIDE); float* SB = WSP(float, R_SC + 5 * SC_STRIDE); float* BONUS = WSP(float, WS_SMALL + SM_BONUS);
    const int lane = F.lane;
    for (int t = F.gw; t < T; t += F.NGW) {
        const bf16* p0 = PROJ + (size_t)t * AB_PAD; const float* lo = LOUT + (size_t)t * 3072;
        for (int h = 0; h < NH_R; ++h) { const int c = 64 * h + lane;
            float r = bf2f(p0[c]), k = bf2f(p0[1024 + c]), v = bf2f(p0[2048 + c]);
            if (t > 0) { const float pr = bf2f(p0[c - AB_PAD]), pk = bf2f(p0[1024 + c - AB_PAD]), pv = bf2f(p0[2048 + c - AB_PAD]);
                r += (pr - r) * mu[c]; k += (pk - k) * mu[1024 + c]; v += (pv - v) * mu[2048 + c]; }
            else { r -= r * mu[c]; k -= k * mu[1024 + c]; v -= v * mu[2048 + c]; }
            const float w = __expf(-0.6065306597126334f * sigmoidf_(lo[c] + w0[c]));
            const float a = sigmoidf_(a0[c] + lo[1024 + c]);
            float kk = k * kk_[c]; const float nrm = sqrtf(wave_sum(kk * kk)); kk = kk / fmaxf(nrm, 1e-12f);
            const float km = k * (1.0f + (a - 1.0f) * ka_[c]);
            const float bon = wave_sum(r * km * rk_[c]);
            const size_t o = (size_t)t * 1024 + c;
            SR[o] = r; SW[o] = w; SKM[o] = km; SV[o] = v; SKK[o] = kk; SB[o] = kk * a;
            if (lane == 0) BONUS[t * 16 + h] = bon; }
    }
    if (F.gw < NH_M) { const int h = F.gw;
        const float* BCUM = WSP(float, WS_SMALL + SM_BCUM); const float* IG = WSP(float, WS_SMALL + SM_IG); const float* CHBL = WSP(float, WS_SMALL + SM_CHBL); const float* CHMD = WSP(float, WS_SMALL + SM_CHMD);
        float* MSEQ = WSP(float, WS_SMALL + SM_MSEQ); float* WCARRY = WSP(float, WS_SMALL + SM_WCARRY); float* WSTATE = WSP(float, WS_SMALL + SM_WSTATE);
        const float bl0 = CHBL[h * 128 + lane], bl1 = CHBL[h * 128 + 64 + lane], md0 = CHMD[h * 128 + lane], md1 = CHMD[h * 128 + 64 + lane];
        float m = 0.f, mine_in0 = 0.f, mine_in1 = 0.f, mine_out0 = 0.f, mine_out1 = 0.f;
#pragma unroll
        for (int c = 0; c < 128; ++c) { const float bl = __shfl(c < 64 ? bl0 : bl1, c & 63), md = __shfl(c < 64 ? md0 : md1, c & 63);
            const float mn = fmaxf(bl + m, md);
            if ((c & 63) == lane) { if (c < 64) { mine_in0 = m; mine_out0 = mn; } else { mine_in1 = m; mine_out1 = mn; } }
            m = mn; }
        MSEQ[h * 128 + lane] = mine_in0; MSEQ[h * 128 + 64 + lane] = mine_in1;
        WCARRY[h * 128 + lane] = __expf(bl0 + mine_in0 - mine_out0); WCARRY[h * 128 + 64 + lane] = __expf(bl1 + mine_in1 - mine_out1);
        for (int c = 0; c < 128; ++c) { const float bl = __shfl(c < 64 ? bl0 : bl1, c & 63), mo = __shfl(c < 64 ? mine_out0 : mine_out1, c & 63); const int t = 64 * c + lane;
            WSTATE[h * T + t] = __expf(bl - BCUM[h * T + t] + IG[h * T + t] - mo); }
    }
}

__device__ __forceinline__ float row16_sum(float x) {
    x += __builtin_bit_cast(float, __builtin_amdgcn_update_dpp(0, __builtin_bit_cast(int, x), 0xB1, 0xF, 0xF, true));
    x += __builtin_bit_cast(float, __builtin_amdgcn_update_dpp(0, __builtin_bit_cast(int, x), 0x4E, 0xF, 0xF, true));
    x += __builtin_bit_cast(float, __builtin_amdgcn_update_dpp(0, __builtin_bit_cast(int, x), 0x141, 0xF, 0xF, true));
    x += __builtin_bit_cast(float, __builtin_amdgcn_update_dpp(0, __builtin_bit_cast(int, x), 0x140, 0xF, 0xF, true));
    return x;
}
constexpr int SCH = 16;
constexpr int SC_VEC = SCH * 256;
constexpr int SC_BUF = 5 * SC_VEC + 1024;
constexpr int SC_NBUF = 3, SC_LDS = SC_NBUF * SC_BUF;
constexpr int SC_NLOAD = 5 * (SCH / 4) + 1;
__device__ __forceinline__ void p_scan(const Frame& F) {
    const int b = blockIdx.x, head = (b & 7) * 2 + ((b >> 3) & 1), rg = b >> 4, lane = F.lane, row = lane >> 4, j = lane & 15;
    const float* SR = WSP(float, R_SC); const float* SW = WSP(float, R_SC + SC_STRIDE); const float* SKM = WSP(float, R_SC + 2 * SC_STRIDE); const float* SV = WSP(float, R_SC + 3 * SC_STRIDE);
    const float* SKK = WSP(float, R_SC + 4 * SC_STRIDE); const float* SB = WSP(float, R_SC + 5 * SC_STRIDE); float* Y = WSP(float, R_Y);
    LAS unsigned char* lds = F.lds + RING_OFF;
    const size_t goff = (size_t)(lane >> 4) * 1024 + head * 64 + (lane & 15) * 4;
    f32x4 S = {0.f, 0.f, 0.f, 0.f};
#define SC_ISSUE(c_, buf_) do { const size_t t0_ = (size_t)(c_) * SCH * 1024; LAS unsigned char* d_ = lds + (buf_) * SC_BUF; \
        _Pragma("unroll") for (int q = 0; q < SCH / 4; ++q) { const size_t o_ = t0_ + (size_t)q * 4096 + goff; \
            __builtin_amdgcn_global_load_lds((const unsigned*)(SKK + o_), (LAS unsigned*)(d_ + 0 * SC_VEC + q * 1024), 16, 0, 0); \
            __builtin_amdgcn_global_load_lds((const unsigned*)(SW  + o_), (LAS unsigned*)(d_ + 1 * SC_VEC + q * 1024), 16, 0, 0); \
            __builtin_amdgcn_global_load_lds((const unsigned*)(SB  + o_), (LAS unsigned*)(d_ + 2 * SC_VEC + q * 1024), 16, 0, 0); \
            __builtin_amdgcn_global_load_lds((const unsigned*)(SKM + o_), (LAS unsigned*)(d_ + 3 * SC_VEC + q * 1024), 16, 0, 0); \
            __builtin_amdgcn_global_load_lds((const unsigned*)(SR  + o_), (LAS unsigned*)(d_ + 4 * SC_VEC + q * 1024), 16, 0, 0); } \
        { int ts_ = (c_) * SCH + lane; ts_ = ts_ < T ? ts_ : T - 1; \
          __builtin_amdgcn_global_load_lds((const unsigned*)(SV + (size_t)ts_ * 1024 + head * 64 + rg * 4), (LAS unsigned*)(d_ + 5 * SC_VEC), 16, 0, 0); } } while (0)
    constexpr int NCH = T / SCH;
    SC_ISSUE(0, 0); SC_ISSUE(1, 1);
    int buf = 0;
    for (int c = 0; c < NCH; ++c) {
        if (c == 0) asm volatile("s_waitcnt vmcnt(21)" ::: "memory"); else if (c == 1) asm volatile("s_waitcnt vmcnt(22)" ::: "memory");
        else if (c < NCH - 1) asm volatile("s_waitcnt vmcnt(23)" ::: "memory"); else asm volatile("s_waitcnt vmcnt(0)" ::: "memory");
        static_assert(SC_NLOAD == 21, "vmcnt immediates above assume 21 loads per chunk and 1 store per chunk");
        if (c + 2 < NCH) { const int nb = buf >= 1 ? buf - 1 : buf + 2; SC_ISSUE(c + 2, nb); }
        const LAS unsigned char* d = lds + buf * SC_BUF;
        float ykeep = 0.f;
#pragma unroll
        for (int s = 0; s < SCH; ++s) {
            const f32x4 kk = *(const LAS f32x4*)(d + 0 * SC_VEC + s * 256 + j * 16), w = *(const LAS f32x4*)(d + 1 * SC_VEC + s * 256 + j * 16), bb = *(const LAS f32x4*)(d + 2 * SC_VEC + s * 256 + j * 16);
            const f32x4 km = *(const LAS f32x4*)(d + 3 * SC_VEC + s * 256 + j * 16), r = *(const LAS f32x4*)(d + 4 * SC_VEC + s * 256 + j * 16);
            const float v = *(const LAS float*)(d + 5 * SC_VEC + s * 16 + row * 4);
            const float sa = row16_sum((S[0] * kk[0] + S[1] * kk[1]) + (S[2] * kk[2] + S[3] * kk[3]));
            S = S * w + (km * v - bb * sa);
            const float y = row16_sum((S[0] * r[0] + S[1] * r[1]) + (S[2] * r[2] + S[3] * r[3]));
            ykeep = (j == s) ? y : ykeep;
        }
        Y[(size_t)(c * SCH + j) * 1024 + head * 64 + rg * 4 + row] = ykeep;
        buf = buf == SC_NBUF - 1 ? 0 : buf + 1;
    }
    asm volatile("s_waitcnt vmcnt(0)" ::: "memory");
#undef SC_ISSUE
}

__device__ __forceinline__ void p_rwkv_post(const Frame& F, const Args& A) {
    const float* Y = WSP(float, R_Y); const float* SV = WSP(float, R_SC + 3 * SC_STRIDE); const float* LOUT = WSP(float, R_LORAOUT); const float* BONUS = WSP(float, WS_SMALL + SM_BONUS);
    const float* lng = A.in[I_RWLNG]; const float* lnb = A.in[I_RWLNB]; bf16* YCAT = WSP(bf16, R_YCAT); const int lane = F.lane;
    for (int t = F.gw; t < T; t += F.NGW)
        for (int h = 0; h < NH_R; ++h) { const int c = 64 * h + lane; const float y = Y[(size_t)t * 1024 + c];
            const float mean = wave_sum(y) * (1.0f / 64.0f), d = y - mean, var = wave_sum(d * d) * (1.0f / 64.0f);
            float o = d * (1.0f / sqrtf(var + 64e-5f)) * lng[c] + lnb[c] + BONUS[t * 16 + h] * SV[(size_t)t * 1024 + c];
            o *= LOUT[(size_t)t * 3072 + 2048 + c];
            YCAT[(size_t)t * D + c] = f2bf(o); }
}

constexpr int ML_P = 264;
__device__ __forceinline__ void ml_stage_chunk(const Frame& F, const bf16* src  , int h, int c, LAS bf16* dst) {
    for (int i = F.tid; i < 64 * 32; i += NWAVES * 64) { const int s = i >> 5, ch = i & 31;
        *(LAS u32x4*)(dst + s * ML_P + 8 * ch) = *(const u32x4*)(src + (size_t)(64 * c + s) * 1024 + 256 * h + 8 * ch); }
}
__device__ __forceinline__ void p_mlu(const Frame& F) {
    const bf16* KB = WSP(bf16, R_KB); const bf16* VB = WSP(bf16, R_VB); const float* WSTATE = WSP(float, WS_SMALL + SM_WSTATE);
    bf16* U = WSP(bf16, R_U); float* NU = WSP(float, WS_SMALL + SM_NU);
    LAS bf16* Ks = (LAS bf16*)(F.lds + RING_OFF); LAS bf16* Vs = Ks + 64 * ML_P; LAS float* wst = (LAS float*)(Vs + 64 * ML_P);
    const int lane = F.lane, r = lane & 31, hg = lane >> 5, w = F.wave;
    for (int L = F.vcu; L < NH_M * 128; L += F.G) { const int h = L >> 7, c = L & 127;
        __syncthreads();
        ml_stage_chunk(F, KB, h, c, Ks); ml_stage_chunk(F, VB, h, c, Vs);
        if (F.tid < 64) wst[F.tid] = WSTATE[h * T + 64 * c + F.tid];
        __syncthreads();
        f32x16 acc[8];
#pragma unroll
        for (int nt = 0; nt < 8; ++nt) acc[nt] = f32x16{};
#pragma unroll
        for (int ks = 0; ks < 4; ++ks) { bf16x8 a; float av[8];
#pragma unroll
            for (int jj = 0; jj < 8; ++jj) { const int s = 16 * ks + 8 * hg + jj; av[jj] = bf2f(Vs[s * ML_P + 32 * w + r]) * wst[s]; }
            { u32x4 p; p.x = cvt_pk_bf16(av[0], av[1]); p.y = cvt_pk_bf16(av[2], av[3]); p.z = cvt_pk_bf16(av[4], av[5]); p.w = cvt_pk_bf16(av[6], av[7]); a = __builtin_bit_cast(bf16x8, p); }
#pragma unroll
            for (int nt = 0; nt < 8; ++nt) { bf16x8 b;
#pragma unroll
                for (int jj = 0; jj < 8; ++jj) b[jj] = (short)Ks[(16 * ks + 8 * hg + jj) * ML_P + 32 * nt + r];
                acc[nt] = __builtin_amdgcn_mfma_f32_32x32x16_bf16(a, b, acc[nt], 0, 0, 0); } }
        bf16* Uo = U + ((size_t)(h * 128 + c) * 256 + 32 * w) * 256;
#pragma unroll
        for (int nt = 0; nt < 8; ++nt)
#pragma unroll
            for (int q = 0; q < 16; ++q) { const int vl = (q & 3) + 8 * (q >> 2) + 4 * hg; Uo[(size_t)vl * 256 + 32 * nt + r] = f2bf(acc[nt][q]); }
        if (F.tid < 256) { float s = 0.f;
            for (int ss = 0; ss < 64; ++ss) s += wst[ss] * bf2f(Ks[ss * ML_P + F.tid]);
            NU[(size_t)(h * 128 + c) * 256 + F.tid] = s; }
    }
}
__device__ __forceinline__ void p_mlscan(const Frame& F) {
    bf16* U = WSP(bf16, R_U); float* NU = WSP(float, WS_SMALL + SM_NU); const float* WCARRY = WSP(float, WS_SMALL + SM_WCARRY);
    const int gt = F.gw * 64 + F.lane, NGT = F.NGW * 64;
    for (int it = gt; it < NH_M * 65536 / 4; it += NGT) { const int h = it >> 14, e = (it & 16383) * 4;
        float C0 = 0.f, C1 = 0.f, C2 = 0.f, C3 = 0.f; bf16* p = U + (size_t)h * 128 * 65536 + e;
#pragma unroll 4
        for (int c = 0; c < 128; ++c) { const u32x2 u = *(const u32x2*)(p + (size_t)c * 65536); const float wc = WCARRY[h * 128 + c];
            u32x2 o; o.x = cvt_pk_bf16(C0, C1); o.y = cvt_pk_bf16(C2, C3); *(u32x2*)(p + (size_t)c * 65536) = o;
            C0 = wc * C0 + bf2f(u.x & 0xffffu); C1 = wc * C1 + bf2f(u.x >> 16); C2 = wc * C2 + bf2f(u.y & 0xffffu); C3 = wc * C3 + bf2f(u.y >> 16); } }
    for (int it = gt; it < NH_M * 256; it += NGT) { const int h = it >> 8, k = it & 255; float n = 0.f; float* p = NU + (size_t)h * 128 * 256 + k;
        for (int c = 0; c < 128; ++c) { const float u = p[c * 256]; p[c * 256] = n; n = WCARRY[h * 128 + c] * n + u; } }
}
__device__ __forceinline__ void p_mlout(const Frame& F, const Args& A) {
    const bf16* QB = WSP(bf16, R_QB); const bf16* KB = WSP(bf16, R_KB); const bf16* VB = WSP(bf16, R_VB); const bf16* CS = WSP(bf16, R_U); const float* NC = WSP(float, WS_SMALL + SM_NU);
    const float* BCUM = WSP(float, WS_SMALL + SM_BCUM); const float* IG = WSP(float, WS_SMALL + SM_IG); const float* MSEQ = WSP(float, WS_SMALL + SM_MSEQ);
    const bf16* PROJ = WSP(bf16, R_PROJ); const float* mhg = A.in[I_MLNG]; bf16* YCAT = WSP(bf16, R_YCAT);
    LAS bf16* Qs = (LAS bf16*)(F.lds + RING_OFF); LAS bf16* Ks = Qs + 64 * ML_P; LAS bf16* Vs = Ks + 64 * ML_P; LAS bf16* Ss = Vs + 64 * ML_P;
    LAS float* fa = (LAS float*)(Ss + 64 * 72); LAS float* bch = fa; LAS float* ich = fa + 64; LAS float* mrow = fa + 128; LAS float* wint = fa + 192; LAS float* rsum = fa + 256  ;
    LAS float* nq = fa + 384; LAS float* nvec = fa + 448  ; LAS float* Hs = (LAS float*)(F.lds + RING_OFF);
    const int lane = F.lane, r = lane & 31, hg = lane >> 5, w = F.wave;
    for (int L = F.vcu; L < NH_M * 128; L += F.G) { const int h = L >> 7, c = L & 127;
        __syncthreads();
        ml_stage_chunk(F, QB, h, c, Qs); ml_stage_chunk(F, KB, h, c, Ks); ml_stage_chunk(F, VB, h, c, Vs);
        if (F.tid < 64) { bch[F.tid] = BCUM[h * T + 64 * c + F.tid]; ich[F.tid] = IG[h * T + 64 * c + F.tid]; }
        if (F.tid < 256) nvec[F.tid] = NC[(size_t)(h * 128 + c) * 256 + F.tid];
        const float mc = MSEQ[h * 128 + c];
        __syncthreads();
        if (w == 0) { float g = ich[lane] - bch[lane];
#pragma unroll
            for (int o = 1; o < 64; o <<= 1) { const float x = __shfl_up(g, o); if (lane >= o) g = fmaxf(g, x); }
            const float mr = bch[lane] + fmaxf(mc, g); mrow[lane] = mr; wint[lane] = __expf(bch[lane] + mc - mr); }
        if (w == 1) { float s = 0.f;
            for (int k = 0; k < 256; ++k) s += nvec[k] * bf2f(Qs[lane * ML_P + k]);
            nq[lane] = s; }
        __syncthreads();
        if (w < 4) { const int st = w & 1, lt = w >> 1; f32x16 acc = f32x16{};
#pragma unroll
            for (int ks = 0; ks < 16; ++ks) { const bf16x8 a = *(const LAS bf16x8*)(Ks + (32 * st + r) * ML_P + 16 * ks + 8 * hg), b = *(const LAS bf16x8*)(Qs + (32 * lt + r) * ML_P + 16 * ks + 8 * hg);
                acc = __builtin_amdgcn_mfma_f32_32x32x16_bf16(a, b, acc, 0, 0, 0); }
            const int l = 32 * lt + r; const float bl_ = bch[l], mr = mrow[l]; float rs = 0.f;
#pragma unroll
            for (int g4 = 0; g4 < 4; ++g4) { float v4[4];
#pragma unroll
                for (int i = 0; i < 4; ++i) { const int s = 32 * st + 8 * g4 + 4 * hg + i; const float d = bl_ - bch[s] + ich[s] - mr;
                    v4[i] = (s <= l) ? acc[4 * g4 + i] * __expf(d) : 0.f; rs += v4[i]; }
                u32x2 p; p.x = cvt_pk_bf16(v4[0], v4[1]); p.y = cvt_pk_bf16(v4[2], v4[3]);
                *(LAS u32x2*)(Ss + l * 72 + 32 * st + 8 * g4 + 4 * hg) = p; }
            rs += __shfl_xor(rs, 32);
            if (hg == 0) rsum[st * 64 + l] = rs; }
        __syncthreads();
        const int lt = w & 1, vg = w >> 1; f32x16 ai[2], aa[2]; ai[0] = f32x16{}; ai[1] = f32x16{}; aa[0] = f32x16{}; aa[1] = f32x16{};
        const bf16* Cb = CS + (size_t)(h * 128 + c) * 65536;
#pragma unroll 4
        for (int ks = 0; ks < 16; ++ks) { const bf16x8 a = *(const LAS bf16x8*)(Qs + (32 * lt + r) * ML_P + 16 * ks + 8 * hg);
#pragma unroll
            for (int jt = 0; jt < 2; ++jt) { const bf16x8 b = *(const bf16x8*)(Cb + (size_t)(64 * vg + 32 * jt + r) * 256 + 16 * ks + 8 * hg);
                ai[jt] = __builtin_amdgcn_mfma_f32_32x32x16_bf16(a, b, ai[jt], 0, 0, 0); } }
#pragma unroll
        for (int ks = 0; ks < 4; ++ks) { const bf16x8 a = *(const LAS bf16x8*)(Ss + (32 * lt + r) * 72 + 16 * ks + 8 * hg);
#pragma unroll
            for (int jt = 0; jt < 2; ++jt) { bf16x8 b;
#pragma unroll
                for (int jj = 0; jj < 8; ++jj) b[jj] = (short)Vs[(16 * ks + 8 * hg + jj) * ML_P + 64 * vg + 32 * jt + r];
                aa[jt] = __builtin_amdgcn_mfma_f32_32x32x16_bf16(a, b, aa[jt], 0, 0, 0); } }
        __syncthreads();
#pragma unroll
        for (int q = 0; q < 16; ++q) { const int l = 32 * lt + (q & 3) + 8 * (q >> 2) + 4 * hg; const float wi = wint[l];
            const float den = rsum[l] + rsum[64 + l] + wi * nq[l]; const float dn = 1.0f / fmaxf(fabsf(den), __expf(-mrow[l]));
#pragma unroll
            for (int jt = 0; jt < 2; ++jt) Hs[l * 260 + 64 * vg + 32 * jt + r] = (aa[jt][q] + wi * ai[jt][q]) * dn; }
        __syncthreads();
        for (int i = 0; i < 8; ++i) { const int l = 8 * w + i, t = 64 * c + l; const f32x4 hv = *(const LAS f32x4*)(Hs + l * 260 + 4 * lane);
            const float ss = wave_sum((hv[0] * hv[0] + hv[1] * hv[1]) + (hv[2] * hv[2] + hv[3] * hv[3])); const float rn = 1.0f / sqrtf(ss * (1.0f / 256.0f) + 1e-6f);
            const f32x4 g = *(const f32x4*)(mhg + 256 * h + 4 * lane); const u32x2 ob = *(const u32x2*)(PROJ + (size_t)t * AB_PAD + 6592 + 256 * h + 4 * lane);
            const float o0 = hv[0] * rn * g[0] * sigmoidf_(bf2f(ob.x & 0xffffu)), o1 = hv[1] * rn * g[1] * sigmoidf_(bf2f(ob.x >> 16));
            const float o2 = hv[2] * rn * g[2] * sigmoidf_(bf2f(ob.y & 0xffffu)), o3 = hv[3] * rn * g[3] * sigmoidf_(bf2f(ob.y >> 16));
            u32x2 p; p.x = cvt_pk_bf16(o0, o1); p.y = cvt_pk_bf16(o2, o3);
            *(u32x2*)(YCAT + (size_t)t * D + 1024 + 256 * h + 4 * lane) = p; }
    }
}

struct XsOrder {
    const bf16* XQ; const bf16* KM; int G, c;
    __device__ __forceinline__ bool next(int i, pg8::Unit& u) const {
        const int L = i * G + c; if (L >= 32 * 4) return false;
        const int pm = L >> 2, hd = L & 3; u.pm = pm; u.pn = 0; u.aux = hd; u.pad = 0;
        u.a = (const char*)(XQ + (size_t)pm * 256 * D + 512 * hd); u.b = (const char*)(KM + 512 * hd); return true;
    }
};
struct XpvOrder {
    const bf16* XP; const bf16* VT; int G, c;
    __device__ __forceinline__ bool next(int i, pg8::Unit& u) const {
        int pm, pn; if (!pg8::static_tile(i, G, c, 32, 8, pm, pn)) return false;
        u.pm = pm; u.pn = pn; u.aux = 0; u.pad = 0;
        u.a = (const char*)(XP + (size_t)pm * 256 * 1024 + 256 * (pn >> 1)); u.b = (const char*)(VT + (size_t)pn * 256 * NMEM); return true;
    }
};
__device__ __forceinline__ void p_xsoftmax(const Frame& F) {
    const float* XS = WSP(float, R_XS); bf16* XP = WSP(bf16, R_XP); const int lane = F.lane;
    for (int t = F.gw; t < T; t += F.NGW)
#pragma unroll
        for (int hd = 0; hd < 4; ++hd) { const f32x4 s = *(const f32x4*)(XS + (size_t)t * 1024 + 256 * hd + 4 * lane);
            const float m = wave_max(fmaxf(fmaxf(s[0], s[1]), fmaxf(s[2], s[3])));
            const float e0 = __expf(s[0] - m), e1 = __expf(s[1] - m), e2 = __expf(s[2] - m), e3 = __expf(s[3] - m);
            const float inv = 1.0f / wave_sum((e0 + e1) + (e2 + e3));
            u32x2 p; p.x = cvt_pk_bf16(e0 * inv, e1 * inv); p.y = cvt_pk_bf16(e2 * inv, e3 * inv);
            *(u32x2*)(XP + (size_t)t * 1024 + 256 * hd + 4 * lane) = p; }
}

__device__ __forceinline__ void p_norm_fpre(const Frame& F, const Args& A) {
    LAS float* Ws = (LAS float*)(F.lds + RING_OFF);
    stage_skinny<16>(F, A.in[I_FOXWIN], FOX_LD, 8192, Ws);
    __syncthreads();
    const float* X = WSP(float, WS_X); bf16* XN = WSP(bf16, WS_XN); float* FPRE = WSP(float, WS_SMALL + SM_FPRE); const float* g = A.in[I_NMIXG] + D;
    for (int t = F.gw; t < T; t += F.NGW) { f32x4 y[8]; rms_row(X + (size_t)t * D, g, XN + (size_t)t * D, F.lane, y);
        float o[16]; skinny_dot<16>(y, Ws, F.lane, o);
        if (F.lane < 16) { float v = o[0];
#pragma unroll
            for (int c = 1; c < 16; ++c) v = (F.lane == c) ? o[c] : v;
            FPRE[t * 16 + F.lane] = v; } }
    __syncthreads();
}
__device__ __forceinline__ void p_foxprep(const Frame& F, const Args& A) {
    bf16* QKVG = WSP(bf16, R_QKVG); const float* qg = A.in[I_FOXQG]; const float* kg = A.in[I_FOXKG]; const int lane = F.lane;
    for (int it = F.gw; it < 2 * T; it += F.NGW) { const int t = it >> 1, sec = it & 1; const float* gg = sec ? kg : qg; const float g0 = gg[2 * lane], g1 = gg[2 * lane + 1];
        unsigned* row = (unsigned*)(QKVG + (size_t)t * 8192 + sec * 2048) + lane;
#pragma unroll 4
        for (int h = 0; h < NH_F; ++h) { const unsigned u = row[64 * h]; const float a = bf2f(u & 0xffffu), b = bf2f(u >> 16);
            const float rn = 1.0f / sqrtf(wave_sum(a * a + b * b) * (1.0f / 128.0f) + 1e-6f);
            row[64 * h] = cvt_pk_bf16(a * rn * g0, b * rn * g1); } }
    if (F.gw < NH_F) { const int h = F.gw; const float* FPRE = WSP(float, WS_SMALL + SM_FPRE); float* BL = WSP(float, WS_SMALL + SM_BIASL2); const float bf = A.in[I_FOXBF][h];
        float carry = 0.f;
        for (int c0 = 0; c0 < 128; c0 += 16) { float v[16];
#pragma unroll
            for (int i = 0; i < 16; ++i) v[i] = FPRE[(size_t)(64 * (c0 + i) + lane) * 16 + h];
#pragma unroll
            for (int i = 0; i < 16; ++i) { float b = logsigmoidf_(v[i] + bf);
#pragma unroll
                for (int o = 1; o < 64; o <<= 1) { const float x = __shfl_up(b, o); if (lane >= o) b += x; }
                b += carry; BL[h * T + 64 * (c0 + i) + lane] = -1.4426950408889634f * b; carry = __shfl(b, 63); } } }
}
__device__ __forceinline__ void p_foxattn(const Frame& F) {
    const bf16* QKVG = WSP(bf16, R_QKVG); bf16* ATTO = WSP(bf16, R_ATTO); const float* BL = WSP(float, WS_SMALL + SM_BIASL2);
    char* lds = (char*)F.ldsg + RING_OFF;
    for (int L = F.vcu; L < 256; L += F.G) { const int h = L >> 4, x = L & 15;
        __syncthreads();
        { float* bl = (float*)(lds + fox::BIAS_OFF); for (int i = F.tid; i < T / 4; i += NWAVES * 64) *(f32x4*)(bl + 4 * i) = *(const f32x4*)(BL + (size_t)h * T + 4 * i); }
        fox::BlockRef b0, b1; const int q0 = x, q1 = 31 - x;
        b0.Q = QKVG + (size_t)q0 * 256 * 8192 + 128 * h; b0.K = QKVG + 2048 + 128 * h; b0.V = QKVG + 4096 + 128 * h; b0.G = QKVG + (size_t)q0 * 256 * 8192 + 6144 + 128 * h;
        b0.O = ATTO + (size_t)q0 * 256 * D + 128 * h; b0.P0 = q0 * 256;
        b1 = b0; b1.Q = QKVG + (size_t)q1 * 256 * 8192 + 128 * h; b1.G = QKVG + (size_t)q1 * 256 * 8192 + 6144 + 128 * h; b1.O = ATTO + (size_t)q1 * 256 * D + 128 * h; b1.P0 = q1 * 256;
        fox::Seam S;
        fox::prime(b0, lds, S);
#ifdef FOX_LOOP
        for (int pass = 0; pass < 2; ++pass) { fox::block(b0, b1, lds, S); b0 = b1; }
#else
        fox::block(b0, b1, lds, S);
        fox::block(b1, b1, lds, S);
#endif
    }
}

__device__ __forceinline__ void p_norm_route(const Frame& F, const Args& A) {
    LAS float* Ws = (LAS float*)(F.lds + RING_OFF); LAS int* cnt = (LAS int*)(F.lds + RING_OFF + 8 * D * 4);
    stage_skinny<8>(F, A.in[I_ROUTER], NEXP, 0, Ws);
    if (F.tid < 8) cnt[F.tid] = 0;
    __syncthreads();
    const float* X = WSP(float, WS_X); bf16* XN = WSP(bf16, WS_XN); const float* g = A.in[I_NFFNG] + D;
    int* TOPI = WSP(int, WS_SMALL + SM_TOPI); float* TOPG = WSP(float, WS_SMALL + SM_TOPG); int* BLKCNT = WSP(int, WS_SMALL + SM_BLKCNT);
    const int b = blockIdx.x;
    for (int i = 0; i < 4; ++i) { const int t = 32 * b + 4 * F.wave + i; f32x4 y[8]; rms_row(X + (size_t)t * D, g, XN + (size_t)t * D, F.lane, y);
        float o[8]; skinny_dot<8>(y, Ws, F.lane, o);
        int i1 = 0; float v1 = o[0];
#pragma unroll
        for (int e = 1; e < 8; ++e) if (o[e] > v1) { v1 = o[e]; i1 = e; }
        int i2 = -1; float v2 = -__builtin_inff();
#pragma unroll
        for (int e = 0; e < 8; ++e) if (e != i1 && o[e] > v2) { v2 = o[e]; i2 = e; }
        const float e2 = __expf(v2 - v1), g1 = 1.0f / (1.0f + e2), g2 = e2 * g1;
        if (F.lane == 0) { TOPI[2 * t] = i1; TOPI[2 * t + 1] = i2; TOPG[2 * t] = g1; TOPG[2 * t + 1] = g2; __hip_atomic_fetch_add(&cnt[i1], 1, __ATOMIC_RELAXED, __HIP_MEMORY_SCOPE_WORKGROUP); __hip_atomic_fetch_add(&cnt[i2], 1, __ATOMIC_RELAXED, __HIP_MEMORY_SCOPE_WORKGROUP); } }
    __syncthreads();
    if (F.tid < 8) BLKCNT[b * 8 + F.tid] = cnt[F.tid];
}
__device__ __forceinline__ void p_route2(const Frame& F) {
    LAS int* sh = (LAS int*)(F.lds + RING_OFF);
    const int* BLKCNT = WSP(int, WS_SMALL + SM_BLKCNT); const int* TOPI = WSP(int, WS_SMALL + SM_TOPI); int* SLOT = WSP(int, WS_SMALL + SM_SLOT); int* TILEE = WSP(int, WS_SMALL + SM_TILEE);
    const bf16* XN = WSP(bf16, WS_XN); bf16* AG = WSP(bf16, R_AG); const int b = blockIdx.x;
    __syncthreads();
    if (F.tid < 8) { int tot = 0, pre = 0; for (int bb = 0; bb < 256; ++bb) { const int v = BLKCNT[bb * 8 + F.tid]; if (bb < b) pre += v; tot += v; } sh[F.tid] = tot; sh[8 + F.tid] = pre; }
    __syncthreads();
    if (F.tid == 0) { int off = 0, nt = 0; for (int e = 0; e < 8; ++e) { sh[16 + e] = off; const int n = (sh[e] + 255) >> 8; if (b == 0) for (int i = 0; i < n; ++i) TILEE[1 + nt + i] = e; nt += n; off += n * 256; } if (b == 0) TILEE[0] = nt; }
    __syncthreads();
    if (F.wave == 0) { const int t = 32 * b + (F.lane >> 1), e = TOPI[2 * t + (F.lane & 1)]; int rank = 0;
#pragma unroll
        for (int ee = 0; ee < 8; ++ee) { const unsigned long long m = __ballot(e == ee); if (e == ee) rank = __popcll(m & ((1ull << F.lane) - 1ull)); }
        const int slot = sh[16 + e] + sh[8 + e] + rank; SLOT[2 * t + (F.lane & 1)] = slot; sh[32 + F.lane] = slot; }
    __syncthreads();
    for (int p = F.wave; p < 64; p += NWAVES) { const int t = 32 * b + (p >> 1), slot = sh[32 + p]; const u32x4* src = (const u32x4*)(XN + (size_t)t * D); u32x4* dst = (u32x4*)(AG + (size_t)slot * D);
#pragma unroll
        for (int j = 0; j < 4; ++j) dst[F.lane + 64 * j] = src[F.lane + 64 * j]; }
}
struct MoeOrder {
    const bf16* Arows; const bf16* W; const int* tilee; int lda, nN; size_t wstride; int G, c;
    __device__ __forceinline__ bool next(int i, pg8::Unit& u) const {
        const int nt = tilee[0]; const long L = (long)i * G + c; if (L >= (long)nt * nN) return false;
        const int ti = (int)(L / nN), pn = (int)(L % nN), e = tilee[1 + ti];
        u.pm = ti; u.pn = pn; u.aux = e; u.pad = 0; u.a = (const char*)(Arows + (size_t)ti * 256 * lda); u.b = (const char*)(W + (size_t)e * wstride + (size_t)pn * 256 * lda); return true;
    }
};
__device__ __forceinline__ void p_final(const Frame& F, const Args& A) {
    const float* X = WSP(float, WS_X); const float* YG = WSP(float, R_YG); const int* SLOT = WSP(int, WS_SMALL + SM_SLOT); const float* TOPG = WSP(float, WS_SMALL + SM_TOPG);
    const float* g = A.in[I_FING]; const int lane = F.lane;
    for (int t = F.gw; t < T; t += F.NGW) { const int s1 = SLOT[2 * t], s2 = SLOT[2 * t + 1]; const float g1 = TOPG[2 * t], g2 = TOPG[2 * t + 1];
        const f32x4* xr = (const f32x4*)(X + (size_t)t * D) + lane; const f32x4* y1 = (const f32x4*)(YG + (size_t)s1 * D) + lane; const f32x4* y2 = (const f32x4*)(YG + (size_t)s2 * D) + lane;
        f32x4 v[8]; float s = 0.f;
#pragma unroll
        for (int j = 0; j < 8; ++j) { v[j] = xr[64 * j] + (y1[64 * j] * g1 + y2[64 * j] * g2); s += (v[j][0] * v[j][0] + v[j][1] * v[j][1]) + (v[j][2] * v[j][2] + v[j][3] * v[j][3]); }
        const float r = 1.0f / sqrtf(wave_sum(s) * (1.0f / D) + 1e-6f); f32x4* o = (f32x4*)(A.out + (size_t)t * D) + lane;
#pragma unroll
        for (int j = 0; j < 8; ++j) o[64 * j] = v[j] * r * ((const f32x4*)g)[lane + 64 * j]; }
}

enum Phase { PH_CONV = 0, PH_INPROJ0, PH_PREPA, PH_LORA, PH_PREPB, PH_SCAN, PH_MLU, PH_MLSCAN, PH_MLOUT, PH_OUTPROJ0,
             PH_NORMX0, PH_XQ0, PH_XS0, PH_XSM0, PH_XPV0, PH_XO0, PH_NORMF0, PH_FFNGU, PH_FFND,
             PH_NORMM1, PH_FOXIN, PH_FOXPREP, PH_FOXATT, PH_FOXOUT,
             PH_NORMX1, PH_XQ1, PH_XS1, PH_XSM1, PH_XPV1, PH_XO1, PH_NORMF1, PH_ROUTE2, PH_MOEGU, PH_MOED, PH_FINAL, N_PHASES };

__global__ void __launch_bounds__(NWAVES * 64, 2) trunk_fwd(Args A) {
    extern __shared__ __attribute__((aligned(16))) unsigned char lds[];
    Frame F;
    F.lds = (LAS unsigned char*)lds; F.ldsg = lds; F.ws = A.ws;
    F.tid = threadIdx.x; F.lane = F.tid & 63; F.wave = __builtin_amdgcn_readfirstlane(F.tid >> 6);
    F.G = gridDim.x; { const int bx = blockIdx.x; F.vcu = (F.G % 8 == 0) ? (bx % 8) * (F.G / 8) + bx / 8 : bx; }
    F.gw = F.vcu * NWAVES + F.wave; F.NGW = F.G * NWAVES;
    volatile LAS unsigned* MISC = (volatile LAS unsigned*)(F.lds + MISC_OFF);
    for (int u = F.tid; u < (LDS_BYTES - LDSCTL_OFF) / 4; u += NWAVES * 64) ((LAS unsigned*)(F.lds + LDSCTL_OFF))[u] = 0u;
    __syncthreads();
    const int lo = A.ph_lo, hi = A.ph_hi;
    const bool multi = (hi - lo) > 1;
    XcdBarrier bar; bar.bar = (unsigned*)(A.ws + WS_CTL) + CW_BAR; bar.x = 0; bar.st = nullptr;
    if (multi) bar = xcd_barrier_post((unsigned*)(A.ws + WS_CTL) + CW_BAR, MISC + 8);
#ifndef PH_ENABLE
#define PH_ENABLE 0xFFFFFFFFFFFFFFFFull
#endif
#define IN(k) ((((PH_ENABLE) >> (k)) & 1ull) && lo <= (k) && (k) < hi)
#define SEAM(k) do { if (IN(k) && IN((k) + 1)) xcd_barrier(bar); } while (0)
    LAS unsigned char* ring = F.lds + RING_OFF;
    const int cb = (int)blockIdx.x;

    if (IN(PH_CONV)) { p_convert_early(F, A); } SEAM(PH_CONV);
    if (IN(PH_INPROJ0)) { InprojKvOrder S{WSP(bf16, WS_XN), WSP(bf16, WS_W_ABIN), WSP(bf16, WS_MEMN), WSP(bf16, WS_W_XKV), F.G, cb};
        EpiInprojKv E{WSP(bf16, R_PROJ), WSP(float, R_GATES32), WSP(bf16, WS_KMEM), WSP(bf16, WS_VTMEM)};
        pg8::gemm_phase<EpiInprojKv, InprojKvOrder, true>(ring, pg8::Gemm{D, D, D}, S, E); } SEAM(PH_INPROJ0);
    if (IN(PH_PREPA)) { p_prepa(F, A); } SEAM(PH_PREPA);
    if (IN(PH_LORA)) { pg8::PlainOrder S{WSP(bf16, R_LORAIN), WSP(bf16, WS_W_LORA), 512, 512, 32, 12, F.G, cb}; pg8::EpiF32 E{WSP(float, R_LORAOUT), 3072, 0, 1.0f};
        pg8::gemm_phase<pg8::EpiF32, pg8::PlainOrder, true>(ring, pg8::Gemm{512, 512, 512}, S, E); } SEAM(PH_LORA);
    if (IN(PH_PREPB)) { p_prepb(F, A); } SEAM(PH_PREPB);
    if (IN(PH_SCAN)) {
        if (F.wave == 0) p_scan(F);
        else p_convert_late(F, A, F.vcu * (NWAVES - 1) + F.wave - 1, F.G * (NWAVES - 1), (LAS float*)(F.lds + RING_OFF + SC_LDS + (F.wave - 1) * 8448)); } SEAM(PH_SCAN);
    if (IN(PH_MLU)) { p_mlu(F); } SEAM(PH_MLU);
    if (IN(PH_MLSCAN)) { p_mlscan(F); p_rwkv_post(F, A); } SEAM(PH_MLSCAN);
    if (IN(PH_MLOUT)) { p_mlout(F, A); } SEAM(PH_MLOUT);
    if (IN(PH_OUTPROJ0)) { pg8::PlainOrder S{WSP(bf16, R_YCAT), WSP(bf16, WS_W_ABOUT), D, D, 32, 8, F.G, cb}; pg8::EpiResid E{A.in[I_X], WSP(float, WS_X), D};
        pg8::gemm_phase<pg8::EpiResid, pg8::PlainOrder, false>(ring, pg8::Gemm{D, D, D}, S, E); } SEAM(PH_OUTPROJ0);
#define XATTN(l, P_NORM, P_Q, P_S, P_SM, P_PV, P_O) \
    if (IN(P_NORM)) { norm_phase(F, WSP(float, WS_X), A.in[I_NXAG] + (l) * D, WSP(bf16, WS_XN), T); } SEAM(P_NORM); \
    if (IN(P_Q)) { pg8::PlainOrder S{WSP(bf16, WS_XN), WSP(bf16, WS_W_XQ) + (size_t)(l) * D * D, D, D, 32, 8, F.G, cb}; pg8::EpiBf16 E{WSP(bf16, R_XQ), D, nullptr, -1}; \
        pg8::gemm_phase<pg8::EpiBf16, pg8::PlainOrder, false>(ring, pg8::Gemm{D, D, D}, S, E); } SEAM(P_Q); \
    if (IN(P_S)) { XsOrder S{WSP(bf16, R_XQ), WSP(bf16, WS_KMEM) + (size_t)(l) * NMEM * D, F.G, cb}; pg8::EpiF32 E{WSP(float, R_XS), 1024, 256, 0.044194173824159216f}; \
        pg8::gemm_phase<pg8::EpiF32, XsOrder, false>(ring, pg8::Gemm{D, D, 512}, S, E); } SEAM(P_S); \
    if (IN(P_SM)) { p_xsoftmax(F); } SEAM(P_SM); \
    if (IN(P_PV)) { XpvOrder S{WSP(bf16, R_XP), WSP(bf16, WS_VTMEM) + (size_t)(l) * D * NMEM, F.G, cb}; pg8::EpiBf16 E{WSP(bf16, R_XO), D, nullptr, -1}; \
        pg8::gemm_phase<pg8::EpiBf16, XpvOrder, false>(ring, pg8::Gemm{1024, NMEM, 256}, S, E); } SEAM(P_PV); \
    if (IN(P_O)) { pg8::PlainOrder S{WSP(bf16, R_XO), WSP(bf16, WS_W_XO) + (size_t)(l) * D * D, D, D, 32, 8, F.G, cb}; pg8::EpiResid E{WSP(float, WS_X), WSP(float, WS_X), D}; \
        pg8::gemm_phase<pg8::EpiResid, pg8::PlainOrder, false>(ring, pg8::Gemm{D, D, D}, S, E); } SEAM(P_O);

    XATTN(0, PH_NORMX0, PH_XQ0, PH_XS0, PH_XSM0, PH_XPV0, PH_XO0)
    if (IN(PH_NORMF0)) { norm_phase(F, WSP(float, WS_X), A.in[I_NFFNG], WSP(bf16, WS_XN), T); } SEAM(PH_NORMF0);
    if (IN(PH_FFNGU)) { pg8::PlainOrder S{WSP(bf16, WS_XN), WSP(bf16, WS_W_FFNGU), D, D, 32, 44, F.G, cb}; pg8::EpiSwiGLU E{WSP(bf16, R_ACT), DFF};
        pg8::gemm_phase<pg8::EpiSwiGLU, pg8::PlainOrder, true>(ring, pg8::Gemm{D, D, D}, S, E); } SEAM(PH_FFNGU);
    if (IN(PH_FFND)) { pg8::PlainOrder S{WSP(bf16, R_ACT), WSP(bf16, WS_W_FFND), DFF, DFF, 32, 8, F.G, cb}; pg8::EpiResid E{WSP(float, WS_X), WSP(float, WS_X), D};
        pg8::gemm_phase<pg8::EpiResid, pg8::PlainOrder, false>(ring, pg8::Gemm{DFF, DFF, DFF}, S, E); } SEAM(PH_FFND);
    if (IN(PH_NORMM1)) { p_norm_fpre(F, A); } SEAM(PH_NORMM1);
    if (IN(PH_FOXIN)) { pg8::PlainOrder S{WSP(bf16, WS_XN), WSP(bf16, WS_W_FOXIN), D, D, 32, 32, F.G, cb}; pg8::EpiBf16 E{WSP(bf16, R_QKVG), 8192, nullptr, -1};
        pg8::gemm_phase<pg8::EpiBf16, pg8::PlainOrder, true>(ring, pg8::Gemm{D, D, D}, S, E); } SEAM(PH_FOXIN);
    if (IN(PH_FOXPREP)) { p_foxprep(F, A); } SEAM(PH_FOXPREP);
    if (IN(PH_FOXATT)) { p_foxattn(F); } SEAM(PH_FOXATT);
    if (IN(PH_FOXOUT)) { pg8::PlainOrder S{WSP(bf16, R_ATTO), WSP(bf16, WS_W_FOXOUT), D, D, 32, 8, F.G, cb}; pg8::EpiResid E{WSP(float, WS_X), WSP(float, WS_X), D};
        pg8::gemm_phase<pg8::EpiResid, pg8::PlainOrder, false>(ring, pg8::Gemm{D, D, D}, S, E); } SEAM(PH_FOXOUT);
    XATTN(1, PH_NORMX1, PH_XQ1, PH_XS1, PH_XSM1, PH_XPV1, PH_XO1)
    if (IN(PH_NORMF1)) { p_norm_route(F, A); } SEAM(PH_NORMF1);
    if (IN(PH_ROUTE2)) { p_route2(F); } SEAM(PH_ROUTE2);
    if (IN(PH_MOEGU)) { MoeOrder S{WSP(bf16, R_AG), WSP(bf16, WS_W_MOEGU), WSP(int, WS_SMALL + SM_TILEE), D, 44, (size_t)2 * DFF * D, F.G, cb}; pg8::EpiSwiGLU E{WSP(bf16, R_ACTG), DFF};
        pg8::gemm_phase<pg8::EpiSwiGLU, MoeOrder, true>(ring, pg8::Gemm{D, D, D}, S, E); } SEAM(PH_MOEGU);
    if (IN(PH_MOED)) { MoeOrder S{WSP(bf16, R_ACTG), WSP(bf16, WS_W_MOED), WSP(int, WS_SMALL + SM_TILEE), DFF, 8, (size_t)D * DFF, F.G, cb}; pg8::EpiF32 E{WSP(float, R_YG), D, 0, 1.0f};
        pg8::gemm_phase<pg8::EpiF32, MoeOrder, true>(ring, pg8::Gemm{DFF, DFF, DFF}, S, E); } SEAM(PH_MOED);
    if (IN(PH_FINAL)) { p_final(F, A); }
#undef XATTN
#undef IN
#undef SEAM
}

#ifndef MK_ONE_LAUNCH
#define MK_ONE_LAUNCH 1
#endif
extern "C" void kernel_launch(void* const* d_in, const int* in_sizes, int n_in, void* d_out, int out_size, void* d_ws, size_t ws_size, hipStream_t stream) {
    static int ready = 0;
    if (ready == 0) {
        if (n_in != N_IN || in_sizes[0] != T * D || out_size != T * D || ws_size < WS_END) {
            fprintf(stderr, "kernel_launch: built for %d inputs, x/out of %d floats, >= %zu bytes of workspace; got n_in %d, in0 %d, out %d, ws %zu; nothing launched\n", N_IN, T * D, (size_t)WS_END, n_in, n_in > 0 ? in_sizes[0] : -1, out_size, ws_size);
            ready = -1; return; }
        if (hipFuncSetAttribute((const void*)trunk_fwd, hipFuncAttributeMaxDynamicSharedMemorySize, LDS_BYTES) != hipSuccess) { fprintf(stderr, "kernel_launch: hipFuncSetAttribute failed\n"); ready = -1; return; }
        int per_cu = 0;
        if (hipOccupancyMaxActiveBlocksPerMultiprocessor(&per_cu, (const void*)trunk_fwd, NWAVES * 64, LDS_BYTES) != hipSuccess || per_cu < 1)
            fprintf(stderr, "kernel_launch: note: occupancy query reports %d workgroups per CU\n", per_cu);
        (void)hipGetLastError();
        ready = 1;
    }
    if (ready < 0) return;
    const int grid = 256;
    if (hipMemsetAsync((char*)d_ws + WS_CTL, 0, CTL_ZERO_BYTES, stream) != hipSuccess) { fprintf(stderr, "kernel_launch: hipMemsetAsync failed\n"); return; }
    Args a{};
    for (int i = 0; i < N_IN; ++i) a.in[i] = (const float*)d_in[i];
    a.out = (float*)d_out; a.ws = (unsigned char*)d_ws;
#if MK_ONE_LAUNCH
    a.ph_lo = 0; a.ph_hi = N_PHASES;
    hipLaunchKernelGGL(trunk_fwd, dim3(grid), dim3(NWAVES * 64), LDS_BYTES, stream, a);
#else
    for (int p = 0; p < N_PHASES; ++p) { a.ph_lo = p; a.ph_hi = p + 1;
        hipLaunchKernelGGL(trunk_fwd, dim3(grid), dim3(NWAVES * 64), LDS_BYTES, stream, a); }
#endif
    const hipError_t le = hipPeekAtLastError();
    if (le != hipSuccess) fprintf(stderr, "kernel_launch: launch failed: %s\n", hipGetErrorName(le));
}
```

```cpp
#include <hip/hip_runtime.h>
#include <cstdio>
#include <cstdint>

#define GAS __attribute__((address_space(1)))
#define LAS __attribute__((address_space(3)))
typedef unsigned short bf16;
typedef short bf16x8 __attribute__((ext_vector_type(8)));
typedef short s16x4 __attribute__((ext_vector_type(4)));
typedef float f32x2 __attribute__((ext_vector_type(2)));
typedef float f32x4 __attribute__((ext_vector_type(4)));
typedef float f32x16 __attribute__((ext_vector_type(16)));
typedef unsigned u32x2 __attribute__((ext_vector_type(2)));
typedef unsigned u32x4 __attribute__((ext_vector_type(4)));

constexpr int T = 8192, D = 2048, NMEM = 256, DFF = 5632, NEXP = 8;
constexpr int A_COLS = 3520, AB_COLS = 7624, AB_PAD = 7680;
constexpr int FOX_LD = 8208;
constexpr int NH_R = 16, NH_M = 4, NH_F = 16;
constexpr int MOE_ROWS = 72 * 256;

__device__ __forceinline__ float bf2f(unsigned b) { return __uint_as_float(b << 16); }
__device__ __forceinline__ unsigned cvt_pk_bf16(float lo, float hi) { unsigned r; asm volatile("v_cvt_pk_bf16_f32 %0, %1, %2" : "=v"(r) : "v"(lo), "v"(hi)); return r; }
__device__ __forceinline__ bf16 f2bf(float f) { return (bf16)(cvt_pk_bf16(f, 0.f) & 0xffffu); }
__device__ __forceinline__ float wave_sum(float v) {
#pragma unroll
    for (int o = 1; o < 64; o <<= 1) v += __shfl_xor(v, o);
    return v;
}
__device__ __forceinline__ float wave_max(float v) {
#pragma unroll
    for (int o = 1; o < 64; o <<= 1) v = fmaxf(v, __shfl_xor(v, o));
    return v;
}
__device__ __forceinline__ float wave_sum_dpp(float x) {
#define DPPF_(v, ctrl) __builtin_bit_cast(float, __builtin_amdgcn_update_dpp(0, __builtin_bit_cast(int, v), ctrl, 0xF, 0xF, true))
    x += DPPF_(x, 0xB1); x += DPPF_(x, 0x4E); x += DPPF_(x, 0x141); x += DPPF_(x, 0x140);
#undef DPPF_
    const float a = __builtin_bit_cast(float, __builtin_amdgcn_readlane(__builtin_bit_cast(int, x), 0)), b = __builtin_bit_cast(float, __builtin_amdgcn_readlane(__builtin_bit_cast(int, x), 16));
    const float c = __builtin_bit_cast(float, __builtin_amdgcn_readlane(__builtin_bit_cast(int, x), 32)), d = __builtin_bit_cast(float, __builtin_amdgcn_readlane(__builtin_bit_cast(int, x), 48));
    return (a + b) + (c + d);
}
__device__ __forceinline__ float sigmoidf_(float x) { return 1.0f / (1.0f + __expf(-x)); }
__device__ __forceinline__ float logsigmoidf_(float x) { return fminf(x, 0.f) - log1pf(__expf(-fabsf(x))); }

namespace pg8 {
#define PG8_LAS __attribute__((address_space(3)))
typedef unsigned short bf16_t;
constexpr int BM = 256, BK = 64, HALF = 128, HTB = HALF * BK * 2  , STAGE_BYTES = 8 * HTB, NXCD = 8, WGM = 8;

__host__ __device__ __forceinline__ int lds_byte(int r, int c) { const int st = (r >> 4) * 2 + (c >> 5), rr = r & 15, cc = c & 31, ob = rr * 64 + cc * 2; return st * 1024 + (ob ^ (((ob >> 9) & 1) << 5)); }
__host__ __device__ __forceinline__ void stage_rc(int b, int& R, int& C) { const int st = b / 1024, sb = b % 1024, swz = sb ^ (((sb >> 9) & 1) << 5); R = (st >> 1) * 16 + swz / 64; C = (st & 1) * 32 + (swz % 64) / 2; }
__host__ __device__ __forceinline__ int perm32(int rho) { const int n = rho >> 4, i = rho & 15; return 8 * (i >> 2) + 4 * n + (i & 3); }

struct Unit { const char* a; const char* b; int pm, pn, aux, pad; };
struct Gemm { int lda, ldb, K; };

__device__ __forceinline__ bool static_tile(int i, int G, int c, int nM, int nN, int& pm, int& pn) {
    const int nwg = nM * nN; const long L = (long)i * G + c; if (L >= nwg) return false;
    int wgid = (int)L; { const int q = nwg / NXCD, r = nwg % NXCD, xcd = wgid % NXCD, off = wgid / NXCD; wgid = (xcd < r ? xcd * (q + 1) : r * (q + 1) + (xcd - r) * q) + off; }
    const int nig = WGM * nN, gid = wgid / nig, fm = gid * WGM, gsz = (nM - fm) < WGM ? (nM - fm) : WGM;
    pm = fm + ((wgid % nig) % gsz); pn = (wgid % nig) / gsz; return true;
}
struct PlainOrder {
    const bf16_t* A; const bf16_t* Bt; int lda, ldb, nM, nN, G, c;
    __device__ __forceinline__ bool next(int i, Unit& u) const {
        int pm, pn; if (!static_tile(i, G, c, nM, nN, pm, pn)) return false;
        u.pm = pm; u.pn = pn; u.aux = 0; u.pad = 0; u.a = (const char*)(A + (size_t)pm * BM * lda); u.b = (const char*)(Bt + (size_t)pn * BM * ldb); return true;
    }
};

struct EpiF32 {
    static constexpr bool PERM = false;
    float* C; int ldc; int aux_cols; float scale;
    __device__ __forceinline__ void operator()(const f32x4 (&acc)[2][2][4][2], const Unit& u, int wr, int wc, int fr, int fq) const {
        const int row0 = u.pm * BM + wr * 64 + fr, col0 = u.pn * BM + u.aux * aux_cols + wc * 32 + 4 * fq;
#pragma unroll
        for (int ai = 0; ai < 2; ++ai)
#pragma unroll
            for (int m = 0; m < 4; ++m) { float* rowp = C + (size_t)(row0 + ai * HALF + m * 16) * ldc + col0;
#pragma unroll
                for (int bj = 0; bj < 2; ++bj)
#pragma unroll
                    for (int n = 0; n < 2; ++n) *(f32x4*)(rowp + bj * HALF + n * 16) = acc[ai][bj][m][n] * scale; }
    }
};
struct EpiF32Split {
    static constexpr bool PERM = false;
    float* C; float* side; size_t side_stride; int ldc; int pm0;
    __device__ __forceinline__ void operator()(const f32x4 (&acc)[2][2][4][2], const Unit& u, int wr, int wc, int fr, int fq) const {
        float* base = u.aux == 0 ? C + (size_t)u.pm * BM * ldc : side + (size_t)(u.aux - 1) * side_stride + (size_t)(u.pm - pm0) * BM * ldc;
        const int row0 = wr * 64 + fr, col0 = u.pn * BM + wc * 32 + 4 * fq;
#pragma unroll
        for (int ai = 0; ai < 2; ++ai)
#pragma unroll
            for (int m = 0; m < 4; ++m) { float* rowp = base + (size_t)(row0 + ai * HALF + m * 16) * ldc + col0;
#pragma unroll
                for (int bj = 0; bj < 2; ++bj)
#pragma unroll
                    for (int n = 0; n < 2; ++n) *(f32x4*)(rowp + bj * HALF + n * 16) = acc[ai][bj][m][n]; }
    }
};
struct EpiResid {
    static constexpr bool PERM = false;
    const float* base; float* out; int ldc;
    __device__ __forceinline__ void operator()(const f32x4 (&acc)[2][2][4][2], const Unit& u, int wr, int wc, int fr, int fq) const {
        const int row0 = u.pm * BM + wr * 64 + fr, col0 = u.pn * BM + wc * 32 + 4 * fq;
#pragma unroll
        for (int ai = 0; ai < 2; ++ai)
#pragma unroll
            for (int m = 0; m < 4; ++m) { const size_t off = (size_t)(row0 + ai * HALF + m * 16) * ldc + col0;
#pragma unroll
                for (int bj = 0; bj < 2; ++bj)
#pragma unroll
                    for (int n = 0; n < 2; ++n) { const f32x4 b = *(const f32x4*)(base + off + bj * HALF + n * 16); *(f32x4*)(out + off + bj * HALF + n * 16) = b + acc[ai][bj][m][n]; } }
    }
};
struct EpiBf16 {
    static constexpr bool PERM = true;
    bf16_t* O; int ldc; float* side; int side_pn;
    __device__ __forceinline__ void operator()(const f32x4 (&acc)[2][2][4][2], const Unit& u, int wr, int wc, int fr, int fq) const {
        const int row0 = u.pm * BM + wr * 64 + fr, col0 = u.pn * BM + wc * 32 + 8 * fq;
#pragma unroll
        for (int ai = 0; ai < 2; ++ai)
#pragma unroll
            for (int m = 0; m < 4; ++m) { bf16_t* rowp = O + (size_t)(row0 + ai * HALF + m * 16) * ldc + col0;
#pragma unroll
                for (int bj = 0; bj < 2; ++bj) { const f32x4 v0 = acc[ai][bj][m][0], v1 = acc[ai][bj][m][1];
                    u32x4 w; w.x = cvt_pk_bf16(v0[0], v0[1]); w.y = cvt_pk_bf16(v0[2], v0[3]); w.z = cvt_pk_bf16(v1[0], v1[1]); w.w = cvt_pk_bf16(v1[2], v1[3]);
                    *(u32x4*)(rowp + bj * HALF) = w; } }
        if (side != nullptr && u.pn == side_pn) {
#pragma unroll
            for (int ai = 0; ai < 2; ++ai)
#pragma unroll
                for (int m = 0; m < 4; ++m) { float* rowp = side + (size_t)(row0 + ai * HALF + m * 16) * 256 + wc * 32 + 8 * fq;
#pragma unroll
                    for (int bj = 0; bj < 2; ++bj) { *(f32x4*)(rowp + bj * HALF) = acc[ai][bj][m][0]; *(f32x4*)(rowp + bj * HALF + 4) = acc[ai][bj][m][1]; } }
        }
    }
};
struct EpiSwiGLU {
    static constexpr bool PERM = true;
    bf16_t* O; int ldc;
    __device__ __forceinline__ void operator()(const f32x4 (&acc)[2][2][4][2], const Unit& u, int wr, int wc, int fr, int fq) const {
        const int row0 = u.pm * BM + wr * 64 + fr, col0 = u.pn * HALF + wc * 32 + 8 * fq;
#pragma unroll
        for (int ai = 0; ai < 2; ++ai)
#pragma unroll
            for (int m = 0; m < 4; ++m) { bf16_t* rowp = O + (size_t)(row0 + ai * HALF + m * 16) * ldc + col0;
                float o[8];
#pragma unroll
                for (int n = 0; n < 2; ++n)
#pragma unroll
                    for (int j = 0; j < 4; ++j) { const float g = acc[ai][0][m][n][j], up = acc[ai][1][m][n][j];
                        o[n * 4 + j] = g * __builtin_amdgcn_rcpf(1.0f + __builtin_amdgcn_exp2f(-1.4426950408889634f * g)) * up; }
                u32x4 w; w.x = cvt_pk_bf16(o[0], o[1]); w.y = cvt_pk_bf16(o[2], o[3]); w.z = cvt_pk_bf16(o[4], o[5]); w.w = cvt_pk_bf16(o[6], o[7]);
                *(u32x4*)rowp = w; }
    }
};

template <class Epi, class Sched, bool ALIGN_EPI>
__device__ __forceinline__ void gemm_phase(PG8_LAS unsigned char* lds, const Gemm g, const Sched& S, const Epi& E) {
    const int tid = threadIdx.x, wid = __builtin_amdgcn_readfirstlane(tid >> 6), lane = tid & 63, wr = wid >> 2, wc = wid & 3, fr = lane & 15, fq = lane >> 4;
    const int K = g.K, nt = K / BK;
    unsigned voffA[2], voffB[2];
#pragma unroll
    for (int i = 0; i < 2; ++i) { int R, C; stage_rc(tid * 16 + i * 8192, R, C); const int Rb = Epi::PERM ? ((R & ~31) + perm32(R & 31)) : R;
        voffA[i] = (unsigned)(R * g.lda + C) * 2u; voffB[i] = (unsigned)(Rb * g.ldb + C) * 2u; }
    const size_t kstep = (size_t)(BK * 2);
    const size_t hstepA = (size_t)HALF * g.lda * 2, hstepB = (size_t)HALF * g.ldb * 2;
    const unsigned ldsw = (unsigned)wid * 1024u;
    const int aoff = lds_byte(wr * 64 + fr, fq * 8), boff = lds_byte(wc * 32 + fr, fq * 8);
#define PG8_SA(b, h) (((b) * 2 + (h)) * HTB)
#define PG8_SB(b, h) ((4 + (b) * 2 + (h)) * HTB)
#define PG8_STAGE(bufoff, gbase, voff) do { _Pragma("unroll") for (int _i = 0; _i < 2; ++_i) \
        __builtin_amdgcn_global_load_lds((const unsigned*)((const char*)(gbase) + (voff)[_i]), (PG8_LAS unsigned*)(lds + (bufoff) + ldsw + _i * 8192), 16, 0, 0); } while (0)
#define PG8_LDA(dst, b, h) do { _Pragma("unroll") for (int m = 0; m < 4; ++m) _Pragma("unroll") for (int k = 0; k < 2; ++k) dst[m][k] = *(const PG8_LAS bf16x8*)(lds + PG8_SA(b, h) + aoff + m * 2048 + k * 1024); } while (0)
#define PG8_LDB(dst, b, h) do { _Pragma("unroll") for (int n = 0; n < 2; ++n) _Pragma("unroll") for (int k = 0; k < 2; ++k) dst[n][k] = *(const PG8_LAS bf16x8*)(lds + PG8_SB(b, h) + boff + n * 2048 + k * 1024); } while (0)
#define PG8_MMA(ai, bj, At, Bt) do { __builtin_amdgcn_s_setprio(1); _Pragma("unroll") for (int m = 0; m < 4; ++m) _Pragma("unroll") for (int n = 0; n < 2; ++n) _Pragma("unroll") for (int k = 0; k < 2; ++k) \
        acc[ai][bj][m][n] = __builtin_amdgcn_mfma_f32_16x16x32_bf16(Bt[n][k], At[m][k], acc[ai][bj][m][n], 0, 0, 0); __builtin_amdgcn_s_setprio(0); } while (0)
#define PG8_WAIT_V(n) asm volatile("s_waitcnt vmcnt(" #n ")" ::: "memory")
#define PG8_WAIT_L(n) asm volatile("s_waitcnt lgkmcnt(" #n ")" ::: "memory")
#define PG8_BAR __builtin_amdgcn_s_barrier()
#define PG8_SCHED __builtin_amdgcn_sched_barrier(0)
    Unit cur, nxt; int ui = 0;
    if (!S.next(0, cur)) return;
    f32x4 acc[2][2][4][2];
#pragma unroll
    for (int a = 0; a < 2; ++a)
#pragma unroll
        for (int b = 0; b < 2; ++b)
#pragma unroll
            for (int m = 0; m < 4; ++m)
#pragma unroll
                for (int n = 0; n < 2; ++n) acc[a][b][m][n] = (f32x4){0.f, 0.f, 0.f, 0.f};
    bf16x8 At[4][2], B0[2][2], B1[2][2];
    const char* cA = cur.a; const char* cB = cur.b;
    PG8_STAGE(PG8_SB(0, 0), cB, voffB); PG8_STAGE(PG8_SB(0, 1), cB + hstepB, voffB); PG8_STAGE(PG8_SA(0, 0), cA, voffA); PG8_STAGE(PG8_SA(0, 1), cA + hstepA, voffA);
    if (wr == 1) PG8_BAR;
    PG8_WAIT_V(2); PG8_BAR;
    PG8_STAGE(PG8_SB(1, 0), cB + kstep, voffB); PG8_STAGE(PG8_SA(1, 0), cA + kstep, voffA); PG8_STAGE(PG8_SB(1, 1), cB + hstepB + kstep, voffB);
    PG8_WAIT_V(6); PG8_BAR;
    for (;;) {
        const bool has_next = S.next(ui + 1, nxt);
        const char* nA = has_next ? nxt.a : cA; const char* nB = has_next ? nxt.b : cB;
        for (int t = 0; t < nt; t += 2) {
            const bool last = (t == nt - 2);
            const char* a1 = cA + (size_t)(t + 1) * kstep;
            const char* a2 = last ? nA : cA + (size_t)(t + 2) * kstep; const char* b2 = last ? nB : cB + (size_t)(t + 2) * kstep;
            const char* a3 = a2 + kstep; const char* b3 = b2 + kstep;
            PG8_LDB(B0, 0, 0); PG8_LDB(B1, 0, 1); PG8_SCHED; PG8_LDA(At, 0, 0); PG8_STAGE(PG8_SA(1, 1), a1 + hstepA, voffA);
            PG8_WAIT_V(8); PG8_WAIT_L(0); PG8_BAR; PG8_MMA(0, 0, At, B0); PG8_MMA(0, 1, At, B1); PG8_BAR; PG8_SCHED;
            PG8_LDA(At, 0, 1); PG8_STAGE(PG8_SB(0, 0), b2, voffB); PG8_STAGE(PG8_SB(0, 1), b2 + hstepB, voffB); PG8_STAGE(PG8_SA(0, 0), a2, voffA);
            PG8_WAIT_V(8); PG8_WAIT_L(0); PG8_BAR; PG8_MMA(1, 0, At, B0); PG8_MMA(1, 1, At, B1); PG8_BAR; PG8_SCHED;
            PG8_LDB(B0, 1, 0); PG8_LDB(B1, 1, 1); PG8_SCHED; PG8_LDA(At, 1, 0); PG8_STAGE(PG8_SA(0, 1), a2 + hstepA, voffA);
            PG8_WAIT_V(8); PG8_WAIT_L(0); PG8_BAR; PG8_MMA(0, 0, At, B0); PG8_MMA(0, 1, At, B1); PG8_BAR; PG8_SCHED;
            PG8_LDA(At, 1, 1); PG8_STAGE(PG8_SB(1, 0), b3, voffB); PG8_STAGE(PG8_SB(1, 1), b3 + hstepB, voffB); PG8_STAGE(PG8_SA(1, 0), a3, voffA);
            PG8_WAIT_V(8); PG8_WAIT_L(0); PG8_BAR; PG8_MMA(1, 0, At, B0); PG8_MMA(1, 1, At, B1); PG8_BAR; PG8_SCHED;
        }
        if constexpr (ALIGN_EPI) { if (wr == 0) PG8_BAR; }
        E(acc, cur, wr, wc, fr, fq);
        if (!has_next) break;
#pragma unroll
        for (int a = 0; a < 2; ++a)
#pragma unroll
            for (int b = 0; b < 2; ++b)
#pragma unroll
                for (int m = 0; m < 4; ++m)
#pragma unroll
                    for (int n = 0; n < 2; ++n) acc[a][b][m][n] = (f32x4){0.f, 0.f, 0.f, 0.f};
        cur = nxt; cA = nA; cB = nB; ++ui;
        if constexpr (ALIGN_EPI) { if (wr == 1) PG8_BAR; }
    }
    PG8_WAIT_V(0);
    if constexpr (!ALIGN_EPI) { if (wr == 0) PG8_BAR; }
    PG8_BAR;
#undef PG8_SA
#undef PG8_SB
#undef PG8_STAGE
#undef PG8_LDA
#undef PG8_LDB
#undef PG8_MMA
#undef PG8_WAIT_V
#undef PG8_WAIT_L
#undef PG8_BAR
#undef PG8_SCHED
}
}

namespace fox {
constexpr int D = 128, LDQ = 8192, LDO = 2048;
constexpr float SCALE = 0.08838834764831845f;
constexpr float THR2 = 8.f * 1.4426950408889634f;
constexpr int NW = 8, QBLK = 32, KVBLK = 64, QB = NW * QBLK;
constexpr int SHM_V = KVBLK * D * 2, SHM_K = KVBLK * D * 2;
constexpr int BIAS_OFF = 2 * SHM_V + 2 * SHM_K + NW * 64 * 4;
constexpr int LDS_BYTES = BIAS_OFF + 8192 * 4;

#define KSWZ(row, colB) ((row) * 256 + ((colB) ^ (((row) & 7) << 4)))
#define SBAR() __builtin_amdgcn_sched_barrier(0)
__device__ __forceinline__ int v_st(int k, int c) { const int kk = (k & ~0xC) | ((k & 4) << 1) | ((k & 8) >> 1); return ((kk >> 3) * 4 + (c >> 5)) * 512 + ((kk & 7) * 32 + (c & 31)) * 2; }
__device__ __forceinline__ int v_rd_base(int lane) { return ((lane & 3) << 3) | (((lane >> 2) & 3) << 6) | (((lane >> 4) & 1) << 5) | (((lane >> 5) & 1) << 8); }
constexpr int v_rd_off(int d0, int ks, int half) { return d0 * 512 + ks * 4096 + half * 2048; }
__device__ __forceinline__ int crow(int r, int hi) { return (r & 3) + 8 * (r >> 2) + 4 * hi; }
__device__ __forceinline__ unsigned cvtpk(float lo, float hi) { unsigned r; asm volatile("v_cvt_pk_bf16_f32 %0, %1, %2" : "=v"(r) : "v"(lo), "v"(hi)); return r; }
__device__ __forceinline__ bf16x8 load8(const bf16* p) { return *reinterpret_cast<const bf16x8*>(p); }
__device__ __forceinline__ void mask_tile(f32x16& p0, f32x16& p1, int dq) {
    const float NEG = -__builtin_inff();
#pragma unroll
    for (int r = 0; r < 16; ++r) {
        const int c = (r & 3) + 8 * (r >> 2);
        if (dq - c < 0) p0[r] = NEG;
        if (dq - c - 32 < 0) p1[r] = NEG;
    }
}
__device__ __forceinline__ void partialSM(f32x16& p0, f32x16& p1, float& m_reg, float& mn, float& alpha, const float* bl) {
    constexpr float C2 = 1.4426950408889634f * SCALE;
#pragma unroll
    for (int a = 0; a < 4; ++a) {
#ifdef FOX_NOBIAS
        const f32x4 b0 = {0,0,0,0}, b1 = {0,0,0,0};
#else
        const f32x4 b0 = *(const f32x4*)(bl + 8 * a), b1 = *(const f32x4*)(bl + 32 + 8 * a);
#endif

#pragma unroll
        for (int i = 0; i < 4; ++i) { p0[4 * a + i] = fmaf(p0[4 * a + i], C2, b0[i]); p1[4 * a + i] = fmaf(p1[4 * a + i], C2, b1[i]); }
        SBAR(); }
    float pmax = p0[0]; for (int r = 1; r < 16; ++r) pmax = fmaxf(pmax, p0[r]); for (int r = 0; r < 16; ++r) pmax = fmaxf(pmax, p1[r]);
    { auto rr = __builtin_amdgcn_permlane32_swap(__float_as_uint(pmax), __float_as_uint(pmax), false, false);
      pmax = fmaxf(__uint_as_float(rr[0]), __uint_as_float(rr[1])); }
    if (__builtin_expect(__all((pmax - m_reg) <= THR2), 1)) { mn = m_reg; alpha = 1.f; }
    else { mn = fmaxf(m_reg, pmax); alpha = __builtin_amdgcn_exp2f(m_reg - mn); m_reg = mn; }
    for (int r = 0; r < 16; ++r) p0[r] = p0[r] - mn; for (int r = 0; r < 16; ++r) p1[r] = p1[r] - mn;
    for (int r = 0; r < 16; ++r) p0[r] = __builtin_amdgcn_exp2f(p0[r]);
}
__device__ __forceinline__ void finishSM(f32x16& p0, f32x16& p1, float alpha, float& l_reg, bf16x8& pa0, bf16x8& pa1, bf16x8& pa2, bf16x8& pa3) {
    for (int r = 0; r < 16; ++r) p1[r] = __builtin_amdgcn_exp2f(p1[r]);
    float ps = 0; for (int r = 0; r < 16; ++r) ps += p0[r]; for (int r = 0; r < 16; ++r) ps += p1[r];
    { auto rr = __builtin_amdgcn_permlane32_swap(__float_as_uint(ps), __float_as_uint(ps), false, false);
      ps = __uint_as_float(rr[0]) + __uint_as_float(rr[1]); }
    l_reg = l_reg * alpha + ps;
#define PK4(P, B_, OUT) do { unsigned a0 = cvtpk(P[B_+0], P[B_+1]), a1 = cvtpk(P[B_+2], P[B_+3]);                          \
        unsigned b0 = cvtpk(P[B_+4], P[B_+5]), b1 = cvtpk(P[B_+6], P[B_+7]);                                             \
        auto r0 = __builtin_amdgcn_permlane32_swap(a0, b0, false, false); auto r1 = __builtin_amdgcn_permlane32_swap(a1, b1, false, false); \
        u32x4 w = {r0[0], r1[0], r0[1], r1[1]}; OUT = *reinterpret_cast<bf16x8*>(&w); } while (0)
    PK4(p0, 0, pa0); PK4(p0, 8, pa1); PK4(p1, 0, pa2); PK4(p1, 8, pa3);
#undef PK4
}
template <int KB>
__device__ __forceinline__ void qkt(f32x16& p0, f32x16& p1, const char* K_lds, int r32, int hi, const bf16x8* qr) {
    p0 = f32x16{}; p1 = f32x16{};
    const char* kb[4];
#pragma unroll
    for (int dd = 0; dd < 4; ++dd) kb[dd] = K_lds + KB * SHM_K + KSWZ(r32, (dd * 16 + hi * 8) * 2);
#pragma unroll
    for (int d0 = 0; d0 < 8; ++d0) { const char* a = kb[d0 & 3] + (d0 >> 2) * 128;
        bf16x8 b0 = *reinterpret_cast<const bf16x8*>(a);
        bf16x8 b1 = *reinterpret_cast<const bf16x8*>(a + 32 * 256);
        p0 = __builtin_amdgcn_mfma_f32_32x32x16_bf16(b0, qr[d0], p0, 0, 0, 0);
        p1 = __builtin_amdgcn_mfma_f32_32x32x16_bf16(b1, qr[d0], p1, 0, 0, 0); }
}
template <int VB>
__device__ __forceinline__ void pv_tile(f32x16* o, int vb0, bf16x8 pa0, bf16x8 pa1, bf16x8 pa2, bf16x8 pa3) {
#define TRRD(dst, off) asm volatile("ds_read_b64_tr_b16 %0, %1 offset:%2" : "=&v"(dst) : "v"(vb0), "i"(off) : "memory")
#define PV_D0(d0) do { s16x4 l0, l1, l2, l3, h0, h1, h2, h3; constexpr int b_ = VB * SHM_V + v_rd_off(d0, 0, 0); \
        TRRD(l0, b_); TRRD(h0, b_ + 2048); TRRD(l1, b_ + 4096); TRRD(h1, b_ + 6144); TRRD(l2, b_ + 8192); TRRD(h2, b_ + 10240); TRRD(l3, b_ + 12288); TRRD(h3, b_ + 14336); \
        asm volatile("s_waitcnt lgkmcnt(0)" ::: "memory"); SBAR();   \
        o[d0] = __builtin_amdgcn_mfma_f32_32x32x16_bf16(pa0, (bf16x8){l0[0], l0[1], l0[2], l0[3], h0[0], h0[1], h0[2], h0[3]}, o[d0], 0, 0, 0);   \
        o[d0] = __builtin_amdgcn_mfma_f32_32x32x16_bf16(pa1, (bf16x8){l1[0], l1[1], l1[2], l1[3], h1[0], h1[1], h1[2], h1[3]}, o[d0], 0, 0, 0);   \
        o[d0] = __builtin_amdgcn_mfma_f32_32x32x16_bf16(pa2, (bf16x8){l2[0], l2[1], l2[2], l2[3], h2[0], h2[1], h2[2], h2[3]}, o[d0], 0, 0, 0);   \
        o[d0] = __builtin_amdgcn_mfma_f32_32x32x16_bf16(pa3, (bf16x8){l3[0], l3[1], l3[2], l3[3], h3[0], h3[1], h3[2], h3[3]}, o[d0], 0, 0, 0); } while (0)
    PV_D0(0); PV_D0(1); PV_D0(2); PV_D0(3);
#undef PV_D0
#undef TRRD
}

struct BlockRef { const bf16* Q; const bf16* K; const bf16* V; const bf16* G; bf16* O; int P0; };
struct Seam { bf16x8 qr[8]; bf16x8 st_v0, st_v1, st_k0, st_k1; };
#define LD8(base, boff) (*reinterpret_cast<const bf16x8*>((const char*)(base) + (boff)))
#define VMW() asm volatile("s_waitcnt vmcnt(0)" ::: "memory")
#define VMWN(n) asm volatile("s_waitcnt vmcnt(%0)" :: "i"(n) : "memory")
#define SLOAD_H(Kp, Vp, k0) do { const char* kb__ = (const char*)(Kp) + (size_t)(k0) * (LDQ * 2); const char* vb__ = (const char*)(Vp) + (size_t)(k0) * (LDQ * 2); \
                         S.st_v0 = LD8(vb__, kvoff); S.st_v1 = LD8(vb__, kvoff + 32u * LDQ * 2u);              \
                         S.st_k0 = LD8(kb__, kvoff); S.st_k1 = LD8(kb__, kvoff + 32u * LDQ * 2u); } while (0)
#define SWRITE_HK(bf) do { *(bf16x8*)(K_lds + (bf) * SHM_K + kws) = S.st_k0; *(bf16x8*)(K_lds + (bf) * SHM_K + kws + 32 * 256) = S.st_k1; } while (0)
#define SWRITE_HV(bf) do { *(bf16x8*)(V_lds + (bf) * SHM_V + vst0) = S.st_v0; *(bf16x8*)(V_lds + (bf) * SHM_V + vst1) = S.st_v1; } while (0)
#define SWRITE_H(bf) do { SWRITE_HV(bf); SWRITE_HK(bf); } while (0)
__device__ __forceinline__ void prime(const BlockRef& cur, char* lds, Seam& S) {
    const int tid = threadIdx.x, wid = __builtin_amdgcn_readfirstlane(tid >> 6), lane = tid & 63, r32 = lane & 31, hi = lane >> 5;
    const int sr = tid >> 4, sc = (tid & 15) * 8, kws = KSWZ(sr, sc * 2); char* K_lds = lds + 2 * SHM_V;
    const unsigned kvoff = (unsigned)(sr * LDQ + sc) * 2u, qoff = (unsigned)((wid * QBLK + r32) * LDQ + hi * 8) * 2u;
    for (int d0 = 0; d0 < 8; ++d0) S.qr[d0] = LD8(cur.Q, qoff + d0 * 32);
    SLOAD_H(cur.K, cur.V, 0); VMW(); SWRITE_HK(0);
    __syncthreads();
}
__device__ __forceinline__ void block(const BlockRef& cur, const BlockRef& nxt, char* lds, Seam& S) {
    const int tid = threadIdx.x, wid = __builtin_amdgcn_readfirstlane(tid >> 6), lane = tid & 63, r32 = lane & 31, hi = lane >> 5;
    const int NT = (cur.P0 + QB - 1) / KVBLK + 1;
    const int qlo = cur.P0 + wid * QBLK, qm = qlo + r32 - 4 * hi;
    char* V_lds = lds; char* K_lds = lds + 2 * SHM_V;
    float* ws = (float*)(lds + 2 * SHM_V + 2 * SHM_K) + wid * 64; float* li_l = ws, * al_l = ws + 32;
    const float* biasl = (const float*)(lds + BIAS_OFF) + 4 * hi;
    float m_reg = -1e30f, l_reg = 0; f32x16 o[4] = {};
    const int sr = tid >> 4, sc = (tid & 15) * 8, vst0 = v_st(sr, sc), vst1 = v_st(32 + sr, sc), kws = KSWZ(sr, sc * 2);
    const unsigned kvoff = (unsigned)(sr * LDQ + sc) * 2u;
    const int vb0 = (int)(uintptr_t)V_lds + v_rd_base(lane);
    const bf16* Kh = cur.K; const bf16* Vh = cur.V;
#define RESC(a) do { if (__any((a) < 1.f)) { if (hi == 0) al_l[r32] = (a); asm volatile("s_waitcnt lgkmcnt(0)" ::: "memory");              \
                     for (int d_ = 0; d_ < 4; ++d_) for (int r = 0; r < 16; ++r) o[d_][r] *= al_l[crow(r, hi)]; } } while (0)
#define KBASE(t) ((t) * KVBLK)
#define MASKT(P0_, P1_, t) do { const int kb_ = KBASE(t); if (kb_ + KVBLK - 1 > qlo) mask_tile(P0_, P1_, qm - kb_); } while (0)
    constexpr int NQL = 8;
#define SEAM_K0() do { VMWN(NQL); SWRITE_HK(0); SBAR(); } while (0)
    f32x16 pA0, pA1, pB0, pB1; float mnA, mnB, alA, alB; bf16x8 pa0, pa1, pa2, pa3;
    SWRITE_HV(0); SBAR();
    if (NT > 1) { SLOAD_H(Kh, Vh, KBASE(1)); }
    SBAR(); qkt<0>(pA0, pA1, K_lds, r32, hi, S.qr);
    MASKT(pA0, pA1, 0); partialSM(pA0, pA1, m_reg, mnA, alA, biasl + KBASE(0));
    if (NT > 1) { VMW(); SWRITE_H(1); }
    __syncthreads();
#define HALF_STEP(PX0, PX1, mnX, alX, PY0, PY1, alY, t, KB, VB, SB) do {                                                      \
        SBAR(); qkt<KB>(PX0, PX1, K_lds, r32, hi, S.qr);                                                                      \
        finishSM(PY0, PY1, alY, l_reg, pa0, pa1, pa2, pa3); SBAR();                                                           \
        if ((t) + 1 < NT) { SLOAD_H(Kh, Vh, KBASE((t) + 1)); SBAR(); }                                                        \
        pv_tile<VB>(o, vb0, pa0, pa1, pa2, pa3); MASKT(PX0, PX1, (t)); partialSM(PX0, PX1, m_reg, mnX, alX, biasl + KBASE(t)); \
        __syncthreads();                                                                                                      \
        if ((t) + 1 < NT) { VMW(); SWRITE_H(SB); }                                                                            \
        RESC(alX); __syncthreads(); } while (0)
    for (int t = 1; t + 1 < NT; t += 2) {
        HALF_STEP(pB0, pB1, mnB, alB, pA0, pA1, alA, t, 1, 0, 0);
        HALF_STEP(pA0, pA1, mnA, alA, pB0, pB1, alB, t + 1, 0, 1, 1);
    }
    const bool even = (NT & 1) == 0;
    if (even) { SBAR(); qkt<1>(pB0, pB1, K_lds, r32, hi, S.qr); SBAR(); }
    SLOAD_H(nxt.K, nxt.V, 0); SBAR();
    { unsigned qoff = (unsigned)((wid * QBLK + r32) * LDQ + hi * 8) * 2u; asm volatile("" : "+v"(qoff));
#pragma unroll
      for (int d0 = 0; d0 < 8; ++d0) S.qr[d0] = LD8(nxt.Q, qoff + d0 * 32); }
    SBAR();
    finishSM(pA0, pA1, alA, l_reg, pa0, pa1, pa2, pa3); SBAR();
    pv_tile<0>(o, vb0, pa0, pa1, pa2, pa3);
    if (even) { MASKT(pB0, pB1, NT - 1); partialSM(pB0, pB1, m_reg, mnB, alB, biasl + KBASE(NT - 1)); __syncthreads(); RESC(alB);
        finishSM(pB0, pB1, alB, l_reg, pa0, pa1, pa2, pa3); SBAR(); pv_tile<1>(o, vb0, pa0, pa1, pa2, pa3); }
    SBAR(); SEAM_K0();
    if (hi == 0) li_l[r32] = l_reg; asm volatile("s_waitcnt lgkmcnt(0)" ::: "memory");
    float rli[16];
#pragma unroll
    for (int r = 0; r < 16; ++r) rli[r] = __builtin_amdgcn_rcpf(li_l[crow(r, hi)]);
    unsigned ooff = (unsigned)((wid * QBLK + 4 * hi) * LDO + r32) * 2u, goff = (unsigned)((wid * QBLK + 4 * hi) * LDQ + r32) * 2u;
    asm volatile("" : "+v"(ooff), "+v"(goff));
#pragma unroll
    for (int r = 0; r < 16; ++r) { const unsigned rr = (unsigned)((r & 3) + 8 * (r >> 2));
#pragma unroll
        for (int d0 = 0; d0 < 4; ++d0) {
#ifdef FOX_NOGATE
            const float gv = 0.f;
#else
            const float gv = bf2f(*(const bf16*)((const char*)cur.G + (goff + rr * (LDQ * 2u) + d0 * 64u)));
#endif

            const float v = o[d0][r] * rli[r] * (1.0f / (1.0f + __expf(-gv)));
            const float vn = __shfl_xor(v, 1);
            if ((r32 & 1) == 0) *(unsigned*)((char*)cur.O + (ooff + rr * (LDO * 2u) + d0 * 64u)) = cvtpk(v, vn); } }
    __syncthreads();
#undef RESC
#undef KBASE
#undef MASKT
#undef SEAM_K0
#undef HALF_STEP
}
#undef LD8
#undef VMW
#undef VMWN
#undef SLOAD_H
#undef SWRITE_HK
#undef SWRITE_HV
#undef SWRITE_H
#undef KSWZ
#undef SBAR
}

constexpr int NWAVES = 8;
constexpr size_t MiB = 1u << 20;
constexpr size_t WS_CTL = 0, CTL_ZERO_BYTES = 1 * MiB;
constexpr size_t WS_MEMN = 1 * MiB;
constexpr size_t WS_KMEM = 2 * MiB;
constexpr size_t WS_VTMEM = 4 * MiB;
constexpr size_t WS_SMALL = 6 * MiB;
constexpr size_t SM_BONUS = 0;
constexpr size_t SM_FPRE = 512 * 1024;
constexpr size_t SM_BIASL2 = 1024 * 1024;
constexpr size_t SM_BCUM = 1536 * 1024;
constexpr size_t SM_IG = SM_BCUM + 128 * 1024;
constexpr size_t SM_WSTATE = SM_IG + 128 * 1024;
constexpr size_t SM_CHBL = SM_WSTATE + 128 * 1024;
constexpr size_t SM_CHMD = SM_CHBL + 4096;
constexpr size_t SM_MSEQ = SM_CHMD + 4096;
constexpr size_t SM_WCARRY = SM_MSEQ + 4096;
constexpr size_t SM_TOPI = 2048 * 1024;
constexpr size_t SM_TOPG = SM_TOPI + 64 * 1024;
constexpr size_t SM_SLOT = SM_TOPG + 64 * 1024;
constexpr size_t SM_BLKCNT = SM_SLOT + 64 * 1024;
constexpr size_t SM_TILEE = SM_BLKCNT + 8192;
constexpr size_t SM_NU = 3 * 1024 * 1024;
constexpr size_t WS_X = 16 * MiB;
constexpr size_t WS_XN = 80 * MiB;
constexpr size_t WS_W_XQ = 112 * MiB, WS_W_XKV = 128 * MiB, WS_W_XO = 160 * MiB, WS_W_ABIN = 176 * MiB, WS_W_LORA = 206 * MiB, WS_W_ABOUT = 209 * MiB,
                 WS_W_FFNGU = 217 * MiB, WS_W_FFND = 261 * MiB, WS_W_FOXIN = 283 * MiB, WS_W_FOXOUT = 315 * MiB, WS_W_MOEGU = 323 * MiB, WS_W_MOED = 675 * MiB;
constexpr size_t WS_R = 851 * MiB;
constexpr size_t R_PROJ = WS_R + 0 * MiB;
constexpr size_t R_GATES32 = WS_R + 120 * MiB;
constexpr size_t R_LORAIN = WS_R + 128 * MiB;
constexpr size_t R_LORAOUT = WS_R + 136 * MiB;
constexpr size_t R_SC = WS_R + 232 * MiB;
constexpr size_t SC_STRIDE = 32 * MiB;
constexpr size_t R_Y = WS_R + 424 * MiB;
constexpr size_t R_QB = WS_R + 456 * MiB, R_KB = WS_R + 472 * MiB, R_VB = WS_R + 488 * MiB;
constexpr size_t R_U = WS_R + 504 * MiB;
constexpr size_t R_YCAT = WS_R + 568 * MiB;
constexpr size_t R_XQ = WS_R + 0 * MiB;
constexpr size_t R_XS = WS_R + 32 * MiB;
constexpr size_t R_XP = WS_R + 64 * MiB;
constexpr size_t R_XO = WS_R + 80 * MiB;
constexpr size_t R_ACT = WS_R + 112 * MiB;
constexpr size_t R_QKVG = WS_R + 200 * MiB;
constexpr size_t R_ATTO = WS_R + 328 * MiB;
constexpr size_t R_AG = WS_R + 0 * MiB;
constexpr size_t R_ACTG = WS_R + 72 * MiB;
constexpr size_t R_YG = WS_R + 270 * MiB;
constexpr size_t R_YSIDE = WS_R + 416 * MiB;
constexpr size_t YSIDE_STRIDE = (size_t)8 * 256 * D;
constexpr size_t WS_END = WS_R + 600 * MiB;
static_assert(R_YG + (size_t)MOE_ROWS * D * 4 <= WS_END && R_ACTG + (size_t)MOE_ROWS * DFF * 2 <= R_YG && R_YCAT + (size_t)T * D * 2 <= WS_END, "ws map");
static_assert(WS_W_MOED + (size_t)NEXP * D * DFF * 2 <= WS_R && WS_W_MOEGU + (size_t)NEXP * 2 * DFF * D * 2 <= WS_W_MOED, "ws map (weights)");
constexpr int CW_BAR = 4096;

constexpr int RING_OFF = 0, RING_BYTES = 131072;
constexpr int LDSCTL_OFF = RING_BYTES, MISC_OFF = LDSCTL_OFF + 320;
constexpr int LDS_BYTES = 147456;

typedef GAS unsigned gu32;
#define RLX_AGENT __ATOMIC_RELAXED, __HIP_MEMORY_SCOPE_AGENT
#define LDS_WAIT() asm volatile("s_waitcnt lgkmcnt(0)" ::: "memory")
#define VM_WAIT() asm volatile("s_waitcnt vmcnt(0)" ::: "memory")

#define XB_TMO      128
#define XB_XCNT(j)  (256  + 64 * (j))
#define XB_XSUB(j)  (1280 + 64 * (j))
#define XB_XGEN(j)  (2304 + 64 * (j))
#define XB_TOP      3328
#define XB_TOPGEN   3392
#define XCD_BAR_WORDS 3456
#define XB_SPIN_CAP (1u << 18)
__device__ __forceinline__ unsigned xb_ld(unsigned* p)              { return __hip_atomic_load(p, __ATOMIC_RELAXED, __HIP_MEMORY_SCOPE_AGENT); }
__device__ __forceinline__ unsigned xb_add(unsigned* p, unsigned v) { return __hip_atomic_fetch_add(p, v, __ATOMIC_RELAXED, __HIP_MEMORY_SCOPE_AGENT); }
__device__ __forceinline__ unsigned xb_xcc_id() { return (unsigned)__builtin_amdgcn_s_getreg((3 << 11) | 20) & 0xFu; }
#define XB_SPIN(cond, bar) do { unsigned _sp = 0; while (cond) { __builtin_amdgcn_s_sleep(1); \
    if ((++_sp & 255u) == 0u) { if (xb_ld(&(bar)[XB_TMO])) break; if (_sp > XB_SPIN_CAP) { atomicAdd(&(bar)[XB_TMO], 1u); break; } } } } while (0)
struct XcdBarrier { unsigned* bar; unsigned x; volatile LAS unsigned* st; };
__device__ __forceinline__ XcdBarrier xcd_barrier_post(unsigned* bar, volatile LAS unsigned* st) {
    XcdBarrier b; b.bar = bar; b.x = xb_xcc_id(); b.st = st;
    if (threadIdx.x == 0) (void)xb_add(&bar[XB_XCNT(b.x)], 1u);
    return b;
}
__device__ __forceinline__ void xcd_barrier_complete(unsigned* bar, unsigned x, unsigned& nloc, unsigned& nx) {
    const unsigned G = gridDim.x * gridDim.y * gridDim.z;
    unsigned sum, cnt, mine, sp = 0u;
    for (;;) {
        sum = 0u; cnt = 0u; mine = 0u;
#pragma unroll
        for (unsigned j = 0; j < 16; ++j) { const unsigned c = xb_ld(&bar[XB_XCNT(j)]); sum += c; cnt += (c > 0u) ? 1u : 0u; mine = (j == x) ? c : mine; }
        if (sum == G) break;
        __builtin_amdgcn_s_sleep(1);
        if ((++sp & 255u) == 0u) { if (xb_ld(&bar[XB_TMO])) break; if (sp > XB_SPIN_CAP) { atomicAdd(&bar[XB_TMO], 1u); break; } }
    }
    nloc = mine > 0u ? mine : 1u; nx = cnt > 0u ? cnt : 1u;
}
__device__ __forceinline__ void xcd_barrier(const XcdBarrier& b) {
    asm volatile("s_waitcnt vmcnt(0)" ::: "memory");
    __syncthreads();
    if (threadIdx.x == 0) {
        unsigned* bar = b.bar;
        __builtin_amdgcn_s_waitcnt(0);
        unsigned nloc = b.st[0], nx = b.st[1];
        if (nloc == 0u) { xcd_barrier_complete(bar, b.x, nloc, nx); b.st[0] = nloc; b.st[1] = nx; }
        const unsigned old = xb_add(&bar[XB_XSUB(b.x)], 1u);
        const unsigned gen = old / nloc;
        if (old + 1u == (gen + 1u) * nloc) {
            __builtin_amdgcn_fence(__ATOMIC_RELEASE, "agent");
            asm volatile("s_waitcnt vmcnt(0)" ::: "memory");
            const unsigned og = xb_add(&bar[XB_TOP], 1u);
            const unsigned tg = og / nx;
            if (og + 1u == (tg + 1u) * nx) xb_add(&bar[XB_TOPGEN], 1u);
            else XB_SPIN(xb_ld(&bar[XB_TOPGEN]) == tg, bar);
            __builtin_amdgcn_fence(__ATOMIC_ACQUIRE, "agent");
            xb_add(&bar[XB_XGEN(b.x)], 1u);
            asm volatile("s_waitcnt vmcnt(0)" ::: "memory");
        } else {
            XB_SPIN(xb_ld(&bar[XB_XGEN(b.x)]) == gen, bar);
            __builtin_amdgcn_fence(__ATOMIC_ACQUIRE, "agent");
            asm volatile("s_waitcnt vmcnt(0)" ::: "memory");
        }
    }
    __syncthreads();
}

struct Frame {
    LAS unsigned char* lds; unsigned char* ldsg;
    unsigned char* ws; const float* const* in; float* out;
    int tid, lane, wave, vcu, G, gw, NGW;
};

enum InIdx { I_X = 0, I_MEM, I_MEMG, I_FING, I_NMIXG, I_NXAG, I_NFFNG, I_XWQ, I_XWKV, I_XWO, I_ABWIN, I_ABMU, I_RWW0, I_RWWUP, I_RWA0, I_RWAUP, I_RWGUP, I_RWKK, I_RWKA, I_RWRK,
             I_RWLNG, I_RWLNB, I_MLCONV, I_MLBIF, I_MLNG, I_ABWOUT, I_FFG, I_FFU, I_FFD, I_FOXWIN, I_FOXBF, I_FOXQG, I_FOXKG, I_FOXWOUT, I_ROUTER, I_MOEG, I_MOEU, I_MOED, N_IN };
struct Args { const float* in[N_IN]; float* out; unsigned char* ws; int ph_lo, ph_hi; };
static_assert(sizeof(Args) == (N_IN + 2) * 8 + 8, "Args has no padding");

#define WSP(T_, off) ((T_*)(F.ws + (off)))

__device__ __forceinline__ void rms_row(const float* xrow, const float* g, bf16* orow, int lane, f32x4 (&y)[8]) {
    const f32x4* xr = (const f32x4*)xrow + lane; const f32x4* gr = (const f32x4*)g + lane;
    float s = 0.f;
#pragma unroll
    for (int j = 0; j < 8; ++j) { y[j] = xr[64 * j]; s += (y[j][0] * y[j][0] + y[j][1] * y[j][1]) + (y[j][2] * y[j][2] + y[j][3] * y[j][3]); }
    const float r = 1.0f / sqrtf(wave_sum(s) * (1.0f / D) + 1e-6f);
#pragma unroll
    for (int j = 0; j < 8; ++j) { const f32x4 gv = gr[64 * j]; y[j] = y[j] * r * gv; }
    if (orow) { u32x2* o8 = (u32x2*)orow + lane;
#pragma unroll
        for (int j = 0; j < 8; ++j) { u32x2 w; w.x = cvt_pk_bf16(y[j][0], y[j][1]); w.y = cvt_pk_bf16(y[j][2], y[j][3]); o8[64 * j] = w; } }
}
__device__ __forceinline__ void norm_phase(const Frame& F, const float* X, const float* g, bf16* XN, int nrows) {
    for (int t = F.gw; t < nrows; t += F.NGW) { f32x4 y[8]; rms_row(X + (size_t)t * D, g, XN + (size_t)t * D, F.lane, y); }
}
template <int NC>
__device__ __forceinline__ void stage_skinny(const Frame& F, const float* W, int ldw, int c0, LAS float* Ws) {
    for (int i = F.tid; i < D * NC; i += NWAVES * 64) { const int e = i / NC, c = i % NC; Ws[c * D + e] = W[(size_t)e * ldw + c0 + c]; }
}
template <int NC>
__device__ __forceinline__ void skinny_dot(const f32x4 (&y)[8], const LAS float* Ws, int lane, float (&out)[NC]) {
#pragma unroll
    for (int c = 0; c < NC; ++c) { float s = 0.f;
#pragma unroll
        for (int j = 0; j < 8; ++j) { const f32x4 w = *(const LAS f32x4*)(Ws + c * D + 256 * j + 4 * lane); s += (y[j][0] * w[0] + y[j][1] * w[1]) + (y[j][2] * w[2] + y[j][3] * w[3]); }
        out[c] = wave_sum(s); }
}

__device__ __forceinline__ void transpose_item(const float* W, int ldw, int k0, int n0, int nvalid, bf16* WT0  , int K, LAS float* scr, int lane) {
#pragma unroll 8
    for (int i = 0; i < 32; ++i) { const int kk = 2 * i + (lane >> 5), n = lane & 31; scr[kk * 33 + n] = (n < nvalid) ? W[(size_t)(k0 + kk) * ldw + n0 + n] : 0.f; }
    LDS_WAIT(); asm volatile("" ::: "memory");
    const int c = lane & 7;
#pragma unroll
    for (int j = 0; j < 4; ++j) { const int n = (lane >> 3) + 8 * j; const LAS float* s = scr + (8 * c) * 33 + n;
        u32x4 o; o.x = cvt_pk_bf16(s[0 * 33], s[1 * 33]); o.y = cvt_pk_bf16(s[2 * 33], s[3 * 33]); o.z = cvt_pk_bf16(s[4 * 33], s[5 * 33]); o.w = cvt_pk_bf16(s[6 * 33], s[7 * 33]);
        if (n < nvalid) *(u32x4*)(WT0 + (size_t)n * K + k0 + 8 * c) = o; }
    LDS_WAIT(); asm volatile("" ::: "memory");
}
__device__ __forceinline__ void transpose_matrix(const Frame& F, int gw, int NGW, const float* W, int ldw, int K, int N, bf16* WT, int mode, int& it0, LAS float* scr) {
    const int nblk = (N + 31) / 32, nitems = (K / 64) * nblk;
    int first = gw - (it0 % NGW); if (first < 0) first += NGW;
    for (int r = first; r < nitems; r += NGW) {
        const int kb = r / nblk, nb = r % nblk, n0 = 32 * nb; const int nvalid = (N - n0) < 32 ? (N - n0) : 32;
        const int drow = mode == 0 ? n0 : ((n0 >> 7) * 256 + (n0 & 127) + (mode == 2 ? 128 : 0));
        transpose_item(W, ldw, 64 * kb, n0, nvalid, WT + (size_t)drow * K, K, scr, F.lane);
    }
    it0 += nitems;
}
__device__ __forceinline__ void p_convert_early(const Frame& F, const Args& A) {
    LAS float* scr = (LAS float*)(F.lds + RING_OFF + F.wave * 16384);
    int it0 = 0;
    for (int l = 0; l < 2; ++l)
        transpose_matrix(F, F.gw, F.NGW, A.in[I_XWKV] + (size_t)l * D * 2 * D, 2 * D, D, 2 * D, WSP(bf16, WS_W_XKV) + (size_t)l * 2 * D * D, 0, it0, scr);
    transpose_matrix(F, F.gw, F.NGW, A.in[I_ABWIN], AB_COLS, D, AB_COLS, WSP(bf16, WS_W_ABIN), 0, it0, scr);
    const int gt = F.gw * 64 + F.lane, NGT = F.NGW * 64;
    { u32x4* z = (u32x4*)(WSP(bf16, WS_W_ABIN) + (size_t)AB_COLS * D); const int n16 = (AB_PAD - AB_COLS) * D * 2 / 16;
      for (int i = gt; i < n16; i += NGT) z[i] = (u32x4){0u, 0u, 0u, 0u}; }
    { bf16* WL = WSP(bf16, WS_W_LORA); const float* wup = A.in[I_RWWUP]; const float* aup = A.in[I_RWAUP]; const float* gup = A.in[I_RWGUP];
      for (int i = gt; i < 3072 * 64; i += NGT) { const int n = i >> 6, k8 = (i & 63) * 8; const int sec = n >> 10, nn = n & 1023; float v[8];
#pragma unroll
          for (int j = 0; j < 8; ++j) { const int k = k8 + j; float x = 0.f;
              if (sec == 0) { if (k < 96) x = wup[(size_t)k * 1024 + nn]; }
              else if (sec == 1) { if (k >= 96 && k < 192) x = aup[(size_t)(k - 96) * 1024 + nn]; }
              else { if (k >= 192 && k < 448) x = gup[(size_t)(k - 192) * 1024 + nn]; }
              v[j] = x; }
          u32x4 o; o.x = cvt_pk_bf16(v[0], v[1]); o.y = cvt_pk_bf16(v[2], v[3]); o.z = cvt_pk_bf16(v[4], v[5]); o.w = cvt_pk_bf16(v[6], v[7]);
          *(u32x4*)(WL + (size_t)n * 512 + k8) = o; } }
    norm_phase(F, A.in[I_MEM], A.in[I_MEMG], WSP(bf16, WS_MEMN), NMEM);
    norm_phase(F, A.in[I_X], A.in[I_NMIXG], WSP(bf16, WS_XN), T);
}
__device__ __forceinline__ void p_convert_late(const Frame& F, const Args& A, int gw, int NGW, LAS float* scr) {
    int it0 = 0;
    transpose_matrix(F, gw, NGW, A.in[I_ABWOUT], D, D, D, WSP(bf16, WS_W_ABOUT), 0, it0, scr);
    for (int l = 0; l < 2; ++l) {
        transpose_matrix(F, gw, NGW, A.in[I_XWQ] + (size_t)l * D * D, D, D, D, WSP(bf16, WS_W_XQ) + (size_t)l * D * D, 0, it0, scr);
        transpose_matrix(F, gw, NGW, A.in[I_XWO] + (size_t)l * D * D, D, D, D, WSP(bf16, WS_W_XO) + (size_t)l * D * D, 0, it0, scr);
    }
    transpose_matrix(F, gw, NGW, A.in[I_FFG], DFF, D, DFF, WSP(bf16, WS_W_FFNGU), 1, it0, scr);
    transpose_matrix(F, gw, NGW, A.in[I_FFU], DFF, D, DFF, WSP(bf16, WS_W_FFNGU), 2, it0, scr);
    transpose_matrix(F, gw, NGW, A.in[I_FFD], D, DFF, D, WSP(bf16, WS_W_FFND), 0, it0, scr);
    transpose_matrix(F, gw, NGW, A.in[I_FOXWIN], FOX_LD, D, 8192, WSP(bf16, WS_W_FOXIN), 0, it0, scr);
    transpose_matrix(F, gw, NGW, A.in[I_FOXWOUT], D, D, D, WSP(bf16, WS_W_FOXOUT), 0, it0, scr);
    for (int e = 0; e < NEXP; ++e) {
        transpose_matrix(F, gw, NGW, A.in[I_MOEG] + (size_t)e * D * DFF, DFF, D, DFF, WSP(bf16, WS_W_MOEGU) + (size_t)e * 2 * DFF * D, 1, it0, scr);
        transpose_matrix(F, gw, NGW, A.in[I_MOEU] + (size_t)e * D * DFF, DFF, D, DFF, WSP(bf16, WS_W_MOEGU) + (size_t)e * 2 * DFF * D, 2, it0, scr);
        transpose_matrix(F, gw, NGW, A.in[I_MOED] + (size_t)e * DFF * D, D, DFF, D, WSP(bf16, WS_W_MOED) + (size_t)e * D * DFF, 0, it0, scr);
    }
}

struct InprojKvOrder {
    const bf16* xn; const bf16* wabin; const bf16* memn; const bf16* wkv; int G, c;
    __device__ __forceinline__ bool next(int i, pg8::Unit& u) const {
        const int L = i * G + c; u.pad = 0;
        if (L < 32 * (AB_PAD / 256)) { int pm, pn; pg8::static_tile(i, G, c, 32, AB_PAD / 256, pm, pn); u.pm = pm; u.pn = pn; u.aux = -1;
            u.a = (const char*)(xn + (size_t)pm * 256 * D); u.b = (const char*)(wabin + (size_t)pn * 256 * D); return true; }
        const int j = L - 32 * (AB_PAD / 256); if (j >= 32) return false;
        const int l = j >> 4, kind = (j >> 3) & 1, idx = j & 7; const bf16* w = wkv + (size_t)l * 2 * D * D;
        if (kind == 0) { u.a = (const char*)memn; u.b = (const char*)(w + (size_t)idx * 256 * D); u.pm = 0; u.pn = idx; }
        else { u.a = (const char*)(w + (size_t)(D + idx * 256) * D); u.b = (const char*)memn; u.pm = idx; u.pn = 0; }
        u.aux = l * 2 + kind; return true;
    }
};
struct EpiInprojKv {
    static constexpr bool PERM = true;
    bf16* proj; float* gates32; bf16* kmem; bf16* vtmem;
    __device__ __forceinline__ void operator()(const f32x4 (&acc)[2][2][4][2], const pg8::Unit& u, int wr, int wc, int fr, int fq) const {
        if (u.aux < 0) { pg8::EpiBf16 E{proj, AB_PAD, gates32, 29}; E(acc, u, wr, wc, fr, fq); }
        else { const int l = u.aux >> 1, kind = u.aux & 1;
            pg8::EpiBf16 E{kind == 0 ? kmem + (size_t)l * NMEM * D : vtmem + (size_t)l * D * NMEM, kind == 0 ? D : NMEM, nullptr, -1};
            E(acc, u, wr, wc, fr, fq); }
    }
};

__device__ __forceinline__ void p_prepa(const Frame& F, const Args& A) {
    const bf16* PROJ = WSP(bf16, R_PROJ); const float* mu = A.in[I_ABMU]; const float* convw = A.in[I_MLCONV];
    bf16* LIN = WSP(bf16, R_LORAIN); bf16* QB = WSP(bf16, R_QB); bf16* KB = WSP(bf16, R_KB); bf16* VB = WSP(bf16, R_VB);
    const int lane = F.lane;
    for (int t = F.gw; t < T; t += F.NGW) {
        const bf16* p0 = PROJ + (size_t)t * AB_PAD;
#pragma unroll
        for (int i = 0; i < 7; ++i) { const int cc = lane + 64 * i, c = 3072 + cc; const float p = bf2f(p0[c]); const float pp = t > 0 ? bf2f(p0[c - AB_PAD]) : 0.f;
            const float s = p + (pp - p) * mu[c]; float o;
            if (cc < 96) o = tanhf(s); else if (cc < 192) o = s; else o = sigmoidf_(s);
            LIN[(size_t)t * 512 + cc] = f2bf(o); }
        LIN[(size_t)t * 512 + 448 + lane] = 0;
#pragma unroll
        for (int i = 0; i < 4; ++i) { const int c = 8 * lane + 512 * i; float acc[8];
#pragma unroll
            for (int j = 0; j < 8; ++j) acc[j] = 0.f;
#pragma unroll
            for (int tap = 0; tap < 4; ++tap) { const int tt = t - 3 + tap; if (tt >= 0) {
                const bf16x8 v = *(const bf16x8*)(PROJ + (size_t)tt * AB_PAD + A_COLS + c); const f32x4 w0 = *(const f32x4*)(convw + tap * 2048 + c), w1 = *(const f32x4*)(convw + tap * 2048 + c + 4);
#pragma unroll
                for (int j = 0; j < 4; ++j) { acc[j] += bf2f((unsigned short)v[j]) * w0[j]; acc[4 + j] += bf2f((unsigned short)v[4 + j]) * w1[j]; } } }
            const float sc = c < 1024 ? 0.0625f : 1.0f; float o[8];
#pragma unroll
            for (int j = 0; j < 8; ++j) o[j] = acc[j] * sigmoidf_(acc[j]) * sc;
            u32x4 w; w.x = cvt_pk_bf16(o[0], o[1]); w.y = cvt_pk_bf16(o[2], o[3]); w.z = cvt_pk_bf16(o[4], o[5]); w.w = cvt_pk_bf16(o[6], o[7]);
            if (c < 1024) *(u32x4*)(QB + (size_t)t * 1024 + c) = w; else *(u32x4*)(KB + (size_t)t * 1024 + c - 1024) = w; }
#pragma unroll
        for (int i = 0; i < 2; ++i) { const int c = 8 * lane + 512 * i; *(u32x4*)(VB + (size_t)t * 1024 + c) = *(const u32x4*)(p0 + 5568 + c); }
    }
    const float* G32 = WSP(float, R_GATES32); const float* bif = A.in[I_MLBIF];
    float* BCUM = WSP(float, WS_SMALL + SM_BCUM); float* IG = WSP(float, WS_SMALL + SM_IG); float* CHBL = WSP(float, WS_SMALL + SM_CHBL); float* CHMD = WSP(float, WS_SMALL + SM_CHMD);
    for (int u = F.gw; u < NH_M * 128; u += F.NGW) { const int h = u >> 7, c = u & 127, t = 64 * c + lane;
        const float ig = G32[(size_t)t * 256 + 192 + h] + bif[h], fg = G32[(size_t)t * 256 + 196 + h] + bif[4 + h];
        float b = logsigmoidf_(fg);
#pragma unroll
        for (int o = 1; o < 64; o <<= 1) { const float x = __shfl_up(b, o); if (lane >= o) b += x; }
        const float bl = __shfl(b, 63); const float md = wave_max(bl - b + ig);
        BCUM[h * T + t] = b; IG[h * T + t] = ig;
        if (lane == 0) { CHBL[u] = bl; CHMD[u] = md; } }
}

__device__ __forceinline__ void p_prepb(const Frame& F, const Args& A) {
    const bf16* PROJ = WSP(bf16, R_PROJ); const float* LOUT = WSP(float, R_LORAOUT); const float* mu = A.in[I_ABMU];
    const float* w0 = A.in[I_RWW0]; const float* a0 = A.in[I_RWA0]; const float* kk_ = A.in[I_RWKK]; const float* ka_ = A.in[I_RWKA]; const float* rk_ = A.in[I_RWRK];
    float* SR = WSP(float, R_SC); float* SW = WSP(float, R_SC + SC_STRIDE); float* SKM = WSP(float, R_SC + 2 * SC_STRIDE); float* SV = WSP(float, R_SC + 3 * SC_STRIDE);
    float* SKK = WSP(float, R_SC + 4 * SC_STRIDE); float* SB = WSP(float, R_SC + 5 * SC_STRIDE); float* BONUS = WSP(float, WS_SMALL + SM_BONUS);
    const int lane = F.lane;
    for (int u = F.gw; u < NH_R * (T / 64); u += F.NGW) { const int h = u & 15, tb = u >> 4, c = 64 * h + lane, t0 = 64 * tb;
        const float mur = mu[c], muk = mu[1024 + c], muv = mu[2048 + c], w0c = w0[c], a0c = a0[c], kkc = kk_[c], kac = ka_[c], rkc = rk_[c];
        float pr = 0.f, pk = 0.f, pv = 0.f;
        if (t0 > 0) { const bf16* pp = PROJ + (size_t)(t0 - 1) * AB_PAD; pr = bf2f(pp[c]); pk = bf2f(pp[1024 + c]); pv = bf2f(pp[2048 + c]); }
        for (int tt = 0; tt < 64; tt += 4) {
            float xr[4], xk[4], xv[4], lw[4], la[4];
#pragma unroll
            for (int i = 0; i < 4; ++i) { const bf16* p0 = PROJ + (size_t)(t0 + tt + i) * AB_PAD; const float* lo = LOUT + (size_t)(t0 + tt + i) * 3072;
                xr[i] = bf2f(p0[c]); xk[i] = bf2f(p0[1024 + c]); xv[i] = bf2f(p0[2048 + c]); lw[i] = lo[c]; la[i] = lo[1024 + c]; }
            float kk[4], km[4], r[4], v[4], a[4], w[4], q1[4], q2[4];
#pragma unroll
            for (int i = 0; i < 4; ++i) { r[i] = xr[i] + (pr - xr[i]) * mur; const float k = xk[i] + (pk - xk[i]) * muk; v[i] = xv[i] + (pv - xv[i]) * muv; pr = xr[i]; pk = xk[i]; pv = xv[i];
                w[i] = __expf(-0.6065306597126334f * sigmoidf_(lw[i] + w0c)); a[i] = sigmoidf_(a0c + la[i]);
                kk[i] = k * kkc; km[i] = k * (1.0f + (a[i] - 1.0f) * kac); q1[i] = kk[i] * kk[i]; q2[i] = r[i] * km[i] * rkc; }
#pragma unroll
            for (int i = 0; i < 4; ++i) { q1[i] = wave_sum_dpp(q1[i]); q2[i] = wave_sum_dpp(q2[i]); }
#pragma unroll
            for (int i = 0; i < 4; ++i) { const float kn = kk[i] / fmaxf(sqrtf(q1[i]), 1e-12f); const size_t o = (size_t)(t0 + tt + i) * 1024 + c;
                SR[o] = r[i]; SW[o] = w[i]; SKM[o] = km[i]; SV[o] = v[i]; SKK[o] = kn; SB[o] = kn * a[i];
                if (lane == 0) BONUS[(t0 + tt + i) * 16 + h] = q2[i]; }
        }
    }
    if (F.gw < NH_M) { const int h = F.gw;
        const float* BCUM = WSP(float, WS_SMALL + SM_BCUM); const float* IG = WSP(float, WS_SMALL + SM_IG); const float* CHBL = WSP(float, WS_SMALL + SM_CHBL); const float* CHMD = WSP(float, WS_SMALL + SM_CHMD);
        float* MSEQ = WSP(float, WS_SMALL + SM_MSEQ); float* WCARRY = WSP(float, WS_SMALL + SM_WCARRY); float* WSTATE = WSP(float, WS_SMALL + SM_WSTATE);
        const float bl0 = CHBL[h * 128 + lane], bl1 = CHBL[h * 128 + 64 + lane], md0 = CHMD[h * 128 + lane], md1 = CHMD[h * 128 + 64 + lane];
        float m = 0.f, mine_in0 = 0.f, mine_in1 = 0.f, mine_out0 = 0.f, mine_out1 = 0.f;
#pragma unroll
        for (int c = 0; c < 128; ++c) { const float bl = __shfl(c < 64 ? bl0 : bl1, c & 63), md = __shfl(c < 64 ? md0 : md1, c & 63);
            const float mn = fmaxf(bl + m, md);
            if ((c & 63) == lane) { if (c < 64) { mine_in0 = m; mine_out0 = mn; } else { mine_in1 = m; mine_out1 = mn; } }
            m = mn; }
        MSEQ[h * 128 + lane] = mine_in0; MSEQ[h * 128 + 64 + lane] = mine_in1;
        WCARRY[h * 128 + lane] = __expf(bl0 + mine_in0 - mine_out0); WCARRY[h * 128 + 64 + lane] = __expf(bl1 + mine_in1 - mine_out1);
        for (int c = 0; c < 128; ++c) { const float bl = __shfl(c < 64 ? bl0 : bl1, c & 63), mo = __shfl(c < 64 ? mine_out0 : mine_out1, c & 63); const int t = 64 * c + lane;
            WSTATE[h * T + t] = __expf(bl - BCUM[h * T + t] + IG[h * T + t] - mo); }
    }
}

__device__ __forceinline__ float row16_sum(float x) {
    x += __builtin_bit_cast(float, __builtin_amdgcn_update_dpp(0, __builtin_bit_cast(int, x), 0xB1, 0xF, 0xF, true));
    x += __builtin_bit_cast(float, __builtin_amdgcn_update_dpp(0, __builtin_bit_cast(int, x), 0x4E, 0xF, 0xF, true));
    x += __builtin_bit_cast(float, __builtin_amdgcn_update_dpp(0, __builtin_bit_cast(int, x), 0x141, 0xF, 0xF, true));
    x += __builtin_bit_cast(float, __builtin_amdgcn_update_dpp(0, __builtin_bit_cast(int, x), 0x140, 0xF, 0xF, true));
    return x;
}
__device__ __forceinline__ void row16_sum2(float& a, float& b) {
#define DPPF(x, ctrl) __builtin_bit_cast(float, __builtin_amdgcn_update_dpp(0, __builtin_bit_cast(int, x), ctrl, 0xF, 0xF, true))
    a += DPPF(a, 0xB1); b += DPPF(b, 0xB1); a += DPPF(a, 0x4E); b += DPPF(b, 0x4E); a += DPPF(a, 0x141); b += DPPF(b, 0x141); a += DPPF(a, 0x140); b += DPPF(b, 0x140);
#undef DPPF
}
constexpr int SCH = 16;
constexpr int SC_VEC = SCH * 256;
constexpr int SC_BUF = 5 * SC_VEC + 1024;
constexpr int SC_NBUF = 3, SC_LDS = SC_NBUF * SC_BUF;
constexpr int SC_NLOAD = 5 * (SCH / 4) + 1;
__device__ __forceinline__ void p_scan(const Frame& F) {
    const int b = blockIdx.x, head = (b & 7) * 2 + ((b >> 3) & 1), rg = b >> 4, lane = F.lane, row = lane >> 4, j = lane & 15;
    const float* SR = WSP(float, R_SC); const float* SW = WSP(float, R_SC + SC_STRIDE); const float* SKM = WSP(float, R_SC + 2 * SC_STRIDE); const float* SV = WSP(float, R_SC + 3 * SC_STRIDE);
    const float* SKK = WSP(float, R_SC + 4 * SC_STRIDE); const float* SB = WSP(float, R_SC + 5 * SC_STRIDE); float* Y = WSP(float, R_Y);
    LAS unsigned char* lds = F.lds + RING_OFF;
    const size_t goff = (size_t)(lane >> 4) * 1024 + head * 64 + (lane & 15) * 4;
    f32x2 St0 = {0.f, 0.f}, St1 = {0.f, 0.f};
#define SC_ISSUE(c_, buf_) do { const size_t t0_ = (size_t)(c_) * SCH * 1024; LAS unsigned char* d_ = lds + (buf_) * SC_BUF; \
        _Pragma("unroll") for (int q = 0; q < SCH / 4; ++q) { const size_t o_ = t0_ + (size_t)q * 4096 + goff; \
            __builtin_amdgcn_global_load_lds((const unsigned*)(SKK + o_), (LAS unsigned*)(d_ + 0 * SC_VEC + q * 1024), 16, 0, 0); \
            __builtin_amdgcn_global_load_lds((const unsigned*)(SW  + o_), (LAS unsigned*)(d_ + 1 * SC_VEC + q * 1024), 16, 0, 0); \
            __builtin_amdgcn_global_load_lds((const unsigned*)(SB  + o_), (LAS unsigned*)(d_ + 2 * SC_VEC + q * 1024), 16, 0, 0); \
            __builtin_amdgcn_global_load_lds((const unsigned*)(SKM + o_), (LAS unsigned*)(d_ + 3 * SC_VEC + q * 1024), 16, 0, 0); \
            __builtin_amdgcn_global_load_lds((const unsigned*)(SR  + o_), (LAS unsigned*)(d_ + 4 * SC_VEC + q * 1024), 16, 0, 0); } \
        { int ts_ = (c_) * SCH + lane; ts_ = ts_ < T ? ts_ : T - 1; \
          __builtin_amdgcn_global_load_lds((const unsigned*)(SV + (size_t)ts_ * 1024 + head * 64 + rg * 4), (LAS unsigned*)(d_ + 5 * SC_VEC), 16, 0, 0); } } while (0)
    constexpr int NCH = T / SCH;
    SC_ISSUE(0, 0); SC_ISSUE(1, 1);
    int buf = 0;
    for (int c = 0; c < NCH; ++c) {
        if (c == 0) asm volatile("s_waitcnt vmcnt(21)" ::: "memory"); else if (c == 1) asm volatile("s_waitcnt vmcnt(22)" ::: "memory");
        else if (c < NCH - 1) asm volatile("s_waitcnt vmcnt(23)" ::: "memory"); else asm volatile("s_waitcnt vmcnt(0)" ::: "memory");
        static_assert(SC_NLOAD == 21, "vmcnt immediates above assume 21 loads per chunk and 1 store per chunk");
        if (c + 2 < NCH) { const int nb = buf >= 1 ? buf - 1 : buf + 2; SC_ISSUE(c + 2, nb); }
        const LAS unsigned char* d = lds + buf * SC_BUF + j * 16;
        const LAS unsigned char* dv = lds + buf * SC_BUF + 5 * SC_VEC + row * 4;
        float ykeep = 0.f;
        f32x2 kkA, kkB, wA, wB, bA, bB, kmA, kmB, rA, rB; float vv;
#define SC_LOAD(s_) do { const f32x4 kk_ = *(const LAS f32x4*)(d + 0 * SC_VEC + (s_) * 256), w_ = *(const LAS f32x4*)(d + 1 * SC_VEC + (s_) * 256), b_ = *(const LAS f32x4*)(d + 2 * SC_VEC + (s_) * 256); \
        const f32x4 km_ = *(const LAS f32x4*)(d + 3 * SC_VEC + (s_) * 256), r_ = *(const LAS f32x4*)(d + 4 * SC_VEC + (s_) * 256); vv = *(const LAS float*)(dv + (s_) * 16); \
        kkA = (f32x2){kk_[0], kk_[1]}; kkB = (f32x2){kk_[2], kk_[3]}; wA = (f32x2){w_[0], w_[1]}; wB = (f32x2){w_[2], w_[3]}; bA = (f32x2){b_[0], b_[1]}; bB = (f32x2){b_[2], b_[3]}; \
        kmA = (f32x2){km_[0], km_[1]}; kmB = (f32x2){km_[2], km_[3]}; rA = (f32x2){r_[0], r_[1]}; rB = (f32x2){r_[2], r_[3]}; } while (0)
        SC_LOAD(0);
        f32x2 rp0 = {0.f, 0.f}, rp1 = {0.f, 0.f};
#pragma unroll
        for (int s = 0; s < SCH; ++s) {
            f32x2 kk0 = kkA, kk1 = kkB, w0 = wA, w1 = wB, b0 = bA, b1 = bB, r0 = rA, r1 = rB, km0 = kmA, km1 = kmB; float v_ = vv;
            asm volatile("" : "+v"(kk0), "+v"(kk1), "+v"(w0), "+v"(w1), "+v"(b0), "+v"(b1), "+v"(r0), "+v"(r1), "+v"(km0), "+v"(km1), "+v"(v_));
            if (s + 1 < SCH) { SC_LOAD(s + 1); }
            __builtin_amdgcn_sched_barrier(0);
            const f32x2 kv0 = km0 * v_, kv1 = km1 * v_;
            f32x2 t = St0 * kk0, u = St0 * rp0; t = St1 * kk1 + t; u = St1 * rp1 + u;
            float ts = t[0] + t[1], us = u[0] + u[1];
            row16_sum2(ts, us);
            if (s > 0) ykeep = (j == s - 1) ? us : ykeep;
            St0 = St0 * w0 + (kv0 - b0 * ts); St1 = St1 * w1 + (kv1 - b1 * ts);
            rp0 = r0; rp1 = r1;
            __builtin_amdgcn_sched_barrier(0);
        }
        { f32x2 u = St0 * rp0; u = St1 * rp1 + u; const float us = row16_sum(u[0] + u[1]); ykeep = (j == SCH - 1) ? us : ykeep; }
#undef SC_LOAD
        Y[(size_t)(c * SCH + j) * 1024 + head * 64 + rg * 4 + row] = ykeep;
        buf = buf == SC_NBUF - 1 ? 0 : buf + 1;
    }
    asm volatile("s_waitcnt vmcnt(0)" ::: "memory");
#undef SC_ISSUE
}

__device__ __forceinline__ void p_rwkv_post(const Frame& F, const Args& A) {
    const float* Y = WSP(float, R_Y); const float* SV = WSP(float, R_SC + 3 * SC_STRIDE); const float* LOUT = WSP(float, R_LORAOUT); const float* BONUS = WSP(float, WS_SMALL + SM_BONUS);
    const float* lng = A.in[I_RWLNG]; const float* lnb = A.in[I_RWLNB]; bf16* YCAT = WSP(bf16, R_YCAT); const int lane = F.lane;
    for (int u = F.gw; u < NH_R * (T / 64); u += F.NGW) { const int h = u & 15, tb = u >> 4, c = 64 * h + lane, t0 = 64 * tb; const float lg = lng[c], lb = lnb[c];
        for (int tt = 0; tt < 64; tt += 4) { float y[4], sv[4], g[4], bo[4], d[4];
#pragma unroll
            for (int i = 0; i < 4; ++i) { const size_t t = t0 + tt + i; y[i] = Y[t * 1024 + c]; sv[i] = SV[t * 1024 + c]; g[i] = LOUT[t * 3072 + 2048 + c]; bo[i] = BONUS[t * 16 + h]; }
#pragma unroll
            for (int i = 0; i < 4; ++i) d[i] = wave_sum_dpp(y[i]);
#pragma unroll
            for (int i = 0; i < 4; ++i) { y[i] -= d[i] * (1.0f / 64.0f); d[i] = y[i] * y[i]; }
#pragma unroll
            for (int i = 0; i < 4; ++i) d[i] = wave_sum_dpp(d[i]);
#pragma unroll
            for (int i = 0; i < 4; ++i) { const float o = (y[i] * (1.0f / sqrtf(d[i] * (1.0f / 64.0f) + 64e-5f)) * lg + lb + bo[i] * sv[i]) * g[i];
                YCAT[(size_t)(t0 + tt + i) * D + c] = f2bf(o); } } }
}

constexpr int ML_P = 264;
__device__ __forceinline__ void ml_stage_chunk(const Frame& F, const bf16* src  , int h, int c, LAS bf16* dst) {
    for (int i = F.tid; i < 64 * 32; i += NWAVES * 64) { const int s = i >> 5, ch = i & 31;
        *(LAS u32x4*)(dst + s * ML_P + 8 * ch) = *(const u32x4*)(src + (size_t)(64 * c + s) * 1024 + 256 * h + 8 * ch); }
}
__device__ __forceinline__ void p_mlu(const Frame& F) {
    const bf16* KB = WSP(bf16, R_KB); const bf16* VB = WSP(bf16, R_VB); const float* WSTATE = WSP(float, WS_SMALL + SM_WSTATE);
    bf16* U = WSP(bf16, R_U); float* NU = WSP(float, WS_SMALL + SM_NU);
    LAS bf16* Ks = (LAS bf16*)(F.lds + RING_OFF); LAS bf16* Vs = Ks + 64 * ML_P; LAS float* wst = (LAS float*)(Vs + 64 * ML_P);
    const int lane = F.lane, r = lane & 31, hg = lane >> 5, w = F.wave;
    for (int L = F.vcu; L < NH_M * 128; L += F.G) { const int h = L >> 7, c = L & 127;
        __syncthreads();
        ml_stage_chunk(F, KB, h, c, Ks); ml_stage_chunk(F, VB, h, c, Vs);
        if (F.tid < 64) wst[F.tid] = WSTATE[h * T + 64 * c + F.tid];
        __syncthreads();
        f32x16 acc[8];
#pragma unroll
        for (int nt = 0; nt < 8; ++nt) acc[nt] = f32x16{};
#pragma unroll
        for (int ks = 0; ks < 4; ++ks) { bf16x8 a; float av[8];
#pragma unroll
            for (int jj = 0; jj < 8; ++jj) { const int s = 16 * ks + 8 * hg + jj; av[jj] = bf2f(Vs[s * ML_P + 32 * w + r]) * wst[s]; }
            { u32x4 p; p.x = cvt_pk_bf16(av[0], av[1]); p.y = cvt_pk_bf16(av[2], av[3]); p.z = cvt_pk_bf16(av[4], av[5]); p.w = cvt_pk_bf16(av[6], av[7]); a = __builtin_bit_cast(bf16x8, p); }
#pragma unroll
            for (int nt = 0; nt < 8; ++nt) { bf16x8 b;
#pragma unroll
                for (int jj = 0; jj < 8; ++jj) b[jj] = (short)Ks[(16 * ks + 8 * hg + jj) * ML_P + 32 * nt + r];
                acc[nt] = __builtin_amdgcn_mfma_f32_32x32x16_bf16(a, b, acc[nt], 0, 0, 0); } }
        bf16* Uo = U + ((size_t)(h * 128 + c) * 256 + 32 * w) * 256;
#pragma unroll
        for (int nt = 0; nt < 8; ++nt)
#pragma unroll
            for (int q = 0; q < 16; ++q) { const int vl = (q & 3) + 8 * (q >> 2) + 4 * hg; Uo[(size_t)vl * 256 + 32 * nt + r] = f2bf(acc[nt][q]); }
        if (F.tid < 256) { float s = 0.f;
            for (int ss = 0; ss < 64; ++ss) s += wst[ss] * bf2f(Ks[ss * ML_P + F.tid]);
            NU[(size_t)(h * 128 + c) * 256 + F.tid] = s; }
    }
}
__device__ __forceinline__ void p_mlscan(const Frame& F) {
    bf16* U = WSP(bf16, R_U); float* NU = WSP(float, WS_SMALL + SM_NU); const float* WCARRY = WSP(float, WS_SMALL + SM_WCARRY);
    const int gt = F.gw * 64 + F.lane, NGT = F.NGW * 64;
    for (int it = gt; it < NH_M * 65536 / 4; it += NGT) { const int h = it >> 14, e = (it & 16383) * 4;
        float C0 = 0.f, C1 = 0.f, C2 = 0.f, C3 = 0.f; bf16* p = U + (size_t)h * 128 * 65536 + e;
#pragma unroll 4
        for (int c = 0; c < 128; ++c) { const u32x2 u = *(const u32x2*)(p + (size_t)c * 65536); const float wc = WCARRY[h * 128 + c];
            u32x2 o; o.x = cvt_pk_bf16(C0, C1); o.y = cvt_pk_bf16(C2, C3); *(u32x2*)(p + (size_t)c * 65536) = o;
            C0 = wc * C0 + bf2f(u.x & 0xffffu); C1 = wc * C1 + bf2f(u.x >> 16); C2 = wc * C2 + bf2f(u.y & 0xffffu); C3 = wc * C3 + bf2f(u.y >> 16); } }
    for (int it = gt; it < NH_M * 256; it += NGT) { const int h = it >> 8, k = it & 255; float n = 0.f; float* p = NU + (size_t)h * 128 * 256 + k;
        for (int c = 0; c < 128; ++c) { const float u = p[c * 256]; p[c * 256] = n; n = WCARRY[h * 128 + c] * n + u; } }
}
__device__ __forceinline__ void p_mlout(const Frame& F, const Args& A) {
    const bf16* QB = WSP(bf16, R_QB); const bf16* KB = WSP(bf16, R_KB); const bf16* VB = WSP(bf16, R_VB); const bf16* CS = WSP(bf16, R_U); const float* NC = WSP(float, WS_SMALL + SM_NU);
    const float* BCUM = WSP(float, WS_SMALL + SM_BCUM); const float* IG = WSP(float, WS_SMALL + SM_IG); const float* MSEQ = WSP(float, WS_SMALL + SM_MSEQ);
    const bf16* PROJ = WSP(bf16, R_PROJ); const float* mhg = A.in[I_MLNG]; bf16* YCAT = WSP(bf16, R_YCAT);
    LAS bf16* Qs = (LAS bf16*)(F.lds + RING_OFF); LAS bf16* Ks = Qs + 64 * ML_P; LAS bf16* Vs = Ks + 64 * ML_P; LAS bf16* Ss = Vs + 64 * ML_P;
    LAS float* fa = (LAS float*)(Ss + 64 * 72); LAS float* bch = fa; LAS float* ich = fa + 64; LAS float* mrow = fa + 128; LAS float* wint = fa + 192; LAS float* rsum = fa + 256  ;
    LAS float* nq = fa + 384; LAS float* nvec = fa + 448  ; LAS float* Hs = (LAS float*)(F.lds + RING_OFF);
    const int lane = F.lane, r = lane & 31, hg = lane >> 5, w = F.wave;
    for (int L = F.vcu; L < NH_M * 128; L += F.G) { const int h = L >> 7, c = L & 127;
        __syncthreads();
        ml_stage_chunk(F, QB, h, c, Qs); ml_stage_chunk(F, KB, h, c, Ks); ml_stage_chunk(F, VB, h, c, Vs);
        if (F.tid < 64) { bch[F.tid] = BCUM[h * T + 64 * c + F.tid]; ich[F.tid] = IG[h * T + 64 * c + F.tid]; }
        if (F.tid < 256) nvec[F.tid] = NC[(size_t)(h * 128 + c) * 256 + F.tid];
        const float mc = MSEQ[h * 128 + c];
        __syncthreads();
        if (w == 0) { float g = ich[lane] - bch[lane];
#pragma unroll
            for (int o = 1; o < 64; o <<= 1) { const float x = __shfl_up(g, o); if (lane >= o) g = fmaxf(g, x); }
            const float mr = bch[lane] + fmaxf(mc, g); mrow[lane] = mr; wint[lane] = __expf(bch[lane] + mc - mr); }
        if (w == 1) { float s = 0.f;
            for (int k = 0; k < 256; ++k) s += nvec[k] * bf2f(Qs[lane * ML_P + k]);
            nq[lane] = s; }
        __syncthreads();
        if (w < 4) { const int st = w & 1, lt = w >> 1; f32x16 acc = f32x16{};
#pragma unroll
            for (int ks = 0; ks < 16; ++ks) { const bf16x8 a = *(const LAS bf16x8*)(Ks + (32 * st + r) * ML_P + 16 * ks + 8 * hg), b = *(const LAS bf16x8*)(Qs + (32 * lt + r) * ML_P + 16 * ks + 8 * hg);
                acc = __builtin_amdgcn_mfma_f32_32x32x16_bf16(a, b, acc, 0, 0, 0); }
            const int l = 32 * lt + r; const float bl_ = bch[l], mr = mrow[l]; float rs = 0.f;
#pragma unroll
            for (int g4 = 0; g4 < 4; ++g4) { float v4[4];
#pragma unroll
                for (int i = 0; i < 4; ++i) { const int s = 32 * st + 8 * g4 + 4 * hg + i; const float d = bl_ - bch[s] + ich[s] - mr;
                    v4[i] = (s <= l) ? acc[4 * g4 + i] * __expf(d) : 0.f; rs += v4[i]; }
                u32x2 p; p.x = cvt_pk_bf16(v4[0], v4[1]); p.y = cvt_pk_bf16(v4[2], v4[3]);
                *(LAS u32x2*)(Ss + l * 72 + 32 * st + 8 * g4 + 4 * hg) = p; }
            rs += __shfl_xor(rs, 32);
            if (hg == 0) rsum[st * 64 + l] = rs; }
        __syncthreads();
        const int lt = w & 1, vg = w >> 1; f32x16 ai[2], aa[2]; ai[0] = f32x16{}; ai[1] = f32x16{}; aa[0] = f32x16{}; aa[1] = f32x16{};
        const bf16* Cb = CS + (size_t)(h * 128 + c) * 65536;
#pragma unroll 4
        for (int ks = 0; ks < 16; ++ks) { const bf16x8 a = *(const LAS bf16x8*)(Qs + (32 * lt + r) * ML_P + 16 * ks + 8 * hg);
#pragma unroll
            for (int jt = 0; jt < 2; ++jt) { const bf16x8 b = *(const bf16x8*)(Cb + (size_t)(64 * vg + 32 * jt + r) * 256 + 16 * ks + 8 * hg);
                ai[jt] = __builtin_amdgcn_mfma_f32_32x32x16_bf16(a, b, ai[jt], 0, 0, 0); } }
#pragma unroll
        for (int ks = 0; ks < 4; ++ks) { const bf16x8 a = *(const LAS bf16x8*)(Ss + (32 * lt + r) * 72 + 16 * ks + 8 * hg);
#pragma unroll
            for (int jt = 0; jt < 2; ++jt) { bf16x8 b;
#pragma unroll
                for (int jj = 0; jj < 8; ++jj) b[jj] = (short)Vs[(16 * ks + 8 * hg + jj) * ML_P + 64 * vg + 32 * jt + r];
                aa[jt] = __builtin_amdgcn_mfma_f32_32x32x16_bf16(a, b, aa[jt], 0, 0, 0); } }
        __syncthreads();
#pragma unroll
        for (int q = 0; q < 16; ++q) { const int l = 32 * lt + (q & 3) + 8 * (q >> 2) + 4 * hg; const float wi = wint[l];
            const float den = rsum[l] + rsum[64 + l] + wi * nq[l]; const float dn = 1.0f / fmaxf(fabsf(den), __expf(-mrow[l]));
#pragma unroll
            for (int jt = 0; jt < 2; ++jt) Hs[l * 260 + 64 * vg + 32 * jt + r] = (aa[jt][q] + wi * ai[jt][q]) * dn; }
        __syncthreads();
        for (int i = 0; i < 8; ++i) { const int l = 8 * w + i, t = 64 * c + l; const f32x4 hv = *(const LAS f32x4*)(Hs + l * 260 + 4 * lane);
            const float ss = wave_sum((hv[0] * hv[0] + hv[1] * hv[1]) + (hv[2] * hv[2] + hv[3] * hv[3])); const float rn = 1.0f / sqrtf(ss * (1.0f / 256.0f) + 1e-6f);
            const f32x4 g = *(const f32x4*)(mhg + 256 * h + 4 * lane); const u32x2 ob = *(const u32x2*)(PROJ + (size_t)t * AB_PAD + 6592 + 256 * h + 4 * lane);
            const float o0 = hv[0] * rn * g[0] * sigmoidf_(bf2f(ob.x & 0xffffu)), o1 = hv[1] * rn * g[1] * sigmoidf_(bf2f(ob.x >> 16));
            const float o2 = hv[2] * rn * g[2] * sigmoidf_(bf2f(ob.y & 0xffffu)), o3 = hv[3] * rn * g[3] * sigmoidf_(bf2f(ob.y >> 16));
            u32x2 p; p.x = cvt_pk_bf16(o0, o1); p.y = cvt_pk_bf16(o2, o3);
            *(u32x2*)(YCAT + (size_t)t * D + 1024 + 256 * h + 4 * lane) = p; }
    }
}

struct XsOrder {
    const bf16* XQ; const bf16* KM; int G, c;
    __device__ __forceinline__ bool next(int i, pg8::Unit& u) const {
        const int L = i * G + c; if (L >= 32 * 4) return false;
        const int pm = L >> 2, hd = L & 3; u.pm = pm; u.pn = 0; u.aux = hd; u.pad = 0;
        u.a = (const char*)(XQ + (size_t)pm * 256 * D + 512 * hd); u.b = (const char*)(KM + 512 * hd); return true;
    }
};
struct XpvOrder {
    const bf16* XP; const bf16* VT; int G, c;
    __device__ __forceinline__ bool next(int i, pg8::Unit& u) const {
        int pm, pn; if (!pg8::static_tile(i, G, c, 32, 8, pm, pn)) return false;
        u.pm = pm; u.pn = pn; u.aux = 0; u.pad = 0;
        u.a = (const char*)(XP + (size_t)pm * 256 * 1024 + 256 * (pn >> 1)); u.b = (const char*)(VT + (size_t)pn * 256 * NMEM); return true;
    }
};
__device__ __forceinline__ void p_xsoftmax(const Frame& F) {
    const float* XS = WSP(float, R_XS); bf16* XP = WSP(bf16, R_XP); const int lane = F.lane;
    for (int t = F.gw; t < T; t += F.NGW)
#pragma unroll
        for (int hd = 0; hd < 4; ++hd) { const f32x4 s = *(const f32x4*)(XS + (size_t)t * 1024 + 256 * hd + 4 * lane);
            const float m = wave_max(fmaxf(fmaxf(s[0], s[1]), fmaxf(s[2], s[3])));
            const float e0 = __expf(s[0] - m), e1 = __expf(s[1] - m), e2 = __expf(s[2] - m), e3 = __expf(s[3] - m);
            const float inv = 1.0f / wave_sum((e0 + e1) + (e2 + e3));
            u32x2 p; p.x = cvt_pk_bf16(e0 * inv, e1 * inv); p.y = cvt_pk_bf16(e2 * inv, e3 * inv);
            *(u32x2*)(XP + (size_t)t * 1024 + 256 * hd + 4 * lane) = p; }
}

__device__ __forceinline__ void p_norm_fpre(const Frame& F, const Args& A) {
    LAS float* Ws = (LAS float*)(F.lds + RING_OFF);
    stage_skinny<16>(F, A.in[I_FOXWIN], FOX_LD, 8192, Ws);
    __syncthreads();
    const float* X = WSP(float, WS_X); bf16* XN = WSP(bf16, WS_XN); float* FPRE = WSP(float, WS_SMALL + SM_FPRE); const float* g = A.in[I_NMIXG] + D;
    for (int t = F.gw; t < T; t += F.NGW) { f32x4 y[8]; rms_row(X + (size_t)t * D, g, XN + (size_t)t * D, F.lane, y);
        float o[16]; skinny_dot<16>(y, Ws, F.lane, o);
        if (F.lane < 16) { float v = o[0];
#pragma unroll
            for (int c = 1; c < 16; ++c) v = (F.lane == c) ? o[c] : v;
            FPRE[t * 16 + F.lane] = v; } }
    __syncthreads();
}
__device__ __forceinline__ void p_foxprep(const Frame& F, const Args& A) {
    bf16* QKVG = WSP(bf16, R_QKVG); const float* qg = A.in[I_FOXQG]; const float* kg = A.in[I_FOXKG]; const int lane = F.lane;
    for (int it = F.gw; it < 2 * T; it += F.NGW) { const int t = it >> 1, sec = it & 1; const float* gg = sec ? kg : qg; const float g0 = gg[2 * lane], g1 = gg[2 * lane + 1];
        unsigned* row = (unsigned*)(QKVG + (size_t)t * 8192 + sec * 2048) + lane;
#pragma unroll 4
        for (int h = 0; h < NH_F; ++h) { const unsigned u = row[64 * h]; const float a = bf2f(u & 0xffffu), b = bf2f(u >> 16);
            const float rn = 1.0f / sqrtf(wave_sum(a * a + b * b) * (1.0f / 128.0f) + 1e-6f);
            row[64 * h] = cvt_pk_bf16(a * rn * g0, b * rn * g1); } }
    if (F.gw < NH_F) { const int h = F.gw; const float* FPRE = WSP(float, WS_SMALL + SM_FPRE); float* BL = WSP(float, WS_SMALL + SM_BIASL2); const float bf = A.in[I_FOXBF][h];
        float carry = 0.f;
        for (int c0 = 0; c0 < 128; c0 += 16) { float v[16];
#pragma unroll
            for (int i = 0; i < 16; ++i) v[i] = FPRE[(size_t)(64 * (c0 + i) + lane) * 16 + h];
#pragma unroll
            for (int i = 0; i < 16; ++i) { float b = logsigmoidf_(v[i] + bf);
#pragma unroll
                for (int o = 1; o < 64; o <<= 1) { const float x = __shfl_up(b, o); if (lane >= o) b += x; }
                b += carry; BL[h * T + 64 * (c0 + i) + lane] = -1.4426950408889634f * b; carry = __shfl(b, 63); } } }
}
__device__ __forceinline__ void p_foxattn(const Frame& F) {
    const bf16* QKVG = WSP(bf16, R_QKVG); bf16* ATTO = WSP(bf16, R_ATTO); const float* BL = WSP(float, WS_SMALL + SM_BIASL2);
    char* lds = (char*)F.ldsg + RING_OFF;
    for (int L = F.vcu; L < 256; L += F.G) { const int h = L >> 4, x = L & 15;
        __syncthreads();
        { float* bl = (float*)(lds + fox::BIAS_OFF); for (int i = F.tid; i < T / 4; i += NWAVES * 64) *(f32x4*)(bl + 4 * i) = *(const f32x4*)(BL + (size_t)h * T + 4 * i); }
        fox::BlockRef b0, b1; const int q0 = x, q1 = 31 - x;
        b0.Q = QKVG + (size_t)q0 * 256 * 8192 + 128 * h; b0.K = QKVG + 2048 + 128 * h; b0.V = QKVG + 4096 + 128 * h; b0.G = QKVG + (size_t)q0 * 256 * 8192 + 6144 + 128 * h;
        b0.O = ATTO + (size_t)q0 * 256 * D + 128 * h; b0.P0 = q0 * 256;
        b1 = b0; b1.Q = QKVG + (size_t)q1 * 256 * 8192 + 128 * h; b1.G = QKVG + (size_t)q1 * 256 * 8192 + 6144 + 128 * h; b1.O = ATTO + (size_t)q1 * 256 * D + 128 * h; b1.P0 = q1 * 256;
        fox::Seam S;
        fox::prime(b0, lds, S);
#ifdef FOX_LOOP
        for (int pass = 0; pass < 2; ++pass) { fox::block(b0, b1, lds, S); b0 = b1; }
#else
        fox::block(b0, b1, lds, S);
        fox::block(b1, b1, lds, S);
#endif
    }
}

__device__ __forceinline__ void p_norm_route(const Frame& F, const Args& A) {
    LAS float* Ws = (LAS float*)(F.lds + RING_OFF); LAS int* cnt = (LAS int*)(F.lds + RING_OFF + 8 * D * 4);
    stage_skinny<8>(F, A.in[I_ROUTER], NEXP, 0, Ws);
    if (F.tid < 8) cnt[F.tid] = 0;
    __syncthreads();
    const float* X = WSP(float, WS_X); bf16* XN = WSP(bf16, WS_XN); const float* g = A.in[I_NFFNG] + D;
    int* TOPI = WSP(int, WS_SMALL + SM_TOPI); float* TOPG = WSP(float, WS_SMALL + SM_TOPG); int* BLKCNT = WSP(int, WS_SMALL + SM_BLKCNT);
    const int b = blockIdx.x;
    for (int i = 0; i < 4; ++i) { const int t = 32 * b + 4 * F.wave + i; f32x4 y[8]; rms_row(X + (size_t)t * D, g, XN + (size_t)t * D, F.lane, y);
        float o[8]; skinny_dot<8>(y, Ws, F.lane, o);
        int i1 = 0; float v1 = o[0];
#pragma unroll
        for (int e = 1; e < 8; ++e) if (o[e] > v1) { v1 = o[e]; i1 = e; }
        int i2 = -1; float v2 = -__builtin_inff();
#pragma unroll
        for (int e = 0; e < 8; ++e) if (e != i1 && o[e] > v2) { v2 = o[e]; i2 = e; }
        const float e2 = __expf(v2 - v1), g1 = 1.0f / (1.0f + e2), g2 = e2 * g1;
        if (F.lane == 0) { TOPI[2 * t] = i1; TOPI[2 * t + 1] = i2; TOPG[2 * t] = g1; TOPG[2 * t + 1] = g2; __hip_atomic_fetch_add(&cnt[i1], 1, __ATOMIC_RELAXED, __HIP_MEMORY_SCOPE_WORKGROUP); __hip_atomic_fetch_add(&cnt[i2], 1, __ATOMIC_RELAXED, __HIP_MEMORY_SCOPE_WORKGROUP); } }
    __syncthreads();
    if (F.tid < 8) BLKCNT[b * 8 + F.tid] = cnt[F.tid];
}
__device__ __forceinline__ void p_route2(const Frame& F) {
    LAS int* sh = (LAS int*)(F.lds + RING_OFF);
    const int* BLKCNT = WSP(int, WS_SMALL + SM_BLKCNT); const int* TOPI = WSP(int, WS_SMALL + SM_TOPI); int* SLOT = WSP(int, WS_SMALL + SM_SLOT); int* TILEE = WSP(int, WS_SMALL + SM_TILEE);
    const bf16* XN = WSP(bf16, WS_XN); bf16* AG = WSP(bf16, R_AG); const int b = blockIdx.x;
    __syncthreads();
    if (F.tid < 8) { int tot = 0, pre = 0; for (int bb = 0; bb < 256; ++bb) { const int v = BLKCNT[bb * 8 + F.tid]; if (bb < b) pre += v; tot += v; } sh[F.tid] = tot; sh[8 + F.tid] = pre; }
    __syncthreads();
    if (F.tid == 0) { int off = 0, nt = 0; for (int e = 0; e < 8; ++e) { sh[16 + e] = off; const int n = (sh[e] + 255) >> 8; if (b == 0) for (int i = 0; i < n; ++i) TILEE[1 + nt + i] = e; nt += n; off += n * 256; } if (b == 0) TILEE[0] = nt; }
    __syncthreads();
    if (F.wave == 0) { const int t = 32 * b + (F.lane >> 1), e = TOPI[2 * t + (F.lane & 1)]; int rank = 0;
#pragma unroll
        for (int ee = 0; ee < 8; ++ee) { const unsigned long long m = __ballot(e == ee); if (e == ee) rank = __popcll(m & ((1ull << F.lane) - 1ull)); }
        const int slot = sh[16 + e] + sh[8 + e] + rank; SLOT[2 * t + (F.lane & 1)] = slot; sh[32 + F.lane] = slot; }
    __syncthreads();
    for (int p = F.wave; p < 64; p += NWAVES) { const int t = 32 * b + (p >> 1), slot = sh[32 + p]; const u32x4* src = (const u32x4*)(XN + (size_t)t * D); u32x4* dst = (u32x4*)(AG + (size_t)slot * D);
#pragma unroll
        for (int j = 0; j < 4; ++j) dst[F.lane + 64 * j] = src[F.lane + 64 * j]; }
}
struct MoeOrder {
    const bf16* Arows; const bf16* W; const int* tilee; int lda, nN; size_t wstride; int G, c; bool whole_rounds;
    __device__ __forceinline__ bool next(int i, pg8::Unit& u) const {
        const int nt = tilee[0]; const long L = (long)i * G + c; long nu = (long)nt * nN; if (whole_rounds) nu = (nu / G) * G; if (L >= nu) return false;
        const int ti = (int)(L / nN), pn = (int)(L % nN), e = tilee[1 + ti];
        u.pm = ti; u.pn = pn; u.aux = e; u.pad = 0; u.a = (const char*)(Arows + (size_t)ti * 256 * lda); u.b = (const char*)(W + (size_t)e * wstride + (size_t)pn * 256 * lda); return true;
    }
};
constexpr int MOE_KSPLIT = 4;
struct MoeSplitOrder {
    const bf16* Arows; const bf16* W; const int* tilee; int lda, nN, kslice; size_t wstride; int G, c;
    __device__ __forceinline__ bool next(int i, pg8::Unit& u) const {
        const int nt = tilee[0]; const long nu = (long)nt * nN, nfull = (nu / G) * G; const long L = (long)i * G + c; if (L >= (nu - nfull) * MOE_KSPLIT) return false;
        const long j = nfull + L / MOE_KSPLIT; const int kq = (int)(L % MOE_KSPLIT); const int ti = (int)(j / nN), pn = (int)(j % nN), e = tilee[1 + ti];
        u.pm = ti; u.pn = pn; u.aux = kq; u.pad = 0; u.a = (const char*)(Arows + (size_t)ti * 256 * lda + (size_t)kq * kslice); u.b = (const char*)(W + (size_t)e * wstride + (size_t)pn * 256 * lda + (size_t)kq * kslice); return true;
    }
};
__device__ __forceinline__ void p_final(const Frame& F, const Args& A) {
    const float* X = WSP(float, WS_X); const float* YG = WSP(float, R_YG); const float* YS = WSP(float, R_YSIDE); const int* SLOT = WSP(int, WS_SMALL + SM_SLOT); const float* TOPG = WSP(float, WS_SMALL + SM_TOPG);
    const float* g = A.in[I_FING]; const int lane = F.lane;
    const int nt = WSP(int, WS_SMALL + SM_TILEE)[0]; const int srow0 = (((nt * 8) / F.G) * F.G / 8) * 256;
    for (int t = F.gw; t < T; t += F.NGW) { const int s1 = SLOT[2 * t], s2 = SLOT[2 * t + 1]; const float g1 = TOPG[2 * t], g2 = TOPG[2 * t + 1];
        const f32x4* xr = (const f32x4*)(X + (size_t)t * D) + lane; const f32x4* y1 = (const f32x4*)(YG + (size_t)s1 * D) + lane; const f32x4* y2 = (const f32x4*)(YG + (size_t)s2 * D) + lane;
        f32x4 v[8]; float s = 0.f;
#pragma unroll
        for (int j = 0; j < 8; ++j) { f32x4 a = y1[64 * j], b = y2[64 * j];
            if (s1 >= srow0) { const f32x4* p = (const f32x4*)(YS + (size_t)(s1 - srow0) * D) + lane + 64 * j; a = a + ((p[0] + p[YSIDE_STRIDE / 4]) + p[2 * (YSIDE_STRIDE / 4)]); }
            if (s2 >= srow0) { const f32x4* p = (const f32x4*)(YS + (size_t)(s2 - srow0) * D) + lane + 64 * j; b = b + ((p[0] + p[YSIDE_STRIDE / 4]) + p[2 * (YSIDE_STRIDE / 4)]); }
            v[j] = xr[64 * j] + (a * g1 + b * g2); s += (v[j][0] * v[j][0] + v[j][1] * v[j][1]) + (v[j][2] * v[j][2] + v[j][3] * v[j][3]); }
        const float r = 1.0f / sqrtf(wave_sum(s) * (1.0f / D) + 1e-6f); f32x4* o = (f32x4*)(A.out + (size_t)t * D) + lane;
#pragma unroll
        for (int j = 0; j < 8; ++j) o[64 * j] = v[j] * r * ((const f32x4*)g)[lane + 64 * j]; }
}

enum Phase { PH_CONV = 0, PH_INPROJ0, PH_PREPA, PH_LORA, PH_PREPB, PH_SCAN, PH_MLU, PH_MLSCAN, PH_MLOUT, PH_OUTPROJ0,
             PH_NORMX0, PH_XQ0, PH_XS0, PH_XSM0, PH_XPV0, PH_XO0, PH_NORMF0, PH_FFNGU, PH_FFND,
             PH_NORMM1, PH_FOXIN, PH_FOXPREP, PH_FOXATT, PH_FOXOUT,
             PH_NORMX1, PH_XQ1, PH_XS1, PH_XSM1, PH_XPV1, PH_XO1, PH_NORMF1, PH_ROUTE2, PH_MOEGU, PH_MOED, PH_FINAL, N_PHASES };

__global__ void __launch_bounds__(NWAVES * 64, 2) trunk_fwd(Args A) {
    extern __shared__ __attribute__((aligned(16))) unsigned char lds[];
    Frame F;
    F.lds = (LAS unsigned char*)lds; F.ldsg = lds; F.ws = A.ws;
    F.tid = threadIdx.x; F.lane = F.tid & 63; F.wave = __builtin_amdgcn_readfirstlane(F.tid >> 6);
    F.G = gridDim.x; { const int bx = blockIdx.x; F.vcu = (F.G % 8 == 0) ? (bx % 8) * (F.G / 8) + bx / 8 : bx; }
    F.gw = F.vcu * NWAVES + F.wave; F.NGW = F.G * NWAVES;
    volatile LAS unsigned* MISC = (volatile LAS unsigned*)(F.lds + MISC_OFF);
    for (int u = F.tid; u < (LDS_BYTES - LDSCTL_OFF) / 4; u += NWAVES * 64) ((LAS unsigned*)(F.lds + LDSCTL_OFF))[u] = 0u;
    __syncthreads();
    const int lo = A.ph_lo, hi = A.ph_hi;
    const bool multi = (hi - lo) > 1;
    XcdBarrier bar; bar.bar = (unsigned*)(A.ws + WS_CTL) + CW_BAR; bar.x = 0; bar.st = nullptr;
    if (multi) bar = xcd_barrier_post((unsigned*)(A.ws + WS_CTL) + CW_BAR, MISC + 8);
#ifndef PH_ENABLE
#define PH_ENABLE 0xFFFFFFFFFFFFFFFFull
#endif
#define IN(k) ((((PH_ENABLE) >> (k)) & 1ull) && lo <= (k) && (k) < hi)
#ifndef PROBE_DUP
#define PROBE_DUP 0ull
#endif
#define DUP(k) if ((((PROBE_DUP) >> (k)) & 1ull) != 0ull)
#define SEAM(k) do { if (IN(k) && IN((k) + 1)) xcd_barrier(bar); } while (0)
    LAS unsigned char* ring = F.lds + RING_OFF;
    const int cb = (int)blockIdx.x;

    if (IN(PH_CONV)) { p_convert_early(F, A); } SEAM(PH_CONV);
    if (IN(PH_INPROJ0)) { InprojKvOrder S{WSP(bf16, WS_XN), WSP(bf16, WS_W_ABIN), WSP(bf16, WS_MEMN), WSP(bf16, WS_W_XKV), F.G, cb};
        EpiInprojKv E{WSP(bf16, R_PROJ), WSP(float, R_GATES32), WSP(bf16, WS_KMEM), WSP(bf16, WS_VTMEM)};
        pg8::gemm_phase<EpiInprojKv, InprojKvOrder, true>(ring, pg8::Gemm{D, D, D}, S, E); } SEAM(PH_INPROJ0);
    if (IN(PH_PREPA)) { p_prepa(F, A); DUP(PH_PREPA) { __syncthreads(); p_prepa(F, A); } } SEAM(PH_PREPA);
    if (IN(PH_LORA)) { pg8::PlainOrder S{WSP(bf16, R_LORAIN), WSP(bf16, WS_W_LORA), 512, 512, 32, 12, F.G, cb}; pg8::EpiF32 E{WSP(float, R_LORAOUT), 3072, 0, 1.0f};
        pg8::gemm_phase<pg8::EpiF32, pg8::PlainOrder, true>(ring, pg8::Gemm{512, 512, 512}, S, E); } SEAM(PH_LORA);
    if (IN(PH_PREPB)) { p_prepb(F, A); DUP(PH_PREPB) { __syncthreads(); p_prepb(F, A); } } SEAM(PH_PREPB);
    if (IN(PH_SCAN)) {
        if (F.wave == 0) p_scan(F);
        else p_convert_late(F, A, F.vcu * (NWAVES - 1) + F.wave - 1, F.G * (NWAVES - 1), (LAS float*)(F.lds + RING_OFF + SC_LDS + (F.wave - 1) * 8448));
        DUP(PH_SCAN) { __syncthreads(); if (F.wave == 0) p_scan(F); else p_convert_late(F, A, F.vcu * (NWAVES - 1) + F.wave - 1, F.G * (NWAVES - 1), (LAS float*)(F.lds + RING_OFF + SC_LDS + (F.wave - 1) * 8448)); }
        DUP(62) { __syncthreads(); if (F.wave == 0) p_scan(F); }
        DUP(63) { __syncthreads(); if (F.wave != 0) p_convert_late(F, A, F.vcu * (NWAVES - 1) + F.wave - 1, F.G * (NWAVES - 1), (LAS float*)(F.lds + RING_OFF + SC_LDS + (F.wave - 1) * 8448)); } } SEAM(PH_SCAN);
    if (IN(PH_MLU)) { p_mlu(F); DUP(PH_MLU) { __syncthreads(); p_mlu(F); } } SEAM(PH_MLU);
    if (IN(PH_MLSCAN)) { p_mlscan(F); p_rwkv_post(F, A); DUP(PH_MLSCAN) { __syncthreads(); p_rwkv_post(F, A); } } SEAM(PH_MLSCAN);
    if (IN(PH_MLOUT)) { p_mlout(F, A); DUP(PH_MLOUT) { __syncthreads(); p_mlout(F, A); } } SEAM(PH_MLOUT);
    if (IN(PH_OUTPROJ0)) { pg8::PlainOrder S{WSP(bf16, R_YCAT), WSP(bf16, WS_W_ABOUT), D, D, 32, 8, F.G, cb}; pg8::EpiResid E{A.in[I_X], WSP(float, WS_X), D};
        pg8::gemm_phase<pg8::EpiResid, pg8::PlainOrder, false>(ring, pg8::Gemm{D, D, D}, S, E); } SEAM(PH_OUTPROJ0);
#define XATTN(l, P_NORM, P_Q, P_S, P_SM, P_PV, P_O) \
    if (IN(P_NORM)) { norm_phase(F, WSP(float, WS_X), A.in[I_NXAG] + (l) * D, WSP(bf16, WS_XN), T); DUP(P_NORM) { norm_phase(F, WSP(float, WS_X), A.in[I_NXAG] + (l) * D, WSP(bf16, WS_XN), T); } } SEAM(P_NORM); \
    if (IN(P_Q)) { pg8::PlainOrder S{WSP(bf16, WS_XN), WSP(bf16, WS_W_XQ) + (size_t)(l) * D * D, D, D, 32, 8, F.G, cb}; pg8::EpiBf16 E{WSP(bf16, R_XQ), D, nullptr, -1}; \
        pg8::gemm_phase<pg8::EpiBf16, pg8::PlainOrder, false>(ring, pg8::Gemm{D, D, D}, S, E); } SEAM(P_Q); \
    if (IN(P_S)) { XsOrder S{WSP(bf16, R_XQ), WSP(bf16, WS_KMEM) + (size_t)(l) * NMEM * D, F.G, cb}; pg8::EpiF32 E{WSP(float, R_XS), 1024, 256, 0.044194173824159216f}; \
        pg8::gemm_phase<pg8::EpiF32, XsOrder, false>(ring, pg8::Gemm{D, D, 512}, S, E); } SEAM(P_S); \
    if (IN(P_SM)) { p_xsoftmax(F); DUP(P_SM) { p_xsoftmax(F); } } SEAM(P_SM); \
    if (IN(P_PV)) { XpvOrder S{WSP(bf16, R_XP), WSP(bf16, WS_VTMEM) + (size_t)(l) * D * NMEM, F.G, cb}; pg8::EpiBf16 E{WSP(bf16, R_XO), D, nullptr, -1}; \
        pg8::gemm_phase<pg8::EpiBf16, XpvOrder, false>(ring, pg8::Gemm{1024, NMEM, 256}, S, E); } SEAM(P_PV); \
    if (IN(P_O)) { pg8::PlainOrder S{WSP(bf16, R_XO), WSP(bf16, WS_W_XO) + (size_t)(l) * D * D, D, D, 32, 8, F.G, cb}; pg8::EpiResid E{WSP(float, WS_X), WSP(float, WS_X), D}; \
        pg8::gemm_phase<pg8::EpiResid, pg8::PlainOrder, false>(ring, pg8::Gemm{D, D, D}, S, E); } SEAM(P_O);

    XATTN(0, PH_NORMX0, PH_XQ0, PH_XS0, PH_XSM0, PH_XPV0, PH_XO0)
    if (IN(PH_NORMF0)) { norm_phase(F, WSP(float, WS_X), A.in[I_NFFNG], WSP(bf16, WS_XN), T); DUP(PH_NORMF0) { norm_phase(F, WSP(float, WS_X), A.in[I_NFFNG], WSP(bf16, WS_XN), T); } } SEAM(PH_NORMF0);
    if (IN(PH_FFNGU)) { pg8::PlainOrder S{WSP(bf16, WS_XN), WSP(bf16, WS_W_FFNGU), D, D, 32, 44, F.G, cb}; pg8::EpiSwiGLU E{WSP(bf16, R_ACT), DFF};
        pg8::gemm_phase<pg8::EpiSwiGLU, pg8::PlainOrder, true>(ring, pg8::Gemm{D, D, D}, S, E); DUP(PH_FFNGU) { pg8::gemm_phase<pg8::EpiSwiGLU, pg8::PlainOrder, true>(ring, pg8::Gemm{D, D, D}, S, E); } } SEAM(PH_FFNGU);
    if (IN(PH_FFND)) { pg8::PlainOrder S{WSP(bf16, R_ACT), WSP(bf16, WS_W_FFND), DFF, DFF, 32, 8, F.G, cb}; pg8::EpiResid E{WSP(float, WS_X), WSP(float, WS_X), D};
        pg8::gemm_phase<pg8::EpiResid, pg8::PlainOrder, false>(ring, pg8::Gemm{DFF, DFF, DFF}, S, E); } SEAM(PH_FFND);
    if (IN(PH_NORMM1)) { p_norm_fpre(F, A); DUP(PH_NORMM1) { p_norm_fpre(F, A); } } SEAM(PH_NORMM1);
    if (IN(PH_FOXIN)) { pg8::PlainOrder S{WSP(bf16, WS_XN), WSP(bf16, WS_W_FOXIN), D, D, 32, 32, F.G, cb}; pg8::EpiBf16 E{WSP(bf16, R_QKVG), 8192, nullptr, -1};
        pg8::gemm_phase<pg8::EpiBf16, pg8::PlainOrder, true>(ring, pg8::Gemm{D, D, D}, S, E); DUP(PH_FOXIN) { pg8::gemm_phase<pg8::EpiBf16, pg8::PlainOrder, true>(ring, pg8::Gemm{D, D, D}, S, E); } } SEAM(PH_FOXIN);
    if (IN(PH_FOXPREP)) { p_foxprep(F, A); } SEAM(PH_FOXPREP);
    if (IN(PH_FOXATT)) { p_foxattn(F); DUP(PH_FOXATT) { __syncthreads(); p_foxattn(F); } } SEAM(PH_FOXATT);
    if (IN(PH_FOXOUT)) { pg8::PlainOrder S{WSP(bf16, R_ATTO), WSP(bf16, WS_W_FOXOUT), D, D, 32, 8, F.G, cb}; pg8::EpiResid E{WSP(float, WS_X), WSP(float, WS_X), D};
        pg8::gemm_phase<pg8::EpiResid, pg8::PlainOrder, false>(ring, pg8::Gemm{D, D, D}, S, E); } SEAM(PH_FOXOUT);
    XATTN(1, PH_NORMX1, PH_XQ1, PH_XS1, PH_XSM1, PH_XPV1, PH_XO1)
    if (IN(PH_NORMF1)) { p_norm_route(F, A); } SEAM(PH_NORMF1);
    if (IN(PH_ROUTE2)) { p_route2(F); } SEAM(PH_ROUTE2);
    if (IN(PH_MOEGU)) { MoeOrder S{WSP(bf16, R_AG), WSP(bf16, WS_W_MOEGU), WSP(int, WS_SMALL + SM_TILEE), D, 44, (size_t)2 * DFF * D, F.G, cb, false}; pg8::EpiSwiGLU E{WSP(bf16, R_ACTG), DFF};
        pg8::gemm_phase<pg8::EpiSwiGLU, MoeOrder, true>(ring, pg8::Gemm{D, D, D}, S, E); } SEAM(PH_MOEGU);
    if (IN(PH_MOED)) {
        { MoeOrder S{WSP(bf16, R_ACTG), WSP(bf16, WS_W_MOED), WSP(int, WS_SMALL + SM_TILEE), DFF, 8, (size_t)D * DFF, F.G, cb, true}; pg8::EpiF32 E{WSP(float, R_YG), D, 0, 1.0f};
          pg8::gemm_phase<pg8::EpiF32, MoeOrder, true>(ring, pg8::Gemm{DFF, DFF, DFF}, S, E); }
        { MoeSplitOrder S{WSP(bf16, R_ACTG), WSP(bf16, WS_W_MOED), WSP(int, WS_SMALL + SM_TILEE), DFF, 8, DFF / MOE_KSPLIT, (size_t)D * DFF, F.G, cb}; const int nt_ = WSP(int, WS_SMALL + SM_TILEE)[0]; pg8::EpiF32Split E{WSP(float, R_YG), WSP(float, R_YSIDE), YSIDE_STRIDE, D, ((nt_ * 8) / F.G) * F.G / 8};
          pg8::gemm_phase<pg8::EpiF32Split, MoeSplitOrder, false>(ring, pg8::Gemm{DFF, DFF, DFF / MOE_KSPLIT}, S, E); } } SEAM(PH_MOED);
    if (IN(PH_FINAL)) { p_final(F, A); }
#undef XATTN
#undef IN
#undef SEAM
}

#ifndef MK_ONE_LAUNCH
#define MK_ONE_LAUNCH 1
#endif
extern "C" void kernel_launch(void* const* d_in, const int* in_sizes, int n_in, void* d_out, int out_size, void* d_ws, size_t ws_size, hipStream_t stream) {
    static int ready = 0;
    if (ready == 0) {
        if (n_in != N_IN || in_sizes[0] != T * D || out_size != T * D || ws_size < WS_END) {
            fprintf(stderr, "kernel_launch: built for %d inputs, x/out of %d floats, >= %zu bytes of workspace; got n_in %d, in0 %d, out %d, ws %zu; nothing launched\n", N_IN, T * D, (size_t)WS_END, n_in, n_in > 0 ? in_sizes[0] : -1, out_size, ws_size);
            ready = -1; return; }
        if (hipFuncSetAttribute((const void*)trunk_fwd, hipFuncAttributeMaxDynamicSharedMemorySize, LDS_BYTES) != hipSuccess) { fprintf(stderr, "kernel_launch: hipFuncSetAttribute failed\n"); ready = -1; return; }
        int per_cu = 0;
        if (hipOccupancyMaxActiveBlocksPerMultiprocessor(&per_cu, (const void*)trunk_fwd, NWAVES * 64, LDS_BYTES) != hipSuccess || per_cu < 1)
            fprintf(stderr, "kernel_launch: note: occupancy query reports %d workgroups per CU\n", per_cu);
        (void)hipGetLastError();
        ready = 1;
    }
    if (ready < 0) return;
    const int grid = 256;
    if (hipMemsetAsync((char*)d_ws + WS_CTL, 0, CTL_ZERO_BYTES, stream) != hipSuccess) { fprintf(stderr, "kernel_launch: hipMemsetAsync failed\n"); return; }
    Args a{};
    for (int i = 0; i < N_IN; ++i) a.in[i] = (const float*)d_in[i];
    a.out = (float*)d_out; a.ws = (unsigned char*)d_ws;
#if MK_ONE_LAUNCH
    a.ph_lo = 0; a.ph_hi = N_PHASES;
    hipLaunchKernelGGL(trunk_fwd, dim3(grid), dim3(NWAVES * 64), LDS_BYTES, stream, a);
#else
    for (int p = 0; p < N_PHASES; ++p) { a.ph_lo = p; a.ph_hi = p + 1;
        hipLaunchKernelGGL(trunk_fwd, dim3(grid), dim3(NWAVES * 64), LDS_BYTES, stream, a); }
#endif
    const hipError_t le = hipPeekAtLastError();
    if (le != hipSuccess) fprintf(stderr, "kernel_launch: launch failed: %s\n", hipGetErrorName(le));
}
```

```cpp
#include <hip/hip_runtime.h>
#include <cstdio>
#include <cstdint>

#define GAS __attribute__((address_space(1)))
#define LAS __attribute__((address_space(3)))
typedef unsigned short bf16;
typedef short bf16x8 __attribute__((ext_vector_type(8)));
typedef short s16x4 __attribute__((ext_vector_type(4)));
typedef float f32x2 __attribute__((ext_vector_type(2)));
typedef float f32x4 __attribute__((ext_vector_type(4)));
typedef float f32x16 __attribute__((ext_vector_type(16)));
typedef unsigned u32x2 __attribute__((ext_vector_type(2)));
typedef unsigned u32x4 __attribute__((ext_vector_type(4)));

constexpr int T = 8192, D = 2048, NMEM = 256, DFF = 5632, NEXP = 8;
constexpr int A_COLS = 3520, AB_COLS = 7624, AB_PAD = 7680;
constexpr int FOX_LD = 8208;
constexpr int NH_R = 16, NH_M = 4, NH_F = 16;
constexpr int MOE_ROWS = 72 * 256;

__device__ __forceinline__ float bf2f(unsigned b) { return __uint_as_float(b << 16); }
__device__ __forceinline__ unsigned cvt_pk_bf16(float lo, float hi) { unsigned r; asm volatile("v_cvt_pk_bf16_f32 %0, %1, %2" : "=v"(r) : "v"(lo), "v"(hi)); return r; }
__device__ __forceinline__ bf16 f2bf(float f) { return (bf16)(cvt_pk_bf16(f, 0.f) & 0xffffu); }
__device__ __forceinline__ float wave_sum(float v) {
#pragma unroll
    for (int o = 1; o < 64; o <<= 1) v += __shfl_xor(v, o);
    return v;
}
__device__ __forceinline__ float wave_max(float v) {
#pragma unroll
    for (int o = 1; o < 64; o <<= 1) v = fmaxf(v, __shfl_xor(v, o));
    return v;
}
__device__ __forceinline__ float wave_sum_dpp(float x) {
#define DPPF_(v, ctrl) __builtin_bit_cast(float, __builtin_amdgcn_update_dpp(0, __builtin_bit_cast(int, v), ctrl, 0xF, 0xF, true))
    x += DPPF_(x, 0xB1); x += DPPF_(x, 0x4E); x += DPPF_(x, 0x141); x += DPPF_(x, 0x140);
#undef DPPF_
    const float a = __builtin_bit_cast(float, __builtin_amdgcn_readlane(__builtin_bit_cast(int, x), 0)), b = __builtin_bit_cast(float, __builtin_amdgcn_readlane(__builtin_bit_cast(int, x), 16));
    const float c = __builtin_bit_cast(float, __builtin_amdgcn_readlane(__builtin_bit_cast(int, x), 32)), d = __builtin_bit_cast(float, __builtin_amdgcn_readlane(__builtin_bit_cast(int, x), 48));
    return (a + b) + (c + d);
}
__device__ __forceinline__ float sigmoidf_(float x) { return 1.0f / (1.0f + __expf(-x)); }
__device__ __forceinline__ float logsigmoidf_(float x) { return fminf(x, 0.f) - log1pf(__expf(-fabsf(x))); }

namespace pg8 {
#define PG8_LAS __attribute__((address_space(3)))
typedef unsigned short bf16_t;
constexpr int BM = 256, BK = 64, HALF = 128, HTB = HALF * BK * 2  , STAGE_BYTES = 8 * HTB, NXCD = 8, WGM = 8;

__host__ __device__ __forceinline__ int lds_byte(int r, int c) { const int st = (r >> 4) * 2 + (c >> 5), rr = r & 15, cc = c & 31, ob = rr * 64 + cc * 2; return st * 1024 + (ob ^ (((ob >> 9) & 1) << 5)); }
__host__ __device__ __forceinline__ void stage_rc(int b, int& R, int& C) { const int st = b / 1024, sb = b % 1024, swz = sb ^ (((sb >> 9) & 1) << 5); R = (st >> 1) * 16 + swz / 64; C = (st & 1) * 32 + (swz % 64) / 2; }
__host__ __device__ __forceinline__ int perm32(int rho) { const int n = rho >> 4, i = rho & 15; return 8 * (i >> 2) + 4 * n + (i & 3); }

struct Unit { const char* a; const char* b; int pm, pn, aux, pad; };
struct Gemm { int lda, ldb, K; };

__device__ __forceinline__ bool static_tile(int i, int G, int c, int nM, int nN, int& pm, int& pn) {
    const int nwg = nM * nN; const long L = (long)i * G + c; if (L >= nwg) return false;
    int wgid = (int)L; { const int q = nwg / NXCD, r = nwg % NXCD, xcd = wgid % NXCD, off = wgid / NXCD; wgid = (xcd < r ? xcd * (q + 1) : r * (q + 1) + (xcd - r) * q) + off; }
    const int nig = WGM * nN, gid = wgid / nig, fm = gid * WGM, gsz = (nM - fm) < WGM ? (nM - fm) : WGM;
    pm = fm + ((wgid % nig) % gsz); pn = (wgid % nig) / gsz; return true;
}
struct PlainOrder {
    const bf16_t* A; const bf16_t* Bt; int lda, ldb, nM, nN, G, c;
    __device__ __forceinline__ bool next(int i, Unit& u) const {
        int pm, pn; if (!static_tile(i, G, c, nM, nN, pm, pn)) return false;
        u.pm = pm; u.pn = pn; u.aux = 0; u.pad = 0; u.a = (const char*)(A + (size_t)pm * BM * lda); u.b = (const char*)(Bt + (size_t)pn * BM * ldb); return true;
    }
};

struct EpiF32 {
    static constexpr bool PERM = false;
    float* C; int ldc; int aux_cols; float scale;
    __device__ __forceinline__ void operator()(const f32x4 (&acc)[2][2][4][2], const Unit& u, int wr, int wc, int fr, int fq) const {
        const int row0 = u.pm * BM + wr * 64 + fr, col0 = u.pn * BM + u.aux * aux_cols + wc * 32 + 4 * fq;
#pragma unroll
        for (int ai = 0; ai < 2; ++ai)
#pragma unroll
            for (int m = 0; m < 4; ++m) { float* rowp = C + (size_t)(row0 + ai * HALF + m * 16) * ldc + col0;
#pragma unroll
                for (int bj = 0; bj < 2; ++bj)
#pragma unroll
                    for (int n = 0; n < 2; ++n) *(f32x4*)(rowp + bj * HALF + n * 16) = acc[ai][bj][m][n] * scale; }
    }
};
struct EpiF32Split {
    static constexpr bool PERM = false;
    float* C; float* side; size_t side_stride; int ldc; int pm0;
    __device__ __forceinline__ void operator()(const f32x4 (&acc)[2][2][4][2], const Unit& u, int wr, int wc, int fr, int fq) const {
        float* base = u.aux == 0 ? C + (size_t)u.pm * BM * ldc : side + (size_t)(u.aux - 1) * side_stride + (size_t)(u.pm - pm0) * BM * ldc;
        const int row0 = wr * 64 + fr, col0 = u.pn * BM + wc * 32 + 4 * fq;
#pragma unroll
        for (int ai = 0; ai < 2; ++ai)
#pragma unroll
            for (int m = 0; m < 4; ++m) { float* rowp = base + (size_t)(row0 + ai * HALF + m * 16) * ldc + col0;
#pragma unroll
                for (int bj = 0; bj < 2; ++bj)
#pragma unroll
                    for (int n = 0; n < 2; ++n) *(f32x4*)(rowp + bj * HALF + n * 16) = acc[ai][bj][m][n]; }
    }
};
struct EpiResid {
    static constexpr bool PERM = false;
    const float* base; float* out; int ldc;
    __device__ __forceinline__ void operator()(const f32x4 (&acc)[2][2][4][2], const Unit& u, int wr, int wc, int fr, int fq) const {
        const int row0 = u.pm * BM + wr * 64 + fr, col0 = u.pn * BM + wc * 32 + 4 * fq;
#pragma unroll
        for (int ai = 0; ai < 2; ++ai)
#pragma unroll
            for (int m = 0; m < 4; ++m) { const size_t off = (size_t)(row0 + ai * HALF + m * 16) * ldc + col0;
#pragma unroll
                for (int bj = 0; bj < 2; ++bj)
#pragma unroll
                    for (int n = 0; n < 2; ++n) { const f32x4 b = *(const f32x4*)(base + off + bj * HALF + n * 16); *(f32x4*)(out + off + bj * HALF + n * 16) = b + acc[ai][bj][m][n]; } }
    }
};
struct EpiBf16 {
    static constexpr bool PERM = true;
    bf16_t* O; int ldc; float* side; int side_pn;
    __device__ __forceinline__ void operator()(const f32x4 (&acc)[2][2][4][2], const Unit& u, int wr, int wc, int fr, int fq) const {
        const int row0 = u.pm * BM + wr * 64 + fr, col0 = u.pn * BM + wc * 32 + 8 * fq;
#pragma unroll
        for (int ai = 0; ai < 2; ++ai)
#pragma unroll
            for (int m = 0; m < 4; ++m) { bf16_t* rowp = O + (size_t)(row0 + ai * HALF + m * 16) * ldc + col0;
#pragma unroll
                for (int bj = 0; bj < 2; ++bj) { const f32x4 v0 = acc[ai][bj][m][0], v1 = acc[ai][bj][m][1];
                    u32x4 w; w.x = cvt_pk_bf16(v0[0], v0[1]); w.y = cvt_pk_bf16(v0[2], v0[3]); w.z = cvt_pk_bf16(v1[0], v1[1]); w.w = cvt_pk_bf16(v1[2], v1[3]);
                    *(u32x4*)(rowp + bj * HALF) = w; } }
        if (side != nullptr && u.pn == side_pn) {
#pragma unroll
            for (int ai = 0; ai < 2; ++ai)
#pragma unroll
                for (int m = 0; m < 4; ++m) { float* rowp = side + (size_t)(row0 + ai * HALF + m * 16) * 256 + wc * 32 + 8 * fq;
#pragma unroll
                    for (int bj = 0; bj < 2; ++bj) { *(f32x4*)(rowp + bj * HALF) = acc[ai][bj][m][0]; *(f32x4*)(rowp + bj * HALF + 4) = acc[ai][bj][m][1]; } }
        }
    }
};
struct EpiSwiGLU {
    static constexpr bool PERM = true;
    bf16_t* O; int ldc;
    __device__ __forceinline__ void operator()(const f32x4 (&acc)[2][2][4][2], const Unit& u, int wr, int wc, int fr, int fq) const {
        const int row0 = u.pm * BM + wr * 64 + fr, col0 = u.pn * HALF + wc * 32 + 8 * fq;
#pragma unroll
        for (int ai = 0; ai < 2; ++ai)
#pragma unroll
            for (int m = 0; m < 4; ++m) { bf16_t* rowp = O + (size_t)(row0 + ai * HALF + m * 16) * ldc + col0;
                float o[8];
#pragma unroll
                for (int n = 0; n < 2; ++n)
#pragma unroll
                    for (int j = 0; j < 4; ++j) { const float g = acc[ai][0][m][n][j], up = acc[ai][1][m][n][j];
                        o[n * 4 + j] = g * __builtin_amdgcn_rcpf(1.0f + __builtin_amdgcn_exp2f(-1.4426950408889634f * g)) * up; }
                u32x4 w; w.x = cvt_pk_bf16(o[0], o[1]); w.y = cvt_pk_bf16(o[2], o[3]); w.z = cvt_pk_bf16(o[4], o[5]); w.w = cvt_pk_bf16(o[6], o[7]);
                *(u32x4*)rowp = w; }
    }
};

template <class Epi, class Sched, bool ALIGN_EPI>
__device__ __forceinline__ void gemm_phase(PG8_LAS unsigned char* lds, const Gemm g, const Sched& S, const Epi& E) {
    const int tid = threadIdx.x, wid = __builtin_amdgcn_readfirstlane(tid >> 6), lane = tid & 63, wr = wid >> 2, wc = wid & 3, fr = lane & 15, fq = lane >> 4;
    const int K = g.K, nt = K / BK;
    unsigned voffA[2], voffB[2];
#pragma unroll
    for (int i = 0; i < 2; ++i) { int R, C; stage_rc(tid * 16 + i * 8192, R, C); const int Rb = Epi::PERM ? ((R & ~31) + perm32(R & 31)) : R;
        voffA[i] = (unsigned)(R * g.lda + C) * 2u; voffB[i] = (unsigned)(Rb * g.ldb + C) * 2u; }
    const size_t kstep = (size_t)(BK * 2);
    const size_t hstepA = (size_t)HALF * g.lda * 2, hstepB = (size_t)HALF * g.ldb * 2;
    const unsigned ldsw = (unsigned)wid * 1024u;
    const int aoff = lds_byte(wr * 64 + fr, fq * 8), boff = lds_byte(wc * 32 + fr, fq * 8);
#define PG8_SA(b, h) (((b) * 2 + (h)) * HTB)
#define PG8_SB(b, h) ((4 + (b) * 2 + (h)) * HTB)
#define PG8_STAGE(bufoff, gbase, voff) do { _Pragma("unroll") for (int _i = 0; _i < 2; ++_i) \
        __builtin_amdgcn_global_load_lds((const unsigned*)((const char*)(gbase) + (voff)[_i]), (PG8_LAS unsigned*)(lds + (bufoff) + ldsw + _i * 8192), 16, 0, 0); } while (0)
#define PG8_LDA(dst, b, h) do { _Pragma("unroll") for (int m = 0; m < 4; ++m) _Pragma("unroll") for (int k = 0; k < 2; ++k) dst[m][k] = *(const PG8_LAS bf16x8*)(lds + PG8_SA(b, h) + aoff + m * 2048 + k * 1024); } while (0)
#define PG8_LDB(dst, b, h) do { _Pragma("unroll") for (int n = 0; n < 2; ++n) _Pragma("unroll") for (int k = 0; k < 2; ++k) dst[n][k] = *(const PG8_LAS bf16x8*)(lds + PG8_SB(b, h) + boff + n * 2048 + k * 1024); } while (0)
#define PG8_MMA(ai, bj, At, Bt) do { __builtin_amdgcn_s_setprio(1); _Pragma("unroll") for (int m = 0; m < 4; ++m) _Pragma("unroll") for (int n = 0; n < 2; ++n) _Pragma("unroll") for (int k = 0; k < 2; ++k) \
        acc[ai][bj][m][n] = __builtin_amdgcn_mfma_f32_16x16x32_bf16(Bt[n][k], At[m][k], acc[ai][bj][m][n], 0, 0, 0); __builtin_amdgcn_s_setprio(0); } while (0)
#define PG8_WAIT_V(n) asm volatile("s_waitcnt vmcnt(" #n ")" ::: "memory")
#define PG8_WAIT_L(n) asm volatile("s_waitcnt lgkmcnt(" #n ")" ::: "memory")
#define PG8_BAR __builtin_amdgcn_s_barrier()
#define PG8_SCHED __builtin_amdgcn_sched_barrier(0)
    Unit cur, nxt; int ui = 0;
    if (!S.next(0, cur)) return;
    f32x4 acc[2][2][4][2];
#pragma unroll
    for (int a = 0; a < 2; ++a)
#pragma unroll
        for (int b = 0; b < 2; ++b)
#pragma unroll
            for (int m = 0; m < 4; ++m)
#pragma unroll
                for (int n = 0; n < 2; ++n) acc[a][b][m][n] = (f32x4){0.f, 0.f, 0.f, 0.f};
    bf16x8 At[4][2], B0[2][2], B1[2][2];
    const char* cA = cur.a; const char* cB = cur.b;
    PG8_STAGE(PG8_SB(0, 0), cB, voffB); PG8_STAGE(PG8_SB(0, 1), cB + hstepB, voffB); PG8_STAGE(PG8_SA(0, 0), cA, voffA); PG8_STAGE(PG8_SA(0, 1), cA + hstepA, voffA);
    if (wr == 1) PG8_BAR;
    PG8_WAIT_V(2); PG8_BAR;
    PG8_STAGE(PG8_SB(1, 0), cB + kstep, voffB); PG8_STAGE(PG8_SA(1, 0), cA + kstep, voffA); PG8_STAGE(PG8_SB(1, 1), cB + hstepB + kstep, voffB);
    PG8_WAIT_V(6); PG8_BAR;
    for (;;) {
        const bool has_next = S.next(ui + 1, nxt);
        const char* nA = has_next ? nxt.a : cA; const char* nB = has_next ? nxt.b : cB;
        for (int t = 0; t < nt; t += 2) {
            const bool last = (t == nt - 2);
            const char* a1 = cA + (size_t)(t + 1) * kstep;
            const char* a2 = last ? nA : cA + (size_t)(t + 2) * kstep; const char* b2 = last ? nB : cB + (size_t)(t + 2) * kstep;
            const char* a3 = a2 + kstep; const char* b3 = b2 + kstep;
            PG8_LDB(B0, 0, 0); PG8_LDB(B1, 0, 1); PG8_SCHED; PG8_LDA(At, 0, 0); PG8_STAGE(PG8_SA(1, 1), a1 + hstepA, voffA);
            PG8_WAIT_V(8); PG8_WAIT_L(0); PG8_BAR; PG8_MMA(0, 0, At, B0); PG8_MMA(0, 1, At, B1); PG8_BAR; PG8_SCHED;
            PG8_LDA(At, 0, 1); PG8_STAGE(PG8_SB(0, 0), b2, voffB); PG8_STAGE(PG8_SB(0, 1), b2 + hstepB, voffB); PG8_STAGE(PG8_SA(0, 0), a2, voffA);
            PG8_WAIT_V(8); PG8_WAIT_L(0); PG8_BAR; PG8_MMA(1, 0, At, B0); PG8_MMA(1, 1, At, B1); PG8_BAR; PG8_SCHED;
            PG8_LDB(B0, 1, 0); PG8_LDB(B1, 1, 1); PG8_SCHED; PG8_LDA(At, 1, 0); PG8_STAGE(PG8_SA(0, 1), a2 + hstepA, voffA);
            PG8_WAIT_V(8); PG8_WAIT_L(0); PG8_BAR; PG8_MMA(0, 0, At, B0); PG8_MMA(0, 1, At, B1); PG8_BAR; PG8_SCHED;
            PG8_LDA(At, 1, 1); PG8_STAGE(PG8_SB(1, 0), b3, voffB); PG8_STAGE(PG8_SB(1, 1), b3 + hstepB, voffB); PG8_STAGE(PG8_SA(1, 0), a3, voffA);
            PG8_WAIT_V(8); PG8_WAIT_L(0); PG8_BAR; PG8_MMA(1, 0, At, B0); PG8_MMA(1, 1, At, B1); PG8_BAR; PG8_SCHED;
        }
        if constexpr (ALIGN_EPI) { if (wr == 0) PG8_BAR; }
        E(acc, cur, wr, wc, fr, fq);
        if (!has_next) break;
#pragma unroll
        for (int a = 0; a < 2; ++a)
#pragma unroll
            for (int b = 0; b < 2; ++b)
#pragma unroll
                for (int m = 0; m < 4; ++m)
#pragma unroll
                    for (int n = 0; n < 2; ++n) acc[a][b][m][n] = (f32x4){0.f, 0.f, 0.f, 0.f};
        cur = nxt; cA = nA; cB = nB; ++ui;
        if constexpr (ALIGN_EPI) { if (wr == 1) PG8_BAR; }
    }
    PG8_WAIT_V(0);
    if constexpr (!ALIGN_EPI) { if (wr == 0) PG8_BAR; }
    PG8_BAR;
#undef PG8_SA
#undef PG8_SB
#undef PG8_STAGE
#undef PG8_LDA
#undef PG8_LDB
#undef PG8_MMA
#undef PG8_WAIT_V
#undef PG8_WAIT_L
#undef PG8_BAR
#undef PG8_SCHED
}
}

namespace fox {
constexpr int D = 128, LDQ = 8192, LDO = 2048;
constexpr float SCALE = 0.08838834764831845f;
constexpr float THR2 = 8.f * 1.4426950408889634f;
constexpr int NW = 8, QBLK = 32, KVBLK = 64, QB = NW * QBLK;
constexpr int SHM_V = KVBLK * D * 2, SHM_K = KVBLK * D * 2;
constexpr int BIAS_OFF = 2 * SHM_V + 2 * SHM_K + NW * 64 * 4;
constexpr int LDS_BYTES = BIAS_OFF + 8192 * 4;

#define KSWZ(row, colB) ((row) * 256 + ((colB) ^ (((row) & 7) << 4)))
#define SBAR() __builtin_amdgcn_sched_barrier(0)
__device__ __forceinline__ int v_st(int k, int c) { const int kk = (k & ~0xC) | ((k & 4) << 1) | ((k & 8) >> 1); return ((kk >> 3) * 4 + (c >> 5)) * 512 + ((kk & 7) * 32 + (c & 31)) * 2; }
__device__ __forceinline__ int v_rd_base(int lane) { return ((lane & 3) << 3) | (((lane >> 2) & 3) << 6) | (((lane >> 4) & 1) << 5) | (((lane >> 5) & 1) << 8); }
constexpr int v_rd_off(int d0, int ks, int half) { return d0 * 512 + ks * 4096 + half * 2048; }
__device__ __forceinline__ int crow(int r, int hi) { return (r & 3) + 8 * (r >> 2) + 4 * hi; }
__device__ __forceinline__ unsigned cvtpk(float lo, float hi) { unsigned r; asm volatile("v_cvt_pk_bf16_f32 %0, %1, %2" : "=v"(r) : "v"(lo), "v"(hi)); return r; }
__device__ __forceinline__ bf16x8 load8(const bf16* p) { return *reinterpret_cast<const bf16x8*>(p); }
__device__ __forceinline__ void mask_tile(f32x16& p0, f32x16& p1, int dq) {
    const float NEG = -__builtin_inff();
#pragma unroll
    for (int r = 0; r < 16; ++r) {
        const int c = (r & 3) + 8 * (r >> 2);
        if (dq - c < 0) p0[r] = NEG;
        if (dq - c - 32 < 0) p1[r] = NEG;
    }
}
__device__ __forceinline__ void partialSM(f32x16& p0, f32x16& p1, float& m_reg, float& mn, float& alpha, const float* bl) {
    constexpr float C2 = 1.4426950408889634f * SCALE;
#pragma unroll
    for (int a = 0; a < 4; ++a) {
#ifdef FOX_NOBIAS
        const f32x4 b0 = {0,0,0,0}, b1 = {0,0,0,0};
#else
        const f32x4 b0 = *(const f32x4*)(bl + 8 * a), b1 = *(const f32x4*)(bl + 32 + 8 * a);
#endif

#pragma unroll
        for (int i = 0; i < 4; ++i) { p0[4 * a + i] = fmaf(p0[4 * a + i], C2, b0[i]); p1[4 * a + i] = fmaf(p1[4 * a + i], C2, b1[i]); }
        SBAR(); }
    float pmax = p0[0]; for (int r = 1; r < 16; ++r) pmax = fmaxf(pmax, p0[r]); for (int r = 0; r < 16; ++r) pmax = fmaxf(pmax, p1[r]);
    { auto rr = __builtin_amdgcn_permlane32_swap(__float_as_uint(pmax), __float_as_uint(pmax), false, false);
      pmax = fmaxf(__uint_as_float(rr[0]), __uint_as_float(rr[1])); }
    if (__builtin_expect(__all((pmax - m_reg) <= THR2), 1)) { mn = m_reg; alpha = 1.f; }
    else { mn = fmaxf(m_reg, pmax); alpha = __builtin_amdgcn_exp2f(m_reg - mn); m_reg = mn; }
    for (int r = 0; r < 16; ++r) p0[r] = p0[r] - mn; for (int r = 0; r < 16; ++r) p1[r] = p1[r] - mn;
    for (int r = 0; r < 16; ++r) p0[r] = __builtin_amdgcn_exp2f(p0[r]);
}
__device__ __forceinline__ void finishSM(f32x16& p0, f32x16& p1, float alpha, float& l_reg, bf16x8& pa0, bf16x8& pa1, bf16x8& pa2, bf16x8& pa3) {
    for (int r = 0; r < 16; ++r) p1[r] = __builtin_amdgcn_exp2f(p1[r]);
    float ps = 0; for (int r = 0; r < 16; ++r) ps += p0[r]; for (int r = 0; r < 16; ++r) ps += p1[r];
    { auto rr = __builtin_amdgcn_permlane32_swap(__float_as_uint(ps), __float_as_uint(ps), false, false);
      ps = __uint_as_float(rr[0]) + __uint_as_float(rr[1]); }
    l_reg = l_reg * alpha + ps;
#define PK4(P, B_, OUT) do { unsigned a0 = cvtpk(P[B_+0], P[B_+1]), a1 = cvtpk(P[B_+2], P[B_+3]);                          \
        unsigned b0 = cvtpk(P[B_+4], P[B_+5]), b1 = cvtpk(P[B_+6], P[B_+7]);                                             \
        auto r0 = __builtin_amdgcn_permlane32_swap(a0, b0, false, false); auto r1 = __builtin_amdgcn_permlane32_swap(a1, b1, false, false); \
        u32x4 w = {r0[0], r1[0], r0[1], r1[1]}; OUT = *reinterpret_cast<bf16x8*>(&w); } while (0)
    PK4(p0, 0, pa0); PK4(p0, 8, pa1); PK4(p1, 0, pa2); PK4(p1, 8, pa3);
#undef PK4
}
template <int KB>
__device__ __forceinline__ void qkt(f32x16& p0, f32x16& p1, const char* K_lds, int r32, int hi, const bf16x8* qr) {
    p0 = f32x16{}; p1 = f32x16{};
    const char* kb[4];
#pragma unroll
    for (int dd = 0; dd < 4; ++dd) kb[dd] = K_lds + KB * SHM_K + KSWZ(r32, (dd * 16 + hi * 8) * 2);
#pragma unroll
    for (int d0 = 0; d0 < 8; ++d0) { const char* a = kb[d0 & 3] + (d0 >> 2) * 128;
        bf16x8 b0 = *reinterpret_cast<const bf16x8*>(a);
        bf16x8 b1 = *reinterpret_cast<const bf16x8*>(a + 32 * 256);
        p0 = __builtin_amdgcn_mfma_f32_32x32x16_bf16(b0, qr[d0], p0, 0, 0, 0);
        p1 = __builtin_amdgcn_mfma_f32_32x32x16_bf16(b1, qr[d0], p1, 0, 0, 0); }
}
template <int VB>
__device__ __forceinline__ void pv_tile(f32x16* o, int vb0, bf16x8 pa0, bf16x8 pa1, bf16x8 pa2, bf16x8 pa3) {
#define TRRD(dst, off) asm volatile("ds_read_b64_tr_b16 %0, %1 offset:%2" : "=&v"(dst) : "v"(vb0), "i"(off) : "memory")
#define PV_D0(d0) do { s16x4 l0, l1, l2, l3, h0, h1, h2, h3; constexpr int b_ = VB * SHM_V + v_rd_off(d0, 0, 0); \
        TRRD(l0, b_); TRRD(h0, b_ + 2048); TRRD(l1, b_ + 4096); TRRD(h1, b_ + 6144); TRRD(l2, b_ + 8192); TRRD(h2, b_ + 10240); TRRD(l3, b_ + 12288); TRRD(h3, b_ + 14336); \
        asm volatile("s_waitcnt lgkmcnt(0)" ::: "memory"); SBAR();   \
        o[d0] = __builtin_amdgcn_mfma_f32_32x32x16_bf16(pa0, (bf16x8){l0[0], l0[1], l0[2], l0[3], h0[0], h0[1], h0[2], h0[3]}, o[d0], 0, 0, 0);   \
        o[d0] = __builtin_amdgcn_mfma_f32_32x32x16_bf16(pa1, (bf16x8){l1[0], l1[1], l1[2], l1[3], h1[0], h1[1], h1[2], h1[3]}, o[d0], 0, 0, 0);   \
        o[d0] = __builtin_amdgcn_mfma_f32_32x32x16_bf16(pa2, (bf16x8){l2[0], l2[1], l2[2], l2[3], h2[0], h2[1], h2[2], h2[3]}, o[d0], 0, 0, 0);   \
        o[d0] = __builtin_amdgcn_mfma_f32_32x32x16_bf16(pa3, (bf16x8){l3[0], l3[1], l3[2], l3[3], h3[0], h3[1], h3[2], h3[3]}, o[d0], 0, 0, 0); } while (0)
    PV_D0(0); PV_D0(1); PV_D0(2); PV_D0(3);
#undef PV_D0
#undef TRRD
}

struct BlockRef { const bf16* Q; const bf16* K; const bf16* V; const bf16* G; bf16* O; int P0; };
struct Seam { bf16x8 qr[8]; bf16x8 st_v0, st_v1, st_k0, st_k1; };
#define LD8(base, boff) (*reinterpret_cast<const bf16x8*>((const char*)(base) + (boff)))
#define VMW() asm volatile("s_waitcnt vmcnt(0)" ::: "memory")
#define VMWN(n) asm volatile("s_waitcnt vmcnt(%0)" :: "i"(n) : "memory")
#define SLOAD_H(Kp, Vp, k0) do { const char* kb__ = (const char*)(Kp) + (size_t)(k0) * (LDQ * 2); const char* vb__ = (const char*)(Vp) + (size_t)(k0) * (LDQ * 2); \
                         S.st_v0 = LD8(vb__, kvoff); S.st_v1 = LD8(vb__, kvoff + 32u * LDQ * 2u);              \
                         S.st_k0 = LD8(kb__, kvoff); S.st_k1 = LD8(kb__, kvoff + 32u * LDQ * 2u); } while (0)
#define SWRITE_HK(bf) do { *(bf16x8*)(K_lds + (bf) * SHM_K + kws) = S.st_k0; *(bf16x8*)(K_lds + (bf) * SHM_K + kws + 32 * 256) = S.st_k1; } while (0)
#define SWRITE_HV(bf) do { *(bf16x8*)(V_lds + (bf) * SHM_V + vst0) = S.st_v0; *(bf16x8*)(V_lds + (bf) * SHM_V + vst1) = S.st_v1; } while (0)
#define SWRITE_H(bf) do { SWRITE_HV(bf); SWRITE_HK(bf); } while (0)
__device__ __forceinline__ void prime(const BlockRef& cur, char* lds, Seam& S) {
    const int tid = threadIdx.x, wid = __builtin_amdgcn_readfirstlane(tid >> 6), lane = tid & 63, r32 = lane & 31, hi = lane >> 5;
    const int sr = tid >> 4, sc = (tid & 15) * 8, kws = KSWZ(sr, sc * 2); char* K_lds = lds + 2 * SHM_V;
    const unsigned kvoff = (unsigned)(sr * LDQ + sc) * 2u, qoff = (unsigned)((wid * QBLK + r32) * LDQ + hi * 8) * 2u;
    for (int d0 = 0; d0 < 8; ++d0) S.qr[d0] = LD8(cur.Q, qoff + d0 * 32);
    SLOAD_H(cur.K, cur.V, 0); VMW(); SWRITE_HK(0);
    __syncthreads();
}
__device__ __forceinline__ void block(const BlockRef& cur, const BlockRef& nxt, char* lds, Seam& S) {
    const int tid = threadIdx.x, wid = __builtin_amdgcn_readfirstlane(tid >> 6), lane = tid & 63, r32 = lane & 31, hi = lane >> 5;
    const int NT = (cur.P0 + QB - 1) / KVBLK + 1;
    const int qlo = cur.P0 + wid * QBLK, qm = qlo + r32 - 4 * hi;
    char* V_lds = lds; char* K_lds = lds + 2 * SHM_V;
    float* ws = (float*)(lds + 2 * SHM_V + 2 * SHM_K) + wid * 64; float* li_l = ws, * al_l = ws + 32;
    const float* biasl = (const float*)(lds + BIAS_OFF) + 4 * hi;
    float m_reg = -1e30f, l_reg = 0; f32x16 o[4] = {};
    const int sr = tid >> 4, sc = (tid & 15) * 8, vst0 = v_st(sr, sc), vst1 = v_st(32 + sr, sc), kws = KSWZ(sr, sc * 2);
    const unsigned kvoff = (unsigned)(sr * LDQ + sc) * 2u;
    const int vb0 = (int)(uintptr_t)V_lds + v_rd_base(lane);
    const bf16* Kh = cur.K; const bf16* Vh = cur.V;
#define RESC(a) do { if (__any((a) < 1.f)) { if (hi == 0) al_l[r32] = (a); asm volatile("s_waitcnt lgkmcnt(0)" ::: "memory");              \
                     for (int d_ = 0; d_ < 4; ++d_) for (int r = 0; r < 16; ++r) o[d_][r] *= al_l[crow(r, hi)]; } } while (0)
#define KBASE(t) ((t) * KVBLK)
#define MASKT(P0_, P1_, t) do { const int kb_ = KBASE(t); if (kb_ + KVBLK - 1 > qlo) mask_tile(P0_, P1_, qm - kb_); } while (0)
    constexpr int NQL = 8;
#define SEAM_K0() do { VMWN(NQL); SWRITE_HK(0); SBAR(); } while (0)
    f32x16 pA0, pA1, pB0, pB1; float mnA, mnB, alA, alB; bf16x8 pa0, pa1, pa2, pa3;
    SWRITE_HV(0); SBAR();
    if (NT > 1) { SLOAD_H(Kh, Vh, KBASE(1)); }
    SBAR(); qkt<0>(pA0, pA1, K_lds, r32, hi, S.qr);
    MASKT(pA0, pA1, 0); partialSM(pA0, pA1, m_reg, mnA, alA, biasl + KBASE(0));
    if (NT > 1) { VMW(); SWRITE_H(1); }
    __syncthreads();
#define HALF_STEP(PX0, PX1, mnX, alX, PY0, PY1, alY, t, KB, VB, SB) do {                                                      \
        SBAR(); qkt<KB>(PX0, PX1, K_lds, r32, hi, S.qr);                                                                      \
        finishSM(PY0, PY1, alY, l_reg, pa0, pa1, pa2, pa3); SBAR();                                                           \
        if ((t) + 1 < NT) { SLOAD_H(Kh, Vh, KBASE((t) + 1)); SBAR(); }                                                        \
        pv_tile<VB>(o, vb0, pa0, pa1, pa2, pa3); MASKT(PX0, PX1, (t)); partialSM(PX0, PX1, m_reg, mnX, alX, biasl + KBASE(t)); \
        __syncthreads();                                                                                                      \
        if ((t) + 1 < NT) { VMW(); SWRITE_H(SB); }                                                                            \
        RESC(alX); __syncthreads(); } while (0)
    for (int t = 1; t + 1 < NT; t += 2) {
        HALF_STEP(pB0, pB1, mnB, alB, pA0, pA1, alA, t, 1, 0, 0);
        HALF_STEP(pA0, pA1, mnA, alA, pB0, pB1, alB, t + 1, 0, 1, 1);
    }
    const bool even = (NT & 1) == 0;
    if (even) { SBAR(); qkt<1>(pB0, pB1, K_lds, r32, hi, S.qr); SBAR(); }
    SLOAD_H(nxt.K, nxt.V, 0); SBAR();
    { unsigned qoff = (unsigned)((wid * QBLK + r32) * LDQ + hi * 8) * 2u; asm volatile("" : "+v"(qoff));
#pragma unroll
      for (int d0 = 0; d0 < 8; ++d0) S.qr[d0] = LD8(nxt.Q, qoff + d0 * 32); }
    SBAR();
    finishSM(pA0, pA1, alA, l_reg, pa0, pa1, pa2, pa3); SBAR();
    pv_tile<0>(o, vb0, pa0, pa1, pa2, pa3);
    if (even) { MASKT(pB0, pB1, NT - 1); partialSM(pB0, pB1, m_reg, mnB, alB, biasl + KBASE(NT - 1)); __syncthreads(); RESC(alB);
        finishSM(pB0, pB1, alB, l_reg, pa0, pa1, pa2, pa3); SBAR(); pv_tile<1>(o, vb0, pa0, pa1, pa2, pa3); }
    SBAR(); SEAM_K0();
    if (hi == 0) li_l[r32] = l_reg; asm volatile("s_waitcnt lgkmcnt(0)" ::: "memory");
    float rli[16];
#pragma unroll
    for (int r = 0; r < 16; ++r) rli[r] = __builtin_amdgcn_rcpf(li_l[crow(r, hi)]);
    unsigned ooff = (unsigned)((wid * QBLK + 4 * hi) * LDO + r32) * 2u, goff = (unsigned)((wid * QBLK + 4 * hi) * LDQ + r32) * 2u;
    asm volatile("" : "+v"(ooff), "+v"(goff));
#pragma unroll
    for (int r = 0; r < 16; ++r) { const unsigned rr = (unsigned)((r & 3) + 8 * (r >> 2));
#pragma unroll
        for (int d0 = 0; d0 < 4; ++d0) {
#ifdef FOX_NOGATE
            const float gv = 0.f;
#else
            const float gv = bf2f(*(const bf16*)((const char*)cur.G + (goff + rr * (LDQ * 2u) + d0 * 64u)));
#endif

            const float v = o[d0][r] * rli[r] * (1.0f / (1.0f + __expf(-gv)));
            const float vn = __shfl_xor(v, 1);
            if ((r32 & 1) == 0) *(unsigned*)((char*)cur.O + (ooff + rr * (LDO * 2u) + d0 * 64u)) = cvtpk(v, vn); } }
    __syncthreads();
#undef RESC
#undef KBASE
#undef MASKT
#undef SEAM_K0
#undef HALF_STEP
}
#undef LD8
#undef VMW
#undef VMWN
#undef SLOAD_H
#undef SWRITE_HK
#undef SWRITE_HV
#undef SWRITE_H
#undef KSWZ
#undef SBAR
}

constexpr int NWAVES = 8;
constexpr size_t MiB = 1u << 20;
constexpr size_t WS_CTL = 0, CTL_ZERO_BYTES = 1 * MiB;
constexpr size_t WS_MEMN = 1 * MiB;
constexpr size_t WS_KMEM = 2 * MiB;
constexpr size_t WS_VTMEM = 4 * MiB;
constexpr size_t WS_SMALL = 6 * MiB;
constexpr size_t SM_BONUS = 0;
constexpr size_t SM_FPRE = 512 * 1024;
constexpr size_t SM_BIASL2 = 1024 * 1024;
constexpr size_t SM_BCUM = 1536 * 1024;
constexpr size_t SM_IG = SM_BCUM + 128 * 1024;
constexpr size_t SM_WSTATE = SM_IG + 128 * 1024;
constexpr size_t SM_CHBL = SM_WSTATE + 128 * 1024;
constexpr size_t SM_CHMD = SM_CHBL + 4096;
constexpr size_t SM_MSEQ = SM_CHMD + 4096;
constexpr size_t SM_WCARRY = SM_MSEQ + 4096;
constexpr size_t SM_TOPI = 2048 * 1024;
constexpr size_t SM_TOPG = SM_TOPI + 64 * 1024;
constexpr size_t SM_SLOT = SM_TOPG + 64 * 1024;
constexpr size_t SM_BLKCNT = SM_SLOT + 64 * 1024;
constexpr size_t SM_TILEE = SM_BLKCNT + 8192;
constexpr size_t SM_NU = 3 * 1024 * 1024;
constexpr size_t SM_SLOC = 4 * 1024 * 1024;
constexpr size_t SM_PEND = 5 * 1024 * 1024;
constexpr size_t SM_SIN = 6 * 1024 * 1024;
constexpr size_t WS_X = 16 * MiB;
constexpr size_t WS_XN = 80 * MiB;
constexpr size_t WS_W_XQ = 112 * MiB, WS_W_XKV = 128 * MiB, WS_W_XO = 160 * MiB, WS_W_ABIN = 176 * MiB, WS_W_LORA = 206 * MiB, WS_W_ABOUT = 209 * MiB,
                 WS_W_FFNGU = 217 * MiB, WS_W_FFND = 261 * MiB, WS_W_FOXIN = 283 * MiB, WS_W_FOXOUT = 315 * MiB, WS_W_MOEGU = 323 * MiB, WS_W_MOED = 675 * MiB;
constexpr size_t WS_R = 851 * MiB;
constexpr size_t R_PROJ = WS_R + 0 * MiB;
constexpr size_t R_GATES32 = WS_R + 120 * MiB;
constexpr size_t R_LORAIN = WS_R + 128 * MiB;
constexpr size_t R_LORAOUT = WS_R + 136 * MiB;
constexpr size_t R_SC = WS_R + 232 * MiB;
constexpr size_t SC_STRIDE = 32 * MiB;
constexpr size_t R_Y = WS_R + 424 * MiB;
constexpr size_t R_QB = WS_R + 456 * MiB, R_KB = WS_R + 472 * MiB, R_VB = WS_R + 488 * MiB;
constexpr size_t R_U = WS_R + 504 * MiB;
constexpr size_t R_YCAT = WS_R + 568 * MiB;
constexpr size_t R_XQ = WS_R + 0 * MiB;
constexpr size_t R_XS = WS_R + 32 * MiB;
constexpr size_t R_XP = WS_R + 64 * MiB;
constexpr size_t R_XO = WS_R + 80 * MiB;
constexpr size_t R_ACT = WS_R + 112 * MiB;
constexpr size_t R_QKVG = WS_R + 200 * MiB;
constexpr size_t R_ATTO = WS_R + 328 * MiB;
constexpr size_t R_AG = WS_R + 0 * MiB;
constexpr size_t R_ACTG = WS_R + 72 * MiB;
constexpr size_t R_YG = WS_R + 270 * MiB;
constexpr size_t R_YSIDE = WS_R + 416 * MiB;
constexpr size_t YSIDE_STRIDE = (size_t)8 * 256 * D;
constexpr size_t R_Z = WS_R + 600 * MiB;
constexpr size_t WS_END = WS_R + 624 * MiB;
static_assert(R_YG + (size_t)MOE_ROWS * D * 4 <= WS_END && R_ACTG + (size_t)MOE_ROWS * DFF * 2 <= R_YG && R_YCAT + (size_t)T * D * 2 <= WS_END, "ws map");
static_assert(WS_W_MOED + (size_t)NEXP * D * DFF * 2 <= WS_R && WS_W_MOEGU + (size_t)NEXP * 2 * DFF * D * 2 <= WS_W_MOED, "ws map (weights)");
constexpr int CW_BAR = 4096;

constexpr int RING_OFF = 0, RING_BYTES = 147456;
constexpr int LDSCTL_OFF = RING_BYTES, MISC_OFF = LDSCTL_OFF + 320;
constexpr int LDS_BYTES = RING_BYTES + 4096;

typedef GAS unsigned gu32;
#define RLX_AGENT __ATOMIC_RELAXED, __HIP_MEMORY_SCOPE_AGENT
#define LDS_WAIT() asm volatile("s_waitcnt lgkmcnt(0)" ::: "memory")
#define VM_WAIT() asm volatile("s_waitcnt vmcnt(0)" ::: "memory")

#define XB_TMO      128
#define XB_XCNT(j)  (256  + 64 * (j))
#define XB_XSUB(j)  (1280 + 64 * (j))
#define XB_XGEN(j)  (2304 + 64 * (j))
#define XB_TOP      3328
#define XB_TOPGEN   3392
#define XCD_BAR_WORDS 3456
#define XB_SPIN_CAP (1u << 18)
__device__ __forceinline__ unsigned xb_ld(unsigned* p)              { return __hip_atomic_load(p, __ATOMIC_RELAXED, __HIP_MEMORY_SCOPE_AGENT); }
__device__ __forceinline__ unsigned xb_add(unsigned* p, unsigned v) { return __hip_atomic_fetch_add(p, v, __ATOMIC_RELAXED, __HIP_MEMORY_SCOPE_AGENT); }
__device__ __forceinline__ unsigned xb_xcc_id() { return (unsigned)__builtin_amdgcn_s_getreg((3 << 11) | 20) & 0xFu; }
#define XB_SPIN(cond, bar) do { unsigned _sp = 0; while (cond) { __builtin_amdgcn_s_sleep(1); \
    if ((++_sp & 255u) == 0u) { if (xb_ld(&(bar)[XB_TMO])) break; if (_sp > XB_SPIN_CAP) { atomicAdd(&(bar)[XB_TMO], 1u); break; } } } } while (0)
struct XcdBarrier { unsigned* bar; unsigned x; volatile LAS unsigned* st; };
__device__ __forceinline__ XcdBarrier xcd_barrier_post(unsigned* bar, volatile LAS unsigned* st) {
    XcdBarrier b; b.bar = bar; b.x = xb_xcc_id(); b.st = st;
    if (threadIdx.x == 0) (void)xb_add(&bar[XB_XCNT(b.x)], 1u);
    return b;
}
__device__ __forceinline__ void xcd_barrier_complete(unsigned* bar, unsigned x, unsigned& nloc, unsigned& nx) {
    const unsigned G = gridDim.x * gridDim.y * gridDim.z;
    unsigned sum, cnt, mine, sp = 0u;
    for (;;) {
        sum = 0u; cnt = 0u; mine = 0u;
#pragma unroll
        for (unsigned j = 0; j < 16; ++j) { const unsigned c = xb_ld(&bar[XB_XCNT(j)]); sum += c; cnt += (c > 0u) ? 1u : 0u; mine = (j == x) ? c : mine; }
        if (sum == G) break;
        __builtin_amdgcn_s_sleep(1);
        if ((++sp & 255u) == 0u) { if (xb_ld(&bar[XB_TMO])) break; if (sp > XB_SPIN_CAP) { atomicAdd(&bar[XB_TMO], 1u); break; } }
    }
    nloc = mine > 0u ? mine : 1u; nx = cnt > 0u ? cnt : 1u;
}
__device__ __forceinline__ void xcd_barrier(const XcdBarrier& b) {
    asm volatile("s_waitcnt vmcnt(0)" ::: "memory");
    __syncthreads();
    if (threadIdx.x == 0) {
        unsigned* bar = b.bar;
        __builtin_amdgcn_s_waitcnt(0);
        unsigned nloc = b.st[0], nx = b.st[1];
        if (nloc == 0u) { xcd_barrier_complete(bar, b.x, nloc, nx); b.st[0] = nloc; b.st[1] = nx; }
        const unsigned old = xb_add(&bar[XB_XSUB(b.x)], 1u);
        const unsigned gen = old / nloc;
        if (old + 1u == (gen + 1u) * nloc) {
            __builtin_amdgcn_fence(__ATOMIC_RELEASE, "agent");
            asm volatile("s_waitcnt vmcnt(0)" ::: "memory");
            const unsigned og = xb_add(&bar[XB_TOP], 1u);
            const unsigned tg = og / nx;
            if (og + 1u == (tg + 1u) * nx) xb_add(&bar[XB_TOPGEN], 1u);
            else XB_SPIN(xb_ld(&bar[XB_TOPGEN]) == tg, bar);
            __builtin_amdgcn_fence(__ATOMIC_ACQUIRE, "agent");
            xb_add(&bar[XB_XGEN(b.x)], 1u);
            asm volatile("s_waitcnt vmcnt(0)" ::: "memory");
        } else {
            XB_SPIN(xb_ld(&bar[XB_XGEN(b.x)]) == gen, bar);
            __builtin_amdgcn_fence(__ATOMIC_ACQUIRE, "agent");
            asm volatile("s_waitcnt vmcnt(0)" ::: "memory");
        }
    }
    __syncthreads();
}

struct Frame {
    LAS unsigned char* lds; unsigned char* ldsg;
    unsigned char* ws; const float* const* in; float* out;
    int tid, lane, wave, vcu, G, gw, NGW;
};

enum InIdx { I_X = 0, I_MEM, I_MEMG, I_FING, I_NMIXG, I_NXAG, I_NFFNG, I_XWQ, I_XWKV, I_XWO, I_ABWIN, I_ABMU, I_RWW0, I_RWWUP, I_RWA0, I_RWAUP, I_RWGUP, I_RWKK, I_RWKA, I_RWRK,
             I_RWLNG, I_RWLNB, I_MLCONV, I_MLBIF, I_MLNG, I_ABWOUT, I_FFG, I_FFU, I_FFD, I_FOXWIN, I_FOXBF, I_FOXQG, I_FOXKG, I_FOXWOUT, I_ROUTER, I_MOEG, I_MOEU, I_MOED, N_IN };
struct Args { const float* in[N_IN]; float* out; unsigned char* ws; int ph_lo, ph_hi; };
static_assert(sizeof(Args) == (N_IN + 2) * 8 + 8, "Args has no padding");

#define WSP(T_, off) ((T_*)(F.ws + (off)))

__device__ __forceinline__ void rms_row(const float* xrow, const float* g, bf16* orow, int lane, f32x4 (&y)[8]) {
    const f32x4* xr = (const f32x4*)xrow + lane; const f32x4* gr = (const f32x4*)g + lane;
    float s = 0.f;
#pragma unroll
    for (int j = 0; j < 8; ++j) { y[j] = xr[64 * j]; s += (y[j][0] * y[j][0] + y[j][1] * y[j][1]) + (y[j][2] * y[j][2] + y[j][3] * y[j][3]); }
    const float r = 1.0f / sqrtf(wave_sum(s) * (1.0f / D) + 1e-6f);
#pragma unroll
    for (int j = 0; j < 8; ++j) { const f32x4 gv = gr[64 * j]; y[j] = y[j] * r * gv; }
    if (orow) { u32x2* o8 = (u32x2*)orow + lane;
#pragma unroll
        for (int j = 0; j < 8; ++j) { u32x2 w; w.x = cvt_pk_bf16(y[j][0], y[j][1]); w.y = cvt_pk_bf16(y[j][2], y[j][3]); o8[64 * j] = w; } }
}
__device__ __forceinline__ void norm_phase(const Frame& F, const float* X, const float* g, bf16* XN, int nrows) {
    for (int t = F.gw; t < nrows; t += F.NGW) { f32x4 y[8]; rms_row(X + (size_t)t * D, g, XN + (size_t)t * D, F.lane, y); }
}
template <int NC>
__device__ __forceinline__ void stage_skinny(const Frame& F, const float* W, int ldw, int c0, LAS float* Ws) {
    for (int i = F.tid; i < D * NC; i += NWAVES * 64) { const int e = i / NC, c = i % NC; Ws[c * D + e] = W[(size_t)e * ldw + c0 + c]; }
}
template <int NC>
__device__ __forceinline__ void skinny_dot(const f32x4 (&y)[8], const LAS float* Ws, int lane, float (&out)[NC]) {
#pragma unroll
    for (int c = 0; c < NC; ++c) { float s = 0.f;
#pragma unroll
        for (int j = 0; j < 8; ++j) { const f32x4 w = *(const LAS f32x4*)(Ws + c * D + 256 * j + 4 * lane); s += (y[j][0] * w[0] + y[j][1] * w[1]) + (y[j][2] * w[2] + y[j][3] * w[3]); }
        out[c] = wave_sum(s); }
}

__device__ __forceinline__ void titem_load(const float* W, int ldw, int k0, int n0, int nvalid, int lane, float (&v)[32]) {
    const int n = lane & 31; const float* p = W + (size_t)(k0 + (lane >> 5)) * ldw + n0 + n;
#pragma unroll
    for (int i = 0; i < 32; ++i) v[i] = (n < nvalid) ? __builtin_nontemporal_load(p + (size_t)(2 * i) * ldw) : 0.f;
}
__device__ __forceinline__ void titem_finish(const float (&v)[32], int k0, int nvalid, bf16* WT0  , int K, LAS float* scr, int lane) {
#pragma unroll
    for (int i = 0; i < 32; ++i) scr[(2 * i + (lane >> 5)) * 33 + (lane & 31)] = v[i];
    LDS_WAIT(); asm volatile("" ::: "memory");
    const int c = lane & 7;
#pragma unroll
    for (int j = 0; j < 4; ++j) { const int n = (lane >> 3) + 8 * j; const LAS float* s = scr + (8 * c) * 33 + n;
        u32x4 o; o.x = cvt_pk_bf16(s[0 * 33], s[1 * 33]); o.y = cvt_pk_bf16(s[2 * 33], s[3 * 33]); o.z = cvt_pk_bf16(s[4 * 33], s[5 * 33]); o.w = cvt_pk_bf16(s[6 * 33], s[7 * 33]);
        if (n < nvalid) __builtin_nontemporal_store(o, (u32x4*)(WT0 + (size_t)n * K + k0 + 8 * c)); }
    LDS_WAIT(); asm volatile("" ::: "memory");
}
__device__ __forceinline__ void transpose_matrix(const Frame& F, int gw, int NGW, const float* W, int ldw, int K, int N, bf16* WT, int mode, int& it0, LAS float* scr) {
    const int nblk = (N + 31) / 32, nitems = (K / 64) * nblk;
    int first = gw - (it0 % NGW); if (first < 0) first += NGW;
    it0 += nitems;
    if (first >= nitems) return;
    float va[32], vb[32];
    { const int kb = first / nblk, nb = first % nblk, n0 = 32 * nb; titem_load(W, ldw, 64 * kb, n0, (N - n0) < 32 ? (N - n0) : 32, F.lane, va); }
    for (int r = first; r < nitems; r += NGW) {
        const int kb = r / nblk, nb = r % nblk, n0 = 32 * nb; const int nvalid = (N - n0) < 32 ? (N - n0) : 32;
        const int drow = mode == 0 ? n0 : ((n0 >> 7) * 256 + (n0 & 127) + (mode == 2 ? 128 : 0));
        const int rn = r + NGW;
        if (rn < nitems) { const int kbn = rn / nblk, nbn = rn % nblk, n0n = 32 * nbn; titem_load(W, ldw, 64 * kbn, n0n, (N - n0n) < 32 ? (N - n0n) : 32, F.lane, vb); }
        titem_finish(va, 64 * kb, nvalid, WT + (size_t)drow * K, K, scr, F.lane);
#pragma unroll
        for (int i = 0; i < 32; ++i) va[i] = vb[i];
    }
}
__device__ __forceinline__ void p_convert_early(const Frame& F, const Args& A) {
    LAS float* scr = (LAS float*)(F.lds + RING_OFF + F.wave * 16384);
    int it0 = 0;
    for (int l = 0; l < 2; ++l)
        transpose_matrix(F, F.gw, F.NGW, A.in[I_XWKV] + (size_t)l * D * 2 * D, 2 * D, D, 2 * D, WSP(bf16, WS_W_XKV) + (size_t)l * 2 * D * D, 0, it0, scr);
    transpose_matrix(F, F.gw, F.NGW, A.in[I_ABWIN], AB_COLS, D, AB_COLS, WSP(bf16, WS_W_ABIN), 0, it0, scr);
    const int gt = F.gw * 64 + F.lane, NGT = F.NGW * 64;
    { u32x4* z = (u32x4*)(WSP(bf16, WS_W_ABIN) + (size_t)AB_COLS * D); const int n16 = (AB_PAD - AB_COLS) * D * 2 / 16;
      for (int i = gt; i < n16; i += NGT) z[i] = (u32x4){0u, 0u, 0u, 0u}; }
    { bf16* WL = WSP(bf16, WS_W_LORA); const float* wup = A.in[I_RWWUP]; const float* aup = A.in[I_RWAUP]; const float* gup = A.in[I_RWGUP];
      for (int i = gt; i < 3072 * 64; i += NGT) { const int n = i >> 6, k8 = (i & 63) * 8; const int sec = n >> 10, nn = n & 1023; float v[8];
#pragma unroll
          for (int j = 0; j < 8; ++j) { const int k = k8 + j; float x = 0.f;
              if (sec == 0) { if (k < 96) x = wup[(size_t)k * 1024 + nn]; }
              else if (sec == 1) { if (k >= 96 && k < 192) x = aup[(size_t)(k - 96) * 1024 + nn]; }
              else { if (k >= 192 && k < 448) x = gup[(size_t)(k - 192) * 1024 + nn]; }
              v[j] = x; }
          u32x4 o; o.x = cvt_pk_bf16(v[0], v[1]); o.y = cvt_pk_bf16(v[2], v[3]); o.z = cvt_pk_bf16(v[4], v[5]); o.w = cvt_pk_bf16(v[6], v[7]);
          *(u32x4*)(WL + (size_t)n * 512 + k8) = o; } }
    norm_phase(F, A.in[I_MEM], A.in[I_MEMG], WSP(bf16, WS_MEMN), NMEM);
    norm_phase(F, A.in[I_X], A.in[I_NMIXG], WSP(bf16, WS_XN), T);
}
__device__ __forceinline__ void p_convert_late(const Frame& F, const Args& A, int gw, int NGW, LAS float* scr, bool with_dense, int e_lo, int e_hi) {
    int it0 = 0;
    if (with_dense) {
        transpose_matrix(F, gw, NGW, A.in[I_ABWOUT], D, D, D, WSP(bf16, WS_W_ABOUT), 0, it0, scr);
        for (int l = 0; l < 2; ++l) {
            transpose_matrix(F, gw, NGW, A.in[I_XWQ] + (size_t)l * D * D, D, D, D, WSP(bf16, WS_W_XQ) + (size_t)l * D * D, 0, it0, scr);
            transpose_matrix(F, gw, NGW, A.in[I_XWO] + (size_t)l * D * D, D, D, D, WSP(bf16, WS_W_XO) + (size_t)l * D * D, 0, it0, scr);
        }
        transpose_matrix(F, gw, NGW, A.in[I_FFG], DFF, D, DFF, WSP(bf16, WS_W_FFNGU), 1, it0, scr);
        transpose_matrix(F, gw, NGW, A.in[I_FFU], DFF, D, DFF, WSP(bf16, WS_W_FFNGU), 2, it0, scr);
        transpose_matrix(F, gw, NGW, A.in[I_FFD], D, DFF, D, WSP(bf16, WS_W_FFND), 0, it0, scr);
        transpose_matrix(F, gw, NGW, A.in[I_FOXWIN], FOX_LD, D, 8192, WSP(bf16, WS_W_FOXIN), 0, it0, scr);
        transpose_matrix(F, gw, NGW, A.in[I_FOXWOUT], D, D, D, WSP(bf16, WS_W_FOXOUT), 0, it0, scr);
    }
    for (int e = e_lo; e < e_hi; ++e) {
        transpose_matrix(F, gw, NGW, A.in[I_MOEG] + (size_t)e * D * DFF, DFF, D, DFF, WSP(bf16, WS_W_MOEGU) + (size_t)e * 2 * DFF * D, 1, it0, scr);
        transpose_matrix(F, gw, NGW, A.in[I_MOEU] + (size_t)e * D * DFF, DFF, D, DFF, WSP(bf16, WS_W_MOEGU) + (size_t)e * 2 * DFF * D, 2, it0, scr);
        transpose_matrix(F, gw, NGW, A.in[I_MOED] + (size_t)e * DFF * D, D, DFF, D, WSP(bf16, WS_W_MOED) + (size_t)e * D * DFF, 0, it0, scr);
    }
}

struct InprojKvOrder {
    const bf16* xn; const bf16* wabin; const bf16* memn; const bf16* wkv; int G, c;
    __device__ __forceinline__ bool next(int i, pg8::Unit& u) const {
        const int L = i * G + c; u.pad = 0;
        if (L < 32 * (AB_PAD / 256)) { int pm, pn; pg8::static_tile(i, G, c, 32, AB_PAD / 256, pm, pn); u.pm = pm; u.pn = pn; u.aux = -1;
            u.a = (const char*)(xn + (size_t)pm * 256 * D); u.b = (const char*)(wabin + (size_t)pn * 256 * D); return true; }
        const int j = L - 32 * (AB_PAD / 256); if (j >= 32) return false;
        const int l = j >> 4, kind = (j >> 3) & 1, idx = j & 7; const bf16* w = wkv + (size_t)l * 2 * D * D;
        if (kind == 0) { u.a = (const char*)memn; u.b = (const char*)(w + (size_t)idx * 256 * D); u.pm = 0; u.pn = idx; }
        else { u.a = (const char*)(w + (size_t)(D + idx * 256) * D); u.b = (const char*)memn; u.pm = idx; u.pn = 0; }
        u.aux = l * 2 + kind; return true;
    }
};
struct EpiInprojKv {
    static constexpr bool PERM = true;
    bf16* proj; float* gates32; bf16* kmem; bf16* vtmem;
    __device__ __forceinline__ void operator()(const f32x4 (&acc)[2][2][4][2], const pg8::Unit& u, int wr, int wc, int fr, int fq) const {
        if (u.aux < 0) { pg8::EpiBf16 E{proj, AB_PAD, gates32, 29}; E(acc, u, wr, wc, fr, fq); }
        else { const int l = u.aux >> 1, kind = u.aux & 1;
            pg8::EpiBf16 E{kind == 0 ? kmem + (size_t)l * NMEM * D : vtmem + (size_t)l * D * NMEM, kind == 0 ? D : NMEM, nullptr, -1};
            E(acc, u, wr, wc, fr, fq); }
    }
};

__device__ __forceinline__ void p_prepa(const Frame& F, const Args& A) {
    const bf16* PROJ = WSP(bf16, R_PROJ); const float* mu = A.in[I_ABMU]; const float* convw = A.in[I_MLCONV];
    bf16* LIN = WSP(bf16, R_LORAIN); bf16* QB = WSP(bf16, R_QB); bf16* KB = WSP(bf16, R_KB); bf16* VB = WSP(bf16, R_VB);
    const int lane = F.lane;
    for (int t = F.gw; t < T; t += F.NGW) {
        const bf16* p0 = PROJ + (size_t)t * AB_PAD;
#pragma unroll
        for (int i = 0; i < 7; ++i) { const int cc = lane + 64 * i, c = 3072 + cc; const float p = bf2f(p0[c]); const float pp = t > 0 ? bf2f(p0[c - AB_PAD]) : 0.f;
            const float s = p + (pp - p) * mu[c]; float o;
            if (cc < 96) o = tanhf(s); else if (cc < 192) o = s; else o = sigmoidf_(s);
            LIN[(size_t)t * 512 + cc] = f2bf(o); }
        LIN[(size_t)t * 512 + 448 + lane] = 0;
#pragma unroll
        for (int i = 0; i < 4; ++i) { const int c = 8 * lane + 512 * i; float acc[8];
#pragma unroll
            for (int j = 0; j < 8; ++j) acc[j] = 0.f;
#pragma unroll
            for (int tap = 0; tap < 4; ++tap) { const int tt = t - 3 + tap; if (tt >= 0) {
                const bf16x8 v = *(const bf16x8*)(PROJ + (size_t)tt * AB_PAD + A_COLS + c); const f32x4 w0 = *(const f32x4*)(convw + tap * 2048 + c), w1 = *(const f32x4*)(convw + tap * 2048 + c + 4);
#pragma unroll
                for (int j = 0; j < 4; ++j) { acc[j] += bf2f((unsigned short)v[j]) * w0[j]; acc[4 + j] += bf2f((unsigned short)v[4 + j]) * w1[j]; } } }
            const float sc = c < 1024 ? 0.0625f : 1.0f; float o[8];
#pragma unroll
            for (int j = 0; j < 8; ++j) o[j] = acc[j] * sigmoidf_(acc[j]) * sc;
            u32x4 w; w.x = cvt_pk_bf16(o[0], o[1]); w.y = cvt_pk_bf16(o[2], o[3]); w.z = cvt_pk_bf16(o[4], o[5]); w.w = cvt_pk_bf16(o[6], o[7]);
            if (c < 1024) *(u32x4*)(QB + (size_t)t * 1024 + c) = w; else *(u32x4*)(KB + (size_t)t * 1024 + c - 1024) = w; }
#pragma unroll
        for (int i = 0; i < 2; ++i) { const int c = 8 * lane + 512 * i; *(u32x4*)(VB + (size_t)t * 1024 + c) = *(const u32x4*)(p0 + 5568 + c); }
    }
    const float* G32 = WSP(float, R_GATES32); const float* bif = A.in[I_MLBIF];
    float* BCUM = WSP(float, WS_SMALL + SM_BCUM); float* IG = WSP(float, WS_SMALL + SM_IG); float* CHBL = WSP(float, WS_SMALL + SM_CHBL); float* CHMD = WSP(float, WS_SMALL + SM_CHMD);
    for (int u = F.gw; u < NH_M * 128; u += F.NGW) { const int h = u >> 7, c = u & 127, t = 64 * c + lane;
        const float ig = G32[(size_t)t * 256 + 192 + h] + bif[h], fg = G32[(size_t)t * 256 + 196 + h] + bif[4 + h];
        float b = logsigmoidf_(fg);
#pragma unroll
        for (int o = 1; o < 64; o <<= 1) { const float x = __shfl_up(b, o); if (lane >= o) b += x; }
        const float bl = __shfl(b, 63); const float md = wave_max(bl - b + ig);
        BCUM[h * T + t] = b; IG[h * T + t] = ig;
        if (lane == 0) { CHBL[u] = bl; CHMD[u] = md; } }
}

__device__ __forceinline__ void p_prepb(const Frame& F, const Args& A) {
    const bf16* PROJ = WSP(bf16, R_PROJ); const float* LOUT = WSP(float, R_LORAOUT); const float* mu = A.in[I_ABMU];
    const float* w0 = A.in[I_RWW0]; const float* a0 = A.in[I_RWA0]; const float* kk_ = A.in[I_RWKK]; const float* ka_ = A.in[I_RWKA]; const float* rk_ = A.in[I_RWRK];
    float* SR = WSP(float, R_SC); float* SW = WSP(float, R_SC + SC_STRIDE); float* SKM = WSP(float, R_SC + 2 * SC_STRIDE); float* SV = WSP(float, R_SC + 3 * SC_STRIDE);
    float* SKK = WSP(float, R_SC + 4 * SC_STRIDE); float* SB = WSP(float, R_SC + 5 * SC_STRIDE); float* BONUS = WSP(float, WS_SMALL + SM_BONUS);
    const int lane = F.lane;
    for (int u = F.gw; u < NH_R * (T / 64); u += F.NGW) { const int h = u & 15, tb = u >> 4, c = 64 * h + lane, t0 = 64 * tb;
        const float mur = mu[c], muk = mu[1024 + c], muv = mu[2048 + c], w0c = w0[c], a0c = a0[c], kkc = kk_[c], kac = ka_[c], rkc = rk_[c];
        float pr = 0.f, pk = 0.f, pv = 0.f;
        if (t0 > 0) { const bf16* pp = PROJ + (size_t)(t0 - 1) * AB_PAD; pr = bf2f(pp[c]); pk = bf2f(pp[1024 + c]); pv = bf2f(pp[2048 + c]); }
        for (int tt = 0; tt < 64; tt += 4) {
            float xr[4], xk[4], xv[4], lw[4], la[4];
#pragma unroll
            for (int i = 0; i < 4; ++i) { const bf16* p0 = PROJ + (size_t)(t0 + tt + i) * AB_PAD; const float* lo = LOUT + (size_t)(t0 + tt + i) * 3072;
                xr[i] = bf2f(p0[c]); xk[i] = bf2f(p0[1024 + c]); xv[i] = bf2f(p0[2048 + c]); lw[i] = lo[c]; la[i] = lo[1024 + c]; }
            float kk[4], km[4], r[4], v[4], a[4], w[4], q1[4], q2[4];
#pragma unroll
            for (int i = 0; i < 4; ++i) { r[i] = xr[i] + (pr - xr[i]) * mur; const float k = xk[i] + (pk - xk[i]) * muk; v[i] = xv[i] + (pv - xv[i]) * muv; pr = xr[i]; pk = xk[i]; pv = xv[i];
                w[i] = __expf(-0.6065306597126334f * sigmoidf_(lw[i] + w0c)); a[i] = sigmoidf_(a0c + la[i]);
                kk[i] = k * kkc; km[i] = k * (1.0f + (a[i] - 1.0f) * kac); q1[i] = kk[i] * kk[i]; q2[i] = r[i] * km[i] * rkc; }
#pragma unroll
            for (int i = 0; i < 4; ++i) { q1[i] = wave_sum_dpp(q1[i]); q2[i] = wave_sum_dpp(q2[i]); }
#pragma unroll
            for (int i = 0; i < 4; ++i) { const float kn = kk[i] / fmaxf(sqrtf(q1[i]), 1e-12f); const size_t o = (size_t)(t0 + tt + i) * 1024 + c;
                SR[o] = r[i]; SW[o] = w[i]; SKM[o] = km[i]; SV[o] = v[i]; SKK[o] = kn; SB[o] = kn * a[i];
                if (lane == 0) BONUS[(t0 + tt + i) * 16 + h] = q2[i]; }
        }
    }
    if (F.gw < NH_M) { const int h = F.gw;
        const float* BCUM = WSP(float, WS_SMALL + SM_BCUM); const float* IG = WSP(float, WS_SMALL + SM_IG); const float* CHBL = WSP(float, WS_SMALL + SM_CHBL); const float* CHMD = WSP(float, WS_SMALL + SM_CHMD);
        float* MSEQ = WSP(float, WS_SMALL + SM_MSEQ); float* WCARRY = WSP(float, WS_SMALL + SM_WCARRY); float* WSTATE = WSP(float, WS_SMALL + SM_WSTATE);
        const float bl0 = CHBL[h * 128 + lane], bl1 = CHBL[h * 128 + 64 + lane], md0 = CHMD[h * 128 + lane], md1 = CHMD[h * 128 + 64 + lane];
        float m = 0.f, mine_in0 = 0.f, mine_in1 = 0.f, mine_out0 = 0.f, mine_out1 = 0.f;
#pragma unroll
        for (int c = 0; c < 128; ++c) { const float bl = __shfl(c < 64 ? bl0 : bl1, c & 63), md = __shfl(c < 64 ? md0 : md1, c & 63);
            const float mn = fmaxf(bl + m, md);
            if ((c & 63) == lane) { if (c < 64) { mine_in0 = m; mine_out0 = mn; } else { mine_in1 = m; mine_out1 = mn; } }
            m = mn; }
        MSEQ[h * 128 + lane] = mine_in0; MSEQ[h * 128 + 64 + lane] = mine_in1;
        WCARRY[h * 128 + lane] = __expf(bl0 + mine_in0 - mine_out0); WCARRY[h * 128 + 64 + lane] = __expf(bl1 + mine_in1 - mine_out1);
        for (int c = 0; c < 128; ++c) { const float bl = __shfl(c < 64 ? bl0 : bl1, c & 63), mo = __shfl(c < 64 ? mine_out0 : mine_out1, c & 63); const int t = 64 * c + lane;
            WSTATE[h * T + t] = __expf(bl - BCUM[h * T + t] + IG[h * T + t] - mo); }
    }
}

__device__ __forceinline__ float row16_sum(float x) {
    x += __builtin_bit_cast(float, __builtin_amdgcn_update_dpp(0, __builtin_bit_cast(int, x), 0xB1, 0xF, 0xF, true));
    x += __builtin_bit_cast(float, __builtin_amdgcn_update_dpp(0, __builtin_bit_cast(int, x), 0x4E, 0xF, 0xF, true));
    x += __builtin_bit_cast(float, __builtin_amdgcn_update_dpp(0, __builtin_bit_cast(int, x), 0x141, 0xF, 0xF, true));
    x += __builtin_bit_cast(float, __builtin_amdgcn_update_dpp(0, __builtin_bit_cast(int, x), 0x140, 0xF, 0xF, true));
    return x;
}
__device__ __forceinline__ void row16_sum2(float& a, float& b) {
#define DPPF(x, ctrl) __builtin_bit_cast(float, __builtin_amdgcn_update_dpp(0, __builtin_bit_cast(int, x), ctrl, 0xF, 0xF, true))
    a += DPPF(a, 0xB1); b += DPPF(b, 0xB1); a += DPPF(a, 0x4E); b += DPPF(b, 0x4E); a += DPPF(a, 0x141); b += DPPF(b, 0x141); a += DPPF(a, 0x140); b += DPPF(b, 0x140);
#undef DPPF
}
constexpr int SCH = 8;
constexpr int SC_VEC = SCH * 256;
constexpr int SC_BUF = 5 * SC_VEC + 1024;
constexpr int SC_NBUF = 3, SC_NSEG = 4;
constexpr int SC_LDS = SC_NSEG * SC_NBUF * SC_BUF;
constexpr int SC_PROG_OFF = SC_LDS;
constexpr int SC_TOUCH_AHEAD = 12;
__device__ __forceinline__ void row16_sum4(float& a, float& b, float& c, float& d) {
#define DPPF(x, ctrl) __builtin_bit_cast(float, __builtin_amdgcn_update_dpp(0, __builtin_bit_cast(int, x), ctrl, 0xF, 0xF, true))
    a += DPPF(a, 0xB1); b += DPPF(b, 0xB1); c += DPPF(c, 0xB1); d += DPPF(d, 0xB1); a += DPPF(a, 0x4E); b += DPPF(b, 0x4E); c += DPPF(c, 0x4E); d += DPPF(d, 0x4E);
    a += DPPF(a, 0x141); b += DPPF(b, 0x141); c += DPPF(c, 0x141); d += DPPF(d, 0x141); a += DPPF(a, 0x140); b += DPPF(b, 0x140); c += DPPF(c, 0x140); d += DPPF(d, 0x140);
#undef DPPF
}
__host__ __device__ constexpr int sc_len(int s) { return s == 0 ? 3328 : (s == 3 ? 1664 : 1600); }
__host__ __device__ constexpr int sc_tb(int s) { return s == 0 ? 0 : 3328 + (s - 1) * 1600; }
static_assert(sc_tb(3) + sc_len(3) == T, "segments cover the sequence");
__device__ __forceinline__ int sc_seg_of(int t) { return t < 3328 ? 0 : (t < 4928 ? 1 : (t < 6528 ? 2 : 3)); }
template <int SEGI>
__device__ __forceinline__ void p_scan(const Frame& F) {
    constexpr bool TR = SEGI >= 1; constexpr int TB = sc_tb(SEGI), SC_SEG = sc_len(SEGI), SC_SEG0 = sc_len(0);
    const int b = blockIdx.x, head = (b & 7) * 2 + ((b >> 3) & 1), rg = b >> 4, lane = F.lane, row = lane >> 4, j = lane & 15;
    const float* SR = WSP(float, R_SC); const float* SW = WSP(float, R_SC + SC_STRIDE); const float* SKM = WSP(float, R_SC + 2 * SC_STRIDE); const float* SV = WSP(float, R_SC + 3 * SC_STRIDE);
    const float* SKK = WSP(float, R_SC + 4 * SC_STRIDE); const float* SB = WSP(float, R_SC + 5 * SC_STRIDE);
    float* Yo = WSP(float, R_Y) + (size_t)TB * 1024; float* Zo = WSP(float, R_Z) + (size_t)(TR ? TB - SC_SEG0 : 0) * 1024;
    LAS unsigned char* lds = F.lds + RING_OFF + SEGI * SC_NBUF * SC_BUF;
    volatile LAS int* prog = (volatile LAS int*)(F.lds + RING_OFF + SC_PROG_OFF);
    const size_t goff = (size_t)TB * 1024 + (size_t)(lane >> 4) * 1024 + head * 64 + (lane & 15) * 4;
    f32x2 L0 = {0.f, 0.f}, L1 = {0.f, 0.f}, T0 = {0.f, 0.f}, T1 = {0.f, 0.f};
    if (TR) { const int i = rg * 4 + row; if ((i >> 2) == j) { const int e = i & 3; T0[0] = e == 0 ? 1.f : 0.f; T0[1] = e == 1 ? 1.f : 0.f; T1[0] = e == 2 ? 1.f : 0.f; T1[1] = e == 3 ? 1.f : 0.f; } }
#define SC_ISSUE(c_, buf_) do { const size_t t0_ = (size_t)(c_) * SCH * 1024; LAS unsigned char* d_ = lds + (buf_) * SC_BUF; \
        _Pragma("unroll") for (int q = 0; q < SCH / 4; ++q) { const size_t o_ = t0_ + (size_t)q * 4096 + goff; \
            __builtin_amdgcn_global_load_lds((const unsigned*)(SKK + o_), (LAS unsigned*)(d_ + 0 * SC_VEC + q * 1024), 16, 0, 0); \
            __builtin_amdgcn_global_load_lds((const unsigned*)(SW  + o_), (LAS unsigned*)(d_ + 1 * SC_VEC + q * 1024), 16, 0, 0); \
            __builtin_amdgcn_global_load_lds((const unsigned*)(SB  + o_), (LAS unsigned*)(d_ + 2 * SC_VEC + q * 1024), 16, 0, 0); \
            __builtin_amdgcn_global_load_lds((const unsigned*)(SR  + o_), (LAS unsigned*)(d_ + 3 * SC_VEC + q * 1024), 16, 0, 0); \
            __builtin_amdgcn_global_load_lds((const unsigned*)(SKM + o_), (LAS unsigned*)(d_ + 4 * SC_VEC + q * 1024), 16, 0, 0); } \
        { int ts_ = TB + (c_) * SCH + lane; ts_ = ts_ < T ? ts_ : T - 1; \
          __builtin_amdgcn_global_load_lds((const unsigned*)(SV + (size_t)ts_ * 1024 + head * 64 + rg * 4), (LAS unsigned*)(d_ + 5 * SC_VEC), 16, 0, 0); } } while (0)
    __builtin_amdgcn_s_setprio(3);
    constexpr int NCH = SC_SEG / SCH;
    static_assert(NCH % 2 == 0 && SC_NBUF == 3, "three-buffer pipeline, 11 loads per chunk");
    SC_ISSUE(0, 0); SC_ISSUE(1, 1);
    int buf = 0; float ykL = 0.f, ykT = 0.f; f32x2 rp0 = {0.f, 0.f}, rp1 = {0.f, 0.f};
    for (int c = 0; c < NCH; ++c) {
        if (c < NCH - 1) asm volatile("s_waitcnt vmcnt(11)" ::: "memory"); else asm volatile("s_waitcnt vmcnt(0)" ::: "memory");
        if (c + 2 < NCH) { const int nb = buf >= 1 ? buf - 1 : buf + 2; SC_ISSUE(c + 2, nb); }
        if (SEGI == 0 && lane == 0) *prog = c;
        const LAS unsigned char* d = lds + buf * SC_BUF + j * 16;
        const LAS unsigned char* dv = lds + buf * SC_BUF + 5 * SC_VEC + row * 4;
        const int jb = (c & 1) * SCH;
        f32x2 kkA, kkB, wA, wB, bA, bB, kmA, kmB, rA, rB; float vv;
#define SC_LOAD(s_) do { const f32x4 kk_ = *(const LAS f32x4*)(d + 0 * SC_VEC + (s_) * 256), w_ = *(const LAS f32x4*)(d + 1 * SC_VEC + (s_) * 256), b_ = *(const LAS f32x4*)(d + 2 * SC_VEC + (s_) * 256); \
        const f32x4 r_ = *(const LAS f32x4*)(d + 3 * SC_VEC + (s_) * 256), km_ = *(const LAS f32x4*)(d + 4 * SC_VEC + (s_) * 256); vv = *(const LAS float*)(dv + (s_) * 16); \
        kkA = (f32x2){kk_[0], kk_[1]}; kkB = (f32x2){kk_[2], kk_[3]}; wA = (f32x2){w_[0], w_[1]}; wB = (f32x2){w_[2], w_[3]}; bA = (f32x2){b_[0], b_[1]}; bB = (f32x2){b_[2], b_[3]}; \
        rA = (f32x2){r_[0], r_[1]}; rB = (f32x2){r_[2], r_[3]}; kmA = (f32x2){km_[0], km_[1]}; kmB = (f32x2){km_[2], km_[3]}; } while (0)
        SC_LOAD(0);
#pragma unroll
        for (int s = 0; s < SCH; ++s) {
            f32x2 kk0 = kkA, kk1 = kkB, w0 = wA, w1 = wB, b0 = bA, b1 = bB, r0 = rA, r1 = rB, km0 = kmA, km1 = kmB; float v_ = vv;
            asm volatile("" : "+v"(kk0), "+v"(kk1), "+v"(w0), "+v"(w1), "+v"(b0), "+v"(b1), "+v"(r0), "+v"(r1), "+v"(km0), "+v"(km1), "+v"(v_));
            if (s + 1 < SCH) { SC_LOAD(s + 1); }
            __builtin_amdgcn_sched_barrier(0);
            const int keep = (jb + s + 15) & 15;
            if (TR) {
                f32x2 tl = L0 * kk0, ul = L0 * rp0, tt = T0 * kk0, ut = T0 * rp0; tl = L1 * kk1 + tl; ul = L1 * rp1 + ul; tt = T1 * kk1 + tt; ut = T1 * rp1 + ut;
                float sl = tl[0] + tl[1], yl = ul[0] + ul[1], st = tt[0] + tt[1], yt = ut[0] + ut[1];
                row16_sum4(sl, st, yl, yt);
                ykL = (j == keep) ? yl : ykL; ykT = (j == keep) ? yt : ykT;
                if (s == 0 && jb == 0 && c >= 2) { const size_t o = (size_t)((c - 2) * SCH + j) * 1024 + head * 64 + rg * 4 + row; Yo[o] = ykL; Zo[o] = ykT; }
                L0 = L0 * w0 + (km0 * v_ - b0 * sl); L1 = L1 * w1 + (km1 * v_ - b1 * sl); T0 = T0 * w0 - b0 * st; T1 = T1 * w1 - b1 * st;
            } else {
                f32x2 tl = L0 * kk0, ul = L0 * rp0; tl = L1 * kk1 + tl; ul = L1 * rp1 + ul;
                float sl = tl[0] + tl[1], yl = ul[0] + ul[1];
                row16_sum2(sl, yl);
                ykL = (j == keep) ? yl : ykL;
                if (s == 0 && jb == 0 && c >= 2) Yo[(size_t)((c - 2) * SCH + j) * 1024 + head * 64 + rg * 4 + row] = ykL;
                L0 = L0 * w0 + (km0 * v_ - b0 * sl); L1 = L1 * w1 + (km1 * v_ - b1 * sl);
            }
            rp0 = r0; rp1 = r1;
            __builtin_amdgcn_sched_barrier(0);
        }
#undef SC_LOAD
        buf = buf == SC_NBUF - 1 ? 0 : buf + 1;
    }
    { const size_t o = (size_t)(SC_SEG - 16 + j) * 1024 + head * 64 + rg * 4 + row;
      f32x2 u = L0 * rp0; u = L1 * rp1 + u; const float us = row16_sum(u[0] + u[1]); ykL = (j == 15) ? us : ykL; Yo[o] = ykL;
      if (TR) { f32x2 ut = T0 * rp0; ut = T1 * rp1 + ut; const float ut_ = row16_sum(ut[0] + ut[1]); ykT = (j == 15) ? ut_ : ykT; Zo[o] = ykT; } }
    if (SEGI < SC_NSEG - 1) { float* p = WSP(float, WS_SMALL + SM_SLOC) + (((size_t)SEGI * 16 + head) * 64 + rg * 4 + row) * 64 + 4 * j; *(f32x4*)p = (f32x4){L0[0], L0[1], L1[0], L1[1]}; }
    if (TR && SEGI < SC_NSEG - 1) { float* p = WSP(float, WS_SMALL + SM_PEND) + (((size_t)SEGI * 16 + head) * 64 + rg * 4 + row) * 64 + 4 * j; *(f32x4*)p = (f32x4){T0[0], T0[1], T1[0], T1[1]}; }
    asm volatile("s_waitcnt vmcnt(0)" ::: "memory");
    __builtin_amdgcn_s_setprio(0);
#undef SC_ISSUE
}
__device__ __forceinline__ void p_scan_touch(const Frame& F) {
    const int b = blockIdx.x, head = (b & 7) * 2 + ((b >> 3) & 1), lane = F.lane;
    const char* base = (const char*)WSP(float, R_SC); volatile LAS int* prog = (volatile LAS int*)(F.lds + RING_OFF + SC_PROG_OFF);
    constexpr int NCH0 = sc_len(0) / SCH, LPS = SCH * 12;
    unsigned dummy = 0;
    for (int c = 0; c < NCH0; ++c) {
        for (int spin = 0; spin < (1 << 16) && c > *prog + SC_TOUCH_AHEAD; ++spin) __builtin_amdgcn_s_sleep(8);
#pragma unroll
        for (int q = 0; q < 2; ++q) { const int x = q * 64 + lane; if (x < LPS) { const int step = x / 12, arr = (x % 12) >> 1, half = x & 1;
            const char* p = base + (size_t)arr * SC_STRIDE + ((size_t)(c * SCH + step) * 1024 + head * 64 + half * 32) * 4;
            asm volatile("global_load_dword %0, %1, off" : "+v"(dummy) : "v"(p) : "memory"); } }
        if ((c & 1) == 0) { const int c2 = c >> 1;
#pragma unroll
            for (int q = 0; q < 5; ++q) { const int x = q * 64 + lane; if (x < 3 * LPS) { const int seg = 1 + x / LPS, y = x % LPS, step = y / 12, arr = (y % 12) >> 1, half = y & 1;
                if (c2 * SCH < sc_len(seg)) { const char* p = base + (size_t)arr * SC_STRIDE + ((size_t)(sc_tb(seg) + c2 * SCH + step) * 1024 + head * 64 + half * 32) * 4;
                    asm volatile("global_load_dword %0, %1, off" : "+v"(dummy) : "v"(p) : "memory"); } } } }
    }
    asm volatile("s_waitcnt vmcnt(0)" : "+v"(dummy) :: "memory");
}
__device__ __forceinline__ void p_scomb(const Frame& F) {
    const float* SLOC = WSP(float, WS_SMALL + SM_SLOC); const float* PEND = WSP(float, WS_SMALL + SM_PEND); float* SIN = WSP(float, WS_SMALL + SM_SIN); const int lane = F.lane;
    for (int u = F.gw; u < 16 * 64; u += F.NGW) { const int h = u >> 6, v = u & 63;
        float sv = SLOC[((size_t)(0 * 16 + h) * 64 + v) * 64 + lane];
        SIN[((size_t)(1 * 16 + h) * 64 + v) * 64 + lane] = sv;
#pragma unroll
        for (int s = 2; s < SC_NSEG; ++s) { float acc = SLOC[((size_t)((s - 1) * 16 + h) * 64 + v) * 64 + lane]; const float* P = PEND + ((size_t)((s - 1) * 16 + h) * 64) * 64 + lane;
#pragma unroll 8
            for (int i = 0; i < 64; ++i) acc += __builtin_bit_cast(float, __builtin_amdgcn_readlane(__builtin_bit_cast(int, sv), i)) * P[(size_t)i * 64];
            sv = acc; SIN[((size_t)(s * 16 + h) * 64 + v) * 64 + lane] = sv; } }
}

__device__ __forceinline__ void p_rwkv_post(const Frame& F, const Args& A) {
    const float* Y = WSP(float, R_Y); const float* SV = WSP(float, R_SC + 3 * SC_STRIDE); const float* LOUT = WSP(float, R_LORAOUT); const float* BONUS = WSP(float, WS_SMALL + SM_BONUS);
    const float* lng = A.in[I_RWLNG]; const float* lnb = A.in[I_RWLNB]; bf16* YCAT = WSP(bf16, R_YCAT); const int lane = F.lane;
    const float* SIN = WSP(float, WS_SMALL + SM_SIN); const float* Z = WSP(float, R_Z);
    for (int u = F.gw; u < NH_R * (T / 64); u += F.NGW) { const int h = u & 15, tb = u >> 4, c = 64 * h + lane, t0 = 64 * tb; const float lg = lng[c], lb = lnb[c];
        const int seg = sc_seg_of(t0); const bool seg1 = seg >= 1; float sm[64];
        if (seg1) {
#pragma unroll
            for (int q = 0; q < 16; ++q) { const f32x4 x = *(const f32x4*)(SIN + ((size_t)(seg * 16 + h) * 64 + lane) * 64 + 4 * q); sm[4 * q] = x[0]; sm[4 * q + 1] = x[1]; sm[4 * q + 2] = x[2]; sm[4 * q + 3] = x[3]; } }
        for (int tt = 0; tt < 64; tt += 4) { float y[4], sv[4], g[4], bo[4], d[4];
#pragma unroll
            for (int i = 0; i < 4; ++i) { const size_t t = t0 + tt + i; y[i] = Y[t * 1024 + c]; sv[i] = SV[t * 1024 + c]; g[i] = LOUT[t * 3072 + 2048 + c]; bo[i] = BONUS[t * 16 + h]; }
            if (seg1) { float z[4];
#pragma unroll
                for (int i = 0; i < 4; ++i) z[i] = Z[(size_t)(t0 + tt + i - sc_len(0)) * 1024 + c];
#pragma unroll
                for (int q = 0; q < 64; ++q) {
#pragma unroll
                    for (int i = 0; i < 4; ++i) y[i] += sm[q] * __builtin_bit_cast(float, __builtin_amdgcn_readlane(__builtin_bit_cast(int, z[i]), q)); } }
#pragma unroll
            for (int i = 0; i < 4; ++i) d[i] = wave_sum_dpp(y[i]);
#pragma unroll
            for (int i = 0; i < 4; ++i) { y[i] -= d[i] * (1.0f / 64.0f); d[i] = y[i] * y[i]; }
#pragma unroll
            for (int i = 0; i < 4; ++i) d[i] = wave_sum_dpp(d[i]);
#pragma unroll
            for (int i = 0; i < 4; ++i) { const float o = (y[i] * (1.0f / sqrtf(d[i] * (1.0f / 64.0f) + 64e-5f)) * lg + lb + bo[i] * sv[i]) * g[i];
                YCAT[(size_t)(t0 + tt + i) * D + c] = f2bf(o); } } }
}

constexpr int ML_P = 264;
__device__ __forceinline__ void ml_stage_chunk(const Frame& F, const bf16* src  , int h, int c, LAS bf16* dst) {
    for (int i = F.tid; i < 64 * 32; i += NWAVES * 64) { const int s = i >> 5, ch = i & 31;
        *(LAS u32x4*)(dst + s * ML_P + 8 * ch) = *(const u32x4*)(src + (size_t)(64 * c + s) * 1024 + 256 * h + 8 * ch); }
}
__device__ __forceinline__ void p_mlu(const Frame& F) {
    const bf16* KB = WSP(bf16, R_KB); const bf16* VB = WSP(bf16, R_VB); const float* WSTATE = WSP(float, WS_SMALL + SM_WSTATE);
    bf16* U = WSP(bf16, R_U); float* NU = WSP(float, WS_SMALL + SM_NU);
    LAS bf16* Ks = (LAS bf16*)(F.lds + RING_OFF); LAS bf16* Vs = Ks + 64 * ML_P; LAS float* wst = (LAS float*)(Vs + 64 * ML_P);
    const int lane = F.lane, r = lane & 31, hg = lane >> 5, w = F.wave;
    for (int L = F.vcu; L < NH_M * 128; L += F.G) { const int h = L >> 7, c = L & 127;
        __syncthreads();
        ml_stage_chunk(F, KB, h, c, Ks); ml_stage_chunk(F, VB, h, c, Vs);
        if (F.tid < 64) wst[F.tid] = WSTATE[h * T + 64 * c + F.tid];
        __syncthreads();
        f32x16 acc[8];
#pragma unroll
        for (int nt = 0; nt < 8; ++nt) acc[nt] = f32x16{};
#pragma unroll
        for (int ks = 0; ks < 4; ++ks) { bf16x8 a; float av[8];
#pragma unroll
            for (int jj = 0; jj < 8; ++jj) { const int s = 16 * ks + 8 * hg + jj; av[jj] = bf2f(Vs[s * ML_P + 32 * w + r]) * wst[s]; }
            { u32x4 p; p.x = cvt_pk_bf16(av[0], av[1]); p.y = cvt_pk_bf16(av[2], av[3]); p.z = cvt_pk_bf16(av[4], av[5]); p.w = cvt_pk_bf16(av[6], av[7]); a = __builtin_bit_cast(bf16x8, p); }
#pragma unroll
            for (int nt = 0; nt < 8; ++nt) { bf16x8 b;
#pragma unroll
                for (int jj = 0; jj < 8; ++jj) b[jj] = (short)Ks[(16 * ks + 8 * hg + jj) * ML_P + 32 * nt + r];
                acc[nt] = __builtin_amdgcn_mfma_f32_32x32x16_bf16(a, b, acc[nt], 0, 0, 0); } }
        bf16* Uo = U + ((size_t)(h * 128 + c) * 256 + 32 * w) * 256;
#pragma unroll
        for (int nt = 0; nt < 8; ++nt)
#pragma unroll
            for (int q = 0; q < 16; ++q) { const int vl = (q & 3) + 8 * (q >> 2) + 4 * hg; Uo[(size_t)vl * 256 + 32 * nt + r] = f2bf(acc[nt][q]); }
        if (F.tid < 256) { float s = 0.f;
            for (int ss = 0; ss < 64; ++ss) s += wst[ss] * bf2f(Ks[ss * ML_P + F.tid]);
            NU[(size_t)(h * 128 + c) * 256 + F.tid] = s; }
    }
}
__device__ __forceinline__ void p_mlscan(const Frame& F) {
    bf16* U = WSP(bf16, R_U); float* NU = WSP(float, WS_SMALL + SM_NU); const float* WCARRY = WSP(float, WS_SMALL + SM_WCARRY);
    const int gt = F.gw * 64 + F.lane, NGT = F.NGW * 64;
    for (int it = gt; it < NH_M * 65536 / 4; it += NGT) { const int h = it >> 14, e = (it & 16383) * 4;
        float C0 = 0.f, C1 = 0.f, C2 = 0.f, C3 = 0.f; bf16* p = U + (size_t)h * 128 * 65536 + e;
#pragma unroll 4
        for (int c = 0; c < 128; ++c) { const u32x2 u = *(const u32x2*)(p + (size_t)c * 65536); const float wc = WCARRY[h * 128 + c];
            u32x2 o; o.x = cvt_pk_bf16(C0, C1); o.y = cvt_pk_bf16(C2, C3); *(u32x2*)(p + (size_t)c * 65536) = o;
            C0 = wc * C0 + bf2f(u.x & 0xffffu); C1 = wc * C1 + bf2f(u.x >> 16); C2 = wc * C2 + bf2f(u.y & 0xffffu); C3 = wc * C3 + bf2f(u.y >> 16); } }
    for (int it = gt; it < NH_M * 256; it += NGT) { const int h = it >> 8, k = it & 255; float n = 0.f; float* p = NU + (size_t)h * 128 * 256 + k;
        for (int c = 0; c < 128; ++c) { const float u = p[c * 256]; p[c * 256] = n; n = WCARRY[h * 128 + c] * n + u; } }
}
__device__ __forceinline__ void p_mlout(const Frame& F, const Args& A) {
    const bf16* QB = WSP(bf16, R_QB); const bf16* KB = WSP(bf16, R_KB); const bf16* VB = WSP(bf16, R_VB); const bf16* CS = WSP(bf16, R_U); const float* NC = WSP(float, WS_SMALL + SM_NU);
    const float* BCUM = WSP(float, WS_SMALL + SM_BCUM); const float* IG = WSP(float, WS_SMALL + SM_IG); const float* MSEQ = WSP(float, WS_SMALL + SM_MSEQ);
    const bf16* PROJ = WSP(bf16, R_PROJ); const float* mhg = A.in[I_MLNG]; bf16* YCAT = WSP(bf16, R_YCAT);
    LAS bf16* Qs = (LAS bf16*)(F.lds + RING_OFF); LAS bf16* Ks = Qs + 64 * ML_P; LAS bf16* Vs = Ks + 64 * ML_P; LAS bf16* Ss = Vs + 64 * ML_P;
    LAS float* fa = (LAS float*)(Ss + 64 * 72); LAS float* bch = fa; LAS float* ich = fa + 64; LAS float* mrow = fa + 128; LAS float* wint = fa + 192; LAS float* rsum = fa + 256  ;
    LAS float* nq = fa + 384; LAS float* nvec = fa + 448  ; LAS float* Hs = (LAS float*)(F.lds + RING_OFF);
    const int lane = F.lane, r = lane & 31, hg = lane >> 5, w = F.wave;
    for (int L = F.vcu; L < NH_M * 128; L += F.G) { const int h = L >> 7, c = L & 127;
        __syncthreads();
        ml_stage_chunk(F, QB, h, c, Qs); ml_stage_chunk(F, KB, h, c, Ks); ml_stage_chunk(F, VB, h, c, Vs);
        if (F.tid < 64) { bch[F.tid] = BCUM[h * T + 64 * c + F.tid]; ich[F.tid] = IG[h * T + 64 * c + F.tid]; }
        if (F.tid < 256) nvec[F.tid] = NC[(size_t)(h * 128 + c) * 256 + F.tid];
        const float mc = MSEQ[h * 128 + c];
        __syncthreads();
        if (w == 0) { float g = ich[lane] - bch[lane];
#pragma unroll
            for (int o = 1; o < 64; o <<= 1) { const float x = __shfl_up(g, o); if (lane >= o) g = fmaxf(g, x); }
            const float mr = bch[lane] + fmaxf(mc, g); mrow[lane] = mr; wint[lane] = __expf(bch[lane] + mc - mr); }
        if (w == 1) { float s = 0.f;
            for (int k = 0; k < 256; ++k) s += nvec[k] * bf2f(Qs[lane * ML_P + k]);
            nq[lane] = s; }
        __syncthreads();
        if (w < 4) { const int st = w & 1, lt = w >> 1; f32x16 acc = f32x16{};
#pragma unroll
            for (int ks = 0; ks < 16; ++ks) { const bf16x8 a = *(const LAS bf16x8*)(Ks + (32 * st + r) * ML_P + 16 * ks + 8 * hg), b = *(const LAS bf16x8*)(Qs + (32 * lt + r) * ML_P + 16 * ks + 8 * hg);
                acc = __builtin_amdgcn_mfma_f32_32x32x16_bf16(a, b, acc, 0, 0, 0); }
            const int l = 32 * lt + r; const float bl_ = bch[l], mr = mrow[l]; float rs = 0.f;
#pragma unroll
            for (int g4 = 0; g4 < 4; ++g4) { float v4[4];
#pragma unroll
                for (int i = 0; i < 4; ++i) { const int s = 32 * st + 8 * g4 + 4 * hg + i; const float d = bl_ - bch[s] + ich[s] - mr;
                    v4[i] = (s <= l) ? acc[4 * g4 + i] * __expf(d) : 0.f; rs += v4[i]; }
                u32x2 p; p.x = cvt_pk_bf16(v4[0], v4[1]); p.y = cvt_pk_bf16(v4[2], v4[3]);
                *(LAS u32x2*)(Ss + l * 72 + 32 * st + 8 * g4 + 4 * hg) = p; }
            rs += __shfl_xor(rs, 32);
            if (hg == 0) rsum[st * 64 + l] = rs; }
        __syncthreads();
        const int lt = w & 1, vg = w >> 1; f32x16 ai[2], aa[2]; ai[0] = f32x16{}; ai[1] = f32x16{}; aa[0] = f32x16{}; aa[1] = f32x16{};
        const bf16* Cb = CS + (size_t)(h * 128 + c) * 65536;
#pragma unroll 4
        for (int ks = 0; ks < 16; ++ks) { const bf16x8 a = *(const LAS bf16x8*)(Qs + (32 * lt + r) * ML_P + 16 * ks + 8 * hg);
#pragma unroll
            for (int jt = 0; jt < 2; ++jt) { const bf16x8 b = *(const bf16x8*)(Cb + (size_t)(64 * vg + 32 * jt + r) * 256 + 16 * ks + 8 * hg);
                ai[jt] = __builtin_amdgcn_mfma_f32_32x32x16_bf16(a, b, ai[jt], 0, 0, 0); } }
#pragma unroll
        for (int ks = 0; ks < 4; ++ks) { const bf16x8 a = *(const LAS bf16x8*)(Ss + (32 * lt + r) * 72 + 16 * ks + 8 * hg);
#pragma unroll
            for (int jt = 0; jt < 2; ++jt) { bf16x8 b;
#pragma unroll
                for (int jj = 0; jj < 8; ++jj) b[jj] = (short)Vs[(16 * ks + 8 * hg + jj) * ML_P + 64 * vg + 32 * jt + r];
                aa[jt] = __builtin_amdgcn_mfma_f32_32x32x16_bf16(a, b, aa[jt], 0, 0, 0); } }
        __syncthreads();
#pragma unroll
        for (int q = 0; q < 16; ++q) { const int l = 32 * lt + (q & 3) + 8 * (q >> 2) + 4 * hg; const float wi = wint[l];
            const float den = rsum[l] + rsum[64 + l] + wi * nq[l]; const float dn = 1.0f / fmaxf(fabsf(den), __expf(-mrow[l]));
#pragma unroll
            for (int jt = 0; jt < 2; ++jt) Hs[l * 260 + 64 * vg + 32 * jt + r] = (aa[jt][q] + wi * ai[jt][q]) * dn; }
        __syncthreads();
        for (int i = 0; i < 8; ++i) { const int l = 8 * w + i, t = 64 * c + l; const f32x4 hv = *(const LAS f32x4*)(Hs + l * 260 + 4 * lane);
            const float ss = wave_sum((hv[0] * hv[0] + hv[1] * hv[1]) + (hv[2] * hv[2] + hv[3] * hv[3])); const float rn = 1.0f / sqrtf(ss * (1.0f / 256.0f) + 1e-6f);
            const f32x4 g = *(const f32x4*)(mhg + 256 * h + 4 * lane); const u32x2 ob = *(const u32x2*)(PROJ + (size_t)t * AB_PAD + 6592 + 256 * h + 4 * lane);
            const float o0 = hv[0] * rn * g[0] * sigmoidf_(bf2f(ob.x & 0xffffu)), o1 = hv[1] * rn * g[1] * sigmoidf_(bf2f(ob.x >> 16));
            const float o2 = hv[2] * rn * g[2] * sigmoidf_(bf2f(ob.y & 0xffffu)), o3 = hv[3] * rn * g[3] * sigmoidf_(bf2f(ob.y >> 16));
            u32x2 p; p.x = cvt_pk_bf16(o0, o1); p.y = cvt_pk_bf16(o2, o3);
            *(u32x2*)(YCAT + (size_t)t * D + 1024 + 256 * h + 4 * lane) = p; }
    }
}

struct XsOrder {
    const bf16* XQ; const bf16* KM; int G, c;
    __device__ __forceinline__ bool next(int i, pg8::Unit& u) const {
        const int L = i * G + c; if (L >= 32 * 4) return false;
        const int pm = L >> 2, hd = L & 3; u.pm = pm; u.pn = 0; u.aux = hd; u.pad = 0;
        u.a = (const char*)(XQ + (size_t)pm * 256 * D + 512 * hd); u.b = (const char*)(KM + 512 * hd); return true;
    }
};
struct XpvOrder {
    const bf16* XP; const bf16* VT; int G, c;
    __device__ __forceinline__ bool next(int i, pg8::Unit& u) const {
        int pm, pn; if (!pg8::static_tile(i, G, c, 32, 8, pm, pn)) return false;
        u.pm = pm; u.pn = pn; u.aux = 0; u.pad = 0;
        u.a = (const char*)(XP + (size_t)pm * 256 * 1024 + 256 * (pn >> 1)); u.b = (const char*)(VT + (size_t)pn * 256 * NMEM); return true;
    }
};
__device__ __forceinline__ void p_xsoftmax(const Frame& F) {
    const float* XS = WSP(float, R_XS); bf16* XP = WSP(bf16, R_XP); const int lane = F.lane;
    for (int t = F.gw; t < T; t += F.NGW)
#pragma unroll
        for (int hd = 0; hd < 4; ++hd) { const f32x4 s = *(const f32x4*)(XS + (size_t)t * 1024 + 256 * hd + 4 * lane);
            const float m = wave_max(fmaxf(fmaxf(s[0], s[1]), fmaxf(s[2], s[3])));
            const float e0 = __expf(s[0] - m), e1 = __expf(s[1] - m), e2 = __expf(s[2] - m), e3 = __expf(s[3] - m);
            const float inv = 1.0f / wave_sum((e0 + e1) + (e2 + e3));
            u32x2 p; p.x = cvt_pk_bf16(e0 * inv, e1 * inv); p.y = cvt_pk_bf16(e2 * inv, e3 * inv);
            *(u32x2*)(XP + (size_t)t * 1024 + 256 * hd + 4 * lane) = p; }
}

__device__ __forceinline__ void p_norm_fpre(const Frame& F, const Args& A) {
    LAS float* Ws = (LAS float*)(F.lds + RING_OFF);
    stage_skinny<16>(F, A.in[I_FOXWIN], FOX_LD, 8192, Ws);
    __syncthreads();
    const float* X = WSP(float, WS_X); bf16* XN = WSP(bf16, WS_XN); float* FPRE = WSP(float, WS_SMALL + SM_FPRE); const float* g = A.in[I_NMIXG] + D;
    for (int t = F.gw; t < T; t += F.NGW) { f32x4 y[8]; rms_row(X + (size_t)t * D, g, XN + (size_t)t * D, F.lane, y);
        float o[16]; skinny_dot<16>(y, Ws, F.lane, o);
        if (F.lane < 16) { float v = o[0];
#pragma unroll
            for (int c = 1; c < 16; ++c) v = (F.lane == c) ? o[c] : v;
            FPRE[t * 16 + F.lane] = v; } }
    __syncthreads();
}
__device__ __forceinline__ void p_foxprep(const Frame& F, const Args& A) {
    bf16* QKVG = WSP(bf16, R_QKVG); const float* qg = A.in[I_FOXQG]; const float* kg = A.in[I_FOXKG]; const int lane = F.lane;
    for (int it = F.gw; it < 2 * T; it += F.NGW) { const int t = it >> 1, sec = it & 1; const float* gg = sec ? kg : qg; const float g0 = gg[2 * lane], g1 = gg[2 * lane + 1];
        unsigned* row = (unsigned*)(QKVG + (size_t)t * 8192 + sec * 2048) + lane;
#pragma unroll 4
        for (int h = 0; h < NH_F; ++h) { const unsigned u = row[64 * h]; const float a = bf2f(u & 0xffffu), b = bf2f(u >> 16);
            const float rn = 1.0f / sqrtf(wave_sum(a * a + b * b) * (1.0f / 128.0f) + 1e-6f);
            row[64 * h] = cvt_pk_bf16(a * rn * g0, b * rn * g1); } }
    if (F.gw < NH_F) { const int h = F.gw; const float* FPRE = WSP(float, WS_SMALL + SM_FPRE); float* BL = WSP(float, WS_SMALL + SM_BIASL2); const float bf = A.in[I_FOXBF][h];
        float carry = 0.f;
        for (int c0 = 0; c0 < 128; c0 += 16) { float v[16];
#pragma unroll
            for (int i = 0; i < 16; ++i) v[i] = FPRE[(size_t)(64 * (c0 + i) + lane) * 16 + h];
#pragma unroll
            for (int i = 0; i < 16; ++i) { float b = logsigmoidf_(v[i] + bf);
#pragma unroll
                for (int o = 1; o < 64; o <<= 1) { const float x = __shfl_up(b, o); if (lane >= o) b += x; }
                b += carry; BL[h * T + 64 * (c0 + i) + lane] = -1.4426950408889634f * b; carry = __shfl(b, 63); } } }
}
__device__ __forceinline__ void p_foxattn(const Frame& F) {
    const bf16* QKVG = WSP(bf16, R_QKVG); bf16* ATTO = WSP(bf16, R_ATTO); const float* BL = WSP(float, WS_SMALL + SM_BIASL2);
    char* lds = (char*)F.ldsg + RING_OFF;
    for (int L = F.vcu; L < 256; L += F.G) { const int h = L >> 4, x = L & 15;
        __syncthreads();
        { float* bl = (float*)(lds + fox::BIAS_OFF); for (int i = F.tid; i < T / 4; i += NWAVES * 64) *(f32x4*)(bl + 4 * i) = *(const f32x4*)(BL + (size_t)h * T + 4 * i); }
        fox::BlockRef b0, b1; const int q0 = x, q1 = 31 - x;
        b0.Q = QKVG + (size_t)q0 * 256 * 8192 + 128 * h; b0.K = QKVG + 2048 + 128 * h; b0.V = QKVG + 4096 + 128 * h; b0.G = QKVG + (size_t)q0 * 256 * 8192 + 6144 + 128 * h;
        b0.O = ATTO + (size_t)q0 * 256 * D + 128 * h; b0.P0 = q0 * 256;
        b1 = b0; b1.Q = QKVG + (size_t)q1 * 256 * 8192 + 128 * h; b1.G = QKVG + (size_t)q1 * 256 * 8192 + 6144 + 128 * h; b1.O = ATTO + (size_t)q1 * 256 * D + 128 * h; b1.P0 = q1 * 256;
        fox::Seam S;
        fox::prime(b0, lds, S);
#ifdef FOX_LOOP
        for (int pass = 0; pass < 2; ++pass) { fox::block(b0, b1, lds, S); b0 = b1; }
#else
        fox::block(b0, b1, lds, S);
        fox::block(b1, b1, lds, S);
#endif
    }
}

__device__ __forceinline__ void p_norm_route(const Frame& F, const Args& A) {
    LAS float* Ws = (LAS float*)(F.lds + RING_OFF); LAS int* cnt = (LAS int*)(F.lds + RING_OFF + 8 * D * 4);
    stage_skinny<8>(F, A.in[I_ROUTER], NEXP, 0, Ws);
    if (F.tid < 8) cnt[F.tid] = 0;
    __syncthreads();
    const float* X = WSP(float, WS_X); bf16* XN = WSP(bf16, WS_XN); const float* g = A.in[I_NFFNG] + D;
    int* TOPI = WSP(int, WS_SMALL + SM_TOPI); float* TOPG = WSP(float, WS_SMALL + SM_TOPG); int* BLKCNT = WSP(int, WS_SMALL + SM_BLKCNT);
    const int b = blockIdx.x;
    for (int i = 0; i < 4; ++i) { const int t = 32 * b + 4 * F.wave + i; f32x4 y[8]; rms_row(X + (size_t)t * D, g, XN + (size_t)t * D, F.lane, y);
        float o[8]; skinny_dot<8>(y, Ws, F.lane, o);
        int i1 = 0; float v1 = o[0];
#pragma unroll
        for (int e = 1; e < 8; ++e) if (o[e] > v1) { v1 = o[e]; i1 = e; }
        int i2 = -1; float v2 = -__builtin_inff();
#pragma unroll
        for (int e = 0; e < 8; ++e) if (e != i1 && o[e] > v2) { v2 = o[e]; i2 = e; }
        const float e2 = __expf(v2 - v1), g1 = 1.0f / (1.0f + e2), g2 = e2 * g1;
        if (F.lane == 0) { TOPI[2 * t] = i1; TOPI[2 * t + 1] = i2; TOPG[2 * t] = g1; TOPG[2 * t + 1] = g2; __hip_atomic_fetch_add(&cnt[i1], 1, __ATOMIC_RELAXED, __HIP_MEMORY_SCOPE_WORKGROUP); __hip_atomic_fetch_add(&cnt[i2], 1, __ATOMIC_RELAXED, __HIP_MEMORY_SCOPE_WORKGROUP); } }
    __syncthreads();
    if (F.tid < 8) BLKCNT[b * 8 + F.tid] = cnt[F.tid];
}
__device__ __forceinline__ void p_route2(const Frame& F) {
    LAS int* sh = (LAS int*)(F.lds + RING_OFF);
    const int* BLKCNT = WSP(int, WS_SMALL + SM_BLKCNT); const int* TOPI = WSP(int, WS_SMALL + SM_TOPI); int* SLOT = WSP(int, WS_SMALL + SM_SLOT); int* TILEE = WSP(int, WS_SMALL + SM_TILEE);
    const bf16* XN = WSP(bf16, WS_XN); bf16* AG = WSP(bf16, R_AG); const int b = blockIdx.x;
    __syncthreads();
    if (F.tid < 8) { int tot = 0, pre = 0; for (int bb = 0; bb < 256; ++bb) { const int v = BLKCNT[bb * 8 + F.tid]; if (bb < b) pre += v; tot += v; } sh[F.tid] = tot; sh[8 + F.tid] = pre; }
    __syncthreads();
    if (F.tid == 0) { int off = 0, nt = 0; for (int e = 0; e < 8; ++e) { sh[16 + e] = off; const int n = (sh[e] + 255) >> 8; if (b == 0) for (int i = 0; i < n; ++i) TILEE[1 + nt + i] = e; nt += n; off += n * 256; } if (b == 0) TILEE[0] = nt; }
    __syncthreads();
    if (F.wave == 0) { const int t = 32 * b + (F.lane >> 1), e = TOPI[2 * t + (F.lane & 1)]; int rank = 0;
#pragma unroll
        for (int ee = 0; ee < 8; ++ee) { const unsigned long long m = __ballot(e == ee); if (e == ee) rank = __popcll(m & ((1ull << F.lane) - 1ull)); }
        const int slot = sh[16 + e] + sh[8 + e] + rank; SLOT[2 * t + (F.lane & 1)] = slot; sh[32 + F.lane] = slot; }
    __syncthreads();
    for (int p = F.wave; p < 64; p += NWAVES) { const int t = 32 * b + (p >> 1), slot = sh[32 + p]; const u32x4* src = (const u32x4*)(XN + (size_t)t * D); u32x4* dst = (u32x4*)(AG + (size_t)slot * D);
#pragma unroll
        for (int j = 0; j < 4; ++j) dst[F.lane + 64 * j] = src[F.lane + 64 * j]; }
}
struct MoeOrder {
    const bf16* Arows; const bf16* W; const int* tilee; int lda, nN; size_t wstride; int G, c; bool whole_rounds;
    __device__ __forceinline__ bool next(int i, pg8::Unit& u) const {
        const int nt = tilee[0]; const long L = (long)i * G + c; long nu = (long)nt * nN; if (whole_rounds) nu = (nu / G) * G; if (L >= nu) return false;
        const int ti = (int)(L / nN), pn = (int)(L % nN), e = tilee[1 + ti];
        u.pm = ti; u.pn = pn; u.aux = e; u.pad = 0; u.a = (const char*)(Arows + (size_t)ti * 256 * lda); u.b = (const char*)(W + (size_t)e * wstride + (size_t)pn * 256 * lda); return true;
    }
};
constexpr int MOE_KSPLIT = 4;
struct MoeSplitOrder {
    const bf16* Arows; const bf16* W; const int* tilee; int lda, nN, kslice; size_t wstride; int G, c;
    __device__ __forceinline__ bool next(int i, pg8::Unit& u) const {
        const int nt = tilee[0]; const long nu = (long)nt * nN, nfull = (nu / G) * G; const long L = (long)i * G + c; if (L >= (nu - nfull) * MOE_KSPLIT) return false;
        const long j = nfull + L / MOE_KSPLIT; const int kq = (int)(L % MOE_KSPLIT); const int ti = (int)(j / nN), pn = (int)(j % nN), e = tilee[1 + ti];
        u.pm = ti; u.pn = pn; u.aux = kq; u.pad = 0; u.a = (const char*)(Arows + (size_t)ti * 256 * lda + (size_t)kq * kslice); u.b = (const char*)(W + (size_t)e * wstride + (size_t)pn * 256 * lda + (size_t)kq * kslice); return true;
    }
};
__device__ __forceinline__ void p_final(const Frame& F, const Args& A) {
    const float* X = WSP(float, WS_X); const float* YG = WSP(float, R_YG); const float* YS = WSP(float, R_YSIDE); const int* SLOT = WSP(int, WS_SMALL + SM_SLOT); const float* TOPG = WSP(float, WS_SMALL + SM_TOPG);
    const float* g = A.in[I_FING]; const int lane = F.lane;
    const int nt = WSP(int, WS_SMALL + SM_TILEE)[0]; const int srow0 = (((nt * 8) / F.G) * F.G / 8) * 256;
    for (int t = F.gw; t < T; t += F.NGW) { const int s1 = SLOT[2 * t], s2 = SLOT[2 * t + 1]; const float g1 = TOPG[2 * t], g2 = TOPG[2 * t + 1];
        const f32x4* xr = (const f32x4*)(X + (size_t)t * D) + lane; const f32x4* y1 = (const f32x4*)(YG + (size_t)s1 * D) + lane; const f32x4* y2 = (const f32x4*)(YG + (size_t)s2 * D) + lane;
        f32x4 v[8]; float s = 0.f;
#pragma unroll
        for (int j = 0; j < 8; ++j) { f32x4 a = y1[64 * j], b = y2[64 * j];
            if (s1 >= srow0) { const f32x4* p = (const f32x4*)(YS + (size_t)(s1 - srow0) * D) + lane + 64 * j; a = a + ((p[0] + p[YSIDE_STRIDE / 4]) + p[2 * (YSIDE_STRIDE / 4)]); }
            if (s2 >= srow0) { const f32x4* p = (const f32x4*)(YS + (size_t)(s2 - srow0) * D) + lane + 64 * j; b = b + ((p[0] + p[YSIDE_STRIDE / 4]) + p[2 * (YSIDE_STRIDE / 4)]); }
            v[j] = xr[64 * j] + (a * g1 + b * g2); s += (v[j][0] * v[j][0] + v[j][1] * v[j][1]) + (v[j][2] * v[j][2] + v[j][3] * v[j][3]); }
        const float r = 1.0f / sqrtf(wave_sum(s) * (1.0f / D) + 1e-6f); f32x4* o = (f32x4*)(A.out + (size_t)t * D) + lane;
#pragma unroll
        for (int j = 0; j < 8; ++j) o[64 * j] = v[j] * r * ((const f32x4*)g)[lane + 64 * j]; }
}

enum Phase { PH_CONV = 0, PH_INPROJ0, PH_PREPA, PH_LORA, PH_PREPB, PH_SCAN, PH_MLU, PH_MLSCAN, PH_MLOUT, PH_OUTPROJ0,
             PH_NORMX0, PH_XQ0, PH_XS0, PH_XSM0, PH_XPV0, PH_XO0, PH_NORMF0, PH_FFNGU, PH_FFND,
             PH_NORMM1, PH_FOXIN, PH_FOXPREP, PH_FOXATT, PH_FOXOUT,
             PH_NORMX1, PH_XQ1, PH_XS1, PH_XSM1, PH_XPV1, PH_XO1, PH_NORMF1, PH_ROUTE2, PH_MOEGU, PH_MOED, PH_FINAL, N_PHASES };

__global__ void __launch_bounds__(NWAVES * 64, 2) trunk_fwd(Args A) {
    extern __shared__ __attribute__((aligned(16))) unsigned char lds[];
    Frame F;
    F.lds = (LAS unsigned char*)lds; F.ldsg = lds; F.ws = A.ws;
    F.tid = threadIdx.x; F.lane = F.tid & 63; F.wave = __builtin_amdgcn_readfirstlane(F.tid >> 6);
    F.G = gridDim.x; { const int bx = blockIdx.x; F.vcu = (F.G % 8 == 0) ? (bx % 8) * (F.G / 8) + bx / 8 : bx; }
    F.gw = F.vcu * NWAVES + F.wave; F.NGW = F.G * NWAVES;
    volatile LAS unsigned* MISC = (volatile LAS unsigned*)(F.lds + MISC_OFF);
    for (int u = F.tid; u < (LDS_BYTES - LDSCTL_OFF) / 4; u += NWAVES * 64) ((LAS unsigned*)(F.lds + LDSCTL_OFF))[u] = 0u;
    __syncthreads();
    const int lo = A.ph_lo, hi = A.ph_hi;
    const bool multi = (hi - lo) > 1;
    XcdBarrier bar; bar.bar = (unsigned*)(A.ws + WS_CTL) + CW_BAR; bar.x = 0; bar.st = nullptr;
    if (multi) bar = xcd_barrier_post((unsigned*)(A.ws + WS_CTL) + CW_BAR, MISC + 8);
#ifndef PH_ENABLE
#define PH_ENABLE 0xFFFFFFFFFFFFFFFFull
#endif
#define IN(k) ((((PH_ENABLE) >> (k)) & 1ull) && lo <= (k) && (k) < hi)
#ifndef PROBE_DUP
#define PROBE_DUP 0ull
#endif
#define DUP(k) if ((((PROBE_DUP) >> (k)) & 1ull) != 0ull)
#define SEAM(k) do { if (IN(k) && IN((k) + 1)) xcd_barrier(bar); } while (0)
    LAS unsigned char* ring = F.lds + RING_OFF;
    const int cb = (int)blockIdx.x;

    if (IN(PH_CONV)) { p_convert_early(F, A); p_convert_late(F, A, F.gw, F.NGW, (LAS float*)(F.lds + RING_OFF + F.wave * 16384), true, 0, NEXP); } SEAM(PH_CONV);
    if (IN(PH_INPROJ0)) { InprojKvOrder S{WSP(bf16, WS_XN), WSP(bf16, WS_W_ABIN), WSP(bf16, WS_MEMN), WSP(bf16, WS_W_XKV), F.G, cb};
        EpiInprojKv E{WSP(bf16, R_PROJ), WSP(float, R_GATES32), WSP(bf16, WS_KMEM), WSP(bf16, WS_VTMEM)};
        pg8::gemm_phase<EpiInprojKv, InprojKvOrder, true>(ring, pg8::Gemm{D, D, D}, S, E); } SEAM(PH_INPROJ0);
    if (IN(PH_PREPA)) { p_prepa(F, A); DUP(PH_PREPA) { __syncthreads(); p_prepa(F, A); } } SEAM(PH_PREPA);
    if (IN(PH_LORA)) { pg8::PlainOrder S{WSP(bf16, R_LORAIN), WSP(bf16, WS_W_LORA), 512, 512, 32, 12, F.G, cb}; pg8::EpiF32 E{WSP(float, R_LORAOUT), 3072, 0, 1.0f};
        pg8::gemm_phase<pg8::EpiF32, pg8::PlainOrder, true>(ring, pg8::Gemm{512, 512, 512}, S, E); } SEAM(PH_LORA);
    if (IN(PH_PREPB)) { p_prepb(F, A); DUP(PH_PREPB) { __syncthreads(); p_prepb(F, A); } } SEAM(PH_PREPB);
    if (IN(PH_SCAN)) {
        static_assert(SC_LDS + 64 <= RING_BYTES, "scan staging fits the LDS ring");
        if (F.tid == 0) *(volatile LAS int*)(F.lds + RING_OFF + SC_PROG_OFF) = 0;
        __syncthreads();
        switch (F.wave) { case 0: p_scan<0>(F); break; case 1: p_scan<1>(F); break; case 2: p_scan<2>(F); break; case 3: p_scan<3>(F); break; case 7: p_scan_touch(F); break; default: break; } } SEAM(PH_SCAN);
    if (IN(PH_MLU)) { p_scomb(F); p_mlu(F); DUP(PH_MLU) { __syncthreads(); p_mlu(F); } } SEAM(PH_MLU);
    if (IN(PH_MLSCAN)) { p_mlscan(F); p_rwkv_post(F, A); DUP(PH_MLSCAN) { __syncthreads(); p_rwkv_post(F, A); } } SEAM(PH_MLSCAN);
    if (IN(PH_MLOUT)) { p_mlout(F, A); DUP(PH_MLOUT) { __syncthreads(); p_mlout(F, A); } } SEAM(PH_MLOUT);
    if (IN(PH_OUTPROJ0)) { pg8::PlainOrder S{WSP(bf16, R_YCAT), WSP(bf16, WS_W_ABOUT), D, D, 32, 8, F.G, cb}; pg8::EpiResid E{A.in[I_X], WSP(float, WS_X), D};
        pg8::gemm_phase<pg8::EpiResid, pg8::PlainOrder, false>(ring, pg8::Gemm{D, D, D}, S, E); } SEAM(PH_OUTPROJ0);
#define XATTN(l, P_NORM, P_Q, P_S, P_SM, P_PV, P_O) \
    if (IN(P_NORM)) { norm_phase(F, WSP(float, WS_X), A.in[I_NXAG] + (l) * D, WSP(bf16, WS_XN), T); DUP(P_NORM) { norm_phase(F, WSP(float, WS_X), A.in[I_NXAG] + (l) * D, WSP(bf16, WS_XN), T); } } SEAM(P_NORM); \
    if (IN(P_Q)) { pg8::PlainOrder S{WSP(bf16, WS_XN), WSP(bf16, WS_W_XQ) + (size_t)(l) * D * D, D, D, 32, 8, F.G, cb}; pg8::EpiBf16 E{WSP(bf16, R_XQ), D, nullptr, -1}; \
        pg8::gemm_phase<pg8::EpiBf16, pg8::PlainOrder, false>(ring, pg8::Gemm{D, D, D}, S, E); } SEAM(P_Q); \
    if (IN(P_S)) { XsOrder S{WSP(bf16, R_XQ), WSP(bf16, WS_KMEM) + (size_t)(l) * NMEM * D, F.G, cb}; pg8::EpiF32 E{WSP(float, R_XS), 1024, 256, 0.044194173824159216f}; \
        pg8::gemm_phase<pg8::EpiF32, XsOrder, false>(ring, pg8::Gemm{D, D, 512}, S, E); } SEAM(P_S); \
    if (IN(P_SM)) { p_xsoftmax(F); DUP(P_SM) { p_xsoftmax(F); } } SEAM(P_SM); \
    if (IN(P_PV)) { XpvOrder S{WSP(bf16, R_XP), WSP(bf16, WS_VTMEM) + (size_t)(l) * D * NMEM, F.G, cb}; pg8::EpiBf16 E{WSP(bf16, R_XO), D, nullptr, -1}; \
        pg8::gemm_phase<pg8::EpiBf16, XpvOrder, false>(ring, pg8::Gemm{1024, NMEM, 256}, S, E); } SEAM(P_PV); \
    if (IN(P_O)) { pg8::PlainOrder S{WSP(bf16, R_XO), WSP(bf16, WS_W_XO) + (size_t)(l) * D * D, D, D, 32, 8, F.G, cb}; pg8::EpiResid E{WSP(float, WS_X), WSP(float, WS_X), D}; \
        pg8::gemm_phase<pg8::EpiResid, pg8::PlainOrder, false>(ring, pg8::Gemm{D, D, D}, S, E); } SEAM(P_O);

    XATTN(0, PH_NORMX0, PH_XQ0, PH_XS0, PH_XSM0, PH_XPV0, PH_XO0)
    if (IN(PH_NORMF0)) { norm_phase(F, WSP(float, WS_X), A.in[I_NFFNG], WSP(bf16, WS_XN), T); DUP(PH_NORMF0) { norm_phase(F, WSP(float, WS_X), A.in[I_NFFNG], WSP(bf16, WS_XN), T); } } SEAM(PH_NORMF0);
    if (IN(PH_FFNGU)) { pg8::PlainOrder S{WSP(bf16, WS_XN), WSP(bf16, WS_W_FFNGU), D, D, 32, 44, F.G, cb}; pg8::EpiSwiGLU E{WSP(bf16, R_ACT), DFF};
        pg8::gemm_phase<pg8::EpiSwiGLU, pg8::PlainOrder, true>(ring, pg8::Gemm{D, D, D}, S, E); DUP(PH_FFNGU) { pg8::gemm_phase<pg8::EpiSwiGLU, pg8::PlainOrder, true>(ring, pg8::Gemm{D, D, D}, S, E); } } SEAM(PH_FFNGU);
    if (IN(PH_FFND)) { pg8::PlainOrder S{WSP(bf16, R_ACT), WSP(bf16, WS_W_FFND), DFF, DFF, 32, 8, F.G, cb}; pg8::EpiResid E{WSP(float, WS_X), WSP(float, WS_X), D};
        pg8::gemm_phase<pg8::EpiResid, pg8::PlainOrder, false>(ring, pg8::Gemm{DFF, DFF, DFF}, S, E); } SEAM(PH_FFND);
    if (IN(PH_NORMM1)) { p_norm_fpre(F, A); DUP(PH_NORMM1) { p_norm_fpre(F, A); } } SEAM(PH_NORMM1);
    if (IN(PH_FOXIN)) { pg8::PlainOrder S{WSP(bf16, WS_XN), WSP(bf16, WS_W_FOXIN), D, D, 32, 32, F.G, cb}; pg8::EpiBf16 E{WSP(bf16, R_QKVG), 8192, nullptr, -1};
        pg8::gemm_phase<pg8::EpiBf16, pg8::PlainOrder, true>(ring, pg8::Gemm{D, D, D}, S, E); DUP(PH_FOXIN) { pg8::gemm_phase<pg8::EpiBf16, pg8::PlainOrder, true>(ring, pg8::Gemm{D, D, D}, S, E); } } SEAM(PH_FOXIN);
    if (IN(PH_FOXPREP)) { p_foxprep(F, A); } SEAM(PH_FOXPREP);
    if (IN(PH_FOXATT)) { p_foxattn(F); DUP(PH_FOXATT) { __syncthreads(); p_foxattn(F); } } SEAM(PH_FOXATT);
    if (IN(PH_FOXOUT)) { pg8::PlainOrder S{WSP(bf16, R_ATTO), WSP(bf16, WS_W_FOXOUT), D, D, 32, 8, F.G, cb}; pg8::EpiResid E{WSP(float, WS_X), WSP(float, WS_X), D};
        pg8::gemm_phase<pg8::EpiResid, pg8::PlainOrder, false>(ring, pg8::Gemm{D, D, D}, S, E); } SEAM(PH_FOXOUT);
    XATTN(1, PH_NORMX1, PH_XQ1, PH_XS1, PH_XSM1, PH_XPV1, PH_XO1)
    if (IN(PH_NORMF1)) { p_norm_route(F, A); } SEAM(PH_NORMF1);
    if (IN(PH_ROUTE2)) { p_route2(F); } SEAM(PH_ROUTE2);
    if (IN(PH_MOEGU)) { MoeOrder S{WSP(bf16, R_AG), WSP(bf16, WS_W_MOEGU), WSP(int, WS_SMALL + SM_TILEE), D, 44, (size_t)2 * DFF * D, F.G, cb, false}; pg8::EpiSwiGLU E{WSP(bf16, R_ACTG), DFF};
        pg8::gemm_phase<pg8::EpiSwiGLU, MoeOrder, true>(ring, pg8::Gemm{D, D, D}, S, E); } SEAM(PH_MOEGU);
    if (IN(PH_MOED)) {
        { MoeOrder S{WSP(bf16, R_ACTG), WSP(bf16, WS_W_MOED), WSP(int, WS_SMALL + SM_TILEE), DFF, 8, (size_t)D * DFF, F.G, cb, true}; pg8::EpiF32 E{WSP(float, R_YG), D, 0, 1.0f};
          pg8::gemm_phase<pg8::EpiF32, MoeOrder, true>(ring, pg8::Gemm{DFF, DFF, DFF}, S, E); }
        { MoeSplitOrder S{WSP(bf16, R_ACTG), WSP(bf16, WS_W_MOED), WSP(int, WS_SMALL + SM_TILEE), DFF, 8, DFF / MOE_KSPLIT, (size_t)D * DFF, F.G, cb}; const int nt_ = WSP(int, WS_SMALL + SM_TILEE)[0]; pg8::EpiF32Split E{WSP(float, R_YG), WSP(float, R_YSIDE), YSIDE_STRIDE, D, ((nt_ * 8) / F.G) * F.G / 8};
          pg8::gemm_phase<pg8::EpiF32Split, MoeSplitOrder, false>(ring, pg8::Gemm{DFF, DFF, DFF / MOE_KSPLIT}, S, E); } } SEAM(PH_MOED);
    if (IN(PH_FINAL)) { p_final(F, A); }
#undef XATTN
#undef IN
#undef SEAM
}

#ifndef MK_ONE_LAUNCH
#define MK_ONE_LAUNCH 1
#endif
extern "C" void kernel_launch(void* const* d_in, const int* in_sizes, int n_in, void* d_out, int out_size, void* d_ws, size_t ws_size, hipStream_t stream) {
    static int ready = 0;
    if (ready == 0) {
        if (n_in != N_IN || in_sizes[0] != T * D || out_size != T * D || ws_size < WS_END) {
            fprintf(stderr, "kernel_launch: built for %d inputs, x/out of %d floats, >= %zu bytes of workspace; got n_in %d, in0 %d, out %d, ws %zu; nothing launched\n", N_IN, T * D, (size_t)WS_END, n_in, n_in > 0 ? in_sizes[0] : -1, out_size, ws_size);
            ready = -1; return; }
        if (hipFuncSetAttribute((const void*)trunk_fwd, hipFuncAttributeMaxDynamicSharedMemorySize, LDS_BYTES) != hipSuccess) { fprintf(stderr, "kernel_launch: hipFuncSetAttribute failed\n"); ready = -1; return; }
        int per_cu = 0;
        if (hipOccupancyMaxActiveBlocksPerMultiprocessor(&per_cu, (const void*)trunk_fwd, NWAVES * 64, LDS_BYTES) != hipSuccess || per_cu < 1)
            fprintf(stderr, "kernel_launch: note: occupancy query reports %d workgroups per CU\n", per_cu);
        (void)hipGetLastError();
        ready = 1;
    }
    if (ready < 0) return;
    const int grid = 256;
    if (hipMemsetAsync((char*)d_ws + WS_CTL, 0, CTL_ZERO_BYTES, stream) != hipSuccess) { fprintf(stderr, "kernel_launch: hipMemsetAsync failed\n"); return; }
    Args a{};
    for (int i = 0; i < N_IN; ++i) a.in[i] = (const float*)d_in[i];
    a.out = (float*)d_out; a.ws = (unsigned char*)d_ws;
#if MK_ONE_LAUNCH
    a.ph_lo = 0; a.ph_hi = N_PHASES;
    hipLaunchKernelGGL(trunk_fwd, dim3(grid), dim3(NWAVES * 64), LDS_BYTES, stream, a);
#else
    for (int p = 0; p < N_PHASES; ++p) { a.ph_lo = p; a.ph_hi = p + 1;
        hipLaunchKernelGGL(trunk_fwd, dim3(grid), dim3(NWAVES * 64), LDS_BYTES, stream, a); }
#endif
    const hipError_t le = hipPeekAtLastError();
    if (le != hipSuccess) fprintf(stderr, "kernel_launch: launch failed: %s\n", hipGetErrorName(le));
}
```

```cpp
#include <hip/hip_runtime.h>
#include <cstdio>
#include <cstdint>

#define GAS __attribute__((address_space(1)))
#define LAS __attribute__((address_space(3)))
typedef unsigned short bf16;
typedef short bf16x8 __attribute__((ext_vector_type(8)));
typedef short s16x4 __attribute__((ext_vector_type(4)));
typedef float f32x2 __attribute__((ext_vector_type(2)));
typedef float f32x4 __attribute__((ext_vector_type(4)));
typedef float f32x16 __attribute__((ext_vector_type(16)));
typedef unsigned u32x2 __attribute__((ext_vector_type(2)));
typedef unsigned u32x4 __attribute__((ext_vector_type(4)));

constexpr int T = 8192, D = 2048, NMEM = 256, DFF = 5632, NEXP = 8;
constexpr int A_COLS = 3520, AB_COLS = 7624, AB_PAD = 7680;
constexpr int FOX_LD = 8208;
constexpr int NH_R = 16, NH_M = 4, NH_F = 16;
constexpr int MOE_ROWS = 72 * 256;

__device__ __forceinline__ float bf2f(unsigned b) { return __uint_as_float(b << 16); }
__device__ __forceinline__ unsigned cvt_pk_bf16(float lo, float hi) { unsigned r; asm volatile("v_cvt_pk_bf16_f32 %0, %1, %2" : "=v"(r) : "v"(lo), "v"(hi)); return r; }
__device__ __forceinline__ bf16 f2bf(float f) { return (bf16)(cvt_pk_bf16(f, 0.f) & 0xffffu); }
__device__ __forceinline__ float wave_sum(float v) {
#pragma unroll
    for (int o = 1; o < 64; o <<= 1) v += __shfl_xor(v, o);
    return v;
}
__device__ __forceinline__ float wave_max(float v) {
#pragma unroll
    for (int o = 1; o < 64; o <<= 1) v = fmaxf(v, __shfl_xor(v, o));
    return v;
}
__device__ __forceinline__ float wave_sum_dpp(float x) {
#define DPPF_(v, ctrl) __builtin_bit_cast(float, __builtin_amdgcn_update_dpp(0, __builtin_bit_cast(int, v), ctrl, 0xF, 0xF, true))
    x += DPPF_(x, 0xB1); x += DPPF_(x, 0x4E); x += DPPF_(x, 0x141); x += DPPF_(x, 0x140);
#undef DPPF_
    const float a = __builtin_bit_cast(float, __builtin_amdgcn_readlane(__builtin_bit_cast(int, x), 0)), b = __builtin_bit_cast(float, __builtin_amdgcn_readlane(__builtin_bit_cast(int, x), 16));
    const float c = __builtin_bit_cast(float, __builtin_amdgcn_readlane(__builtin_bit_cast(int, x), 32)), d = __builtin_bit_cast(float, __builtin_amdgcn_readlane(__builtin_bit_cast(int, x), 48));
    return (a + b) + (c + d);
}
__device__ __forceinline__ float sigmoidf_(float x) { return 1.0f / (1.0f + __expf(-x)); }
__device__ __forceinline__ float logsigmoidf_(float x) { return fminf(x, 0.f) - log1pf(__expf(-fabsf(x))); }

namespace pg8 {
#define PG8_LAS __attribute__((address_space(3)))
typedef unsigned short bf16_t;
constexpr int BM = 256, BK = 64, HALF = 128, HTB = HALF * BK * 2  , STAGE_BYTES = 8 * HTB, NXCD = 8, WGM = 8;

__host__ __device__ __forceinline__ int lds_byte(int r, int c) { const int st = (r >> 4) * 2 + (c >> 5), rr = r & 15, cc = c & 31, ob = rr * 64 + cc * 2; return st * 1024 + (ob ^ (((ob >> 9) & 1) << 5)); }
__host__ __device__ __forceinline__ void stage_rc(int b, int& R, int& C) { const int st = b / 1024, sb = b % 1024, swz = sb ^ (((sb >> 9) & 1) << 5); R = (st >> 1) * 16 + swz / 64; C = (st & 1) * 32 + (swz % 64) / 2; }
__host__ __device__ __forceinline__ int perm32(int rho) { const int n = rho >> 4, i = rho & 15; return 8 * (i >> 2) + 4 * n + (i & 3); }

struct Unit { const char* a; const char* b; int pm, pn, aux, pad; };
struct Gemm { int lda, ldb, K; };

__device__ __forceinline__ bool static_tile(int i, int G, int c, int nM, int nN, int& pm, int& pn) {
    const int nwg = nM * nN; const long L = (long)i * G + c; if (L >= nwg) return false;
    int wgid = (int)L; { const int q = nwg / NXCD, r = nwg % NXCD, xcd = wgid % NXCD, off = wgid / NXCD; wgid = (xcd < r ? xcd * (q + 1) : r * (q + 1) + (xcd - r) * q) + off; }
    const int nig = WGM * nN, gid = wgid / nig, fm = gid * WGM, gsz = (nM - fm) < WGM ? (nM - fm) : WGM;
    pm = fm + ((wgid % nig) % gsz); pn = (wgid % nig) / gsz; return true;
}
struct PlainOrder {
    const bf16_t* A; const bf16_t* Bt; int lda, ldb, nM, nN, G, c;
    __device__ __forceinline__ bool next(int i, Unit& u) const {
        int pm, pn; if (!static_tile(i, G, c, nM, nN, pm, pn)) return false;
        u.pm = pm; u.pn = pn; u.aux = 0; u.pad = 0; u.a = (const char*)(A + (size_t)pm * BM * lda); u.b = (const char*)(Bt + (size_t)pn * BM * ldb); return true;
    }
};

struct EpiF32 {
    static constexpr bool PERM = false;
    float* C; int ldc; int aux_cols; float scale;
    __device__ __forceinline__ void operator()(const f32x4 (&acc)[2][2][4][2], const Unit& u, int wr, int wc, int fr, int fq) const {
        const int row0 = u.pm * BM + wr * 64 + fr, col0 = u.pn * BM + u.aux * aux_cols + wc * 32 + 4 * fq;
#pragma unroll
        for (int ai = 0; ai < 2; ++ai)
#pragma unroll
            for (int m = 0; m < 4; ++m) { float* rowp = C + (size_t)(row0 + ai * HALF + m * 16) * ldc + col0;
#pragma unroll
                for (int bj = 0; bj < 2; ++bj)
#pragma unroll
                    for (int n = 0; n < 2; ++n) *(f32x4*)(rowp + bj * HALF + n * 16) = acc[ai][bj][m][n] * scale; }
    }
};
struct EpiF32Split {
    static constexpr bool PERM = false;
    float* C; float* side; size_t side_stride; int ldc; int pm0;
    __device__ __forceinline__ void operator()(const f32x4 (&acc)[2][2][4][2], const Unit& u, int wr, int wc, int fr, int fq) const {
        float* base = u.aux == 0 ? C + (size_t)u.pm * BM * ldc : side + (size_t)(u.aux - 1) * side_stride + (size_t)(u.pm - pm0) * BM * ldc;
        const int row0 = wr * 64 + fr, col0 = u.pn * BM + wc * 32 + 4 * fq;
#pragma unroll
        for (int ai = 0; ai < 2; ++ai)
#pragma unroll
            for (int m = 0; m < 4; ++m) { float* rowp = base + (size_t)(row0 + ai * HALF + m * 16) * ldc + col0;
#pragma unroll
                for (int bj = 0; bj < 2; ++bj)
#pragma unroll
                    for (int n = 0; n < 2; ++n) *(f32x4*)(rowp + bj * HALF + n * 16) = acc[ai][bj][m][n]; }
    }
};
struct EpiResid {
    static constexpr bool PERM = false;
    const float* base; float* out; int ldc; bf16_t* xn; const float* gn; float* ssq;
    __device__ __forceinline__ void operator()(const f32x4 (&acc)[2][2][4][2], const Unit& u, int wr, int wc, int fr, int fq) const {
        const int row0 = u.pm * BM + wr * 64 + fr, col0 = u.pn * BM + wc * 32 + 4 * fq;
        f32x4 gv[2][2];
        if (xn) {
#pragma unroll
            for (int bj = 0; bj < 2; ++bj)
#pragma unroll
                for (int n = 0; n < 2; ++n) gv[bj][n] = *(const f32x4*)(gn + col0 + bj * HALF + n * 16); }
#pragma unroll
        for (int ai = 0; ai < 2; ++ai)
#pragma unroll
            for (int m = 0; m < 4; ++m) { const int row = row0 + ai * HALF + m * 16; const size_t off = (size_t)row * ldc + col0; float ss = 0.f;
#pragma unroll
                for (int bj = 0; bj < 2; ++bj)
#pragma unroll
                    for (int n = 0; n < 2; ++n) { const f32x4 b = *(const f32x4*)(base + off + bj * HALF + n * 16); const f32x4 x = b + acc[ai][bj][m][n]; *(f32x4*)(out + off + bj * HALF + n * 16) = x;
                        if (xn) { ss += (x[0] * x[0] + x[1] * x[1]) + (x[2] * x[2] + x[3] * x[3]); const f32x4 y = x * gv[bj][n];
                            u32x2 w; w.x = cvt_pk_bf16(y[0], y[1]); w.y = cvt_pk_bf16(y[2], y[3]); *(u32x2*)(xn + off + bj * HALF + n * 16) = w; } }
                if (xn) { ss += __shfl_xor(ss, 16); ss += __shfl_xor(ss, 32); if (fq == 0) __hip_atomic_fetch_add(ssq + row, ss, __ATOMIC_RELAXED, __HIP_MEMORY_SCOPE_AGENT); } }
    }
};
struct EpiBf16 {
    static constexpr bool PERM = true;
    bf16_t* O; int ldc; float* side; int side_pn; const float* ssq;
    __device__ __forceinline__ void operator()(const f32x4 (&acc)[2][2][4][2], const Unit& u, int wr, int wc, int fr, int fq) const {
        const int row0 = u.pm * BM + wr * 64 + fr, col0 = u.pn * BM + wc * 32 + 8 * fq;
#pragma unroll
        for (int ai = 0; ai < 2; ++ai)
#pragma unroll
            for (int m = 0; m < 4; ++m) { bf16_t* rowp = O + (size_t)(row0 + ai * HALF + m * 16) * ldc + col0;
                const float rs = ssq ? 1.0f / sqrtf(ssq[row0 + ai * HALF + m * 16] * (1.0f / 2048.0f) + 1e-6f) : 1.0f;
#pragma unroll
                for (int bj = 0; bj < 2; ++bj) { const f32x4 v0 = acc[ai][bj][m][0] * rs, v1 = acc[ai][bj][m][1] * rs;
                    u32x4 w; w.x = cvt_pk_bf16(v0[0], v0[1]); w.y = cvt_pk_bf16(v0[2], v0[3]); w.z = cvt_pk_bf16(v1[0], v1[1]); w.w = cvt_pk_bf16(v1[2], v1[3]);
                    *(u32x4*)(rowp + bj * HALF) = w; } }
        if (side != nullptr && u.pn == side_pn) {
#pragma unroll
            for (int ai = 0; ai < 2; ++ai)
#pragma unroll
                for (int m = 0; m < 4; ++m) { float* rowp = side + (size_t)(row0 + ai * HALF + m * 16) * 256 + wc * 32 + 8 * fq;
#pragma unroll
                    for (int bj = 0; bj < 2; ++bj) { *(f32x4*)(rowp + bj * HALF) = acc[ai][bj][m][0]; *(f32x4*)(rowp + bj * HALF + 4) = acc[ai][bj][m][1]; } }
        }
    }
};
struct EpiSwiGLU {
    static constexpr bool PERM = true;
    bf16_t* O; int ldc; const float* ssq;
    __device__ __forceinline__ void operator()(const f32x4 (&acc)[2][2][4][2], const Unit& u, int wr, int wc, int fr, int fq) const {
        const int row0 = u.pm * BM + wr * 64 + fr, col0 = u.pn * HALF + wc * 32 + 8 * fq;
#pragma unroll
        for (int ai = 0; ai < 2; ++ai)
#pragma unroll
            for (int m = 0; m < 4; ++m) { bf16_t* rowp = O + (size_t)(row0 + ai * HALF + m * 16) * ldc + col0;
                const float rs = ssq ? 1.0f / sqrtf(ssq[row0 + ai * HALF + m * 16] * (1.0f / 2048.0f) + 1e-6f) : 1.0f;
                float o[8];
#pragma unroll
                for (int n = 0; n < 2; ++n)
#pragma unroll
                    for (int j = 0; j < 4; ++j) { const float g = acc[ai][0][m][n][j] * rs, up = acc[ai][1][m][n][j] * rs;
                        o[n * 4 + j] = g * __builtin_amdgcn_rcpf(1.0f + __builtin_amdgcn_exp2f(-1.4426950408889634f * g)) * up; }
                u32x4 w; w.x = cvt_pk_bf16(o[0], o[1]); w.y = cvt_pk_bf16(o[2], o[3]); w.z = cvt_pk_bf16(o[4], o[5]); w.w = cvt_pk_bf16(o[6], o[7]);
                *(u32x4*)rowp = w; }
    }
};

template <class Epi, class Sched, bool ALIGN_EPI>
__device__ __forceinline__ void gemm_phase(PG8_LAS unsigned char* lds, const Gemm g, const Sched& S, const Epi& E) {
    const int tid = threadIdx.x, wid = __builtin_amdgcn_readfirstlane(tid >> 6), lane = tid & 63, wr = wid >> 2, wc = wid & 3, fr = lane & 15, fq = lane >> 4;
    const int K = g.K, nt = K / BK;
    unsigned voffA[2], voffB[2];
#pragma unroll
    for (int i = 0; i < 2; ++i) { int R, C; stage_rc(tid * 16 + i * 8192, R, C); const int Rb = Epi::PERM ? ((R & ~31) + perm32(R & 31)) : R;
        voffA[i] = (unsigned)(R * g.lda + C) * 2u; voffB[i] = (unsigned)(Rb * g.ldb + C) * 2u; }
    const size_t kstep = (size_t)(BK * 2);
    const size_t hstepA = (size_t)HALF * g.lda * 2, hstepB = (size_t)HALF * g.ldb * 2;
    const unsigned ldsw = (unsigned)wid * 1024u;
    const int aoff = lds_byte(wr * 64 + fr, fq * 8), boff = lds_byte(wc * 32 + fr, fq * 8);
#define PG8_SA(b, h) (((b) * 2 + (h)) * HTB)
#define PG8_SB(b, h) ((4 + (b) * 2 + (h)) * HTB)
#define PG8_STAGE(bufoff, gbase, voff) do { _Pragma("unroll") for (int _i = 0; _i < 2; ++_i) \
        __builtin_amdgcn_global_load_lds((const unsigned*)((const char*)(gbase) + (voff)[_i]), (PG8_LAS unsigned*)(lds + (bufoff) + ldsw + _i * 8192), 16, 0, 0); } while (0)
#define PG8_LDA(dst, b, h) do { _Pragma("unroll") for (int m = 0; m < 4; ++m) _Pragma("unroll") for (int k = 0; k < 2; ++k) dst[m][k] = *(const PG8_LAS bf16x8*)(lds + PG8_SA(b, h) + aoff + m * 2048 + k * 1024); } while (0)
#define PG8_LDB(dst, b, h) do { _Pragma("unroll") for (int n = 0; n < 2; ++n) _Pragma("unroll") for (int k = 0; k < 2; ++k) dst[n][k] = *(const PG8_LAS bf16x8*)(lds + PG8_SB(b, h) + boff + n * 2048 + k * 1024); } while (0)
#define PG8_MMA(ai, bj, At, Bt) do { __builtin_amdgcn_s_setprio(1); _Pragma("unroll") for (int m = 0; m < 4; ++m) _Pragma("unroll") for (int n = 0; n < 2; ++n) _Pragma("unroll") for (int k = 0; k < 2; ++k) \
        acc[ai][bj][m][n] = __builtin_amdgcn_mfma_f32_16x16x32_bf16(Bt[n][k], At[m][k], acc[ai][bj][m][n], 0, 0, 0); __builtin_amdgcn_s_setprio(0); } while (0)
#define PG8_WAIT_V(n) asm volatile("s_waitcnt vmcnt(" #n ")" ::: "memory")
#define PG8_WAIT_L(n) asm volatile("s_waitcnt lgkmcnt(" #n ")" ::: "memory")
#define PG8_BAR __builtin_amdgcn_s_barrier()
#define PG8_SCHED __builtin_amdgcn_sched_barrier(0)
    Unit cur, nxt; int ui = 0;
    if (!S.next(0, cur)) return;
    f32x4 acc[2][2][4][2];
#pragma unroll
    for (int a = 0; a < 2; ++a)
#pragma unroll
        for (int b = 0; b < 2; ++b)
#pragma unroll
            for (int m = 0; m < 4; ++m)
#pragma unroll
                for (int n = 0; n < 2; ++n) acc[a][b][m][n] = (f32x4){0.f, 0.f, 0.f, 0.f};
    bf16x8 At[4][2], B0[2][2], B1[2][2];
    const char* cA = cur.a; const char* cB = cur.b;
    PG8_STAGE(PG8_SB(0, 0), cB, voffB); PG8_STAGE(PG8_SB(0, 1), cB + hstepB, voffB); PG8_STAGE(PG8_SA(0, 0), cA, voffA); PG8_STAGE(PG8_SA(0, 1), cA + hstepA, voffA);
    if (wr == 1) PG8_BAR;
    PG8_WAIT_V(2); PG8_BAR;
    PG8_STAGE(PG8_SB(1, 0), cB + kstep, voffB); PG8_STAGE(PG8_SA(1, 0), cA + kstep, voffA); PG8_STAGE(PG8_SB(1, 1), cB + hstepB + kstep, voffB);
    PG8_WAIT_V(6); PG8_BAR;
    for (;;) {
        const bool has_next = S.next(ui + 1, nxt);
        const char* nA = has_next ? nxt.a : cA; const char* nB = has_next ? nxt.b : cB;
        for (int t = 0; t < nt; t += 2) {
            const bool last = (t == nt - 2);
            const char* a1 = cA + (size_t)(t + 1) * kstep;
            const char* a2 = last ? nA : cA + (size_t)(t + 2) * kstep; const char* b2 = last ? nB : cB + (size_t)(t + 2) * kstep;
            const char* a3 = a2 + kstep; const char* b3 = b2 + kstep;
            PG8_LDB(B0, 0, 0); PG8_LDB(B1, 0, 1); PG8_SCHED; PG8_LDA(At, 0, 0); PG8_STAGE(PG8_SA(1, 1), a1 + hstepA, voffA);
            PG8_WAIT_V(8); PG8_WAIT_L(0); PG8_BAR; PG8_MMA(0, 0, At, B0); PG8_MMA(0, 1, At, B1); PG8_BAR; PG8_SCHED;
            PG8_LDA(At, 0, 1); PG8_STAGE(PG8_SB(0, 0), b2, voffB); PG8_STAGE(PG8_SB(0, 1), b2 + hstepB, voffB); PG8_STAGE(PG8_SA(0, 0), a2, voffA);
            PG8_WAIT_V(8); PG8_WAIT_L(0); PG8_BAR; PG8_MMA(1, 0, At, B0); PG8_MMA(1, 1, At, B1); PG8_BAR; PG8_SCHED;
            PG8_LDB(B0, 1, 0); PG8_LDB(B1, 1, 1); PG8_SCHED; PG8_LDA(At, 1, 0); PG8_STAGE(PG8_SA(0, 1), a2 + hstepA, voffA);
            PG8_WAIT_V(8); PG8_WAIT_L(0); PG8_BAR; PG8_MMA(0, 0, At, B0); PG8_MMA(0, 1, At, B1); PG8_BAR; PG8_SCHED;
            PG8_LDA(At, 1, 1); PG8_STAGE(PG8_SB(1, 0), b3, voffB); PG8_STAGE(PG8_SB(1, 1), b3 + hstepB, voffB); PG8_STAGE(PG8_SA(1, 0), a3, voffA);
            PG8_WAIT_V(8); PG8_WAIT_L(0); PG8_BAR; PG8_MMA(1, 0, At, B0); PG8_MMA(1, 1, At, B1); PG8_BAR; PG8_SCHED;
        }
        if constexpr (ALIGN_EPI) { if (wr == 0) PG8_BAR; }
        E(acc, cur, wr, wc, fr, fq);
        if (!has_next) break;
#pragma unroll
        for (int a = 0; a < 2; ++a)
#pragma unroll
            for (int b = 0; b < 2; ++b)
#pragma unroll
                for (int m = 0; m < 4; ++m)
#pragma unroll
                    for (int n = 0; n < 2; ++n) acc[a][b][m][n] = (f32x4){0.f, 0.f, 0.f, 0.f};
        cur = nxt; cA = nA; cB = nB; ++ui;
        if constexpr (ALIGN_EPI) { if (wr == 1) PG8_BAR; }
    }
    PG8_WAIT_V(0);
    if constexpr (!ALIGN_EPI) { if (wr == 0) PG8_BAR; }
    PG8_BAR;
#undef PG8_SA
#undef PG8_SB
#undef PG8_STAGE
#undef PG8_LDA
#undef PG8_LDB
#undef PG8_MMA
#undef PG8_WAIT_V
#undef PG8_WAIT_L
#undef PG8_BAR
#undef PG8_SCHED
}
}

namespace fox {
constexpr int D = 128, LDQ = 8192, LDO = 2048;
constexpr float SCALE = 0.08838834764831845f;
constexpr float THR2 = 8.f * 1.4426950408889634f;
constexpr int NW = 8, QBLK = 32, KVBLK = 64, QB = NW * QBLK;
constexpr int SHM_V = KVBLK * D * 2, SHM_K = KVBLK * D * 2;
constexpr int BIAS_OFF = 2 * SHM_V + 2 * SHM_K + NW * 64 * 4;
constexpr int LDS_BYTES = BIAS_OFF + 8192 * 4;

#define KSWZ(row, colB) ((row) * 256 + ((colB) ^ (((row) & 7) << 4)))
#define SBAR() __builtin_amdgcn_sched_barrier(0)
__device__ __forceinline__ int v_st(int k, int c) { const int kk = (k & ~0xC) | ((k & 4) << 1) | ((k & 8) >> 1); return ((kk >> 3) * 4 + (c >> 5)) * 512 + ((kk & 7) * 32 + (c & 31)) * 2; }
__device__ __forceinline__ int v_rd_base(int lane) { return ((lane & 3) << 3) | (((lane >> 2) & 3) << 6) | (((lane >> 4) & 1) << 5) | (((lane >> 5) & 1) << 8); }
constexpr int v_rd_off(int d0, int ks, int half) { return d0 * 512 + ks * 4096 + half * 2048; }
__device__ __forceinline__ int crow(int r, int hi) { return (r & 3) + 8 * (r >> 2) + 4 * hi; }
__device__ __forceinline__ unsigned cvtpk(float lo, float hi) { unsigned r; asm volatile("v_cvt_pk_bf16_f32 %0, %1, %2" : "=v"(r) : "v"(lo), "v"(hi)); return r; }
__device__ __forceinline__ bf16x8 load8(const bf16* p) { return *reinterpret_cast<const bf16x8*>(p); }
__device__ __forceinline__ void mask_tile(f32x16& p0, f32x16& p1, int dq) {
    const float NEG = -__builtin_inff();
#pragma unroll
    for (int r = 0; r < 16; ++r) {
        const int c = (r & 3) + 8 * (r >> 2);
        if (dq - c < 0) p0[r] = NEG;
        if (dq - c - 32 < 0) p1[r] = NEG;
    }
}
__device__ __forceinline__ void partialSM(f32x16& p0, f32x16& p1, float& m_reg, float& mn, float& alpha, const float* bl) {
    constexpr float C2 = 1.4426950408889634f * SCALE;
#pragma unroll
    for (int a = 0; a < 4; ++a) {
#ifdef FOX_NOBIAS
        const f32x4 b0 = {0,0,0,0}, b1 = {0,0,0,0};
#else
        const f32x4 b0 = *(const f32x4*)(bl + 8 * a), b1 = *(const f32x4*)(bl + 32 + 8 * a);
#endif

#pragma unroll
        for (int i = 0; i < 4; ++i) { p0[4 * a + i] = fmaf(p0[4 * a + i], C2, b0[i]); p1[4 * a + i] = fmaf(p1[4 * a + i], C2, b1[i]); }
        SBAR(); }
    float pmax = p0[0]; for (int r = 1; r < 16; ++r) pmax = fmaxf(pmax, p0[r]); for (int r = 0; r < 16; ++r) pmax = fmaxf(pmax, p1[r]);
    { auto rr = __builtin_amdgcn_permlane32_swap(__float_as_uint(pmax), __float_as_uint(pmax), false, false);
      pmax = fmaxf(__uint_as_float(rr[0]), __uint_as_float(rr[1])); }
    if (__builtin_expect(__all((pmax - m_reg) <= THR2), 1)) { mn = m_reg; alpha = 1.f; }
    else { mn = fmaxf(m_reg, pmax); alpha = __builtin_amdgcn_exp2f(m_reg - mn); m_reg = mn; }
    for (int r = 0; r < 16; ++r) p0[r] = p0[r] - mn; for (int r = 0; r < 16; ++r) p1[r] = p1[r] - mn;
    for (int r = 0; r < 16; ++r) p0[r] = __builtin_amdgcn_exp2f(p0[r]);
}
__device__ __forceinline__ void finishSM(f32x16& p0, f32x16& p1, float alpha, float& l_reg, bf16x8& pa0, bf16x8& pa1, bf16x8& pa2, bf16x8& pa3) {
    for (int r = 0; r < 16; ++r) p1[r] = __builtin_amdgcn_exp2f(p1[r]);
    float ps = 0; for (int r = 0; r < 16; ++r) ps += p0[r]; for (int r = 0; r < 16; ++r) ps += p1[r];
    { auto rr = __builtin_amdgcn_permlane32_swap(__float_as_uint(ps), __float_as_uint(ps), false, false);
      ps = __uint_as_float(rr[0]) + __uint_as_float(rr[1]); }
    l_reg = l_reg * alpha + ps;
#define PK4(P, B_, OUT) do { unsigned a0 = cvtpk(P[B_+0], P[B_+1]), a1 = cvtpk(P[B_+2], P[B_+3]);                          \
        unsigned b0 = cvtpk(P[B_+4], P[B_+5]), b1 = cvtpk(P[B_+6], P[B_+7]);                                             \
        auto r0 = __builtin_amdgcn_permlane32_swap(a0, b0, false, false); auto r1 = __builtin_amdgcn_permlane32_swap(a1, b1, false, false); \
        u32x4 w = {r0[0], r1[0], r0[1], r1[1]}; OUT = *reinterpret_cast<bf16x8*>(&w); } while (0)
    PK4(p0, 0, pa0); PK4(p0, 8, pa1); PK4(p1, 0, pa2); PK4(p1, 8, pa3);
#undef PK4
}
template <int KB>
__device__ __forceinline__ void qkt(f32x16& p0, f32x16& p1, const char* K_lds, int r32, int hi, const bf16x8* qr) {
    p0 = f32x16{}; p1 = f32x16{};
    const char* kb[4];
#pragma unroll
    for (int dd = 0; dd < 4; ++dd) kb[dd] = K_lds + KB * SHM_K + KSWZ(r32, (dd * 16 + hi * 8) * 2);
#pragma unroll
    for (int d0 = 0; d0 < 8; ++d0) { const char* a = kb[d0 & 3] + (d0 >> 2) * 128;
        bf16x8 b0 = *reinterpret_cast<const bf16x8*>(a);
        bf16x8 b1 = *reinterpret_cast<const bf16x8*>(a + 32 * 256);
        p0 = __builtin_amdgcn_mfma_f32_32x32x16_bf16(b0, qr[d0], p0, 0, 0, 0);
        p1 = __builtin_amdgcn_mfma_f32_32x32x16_bf16(b1, qr[d0], p1, 0, 0, 0); }
}
template <int VB>
__device__ __forceinline__ void pv_tile(f32x16* o, int vb0, bf16x8 pa0, bf16x8 pa1, bf16x8 pa2, bf16x8 pa3) {
#define TRRD(dst, off) asm volatile("ds_read_b64_tr_b16 %0, %1 offset:%2" : "=&v"(dst) : "v"(vb0), "i"(off) : "memory")
#define PV_D0(d0) do { s16x4 l0, l1, l2, l3, h0, h1, h2, h3; constexpr int b_ = VB * SHM_V + v_rd_off(d0, 0, 0); \
        TRRD(l0, b_); TRRD(h0, b_ + 2048); TRRD(l1, b_ + 4096); TRRD(h1, b_ + 6144); TRRD(l2, b_ + 8192); TRRD(h2, b_ + 10240); TRRD(l3, b_ + 12288); TRRD(h3, b_ + 14336); \
        asm volatile("s_waitcnt lgkmcnt(0)" ::: "memory"); SBAR();   \
        o[d0] = __builtin_amdgcn_mfma_f32_32x32x16_bf16(pa0, (bf16x8){l0[0], l0[1], l0[2], l0[3], h0[0], h0[1], h0[2], h0[3]}, o[d0], 0, 0, 0);   \
        o[d0] = __builtin_amdgcn_mfma_f32_32x32x16_bf16(pa1, (bf16x8){l1[0], l1[1], l1[2], l1[3], h1[0], h1[1], h1[2], h1[3]}, o[d0], 0, 0, 0);   \
        o[d0] = __builtin_amdgcn_mfma_f32_32x32x16_bf16(pa2, (bf16x8){l2[0], l2[1], l2[2], l2[3], h2[0], h2[1], h2[2], h2[3]}, o[d0], 0, 0, 0);   \
        o[d0] = __builtin_amdgcn_mfma_f32_32x32x16_bf16(pa3, (bf16x8){l3[0], l3[1], l3[2], l3[3], h3[0], h3[1], h3[2], h3[3]}, o[d0], 0, 0, 0); } while (0)
    PV_D0(0); PV_D0(1); PV_D0(2); PV_D0(3);
#undef PV_D0
#undef TRRD
}

struct BlockRef { const bf16* Q; const bf16* K; const bf16* V; const bf16* G; bf16* O; int P0; };
struct Seam { bf16x8 qr[8]; bf16x8 st_v0, st_v1, st_k0, st_k1; };
#define LD8(base, boff) (*reinterpret_cast<const bf16x8*>((const char*)(base) + (boff)))
#define VMW() asm volatile("s_waitcnt vmcnt(0)" ::: "memory")
#define VMWN(n) asm volatile("s_waitcnt vmcnt(%0)" :: "i"(n) : "memory")
#define SLOAD_H(Kp, Vp, k0) do { const char* kb__ = (const char*)(Kp) + (size_t)(k0) * (LDQ * 2); const char* vb__ = (const char*)(Vp) + (size_t)(k0) * (LDQ * 2); \
                         S.st_v0 = LD8(vb__, kvoff); S.st_v1 = LD8(vb__, kvoff + 32u * LDQ * 2u);              \
                         S.st_k0 = LD8(kb__, kvoff); S.st_k1 = LD8(kb__, kvoff + 32u * LDQ * 2u); } while (0)
#define SWRITE_HK(bf) do { *(bf16x8*)(K_lds + (bf) * SHM_K + kws) = S.st_k0; *(bf16x8*)(K_lds + (bf) * SHM_K + kws + 32 * 256) = S.st_k1; } while (0)
#define SWRITE_HV(bf) do { *(bf16x8*)(V_lds + (bf) * SHM_V + vst0) = S.st_v0; *(bf16x8*)(V_lds + (bf) * SHM_V + vst1) = S.st_v1; } while (0)
#define SWRITE_H(bf) do { SWRITE_HV(bf); SWRITE_HK(bf); } while (0)
__device__ __forceinline__ void prime(const BlockRef& cur, char* lds, Seam& S) {
    const int tid = threadIdx.x, wid = __builtin_amdgcn_readfirstlane(tid >> 6), lane = tid & 63, r32 = lane & 31, hi = lane >> 5;
    const int sr = tid >> 4, sc = (tid & 15) * 8, kws = KSWZ(sr, sc * 2); char* K_lds = lds + 2 * SHM_V;
    const unsigned kvoff = (unsigned)(sr * LDQ + sc) * 2u, qoff = (unsigned)((wid * QBLK + r32) * LDQ + hi * 8) * 2u;
    for (int d0 = 0; d0 < 8; ++d0) S.qr[d0] = LD8(cur.Q, qoff + d0 * 32);
    SLOAD_H(cur.K, cur.V, 0); VMW(); SWRITE_HK(0);
    __syncthreads();
}
__device__ __forceinline__ void block(const BlockRef& cur, const BlockRef& nxt, char* lds, Seam& S) {
    const int tid = threadIdx.x, wid = __builtin_amdgcn_readfirstlane(tid >> 6), lane = tid & 63, r32 = lane & 31, hi = lane >> 5;
    const int NT = (cur.P0 + QB - 1) / KVBLK + 1;
    const int qlo = cur.P0 + wid * QBLK, qm = qlo + r32 - 4 * hi;
    char* V_lds = lds; char* K_lds = lds + 2 * SHM_V;
    float* ws = (float*)(lds + 2 * SHM_V + 2 * SHM_K) + wid * 64; float* li_l = ws, * al_l = ws + 32;
    const float* biasl = (const float*)(lds + BIAS_OFF) + 4 * hi;
    float m_reg = -1e30f, l_reg = 0; f32x16 o[4] = {};
    const int sr = tid >> 4, sc = (tid & 15) * 8, vst0 = v_st(sr, sc), vst1 = v_st(32 + sr, sc), kws = KSWZ(sr, sc * 2);
    const unsigned kvoff = (unsigned)(sr * LDQ + sc) * 2u;
    const int vb0 = (int)(uintptr_t)V_lds + v_rd_base(lane);
    const bf16* Kh = cur.K; const bf16* Vh = cur.V;
#define RESC(a) do { if (__any((a) < 1.f)) { if (hi == 0) al_l[r32] = (a); asm volatile("s_waitcnt lgkmcnt(0)" ::: "memory");              \
                     for (int d_ = 0; d_ < 4; ++d_) for (int r = 0; r < 16; ++r) o[d_][r] *= al_l[crow(r, hi)]; } } while (0)
#define KBASE(t) ((t) * KVBLK)
#define MASKT(P0_, P1_, t) do { const int kb_ = KBASE(t); if (kb_ + KVBLK - 1 > qlo) mask_tile(P0_, P1_, qm - kb_); } while (0)
    constexpr int NQL = 8;
#define SEAM_K0() do { VMWN(NQL); SWRITE_HK(0); SBAR(); } while (0)
    f32x16 pA0, pA1, pB0, pB1; float mnA, mnB, alA, alB; bf16x8 pa0, pa1, pa2, pa3;
    SWRITE_HV(0); SBAR();
    if (NT > 1) { SLOAD_H(Kh, Vh, KBASE(1)); }
    SBAR(); qkt<0>(pA0, pA1, K_lds, r32, hi, S.qr);
    MASKT(pA0, pA1, 0); partialSM(pA0, pA1, m_reg, mnA, alA, biasl + KBASE(0));
    if (NT > 1) { VMW(); SWRITE_H(1); }
    __syncthreads();
#define HALF_STEP(PX0, PX1, mnX, alX, PY0, PY1, alY, t, KB, VB, SB) do {                                                      \
        SBAR(); qkt<KB>(PX0, PX1, K_lds, r32, hi, S.qr);                                                                      \
        finishSM(PY0, PY1, alY, l_reg, pa0, pa1, pa2, pa3); SBAR();                                                           \
        if ((t) + 1 < NT) { SLOAD_H(Kh, Vh, KBASE((t) + 1)); SBAR(); }                                                        \
        pv_tile<VB>(o, vb0, pa0, pa1, pa2, pa3); MASKT(PX0, PX1, (t)); partialSM(PX0, PX1, m_reg, mnX, alX, biasl + KBASE(t)); \
        __syncthreads();                                                                                                      \
        if ((t) + 1 < NT) { VMW(); SWRITE_H(SB); }                                                                            \
        RESC(alX); __syncthreads(); } while (0)
    for (int t = 1; t + 1 < NT; t += 2) {
        HALF_STEP(pB0, pB1, mnB, alB, pA0, pA1, alA, t, 1, 0, 0);
        HALF_STEP(pA0, pA1, mnA, alA, pB0, pB1, alB, t + 1, 0, 1, 1);
    }
    const bool even = (NT & 1) == 0;
    if (even) { SBAR(); qkt<1>(pB0, pB1, K_lds, r32, hi, S.qr); SBAR(); }
    SLOAD_H(nxt.K, nxt.V, 0); SBAR();
    { unsigned qoff = (unsigned)((wid * QBLK + r32) * LDQ + hi * 8) * 2u; asm volatile("" : "+v"(qoff));
#pragma unroll
      for (int d0 = 0; d0 < 8; ++d0) S.qr[d0] = LD8(nxt.Q, qoff + d0 * 32); }
    SBAR();
    finishSM(pA0, pA1, alA, l_reg, pa0, pa1, pa2, pa3); SBAR();
    pv_tile<0>(o, vb0, pa0, pa1, pa2, pa3);
    if (even) { MASKT(pB0, pB1, NT - 1); partialSM(pB0, pB1, m_reg, mnB, alB, biasl + KBASE(NT - 1)); __syncthreads(); RESC(alB);
        finishSM(pB0, pB1, alB, l_reg, pa0, pa1, pa2, pa3); SBAR(); pv_tile<1>(o, vb0, pa0, pa1, pa2, pa3); }
    SBAR(); SEAM_K0();
    if (hi == 0) li_l[r32] = l_reg; asm volatile("s_waitcnt lgkmcnt(0)" ::: "memory");
    float rli[16];
#pragma unroll
    for (int r = 0; r < 16; ++r) rli[r] = __builtin_amdgcn_rcpf(li_l[crow(r, hi)]);
    unsigned ooff = (unsigned)((wid * QBLK + 4 * hi) * LDO + r32) * 2u, goff = (unsigned)((wid * QBLK + 4 * hi) * LDQ + r32) * 2u;
    asm volatile("" : "+v"(ooff), "+v"(goff));
#pragma unroll
    for (int r = 0; r < 16; ++r) { const unsigned rr = (unsigned)((r & 3) + 8 * (r >> 2));
#pragma unroll
        for (int d0 = 0; d0 < 4; ++d0) {
#ifdef FOX_NOGATE
            const float gv = 0.f;
#else
            const float gv = bf2f(*(const bf16*)((const char*)cur.G + (goff + rr * (LDQ * 2u) + d0 * 64u)));
#endif

            const float v = o[d0][r] * rli[r] * (1.0f / (1.0f + __expf(-gv)));
            const float vn = __shfl_xor(v, 1);
            if ((r32 & 1) == 0) *(unsigned*)((char*)cur.O + (ooff + rr * (LDO * 2u) + d0 * 64u)) = cvtpk(v, vn); } }
    __syncthreads();
#undef RESC
#undef KBASE
#undef MASKT
#undef SEAM_K0
#undef HALF_STEP
}
#undef LD8
#undef VMW
#undef VMWN
#undef SLOAD_H
#undef SWRITE_HK
#undef SWRITE_HV
#undef SWRITE_H
#undef KSWZ
#undef SBAR
}

constexpr int NWAVES = 8;
constexpr size_t MiB = 1u << 20;
constexpr size_t WS_CTL = 0, CTL_ZERO_BYTES = 1 * MiB;
constexpr size_t WS_MEMN = 1 * MiB;
constexpr size_t WS_KMEM = 2 * MiB;
constexpr size_t WS_VTMEM = 4 * MiB;
constexpr size_t WS_SMALL = 6 * MiB;
constexpr size_t SM_BONUS = 0;
constexpr size_t SM_FPRE = 512 * 1024;
constexpr size_t SM_BIASL2 = 1024 * 1024;
constexpr size_t SM_BCUM = 1536 * 1024;
constexpr size_t SM_IG = SM_BCUM + 128 * 1024;
constexpr size_t SM_WSTATE = SM_IG + 128 * 1024;
constexpr size_t SM_CHBL = SM_WSTATE + 128 * 1024;
constexpr size_t SM_CHMD = SM_CHBL + 4096;
constexpr size_t SM_MSEQ = SM_CHMD + 4096;
constexpr size_t SM_WCARRY = SM_MSEQ + 4096;
constexpr size_t SM_TOPI = 2048 * 1024;
constexpr size_t SM_TOPG = SM_TOPI + 64 * 1024;
constexpr size_t SM_SLOT = SM_TOPG + 64 * 1024;
constexpr size_t SM_BLKCNT = SM_SLOT + 64 * 1024;
constexpr size_t SM_TILEE = SM_BLKCNT + 8192;
constexpr size_t SM_NU = 3 * 1024 * 1024;
constexpr size_t SM_SLOC = 4 * 1024 * 1024;
constexpr size_t SM_PEND = 5 * 1024 * 1024;
constexpr size_t SM_SIN = 6 * 1024 * 1024;
constexpr size_t WS_X = 16 * MiB;
constexpr size_t WS_XN = 80 * MiB;
constexpr size_t WS_W_XQ = 112 * MiB, WS_W_XKV = 128 * MiB, WS_W_XO = 160 * MiB, WS_W_ABIN = 176 * MiB, WS_W_LORA = 206 * MiB, WS_W_ABOUT = 209 * MiB,
                 WS_W_FFNGU = 217 * MiB, WS_W_FFND = 261 * MiB, WS_W_FOXIN = 283 * MiB, WS_W_FOXOUT = 315 * MiB, WS_W_MOEGU = 323 * MiB, WS_W_MOED = 675 * MiB;
constexpr size_t WS_R = 851 * MiB;
constexpr size_t R_PROJ = WS_R + 0 * MiB;
constexpr size_t R_GATES32 = WS_R + 120 * MiB;
constexpr size_t R_LORAIN = WS_R + 128 * MiB;
constexpr size_t R_LORAOUT = WS_R + 136 * MiB;
constexpr size_t R_SC = WS_R + 232 * MiB;
constexpr size_t SC_STRIDE = 32 * MiB;
constexpr size_t R_FR = WS_R + 232 * MiB;
constexpr size_t R_SV = WS_R + 392 * MiB;
constexpr size_t R_Y = WS_R + 424 * MiB;
constexpr size_t R_QB = WS_R + 456 * MiB, R_KB = WS_R + 472 * MiB, R_VB = WS_R + 488 * MiB;
constexpr size_t R_U = WS_R + 504 * MiB;
constexpr size_t R_YCAT = WS_R + 568 * MiB;
constexpr size_t R_XQ = WS_R + 0 * MiB;
constexpr size_t R_XS = WS_R + 32 * MiB;
constexpr size_t R_XP = WS_R + 64 * MiB;
constexpr size_t R_XO = WS_R + 80 * MiB;
constexpr size_t R_ACT = WS_R + 112 * MiB;
constexpr size_t R_QKVG = WS_R + 200 * MiB;
constexpr size_t R_ATTO = WS_R + 328 * MiB;
constexpr size_t R_AG = WS_R + 0 * MiB;
constexpr size_t R_ACTG = WS_R + 72 * MiB;
constexpr size_t R_YG = WS_R + 270 * MiB;
constexpr size_t R_YSIDE = WS_R + 416 * MiB;
constexpr size_t YSIDE_STRIDE = (size_t)8 * 256 * D;
constexpr size_t R_Z = WS_R + 600 * MiB;
constexpr size_t WS_END = WS_R + 624 * MiB;
static_assert(R_YG + (size_t)MOE_ROWS * D * 4 <= WS_END && R_ACTG + (size_t)MOE_ROWS * DFF * 2 <= R_YG && R_YCAT + (size_t)T * D * 2 <= WS_END, "ws map");
static_assert(WS_W_MOED + (size_t)NEXP * D * DFF * 2 <= WS_R && WS_W_MOEGU + (size_t)NEXP * 2 * DFF * D * 2 <= WS_W_MOED, "ws map (weights)");
constexpr int CW_BAR = 4096;
constexpr size_t CTL_SSQ = 65536;

constexpr int RING_OFF = 0, RING_BYTES = 147456;
constexpr int LDSCTL_OFF = RING_BYTES, MISC_OFF = LDSCTL_OFF + 320;
constexpr int LDS_BYTES = RING_BYTES + 4096;

typedef GAS unsigned gu32;
#define RLX_AGENT __ATOMIC_RELAXED, __HIP_MEMORY_SCOPE_AGENT
#define LDS_WAIT() asm volatile("s_waitcnt lgkmcnt(0)" ::: "memory")
#define VM_WAIT() asm volatile("s_waitcnt vmcnt(0)" ::: "memory")

#define XB_TMO      128
#define XB_XCNT(j)  (256  + 64 * (j))
#define XB_XSUB(j)  (1280 + 64 * (j))
#define XB_XGEN(j)  (2304 + 64 * (j))
#define XB_TOP      3328
#define XB_TOPGEN   3392
#define XCD_BAR_WORDS 3456
#define XB_SPIN_CAP (1u << 18)
__device__ __forceinline__ unsigned xb_ld(unsigned* p)              { return __hip_atomic_load(p, __ATOMIC_RELAXED, __HIP_MEMORY_SCOPE_AGENT); }
__device__ __forceinline__ unsigned xb_add(unsigned* p, unsigned v) { return __hip_atomic_fetch_add(p, v, __ATOMIC_RELAXED, __HIP_MEMORY_SCOPE_AGENT); }
__device__ __forceinline__ unsigned xb_xcc_id() { return (unsigned)__builtin_amdgcn_s_getreg((3 << 11) | 20) & 0xFu; }
#define XB_SPIN(cond, bar) do { unsigned _sp = 0; while (cond) { __builtin_amdgcn_s_sleep(1); \
    if ((++_sp & 255u) == 0u) { if (xb_ld(&(bar)[XB_TMO])) break; if (_sp > XB_SPIN_CAP) { atomicAdd(&(bar)[XB_TMO], 1u); break; } } } } while (0)
struct XcdBarrier { unsigned* bar; unsigned x; volatile LAS unsigned* st; };
__device__ __forceinline__ XcdBarrier xcd_barrier_post(unsigned* bar, volatile LAS unsigned* st) {
    XcdBarrier b; b.bar = bar; b.x = xb_xcc_id(); b.st = st;
    if (threadIdx.x == 0) (void)xb_add(&bar[XB_XCNT(b.x)], 1u);
    return b;
}
__device__ __forceinline__ void xcd_barrier_complete(unsigned* bar, unsigned x, unsigned& nloc, unsigned& nx) {
    const unsigned G = gridDim.x * gridDim.y * gridDim.z;
    unsigned sum, cnt, mine, sp = 0u;
    for (;;) {
        sum = 0u; cnt = 0u; mine = 0u;
#pragma unroll
        for (unsigned j = 0; j < 16; ++j) { const unsigned c = xb_ld(&bar[XB_XCNT(j)]); sum += c; cnt += (c > 0u) ? 1u : 0u; mine = (j == x) ? c : mine; }
        if (sum == G) break;
        __builtin_amdgcn_s_sleep(1);
        if ((++sp & 255u) == 0u) { if (xb_ld(&bar[XB_TMO])) break; if (sp > XB_SPIN_CAP) { atomicAdd(&bar[XB_TMO], 1u); break; } }
    }
    nloc = mine > 0u ? mine : 1u; nx = cnt > 0u ? cnt : 1u;
}
__device__ __forceinline__ void xcd_barrier(const XcdBarrier& b) {
    asm volatile("s_waitcnt vmcnt(0)" ::: "memory");
    __syncthreads();
    if (threadIdx.x == 0) {
        unsigned* bar = b.bar;
        __builtin_amdgcn_s_waitcnt(0);
        unsigned nloc = b.st[0], nx = b.st[1];
        if (nloc == 0u) { xcd_barrier_complete(bar, b.x, nloc, nx); b.st[0] = nloc; b.st[1] = nx; }
        const unsigned old = xb_add(&bar[XB_XSUB(b.x)], 1u);
        const unsigned gen = old / nloc;
        if (old + 1u == (gen + 1u) * nloc) {
            __builtin_amdgcn_fence(__ATOMIC_RELEASE, "agent");
            asm volatile("s_waitcnt vmcnt(0)" ::: "memory");
            const unsigned og = xb_add(&bar[XB_TOP], 1u);
            const unsigned tg = og / nx;
            if (og + 1u == (tg + 1u) * nx) xb_add(&bar[XB_TOPGEN], 1u);
            else XB_SPIN(xb_ld(&bar[XB_TOPGEN]) == tg, bar);
            __builtin_amdgcn_fence(__ATOMIC_ACQUIRE, "agent");
            xb_add(&bar[XB_XGEN(b.x)], 1u);
            asm volatile("s_waitcnt vmcnt(0)" ::: "memory");
        } else {
            XB_SPIN(xb_ld(&bar[XB_XGEN(b.x)]) == gen, bar);
            __builtin_amdgcn_fence(__ATOMIC_ACQUIRE, "agent");
            asm volatile("s_waitcnt vmcnt(0)" ::: "memory");
        }
    }
    __syncthreads();
}

struct Frame {
    LAS unsigned char* lds; unsigned char* ldsg;
    unsigned char* ws; const float* const* in; float* out;
    int tid, lane, wave, vcu, G, gw, NGW;
};

enum InIdx { I_X = 0, I_MEM, I_MEMG, I_FING, I_NMIXG, I_NXAG, I_NFFNG, I_XWQ, I_XWKV, I_XWO, I_ABWIN, I_ABMU, I_RWW0, I_RWWUP, I_RWA0, I_RWAUP, I_RWGUP, I_RWKK, I_RWKA, I_RWRK,
             I_RWLNG, I_RWLNB, I_MLCONV, I_MLBIF, I_MLNG, I_ABWOUT, I_FFG, I_FFU, I_FFD, I_FOXWIN, I_FOXBF, I_FOXQG, I_FOXKG, I_FOXWOUT, I_ROUTER, I_MOEG, I_MOEU, I_MOED, N_IN };
struct Args { const float* in[N_IN]; float* out; unsigned char* ws; int ph_lo, ph_hi; };
static_assert(sizeof(Args) == (N_IN + 2) * 8 + 8, "Args has no padding");

#define WSP(T_, off) ((T_*)(F.ws + (off)))

__device__ __forceinline__ void rms_row(const float* xrow, const float* g, bf16* orow, int lane, f32x4 (&y)[8]) {
    const f32x4* xr = (const f32x4*)xrow + lane; const f32x4* gr = (const f32x4*)g + lane;
    float s = 0.f;
#pragma unroll
    for (int j = 0; j < 8; ++j) { y[j] = xr[64 * j]; s += (y[j][0] * y[j][0] + y[j][1] * y[j][1]) + (y[j][2] * y[j][2] + y[j][3] * y[j][3]); }
    const float r = 1.0f / sqrtf(wave_sum(s) * (1.0f / D) + 1e-6f);
#pragma unroll
    for (int j = 0; j < 8; ++j) { const f32x4 gv = gr[64 * j]; y[j] = y[j] * r * gv; }
    if (orow) { u32x2* o8 = (u32x2*)orow + lane;
#pragma unroll
        for (int j = 0; j < 8; ++j) { u32x2 w; w.x = cvt_pk_bf16(y[j][0], y[j][1]); w.y = cvt_pk_bf16(y[j][2], y[j][3]); o8[64 * j] = w; } }
}
__device__ __forceinline__ void norm_phase(const Frame& F, const float* X, const float* g, bf16* XN, int nrows) {
    for (int t = F.gw; t < nrows; t += F.NGW) { f32x4 y[8]; rms_row(X + (size_t)t * D, g, XN + (size_t)t * D, F.lane, y); }
}
template <int NC>
__device__ __forceinline__ void stage_skinny(const Frame& F, const float* W, int ldw, int c0, LAS float* Ws) {
    for (int i = F.tid; i < D * NC; i += NWAVES * 64) { const int e = i / NC, c = i % NC; Ws[c * D + e] = W[(size_t)e * ldw + c0 + c]; }
}
template <int NC>
__device__ __forceinline__ void skinny_dot(const f32x4 (&y)[8], const LAS float* Ws, int lane, float (&out)[NC]) {
#pragma unroll
    for (int c = 0; c < NC; ++c) { float s = 0.f;
#pragma unroll
        for (int j = 0; j < 8; ++j) { const f32x4 w = *(const LAS f32x4*)(Ws + c * D + 256 * j + 4 * lane); s += (y[j][0] * w[0] + y[j][1] * w[1]) + (y[j][2] * w[2] + y[j][3] * w[3]); }
        out[c] = wave_sum(s); }
}

__device__ __forceinline__ void titem_load(const float* W, int ldw, int k0, int n0, int nvalid, int lane, float (&v)[32]) {
    const int n = lane & 31; const float* p = W + (size_t)(k0 + (lane >> 5)) * ldw + n0 + n;
#pragma unroll
    for (int i = 0; i < 32; ++i) v[i] = (n < nvalid) ? __builtin_nontemporal_load(p + (size_t)(2 * i) * ldw) : 0.f;
}
__device__ __forceinline__ void titem_finish(const float (&v)[32], int k0, int nvalid, bf16* WT0  , int K, LAS float* scr, int lane) {
#pragma unroll
    for (int i = 0; i < 32; ++i) scr[(2 * i + (lane >> 5)) * 33 + (lane & 31)] = v[i];
    LDS_WAIT(); asm volatile("" ::: "memory");
    const int c = lane & 7;
#pragma unroll
    for (int j = 0; j < 4; ++j) { const int n = (lane >> 3) + 8 * j; const LAS float* s = scr + (8 * c) * 33 + n;
        u32x4 o; o.x = cvt_pk_bf16(s[0 * 33], s[1 * 33]); o.y = cvt_pk_bf16(s[2 * 33], s[3 * 33]); o.z = cvt_pk_bf16(s[4 * 33], s[5 * 33]); o.w = cvt_pk_bf16(s[6 * 33], s[7 * 33]);
        if (n < nvalid) __builtin_nontemporal_store(o, (u32x4*)(WT0 + (size_t)n * K + k0 + 8 * c)); }
    LDS_WAIT(); asm volatile("" ::: "memory");
}
__device__ __forceinline__ void transpose_matrix(const Frame& F, int gw, int NGW, const float* W, int ldw, int K, int N, bf16* WT, int mode, int& it0, LAS float* scr) {
    const int nblk = (N + 31) / 32, nitems = (K / 64) * nblk;
    int first = gw - (it0 % NGW); if (first < 0) first += NGW;
    it0 += nitems;
    if (first >= nitems) return;
    float va[32], vb[32];
    { const int kb = first / nblk, nb = first % nblk, n0 = 32 * nb; titem_load(W, ldw, 64 * kb, n0, (N - n0) < 32 ? (N - n0) : 32, F.lane, va); }
    for (int r = first; r < nitems; r += NGW) {
        const int kb = r / nblk, nb = r % nblk, n0 = 32 * nb; const int nvalid = (N - n0) < 32 ? (N - n0) : 32;
        const int drow = mode == 0 ? n0 : ((n0 >> 7) * 256 + (n0 & 127) + (mode == 2 ? 128 : 0));
        const int rn = r + NGW;
        if (rn < nitems) { const int kbn = rn / nblk, nbn = rn % nblk, n0n = 32 * nbn; titem_load(W, ldw, 64 * kbn, n0n, (N - n0n) < 32 ? (N - n0n) : 32, F.lane, vb); }
        titem_finish(va, 64 * kb, nvalid, WT + (size_t)drow * K, K, scr, F.lane);
#pragma unroll
        for (int i = 0; i < 32; ++i) va[i] = vb[i];
    }
}
__device__ __forceinline__ void p_convert_early(const Frame& F, const Args& A) {
    LAS float* scr = (LAS float*)(F.lds + RING_OFF + F.wave * 16384);
    int it0 = 0;
    for (int l = 0; l < 2; ++l)
        transpose_matrix(F, F.gw, F.NGW, A.in[I_XWKV] + (size_t)l * D * 2 * D, 2 * D, D, 2 * D, WSP(bf16, WS_W_XKV) + (size_t)l * 2 * D * D, 0, it0, scr);
    transpose_matrix(F, F.gw, F.NGW, A.in[I_ABWIN], AB_COLS, D, AB_COLS, WSP(bf16, WS_W_ABIN), 0, it0, scr);
    const int gt = F.gw * 64 + F.lane, NGT = F.NGW * 64;
    { u32x4* z = (u32x4*)(WSP(bf16, WS_W_ABIN) + (size_t)AB_COLS * D); const int n16 = (AB_PAD - AB_COLS) * D * 2 / 16;
      for (int i = gt; i < n16; i += NGT) z[i] = (u32x4){0u, 0u, 0u, 0u}; }
    { bf16* WL = WSP(bf16, WS_W_LORA); const float* wup = A.in[I_RWWUP]; const float* aup = A.in[I_RWAUP]; const float* gup = A.in[I_RWGUP];
      for (int i = gt; i < 3072 * 64; i += NGT) { const int n = i >> 6, k8 = (i & 63) * 8; const int sec = n >> 10, nn = n & 1023; float v[8];
#pragma unroll
          for (int j = 0; j < 8; ++j) { const int k = k8 + j; float x = 0.f;
              if (sec == 0) { if (k < 96) x = wup[(size_t)k * 1024 + nn]; }
              else if (sec == 1) { if (k >= 96 && k < 192) x = aup[(size_t)(k - 96) * 1024 + nn]; }
              else { if (k >= 192 && k < 448) x = gup[(size_t)(k - 192) * 1024 + nn]; }
              v[j] = x; }
          u32x4 o; o.x = cvt_pk_bf16(v[0], v[1]); o.y = cvt_pk_bf16(v[2], v[3]); o.z = cvt_pk_bf16(v[4], v[5]); o.w = cvt_pk_bf16(v[6], v[7]);
          *(u32x4*)(WL + (size_t)n * 512 + k8) = o; } }
    norm_phase(F, A.in[I_MEM], A.in[I_MEMG], WSP(bf16, WS_MEMN), NMEM);
    norm_phase(F, A.in[I_X], A.in[I_NMIXG], WSP(bf16, WS_XN), T);
}
__device__ __forceinline__ void p_convert_late(const Frame& F, const Args& A, int gw, int NGW, LAS float* scr, bool with_dense, int e_lo, int e_hi) {
    int it0 = 0;
    if (with_dense) {
        transpose_matrix(F, gw, NGW, A.in[I_ABWOUT], D, D, D, WSP(bf16, WS_W_ABOUT), 0, it0, scr);
        for (int l = 0; l < 2; ++l) {
            transpose_matrix(F, gw, NGW, A.in[I_XWQ] + (size_t)l * D * D, D, D, D, WSP(bf16, WS_W_XQ) + (size_t)l * D * D, 0, it0, scr);
            transpose_matrix(F, gw, NGW, A.in[I_XWO] + (size_t)l * D * D, D, D, D, WSP(bf16, WS_W_XO) + (size_t)l * D * D, 0, it0, scr);
        }
        transpose_matrix(F, gw, NGW, A.in[I_FFG], DFF, D, DFF, WSP(bf16, WS_W_FFNGU), 1, it0, scr);
        transpose_matrix(F, gw, NGW, A.in[I_FFU], DFF, D, DFF, WSP(bf16, WS_W_FFNGU), 2, it0, scr);
        transpose_matrix(F, gw, NGW, A.in[I_FFD], D, DFF, D, WSP(bf16, WS_W_FFND), 0, it0, scr);
        transpose_matrix(F, gw, NGW, A.in[I_FOXWIN], FOX_LD, D, 8192, WSP(bf16, WS_W_FOXIN), 0, it0, scr);
        transpose_matrix(F, gw, NGW, A.in[I_FOXWOUT], D, D, D, WSP(bf16, WS_W_FOXOUT), 0, it0, scr);
    }
    for (int e = e_lo; e < e_hi; ++e) {
        transpose_matrix(F, gw, NGW, A.in[I_MOEG] + (size_t)e * D * DFF, DFF, D, DFF, WSP(bf16, WS_W_MOEGU) + (size_t)e * 2 * DFF * D, 1, it0, scr);
        transpose_matrix(F, gw, NGW, A.in[I_MOEU] + (size_t)e * D * DFF, DFF, D, DFF, WSP(bf16, WS_W_MOEGU) + (size_t)e * 2 * DFF * D, 2, it0, scr);
        transpose_matrix(F, gw, NGW, A.in[I_MOED] + (size_t)e * DFF * D, D, DFF, D, WSP(bf16, WS_W_MOED) + (size_t)e * D * DFF, 0, it0, scr);
    }
}

struct InprojKvOrder {
    const bf16* xn; const bf16* wabin; const bf16* memn; const bf16* wkv; int G, c;
    __device__ __forceinline__ bool next(int i, pg8::Unit& u) const {
        const int L = i * G + c; u.pad = 0;
        if (L < 32 * (AB_PAD / 256)) { int pm, pn; pg8::static_tile(i, G, c, 32, AB_PAD / 256, pm, pn); u.pm = pm; u.pn = pn; u.aux = -1;
            u.a = (const char*)(xn + (size_t)pm * 256 * D); u.b = (const char*)(wabin + (size_t)pn * 256 * D); return true; }
        const int j = L - 32 * (AB_PAD / 256); if (j >= 32) return false;
        const int l = j >> 4, kind = (j >> 3) & 1, idx = j & 7; const bf16* w = wkv + (size_t)l * 2 * D * D;
        if (kind == 0) { u.a = (const char*)memn; u.b = (const char*)(w + (size_t)idx * 256 * D); u.pm = 0; u.pn = idx; }
        else { u.a = (const char*)(w + (size_t)(D + idx * 256) * D); u.b = (const char*)memn; u.pm = idx; u.pn = 0; }
        u.aux = l * 2 + kind; return true;
    }
};
struct EpiInprojKv {
    static constexpr bool PERM = true;
    bf16* proj; float* gates32; bf16* kmem; bf16* vtmem;
    __device__ __forceinline__ void operator()(const f32x4 (&acc)[2][2][4][2], const pg8::Unit& u, int wr, int wc, int fr, int fq) const {
        if (u.aux < 0) { pg8::EpiBf16 E{proj, AB_PAD, gates32, 29, nullptr}; E(acc, u, wr, wc, fr, fq); }
        else { const int l = u.aux >> 1, kind = u.aux & 1;
            pg8::EpiBf16 E{kind == 0 ? kmem + (size_t)l * NMEM * D : vtmem + (size_t)l * D * NMEM, kind == 0 ? D : NMEM, nullptr, -1, nullptr};
            E(acc, u, wr, wc, fr, fq); }
    }
};

__device__ __forceinline__ void p_prepa(const Frame& F, const Args& A) {
    const bf16* PROJ = WSP(bf16, R_PROJ); const float* mu = A.in[I_ABMU]; const float* convw = A.in[I_MLCONV];
    bf16* LIN = WSP(bf16, R_LORAIN); bf16* QB = WSP(bf16, R_QB); bf16* KB = WSP(bf16, R_KB); bf16* VB = WSP(bf16, R_VB);
    const int lane = F.lane;
    for (int t = F.gw; t < T; t += F.NGW) {
        const bf16* p0 = PROJ + (size_t)t * AB_PAD;
#pragma unroll
        for (int i = 0; i < 7; ++i) { const int cc = lane + 64 * i, c = 3072 + cc; const float p = bf2f(p0[c]); const float pp = t > 0 ? bf2f(p0[c - AB_PAD]) : 0.f;
            const float s = p + (pp - p) * mu[c]; float o;
            if (cc < 96) o = tanhf(s); else if (cc < 192) o = s; else o = sigmoidf_(s);
            LIN[(size_t)t * 512 + cc] = f2bf(o); }
        LIN[(size_t)t * 512 + 448 + lane] = 0;
#pragma unroll
        for (int i = 0; i < 4; ++i) { const int c = 8 * lane + 512 * i; float acc[8];
#pragma unroll
            for (int j = 0; j < 8; ++j) acc[j] = 0.f;
#pragma unroll
            for (int tap = 0; tap < 4; ++tap) { const int tt = t - 3 + tap; if (tt >= 0) {
                const bf16x8 v = *(const bf16x8*)(PROJ + (size_t)tt * AB_PAD + A_COLS + c); const f32x4 w0 = *(const f32x4*)(convw + tap * 2048 + c), w1 = *(const f32x4*)(convw + tap * 2048 + c + 4);
#pragma unroll
                for (int j = 0; j < 4; ++j) { acc[j] += bf2f((unsigned short)v[j]) * w0[j]; acc[4 + j] += bf2f((unsigned short)v[4 + j]) * w1[j]; } } }
            const float sc = c < 1024 ? 0.0625f : 1.0f; float o[8];
#pragma unroll
            for (int j = 0; j < 8; ++j) o[j] = acc[j] * sigmoidf_(acc[j]) * sc;
            u32x4 w; w.x = cvt_pk_bf16(o[0], o[1]); w.y = cvt_pk_bf16(o[2], o[3]); w.z = cvt_pk_bf16(o[4], o[5]); w.w = cvt_pk_bf16(o[6], o[7]);
            if (c < 1024) *(u32x4*)(QB + (size_t)t * 1024 + c) = w; else *(u32x4*)(KB + (size_t)t * 1024 + c - 1024) = w; }
#pragma unroll
        for (int i = 0; i < 2; ++i) { const int c = 8 * lane + 512 * i; *(u32x4*)(VB + (size_t)t * 1024 + c) = *(const u32x4*)(p0 + 5568 + c); }
    }
    const float* G32 = WSP(float, R_GATES32); const float* bif = A.in[I_MLBIF];
    float* BCUM = WSP(float, WS_SMALL + SM_BCUM); float* IG = WSP(float, WS_SMALL + SM_IG); float* CHBL = WSP(float, WS_SMALL + SM_CHBL); float* CHMD = WSP(float, WS_SMALL + SM_CHMD);
    for (int u = F.gw; u < NH_M * 128; u += F.NGW) { const int h = u >> 7, c = u & 127, t = 64 * c + lane;
        const float ig = G32[(size_t)t * 256 + 192 + h] + bif[h], fg = G32[(size_t)t * 256 + 196 + h] + bif[4 + h];
        float b = logsigmoidf_(fg);
#pragma unroll
        for (int o = 1; o < 64; o <<= 1) { const float x = __shfl_up(b, o); if (lane >= o) b += x; }
        const float bl = __shfl(b, 63); const float md = wave_max(bl - b + ig);
        BCUM[h * T + t] = b; IG[h * T + t] = ig;
        if (lane == 0) { CHBL[u] = bl; CHMD[u] = md; } }
}

__device__ __forceinline__ void p_prepb(const Frame& F, const Args& A) {
    const bf16* PROJ = WSP(bf16, R_PROJ); const float* LOUT = WSP(float, R_LORAOUT); const float* mu = A.in[I_ABMU];
    const float* w0 = A.in[I_RWW0]; const float* a0 = A.in[I_RWA0]; const float* kk_ = A.in[I_RWKK]; const float* ka_ = A.in[I_RWKA]; const float* rk_ = A.in[I_RWRK];
    float* SR = WSP(float, R_SC); float* SW = WSP(float, R_SC + SC_STRIDE); float* SKM = WSP(float, R_SC + 2 * SC_STRIDE); float* SV = WSP(float, R_SC + 3 * SC_STRIDE);
    float* SKK = WSP(float, R_SC + 4 * SC_STRIDE); float* SB = WSP(float, R_SC + 5 * SC_STRIDE); float* BONUS = WSP(float, WS_SMALL + SM_BONUS);
    const int lane = F.lane;
    for (int u = F.gw; u < NH_R * (T / 64); u += F.NGW) { const int h = u & 15, tb = u >> 4, c = 64 * h + lane, t0 = 64 * tb;
        const float mur = mu[c], muk = mu[1024 + c], muv = mu[2048 + c], w0c = w0[c], a0c = a0[c], kkc = kk_[c], kac = ka_[c], rkc = rk_[c];
        float pr = 0.f, pk = 0.f, pv = 0.f;
        if (t0 > 0) { const bf16* pp = PROJ + (size_t)(t0 - 1) * AB_PAD; pr = bf2f(pp[c]); pk = bf2f(pp[1024 + c]); pv = bf2f(pp[2048 + c]); }
        constexpr int GT = 8;
        float xr[GT], xk[GT], xv[GT], lw[GT], la[GT], nr[GT], nk[GT], nv[GT], nw[GT], na[GT];
#define PB_LOAD(dr, dk, dv, dw, da, tt_) do { _Pragma("unroll") for (int i = 0; i < GT; ++i) { const bf16* p0 = PROJ + (size_t)(t0 + (tt_) + i) * AB_PAD; const float* lo = LOUT + (size_t)(t0 + (tt_) + i) * 3072; \
            dr[i] = bf2f(p0[c]); dk[i] = bf2f(p0[1024 + c]); dv[i] = bf2f(p0[2048 + c]); dw[i] = lo[c]; da[i] = lo[1024 + c]; } } while (0)
        PB_LOAD(xr, xk, xv, lw, la, 0);
        for (int tt = 0; tt < 64; tt += GT) {
            if (tt + GT < 64) PB_LOAD(nr, nk, nv, nw, na, tt + GT);
            float kk[GT], km[GT], r[GT], v[GT], a[GT], w[GT], q1[GT], q2[GT];
#pragma unroll
            for (int i = 0; i < GT; ++i) { r[i] = xr[i] + (pr - xr[i]) * mur; const float k = xk[i] + (pk - xk[i]) * muk; v[i] = xv[i] + (pv - xv[i]) * muv; pr = xr[i]; pk = xk[i]; pv = xv[i];
                w[i] = __expf(-0.6065306597126334f * sigmoidf_(lw[i] + w0c)); a[i] = sigmoidf_(a0c + la[i]);
                kk[i] = k * kkc; km[i] = k * (1.0f + (a[i] - 1.0f) * kac); q1[i] = kk[i] * kk[i]; q2[i] = r[i] * km[i] * rkc; }
#pragma unroll
            for (int i = 0; i < GT; ++i) { q1[i] = wave_sum_dpp(q1[i]); q2[i] = wave_sum_dpp(q2[i]); }
#pragma unroll
            for (int i = 0; i < GT; ++i) { const float kn = kk[i] / fmaxf(sqrtf(q1[i]), 1e-12f); const size_t o = (size_t)(t0 + tt + i) * 1024 + c;
                SR[o] = r[i]; SW[o] = w[i]; SKM[o] = km[i]; SV[o] = v[i]; SKK[o] = kn; SB[o] = kn * a[i];
                if (lane == 0) BONUS[(t0 + tt + i) * 16 + h] = q2[i]; }
#pragma unroll
            for (int i = 0; i < GT; ++i) { xr[i] = nr[i]; xk[i] = nk[i]; xv[i] = nv[i]; lw[i] = nw[i]; la[i] = na[i]; }
        }
#undef PB_LOAD
    }
    if (F.gw < NH_M) { const int h = F.gw;
        const float* BCUM = WSP(float, WS_SMALL + SM_BCUM); const float* IG = WSP(float, WS_SMALL + SM_IG); const float* CHBL = WSP(float, WS_SMALL + SM_CHBL); const float* CHMD = WSP(float, WS_SMALL + SM_CHMD);
        float* MSEQ = WSP(float, WS_SMALL + SM_MSEQ); float* WCARRY = WSP(float, WS_SMALL + SM_WCARRY); float* WSTATE = WSP(float, WS_SMALL + SM_WSTATE);
        const float bl0 = CHBL[h * 128 + lane], bl1 = CHBL[h * 128 + 64 + lane], md0 = CHMD[h * 128 + lane], md1 = CHMD[h * 128 + 64 + lane];
        float m = 0.f, mine_in0 = 0.f, mine_in1 = 0.f, mine_out0 = 0.f, mine_out1 = 0.f;
#pragma unroll
        for (int c = 0; c < 128; ++c) { const float bl = __shfl(c < 64 ? bl0 : bl1, c & 63), md = __shfl(c < 64 ? md0 : md1, c & 63);
            const float mn = fmaxf(bl + m, md);
            if ((c & 63) == lane) { if (c < 64) { mine_in0 = m; mine_out0 = mn; } else { mine_in1 = m; mine_out1 = mn; } }
            m = mn; }
        MSEQ[h * 128 + lane] = mine_in0; MSEQ[h * 128 + 64 + lane] = mine_in1;
        WCARRY[h * 128 + lane] = __expf(bl0 + mine_in0 - mine_out0); WCARRY[h * 128 + 64 + lane] = __expf(bl1 + mine_in1 - mine_out1);
        for (int c = 0; c < 128; ++c) { const float bl = __shfl(c < 64 ? bl0 : bl1, c & 63), mo = __shfl(c < 64 ? mine_out0 : mine_out1, c & 63); const int t = 64 * c + lane;
            WSTATE[h * T + t] = __expf(bl - BCUM[h * T + t] + IG[h * T + t] - mo); }
    }
}

__device__ __forceinline__ void p_mlstm_pass2(const Frame& F) {
    const int lane = F.lane;
    if (F.gw < NH_M) { const int h = F.gw;
        const float* BCUM = WSP(float, WS_SMALL + SM_BCUM); const float* IG = WSP(float, WS_SMALL + SM_IG); const float* CHBL = WSP(float, WS_SMALL + SM_CHBL); const float* CHMD = WSP(float, WS_SMALL + SM_CHMD);
        float* MSEQ = WSP(float, WS_SMALL + SM_MSEQ); float* WCARRY = WSP(float, WS_SMALL + SM_WCARRY); float* WSTATE = WSP(float, WS_SMALL + SM_WSTATE);
        const float bl0 = CHBL[h * 128 + lane], bl1 = CHBL[h * 128 + 64 + lane], md0 = CHMD[h * 128 + lane], md1 = CHMD[h * 128 + 64 + lane];
        float m = 0.f, mine_in0 = 0.f, mine_in1 = 0.f, mine_out0 = 0.f, mine_out1 = 0.f;
#pragma unroll
        for (int c = 0; c < 128; ++c) { const float bl = __shfl(c < 64 ? bl0 : bl1, c & 63), md = __shfl(c < 64 ? md0 : md1, c & 63);
            const float mn = fmaxf(bl + m, md);
            if ((c & 63) == lane) { if (c < 64) { mine_in0 = m; mine_out0 = mn; } else { mine_in1 = m; mine_out1 = mn; } }
            m = mn; }
        MSEQ[h * 128 + lane] = mine_in0; MSEQ[h * 128 + 64 + lane] = mine_in1;
        WCARRY[h * 128 + lane] = __expf(bl0 + mine_in0 - mine_out0); WCARRY[h * 128 + 64 + lane] = __expf(bl1 + mine_in1 - mine_out1);
        for (int c = 0; c < 128; ++c) { const float bl = __shfl(c < 64 ? bl0 : bl1, c & 63), mo = __shfl(c < 64 ? mine_out0 : mine_out1, c & 63); const int t = 64 * c + lane;
            WSTATE[h * T + t] = __expf(bl - BCUM[h * T + t] + IG[h * T + t] - mo); }
    }
}

__device__ __forceinline__ float row16_sum(float x) {
    x += __builtin_bit_cast(float, __builtin_amdgcn_update_dpp(0, __builtin_bit_cast(int, x), 0xB1, 0xF, 0xF, true));
    x += __builtin_bit_cast(float, __builtin_amdgcn_update_dpp(0, __builtin_bit_cast(int, x), 0x4E, 0xF, 0xF, true));
    x += __builtin_bit_cast(float, __builtin_amdgcn_update_dpp(0, __builtin_bit_cast(int, x), 0x141, 0xF, 0xF, true));
    x += __builtin_bit_cast(float, __builtin_amdgcn_update_dpp(0, __builtin_bit_cast(int, x), 0x140, 0xF, 0xF, true));
    return x;
}
__device__ __forceinline__ void row16_sum2(float& a, float& b) {
#define DPPF(x, ctrl) __builtin_bit_cast(float, __builtin_amdgcn_update_dpp(0, __builtin_bit_cast(int, x), ctrl, 0xF, 0xF, true))
    a += DPPF(a, 0xB1); b += DPPF(b, 0xB1); a += DPPF(a, 0x4E); b += DPPF(b, 0x4E); a += DPPF(a, 0x141); b += DPPF(b, 0x141); a += DPPF(a, 0x140); b += DPPF(b, 0x140);
#undef DPPF
}
constexpr int SCH = 8;
constexpr int SC_VEC = SCH * 256;
constexpr int SC_BUF = 5 * SC_VEC + 1024;
constexpr int SC_NBUF = 3, SC_NSEG = 4;
constexpr int SC_LDS = SC_NSEG * SC_NBUF * SC_BUF;
constexpr int SC_PROG_OFF = SC_LDS;
constexpr int SC_TOUCH_AHEAD = 12;
__device__ __forceinline__ void row16_sum4(float& a, float& b, float& c, float& d) {
#define DPPF(x, ctrl) __builtin_bit_cast(float, __builtin_amdgcn_update_dpp(0, __builtin_bit_cast(int, x), ctrl, 0xF, 0xF, true))
    a += DPPF(a, 0xB1); b += DPPF(b, 0xB1); c += DPPF(c, 0xB1); d += DPPF(d, 0xB1); a += DPPF(a, 0x4E); b += DPPF(b, 0x4E); c += DPPF(c, 0x4E); d += DPPF(d, 0x4E);
    a += DPPF(a, 0x141); b += DPPF(b, 0x141); c += DPPF(c, 0x141); d += DPPF(d, 0x141); a += DPPF(a, 0x140); b += DPPF(b, 0x140); c += DPPF(c, 0x140); d += DPPF(d, 0x140);
#undef DPPF
}
__host__ __device__ constexpr int sc_len(int s) { return s == 0 ? 3328 : (s == 3 ? 1664 : 1600); }
__host__ __device__ constexpr int sc_tb(int s) { return s == 0 ? 0 : 3328 + (s - 1) * 1600; }
static_assert(sc_tb(3) + sc_len(3) == T, "segments cover the sequence");
__device__ __forceinline__ int sc_seg_of(int t) { return t < 3328 ? 0 : (t < 4928 ? 1 : (t < 6528 ? 2 : 3)); }
template <int SEGI>
__device__ __forceinline__ void p_scan(const Frame& F) {
    constexpr bool TR = SEGI >= 1; constexpr int TB = sc_tb(SEGI), SC_SEG = sc_len(SEGI), SC_SEG0 = sc_len(0);
    const int b = blockIdx.x, head = (b & 7) * 2 + ((b >> 3) & 1), rg = b >> 4, lane = F.lane, row = lane >> 4, j = lane & 15;
    const float* SR = WSP(float, R_SC); const float* SW = WSP(float, R_SC + SC_STRIDE); const float* SKM = WSP(float, R_SC + 2 * SC_STRIDE); const float* SV = WSP(float, R_SC + 3 * SC_STRIDE);
    const float* SKK = WSP(float, R_SC + 4 * SC_STRIDE); const float* SB = WSP(float, R_SC + 5 * SC_STRIDE);
    float* Yo = WSP(float, R_Y) + (size_t)TB * 1024; float* Zo = WSP(float, R_Z) + (size_t)(TR ? TB - SC_SEG0 : 0) * 1024;
    LAS unsigned char* lds = F.lds + RING_OFF + SEGI * SC_NBUF * SC_BUF;
    volatile LAS int* prog = (volatile LAS int*)(F.lds + RING_OFF + SC_PROG_OFF);
    const size_t goff = (size_t)TB * 1024 + (size_t)(lane >> 4) * 1024 + head * 64 + (lane & 15) * 4;
    f32x2 L0 = {0.f, 0.f}, L1 = {0.f, 0.f}, T0 = {0.f, 0.f}, T1 = {0.f, 0.f};
    if (TR) { const int i = rg * 4 + row; if ((i >> 2) == j) { const int e = i & 3; T0[0] = e == 0 ? 1.f : 0.f; T0[1] = e == 1 ? 1.f : 0.f; T1[0] = e == 2 ? 1.f : 0.f; T1[1] = e == 3 ? 1.f : 0.f; } }
#define SC_ISSUE(c_, buf_) do { const size_t t0_ = (size_t)(c_) * SCH * 1024; LAS unsigned char* d_ = lds + (buf_) * SC_BUF; \
        _Pragma("unroll") for (int q = 0; q < SCH / 4; ++q) { const size_t o_ = t0_ + (size_t)q * 4096 + goff; \
            __builtin_amdgcn_global_load_lds((const unsigned*)(SKK + o_), (LAS unsigned*)(d_ + 0 * SC_VEC + q * 1024), 16, 0, 0); \
            __builtin_amdgcn_global_load_lds((const unsigned*)(SW  + o_), (LAS unsigned*)(d_ + 1 * SC_VEC + q * 1024), 16, 0, 0); \
            __builtin_amdgcn_global_load_lds((const unsigned*)(SB  + o_), (LAS unsigned*)(d_ + 2 * SC_VEC + q * 1024), 16, 0, 0); \
            __builtin_amdgcn_global_load_lds((const unsigned*)(SR  + o_), (LAS unsigned*)(d_ + 3 * SC_VEC + q * 1024), 16, 0, 0); \
            __builtin_amdgcn_global_load_lds((const unsigned*)(SKM + o_), (LAS unsigned*)(d_ + 4 * SC_VEC + q * 1024), 16, 0, 0); } \
        { int ts_ = TB + (c_) * SCH + lane; ts_ = ts_ < T ? ts_ : T - 1; \
          __builtin_amdgcn_global_load_lds((const unsigned*)(SV + (size_t)ts_ * 1024 + head * 64 + rg * 4), (LAS unsigned*)(d_ + 5 * SC_VEC), 16, 0, 0); } } while (0)
    __builtin_amdgcn_s_setprio(3);
    constexpr int NCH = SC_SEG / SCH;
    static_assert(NCH % 2 == 0 && SC_NBUF == 3, "three-buffer pipeline, 11 loads per chunk");
    SC_ISSUE(0, 0); SC_ISSUE(1, 1);
    int buf = 0; float ykL = 0.f, ykT = 0.f; f32x2 rp0 = {0.f, 0.f}, rp1 = {0.f, 0.f};
    for (int c = 0; c < NCH; ++c) {
        if (c < NCH - 1) asm volatile("s_waitcnt vmcnt(11)" ::: "memory"); else asm volatile("s_waitcnt vmcnt(0)" ::: "memory");
        if (c + 2 < NCH) { const int nb = buf >= 1 ? buf - 1 : buf + 2; SC_ISSUE(c + 2, nb); }
        if (SEGI == 0 && lane == 0) *prog = c;
        const LAS unsigned char* d = lds + buf * SC_BUF + j * 16;
        const LAS unsigned char* dv = lds + buf * SC_BUF + 5 * SC_VEC + row * 4;
        const int jb = (c & 1) * SCH;
        f32x2 kkA, kkB, wA, wB, bA, bB, kmA, kmB, rA, rB; float vv;
#define SC_LOAD(s_) do { const f32x4 kk_ = *(const LAS f32x4*)(d + 0 * SC_VEC + (s_) * 256), w_ = *(const LAS f32x4*)(d + 1 * SC_VEC + (s_) * 256), b_ = *(const LAS f32x4*)(d + 2 * SC_VEC + (s_) * 256); \
        const f32x4 r_ = *(const LAS f32x4*)(d + 3 * SC_VEC + (s_) * 256), km_ = *(const LAS f32x4*)(d + 4 * SC_VEC + (s_) * 256); vv = *(const LAS float*)(dv + (s_) * 16); \
        kkA = (f32x2){kk_[0], kk_[1]}; kkB = (f32x2){kk_[2], kk_[3]}; wA = (f32x2){w_[0], w_[1]}; wB = (f32x2){w_[2], w_[3]}; bA = (f32x2){b_[0], b_[1]}; bB = (f32x2){b_[2], b_[3]}; \
        rA = (f32x2){r_[0], r_[1]}; rB = (f32x2){r_[2], r_[3]}; kmA = (f32x2){km_[0], km_[1]}; kmB = (f32x2){km_[2], km_[3]}; } while (0)
        SC_LOAD(0);
#pragma unroll
        for (int s = 0; s < SCH; ++s) {
            f32x2 kk0 = kkA, kk1 = kkB, w0 = wA, w1 = wB, b0 = bA, b1 = bB, r0 = rA, r1 = rB, km0 = kmA, km1 = kmB; float v_ = vv;
            asm volatile("" : "+v"(kk0), "+v"(kk1), "+v"(w0), "+v"(w1), "+v"(b0), "+v"(b1), "+v"(r0), "+v"(r1), "+v"(km0), "+v"(km1), "+v"(v_));
            if (s + 1 < SCH) { SC_LOAD(s + 1); }
            __builtin_amdgcn_sched_barrier(0);
            const int keep = (jb + s + 15) & 15;
            if (TR) {
                f32x2 tl = L0 * kk0, ul = L0 * rp0, tt = T0 * kk0, ut = T0 * rp0; tl = L1 * kk1 + tl; ul = L1 * rp1 + ul; tt = T1 * kk1 + tt; ut = T1 * rp1 + ut;
                float sl = tl[0] + tl[1], yl = ul[0] + ul[1], st = tt[0] + tt[1], yt = ut[0] + ut[1];
                row16_sum4(sl, st, yl, yt);
                ykL = (j == keep) ? yl : ykL; ykT = (j == keep) ? yt : ykT;
                if (s == 0 && jb == 0 && c >= 2) { const size_t o = (size_t)((c - 2) * SCH + j) * 1024 + head * 64 + rg * 4 + row; Yo[o] = ykL; Zo[o] = ykT; }
                L0 = L0 * w0 + (km0 * v_ - b0 * sl); L1 = L1 * w1 + (km1 * v_ - b1 * sl); T0 = T0 * w0 - b0 * st; T1 = T1 * w1 - b1 * st;
            } else {
                f32x2 tl = L0 * kk0, ul = L0 * rp0; tl = L1 * kk1 + tl; ul = L1 * rp1 + ul;
                float sl = tl[0] + tl[1], yl = ul[0] + ul[1];
                row16_sum2(sl, yl);
                ykL = (j == keep) ? yl : ykL;
                if (s == 0 && jb == 0 && c >= 2) Yo[(size_t)((c - 2) * SCH + j) * 1024 + head * 64 + rg * 4 + row] = ykL;
                L0 = L0 * w0 + (km0 * v_ - b0 * sl); L1 = L1 * w1 + (km1 * v_ - b1 * sl);
            }
            rp0 = r0; rp1 = r1;
            __builtin_amdgcn_sched_barrier(0);
        }
#undef SC_LOAD
        buf = buf == SC_NBUF - 1 ? 0 : buf + 1;
    }
    { const size_t o = (size_t)(SC_SEG - 16 + j) * 1024 + head * 64 + rg * 4 + row;
      f32x2 u = L0 * rp0; u = L1 * rp1 + u; const float us = row16_sum(u[0] + u[1]); ykL = (j == 15) ? us : ykL; Yo[o] = ykL;
      if (TR) { f32x2 ut = T0 * rp0; ut = T1 * rp1 + ut; const float ut_ = row16_sum(ut[0] + ut[1]); ykT = (j == 15) ? ut_ : ykT; Zo[o] = ykT; } }
    if (SEGI < SC_NSEG - 1) { float* p = WSP(float, WS_SMALL + SM_SLOC) + (((size_t)SEGI * 16 + head) * 64 + rg * 4 + row) * 64 + 4 * j; *(f32x4*)p = (f32x4){L0[0], L0[1], L1[0], L1[1]}; }
    if (TR && SEGI < SC_NSEG - 1) { float* p = WSP(float, WS_SMALL + SM_PEND) + (((size_t)SEGI * 16 + head) * 64 + rg * 4 + row) * 64 + 4 * j; *(f32x4*)p = (f32x4){T0[0], T0[1], T1[0], T1[1]}; }
    asm volatile("s_waitcnt vmcnt(0)" ::: "memory");
    __builtin_amdgcn_s_setprio(0);
#undef SC_ISSUE
}
__device__ __forceinline__ void p_scan_touch(const Frame& F) {
    const int b = blockIdx.x, head = (b & 7) * 2 + ((b >> 3) & 1), lane = F.lane;
    const char* base = (const char*)WSP(float, R_SC); volatile LAS int* prog = (volatile LAS int*)(F.lds + RING_OFF + SC_PROG_OFF);
    constexpr int NCH0 = sc_len(0) / SCH, LPS = SCH * 12;
    unsigned dummy = 0;
    for (int c = 0; c < NCH0; ++c) {
        for (int spin = 0; spin < (1 << 16) && c > *prog + SC_TOUCH_AHEAD; ++spin) __builtin_amdgcn_s_sleep(8);
#pragma unroll
        for (int q = 0; q < 2; ++q) { const int x = q * 64 + lane; if (x < LPS) { const int step = x / 12, arr = (x % 12) >> 1, half = x & 1;
            const char* p = base + (size_t)arr * SC_STRIDE + ((size_t)(c * SCH + step) * 1024 + head * 64 + half * 32) * 4;
            asm volatile("global_load_dword %0, %1, off" : "+v"(dummy) : "v"(p) : "memory"); } }
        if ((c & 1) == 0) { const int c2 = c >> 1;
#pragma unroll
            for (int q = 0; q < 5; ++q) { const int x = q * 64 + lane; if (x < 3 * LPS) { const int seg = 1 + x / LPS, y = x % LPS, step = y / 12, arr = (y % 12) >> 1, half = y & 1;
                if (c2 * SCH < sc_len(seg)) { const char* p = base + (size_t)arr * SC_STRIDE + ((size_t)(sc_tb(seg) + c2 * SCH + step) * 1024 + head * 64 + half * 32) * 4;
                    asm volatile("global_load_dword %0, %1, off" : "+v"(dummy) : "v"(p) : "memory"); } } } }
    }
    asm volatile("s_waitcnt vmcnt(0)" : "+v"(dummy) :: "memory");
}
__device__ __forceinline__ void p_scomb(const Frame& F) {
    const float* SLOC = WSP(float, WS_SMALL + SM_SLOC); const float* PEND = WSP(float, WS_SMALL + SM_PEND); float* SIN = WSP(float, WS_SMALL + SM_SIN); const int lane = F.lane;
    for (int u = F.gw; u < 16 * 64; u += F.NGW) { const int h = u >> 6, v = u & 63;
        float sv = SLOC[((size_t)(0 * 16 + h) * 64 + v) * 64 + lane];
        SIN[((size_t)(1 * 16 + h) * 64 + v) * 64 + lane] = sv;
#pragma unroll
        for (int s = 2; s < SC_NSEG; ++s) { float acc = SLOC[((size_t)((s - 1) * 16 + h) * 64 + v) * 64 + lane]; const float* P = PEND + ((size_t)((s - 1) * 16 + h) * 64) * 64 + lane;
#pragma unroll 8
            for (int i = 0; i < 64; ++i) acc += __builtin_bit_cast(float, __builtin_amdgcn_readlane(__builtin_bit_cast(int, sv), i)) * P[(size_t)i * 64];
            sv = acc; SIN[((size_t)(s * 16 + h) * 64 + v) * 64 + lane] = sv; } }
}

__device__ __forceinline__ void p_rwkv_post(const Frame& F, const Args& A) {
    const float* Y = WSP(float, R_Y); const float* SV = WSP(float, R_SV); const float* LOUT = WSP(float, R_LORAOUT); const float* BONUS = WSP(float, WS_SMALL + SM_BONUS);
    const float* lng = A.in[I_RWLNG]; const float* lnb = A.in[I_RWLNB]; bf16* YCAT = WSP(bf16, R_YCAT); const int lane = F.lane;
    const float* SIN = WSP(float, WS_SMALL + SM_SIN); const float* Z = WSP(float, R_Z);
    for (int u = F.gw; u < NH_R * (T / 64); u += F.NGW) { const int h = u & 15, tb = u >> 4, c = 64 * h + lane, t0 = 64 * tb; const float lg = lng[c], lb = lnb[c];
        const int seg = 0; const bool seg1 = false; float sm[64];
        if (seg1) {
#pragma unroll
            for (int q = 0; q < 16; ++q) { const f32x4 x = *(const f32x4*)(SIN + ((size_t)(seg * 16 + h) * 64 + lane) * 64 + 4 * q); sm[4 * q] = x[0]; sm[4 * q + 1] = x[1]; sm[4 * q + 2] = x[2]; sm[4 * q + 3] = x[3]; } }
        constexpr int GT = 4;
        float y[GT], sv[GT], g[GT], bo[GT], z[GT], ny[GT], nsv[GT], ng[GT], nbo[GT], nz[GT], d[GT];
#define PP_LOAD(dy, dsv, dg, dbo, dz, tt_) do { _Pragma("unroll") for (int i = 0; i < GT; ++i) { const size_t t = t0 + (tt_) + i; dy[i] = Y[t * 1024 + c]; dsv[i] = SV[t * 1024 + c]; dg[i] = LOUT[t * 3072 + 2048 + c]; dbo[i] = BONUS[t * 16 + h]; \
            dz[i] = seg1 ? Z[(t - sc_len(0)) * 1024 + c] : 0.f; } } while (0)
        PP_LOAD(y, sv, g, bo, z, 0);
        for (int tt = 0; tt < 64; tt += GT) {
            if (tt + GT < 64) PP_LOAD(ny, nsv, ng, nbo, nz, tt + GT);
            if (seg1) {
#pragma unroll
                for (int q = 0; q < 64; ++q) {
#pragma unroll
                    for (int i = 0; i < GT; ++i) y[i] += sm[q] * __builtin_bit_cast(float, __builtin_amdgcn_readlane(__builtin_bit_cast(int, z[i]), q)); } }
#pragma unroll
            for (int i = 0; i < GT; ++i) d[i] = wave_sum_dpp(y[i]);
#pragma unroll
            for (int i = 0; i < GT; ++i) { y[i] -= d[i] * (1.0f / 64.0f); d[i] = y[i] * y[i]; }
#pragma unroll
            for (int i = 0; i < GT; ++i) d[i] = wave_sum_dpp(d[i]);
#pragma unroll
            for (int i = 0; i < GT; ++i) { const float o = (y[i] * (1.0f / sqrtf(d[i] * (1.0f / 64.0f) + 64e-5f)) * lg + lb + bo[i] * sv[i]) * g[i];
                YCAT[(size_t)(t0 + tt + i) * D + c] = f2bf(o); }
#pragma unroll
            for (int i = 0; i < GT; ++i) { y[i] = ny[i]; sv[i] = nsv[i]; g[i] = ng[i]; bo[i] = nbo[i]; z[i] = nz[i]; }
        }
#undef PP_LOAD
    }
}

constexpr int CK = 16, NCK = T / CK;
constexpr int CK_NFR = 19;
constexpr int CKP = 65;
__device__ __forceinline__ void ck_kpos(int k, int& g, int& kq, int& j) { g = k >> 5; const int kl = k & 31; if (kl < 16) { kq = kl >> 2; j = kl & 3; } else { kq = (kl - 16) >> 2; j = 4 + (kl & 3); } }

__device__ __forceinline__ void p_rwkv_chunk(const Frame& F, const Args& A) {
    const bf16* PROJ = WSP(bf16, R_PROJ); const float* LOUT = WSP(float, R_LORAOUT); const float* mu = A.in[I_ABMU];
    const float* w0 = A.in[I_RWW0]; const float* a0 = A.in[I_RWA0]; const float* kk_ = A.in[I_RWKK]; const float* ka_ = A.in[I_RWKA]; const float* rk_ = A.in[I_RWRK];
    float* SV = WSP(float, R_SV); float* BONUS = WSP(float, WS_SMALL + SM_BONUS); unsigned char* FR = WSP(unsigned char, R_FR);
    LAS float* L = (LAS float*)(F.lds + RING_OFF);
    LAS float* sA = L; LAS float* sP = L + 16 * CKP; LAS float* sB = L + 2 * 16 * CKP; LAS float* sKM = L + 3 * 16 * CKP; LAS float* sRH = L + 4 * 16 * CKP;
    LAS float* sCS = L + 5 * 16 * CKP; LAS float* sDM = L + 6 * 16 * CKP; LAS float* sCL = L + 7 * 16 * CKP; LAS float* sDL = L + 8 * 16 * CKP; LAS float* sV = L + 9 * 16 * CKP;
    LAS float* sAn = L + 10 * 16 * CKP; LAS float* sRn = L + 11 * 16 * CKP;
    LAS float* sU = L + 12 * 16 * CKP;
    LAS float* sAP = sU + 4 * 16 * 17;
    LAS float* sDP = sAP + 64 * 17;
    LAS float* sPL = sDP + 16 * 17;
    LAS bf16* sFR = (LAS bf16*)(sPL + 64);
    static_assert(((12 * 16 * CKP + 4 * 16 * 17 + 64 * 17 + 16 * 17 + 64) * 4) % 16 == 0, "fragment image alignment");
    const int tid = F.tid, lane = F.lane, wave = F.wave;
    for (int i = tid; i < CK_NFR * 512; i += NWAVES * 64) sFR[i] = 0;
    __syncthreads();
    const int upb = (NH_R * NCK) / F.G;
    const int r32 = lane & 31, hg = lane >> 5;
    float xr[3], xk[3], xv[3], lw[2], la[2], pm[8];
#define CK_LOAD(u_) do { const int c_ = (u_) >> 4, h_ = (u_) & 15, ch_ = 64 * h_ + lane, ta_ = c_ * CK + 2 * wave; \
        pm[0] = mu[ch_]; pm[1] = mu[1024 + ch_]; pm[2] = mu[2048 + ch_]; pm[3] = w0[ch_]; pm[4] = a0[ch_]; pm[5] = kk_[ch_]; pm[6] = ka_[ch_]; pm[7] = rk_[ch_]; \
        if (ta_ > 0) { const bf16* pp = PROJ + (size_t)(ta_ - 1) * AB_PAD; xr[0] = bf2f(pp[ch_]); xk[0] = bf2f(pp[1024 + ch_]); xv[0] = bf2f(pp[2048 + ch_]); } else { xr[0] = 0.f; xk[0] = 0.f; xv[0] = 0.f; } \
        _Pragma("unroll") for (int i = 0; i < 2; ++i) { const bf16* p0 = PROJ + (size_t)(ta_ + i) * AB_PAD; const float* lo = LOUT + (size_t)(ta_ + i) * 3072; \
            xr[1 + i] = bf2f(p0[ch_]); xk[1 + i] = bf2f(p0[1024 + ch_]); xv[1 + i] = bf2f(p0[2048 + ch_]); lw[i] = lo[ch_]; la[i] = lo[1024 + ch_]; } } while (0)
    CK_LOAD(F.vcu * upb);
    for (int ui = 0; ui < upb; ++ui) { const int u = F.vcu * upb + ui, c = u >> 4, h = u & 15, t0 = c * CK;
        { const int ch = 64 * h + lane; const int ta = t0 + 2 * wave; float pr = xr[0], pk = xk[0], pv = xv[0];
#pragma unroll
          for (int i = 0; i < 2; ++i) { const int t = ta + i, tl = 2 * wave + i;
              const float r = xr[1 + i] + (pr - xr[1 + i]) * pm[0], k = xk[1 + i] + (pk - xk[1 + i]) * pm[1], v = xv[1 + i] + (pv - xv[1 + i]) * pm[2]; pr = xr[1 + i]; pk = xk[1 + i]; pv = xv[1 + i];
              const float w = __expf(-0.6065306597126334f * sigmoidf_(lw[i] + pm[3])), a = sigmoidf_(pm[4] + la[i]);
              float kk = k * pm[5]; const float km = k * (1.0f + (a - 1.0f) * pm[6]);
              const float q1 = wave_sum_dpp(kk * kk), q2 = wave_sum_dpp(r * km * pm[7]);
              kk = kk / fmaxf(sqrtf(q1), 1e-12f);
              sA[tl * CKP + lane] = kk; sP[tl * CKP + lane] = w; sB[tl * CKP + lane] = kk * a; sKM[tl * CKP + lane] = km; sRH[tl * CKP + lane] = r; sV[tl * CKP + lane] = v;
              SV[(size_t)t * 1024 + ch] = v; if (lane == 0) BONUS[t * 16 + h] = q2; } }
        if (ui + 1 < upb) CK_LOAD(u + 1);
        __syncthreads();
        { const int k = tid & 63;
#pragma unroll
          for (int q = 0; q < 2; ++q) { const int t = (tid >> 6) * 2 + q; float Pp = 1.f, P = 1.f, PL = 1.f;
#pragma unroll
              for (int i = 0; i < CK; ++i) { const float wv = sP[i * CKP + k]; PL *= wv; if (i < t) Pp *= wv; if (i <= t) P *= wv; }
              const float inv = 1.0f / P, ratio = PL * inv, kkv = sA[t * CKP + k], bv = sB[t * CKP + k], kmv = sKM[t * CKP + k], rv = sRH[t * CKP + k];
              sCS[t * CKP + k] = bv * inv; sDM[t * CKP + k] = kmv * inv; sCL[t * CKP + k] = bv * ratio; sDL[t * CKP + k] = kmv * ratio;
              sAn[t * CKP + k] = Pp * kkv; sRn[t * CKP + k] = P * rv; if (t == 0) sPL[k] = PL; } }
        if (tid >= 64 && tid < 64 + 128) { const int x = tid - 64, vq = x >> 5, ln = x & 31, n = ln & 15, kq = ln >> 4; u32x4 o; float vv[8];
#pragma unroll
            for (int j = 0; j < 8; ++j) vv[j] = sV[(8 * kq + j) * CKP + 16 * vq + n];
            o.x = cvt_pk_bf16(vv[0], vv[1]); o.y = cvt_pk_bf16(vv[2], vv[3]); o.z = cvt_pk_bf16(vv[4], vv[5]); o.w = cvt_pk_bf16(vv[6], vv[7]);
            *(LAS u32x4*)(sFR + (15 + vq) * 512 + (n + 16 * kq) * 8) = o; }
        __syncthreads();
        if (wave == 0) { const LAS float* ar = (r32 < 16 ? sCS + r32 * CKP : sDM + (r32 - 16) * CKP); const LAS float* br = (r32 < 16 ? sAn + r32 * CKP : sRn + (r32 - 16) * CKP); f32x16 acc = f32x16{};
#pragma unroll
            for (int ks = 0; ks < 4; ++ks) { float av[8], bv[8];
#pragma unroll
                for (int j = 0; j < 8; ++j) { av[j] = ar[16 * ks + 8 * hg + j]; bv[j] = br[16 * ks + 8 * hg + j]; }
                u32x4 pa, pb; pa.x = cvt_pk_bf16(av[0], av[1]); pa.y = cvt_pk_bf16(av[2], av[3]); pa.z = cvt_pk_bf16(av[4], av[5]); pa.w = cvt_pk_bf16(av[6], av[7]);
                pb.x = cvt_pk_bf16(bv[0], bv[1]); pb.y = cvt_pk_bf16(bv[2], bv[3]); pb.z = cvt_pk_bf16(bv[4], bv[5]); pb.w = cvt_pk_bf16(bv[6], bv[7]);
                acc = __builtin_amdgcn_mfma_f32_32x32x16_bf16(__builtin_bit_cast(bf16x8, pa), __builtin_bit_cast(bf16x8, pb), acc, 0, 0, 0); }
#pragma unroll
            for (int q = 0; q < 16; ++q) { const int row = (q & 3) + 8 * (q >> 2) + 4 * hg, col = r32, mat = (row >> 4) + 2 * (col >> 4), i = row & 15, t = col & 15;
                const bool keep = (mat & 2) ? (i <= t) : (i < t); sU[mat * 16 * 17 + i * 17 + t] = keep ? acc[q] : 0.f; } }
        __syncthreads();
        if (tid < 80) { float x[CK]; const bool isA = tid < 64; const int ri = isA ? tid : tid - 64;
#pragma unroll
            for (int t = 0; t < CK; ++t) x[t] = isA ? sAn[t * CKP + ri] : sU[1 * 16 * 17 + ri * 17 + t];
#pragma unroll
            for (int jx = 0; jx < CK - 1; ++jx) { float urow[CK];
#pragma unroll
                for (int t = 0; t < CK; ++t) if (t > jx) urow[t] = sU[jx * 17 + t];
#pragma unroll
                for (int t = 0; t < CK; ++t) if (t > jx) x[t] -= x[jx] * urow[t]; }
            LAS float* dst = isA ? sAP + ri * 17 : sDP + ri * 17;
#pragma unroll
            for (int t = 0; t < CK; ++t) dst[t] = x[t]; }
        __syncthreads();
        {
#define CK_PACK(v_) ({ u32x4 p_; p_.x = cvt_pk_bf16(v_[0], v_[1]); p_.y = cvt_pk_bf16(v_[2], v_[3]); p_.z = cvt_pk_bf16(v_[4], v_[5]); p_.w = cvt_pk_bf16(v_[6], v_[7]); __builtin_bit_cast(bf16x8, p_); })
          if (wave < 4) {
              const int kr = 32 * (wave >> 1) + r32, kc = 32 * (wave & 1) + r32; float av[8], bv[8];
#pragma unroll
              for (int j = 0; j < 8; ++j) { av[j] = sAP[kr * 17 + 8 * hg + j]; bv[j] = sCL[(8 * hg + j) * CKP + kc]; }
              f32x16 acc = __builtin_amdgcn_mfma_f32_32x32x16_bf16(CK_PACK(av), CK_PACK(bv), f32x16{}, 0, 0, 0);
              const float pl = sPL[kc]; const int ktp = kc >> 4, ii = kc & 15;
#pragma unroll
              for (int q = 0; q < 16; ++q) { const int k = 32 * (wave >> 1) + (q & 3) + 8 * (q >> 2) + 4 * hg; const float m = ((k == kc) ? pl : 0.f) - acc[q];
                  int g, kq, j; ck_kpos(k, g, kq, j); sFR[(ktp * 2 + g) * 512 + (ii + 16 * kq) * 8 + j] = f2bf(m); }
          } else if (wave < 6) {
              const int kc = 32 * (wave - 4) + r32; float av[8], bv[8];
#pragma unroll
              for (int j = 0; j < 8; ++j) { av[j] = r32 < 16 ? sDP[r32 * 17 + 8 * hg + j] : 0.f; bv[j] = sCL[(8 * hg + j) * CKP + kc]; }
              f32x16 acc = __builtin_amdgcn_mfma_f32_32x32x16_bf16(CK_PACK(av), CK_PACK(bv), f32x16{}, 0, 0, 0);
              const int ktp = kc >> 4, ii = kc & 15;
#pragma unroll
              for (int q = 0; q < 8; ++q) { const int t = (q & 3) + 8 * (q >> 2) + 4 * hg; const float nv = sDL[t * CKP + kc] - acc[q];
                  sFR[(8 + ktp) * 512 + (ii + 16 * (t >> 3)) * 8 + (t & 7)] = f2bf(nv); }
          } else {
              const int kr = 32 * (wave - 6) + r32; float av[8], bv[8];
#pragma unroll
              for (int j = 0; j < 8; ++j) { av[j] = sAP[kr * 17 + 8 * hg + j]; bv[j] = r32 < 16 ? sU[2 * 16 * 17 + (8 * hg + j) * 17 + r32] : 0.f; }
              f32x16 acc = __builtin_amdgcn_mfma_f32_32x32x16_bf16(CK_PACK(av), CK_PACK(bv), f32x16{}, 0, 0, 0);
              if (r32 < 16) { const int t = r32;
#pragma unroll
                  for (int q = 0; q < 16; ++q) { const int k = 32 * (wave - 6) + (q & 3) + 8 * (q >> 2) + 4 * hg; const float rv = sRn[t * CKP + k] - acc[q];
                      int g, kq, j; ck_kpos(k, g, kq, j); sFR[(12 + g) * 512 + (t + 16 * kq) * 8 + j] = f2bf(rv); } }
              if (wave == 7) {
                  float ev[8];
#pragma unroll
                  for (int j = 0; j < 8; ++j) ev[j] = r32 < 16 ? sDP[r32 * 17 + 8 * hg + j] : 0.f;
                  f32x16 ae = __builtin_amdgcn_mfma_f32_32x32x16_bf16(CK_PACK(ev), CK_PACK(bv), f32x16{}, 0, 0, 0);
                  if (r32 < 16) { const int t = r32;
#pragma unroll
                      for (int q = 0; q < 8; ++q) { const int i = (q & 3) + 8 * (q >> 2) + 4 * hg; const float e = sU[3 * 16 * 17 + i * 17 + t] - ae[q];
                          sFR[14 * 512 + (t + 16 * (i >> 3)) * 8 + (i & 7)] = f2bf(e); } } } }
#undef CK_PACK
        }
        __syncthreads();
        { u32x4* dst = (u32x4*)(FR + ((size_t)(h * NCK + c) * CK_NFR) * 1024); const LAS u32x4* src = (const LAS u32x4*)sFR;
          for (int i = tid; i < CK_NFR * 64; i += NWAVES * 64) dst[i] = src[i]; }
        __syncthreads();
    }
#undef CK_LOAD
}

constexpr int SQ_SLOT = CK_NFR * 1024, SQ_NSLOT = 7, SQ_AHEAD = 6, SQ_TOUCH = 24;
constexpr bool SQ_TOUCH_ON = false;
static_assert(SQ_SLOT * SQ_NSLOT <= RING_BYTES, "fragment ring fits the LDS ring");
__device__ __forceinline__ void p_rwkv_seq(const Frame& F) {
    const int head = blockIdx.x, vq = F.wave & 3, lane = F.lane, n = lane & 15, q = lane >> 4; const bool worker = F.wave < 4;
    const unsigned char* FRh = WSP(unsigned char, R_FR) + (size_t)head * NCK * CK_NFR * 1024 + lane * 16; float* Y = WSP(float, R_Y) + head * 64 + vq * 16 + n;
    LAS unsigned char* lds = F.lds + RING_OFF;
#define SQ_ISSUE(c_, s_) do { const unsigned char* g_ = FRh + (size_t)(c_) * CK_NFR * 1024; LAS unsigned char* d_ = lds + (s_) * SQ_SLOT; \
        _Pragma("unroll") for (int f = 0; f < 5; ++f) if (vq + 4 * f < CK_NFR) __builtin_amdgcn_global_load_lds((const unsigned*)(g_ + (vq + 4 * f) * 1024), (LAS unsigned*)(d_ + (vq + 4 * f) * 1024), 16, 0, 0); } while (0)
#define SQ_READ(dst, s_) do { const LAS unsigned char* d_ = lds + (s_) * SQ_SLOT + lane * 16; _Pragma("unroll") for (int f = 0; f < 15; ++f) dst[f] = *(const LAS bf16x8*)(d_ + f * 1024); \
        dst[15] = *(const LAS bf16x8*)(d_ + (15 + vq) * 1024); } while (0)
#define SQ_STEP(cur, nxt, c_) do { \
        if (worker) { if ((c_) + SQ_AHEAD >= NCK) asm volatile("s_waitcnt vmcnt(0)" ::: "memory"); else if (vq == 3) asm volatile("s_waitcnt vmcnt(36)" ::: "memory"); else asm volatile("s_waitcnt vmcnt(40)" ::: "memory"); }     \
        else if (SQ_TOUCH_ON && F.wave == 4 && (c_) + SQ_TOUCH < NCK) { const unsigned char* g_ = FRh - lane * 16 + (size_t)((c_) + SQ_TOUCH) * CK_NFR * 1024 + lane * 128; \
            _Pragma("unroll") for (int i_ = 0; i_ < 3; ++i_) if (i_ * 64 + lane < CK_NFR * 8) asm volatile("global_load_dword %0, %1, off" : "+v"(dummy) : "v"(g_ + i_ * 8192) : "memory"); }     \
        __builtin_amdgcn_s_barrier();                                                       \
        if (worker) { \
            if ((c_) + SQ_AHEAD < NCK) { SQ_ISSUE((c_) + SQ_AHEAD, sl_free); } \
            if ((c_) + 1 < NCK) SQ_READ(nxt, sl_next); \
            bf16x8 xb[2]; \
            _Pragma("unroll") for (int g = 0; g < 2; ++g) { u32x4 p; p.x = cvt_pk_bf16(X[2 * g][0], X[2 * g][1]); p.y = cvt_pk_bf16(X[2 * g][2], X[2 * g][3]); p.z = cvt_pk_bf16(X[2 * g + 1][0], X[2 * g + 1][1]); p.w = cvt_pk_bf16(X[2 * g + 1][2], X[2 * g + 1][3]); \
                xb[g] = __builtin_bit_cast(bf16x8, p); } \
            f32x4 y = (f32x4){0.f, 0.f, 0.f, 0.f}; \
            y = __builtin_amdgcn_mfma_f32_16x16x32_bf16(cur[14], cur[15], y, 0, 0, 0); \
            y = __builtin_amdgcn_mfma_f32_16x16x32_bf16(cur[12], xb[0], y, 0, 0, 0); \
            y = __builtin_amdgcn_mfma_f32_16x16x32_bf16(cur[13], xb[1], y, 0, 0, 0); \
            f32x4 Xn[4]; \
            _Pragma("unroll") for (int kt = 0; kt < 4; ++kt) { f32x4 a = (f32x4){0.f, 0.f, 0.f, 0.f}; \
                a = __builtin_amdgcn_mfma_f32_16x16x32_bf16(cur[8 + kt], cur[15], a, 0, 0, 0); \
                a = __builtin_amdgcn_mfma_f32_16x16x32_bf16(cur[2 * kt], xb[0], a, 0, 0, 0); \
                a = __builtin_amdgcn_mfma_f32_16x16x32_bf16(cur[2 * kt + 1], xb[1], a, 0, 0, 0); \
                Xn[kt] = a; } \
            _Pragma("unroll") for (int r = 0; r < 4; ++r) Y[(size_t)((c_) * CK + 4 * q + r) * 1024] = y[r]; \
            _Pragma("unroll") for (int kt = 0; kt < 4; ++kt) X[kt] = Xn[kt]; } \
        sl_free = sl_free == SQ_NSLOT - 1 ? 0 : sl_free + 1; sl_next = sl_next == SQ_NSLOT - 1 ? 0 : sl_next + 1; } while (0)
    f32x4 X[4]; unsigned dummy = 0;
#pragma unroll
    for (int i = 0; i < 4; ++i) X[i] = (f32x4){0.f, 0.f, 0.f, 0.f};
    bf16x8 fa[16], fb[16];
    if (worker) {
#pragma unroll
        for (int c = 0; c < SQ_AHEAD; ++c) SQ_ISSUE(c, c); }
    asm volatile("s_waitcnt vmcnt(0)" ::: "memory");
    __builtin_amdgcn_s_barrier();
    if (worker) SQ_READ(fa, 0);
    int sl_free = SQ_AHEAD, sl_next = 1;
    for (int c = 0; c < NCK; c += 2) { SQ_STEP(fa, fb, c); SQ_STEP(fb, fa, c + 1); }
    asm volatile("s_waitcnt vmcnt(0)" : "+v"(dummy) :: "memory");
#undef SQ_ISSUE
#undef SQ_READ
#undef SQ_STEP
}

constexpr int ML_P = 264;
__device__ __forceinline__ void ml_stage_chunk(const Frame& F, const bf16* src  , int h, int c, LAS bf16* dst) {
    for (int i = F.tid; i < 64 * 32; i += NWAVES * 64) { const int s = i >> 5, ch = i & 31;
        *(LAS u32x4*)(dst + s * ML_P + 8 * ch) = *(const u32x4*)(src + (size_t)(64 * c + s) * 1024 + 256 * h + 8 * ch); }
}
__device__ __forceinline__ void p_mlu(const Frame& F, int first, int stride) {
    const bf16* KB = WSP(bf16, R_KB); const bf16* VB = WSP(bf16, R_VB); const float* WSTATE = WSP(float, WS_SMALL + SM_WSTATE);
    bf16* U = WSP(bf16, R_U); float* NU = WSP(float, WS_SMALL + SM_NU);
    LAS bf16* Ks = (LAS bf16*)(F.lds + RING_OFF); LAS bf16* Vs = Ks + 64 * ML_P; LAS float* wst = (LAS float*)(Vs + 64 * ML_P);
    const int lane = F.lane, r = lane & 31, hg = lane >> 5, w = F.wave;
    for (int L = first; L < NH_M * 128; L += stride) { const int h = L >> 7, c = L & 127;
        __syncthreads();
        ml_stage_chunk(F, KB, h, c, Ks); ml_stage_chunk(F, VB, h, c, Vs);
        if (F.tid < 64) wst[F.tid] = WSTATE[h * T + 64 * c + F.tid];
        __syncthreads();
        f32x16 acc[8];
#pragma unroll
        for (int nt = 0; nt < 8; ++nt) acc[nt] = f32x16{};
#pragma unroll
        for (int ks = 0; ks < 4; ++ks) { bf16x8 a; float av[8];
#pragma unroll
            for (int jj = 0; jj < 8; ++jj) { const int s = 16 * ks + 8 * hg + jj; av[jj] = bf2f(Vs[s * ML_P + 32 * w + r]) * wst[s]; }
            { u32x4 p; p.x = cvt_pk_bf16(av[0], av[1]); p.y = cvt_pk_bf16(av[2], av[3]); p.z = cvt_pk_bf16(av[4], av[5]); p.w = cvt_pk_bf16(av[6], av[7]); a = __builtin_bit_cast(bf16x8, p); }
#pragma unroll
            for (int nt = 0; nt < 8; ++nt) { bf16x8 b;
#pragma unroll
                for (int jj = 0; jj < 8; ++jj) b[jj] = (short)Ks[(16 * ks + 8 * hg + jj) * ML_P + 32 * nt + r];
                acc[nt] = __builtin_amdgcn_mfma_f32_32x32x16_bf16(a, b, acc[nt], 0, 0, 0); } }
        bf16* Uo = U + ((size_t)(h * 128 + c) * 256 + 32 * w) * 256;
#pragma unroll
        for (int nt = 0; nt < 8; ++nt)
#pragma unroll
            for (int q = 0; q < 16; ++q) { const int vl = (q & 3) + 8 * (q >> 2) + 4 * hg; Uo[(size_t)vl * 256 + 32 * nt + r] = f2bf(acc[nt][q]); }
        if (F.tid < 256) { float s = 0.f;
            for (int ss = 0; ss < 64; ++ss) s += wst[ss] * bf2f(Ks[ss * ML_P + F.tid]);
            NU[(size_t)(h * 128 + c) * 256 + F.tid] = s; }
    }
}
__device__ __forceinline__ void p_mlscan(const Frame& F) {
    bf16* U = WSP(bf16, R_U); float* NU = WSP(float, WS_SMALL + SM_NU); const float* WCARRY = WSP(float, WS_SMALL + SM_WCARRY);
    const int gt = F.gw * 64 + F.lane, NGT = F.NGW * 64;
    for (int it = gt; it < NH_M * 65536 / 4; it += NGT) { const int h = it >> 14, e = (it & 16383) * 4;
        float C0 = 0.f, C1 = 0.f, C2 = 0.f, C3 = 0.f; bf16* p = U + (size_t)h * 128 * 65536 + e;
#pragma unroll 4
        for (int c = 0; c < 128; ++c) { const u32x2 u = *(const u32x2*)(p + (size_t)c * 65536); const float wc = WCARRY[h * 128 + c];
            u32x2 o; o.x = cvt_pk_bf16(C0, C1); o.y = cvt_pk_bf16(C2, C3); *(u32x2*)(p + (size_t)c * 65536) = o;
            C0 = wc * C0 + bf2f(u.x & 0xffffu); C1 = wc * C1 + bf2f(u.x >> 16); C2 = wc * C2 + bf2f(u.y & 0xffffu); C3 = wc * C3 + bf2f(u.y >> 16); } }
    for (int it = gt; it < NH_M * 256; it += NGT) { const int h = it >> 8, k = it & 255; float n = 0.f; float* p = NU + (size_t)h * 128 * 256 + k;
        for (int c = 0; c < 128; ++c) { const float u = p[c * 256]; p[c * 256] = n; n = WCARRY[h * 128 + c] * n + u; } }
}
__device__ __forceinline__ void p_mlout(const Frame& F, const Args& A) {
    const bf16* QB = WSP(bf16, R_QB); const bf16* KB = WSP(bf16, R_KB); const bf16* VB = WSP(bf16, R_VB); const bf16* CS = WSP(bf16, R_U); const float* NC = WSP(float, WS_SMALL + SM_NU);
    const float* BCUM = WSP(float, WS_SMALL + SM_BCUM); const float* IG = WSP(float, WS_SMALL + SM_IG); const float* MSEQ = WSP(float, WS_SMALL + SM_MSEQ);
    const bf16* PROJ = WSP(bf16, R_PROJ); const float* mhg = A.in[I_MLNG]; bf16* YCAT = WSP(bf16, R_YCAT);
    LAS bf16* Qs = (LAS bf16*)(F.lds + RING_OFF); LAS bf16* Ks = Qs + 64 * ML_P; LAS bf16* Vs = Ks + 64 * ML_P; LAS bf16* Ss = Vs + 64 * ML_P;
    LAS float* fa = (LAS float*)(Ss + 64 * 72); LAS float* bch = fa; LAS float* ich = fa + 64; LAS float* mrow = fa + 128; LAS float* wint = fa + 192; LAS float* rsum = fa + 256  ;
    LAS float* nq = fa + 384; LAS float* nvec = fa + 448  ; LAS float* Hs = (LAS float*)(F.lds + RING_OFF);
    const int lane = F.lane, r = lane & 31, hg = lane >> 5, w = F.wave;
    for (int L = F.vcu; L < NH_M * 128; L += F.G) { const int h = L >> 7, c = L & 127;
        __syncthreads();
        ml_stage_chunk(F, QB, h, c, Qs); ml_stage_chunk(F, KB, h, c, Ks); ml_stage_chunk(F, VB, h, c, Vs);
        if (F.tid < 64) { bch[F.tid] = BCUM[h * T + 64 * c + F.tid]; ich[F.tid] = IG[h * T + 64 * c + F.tid]; }
        if (F.tid < 256) nvec[F.tid] = NC[(size_t)(h * 128 + c) * 256 + F.tid];
        const float mc = MSEQ[h * 128 + c];
        __syncthreads();
        if (w == 0) { float g = ich[lane] - bch[lane];
#pragma unroll
            for (int o = 1; o < 64; o <<= 1) { const float x = __shfl_up(g, o); if (lane >= o) g = fmaxf(g, x); }
            const float mr = bch[lane] + fmaxf(mc, g); mrow[lane] = mr; wint[lane] = __expf(bch[lane] + mc - mr); }
        if (w == 1) { float s = 0.f;
            for (int k = 0; k < 256; ++k) s += nvec[k] * bf2f(Qs[lane * ML_P + k]);
            nq[lane] = s; }
        __syncthreads();
        if (w < 4) { const int st = w & 1, lt = w >> 1; f32x16 acc = f32x16{};
#pragma unroll
            for (int ks = 0; ks < 16; ++ks) { const bf16x8 a = *(const LAS bf16x8*)(Ks + (32 * st + r) * ML_P + 16 * ks + 8 * hg), b = *(const LAS bf16x8*)(Qs + (32 * lt + r) * ML_P + 16 * ks + 8 * hg);
                acc = __builtin_amdgcn_mfma_f32_32x32x16_bf16(a, b, acc, 0, 0, 0); }
            const int l = 32 * lt + r; const float bl_ = bch[l], mr = mrow[l]; float rs = 0.f;
#pragma unroll
            for (int g4 = 0; g4 < 4; ++g4) { float v4[4];
#pragma unroll
                for (int i = 0; i < 4; ++i) { const int s = 32 * st + 8 * g4 + 4 * hg + i; const float d = bl_ - bch[s] + ich[s] - mr;
                    v4[i] = (s <= l) ? acc[4 * g4 + i] * __expf(d) : 0.f; rs += v4[i]; }
                u32x2 p; p.x = cvt_pk_bf16(v4[0], v4[1]); p.y = cvt_pk_bf16(v4[2], v4[3]);
                *(LAS u32x2*)(Ss + l * 72 + 32 * st + 8 * g4 + 4 * hg) = p; }
            rs += __shfl_xor(rs, 32);
            if (hg == 0) rsum[st * 64 + l] = rs; }
        __syncthreads();
        const int lt = w & 1, vg = w >> 1; f32x16 ai[2], aa[2]; ai[0] = f32x16{}; ai[1] = f32x16{}; aa[0] = f32x16{}; aa[1] = f32x16{};
        const bf16* Cb = CS + (size_t)(h * 128 + c) * 65536;
#pragma unroll 4
        for (int ks = 0; ks < 16; ++ks) { const bf16x8 a = *(const LAS bf16x8*)(Qs + (32 * lt + r) * ML_P + 16 * ks + 8 * hg);
#pragma unroll
            for (int jt = 0; jt < 2; ++jt) { const bf16x8 b = *(const bf16x8*)(Cb + (size_t)(64 * vg + 32 * jt + r) * 256 + 16 * ks + 8 * hg);
                ai[jt] = __builtin_amdgcn_mfma_f32_32x32x16_bf16(a, b, ai[jt], 0, 0, 0); } }
#pragma unroll
        for (int ks = 0; ks < 4; ++ks) { const bf16x8 a = *(const LAS bf16x8*)(Ss + (32 * lt + r) * 72 + 16 * ks + 8 * hg);
#pragma unroll
            for (int jt = 0; jt < 2; ++jt) { bf16x8 b;
#pragma unroll
                for (int jj = 0; jj < 8; ++jj) b[jj] = (short)Vs[(16 * ks + 8 * hg + jj) * ML_P + 64 * vg + 32 * jt + r];
                aa[jt] = __builtin_amdgcn_mfma_f32_32x32x16_bf16(a, b, aa[jt], 0, 0, 0); } }
        __syncthreads();
#pragma unroll
        for (int q = 0; q < 16; ++q) { const int l = 32 * lt + (q & 3) + 8 * (q >> 2) + 4 * hg; const float wi = wint[l];
            const float den = rsum[l] + rsum[64 + l] + wi * nq[l]; const float dn = 1.0f / fmaxf(fabsf(den), __expf(-mrow[l]));
#pragma unroll
            for (int jt = 0; jt < 2; ++jt) Hs[l * 260 + 64 * vg + 32 * jt + r] = (aa[jt][q] + wi * ai[jt][q]) * dn; }
        __syncthreads();
        for (int i = 0; i < 8; ++i) { const int l = 8 * w + i, t = 64 * c + l; const f32x4 hv = *(const LAS f32x4*)(Hs + l * 260 + 4 * lane);
            const float ss = wave_sum((hv[0] * hv[0] + hv[1] * hv[1]) + (hv[2] * hv[2] + hv[3] * hv[3])); const float rn = 1.0f / sqrtf(ss * (1.0f / 256.0f) + 1e-6f);
            const f32x4 g = *(const f32x4*)(mhg + 256 * h + 4 * lane); const u32x2 ob = *(const u32x2*)(PROJ + (size_t)t * AB_PAD + 6592 + 256 * h + 4 * lane);
            const float o0 = hv[0] * rn * g[0] * sigmoidf_(bf2f(ob.x & 0xffffu)), o1 = hv[1] * rn * g[1] * sigmoidf_(bf2f(ob.x >> 16));
            const float o2 = hv[2] * rn * g[2] * sigmoidf_(bf2f(ob.y & 0xffffu)), o3 = hv[3] * rn * g[3] * sigmoidf_(bf2f(ob.y >> 16));
            u32x2 p; p.x = cvt_pk_bf16(o0, o1); p.y = cvt_pk_bf16(o2, o3);
            *(u32x2*)(YCAT + (size_t)t * D + 1024 + 256 * h + 4 * lane) = p; }
    }
}

struct XsOrder {
    const bf16* XQ; const bf16* KM; int G, c;
    __device__ __forceinline__ bool next(int i, pg8::Unit& u) const {
        const int L = i * G + c; if (L >= 32 * 4) return false;
        const int pm = L >> 2, hd = L & 3; u.pm = pm; u.pn = 0; u.aux = hd; u.pad = 0;
        u.a = (const char*)(XQ + (size_t)pm * 256 * D + 512 * hd); u.b = (const char*)(KM + 512 * hd); return true;
    }
};
struct XpvOrder {
    const bf16* XP; const bf16* VT; int G, c;
    __device__ __forceinline__ bool next(int i, pg8::Unit& u) const {
        int pm, pn; if (!pg8::static_tile(i, G, c, 32, 8, pm, pn)) return false;
        u.pm = pm; u.pn = pn; u.aux = 0; u.pad = 0;
        u.a = (const char*)(XP + (size_t)pm * 256 * 1024 + 256 * (pn >> 1)); u.b = (const char*)(VT + (size_t)pn * 256 * NMEM); return true;
    }
};
__device__ __forceinline__ void p_xsoftmax(const Frame& F) {
    const float* XS = WSP(float, R_XS); bf16* XP = WSP(bf16, R_XP); const int lane = F.lane;
    for (int t = F.gw; t < T; t += F.NGW)
#pragma unroll
        for (int hd = 0; hd < 4; ++hd) { const f32x4 s = *(const f32x4*)(XS + (size_t)t * 1024 + 256 * hd + 4 * lane);
            const float m = wave_max(fmaxf(fmaxf(s[0], s[1]), fmaxf(s[2], s[3])));
            const float e0 = __expf(s[0] - m), e1 = __expf(s[1] - m), e2 = __expf(s[2] - m), e3 = __expf(s[3] - m);
            const float inv = 1.0f / wave_sum((e0 + e1) + (e2 + e3));
            u32x2 p; p.x = cvt_pk_bf16(e0 * inv, e1 * inv); p.y = cvt_pk_bf16(e2 * inv, e3 * inv);
            *(u32x2*)(XP + (size_t)t * 1024 + 256 * hd + 4 * lane) = p; }
}

__device__ __forceinline__ void p_norm_fpre(const Frame& F, const Args& A) {
    LAS float* Ws = (LAS float*)(F.lds + RING_OFF);
    stage_skinny<16>(F, A.in[I_FOXWIN], FOX_LD, 8192, Ws);
    __syncthreads();
    const float* X = WSP(float, WS_X); bf16* XN = WSP(bf16, WS_XN); float* FPRE = WSP(float, WS_SMALL + SM_FPRE); const float* g = A.in[I_NMIXG] + D;
    for (int t = F.gw; t < T; t += F.NGW) { f32x4 y[8]; rms_row(X + (size_t)t * D, g, XN + (size_t)t * D, F.lane, y);
        float o[16]; skinny_dot<16>(y, Ws, F.lane, o);
        if (F.lane < 16) { float v = o[0];
#pragma unroll
            for (int c = 1; c < 16; ++c) v = (F.lane == c) ? o[c] : v;
            FPRE[t * 16 + F.lane] = v; } }
    __syncthreads();
}
__device__ __forceinline__ void p_foxprep(const Frame& F, const Args& A) {
    bf16* QKVG = WSP(bf16, R_QKVG); const float* qg = A.in[I_FOXQG]; const float* kg = A.in[I_FOXKG]; const int lane = F.lane;
    for (int it = F.gw; it < 2 * T; it += F.NGW) { const int t = it >> 1, sec = it & 1; const float* gg = sec ? kg : qg; const float g0 = gg[2 * lane], g1 = gg[2 * lane + 1];
        unsigned* row = (unsigned*)(QKVG + (size_t)t * 8192 + sec * 2048) + lane;
#pragma unroll 4
        for (int h = 0; h < NH_F; ++h) { const unsigned u = row[64 * h]; const float a = bf2f(u & 0xffffu), b = bf2f(u >> 16);
            const float rn = 1.0f / sqrtf(wave_sum(a * a + b * b) * (1.0f / 128.0f) + 1e-6f);
            row[64 * h] = cvt_pk_bf16(a * rn * g0, b * rn * g1); } }
    if (F.gw < NH_F) { const int h = F.gw; const float* FPRE = WSP(float, WS_SMALL + SM_FPRE); float* BL = WSP(float, WS_SMALL + SM_BIASL2); const float bf = A.in[I_FOXBF][h];
        float carry = 0.f;
        for (int c0 = 0; c0 < 128; c0 += 16) { float v[16];
#pragma unroll
            for (int i = 0; i < 16; ++i) v[i] = FPRE[(size_t)(64 * (c0 + i) + lane) * 16 + h];
#pragma unroll
            for (int i = 0; i < 16; ++i) { float b = logsigmoidf_(v[i] + bf);
#pragma unroll
                for (int o = 1; o < 64; o <<= 1) { const float x = __shfl_up(b, o); if (lane >= o) b += x; }
                b += carry; BL[h * T + 64 * (c0 + i) + lane] = -1.4426950408889634f * b; carry = __shfl(b, 63); } } }
}
__device__ __forceinline__ void p_foxattn(const Frame& F) {
    const bf16* QKVG = WSP(bf16, R_QKVG); bf16* ATTO = WSP(bf16, R_ATTO); const float* BL = WSP(float, WS_SMALL + SM_BIASL2);
    char* lds = (char*)F.ldsg + RING_OFF;
    for (int L = F.vcu; L < 256; L += F.G) { const int h = L >> 4, x = L & 15;
        __syncthreads();
        { float* bl = (float*)(lds + fox::BIAS_OFF); for (int i = F.tid; i < T / 4; i += NWAVES * 64) *(f32x4*)(bl + 4 * i) = *(const f32x4*)(BL + (size_t)h * T + 4 * i); }
        fox::BlockRef b0, b1; const int q0 = x, q1 = 31 - x;
        b0.Q = QKVG + (size_t)q0 * 256 * 8192 + 128 * h; b0.K = QKVG + 2048 + 128 * h; b0.V = QKVG + 4096 + 128 * h; b0.G = QKVG + (size_t)q0 * 256 * 8192 + 6144 + 128 * h;
        b0.O = ATTO + (size_t)q0 * 256 * D + 128 * h; b0.P0 = q0 * 256;
        b1 = b0; b1.Q = QKVG + (size_t)q1 * 256 * 8192 + 128 * h; b1.G = QKVG + (size_t)q1 * 256 * 8192 + 6144 + 128 * h; b1.O = ATTO + (size_t)q1 * 256 * D + 128 * h; b1.P0 = q1 * 256;
        fox::Seam S;
        fox::prime(b0, lds, S);
#ifdef FOX_LOOP
        for (int pass = 0; pass < 2; ++pass) { fox::block(b0, b1, lds, S); b0 = b1; }
#else
        fox::block(b0, b1, lds, S);
        fox::block(b1, b1, lds, S);
#endif
    }
}

__device__ __forceinline__ void p_norm_route(const Frame& F, const Args& A) {
    LAS float* Ws = (LAS float*)(F.lds + RING_OFF); LAS int* cnt = (LAS int*)(F.lds + RING_OFF + 8 * D * 4);
    stage_skinny<8>(F, A.in[I_ROUTER], NEXP, 0, Ws);
    if (F.tid < 8) cnt[F.tid] = 0;
    __syncthreads();
    const float* X = WSP(float, WS_X); bf16* XN = WSP(bf16, WS_XN); const float* g = A.in[I_NFFNG] + D;
    int* TOPI = WSP(int, WS_SMALL + SM_TOPI); float* TOPG = WSP(float, WS_SMALL + SM_TOPG); int* BLKCNT = WSP(int, WS_SMALL + SM_BLKCNT);
    const int b = blockIdx.x;
    for (int i = 0; i < 4; ++i) { const int t = 32 * b + 4 * F.wave + i; f32x4 y[8]; rms_row(X + (size_t)t * D, g, XN + (size_t)t * D, F.lane, y);
        float o[8]; skinny_dot<8>(y, Ws, F.lane, o);
        int i1 = 0; float v1 = o[0];
#pragma unroll
        for (int e = 1; e < 8; ++e) if (o[e] > v1) { v1 = o[e]; i1 = e; }
        int i2 = -1; float v2 = -__builtin_inff();
#pragma unroll
        for (int e = 0; e < 8; ++e) if (e != i1 && o[e] > v2) { v2 = o[e]; i2 = e; }
        const float e2 = __expf(v2 - v1), g1 = 1.0f / (1.0f + e2), g2 = e2 * g1;
        if (F.lane == 0) { TOPI[2 * t] = i1; TOPI[2 * t + 1] = i2; TOPG[2 * t] = g1; TOPG[2 * t + 1] = g2; __hip_atomic_fetch_add(&cnt[i1], 1, __ATOMIC_RELAXED, __HIP_MEMORY_SCOPE_WORKGROUP); __hip_atomic_fetch_add(&cnt[i2], 1, __ATOMIC_RELAXED, __HIP_MEMORY_SCOPE_WORKGROUP); } }
    __syncthreads();
    if (F.tid < 8) BLKCNT[b * 8 + F.tid] = cnt[F.tid];
}
__device__ __forceinline__ void p_route2(const Frame& F) {
    LAS int* sh = (LAS int*)(F.lds + RING_OFF);
    const int* BLKCNT = WSP(int, WS_SMALL + SM_BLKCNT); const int* TOPI = WSP(int, WS_SMALL + SM_TOPI); int* SLOT = WSP(int, WS_SMALL + SM_SLOT); int* TILEE = WSP(int, WS_SMALL + SM_TILEE);
    const bf16* XN = WSP(bf16, WS_XN); bf16* AG = WSP(bf16, R_AG); const int b = blockIdx.x;
    __syncthreads();
    if (F.tid < 8) { int tot = 0, pre = 0; for (int bb = 0; bb < 256; ++bb) { const int v = BLKCNT[bb * 8 + F.tid]; if (bb < b) pre += v; tot += v; } sh[F.tid] = tot; sh[8 + F.tid] = pre; }
    __syncthreads();
    if (F.tid == 0) { int off = 0, nt = 0; for (int e = 0; e < 8; ++e) { sh[16 + e] = off; const int n = (sh[e] + 255) >> 8; if (b == 0) for (int i = 0; i < n; ++i) TILEE[1 + nt + i] = e; nt += n; off += n * 256; } if (b == 0) TILEE[0] = nt; }
    __syncthreads();
    if (F.wave == 0) { const int t = 32 * b + (F.lane >> 1), e = TOPI[2 * t + (F.lane & 1)]; int rank = 0;
#pragma unroll
        for (int ee = 0; ee < 8; ++ee) { const unsigned long long m = __ballot(e == ee); if (e == ee) rank = __popcll(m & ((1ull << F.lane) - 1ull)); }
        const int slot = sh[16 + e] + sh[8 + e] + rank; SLOT[2 * t + (F.lane & 1)] = slot; sh[32 + F.lane] = slot; }
    __syncthreads();
    for (int p = F.wave; p < 64; p += NWAVES) { const int t = 32 * b + (p >> 1), slot = sh[32 + p]; const u32x4* src = (const u32x4*)(XN + (size_t)t * D); u32x4* dst = (u32x4*)(AG + (size_t)slot * D);
#pragma unroll
        for (int j = 0; j < 4; ++j) dst[F.lane + 64 * j] = src[F.lane + 64 * j]; }
}
struct MoeOrder {
    const bf16* Arows; const bf16* W; const int* tilee; int lda, nN; size_t wstride; int G, c; bool whole_rounds;
    __device__ __forceinline__ bool next(int i, pg8::Unit& u) const {
        const int nt = tilee[0]; const long L = (long)i * G + c; long nu = (long)nt * nN; if (whole_rounds) nu = (nu / G) * G; if (L >= nu) return false;
        const int ti = (int)(L / nN), pn = (int)(L % nN), e = tilee[1 + ti];
        u.pm = ti; u.pn = pn; u.aux = e; u.pad = 0; u.a = (const char*)(Arows + (size_t)ti * 256 * lda); u.b = (const char*)(W + (size_t)e * wstride + (size_t)pn * 256 * lda); return true;
    }
};
constexpr int MOE_KSPLIT = 4;
struct MoeSplitOrder {
    const bf16* Arows; const bf16* W; const int* tilee; int lda, nN, kslice; size_t wstride; int G, c;
    __device__ __forceinline__ bool next(int i, pg8::Unit& u) const {
        const int nt = tilee[0]; const long nu = (long)nt * nN, nfull = (nu / G) * G; const long L = (long)i * G + c; if (L >= (nu - nfull) * MOE_KSPLIT) return false;
        const long j = nfull + L / MOE_KSPLIT; const int kq = (int)(L % MOE_KSPLIT); const int ti = (int)(j / nN), pn = (int)(j % nN), e = tilee[1 + ti];
        u.pm = ti; u.pn = pn; u.aux = kq; u.pad = 0; u.a = (const char*)(Arows + (size_t)ti * 256 * lda + (size_t)kq * kslice); u.b = (const char*)(W + (size_t)e * wstride + (size_t)pn * 256 * lda + (size_t)kq * kslice); return true;
    }
};
__device__ __forceinline__ void p_final(const Frame& F, const Args& A) {
    const float* X = WSP(float, WS_X); const float* YG = WSP(float, R_YG); const float* YS = WSP(float, R_YSIDE); const int* SLOT = WSP(int, WS_SMALL + SM_SLOT); const float* TOPG = WSP(float, WS_SMALL + SM_TOPG);
    const float* g = A.in[I_FING]; const int lane = F.lane;
    const int nt = WSP(int, WS_SMALL + SM_TILEE)[0]; const int srow0 = (((nt * 8) / F.G) * F.G / 8) * 256;
    for (int t = F.gw; t < T; t += F.NGW) { const int s1 = SLOT[2 * t], s2 = SLOT[2 * t + 1]; const float g1 = TOPG[2 * t], g2 = TOPG[2 * t + 1];
        const f32x4* xr = (const f32x4*)(X + (size_t)t * D) + lane; const f32x4* y1 = (const f32x4*)(YG + (size_t)s1 * D) + lane; const f32x4* y2 = (const f32x4*)(YG + (size_t)s2 * D) + lane;
        f32x4 v[8]; float s = 0.f;
#pragma unroll
        for (int j = 0; j < 8; ++j) { f32x4 a = y1[64 * j], b = y2[64 * j];
            if (s1 >= srow0) { const f32x4* p = (const f32x4*)(YS + (size_t)(s1 - srow0) * D) + lane + 64 * j; a = a + ((p[0] + p[YSIDE_STRIDE / 4]) + p[2 * (YSIDE_STRIDE / 4)]); }
            if (s2 >= srow0) { const f32x4* p = (const f32x4*)(YS + (size_t)(s2 - srow0) * D) + lane + 64 * j; b = b + ((p[0] + p[YSIDE_STRIDE / 4]) + p[2 * (YSIDE_STRIDE / 4)]); }
            v[j] = xr[64 * j] + (a * g1 + b * g2); s += (v[j][0] * v[j][0] + v[j][1] * v[j][1]) + (v[j][2] * v[j][2] + v[j][3] * v[j][3]); }
        const float r = 1.0f / sqrtf(wave_sum(s) * (1.0f / D) + 1e-6f); f32x4* o = (f32x4*)(A.out + (size_t)t * D) + lane;
#pragma unroll
        for (int j = 0; j < 8; ++j) o[64 * j] = v[j] * r * ((const f32x4*)g)[lane + 64 * j]; }
}

enum Phase { PH_CONV = 0, PH_INPROJ0, PH_PREPA, PH_LORA, PH_PREPB, PH_SCAN, PH_MLSCAN, PH_MLOUT, PH_OUTPROJ0,
             PH_NORMX0, PH_XQ0, PH_XS0, PH_XSM0, PH_XPV0, PH_XO0, PH_NORMF0, PH_FFNGU, PH_FFND,
             PH_NORMM1, PH_FOXIN, PH_FOXPREP, PH_FOXATT, PH_FOXOUT,
             PH_NORMX1, PH_XQ1, PH_XS1, PH_XSM1, PH_XPV1, PH_XO1, PH_NORMF1, PH_ROUTE2, PH_MOEGU, PH_MOED, PH_FINAL, N_PHASES };

__global__ void __launch_bounds__(NWAVES * 64, 2) trunk_fwd(Args A) {
    extern __shared__ __attribute__((aligned(16))) unsigned char lds[];
    Frame F;
    F.lds = (LAS unsigned char*)lds; F.ldsg = lds; F.ws = A.ws;
    F.tid = threadIdx.x; F.lane = F.tid & 63; F.wave = __builtin_amdgcn_readfirstlane(F.tid >> 6);
    F.G = gridDim.x; { const int bx = blockIdx.x; F.vcu = (F.G % 8 == 0) ? (bx % 8) * (F.G / 8) + bx / 8 : bx; }
    F.gw = F.vcu * NWAVES + F.wave; F.NGW = F.G * NWAVES;
    volatile LAS unsigned* MISC = (volatile LAS unsigned*)(F.lds + MISC_OFF);
    for (int u = F.tid; u < (LDS_BYTES - LDSCTL_OFF) / 4; u += NWAVES * 64) ((LAS unsigned*)(F.lds + LDSCTL_OFF))[u] = 0u;
    __syncthreads();
    const int lo = A.ph_lo, hi = A.ph_hi;
    const bool multi = (hi - lo) > 1;
    XcdBarrier bar; bar.bar = (unsigned*)(A.ws + WS_CTL) + CW_BAR; bar.x = 0; bar.st = nullptr;
    if (multi) bar = xcd_barrier_post((unsigned*)(A.ws + WS_CTL) + CW_BAR, MISC + 8);
#ifndef PH_ENABLE
#define PH_ENABLE 0xFFFFFFFFFFFFFFFFull
#endif
#define IN(k) ((((PH_ENABLE) >> (k)) & 1ull) && lo <= (k) && (k) < hi)
#ifndef PROBE_DUP
#define PROBE_DUP 0ull
#endif
#define DUP(k) if ((((PROBE_DUP) >> (k)) & 1ull) != 0ull)
#define SEAM(k) do { if (IN(k) && IN((k) + 1)) xcd_barrier(bar); } while (0)
    LAS unsigned char* ring = F.lds + RING_OFF;
    const int cb = (int)blockIdx.x;
    float* const SSQ = (float*)(A.ws + WS_CTL + CTL_SSQ);

    constexpr int MOE_E_EARLY = 0;
    if (IN(PH_CONV)) { p_convert_early(F, A); if (MOE_E_EARLY > 0) p_convert_late(F, A, F.gw, F.NGW, (LAS float*)(F.lds + RING_OFF + F.wave * 16384), false, 0, MOE_E_EARLY); } SEAM(PH_CONV);
    if (IN(PH_INPROJ0)) { InprojKvOrder S{WSP(bf16, WS_XN), WSP(bf16, WS_W_ABIN), WSP(bf16, WS_MEMN), WSP(bf16, WS_W_XKV), F.G, cb};
        EpiInprojKv E{WSP(bf16, R_PROJ), WSP(float, R_GATES32), WSP(bf16, WS_KMEM), WSP(bf16, WS_VTMEM)};
        pg8::gemm_phase<EpiInprojKv, InprojKvOrder, true>(ring, pg8::Gemm{D, D, D}, S, E); } SEAM(PH_INPROJ0);
    if (IN(PH_PREPA)) { p_prepa(F, A); DUP(PH_PREPA) { __syncthreads(); p_prepa(F, A); } } SEAM(PH_PREPA);
    if (IN(PH_LORA)) { pg8::PlainOrder S{WSP(bf16, R_LORAIN), WSP(bf16, WS_W_LORA), 512, 512, 32, 12, F.G, cb}; pg8::EpiF32 E{WSP(float, R_LORAOUT), 3072, 0, 1.0f};
        pg8::gemm_phase<pg8::EpiF32, pg8::PlainOrder, true>(ring, pg8::Gemm{512, 512, 512}, S, E); } SEAM(PH_LORA);
    if (IN(PH_PREPB)) { p_rwkv_chunk(F, A); p_mlstm_pass2(F); DUP(PH_PREPB) { __syncthreads(); p_rwkv_chunk(F, A); } } SEAM(PH_PREPB);
    if (IN(PH_SCAN)) {
        if (cb < 16) p_rwkv_seq(F);
        else { p_mlu(F, cb - 16, F.G - 16); __syncthreads(); p_convert_late(F, A, (cb - 16) * NWAVES + F.wave, (F.G - 16) * NWAVES, (LAS float*)(F.lds + RING_OFF + F.wave * 16384), true, MOE_E_EARLY, NEXP); }
        DUP(62) { __syncthreads(); if (cb < 16) p_rwkv_seq(F); } } SEAM(PH_SCAN);
    if (IN(PH_MLSCAN)) { p_mlscan(F); p_rwkv_post(F, A); DUP(PH_MLSCAN) { __syncthreads(); p_rwkv_post(F, A); } } SEAM(PH_MLSCAN);
    if (IN(PH_MLOUT)) { p_mlout(F, A); DUP(PH_MLOUT) { __syncthreads(); p_mlout(F, A); } } SEAM(PH_MLOUT);
    if (IN(PH_OUTPROJ0)) { pg8::PlainOrder S{WSP(bf16, R_YCAT), WSP(bf16, WS_W_ABOUT), D, D, 32, 8, F.G, cb}; pg8::EpiResid E{A.in[I_X], WSP(float, WS_X), D, nullptr, nullptr, nullptr};
        pg8::gemm_phase<pg8::EpiResid, pg8::PlainOrder, false>(ring, pg8::Gemm{D, D, D}, S, E); } SEAM(PH_OUTPROJ0);
#define XATTN(l, P_NORM, P_Q, P_S, P_SM, P_PV, P_O, SSQ_IN, XN_OUT, G_OUT, SSQ_OUT) \
    if (IN(P_NORM)) { norm_phase(F, WSP(float, WS_X), A.in[I_NXAG] + (l) * D, WSP(bf16, WS_XN), T); } SEAM(P_NORM); \
    if (IN(P_Q)) { pg8::PlainOrder S{WSP(bf16, WS_XN), WSP(bf16, WS_W_XQ) + (size_t)(l) * D * D, D, D, 32, 8, F.G, cb}; pg8::EpiBf16 E{WSP(bf16, R_XQ), D, nullptr, -1, SSQ_IN}; \
        pg8::gemm_phase<pg8::EpiBf16, pg8::PlainOrder, false>(ring, pg8::Gemm{D, D, D}, S, E); } SEAM(P_Q); \
    if (IN(P_S)) { XsOrder S{WSP(bf16, R_XQ), WSP(bf16, WS_KMEM) + (size_t)(l) * NMEM * D, F.G, cb}; pg8::EpiF32 E{WSP(float, R_XS), 1024, 256, 0.044194173824159216f}; \
        pg8::gemm_phase<pg8::EpiF32, XsOrder, false>(ring, pg8::Gemm{D, D, 512}, S, E); } SEAM(P_S); \
    if (IN(P_SM)) { p_xsoftmax(F); DUP(P_SM) { p_xsoftmax(F); } } SEAM(P_SM); \
    if (IN(P_PV)) { XpvOrder S{WSP(bf16, R_XP), WSP(bf16, WS_VTMEM) + (size_t)(l) * D * NMEM, F.G, cb}; pg8::EpiBf16 E{WSP(bf16, R_XO), D, nullptr, -1, nullptr}; \
        pg8::gemm_phase<pg8::EpiBf16, XpvOrder, false>(ring, pg8::Gemm{1024, NMEM, 256}, S, E); } SEAM(P_PV); \
    if (IN(P_O)) { pg8::PlainOrder S{WSP(bf16, R_XO), WSP(bf16, WS_W_XO) + (size_t)(l) * D * D, D, D, 32, 8, F.G, cb}; pg8::EpiResid E{WSP(float, WS_X), WSP(float, WS_X), D, XN_OUT, G_OUT, SSQ_OUT}; \
        pg8::gemm_phase<pg8::EpiResid, pg8::PlainOrder, false>(ring, pg8::Gemm{D, D, D}, S, E); } SEAM(P_O);

    XATTN(0, PH_NORMX0, PH_XQ0, PH_XS0, PH_XSM0, PH_XPV0, PH_XO0, (const float*)nullptr, (bf16*)nullptr, (const float*)nullptr, (float*)nullptr)
    if (IN(PH_NORMF0)) { norm_phase(F, WSP(float, WS_X), A.in[I_NFFNG], WSP(bf16, WS_XN), T); } SEAM(PH_NORMF0);
    if (IN(PH_FFNGU)) { pg8::PlainOrder S{WSP(bf16, WS_XN), WSP(bf16, WS_W_FFNGU), D, D, 32, 44, F.G, cb}; pg8::EpiSwiGLU E{WSP(bf16, R_ACT), DFF, nullptr};
        pg8::gemm_phase<pg8::EpiSwiGLU, pg8::PlainOrder, true>(ring, pg8::Gemm{D, D, D}, S, E); DUP(PH_FFNGU) { pg8::gemm_phase<pg8::EpiSwiGLU, pg8::PlainOrder, true>(ring, pg8::Gemm{D, D, D}, S, E); } } SEAM(PH_FFNGU);
    if (IN(PH_FFND)) { pg8::PlainOrder S{WSP(bf16, R_ACT), WSP(bf16, WS_W_FFND), DFF, DFF, 32, 8, F.G, cb}; pg8::EpiResid E{WSP(float, WS_X), WSP(float, WS_X), D, nullptr, nullptr, nullptr};
        pg8::gemm_phase<pg8::EpiResid, pg8::PlainOrder, false>(ring, pg8::Gemm{DFF, DFF, DFF}, S, E); } SEAM(PH_FFND);
    if (IN(PH_NORMM1)) { p_norm_fpre(F, A); DUP(PH_NORMM1) { p_norm_fpre(F, A); } } SEAM(PH_NORMM1);
    if (IN(PH_FOXIN)) { pg8::PlainOrder S{WSP(bf16, WS_XN), WSP(bf16, WS_W_FOXIN), D, D, 32, 32, F.G, cb}; pg8::EpiBf16 E{WSP(bf16, R_QKVG), 8192, nullptr, -1, nullptr};
        pg8::gemm_phase<pg8::EpiBf16, pg8::PlainOrder, true>(ring, pg8::Gemm{D, D, D}, S, E); DUP(PH_FOXIN) { pg8::gemm_phase<pg8::EpiBf16, pg8::PlainOrder, true>(ring, pg8::Gemm{D, D, D}, S, E); } } SEAM(PH_FOXIN);
    if (IN(PH_FOXPREP)) { p_foxprep(F, A); } SEAM(PH_FOXPREP);
    if (IN(PH_FOXATT)) { p_foxattn(F); DUP(PH_FOXATT) { __syncthreads(); p_foxattn(F); } } SEAM(PH_FOXATT);
    if (IN(PH_FOXOUT)) { pg8::PlainOrder S{WSP(bf16, R_ATTO), WSP(bf16, WS_W_FOXOUT), D, D, 32, 8, F.G, cb}; pg8::EpiResid E{WSP(float, WS_X), WSP(float, WS_X), D, nullptr, nullptr, nullptr};
        pg8::gemm_phase<pg8::EpiResid, pg8::PlainOrder, false>(ring, pg8::Gemm{D, D, D}, S, E); } SEAM(PH_FOXOUT);
    XATTN(1, PH_NORMX1, PH_XQ1, PH_XS1, PH_XSM1, PH_XPV1, PH_XO1, (const float*)nullptr, (bf16*)nullptr, (const float*)nullptr, (float*)nullptr)
    if (IN(PH_NORMF1)) { p_norm_route(F, A); } SEAM(PH_NORMF1);
    if (IN(PH_ROUTE2)) { p_route2(F); } SEAM(PH_ROUTE2);
    if (IN(PH_MOEGU)) { MoeOrder S{WSP(bf16, R_AG), WSP(bf16, WS_W_MOEGU), WSP(int, WS_SMALL + SM_TILEE), D, 44, (size_t)2 * DFF * D, F.G, cb, false}; pg8::EpiSwiGLU E{WSP(bf16, R_ACTG), DFF, nullptr};
        pg8::gemm_phase<pg8::EpiSwiGLU, MoeOrder, true>(ring, pg8::Gemm{D, D, D}, S, E); } SEAM(PH_MOEGU);
    if (IN(PH_MOED)) {
        { MoeOrder S{WSP(bf16, R_ACTG), WSP(bf16, WS_W_MOED), WSP(int, WS_SMALL + SM_TILEE), DFF, 8, (size_t)D * DFF, F.G, cb, true}; pg8::EpiF32 E{WSP(float, R_YG), D, 0, 1.0f};
          pg8::gemm_phase<pg8::EpiF32, MoeOrder, true>(ring, pg8::Gemm{DFF, DFF, DFF}, S, E); }
        { MoeSplitOrder S{WSP(bf16, R_ACTG), WSP(bf16, WS_W_MOED), WSP(int, WS_SMALL + SM_TILEE), DFF, 8, DFF / MOE_KSPLIT, (size_t)D * DFF, F.G, cb}; const int nt_ = WSP(int, WS_SMALL + SM_TILEE)[0]; pg8::EpiF32Split E{WSP(float, R_YG), WSP(float, R_YSIDE), YSIDE_STRIDE, D, ((nt_ * 8) / F.G) * F.G / 8};
          pg8::gemm_phase<pg8::EpiF32Split, MoeSplitOrder, false>(ring, pg8::Gemm{DFF, DFF, DFF / MOE_KSPLIT}, S, E); } } SEAM(PH_MOED);
    if (IN(PH_FINAL)) { p_final(F, A); }
#undef XATTN
#undef IN
#undef SEAM
}

#ifndef MK_ONE_LAUNCH
#define MK_ONE_LAUNCH 1
#endif
extern "C" void kernel_launch(void* const* d_in, const int* in_sizes, int n_in, void* d_out, int out_size, void* d_ws, size_t ws_size, hipStream_t stream) {
    static int ready = 0;
    if (ready == 0) {
        if (n_in != N_IN || in_sizes[0] != T * D || out_size != T * D || ws_size < WS_END) {
            fprintf(stderr, "kernel_launch: built for %d inputs, x/out of %d floats, >= %zu bytes of workspace; got n_in %d, in0 %d, out %d, ws %zu; nothing launched\n", N_IN, T * D, (size_t)WS_END, n_in, n_in > 0 ? in_sizes[0] : -1, out_size, ws_size);
            ready = -1; return; }
        if (hipFuncSetAttribute((const void*)trunk_fwd, hipFuncAttributeMaxDynamicSharedMemorySize, LDS_BYTES) != hipSuccess) { fprintf(stderr, "kernel_launch: hipFuncSetAttribute failed\n"); ready = -1; return; }
        int per_cu = 0;
        if (hipOccupancyMaxActiveBlocksPerMultiprocessor(&per_cu, (const void*)trunk_fwd, NWAVES * 64, LDS_BYTES) != hipSuccess || per_cu < 1)
            fprintf(stderr, "kernel_launch: note: occupancy query reports %d workgroups per CU\n", per_cu);
        (void)hipGetLastError();
        ready = 1;
    }
    if (ready < 0) return;
    const int grid = 256;
    if (hipMemsetAsync((char*)d_ws + WS_CTL, 0, CTL_ZERO_BYTES, stream) != hipSuccess) { fprintf(stderr, "kernel_launch: hipMemsetAsync failed\n"); return; }
    Args a{};
    for (int i = 0; i < N_IN; ++i) a.in[i] = (const float*)d_in[i];
    a.out = (float*)d_out; a.ws = (unsigned char*)d_ws;
#if MK_ONE_LAUNCH
    a.ph_lo = 0; a.ph_hi = N_PHASES;
    hipLaunchKernelGGL(trunk_fwd, dim3(grid), dim3(NWAVES * 64), LDS_BYTES, stream, a);
#else
    for (int p = 0; p < N_PHASES; ++p) { a.ph_lo = p; a.ph_hi = p + 1;
        hipLaunchKernelGGL(trunk_fwd, dim3(grid), dim3(NWAVES * 64), LDS_BYTES, stream, a); }
#endif
    const hipError_t le = hipPeekAtLastError();
    if (le != hipSuccess) fprintf(stderr, "kernel_launch: launch failed: %s\n", hipGetErrorName(le));
}
```

```cpp
#include <hip/hip_runtime.h>
#include <cstdio>
#include <cstdint>

#define GAS __attribute__((address_space(1)))
#define LAS __attribute__((address_space(3)))
typedef unsigned short bf16;
typedef short bf16x8 __attribute__((ext_vector_type(8)));
typedef short s16x4 __attribute__((ext_vector_type(4)));
typedef float f32x2 __attribute__((ext_vector_type(2)));
typedef float f32x4 __attribute__((ext_vector_type(4)));
typedef float f32x16 __attribute__((ext_vector_type(16)));
typedef unsigned u32x2 __attribute__((ext_vector_type(2)));
typedef unsigned u32x4 __attribute__((ext_vector_type(4)));

constexpr int T = 8192, D = 2048, NMEM = 256, DFF = 5632, NEXP = 8;
constexpr int A_COLS = 3520, AB_COLS = 7624, AB_PAD = 7680;
constexpr int FOX_LD = 8208;
constexpr int NH_R = 16, NH_M = 4, NH_F = 16;
constexpr int MOE_ROWS = 72 * 256;

__device__ __forceinline__ float bf2f(unsigned b) { return __uint_as_float(b << 16); }
__device__ __forceinline__ unsigned cvt_pk_bf16(float lo, float hi) { unsigned r; asm volatile("v_cvt_pk_bf16_f32 %0, %1, %2" : "=v"(r) : "v"(lo), "v"(hi)); return r; }
__device__ __forceinline__ bf16 f2bf(float f) { return (bf16)(cvt_pk_bf16(f, 0.f) & 0xffffu); }
__device__ __forceinline__ float wave_sum(float v) {
#pragma unroll
    for (int o = 1; o < 64; o <<= 1) v += __shfl_xor(v, o);
    return v;
}
__device__ __forceinline__ float wave_max(float v) {
#pragma unroll
    for (int o = 1; o < 64; o <<= 1) v = fmaxf(v, __shfl_xor(v, o));
    return v;
}
__device__ __forceinline__ float wave_sum_dpp(float x) {
#define DPPF_(v, ctrl) __builtin_bit_cast(float, __builtin_amdgcn_update_dpp(0, __builtin_bit_cast(int, v), ctrl, 0xF, 0xF, true))
    x += DPPF_(x, 0xB1); x += DPPF_(x, 0x4E); x += DPPF_(x, 0x141); x += DPPF_(x, 0x140);
#undef DPPF_
    const float a = __builtin_bit_cast(float, __builtin_amdgcn_readlane(__builtin_bit_cast(int, x), 0)), b = __builtin_bit_cast(float, __builtin_amdgcn_readlane(__builtin_bit_cast(int, x), 16));
    const float c = __builtin_bit_cast(float, __builtin_amdgcn_readlane(__builtin_bit_cast(int, x), 32)), d = __builtin_bit_cast(float, __builtin_amdgcn_readlane(__builtin_bit_cast(int, x), 48));
    return (a + b) + (c + d);
}
__device__ __forceinline__ float sigmoidf_(float x) { return 1.0f / (1.0f + __expf(-x)); }
__device__ __forceinline__ float logsigmoidf_(float x) { return fminf(x, 0.f) - log1pf(__expf(-fabsf(x))); }

namespace pg8 {
#define PG8_LAS __attribute__((address_space(3)))
typedef unsigned short bf16_t;
constexpr int BM = 256, BK = 64, HALF = 128, HTB = HALF * BK * 2  , STAGE_BYTES = 8 * HTB, NXCD = 8, WGM = 8;

__host__ __device__ __forceinline__ int lds_byte(int r, int c) { const int st = (r >> 4) * 2 + (c >> 5), rr = r & 15, cc = c & 31, ob = rr * 64 + cc * 2; return st * 1024 + (ob ^ (((ob >> 9) & 1) << 5)); }
__host__ __device__ __forceinline__ void stage_rc(int b, int& R, int& C) { const int st = b / 1024, sb = b % 1024, swz = sb ^ (((sb >> 9) & 1) << 5); R = (st >> 1) * 16 + swz / 64; C = (st & 1) * 32 + (swz % 64) / 2; }
__host__ __device__ __forceinline__ int perm32(int rho) { const int n = rho >> 4, i = rho & 15; return 8 * (i >> 2) + 4 * n + (i & 3); }

struct Unit { const char* a; const char* b; int pm, pn, aux, pad; };
struct Gemm { int lda, ldb, K; };

__device__ __forceinline__ bool static_tile(int i, int G, int c, int nM, int nN, int& pm, int& pn) {
    const int nwg = nM * nN; const long L = (long)i * G + c; if (L >= nwg) return false;
    int wgid = (int)L; { const int q = nwg / NXCD, r = nwg % NXCD, xcd = wgid % NXCD, off = wgid / NXCD; wgid = (xcd < r ? xcd * (q + 1) : r * (q + 1) + (xcd - r) * q) + off; }
    const int nig = WGM * nN, gid = wgid / nig, fm = gid * WGM, gsz = (nM - fm) < WGM ? (nM - fm) : WGM;
    pm = fm + ((wgid % nig) % gsz); pn = (wgid % nig) / gsz; return true;
}
struct PlainOrder {
    const bf16_t* A; const bf16_t* Bt; int lda, ldb, nM, nN, G, c;
    __device__ __forceinline__ bool next(int i, Unit& u) const {
        int pm, pn; if (!static_tile(i, G, c, nM, nN, pm, pn)) return false;
        u.pm = pm; u.pn = pn; u.aux = 0; u.pad = 0; u.a = (const char*)(A + (size_t)pm * BM * lda); u.b = (const char*)(Bt + (size_t)pn * BM * ldb); return true;
    }
};

struct EpiF32 {
    static constexpr bool PERM = false;
    float* C; int ldc; int aux_cols; float scale;
    __device__ __forceinline__ void operator()(const f32x4 (&acc)[2][2][4][2], const Unit& u, int wr, int wc, int fr, int fq) const {
        const int row0 = u.pm * BM + wr * 64 + fr, col0 = u.pn * BM + u.aux * aux_cols + wc * 32 + 4 * fq;
#pragma unroll
        for (int ai = 0; ai < 2; ++ai)
#pragma unroll
            for (int m = 0; m < 4; ++m) { float* rowp = C + (size_t)(row0 + ai * HALF + m * 16) * ldc + col0;
#pragma unroll
                for (int bj = 0; bj < 2; ++bj)
#pragma unroll
                    for (int n = 0; n < 2; ++n) *(f32x4*)(rowp + bj * HALF + n * 16) = acc[ai][bj][m][n] * scale; }
    }
};
struct EpiF32Split {
    static constexpr bool PERM = false;
    float* C; float* side; size_t side_stride; int ldc; int pm0;
    __device__ __forceinline__ void operator()(const f32x4 (&acc)[2][2][4][2], const Unit& u, int wr, int wc, int fr, int fq) const {
        float* base = u.aux == 0 ? C + (size_t)u.pm * BM * ldc : side + (size_t)(u.aux - 1) * side_stride + (size_t)(u.pm - pm0) * BM * ldc;
        const int row0 = wr * 64 + fr, col0 = u.pn * BM + wc * 32 + 4 * fq;
#pragma unroll
        for (int ai = 0; ai < 2; ++ai)
#pragma unroll
            for (int m = 0; m < 4; ++m) { float* rowp = base + (size_t)(row0 + ai * HALF + m * 16) * ldc + col0;
#pragma unroll
                for (int bj = 0; bj < 2; ++bj)
#pragma unroll
                    for (int n = 0; n < 2; ++n) *(f32x4*)(rowp + bj * HALF + n * 16) = acc[ai][bj][m][n]; }
    }
};
struct EpiResid {
    static constexpr bool PERM = false;
    const float* base; float* out; int ldc; bf16_t* xn; const float* gn; float* ssq;
    __device__ __forceinline__ void operator()(const f32x4 (&acc)[2][2][4][2], const Unit& u, int wr, int wc, int fr, int fq) const {
        const int row0 = u.pm * BM + wr * 64 + fr, col0 = u.pn * BM + wc * 32 + 4 * fq;
        f32x4 gv[2][2];
        if (xn) {
#pragma unroll
            for (int bj = 0; bj < 2; ++bj)
#pragma unroll
                for (int n = 0; n < 2; ++n) gv[bj][n] = *(const f32x4*)(gn + col0 + bj * HALF + n * 16); }
#pragma unroll
        for (int ai = 0; ai < 2; ++ai)
#pragma unroll
            for (int m = 0; m < 4; ++m) { const int row = row0 + ai * HALF + m * 16; const size_t off = (size_t)row * ldc + col0; float ss = 0.f;
#pragma unroll
                for (int bj = 0; bj < 2; ++bj)
#pragma unroll
                    for (int n = 0; n < 2; ++n) { const f32x4 b = *(const f32x4*)(base + off + bj * HALF + n * 16); const f32x4 x = b + acc[ai][bj][m][n]; *(f32x4*)(out + off + bj * HALF + n * 16) = x;
                        if (xn) { ss += (x[0] * x[0] + x[1] * x[1]) + (x[2] * x[2] + x[3] * x[3]); const f32x4 y = x * gv[bj][n];
                            u32x2 w; w.x = cvt_pk_bf16(y[0], y[1]); w.y = cvt_pk_bf16(y[2], y[3]); *(u32x2*)(xn + off + bj * HALF + n * 16) = w; } }
                if (xn) { ss += __shfl_xor(ss, 16); ss += __shfl_xor(ss, 32); if (fq == 0) __hip_atomic_fetch_add(ssq + row, ss, __ATOMIC_RELAXED, __HIP_MEMORY_SCOPE_AGENT); } }
    }
};
struct EpiBf16 {
    static constexpr bool PERM = true;
    bf16_t* O; int ldc; float* side; int side_pn; const float* ssq;
    __device__ __forceinline__ void operator()(const f32x4 (&acc)[2][2][4][2], const Unit& u, int wr, int wc, int fr, int fq) const {
        const int row0 = u.pm * BM + wr * 64 + fr, col0 = u.pn * BM + wc * 32 + 8 * fq;
#pragma unroll
        for (int ai = 0; ai < 2; ++ai)
#pragma unroll
            for (int m = 0; m < 4; ++m) { bf16_t* rowp = O + (size_t)(row0 + ai * HALF + m * 16) * ldc + col0;
                const float rs = ssq ? 1.0f / sqrtf(ssq[row0 + ai * HALF + m * 16] * (1.0f / 2048.0f) + 1e-6f) : 1.0f;
#pragma unroll
                for (int bj = 0; bj < 2; ++bj) { const f32x4 v0 = acc[ai][bj][m][0] * rs, v1 = acc[ai][bj][m][1] * rs;
                    u32x4 w; w.x = cvt_pk_bf16(v0[0], v0[1]); w.y = cvt_pk_bf16(v0[2], v0[3]); w.z = cvt_pk_bf16(v1[0], v1[1]); w.w = cvt_pk_bf16(v1[2], v1[3]);
                    *(u32x4*)(rowp + bj * HALF) = w; } }
        if (side != nullptr && u.pn == side_pn) {
#pragma unroll
            for (int ai = 0; ai < 2; ++ai)
#pragma unroll
                for (int m = 0; m < 4; ++m) { float* rowp = side + (size_t)(row0 + ai * HALF + m * 16) * 256 + wc * 32 + 8 * fq;
#pragma unroll
                    for (int bj = 0; bj < 2; ++bj) { *(f32x4*)(rowp + bj * HALF) = acc[ai][bj][m][0]; *(f32x4*)(rowp + bj * HALF + 4) = acc[ai][bj][m][1]; } }
        }
    }
};
struct EpiSwiGLU {
    static constexpr bool PERM = true;
    bf16_t* O; int ldc; const float* ssq;
    __device__ __forceinline__ void operator()(const f32x4 (&acc)[2][2][4][2], const Unit& u, int wr, int wc, int fr, int fq) const {
        const int row0 = u.pm * BM + wr * 64 + fr, col0 = u.pn * HALF + wc * 32 + 8 * fq;
#pragma unroll
        for (int ai = 0; ai < 2; ++ai)
#pragma unroll
            for (int m = 0; m < 4; ++m) { bf16_t* rowp = O + (size_t)(row0 + ai * HALF + m * 16) * ldc + col0;
                const float rs = ssq ? 1.0f / sqrtf(ssq[row0 + ai * HALF + m * 16] * (1.0f / 2048.0f) + 1e-6f) : 1.0f;
                float o[8];
#pragma unroll
                for (int n = 0; n < 2; ++n)
#pragma unroll
                    for (int j = 0; j < 4; ++j) { const float g = acc[ai][0][m][n][j] * rs, up = acc[ai][1][m][n][j] * rs;
                        o[n * 4 + j] = g * __builtin_amdgcn_rcpf(1.0f + __builtin_amdgcn_exp2f(-1.4426950408889634f * g)) * up; }
                u32x4 w; w.x = cvt_pk_bf16(o[0], o[1]); w.y = cvt_pk_bf16(o[2], o[3]); w.z = cvt_pk_bf16(o[4], o[5]); w.w = cvt_pk_bf16(o[6], o[7]);
                *(u32x4*)rowp = w; }
    }
};

template <class Epi, class Sched, bool ALIGN_EPI>
__device__ __forceinline__ void gemm_phase(PG8_LAS unsigned char* lds, const Gemm g, const Sched& S, const Epi& E) {
    const int tid = threadIdx.x, wid = __builtin_amdgcn_readfirstlane(tid >> 6), lane = tid & 63, wr = wid >> 2, wc = wid & 3, fr = lane & 15, fq = lane >> 4;
    const int K = g.K, nt = K / BK;
    unsigned voffA[2], voffB[2];
#pragma unroll
    for (int i = 0; i < 2; ++i) { int R, C; stage_rc(tid * 16 + i * 8192, R, C); const int Rb = Epi::PERM ? ((R & ~31) + perm32(R & 31)) : R;
        voffA[i] = (unsigned)(R * g.lda + C) * 2u; voffB[i] = (unsigned)(Rb * g.ldb + C) * 2u; }
    const size_t kstep = (size_t)(BK * 2);
    const size_t hstepA = (size_t)HALF * g.lda * 2, hstepB = (size_t)HALF * g.ldb * 2;
    const unsigned ldsw = (unsigned)wid * 1024u;
    const int aoff = lds_byte(wr * 64 + fr, fq * 8), boff = lds_byte(wc * 32 + fr, fq * 8);
#define PG8_SA(b, h) (((b) * 2 + (h)) * HTB)
#define PG8_SB(b, h) ((4 + (b) * 2 + (h)) * HTB)
#define PG8_STAGE(bufoff, gbase, voff) do { _Pragma("unroll") for (int _i = 0; _i < 2; ++_i) \
        __builtin_amdgcn_global_load_lds((const unsigned*)((const char*)(gbase) + (voff)[_i]), (PG8_LAS unsigned*)(lds + (bufoff) + ldsw + _i * 8192), 16, 0, 0); } while (0)
#define PG8_LDA(dst, b, h) do { _Pragma("unroll") for (int m = 0; m < 4; ++m) _Pragma("unroll") for (int k = 0; k < 2; ++k) dst[m][k] = *(const PG8_LAS bf16x8*)(lds + PG8_SA(b, h) + aoff + m * 2048 + k * 1024); } while (0)
#define PG8_LDB(dst, b, h) do { _Pragma("unroll") for (int n = 0; n < 2; ++n) _Pragma("unroll") for (int k = 0; k < 2; ++k) dst[n][k] = *(const PG8_LAS bf16x8*)(lds + PG8_SB(b, h) + boff + n * 2048 + k * 1024); } while (0)
#define PG8_MMA(ai, bj, At, Bt) do { __builtin_amdgcn_s_setprio(1); _Pragma("unroll") for (int m = 0; m < 4; ++m) _Pragma("unroll") for (int n = 0; n < 2; ++n) _Pragma("unroll") for (int k = 0; k < 2; ++k) \
        acc[ai][bj][m][n] = __builtin_amdgcn_mfma_f32_16x16x32_bf16(Bt[n][k], At[m][k], acc[ai][bj][m][n], 0, 0, 0); __builtin_amdgcn_s_setprio(0); } while (0)
#define PG8_WAIT_V(n) asm volatile("s_waitcnt vmcnt(" #n ")" ::: "memory")
#define PG8_WAIT_L(n) asm volatile("s_waitcnt lgkmcnt(" #n ")" ::: "memory")
#define PG8_BAR __builtin_amdgcn_s_barrier()
#define PG8_SCHED __builtin_amdgcn_sched_barrier(0)
    Unit cur, nxt; int ui = 0;
    if (!S.next(0, cur)) return;
    f32x4 acc[2][2][4][2];
#pragma unroll
    for (int a = 0; a < 2; ++a)
#pragma unroll
        for (int b = 0; b < 2; ++b)
#pragma unroll
            for (int m = 0; m < 4; ++m)
#pragma unroll
                for (int n = 0; n < 2; ++n) acc[a][b][m][n] = (f32x4){0.f, 0.f, 0.f, 0.f};
    bf16x8 At[4][2], B0[2][2], B1[2][2];
    const char* cA = cur.a; const char* cB = cur.b;
    PG8_STAGE(PG8_SB(0, 0), cB, voffB); PG8_STAGE(PG8_SB(0, 1), cB + hstepB, voffB); PG8_STAGE(PG8_SA(0, 0), cA, voffA); PG8_STAGE(PG8_SA(0, 1), cA + hstepA, voffA);
    if (wr == 1) PG8_BAR;
    PG8_WAIT_V(2); PG8_BAR;
    PG8_STAGE(PG8_SB(1, 0), cB + kstep, voffB); PG8_STAGE(PG8_SA(1, 0), cA + kstep, voffA); PG8_STAGE(PG8_SB(1, 1), cB + hstepB + kstep, voffB);
    PG8_WAIT_V(6); PG8_BAR;
    for (;;) {
        const bool has_next = S.next(ui + 1, nxt);
        const char* nA = has_next ? nxt.a : cA; const char* nB = has_next ? nxt.b : cB;
        for (int t = 0; t < nt; t += 2) {
            const bool last = (t == nt - 2);
            const char* a1 = cA + (size_t)(t + 1) * kstep;
            const char* a2 = last ? nA : cA + (size_t)(t + 2) * kstep; const char* b2 = last ? nB : cB + (size_t)(t + 2) * kstep;
            const char* a3 = a2 + kstep; const char* b3 = b2 + kstep;
            PG8_LDB(B0, 0, 0); PG8_LDB(B1, 0, 1); PG8_SCHED; PG8_LDA(At, 0, 0); PG8_STAGE(PG8_SA(1, 1), a1 + hstepA, voffA);
            PG8_WAIT_V(8); PG8_WAIT_L(0); PG8_BAR; PG8_MMA(0, 0, At, B0); PG8_MMA(0, 1, At, B1); PG8_BAR; PG8_SCHED;
            PG8_LDA(At, 0, 1); PG8_STAGE(PG8_SB(0, 0), b2, voffB); PG8_STAGE(PG8_SB(0, 1), b2 + hstepB, voffB); PG8_STAGE(PG8_SA(0, 0), a2, voffA);
            PG8_WAIT_V(8); PG8_WAIT_L(0); PG8_BAR; PG8_MMA(1, 0, At, B0); PG8_MMA(1, 1, At, B1); PG8_BAR; PG8_SCHED;
            PG8_LDB(B0, 1, 0); PG8_LDB(B1, 1, 1); PG8_SCHED; PG8_LDA(At, 1, 0); PG8_STAGE(PG8_SA(0, 1), a2 + hstepA, voffA);
            PG8_WAIT_V(8); PG8_WAIT_L(0); PG8_BAR; PG8_MMA(0, 0, At, B0); PG8_MMA(0, 1, At, B1); PG8_BAR; PG8_SCHED;
            PG8_LDA(At, 1, 1); PG8_STAGE(PG8_SB(1, 0), b3, voffB); PG8_STAGE(PG8_SB(1, 1), b3 + hstepB, voffB); PG8_STAGE(PG8_SA(1, 0), a3, voffA);
            PG8_WAIT_V(8); PG8_WAIT_L(0); PG8_BAR; PG8_MMA(1, 0, At, B0); PG8_MMA(1, 1, At, B1); PG8_BAR; PG8_SCHED;
        }
        if constexpr (ALIGN_EPI) { if (wr == 0) PG8_BAR; }
        E(acc, cur, wr, wc, fr, fq);
        if (!has_next) break;
#pragma unroll
        for (int a = 0; a < 2; ++a)
#pragma unroll
            for (int b = 0; b < 2; ++b)
#pragma unroll
                for (int m = 0; m < 4; ++m)
#pragma unroll
                    for (int n = 0; n < 2; ++n) acc[a][b][m][n] = (f32x4){0.f, 0.f, 0.f, 0.f};
        cur = nxt; cA = nA; cB = nB; ++ui;
        if constexpr (ALIGN_EPI) { if (wr == 1) PG8_BAR; }
    }
    PG8_WAIT_V(0);
    if constexpr (!ALIGN_EPI) { if (wr == 0) PG8_BAR; }
    PG8_BAR;
#undef PG8_SA
#undef PG8_SB
#undef PG8_STAGE
#undef PG8_LDA
#undef PG8_LDB
#undef PG8_MMA
#undef PG8_WAIT_V
#undef PG8_WAIT_L
#undef PG8_BAR
#undef PG8_SCHED
}
}

namespace fox {
constexpr int D = 128, LDQ = 8192, LDO = 2048;
constexpr float SCALE = 0.08838834764831845f;
constexpr float THR2 = 8.f * 1.4426950408889634f;
constexpr int NW = 8, QBLK = 32, KVBLK = 64, QB = NW * QBLK;
constexpr int SHM_V = KVBLK * D * 2, SHM_K = KVBLK * D * 2;
constexpr int BIAS_OFF = 2 * SHM_V + 2 * SHM_K + NW * 64 * 4;
constexpr int LDS_BYTES = BIAS_OFF + 8192 * 4;

#define KSWZ(row, colB) ((row) * 256 + ((colB) ^ (((row) & 7) << 4)))
#define SBAR() __builtin_amdgcn_sched_barrier(0)
__device__ __forceinline__ int v_st(int k, int c) { const int kk = (k & ~0xC) | ((k & 4) << 1) | ((k & 8) >> 1); return ((kk >> 3) * 4 + (c >> 5)) * 512 + ((kk & 7) * 32 + (c & 31)) * 2; }
__device__ __forceinline__ int v_rd_base(int lane) { return ((lane & 3) << 3) | (((lane >> 2) & 3) << 6) | (((lane >> 4) & 1) << 5) | (((lane >> 5) & 1) << 8); }
constexpr int v_rd_off(int d0, int ks, int half) { return d0 * 512 + ks * 4096 + half * 2048; }
__device__ __forceinline__ int crow(int r, int hi) { return (r & 3) + 8 * (r >> 2) + 4 * hi; }
__device__ __forceinline__ unsigned cvtpk(float lo, float hi) { unsigned r; asm volatile("v_cvt_pk_bf16_f32 %0, %1, %2" : "=v"(r) : "v"(lo), "v"(hi)); return r; }
__device__ __forceinline__ bf16x8 load8(const bf16* p) { return *reinterpret_cast<const bf16x8*>(p); }
__device__ __forceinline__ void mask_tile(f32x16& p0, f32x16& p1, int dq) {
    const float NEG = -__builtin_inff();
#pragma unroll
    for (int r = 0; r < 16; ++r) {
        const int c = (r & 3) + 8 * (r >> 2);
        if (dq - c < 0) p0[r] = NEG;
        if (dq - c - 32 < 0) p1[r] = NEG;
    }
}
__device__ __forceinline__ void partialSM(f32x16& p0, f32x16& p1, float& m_reg, float& mn, float& alpha, const float* bl) {
    constexpr float C2 = 1.4426950408889634f * SCALE;
#pragma unroll
    for (int a = 0; a < 4; ++a) {
#ifdef FOX_NOBIAS
        const f32x4 b0 = {0,0,0,0}, b1 = {0,0,0,0};
#else
        const f32x4 b0 = *(const f32x4*)(bl + 8 * a), b1 = *(const f32x4*)(bl + 32 + 8 * a);
#endif

#pragma unroll
        for (int i = 0; i < 4; ++i) { p0[4 * a + i] = fmaf(p0[4 * a + i], C2, b0[i]); p1[4 * a + i] = fmaf(p1[4 * a + i], C2, b1[i]); }
        SBAR(); }
    float pmax = p0[0]; for (int r = 1; r < 16; ++r) pmax = fmaxf(pmax, p0[r]); for (int r = 0; r < 16; ++r) pmax = fmaxf(pmax, p1[r]);
    { auto rr = __builtin_amdgcn_permlane32_swap(__float_as_uint(pmax), __float_as_uint(pmax), false, false);
      pmax = fmaxf(__uint_as_float(rr[0]), __uint_as_float(rr[1])); }
    if (__builtin_expect(__all((pmax - m_reg) <= THR2), 1)) { mn = m_reg; alpha = 1.f; }
    else { mn = fmaxf(m_reg, pmax); alpha = __builtin_amdgcn_exp2f(m_reg - mn); m_reg = mn; }
    for (int r = 0; r < 16; ++r) p0[r] = p0[r] - mn; for (int r = 0; r < 16; ++r) p1[r] = p1[r] - mn;
    for (int r = 0; r < 16; ++r) p0[r] = __builtin_amdgcn_exp2f(p0[r]);
}
__device__ __forceinline__ void finishSM(f32x16& p0, f32x16& p1, float alpha, float& l_reg, bf16x8& pa0, bf16x8& pa1, bf16x8& pa2, bf16x8& pa3) {
    for (int r = 0; r < 16; ++r) p1[r] = __builtin_amdgcn_exp2f(p1[r]);
    float ps = 0; for (int r = 0; r < 16; ++r) ps += p0[r]; for (int r = 0; r < 16; ++r) ps += p1[r];
    { auto rr = __builtin_amdgcn_permlane32_swap(__float_as_uint(ps), __float_as_uint(ps), false, false);
      ps = __uint_as_float(rr[0]) + __uint_as_float(rr[1]); }
    l_reg = l_reg * alpha + ps;
#define PK4(P, B_, OUT) do { unsigned a0 = cvtpk(P[B_+0], P[B_+1]), a1 = cvtpk(P[B_+2], P[B_+3]);                          \
        unsigned b0 = cvtpk(P[B_+4], P[B_+5]), b1 = cvtpk(P[B_+6], P[B_+7]);                                             \
        auto r0 = __builtin_amdgcn_permlane32_swap(a0, b0, false, false); auto r1 = __builtin_amdgcn_permlane32_swap(a1, b1, false, false); \
        u32x4 w = {r0[0], r1[0], r0[1], r1[1]}; OUT = *reinterpret_cast<bf16x8*>(&w); } while (0)
    PK4(p0, 0, pa0); PK4(p0, 8, pa1); PK4(p1, 0, pa2); PK4(p1, 8, pa3);
#undef PK4
}
template <int KB>
__device__ __forceinline__ void qkt(f32x16& p0, f32x16& p1, const char* K_lds, int r32, int hi, const bf16x8* qr) {
    p0 = f32x16{}; p1 = f32x16{};
    const char* kb[4];
#pragma unroll
    for (int dd = 0; dd < 4; ++dd) kb[dd] = K_lds + KB * SHM_K + KSWZ(r32, (dd * 16 + hi * 8) * 2);
#pragma unroll
    for (int d0 = 0; d0 < 8; ++d0) { const char* a = kb[d0 & 3] + (d0 >> 2) * 128;
        bf16x8 b0 = *reinterpret_cast<const bf16x8*>(a);
        bf16x8 b1 = *reinterpret_cast<const bf16x8*>(a + 32 * 256);
        p0 = __builtin_amdgcn_mfma_f32_32x32x16_bf16(b0, qr[d0], p0, 0, 0, 0);
        p1 = __builtin_amdgcn_mfma_f32_32x32x16_bf16(b1, qr[d0], p1, 0, 0, 0); }
}
template <int VB>
__device__ __forceinline__ void pv_tile(f32x16* o, int vb0, bf16x8 pa0, bf16x8 pa1, bf16x8 pa2, bf16x8 pa3) {
#define TRRD(dst, off) asm volatile("ds_read_b64_tr_b16 %0, %1 offset:%2" : "=&v"(dst) : "v"(vb0), "i"(off) : "memory")
#define PV_D0(d0) do { s16x4 l0, l1, l2, l3, h0, h1, h2, h3; constexpr int b_ = VB * SHM_V + v_rd_off(d0, 0, 0); \
        TRRD(l0, b_); TRRD(h0, b_ + 2048); TRRD(l1, b_ + 4096); TRRD(h1, b_ + 6144); TRRD(l2, b_ + 8192); TRRD(h2, b_ + 10240); TRRD(l3, b_ + 12288); TRRD(h3, b_ + 14336); \
        asm volatile("s_waitcnt lgkmcnt(0)" ::: "memory"); SBAR();   \
        o[d0] = __builtin_amdgcn_mfma_f32_32x32x16_bf16(pa0, (bf16x8){l0[0], l0[1], l0[2], l0[3], h0[0], h0[1], h0[2], h0[3]}, o[d0], 0, 0, 0);   \
        o[d0] = __builtin_amdgcn_mfma_f32_32x32x16_bf16(pa1, (bf16x8){l1[0], l1[1], l1[2], l1[3], h1[0], h1[1], h1[2], h1[3]}, o[d0], 0, 0, 0);   \
        o[d0] = __builtin_amdgcn_mfma_f32_32x32x16_bf16(pa2, (bf16x8){l2[0], l2[1], l2[2], l2[3], h2[0], h2[1], h2[2], h2[3]}, o[d0], 0, 0, 0);   \
        o[d0] = __builtin_amdgcn_mfma_f32_32x32x16_bf16(pa3, (bf16x8){l3[0], l3[1], l3[2], l3[3], h3[0], h3[1], h3[2], h3[3]}, o[d0], 0, 0, 0); } while (0)
    PV_D0(0); PV_D0(1); PV_D0(2); PV_D0(3);
#undef PV_D0
#undef TRRD
}

struct BlockRef { const bf16* Q; const bf16* K; const bf16* V; const bf16* G; bf16* O; int P0; };
struct Seam { bf16x8 qr[8]; bf16x8 st_v0, st_v1, st_k0, st_k1; };
#define LD8(base, boff) (*reinterpret_cast<const bf16x8*>((const char*)(base) + (boff)))
#define VMW() asm volatile("s_waitcnt vmcnt(0)" ::: "memory")
#define VMWN(n) asm volatile("s_waitcnt vmcnt(%0)" :: "i"(n) : "memory")
#define SLOAD_H(Kp, Vp, k0) do { const char* kb__ = (const char*)(Kp) + (size_t)(k0) * (LDQ * 2); const char* vb__ = (const char*)(Vp) + (size_t)(k0) * (LDQ * 2); \
                         S.st_v0 = LD8(vb__, kvoff); S.st_v1 = LD8(vb__, kvoff + 32u * LDQ * 2u);              \
                         S.st_k0 = LD8(kb__, kvoff); S.st_k1 = LD8(kb__, kvoff + 32u * LDQ * 2u); } while (0)
#define SWRITE_HK(bf) do { *(bf16x8*)(K_lds + (bf) * SHM_K + kws) = S.st_k0; *(bf16x8*)(K_lds + (bf) * SHM_K + kws + 32 * 256) = S.st_k1; } while (0)
#define SWRITE_HV(bf) do { *(bf16x8*)(V_lds + (bf) * SHM_V + vst0) = S.st_v0; *(bf16x8*)(V_lds + (bf) * SHM_V + vst1) = S.st_v1; } while (0)
#define SWRITE_H(bf) do { SWRITE_HV(bf); SWRITE_HK(bf); } while (0)
__device__ __forceinline__ void prime(const BlockRef& cur, char* lds, Seam& S) {
    const int tid = threadIdx.x, wid = __builtin_amdgcn_readfirstlane(tid >> 6), lane = tid & 63, r32 = lane & 31, hi = lane >> 5;
    const int sr = tid >> 4, sc = (tid & 15) * 8, kws = KSWZ(sr, sc * 2); char* K_lds = lds + 2 * SHM_V;
    const unsigned kvoff = (unsigned)(sr * LDQ + sc) * 2u, qoff = (unsigned)((wid * QBLK + r32) * LDQ + hi * 8) * 2u;
    for (int d0 = 0; d0 < 8; ++d0) S.qr[d0] = LD8(cur.Q, qoff + d0 * 32);
    SLOAD_H(cur.K, cur.V, 0); VMW(); SWRITE_HK(0);
    __syncthreads();
}
__device__ __forceinline__ void block(const BlockRef& cur, const BlockRef& nxt, char* lds, Seam& S) {
    const int tid = threadIdx.x, wid = __builtin_amdgcn_readfirstlane(tid >> 6), lane = tid & 63, r32 = lane & 31, hi = lane >> 5;
    const int NT = (cur.P0 + QB - 1) / KVBLK + 1;
    const int qlo = cur.P0 + wid * QBLK, qm = qlo + r32 - 4 * hi;
    char* V_lds = lds; char* K_lds = lds + 2 * SHM_V;
    float* ws = (float*)(lds + 2 * SHM_V + 2 * SHM_K) + wid * 64; float* li_l = ws, * al_l = ws + 32;
    const float* biasl = (const float*)(lds + BIAS_OFF) + 4 * hi;
    float m_reg = -1e30f, l_reg = 0; f32x16 o[4] = {};
    const int sr = tid >> 4, sc = (tid & 15) * 8, vst0 = v_st(sr, sc), vst1 = v_st(32 + sr, sc), kws = KSWZ(sr, sc * 2);
    const unsigned kvoff = (unsigned)(sr * LDQ + sc) * 2u;
    const int vb0 = (int)(uintptr_t)V_lds + v_rd_base(lane);
    const bf16* Kh = cur.K; const bf16* Vh = cur.V;
#define RESC(a) do { if (__any((a) < 1.f)) { if (hi == 0) al_l[r32] = (a); asm volatile("s_waitcnt lgkmcnt(0)" ::: "memory");              \
                     for (int d_ = 0; d_ < 4; ++d_) for (int r = 0; r < 16; ++r) o[d_][r] *= al_l[crow(r, hi)]; } } while (0)
#define KBASE(t) ((t) * KVBLK)
#define MASKT(P0_, P1_, t) do { const int kb_ = KBASE(t); if (kb_ + KVBLK - 1 > qlo) mask_tile(P0_, P1_, qm - kb_); } while (0)
    constexpr int NQL = 8;
#define SEAM_K0() do { VMWN(NQL); SWRITE_HK(0); SBAR(); } while (0)
    f32x16 pA0, pA1, pB0, pB1; float mnA, mnB, alA, alB; bf16x8 pa0, pa1, pa2, pa3;
    SWRITE_HV(0); SBAR();
    if (NT > 1) { SLOAD_H(Kh, Vh, KBASE(1)); }
    SBAR(); qkt<0>(pA0, pA1, K_lds, r32, hi, S.qr);
    MASKT(pA0, pA1, 0); partialSM(pA0, pA1, m_reg, mnA, alA, biasl + KBASE(0));
    if (NT > 1) { VMW(); SWRITE_H(1); }
    __syncthreads();
#define HALF_STEP(PX0, PX1, mnX, alX, PY0, PY1, alY, t, KB, VB, SB) do {                                                      \
        SBAR(); qkt<KB>(PX0, PX1, K_lds, r32, hi, S.qr);                                                                      \
        finishSM(PY0, PY1, alY, l_reg, pa0, pa1, pa2, pa3); SBAR();                                                           \
        if ((t) + 1 < NT) { SLOAD_H(Kh, Vh, KBASE((t) + 1)); SBAR(); }                                                        \
        pv_tile<VB>(o, vb0, pa0, pa1, pa2, pa3); MASKT(PX0, PX1, (t)); partialSM(PX0, PX1, m_reg, mnX, alX, biasl + KBASE(t)); \
        __syncthreads();                                                                                                      \
        if ((t) + 1 < NT) { VMW(); SWRITE_H(SB); }                                                                            \
        RESC(alX); __syncthreads(); } while (0)
    for (int t = 1; t + 1 < NT; t += 2) {
        HALF_STEP(pB0, pB1, mnB, alB, pA0, pA1, alA, t, 1, 0, 0);
        HALF_STEP(pA0, pA1, mnA, alA, pB0, pB1, alB, t + 1, 0, 1, 1);
    }
    const bool even = (NT & 1) == 0;
    if (even) { SBAR(); qkt<1>(pB0, pB1, K_lds, r32, hi, S.qr); SBAR(); }
    SLOAD_H(nxt.K, nxt.V, 0); SBAR();
    { unsigned qoff = (unsigned)((wid * QBLK + r32) * LDQ + hi * 8) * 2u; asm volatile("" : "+v"(qoff));
#pragma unroll
      for (int d0 = 0; d0 < 8; ++d0) S.qr[d0] = LD8(nxt.Q, qoff + d0 * 32); }
    SBAR();
    finishSM(pA0, pA1, alA, l_reg, pa0, pa1, pa2, pa3); SBAR();
    pv_tile<0>(o, vb0, pa0, pa1, pa2, pa3);
    if (even) { MASKT(pB0, pB1, NT - 1); partialSM(pB0, pB1, m_reg, mnB, alB, biasl + KBASE(NT - 1)); __syncthreads(); RESC(alB);
        finishSM(pB0, pB1, alB, l_reg, pa0, pa1, pa2, pa3); SBAR(); pv_tile<1>(o, vb0, pa0, pa1, pa2, pa3); }
    SBAR(); SEAM_K0();
    if (hi == 0) li_l[r32] = l_reg; asm volatile("s_waitcnt lgkmcnt(0)" ::: "memory");
    float rli[16];
#pragma unroll
    for (int r = 0; r < 16; ++r) rli[r] = __builtin_amdgcn_rcpf(li_l[crow(r, hi)]);
    unsigned ooff = (unsigned)((wid * QBLK + 4 * hi) * LDO + r32) * 2u, goff = (unsigned)((wid * QBLK + 4 * hi) * LDQ + r32) * 2u;
    asm volatile("" : "+v"(ooff), "+v"(goff));
#pragma unroll
    for (int r = 0; r < 16; ++r) { const unsigned rr = (unsigned)((r & 3) + 8 * (r >> 2));
#pragma unroll
        for (int d0 = 0; d0 < 4; ++d0) {
#ifdef FOX_NOGATE
            const float gv = 0.f;
#else
            const float gv = bf2f(*(const bf16*)((const char*)cur.G + (goff + rr * (LDQ * 2u) + d0 * 64u)));
#endif

            const float v = o[d0][r] * rli[r] * (1.0f / (1.0f + __expf(-gv)));
            const float vn = __shfl_xor(v, 1);
            if ((r32 & 1) == 0) *(unsigned*)((char*)cur.O + (ooff + rr * (LDO * 2u) + d0 * 64u)) = cvtpk(v, vn); } }
    __syncthreads();
#undef RESC
#undef KBASE
#undef MASKT
#undef SEAM_K0
#undef HALF_STEP
}
#undef LD8
#undef VMW
#undef VMWN
#undef SLOAD_H
#undef SWRITE_HK
#undef SWRITE_HV
#undef SWRITE_H
#undef KSWZ
#undef SBAR
}

constexpr int NWAVES = 8;
constexpr size_t MiB = 1u << 20;
constexpr size_t WS_CTL = 0, CTL_ZERO_BYTES = 1 * MiB;
constexpr size_t WS_MEMN = 1 * MiB;
constexpr size_t WS_KMEM = 2 * MiB;
constexpr size_t WS_VTMEM = 4 * MiB;
constexpr size_t WS_SMALL = 6 * MiB;
constexpr size_t SM_BONUS = 0;
constexpr size_t SM_FPRE = 512 * 1024;
constexpr size_t SM_BIASL2 = 1024 * 1024;
constexpr size_t SM_BCUM = 1536 * 1024;
constexpr size_t SM_IG = SM_BCUM + 128 * 1024;
constexpr size_t SM_WSTATE = SM_IG + 128 * 1024;
constexpr size_t SM_CHBL = SM_WSTATE + 128 * 1024;
constexpr size_t SM_CHMD = SM_CHBL + 4096;
constexpr size_t SM_MSEQ = SM_CHMD + 4096;
constexpr size_t SM_WCARRY = SM_MSEQ + 4096;
constexpr size_t SM_MOUT = SM_WCARRY + 4096;
constexpr size_t SM_TOPI = 2048 * 1024;
constexpr size_t SM_TOPG = SM_TOPI + 64 * 1024;
constexpr size_t SM_SLOT = SM_TOPG + 64 * 1024;
constexpr size_t SM_BLKCNT = SM_SLOT + 64 * 1024;
constexpr size_t SM_TILEE = SM_BLKCNT + 8192;
constexpr size_t SM_NU = 3 * 1024 * 1024;
constexpr size_t SM_SLOC = 4 * 1024 * 1024;
constexpr size_t SM_PEND = 5 * 1024 * 1024;
constexpr size_t SM_SIN = 6 * 1024 * 1024;
constexpr size_t WS_X = 16 * MiB;
constexpr size_t WS_XN = 80 * MiB;
constexpr size_t WS_W_XQ = 112 * MiB, WS_W_XKV = 128 * MiB, WS_W_XO = 160 * MiB, WS_W_ABIN = 176 * MiB, WS_W_LORA = 206 * MiB, WS_W_ABOUT = 209 * MiB,
                 WS_W_FFNGU = 217 * MiB, WS_W_FFND = 261 * MiB, WS_W_FOXIN = 283 * MiB, WS_W_FOXOUT = 315 * MiB, WS_W_MOEGU = 323 * MiB, WS_W_MOED = 675 * MiB;
constexpr size_t WS_R = 851 * MiB;
constexpr size_t R_PROJ = WS_R + 0 * MiB;
constexpr size_t R_GATES32 = WS_R + 120 * MiB;
constexpr size_t R_LORAIN = WS_R + 128 * MiB;
constexpr size_t R_LORAOUT = WS_R + 136 * MiB;
constexpr size_t R_SC = WS_R + 232 * MiB;
constexpr size_t SC_STRIDE = 32 * MiB;
constexpr size_t R_FR = WS_R + 232 * MiB;
constexpr size_t R_SV = WS_R + 392 * MiB;
constexpr size_t R_Y = WS_R + 424 * MiB;
constexpr size_t R_QB = WS_R + 456 * MiB, R_KB = WS_R + 472 * MiB, R_VB = WS_R + 488 * MiB;
constexpr size_t R_U = WS_R + 504 * MiB;
constexpr size_t R_YCAT = WS_R + 568 * MiB;
constexpr size_t R_XQ = WS_R + 0 * MiB;
constexpr size_t R_XS = WS_R + 32 * MiB;
constexpr size_t R_XP = WS_R + 64 * MiB;
constexpr size_t R_XO = WS_R + 80 * MiB;
constexpr size_t R_ACT = WS_R + 112 * MiB;
constexpr size_t R_QKVG = WS_R + 200 * MiB;
constexpr size_t R_ATTO = WS_R + 328 * MiB;
constexpr size_t R_AG = WS_R + 0 * MiB;
constexpr size_t R_ACTG = WS_R + 72 * MiB;
constexpr size_t R_YG = WS_R + 270 * MiB;
constexpr size_t R_YSIDE = WS_R + 416 * MiB;
constexpr size_t YSIDE_STRIDE = (size_t)8 * 256 * D;
constexpr size_t R_Z = WS_R + 600 * MiB;
constexpr size_t WS_END = WS_R + 624 * MiB;
static_assert(R_YG + (size_t)MOE_ROWS * D * 4 <= WS_END && R_ACTG + (size_t)MOE_ROWS * DFF * 2 <= R_YG && R_YCAT + (size_t)T * D * 2 <= WS_END, "ws map");
static_assert(WS_W_MOED + (size_t)NEXP * D * DFF * 2 <= WS_R && WS_W_MOEGU + (size_t)NEXP * 2 * DFF * D * 2 <= WS_W_MOED, "ws map (weights)");
constexpr int CW_BAR = 4096;
constexpr size_t CTL_SSQ = 65536;

constexpr int RING_OFF = 0, RING_BYTES = 147456;
constexpr int LDSCTL_OFF = RING_BYTES, MISC_OFF = LDSCTL_OFF + 320;
constexpr int LDS_BYTES = RING_BYTES + 4096;

typedef GAS unsigned gu32;
#define RLX_AGENT __ATOMIC_RELAXED, __HIP_MEMORY_SCOPE_AGENT
#define LDS_WAIT() asm volatile("s_waitcnt lgkmcnt(0)" ::: "memory")
#define VM_WAIT() asm volatile("s_waitcnt vmcnt(0)" ::: "memory")

#define XB_TMO      128
#define XB_XCNT(j)  (256  + 64 * (j))
#define XB_XSUB(j)  (1280 + 64 * (j))
#define XB_XGEN(j)  (2304 + 64 * (j))
#define XB_TOP      3328
#define XB_TOPGEN   3392
#define XCD_BAR_WORDS 3456
#define XB_SPIN_CAP (1u << 18)
__device__ __forceinline__ unsigned xb_ld(unsigned* p)              { return __hip_atomic_load(p, __ATOMIC_RELAXED, __HIP_MEMORY_SCOPE_AGENT); }
__device__ __forceinline__ unsigned xb_add(unsigned* p, unsigned v) { return __hip_atomic_fetch_add(p, v, __ATOMIC_RELAXED, __HIP_MEMORY_SCOPE_AGENT); }
__device__ __forceinline__ unsigned xb_xcc_id() { return (unsigned)__builtin_amdgcn_s_getreg((3 << 11) | 20) & 0xFu; }
#define XB_SPIN(cond, bar) do { unsigned _sp = 0; while (cond) { __builtin_amdgcn_s_sleep(1); \
    if ((++_sp & 255u) == 0u) { if (xb_ld(&(bar)[XB_TMO])) break; if (_sp > XB_SPIN_CAP) { atomicAdd(&(bar)[XB_TMO], 1u); break; } } } } while (0)
struct XcdBarrier { unsigned* bar; unsigned x; volatile LAS unsigned* st; };
__device__ __forceinline__ XcdBarrier xcd_barrier_post(unsigned* bar, volatile LAS unsigned* st) {
    XcdBarrier b; b.bar = bar; b.x = xb_xcc_id(); b.st = st;
    if (threadIdx.x == 0) (void)xb_add(&bar[XB_XCNT(b.x)], 1u);
    return b;
}
__device__ __forceinline__ void xcd_barrier_complete(unsigned* bar, unsigned x, unsigned& nloc, unsigned& nx) {
    const unsigned G = gridDim.x * gridDim.y * gridDim.z;
    unsigned sum, cnt, mine, sp = 0u;
    for (;;) {
        sum = 0u; cnt = 0u; mine = 0u;
#pragma unroll
        for (unsigned j = 0; j < 16; ++j) { const unsigned c = xb_ld(&bar[XB_XCNT(j)]); sum += c; cnt += (c > 0u) ? 1u : 0u; mine = (j == x) ? c : mine; }
        if (sum == G) break;
        __builtin_amdgcn_s_sleep(1);
        if ((++sp & 255u) == 0u) { if (xb_ld(&bar[XB_TMO])) break; if (sp > XB_SPIN_CAP) { atomicAdd(&bar[XB_TMO], 1u); break; } }
    }
    nloc = mine > 0u ? mine : 1u; nx = cnt > 0u ? cnt : 1u;
}
__device__ __forceinline__ void xcd_barrier(const XcdBarrier& b) {
    asm volatile("s_waitcnt vmcnt(0)" ::: "memory");
    __syncthreads();
    if (threadIdx.x == 0) {
        unsigned* bar = b.bar;
        __builtin_amdgcn_s_waitcnt(0);
        unsigned nloc = b.st[0], nx = b.st[1];
        if (nloc == 0u) { xcd_barrier_complete(bar, b.x, nloc, nx); b.st[0] = nloc; b.st[1] = nx; }
        const unsigned old = xb_add(&bar[XB_XSUB(b.x)], 1u);
        const unsigned gen = old / nloc;
        if (old + 1u == (gen + 1u) * nloc) {
            __builtin_amdgcn_fence(__ATOMIC_RELEASE, "agent");
            asm volatile("s_waitcnt vmcnt(0)" ::: "memory");
            const unsigned og = xb_add(&bar[XB_TOP], 1u);
            const unsigned tg = og / nx;
            if (og + 1u == (tg + 1u) * nx) xb_add(&bar[XB_TOPGEN], 1u);
            else XB_SPIN(xb_ld(&bar[XB_TOPGEN]) == tg, bar);
            __builtin_amdgcn_fence(__ATOMIC_ACQUIRE, "agent");
            xb_add(&bar[XB_XGEN(b.x)], 1u);
            asm volatile("s_waitcnt vmcnt(0)" ::: "memory");
        } else {
            XB_SPIN(xb_ld(&bar[XB_XGEN(b.x)]) == gen, bar);
            __builtin_amdgcn_fence(__ATOMIC_ACQUIRE, "agent");
            asm volatile("s_waitcnt vmcnt(0)" ::: "memory");
        }
    }
    __syncthreads();
}

struct Frame {
    LAS unsigned char* lds; unsigned char* ldsg;
    unsigned char* ws; const float* const* in; float* out;
    int tid, lane, wave, vcu, G, gw, NGW;
};

enum InIdx { I_X = 0, I_MEM, I_MEMG, I_FING, I_NMIXG, I_NXAG, I_NFFNG, I_XWQ, I_XWKV, I_XWO, I_ABWIN, I_ABMU, I_RWW0, I_RWWUP, I_RWA0, I_RWAUP, I_RWGUP, I_RWKK, I_RWKA, I_RWRK,
             I_RWLNG, I_RWLNB, I_MLCONV, I_MLBIF, I_MLNG, I_ABWOUT, I_FFG, I_FFU, I_FFD, I_FOXWIN, I_FOXBF, I_FOXQG, I_FOXKG, I_FOXWOUT, I_ROUTER, I_MOEG, I_MOEU, I_MOED, N_IN };
struct Args { const float* in[N_IN]; float* out; unsigned char* ws; int ph_lo, ph_hi; };
static_assert(sizeof(Args) == (N_IN + 2) * 8 + 8, "Args has no padding");

#define WSP(T_, off) ((T_*)(F.ws + (off)))

__device__ __forceinline__ void rms_row(const float* xrow, const float* g, bf16* orow, int lane, f32x4 (&y)[8]) {
    const f32x4* xr = (const f32x4*)xrow + lane; const f32x4* gr = (const f32x4*)g + lane;
    float s = 0.f;
#pragma unroll
    for (int j = 0; j < 8; ++j) { y[j] = xr[64 * j]; s += (y[j][0] * y[j][0] + y[j][1] * y[j][1]) + (y[j][2] * y[j][2] + y[j][3] * y[j][3]); }
    const float r = 1.0f / sqrtf(wave_sum(s) * (1.0f / D) + 1e-6f);
#pragma unroll
    for (int j = 0; j < 8; ++j) { const f32x4 gv = gr[64 * j]; y[j] = y[j] * r * gv; }
    if (orow) { u32x2* o8 = (u32x2*)orow + lane;
#pragma unroll
        for (int j = 0; j < 8; ++j) { u32x2 w; w.x = cvt_pk_bf16(y[j][0], y[j][1]); w.y = cvt_pk_bf16(y[j][2], y[j][3]); o8[64 * j] = w; } }
}
__device__ __forceinline__ void norm_phase(const Frame& F, const float* X, const float* g, bf16* XN, int nrows) {
    for (int t = F.gw; t < nrows; t += F.NGW) { f32x4 y[8]; rms_row(X + (size_t)t * D, g, XN + (size_t)t * D, F.lane, y); }
}
template <int NC>
__device__ __forceinline__ void stage_skinny(const Frame& F, const float* W, int ldw, int c0, LAS float* Ws) {
    for (int i = F.tid; i < D * NC; i += NWAVES * 64) { const int e = i / NC, c = i % NC; Ws[c * D + e] = W[(size_t)e * ldw + c0 + c]; }
}
template <int NC>
__device__ __forceinline__ void skinny_dot(const f32x4 (&y)[8], const LAS float* Ws, int lane, float (&out)[NC]) {
#pragma unroll
    for (int c = 0; c < NC; ++c) { float s = 0.f;
#pragma unroll
        for (int j = 0; j < 8; ++j) { const f32x4 w = *(const LAS f32x4*)(Ws + c * D + 256 * j + 4 * lane); s += (y[j][0] * w[0] + y[j][1] * w[1]) + (y[j][2] * w[2] + y[j][3] * w[3]); }
        out[c] = wave_sum(s); }
}

__device__ __forceinline__ void titem_load(const float* W, int ldw, int k0, int n0, int nvalid, int lane, float (&v)[32]) {
    const int n = lane & 31; const float* p = W + (size_t)(k0 + (lane >> 5)) * ldw + n0 + n;
#pragma unroll
    for (int i = 0; i < 32; ++i) v[i] = (n < nvalid) ? __builtin_nontemporal_load(p + (size_t)(2 * i) * ldw) : 0.f;
}
__device__ __forceinline__ void titem_finish(const float (&v)[32], int k0, int nvalid, bf16* WT0  , int K, LAS float* scr, int lane) {
#pragma unroll
    for (int i = 0; i < 32; ++i) scr[(2 * i + (lane >> 5)) * 33 + (lane & 31)] = v[i];
    LDS_WAIT(); asm volatile("" ::: "memory");
    const int c = lane & 7;
#pragma unroll
    for (int j = 0; j < 4; ++j) { const int n = (lane >> 3) + 8 * j; const LAS float* s = scr + (8 * c) * 33 + n;
        u32x4 o; o.x = cvt_pk_bf16(s[0 * 33], s[1 * 33]); o.y = cvt_pk_bf16(s[2 * 33], s[3 * 33]); o.z = cvt_pk_bf16(s[4 * 33], s[5 * 33]); o.w = cvt_pk_bf16(s[6 * 33], s[7 * 33]);
        if (n < nvalid) __builtin_nontemporal_store(o, (u32x4*)(WT0 + (size_t)n * K + k0 + 8 * c)); }
    LDS_WAIT(); asm volatile("" ::: "memory");
}
__device__ __forceinline__ void transpose_matrix(const Frame& F, int gw, int NGW, const float* W, int ldw, int K, int N, bf16* WT, int mode, int& it0, LAS float* scr) {
    const int nblk = (N + 31) / 32, nitems = (K / 64) * nblk;
    int first = gw - (it0 % NGW); if (first < 0) first += NGW;
    it0 += nitems;
    if (first >= nitems) return;
    float va[32], vb[32];
    { const int kb = first / nblk, nb = first % nblk, n0 = 32 * nb; titem_load(W, ldw, 64 * kb, n0, (N - n0) < 32 ? (N - n0) : 32, F.lane, va); }
    for (int r = first; r < nitems; r += NGW) {
        const int kb = r / nblk, nb = r % nblk, n0 = 32 * nb; const int nvalid = (N - n0) < 32 ? (N - n0) : 32;
        const int drow = mode == 0 ? n0 : ((n0 >> 7) * 256 + (n0 & 127) + (mode == 2 ? 128 : 0));
        const int rn = r + NGW;
        if (rn < nitems) { const int kbn = rn / nblk, nbn = rn % nblk, n0n = 32 * nbn; titem_load(W, ldw, 64 * kbn, n0n, (N - n0n) < 32 ? (N - n0n) : 32, F.lane, vb); }
        titem_finish(va, 64 * kb, nvalid, WT + (size_t)drow * K, K, scr, F.lane);
#pragma unroll
        for (int i = 0; i < 32; ++i) va[i] = vb[i];
    }
}
__device__ __forceinline__ void p_convert_early(const Frame& F, const Args& A) {
    LAS float* scr = (LAS float*)(F.lds + RING_OFF + F.wave * 16384);
    int it0 = 0;
    for (int l = 0; l < 2; ++l)
        transpose_matrix(F, F.gw, F.NGW, A.in[I_XWKV] + (size_t)l * D * 2 * D, 2 * D, D, 2 * D, WSP(bf16, WS_W_XKV) + (size_t)l * 2 * D * D, 0, it0, scr);
    transpose_matrix(F, F.gw, F.NGW, A.in[I_ABWIN], AB_COLS, D, AB_COLS, WSP(bf16, WS_W_ABIN), 0, it0, scr);
    const int gt = F.gw * 64 + F.lane, NGT = F.NGW * 64;
    { u32x4* z = (u32x4*)(WSP(bf16, WS_W_ABIN) + (size_t)AB_COLS * D); const int n16 = (AB_PAD - AB_COLS) * D * 2 / 16;
      for (int i = gt; i < n16; i += NGT) z[i] = (u32x4){0u, 0u, 0u, 0u}; }
    { bf16* WL = WSP(bf16, WS_W_LORA); const float* wup = A.in[I_RWWUP]; const float* aup = A.in[I_RWAUP]; const float* gup = A.in[I_RWGUP];
      for (int i = gt; i < 3072 * 64; i += NGT) { const int n = i >> 6, k8 = (i & 63) * 8; const int sec = n >> 10, nn = n & 1023; float v[8];
#pragma unroll
          for (int j = 0; j < 8; ++j) { const int k = k8 + j; float x = 0.f;
              if (sec == 0) { if (k < 96) x = wup[(size_t)k * 1024 + nn]; }
              else if (sec == 1) { if (k >= 96 && k < 192) x = aup[(size_t)(k - 96) * 1024 + nn]; }
              else { if (k >= 192 && k < 448) x = gup[(size_t)(k - 192) * 1024 + nn]; }
              v[j] = x; }
          u32x4 o; o.x = cvt_pk_bf16(v[0], v[1]); o.y = cvt_pk_bf16(v[2], v[3]); o.z = cvt_pk_bf16(v[4], v[5]); o.w = cvt_pk_bf16(v[6], v[7]);
          *(u32x4*)(WL + (size_t)n * 512 + k8) = o; } }
    norm_phase(F, A.in[I_MEM], A.in[I_MEMG], WSP(bf16, WS_MEMN), NMEM);
    norm_phase(F, A.in[I_X], A.in[I_NMIXG], WSP(bf16, WS_XN), T);
}
__device__ __forceinline__ void p_convert_late(const Frame& F, const Args& A, int gw, int NGW, LAS float* scr, bool with_dense, int e_lo, int e_hi) {
    int it0 = 0;
    if (with_dense) {
        transpose_matrix(F, gw, NGW, A.in[I_ABWOUT], D, D, D, WSP(bf16, WS_W_ABOUT), 0, it0, scr);
        for (int l = 0; l < 2; ++l) {
            transpose_matrix(F, gw, NGW, A.in[I_XWQ] + (size_t)l * D * D, D, D, D, WSP(bf16, WS_W_XQ) + (size_t)l * D * D, 0, it0, scr);
            transpose_matrix(F, gw, NGW, A.in[I_XWO] + (size_t)l * D * D, D, D, D, WSP(bf16, WS_W_XO) + (size_t)l * D * D, 0, it0, scr);
        }
        transpose_matrix(F, gw, NGW, A.in[I_FFG], DFF, D, DFF, WSP(bf16, WS_W_FFNGU), 1, it0, scr);
        transpose_matrix(F, gw, NGW, A.in[I_FFU], DFF, D, DFF, WSP(bf16, WS_W_FFNGU), 2, it0, scr);
        transpose_matrix(F, gw, NGW, A.in[I_FFD], D, DFF, D, WSP(bf16, WS_W_FFND), 0, it0, scr);
        transpose_matrix(F, gw, NGW, A.in[I_FOXWIN], FOX_LD, D, 8192, WSP(bf16, WS_W_FOXIN), 0, it0, scr);
        transpose_matrix(F, gw, NGW, A.in[I_FOXWOUT], D, D, D, WSP(bf16, WS_W_FOXOUT), 0, it0, scr);
    }
    for (int e = e_lo; e < e_hi; ++e) {
        transpose_matrix(F, gw, NGW, A.in[I_MOEG] + (size_t)e * D * DFF, DFF, D, DFF, WSP(bf16, WS_W_MOEGU) + (size_t)e * 2 * DFF * D, 1, it0, scr);
        transpose_matrix(F, gw, NGW, A.in[I_MOEU] + (size_t)e * D * DFF, DFF, D, DFF, WSP(bf16, WS_W_MOEGU) + (size_t)e * 2 * DFF * D, 2, it0, scr);
        transpose_matrix(F, gw, NGW, A.in[I_MOED] + (size_t)e * DFF * D, D, DFF, D, WSP(bf16, WS_W_MOED) + (size_t)e * D * DFF, 0, it0, scr);
    }
}

struct InprojKvOrder {
    const bf16* xn; const bf16* wabin; const bf16* memn; const bf16* wkv; int G, c;
    __device__ __forceinline__ bool next(int i, pg8::Unit& u) const {
        const int L = i * G + c; u.pad = 0;
        if (L < 32 * (AB_PAD / 256)) { int pm, pn; pg8::static_tile(i, G, c, 32, AB_PAD / 256, pm, pn); u.pm = pm; u.pn = pn; u.aux = -1;
            u.a = (const char*)(xn + (size_t)pm * 256 * D); u.b = (const char*)(wabin + (size_t)pn * 256 * D); return true; }
        const int j = L - 32 * (AB_PAD / 256); if (j >= 32) return false;
        const int l = j >> 4, kind = (j >> 3) & 1, idx = j & 7; const bf16* w = wkv + (size_t)l * 2 * D * D;
        if (kind == 0) { u.a = (const char*)memn; u.b = (const char*)(w + (size_t)idx * 256 * D); u.pm = 0; u.pn = idx; }
        else { u.a = (const char*)(w + (size_t)(D + idx * 256) * D); u.b = (const char*)memn; u.pm = idx; u.pn = 0; }
        u.aux = l * 2 + kind; return true;
    }
};
struct EpiInprojKv {
    static constexpr bool PERM = true;
    bf16* proj; float* gates32; bf16* kmem; bf16* vtmem;
    __device__ __forceinline__ void operator()(const f32x4 (&acc)[2][2][4][2], const pg8::Unit& u, int wr, int wc, int fr, int fq) const {
        if (u.aux < 0) { pg8::EpiBf16 E{proj, AB_PAD, gates32, 29, nullptr}; E(acc, u, wr, wc, fr, fq); }
        else { const int l = u.aux >> 1, kind = u.aux & 1;
            pg8::EpiBf16 E{kind == 0 ? kmem + (size_t)l * NMEM * D : vtmem + (size_t)l * D * NMEM, kind == 0 ? D : NMEM, nullptr, -1, nullptr};
            E(acc, u, wr, wc, fr, fq); }
    }
};

__device__ __forceinline__ void p_prepa(const Frame& F, const Args& A) {
    const bf16* PROJ = WSP(bf16, R_PROJ); const float* mu = A.in[I_ABMU]; const float* convw = A.in[I_MLCONV];
    bf16* LIN = WSP(bf16, R_LORAIN); bf16* QB = WSP(bf16, R_QB); bf16* KB = WSP(bf16, R_KB); bf16* VB = WSP(bf16, R_VB);
    const int lane = F.lane;
    for (int t = F.gw; t < T; t += F.NGW) {
        const bf16* p0 = PROJ + (size_t)t * AB_PAD;
#pragma unroll
        for (int i = 0; i < 7; ++i) { const int cc = lane + 64 * i, c = 3072 + cc; const float p = bf2f(p0[c]); const float pp = t > 0 ? bf2f(p0[c - AB_PAD]) : 0.f;
            const float s = p + (pp - p) * mu[c]; float o;
            if (cc < 96) o = tanhf(s); else if (cc < 192) o = s; else o = sigmoidf_(s);
            LIN[(size_t)t * 512 + cc] = f2bf(o); }
        LIN[(size_t)t * 512 + 448 + lane] = 0;
#pragma unroll
        for (int i = 0; i < 4; ++i) { const int c = 8 * lane + 512 * i; float acc[8];
#pragma unroll
            for (int j = 0; j < 8; ++j) acc[j] = 0.f;
#pragma unroll
            for (int tap = 0; tap < 4; ++tap) { const int tt = t - 3 + tap; if (tt >= 0) {
                const bf16x8 v = *(const bf16x8*)(PROJ + (size_t)tt * AB_PAD + A_COLS + c); const f32x4 w0 = *(const f32x4*)(convw + tap * 2048 + c), w1 = *(const f32x4*)(convw + tap * 2048 + c + 4);
#pragma unroll
                for (int j = 0; j < 4; ++j) { acc[j] += bf2f((unsigned short)v[j]) * w0[j]; acc[4 + j] += bf2f((unsigned short)v[4 + j]) * w1[j]; } } }
            const float sc = c < 1024 ? 0.0625f : 1.0f; float o[8];
#pragma unroll
            for (int j = 0; j < 8; ++j) o[j] = acc[j] * sigmoidf_(acc[j]) * sc;
            u32x4 w; w.x = cvt_pk_bf16(o[0], o[1]); w.y = cvt_pk_bf16(o[2], o[3]); w.z = cvt_pk_bf16(o[4], o[5]); w.w = cvt_pk_bf16(o[6], o[7]);
            if (c < 1024) *(u32x4*)(QB + (size_t)t * 1024 + c) = w; else *(u32x4*)(KB + (size_t)t * 1024 + c - 1024) = w; }
#pragma unroll
        for (int i = 0; i < 2; ++i) { const int c = 8 * lane + 512 * i; *(u32x4*)(VB + (size_t)t * 1024 + c) = *(const u32x4*)(p0 + 5568 + c); }
    }
    const float* G32 = WSP(float, R_GATES32); const float* bif = A.in[I_MLBIF];
    float* BCUM = WSP(float, WS_SMALL + SM_BCUM); float* IG = WSP(float, WS_SMALL + SM_IG); float* CHBL = WSP(float, WS_SMALL + SM_CHBL); float* CHMD = WSP(float, WS_SMALL + SM_CHMD);
    for (int u = F.gw; u < NH_M * 128; u += F.NGW) { const int h = u >> 7, c = u & 127, t = 64 * c + lane;
        const float ig = G32[(size_t)t * 256 + 192 + h] + bif[h], fg = G32[(size_t)t * 256 + 196 + h] + bif[4 + h];
        float b = logsigmoidf_(fg);
#pragma unroll
        for (int o = 1; o < 64; o <<= 1) { const float x = __shfl_up(b, o); if (lane >= o) b += x; }
        const float bl = __shfl(b, 63); const float md = wave_max(bl - b + ig);
        BCUM[h * T + t] = b; IG[h * T + t] = ig;
        if (lane == 0) { CHBL[u] = bl; CHMD[u] = md; } }
}

__device__ __forceinline__ void p_prepb(const Frame& F, const Args& A) {
    const bf16* PROJ = WSP(bf16, R_PROJ); const float* LOUT = WSP(float, R_LORAOUT); const float* mu = A.in[I_ABMU];
    const float* w0 = A.in[I_RWW0]; const float* a0 = A.in[I_RWA0]; const float* kk_ = A.in[I_RWKK]; const float* ka_ = A.in[I_RWKA]; const float* rk_ = A.in[I_RWRK];
    float* SR = WSP(float, R_SC); float* SW = WSP(float, R_SC + SC_STRIDE); float* SKM = WSP(float, R_SC + 2 * SC_STRIDE); float* SV = WSP(float, R_SC + 3 * SC_STRIDE);
    float* SKK = WSP(float, R_SC + 4 * SC_STRIDE); float* SB = WSP(float, R_SC + 5 * SC_STRIDE); float* BONUS = WSP(float, WS_SMALL + SM_BONUS);
    const int lane = F.lane;
    for (int u = F.gw; u < NH_R * (T / 64); u += F.NGW) { const int h = u & 15, tb = u >> 4, c = 64 * h + lane, t0 = 64 * tb;
        const float mur = mu[c], muk = mu[1024 + c], muv = mu[2048 + c], w0c = w0[c], a0c = a0[c], kkc = kk_[c], kac = ka_[c], rkc = rk_[c];
        float pr = 0.f, pk = 0.f, pv = 0.f;
        if (t0 > 0) { const bf16* pp = PROJ + (size_t)(t0 - 1) * AB_PAD; pr = bf2f(pp[c]); pk = bf2f(pp[1024 + c]); pv = bf2f(pp[2048 + c]); }
        constexpr int GT = 8;
        float xr[GT], xk[GT], xv[GT], lw[GT], la[GT], nr[GT], nk[GT], nv[GT], nw[GT], na[GT];
#define PB_LOAD(dr, dk, dv, dw, da, tt_) do { _Pragma("unroll") for (int i = 0; i < GT; ++i) { const bf16* p0 = PROJ + (size_t)(t0 + (tt_) + i) * AB_PAD; const float* lo = LOUT + (size_t)(t0 + (tt_) + i) * 3072; \
            dr[i] = bf2f(p0[c]); dk[i] = bf2f(p0[1024 + c]); dv[i] = bf2f(p0[2048 + c]); dw[i] = lo[c]; da[i] = lo[1024 + c]; } } while (0)
        PB_LOAD(xr, xk, xv, lw, la, 0);
        for (int tt = 0; tt < 64; tt += GT) {
            if (tt + GT < 64) PB_LOAD(nr, nk, nv, nw, na, tt + GT);
            float kk[GT], km[GT], r[GT], v[GT], a[GT], w[GT], q1[GT], q2[GT];
#pragma unroll
            for (int i = 0; i < GT; ++i) { r[i] = xr[i] + (pr - xr[i]) * mur; const float k = xk[i] + (pk - xk[i]) * muk; v[i] = xv[i] + (pv - xv[i]) * muv; pr = xr[i]; pk = xk[i]; pv = xv[i];
                w[i] = __expf(-0.6065306597126334f * sigmoidf_(lw[i] + w0c)); a[i] = sigmoidf_(a0c + la[i]);
                kk[i] = k * kkc; km[i] = k * (1.0f + (a[i] - 1.0f) * kac); q1[i] = kk[i] * kk[i]; q2[i] = r[i] * km[i] * rkc; }
#pragma unroll
            for (int i = 0; i < GT; ++i) { q1[i] = wave_sum_dpp(q1[i]); q2[i] = wave_sum_dpp(q2[i]); }
#pragma unroll
            for (int i = 0; i < GT; ++i) { const float kn = kk[i] / fmaxf(sqrtf(q1[i]), 1e-12f); const size_t o = (size_t)(t0 + tt + i) * 1024 + c;
                SR[o] = r[i]; SW[o] = w[i]; SKM[o] = km[i]; SV[o] = v[i]; SKK[o] = kn; SB[o] = kn * a[i];
                if (lane == 0) BONUS[(t0 + tt + i) * 16 + h] = q2[i]; }
#pragma unroll
            for (int i = 0; i < GT; ++i) { xr[i] = nr[i]; xk[i] = nk[i]; xv[i] = nv[i]; lw[i] = nw[i]; la[i] = na[i]; }
        }
#undef PB_LOAD
    }
    if (F.gw < NH_M) { const int h = F.gw;
        const float* BCUM = WSP(float, WS_SMALL + SM_BCUM); const float* IG = WSP(float, WS_SMALL + SM_IG); const float* CHBL = WSP(float, WS_SMALL + SM_CHBL); const float* CHMD = WSP(float, WS_SMALL + SM_CHMD);
        float* MSEQ = WSP(float, WS_SMALL + SM_MSEQ); float* WCARRY = WSP(float, WS_SMALL + SM_WCARRY);
        const float bl0 = CHBL[h * 128 + lane], bl1 = CHBL[h * 128 + 64 + lane], md0 = CHMD[h * 128 + lane], md1 = CHMD[h * 128 + 64 + lane];
        float m = 0.f, mine_in0 = 0.f, mine_in1 = 0.f, mine_out0 = 0.f, mine_out1 = 0.f;
#pragma unroll
        for (int c = 0; c < 128; ++c) { const float bl = __shfl(c < 64 ? bl0 : bl1, c & 63), md = __shfl(c < 64 ? md0 : md1, c & 63);
            const float mn = fmaxf(bl + m, md);
            if ((c & 63) == lane) { if (c < 64) { mine_in0 = m; mine_out0 = mn; } else { mine_in1 = m; mine_out1 = mn; } }
            m = mn; }
        MSEQ[h * 128 + lane] = mine_in0; MSEQ[h * 128 + 64 + lane] = mine_in1;
        WCARRY[h * 128 + lane] = __expf(bl0 + mine_in0 - mine_out0); WCARRY[h * 128 + 64 + lane] = __expf(bl1 + mine_in1 - mine_out1);
        float* MOUT = WSP(float, WS_SMALL + SM_MOUT); MOUT[h * 128 + lane] = mine_out0; MOUT[h * 128 + 64 + lane] = mine_out1;
    }
}

__device__ __forceinline__ void p_mlstm_pass2(const Frame& F, bool mine, int hh) {
    const int lane = F.lane;
    if (mine) { const int h = hh;
        const float* CHBL = WSP(float, WS_SMALL + SM_CHBL); const float* CHMD = WSP(float, WS_SMALL + SM_CHMD);
        float* MSEQ = WSP(float, WS_SMALL + SM_MSEQ); float* WCARRY = WSP(float, WS_SMALL + SM_WCARRY);
        const float bl0 = CHBL[h * 128 + lane], bl1 = CHBL[h * 128 + 64 + lane], md0 = CHMD[h * 128 + lane], md1 = CHMD[h * 128 + 64 + lane];
        float m = 0.f, mine_in0 = 0.f, mine_in1 = 0.f, mine_out0 = 0.f, mine_out1 = 0.f;
#pragma unroll
        for (int c = 0; c < 128; ++c) { const float bl = __shfl(c < 64 ? bl0 : bl1, c & 63), md = __shfl(c < 64 ? md0 : md1, c & 63);
            const float mn = fmaxf(bl + m, md);
            if ((c & 63) == lane) { if (c < 64) { mine_in0 = m; mine_out0 = mn; } else { mine_in1 = m; mine_out1 = mn; } }
            m = mn; }
        MSEQ[h * 128 + lane] = mine_in0; MSEQ[h * 128 + 64 + lane] = mine_in1;
        WCARRY[h * 128 + lane] = __expf(bl0 + mine_in0 - mine_out0); WCARRY[h * 128 + 64 + lane] = __expf(bl1 + mine_in1 - mine_out1);
        float* MOUT = WSP(float, WS_SMALL + SM_MOUT); MOUT[h * 128 + lane] = mine_out0; MOUT[h * 128 + 64 + lane] = mine_out1;
    }
}

__device__ __forceinline__ float row16_sum(float x) {
    x += __builtin_bit_cast(float, __builtin_amdgcn_update_dpp(0, __builtin_bit_cast(int, x), 0xB1, 0xF, 0xF, true));
    x += __builtin_bit_cast(float, __builtin_amdgcn_update_dpp(0, __builtin_bit_cast(int, x), 0x4E, 0xF, 0xF, true));
    x += __builtin_bit_cast(float, __builtin_amdgcn_update_dpp(0, __builtin_bit_cast(int, x), 0x141, 0xF, 0xF, true));
    x += __builtin_bit_cast(float, __builtin_amdgcn_update_dpp(0, __builtin_bit_cast(int, x), 0x140, 0xF, 0xF, true));
    return x;
}
__device__ __forceinline__ void row16_sum2(float& a, float& b) {
#define DPPF(x, ctrl) __builtin_bit_cast(float, __builtin_amdgcn_update_dpp(0, __builtin_bit_cast(int, x), ctrl, 0xF, 0xF, true))
    a += DPPF(a, 0xB1); b += DPPF(b, 0xB1); a += DPPF(a, 0x4E); b += DPPF(b, 0x4E); a += DPPF(a, 0x141); b += DPPF(b, 0x141); a += DPPF(a, 0x140); b += DPPF(b, 0x140);
#undef DPPF
}
constexpr int SCH = 8;
constexpr int SC_VEC = SCH * 256;
constexpr int SC_BUF = 5 * SC_VEC + 1024;
constexpr int SC_NBUF = 3, SC_NSEG = 4;
constexpr int SC_LDS = SC_NSEG * SC_NBUF * SC_BUF;
constexpr int SC_PROG_OFF = SC_LDS;
constexpr int SC_TOUCH_AHEAD = 12;
__device__ __forceinline__ void row16_sum4(float& a, float& b, float& c, float& d) {
#define DPPF(x, ctrl) __builtin_bit_cast(float, __builtin_amdgcn_update_dpp(0, __builtin_bit_cast(int, x), ctrl, 0xF, 0xF, true))
    a += DPPF(a, 0xB1); b += DPPF(b, 0xB1); c += DPPF(c, 0xB1); d += DPPF(d, 0xB1); a += DPPF(a, 0x4E); b += DPPF(b, 0x4E); c += DPPF(c, 0x4E); d += DPPF(d, 0x4E);
    a += DPPF(a, 0x141); b += DPPF(b, 0x141); c += DPPF(c, 0x141); d += DPPF(d, 0x141); a += DPPF(a, 0x140); b += DPPF(b, 0x140); c += DPPF(c, 0x140); d += DPPF(d, 0x140);
#undef DPPF
}
__host__ __device__ constexpr int sc_len(int s) { return s == 0 ? 3328 : (s == 3 ? 1664 : 1600); }
__host__ __device__ constexpr int sc_tb(int s) { return s == 0 ? 0 : 3328 + (s - 1) * 1600; }
static_assert(sc_tb(3) + sc_len(3) == T, "segments cover the sequence");
__device__ __forceinline__ int sc_seg_of(int t) { return t < 3328 ? 0 : (t < 4928 ? 1 : (t < 6528 ? 2 : 3)); }
template <int SEGI>
__device__ __forceinline__ void p_scan(const Frame& F) {
    constexpr bool TR = SEGI >= 1; constexpr int TB = sc_tb(SEGI), SC_SEG = sc_len(SEGI), SC_SEG0 = sc_len(0);
    const int b = blockIdx.x, head = (b & 7) * 2 + ((b >> 3) & 1), rg = b >> 4, lane = F.lane, row = lane >> 4, j = lane & 15;
    const float* SR = WSP(float, R_SC); const float* SW = WSP(float, R_SC + SC_STRIDE); const float* SKM = WSP(float, R_SC + 2 * SC_STRIDE); const float* SV = WSP(float, R_SC + 3 * SC_STRIDE);
    const float* SKK = WSP(float, R_SC + 4 * SC_STRIDE); const float* SB = WSP(float, R_SC + 5 * SC_STRIDE);
    float* Yo = WSP(float, R_Y) + (size_t)TB * 1024; float* Zo = WSP(float, R_Z) + (size_t)(TR ? TB - SC_SEG0 : 0) * 1024;
    LAS unsigned char* lds = F.lds + RING_OFF + SEGI * SC_NBUF * SC_BUF;
    volatile LAS int* prog = (volatile LAS int*)(F.lds + RING_OFF + SC_PROG_OFF);
    const size_t goff = (size_t)TB * 1024 + (size_t)(lane >> 4) * 1024 + head * 64 + (lane & 15) * 4;
    f32x2 L0 = {0.f, 0.f}, L1 = {0.f, 0.f}, T0 = {0.f, 0.f}, T1 = {0.f, 0.f};
    if (TR) { const int i = rg * 4 + row; if ((i >> 2) == j) { const int e = i & 3; T0[0] = e == 0 ? 1.f : 0.f; T0[1] = e == 1 ? 1.f : 0.f; T1[0] = e == 2 ? 1.f : 0.f; T1[1] = e == 3 ? 1.f : 0.f; } }
#define SC_ISSUE(c_, buf_) do { const size_t t0_ = (size_t)(c_) * SCH * 1024; LAS unsigned char* d_ = lds + (buf_) * SC_BUF; \
        _Pragma("unroll") for (int q = 0; q < SCH / 4; ++q) { const size_t o_ = t0_ + (size_t)q * 4096 + goff; \
            __builtin_amdgcn_global_load_lds((const unsigned*)(SKK + o_), (LAS unsigned*)(d_ + 0 * SC_VEC + q * 1024), 16, 0, 0); \
            __builtin_amdgcn_global_load_lds((const unsigned*)(SW  + o_), (LAS unsigned*)(d_ + 1 * SC_VEC + q * 1024), 16, 0, 0); \
            __builtin_amdgcn_global_load_lds((const unsigned*)(SB  + o_), (LAS unsigned*)(d_ + 2 * SC_VEC + q * 1024), 16, 0, 0); \
            __builtin_amdgcn_global_load_lds((const unsigned*)(SR  + o_), (LAS unsigned*)(d_ + 3 * SC_VEC + q * 1024), 16, 0, 0); \
            __builtin_amdgcn_global_load_lds((const unsigned*)(SKM + o_), (LAS unsigned*)(d_ + 4 * SC_VEC + q * 1024), 16, 0, 0); } \
        { int ts_ = TB + (c_) * SCH + lane; ts_ = ts_ < T ? ts_ : T - 1; \
          __builtin_amdgcn_global_load_lds((const unsigned*)(SV + (size_t)ts_ * 1024 + head * 64 + rg * 4), (LAS unsigned*)(d_ + 5 * SC_VEC), 16, 0, 0); } } while (0)
    __builtin_amdgcn_s_setprio(3);
    constexpr int NCH = SC_SEG / SCH;
    static_assert(NCH % 2 == 0 && SC_NBUF == 3, "three-buffer pipeline, 11 loads per chunk");
    SC_ISSUE(0, 0); SC_ISSUE(1, 1);
    int buf = 0; float ykL = 0.f, ykT = 0.f; f32x2 rp0 = {0.f, 0.f}, rp1 = {0.f, 0.f};
    for (int c = 0; c < NCH; ++c) {
        if (c < NCH - 1) asm volatile("s_waitcnt vmcnt(11)" ::: "memory"); else asm volatile("s_waitcnt vmcnt(0)" ::: "memory");
        if (c + 2 < NCH) { const int nb = buf >= 1 ? buf - 1 : buf + 2; SC_ISSUE(c + 2, nb); }
        if (SEGI == 0 && lane == 0) *prog = c;
        const LAS unsigned char* d = lds + buf * SC_BUF + j * 16;
        const LAS unsigned char* dv = lds + buf * SC_BUF + 5 * SC_VEC + row * 4;
        const int jb = (c & 1) * SCH;
        f32x2 kkA, kkB, wA, wB, bA, bB, kmA, kmB, rA, rB; float vv;
#define SC_LOAD(s_) do { const f32x4 kk_ = *(const LAS f32x4*)(d + 0 * SC_VEC + (s_) * 256), w_ = *(const LAS f32x4*)(d + 1 * SC_VEC + (s_) * 256), b_ = *(const LAS f32x4*)(d + 2 * SC_VEC + (s_) * 256); \
        const f32x4 r_ = *(const LAS f32x4*)(d + 3 * SC_VEC + (s_) * 256), km_ = *(const LAS f32x4*)(d + 4 * SC_VEC + (s_) * 256); vv = *(const LAS float*)(dv + (s_) * 16); \
        kkA = (f32x2){kk_[0], kk_[1]}; kkB = (f32x2){kk_[2], kk_[3]}; wA = (f32x2){w_[0], w_[1]}; wB = (f32x2){w_[2], w_[3]}; bA = (f32x2){b_[0], b_[1]}; bB = (f32x2){b_[2], b_[3]}; \
        rA = (f32x2){r_[0], r_[1]}; rB = (f32x2){r_[2], r_[3]}; kmA = (f32x2){km_[0], km_[1]}; kmB = (f32x2){km_[2], km_[3]}; } while (0)
        SC_LOAD(0);
#pragma unroll
        for (int s = 0; s < SCH; ++s) {
            f32x2 kk0 = kkA, kk1 = kkB, w0 = wA, w1 = wB, b0 = bA, b1 = bB, r0 = rA, r1 = rB, km0 = kmA, km1 = kmB; float v_ = vv;
            asm volatile("" : "+v"(kk0), "+v"(kk1), "+v"(w0), "+v"(w1), "+v"(b0), "+v"(b1), "+v"(r0), "+v"(r1), "+v"(km0), "+v"(km1), "+v"(v_));
            if (s + 1 < SCH) { SC_LOAD(s + 1); }
            __builtin_amdgcn_sched_barrier(0);
            const int keep = (jb + s + 15) & 15;
            if (TR) {
                f32x2 tl = L0 * kk0, ul = L0 * rp0, tt = T0 * kk0, ut = T0 * rp0; tl = L1 * kk1 + tl; ul = L1 * rp1 + ul; tt = T1 * kk1 + tt; ut = T1 * rp1 + ut;
                float sl = tl[0] + tl[1], yl = ul[0] + ul[1], st = tt[0] + tt[1], yt = ut[0] + ut[1];
                row16_sum4(sl, st, yl, yt);
                ykL = (j == keep) ? yl : ykL; ykT = (j == keep) ? yt : ykT;
                if (s == 0 && jb == 0 && c >= 2) { const size_t o = (size_t)((c - 2) * SCH + j) * 1024 + head * 64 + rg * 4 + row; Yo[o] = ykL; Zo[o] = ykT; }
                L0 = L0 * w0 + (km0 * v_ - b0 * sl); L1 = L1 * w1 + (km1 * v_ - b1 * sl); T0 = T0 * w0 - b0 * st; T1 = T1 * w1 - b1 * st;
            } else {
                f32x2 tl = L0 * kk0, ul = L0 * rp0; tl = L1 * kk1 + tl; ul = L1 * rp1 + ul;
                float sl = tl[0] + tl[1], yl = ul[0] + ul[1];
                row16_sum2(sl, yl);
                ykL = (j == keep) ? yl : ykL;
                if (s == 0 && jb == 0 && c >= 2) Yo[(size_t)((c - 2) * SCH + j) * 1024 + head * 64 + rg * 4 + row] = ykL;
                L0 = L0 * w0 + (km0 * v_ - b0 * sl); L1 = L1 * w1 + (km1 * v_ - b1 * sl);
            }
            rp0 = r0; rp1 = r1;
            __builtin_amdgcn_sched_barrier(0);
        }
#undef SC_LOAD
        buf = buf == SC_NBUF - 1 ? 0 : buf + 1;
    }
    { const size_t o = (size_t)(SC_SEG - 16 + j) * 1024 + head * 64 + rg * 4 + row;
      f32x2 u = L0 * rp0; u = L1 * rp1 + u; const float us = row16_sum(u[0] + u[1]); ykL = (j == 15) ? us : ykL; Yo[o] = ykL;
      if (TR) { f32x2 ut = T0 * rp0; ut = T1 * rp1 + ut; const float ut_ = row16_sum(ut[0] + ut[1]); ykT = (j == 15) ? ut_ : ykT; Zo[o] = ykT; } }
    if (SEGI < SC_NSEG - 1) { float* p = WSP(float, WS_SMALL + SM_SLOC) + (((size_t)SEGI * 16 + head) * 64 + rg * 4 + row) * 64 + 4 * j; *(f32x4*)p = (f32x4){L0[0], L0[1], L1[0], L1[1]}; }
    if (TR && SEGI < SC_NSEG - 1) { float* p = WSP(float, WS_SMALL + SM_PEND) + (((size_t)SEGI * 16 + head) * 64 + rg * 4 + row) * 64 + 4 * j; *(f32x4*)p = (f32x4){T0[0], T0[1], T1[0], T1[1]}; }
    asm volatile("s_waitcnt vmcnt(0)" ::: "memory");
    __builtin_amdgcn_s_setprio(0);
#undef SC_ISSUE
}
__device__ __forceinline__ void p_scan_touch(const Frame& F) {
    const int b = blockIdx.x, head = (b & 7) * 2 + ((b >> 3) & 1), lane = F.lane;
    const char* base = (const char*)WSP(float, R_SC); volatile LAS int* prog = (volatile LAS int*)(F.lds + RING_OFF + SC_PROG_OFF);
    constexpr int NCH0 = sc_len(0) / SCH, LPS = SCH * 12;
    unsigned dummy = 0;
    for (int c = 0; c < NCH0; ++c) {
        for (int spin = 0; spin < (1 << 16) && c > *prog + SC_TOUCH_AHEAD; ++spin) __builtin_amdgcn_s_sleep(8);
#pragma unroll
        for (int q = 0; q < 2; ++q) { const int x = q * 64 + lane; if (x < LPS) { const int step = x / 12, arr = (x % 12) >> 1, half = x & 1;
            const char* p = base + (size_t)arr * SC_STRIDE + ((size_t)(c * SCH + step) * 1024 + head * 64 + half * 32) * 4;
            asm volatile("global_load_dword %0, %1, off" : "+v"(dummy) : "v"(p) : "memory"); } }
        if ((c & 1) == 0) { const int c2 = c >> 1;
#pragma unroll
            for (int q = 0; q < 5; ++q) { const int x = q * 64 + lane; if (x < 3 * LPS) { const int seg = 1 + x / LPS, y = x % LPS, step = y / 12, arr = (y % 12) >> 1, half = y & 1;
                if (c2 * SCH < sc_len(seg)) { const char* p = base + (size_t)arr * SC_STRIDE + ((size_t)(sc_tb(seg) + c2 * SCH + step) * 1024 + head * 64 + half * 32) * 4;
                    asm volatile("global_load_dword %0, %1, off" : "+v"(dummy) : "v"(p) : "memory"); } } } }
    }
    asm volatile("s_waitcnt vmcnt(0)" : "+v"(dummy) :: "memory");
}
__device__ __forceinline__ void p_scomb(const Frame& F) {
    const float* SLOC = WSP(float, WS_SMALL + SM_SLOC); const float* PEND = WSP(float, WS_SMALL + SM_PEND); float* SIN = WSP(float, WS_SMALL + SM_SIN); const int lane = F.lane;
    for (int u = F.gw; u < 16 * 64; u += F.NGW) { const int h = u >> 6, v = u & 63;
        float sv = SLOC[((size_t)(0 * 16 + h) * 64 + v) * 64 + lane];
        SIN[((size_t)(1 * 16 + h) * 64 + v) * 64 + lane] = sv;
#pragma unroll
        for (int s = 2; s < SC_NSEG; ++s) { float acc = SLOC[((size_t)((s - 1) * 16 + h) * 64 + v) * 64 + lane]; const float* P = PEND + ((size_t)((s - 1) * 16 + h) * 64) * 64 + lane;
#pragma unroll 8
            for (int i = 0; i < 64; ++i) acc += __builtin_bit_cast(float, __builtin_amdgcn_readlane(__builtin_bit_cast(int, sv), i)) * P[(size_t)i * 64];
            sv = acc; SIN[((size_t)(s * 16 + h) * 64 + v) * 64 + lane] = sv; } }
}

__device__ __forceinline__ void p_rwkv_post(const Frame& F, const Args& A) {
    const float* Y = WSP(float, R_Y); const float* SV = WSP(float, R_SV); const float* LOUT = WSP(float, R_LORAOUT); const float* BONUS = WSP(float, WS_SMALL + SM_BONUS);
    const float* lng = A.in[I_RWLNG]; const float* lnb = A.in[I_RWLNB]; bf16* YCAT = WSP(bf16, R_YCAT); const int lane = F.lane;
    const float* SIN = WSP(float, WS_SMALL + SM_SIN); const float* Z = WSP(float, R_Z);
    for (int u = F.gw; u < NH_R * (T / 64); u += F.NGW) { const int h = u & 15, tb = u >> 4, c = 64 * h + lane, t0 = 64 * tb; const float lg = lng[c], lb = lnb[c];
        const int seg = 0; const bool seg1 = false; float sm[64];
        if (seg1) {
#pragma unroll
            for (int q = 0; q < 16; ++q) { const f32x4 x = *(const f32x4*)(SIN + ((size_t)(seg * 16 + h) * 64 + lane) * 64 + 4 * q); sm[4 * q] = x[0]; sm[4 * q + 1] = x[1]; sm[4 * q + 2] = x[2]; sm[4 * q + 3] = x[3]; } }
        constexpr int GT = 4;
        float y[GT], sv[GT], g[GT], bo[GT], z[GT], ny[GT], nsv[GT], ng[GT], nbo[GT], nz[GT], d[GT];
#define PP_LOAD(dy, dsv, dg, dbo, dz, tt_) do { _Pragma("unroll") for (int i = 0; i < GT; ++i) { const size_t t = t0 + (tt_) + i; dy[i] = Y[t * 1024 + c]; dsv[i] = SV[t * 1024 + c]; dg[i] = LOUT[t * 3072 + 2048 + c]; dbo[i] = BONUS[t * 16 + h]; \
            dz[i] = seg1 ? Z[(t - sc_len(0)) * 1024 + c] : 0.f; } } while (0)
        PP_LOAD(y, sv, g, bo, z, 0);
        for (int tt = 0; tt < 64; tt += GT) {
            if (tt + GT < 64) PP_LOAD(ny, nsv, ng, nbo, nz, tt + GT);
            if (seg1) {
#pragma unroll
                for (int q = 0; q < 64; ++q) {
#pragma unroll
                    for (int i = 0; i < GT; ++i) y[i] += sm[q] * __builtin_bit_cast(float, __builtin_amdgcn_readlane(__builtin_bit_cast(int, z[i]), q)); } }
#pragma unroll
            for (int i = 0; i < GT; ++i) d[i] = wave_sum_dpp(y[i]);
#pragma unroll
            for (int i = 0; i < GT; ++i) { y[i] -= d[i] * (1.0f / 64.0f); d[i] = y[i] * y[i]; }
#pragma unroll
            for (int i = 0; i < GT; ++i) d[i] = wave_sum_dpp(d[i]);
#pragma unroll
            for (int i = 0; i < GT; ++i) { const float o = (y[i] * (1.0f / sqrtf(d[i] * (1.0f / 64.0f) + 64e-5f)) * lg + lb + bo[i] * sv[i]) * g[i];
                YCAT[(size_t)(t0 + tt + i) * D + c] = f2bf(o); }
#pragma unroll
            for (int i = 0; i < GT; ++i) { y[i] = ny[i]; sv[i] = nsv[i]; g[i] = ng[i]; bo[i] = nbo[i]; z[i] = nz[i]; }
        }
#undef PP_LOAD
    }
}

constexpr int CK = 16, NCK = T / CK;
constexpr int CK_NFR = 19;
constexpr int CKP = 65;
__device__ __forceinline__ void ck_kpos(int k, int& g, int& kq, int& j) { g = k >> 5; const int kl = k & 31; if (kl < 16) { kq = kl >> 2; j = kl & 3; } else { kq = (kl - 16) >> 2; j = 4 + (kl & 3); } }

__device__ __forceinline__ void p_rwkv_chunk(const Frame& F, const Args& A) {
    const bf16* PROJ = WSP(bf16, R_PROJ); const float* LOUT = WSP(float, R_LORAOUT); const float* mu = A.in[I_ABMU];
    const float* w0 = A.in[I_RWW0]; const float* a0 = A.in[I_RWA0]; const float* kk_ = A.in[I_RWKK]; const float* ka_ = A.in[I_RWKA]; const float* rk_ = A.in[I_RWRK];
    float* SV = WSP(float, R_SV); float* BONUS = WSP(float, WS_SMALL + SM_BONUS); unsigned char* FR = WSP(unsigned char, R_FR);
    LAS float* L = (LAS float*)(F.lds + RING_OFF);
    LAS float* sA = L; LAS float* sP = L + 16 * CKP; LAS float* sB = L + 2 * 16 * CKP; LAS float* sKM = L + 3 * 16 * CKP; LAS float* sRH = L + 4 * 16 * CKP;
    LAS float* sCS = L + 5 * 16 * CKP; LAS float* sDM = L + 6 * 16 * CKP; LAS float* sCL = L + 7 * 16 * CKP; LAS float* sDL = L + 8 * 16 * CKP; LAS float* sV = L + 9 * 16 * CKP;
    LAS float* sAn = L + 10 * 16 * CKP; LAS float* sRn = L + 11 * 16 * CKP;
    LAS float* sU = L + 12 * 16 * CKP;
    LAS float* sAP = sU + 4 * 16 * 17;
    LAS float* sDP = sAP + 64 * 17;
    LAS float* sPL = sDP + 16 * 17;
    LAS bf16* sFR = (LAS bf16*)(sPL + 64);
    static_assert(((12 * 16 * CKP + 4 * 16 * 17 + 64 * 17 + 16 * 17 + 64) * 4) % 16 == 0, "fragment image alignment");
    const int tid = F.tid, lane = F.lane, wave = F.wave;
    for (int i = tid; i < CK_NFR * 512; i += NWAVES * 64) sFR[i] = 0;
    __syncthreads();
    const int upb = (NH_R * NCK) / F.G;
    const int r32 = lane & 31, hg = lane >> 5;
    float xr[3], xk[3], xv[3], lw[2], la[2], pm[8];
#define CK_LOAD(u_) do { const int c_ = (u_) >> 4, h_ = (u_) & 15, ch_ = 64 * h_ + lane, ta_ = c_ * CK + 2 * wave; \
        pm[0] = mu[ch_]; pm[1] = mu[1024 + ch_]; pm[2] = mu[2048 + ch_]; pm[3] = w0[ch_]; pm[4] = a0[ch_]; pm[5] = kk_[ch_]; pm[6] = ka_[ch_]; pm[7] = rk_[ch_]; \
        if (ta_ > 0) { const bf16* pp = PROJ + (size_t)(ta_ - 1) * AB_PAD; xr[0] = bf2f(pp[ch_]); xk[0] = bf2f(pp[1024 + ch_]); xv[0] = bf2f(pp[2048 + ch_]); } else { xr[0] = 0.f; xk[0] = 0.f; xv[0] = 0.f; } \
        _Pragma("unroll") for (int i = 0; i < 2; ++i) { const bf16* p0 = PROJ + (size_t)(ta_ + i) * AB_PAD; const float* lo = LOUT + (size_t)(ta_ + i) * 3072; \
            xr[1 + i] = bf2f(p0[ch_]); xk[1 + i] = bf2f(p0[1024 + ch_]); xv[1 + i] = bf2f(p0[2048 + ch_]); lw[i] = lo[ch_]; la[i] = lo[1024 + ch_]; } } while (0)
    CK_LOAD(F.vcu * upb);
    for (int ui = 0; ui < upb; ++ui) { const int u = F.vcu * upb + ui, c = u >> 4, h = u & 15, t0 = c * CK;
        { const int ch = 64 * h + lane; const int ta = t0 + 2 * wave; float pr = xr[0], pk = xk[0], pv = xv[0];
#pragma unroll
          for (int i = 0; i < 2; ++i) { const int t = ta + i, tl = 2 * wave + i;
              const float r = xr[1 + i] + (pr - xr[1 + i]) * pm[0], k = xk[1 + i] + (pk - xk[1 + i]) * pm[1], v = xv[1 + i] + (pv - xv[1 + i]) * pm[2]; pr = xr[1 + i]; pk = xk[1 + i]; pv = xv[1 + i];
              const float w = __expf(-0.6065306597126334f * sigmoidf_(lw[i] + pm[3])), a = sigmoidf_(pm[4] + la[i]);
              float kk = k * pm[5]; const float km = k * (1.0f + (a - 1.0f) * pm[6]);
              const float q1 = wave_sum_dpp(kk * kk), q2 = wave_sum_dpp(r * km * pm[7]);
              kk = kk / fmaxf(sqrtf(q1), 1e-12f);
              sA[tl * CKP + lane] = kk; sP[tl * CKP + lane] = w; sB[tl * CKP + lane] = kk * a; sKM[tl * CKP + lane] = km; sRH[tl * CKP + lane] = r; sV[tl * CKP + lane] = v;
              SV[(size_t)t * 1024 + ch] = v; if (lane == 0) BONUS[t * 16 + h] = q2; } }
        if (ui + 1 < upb) CK_LOAD(u + 1);
        __syncthreads();
        { const int k = tid & 63;
#pragma unroll
          for (int q = 0; q < 2; ++q) { const int t = (tid >> 6) * 2 + q; float Pp = 1.f, P = 1.f, PL = 1.f;
#pragma unroll
              for (int i = 0; i < CK; ++i) { const float wv = sP[i * CKP + k]; PL *= wv; if (i < t) Pp *= wv; if (i <= t) P *= wv; }
              const float inv = 1.0f / P, ratio = PL * inv, kkv = sA[t * CKP + k], bv = sB[t * CKP + k], kmv = sKM[t * CKP + k], rv = sRH[t * CKP + k];
              sCS[t * CKP + k] = bv * inv; sDM[t * CKP + k] = kmv * inv; sCL[t * CKP + k] = bv * ratio; sDL[t * CKP + k] = kmv * ratio;
              sAn[t * CKP + k] = Pp * kkv; sRn[t * CKP + k] = P * rv; if (t == 0) sPL[k] = PL; } }
        if (tid >= 64 && tid < 64 + 128) { const int x = tid - 64, vq = x >> 5, ln = x & 31, n = ln & 15, kq = ln >> 4; u32x4 o; float vv[8];
#pragma unroll
            for (int j = 0; j < 8; ++j) vv[j] = sV[(8 * kq + j) * CKP + 16 * vq + n];
            o.x = cvt_pk_bf16(vv[0], vv[1]); o.y = cvt_pk_bf16(vv[2], vv[3]); o.z = cvt_pk_bf16(vv[4], vv[5]); o.w = cvt_pk_bf16(vv[6], vv[7]);
            *(LAS u32x4*)(sFR + (15 + vq) * 512 + (n + 16 * kq) * 8) = o; }
        __syncthreads();
        if (wave == 0) { const LAS float* ar = (r32 < 16 ? sCS + r32 * CKP : sDM + (r32 - 16) * CKP); const LAS float* br = (r32 < 16 ? sAn + r32 * CKP : sRn + (r32 - 16) * CKP); f32x16 acc = f32x16{};
#pragma unroll
            for (int ks = 0; ks < 4; ++ks) { float av[8], bv[8];
#pragma unroll
                for (int j = 0; j < 8; ++j) { av[j] = ar[16 * ks + 8 * hg + j]; bv[j] = br[16 * ks + 8 * hg + j]; }
                u32x4 pa, pb; pa.x = cvt_pk_bf16(av[0], av[1]); pa.y = cvt_pk_bf16(av[2], av[3]); pa.z = cvt_pk_bf16(av[4], av[5]); pa.w = cvt_pk_bf16(av[6], av[7]);
                pb.x = cvt_pk_bf16(bv[0], bv[1]); pb.y = cvt_pk_bf16(bv[2], bv[3]); pb.z = cvt_pk_bf16(bv[4], bv[5]); pb.w = cvt_pk_bf16(bv[6], bv[7]);
                acc = __builtin_amdgcn_mfma_f32_32x32x16_bf16(__builtin_bit_cast(bf16x8, pa), __builtin_bit_cast(bf16x8, pb), acc, 0, 0, 0); }
#pragma unroll
            for (int q = 0; q < 16; ++q) { const int row = (q & 3) + 8 * (q >> 2) + 4 * hg, col = r32, mat = (row >> 4) + 2 * (col >> 4), i = row & 15, t = col & 15;
                const bool keep = (mat & 2) ? (i <= t) : (i < t); sU[mat * 16 * 17 + i * 17 + t] = keep ? acc[q] : 0.f; } }
        __syncthreads();
        if (tid < 80) { float x[CK]; const bool isA = tid < 64; const int ri = isA ? tid : tid - 64;
#pragma unroll
            for (int t = 0; t < CK; ++t) x[t] = isA ? sAn[t * CKP + ri] : sU[1 * 16 * 17 + ri * 17 + t];
#pragma unroll
            for (int jx = 0; jx < CK - 1; ++jx) { float urow[CK];
#pragma unroll
                for (int t = 0; t < CK; ++t) if (t > jx) urow[t] = sU[jx * 17 + t];
#pragma unroll
                for (int t = 0; t < CK; ++t) if (t > jx) x[t] -= x[jx] * urow[t]; }
            LAS float* dst = isA ? sAP + ri * 17 : sDP + ri * 17;
#pragma unroll
            for (int t = 0; t < CK; ++t) dst[t] = x[t]; }
        __syncthreads();
        {
#define CK_PACK(v_) ({ u32x4 p_; p_.x = cvt_pk_bf16(v_[0], v_[1]); p_.y = cvt_pk_bf16(v_[2], v_[3]); p_.z = cvt_pk_bf16(v_[4], v_[5]); p_.w = cvt_pk_bf16(v_[6], v_[7]); __builtin_bit_cast(bf16x8, p_); })
          if (wave < 4) {
              const int kr = 32 * (wave >> 1) + r32, kc = 32 * (wave & 1) + r32; float av[8], bv[8];
#pragma unroll
              for (int j = 0; j < 8; ++j) { av[j] = sAP[kr * 17 + 8 * hg + j]; bv[j] = sCL[(8 * hg + j) * CKP + kc]; }
              f32x16 acc = __builtin_amdgcn_mfma_f32_32x32x16_bf16(CK_PACK(av), CK_PACK(bv), f32x16{}, 0, 0, 0);
              const float pl = sPL[kc]; const int ktp = kc >> 4, ii = kc & 15;
#pragma unroll
              for (int q = 0; q < 16; ++q) { const int k = 32 * (wave >> 1) + (q & 3) + 8 * (q >> 2) + 4 * hg; const float m = ((k == kc) ? pl : 0.f) - acc[q];
                  int g, kq, j; ck_kpos(k, g, kq, j); sFR[(ktp * 2 + g) * 512 + (ii + 16 * kq) * 8 + j] = f2bf(m); }
          } else if (wave < 6) {
              const int kc = 32 * (wave - 4) + r32; float av[8], bv[8];
#pragma unroll
              for (int j = 0; j < 8; ++j) { av[j] = r32 < 16 ? sDP[r32 * 17 + 8 * hg + j] : 0.f; bv[j] = sCL[(8 * hg + j) * CKP + kc]; }
              f32x16 acc = __builtin_amdgcn_mfma_f32_32x32x16_bf16(CK_PACK(av), CK_PACK(bv), f32x16{}, 0, 0, 0);
              const int ktp = kc >> 4, ii = kc & 15;
#pragma unroll
              for (int q = 0; q < 8; ++q) { const int t = (q & 3) + 8 * (q >> 2) + 4 * hg; const float nv = sDL[t * CKP + kc] - acc[q];
                  sFR[(8 + ktp) * 512 + (ii + 16 * (t >> 3)) * 8 + (t & 7)] = f2bf(nv); }
          } else {
              const int kr = 32 * (wave - 6) + r32; float av[8], bv[8];
#pragma unroll
              for (int j = 0; j < 8; ++j) { av[j] = sAP[kr * 17 + 8 * hg + j]; bv[j] = r32 < 16 ? sU[2 * 16 * 17 + (8 * hg + j) * 17 + r32] : 0.f; }
              f32x16 acc = __builtin_amdgcn_mfma_f32_32x32x16_bf16(CK_PACK(av), CK_PACK(bv), f32x16{}, 0, 0, 0);
              if (r32 < 16) { const int t = r32;
#pragma unroll
                  for (int q = 0; q < 16; ++q) { const int k = 32 * (wave - 6) + (q & 3) + 8 * (q >> 2) + 4 * hg; const float rv = sRn[t * CKP + k] - acc[q];
                      int g, kq, j; ck_kpos(k, g, kq, j); sFR[(12 + g) * 512 + (t + 16 * kq) * 8 + j] = f2bf(rv); } }
              if (wave == 7) {
                  float ev[8];
#pragma unroll
                  for (int j = 0; j < 8; ++j) ev[j] = r32 < 16 ? sDP[r32 * 17 + 8 * hg + j] : 0.f;
                  f32x16 ae = __builtin_amdgcn_mfma_f32_32x32x16_bf16(CK_PACK(ev), CK_PACK(bv), f32x16{}, 0, 0, 0);
                  if (r32 < 16) { const int t = r32;
#pragma unroll
                      for (int q = 0; q < 8; ++q) { const int i = (q & 3) + 8 * (q >> 2) + 4 * hg; const float e = sU[3 * 16 * 17 + i * 17 + t] - ae[q];
                          sFR[14 * 512 + (t + 16 * (i >> 3)) * 8 + (i & 7)] = f2bf(e); } } } }
#undef CK_PACK
        }
        __syncthreads();
        { u32x4* dst = (u32x4*)(FR + ((size_t)(h * NCK + c) * CK_NFR) * 1024); const LAS u32x4* src = (const LAS u32x4*)sFR;
          for (int i = tid; i < CK_NFR * 64; i += NWAVES * 64) dst[i] = src[i]; }
        __syncthreads();
    }
#undef CK_LOAD
}

constexpr int CK2_FLOATS = 9 * 16 * CKP + 4 * 16 * 17 + 64 * 17 + 16 * 17 + 64;
constexpr int CK2_BYTES = CK2_FLOATS * 4 + CK_NFR * 1024;
static_assert((CK2_FLOATS * 4) % 16 == 0 && CK2_BYTES % 16 == 0 && 2 * CK2_BYTES <= RING_BYTES, "two pre-pass groups fit the LDS ring");
__device__ __forceinline__ void p_rwkv_chunk2(const Frame& F, const Args& A) {
    const bf16* PROJ = WSP(bf16, R_PROJ); const float* LOUT = WSP(float, R_LORAOUT); const float* mu = A.in[I_ABMU];
    const float* w0 = A.in[I_RWW0]; const float* a0 = A.in[I_RWA0]; const float* kk_ = A.in[I_RWKK]; const float* ka_ = A.in[I_RWKA]; const float* rk_ = A.in[I_RWRK];
    float* SV = WSP(float, R_SV); float* BONUS = WSP(float, WS_SMALL + SM_BONUS); unsigned char* FR = WSP(unsigned char, R_FR);
    const int tid = F.tid, lane = F.lane, grp = F.wave >> 2, wl = F.wave & 3, ltid = tid & 255, r32 = lane & 31, hg = lane >> 5;
    LAS float* L = (LAS float*)(F.lds + RING_OFF + grp * CK2_BYTES);
    LAS float* sA = L; LAS float* sP = L + 16 * CKP; LAS float* sB = L + 2 * 16 * CKP; LAS float* sKM = L + 3 * 16 * CKP; LAS float* sRH = L + 4 * 16 * CKP;
    LAS float* sCS = L + 5 * 16 * CKP; LAS float* sDM = L + 6 * 16 * CKP; LAS float* sCL = L + 7 * 16 * CKP; LAS float* sDL = L + 8 * 16 * CKP;
    LAS float* sU = L + 9 * 16 * CKP; LAS float* sAP = sU + 4 * 16 * 17; LAS float* sDP = sAP + 64 * 17; LAS float* sPL = sDP + 16 * 17; LAS bf16* sFR = (LAS bf16*)(sPL + 64);
    for (int i = ltid; i < CK_NFR * 512; i += 256) sFR[i] = 0;
    __syncthreads();
    const int upb = (NH_R * NCK) / F.G;
    float xr[5], xk[5], xv[5], lw[4], la[4], pm[8];
#define CK_LOAD(u_) do { const int c_ = (u_) >> 4, h_ = (u_) & 15, ch_ = 64 * h_ + lane, ta_ = c_ * CK + 4 * wl; \
        pm[0] = mu[ch_]; pm[1] = mu[1024 + ch_]; pm[2] = mu[2048 + ch_]; pm[3] = w0[ch_]; pm[4] = a0[ch_]; pm[5] = kk_[ch_]; pm[6] = ka_[ch_]; pm[7] = rk_[ch_]; \
        if (ta_ > 0) { const bf16* pp = PROJ + (size_t)(ta_ - 1) * AB_PAD; xr[0] = bf2f(pp[ch_]); xk[0] = bf2f(pp[1024 + ch_]); xv[0] = bf2f(pp[2048 + ch_]); } else { xr[0] = 0.f; xk[0] = 0.f; xv[0] = 0.f; } \
        _Pragma("unroll") for (int i = 0; i < 4; ++i) { const bf16* p0 = PROJ + (size_t)(ta_ + i) * AB_PAD; const float* lo = LOUT + (size_t)(ta_ + i) * 3072; \
            xr[1 + i] = bf2f(p0[ch_]); xk[1 + i] = bf2f(p0[1024 + ch_]); xv[1 + i] = bf2f(p0[2048 + ch_]); lw[i] = lo[ch_]; la[i] = lo[1024 + ch_]; } } while (0)
#define CK_PACK(v_) ({ u32x4 p_; p_.x = cvt_pk_bf16(v_[0], v_[1]); p_.y = cvt_pk_bf16(v_[2], v_[3]); p_.z = cvt_pk_bf16(v_[4], v_[5]); p_.w = cvt_pk_bf16(v_[6], v_[7]); __builtin_bit_cast(bf16x8, p_); })
    CK_LOAD(F.vcu * upb + grp);
    for (int ui = 0; ui < upb / 2; ++ui) { const int u = F.vcu * upb + 2 * ui + grp, c = u >> 4, h = u & 15, t0 = c * CK;
        { const int ch = 64 * h + lane; const int ta = t0 + 4 * wl; float pr = xr[0], pk = xk[0], pv = xv[0];
#pragma unroll
          for (int i = 0; i < 4; ++i) { const int t = ta + i, tl = 4 * wl + i;
              const float r = xr[1 + i] + (pr - xr[1 + i]) * pm[0], k = xk[1 + i] + (pk - xk[1 + i]) * pm[1], v = xv[1 + i] + (pv - xv[1 + i]) * pm[2]; pr = xr[1 + i]; pk = xk[1 + i]; pv = xv[1 + i];
              const float w = __expf(-0.6065306597126334f * sigmoidf_(lw[i] + pm[3])), a = sigmoidf_(pm[4] + la[i]);
              float kk = k * pm[5]; const float km = k * (1.0f + (a - 1.0f) * pm[6]);
              const float q1 = wave_sum_dpp(kk * kk), q2 = wave_sum_dpp(r * km * pm[7]);
              kk = kk / fmaxf(sqrtf(q1), 1e-12f);
              sA[tl * CKP + lane] = kk; sP[tl * CKP + lane] = w; sB[tl * CKP + lane] = kk * a; sKM[tl * CKP + lane] = km; sRH[tl * CKP + lane] = r;
              sFR[(15 + (lane >> 4)) * 512 + ((lane & 15) + 16 * (tl >> 3)) * 8 + (tl & 7)] = f2bf(v);
              SV[(size_t)t * 1024 + ch] = v; if (lane == 0) BONUS[t * 16 + h] = q2; } }
        if (ui + 1 < upb / 2) CK_LOAD(u + 2);
        __syncthreads();
        { const int k = ltid & 63;
#pragma unroll
          for (int q = 0; q < 4; ++q) { const int t = (ltid >> 6) * 4 + q; float Pp = 1.f, P = 1.f, PL = 1.f;
#pragma unroll
              for (int i = 0; i < CK; ++i) { const float wv = sP[i * CKP + k]; PL *= wv; if (i < t) Pp *= wv; if (i <= t) P *= wv; }
              const float inv = 1.0f / P, ratio = PL * inv, kkv = sA[t * CKP + k], bv = sB[t * CKP + k], kmv = sKM[t * CKP + k], rv = sRH[t * CKP + k];
              sCS[t * CKP + k] = bv * inv; sDM[t * CKP + k] = kmv * inv; sCL[t * CKP + k] = bv * ratio; sDL[t * CKP + k] = kmv * ratio;
              sA[t * CKP + k] = Pp * kkv; sRH[t * CKP + k] = P * rv; if (t == 0) sPL[k] = PL; } }
        __syncthreads();
        if (wl == 0) { const LAS float* ar = (r32 < 16 ? sCS + r32 * CKP : sDM + (r32 - 16) * CKP); const LAS float* br = (r32 < 16 ? sA + r32 * CKP : sRH + (r32 - 16) * CKP); f32x16 acc = f32x16{};
#pragma unroll
            for (int ks = 0; ks < 4; ++ks) { float av[8], bv[8];
#pragma unroll
                for (int j = 0; j < 8; ++j) { av[j] = ar[16 * ks + 8 * hg + j]; bv[j] = br[16 * ks + 8 * hg + j]; }
                acc = __builtin_amdgcn_mfma_f32_32x32x16_bf16(CK_PACK(av), CK_PACK(bv), acc, 0, 0, 0); }
#pragma unroll
            for (int q = 0; q < 16; ++q) { const int row = (q & 3) + 8 * (q >> 2) + 4 * hg, col = r32, mat = (row >> 4) + 2 * (col >> 4), i = row & 15, t = col & 15;
                const bool keep = (mat & 2) ? (i <= t) : (i < t); sU[mat * 16 * 17 + i * 17 + t] = keep ? acc[q] : 0.f; } }
        __syncthreads();
        if (ltid < 80) { float x[CK]; const bool isA = ltid < 64; const int ri = isA ? ltid : ltid - 64;
#pragma unroll
            for (int t = 0; t < CK; ++t) x[t] = isA ? sA[t * CKP + ri] : sU[1 * 16 * 17 + ri * 17 + t];
#pragma unroll
            for (int jx = 0; jx < CK - 1; ++jx) { float urow[CK];
#pragma unroll
                for (int t = 0; t < CK; ++t) if (t > jx) urow[t] = sU[jx * 17 + t];
#pragma unroll
                for (int t = 0; t < CK; ++t) if (t > jx) x[t] -= x[jx] * urow[t]; }
            LAS float* dst = isA ? sAP + ri * 17 : sDP + ri * 17;
#pragma unroll
            for (int t = 0; t < CK; ++t) dst[t] = x[t]; }
        __syncthreads();
        { { const int kr = 32 * (wl >> 1) + r32, kc = 32 * (wl & 1) + r32; float av[8], bv[8];
#pragma unroll
            for (int j = 0; j < 8; ++j) { av[j] = sAP[kr * 17 + 8 * hg + j]; bv[j] = sCL[(8 * hg + j) * CKP + kc]; }
            const f32x16 acc = __builtin_amdgcn_mfma_f32_32x32x16_bf16(CK_PACK(av), CK_PACK(bv), f32x16{}, 0, 0, 0);
            const float pl = sPL[kc]; const int ktp = kc >> 4, ii = kc & 15;
#pragma unroll
            for (int q = 0; q < 16; ++q) { const int k = 32 * (wl >> 1) + (q & 3) + 8 * (q >> 2) + 4 * hg; const float m = ((k == kc) ? pl : 0.f) - acc[q];
                int g, kq, j; ck_kpos(k, g, kq, j); sFR[(ktp * 2 + g) * 512 + (ii + 16 * kq) * 8 + j] = f2bf(m); } }
          if (wl < 2) {
              const int kc = 32 * wl + r32; float av[8], bv[8];
#pragma unroll
              for (int j = 0; j < 8; ++j) { av[j] = r32 < 16 ? sDP[r32 * 17 + 8 * hg + j] : 0.f; bv[j] = sCL[(8 * hg + j) * CKP + kc]; }
              const f32x16 acc = __builtin_amdgcn_mfma_f32_32x32x16_bf16(CK_PACK(av), CK_PACK(bv), f32x16{}, 0, 0, 0);
              const int ktp = kc >> 4, ii = kc & 15;
#pragma unroll
              for (int q = 0; q < 8; ++q) { const int t = (q & 3) + 8 * (q >> 2) + 4 * hg; const float nv = sDL[t * CKP + kc] - acc[q];
                  sFR[(8 + ktp) * 512 + (ii + 16 * (t >> 3)) * 8 + (t & 7)] = f2bf(nv); }
          } else {
              const int kr = 32 * (wl - 2) + r32; float av[8], bv[8];
#pragma unroll
              for (int j = 0; j < 8; ++j) { av[j] = sAP[kr * 17 + 8 * hg + j]; bv[j] = r32 < 16 ? sU[2 * 16 * 17 + (8 * hg + j) * 17 + r32] : 0.f; }
              const f32x16 acc = __builtin_amdgcn_mfma_f32_32x32x16_bf16(CK_PACK(av), CK_PACK(bv), f32x16{}, 0, 0, 0);
              if (r32 < 16) { const int t = r32;
#pragma unroll
                  for (int q = 0; q < 16; ++q) { const int k = 32 * (wl - 2) + (q & 3) + 8 * (q >> 2) + 4 * hg; const float rv = sRH[t * CKP + k] - acc[q];
                      int g, kq, j; ck_kpos(k, g, kq, j); sFR[(12 + g) * 512 + (t + 16 * kq) * 8 + j] = f2bf(rv); } }
              if (wl == 3) {
                  float ev[8];
#pragma unroll
                  for (int j = 0; j < 8; ++j) ev[j] = r32 < 16 ? sDP[r32 * 17 + 8 * hg + j] : 0.f;
                  const f32x16 ae = __builtin_amdgcn_mfma_f32_32x32x16_bf16(CK_PACK(ev), CK_PACK(bv), f32x16{}, 0, 0, 0);
                  if (r32 < 16) { const int t = r32;
#pragma unroll
                      for (int q = 0; q < 8; ++q) { const int i = (q & 3) + 8 * (q >> 2) + 4 * hg; const float e = sU[3 * 16 * 17 + i * 17 + t] - ae[q];
                          sFR[14 * 512 + (t + 16 * (i >> 3)) * 8 + (i & 7)] = f2bf(e); } } } } }
        __syncthreads();
        { u32x4* dst = (u32x4*)(FR + ((size_t)(h * NCK + c) * CK_NFR) * 1024); const LAS u32x4* src = (const LAS u32x4*)sFR;
          for (int i = ltid; i < CK_NFR * 64; i += 256) dst[i] = src[i]; }
        __syncthreads();
    }
#undef CK_LOAD
#undef CK_PACK
}

constexpr int SQ_SLOT = CK_NFR * 1024, SQ_NSLOT = 7, SQ_AHEAD = 6, SQ_TOUCH = 24;
constexpr bool SQ_TOUCH_ON = false;
static_assert(SQ_SLOT * SQ_NSLOT <= RING_BYTES, "fragment ring fits the LDS ring");
__device__ __forceinline__ void p_rwkv_seq(const Frame& F) {
    const int head = blockIdx.x, vq = F.wave & 3, lane = F.lane, n = lane & 15, q = lane >> 4; const bool worker = F.wave < 4;
    const unsigned char* FRh = WSP(unsigned char, R_FR) + (size_t)head * NCK * CK_NFR * 1024 + lane * 16; float* Y = WSP(float, R_Y) + head * 64 + vq * 16 + n;
    LAS unsigned char* lds = F.lds + RING_OFF;
#define SQ_ISSUE(c_, s_) do { const unsigned char* g_ = FRh + (size_t)(c_) * CK_NFR * 1024; LAS unsigned char* d_ = lds + (s_) * SQ_SLOT; \
        _Pragma("unroll") for (int f = 0; f < 5; ++f) if (vq + 4 * f < CK_NFR) __builtin_amdgcn_global_load_lds((const unsigned*)(g_ + (vq + 4 * f) * 1024), (LAS unsigned*)(d_ + (vq + 4 * f) * 1024), 16, 0, 0); } while (0)
#define SQ_READ(dst, s_) do { const LAS unsigned char* d_ = lds + (s_) * SQ_SLOT + lane * 16; _Pragma("unroll") for (int f = 0; f < 15; ++f) dst[f] = *(const LAS bf16x8*)(d_ + f * 1024); \
        dst[15] = *(const LAS bf16x8*)(d_ + (15 + vq) * 1024); } while (0)
#define SQ_STEP(cur, nxt, c_) do { \
        if (worker) { if ((c_) + SQ_AHEAD >= NCK) asm volatile("s_waitcnt vmcnt(0)" ::: "memory"); else if (vq == 3) asm volatile("s_waitcnt vmcnt(36)" ::: "memory"); else asm volatile("s_waitcnt vmcnt(40)" ::: "memory"); }     \
        else if (SQ_TOUCH_ON && F.wave == 4 && (c_) + SQ_TOUCH < NCK) { const unsigned char* g_ = FRh - lane * 16 + (size_t)((c_) + SQ_TOUCH) * CK_NFR * 1024 + lane * 128; \
            _Pragma("unroll") for (int i_ = 0; i_ < 3; ++i_) if (i_ * 64 + lane < CK_NFR * 8) asm volatile("global_load_dword %0, %1, off" : "+v"(dummy) : "v"(g_ + i_ * 8192) : "memory"); }     \
        __builtin_amdgcn_s_barrier();                                                       \
        if (worker) { \
            if ((c_) + SQ_AHEAD < NCK) { SQ_ISSUE((c_) + SQ_AHEAD, sl_free); } \
            if ((c_) + 1 < NCK) SQ_READ(nxt, sl_next); \
            bf16x8 xb[2]; \
            _Pragma("unroll") for (int g = 0; g < 2; ++g) { u32x4 p; p.x = cvt_pk_bf16(X[2 * g][0], X[2 * g][1]); p.y = cvt_pk_bf16(X[2 * g][2], X[2 * g][3]); p.z = cvt_pk_bf16(X[2 * g + 1][0], X[2 * g + 1][1]); p.w = cvt_pk_bf16(X[2 * g + 1][2], X[2 * g + 1][3]); \
                xb[g] = __builtin_bit_cast(bf16x8, p); } \
            f32x4 y = (f32x4){0.f, 0.f, 0.f, 0.f}; \
            y = __builtin_amdgcn_mfma_f32_16x16x32_bf16(cur[14], cur[15], y, 0, 0, 0); \
            y = __builtin_amdgcn_mfma_f32_16x16x32_bf16(cur[12], xb[0], y, 0, 0, 0); \
            y = __builtin_amdgcn_mfma_f32_16x16x32_bf16(cur[13], xb[1], y, 0, 0, 0); \
            f32x4 Xn[4]; \
            _Pragma("unroll") for (int kt = 0; kt < 4; ++kt) { f32x4 a = (f32x4){0.f, 0.f, 0.f, 0.f}; \
                a = __builtin_amdgcn_mfma_f32_16x16x32_bf16(cur[8 + kt], cur[15], a, 0, 0, 0); \
                a = __builtin_amdgcn_mfma_f32_16x16x32_bf16(cur[2 * kt], xb[0], a, 0, 0, 0); \
                a = __builtin_amdgcn_mfma_f32_16x16x32_bf16(cur[2 * kt + 1], xb[1], a, 0, 0, 0); \
                Xn[kt] = a; } \
            _Pragma("unroll") for (int r = 0; r < 4; ++r) Y[(size_t)((c_) * CK + 4 * q + r) * 1024] = y[r]; \
            _Pragma("unroll") for (int kt = 0; kt < 4; ++kt) X[kt] = Xn[kt]; } \
        sl_free = sl_free == SQ_NSLOT - 1 ? 0 : sl_free + 1; sl_next = sl_next == SQ_NSLOT - 1 ? 0 : sl_next + 1; } while (0)
    f32x4 X[4]; unsigned dummy = 0;
#pragma unroll
    for (int i = 0; i < 4; ++i) X[i] = (f32x4){0.f, 0.f, 0.f, 0.f};
    bf16x8 fa[16], fb[16];
    if (worker) {
#pragma unroll
        for (int c = 0; c < SQ_AHEAD; ++c) SQ_ISSUE(c, c); }
    asm volatile("s_waitcnt vmcnt(0)" ::: "memory");
    __builtin_amdgcn_s_barrier();
    if (worker) SQ_READ(fa, 0);
    int sl_free = SQ_AHEAD, sl_next = 1;
    for (int c = 0; c < NCK; c += 2) { SQ_STEP(fa, fb, c); SQ_STEP(fb, fa, c + 1); }
    asm volatile("s_waitcnt vmcnt(0)" : "+v"(dummy) :: "memory");
#undef SQ_ISSUE
#undef SQ_READ
#undef SQ_STEP
}

constexpr int ML_P = 264;
__device__ __forceinline__ void ml_stage_chunk(const Frame& F, const bf16* src  , int h, int c, LAS bf16* dst) {
    for (int i = F.tid; i < 64 * 32; i += NWAVES * 64) { const int s = i >> 5, ch = i & 31;
        *(LAS u32x4*)(dst + s * ML_P + 8 * ch) = *(const u32x4*)(src + (size_t)(64 * c + s) * 1024 + 256 * h + 8 * ch); }
}
__device__ __forceinline__ void p_mlu(const Frame& F, int first, int stride) {
    const bf16* KB = WSP(bf16, R_KB); const bf16* VB = WSP(bf16, R_VB); const float* BCUM = WSP(float, WS_SMALL + SM_BCUM); const float* IG = WSP(float, WS_SMALL + SM_IG);
    const float* CHBL = WSP(float, WS_SMALL + SM_CHBL); const float* MOUT = WSP(float, WS_SMALL + SM_MOUT);
    bf16* U = WSP(bf16, R_U); float* NU = WSP(float, WS_SMALL + SM_NU);
    LAS bf16* Ks = (LAS bf16*)(F.lds + RING_OFF); LAS bf16* Vs = Ks + 64 * ML_P; LAS float* wst = (LAS float*)(Vs + 64 * ML_P);
    const int lane = F.lane, r = lane & 31, hg = lane >> 5, w = F.wave;
    for (int L = first; L < NH_M * 128; L += stride) { const int h = L >> 7, c = L & 127;
        __syncthreads();
        ml_stage_chunk(F, KB, h, c, Ks); ml_stage_chunk(F, VB, h, c, Vs);
        if (F.tid < 64) wst[F.tid] = __expf(CHBL[h * 128 + c] - BCUM[h * T + 64 * c + F.tid] + IG[h * T + 64 * c + F.tid] - MOUT[h * 128 + c]);
        __syncthreads();
        f32x16 acc[8];
#pragma unroll
        for (int nt = 0; nt < 8; ++nt) acc[nt] = f32x16{};
#pragma unroll
        for (int ks = 0; ks < 4; ++ks) { bf16x8 a; float av[8];
#pragma unroll
            for (int jj = 0; jj < 8; ++jj) { const int s = 16 * ks + 8 * hg + jj; av[jj] = bf2f(Vs[s * ML_P + 32 * w + r]) * wst[s]; }
            { u32x4 p; p.x = cvt_pk_bf16(av[0], av[1]); p.y = cvt_pk_bf16(av[2], av[3]); p.z = cvt_pk_bf16(av[4], av[5]); p.w = cvt_pk_bf16(av[6], av[7]); a = __builtin_bit_cast(bf16x8, p); }
#pragma unroll
            for (int nt = 0; nt < 8; ++nt) { bf16x8 b;
#pragma unroll
                for (int jj = 0; jj < 8; ++jj) b[jj] = (short)Ks[(16 * ks + 8 * hg + jj) * ML_P + 32 * nt + r];
                acc[nt] = __builtin_amdgcn_mfma_f32_32x32x16_bf16(a, b, acc[nt], 0, 0, 0); } }
        bf16* Uo = U + ((size_t)(h * 128 + c) * 256 + 32 * w) * 256;
#pragma unroll
        for (int nt = 0; nt < 8; ++nt)
#pragma unroll
            for (int q = 0; q < 16; ++q) { const int vl = (q & 3) + 8 * (q >> 2) + 4 * hg; Uo[(size_t)vl * 256 + 32 * nt + r] = f2bf(acc[nt][q]); }
        if (F.tid < 256) { float s = 0.f;
            for (int ss = 0; ss < 64; ++ss) s += wst[ss] * bf2f(Ks[ss * ML_P + F.tid]);
            NU[(size_t)(h * 128 + c) * 256 + F.tid] = s; }
    }
}
__device__ __forceinline__ void p_mlscan(const Frame& F) {
    bf16* U = WSP(bf16, R_U); float* NU = WSP(float, WS_SMALL + SM_NU); const float* WCARRY = WSP(float, WS_SMALL + SM_WCARRY);
    const int gt = F.gw * 64 + F.lane, NGT = F.NGW * 64;
    for (int it = gt; it < NH_M * 65536 / 4; it += NGT) { const int h = it >> 14, e = (it & 16383) * 4;
        float C0 = 0.f, C1 = 0.f, C2 = 0.f, C3 = 0.f; bf16* p = U + (size_t)h * 128 * 65536 + e;
#pragma unroll 4
        for (int c = 0; c < 128; ++c) { const u32x2 u = *(const u32x2*)(p + (size_t)c * 65536); const float wc = WCARRY[h * 128 + c];
            u32x2 o; o.x = cvt_pk_bf16(C0, C1); o.y = cvt_pk_bf16(C2, C3); *(u32x2*)(p + (size_t)c * 65536) = o;
            C0 = wc * C0 + bf2f(u.x & 0xffffu); C1 = wc * C1 + bf2f(u.x >> 16); C2 = wc * C2 + bf2f(u.y & 0xffffu); C3 = wc * C3 + bf2f(u.y >> 16); } }
    for (int it = gt; it < NH_M * 256; it += NGT) { const int h = it >> 8, k = it & 255; float n = 0.f; float* p = NU + (size_t)h * 128 * 256 + k;
        for (int c = 0; c < 128; ++c) { const float u = p[c * 256]; p[c * 256] = n; n = WCARRY[h * 128 + c] * n + u; } }
}
__device__ __forceinline__ void p_mlout(const Frame& F, const Args& A) {
    const bf16* QB = WSP(bf16, R_QB); const bf16* KB = WSP(bf16, R_KB); const bf16* VB = WSP(bf16, R_VB); const bf16* CS = WSP(bf16, R_U); const float* NC = WSP(float, WS_SMALL + SM_NU);
    const float* BCUM = WSP(float, WS_SMALL + SM_BCUM); const float* IG = WSP(float, WS_SMALL + SM_IG); const float* MSEQ = WSP(float, WS_SMALL + SM_MSEQ);
    const bf16* PROJ = WSP(bf16, R_PROJ); const float* mhg = A.in[I_MLNG]; bf16* YCAT = WSP(bf16, R_YCAT);
    LAS bf16* Qs = (LAS bf16*)(F.lds + RING_OFF); LAS bf16* Ks = Qs + 64 * ML_P; LAS bf16* Vs = Ks + 64 * ML_P; LAS bf16* Ss = Vs + 64 * ML_P;
    LAS float* fa = (LAS float*)(Ss + 64 * 72); LAS float* bch = fa; LAS float* ich = fa + 64; LAS float* mrow = fa + 128; LAS float* wint = fa + 192; LAS float* rsum = fa + 256  ;
    LAS float* nq = fa + 384; LAS float* nvec = fa + 448  ; LAS float* Hs = (LAS float*)(F.lds + RING_OFF);
    const int lane = F.lane, r = lane & 31, hg = lane >> 5, w = F.wave;
    for (int L = F.vcu; L < NH_M * 128; L += F.G) { const int h = L >> 7, c = L & 127;
        __syncthreads();
        ml_stage_chunk(F, QB, h, c, Qs); ml_stage_chunk(F, KB, h, c, Ks); ml_stage_chunk(F, VB, h, c, Vs);
        if (F.tid < 64) { bch[F.tid] = BCUM[h * T + 64 * c + F.tid]; ich[F.tid] = IG[h * T + 64 * c + F.tid]; }
        if (F.tid < 256) nvec[F.tid] = NC[(size_t)(h * 128 + c) * 256 + F.tid];
        const float mc = MSEQ[h * 128 + c];
        __syncthreads();
        if (w == 0) { float g = ich[lane] - bch[lane];
#pragma unroll
            for (int o = 1; o < 64; o <<= 1) { const float x = __shfl_up(g, o); if (lane >= o) g = fmaxf(g, x); }
            const float mr = bch[lane] + fmaxf(mc, g); mrow[lane] = mr; wint[lane] = __expf(bch[lane] + mc - mr); }
        if (w == 1) { float s = 0.f;
            for (int k = 0; k < 256; ++k) s += nvec[k] * bf2f(Qs[lane * ML_P + k]);
            nq[lane] = s; }
        __syncthreads();
        if (w < 4) { const int st = w & 1, lt = w >> 1; f32x16 acc = f32x16{};
#pragma unroll
            for (int ks = 0; ks < 16; ++ks) { const bf16x8 a = *(const LAS bf16x8*)(Ks + (32 * st + r) * ML_P + 16 * ks + 8 * hg), b = *(const LAS bf16x8*)(Qs + (32 * lt + r) * ML_P + 16 * ks + 8 * hg);
                acc = __builtin_amdgcn_mfma_f32_32x32x16_bf16(a, b, acc, 0, 0, 0); }
            const int l = 32 * lt + r; const float bl_ = bch[l], mr = mrow[l]; float rs = 0.f;
#pragma unroll
            for (int g4 = 0; g4 < 4; ++g4) { float v4[4];
#pragma unroll
                for (int i = 0; i < 4; ++i) { const int s = 32 * st + 8 * g4 + 4 * hg + i; const float d = bl_ - bch[s] + ich[s] - mr;
                    v4[i] = (s <= l) ? acc[4 * g4 + i] * __expf(d) : 0.f; rs += v4[i]; }
                u32x2 p; p.x = cvt_pk_bf16(v4[0], v4[1]); p.y = cvt_pk_bf16(v4[2], v4[3]);
                *(LAS u32x2*)(Ss + l * 72 + 32 * st + 8 * g4 + 4 * hg) = p; }
            rs += __shfl_xor(rs, 32);
            if (hg == 0) rsum[st * 64 + l] = rs; }
        __syncthreads();
        const int lt = w & 1, vg = w >> 1; f32x16 ai[2], aa[2]; ai[0] = f32x16{}; ai[1] = f32x16{}; aa[0] = f32x16{}; aa[1] = f32x16{};
        const bf16* Cb = CS + (size_t)(h * 128 + c) * 65536;
#pragma unroll 4
        for (int ks = 0; ks < 16; ++ks) { const bf16x8 a = *(const LAS bf16x8*)(Qs + (32 * lt + r) * ML_P + 16 * ks + 8 * hg);
#pragma unroll
            for (int jt = 0; jt < 2; ++jt) { const bf16x8 b = *(const bf16x8*)(Cb + (size_t)(64 * vg + 32 * jt + r) * 256 + 16 * ks + 8 * hg);
                ai[jt] = __builtin_amdgcn_mfma_f32_32x32x16_bf16(a, b, ai[jt], 0, 0, 0); } }
#pragma unroll
        for (int ks = 0; ks < 4; ++ks) { const bf16x8 a = *(const LAS bf16x8*)(Ss + (32 * lt + r) * 72 + 16 * ks + 8 * hg);
#pragma unroll
            for (int jt = 0; jt < 2; ++jt) { bf16x8 b;
#pragma unroll
                for (int jj = 0; jj < 8; ++jj) b[jj] = (short)Vs[(16 * ks + 8 * hg + jj) * ML_P + 64 * vg + 32 * jt + r];
                aa[jt] = __builtin_amdgcn_mfma_f32_32x32x16_bf16(a, b, aa[jt], 0, 0, 0); } }
        __syncthreads();
#pragma unroll
        for (int q = 0; q < 16; ++q) { const int l = 32 * lt + (q & 3) + 8 * (q >> 2) + 4 * hg; const float wi = wint[l];
            const float den = rsum[l] + rsum[64 + l] + wi * nq[l]; const float dn = 1.0f / fmaxf(fabsf(den), __expf(-mrow[l]));
#pragma unroll
            for (int jt = 0; jt < 2; ++jt) Hs[l * 260 + 64 * vg + 32 * jt + r] = (aa[jt][q] + wi * ai[jt][q]) * dn; }
        __syncthreads();
        for (int i = 0; i < 8; ++i) { const int l = 8 * w + i, t = 64 * c + l; const f32x4 hv = *(const LAS f32x4*)(Hs + l * 260 + 4 * lane);
            const float ss = wave_sum((hv[0] * hv[0] + hv[1] * hv[1]) + (hv[2] * hv[2] + hv[3] * hv[3])); const float rn = 1.0f / sqrtf(ss * (1.0f / 256.0f) + 1e-6f);
            const f32x4 g = *(const f32x4*)(mhg + 256 * h + 4 * lane); const u32x2 ob = *(const u32x2*)(PROJ + (size_t)t * AB_PAD + 6592 + 256 * h + 4 * lane);
            const float o0 = hv[0] * rn * g[0] * sigmoidf_(bf2f(ob.x & 0xffffu)), o1 = hv[1] * rn * g[1] * sigmoidf_(bf2f(ob.x >> 16));
            const float o2 = hv[2] * rn * g[2] * sigmoidf_(bf2f(ob.y & 0xffffu)), o3 = hv[3] * rn * g[3] * sigmoidf_(bf2f(ob.y >> 16));
            u32x2 p; p.x = cvt_pk_bf16(o0, o1); p.y = cvt_pk_bf16(o2, o3);
            *(u32x2*)(YCAT + (size_t)t * D + 1024 + 256 * h + 4 * lane) = p; }
    }
}

struct XsOrder {
    const bf16* XQ; const bf16* KM; int G, c;
    __device__ __forceinline__ bool next(int i, pg8::Unit& u) const {
        const int L = i * G + c; if (L >= 32 * 4) return false;
        const int pm = L >> 2, hd = L & 3; u.pm = pm; u.pn = 0; u.aux = hd; u.pad = 0;
        u.a = (const char*)(XQ + (size_t)pm * 256 * D + 512 * hd); u.b = (const char*)(KM + 512 * hd); return true;
    }
};
struct XpvOrder {
    const bf16* XP; const bf16* VT; int G, c;
    __device__ __forceinline__ bool next(int i, pg8::Unit& u) const {
        int pm, pn; if (!pg8::static_tile(i, G, c, 32, 8, pm, pn)) return false;
        u.pm = pm; u.pn = pn; u.aux = 0; u.pad = 0;
        u.a = (const char*)(XP + (size_t)pm * 256 * 1024 + 256 * (pn >> 1)); u.b = (const char*)(VT + (size_t)pn * 256 * NMEM); return true;
    }
};
__device__ __forceinline__ void p_xsoftmax(const Frame& F) {
    const float* XS = WSP(float, R_XS); bf16* XP = WSP(bf16, R_XP); const int lane = F.lane;
    for (int t = F.gw; t < T; t += F.NGW)
#pragma unroll
        for (int hd = 0; hd < 4; ++hd) { const f32x4 s = *(const f32x4*)(XS + (size_t)t * 1024 + 256 * hd + 4 * lane);
            const float m = wave_max(fmaxf(fmaxf(s[0], s[1]), fmaxf(s[2], s[3])));
            const float e0 = __expf(s[0] - m), e1 = __expf(s[1] - m), e2 = __expf(s[2] - m), e3 = __expf(s[3] - m);
            const float inv = 1.0f / wave_sum((e0 + e1) + (e2 + e3));
            u32x2 p; p.x = cvt_pk_bf16(e0 * inv, e1 * inv); p.y = cvt_pk_bf16(e2 * inv, e3 * inv);
            *(u32x2*)(XP + (size_t)t * 1024 + 256 * hd + 4 * lane) = p; }
}

__device__ __forceinline__ void p_norm_fpre(const Frame& F, const Args& A) {
    LAS float* Ws = (LAS float*)(F.lds + RING_OFF);
    stage_skinny<16>(F, A.in[I_FOXWIN], FOX_LD, 8192, Ws);
    __syncthreads();
    const float* X = WSP(float, WS_X); bf16* XN = WSP(bf16, WS_XN); float* FPRE = WSP(float, WS_SMALL + SM_FPRE); const float* g = A.in[I_NMIXG] + D;
    for (int t = F.gw; t < T; t += F.NGW) { f32x4 y[8]; rms_row(X + (size_t)t * D, g, XN + (size_t)t * D, F.lane, y);
        float o[16]; skinny_dot<16>(y, Ws, F.lane, o);
        if (F.lane < 16) { float v = o[0];
#pragma unroll
            for (int c = 1; c < 16; ++c) v = (F.lane == c) ? o[c] : v;
            FPRE[t * 16 + F.lane] = v; } }
    __syncthreads();
}
__device__ __forceinline__ void p_foxprep(const Frame& F, const Args& A) {
    bf16* QKVG = WSP(bf16, R_QKVG); const float* qg = A.in[I_FOXQG]; const float* kg = A.in[I_FOXKG]; const int lane = F.lane;
    for (int it = F.gw; it < 2 * T; it += F.NGW) { const int t = it >> 1, sec = it & 1; const float* gg = sec ? kg : qg; const float g0 = gg[2 * lane], g1 = gg[2 * lane + 1];
        unsigned* row = (unsigned*)(QKVG + (size_t)t * 8192 + sec * 2048) + lane;
#pragma unroll 4
        for (int h = 0; h < NH_F; ++h) { const unsigned u = row[64 * h]; const float a = bf2f(u & 0xffffu), b = bf2f(u >> 16);
            const float rn = 1.0f / sqrtf(wave_sum(a * a + b * b) * (1.0f / 128.0f) + 1e-6f);
            row[64 * h] = cvt_pk_bf16(a * rn * g0, b * rn * g1); } }
    if (F.gw < NH_F) { const int h = F.gw; const float* FPRE = WSP(float, WS_SMALL + SM_FPRE); float* BL = WSP(float, WS_SMALL + SM_BIASL2); const float bf = A.in[I_FOXBF][h];
        float carry = 0.f;
        for (int c0 = 0; c0 < 128; c0 += 16) { float v[16];
#pragma unroll
            for (int i = 0; i < 16; ++i) v[i] = FPRE[(size_t)(64 * (c0 + i) + lane) * 16 + h];
#pragma unroll
            for (int i = 0; i < 16; ++i) { float b = logsigmoidf_(v[i] + bf);
#pragma unroll
                for (int o = 1; o < 64; o <<= 1) { const float x = __shfl_up(b, o); if (lane >= o) b += x; }
                b += carry; BL[h * T + 64 * (c0 + i) + lane] = -1.4426950408889634f * b; carry = __shfl(b, 63); } } }
}
__device__ __forceinline__ void p_foxattn(const Frame& F) {
    const bf16* QKVG = WSP(bf16, R_QKVG); bf16* ATTO = WSP(bf16, R_ATTO); const float* BL = WSP(float, WS_SMALL + SM_BIASL2);
    char* lds = (char*)F.ldsg + RING_OFF;
    for (int L = F.vcu; L < 256; L += F.G) { const int h = L >> 4, x = L & 15;
        __syncthreads();
        { float* bl = (float*)(lds + fox::BIAS_OFF); for (int i = F.tid; i < T / 4; i += NWAVES * 64) *(f32x4*)(bl + 4 * i) = *(const f32x4*)(BL + (size_t)h * T + 4 * i); }
        fox::BlockRef b0, b1; const int q0 = x, q1 = 31 - x;
        b0.Q = QKVG + (size_t)q0 * 256 * 8192 + 128 * h; b0.K = QKVG + 2048 + 128 * h; b0.V = QKVG + 4096 + 128 * h; b0.G = QKVG + (size_t)q0 * 256 * 8192 + 6144 + 128 * h;
        b0.O = ATTO + (size_t)q0 * 256 * D + 128 * h; b0.P0 = q0 * 256;
        b1 = b0; b1.Q = QKVG + (size_t)q1 * 256 * 8192 + 128 * h; b1.G = QKVG + (size_t)q1 * 256 * 8192 + 6144 + 128 * h; b1.O = ATTO + (size_t)q1 * 256 * D + 128 * h; b1.P0 = q1 * 256;
        fox::Seam S;
        fox::prime(b0, lds, S);
#ifdef FOX_LOOP
        for (int pass = 0; pass < 2; ++pass) { fox::block(b0, b1, lds, S); b0 = b1; }
#else
        fox::block(b0, b1, lds, S);
        fox::block(b1, b1, lds, S);
#endif
    }
}

__device__ __forceinline__ void p_norm_route(const Frame& F, const Args& A) {
    LAS float* Ws = (LAS float*)(F.lds + RING_OFF); LAS int* cnt = (LAS int*)(F.lds + RING_OFF + 8 * D * 4);
    stage_skinny<8>(F, A.in[I_ROUTER], NEXP, 0, Ws);
    if (F.tid < 8) cnt[F.tid] = 0;
    __syncthreads();
    const float* X = WSP(float, WS_X); bf16* XN = WSP(bf16, WS_XN); const float* g = A.in[I_NFFNG] + D;
    int* TOPI = WSP(int, WS_SMALL + SM_TOPI); float* TOPG = WSP(float, WS_SMALL + SM_TOPG); int* BLKCNT = WSP(int, WS_SMALL + SM_BLKCNT);
    const int b = blockIdx.x;
    for (int i = 0; i < 4; ++i) { const int t = 32 * b + 4 * F.wave + i; f32x4 y[8]; rms_row(X + (size_t)t * D, g, XN + (size_t)t * D, F.lane, y);
        float o[8]; skinny_dot<8>(y, Ws, F.lane, o);
        int i1 = 0; float v1 = o[0];
#pragma unroll
        for (int e = 1; e < 8; ++e) if (o[e] > v1) { v1 = o[e]; i1 = e; }
        int i2 = -1; float v2 = -__builtin_inff();
#pragma unroll
        for (int e = 0; e < 8; ++e) if (e != i1 && o[e] > v2) { v2 = o[e]; i2 = e; }
        const float e2 = __expf(v2 - v1), g1 = 1.0f / (1.0f + e2), g2 = e2 * g1;
        if (F.lane == 0) { TOPI[2 * t] = i1; TOPI[2 * t + 1] = i2; TOPG[2 * t] = g1; TOPG[2 * t + 1] = g2; __hip_atomic_fetch_add(&cnt[i1], 1, __ATOMIC_RELAXED, __HIP_MEMORY_SCOPE_WORKGROUP); __hip_atomic_fetch_add(&cnt[i2], 1, __ATOMIC_RELAXED, __HIP_MEMORY_SCOPE_WORKGROUP); } }
    __syncthreads();
    if (F.tid < 8) BLKCNT[b * 8 + F.tid] = cnt[F.tid];
}
__device__ __forceinline__ void p_route2(const Frame& F) {
    LAS int* sh = (LAS int*)(F.lds + RING_OFF);
    const int* BLKCNT = WSP(int, WS_SMALL + SM_BLKCNT); const int* TOPI = WSP(int, WS_SMALL + SM_TOPI); int* SLOT = WSP(int, WS_SMALL + SM_SLOT); int* TILEE = WSP(int, WS_SMALL + SM_TILEE);
    const bf16* XN = WSP(bf16, WS_XN); bf16* AG = WSP(bf16, R_AG); const int b = blockIdx.x;
    __syncthreads();
    if (F.tid < 8) { int tot = 0, pre = 0; for (int bb = 0; bb < 256; ++bb) { const int v = BLKCNT[bb * 8 + F.tid]; if (bb < b) pre += v; tot += v; } sh[F.tid] = tot; sh[8 + F.tid] = pre; }
    __syncthreads();
    if (F.tid == 0) { int off = 0, nt = 0; for (int e = 0; e < 8; ++e) { sh[16 + e] = off; const int n = (sh[e] + 255) >> 8; if (b == 0) for (int i = 0; i < n; ++i) TILEE[1 + nt + i] = e; nt += n; off += n * 256; } if (b == 0) TILEE[0] = nt; }
    __syncthreads();
    if (F.wave == 0) { const int t = 32 * b + (F.lane >> 1), e = TOPI[2 * t + (F.lane & 1)]; int rank = 0;
#pragma unroll
        for (int ee = 0; ee < 8; ++ee) { const unsigned long long m = __ballot(e == ee); if (e == ee) rank = __popcll(m & ((1ull << F.lane) - 1ull)); }
        const int slot = sh[16 + e] + sh[8 + e] + rank; SLOT[2 * t + (F.lane & 1)] = slot; sh[32 + F.lane] = slot; }
    __syncthreads();
    for (int p = F.wave; p < 64; p += NWAVES) { const int t = 32 * b + (p >> 1), slot = sh[32 + p]; const u32x4* src = (const u32x4*)(XN + (size_t)t * D); u32x4* dst = (u32x4*)(AG + (size_t)slot * D);
#pragma unroll
        for (int j = 0; j < 4; ++j) dst[F.lane + 64 * j] = src[F.lane + 64 * j]; }
}
struct MoeOrder {
    const bf16* Arows; const bf16* W; const int* tilee; int lda, nN; size_t wstride; int G, c; bool whole_rounds;
    __device__ __forceinline__ bool next(int i, pg8::Unit& u) const {
        const int nt = tilee[0]; const long L = (long)i * G + c; long nu = (long)nt * nN; if (whole_rounds) nu = (nu / G) * G; if (L >= nu) return false;
        const int ti = (int)(L / nN), pn = (int)(L % nN), e = tilee[1 + ti];
        u.pm = ti; u.pn = pn; u.aux = e; u.pad = 0; u.a = (const char*)(Arows + (size_t)ti * 256 * lda); u.b = (const char*)(W + (size_t)e * wstride + (size_t)pn * 256 * lda); return true;
    }
};
constexpr int MOE_KSPLIT = 4;
struct MoeSplitOrder {
    const bf16* Arows; const bf16* W; const int* tilee; int lda, nN, kslice; size_t wstride; int G, c;
    __device__ __forceinline__ bool next(int i, pg8::Unit& u) const {
        const int nt = tilee[0]; const long nu = (long)nt * nN, nfull = (nu / G) * G; const long L = (long)i * G + c; if (L >= (nu - nfull) * MOE_KSPLIT) return false;
        const long j = nfull + L / MOE_KSPLIT; const int kq = (int)(L % MOE_KSPLIT); const int ti = (int)(j / nN), pn = (int)(j % nN), e = tilee[1 + ti];
        u.pm = ti; u.pn = pn; u.aux = kq; u.pad = 0; u.a = (const char*)(Arows + (size_t)ti * 256 * lda + (size_t)kq * kslice); u.b = (const char*)(W + (size_t)e * wstride + (size_t)pn * 256 * lda + (size_t)kq * kslice); return true;
    }
};
__device__ __forceinline__ void p_final(const Frame& F, const Args& A) {
    const float* X = WSP(float, WS_X); const float* YG = WSP(float, R_YG); const float* YS = WSP(float, R_YSIDE); const int* SLOT = WSP(int, WS_SMALL + SM_SLOT); const float* TOPG = WSP(float, WS_SMALL + SM_TOPG);
    const float* g = A.in[I_FING]; const int lane = F.lane;
    const int nt = WSP(int, WS_SMALL + SM_TILEE)[0]; const int srow0 = (((nt * 8) / F.G) * F.G / 8) * 256;
    for (int t = F.gw; t < T; t += F.NGW) { const int s1 = SLOT[2 * t], s2 = SLOT[2 * t + 1]; const float g1 = TOPG[2 * t], g2 = TOPG[2 * t + 1];
        const f32x4* xr = (const f32x4*)(X + (size_t)t * D) + lane; const f32x4* y1 = (const f32x4*)(YG + (size_t)s1 * D) + lane; const f32x4* y2 = (const f32x4*)(YG + (size_t)s2 * D) + lane;
        f32x4 v[8]; float s = 0.f;
#pragma unroll
        for (int j = 0; j < 8; ++j) { f32x4 a = y1[64 * j], b = y2[64 * j];
            if (s1 >= srow0) { const f32x4* p = (const f32x4*)(YS + (size_t)(s1 - srow0) * D) + lane + 64 * j; a = a + ((p[0] + p[YSIDE_STRIDE / 4]) + p[2 * (YSIDE_STRIDE / 4)]); }
            if (s2 >= srow0) { const f32x4* p = (const f32x4*)(YS + (size_t)(s2 - srow0) * D) + lane + 64 * j; b = b + ((p[0] + p[YSIDE_STRIDE / 4]) + p[2 * (YSIDE_STRIDE / 4)]); }
            v[j] = xr[64 * j] + (a * g1 + b * g2); s += (v[j][0] * v[j][0] + v[j][1] * v[j][1]) + (v[j][2] * v[j][2] + v[j][3] * v[j][3]); }
        const float r = 1.0f / sqrtf(wave_sum(s) * (1.0f / D) + 1e-6f); f32x4* o = (f32x4*)(A.out + (size_t)t * D) + lane;
#pragma unroll
        for (int j = 0; j < 8; ++j) o[64 * j] = v[j] * r * ((const f32x4*)g)[lane + 64 * j]; }
}

enum Phase { PH_CONV = 0, PH_INPROJ0, PH_PREPA, PH_LORA, PH_PREPB, PH_SCAN, PH_MLSCAN, PH_MLOUT, PH_OUTPROJ0,
             PH_NORMX0, PH_XQ0, PH_XS0, PH_XSM0, PH_XPV0, PH_XO0, PH_NORMF0, PH_FFNGU, PH_FFND,
             PH_NORMM1, PH_FOXIN, PH_FOXPREP, PH_FOXATT, PH_FOXOUT,
             PH_NORMX1, PH_XQ1, PH_XS1, PH_XSM1, PH_XPV1, PH_XO1, PH_NORMF1, PH_ROUTE2, PH_MOEGU, PH_MOED, PH_FINAL, N_PHASES };

__global__ void __launch_bounds__(NWAVES * 64, 2) trunk_fwd(Args A) {
    extern __shared__ __attribute__((aligned(16))) unsigned char lds[];
    Frame F;
    F.lds = (LAS unsigned char*)lds; F.ldsg = lds; F.ws = A.ws;
    F.tid = threadIdx.x; F.lane = F.tid & 63; F.wave = __builtin_amdgcn_readfirstlane(F.tid >> 6);
    F.G = gridDim.x; { const int bx = blockIdx.x; F.vcu = (F.G % 8 == 0) ? (bx % 8) * (F.G / 8) + bx / 8 : bx; }
    F.gw = F.vcu * NWAVES + F.wave; F.NGW = F.G * NWAVES;
    volatile LAS unsigned* MISC = (volatile LAS unsigned*)(F.lds + MISC_OFF);
    for (int u = F.tid; u < (LDS_BYTES - LDSCTL_OFF) / 4; u += NWAVES * 64) ((LAS unsigned*)(F.lds + LDSCTL_OFF))[u] = 0u;
    __syncthreads();
    const int lo = A.ph_lo, hi = A.ph_hi;
    const bool multi = (hi - lo) > 1;
    XcdBarrier bar; bar.bar = (unsigned*)(A.ws + WS_CTL) + CW_BAR; bar.x = 0; bar.st = nullptr;
    if (multi) bar = xcd_barrier_post((unsigned*)(A.ws + WS_CTL) + CW_BAR, MISC + 8);
#ifndef PH_ENABLE
#define PH_ENABLE 0xFFFFFFFFFFFFFFFFull
#endif
#define IN(k) ((((PH_ENABLE) >> (k)) & 1ull) && lo <= (k) && (k) < hi)
#ifndef PROBE_DUP
#define PROBE_DUP 0ull
#endif
#define DUP(k) if ((((PROBE_DUP) >> (k)) & 1ull) != 0ull)
#define SEAM(k) do { if (IN(k) && IN((k) + 1)) xcd_barrier(bar); } while (0)
    LAS unsigned char* ring = F.lds + RING_OFF;
    const int cb = (int)blockIdx.x;
    float* const SSQ = (float*)(A.ws + WS_CTL + CTL_SSQ);

    constexpr int MOE_E_EARLY = 0;
    if (IN(PH_CONV)) { p_convert_early(F, A); if (MOE_E_EARLY > 0) p_convert_late(F, A, F.gw, F.NGW, (LAS float*)(F.lds + RING_OFF + F.wave * 16384), false, 0, MOE_E_EARLY); } SEAM(PH_CONV);
    if (IN(PH_INPROJ0)) { InprojKvOrder S{WSP(bf16, WS_XN), WSP(bf16, WS_W_ABIN), WSP(bf16, WS_MEMN), WSP(bf16, WS_W_XKV), F.G, cb};
        EpiInprojKv E{WSP(bf16, R_PROJ), WSP(float, R_GATES32), WSP(bf16, WS_KMEM), WSP(bf16, WS_VTMEM)};
        pg8::gemm_phase<EpiInprojKv, InprojKvOrder, true>(ring, pg8::Gemm{D, D, D}, S, E); } SEAM(PH_INPROJ0);
    if (IN(PH_PREPA)) { p_prepa(F, A); DUP(PH_PREPA) { __syncthreads(); p_prepa(F, A); } } SEAM(PH_PREPA);
    if (IN(PH_LORA)) { pg8::PlainOrder S{WSP(bf16, R_LORAIN), WSP(bf16, WS_W_LORA), 512, 512, 32, 12, F.G, cb}; pg8::EpiF32 E{WSP(float, R_LORAOUT), 3072, 0, 1.0f};
        pg8::gemm_phase<pg8::EpiF32, pg8::PlainOrder, true>(ring, pg8::Gemm{512, 512, 512}, S, E);
        p_mlstm_pass2(F, cb == (int)F.G - 1 && F.wave < NH_M, F.wave); } SEAM(PH_LORA);
    if (IN(PH_PREPB)) { p_rwkv_chunk2(F, A); DUP(PH_PREPB) { __syncthreads(); p_rwkv_chunk2(F, A); } } SEAM(PH_PREPB);
    if (IN(PH_SCAN)) {
        if (cb < 16) p_rwkv_seq(F);
        else { p_mlu(F, cb - 16, F.G - 16); __syncthreads(); p_convert_late(F, A, (cb - 16) * NWAVES + F.wave, (F.G - 16) * NWAVES, (LAS float*)(F.lds + RING_OFF + F.wave * 16384), true, MOE_E_EARLY, NEXP); }
        DUP(62) { __syncthreads(); if (cb < 16) p_rwkv_seq(F); } } SEAM(PH_SCAN);
    if (IN(PH_MLSCAN)) { p_mlscan(F); p_rwkv_post(F, A); DUP(PH_MLSCAN) { __syncthreads(); p_rwkv_post(F, A); } } SEAM(PH_MLSCAN);
    if (IN(PH_MLOUT)) { p_mlout(F, A); DUP(PH_MLOUT) { __syncthreads(); p_mlout(F, A); } } SEAM(PH_MLOUT);
    if (IN(PH_OUTPROJ0)) { pg8::PlainOrder S{WSP(bf16, R_YCAT), WSP(bf16, WS_W_ABOUT), D, D, 32, 8, F.G, cb}; pg8::EpiResid E{A.in[I_X], WSP(float, WS_X), D, nullptr, nullptr, nullptr};
        pg8::gemm_phase<pg8::EpiResid, pg8::PlainOrder, false>(ring, pg8::Gemm{D, D, D}, S, E); } SEAM(PH_OUTPROJ0);
#define XATTN(l, P_NORM, P_Q, P_S, P_SM, P_PV, P_O, SSQ_IN, XN_OUT, G_OUT, SSQ_OUT) \
    if (IN(P_NORM)) { norm_phase(F, WSP(float, WS_X), A.in[I_NXAG] + (l) * D, WSP(bf16, WS_XN), T); } SEAM(P_NORM); \
    if (IN(P_Q)) { pg8::PlainOrder S{WSP(bf16, WS_XN), WSP(bf16, WS_W_XQ) + (size_t)(l) * D * D, D, D, 32, 8, F.G, cb}; pg8::EpiBf16 E{WSP(bf16, R_XQ), D, nullptr, -1, SSQ_IN}; \
        pg8::gemm_phase<pg8::EpiBf16, pg8::PlainOrder, false>(ring, pg8::Gemm{D, D, D}, S, E); } SEAM(P_Q); \
    if (IN(P_S)) { XsOrder S{WSP(bf16, R_XQ), WSP(bf16, WS_KMEM) + (size_t)(l) * NMEM * D, F.G, cb}; pg8::EpiF32 E{WSP(float, R_XS), 1024, 256, 0.044194173824159216f}; \
        pg8::gemm_phase<pg8::EpiF32, XsOrder, false>(ring, pg8::Gemm{D, D, 512}, S, E); } SEAM(P_S); \
    if (IN(P_SM)) { p_xsoftmax(F); DUP(P_SM) { p_xsoftmax(F); } } SEAM(P_SM); \
    if (IN(P_PV)) { XpvOrder S{WSP(bf16, R_XP), WSP(bf16, WS_VTMEM) + (size_t)(l) * D * NMEM, F.G, cb}; pg8::EpiBf16 E{WSP(bf16, R_XO), D, nullptr, -1, nullptr}; \
        pg8::gemm_phase<pg8::EpiBf16, XpvOrder, false>(ring, pg8::Gemm{1024, NMEM, 256}, S, E); } SEAM(P_PV); \
    if (IN(P_O)) { pg8::PlainOrder S{WSP(bf16, R_XO), WSP(bf16, WS_W_XO) + (size_t)(l) * D * D, D, D, 32, 8, F.G, cb}; pg8::EpiResid E{WSP(float, WS_X), WSP(float, WS_X), D, XN_OUT, G_OUT, SSQ_OUT}; \
        pg8::gemm_phase<pg8::EpiResid, pg8::PlainOrder, false>(ring, pg8::Gemm{D, D, D}, S, E); } SEAM(P_O);

    XATTN(0, PH_NORMX0, PH_XQ0, PH_XS0, PH_XSM0, PH_XPV0, PH_XO0, (const float*)nullptr, (bf16*)nullptr, (const float*)nullptr, (float*)nullptr)
    if (IN(PH_NORMF0)) { norm_phase(F, WSP(float, WS_X), A.in[I_NFFNG], WSP(bf16, WS_XN), T); } SEAM(PH_NORMF0);
    if (IN(PH_FFNGU)) { pg8::PlainOrder S{WSP(bf16, WS_XN), WSP(bf16, WS_W_FFNGU), D, D, 32, 44, F.G, cb}; pg8::EpiSwiGLU E{WSP(bf16, R_ACT), DFF, nullptr};
        pg8::gemm_phase<pg8::EpiSwiGLU, pg8::PlainOrder, true>(ring, pg8::Gemm{D, D, D}, S, E); DUP(PH_FFNGU) { pg8::gemm_phase<pg8::EpiSwiGLU, pg8::PlainOrder, true>(ring, pg8::Gemm{D, D, D}, S, E); } } SEAM(PH_FFNGU);
    if (IN(PH_FFND)) { pg8::PlainOrder S{WSP(bf16, R_ACT), WSP(bf16, WS_W_FFND), DFF, DFF, 32, 8, F.G, cb}; pg8::EpiResid E{WSP(float, WS_X), WSP(float, WS_X), D, nullptr, nullptr, nullptr};
        pg8::gemm_phase<pg8::EpiResid, pg8::PlainOrder, false>(ring, pg8::Gemm{DFF, DFF, DFF}, S, E); } SEAM(PH_FFND);
    if (IN(PH_NORMM1)) { p_norm_fpre(F, A); DUP(PH_NORMM1) { p_norm_fpre(F, A); } } SEAM(PH_NORMM1);
    if (IN(PH_FOXIN)) { pg8::PlainOrder S{WSP(bf16, WS_XN), WSP(bf16, WS_W_FOXIN), D, D, 32, 32, F.G, cb}; pg8::EpiBf16 E{WSP(bf16, R_QKVG), 8192, nullptr, -1, nullptr};
        pg8::gemm_phase<pg8::EpiBf16, pg8::PlainOrder, true>(ring, pg8::Gemm{D, D, D}, S, E); DUP(PH_FOXIN) { pg8::gemm_phase<pg8::EpiBf16, pg8::PlainOrder, true>(ring, pg8::Gemm{D, D, D}, S, E); } } SEAM(PH_FOXIN);
    if (IN(PH_FOXPREP)) { p_foxprep(F, A); } SEAM(PH_FOXPREP);
    if (IN(PH_FOXATT)) { p_foxattn(F); DUP(PH_FOXATT) { __syncthreads(); p_foxattn(F); } } SEAM(PH_FOXATT);
    if (IN(PH_FOXOUT)) { pg8::PlainOrder S{WSP(bf16, R_ATTO), WSP(bf16, WS_W_FOXOUT), D, D, 32, 8, F.G, cb}; pg8::EpiResid E{WSP(float, WS_X), WSP(float, WS_X), D, nullptr, nullptr, nullptr};
        pg8::gemm_phase<pg8::EpiResid, pg8::PlainOrder, false>(ring, pg8::Gemm{D, D, D}, S, E); } SEAM(PH_FOXOUT);
    XATTN(1, PH_NORMX1, PH_XQ1, PH_XS1, PH_XSM1, PH_XPV1, PH_XO1, (const float*)nullptr, (bf16*)nullptr, (const float*)nullptr, (float*)nullptr)
    if (IN(PH_NORMF1)) { p_norm_route(F, A); } SEAM(PH_NORMF1);
    if (IN(PH_ROUTE2)) { p_route2(F); } SEAM(PH_ROUTE2);
    if (IN(PH_MOEGU)) { MoeOrder S{WSP(bf16, R_AG), WSP(bf16, WS_W_MOEGU), WSP(int, WS_SMALL + SM_TILEE), D, 44, (size_t)2 * DFF * D, F.G, cb, false}; pg8::EpiSwiGLU E{WSP(bf16, R_ACTG), DFF, nullptr};
        pg8::gemm_phase<pg8::EpiSwiGLU, MoeOrder, true>(ring, pg8::Gemm{D, D, D}, S, E); } SEAM(PH_MOEGU);
    if (IN(PH_MOED)) {
        { MoeOrder S{WSP(bf16, R_ACTG), WSP(bf16, WS_W_MOED), WSP(int, WS_SMALL + SM_TILEE), DFF, 8, (size_t)D * DFF, F.G, cb, true}; pg8::EpiF32 E{WSP(float, R_YG), D, 0, 1.0f};
          pg8::gemm_phase<pg8::EpiF32, MoeOrder, true>(ring, pg8::Gemm{DFF, DFF, DFF}, S, E); }
        { MoeSplitOrder S{WSP(bf16, R_ACTG), WSP(bf16, WS_W_MOED), WSP(int, WS_SMALL + SM_TILEE), DFF, 8, DFF / MOE_KSPLIT, (size_t)D * DFF, F.G, cb}; const int nt_ = WSP(int, WS_SMALL + SM_TILEE)[0]; pg8::EpiF32Split E{WSP(float, R_YG), WSP(float, R_YSIDE), YSIDE_STRIDE, D, ((nt_ * 8) / F.G) * F.G / 8};
          pg8::gemm_phase<pg8::EpiF32Split, MoeSplitOrder, false>(ring, pg8::Gemm{DFF, DFF, DFF / MOE_KSPLIT}, S, E); } } SEAM(PH_MOED);
    if (IN(PH_FINAL)) { p_final(F, A); }
#undef XATTN
#undef IN
#undef SEAM
}

#ifndef MK_ONE_LAUNCH
#define MK_ONE_LAUNCH 1
#endif
extern "C" void kernel_launch(void* const* d_in, const int* in_sizes, int n_in, void* d_out, int out_size, void* d_ws, size_t ws_size, hipStream_t stream) {
    static int ready = 0;
    if (ready == 0) {
        if (n_in != N_IN || in_sizes[0] != T * D || out_size != T * D || ws_size < WS_END) {
            fprintf(stderr, "kernel_launch: built for %d inputs, x/out of %d floats, >= %zu bytes of workspace; got n_in %d, in0 %d, out %d, ws %zu; nothing launched\n", N_IN, T * D, (size_t)WS_END, n_in, n_in > 0 ? in_sizes[0] : -1, out_size, ws_size);
            ready = -1; return; }
        if (hipFuncSetAttribute((const void*)trunk_fwd, hipFuncAttributeMaxDynamicSharedMemorySize, LDS_BYTES) != hipSuccess) { fprintf(stderr, "kernel_launch: hipFuncSetAttribute failed\n"); ready = -1; return; }
        int per_cu = 0;
        if (hipOccupancyMaxActiveBlocksPerMultiprocessor(&per_cu, (const void*)trunk_fwd, NWAVES * 64, LDS_BYTES) != hipSuccess || per_cu < 1)
            fprintf(stderr, "kernel_launch: note: occupancy query reports %d workgroups per CU\n", per_cu);
        (void)hipGetLastError();
        ready = 1;
    }
    if (ready < 0) return;
    const int grid = 256;
    if (hipMemsetAsync((char*)d_ws + WS_CTL, 0, CTL_ZERO_BYTES, stream) != hipSuccess) { fprintf(stderr, "kernel_launch: hipMemsetAsync failed\n"); return; }
    Args a{};
    for (int i = 0; i < N_IN; ++i) a.in[i] = (const float*)d_in[i];
    a.out = (float*)d_out; a.ws = (unsigned char*)d_ws;
#if MK_ONE_LAUNCH
    a.ph_lo = 0; a.ph_hi = N_PHASES;
    hipLaunchKernelGGL(trunk_fwd, dim3(grid), dim3(NWAVES * 64), LDS_BYTES, stream, a);
#else
    for (int p = 0; p < N_PHASES; ++p) { a.ph_lo = p; a.ph_hi = p + 1;
        hipLaunchKernelGGL(trunk_fwd, dim3(grid), dim3(NWAVES * 64), LDS_BYTES, stream, a); }
#endif
    const hipError_t le = hipPeekAtLastError();
    if (le != hipSuccess) fprintf(stderr, "kernel_launch: launch failed: %s\n", hipGetErrorName(le));
}
```

```cpp
#include <hip/hip_runtime.h>
#include <cstdio>
#include <cstdint>

#define GAS __attribute__((address_space(1)))
#define LAS __attribute__((address_space(3)))
typedef unsigned short bf16;
typedef short bf16x8 __attribute__((ext_vector_type(8)));
typedef short s16x4 __attribute__((ext_vector_type(4)));
typedef float f32x2 __attribute__((ext_vector_type(2)));
typedef float f32x4 __attribute__((ext_vector_type(4)));
typedef float f32x16 __attribute__((ext_vector_type(16)));
typedef unsigned u32x2 __attribute__((ext_vector_type(2)));
typedef unsigned u32x4 __attribute__((ext_vector_type(4)));

constexpr int T = 8192, D = 2048, NMEM = 256, DFF = 5632, NEXP = 8;
constexpr int A_COLS = 3520, AB_COLS = 7624, AB_PAD = 7680;
constexpr int FOX_LD = 8208;
constexpr int NH_R = 16, NH_M = 4, NH_F = 16;
constexpr int MOE_ROWS = 72 * 256;

__device__ __forceinline__ float bf2f(unsigned b) { return __uint_as_float(b << 16); }
__device__ __forceinline__ unsigned cvt_pk_bf16(float lo, float hi) { unsigned r; asm volatile("v_cvt_pk_bf16_f32 %0, %1, %2" : "=v"(r) : "v"(lo), "v"(hi)); return r; }
__device__ __forceinline__ bf16 f2bf(float f) { return (bf16)(cvt_pk_bf16(f, 0.f) & 0xffffu); }
__device__ __forceinline__ float wave_sum(float v) {
#pragma unroll
    for (int o = 1; o < 64; o <<= 1) v += __shfl_xor(v, o);
    return v;
}
__device__ __forceinline__ float wave_max(float v) {
#pragma unroll
    for (int o = 1; o < 64; o <<= 1) v = fmaxf(v, __shfl_xor(v, o));
    return v;
}
__device__ __forceinline__ float wave_sum_dpp(float x) {
#define DPPF_(v, ctrl) __builtin_bit_cast(float, __builtin_amdgcn_update_dpp(0, __builtin_bit_cast(int, v), ctrl, 0xF, 0xF, true))
    x += DPPF_(x, 0xB1); x += DPPF_(x, 0x4E); x += DPPF_(x, 0x141); x += DPPF_(x, 0x140);
#undef DPPF_
    const float a = __builtin_bit_cast(float, __builtin_amdgcn_readlane(__builtin_bit_cast(int, x), 0)), b = __builtin_bit_cast(float, __builtin_amdgcn_readlane(__builtin_bit_cast(int, x), 16));
    const float c = __builtin_bit_cast(float, __builtin_amdgcn_readlane(__builtin_bit_cast(int, x), 32)), d = __builtin_bit_cast(float, __builtin_amdgcn_readlane(__builtin_bit_cast(int, x), 48));
    return (a + b) + (c + d);
}
__device__ __forceinline__ float sigmoidf_(float x) { return 1.0f / (1.0f + __expf(-x)); }
__device__ __forceinline__ float logsigmoidf_(float x) { return fminf(x, 0.f) - log1pf(__expf(-fabsf(x))); }

namespace pg8 {
#define PG8_LAS __attribute__((address_space(3)))
typedef unsigned short bf16_t;
constexpr int BM = 256, BK = 64, HALF = 128, HTB = HALF * BK * 2  , STAGE_BYTES = 8 * HTB, NXCD = 8, WGM = 8;

__host__ __device__ __forceinline__ int lds_byte(int r, int c) { const int st = (r >> 4) * 2 + (c >> 5), rr = r & 15, cc = c & 31, ob = rr * 64 + cc * 2; return st * 1024 + (ob ^ (((ob >> 9) & 1) << 5)); }
__host__ __device__ __forceinline__ void stage_rc(int b, int& R, int& C) { const int st = b / 1024, sb = b % 1024, swz = sb ^ (((sb >> 9) & 1) << 5); R = (st >> 1) * 16 + swz / 64; C = (st & 1) * 32 + (swz % 64) / 2; }
__host__ __device__ __forceinline__ int perm32(int rho) { const int n = rho >> 4, i = rho & 15; return 8 * (i >> 2) + 4 * n + (i & 3); }

struct Unit { const char* a; const char* b; int pm, pn, aux, pad; };
struct Gemm { int lda, ldb, K; };

__device__ __forceinline__ bool static_tile(int i, int G, int c, int nM, int nN, int& pm, int& pn) {
    const int nwg = nM * nN; const long L = (long)i * G + c; if (L >= nwg) return false;
    int wgid = (int)L; { const int q = nwg / NXCD, r = nwg % NXCD, xcd = wgid % NXCD, off = wgid / NXCD; wgid = (xcd < r ? xcd * (q + 1) : r * (q + 1) + (xcd - r) * q) + off; }
    const int nig = WGM * nN, gid = wgid / nig, fm = gid * WGM, gsz = (nM - fm) < WGM ? (nM - fm) : WGM;
    pm = fm + ((wgid % nig) % gsz); pn = (wgid % nig) / gsz; return true;
}
struct PlainOrder {
    const bf16_t* A; const bf16_t* Bt; int lda, ldb, nM, nN, G, c;
    __device__ __forceinline__ bool next(int i, Unit& u) const {
        int pm, pn; if (!static_tile(i, G, c, nM, nN, pm, pn)) return false;
        u.pm = pm; u.pn = pn; u.aux = 0; u.pad = 0; u.a = (const char*)(A + (size_t)pm * BM * lda); u.b = (const char*)(Bt + (size_t)pn * BM * ldb); return true;
    }
};

struct EpiF32 {
    static constexpr bool PERM = false;
    float* C; int ldc; int aux_cols; float scale;
    __device__ __forceinline__ void operator()(const f32x4 (&acc)[2][2][4][2], const Unit& u, int wr, int wc, int fr, int fq) const {
        const int row0 = u.pm * BM + wr * 64 + fr, col0 = u.pn * BM + u.aux * aux_cols + wc * 32 + 4 * fq;
#pragma unroll
        for (int ai = 0; ai < 2; ++ai)
#pragma unroll
            for (int m = 0; m < 4; ++m) { float* rowp = C + (size_t)(row0 + ai * HALF + m * 16) * ldc + col0;
#pragma unroll
                for (int bj = 0; bj < 2; ++bj)
#pragma unroll
                    for (int n = 0; n < 2; ++n) *(f32x4*)(rowp + bj * HALF + n * 16) = acc[ai][bj][m][n] * scale; }
    }
};
struct EpiF32Split {
    static constexpr bool PERM = false;
    float* C; float* side; size_t side_stride; int ldc; int pm0;
    __device__ __forceinline__ void operator()(const f32x4 (&acc)[2][2][4][2], const Unit& u, int wr, int wc, int fr, int fq) const {
        float* base = u.aux == 0 ? C + (size_t)u.pm * BM * ldc : side + (size_t)(u.aux - 1) * side_stride + (size_t)(u.pm - pm0) * BM * ldc;
        const int row0 = wr * 64 + fr, col0 = u.pn * BM + wc * 32 + 4 * fq;
#pragma unroll
        for (int ai = 0; ai < 2; ++ai)
#pragma unroll
            for (int m = 0; m < 4; ++m) { float* rowp = base + (size_t)(row0 + ai * HALF + m * 16) * ldc + col0;
#pragma unroll
                for (int bj = 0; bj < 2; ++bj)
#pragma unroll
                    for (int n = 0; n < 2; ++n) *(f32x4*)(rowp + bj * HALF + n * 16) = acc[ai][bj][m][n]; }
    }
};
struct EpiResid {
    static constexpr bool PERM = false;
    const float* base; float* out; int ldc; bf16_t* xn; const float* gn; float* ssq;
    __device__ __forceinline__ void operator()(const f32x4 (&acc)[2][2][4][2], const Unit& u, int wr, int wc, int fr, int fq) const {
        const int row0 = u.pm * BM + wr * 64 + fr, col0 = u.pn * BM + wc * 32 + 4 * fq;
        f32x4 gv[2][2];
        if (xn) {
#pragma unroll
            for (int bj = 0; bj < 2; ++bj)
#pragma unroll
                for (int n = 0; n < 2; ++n) gv[bj][n] = *(const f32x4*)(gn + col0 + bj * HALF + n * 16); }
#pragma unroll
        for (int ai = 0; ai < 2; ++ai)
#pragma unroll
            for (int m = 0; m < 4; ++m) { const int row = row0 + ai * HALF + m * 16; const size_t off = (size_t)row * ldc + col0; float ss = 0.f;
#pragma unroll
                for (int bj = 0; bj < 2; ++bj)
#pragma unroll
                    for (int n = 0; n < 2; ++n) { const f32x4 b = *(const f32x4*)(base + off + bj * HALF + n * 16); const f32x4 x = b + acc[ai][bj][m][n]; *(f32x4*)(out + off + bj * HALF + n * 16) = x;
                        if (xn) { ss += (x[0] * x[0] + x[1] * x[1]) + (x[2] * x[2] + x[3] * x[3]); const f32x4 y = x * gv[bj][n];
                            u32x2 w; w.x = cvt_pk_bf16(y[0], y[1]); w.y = cvt_pk_bf16(y[2], y[3]); *(u32x2*)(xn + off + bj * HALF + n * 16) = w; } }
                if (xn) { ss += __shfl_xor(ss, 16); ss += __shfl_xor(ss, 32); if (fq == 0) __hip_atomic_fetch_add(ssq + row, ss, __ATOMIC_RELAXED, __HIP_MEMORY_SCOPE_AGENT); } }
    }
};
struct EpiBf16 {
    static constexpr bool PERM = true;
    bf16_t* O; int ldc; float* side; int side_pn; const float* ssq;
    __device__ __forceinline__ void operator()(const f32x4 (&acc)[2][2][4][2], const Unit& u, int wr, int wc, int fr, int fq) const {
        const int row0 = u.pm * BM + wr * 64 + fr, col0 = u.pn * BM + wc * 32 + 8 * fq;
#pragma unroll
        for (int ai = 0; ai < 2; ++ai)
#pragma unroll
            for (int m = 0; m < 4; ++m) { bf16_t* rowp = O + (size_t)(row0 + ai * HALF + m * 16) * ldc + col0;
                const float rs = ssq ? 1.0f / sqrtf(ssq[row0 + ai * HALF + m * 16] * (1.0f / 2048.0f) + 1e-6f) : 1.0f;
#pragma unroll
                for (int bj = 0; bj < 2; ++bj) { const f32x4 v0 = acc[ai][bj][m][0] * rs, v1 = acc[ai][bj][m][1] * rs;
                    u32x4 w; w.x = cvt_pk_bf16(v0[0], v0[1]); w.y = cvt_pk_bf16(v0[2], v0[3]); w.z = cvt_pk_bf16(v1[0], v1[1]); w.w = cvt_pk_bf16(v1[2], v1[3]);
                    *(u32x4*)(rowp + bj * HALF) = w; } }
        if (side != nullptr && u.pn == side_pn) {
#pragma unroll
            for (int ai = 0; ai < 2; ++ai)
#pragma unroll
                for (int m = 0; m < 4; ++m) { float* rowp = side + (size_t)(row0 + ai * HALF + m * 16) * 256 + wc * 32 + 8 * fq;
#pragma unroll
                    for (int bj = 0; bj < 2; ++bj) { *(f32x4*)(rowp + bj * HALF) = acc[ai][bj][m][0]; *(f32x4*)(rowp + bj * HALF + 4) = acc[ai][bj][m][1]; } }
        }
    }
};
struct EpiSwiGLU {
    static constexpr bool PERM = true;
    bf16_t* O; int ldc; const float* ssq;
    __device__ __forceinline__ void operator()(const f32x4 (&acc)[2][2][4][2], const Unit& u, int wr, int wc, int fr, int fq) const {
        const int row0 = u.pm * BM + wr * 64 + fr, col0 = u.pn * HALF + wc * 32 + 8 * fq;
#pragma unroll
        for (int ai = 0; ai < 2; ++ai)
#pragma unroll
            for (int m = 0; m < 4; ++m) { bf16_t* rowp = O + (size_t)(row0 + ai * HALF + m * 16) * ldc + col0;
                const float rs = ssq ? 1.0f / sqrtf(ssq[row0 + ai * HALF + m * 16] * (1.0f / 2048.0f) + 1e-6f) : 1.0f;
                float o[8];
#pragma unroll
                for (int n = 0; n < 2; ++n)
#pragma unroll
                    for (int j = 0; j < 4; ++j) { const float g = acc[ai][0][m][n][j] * rs, up = acc[ai][1][m][n][j] * rs;
                        o[n * 4 + j] = g * __builtin_amdgcn_rcpf(1.0f + __builtin_amdgcn_exp2f(-1.4426950408889634f * g)) * up; }
                u32x4 w; w.x = cvt_pk_bf16(o[0], o[1]); w.y = cvt_pk_bf16(o[2], o[3]); w.z = cvt_pk_bf16(o[4], o[5]); w.w = cvt_pk_bf16(o[6], o[7]);
                *(u32x4*)rowp = w; }
    }
};

template <class E, class = void> struct epi_after_drain { static constexpr bool value = false; };
template <class E> struct epi_after_drain<E, decltype((void)E::AFTER_DRAIN)> { static constexpr bool value = E::AFTER_DRAIN; };
struct EpiSoftmaxBf16 {
    static constexpr bool PERM = false, AFTER_DRAIN = true;
    bf16_t* P; int ldc; int aux_cols; float scale;
    __device__ __forceinline__ void fused(f32x4 (&acc)[2][2][4][2], const Unit& u, int wr, int wc, int fr, int fq, PG8_LAS unsigned char* lds) const {
        PG8_LAS float* pm = (PG8_LAS float*)lds;
        PG8_LAS float* ps = pm + 1024;
        float mx[2][4];
#pragma unroll
        for (int ai = 0; ai < 2; ++ai)
#pragma unroll
            for (int m = 0; m < 4; ++m) { float v = -3.0e38f;
#pragma unroll
                for (int bj = 0; bj < 2; ++bj)
#pragma unroll
                    for (int n = 0; n < 2; ++n) { acc[ai][bj][m][n] = acc[ai][bj][m][n] * scale; const f32x4 x = acc[ai][bj][m][n]; v = fmaxf(v, fmaxf(fmaxf(x[0], x[1]), fmaxf(x[2], x[3]))); }
                v = fmaxf(v, __shfl_xor(v, 16)); v = fmaxf(v, __shfl_xor(v, 32)); mx[ai][m] = v;
                if (fq == 0) pm[(ai * HALF + wr * 64 + m * 16 + fr) * 4 + wc] = v; }
        asm volatile("s_waitcnt lgkmcnt(0)" ::: "memory"); __builtin_amdgcn_s_barrier(); asm volatile("" ::: "memory");
        float sm[2][4];
#pragma unroll
        for (int ai = 0; ai < 2; ++ai)
#pragma unroll
            for (int m = 0; m < 4; ++m) { const f32x4 p4 = *(const PG8_LAS f32x4*)(pm + (ai * HALF + wr * 64 + m * 16 + fr) * 4); const float mr = fmaxf(fmaxf(p4[0], p4[1]), fmaxf(p4[2], p4[3])); float s = 0.f;
#pragma unroll
                for (int bj = 0; bj < 2; ++bj)
#pragma unroll
                    for (int n = 0; n < 2; ++n) { f32x4 x = acc[ai][bj][m][n];
#pragma unroll
                        for (int j = 0; j < 4; ++j) { x[j] = __expf(x[j] - mr); s += x[j]; }
                        acc[ai][bj][m][n] = x; }
                s += __shfl_xor(s, 16); s += __shfl_xor(s, 32); sm[ai][m] = s;
                if (fq == 0) ps[(ai * HALF + wr * 64 + m * 16 + fr) * 4 + wc] = s; }
        asm volatile("s_waitcnt lgkmcnt(0)" ::: "memory"); __builtin_amdgcn_s_barrier(); asm volatile("" ::: "memory");
        const int row0 = u.pm * BM + wr * 64 + fr, col0 = u.pn * BM + u.aux * aux_cols + wc * 32 + 4 * fq;
#pragma unroll
        for (int ai = 0; ai < 2; ++ai)
#pragma unroll
            for (int m = 0; m < 4; ++m) { const f32x4 s4 = *(const PG8_LAS f32x4*)(ps + (ai * HALF + wr * 64 + m * 16 + fr) * 4); const float inv = 1.0f / ((s4[0] + s4[1]) + (s4[2] + s4[3]));
                bf16_t* rowp = P + (size_t)(row0 + ai * HALF + m * 16) * ldc + col0;
#pragma unroll
                for (int bj = 0; bj < 2; ++bj)
#pragma unroll
                    for (int n = 0; n < 2; ++n) { const f32x4 x = acc[ai][bj][m][n] * inv; u32x2 w; w.x = cvt_pk_bf16(x[0], x[1]); w.y = cvt_pk_bf16(x[2], x[3]); *(u32x2*)(rowp + bj * HALF + n * 16) = w; } }
        (void)mx; (void)sm;
    }
};

template <class Epi, class Sched, bool ALIGN_EPI>
__device__ __forceinline__ void gemm_phase(PG8_LAS unsigned char* lds, const Gemm g, const Sched& S, const Epi& E) {
    const int tid = threadIdx.x, wid = __builtin_amdgcn_readfirstlane(tid >> 6), lane = tid & 63, wr = wid >> 2, wc = wid & 3, fr = lane & 15, fq = lane >> 4;
    const int K = g.K, nt = K / BK;
    unsigned voffA[2], voffB[2];
#pragma unroll
    for (int i = 0; i < 2; ++i) { int R, C; stage_rc(tid * 16 + i * 8192, R, C); const int Rb = Epi::PERM ? ((R & ~31) + perm32(R & 31)) : R;
        voffA[i] = (unsigned)(R * g.lda + C) * 2u; voffB[i] = (unsigned)(Rb * g.ldb + C) * 2u; }
    const size_t kstep = (size_t)(BK * 2);
    const size_t hstepA = (size_t)HALF * g.lda * 2, hstepB = (size_t)HALF * g.ldb * 2;
    const unsigned ldsw = (unsigned)wid * 1024u;
    const int aoff = lds_byte(wr * 64 + fr, fq * 8), boff = lds_byte(wc * 32 + fr, fq * 8);
#define PG8_SA(b, h) (((b) * 2 + (h)) * HTB)
#define PG8_SB(b, h) ((4 + (b) * 2 + (h)) * HTB)
#define PG8_STAGE(bufoff, gbase, voff) do { _Pragma("unroll") for (int _i = 0; _i < 2; ++_i) \
        __builtin_amdgcn_global_load_lds((const unsigned*)((const char*)(gbase) + (voff)[_i]), (PG8_LAS unsigned*)(lds + (bufoff) + ldsw + _i * 8192), 16, 0, 0); } while (0)
#define PG8_LDA(dst, b, h) do { _Pragma("unroll") for (int m = 0; m < 4; ++m) _Pragma("unroll") for (int k = 0; k < 2; ++k) dst[m][k] = *(const PG8_LAS bf16x8*)(lds + PG8_SA(b, h) + aoff + m * 2048 + k * 1024); } while (0)
#define PG8_LDB(dst, b, h) do { _Pragma("unroll") for (int n = 0; n < 2; ++n) _Pragma("unroll") for (int k = 0; k < 2; ++k) dst[n][k] = *(const PG8_LAS bf16x8*)(lds + PG8_SB(b, h) + boff + n * 2048 + k * 1024); } while (0)
#define PG8_MMA(ai, bj, At, Bt) do { __builtin_amdgcn_s_setprio(1); _Pragma("unroll") for (int m = 0; m < 4; ++m) _Pragma("unroll") for (int n = 0; n < 2; ++n) _Pragma("unroll") for (int k = 0; k < 2; ++k) \
        acc[ai][bj][m][n] = __builtin_amdgcn_mfma_f32_16x16x32_bf16(Bt[n][k], At[m][k], acc[ai][bj][m][n], 0, 0, 0); __builtin_amdgcn_s_setprio(0); } while (0)
#define PG8_WAIT_V(n) asm volatile("s_waitcnt vmcnt(" #n ")" ::: "memory")
#define PG8_WAIT_L(n) asm volatile("s_waitcnt lgkmcnt(" #n ")" ::: "memory")
#define PG8_BAR __builtin_amdgcn_s_barrier()
#define PG8_SCHED __builtin_amdgcn_sched_barrier(0)
    Unit cur, nxt; int ui = 0;
    if (!S.next(0, cur)) return;
    f32x4 acc[2][2][4][2];
#pragma unroll
    for (int a = 0; a < 2; ++a)
#pragma unroll
        for (int b = 0; b < 2; ++b)
#pragma unroll
            for (int m = 0; m < 4; ++m)
#pragma unroll
                for (int n = 0; n < 2; ++n) acc[a][b][m][n] = (f32x4){0.f, 0.f, 0.f, 0.f};
    bf16x8 At[4][2], B0[2][2], B1[2][2];
    const char* cA = cur.a; const char* cB = cur.b;
    PG8_STAGE(PG8_SB(0, 0), cB, voffB); PG8_STAGE(PG8_SB(0, 1), cB + hstepB, voffB); PG8_STAGE(PG8_SA(0, 0), cA, voffA); PG8_STAGE(PG8_SA(0, 1), cA + hstepA, voffA);
    if (wr == 1) PG8_BAR;
    PG8_WAIT_V(2); PG8_BAR;
    PG8_STAGE(PG8_SB(1, 0), cB + kstep, voffB); PG8_STAGE(PG8_SA(1, 0), cA + kstep, voffA); PG8_STAGE(PG8_SB(1, 1), cB + hstepB + kstep, voffB);
    PG8_WAIT_V(6); PG8_BAR;
    for (;;) {
        const bool has_next = S.next(ui + 1, nxt);
        const char* nA = has_next ? nxt.a : cA; const char* nB = has_next ? nxt.b : cB;
        for (int t = 0; t < nt; t += 2) {
            const bool last = (t == nt - 2);
            const char* a1 = cA + (size_t)(t + 1) * kstep;
            const char* a2 = last ? nA : cA + (size_t)(t + 2) * kstep; const char* b2 = last ? nB : cB + (size_t)(t + 2) * kstep;
            const char* a3 = a2 + kstep; const char* b3 = b2 + kstep;
            PG8_LDB(B0, 0, 0); PG8_LDB(B1, 0, 1); PG8_SCHED; PG8_LDA(At, 0, 0); PG8_STAGE(PG8_SA(1, 1), a1 + hstepA, voffA);
            PG8_WAIT_V(8); PG8_WAIT_L(0); PG8_BAR; PG8_MMA(0, 0, At, B0); PG8_MMA(0, 1, At, B1); PG8_BAR; PG8_SCHED;
            PG8_LDA(At, 0, 1); PG8_STAGE(PG8_SB(0, 0), b2, voffB); PG8_STAGE(PG8_SB(0, 1), b2 + hstepB, voffB); PG8_STAGE(PG8_SA(0, 0), a2, voffA);
            PG8_WAIT_V(8); PG8_WAIT_L(0); PG8_BAR; PG8_MMA(1, 0, At, B0); PG8_MMA(1, 1, At, B1); PG8_BAR; PG8_SCHED;
            PG8_LDB(B0, 1, 0); PG8_LDB(B1, 1, 1); PG8_SCHED; PG8_LDA(At, 1, 0); PG8_STAGE(PG8_SA(0, 1), a2 + hstepA, voffA);
            PG8_WAIT_V(8); PG8_WAIT_L(0); PG8_BAR; PG8_MMA(0, 0, At, B0); PG8_MMA(0, 1, At, B1); PG8_BAR; PG8_SCHED;
            PG8_LDA(At, 1, 1); PG8_STAGE(PG8_SB(1, 0), b3, voffB); PG8_STAGE(PG8_SB(1, 1), b3 + hstepB, voffB); PG8_STAGE(PG8_SA(1, 0), a3, voffA);
            PG8_WAIT_V(8); PG8_WAIT_L(0); PG8_BAR; PG8_MMA(1, 0, At, B0); PG8_MMA(1, 1, At, B1); PG8_BAR; PG8_SCHED;
        }
        if constexpr (ALIGN_EPI) { if (wr == 0) PG8_BAR; }
        if constexpr (!epi_after_drain<Epi>::value) E(acc, cur, wr, wc, fr, fq);
        if (!has_next) break;
#pragma unroll
        for (int a = 0; a < 2; ++a)
#pragma unroll
            for (int b = 0; b < 2; ++b)
#pragma unroll
                for (int m = 0; m < 4; ++m)
#pragma unroll
                    for (int n = 0; n < 2; ++n) acc[a][b][m][n] = (f32x4){0.f, 0.f, 0.f, 0.f};
        cur = nxt; cA = nA; cB = nB; ++ui;
        if constexpr (ALIGN_EPI) { if (wr == 1) PG8_BAR; }
    }
    PG8_WAIT_V(0);
    if constexpr (!ALIGN_EPI) { if (wr == 0) PG8_BAR; }
    PG8_BAR;
    if constexpr (epi_after_drain<Epi>::value) E.fused(acc, cur, wr, wc, fr, fq, lds);
#undef PG8_SA
#undef PG8_SB
#undef PG8_STAGE
#undef PG8_LDA
#undef PG8_LDB
#undef PG8_MMA
#undef PG8_WAIT_V
#undef PG8_WAIT_L
#undef PG8_BAR
#undef PG8_SCHED
}
}

namespace fox {
constexpr int D = 128, LDQ = 8192, LDO = 2048;
constexpr float SCALE = 0.08838834764831845f;
constexpr float THR2 = 8.f * 1.4426950408889634f;
constexpr int NW = 8, QBLK = 32, KVBLK = 64, QB = NW * QBLK;
constexpr int SHM_V = KVBLK * D * 2, SHM_K = KVBLK * D * 2;
constexpr int BIAS_OFF = 2 * SHM_V + 2 * SHM_K + NW * 64 * 4;
constexpr int LDS_BYTES = BIAS_OFF + 8192 * 4;

#define KSWZ(row, colB) ((row) * 256 + ((colB) ^ (((row) & 7) << 4)))
#define SBAR() __builtin_amdgcn_sched_barrier(0)
__device__ __forceinline__ int v_st(int k, int c) { const int kk = (k & ~0xC) | ((k & 4) << 1) | ((k & 8) >> 1); return ((kk >> 3) * 4 + (c >> 5)) * 512 + ((kk & 7) * 32 + (c & 31)) * 2; }
__device__ __forceinline__ int v_rd_base(int lane) { return ((lane & 3) << 3) | (((lane >> 2) & 3) << 6) | (((lane >> 4) & 1) << 5) | (((lane >> 5) & 1) << 8); }
constexpr int v_rd_off(int d0, int ks, int half) { return d0 * 512 + ks * 4096 + half * 2048; }
__device__ __forceinline__ int crow(int r, int hi) { return (r & 3) + 8 * (r >> 2) + 4 * hi; }
__device__ __forceinline__ unsigned cvtpk(float lo, float hi) { unsigned r; asm volatile("v_cvt_pk_bf16_f32 %0, %1, %2" : "=v"(r) : "v"(lo), "v"(hi)); return r; }
__device__ __forceinline__ bf16x8 load8(const bf16* p) { return *reinterpret_cast<const bf16x8*>(p); }
__device__ __forceinline__ void mask_tile(f32x16& p0, f32x16& p1, int dq) {
    const float NEG = -__builtin_inff();
#pragma unroll
    for (int r = 0; r < 16; ++r) {
        const int c = (r & 3) + 8 * (r >> 2);
        if (dq - c < 0) p0[r] = NEG;
        if (dq - c - 32 < 0) p1[r] = NEG;
    }
}
__device__ __forceinline__ void partialSM(f32x16& p0, f32x16& p1, float& m_reg, float& mn, float& alpha, const float* bl) {
    constexpr float C2 = 1.4426950408889634f * SCALE;
#pragma unroll
    for (int a = 0; a < 4; ++a) {
#ifdef FOX_NOBIAS
        const f32x4 b0 = {0,0,0,0}, b1 = {0,0,0,0};
#else
        const f32x4 b0 = *(const f32x4*)(bl + 8 * a), b1 = *(const f32x4*)(bl + 32 + 8 * a);
#endif

#pragma unroll
        for (int i = 0; i < 4; ++i) { p0[4 * a + i] = fmaf(p0[4 * a + i], C2, b0[i]); p1[4 * a + i] = fmaf(p1[4 * a + i], C2, b1[i]); }
        SBAR(); }
    float pmax = p0[0]; for (int r = 1; r < 16; ++r) pmax = fmaxf(pmax, p0[r]); for (int r = 0; r < 16; ++r) pmax = fmaxf(pmax, p1[r]);
    { auto rr = __builtin_amdgcn_permlane32_swap(__float_as_uint(pmax), __float_as_uint(pmax), false, false);
      pmax = fmaxf(__uint_as_float(rr[0]), __uint_as_float(rr[1])); }
    if (__builtin_expect(__all((pmax - m_reg) <= THR2), 1)) { mn = m_reg; alpha = 1.f; }
    else { mn = fmaxf(m_reg, pmax); alpha = __builtin_amdgcn_exp2f(m_reg - mn); m_reg = mn; }
    for (int r = 0; r < 16; ++r) p0[r] = p0[r] - mn; for (int r = 0; r < 16; ++r) p1[r] = p1[r] - mn;
    for (int r = 0; r < 16; ++r) p0[r] = __builtin_amdgcn_exp2f(p0[r]);
}
__device__ __forceinline__ void finishSM(f32x16& p0, f32x16& p1, float alpha, float& l_reg, bf16x8& pa0, bf16x8& pa1, bf16x8& pa2, bf16x8& pa3) {
    for (int r = 0; r < 16; ++r) p1[r] = __builtin_amdgcn_exp2f(p1[r]);
    float ps = 0; for (int r = 0; r < 16; ++r) ps += p0[r]; for (int r = 0; r < 16; ++r) ps += p1[r];
    { auto rr = __builtin_amdgcn_permlane32_swap(__float_as_uint(ps), __float_as_uint(ps), false, false);
      ps = __uint_as_float(rr[0]) + __uint_as_float(rr[1]); }
    l_reg = l_reg * alpha + ps;
#define PK4(P, B_, OUT) do { unsigned a0 = cvtpk(P[B_+0], P[B_+1]), a1 = cvtpk(P[B_+2], P[B_+3]);                          \
        unsigned b0 = cvtpk(P[B_+4], P[B_+5]), b1 = cvtpk(P[B_+6], P[B_+7]);                                             \
        auto r0 = __builtin_amdgcn_permlane32_swap(a0, b0, false, false); auto r1 = __builtin_amdgcn_permlane32_swap(a1, b1, false, false); \
        u32x4 w = {r0[0], r1[0], r0[1], r1[1]}; OUT = *reinterpret_cast<bf16x8*>(&w); } while (0)
    PK4(p0, 0, pa0); PK4(p0, 8, pa1); PK4(p1, 0, pa2); PK4(p1, 8, pa3);
#undef PK4
}
template <int KB>
__device__ __forceinline__ void qkt(f32x16& p0, f32x16& p1, const char* K_lds, int r32, int hi, const bf16x8* qr) {
    p0 = f32x16{}; p1 = f32x16{};
    const char* kb[4];
#pragma unroll
    for (int dd = 0; dd < 4; ++dd) kb[dd] = K_lds + KB * SHM_K + KSWZ(r32, (dd * 16 + hi * 8) * 2);
#pragma unroll
    for (int d0 = 0; d0 < 8; ++d0) { const char* a = kb[d0 & 3] + (d0 >> 2) * 128;
        bf16x8 b0 = *reinterpret_cast<const bf16x8*>(a);
        bf16x8 b1 = *reinterpret_cast<const bf16x8*>(a + 32 * 256);
        p0 = __builtin_amdgcn_mfma_f32_32x32x16_bf16(b0, qr[d0], p0, 0, 0, 0);
        p1 = __builtin_amdgcn_mfma_f32_32x32x16_bf16(b1, qr[d0], p1, 0, 0, 0); }
}
template <int VB>
__device__ __forceinline__ void pv_tile(f32x16* o, int vb0, bf16x8 pa0, bf16x8 pa1, bf16x8 pa2, bf16x8 pa3) {
#define TRRD(dst, off) asm volatile("ds_read_b64_tr_b16 %0, %1 offset:%2" : "=&v"(dst) : "v"(vb0), "i"(off) : "memory")
#define PV_D0(d0) do { s16x4 l0, l1, l2, l3, h0, h1, h2, h3; constexpr int b_ = VB * SHM_V + v_rd_off(d0, 0, 0); \
        TRRD(l0, b_); TRRD(h0, b_ + 2048); TRRD(l1, b_ + 4096); TRRD(h1, b_ + 6144); TRRD(l2, b_ + 8192); TRRD(h2, b_ + 10240); TRRD(l3, b_ + 12288); TRRD(h3, b_ + 14336); \
        asm volatile("s_waitcnt lgkmcnt(0)" ::: "memory"); SBAR();   \
        o[d0] = __builtin_amdgcn_mfma_f32_32x32x16_bf16(pa0, (bf16x8){l0[0], l0[1], l0[2], l0[3], h0[0], h0[1], h0[2], h0[3]}, o[d0], 0, 0, 0);   \
        o[d0] = __builtin_amdgcn_mfma_f32_32x32x16_bf16(pa1, (bf16x8){l1[0], l1[1], l1[2], l1[3], h1[0], h1[1], h1[2], h1[3]}, o[d0], 0, 0, 0);   \
        o[d0] = __builtin_amdgcn_mfma_f32_32x32x16_bf16(pa2, (bf16x8){l2[0], l2[1], l2[2], l2[3], h2[0], h2[1], h2[2], h2[3]}, o[d0], 0, 0, 0);   \
        o[d0] = __builtin_amdgcn_mfma_f32_32x32x16_bf16(pa3, (bf16x8){l3[0], l3[1], l3[2], l3[3], h3[0], h3[1], h3[2], h3[3]}, o[d0], 0, 0, 0); } while (0)
    PV_D0(0); PV_D0(1); PV_D0(2); PV_D0(3);
#undef PV_D0
#undef TRRD
}

struct BlockRef { const bf16* Q; const bf16* K; const bf16* V; const bf16* G; bf16* O; int P0; };
struct Seam { bf16x8 qr[8]; bf16x8 st_v0, st_v1, st_k0, st_k1; };
#define LD8(base, boff) (*reinterpret_cast<const bf16x8*>((const char*)(base) + (boff)))
#define VMW() asm volatile("s_waitcnt vmcnt(0)" ::: "memory")
#define VMWN(n) asm volatile("s_waitcnt vmcnt(%0)" :: "i"(n) : "memory")
#define SLOAD_H(Kp, Vp, k0) do { const char* kb__ = (const char*)(Kp) + (size_t)(k0) * (LDQ * 2); const char* vb__ = (const char*)(Vp) + (size_t)(k0) * (LDQ * 2); \
                         S.st_v0 = LD8(vb__, kvoff); S.st_v1 = LD8(vb__, kvoff + 32u * LDQ * 2u);              \
                         S.st_k0 = LD8(kb__, kvoff); S.st_k1 = LD8(kb__, kvoff + 32u * LDQ * 2u); } while (0)
#define SWRITE_HK(bf) do { *(bf16x8*)(K_lds + (bf) * SHM_K + kws) = S.st_k0; *(bf16x8*)(K_lds + (bf) * SHM_K + kws + 32 * 256) = S.st_k1; } while (0)
#define SWRITE_HV(bf) do { *(bf16x8*)(V_lds + (bf) * SHM_V + vst0) = S.st_v0; *(bf16x8*)(V_lds + (bf) * SHM_V + vst1) = S.st_v1; } while (0)
#define SWRITE_H(bf) do { SWRITE_HV(bf); SWRITE_HK(bf); } while (0)
__device__ __forceinline__ void prime(const BlockRef& cur, char* lds, Seam& S) {
    const int tid = threadIdx.x, wid = __builtin_amdgcn_readfirstlane(tid >> 6), lane = tid & 63, r32 = lane & 31, hi = lane >> 5;
    const int sr = tid >> 4, sc = (tid & 15) * 8, kws = KSWZ(sr, sc * 2); char* K_lds = lds + 2 * SHM_V;
    const unsigned kvoff = (unsigned)(sr * LDQ + sc) * 2u, qoff = (unsigned)((wid * QBLK + r32) * LDQ + hi * 8) * 2u;
    for (int d0 = 0; d0 < 8; ++d0) S.qr[d0] = LD8(cur.Q, qoff + d0 * 32);
    SLOAD_H(cur.K, cur.V, 0); VMW(); SWRITE_HK(0);
    __syncthreads();
}
__device__ __forceinline__ void block(const BlockRef& cur, const BlockRef& nxt, char* lds, Seam& S) {
    const int tid = threadIdx.x, wid = __builtin_amdgcn_readfirstlane(tid >> 6), lane = tid & 63, r32 = lane & 31, hi = lane >> 5;
    const int NT = (cur.P0 + QB - 1) / KVBLK + 1;
    const int qlo = cur.P0 + wid * QBLK, qm = qlo + r32 - 4 * hi;
    char* V_lds = lds; char* K_lds = lds + 2 * SHM_V;
    float* ws = (float*)(lds + 2 * SHM_V + 2 * SHM_K) + wid * 64; float* li_l = ws, * al_l = ws + 32;
    const float* biasl = (const float*)(lds + BIAS_OFF) + 4 * hi;
    float m_reg = -1e30f, l_reg = 0; f32x16 o[4] = {};
    const int sr = tid >> 4, sc = (tid & 15) * 8, vst0 = v_st(sr, sc), vst1 = v_st(32 + sr, sc), kws = KSWZ(sr, sc * 2);
    const unsigned kvoff = (unsigned)(sr * LDQ + sc) * 2u;
    const int vb0 = (int)(uintptr_t)V_lds + v_rd_base(lane);
    const bf16* Kh = cur.K; const bf16* Vh = cur.V;
#define RESC(a) do { if (__any((a) < 1.f)) { if (hi == 0) al_l[r32] = (a); asm volatile("s_waitcnt lgkmcnt(0)" ::: "memory");              \
                     for (int d_ = 0; d_ < 4; ++d_) for (int r = 0; r < 16; ++r) o[d_][r] *= al_l[crow(r, hi)]; } } while (0)
#define KBASE(t) ((t) * KVBLK)
#define MASKT(P0_, P1_, t) do { const int kb_ = KBASE(t); if (kb_ + KVBLK - 1 > qlo) mask_tile(P0_, P1_, qm - kb_); } while (0)
    constexpr int NQL = 8;
#define SEAM_K0() do { VMWN(NQL); SWRITE_HK(0); SBAR(); } while (0)
    f32x16 pA0, pA1, pB0, pB1; float mnA, mnB, alA, alB; bf16x8 pa0, pa1, pa2, pa3;
    SWRITE_HV(0); SBAR();
    if (NT > 1) { SLOAD_H(Kh, Vh, KBASE(1)); }
    SBAR(); qkt<0>(pA0, pA1, K_lds, r32, hi, S.qr);
    MASKT(pA0, pA1, 0); partialSM(pA0, pA1, m_reg, mnA, alA, biasl + KBASE(0));
    if (NT > 1) { VMW(); SWRITE_H(1); }
    __syncthreads();
#define HALF_STEP(PX0, PX1, mnX, alX, PY0, PY1, alY, t, KB, VB, SB) do {                                                      \
        SBAR(); qkt<KB>(PX0, PX1, K_lds, r32, hi, S.qr);                                                                      \
        finishSM(PY0, PY1, alY, l_reg, pa0, pa1, pa2, pa3); SBAR();                                                           \
        if ((t) + 1 < NT) { SLOAD_H(Kh, Vh, KBASE((t) + 1)); SBAR(); }                                                        \
        pv_tile<VB>(o, vb0, pa0, pa1, pa2, pa3); MASKT(PX0, PX1, (t)); partialSM(PX0, PX1, m_reg, mnX, alX, biasl + KBASE(t)); \
        __syncthreads();                                                                                                      \
        if ((t) + 1 < NT) { VMW(); SWRITE_H(SB); }                                                                            \
        RESC(alX); __syncthreads(); } while (0)
    for (int t = 1; t + 1 < NT; t += 2) {
        HALF_STEP(pB0, pB1, mnB, alB, pA0, pA1, alA, t, 1, 0, 0);
        HALF_STEP(pA0, pA1, mnA, alA, pB0, pB1, alB, t + 1, 0, 1, 1);
    }
    const bool even = (NT & 1) == 0;
    if (even) { SBAR(); qkt<1>(pB0, pB1, K_lds, r32, hi, S.qr); SBAR(); }
    SLOAD_H(nxt.K, nxt.V, 0); SBAR();
    { unsigned qoff = (unsigned)((wid * QBLK + r32) * LDQ + hi * 8) * 2u; asm volatile("" : "+v"(qoff));
#pragma unroll
      for (int d0 = 0; d0 < 8; ++d0) S.qr[d0] = LD8(nxt.Q, qoff + d0 * 32); }
    SBAR();
    finishSM(pA0, pA1, alA, l_reg, pa0, pa1, pa2, pa3); SBAR();
    pv_tile<0>(o, vb0, pa0, pa1, pa2, pa3);
    if (even) { MASKT(pB0, pB1, NT - 1); partialSM(pB0, pB1, m_reg, mnB, alB, biasl + KBASE(NT - 1)); __syncthreads(); RESC(alB);
        finishSM(pB0, pB1, alB, l_reg, pa0, pa1, pa2, pa3); SBAR(); pv_tile<1>(o, vb0, pa0, pa1, pa2, pa3); }
    SBAR(); SEAM_K0();
    if (hi == 0) li_l[r32] = l_reg; asm volatile("s_waitcnt lgkmcnt(0)" ::: "memory");
    float rli[16];
#pragma unroll
    for (int r = 0; r < 16; ++r) rli[r] = __builtin_amdgcn_rcpf(li_l[crow(r, hi)]);
    unsigned ooff = (unsigned)((wid * QBLK + 4 * hi) * LDO + r32) * 2u, goff = (unsigned)((wid * QBLK + 4 * hi) * LDQ + r32) * 2u;
    asm volatile("" : "+v"(ooff), "+v"(goff));
#pragma unroll
    for (int r = 0; r < 16; ++r) { const unsigned rr = (unsigned)((r & 3) + 8 * (r >> 2));
#pragma unroll
        for (int d0 = 0; d0 < 4; ++d0) {
#ifdef FOX_NOGATE
            const float gv = 0.f;
#else
            const float gv = bf2f(*(const bf16*)((const char*)cur.G + (goff + rr * (LDQ * 2u) + d0 * 64u)));
#endif

            const float v = o[d0][r] * rli[r] * (1.0f / (1.0f + __expf(-gv)));
            const float vn = __shfl_xor(v, 1);
            if ((r32 & 1) == 0) *(unsigned*)((char*)cur.O + (ooff + rr * (LDO * 2u) + d0 * 64u)) = cvtpk(v, vn); } }
    __syncthreads();
#undef RESC
#undef KBASE
#undef MASKT
#undef SEAM_K0
#undef HALF_STEP
}
#undef LD8
#undef VMW
#undef VMWN
#undef SLOAD_H
#undef SWRITE_HK
#undef SWRITE_HV
#undef SWRITE_H
#undef KSWZ
#undef SBAR
}

constexpr int NWAVES = 8;
constexpr size_t MiB = 1u << 20;
constexpr size_t WS_CTL = 0, CTL_ZERO_BYTES = 1 * MiB;
constexpr size_t WS_MEMN = 1 * MiB;
constexpr size_t WS_KMEM = 2 * MiB;
constexpr size_t WS_VTMEM = 4 * MiB;
constexpr size_t WS_SMALL = 6 * MiB;
constexpr size_t SM_BONUS = 0;
constexpr size_t SM_FPRE = 512 * 1024;
constexpr size_t SM_BIASL2 = 1024 * 1024;
constexpr size_t SM_BCUM = 1536 * 1024;
constexpr size_t SM_IG = SM_BCUM + 128 * 1024;
constexpr size_t SM_WSTATE = SM_IG + 128 * 1024;
constexpr size_t SM_CHBL = SM_WSTATE + 128 * 1024;
constexpr size_t SM_CHMD = SM_CHBL + 4096;
constexpr size_t SM_MSEQ = SM_CHMD + 4096;
constexpr size_t SM_WCARRY = SM_MSEQ + 4096;
constexpr size_t SM_MOUT = SM_WCARRY + 4096;
constexpr size_t SM_TOPI = 2048 * 1024;
constexpr size_t SM_TOPG = SM_TOPI + 64 * 1024;
constexpr size_t SM_SLOT = SM_TOPG + 64 * 1024;
constexpr size_t SM_BLKCNT = SM_SLOT + 64 * 1024;
constexpr size_t SM_TILEE = SM_BLKCNT + 8192;
constexpr size_t SM_NU = 3 * 1024 * 1024;
constexpr size_t SM_SLOC = 4 * 1024 * 1024;
constexpr size_t SM_PEND = 5 * 1024 * 1024;
constexpr size_t SM_SIN = 6 * 1024 * 1024;
constexpr size_t WS_X = 16 * MiB;
constexpr size_t WS_XN = 80 * MiB;
constexpr size_t WS_W_XQ = 112 * MiB, WS_W_XKV = 128 * MiB, WS_W_XO = 160 * MiB, WS_W_ABIN = 176 * MiB, WS_W_LORA = 206 * MiB, WS_W_ABOUT = 209 * MiB,
                 WS_W_FFNGU = 217 * MiB, WS_W_FFND = 261 * MiB, WS_W_FOXIN = 283 * MiB, WS_W_FOXOUT = 315 * MiB, WS_W_MOEGU = 323 * MiB, WS_W_MOED = 675 * MiB;
constexpr size_t WS_R = 851 * MiB;
constexpr size_t R_PROJ = WS_R + 0 * MiB;
constexpr size_t R_GATES32 = WS_R + 120 * MiB;
constexpr size_t R_LORAIN = WS_R + 128 * MiB;
constexpr size_t R_LORAOUT = WS_R + 136 * MiB;
constexpr size_t R_SC = WS_R + 232 * MiB;
constexpr size_t SC_STRIDE = 32 * MiB;
constexpr size_t R_FR = WS_R + 232 * MiB;
constexpr size_t R_SV = WS_R + 392 * MiB;
constexpr size_t R_Y = WS_R + 424 * MiB;
constexpr size_t R_QB = WS_R + 456 * MiB, R_KB = WS_R + 472 * MiB, R_VB = WS_R + 488 * MiB;
constexpr size_t R_U = WS_R + 504 * MiB;
constexpr size_t R_YCAT = WS_R + 568 * MiB;
constexpr size_t R_XQ = WS_R + 0 * MiB;
constexpr size_t R_XS = WS_R + 32 * MiB;
constexpr size_t R_XP = WS_R + 64 * MiB;
constexpr size_t R_XO = WS_R + 80 * MiB;
constexpr size_t R_ACT = WS_R + 112 * MiB;
constexpr size_t R_QKVG = WS_R + 200 * MiB;
constexpr size_t R_ATTO = WS_R + 328 * MiB;
constexpr size_t R_AG = WS_R + 0 * MiB;
constexpr size_t R_ACTG = WS_R + 72 * MiB;
constexpr size_t R_YG = WS_R + 270 * MiB;
constexpr size_t R_YSIDE = WS_R + 416 * MiB;
constexpr size_t YSIDE_STRIDE = (size_t)8 * 256 * D;
constexpr size_t R_Z = WS_R + 600 * MiB;
constexpr size_t WS_END = WS_R + 624 * MiB;
static_assert(R_YG + (size_t)MOE_ROWS * D * 4 <= WS_END && R_ACTG + (size_t)MOE_ROWS * DFF * 2 <= R_YG && R_YCAT + (size_t)T * D * 2 <= WS_END, "ws map");
static_assert(WS_W_MOED + (size_t)NEXP * D * DFF * 2 <= WS_R && WS_W_MOEGU + (size_t)NEXP * 2 * DFF * D * 2 <= WS_W_MOED, "ws map (weights)");
constexpr int CW_BAR = 4096;
constexpr size_t CTL_SSQ = 65536;

constexpr int RING_OFF = 0, RING_BYTES = 147456;
constexpr int LDSCTL_OFF = RING_BYTES, MISC_OFF = LDSCTL_OFF + 320;
constexpr int LDS_BYTES = RING_BYTES + 4096;

typedef GAS unsigned gu32;
#define RLX_AGENT __ATOMIC_RELAXED, __HIP_MEMORY_SCOPE_AGENT
#define LDS_WAIT() asm volatile("s_waitcnt lgkmcnt(0)" ::: "memory")
#define VM_WAIT() asm volatile("s_waitcnt vmcnt(0)" ::: "memory")

#define XB_TMO      128
#define XB_XCNT(j)  (256  + 64 * (j))
#define XB_XSUB(j)  (1280 + 64 * (j))
#define XB_XGEN(j)  (2304 + 64 * (j))
#define XB_TOP      3328
#define XB_TOPGEN   3392
#define XCD_BAR_WORDS 3456
#define XB_SPIN_CAP (1u << 18)
__device__ __forceinline__ unsigned xb_ld(unsigned* p)              { return __hip_atomic_load(p, __ATOMIC_RELAXED, __HIP_MEMORY_SCOPE_AGENT); }
__device__ __forceinline__ unsigned xb_add(unsigned* p, unsigned v) { return __hip_atomic_fetch_add(p, v, __ATOMIC_RELAXED, __HIP_MEMORY_SCOPE_AGENT); }
__device__ __forceinline__ unsigned xb_xcc_id() { return (unsigned)__builtin_amdgcn_s_getreg((3 << 11) | 20) & 0xFu; }
#define XB_SPIN(cond, bar) do { unsigned _sp = 0; while (cond) { __builtin_amdgcn_s_sleep(1); \
    if ((++_sp & 255u) == 0u) { if (xb_ld(&(bar)[XB_TMO])) break; if (_sp > XB_SPIN_CAP) { atomicAdd(&(bar)[XB_TMO], 1u); break; } } } } while (0)
struct XcdBarrier { unsigned* bar; unsigned x; volatile LAS unsigned* st; };
__device__ __forceinline__ XcdBarrier xcd_barrier_post(unsigned* bar, volatile LAS unsigned* st) {
    XcdBarrier b; b.bar = bar; b.x = xb_xcc_id(); b.st = st;
    if (threadIdx.x == 0) (void)xb_add(&bar[XB_XCNT(b.x)], 1u);
    return b;
}
__device__ __forceinline__ void xcd_barrier_complete(unsigned* bar, unsigned x, unsigned& nloc, unsigned& nx) {
    const unsigned G = gridDim.x * gridDim.y * gridDim.z;
    unsigned sum, cnt, mine, sp = 0u;
    for (;;) {
        sum = 0u; cnt = 0u; mine = 0u;
#pragma unroll
        for (unsigned j = 0; j < 16; ++j) { const unsigned c = xb_ld(&bar[XB_XCNT(j)]); sum += c; cnt += (c > 0u) ? 1u : 0u; mine = (j == x) ? c : mine; }
        if (sum == G) break;
        __builtin_amdgcn_s_sleep(1);
        if ((++sp & 255u) == 0u) { if (xb_ld(&bar[XB_TMO])) break; if (sp > XB_SPIN_CAP) { atomicAdd(&bar[XB_TMO], 1u); break; } }
    }
    nloc = mine > 0u ? mine : 1u; nx = cnt > 0u ? cnt : 1u;
}
__device__ __forceinline__ void xcd_barrier(const XcdBarrier& b) {
    asm volatile("s_waitcnt vmcnt(0)" ::: "memory");
    __syncthreads();
    if (threadIdx.x == 0) {
        unsigned* bar = b.bar;
        __builtin_amdgcn_s_waitcnt(0);
        unsigned nloc = b.st[0], nx = b.st[1];
        if (nloc == 0u) { xcd_barrier_complete(bar, b.x, nloc, nx); b.st[0] = nloc; b.st[1] = nx; }
        const unsigned old = xb_add(&bar[XB_XSUB(b.x)], 1u);
        const unsigned gen = old / nloc;
        if (old + 1u == (gen + 1u) * nloc) {
            __builtin_amdgcn_fence(__ATOMIC_RELEASE, "agent");
            asm volatile("s_waitcnt vmcnt(0)" ::: "memory");
            const unsigned og = xb_add(&bar[XB_TOP], 1u);
            const unsigned tg = og / nx;
            if (og + 1u == (tg + 1u) * nx) xb_add(&bar[XB_TOPGEN], 1u);
            else XB_SPIN(xb_ld(&bar[XB_TOPGEN]) == tg, bar);
            __builtin_amdgcn_fence(__ATOMIC_ACQUIRE, "agent");
            xb_add(&bar[XB_XGEN(b.x)], 1u);
            asm volatile("s_waitcnt vmcnt(0)" ::: "memory");
        } else {
            XB_SPIN(xb_ld(&bar[XB_XGEN(b.x)]) == gen, bar);
            __builtin_amdgcn_fence(__ATOMIC_ACQUIRE, "agent");
            asm volatile("s_waitcnt vmcnt(0)" ::: "memory");
        }
    }
    __syncthreads();
}

struct Frame {
    LAS unsigned char* lds; unsigned char* ldsg;
    unsigned char* ws; const float* const* in; float* out;
    int tid, lane, wave, vcu, G, gw, NGW;
};

enum InIdx { I_X = 0, I_MEM, I_MEMG, I_FING, I_NMIXG, I_NXAG, I_NFFNG, I_XWQ, I_XWKV, I_XWO, I_ABWIN, I_ABMU, I_RWW0, I_RWWUP, I_RWA0, I_RWAUP, I_RWGUP, I_RWKK, I_RWKA, I_RWRK,
             I_RWLNG, I_RWLNB, I_MLCONV, I_MLBIF, I_MLNG, I_ABWOUT, I_FFG, I_FFU, I_FFD, I_FOXWIN, I_FOXBF, I_FOXQG, I_FOXKG, I_FOXWOUT, I_ROUTER, I_MOEG, I_MOEU, I_MOED, N_IN };
struct Args { const float* in[N_IN]; float* out; unsigned char* ws; int ph_lo, ph_hi; };
static_assert(sizeof(Args) == (N_IN + 2) * 8 + 8, "Args has no padding");

#define WSP(T_, off) ((T_*)(F.ws + (off)))

__device__ __forceinline__ void rms_row(const float* xrow, const float* g, bf16* orow, int lane, f32x4 (&y)[8]) {
    const f32x4* xr = (const f32x4*)xrow + lane; const f32x4* gr = (const f32x4*)g + lane;
    float s = 0.f;
#pragma unroll
    for (int j = 0; j < 8; ++j) { y[j] = xr[64 * j]; s += (y[j][0] * y[j][0] + y[j][1] * y[j][1]) + (y[j][2] * y[j][2] + y[j][3] * y[j][3]); }
    const float r = 1.0f / sqrtf(wave_sum(s) * (1.0f / D) + 1e-6f);
#pragma unroll
    for (int j = 0; j < 8; ++j) { const f32x4 gv = gr[64 * j]; y[j] = y[j] * r * gv; }
    if (orow) { u32x2* o8 = (u32x2*)orow + lane;
#pragma unroll
        for (int j = 0; j < 8; ++j) { u32x2 w; w.x = cvt_pk_bf16(y[j][0], y[j][1]); w.y = cvt_pk_bf16(y[j][2], y[j][3]); o8[64 * j] = w; } }
}
__device__ __forceinline__ void norm_phase(const Frame& F, const float* X, const float* g, bf16* XN, int nrows) {
    for (int t = F.gw; t < nrows; t += F.NGW) { f32x4 y[8]; rms_row(X + (size_t)t * D, g, XN + (size_t)t * D, F.lane, y); }
}
template <int NC>
__device__ __forceinline__ void stage_skinny(const Frame& F, const float* W, int ldw, int c0, LAS float* Ws) {
    for (int i = F.tid; i < D * NC; i += NWAVES * 64) { const int e = i / NC, c = i % NC; Ws[c * D + e] = W[(size_t)e * ldw + c0 + c]; }
}
template <int NC>
__device__ __forceinline__ void skinny_dot(const f32x4 (&y)[8], const LAS float* Ws, int lane, float (&out)[NC]) {
#pragma unroll
    for (int c = 0; c < NC; ++c) { float s = 0.f;
#pragma unroll
        for (int j = 0; j < 8; ++j) { const f32x4 w = *(const LAS f32x4*)(Ws + c * D + 256 * j + 4 * lane); s += (y[j][0] * w[0] + y[j][1] * w[1]) + (y[j][2] * w[2] + y[j][3] * w[3]); }
        out[c] = wave_sum(s); }
}

__device__ __forceinline__ void titem_load(const float* W, int ldw, int k0, int n0, int nvalid, int lane, float (&v)[32]) {
    const int n = lane & 31; const float* p = W + (size_t)(k0 + (lane >> 5)) * ldw + n0 + n;
#pragma unroll
    for (int i = 0; i < 32; ++i) v[i] = (n < nvalid) ? __builtin_nontemporal_load(p + (size_t)(2 * i) * ldw) : 0.f;
}
__device__ __forceinline__ void titem_finish(const float (&v)[32], int k0, int nvalid, bf16* WT0  , int K, LAS float* scr, int lane) {
#pragma unroll
    for (int i = 0; i < 32; ++i) scr[(2 * i + (lane >> 5)) * 33 + (lane & 31)] = v[i];
    LDS_WAIT(); asm volatile("" ::: "memory");
    const int c = lane & 7;
#pragma unroll
    for (int j = 0; j < 4; ++j) { const int n = (lane >> 3) + 8 * j; const LAS float* s = scr + (8 * c) * 33 + n;
        u32x4 o; o.x = cvt_pk_bf16(s[0 * 33], s[1 * 33]); o.y = cvt_pk_bf16(s[2 * 33], s[3 * 33]); o.z = cvt_pk_bf16(s[4 * 33], s[5 * 33]); o.w = cvt_pk_bf16(s[6 * 33], s[7 * 33]);
        if (n < nvalid) __builtin_nontemporal_store(o, (u32x4*)(WT0 + (size_t)n * K + k0 + 8 * c)); }
    LDS_WAIT(); asm volatile("" ::: "memory");
}
__device__ __forceinline__ void transpose_matrix(const Frame& F, int gw, int NGW, const float* W, int ldw, int K, int N, bf16* WT, int mode, int& it0, LAS float* scr) {
    const int nblk = (N + 31) / 32, nitems = (K / 64) * nblk;
    int first = gw - (it0 % NGW); if (first < 0) first += NGW;
    it0 += nitems;
    if (first >= nitems) return;
    float va[32], vb[32];
    { const int kb = first / nblk, nb = first % nblk, n0 = 32 * nb; titem_load(W, ldw, 64 * kb, n0, (N - n0) < 32 ? (N - n0) : 32, F.lane, va); }
    for (int r = first; r < nitems; r += NGW) {
        const int kb = r / nblk, nb = r % nblk, n0 = 32 * nb; const int nvalid = (N - n0) < 32 ? (N - n0) : 32;
        const int drow = mode == 0 ? n0 : ((n0 >> 7) * 256 + (n0 & 127) + (mode == 2 ? 128 : 0));
        const int rn = r + NGW;
        if (rn < nitems) { const int kbn = rn / nblk, nbn = rn % nblk, n0n = 32 * nbn; titem_load(W, ldw, 64 * kbn, n0n, (N - n0n) < 32 ? (N - n0n) : 32, F.lane, vb); }
        titem_finish(va, 64 * kb, nvalid, WT + (size_t)drow * K, K, scr, F.lane);
#pragma unroll
        for (int i = 0; i < 32; ++i) va[i] = vb[i];
    }
}
__device__ __forceinline__ void p_convert_early(const Frame& F, const Args& A) {
    LAS float* scr = (LAS float*)(F.lds + RING_OFF + F.wave * 16384);
    int it0 = 0;
    for (int l = 0; l < 2; ++l)
        transpose_matrix(F, F.gw, F.NGW, A.in[I_XWKV] + (size_t)l * D * 2 * D, 2 * D, D, 2 * D, WSP(bf16, WS_W_XKV) + (size_t)l * 2 * D * D, 0, it0, scr);
    transpose_matrix(F, F.gw, F.NGW, A.in[I_ABWIN], AB_COLS, D, AB_COLS, WSP(bf16, WS_W_ABIN), 0, it0, scr);
    const int gt = F.gw * 64 + F.lane, NGT = F.NGW * 64;
    { u32x4* z = (u32x4*)(WSP(bf16, WS_W_ABIN) + (size_t)AB_COLS * D); const int n16 = (AB_PAD - AB_COLS) * D * 2 / 16;
      for (int i = gt; i < n16; i += NGT) z[i] = (u32x4){0u, 0u, 0u, 0u}; }
    { bf16* WL = WSP(bf16, WS_W_LORA); const float* wup = A.in[I_RWWUP]; const float* aup = A.in[I_RWAUP]; const float* gup = A.in[I_RWGUP];
      for (int i = gt; i < 3072 * 64; i += NGT) { const int n = i >> 6, k8 = (i & 63) * 8; const int sec = n >> 10, nn = n & 1023; float v[8];
#pragma unroll
          for (int j = 0; j < 8; ++j) { const int k = k8 + j; float x = 0.f;
              if (sec == 0) { if (k < 96) x = wup[(size_t)k * 1024 + nn]; }
              else if (sec == 1) { if (k >= 96 && k < 192) x = aup[(size_t)(k - 96) * 1024 + nn]; }
              else { if (k >= 192 && k < 448) x = gup[(size_t)(k - 192) * 1024 + nn]; }
              v[j] = x; }
          u32x4 o; o.x = cvt_pk_bf16(v[0], v[1]); o.y = cvt_pk_bf16(v[2], v[3]); o.z = cvt_pk_bf16(v[4], v[5]); o.w = cvt_pk_bf16(v[6], v[7]);
          *(u32x4*)(WL + (size_t)n * 512 + k8) = o; } }
    norm_phase(F, A.in[I_MEM], A.in[I_MEMG], WSP(bf16, WS_MEMN), NMEM);
    norm_phase(F, A.in[I_X], A.in[I_NMIXG], WSP(bf16, WS_XN), T);
}
__device__ __forceinline__ void p_convert_late(const Frame& F, const Args& A, int gw, int NGW, LAS float* scr, bool with_dense, int e_lo, int e_hi) {
    int it0 = 0;
    if (with_dense) {
        transpose_matrix(F, gw, NGW, A.in[I_ABWOUT], D, D, D, WSP(bf16, WS_W_ABOUT), 0, it0, scr);
        for (int l = 0; l < 2; ++l) {
            transpose_matrix(F, gw, NGW, A.in[I_XWQ] + (size_t)l * D * D, D, D, D, WSP(bf16, WS_W_XQ) + (size_t)l * D * D, 0, it0, scr);
            transpose_matrix(F, gw, NGW, A.in[I_XWO] + (size_t)l * D * D, D, D, D, WSP(bf16, WS_W_XO) + (size_t)l * D * D, 0, it0, scr);
        }
        transpose_matrix(F, gw, NGW, A.in[I_FFG], DFF, D, DFF, WSP(bf16, WS_W_FFNGU), 1, it0, scr);
        transpose_matrix(F, gw, NGW, A.in[I_FFU], DFF, D, DFF, WSP(bf16, WS_W_FFNGU), 2, it0, scr);
        transpose_matrix(F, gw, NGW, A.in[I_FFD], D, DFF, D, WSP(bf16, WS_W_FFND), 0, it0, scr);
        transpose_matrix(F, gw, NGW, A.in[I_FOXWIN], FOX_LD, D, 8192, WSP(bf16, WS_W_FOXIN), 0, it0, scr);
        transpose_matrix(F, gw, NGW, A.in[I_FOXWOUT], D, D, D, WSP(bf16, WS_W_FOXOUT), 0, it0, scr);
    }
    for (int e = e_lo; e < e_hi; ++e) {
        transpose_matrix(F, gw, NGW, A.in[I_MOEG] + (size_t)e * D * DFF, DFF, D, DFF, WSP(bf16, WS_W_MOEGU) + (size_t)e * 2 * DFF * D, 1, it0, scr);
        transpose_matrix(F, gw, NGW, A.in[I_MOEU] + (size_t)e * D * DFF, DFF, D, DFF, WSP(bf16, WS_W_MOEGU) + (size_t)e * 2 * DFF * D, 2, it0, scr);
        transpose_matrix(F, gw, NGW, A.in[I_MOED] + (size_t)e * DFF * D, D, DFF, D, WSP(bf16, WS_W_MOED) + (size_t)e * D * DFF, 0, it0, scr);
    }
}

struct InprojKvOrder {
    const bf16* xn; const bf16* wabin; const bf16* memn; const bf16* wkv; int G, c;
    __device__ __forceinline__ bool next(int i, pg8::Unit& u) const {
        const int L = i * G + c; u.pad = 0;
        if (L < 32 * (AB_PAD / 256)) { int pm, pn; pg8::static_tile(i, G, c, 32, AB_PAD / 256, pm, pn); u.pm = pm; u.pn = pn; u.aux = -1;
            u.a = (const char*)(xn + (size_t)pm * 256 * D); u.b = (const char*)(wabin + (size_t)pn * 256 * D); return true; }
        const int j = L - 32 * (AB_PAD / 256); if (j >= 32) return false;
        const int l = j >> 4, kind = (j >> 3) & 1, idx = j & 7; const bf16* w = wkv + (size_t)l * 2 * D * D;
        if (kind == 0) { u.a = (const char*)memn; u.b = (const char*)(w + (size_t)idx * 256 * D); u.pm = 0; u.pn = idx; }
        else { u.a = (const char*)(w + (size_t)(D + idx * 256) * D); u.b = (const char*)memn; u.pm = idx; u.pn = 0; }
        u.aux = l * 2 + kind; return true;
    }
};
struct EpiInprojKv {
    static constexpr bool PERM = true;
    bf16* proj; float* gates32; bf16* kmem; bf16* vtmem;
    __device__ __forceinline__ void operator()(const f32x4 (&acc)[2][2][4][2], const pg8::Unit& u, int wr, int wc, int fr, int fq) const {
        if (u.aux < 0) { pg8::EpiBf16 E{proj, AB_PAD, gates32, 29, nullptr}; E(acc, u, wr, wc, fr, fq); }
        else { const int l = u.aux >> 1, kind = u.aux & 1;
            pg8::EpiBf16 E{kind == 0 ? kmem + (size_t)l * NMEM * D : vtmem + (size_t)l * D * NMEM, kind == 0 ? D : NMEM, nullptr, -1, nullptr};
            E(acc, u, wr, wc, fr, fq); }
    }
};

__device__ __forceinline__ void p_prepa(const Frame& F, const Args& A) {
    const bf16* PROJ = WSP(bf16, R_PROJ); const float* mu = A.in[I_ABMU]; const float* convw = A.in[I_MLCONV];
    bf16* LIN = WSP(bf16, R_LORAIN); bf16* QB = WSP(bf16, R_QB); bf16* KB = WSP(bf16, R_KB); bf16* VB = WSP(bf16, R_VB);
    const int lane = F.lane;
    for (int t = F.gw; t < T; t += F.NGW) {
        const bf16* p0 = PROJ + (size_t)t * AB_PAD;
#pragma unroll
        for (int i = 0; i < 7; ++i) { const int cc = lane + 64 * i, c = 3072 + cc; const float p = bf2f(p0[c]); const float pp = t > 0 ? bf2f(p0[c - AB_PAD]) : 0.f;
            const float s = p + (pp - p) * mu[c]; float o;
            if (cc < 96) o = tanhf(s); else if (cc < 192) o = s; else o = sigmoidf_(s);
            LIN[(size_t)t * 512 + cc] = f2bf(o); }
        LIN[(size_t)t * 512 + 448 + lane] = 0;
#pragma unroll
        for (int i = 0; i < 4; ++i) { const int c = 8 * lane + 512 * i; float acc[8];
#pragma unroll
            for (int j = 0; j < 8; ++j) acc[j] = 0.f;
#pragma unroll
            for (int tap = 0; tap < 4; ++tap) { const int tt = t - 3 + tap; if (tt >= 0) {
                const bf16x8 v = *(const bf16x8*)(PROJ + (size_t)tt * AB_PAD + A_COLS + c); const f32x4 w0 = *(const f32x4*)(convw + tap * 2048 + c), w1 = *(const f32x4*)(convw + tap * 2048 + c + 4);
#pragma unroll
                for (int j = 0; j < 4; ++j) { acc[j] += bf2f((unsigned short)v[j]) * w0[j]; acc[4 + j] += bf2f((unsigned short)v[4 + j]) * w1[j]; } } }
            const float sc = c < 1024 ? 0.0625f : 1.0f; float o[8];
#pragma unroll
            for (int j = 0; j < 8; ++j) o[j] = acc[j] * sigmoidf_(acc[j]) * sc;
            u32x4 w; w.x = cvt_pk_bf16(o[0], o[1]); w.y = cvt_pk_bf16(o[2], o[3]); w.z = cvt_pk_bf16(o[4], o[5]); w.w = cvt_pk_bf16(o[6], o[7]);
            if (c < 1024) *(u32x4*)(QB + (size_t)t * 1024 + c) = w; else *(u32x4*)(KB + (size_t)t * 1024 + c - 1024) = w; }
#pragma unroll
        for (int i = 0; i < 2; ++i) { const int c = 8 * lane + 512 * i; *(u32x4*)(VB + (size_t)t * 1024 + c) = *(const u32x4*)(p0 + 5568 + c); }
    }
    const float* G32 = WSP(float, R_GATES32); const float* bif = A.in[I_MLBIF];
    float* BCUM = WSP(float, WS_SMALL + SM_BCUM); float* IG = WSP(float, WS_SMALL + SM_IG); float* CHBL = WSP(float, WS_SMALL + SM_CHBL); float* CHMD = WSP(float, WS_SMALL + SM_CHMD);
    for (int u = F.gw; u < NH_M * 128; u += F.NGW) { const int h = u >> 7, c = u & 127, t = 64 * c + lane;
        const float ig = G32[(size_t)t * 256 + 192 + h] + bif[h], fg = G32[(size_t)t * 256 + 196 + h] + bif[4 + h];
        float b = logsigmoidf_(fg);
#pragma unroll
        for (int o = 1; o < 64; o <<= 1) { const float x = __shfl_up(b, o); if (lane >= o) b += x; }
        const float bl = __shfl(b, 63); const float md = wave_max(bl - b + ig);
        BCUM[h * T + t] = b; IG[h * T + t] = ig;
        if (lane == 0) { CHBL[u] = bl; CHMD[u] = md; } }
}

__device__ __forceinline__ void p_prepb(const Frame& F, const Args& A) {
    const bf16* PROJ = WSP(bf16, R_PROJ); const float* LOUT = WSP(float, R_LORAOUT); const float* mu = A.in[I_ABMU];
    const float* w0 = A.in[I_RWW0]; const float* a0 = A.in[I_RWA0]; const float* kk_ = A.in[I_RWKK]; const float* ka_ = A.in[I_RWKA]; const float* rk_ = A.in[I_RWRK];
    float* SR = WSP(float, R_SC); float* SW = WSP(float, R_SC + SC_STRIDE); float* SKM = WSP(float, R_SC + 2 * SC_STRIDE); float* SV = WSP(float, R_SC + 3 * SC_STRIDE);
    float* SKK = WSP(float, R_SC + 4 * SC_STRIDE); float* SB = WSP(float, R_SC + 5 * SC_STRIDE); float* BONUS = WSP(float, WS_SMALL + SM_BONUS);
    const int lane = F.lane;
    for (int u = F.gw; u < NH_R * (T / 64); u += F.NGW) { const int h = u & 15, tb = u >> 4, c = 64 * h + lane, t0 = 64 * tb;
        const float mur = mu[c], muk = mu[1024 + c], muv = mu[2048 + c], w0c = w0[c], a0c = a0[c], kkc = kk_[c], kac = ka_[c], rkc = rk_[c];
        float pr = 0.f, pk = 0.f, pv = 0.f;
        if (t0 > 0) { const bf16* pp = PROJ + (size_t)(t0 - 1) * AB_PAD; pr = bf2f(pp[c]); pk = bf2f(pp[1024 + c]); pv = bf2f(pp[2048 + c]); }
        constexpr int GT = 8;
        float xr[GT], xk[GT], xv[GT], lw[GT], la[GT], nr[GT], nk[GT], nv[GT], nw[GT], na[GT];
#define PB_LOAD(dr, dk, dv, dw, da, tt_) do { _Pragma("unroll") for (int i = 0; i < GT; ++i) { const bf16* p0 = PROJ + (size_t)(t0 + (tt_) + i) * AB_PAD; const float* lo = LOUT + (size_t)(t0 + (tt_) + i) * 3072; \
            dr[i] = bf2f(p0[c]); dk[i] = bf2f(p0[1024 + c]); dv[i] = bf2f(p0[2048 + c]); dw[i] = lo[c]; da[i] = lo[1024 + c]; } } while (0)
        PB_LOAD(xr, xk, xv, lw, la, 0);
        for (int tt = 0; tt < 64; tt += GT) {
            if (tt + GT < 64) PB_LOAD(nr, nk, nv, nw, na, tt + GT);
            float kk[GT], km[GT], r[GT], v[GT], a[GT], w[GT], q1[GT], q2[GT];
#pragma unroll
            for (int i = 0; i < GT; ++i) { r[i] = xr[i] + (pr - xr[i]) * mur; const float k = xk[i] + (pk - xk[i]) * muk; v[i] = xv[i] + (pv - xv[i]) * muv; pr = xr[i]; pk = xk[i]; pv = xv[i];
                w[i] = __expf(-0.6065306597126334f * sigmoidf_(lw[i] + w0c)); a[i] = sigmoidf_(a0c + la[i]);
                kk[i] = k * kkc; km[i] = k * (1.0f + (a[i] - 1.0f) * kac); q1[i] = kk[i] * kk[i]; q2[i] = r[i] * km[i] * rkc; }
#pragma unroll
            for (int i = 0; i < GT; ++i) { q1[i] = wave_sum_dpp(q1[i]); q2[i] = wave_sum_dpp(q2[i]); }
#pragma unroll
            for (int i = 0; i < GT; ++i) { const float kn = kk[i] / fmaxf(sqrtf(q1[i]), 1e-12f); const size_t o = (size_t)(t0 + tt + i) * 1024 + c;
                SR[o] = r[i]; SW[o] = w[i]; SKM[o] = km[i]; SV[o] = v[i]; SKK[o] = kn; SB[o] = kn * a[i];
                if (lane == 0) BONUS[(t0 + tt + i) * 16 + h] = q2[i]; }
#pragma unroll
            for (int i = 0; i < GT; ++i) { xr[i] = nr[i]; xk[i] = nk[i]; xv[i] = nv[i]; lw[i] = nw[i]; la[i] = na[i]; }
        }
#undef PB_LOAD
    }
    if (F.gw < NH_M) { const int h = F.gw;
        const float* BCUM = WSP(float, WS_SMALL + SM_BCUM); const float* IG = WSP(float, WS_SMALL + SM_IG); const float* CHBL = WSP(float, WS_SMALL + SM_CHBL); const float* CHMD = WSP(float, WS_SMALL + SM_CHMD);
        float* MSEQ = WSP(float, WS_SMALL + SM_MSEQ); float* WCARRY = WSP(float, WS_SMALL + SM_WCARRY);
        const float bl0 = CHBL[h * 128 + lane], bl1 = CHBL[h * 128 + 64 + lane], md0 = CHMD[h * 128 + lane], md1 = CHMD[h * 128 + 64 + lane];
        float m = 0.f, mine_in0 = 0.f, mine_in1 = 0.f, mine_out0 = 0.f, mine_out1 = 0.f;
#pragma unroll
        for (int c = 0; c < 128; ++c) { const float bl = __shfl(c < 64 ? bl0 : bl1, c & 63), md = __shfl(c < 64 ? md0 : md1, c & 63);
            const float mn = fmaxf(bl + m, md);
            if ((c & 63) == lane) { if (c < 64) { mine_in0 = m; mine_out0 = mn; } else { mine_in1 = m; mine_out1 = mn; } }
            m = mn; }
        MSEQ[h * 128 + lane] = mine_in0; MSEQ[h * 128 + 64 + lane] = mine_in1;
        WCARRY[h * 128 + lane] = __expf(bl0 + mine_in0 - mine_out0); WCARRY[h * 128 + 64 + lane] = __expf(bl1 + mine_in1 - mine_out1);
        float* MOUT = WSP(float, WS_SMALL + SM_MOUT); MOUT[h * 128 + lane] = mine_out0; MOUT[h * 128 + 64 + lane] = mine_out1;
    }
}

__device__ __forceinline__ void p_mlstm_pass2(const Frame& F, bool mine, int hh) {
    const int lane = F.lane;
    if (mine) { const int h = hh;
        const float* CHBL = WSP(float, WS_SMALL + SM_CHBL); const float* CHMD = WSP(float, WS_SMALL + SM_CHMD);
        float* MSEQ = WSP(float, WS_SMALL + SM_MSEQ); float* WCARRY = WSP(float, WS_SMALL + SM_WCARRY);
        const float bl0 = CHBL[h * 128 + lane], bl1 = CHBL[h * 128 + 64 + lane], md0 = CHMD[h * 128 + lane], md1 = CHMD[h * 128 + 64 + lane];
        float m = 0.f, mine_in0 = 0.f, mine_in1 = 0.f, mine_out0 = 0.f, mine_out1 = 0.f;
#pragma unroll
        for (int c = 0; c < 128; ++c) { const float bl = __shfl(c < 64 ? bl0 : bl1, c & 63), md = __shfl(c < 64 ? md0 : md1, c & 63);
            const float mn = fmaxf(bl + m, md);
            if ((c & 63) == lane) { if (c < 64) { mine_in0 = m; mine_out0 = mn; } else { mine_in1 = m; mine_out1 = mn; } }
            m = mn; }
        MSEQ[h * 128 + lane] = mine_in0; MSEQ[h * 128 + 64 + lane] = mine_in1;
        WCARRY[h * 128 + lane] = __expf(bl0 + mine_in0 - mine_out0); WCARRY[h * 128 + 64 + lane] = __expf(bl1 + mine_in1 - mine_out1);
        float* MOUT = WSP(float, WS_SMALL + SM_MOUT); MOUT[h * 128 + lane] = mine_out0; MOUT[h * 128 + 64 + lane] = mine_out1;
    }
}

__device__ __forceinline__ float row16_sum(float x) {
    x += __builtin_bit_cast(float, __builtin_amdgcn_update_dpp(0, __builtin_bit_cast(int, x), 0xB1, 0xF, 0xF, true));
    x += __builtin_bit_cast(float, __builtin_amdgcn_update_dpp(0, __builtin_bit_cast(int, x), 0x4E, 0xF, 0xF, true));
    x += __builtin_bit_cast(float, __builtin_amdgcn_update_dpp(0, __builtin_bit_cast(int, x), 0x141, 0xF, 0xF, true));
    x += __builtin_bit_cast(float, __builtin_amdgcn_update_dpp(0, __builtin_bit_cast(int, x), 0x140, 0xF, 0xF, true));
    return x;
}
__device__ __forceinline__ void row16_sum2(float& a, float& b) {
#define DPPF(x, ctrl) __builtin_bit_cast(float, __builtin_amdgcn_update_dpp(0, __builtin_bit_cast(int, x), ctrl, 0xF, 0xF, true))
    a += DPPF(a, 0xB1); b += DPPF(b, 0xB1); a += DPPF(a, 0x4E); b += DPPF(b, 0x4E); a += DPPF(a, 0x141); b += DPPF(b, 0x141); a += DPPF(a, 0x140); b += DPPF(b, 0x140);
#undef DPPF
}
constexpr int SCH = 8;
constexpr int SC_VEC = SCH * 256;
constexpr int SC_BUF = 5 * SC_VEC + 1024;
constexpr int SC_NBUF = 3, SC_NSEG = 4;
constexpr int SC_LDS = SC_NSEG * SC_NBUF * SC_BUF;
constexpr int SC_PROG_OFF = SC_LDS;
constexpr int SC_TOUCH_AHEAD = 12;
__device__ __forceinline__ void row16_sum4(float& a, float& b, float& c, float& d) {
#define DPPF(x, ctrl) __builtin_bit_cast(float, __builtin_amdgcn_update_dpp(0, __builtin_bit_cast(int, x), ctrl, 0xF, 0xF, true))
    a += DPPF(a, 0xB1); b += DPPF(b, 0xB1); c += DPPF(c, 0xB1); d += DPPF(d, 0xB1); a += DPPF(a, 0x4E); b += DPPF(b, 0x4E); c += DPPF(c, 0x4E); d += DPPF(d, 0x4E);
    a += DPPF(a, 0x141); b += DPPF(b, 0x141); c += DPPF(c, 0x141); d += DPPF(d, 0x141); a += DPPF(a, 0x140); b += DPPF(b, 0x140); c += DPPF(c, 0x140); d += DPPF(d, 0x140);
#undef DPPF
}
__host__ __device__ constexpr int sc_len(int s) { return s == 0 ? 3328 : (s == 3 ? 1664 : 1600); }
__host__ __device__ constexpr int sc_tb(int s) { return s == 0 ? 0 : 3328 + (s - 1) * 1600; }
static_assert(sc_tb(3) + sc_len(3) == T, "segments cover the sequence");
__device__ __forceinline__ int sc_seg_of(int t) { return t < 3328 ? 0 : (t < 4928 ? 1 : (t < 6528 ? 2 : 3)); }
template <int SEGI>
__device__ __forceinline__ void p_scan(const Frame& F) {
    constexpr bool TR = SEGI >= 1; constexpr int TB = sc_tb(SEGI), SC_SEG = sc_len(SEGI), SC_SEG0 = sc_len(0);
    const int b = blockIdx.x, head = (b & 7) * 2 + ((b >> 3) & 1), rg = b >> 4, lane = F.lane, row = lane >> 4, j = lane & 15;
    const float* SR = WSP(float, R_SC); const float* SW = WSP(float, R_SC + SC_STRIDE); const float* SKM = WSP(float, R_SC + 2 * SC_STRIDE); const float* SV = WSP(float, R_SC + 3 * SC_STRIDE);
    const float* SKK = WSP(float, R_SC + 4 * SC_STRIDE); const float* SB = WSP(float, R_SC + 5 * SC_STRIDE);
    float* Yo = WSP(float, R_Y) + (size_t)TB * 1024; float* Zo = WSP(float, R_Z) + (size_t)(TR ? TB - SC_SEG0 : 0) * 1024;
    LAS unsigned char* lds = F.lds + RING_OFF + SEGI * SC_NBUF * SC_BUF;
    volatile LAS int* prog = (volatile LAS int*)(F.lds + RING_OFF + SC_PROG_OFF);
    const size_t goff = (size_t)TB * 1024 + (size_t)(lane >> 4) * 1024 + head * 64 + (lane & 15) * 4;
    f32x2 L0 = {0.f, 0.f}, L1 = {0.f, 0.f}, T0 = {0.f, 0.f}, T1 = {0.f, 0.f};
    if (TR) { const int i = rg * 4 + row; if ((i >> 2) == j) { const int e = i & 3; T0[0] = e == 0 ? 1.f : 0.f; T0[1] = e == 1 ? 1.f : 0.f; T1[0] = e == 2 ? 1.f : 0.f; T1[1] = e == 3 ? 1.f : 0.f; } }
#define SC_ISSUE(c_, buf_) do { const size_t t0_ = (size_t)(c_) * SCH * 1024; LAS unsigned char* d_ = lds + (buf_) * SC_BUF; \
        _Pragma("unroll") for (int q = 0; q < SCH / 4; ++q) { const size_t o_ = t0_ + (size_t)q * 4096 + goff; \
            __builtin_amdgcn_global_load_lds((const unsigned*)(SKK + o_), (LAS unsigned*)(d_ + 0 * SC_VEC + q * 1024), 16, 0, 0); \
            __builtin_amdgcn_global_load_lds((const unsigned*)(SW  + o_), (LAS unsigned*)(d_ + 1 * SC_VEC + q * 1024), 16, 0, 0); \
            __builtin_amdgcn_global_load_lds((const unsigned*)(SB  + o_), (LAS unsigned*)(d_ + 2 * SC_VEC + q * 1024), 16, 0, 0); \
            __builtin_amdgcn_global_load_lds((const unsigned*)(SR  + o_), (LAS unsigned*)(d_ + 3 * SC_VEC + q * 1024), 16, 0, 0); \
            __builtin_amdgcn_global_load_lds((const unsigned*)(SKM + o_), (LAS unsigned*)(d_ + 4 * SC_VEC + q * 1024), 16, 0, 0); } \
        { int ts_ = TB + (c_) * SCH + lane; ts_ = ts_ < T ? ts_ : T - 1; \
          __builtin_amdgcn_global_load_lds((const unsigned*)(SV + (size_t)ts_ * 1024 + head * 64 + rg * 4), (LAS unsigned*)(d_ + 5 * SC_VEC), 16, 0, 0); } } while (0)
    __builtin_amdgcn_s_setprio(3);
    constexpr int NCH = SC_SEG / SCH;
    static_assert(NCH % 2 == 0 && SC_NBUF == 3, "three-buffer pipeline, 11 loads per chunk");
    SC_ISSUE(0, 0); SC_ISSUE(1, 1);
    int buf = 0; float ykL = 0.f, ykT = 0.f; f32x2 rp0 = {0.f, 0.f}, rp1 = {0.f, 0.f};
    for (int c = 0; c < NCH; ++c) {
        if (c < NCH - 1) asm volatile("s_waitcnt vmcnt(11)" ::: "memory"); else asm volatile("s_waitcnt vmcnt(0)" ::: "memory");
        if (c + 2 < NCH) { const int nb = buf >= 1 ? buf - 1 : buf + 2; SC_ISSUE(c + 2, nb); }
        if (SEGI == 0 && lane == 0) *prog = c;
        const LAS unsigned char* d = lds + buf * SC_BUF + j * 16;
        const LAS unsigned char* dv = lds + buf * SC_BUF + 5 * SC_VEC + row * 4;
        const int jb = (c & 1) * SCH;
        f32x2 kkA, kkB, wA, wB, bA, bB, kmA, kmB, rA, rB; float vv;
#define SC_LOAD(s_) do { const f32x4 kk_ = *(const LAS f32x4*)(d + 0 * SC_VEC + (s_) * 256), w_ = *(const LAS f32x4*)(d + 1 * SC_VEC + (s_) * 256), b_ = *(const LAS f32x4*)(d + 2 * SC_VEC + (s_) * 256); \
        const f32x4 r_ = *(const LAS f32x4*)(d + 3 * SC_VEC + (s_) * 256), km_ = *(const LAS f32x4*)(d + 4 * SC_VEC + (s_) * 256); vv = *(const LAS float*)(dv + (s_) * 16); \
        kkA = (f32x2){kk_[0], kk_[1]}; kkB = (f32x2){kk_[2], kk_[3]}; wA = (f32x2){w_[0], w_[1]}; wB = (f32x2){w_[2], w_[3]}; bA = (f32x2){b_[0], b_[1]}; bB = (f32x2){b_[2], b_[3]}; \
        rA = (f32x2){r_[0], r_[1]}; rB = (f32x2){r_[2], r_[3]}; kmA = (f32x2){km_[0], km_[1]}; kmB = (f32x2){km_[2], km_[3]}; } while (0)
        SC_LOAD(0);
#pragma unroll
        for (int s = 0; s < SCH; ++s) {
            f32x2 kk0 = kkA, kk1 = kkB, w0 = wA, w1 = wB, b0 = bA, b1 = bB, r0 = rA, r1 = rB, km0 = kmA, km1 = kmB; float v_ = vv;
            asm volatile("" : "+v"(kk0), "+v"(kk1), "+v"(w0), "+v"(w1), "+v"(b0), "+v"(b1), "+v"(r0), "+v"(r1), "+v"(km0), "+v"(km1), "+v"(v_));
            if (s + 1 < SCH) { SC_LOAD(s + 1); }
            __builtin_amdgcn_sched_barrier(0);
            const int keep = (jb + s + 15) & 15;
            if (TR) {
                f32x2 tl = L0 * kk0, ul = L0 * rp0, tt = T0 * kk0, ut = T0 * rp0; tl = L1 * kk1 + tl; ul = L1 * rp1 + ul; tt = T1 * kk1 + tt; ut = T1 * rp1 + ut;
                float sl = tl[0] + tl[1], yl = ul[0] + ul[1], st = tt[0] + tt[1], yt = ut[0] + ut[1];
                row16_sum4(sl, st, yl, yt);
                ykL = (j == keep) ? yl : ykL; ykT = (j == keep) ? yt : ykT;
                if (s == 0 && jb == 0 && c >= 2) { const size_t o = (size_t)((c - 2) * SCH + j) * 1024 + head * 64 + rg * 4 + row; Yo[o] = ykL; Zo[o] = ykT; }
                L0 = L0 * w0 + (km0 * v_ - b0 * sl); L1 = L1 * w1 + (km1 * v_ - b1 * sl); T0 = T0 * w0 - b0 * st; T1 = T1 * w1 - b1 * st;
            } else {
                f32x2 tl = L0 * kk0, ul = L0 * rp0; tl = L1 * kk1 + tl; ul = L1 * rp1 + ul;
                float sl = tl[0] + tl[1], yl = ul[0] + ul[1];
                row16_sum2(sl, yl);
                ykL = (j == keep) ? yl : ykL;
                if (s == 0 && jb == 0 && c >= 2) Yo[(size_t)((c - 2) * SCH + j) * 1024 + head * 64 + rg * 4 + row] = ykL;
                L0 = L0 * w0 + (km0 * v_ - b0 * sl); L1 = L1 * w1 + (km1 * v_ - b1 * sl);
            }
            rp0 = r0; rp1 = r1;
            __builtin_amdgcn_sched_barrier(0);
        }
#undef SC_LOAD
        buf = buf == SC_NBUF - 1 ? 0 : buf + 1;
    }
    { const size_t o = (size_t)(SC_SEG - 16 + j) * 1024 + head * 64 + rg * 4 + row;
      f32x2 u = L0 * rp0; u = L1 * rp1 + u; const float us = row16_sum(u[0] + u[1]); ykL = (j == 15) ? us : ykL; Yo[o] = ykL;
      if (TR) { f32x2 ut = T0 * rp0; ut = T1 * rp1 + ut; const float ut_ = row16_sum(ut[0] + ut[1]); ykT = (j == 15) ? ut_ : ykT; Zo[o] = ykT; } }
    if (SEGI < SC_NSEG - 1) { float* p = WSP(float, WS_SMALL + SM_SLOC) + (((size_t)SEGI * 16 + head) * 64 + rg * 4 + row) * 64 + 4 * j; *(f32x4*)p = (f32x4){L0[0], L0[1], L1[0], L1[1]}; }
    if (TR && SEGI < SC_NSEG - 1) { float* p = WSP(float, WS_SMALL + SM_PEND) + (((size_t)SEGI * 16 + head) * 64 + rg * 4 + row) * 64 + 4 * j; *(f32x4*)p = (f32x4){T0[0], T0[1], T1[0], T1[1]}; }
    asm volatile("s_waitcnt vmcnt(0)" ::: "memory");
    __builtin_amdgcn_s_setprio(0);
#undef SC_ISSUE
}
__device__ __forceinline__ void p_scan_touch(const Frame& F) {
    const int b = blockIdx.x, head = (b & 7) * 2 + ((b >> 3) & 1), lane = F.lane;
    const char* base = (const char*)WSP(float, R_SC); volatile LAS int* prog = (volatile LAS int*)(F.lds + RING_OFF + SC_PROG_OFF);
    constexpr int NCH0 = sc_len(0) / SCH, LPS = SCH * 12;
    unsigned dummy = 0;
    for (int c = 0; c < NCH0; ++c) {
        for (int spin = 0; spin < (1 << 16) && c > *prog + SC_TOUCH_AHEAD; ++spin) __builtin_amdgcn_s_sleep(8);
#pragma unroll
        for (int q = 0; q < 2; ++q) { const int x = q * 64 + lane; if (x < LPS) { const int step = x / 12, arr = (x % 12) >> 1, half = x & 1;
            const char* p = base + (size_t)arr * SC_STRIDE + ((size_t)(c * SCH + step) * 1024 + head * 64 + half * 32) * 4;
            asm volatile("global_load_dword %0, %1, off" : "+v"(dummy) : "v"(p) : "memory"); } }
        if ((c & 1) == 0) { const int c2 = c >> 1;
#pragma unroll
            for (int q = 0; q < 5; ++q) { const int x = q * 64 + lane; if (x < 3 * LPS) { const int seg = 1 + x / LPS, y = x % LPS, step = y / 12, arr = (y % 12) >> 1, half = y & 1;
                if (c2 * SCH < sc_len(seg)) { const char* p = base + (size_t)arr * SC_STRIDE + ((size_t)(sc_tb(seg) + c2 * SCH + step) * 1024 + head * 64 + half * 32) * 4;
                    asm volatile("global_load_dword %0, %1, off" : "+v"(dummy) : "v"(p) : "memory"); } } } }
    }
    asm volatile("s_waitcnt vmcnt(0)" : "+v"(dummy) :: "memory");
}
__device__ __forceinline__ void p_scomb(const Frame& F) {
    const float* SLOC = WSP(float, WS_SMALL + SM_SLOC); const float* PEND = WSP(float, WS_SMALL + SM_PEND); float* SIN = WSP(float, WS_SMALL + SM_SIN); const int lane = F.lane;
    for (int u = F.gw; u < 16 * 64; u += F.NGW) { const int h = u >> 6, v = u & 63;
        float sv = SLOC[((size_t)(0 * 16 + h) * 64 + v) * 64 + lane];
        SIN[((size_t)(1 * 16 + h) * 64 + v) * 64 + lane] = sv;
#pragma unroll
        for (int s = 2; s < SC_NSEG; ++s) { float acc = SLOC[((size_t)((s - 1) * 16 + h) * 64 + v) * 64 + lane]; const float* P = PEND + ((size_t)((s - 1) * 16 + h) * 64) * 64 + lane;
#pragma unroll 8
            for (int i = 0; i < 64; ++i) acc += __builtin_bit_cast(float, __builtin_amdgcn_readlane(__builtin_bit_cast(int, sv), i)) * P[(size_t)i * 64];
            sv = acc; SIN[((size_t)(s * 16 + h) * 64 + v) * 64 + lane] = sv; } }
}

__device__ __forceinline__ void p_rwkv_post(const Frame& F, const Args& A) {
    const float* Y = WSP(float, R_Y); const float* SV = WSP(float, R_SV); const float* LOUT = WSP(float, R_LORAOUT); const float* BONUS = WSP(float, WS_SMALL + SM_BONUS);
    const float* lng = A.in[I_RWLNG]; const float* lnb = A.in[I_RWLNB]; bf16* YCAT = WSP(bf16, R_YCAT); const int lane = F.lane;
    const float* SIN = WSP(float, WS_SMALL + SM_SIN); const float* Z = WSP(float, R_Z);
    for (int u = F.gw; u < NH_R * (T / 64); u += F.NGW) { const int h = u & 15, tb = u >> 4, c = 64 * h + lane, t0 = 64 * tb; const float lg = lng[c], lb = lnb[c];
        const int seg = 0; const bool seg1 = false; float sm[64];
        if (seg1) {
#pragma unroll
            for (int q = 0; q < 16; ++q) { const f32x4 x = *(const f32x4*)(SIN + ((size_t)(seg * 16 + h) * 64 + lane) * 64 + 4 * q); sm[4 * q] = x[0]; sm[4 * q + 1] = x[1]; sm[4 * q + 2] = x[2]; sm[4 * q + 3] = x[3]; } }
        constexpr int GT = 4;
        float y[GT], sv[GT], g[GT], bo[GT], z[GT], ny[GT], nsv[GT], ng[GT], nbo[GT], nz[GT], d[GT];
#define PP_LOAD(dy, dsv, dg, dbo, dz, tt_) do { _Pragma("unroll") for (int i = 0; i < GT; ++i) { const size_t t = t0 + (tt_) + i; dy[i] = Y[t * 1024 + c]; dsv[i] = SV[t * 1024 + c]; dg[i] = LOUT[t * 3072 + 2048 + c]; dbo[i] = BONUS[t * 16 + h]; \
            dz[i] = seg1 ? Z[(t - sc_len(0)) * 1024 + c] : 0.f; } } while (0)
        PP_LOAD(y, sv, g, bo, z, 0);
        for (int tt = 0; tt < 64; tt += GT) {
            if (tt + GT < 64) PP_LOAD(ny, nsv, ng, nbo, nz, tt + GT);
            if (seg1) {
#pragma unroll
                for (int q = 0; q < 64; ++q) {
#pragma unroll
                    for (int i = 0; i < GT; ++i) y[i] += sm[q] * __builtin_bit_cast(float, __builtin_amdgcn_readlane(__builtin_bit_cast(int, z[i]), q)); } }
#pragma unroll
            for (int i = 0; i < GT; ++i) d[i] = wave_sum_dpp(y[i]);
#pragma unroll
            for (int i = 0; i < GT; ++i) { y[i] -= d[i] * (1.0f / 64.0f); d[i] = y[i] * y[i]; }
#pragma unroll
            for (int i = 0; i < GT; ++i) d[i] = wave_sum_dpp(d[i]);
#pragma unroll
            for (int i = 0; i < GT; ++i) { const float o = (y[i] * (1.0f / sqrtf(d[i] * (1.0f / 64.0f) + 64e-5f)) * lg + lb + bo[i] * sv[i]) * g[i];
                YCAT[(size_t)(t0 + tt + i) * D + c] = f2bf(o); }
#pragma unroll
            for (int i = 0; i < GT; ++i) { y[i] = ny[i]; sv[i] = nsv[i]; g[i] = ng[i]; bo[i] = nbo[i]; z[i] = nz[i]; }
        }
#undef PP_LOAD
    }
}

constexpr int CK = 16, NCK = T / CK;
constexpr int CK_NFR = 19;
constexpr int CKP = 65;
__device__ __forceinline__ void ck_kpos(int k, int& g, int& kq, int& j) { g = k >> 5; const int kl = k & 31; if (kl < 16) { kq = kl >> 2; j = kl & 3; } else { kq = (kl - 16) >> 2; j = 4 + (kl & 3); } }

__device__ __forceinline__ void p_rwkv_chunk(const Frame& F, const Args& A) {
    const bf16* PROJ = WSP(bf16, R_PROJ); const float* LOUT = WSP(float, R_LORAOUT); const float* mu = A.in[I_ABMU];
    const float* w0 = A.in[I_RWW0]; const float* a0 = A.in[I_RWA0]; const float* kk_ = A.in[I_RWKK]; const float* ka_ = A.in[I_RWKA]; const float* rk_ = A.in[I_RWRK];
    float* SV = WSP(float, R_SV); float* BONUS = WSP(float, WS_SMALL + SM_BONUS); unsigned char* FR = WSP(unsigned char, R_FR);
    LAS float* L = (LAS float*)(F.lds + RING_OFF);
    LAS float* sA = L; LAS float* sP = L + 16 * CKP; LAS float* sB = L + 2 * 16 * CKP; LAS float* sKM = L + 3 * 16 * CKP; LAS float* sRH = L + 4 * 16 * CKP;
    LAS float* sCS = L + 5 * 16 * CKP; LAS float* sDM = L + 6 * 16 * CKP; LAS float* sCL = L + 7 * 16 * CKP; LAS float* sDL = L + 8 * 16 * CKP; LAS float* sV = L + 9 * 16 * CKP;
    LAS float* sAn = L + 10 * 16 * CKP; LAS float* sRn = L + 11 * 16 * CKP;
    LAS float* sU = L + 12 * 16 * CKP;
    LAS float* sAP = sU + 4 * 16 * 17;
    LAS float* sDP = sAP + 64 * 17;
    LAS float* sPL = sDP + 16 * 17;
    LAS bf16* sFR = (LAS bf16*)(sPL + 64);
    static_assert(((12 * 16 * CKP + 4 * 16 * 17 + 64 * 17 + 16 * 17 + 64) * 4) % 16 == 0, "fragment image alignment");
    const int tid = F.tid, lane = F.lane, wave = F.wave;
    for (int i = tid; i < CK_NFR * 512; i += NWAVES * 64) sFR[i] = 0;
    __syncthreads();
    const int upb = (NH_R * NCK) / F.G;
    const int r32 = lane & 31, hg = lane >> 5;
    float xr[3], xk[3], xv[3], lw[2], la[2], pm[8];
#define CK_LOAD(u_) do { const int c_ = (u_) >> 4, h_ = (u_) & 15, ch_ = 64 * h_ + lane, ta_ = c_ * CK + 2 * wave; \
        pm[0] = mu[ch_]; pm[1] = mu[1024 + ch_]; pm[2] = mu[2048 + ch_]; pm[3] = w0[ch_]; pm[4] = a0[ch_]; pm[5] = kk_[ch_]; pm[6] = ka_[ch_]; pm[7] = rk_[ch_]; \
        if (ta_ > 0) { const bf16* pp = PROJ + (size_t)(ta_ - 1) * AB_PAD; xr[0] = bf2f(pp[ch_]); xk[0] = bf2f(pp[1024 + ch_]); xv[0] = bf2f(pp[2048 + ch_]); } else { xr[0] = 0.f; xk[0] = 0.f; xv[0] = 0.f; } \
        _Pragma("unroll") for (int i = 0; i < 2; ++i) { const bf16* p0 = PROJ + (size_t)(ta_ + i) * AB_PAD; const float* lo = LOUT + (size_t)(ta_ + i) * 3072; \
            xr[1 + i] = bf2f(p0[ch_]); xk[1 + i] = bf2f(p0[1024 + ch_]); xv[1 + i] = bf2f(p0[2048 + ch_]); lw[i] = lo[ch_]; la[i] = lo[1024 + ch_]; } } while (0)
    CK_LOAD(F.vcu * upb);
    for (int ui = 0; ui < upb; ++ui) { const int u = F.vcu * upb + ui, c = u >> 4, h = u & 15, t0 = c * CK;
        { const int ch = 64 * h + lane; const int ta = t0 + 2 * wave; float pr = xr[0], pk = xk[0], pv = xv[0];
#pragma unroll
          for (int i = 0; i < 2; ++i) { const int t = ta + i, tl = 2 * wave + i;
              const float r = xr[1 + i] + (pr - xr[1 + i]) * pm[0], k = xk[1 + i] + (pk - xk[1 + i]) * pm[1], v = xv[1 + i] + (pv - xv[1 + i]) * pm[2]; pr = xr[1 + i]; pk = xk[1 + i]; pv = xv[1 + i];
              const float w = __expf(-0.6065306597126334f * sigmoidf_(lw[i] + pm[3])), a = sigmoidf_(pm[4] + la[i]);
              float kk = k * pm[5]; const float km = k * (1.0f + (a - 1.0f) * pm[6]);
              const float q1 = wave_sum_dpp(kk * kk), q2 = wave_sum_dpp(r * km * pm[7]);
              kk = kk / fmaxf(sqrtf(q1), 1e-12f);
              sA[tl * CKP + lane] = kk; sP[tl * CKP + lane] = w; sB[tl * CKP + lane] = kk * a; sKM[tl * CKP + lane] = km; sRH[tl * CKP + lane] = r; sV[tl * CKP + lane] = v;
              SV[(size_t)t * 1024 + ch] = v; if (lane == 0) BONUS[t * 16 + h] = q2; } }
        if (ui + 1 < upb) CK_LOAD(u + 1);
        __syncthreads();
        { const int k = tid & 63;
#pragma unroll
          for (int q = 0; q < 2; ++q) { const int t = (tid >> 6) * 2 + q; float Pp = 1.f, P = 1.f, PL = 1.f;
#pragma unroll
              for (int i = 0; i < CK; ++i) { const float wv = sP[i * CKP + k]; PL *= wv; if (i < t) Pp *= wv; if (i <= t) P *= wv; }
              const float inv = 1.0f / P, ratio = PL * inv, kkv = sA[t * CKP + k], bv = sB[t * CKP + k], kmv = sKM[t * CKP + k], rv = sRH[t * CKP + k];
              sCS[t * CKP + k] = bv * inv; sDM[t * CKP + k] = kmv * inv; sCL[t * CKP + k] = bv * ratio; sDL[t * CKP + k] = kmv * ratio;
              sAn[t * CKP + k] = Pp * kkv; sRn[t * CKP + k] = P * rv; if (t == 0) sPL[k] = PL; } }
        if (tid >= 64 && tid < 64 + 128) { const int x = tid - 64, vq = x >> 5, ln = x & 31, n = ln & 15, kq = ln >> 4; u32x4 o; float vv[8];
#pragma unroll
            for (int j = 0; j < 8; ++j) vv[j] = sV[(8 * kq + j) * CKP + 16 * vq + n];
            o.x = cvt_pk_bf16(vv[0], vv[1]); o.y = cvt_pk_bf16(vv[2], vv[3]); o.z = cvt_pk_bf16(vv[4], vv[5]); o.w = cvt_pk_bf16(vv[6], vv[7]);
            *(LAS u32x4*)(sFR + (15 + vq) * 512 + (n + 16 * kq) * 8) = o; }
        __syncthreads();
        if (wave == 0) { const LAS float* ar = (r32 < 16 ? sCS + r32 * CKP : sDM + (r32 - 16) * CKP); const LAS float* br = (r32 < 16 ? sAn + r32 * CKP : sRn + (r32 - 16) * CKP); f32x16 acc = f32x16{};
#pragma unroll
            for (int ks = 0; ks < 4; ++ks) { float av[8], bv[8];
#pragma unroll
                for (int j = 0; j < 8; ++j) { av[j] = ar[16 * ks + 8 * hg + j]; bv[j] = br[16 * ks + 8 * hg + j]; }
                u32x4 pa, pb; pa.x = cvt_pk_bf16(av[0], av[1]); pa.y = cvt_pk_bf16(av[2], av[3]); pa.z = cvt_pk_bf16(av[4], av[5]); pa.w = cvt_pk_bf16(av[6], av[7]);
                pb.x = cvt_pk_bf16(bv[0], bv[1]); pb.y = cvt_pk_bf16(bv[2], bv[3]); pb.z = cvt_pk_bf16(bv[4], bv[5]); pb.w = cvt_pk_bf16(bv[6], bv[7]);
                acc = __builtin_amdgcn_mfma_f32_32x32x16_bf16(__builtin_bit_cast(bf16x8, pa), __builtin_bit_cast(bf16x8, pb), acc, 0, 0, 0); }
#pragma unroll
            for (int q = 0; q < 16; ++q) { const int row = (q & 3) + 8 * (q >> 2) + 4 * hg, col = r32, mat = (row >> 4) + 2 * (col >> 4), i = row & 15, t = col & 15;
                const bool keep = (mat & 2) ? (i <= t) : (i < t); sU[mat * 16 * 17 + i * 17 + t] = keep ? acc[q] : 0.f; } }
        __syncthreads();
        if (tid < 80) { float x[CK]; const bool isA = tid < 64; const int ri = isA ? tid : tid - 64;
#pragma unroll
            for (int t = 0; t < CK; ++t) x[t] = isA ? sAn[t * CKP + ri] : sU[1 * 16 * 17 + ri * 17 + t];
#pragma unroll
            for (int jx = 0; jx < CK - 1; ++jx) { float urow[CK];
#pragma unroll
                for (int t = 0; t < CK; ++t) if (t > jx) urow[t] = sU[jx * 17 + t];
#pragma unroll
                for (int t = 0; t < CK; ++t) if (t > jx) x[t] -= x[jx] * urow[t]; }
            LAS float* dst = isA ? sAP + ri * 17 : sDP + ri * 17;
#pragma unroll
            for (int t = 0; t < CK; ++t) dst[t] = x[t]; }
        __syncthreads();
        {
#define CK_PACK(v_) ({ u32x4 p_; p_.x = cvt_pk_bf16(v_[0], v_[1]); p_.y = cvt_pk_bf16(v_[2], v_[3]); p_.z = cvt_pk_bf16(v_[4], v_[5]); p_.w = cvt_pk_bf16(v_[6], v_[7]); __builtin_bit_cast(bf16x8, p_); })
          if (wave < 4) {
              const int kr = 32 * (wave >> 1) + r32, kc = 32 * (wave & 1) + r32; float av[8], bv[8];
#pragma unroll
              for (int j = 0; j < 8; ++j) { av[j] = sAP[kr * 17 + 8 * hg + j]; bv[j] = sCL[(8 * hg + j) * CKP + kc]; }
              f32x16 acc = __builtin_amdgcn_mfma_f32_32x32x16_bf16(CK_PACK(av), CK_PACK(bv), f32x16{}, 0, 0, 0);
              const float pl = sPL[kc]; const int ktp = kc >> 4, ii = kc & 15;
#pragma unroll
              for (int q = 0; q < 16; ++q) { const int k = 32 * (wave >> 1) + (q & 3) + 8 * (q >> 2) + 4 * hg; const float m = ((k == kc) ? pl : 0.f) - acc[q];
                  int g, kq, j; ck_kpos(k, g, kq, j); sFR[(ktp * 2 + g) * 512 + (ii + 16 * kq) * 8 + j] = f2bf(m); }
          } else if (wave < 6) {
              const int kc = 32 * (wave - 4) + r32; float av[8], bv[8];
#pragma unroll
              for (int j = 0; j < 8; ++j) { av[j] = r32 < 16 ? sDP[r32 * 17 + 8 * hg + j] : 0.f; bv[j] = sCL[(8 * hg + j) * CKP + kc]; }
              f32x16 acc = __builtin_amdgcn_mfma_f32_32x32x16_bf16(CK_PACK(av), CK_PACK(bv), f32x16{}, 0, 0, 0);
              const int ktp = kc >> 4, ii = kc & 15;
#pragma unroll
              for (int q = 0; q < 8; ++q) { const int t = (q & 3) + 8 * (q >> 2) + 4 * hg; const float nv = sDL[t * CKP + kc] - acc[q];
                  sFR[(8 + ktp) * 512 + (ii + 16 * (t >> 3)) * 8 + (t & 7)] = f2bf(nv); }
          } else {
              const int kr = 32 * (wave - 6) + r32; float av[8], bv[8];
#pragma unroll
              for (int j = 0; j < 8; ++j) { av[j] = sAP[kr * 17 + 8 * hg + j]; bv[j] = r32 < 16 ? sU[2 * 16 * 17 + (8 * hg + j) * 17 + r32] : 0.f; }
              f32x16 acc = __builtin_amdgcn_mfma_f32_32x32x16_bf16(CK_PACK(av), CK_PACK(bv), f32x16{}, 0, 0, 0);
              if (r32 < 16) { const int t = r32;
#pragma unroll
                  for (int q = 0; q < 16; ++q) { const int k = 32 * (wave - 6) + (q & 3) + 8 * (q >> 2) + 4 * hg; const float rv = sRn[t * CKP + k] - acc[q];
                      int g, kq, j; ck_kpos(k, g, kq, j); sFR[(12 + g) * 512 + (t + 16 * kq) * 8 + j] = f2bf(rv); } }
              if (wave == 7) {
                  float ev[8];
#pragma unroll
                  for (int j = 0; j < 8; ++j) ev[j] = r32 < 16 ? sDP[r32 * 17 + 8 * hg + j] : 0.f;
                  f32x16 ae = __builtin_amdgcn_mfma_f32_32x32x16_bf16(CK_PACK(ev), CK_PACK(bv), f32x16{}, 0, 0, 0);
                  if (r32 < 16) { const int t = r32;
#pragma unroll
                      for (int q = 0; q < 8; ++q) { const int i = (q & 3) + 8 * (q >> 2) + 4 * hg; const float e = sU[3 * 16 * 17 + i * 17 + t] - ae[q];
                          sFR[14 * 512 + (t + 16 * (i >> 3)) * 8 + (i & 7)] = f2bf(e); } } } }
#undef CK_PACK
        }
        __syncthreads();
        { u32x4* dst = (u32x4*)(FR + ((size_t)(h * NCK + c) * CK_NFR) * 1024); const LAS u32x4* src = (const LAS u32x4*)sFR;
          for (int i = tid; i < CK_NFR * 64; i += NWAVES * 64) dst[i] = src[i]; }
        __syncthreads();
    }
#undef CK_LOAD
}

constexpr int CK2_FLOATS = 9 * 16 * CKP + 4 * 16 * 17 + 64 * 17 + 16 * 17 + 64;
constexpr int CK2_BYTES = CK2_FLOATS * 4 + CK_NFR * 1024;
static_assert((CK2_FLOATS * 4) % 16 == 0 && CK2_BYTES % 16 == 0 && 2 * CK2_BYTES <= RING_BYTES, "two pre-pass groups fit the LDS ring");
__device__ __forceinline__ void p_rwkv_chunk2(const Frame& F, const Args& A) {
    const bf16* PROJ = WSP(bf16, R_PROJ); const float* LOUT = WSP(float, R_LORAOUT); const float* mu = A.in[I_ABMU];
    const float* w0 = A.in[I_RWW0]; const float* a0 = A.in[I_RWA0]; const float* kk_ = A.in[I_RWKK]; const float* ka_ = A.in[I_RWKA]; const float* rk_ = A.in[I_RWRK];
    float* SV = WSP(float, R_SV); float* BONUS = WSP(float, WS_SMALL + SM_BONUS); unsigned char* FR = WSP(unsigned char, R_FR);
    const int tid = F.tid, lane = F.lane, grp = F.wave >> 2, wl = F.wave & 3, ltid = tid & 255, r32 = lane & 31, hg = lane >> 5;
    LAS float* L = (LAS float*)(F.lds + RING_OFF + grp * CK2_BYTES);
    LAS float* sA = L; LAS float* sP = L + 16 * CKP; LAS float* sB = L + 2 * 16 * CKP; LAS float* sKM = L + 3 * 16 * CKP; LAS float* sRH = L + 4 * 16 * CKP;
    LAS float* sCS = L + 5 * 16 * CKP; LAS float* sDM = L + 6 * 16 * CKP; LAS float* sCL = L + 7 * 16 * CKP; LAS float* sDL = L + 8 * 16 * CKP;
    LAS float* sU = L + 9 * 16 * CKP; LAS float* sAP = sU + 4 * 16 * 17; LAS float* sDP = sAP + 64 * 17; LAS float* sPL = sDP + 16 * 17; LAS bf16* sFR = (LAS bf16*)(sPL + 64);
    for (int i = ltid; i < CK_NFR * 512; i += 256) sFR[i] = 0;
    __syncthreads();
    const int upb = (NH_R * NCK) / F.G;
    float xr[5], xk[5], xv[5], lw[4], la[4], pm[8];
#define CK_LOAD(u_) do { const int c_ = (u_) >> 4, h_ = (u_) & 15, ch_ = 64 * h_ + lane, ta_ = c_ * CK + 4 * wl; \
        pm[0] = mu[ch_]; pm[1] = mu[1024 + ch_]; pm[2] = mu[2048 + ch_]; pm[3] = w0[ch_]; pm[4] = a0[ch_]; pm[5] = kk_[ch_]; pm[6] = ka_[ch_]; pm[7] = rk_[ch_]; \
        if (ta_ > 0) { const bf16* pp = PROJ + (size_t)(ta_ - 1) * AB_PAD; xr[0] = bf2f(pp[ch_]); xk[0] = bf2f(pp[1024 + ch_]); xv[0] = bf2f(pp[2048 + ch_]); } else { xr[0] = 0.f; xk[0] = 0.f; xv[0] = 0.f; } \
        _Pragma("unroll") for (int i = 0; i < 4; ++i) { const bf16* p0 = PROJ + (size_t)(ta_ + i) * AB_PAD; const float* lo = LOUT + (size_t)(ta_ + i) * 3072; \
            xr[1 + i] = bf2f(p0[ch_]); xk[1 + i] = bf2f(p0[1024 + ch_]); xv[1 + i] = bf2f(p0[2048 + ch_]); lw[i] = lo[ch_]; la[i] = lo[1024 + ch_]; } } while (0)
#define CK_PACK(v_) ({ u32x4 p_; p_.x = cvt_pk_bf16(v_[0], v_[1]); p_.y = cvt_pk_bf16(v_[2], v_[3]); p_.z = cvt_pk_bf16(v_[4], v_[5]); p_.w = cvt_pk_bf16(v_[6], v_[7]); __builtin_bit_cast(bf16x8, p_); })
    CK_LOAD(F.vcu * upb + grp);
    for (int ui = 0; ui < upb / 2; ++ui) { const int u = F.vcu * upb + 2 * ui + grp, c = u >> 4, h = u & 15, t0 = c * CK;
        { const int ch = 64 * h + lane; const int ta = t0 + 4 * wl; float pr = xr[0], pk = xk[0], pv = xv[0];
#pragma unroll
          for (int i = 0; i < 4; ++i) { const int t = ta + i, tl = 4 * wl + i;
              const float r = xr[1 + i] + (pr - xr[1 + i]) * pm[0], k = xk[1 + i] + (pk - xk[1 + i]) * pm[1], v = xv[1 + i] + (pv - xv[1 + i]) * pm[2]; pr = xr[1 + i]; pk = xk[1 + i]; pv = xv[1 + i];
              const float w = __expf(-0.6065306597126334f * sigmoidf_(lw[i] + pm[3])), a = sigmoidf_(pm[4] + la[i]);
              float kk = k * pm[5]; const float km = k * (1.0f + (a - 1.0f) * pm[6]);
              const float q1 = wave_sum_dpp(kk * kk), q2 = wave_sum_dpp(r * km * pm[7]);
              kk = kk / fmaxf(sqrtf(q1), 1e-12f);
              sA[tl * CKP + lane] = kk; sP[tl * CKP + lane] = w; sB[tl * CKP + lane] = kk * a; sKM[tl * CKP + lane] = km; sRH[tl * CKP + lane] = r;
              sFR[(15 + (lane >> 4)) * 512 + ((lane & 15) + 16 * (tl >> 3)) * 8 + (tl & 7)] = f2bf(v);
              SV[(size_t)t * 1024 + ch] = v; if (lane == 0) BONUS[t * 16 + h] = q2; } }
        if (ui + 1 < upb / 2) CK_LOAD(u + 2);
        __syncthreads();
        { const int k = ltid & 63;
#pragma unroll
          for (int q = 0; q < 4; ++q) { const int t = (ltid >> 6) * 4 + q; float Pp = 1.f, P = 1.f, PL = 1.f;
#pragma unroll
              for (int i = 0; i < CK; ++i) { const float wv = sP[i * CKP + k]; PL *= wv; if (i < t) Pp *= wv; if (i <= t) P *= wv; }
              const float inv = 1.0f / P, ratio = PL * inv, kkv = sA[t * CKP + k], bv = sB[t * CKP + k], kmv = sKM[t * CKP + k], rv = sRH[t * CKP + k];
              sCS[t * CKP + k] = bv * inv; sDM[t * CKP + k] = kmv * inv; sCL[t * CKP + k] = bv * ratio; sDL[t * CKP + k] = kmv * ratio;
              sA[t * CKP + k] = Pp * kkv; sRH[t * CKP + k] = P * rv; if (t == 0) sPL[k] = PL; } }
        __syncthreads();
        if (wl == 0) { const LAS float* ar = (r32 < 16 ? sCS + r32 * CKP : sDM + (r32 - 16) * CKP); const LAS float* br = (r32 < 16 ? sA + r32 * CKP : sRH + (r32 - 16) * CKP); f32x16 acc = f32x16{};
#pragma unroll
            for (int ks = 0; ks < 4; ++ks) { float av[8], bv[8];
#pragma unroll
                for (int j = 0; j < 8; ++j) { av[j] = ar[16 * ks + 8 * hg + j]; bv[j] = br[16 * ks + 8 * hg + j]; }
                acc = __builtin_amdgcn_mfma_f32_32x32x16_bf16(CK_PACK(av), CK_PACK(bv), acc, 0, 0, 0); }
#pragma unroll
            for (int q = 0; q < 16; ++q) { const int row = (q & 3) + 8 * (q >> 2) + 4 * hg, col = r32, mat = (row >> 4) + 2 * (col >> 4), i = row & 15, t = col & 15;
                const bool keep = (mat & 2) ? (i <= t) : (i < t); sU[mat * 16 * 17 + i * 17 + t] = keep ? acc[q] : 0.f; } }
        __syncthreads();
        if (ltid < 80) { float x[CK]; const bool isA = ltid < 64; const int ri = isA ? ltid : ltid - 64;
#pragma unroll
            for (int t = 0; t < CK; ++t) x[t] = isA ? sA[t * CKP + ri] : sU[1 * 16 * 17 + ri * 17 + t];
#pragma unroll
            for (int jx = 0; jx < CK - 1; ++jx) { float urow[CK];
#pragma unroll
                for (int t = 0; t < CK; ++t) if (t > jx) urow[t] = sU[jx * 17 + t];
#pragma unroll
                for (int t = 0; t < CK; ++t) if (t > jx) x[t] -= x[jx] * urow[t]; }
            LAS float* dst = isA ? sAP + ri * 17 : sDP + ri * 17;
#pragma unroll
            for (int t = 0; t < CK; ++t) dst[t] = x[t]; }
        __syncthreads();
        { { const int kr = 32 * (wl >> 1) + r32, kc = 32 * (wl & 1) + r32; float av[8], bv[8];
#pragma unroll
            for (int j = 0; j < 8; ++j) { av[j] = sAP[kr * 17 + 8 * hg + j]; bv[j] = sCL[(8 * hg + j) * CKP + kc]; }
            const f32x16 acc = __builtin_amdgcn_mfma_f32_32x32x16_bf16(CK_PACK(av), CK_PACK(bv), f32x16{}, 0, 0, 0);
            const float pl = sPL[kc]; const int ktp = kc >> 4, ii = kc & 15;
#pragma unroll
            for (int q = 0; q < 16; ++q) { const int k = 32 * (wl >> 1) + (q & 3) + 8 * (q >> 2) + 4 * hg; const float m = ((k == kc) ? pl : 0.f) - acc[q];
                int g, kq, j; ck_kpos(k, g, kq, j); sFR[(ktp * 2 + g) * 512 + (ii + 16 * kq) * 8 + j] = f2bf(m); } }
          if (wl < 2) {
              const int kc = 32 * wl + r32; float av[8], bv[8];
#pragma unroll
              for (int j = 0; j < 8; ++j) { av[j] = r32 < 16 ? sDP[r32 * 17 + 8 * hg + j] : 0.f; bv[j] = sCL[(8 * hg + j) * CKP + kc]; }
              const f32x16 acc = __builtin_amdgcn_mfma_f32_32x32x16_bf16(CK_PACK(av), CK_PACK(bv), f32x16{}, 0, 0, 0);
              const int ktp = kc >> 4, ii = kc & 15;
#pragma unroll
              for (int q = 0; q < 8; ++q) { const int t = (q & 3) + 8 * (q >> 2) + 4 * hg; const float nv = sDL[t * CKP + kc] - acc[q];
                  sFR[(8 + ktp) * 512 + (ii + 16 * (t >> 3)) * 8 + (t & 7)] = f2bf(nv); }
          } else {
              const int kr = 32 * (wl - 2) + r32; float av[8], bv[8];
#pragma unroll
              for (int j = 0; j < 8; ++j) { av[j] = sAP[kr * 17 + 8 * hg + j]; bv[j] = r32 < 16 ? sU[2 * 16 * 17 + (8 * hg + j) * 17 + r32] : 0.f; }
              const f32x16 acc = __builtin_amdgcn_mfma_f32_32x32x16_bf16(CK_PACK(av), CK_PACK(bv), f32x16{}, 0, 0, 0);
              if (r32 < 16) { const int t = r32;
#pragma unroll
                  for (int q = 0; q < 16; ++q) { const int k = 32 * (wl - 2) + (q & 3) + 8 * (q >> 2) + 4 * hg; const float rv = sRH[t * CKP + k] - acc[q];
                      int g, kq, j; ck_kpos(k, g, kq, j); sFR[(12 + g) * 512 + (t + 16 * kq) * 8 + j] = f2bf(rv); } }
              if (wl == 3) {
                  float ev[8];
#pragma unroll
                  for (int j = 0; j < 8; ++j) ev[j] = r32 < 16 ? sDP[r32 * 17 + 8 * hg + j] : 0.f;
                  const f32x16 ae = __builtin_amdgcn_mfma_f32_32x32x16_bf16(CK_PACK(ev), CK_PACK(bv), f32x16{}, 0, 0, 0);
                  if (r32 < 16) { const int t = r32;
#pragma unroll
                      for (int q = 0; q < 8; ++q) { const int i = (q & 3) + 8 * (q >> 2) + 4 * hg; const float e = sU[3 * 16 * 17 + i * 17 + t] - ae[q];
                          sFR[14 * 512 + (t + 16 * (i >> 3)) * 8 + (i & 7)] = f2bf(e); } } } } }
        __syncthreads();
        { u32x4* dst = (u32x4*)(FR + ((size_t)(h * NCK + c) * CK_NFR) * 1024); const LAS u32x4* src = (const LAS u32x4*)sFR;
          for (int i = ltid; i < CK_NFR * 64; i += 256) dst[i] = src[i]; }
        __syncthreads();
    }
#undef CK_LOAD
#undef CK_PACK
}

constexpr int SQ_SLOT = CK_NFR * 1024, SQ_NSLOT = 7, SQ_AHEAD = 6, SQ_TOUCH = 24;
constexpr bool SQ_TOUCH_ON = false;
static_assert(SQ_SLOT * SQ_NSLOT <= RING_BYTES, "fragment ring fits the LDS ring");
__device__ __forceinline__ void p_rwkv_seq(const Frame& F) {
    const int head = blockIdx.x, vq = F.wave & 3, lane = F.lane, n = lane & 15, q = lane >> 4; const bool worker = F.wave < 4;
    const unsigned char* FRh = WSP(unsigned char, R_FR) + (size_t)head * NCK * CK_NFR * 1024 + lane * 16; float* Y = WSP(float, R_Y) + head * 64 + vq * 16 + n;
    LAS unsigned char* lds = F.lds + RING_OFF;
#define SQ_ISSUE(c_, s_) do { const unsigned char* g_ = FRh + (size_t)(c_) * CK_NFR * 1024; LAS unsigned char* d_ = lds + (s_) * SQ_SLOT; \
        _Pragma("unroll") for (int f = 0; f < 5; ++f) if (vq + 4 * f < CK_NFR) __builtin_amdgcn_global_load_lds((const unsigned*)(g_ + (vq + 4 * f) * 1024), (LAS unsigned*)(d_ + (vq + 4 * f) * 1024), 16, 0, 0); } while (0)
#define SQ_READ(dst, s_) do { const LAS unsigned char* d_ = lds + (s_) * SQ_SLOT + lane * 16; _Pragma("unroll") for (int f = 0; f < 15; ++f) dst[f] = *(const LAS bf16x8*)(d_ + f * 1024); \
        dst[15] = *(const LAS bf16x8*)(d_ + (15 + vq) * 1024); } while (0)
#define SQ_STEP(cur, nxt, c_) do { \
        if (worker) { if ((c_) + SQ_AHEAD >= NCK) asm volatile("s_waitcnt vmcnt(0)" ::: "memory"); else if (vq == 3) asm volatile("s_waitcnt vmcnt(36)" ::: "memory"); else asm volatile("s_waitcnt vmcnt(40)" ::: "memory"); }     \
        else if (SQ_TOUCH_ON && F.wave == 4 && (c_) + SQ_TOUCH < NCK) { const unsigned char* g_ = FRh - lane * 16 + (size_t)((c_) + SQ_TOUCH) * CK_NFR * 1024 + lane * 128; \
            _Pragma("unroll") for (int i_ = 0; i_ < 3; ++i_) if (i_ * 64 + lane < CK_NFR * 8) asm volatile("global_load_dword %0, %1, off" : "+v"(dummy) : "v"(g_ + i_ * 8192) : "memory"); }     \
        __builtin_amdgcn_s_barrier();                                                       \
        if (worker) { \
            if ((c_) + SQ_AHEAD < NCK) { SQ_ISSUE((c_) + SQ_AHEAD, sl_free); } \
            if ((c_) + 1 < NCK) SQ_READ(nxt, sl_next); \
            bf16x8 xb[2]; \
            _Pragma("unroll") for (int g = 0; g < 2; ++g) { u32x4 p; p.x = cvt_pk_bf16(X[2 * g][0], X[2 * g][1]); p.y = cvt_pk_bf16(X[2 * g][2], X[2 * g][3]); p.z = cvt_pk_bf16(X[2 * g + 1][0], X[2 * g + 1][1]); p.w = cvt_pk_bf16(X[2 * g + 1][2], X[2 * g + 1][3]); \
                xb[g] = __builtin_bit_cast(bf16x8, p); } \
            f32x4 y = (f32x4){0.f, 0.f, 0.f, 0.f}; \
            y = __builtin_amdgcn_mfma_f32_16x16x32_bf16(cur[14], cur[15], y, 0, 0, 0); \
            y = __builtin_amdgcn_mfma_f32_16x16x32_bf16(cur[12], xb[0], y, 0, 0, 0); \
            y = __builtin_amdgcn_mfma_f32_16x16x32_bf16(cur[13], xb[1], y, 0, 0, 0); \
            f32x4 Xn[4]; \
            _Pragma("unroll") for (int kt = 0; kt < 4; ++kt) { f32x4 a = (f32x4){0.f, 0.f, 0.f, 0.f}; \
                a = __builtin_amdgcn_mfma_f32_16x16x32_bf16(cur[8 + kt], cur[15], a, 0, 0, 0); \
                a = __builtin_amdgcn_mfma_f32_16x16x32_bf16(cur[2 * kt], xb[0], a, 0, 0, 0); \
                a = __builtin_amdgcn_mfma_f32_16x16x32_bf16(cur[2 * kt + 1], xb[1], a, 0, 0, 0); \
                Xn[kt] = a; } \
            _Pragma("unroll") for (int r = 0; r < 4; ++r) Y[(size_t)((c_) * CK + 4 * q + r) * 1024] = y[r]; \
            _Pragma("unroll") for (int kt = 0; kt < 4; ++kt) X[kt] = Xn[kt]; } \
        sl_free = sl_free == SQ_NSLOT - 1 ? 0 : sl_free + 1; sl_next = sl_next == SQ_NSLOT - 1 ? 0 : sl_next + 1; } while (0)
    f32x4 X[4]; unsigned dummy = 0;
#pragma unroll
    for (int i = 0; i < 4; ++i) X[i] = (f32x4){0.f, 0.f, 0.f, 0.f};
    bf16x8 fa[16], fb[16];
    if (worker) {
#pragma unroll
        for (int c = 0; c < SQ_AHEAD; ++c) SQ_ISSUE(c, c); }
    asm volatile("s_waitcnt vmcnt(0)" ::: "memory");
    __builtin_amdgcn_s_barrier();
    if (worker) SQ_READ(fa, 0);
    int sl_free = SQ_AHEAD, sl_next = 1;
    for (int c = 0; c < NCK; c += 2) { SQ_STEP(fa, fb, c); SQ_STEP(fb, fa, c + 1); }
    asm volatile("s_waitcnt vmcnt(0)" : "+v"(dummy) :: "memory");
#undef SQ_ISSUE
#undef SQ_READ
#undef SQ_STEP
}

constexpr int ML_P = 264;
__device__ __forceinline__ void ml_stage_chunk(const Frame& F, const bf16* src  , int h, int c, LAS bf16* dst) {
    for (int i = F.tid; i < 64 * 32; i += NWAVES * 64) { const int s = i >> 5, ch = i & 31;
        *(LAS u32x4*)(dst + s * ML_P + 8 * ch) = *(const u32x4*)(src + (size_t)(64 * c + s) * 1024 + 256 * h + 8 * ch); }
}
__device__ __forceinline__ void p_mlu(const Frame& F, int first, int stride) {
    const bf16* KB = WSP(bf16, R_KB); const bf16* VB = WSP(bf16, R_VB); const float* BCUM = WSP(float, WS_SMALL + SM_BCUM); const float* IG = WSP(float, WS_SMALL + SM_IG);
    const float* CHBL = WSP(float, WS_SMALL + SM_CHBL); const float* MOUT = WSP(float, WS_SMALL + SM_MOUT);
    bf16* U = WSP(bf16, R_U); float* NU = WSP(float, WS_SMALL + SM_NU);
    LAS bf16* Ks = (LAS bf16*)(F.lds + RING_OFF); LAS bf16* Vs = Ks + 64 * ML_P; LAS float* wst = (LAS float*)(Vs + 64 * ML_P);
    const int lane = F.lane, r = lane & 31, hg = lane >> 5, w = F.wave;
    for (int L = first; L < NH_M * 128; L += stride) { const int h = L >> 7, c = L & 127;
        __syncthreads();
        ml_stage_chunk(F, KB, h, c, Ks); ml_stage_chunk(F, VB, h, c, Vs);
        if (F.tid < 64) wst[F.tid] = __expf(CHBL[h * 128 + c] - BCUM[h * T + 64 * c + F.tid] + IG[h * T + 64 * c + F.tid] - MOUT[h * 128 + c]);
        __syncthreads();
        f32x16 acc[8];
#pragma unroll
        for (int nt = 0; nt < 8; ++nt) acc[nt] = f32x16{};
#pragma unroll
        for (int ks = 0; ks < 4; ++ks) { bf16x8 a; float av[8];
#pragma unroll
            for (int jj = 0; jj < 8; ++jj) { const int s = 16 * ks + 8 * hg + jj; av[jj] = bf2f(Vs[s * ML_P + 32 * w + r]) * wst[s]; }
            { u32x4 p; p.x = cvt_pk_bf16(av[0], av[1]); p.y = cvt_pk_bf16(av[2], av[3]); p.z = cvt_pk_bf16(av[4], av[5]); p.w = cvt_pk_bf16(av[6], av[7]); a = __builtin_bit_cast(bf16x8, p); }
#pragma unroll
            for (int nt = 0; nt < 8; ++nt) { bf16x8 b;
#pragma unroll
                for (int jj = 0; jj < 8; ++jj) b[jj] = (short)Ks[(16 * ks + 8 * hg + jj) * ML_P + 32 * nt + r];
                acc[nt] = __builtin_amdgcn_mfma_f32_32x32x16_bf16(a, b, acc[nt], 0, 0, 0); } }
        bf16* Uo = U + ((size_t)(h * 128 + c) * 256 + 32 * w) * 256;
#pragma unroll
        for (int nt = 0; nt < 8; ++nt)
#pragma unroll
            for (int q = 0; q < 16; ++q) { const int vl = (q & 3) + 8 * (q >> 2) + 4 * hg; Uo[(size_t)vl * 256 + 32 * nt + r] = f2bf(acc[nt][q]); }
        if (F.tid < 256) { float s = 0.f;
            for (int ss = 0; ss < 64; ++ss) s += wst[ss] * bf2f(Ks[ss * ML_P + F.tid]);
            NU[(size_t)(h * 128 + c) * 256 + F.tid] = s; }
    }
}
__device__ __forceinline__ void p_mlscan(const Frame& F) {
    bf16* U = WSP(bf16, R_U); float* NU = WSP(float, WS_SMALL + SM_NU); const float* WCARRY = WSP(float, WS_SMALL + SM_WCARRY);
    const int gt = F.gw * 64 + F.lane, NGT = F.NGW * 64;
    for (int it = gt; it < NH_M * 65536 / 4; it += NGT) { const int h = it >> 14, e = (it & 16383) * 4;
        float C0 = 0.f, C1 = 0.f, C2 = 0.f, C3 = 0.f; bf16* p = U + (size_t)h * 128 * 65536 + e;
#pragma unroll 4
        for (int c = 0; c < 128; ++c) { const u32x2 u = *(const u32x2*)(p + (size_t)c * 65536); const float wc = WCARRY[h * 128 + c];
            u32x2 o; o.x = cvt_pk_bf16(C0, C1); o.y = cvt_pk_bf16(C2, C3); *(u32x2*)(p + (size_t)c * 65536) = o;
            C0 = wc * C0 + bf2f(u.x & 0xffffu); C1 = wc * C1 + bf2f(u.x >> 16); C2 = wc * C2 + bf2f(u.y & 0xffffu); C3 = wc * C3 + bf2f(u.y >> 16); } }
    for (int it = gt; it < NH_M * 256; it += NGT) { const int h = it >> 8, k = it & 255; float n = 0.f; float* p = NU + (size_t)h * 128 * 256 + k;
        for (int c = 0; c < 128; ++c) { const float u = p[c * 256]; p[c * 256] = n; n = WCARRY[h * 128 + c] * n + u; } }
}
__device__ __forceinline__ void p_mlout(const Frame& F, const Args& A) {
    const bf16* QB = WSP(bf16, R_QB); const bf16* KB = WSP(bf16, R_KB); const bf16* VB = WSP(bf16, R_VB); const bf16* CS = WSP(bf16, R_U); const float* NC = WSP(float, WS_SMALL + SM_NU);
    const float* BCUM = WSP(float, WS_SMALL + SM_BCUM); const float* IG = WSP(float, WS_SMALL + SM_IG); const float* MSEQ = WSP(float, WS_SMALL + SM_MSEQ);
    const bf16* PROJ = WSP(bf16, R_PROJ); const float* mhg = A.in[I_MLNG]; bf16* YCAT = WSP(bf16, R_YCAT);
    LAS bf16* Qs = (LAS bf16*)(F.lds + RING_OFF); LAS bf16* Ks = Qs + 64 * ML_P; LAS bf16* Vs = Ks + 64 * ML_P; LAS bf16* Ss = Vs + 64 * ML_P;
    LAS float* fa = (LAS float*)(Ss + 64 * 72); LAS float* bch = fa; LAS float* ich = fa + 64; LAS float* mrow = fa + 128; LAS float* wint = fa + 192; LAS float* rsum = fa + 256  ;
    LAS float* nq = fa + 384; LAS float* nvec = fa + 448  ; LAS float* Hs = (LAS float*)(F.lds + RING_OFF);
    const int lane = F.lane, r = lane & 31, hg = lane >> 5, w = F.wave;
    for (int L = F.vcu; L < NH_M * 128; L += F.G) { const int h = L >> 7, c = L & 127;
        __syncthreads();
        ml_stage_chunk(F, QB, h, c, Qs); ml_stage_chunk(F, KB, h, c, Ks); ml_stage_chunk(F, VB, h, c, Vs);
        if (F.tid < 64) { bch[F.tid] = BCUM[h * T + 64 * c + F.tid]; ich[F.tid] = IG[h * T + 64 * c + F.tid]; }
        if (F.tid < 256) nvec[F.tid] = NC[(size_t)(h * 128 + c) * 256 + F.tid];
        const float mc = MSEQ[h * 128 + c];
        __syncthreads();
        if (w == 0) { float g = ich[lane] - bch[lane];
#pragma unroll
            for (int o = 1; o < 64; o <<= 1) { const float x = __shfl_up(g, o); if (lane >= o) g = fmaxf(g, x); }
            const float mr = bch[lane] + fmaxf(mc, g); mrow[lane] = mr; wint[lane] = __expf(bch[lane] + mc - mr); }
        if (w == 1) { float s = 0.f;
            for (int k = 0; k < 256; ++k) s += nvec[k] * bf2f(Qs[lane * ML_P + k]);
            nq[lane] = s; }
        __syncthreads();
        if (w < 4) { const int st = w & 1, lt = w >> 1; f32x16 acc = f32x16{};
#pragma unroll
            for (int ks = 0; ks < 16; ++ks) { const bf16x8 a = *(const LAS bf16x8*)(Ks + (32 * st + r) * ML_P + 16 * ks + 8 * hg), b = *(const LAS bf16x8*)(Qs + (32 * lt + r) * ML_P + 16 * ks + 8 * hg);
                acc = __builtin_amdgcn_mfma_f32_32x32x16_bf16(a, b, acc, 0, 0, 0); }
            const int l = 32 * lt + r; const float bl_ = bch[l], mr = mrow[l]; float rs = 0.f;
#pragma unroll
            for (int g4 = 0; g4 < 4; ++g4) { float v4[4];
#pragma unroll
                for (int i = 0; i < 4; ++i) { const int s = 32 * st + 8 * g4 + 4 * hg + i; const float d = bl_ - bch[s] + ich[s] - mr;
                    v4[i] = (s <= l) ? acc[4 * g4 + i] * __expf(d) : 0.f; rs += v4[i]; }
                u32x2 p; p.x = cvt_pk_bf16(v4[0], v4[1]); p.y = cvt_pk_bf16(v4[2], v4[3]);
                *(LAS u32x2*)(Ss + l * 72 + 32 * st + 8 * g4 + 4 * hg) = p; }
            rs += __shfl_xor(rs, 32);
            if (hg == 0) rsum[st * 64 + l] = rs; }
        __syncthreads();
        const int lt = w & 1, vg = w >> 1; f32x16 ai[2], aa[2]; ai[0] = f32x16{}; ai[1] = f32x16{}; aa[0] = f32x16{}; aa[1] = f32x16{};
        const bf16* Cb = CS + (size_t)(h * 128 + c) * 65536;
#pragma unroll 4
        for (int ks = 0; ks < 16; ++ks) { const bf16x8 a = *(const LAS bf16x8*)(Qs + (32 * lt + r) * ML_P + 16 * ks + 8 * hg);
#pragma unroll
            for (int jt = 0; jt < 2; ++jt) { const bf16x8 b = *(const bf16x8*)(Cb + (size_t)(64 * vg + 32 * jt + r) * 256 + 16 * ks + 8 * hg);
                ai[jt] = __builtin_amdgcn_mfma_f32_32x32x16_bf16(a, b, ai[jt], 0, 0, 0); } }
#pragma unroll
        for (int ks = 0; ks < 4; ++ks) { const bf16x8 a = *(const LAS bf16x8*)(Ss + (32 * lt + r) * 72 + 16 * ks + 8 * hg);
#pragma unroll
            for (int jt = 0; jt < 2; ++jt) { bf16x8 b;
#pragma unroll
                for (int jj = 0; jj < 8; ++jj) b[jj] = (short)Vs[(16 * ks + 8 * hg + jj) * ML_P + 64 * vg + 32 * jt + r];
                aa[jt] = __builtin_amdgcn_mfma_f32_32x32x16_bf16(a, b, aa[jt], 0, 0, 0); } }
        __syncthreads();
#pragma unroll
        for (int q = 0; q < 16; ++q) { const int l = 32 * lt + (q & 3) + 8 * (q >> 2) + 4 * hg; const float wi = wint[l];
            const float den = rsum[l] + rsum[64 + l] + wi * nq[l]; const float dn = 1.0f / fmaxf(fabsf(den), __expf(-mrow[l]));
#pragma unroll
            for (int jt = 0; jt < 2; ++jt) Hs[l * 260 + 64 * vg + 32 * jt + r] = (aa[jt][q] + wi * ai[jt][q]) * dn; }
        __syncthreads();
        for (int i = 0; i < 8; ++i) { const int l = 8 * w + i, t = 64 * c + l; const f32x4 hv = *(const LAS f32x4*)(Hs + l * 260 + 4 * lane);
            const float ss = wave_sum((hv[0] * hv[0] + hv[1] * hv[1]) + (hv[2] * hv[2] + hv[3] * hv[3])); const float rn = 1.0f / sqrtf(ss * (1.0f / 256.0f) + 1e-6f);
            const f32x4 g = *(const f32x4*)(mhg + 256 * h + 4 * lane); const u32x2 ob = *(const u32x2*)(PROJ + (size_t)t * AB_PAD + 6592 + 256 * h + 4 * lane);
            const float o0 = hv[0] * rn * g[0] * sigmoidf_(bf2f(ob.x & 0xffffu)), o1 = hv[1] * rn * g[1] * sigmoidf_(bf2f(ob.x >> 16));
            const float o2 = hv[2] * rn * g[2] * sigmoidf_(bf2f(ob.y & 0xffffu)), o3 = hv[3] * rn * g[3] * sigmoidf_(bf2f(ob.y >> 16));
            u32x2 p; p.x = cvt_pk_bf16(o0, o1); p.y = cvt_pk_bf16(o2, o3);
            *(u32x2*)(YCAT + (size_t)t * D + 1024 + 256 * h + 4 * lane) = p; }
    }
}

struct XsOrder {
    const bf16* XQ; const bf16* KM; int G, c;
    __device__ __forceinline__ bool next(int i, pg8::Unit& u) const {
        const int L = i * G + c; if (L >= 32 * 4) return false;
        const int pm = L >> 2, hd = L & 3; u.pm = pm; u.pn = 0; u.aux = hd; u.pad = 0;
        u.a = (const char*)(XQ + (size_t)pm * 256 * D + 512 * hd); u.b = (const char*)(KM + 512 * hd); return true;
    }
};
struct XpvOrder {
    const bf16* XP; const bf16* VT; int G, c;
    __device__ __forceinline__ bool next(int i, pg8::Unit& u) const {
        int pm, pn; if (!pg8::static_tile(i, G, c, 32, 8, pm, pn)) return false;
        u.pm = pm; u.pn = pn; u.aux = 0; u.pad = 0;
        u.a = (const char*)(XP + (size_t)pm * 256 * 1024 + 256 * (pn >> 1)); u.b = (const char*)(VT + (size_t)pn * 256 * NMEM); return true;
    }
};
__device__ __forceinline__ void p_xsoftmax(const Frame& F) {
    const float* XS = WSP(float, R_XS); bf16* XP = WSP(bf16, R_XP); const int lane = F.lane;
    for (int t = F.gw; t < T; t += F.NGW)
#pragma unroll
        for (int hd = 0; hd < 4; ++hd) { const f32x4 s = *(const f32x4*)(XS + (size_t)t * 1024 + 256 * hd + 4 * lane);
            const float m = wave_max(fmaxf(fmaxf(s[0], s[1]), fmaxf(s[2], s[3])));
            const float e0 = __expf(s[0] - m), e1 = __expf(s[1] - m), e2 = __expf(s[2] - m), e3 = __expf(s[3] - m);
            const float inv = 1.0f / wave_sum((e0 + e1) + (e2 + e3));
            u32x2 p; p.x = cvt_pk_bf16(e0 * inv, e1 * inv); p.y = cvt_pk_bf16(e2 * inv, e3 * inv);
            *(u32x2*)(XP + (size_t)t * 1024 + 256 * hd + 4 * lane) = p; }
}

__device__ __forceinline__ void p_norm_fpre(const Frame& F, const Args& A) {
    LAS float* Ws = (LAS float*)(F.lds + RING_OFF);
    stage_skinny<16>(F, A.in[I_FOXWIN], FOX_LD, 8192, Ws);
    __syncthreads();
    const float* X = WSP(float, WS_X); bf16* XN = WSP(bf16, WS_XN); float* FPRE = WSP(float, WS_SMALL + SM_FPRE); const float* g = A.in[I_NMIXG] + D;
    for (int t = F.gw; t < T; t += F.NGW) { f32x4 y[8]; rms_row(X + (size_t)t * D, g, XN + (size_t)t * D, F.lane, y);
        float o[16]; skinny_dot<16>(y, Ws, F.lane, o);
        if (F.lane < 16) { float v = o[0];
#pragma unroll
            for (int c = 1; c < 16; ++c) v = (F.lane == c) ? o[c] : v;
            FPRE[t * 16 + F.lane] = v; } }
    __syncthreads();
}
__device__ __forceinline__ void p_foxprep(const Frame& F, const Args& A) {
    bf16* QKVG = WSP(bf16, R_QKVG); const float* qg = A.in[I_FOXQG]; const float* kg = A.in[I_FOXKG]; const int lane = F.lane;
    for (int it = F.gw; it < 2 * T; it += F.NGW) { const int t = it >> 1, sec = it & 1; const float* gg = sec ? kg : qg; const float g0 = gg[2 * lane], g1 = gg[2 * lane + 1];
        unsigned* row = (unsigned*)(QKVG + (size_t)t * 8192 + sec * 2048) + lane;
#pragma unroll 4
        for (int h = 0; h < NH_F; ++h) { const unsigned u = row[64 * h]; const float a = bf2f(u & 0xffffu), b = bf2f(u >> 16);
            const float rn = 1.0f / sqrtf(wave_sum(a * a + b * b) * (1.0f / 128.0f) + 1e-6f);
            row[64 * h] = cvt_pk_bf16(a * rn * g0, b * rn * g1); } }
    if (F.gw < NH_F) { const int h = F.gw; const float* FPRE = WSP(float, WS_SMALL + SM_FPRE); float* BL = WSP(float, WS_SMALL + SM_BIASL2); const float bf = A.in[I_FOXBF][h];
        float carry = 0.f;
        for (int c0 = 0; c0 < 128; c0 += 16) { float v[16];
#pragma unroll
            for (int i = 0; i < 16; ++i) v[i] = FPRE[(size_t)(64 * (c0 + i) + lane) * 16 + h];
#pragma unroll
            for (int i = 0; i < 16; ++i) { float b = logsigmoidf_(v[i] + bf);
#pragma unroll
                for (int o = 1; o < 64; o <<= 1) { const float x = __shfl_up(b, o); if (lane >= o) b += x; }
                b += carry; BL[h * T + 64 * (c0 + i) + lane] = -1.4426950408889634f * b; carry = __shfl(b, 63); } } }
}
__device__ __forceinline__ void p_foxattn(const Frame& F) {
    const bf16* QKVG = WSP(bf16, R_QKVG); bf16* ATTO = WSP(bf16, R_ATTO); const float* BL = WSP(float, WS_SMALL + SM_BIASL2);
    char* lds = (char*)F.ldsg + RING_OFF;
    for (int L = F.vcu; L < 256; L += F.G) { const int h = L >> 4, x = L & 15;
        __syncthreads();
        { float* bl = (float*)(lds + fox::BIAS_OFF); for (int i = F.tid; i < T / 4; i += NWAVES * 64) *(f32x4*)(bl + 4 * i) = *(const f32x4*)(BL + (size_t)h * T + 4 * i); }
        fox::BlockRef b0, b1; const int q0 = x, q1 = 31 - x;
        b0.Q = QKVG + (size_t)q0 * 256 * 8192 + 128 * h; b0.K = QKVG + 2048 + 128 * h; b0.V = QKVG + 4096 + 128 * h; b0.G = QKVG + (size_t)q0 * 256 * 8192 + 6144 + 128 * h;
        b0.O = ATTO + (size_t)q0 * 256 * D + 128 * h; b0.P0 = q0 * 256;
        b1 = b0; b1.Q = QKVG + (size_t)q1 * 256 * 8192 + 128 * h; b1.G = QKVG + (size_t)q1 * 256 * 8192 + 6144 + 128 * h; b1.O = ATTO + (size_t)q1 * 256 * D + 128 * h; b1.P0 = q1 * 256;
        fox::Seam S;
        fox::prime(b0, lds, S);
#ifdef FOX_LOOP
        for (int pass = 0; pass < 2; ++pass) { fox::block(b0, b1, lds, S); b0 = b1; }
#else
        fox::block(b0, b1, lds, S);
        fox::block(b1, b1, lds, S);
#endif
    }
}

__device__ __forceinline__ void p_norm_route(const Frame& F, const Args& A) {
    LAS float* Ws = (LAS float*)(F.lds + RING_OFF); LAS int* cnt = (LAS int*)(F.lds + RING_OFF + 8 * D * 4);
    stage_skinny<8>(F, A.in[I_ROUTER], NEXP, 0, Ws);
    if (F.tid < 8) cnt[F.tid] = 0;
    __syncthreads();
    const float* X = WSP(float, WS_X); bf16* XN = WSP(bf16, WS_XN); const float* g = A.in[I_NFFNG] + D;
    int* TOPI = WSP(int, WS_SMALL + SM_TOPI); float* TOPG = WSP(float, WS_SMALL + SM_TOPG); int* BLKCNT = WSP(int, WS_SMALL + SM_BLKCNT);
    const int b = blockIdx.x;
    for (int i = 0; i < 4; ++i) { const int t = 32 * b + 4 * F.wave + i; f32x4 y[8]; rms_row(X + (size_t)t * D, g, XN + (size_t)t * D, F.lane, y);
        float o[8]; skinny_dot<8>(y, Ws, F.lane, o);
        int i1 = 0; float v1 = o[0];
#pragma unroll
        for (int e = 1; e < 8; ++e) if (o[e] > v1) { v1 = o[e]; i1 = e; }
        int i2 = -1; float v2 = -__builtin_inff();
#pragma unroll
        for (int e = 0; e < 8; ++e) if (e != i1 && o[e] > v2) { v2 = o[e]; i2 = e; }
        const float e2 = __expf(v2 - v1), g1 = 1.0f / (1.0f + e2), g2 = e2 * g1;
        if (F.lane == 0) { TOPI[2 * t] = i1; TOPI[2 * t + 1] = i2; TOPG[2 * t] = g1; TOPG[2 * t + 1] = g2; __hip_atomic_fetch_add(&cnt[i1], 1, __ATOMIC_RELAXED, __HIP_MEMORY_SCOPE_WORKGROUP); __hip_atomic_fetch_add(&cnt[i2], 1, __ATOMIC_RELAXED, __HIP_MEMORY_SCOPE_WORKGROUP); } }
    __syncthreads();
    if (F.tid < 8) BLKCNT[b * 8 + F.tid] = cnt[F.tid];
}
__device__ __forceinline__ void p_route2(const Frame& F) {
    LAS int* sh = (LAS int*)(F.lds + RING_OFF);
    const int* BLKCNT = WSP(int, WS_SMALL + SM_BLKCNT); const int* TOPI = WSP(int, WS_SMALL + SM_TOPI); int* SLOT = WSP(int, WS_SMALL + SM_SLOT); int* TILEE = WSP(int, WS_SMALL + SM_TILEE);
    const bf16* XN = WSP(bf16, WS_XN); bf16* AG = WSP(bf16, R_AG); const int b = blockIdx.x;
    __syncthreads();
    if (F.tid < 8) { int tot = 0, pre = 0; for (int bb = 0; bb < 256; ++bb) { const int v = BLKCNT[bb * 8 + F.tid]; if (bb < b) pre += v; tot += v; } sh[F.tid] = tot; sh[8 + F.tid] = pre; }
    __syncthreads();
    if (F.tid == 0) { int off = 0, nt = 0; for (int e = 0; e < 8; ++e) { sh[16 + e] = off; const int n = (sh[e] + 255) >> 8; if (b == 0) for (int i = 0; i < n; ++i) TILEE[1 + nt + i] = e; nt += n; off += n * 256; } if (b == 0) TILEE[0] = nt; }
    __syncthreads();
    if (F.wave == 0) { const int t = 32 * b + (F.lane >> 1), e = TOPI[2 * t + (F.lane & 1)]; int rank = 0;
#pragma unroll
        for (int ee = 0; ee < 8; ++ee) { const unsigned long long m = __ballot(e == ee); if (e == ee) rank = __popcll(m & ((1ull << F.lane) - 1ull)); }
        const int slot = sh[16 + e] + sh[8 + e] + rank; SLOT[2 * t + (F.lane & 1)] = slot; sh[32 + F.lane] = slot; }
    __syncthreads();
    for (int p = F.wave; p < 64; p += NWAVES) { const int t = 32 * b + (p >> 1), slot = sh[32 + p]; const u32x4* src = (const u32x4*)(XN + (size_t)t * D); u32x4* dst = (u32x4*)(AG + (size_t)slot * D);
#pragma unroll
        for (int j = 0; j < 4; ++j) dst[F.lane + 64 * j] = src[F.lane + 64 * j]; }
}
struct MoeOrder {
    const bf16* Arows; const bf16* W; const int* tilee; int lda, nN; size_t wstride; int G, c; bool whole_rounds;
    __device__ __forceinline__ bool next(int i, pg8::Unit& u) const {
        const int nt = tilee[0]; const long L = (long)i * G + c; long nu = (long)nt * nN; if (whole_rounds) nu = (nu / G) * G; if (L >= nu) return false;
        const int ti = (int)(L / nN), pn = (int)(L % nN), e = tilee[1 + ti];
        u.pm = ti; u.pn = pn; u.aux = e; u.pad = 0; u.a = (const char*)(Arows + (size_t)ti * 256 * lda); u.b = (const char*)(W + (size_t)e * wstride + (size_t)pn * 256 * lda); return true;
    }
};
constexpr int MOE_KSPLIT = 4;
struct MoeSplitOrder {
    const bf16* Arows; const bf16* W; const int* tilee; int lda, nN, kslice; size_t wstride; int G, c;
    __device__ __forceinline__ bool next(int i, pg8::Unit& u) const {
        const int nt = tilee[0]; const long nu = (long)nt * nN, nfull = (nu / G) * G; const long L = (long)i * G + c; if (L >= (nu - nfull) * MOE_KSPLIT) return false;
        const long j = nfull + L / MOE_KSPLIT; const int kq = (int)(L % MOE_KSPLIT); const int ti = (int)(j / nN), pn = (int)(j % nN), e = tilee[1 + ti];
        u.pm = ti; u.pn = pn; u.aux = kq; u.pad = 0; u.a = (const char*)(Arows + (size_t)ti * 256 * lda + (size_t)kq * kslice); u.b = (const char*)(W + (size_t)e * wstride + (size_t)pn * 256 * lda + (size_t)kq * kslice); return true;
    }
};
__device__ __forceinline__ void p_final(const Frame& F, const Args& A) {
    const float* X = WSP(float, WS_X); const float* YG = WSP(float, R_YG); const float* YS = WSP(float, R_YSIDE); const int* SLOT = WSP(int, WS_SMALL + SM_SLOT); const float* TOPG = WSP(float, WS_SMALL + SM_TOPG);
    const float* g = A.in[I_FING]; const int lane = F.lane;
    const int nt = WSP(int, WS_SMALL + SM_TILEE)[0]; const int srow0 = (((nt * 8) / F.G) * F.G / 8) * 256;
    for (int t = F.gw; t < T; t += F.NGW) { const int s1 = SLOT[2 * t], s2 = SLOT[2 * t + 1]; const float g1 = TOPG[2 * t], g2 = TOPG[2 * t + 1];
        const f32x4* xr = (const f32x4*)(X + (size_t)t * D) + lane; const f32x4* y1 = (const f32x4*)(YG + (size_t)s1 * D) + lane; const f32x4* y2 = (const f32x4*)(YG + (size_t)s2 * D) + lane;
        f32x4 v[8]; float s = 0.f;
#pragma unroll
        for (int j = 0; j < 8; ++j) { f32x4 a = y1[64 * j], b = y2[64 * j];
            if (s1 >= srow0) { const f32x4* p = (const f32x4*)(YS + (size_t)(s1 - srow0) * D) + lane + 64 * j; a = a + ((p[0] + p[YSIDE_STRIDE / 4]) + p[2 * (YSIDE_STRIDE / 4)]); }
            if (s2 >= srow0) { const f32x4* p = (const f32x4*)(YS + (size_t)(s2 - srow0) * D) + lane + 64 * j; b = b + ((p[0] + p[YSIDE_STRIDE / 4]) + p[2 * (YSIDE_STRIDE / 4)]); }
            v[j] = xr[64 * j] + (a * g1 + b * g2); s += (v[j][0] * v[j][0] + v[j][1] * v[j][1]) + (v[j][2] * v[j][2] + v[j][3] * v[j][3]); }
        const float r = 1.0f / sqrtf(wave_sum(s) * (1.0f / D) + 1e-6f); f32x4* o = (f32x4*)(A.out + (size_t)t * D) + lane;
#pragma unroll
        for (int j = 0; j < 8; ++j) o[64 * j] = v[j] * r * ((const f32x4*)g)[lane + 64 * j]; }
}

enum Phase { PH_CONV = 0, PH_INPROJ0, PH_PREPA, PH_LORA, PH_PREPB, PH_SCAN, PH_MLSCAN, PH_MLOUT, PH_OUTPROJ0,
             PH_NORMX0, PH_XQ0, PH_XS0, PH_XPV0, PH_XO0, PH_NORMF0, PH_FFNGU, PH_FFND,
             PH_NORMM1, PH_FOXIN, PH_FOXPREP, PH_FOXATT, PH_FOXOUT,
             PH_NORMX1, PH_XQ1, PH_XS1, PH_XPV1, PH_XO1, PH_NORMF1, PH_ROUTE2, PH_MOEGU, PH_MOED, PH_FINAL, N_PHASES };

__global__ void __launch_bounds__(NWAVES * 64, 2) trunk_fwd(Args A) {
    extern __shared__ __attribute__((aligned(16))) unsigned char lds[];
    Frame F;
    F.lds = (LAS unsigned char*)lds; F.ldsg = lds; F.ws = A.ws;
    F.tid = threadIdx.x; F.lane = F.tid & 63; F.wave = __builtin_amdgcn_readfirstlane(F.tid >> 6);
    F.G = gridDim.x; { const int bx = blockIdx.x; F.vcu = (F.G % 8 == 0) ? (bx % 8) * (F.G / 8) + bx / 8 : bx; }
    F.gw = F.vcu * NWAVES + F.wave; F.NGW = F.G * NWAVES;
    volatile LAS unsigned* MISC = (volatile LAS unsigned*)(F.lds + MISC_OFF);
    for (int u = F.tid; u < (LDS_BYTES - LDSCTL_OFF) / 4; u += NWAVES * 64) ((LAS unsigned*)(F.lds + LDSCTL_OFF))[u] = 0u;
    __syncthreads();
    const int lo = A.ph_lo, hi = A.ph_hi;
    const bool multi = (hi - lo) > 1;
    XcdBarrier bar; bar.bar = (unsigned*)(A.ws + WS_CTL) + CW_BAR; bar.x = 0; bar.st = nullptr;
    if (multi) bar = xcd_barrier_post((unsigned*)(A.ws + WS_CTL) + CW_BAR, MISC + 8);
#ifndef PH_ENABLE
#define PH_ENABLE 0xFFFFFFFFFFFFFFFFull
#endif
#define IN(k) ((((PH_ENABLE) >> (k)) & 1ull) && lo <= (k) && (k) < hi)
#ifndef PROBE_DUP
#define PROBE_DUP 0ull
#endif
#define DUP(k) if ((((PROBE_DUP) >> (k)) & 1ull) != 0ull)
#define SEAM(k) do { if (IN(k) && IN((k) + 1)) xcd_barrier(bar); } while (0)
    LAS unsigned char* ring = F.lds + RING_OFF;
    const int cb = (int)blockIdx.x;
    float* const SSQ = (float*)(A.ws + WS_CTL + CTL_SSQ);

    constexpr int MOE_E_EARLY = 0;
    if (IN(PH_CONV)) { p_convert_early(F, A); if (MOE_E_EARLY > 0) p_convert_late(F, A, F.gw, F.NGW, (LAS float*)(F.lds + RING_OFF + F.wave * 16384), false, 0, MOE_E_EARLY); } SEAM(PH_CONV);
    if (IN(PH_INPROJ0)) { InprojKvOrder S{WSP(bf16, WS_XN), WSP(bf16, WS_W_ABIN), WSP(bf16, WS_MEMN), WSP(bf16, WS_W_XKV), F.G, cb};
        EpiInprojKv E{WSP(bf16, R_PROJ), WSP(float, R_GATES32), WSP(bf16, WS_KMEM), WSP(bf16, WS_VTMEM)};
        pg8::gemm_phase<EpiInprojKv, InprojKvOrder, true>(ring, pg8::Gemm{D, D, D}, S, E); } SEAM(PH_INPROJ0);
    if (IN(PH_PREPA)) { p_prepa(F, A); DUP(PH_PREPA) { __syncthreads(); p_prepa(F, A); } } SEAM(PH_PREPA);
    if (IN(PH_LORA)) { pg8::PlainOrder S{WSP(bf16, R_LORAIN), WSP(bf16, WS_W_LORA), 512, 512, 32, 12, F.G, cb}; pg8::EpiF32 E{WSP(float, R_LORAOUT), 3072, 0, 1.0f};
        pg8::gemm_phase<pg8::EpiF32, pg8::PlainOrder, true>(ring, pg8::Gemm{512, 512, 512}, S, E);
        p_mlstm_pass2(F, cb == (int)F.G - 1 && F.wave < NH_M, F.wave); } SEAM(PH_LORA);
    if (IN(PH_PREPB)) { p_rwkv_chunk2(F, A); DUP(PH_PREPB) { __syncthreads(); p_rwkv_chunk2(F, A); } } SEAM(PH_PREPB);
    if (IN(PH_SCAN)) {
        if (cb < 16) p_rwkv_seq(F);
        else { p_mlu(F, cb - 16, F.G - 16); __syncthreads(); p_convert_late(F, A, (cb - 16) * NWAVES + F.wave, (F.G - 16) * NWAVES, (LAS float*)(F.lds + RING_OFF + F.wave * 16384), true, MOE_E_EARLY, NEXP); }
        DUP(62) { __syncthreads(); if (cb < 16) p_rwkv_seq(F); } } SEAM(PH_SCAN);
    if (IN(PH_MLSCAN)) { p_mlscan(F); p_rwkv_post(F, A); DUP(PH_MLSCAN) { __syncthreads(); p_rwkv_post(F, A); } } SEAM(PH_MLSCAN);
    if (IN(PH_MLOUT)) { p_mlout(F, A); DUP(PH_MLOUT) { __syncthreads(); p_mlout(F, A); } } SEAM(PH_MLOUT);
    if (IN(PH_OUTPROJ0)) { pg8::PlainOrder S{WSP(bf16, R_YCAT), WSP(bf16, WS_W_ABOUT), D, D, 32, 8, F.G, cb}; pg8::EpiResid E{A.in[I_X], WSP(float, WS_X), D, nullptr, nullptr, nullptr};
        pg8::gemm_phase<pg8::EpiResid, pg8::PlainOrder, false>(ring, pg8::Gemm{D, D, D}, S, E); } SEAM(PH_OUTPROJ0);
#define XATTN(l, P_NORM, P_Q, P_S, P_PV, P_O, SSQ_IN, XN_OUT, G_OUT, SSQ_OUT) \
    if (IN(P_NORM)) { norm_phase(F, WSP(float, WS_X), A.in[I_NXAG] + (l) * D, WSP(bf16, WS_XN), T); } SEAM(P_NORM); \
    if (IN(P_Q)) { pg8::PlainOrder S{WSP(bf16, WS_XN), WSP(bf16, WS_W_XQ) + (size_t)(l) * D * D, D, D, 32, 8, F.G, cb}; pg8::EpiBf16 E{WSP(bf16, R_XQ), D, nullptr, -1, SSQ_IN}; \
        pg8::gemm_phase<pg8::EpiBf16, pg8::PlainOrder, false>(ring, pg8::Gemm{D, D, D}, S, E); } SEAM(P_Q); \
    if (IN(P_S)) { XsOrder S{WSP(bf16, R_XQ), WSP(bf16, WS_KMEM) + (size_t)(l) * NMEM * D, F.G, cb}; pg8::EpiSoftmaxBf16 E{WSP(bf16, R_XP), 1024, 256, 0.044194173824159216f}; \
        pg8::gemm_phase<pg8::EpiSoftmaxBf16, XsOrder, false>(ring, pg8::Gemm{D, D, 512}, S, E); } SEAM(P_S); \
    if (IN(P_PV)) { XpvOrder S{WSP(bf16, R_XP), WSP(bf16, WS_VTMEM) + (size_t)(l) * D * NMEM, F.G, cb}; pg8::EpiBf16 E{WSP(bf16, R_XO), D, nullptr, -1, nullptr}; \
        pg8::gemm_phase<pg8::EpiBf16, XpvOrder, false>(ring, pg8::Gemm{1024, NMEM, 256}, S, E); } SEAM(P_PV); \
    if (IN(P_O)) { pg8::PlainOrder S{WSP(bf16, R_XO), WSP(bf16, WS_W_XO) + (size_t)(l) * D * D, D, D, 32, 8, F.G, cb}; pg8::EpiResid E{WSP(float, WS_X), WSP(float, WS_X), D, XN_OUT, G_OUT, SSQ_OUT}; \
        pg8::gemm_phase<pg8::EpiResid, pg8::PlainOrder, false>(ring, pg8::Gemm{D, D, D}, S, E); } SEAM(P_O);

    XATTN(0, PH_NORMX0, PH_XQ0, PH_XS0, PH_XPV0, PH_XO0, (const float*)nullptr, (bf16*)nullptr, (const float*)nullptr, (float*)nullptr)
    if (IN(PH_NORMF0)) { norm_phase(F, WSP(float, WS_X), A.in[I_NFFNG], WSP(bf16, WS_XN), T); } SEAM(PH_NORMF0);
    if (IN(PH_FFNGU)) { pg8::PlainOrder S{WSP(bf16, WS_XN), WSP(bf16, WS_W_FFNGU), D, D, 32, 44, F.G, cb}; pg8::EpiSwiGLU E{WSP(bf16, R_ACT), DFF, nullptr};
        pg8::gemm_phase<pg8::EpiSwiGLU, pg8::PlainOrder, true>(ring, pg8::Gemm{D, D, D}, S, E); DUP(PH_FFNGU) { pg8::gemm_phase<pg8::EpiSwiGLU, pg8::PlainOrder, true>(ring, pg8::Gemm{D, D, D}, S, E); } } SEAM(PH_FFNGU);
    if (IN(PH_FFND)) { pg8::PlainOrder S{WSP(bf16, R_ACT), WSP(bf16, WS_W_FFND), DFF, DFF, 32, 8, F.G, cb}; pg8::EpiResid E{WSP(float, WS_X), WSP(float, WS_X), D, nullptr, nullptr, nullptr};
        pg8::gemm_phase<pg8::EpiResid, pg8::PlainOrder, false>(ring, pg8::Gemm{DFF, DFF, DFF}, S, E); } SEAM(PH_FFND);
    if (IN(PH_NORMM1)) { p_norm_fpre(F, A); DUP(PH_NORMM1) { p_norm_fpre(F, A); } } SEAM(PH_NORMM1);
    if (IN(PH_FOXIN)) { pg8::PlainOrder S{WSP(bf16, WS_XN), WSP(bf16, WS_W_FOXIN), D, D, 32, 32, F.G, cb}; pg8::EpiBf16 E{WSP(bf16, R_QKVG), 8192, nullptr, -1, nullptr};
        pg8::gemm_phase<pg8::EpiBf16, pg8::PlainOrder, true>(ring, pg8::Gemm{D, D, D}, S, E); DUP(PH_FOXIN) { pg8::gemm_phase<pg8::EpiBf16, pg8::PlainOrder, true>(ring, pg8::Gemm{D, D, D}, S, E); } } SEAM(PH_FOXIN);
    if (IN(PH_FOXPREP)) { p_foxprep(F, A); } SEAM(PH_FOXPREP);
    if (IN(PH_FOXATT)) { p_foxattn(F); DUP(PH_FOXATT) { __syncthreads(); p_foxattn(F); } } SEAM(PH_FOXATT);
    if (IN(PH_FOXOUT)) { pg8::PlainOrder S{WSP(bf16, R_ATTO), WSP(bf16, WS_W_FOXOUT), D, D, 32, 8, F.G, cb}; pg8::EpiResid E{WSP(float, WS_X), WSP(float, WS_X), D, nullptr, nullptr, nullptr};
        pg8::gemm_phase<pg8::EpiResid, pg8::PlainOrder, false>(ring, pg8::Gemm{D, D, D}, S, E); } SEAM(PH_FOXOUT);
    XATTN(1, PH_NORMX1, PH_XQ1, PH_XS1, PH_XPV1, PH_XO1, (const float*)nullptr, (bf16*)nullptr, (const float*)nullptr, (float*)nullptr)
    if (IN(PH_NORMF1)) { p_norm_route(F, A); } SEAM(PH_NORMF1);
    if (IN(PH_ROUTE2)) { p_route2(F); } SEAM(PH_ROUTE2);
    if (IN(PH_MOEGU)) { MoeOrder S{WSP(bf16, R_AG), WSP(bf16, WS_W_MOEGU), WSP(int, WS_SMALL + SM_TILEE), D, 44, (size_t)2 * DFF * D, F.G, cb, false}; pg8::EpiSwiGLU E{WSP(bf16, R_ACTG), DFF, nullptr};
        pg8::gemm_phase<pg8::EpiSwiGLU, MoeOrder, true>(ring, pg8::Gemm{D, D, D}, S, E); } SEAM(PH_MOEGU);
    if (IN(PH_MOED)) {
        { MoeOrder S{WSP(bf16, R_ACTG), WSP(bf16, WS_W_MOED), WSP(int, WS_SMALL + SM_TILEE), DFF, 8, (size_t)D * DFF, F.G, cb, true}; pg8::EpiF32 E{WSP(float, R_YG), D, 0, 1.0f};
          pg8::gemm_phase<pg8::EpiF32, MoeOrder, true>(ring, pg8::Gemm{DFF, DFF, DFF}, S, E); }
        { MoeSplitOrder S{WSP(bf16, R_ACTG), WSP(bf16, WS_W_MOED), WSP(int, WS_SMALL + SM_TILEE), DFF, 8, DFF / MOE_KSPLIT, (size_t)D * DFF, F.G, cb}; const int nt_ = WSP(int, WS_SMALL + SM_TILEE)[0]; pg8::EpiF32Split E{WSP(float, R_YG), WSP(float, R_YSIDE), YSIDE_STRIDE, D, ((nt_ * 8) / F.G) * F.G / 8};
          pg8::gemm_phase<pg8::EpiF32Split, MoeSplitOrder, false>(ring, pg8::Gemm{DFF, DFF, DFF / MOE_KSPLIT}, S, E); } } SEAM(PH_MOED);
    if (IN(PH_FINAL)) { p_final(F, A); }
#undef XATTN
#undef IN
#undef SEAM
}

#ifndef MK_ONE_LAUNCH
#define MK_ONE_LAUNCH 1
#endif
extern "C" void kernel_launch(void* const* d_in, const int* in_sizes, int n_in, void* d_out, int out_size, void* d_ws, size_t ws_size, hipStream_t stream) {
    static int ready = 0;
    if (ready == 0) {
        if (n_in != N_IN || in_sizes[0] != T * D || out_size != T * D || ws_size < WS_END) {
            fprintf(stderr, "kernel_launch: built for %d inputs, x/out of %d floats, >= %zu bytes of workspace; got n_in %d, in0 %d, out %d, ws %zu; nothing launched\n", N_IN, T * D, (size_t)WS_END, n_in, n_in > 0 ? in_sizes[0] : -1, out_size, ws_size);
            ready = -1; return; }
        if (hipFuncSetAttribute((const void*)trunk_fwd, hipFuncAttributeMaxDynamicSharedMemorySize, LDS_BYTES) != hipSuccess) { fprintf(stderr, "kernel_launch: hipFuncSetAttribute failed\n"); ready = -1; return; }
        int per_cu = 0;
        if (hipOccupancyMaxActiveBlocksPerMultiprocessor(&per_cu, (const void*)trunk_fwd, NWAVES * 64, LDS_BYTES) != hipSuccess || per_cu < 1)
            fprintf(stderr, "kernel_launch: note: occupancy query reports %d workgroups per CU\n", per_cu);
        (void)hipGetLastError();
        ready = 1;
    }
    if (ready < 0) return;
    const int grid = 256;
    if (hipMemsetAsync((char*)d_ws + WS_CTL, 0, CTL_ZERO_BYTES, stream) != hipSuccess) { fprintf(stderr, "kernel_launch: hipMemsetAsync failed\n"); return; }
    Args a{};
    for (int i = 0; i < N_IN; ++i) a.in[i] = (const float*)d_in[i];
    a.out = (float*)d_out; a.ws = (unsigned char*)d_ws;
#if MK_ONE_LAUNCH
    a.ph_lo = 0; a.ph_hi = N_PHASES;
    hipLaunchKernelGGL(trunk_fwd, dim3(grid), dim3(NWAVES * 64), LDS_BYTES, stream, a);
#else
    for (int p = 0; p < N_PHASES; ++p) { a.ph_lo = p; a.ph_hi = p + 1;
        hipLaunchKernelGGL(trunk_fwd, dim3(grid), dim3(NWAVES * 64), LDS_BYTES, stream, a); }
#endif
    const hipError_t le = hipPeekAtLastError();
    if (le != hipSuccess) fprintf(stderr, "kernel_launch: launch failed: %s\n", hipGetErrorName(le));
}
```

```cpp
#include <hip/hip_runtime.h>
#include <cstdio>
#include <cstdint>

#define GAS __attribute__((address_space(1)))
#define LAS __attribute__((address_space(3)))
typedef unsigned short bf16;
typedef short bf16x8 __attribute__((ext_vector_type(8)));
typedef short s16x4 __attribute__((ext_vector_type(4)));
typedef float f32x2 __attribute__((ext_vector_type(2)));
typedef float f32x4 __attribute__((ext_vector_type(4)));
typedef float f32x16 __attribute__((ext_vector_type(16)));
typedef unsigned u32x2 __attribute__((ext_vector_type(2)));
typedef unsigned u32x4 __attribute__((ext_vector_type(4)));

constexpr int T = 8192, D = 2048, NMEM = 256, DFF = 5632, NEXP = 8;
constexpr int A_COLS = 3520, AB_COLS = 7624, AB_PAD = 7680;
constexpr int FOX_LD = 8208;
constexpr int NH_R = 16, NH_M = 4, NH_F = 16;
constexpr int MOE_ROWS = 72 * 256;

__device__ __forceinline__ float bf2f(unsigned b) { return __uint_as_float(b << 16); }
__device__ __forceinline__ unsigned cvt_pk_bf16(float lo, float hi) { unsigned r; asm volatile("v_cvt_pk_bf16_f32 %0, %1, %2" : "=v"(r) : "v"(lo), "v"(hi)); return r; }
__device__ __forceinline__ bf16 f2bf(float f) { return (bf16)(cvt_pk_bf16(f, 0.f) & 0xffffu); }
__device__ __forceinline__ float wave_sum(float v) {
#pragma unroll
    for (int o = 1; o < 64; o <<= 1) v += __shfl_xor(v, o);
    return v;
}
__device__ __forceinline__ float wave_max(float v) {
#pragma unroll
    for (int o = 1; o < 64; o <<= 1) v = fmaxf(v, __shfl_xor(v, o));
    return v;
}
__device__ __forceinline__ float wave_sum_dpp(float x) {
#define DPPF_(v, ctrl) __builtin_bit_cast(float, __builtin_amdgcn_update_dpp(0, __builtin_bit_cast(int, v), ctrl, 0xF, 0xF, true))
    x += DPPF_(x, 0xB1); x += DPPF_(x, 0x4E); x += DPPF_(x, 0x141); x += DPPF_(x, 0x140);
#undef DPPF_
    const float a = __builtin_bit_cast(float, __builtin_amdgcn_readlane(__builtin_bit_cast(int, x), 0)), b = __builtin_bit_cast(float, __builtin_amdgcn_readlane(__builtin_bit_cast(int, x), 16));
    const float c = __builtin_bit_cast(float, __builtin_amdgcn_readlane(__builtin_bit_cast(int, x), 32)), d = __builtin_bit_cast(float, __builtin_amdgcn_readlane(__builtin_bit_cast(int, x), 48));
    return (a + b) + (c + d);
}
__device__ __forceinline__ float sigmoidf_(float x) { return 1.0f / (1.0f + __expf(-x)); }
__device__ __forceinline__ float logsigmoidf_(float x) { return fminf(x, 0.f) - log1pf(__expf(-fabsf(x))); }

namespace pg8 {
#define PG8_LAS __attribute__((address_space(3)))
typedef unsigned short bf16_t;
constexpr int BM = 256, BK = 64, HALF = 128, HTB = HALF * BK * 2  , STAGE_BYTES = 8 * HTB, NXCD = 8, WGM = 8;

__host__ __device__ __forceinline__ int lds_byte(int r, int c) { const int st = (r >> 4) * 2 + (c >> 5), rr = r & 15, cc = c & 31, ob = rr * 64 + cc * 2; return st * 1024 + (ob ^ (((ob >> 9) & 1) << 5)); }
__host__ __device__ __forceinline__ void stage_rc(int b, int& R, int& C) { const int st = b / 1024, sb = b % 1024, swz = sb ^ (((sb >> 9) & 1) << 5); R = (st >> 1) * 16 + swz / 64; C = (st & 1) * 32 + (swz % 64) / 2; }
__host__ __device__ __forceinline__ int perm32(int rho) { const int n = rho >> 4, i = rho & 15; return 8 * (i >> 2) + 4 * n + (i & 3); }

struct Unit { const char* a; const char* b; int pm, pn, aux, pad; };
struct Gemm { int lda, ldb, K; };

__device__ __forceinline__ bool static_tile(int i, int G, int c, int nM, int nN, int& pm, int& pn) {
    const int nwg = nM * nN; const long L = (long)i * G + c; if (L >= nwg) return false;
    int wgid = (int)L; { const int q = nwg / NXCD, r = nwg % NXCD, xcd = wgid % NXCD, off = wgid / NXCD; wgid = (xcd < r ? xcd * (q + 1) : r * (q + 1) + (xcd - r) * q) + off; }
    const int nig = WGM * nN, gid = wgid / nig, fm = gid * WGM, gsz = (nM - fm) < WGM ? (nM - fm) : WGM;
    pm = fm + ((wgid % nig) % gsz); pn = (wgid % nig) / gsz; return true;
}
struct PlainOrder {
    const bf16_t* A; const bf16_t* Bt; int lda, ldb, nM, nN, G, c;
    __device__ __forceinline__ bool next(int i, Unit& u) const {
        int pm, pn; if (!static_tile(i, G, c, nM, nN, pm, pn)) return false;
        u.pm = pm; u.pn = pn; u.aux = 0; u.pad = 0; u.a = (const char*)(A + (size_t)pm * BM * lda); u.b = (const char*)(Bt + (size_t)pn * BM * ldb); return true;
    }
};

struct EpiF32 {
    static constexpr bool PERM = false;
    float* C; int ldc; int aux_cols; float scale;
    __device__ __forceinline__ void operator()(const f32x4 (&acc)[2][2][4][2], const Unit& u, int wr, int wc, int fr, int fq) const {
        const int row0 = u.pm * BM + wr * 64 + fr, col0 = u.pn * BM + u.aux * aux_cols + wc * 32 + 4 * fq;
#pragma unroll
        for (int ai = 0; ai < 2; ++ai)
#pragma unroll
            for (int m = 0; m < 4; ++m) { float* rowp = C + (size_t)(row0 + ai * HALF + m * 16) * ldc + col0;
#pragma unroll
                for (int bj = 0; bj < 2; ++bj)
#pragma unroll
                    for (int n = 0; n < 2; ++n) *(f32x4*)(rowp + bj * HALF + n * 16) = acc[ai][bj][m][n] * scale; }
    }
};
struct EpiF32Split {
    static constexpr bool PERM = false;
    float* C; float* side; size_t side_stride; int ldc; int pm0;
    __device__ __forceinline__ void operator()(const f32x4 (&acc)[2][2][4][2], const Unit& u, int wr, int wc, int fr, int fq) const {
        float* base = u.aux == 0 ? C + (size_t)u.pm * BM * ldc : side + (size_t)(u.aux - 1) * side_stride + (size_t)(u.pm - pm0) * BM * ldc;
        const int row0 = wr * 64 + fr, col0 = u.pn * BM + wc * 32 + 4 * fq;
#pragma unroll
        for (int ai = 0; ai < 2; ++ai)
#pragma unroll
            for (int m = 0; m < 4; ++m) { float* rowp = base + (size_t)(row0 + ai * HALF + m * 16) * ldc + col0;
#pragma unroll
                for (int bj = 0; bj < 2; ++bj)
#pragma unroll
                    for (int n = 0; n < 2; ++n) *(f32x4*)(rowp + bj * HALF + n * 16) = acc[ai][bj][m][n]; }
    }
};
struct EpiResid {
    static constexpr bool PERM = false;
    const float* base; float* out; int ldc; bf16_t* xn; const float* gn; float* ssq;
    __device__ __forceinline__ void operator()(const f32x4 (&acc)[2][2][4][2], const Unit& u, int wr, int wc, int fr, int fq) const {
        const int row0 = u.pm * BM + wr * 64 + fr, col0 = u.pn * BM + wc * 32 + 4 * fq;
        f32x4 gv[2][2];
        if (xn) {
#pragma unroll
            for (int bj = 0; bj < 2; ++bj)
#pragma unroll
                for (int n = 0; n < 2; ++n) gv[bj][n] = *(const f32x4*)(gn + col0 + bj * HALF + n * 16); }
#pragma unroll
        for (int ai = 0; ai < 2; ++ai)
#pragma unroll
            for (int m = 0; m < 4; ++m) { const int row = row0 + ai * HALF + m * 16; const size_t off = (size_t)row * ldc + col0; float ss = 0.f;
#pragma unroll
                for (int bj = 0; bj < 2; ++bj)
#pragma unroll
                    for (int n = 0; n < 2; ++n) { const f32x4 b = *(const f32x4*)(base + off + bj * HALF + n * 16); const f32x4 x = b + acc[ai][bj][m][n]; *(f32x4*)(out + off + bj * HALF + n * 16) = x;
                        if (xn) { ss += (x[0] * x[0] + x[1] * x[1]) + (x[2] * x[2] + x[3] * x[3]); const f32x4 y = x * gv[bj][n];
                            u32x2 w; w.x = cvt_pk_bf16(y[0], y[1]); w.y = cvt_pk_bf16(y[2], y[3]); *(u32x2*)(xn + off + bj * HALF + n * 16) = w; } }
                if (xn) { ss += __shfl_xor(ss, 16); ss += __shfl_xor(ss, 32); if (fq == 0) __hip_atomic_fetch_add(ssq + row, ss, __ATOMIC_RELAXED, __HIP_MEMORY_SCOPE_AGENT); } }
    }
};
struct EpiBf16 {
    static constexpr bool PERM = true;
    bf16_t* O; int ldc; float* side; int side_pn; const float* ssq;
    __device__ __forceinline__ void operator()(const f32x4 (&acc)[2][2][4][2], const Unit& u, int wr, int wc, int fr, int fq) const {
        const int row0 = u.pm * BM + wr * 64 + fr, col0 = u.pn * BM + wc * 32 + 8 * fq;
#pragma unroll
        for (int ai = 0; ai < 2; ++ai)
#pragma unroll
            for (int m = 0; m < 4; ++m) { bf16_t* rowp = O + (size_t)(row0 + ai * HALF + m * 16) * ldc + col0;
                const float rs = ssq ? 1.0f / sqrtf(ssq[row0 + ai * HALF + m * 16] * (1.0f / 2048.0f) + 1e-6f) : 1.0f;
#pragma unroll
                for (int bj = 0; bj < 2; ++bj) { const f32x4 v0 = acc[ai][bj][m][0] * rs, v1 = acc[ai][bj][m][1] * rs;
                    u32x4 w; w.x = cvt_pk_bf16(v0[0], v0[1]); w.y = cvt_pk_bf16(v0[2], v0[3]); w.z = cvt_pk_bf16(v1[0], v1[1]); w.w = cvt_pk_bf16(v1[2], v1[3]);
                    *(u32x4*)(rowp + bj * HALF) = w; } }
        if (side != nullptr && u.pn == side_pn) {
#pragma unroll
            for (int ai = 0; ai < 2; ++ai)
#pragma unroll
                for (int m = 0; m < 4; ++m) { float* rowp = side + (size_t)(row0 + ai * HALF + m * 16) * 256 + wc * 32 + 8 * fq;
#pragma unroll
                    for (int bj = 0; bj < 2; ++bj) { *(f32x4*)(rowp + bj * HALF) = acc[ai][bj][m][0]; *(f32x4*)(rowp + bj * HALF + 4) = acc[ai][bj][m][1]; } }
        }
    }
};
struct EpiSwiGLU {
    static constexpr bool PERM = true;
    bf16_t* O; int ldc; const float* ssq;
    __device__ __forceinline__ void operator()(const f32x4 (&acc)[2][2][4][2], const Unit& u, int wr, int wc, int fr, int fq) const {
        const int row0 = u.pm * BM + wr * 64 + fr, col0 = u.pn * HALF + wc * 32 + 8 * fq;
#pragma unroll
        for (int ai = 0; ai < 2; ++ai)
#pragma unroll
            for (int m = 0; m < 4; ++m) { bf16_t* rowp = O + (size_t)(row0 + ai * HALF + m * 16) * ldc + col0;
                const float rs = ssq ? 1.0f / sqrtf(ssq[row0 + ai * HALF + m * 16] * (1.0f / 2048.0f) + 1e-6f) : 1.0f;
                float o[8];
#pragma unroll
                for (int n = 0; n < 2; ++n)
#pragma unroll
                    for (int j = 0; j < 4; ++j) { const float g = acc[ai][0][m][n][j] * rs, up = acc[ai][1][m][n][j] * rs;
                        o[n * 4 + j] = g * __builtin_amdgcn_rcpf(1.0f + __builtin_amdgcn_exp2f(-1.4426950408889634f * g)) * up; }
                u32x4 w; w.x = cvt_pk_bf16(o[0], o[1]); w.y = cvt_pk_bf16(o[2], o[3]); w.z = cvt_pk_bf16(o[4], o[5]); w.w = cvt_pk_bf16(o[6], o[7]);
                *(u32x4*)rowp = w; }
    }
};

template <class E, class = void> struct epi_after_drain { static constexpr bool value = false; };
template <class E> struct epi_after_drain<E, decltype((void)E::AFTER_DRAIN)> { static constexpr bool value = E::AFTER_DRAIN; };
struct EpiSoftmaxBf16 {
    static constexpr bool PERM = false, AFTER_DRAIN = true;
    bf16_t* P; int ldc; int aux_cols; float scale;
    __device__ __forceinline__ void fused(f32x4 (&acc)[2][2][4][2], const Unit& u, int wr, int wc, int fr, int fq, PG8_LAS unsigned char* lds) const {
        PG8_LAS float* pm = (PG8_LAS float*)lds;
        PG8_LAS float* ps = pm + 1024;
        float mx[2][4];
#pragma unroll
        for (int ai = 0; ai < 2; ++ai)
#pragma unroll
            for (int m = 0; m < 4; ++m) { float v = -3.0e38f;
#pragma unroll
                for (int bj = 0; bj < 2; ++bj)
#pragma unroll
                    for (int n = 0; n < 2; ++n) { acc[ai][bj][m][n] = acc[ai][bj][m][n] * scale; const f32x4 x = acc[ai][bj][m][n]; v = fmaxf(v, fmaxf(fmaxf(x[0], x[1]), fmaxf(x[2], x[3]))); }
                v = fmaxf(v, __shfl_xor(v, 16)); v = fmaxf(v, __shfl_xor(v, 32)); mx[ai][m] = v;
                if (fq == 0) pm[(ai * HALF + wr * 64 + m * 16 + fr) * 4 + wc] = v; }
        asm volatile("s_waitcnt lgkmcnt(0)" ::: "memory"); __builtin_amdgcn_s_barrier(); asm volatile("" ::: "memory");
        float sm[2][4];
#pragma unroll
        for (int ai = 0; ai < 2; ++ai)
#pragma unroll
            for (int m = 0; m < 4; ++m) { const f32x4 p4 = *(const PG8_LAS f32x4*)(pm + (ai * HALF + wr * 64 + m * 16 + fr) * 4); const float mr = fmaxf(fmaxf(p4[0], p4[1]), fmaxf(p4[2], p4[3])); float s = 0.f;
#pragma unroll
                for (int bj = 0; bj < 2; ++bj)
#pragma unroll
                    for (int n = 0; n < 2; ++n) { f32x4 x = acc[ai][bj][m][n];
#pragma unroll
                        for (int j = 0; j < 4; ++j) { x[j] = __expf(x[j] - mr); s += x[j]; }
                        acc[ai][bj][m][n] = x; }
                s += __shfl_xor(s, 16); s += __shfl_xor(s, 32); sm[ai][m] = s;
                if (fq == 0) ps[(ai * HALF + wr * 64 + m * 16 + fr) * 4 + wc] = s; }
        asm volatile("s_waitcnt lgkmcnt(0)" ::: "memory"); __builtin_amdgcn_s_barrier(); asm volatile("" ::: "memory");
        const int row0 = u.pm * BM + wr * 64 + fr, col0 = u.pn * BM + u.aux * aux_cols + wc * 32 + 4 * fq;
#pragma unroll
        for (int ai = 0; ai < 2; ++ai)
#pragma unroll
            for (int m = 0; m < 4; ++m) { const f32x4 s4 = *(const PG8_LAS f32x4*)(ps + (ai * HALF + wr * 64 + m * 16 + fr) * 4); const float inv = 1.0f / ((s4[0] + s4[1]) + (s4[2] + s4[3]));
                bf16_t* rowp = P + (size_t)(row0 + ai * HALF + m * 16) * ldc + col0;
#pragma unroll
                for (int bj = 0; bj < 2; ++bj)
#pragma unroll
                    for (int n = 0; n < 2; ++n) { const f32x4 x = acc[ai][bj][m][n] * inv; u32x2 w; w.x = cvt_pk_bf16(x[0], x[1]); w.y = cvt_pk_bf16(x[2], x[3]); *(u32x2*)(rowp + bj * HALF + n * 16) = w; } }
        (void)mx; (void)sm;
    }
};

template <class Epi, class Sched, bool ALIGN_EPI>
__device__ __forceinline__ void gemm_phase(PG8_LAS unsigned char* lds, const Gemm g, const Sched& S, const Epi& E) {
    const int tid = threadIdx.x, wid = __builtin_amdgcn_readfirstlane(tid >> 6), lane = tid & 63, wr = wid >> 2, wc = wid & 3, fr = lane & 15, fq = lane >> 4;
    const int K = g.K, nt = K / BK;
    unsigned voffA[2], voffB[2];
#pragma unroll
    for (int i = 0; i < 2; ++i) { int R, C; stage_rc(tid * 16 + i * 8192, R, C); const int Rb = Epi::PERM ? ((R & ~31) + perm32(R & 31)) : R;
        voffA[i] = (unsigned)(R * g.lda + C) * 2u; voffB[i] = (unsigned)(Rb * g.ldb + C) * 2u; }
    const size_t kstep = (size_t)(BK * 2);
    const size_t hstepA = (size_t)HALF * g.lda * 2, hstepB = (size_t)HALF * g.ldb * 2;
    const unsigned ldsw = (unsigned)wid * 1024u;
    const int aoff = lds_byte(wr * 64 + fr, fq * 8), boff = lds_byte(wc * 32 + fr, fq * 8);
#define PG8_SA(b, h) (((b) * 2 + (h)) * HTB)
#define PG8_SB(b, h) ((4 + (b) * 2 + (h)) * HTB)
#define PG8_STAGE(bufoff, gbase, voff) do { _Pragma("unroll") for (int _i = 0; _i < 2; ++_i) \
        __builtin_amdgcn_global_load_lds((const unsigned*)((const char*)(gbase) + (voff)[_i]), (PG8_LAS unsigned*)(lds + (bufoff) + ldsw + _i * 8192), 16, 0, 0); } while (0)
#define PG8_LDA(dst, b, h) do { _Pragma("unroll") for (int m = 0; m < 4; ++m) _Pragma("unroll") for (int k = 0; k < 2; ++k) dst[m][k] = *(const PG8_LAS bf16x8*)(lds + PG8_SA(b, h) + aoff + m * 2048 + k * 1024); } while (0)
#define PG8_LDB(dst, b, h) do { _Pragma("unroll") for (int n = 0; n < 2; ++n) _Pragma("unroll") for (int k = 0; k < 2; ++k) dst[n][k] = *(const PG8_LAS bf16x8*)(lds + PG8_SB(b, h) + boff + n * 2048 + k * 1024); } while (0)
#define PG8_MMA(ai, bj, At, Bt) do { __builtin_amdgcn_s_setprio(1); _Pragma("unroll") for (int m = 0; m < 4; ++m) _Pragma("unroll") for (int n = 0; n < 2; ++n) _Pragma("unroll") for (int k = 0; k < 2; ++k) \
        acc[ai][bj][m][n] = __builtin_amdgcn_mfma_f32_16x16x32_bf16(Bt[n][k], At[m][k], acc[ai][bj][m][n], 0, 0, 0); __builtin_amdgcn_s_setprio(0); } while (0)
#define PG8_WAIT_V(n) asm volatile("s_waitcnt vmcnt(" #n ")" ::: "memory")
#define PG8_WAIT_L(n) asm volatile("s_waitcnt lgkmcnt(" #n ")" ::: "memory")
#define PG8_BAR __builtin_amdgcn_s_barrier()
#define PG8_SCHED __builtin_amdgcn_sched_barrier(0)
    Unit cur, nxt; int ui = 0;
    if (!S.next(0, cur)) return;
    f32x4 acc[2][2][4][2];
#pragma unroll
    for (int a = 0; a < 2; ++a)
#pragma unroll
        for (int b = 0; b < 2; ++b)
#pragma unroll
            for (int m = 0; m < 4; ++m)
#pragma unroll
                for (int n = 0; n < 2; ++n) acc[a][b][m][n] = (f32x4){0.f, 0.f, 0.f, 0.f};
    bf16x8 At[4][2], B0[2][2], B1[2][2];
    const char* cA = cur.a; const char* cB = cur.b;
    PG8_STAGE(PG8_SB(0, 0), cB, voffB); PG8_STAGE(PG8_SB(0, 1), cB + hstepB, voffB); PG8_STAGE(PG8_SA(0, 0), cA, voffA); PG8_STAGE(PG8_SA(0, 1), cA + hstepA, voffA);
    if (wr == 1) PG8_BAR;
    PG8_WAIT_V(2); PG8_BAR;
    PG8_STAGE(PG8_SB(1, 0), cB + kstep, voffB); PG8_STAGE(PG8_SA(1, 0), cA + kstep, voffA); PG8_STAGE(PG8_SB(1, 1), cB + hstepB + kstep, voffB);
    PG8_WAIT_V(6); PG8_BAR;
    for (;;) {
        const bool has_next = S.next(ui + 1, nxt);
        const char* nA = has_next ? nxt.a : cA; const char* nB = has_next ? nxt.b : cB;
        for (int t = 0; t < nt; t += 2) {
            const bool last = (t == nt - 2);
            const char* a1 = cA + (size_t)(t + 1) * kstep;
            const char* a2 = last ? nA : cA + (size_t)(t + 2) * kstep; const char* b2 = last ? nB : cB + (size_t)(t + 2) * kstep;
            const char* a3 = a2 + kstep; const char* b3 = b2 + kstep;
            PG8_LDB(B0, 0, 0); PG8_LDB(B1, 0, 1); PG8_SCHED; PG8_LDA(At, 0, 0); PG8_STAGE(PG8_SA(1, 1), a1 + hstepA, voffA);
            PG8_WAIT_V(8); PG8_WAIT_L(0); PG8_BAR; PG8_MMA(0, 0, At, B0); PG8_MMA(0, 1, At, B1); PG8_BAR; PG8_SCHED;
            PG8_LDA(At, 0, 1); PG8_STAGE(PG8_SB(0, 0), b2, voffB); PG8_STAGE(PG8_SB(0, 1), b2 + hstepB, voffB); PG8_STAGE(PG8_SA(0, 0), a2, voffA);
            PG8_WAIT_V(8); PG8_WAIT_L(0); PG8_BAR; PG8_MMA(1, 0, At, B0); PG8_MMA(1, 1, At, B1); PG8_BAR; PG8_SCHED;
            PG8_LDB(B0, 1, 0); PG8_LDB(B1, 1, 1); PG8_SCHED; PG8_LDA(At, 1, 0); PG8_STAGE(PG8_SA(0, 1), a2 + hstepA, voffA);
            PG8_WAIT_V(8); PG8_WAIT_L(0); PG8_BAR; PG8_MMA(0, 0, At, B0); PG8_MMA(0, 1, At, B1); PG8_BAR; PG8_SCHED;
            PG8_LDA(At, 1, 1); PG8_STAGE(PG8_SB(1, 0), b3, voffB); PG8_STAGE(PG8_SB(1, 1), b3 + hstepB, voffB); PG8_STAGE(PG8_SA(1, 0), a3, voffA);
            PG8_WAIT_V(8); PG8_WAIT_L(0); PG8_BAR; PG8_MMA(1, 0, At, B0); PG8_MMA(1, 1, At, B1); PG8_BAR; PG8_SCHED;
        }
        if constexpr (ALIGN_EPI) { if (wr == 0) PG8_BAR; }
        if constexpr (!epi_after_drain<Epi>::value) E(acc, cur, wr, wc, fr, fq);
        if (!has_next) break;
#pragma unroll
        for (int a = 0; a < 2; ++a)
#pragma unroll
            for (int b = 0; b < 2; ++b)
#pragma unroll
                for (int m = 0; m < 4; ++m)
#pragma unroll
                    for (int n = 0; n < 2; ++n) acc[a][b][m][n] = (f32x4){0.f, 0.f, 0.f, 0.f};
        cur = nxt; cA = nA; cB = nB; ++ui;
        if constexpr (ALIGN_EPI) { if (wr == 1) PG8_BAR; }
    }
    PG8_WAIT_V(0);
    if constexpr (!ALIGN_EPI) { if (wr == 0) PG8_BAR; }
    PG8_BAR;
    if constexpr (epi_after_drain<Epi>::value) E.fused(acc, cur, wr, wc, fr, fq, lds);
#undef PG8_SA
#undef PG8_SB
#undef PG8_STAGE
#undef PG8_LDA
#undef PG8_LDB
#undef PG8_MMA
#undef PG8_WAIT_V
#undef PG8_WAIT_L
#undef PG8_BAR
#undef PG8_SCHED
}
}

namespace fox {
constexpr int D = 128, LDQ = 8192, LDO = 2048;
constexpr float SCALE = 0.08838834764831845f;
constexpr float THR2 = 8.f * 1.4426950408889634f;
constexpr int NW = 8, QBLK = 32, KVBLK = 64, QB = NW * QBLK;
constexpr int SHM_V = KVBLK * D * 2, SHM_K = KVBLK * D * 2;
constexpr int BIAS_OFF = 2 * SHM_V + 2 * SHM_K + NW * 64 * 4;
constexpr int LDS_BYTES = BIAS_OFF + 8192 * 4;

#define KSWZ(row, colB) ((row) * 256 + ((colB) ^ (((row) & 7) << 4)))
#define SBAR() __builtin_amdgcn_sched_barrier(0)
__device__ __forceinline__ int v_st(int k, int c) { const int kk = (k & ~0xC) | ((k & 4) << 1) | ((k & 8) >> 1); return ((kk >> 3) * 4 + (c >> 5)) * 512 + ((kk & 7) * 32 + (c & 31)) * 2; }
__device__ __forceinline__ int v_rd_base(int lane) { return ((lane & 3) << 3) | (((lane >> 2) & 3) << 6) | (((lane >> 4) & 1) << 5) | (((lane >> 5) & 1) << 8); }
constexpr int v_rd_off(int d0, int ks, int half) { return d0 * 512 + ks * 4096 + half * 2048; }
__device__ __forceinline__ int crow(int r, int hi) { return (r & 3) + 8 * (r >> 2) + 4 * hi; }
__device__ __forceinline__ unsigned cvtpk(float lo, float hi) { unsigned r; asm volatile("v_cvt_pk_bf16_f32 %0, %1, %2" : "=v"(r) : "v"(lo), "v"(hi)); return r; }
__device__ __forceinline__ bf16x8 load8(const bf16* p) { return *reinterpret_cast<const bf16x8*>(p); }
__device__ __forceinline__ void mask_tile(f32x16& p0, f32x16& p1, int dq) {
    const float NEG = -__builtin_inff();
#pragma unroll
    for (int r = 0; r < 16; ++r) {
        const int c = (r & 3) + 8 * (r >> 2);
        if (dq - c < 0) p0[r] = NEG;
        if (dq - c - 32 < 0) p1[r] = NEG;
    }
}
__device__ __forceinline__ void partialSM(f32x16& p0, f32x16& p1, float& m_reg, float& mn, float& alpha, const float* bl) {
    constexpr float C2 = 1.4426950408889634f * SCALE;
#pragma unroll
    for (int a = 0; a < 4; ++a) {
#ifdef FOX_NOBIAS
        const f32x4 b0 = {0,0,0,0}, b1 = {0,0,0,0};
#else
        const f32x4 b0 = *(const f32x4*)(bl + 8 * a), b1 = *(const f32x4*)(bl + 32 + 8 * a);
#endif

#pragma unroll
        for (int i = 0; i < 4; ++i) { p0[4 * a + i] = fmaf(p0[4 * a + i], C2, b0[i]); p1[4 * a + i] = fmaf(p1[4 * a + i], C2, b1[i]); }
        SBAR(); }
    float pmax = p0[0]; for (int r = 1; r < 16; ++r) pmax = fmaxf(pmax, p0[r]); for (int r = 0; r < 16; ++r) pmax = fmaxf(pmax, p1[r]);
    { auto rr = __builtin_amdgcn_permlane32_swap(__float_as_uint(pmax), __float_as_uint(pmax), false, false);
      pmax = fmaxf(__uint_as_float(rr[0]), __uint_as_float(rr[1])); }
    if (__builtin_expect(__all((pmax - m_reg) <= THR2), 1)) { mn = m_reg; alpha = 1.f; }
    else { mn = fmaxf(m_reg, pmax); alpha = __builtin_amdgcn_exp2f(m_reg - mn); m_reg = mn; }
    for (int r = 0; r < 16; ++r) p0[r] = p0[r] - mn; for (int r = 0; r < 16; ++r) p1[r] = p1[r] - mn;
    for (int r = 0; r < 16; ++r) p0[r] = __builtin_amdgcn_exp2f(p0[r]);
}
__device__ __forceinline__ void finishSM(f32x16& p0, f32x16& p1, float alpha, float& l_reg, bf16x8& pa0, bf16x8& pa1, bf16x8& pa2, bf16x8& pa3) {
    for (int r = 0; r < 16; ++r) p1[r] = __builtin_amdgcn_exp2f(p1[r]);
    float ps = 0; for (int r = 0; r < 16; ++r) ps += p0[r]; for (int r = 0; r < 16; ++r) ps += p1[r];
    { auto rr = __builtin_amdgcn_permlane32_swap(__float_as_uint(ps), __float_as_uint(ps), false, false);
      ps = __uint_as_float(rr[0]) + __uint_as_float(rr[1]); }
    l_reg = l_reg * alpha + ps;
#define PK4(P, B_, OUT) do { unsigned a0 = cvtpk(P[B_+0], P[B_+1]), a1 = cvtpk(P[B_+2], P[B_+3]);                          \
        unsigned b0 = cvtpk(P[B_+4], P[B_+5]), b1 = cvtpk(P[B_+6], P[B_+7]);                                             \
        auto r0 = __builtin_amdgcn_permlane32_swap(a0, b0, false, false); auto r1 = __builtin_amdgcn_permlane32_swap(a1, b1, false, false); \
        u32x4 w = {r0[0], r1[0], r0[1], r1[1]}; OUT = *reinterpret_cast<bf16x8*>(&w); } while (0)
    PK4(p0, 0, pa0); PK4(p0, 8, pa1); PK4(p1, 0, pa2); PK4(p1, 8, pa3);
#undef PK4
}
template <int KB>
__device__ __forceinline__ void qkt(f32x16& p0, f32x16& p1, const char* K_lds, int r32, int hi, const bf16x8* qr) {
    p0 = f32x16{}; p1 = f32x16{};
    const char* kb[4];
#pragma unroll
    for (int dd = 0; dd < 4; ++dd) kb[dd] = K_lds + KB * SHM_K + KSWZ(r32, (dd * 16 + hi * 8) * 2);
#pragma unroll
    for (int d0 = 0; d0 < 8; ++d0) { const char* a = kb[d0 & 3] + (d0 >> 2) * 128;
        bf16x8 b0 = *reinterpret_cast<const bf16x8*>(a);
        bf16x8 b1 = *reinterpret_cast<const bf16x8*>(a + 32 * 256);
        p0 = __builtin_amdgcn_mfma_f32_32x32x16_bf16(b0, qr[d0], p0, 0, 0, 0);
        p1 = __builtin_amdgcn_mfma_f32_32x32x16_bf16(b1, qr[d0], p1, 0, 0, 0); }
}
template <int VB>
__device__ __forceinline__ void pv_tile(f32x16* o, int vb0, bf16x8 pa0, bf16x8 pa1, bf16x8 pa2, bf16x8 pa3) {
#define TRRD(dst, off) asm volatile("ds_read_b64_tr_b16 %0, %1 offset:%2" : "=&v"(dst) : "v"(vb0), "i"(off) : "memory")
#define PV_D0(d0) do { s16x4 l0, l1, l2, l3, h0, h1, h2, h3; constexpr int b_ = VB * SHM_V + v_rd_off(d0, 0, 0); \
        TRRD(l0, b_); TRRD(h0, b_ + 2048); TRRD(l1, b_ + 4096); TRRD(h1, b_ + 6144); TRRD(l2, b_ + 8192); TRRD(h2, b_ + 10240); TRRD(l3, b_ + 12288); TRRD(h3, b_ + 14336); \
        asm volatile("s_waitcnt lgkmcnt(0)" ::: "memory"); SBAR();   \
        o[d0] = __builtin_amdgcn_mfma_f32_32x32x16_bf16(pa0, (bf16x8){l0[0], l0[1], l0[2], l0[3], h0[0], h0[1], h0[2], h0[3]}, o[d0], 0, 0, 0);   \
        o[d0] = __builtin_amdgcn_mfma_f32_32x32x16_bf16(pa1, (bf16x8){l1[0], l1[1], l1[2], l1[3], h1[0], h1[1], h1[2], h1[3]}, o[d0], 0, 0, 0);   \
        o[d0] = __builtin_amdgcn_mfma_f32_32x32x16_bf16(pa2, (bf16x8){l2[0], l2[1], l2[2], l2[3], h2[0], h2[1], h2[2], h2[3]}, o[d0], 0, 0, 0);   \
        o[d0] = __builtin_amdgcn_mfma_f32_32x32x16_bf16(pa3, (bf16x8){l3[0], l3[1], l3[2], l3[3], h3[0], h3[1], h3[2], h3[3]}, o[d0], 0, 0, 0); } while (0)
    PV_D0(0); PV_D0(1); PV_D0(2); PV_D0(3);
#undef PV_D0
#undef TRRD
}

struct BlockRef { const bf16* Q; const bf16* K; const bf16* V; const bf16* G; bf16* O; int P0; };
struct Seam { bf16x8 qr[8]; bf16x8 st_v0, st_v1, st_k0, st_k1; };
#define LD8(base, boff) (*reinterpret_cast<const bf16x8*>((const char*)(base) + (boff)))
#define VMW() asm volatile("s_waitcnt vmcnt(0)" ::: "memory")
#define VMWN(n) asm volatile("s_waitcnt vmcnt(%0)" :: "i"(n) : "memory")
#define SLOAD_H(Kp, Vp, k0) do { const char* kb__ = (const char*)(Kp) + (size_t)(k0) * (LDQ * 2); const char* vb__ = (const char*)(Vp) + (size_t)(k0) * (LDQ * 2); \
                         S.st_v0 = LD8(vb__, kvoff); S.st_v1 = LD8(vb__, kvoff + 32u * LDQ * 2u);              \
                         S.st_k0 = LD8(kb__, kvoff); S.st_k1 = LD8(kb__, kvoff + 32u * LDQ * 2u); } while (0)
#define SWRITE_HK(bf) do { *(bf16x8*)(K_lds + (bf) * SHM_K + kws) = S.st_k0; *(bf16x8*)(K_lds + (bf) * SHM_K + kws + 32 * 256) = S.st_k1; } while (0)
#define SWRITE_HV(bf) do { *(bf16x8*)(V_lds + (bf) * SHM_V + vst0) = S.st_v0; *(bf16x8*)(V_lds + (bf) * SHM_V + vst1) = S.st_v1; } while (0)
#define SWRITE_H(bf) do { SWRITE_HV(bf); SWRITE_HK(bf); } while (0)
__device__ __forceinline__ void prime(const BlockRef& cur, char* lds, Seam& S) {
    const int tid = threadIdx.x, wid = __builtin_amdgcn_readfirstlane(tid >> 6), lane = tid & 63, r32 = lane & 31, hi = lane >> 5;
    const int sr = tid >> 4, sc = (tid & 15) * 8, kws = KSWZ(sr, sc * 2); char* K_lds = lds + 2 * SHM_V;
    const unsigned kvoff = (unsigned)(sr * LDQ + sc) * 2u, qoff = (unsigned)((wid * QBLK + r32) * LDQ + hi * 8) * 2u;
    for (int d0 = 0; d0 < 8; ++d0) S.qr[d0] = LD8(cur.Q, qoff + d0 * 32);
    SLOAD_H(cur.K, cur.V, 0); VMW(); SWRITE_HK(0);
    __syncthreads();
}
__device__ __forceinline__ void block(const BlockRef& cur, const BlockRef& nxt, char* lds, Seam& S) {
    const int tid = threadIdx.x, wid = __builtin_amdgcn_readfirstlane(tid >> 6), lane = tid & 63, r32 = lane & 31, hi = lane >> 5;
    const int NT = (cur.P0 + QB - 1) / KVBLK + 1;
    const int qlo = cur.P0 + wid * QBLK, qm = qlo + r32 - 4 * hi;
    char* V_lds = lds; char* K_lds = lds + 2 * SHM_V;
    float* ws = (float*)(lds + 2 * SHM_V + 2 * SHM_K) + wid * 64; float* li_l = ws, * al_l = ws + 32;
    const float* biasl = (const float*)(lds + BIAS_OFF) + 4 * hi;
    float m_reg = -1e30f, l_reg = 0; f32x16 o[4] = {};
    const int sr = tid >> 4, sc = (tid & 15) * 8, vst0 = v_st(sr, sc), vst1 = v_st(32 + sr, sc), kws = KSWZ(sr, sc * 2);
    const unsigned kvoff = (unsigned)(sr * LDQ + sc) * 2u;
    const int vb0 = (int)(uintptr_t)V_lds + v_rd_base(lane);
    const bf16* Kh = cur.K; const bf16* Vh = cur.V;
#define RESC(a) do { if (__any((a) < 1.f)) { if (hi == 0) al_l[r32] = (a); asm volatile("s_waitcnt lgkmcnt(0)" ::: "memory");              \
                     for (int d_ = 0; d_ < 4; ++d_) for (int r = 0; r < 16; ++r) o[d_][r] *= al_l[crow(r, hi)]; } } while (0)
#define KBASE(t) ((t) * KVBLK)
#define MASKT(P0_, P1_, t) do { const int kb_ = KBASE(t); if (kb_ + KVBLK - 1 > qlo) mask_tile(P0_, P1_, qm - kb_); } while (0)
    constexpr int NQL = 8;
#define SEAM_K0() do { VMWN(NQL); SWRITE_HK(0); SBAR(); } while (0)
    f32x16 pA0, pA1, pB0, pB1; float mnA, mnB, alA, alB; bf16x8 pa0, pa1, pa2, pa3;
    SWRITE_HV(0); SBAR();
    if (NT > 1) { SLOAD_H(Kh, Vh, KBASE(1)); }
    SBAR(); qkt<0>(pA0, pA1, K_lds, r32, hi, S.qr);
    MASKT(pA0, pA1, 0); partialSM(pA0, pA1, m_reg, mnA, alA, biasl + KBASE(0));
    if (NT > 1) { VMW(); SWRITE_H(1); }
    __syncthreads();
#define HALF_STEP(PX0, PX1, mnX, alX, PY0, PY1, alY, t, KB, VB, SB) do {                                                      \
        SBAR(); qkt<KB>(PX0, PX1, K_lds, r32, hi, S.qr);                                                                      \
        finishSM(PY0, PY1, alY, l_reg, pa0, pa1, pa2, pa3); SBAR();                                                           \
        if ((t) + 1 < NT) { SLOAD_H(Kh, Vh, KBASE((t) + 1)); SBAR(); }                                                        \
        pv_tile<VB>(o, vb0, pa0, pa1, pa2, pa3); MASKT(PX0, PX1, (t)); partialSM(PX0, PX1, m_reg, mnX, alX, biasl + KBASE(t)); \
        __syncthreads();                                                                                                      \
        if ((t) + 1 < NT) { VMW(); SWRITE_H(SB); }                                                                            \
        RESC(alX); __syncthreads(); } while (0)
    for (int t = 1; t + 1 < NT; t += 2) {
        HALF_STEP(pB0, pB1, mnB, alB, pA0, pA1, alA, t, 1, 0, 0);
        HALF_STEP(pA0, pA1, mnA, alA, pB0, pB1, alB, t + 1, 0, 1, 1);
    }
    const bool even = (NT & 1) == 0;
    if (even) { SBAR(); qkt<1>(pB0, pB1, K_lds, r32, hi, S.qr); SBAR(); }
    SLOAD_H(nxt.K, nxt.V, 0); SBAR();
    { unsigned qoff = (unsigned)((wid * QBLK + r32) * LDQ + hi * 8) * 2u; asm volatile("" : "+v"(qoff));
#pragma unroll
      for (int d0 = 0; d0 < 8; ++d0) S.qr[d0] = LD8(nxt.Q, qoff + d0 * 32); }
    SBAR();
    finishSM(pA0, pA1, alA, l_reg, pa0, pa1, pa2, pa3); SBAR();
    pv_tile<0>(o, vb0, pa0, pa1, pa2, pa3);
    if (even) { MASKT(pB0, pB1, NT - 1); partialSM(pB0, pB1, m_reg, mnB, alB, biasl + KBASE(NT - 1)); __syncthreads(); RESC(alB);
        finishSM(pB0, pB1, alB, l_reg, pa0, pa1, pa2, pa3); SBAR(); pv_tile<1>(o, vb0, pa0, pa1, pa2, pa3); }
    SBAR(); SEAM_K0();
    if (hi == 0) li_l[r32] = l_reg; asm volatile("s_waitcnt lgkmcnt(0)" ::: "memory");
    float rli[16];
#pragma unroll
    for (int r = 0; r < 16; ++r) rli[r] = __builtin_amdgcn_rcpf(li_l[crow(r, hi)]);
    unsigned ooff = (unsigned)((wid * QBLK + 4 * hi) * LDO + r32) * 2u, goff = (unsigned)((wid * QBLK + 4 * hi) * LDQ + r32) * 2u;
    asm volatile("" : "+v"(ooff), "+v"(goff));
#pragma unroll
    for (int r = 0; r < 16; ++r) { const unsigned rr = (unsigned)((r & 3) + 8 * (r >> 2));
#pragma unroll
        for (int d0 = 0; d0 < 4; ++d0) {
#ifdef FOX_NOGATE
            const float gv = 0.f;
#else
            const float gv = bf2f(*(const bf16*)((const char*)cur.G + (goff + rr * (LDQ * 2u) + d0 * 64u)));
#endif

            const float v = o[d0][r] * rli[r] * (1.0f / (1.0f + __expf(-gv)));
            const float vn = __shfl_xor(v, 1);
            if ((r32 & 1) == 0) *(unsigned*)((char*)cur.O + (ooff + rr * (LDO * 2u) + d0 * 64u)) = cvtpk(v, vn); } }
    __syncthreads();
#undef RESC
#undef KBASE
#undef MASKT
#undef SEAM_K0
#undef HALF_STEP
}
#undef LD8
#undef VMW
#undef VMWN
#undef SLOAD_H
#undef SWRITE_HK
#undef SWRITE_HV
#undef SWRITE_H
#undef KSWZ
#undef SBAR
}

constexpr int NWAVES = 8;
constexpr size_t MiB = 1u << 20;
constexpr size_t WS_CTL = 0, CTL_ZERO_BYTES = 1 * MiB;
constexpr size_t WS_MEMN = 1 * MiB;
constexpr size_t WS_KMEM = 2 * MiB;
constexpr size_t WS_VTMEM = 4 * MiB;
constexpr size_t WS_SMALL = 6 * MiB;
constexpr size_t SM_BONUS = 0;
constexpr size_t SM_FPRE = 512 * 1024;
constexpr size_t SM_BIASL2 = 1024 * 1024;
constexpr size_t SM_BCUM = 1536 * 1024;
constexpr size_t SM_IG = SM_BCUM + 128 * 1024;
constexpr size_t SM_WSTATE = SM_IG + 128 * 1024;
constexpr size_t SM_CHBL = SM_WSTATE + 128 * 1024;
constexpr size_t SM_CHMD = SM_CHBL + 4096;
constexpr size_t SM_MSEQ = SM_CHMD + 4096;
constexpr size_t SM_WCARRY = SM_MSEQ + 4096;
constexpr size_t SM_MOUT = SM_WCARRY + 4096;
constexpr size_t SM_TOPI = 2048 * 1024;
constexpr size_t SM_TOPG = SM_TOPI + 64 * 1024;
constexpr size_t SM_SLOT = SM_TOPG + 64 * 1024;
constexpr size_t SM_BLKCNT = SM_SLOT + 64 * 1024;
constexpr size_t SM_TILEE = SM_BLKCNT + 8192;
constexpr size_t SM_NU = 3 * 1024 * 1024;
constexpr size_t SM_SLOC = 4 * 1024 * 1024;
constexpr size_t SM_PEND = 5 * 1024 * 1024;
constexpr size_t SM_SIN = 6 * 1024 * 1024;
constexpr size_t WS_X = 16 * MiB;
constexpr size_t WS_XN = 80 * MiB;
constexpr size_t WS_W_XQ = 112 * MiB, WS_W_XKV = 128 * MiB, WS_W_XO = 160 * MiB, WS_W_ABIN = 176 * MiB, WS_W_LORA = 206 * MiB, WS_W_ABOUT = 209 * MiB,
                 WS_W_FFNGU = 217 * MiB, WS_W_FFND = 261 * MiB, WS_W_FOXIN = 283 * MiB, WS_W_FOXOUT = 315 * MiB, WS_W_MOEGU = 323 * MiB, WS_W_MOED = 675 * MiB;
constexpr size_t WS_R = 851 * MiB;
constexpr size_t R_PROJ = WS_R + 0 * MiB;
constexpr size_t R_GATES32 = WS_R + 120 * MiB;
constexpr size_t R_LORAIN = WS_R + 128 * MiB;
constexpr size_t R_LORAOUT = WS_R + 136 * MiB;
constexpr size_t R_SC = WS_R + 232 * MiB;
constexpr size_t SC_STRIDE = 32 * MiB;
constexpr size_t R_FR = WS_R + 232 * MiB;
constexpr size_t R_SV = WS_R + 392 * MiB;
constexpr size_t R_Y = WS_R + 424 * MiB;
constexpr size_t R_QB = WS_R + 456 * MiB, R_KB = WS_R + 472 * MiB, R_VB = WS_R + 488 * MiB;
constexpr size_t R_U = WS_R + 504 * MiB;
constexpr size_t R_YCAT = WS_R + 568 * MiB;
constexpr size_t R_XQ = WS_R + 0 * MiB;
constexpr size_t R_XS = WS_R + 32 * MiB;
constexpr size_t R_XP = WS_R + 64 * MiB;
constexpr size_t R_XO = WS_R + 80 * MiB;
constexpr size_t R_ACT = WS_R + 112 * MiB;
constexpr size_t R_QKVG = WS_R + 200 * MiB;
constexpr size_t R_ATTO = WS_R + 328 * MiB;
constexpr size_t R_AG = WS_R + 0 * MiB;
constexpr size_t R_ACTG = WS_R + 72 * MiB;
constexpr size_t R_YG = WS_R + 270 * MiB;
constexpr size_t R_YSIDE = WS_R + 416 * MiB;
constexpr size_t YSIDE_STRIDE = (size_t)8 * 256 * D;
constexpr size_t R_Z = WS_R + 600 * MiB;
constexpr size_t WS_END = WS_R + 624 * MiB;
static_assert(R_YG + (size_t)MOE_ROWS * D * 4 <= WS_END && R_ACTG + (size_t)MOE_ROWS * DFF * 2 <= R_YG && R_YCAT + (size_t)T * D * 2 <= WS_END, "ws map");
static_assert(WS_W_MOED + (size_t)NEXP * D * DFF * 2 <= WS_R && WS_W_MOEGU + (size_t)NEXP * 2 * DFF * D * 2 <= WS_W_MOED, "ws map (weights)");
constexpr int CW_BAR = 4096;
constexpr size_t CTL_FRFLAG = 262144;
constexpr size_t CTL_SSQ = 65536;

constexpr int RING_OFF = 0, RING_BYTES = 147456;
constexpr int LDSCTL_OFF = RING_BYTES, MISC_OFF = LDSCTL_OFF + 320;
constexpr int LDS_BYTES = RING_BYTES + 4096;

typedef GAS unsigned gu32;
#define RLX_AGENT __ATOMIC_RELAXED, __HIP_MEMORY_SCOPE_AGENT
#define LDS_WAIT() asm volatile("s_waitcnt lgkmcnt(0)" ::: "memory")
#define VM_WAIT() asm volatile("s_waitcnt vmcnt(0)" ::: "memory")

#define XB_TMO      128
#define XB_XCNT(j)  (256  + 64 * (j))
#define XB_XSUB(j)  (1280 + 64 * (j))
#define XB_XGEN(j)  (2304 + 64 * (j))
#define XB_TOP      3328
#define XB_TOPGEN   3392
#define XCD_BAR_WORDS 3456
#define XB_SPIN_CAP (1u << 18)
__device__ __forceinline__ unsigned xb_ld(unsigned* p)              { return __hip_atomic_load(p, __ATOMIC_RELAXED, __HIP_MEMORY_SCOPE_AGENT); }
__device__ __forceinline__ unsigned xb_add(unsigned* p, unsigned v) { return __hip_atomic_fetch_add(p, v, __ATOMIC_RELAXED, __HIP_MEMORY_SCOPE_AGENT); }
__device__ __forceinline__ unsigned xb_xcc_id() { return (unsigned)__builtin_amdgcn_s_getreg((3 << 11) | 20) & 0xFu; }
#define XB_SPIN(cond, bar) do { unsigned _sp = 0; while (cond) { __builtin_amdgcn_s_sleep(1); \
    if ((++_sp & 255u) == 0u) { if (xb_ld(&(bar)[XB_TMO])) break; if (_sp > XB_SPIN_CAP) { atomicAdd(&(bar)[XB_TMO], 1u); break; } } } } while (0)
struct XcdBarrier { unsigned* bar; unsigned x; volatile LAS unsigned* st; };
__device__ __forceinline__ XcdBarrier xcd_barrier_post(unsigned* bar, volatile LAS unsigned* st) {
    XcdBarrier b; b.bar = bar; b.x = xb_xcc_id(); b.st = st;
    if (threadIdx.x == 0) (void)xb_add(&bar[XB_XCNT(b.x)], 1u);
    return b;
}
__device__ __forceinline__ void xcd_barrier_complete(unsigned* bar, unsigned x, unsigned& nloc, unsigned& nx) {
    const unsigned G = gridDim.x * gridDim.y * gridDim.z;
    unsigned sum, cnt, mine, sp = 0u;
    for (;;) {
        sum = 0u; cnt = 0u; mine = 0u;
#pragma unroll
        for (unsigned j = 0; j < 16; ++j) { const unsigned c = xb_ld(&bar[XB_XCNT(j)]); sum += c; cnt += (c > 0u) ? 1u : 0u; mine = (j == x) ? c : mine; }
        if (sum == G) break;
        __builtin_amdgcn_s_sleep(1);
        if ((++sp & 255u) == 0u) { if (xb_ld(&bar[XB_TMO])) break; if (sp > XB_SPIN_CAP) { atomicAdd(&bar[XB_TMO], 1u); break; } }
    }
    nloc = mine > 0u ? mine : 1u; nx = cnt > 0u ? cnt : 1u;
}
__device__ __forceinline__ void xcd_barrier(const XcdBarrier& b) {
    asm volatile("s_waitcnt vmcnt(0)" ::: "memory");
    __syncthreads();
    if (threadIdx.x == 0) {
        unsigned* bar = b.bar;
        __builtin_amdgcn_s_waitcnt(0);
        unsigned nloc = b.st[0], nx = b.st[1];
        if (nloc == 0u) { xcd_barrier_complete(bar, b.x, nloc, nx); b.st[0] = nloc; b.st[1] = nx; }
        const unsigned old = xb_add(&bar[XB_XSUB(b.x)], 1u);
        const unsigned gen = old / nloc;
        if (old + 1u == (gen + 1u) * nloc) {
            __builtin_amdgcn_fence(__ATOMIC_RELEASE, "agent");
            asm volatile("s_waitcnt vmcnt(0)" ::: "memory");
            const unsigned og = xb_add(&bar[XB_TOP], 1u);
            const unsigned tg = og / nx;
            if (og + 1u == (tg + 1u) * nx) xb_add(&bar[XB_TOPGEN], 1u);
            else XB_SPIN(xb_ld(&bar[XB_TOPGEN]) == tg, bar);
            __builtin_amdgcn_fence(__ATOMIC_ACQUIRE, "agent");
            xb_add(&bar[XB_XGEN(b.x)], 1u);
            asm volatile("s_waitcnt vmcnt(0)" ::: "memory");
        } else {
            XB_SPIN(xb_ld(&bar[XB_XGEN(b.x)]) == gen, bar);
            __builtin_amdgcn_fence(__ATOMIC_ACQUIRE, "agent");
            asm volatile("s_waitcnt vmcnt(0)" ::: "memory");
        }
    }
    __syncthreads();
}

struct Frame {
    LAS unsigned char* lds; unsigned char* ldsg;
    unsigned char* ws; const float* const* in; float* out;
    int tid, lane, wave, vcu, G, gw, NGW;
};

enum InIdx { I_X = 0, I_MEM, I_MEMG, I_FING, I_NMIXG, I_NXAG, I_NFFNG, I_XWQ, I_XWKV, I_XWO, I_ABWIN, I_ABMU, I_RWW0, I_RWWUP, I_RWA0, I_RWAUP, I_RWGUP, I_RWKK, I_RWKA, I_RWRK,
             I_RWLNG, I_RWLNB, I_MLCONV, I_MLBIF, I_MLNG, I_ABWOUT, I_FFG, I_FFU, I_FFD, I_FOXWIN, I_FOXBF, I_FOXQG, I_FOXKG, I_FOXWOUT, I_ROUTER, I_MOEG, I_MOEU, I_MOED, N_IN };
struct Args { const float* in[N_IN]; float* out; unsigned char* ws; int ph_lo, ph_hi; };
static_assert(sizeof(Args) == (N_IN + 2) * 8 + 8, "Args has no padding");

#define WSP(T_, off) ((T_*)(F.ws + (off)))

__device__ __forceinline__ void rms_row(const float* xrow, const float* g, bf16* orow, int lane, f32x4 (&y)[8]) {
    const f32x4* xr = (const f32x4*)xrow + lane; const f32x4* gr = (const f32x4*)g + lane;
    float s = 0.f;
#pragma unroll
    for (int j = 0; j < 8; ++j) { y[j] = xr[64 * j]; s += (y[j][0] * y[j][0] + y[j][1] * y[j][1]) + (y[j][2] * y[j][2] + y[j][3] * y[j][3]); }
    const float r = 1.0f / sqrtf(wave_sum(s) * (1.0f / D) + 1e-6f);
#pragma unroll
    for (int j = 0; j < 8; ++j) { const f32x4 gv = gr[64 * j]; y[j] = y[j] * r * gv; }
    if (orow) { u32x2* o8 = (u32x2*)orow + lane;
#pragma unroll
        for (int j = 0; j < 8; ++j) { u32x2 w; w.x = cvt_pk_bf16(y[j][0], y[j][1]); w.y = cvt_pk_bf16(y[j][2], y[j][3]); o8[64 * j] = w; } }
}
__device__ __forceinline__ void norm_phase(const Frame& F, const float* X, const float* g, bf16* XN, int nrows) {
    for (int t = F.gw; t < nrows; t += F.NGW) { f32x4 y[8]; rms_row(X + (size_t)t * D, g, XN + (size_t)t * D, F.lane, y); }
}
template <int NC>
__device__ __forceinline__ void stage_skinny(const Frame& F, const float* W, int ldw, int c0, LAS float* Ws) {
    for (int i = F.tid; i < D * NC; i += NWAVES * 64) { const int e = i / NC, c = i % NC; Ws[c * D + e] = W[(size_t)e * ldw + c0 + c]; }
}
template <int NC>
__device__ __forceinline__ void skinny_dot(const f32x4 (&y)[8], const LAS float* Ws, int lane, float (&out)[NC]) {
#pragma unroll
    for (int c = 0; c < NC; ++c) { float s = 0.f;
#pragma unroll
        for (int j = 0; j < 8; ++j) { const f32x4 w = *(const LAS f32x4*)(Ws + c * D + 256 * j + 4 * lane); s += (y[j][0] * w[0] + y[j][1] * w[1]) + (y[j][2] * w[2] + y[j][3] * w[3]); }
        out[c] = wave_sum(s); }
}

__device__ __forceinline__ void titem_load(const float* W, int ldw, int k0, int n0, int nvalid, int lane, float (&v)[32]) {
    const int n = lane & 31; const float* p = W + (size_t)(k0 + (lane >> 5)) * ldw + n0 + n;
#pragma unroll
    for (int i = 0; i < 32; ++i) v[i] = (n < nvalid) ? __builtin_nontemporal_load(p + (size_t)(2 * i) * ldw) : 0.f;
}
__device__ __forceinline__ void titem_finish(const float (&v)[32], int k0, int nvalid, bf16* WT0  , int K, LAS float* scr, int lane) {
#pragma unroll
    for (int i = 0; i < 32; ++i) scr[(2 * i + (lane >> 5)) * 33 + (lane & 31)] = v[i];
    LDS_WAIT(); asm volatile("" ::: "memory");
    const int c = lane & 7;
#pragma unroll
    for (int j = 0; j < 4; ++j) { const int n = (lane >> 3) + 8 * j; const LAS float* s = scr + (8 * c) * 33 + n;
        u32x4 o; o.x = cvt_pk_bf16(s[0 * 33], s[1 * 33]); o.y = cvt_pk_bf16(s[2 * 33], s[3 * 33]); o.z = cvt_pk_bf16(s[4 * 33], s[5 * 33]); o.w = cvt_pk_bf16(s[6 * 33], s[7 * 33]);
        if (n < nvalid) __builtin_nontemporal_store(o, (u32x4*)(WT0 + (size_t)n * K + k0 + 8 * c)); }
    LDS_WAIT(); asm volatile("" ::: "memory");
}
__device__ __forceinline__ void transpose_matrix(const Frame& F, int gw, int NGW, const float* W, int ldw, int K, int N, bf16* WT, int mode, int& it0, LAS float* scr) {
    const int nblk = (N + 31) / 32, nitems = (K / 64) * nblk;
    int first = gw - (it0 % NGW); if (first < 0) first += NGW;
    it0 += nitems;
    if (first >= nitems) return;
    float va[32], vb[32];
    { const int kb = first / nblk, nb = first % nblk, n0 = 32 * nb; titem_load(W, ldw, 64 * kb, n0, (N - n0) < 32 ? (N - n0) : 32, F.lane, va); }
    for (int r = first; r < nitems; r += NGW) {
        const int kb = r / nblk, nb = r % nblk, n0 = 32 * nb; const int nvalid = (N - n0) < 32 ? (N - n0) : 32;
        const int drow = mode == 0 ? n0 : ((n0 >> 7) * 256 + (n0 & 127) + (mode == 2 ? 128 : 0));
        const int rn = r + NGW;
        if (rn < nitems) { const int kbn = rn / nblk, nbn = rn % nblk, n0n = 32 * nbn; titem_load(W, ldw, 64 * kbn, n0n, (N - n0n) < 32 ? (N - n0n) : 32, F.lane, vb); }
        titem_finish(va, 64 * kb, nvalid, WT + (size_t)drow * K, K, scr, F.lane);
#pragma unroll
        for (int i = 0; i < 32; ++i) va[i] = vb[i];
    }
}
__device__ __forceinline__ void p_convert_early(const Frame& F, const Args& A) {
    LAS float* scr = (LAS float*)(F.lds + RING_OFF + F.wave * 16384);
    int it0 = 0;
    for (int l = 0; l < 2; ++l)
        transpose_matrix(F, F.gw, F.NGW, A.in[I_XWKV] + (size_t)l * D * 2 * D, 2 * D, D, 2 * D, WSP(bf16, WS_W_XKV) + (size_t)l * 2 * D * D, 0, it0, scr);
    transpose_matrix(F, F.gw, F.NGW, A.in[I_ABWIN], AB_COLS, D, AB_COLS, WSP(bf16, WS_W_ABIN), 0, it0, scr);
    const int gt = F.gw * 64 + F.lane, NGT = F.NGW * 64;
    { u32x4* z = (u32x4*)(WSP(bf16, WS_W_ABIN) + (size_t)AB_COLS * D); const int n16 = (AB_PAD - AB_COLS) * D * 2 / 16;
      for (int i = gt; i < n16; i += NGT) z[i] = (u32x4){0u, 0u, 0u, 0u}; }
    { bf16* WL = WSP(bf16, WS_W_LORA); const float* wup = A.in[I_RWWUP]; const float* aup = A.in[I_RWAUP]; const float* gup = A.in[I_RWGUP];
      for (int i = gt; i < 3072 * 64; i += NGT) { const int n = i >> 6, k8 = (i & 63) * 8; const int sec = n >> 10, nn = n & 1023; float v[8];
#pragma unroll
          for (int j = 0; j < 8; ++j) { const int k = k8 + j; float x = 0.f;
              if (sec == 0) { if (k < 96) x = wup[(size_t)k * 1024 + nn]; }
              else if (sec == 1) { if (k >= 96 && k < 192) x = aup[(size_t)(k - 96) * 1024 + nn]; }
              else { if (k >= 192 && k < 448) x = gup[(size_t)(k - 192) * 1024 + nn]; }
              v[j] = x; }
          u32x4 o; o.x = cvt_pk_bf16(v[0], v[1]); o.y = cvt_pk_bf16(v[2], v[3]); o.z = cvt_pk_bf16(v[4], v[5]); o.w = cvt_pk_bf16(v[6], v[7]);
          *(u32x4*)(WL + (size_t)n * 512 + k8) = o; } }
    norm_phase(F, A.in[I_MEM], A.in[I_MEMG], WSP(bf16, WS_MEMN), NMEM);
    norm_phase(F, A.in[I_X], A.in[I_NMIXG], WSP(bf16, WS_XN), T);
}
__device__ __forceinline__ void p_convert_late(const Frame& F, const Args& A, int gw, int NGW, LAS float* scr, bool with_dense, int e_lo, int e_hi) {
    int it0 = 0;
    if (with_dense) {
        transpose_matrix(F, gw, NGW, A.in[I_ABWOUT], D, D, D, WSP(bf16, WS_W_ABOUT), 0, it0, scr);
        for (int l = 0; l < 2; ++l) {
            transpose_matrix(F, gw, NGW, A.in[I_XWQ] + (size_t)l * D * D, D, D, D, WSP(bf16, WS_W_XQ) + (size_t)l * D * D, 0, it0, scr);
            transpose_matrix(F, gw, NGW, A.in[I_XWO] + (size_t)l * D * D, D, D, D, WSP(bf16, WS_W_XO) + (size_t)l * D * D, 0, it0, scr);
        }
        transpose_matrix(F, gw, NGW, A.in[I_FFG], DFF, D, DFF, WSP(bf16, WS_W_FFNGU), 1, it0, scr);
        transpose_matrix(F, gw, NGW, A.in[I_FFU], DFF, D, DFF, WSP(bf16, WS_W_FFNGU), 2, it0, scr);
        transpose_matrix(F, gw, NGW, A.in[I_FFD], D, DFF, D, WSP(bf16, WS_W_FFND), 0, it0, scr);
        transpose_matrix(F, gw, NGW, A.in[I_FOXWIN], FOX_LD, D, 8192, WSP(bf16, WS_W_FOXIN), 0, it0, scr);
        transpose_matrix(F, gw, NGW, A.in[I_FOXWOUT], D, D, D, WSP(bf16, WS_W_FOXOUT), 0, it0, scr);
    }
    for (int e = e_lo; e < e_hi; ++e) {
        transpose_matrix(F, gw, NGW, A.in[I_MOEG] + (size_t)e * D * DFF, DFF, D, DFF, WSP(bf16, WS_W_MOEGU) + (size_t)e * 2 * DFF * D, 1, it0, scr);
        transpose_matrix(F, gw, NGW, A.in[I_MOEU] + (size_t)e * D * DFF, DFF, D, DFF, WSP(bf16, WS_W_MOEGU) + (size_t)e * 2 * DFF * D, 2, it0, scr);
        transpose_matrix(F, gw, NGW, A.in[I_MOED] + (size_t)e * DFF * D, D, DFF, D, WSP(bf16, WS_W_MOED) + (size_t)e * D * DFF, 0, it0, scr);
    }
}

struct InprojKvOrder {
    const bf16* xn; const bf16* wabin; const bf16* memn; const bf16* wkv; int G, c;
    __device__ __forceinline__ bool next(int i, pg8::Unit& u) const {
        const int L = i * G + c; u.pad = 0;
        if (L < 32 * (AB_PAD / 256)) { int pm, pn; pg8::static_tile(i, G, c, 32, AB_PAD / 256, pm, pn); u.pm = pm; u.pn = pn; u.aux = -1;
            u.a = (const char*)(xn + (size_t)pm * 256 * D); u.b = (const char*)(wabin + (size_t)pn * 256 * D); return true; }
        const int j = L - 32 * (AB_PAD / 256); if (j >= 32) return false;
        const int l = j >> 4, kind = (j >> 3) & 1, idx = j & 7; const bf16* w = wkv + (size_t)l * 2 * D * D;
        if (kind == 0) { u.a = (const char*)memn; u.b = (const char*)(w + (size_t)idx * 256 * D); u.pm = 0; u.pn = idx; }
        else { u.a = (const char*)(w + (size_t)(D + idx * 256) * D); u.b = (const char*)memn; u.pm = idx; u.pn = 0; }
        u.aux = l * 2 + kind; return true;
    }
};
struct EpiInprojKv {
    static constexpr bool PERM = true;
    bf16* proj; float* gates32; bf16* kmem; bf16* vtmem;
    __device__ __forceinline__ void operator()(const f32x4 (&acc)[2][2][4][2], const pg8::Unit& u, int wr, int wc, int fr, int fq) const {
        if (u.aux < 0) { pg8::EpiBf16 E{proj, AB_PAD, gates32, 29, nullptr}; E(acc, u, wr, wc, fr, fq); }
        else { const int l = u.aux >> 1, kind = u.aux & 1;
            pg8::EpiBf16 E{kind == 0 ? kmem + (size_t)l * NMEM * D : vtmem + (size_t)l * D * NMEM, kind == 0 ? D : NMEM, nullptr, -1, nullptr};
            E(acc, u, wr, wc, fr, fq); }
    }
};

__device__ __forceinline__ void p_prepa(const Frame& F, const Args& A) {
    const bf16* PROJ = WSP(bf16, R_PROJ); const float* mu = A.in[I_ABMU]; const float* convw = A.in[I_MLCONV];
    bf16* LIN = WSP(bf16, R_LORAIN); bf16* QB = WSP(bf16, R_QB); bf16* KB = WSP(bf16, R_KB); bf16* VB = WSP(bf16, R_VB);
    const int lane = F.lane;
    for (int t = F.gw; t < T; t += F.NGW) {
        const bf16* p0 = PROJ + (size_t)t * AB_PAD;
#pragma unroll
        for (int i = 0; i < 7; ++i) { const int cc = lane + 64 * i, c = 3072 + cc; const float p = bf2f(p0[c]); const float pp = t > 0 ? bf2f(p0[c - AB_PAD]) : 0.f;
            const float s = p + (pp - p) * mu[c]; float o;
            if (cc < 96) o = tanhf(s); else if (cc < 192) o = s; else o = sigmoidf_(s);
            LIN[(size_t)t * 512 + cc] = f2bf(o); }
        LIN[(size_t)t * 512 + 448 + lane] = 0;
#pragma unroll
        for (int i = 0; i < 4; ++i) { const int c = 8 * lane + 512 * i; float acc[8];
#pragma unroll
            for (int j = 0; j < 8; ++j) acc[j] = 0.f;
#pragma unroll
            for (int tap = 0; tap < 4; ++tap) { const int tt = t - 3 + tap; if (tt >= 0) {
                const bf16x8 v = *(const bf16x8*)(PROJ + (size_t)tt * AB_PAD + A_COLS + c); const f32x4 w0 = *(const f32x4*)(convw + tap * 2048 + c), w1 = *(const f32x4*)(convw + tap * 2048 + c + 4);
#pragma unroll
                for (int j = 0; j < 4; ++j) { acc[j] += bf2f((unsigned short)v[j]) * w0[j]; acc[4 + j] += bf2f((unsigned short)v[4 + j]) * w1[j]; } } }
            const float sc = c < 1024 ? 0.0625f : 1.0f; float o[8];
#pragma unroll
            for (int j = 0; j < 8; ++j) o[j] = acc[j] * sigmoidf_(acc[j]) * sc;
            u32x4 w; w.x = cvt_pk_bf16(o[0], o[1]); w.y = cvt_pk_bf16(o[2], o[3]); w.z = cvt_pk_bf16(o[4], o[5]); w.w = cvt_pk_bf16(o[6], o[7]);
            if (c < 1024) *(u32x4*)(QB + (size_t)t * 1024 + c) = w; else *(u32x4*)(KB + (size_t)t * 1024 + c - 1024) = w; }
#pragma unroll
        for (int i = 0; i < 2; ++i) { const int c = 8 * lane + 512 * i; *(u32x4*)(VB + (size_t)t * 1024 + c) = *(const u32x4*)(p0 + 5568 + c); }
    }
    const float* G32 = WSP(float, R_GATES32); const float* bif = A.in[I_MLBIF];
    float* BCUM = WSP(float, WS_SMALL + SM_BCUM); float* IG = WSP(float, WS_SMALL + SM_IG); float* CHBL = WSP(float, WS_SMALL + SM_CHBL); float* CHMD = WSP(float, WS_SMALL + SM_CHMD);
    for (int u = F.gw; u < NH_M * 128; u += F.NGW) { const int h = u >> 7, c = u & 127, t = 64 * c + lane;
        const float ig = G32[(size_t)t * 256 + 192 + h] + bif[h], fg = G32[(size_t)t * 256 + 196 + h] + bif[4 + h];
        float b = logsigmoidf_(fg);
#pragma unroll
        for (int o = 1; o < 64; o <<= 1) { const float x = __shfl_up(b, o); if (lane >= o) b += x; }
        const float bl = __shfl(b, 63); const float md = wave_max(bl - b + ig);
        BCUM[h * T + t] = b; IG[h * T + t] = ig;
        if (lane == 0) { CHBL[u] = bl; CHMD[u] = md; } }
}

__device__ __forceinline__ void p_prepb(const Frame& F, const Args& A) {
    const bf16* PROJ = WSP(bf16, R_PROJ); const float* LOUT = WSP(float, R_LORAOUT); const float* mu = A.in[I_ABMU];
    const float* w0 = A.in[I_RWW0]; const float* a0 = A.in[I_RWA0]; const float* kk_ = A.in[I_RWKK]; const float* ka_ = A.in[I_RWKA]; const float* rk_ = A.in[I_RWRK];
    float* SR = WSP(float, R_SC); float* SW = WSP(float, R_SC + SC_STRIDE); float* SKM = WSP(float, R_SC + 2 * SC_STRIDE); float* SV = WSP(float, R_SC + 3 * SC_STRIDE);
    float* SKK = WSP(float, R_SC + 4 * SC_STRIDE); float* SB = WSP(float, R_SC + 5 * SC_STRIDE); float* BONUS = WSP(float, WS_SMALL + SM_BONUS);
    const int lane = F.lane;
    for (int u = F.gw; u < NH_R * (T / 64); u += F.NGW) { const int h = u & 15, tb = u >> 4, c = 64 * h + lane, t0 = 64 * tb;
        const float mur = mu[c], muk = mu[1024 + c], muv = mu[2048 + c], w0c = w0[c], a0c = a0[c], kkc = kk_[c], kac = ka_[c], rkc = rk_[c];
        float pr = 0.f, pk = 0.f, pv = 0.f;
        if (t0 > 0) { const bf16* pp = PROJ + (size_t)(t0 - 1) * AB_PAD; pr = bf2f(pp[c]); pk = bf2f(pp[1024 + c]); pv = bf2f(pp[2048 + c]); }
        constexpr int GT = 8;
        float xr[GT], xk[GT], xv[GT], lw[GT], la[GT], nr[GT], nk[GT], nv[GT], nw[GT], na[GT];
#define PB_LOAD(dr, dk, dv, dw, da, tt_) do { _Pragma("unroll") for (int i = 0; i < GT; ++i) { const bf16* p0 = PROJ + (size_t)(t0 + (tt_) + i) * AB_PAD; const float* lo = LOUT + (size_t)(t0 + (tt_) + i) * 3072; \
            dr[i] = bf2f(p0[c]); dk[i] = bf2f(p0[1024 + c]); dv[i] = bf2f(p0[2048 + c]); dw[i] = lo[c]; da[i] = lo[1024 + c]; } } while (0)
        PB_LOAD(xr, xk, xv, lw, la, 0);
        for (int tt = 0; tt < 64; tt += GT) {
            if (tt + GT < 64) PB_LOAD(nr, nk, nv, nw, na, tt + GT);
            float kk[GT], km[GT], r[GT], v[GT], a[GT], w[GT], q1[GT], q2[GT];
#pragma unroll
            for (int i = 0; i < GT; ++i) { r[i] = xr[i] + (pr - xr[i]) * mur; const float k = xk[i] + (pk - xk[i]) * muk; v[i] = xv[i] + (pv - xv[i]) * muv; pr = xr[i]; pk = xk[i]; pv = xv[i];
                w[i] = __expf(-0.6065306597126334f * sigmoidf_(lw[i] + w0c)); a[i] = sigmoidf_(a0c + la[i]);
                kk[i] = k * kkc; km[i] = k * (1.0f + (a[i] - 1.0f) * kac); q1[i] = kk[i] * kk[i]; q2[i] = r[i] * km[i] * rkc; }
#pragma unroll
            for (int i = 0; i < GT; ++i) { q1[i] = wave_sum_dpp(q1[i]); q2[i] = wave_sum_dpp(q2[i]); }
#pragma unroll
            for (int i = 0; i < GT; ++i) { const float kn = kk[i] / fmaxf(sqrtf(q1[i]), 1e-12f); const size_t o = (size_t)(t0 + tt + i) * 1024 + c;
                SR[o] = r[i]; SW[o] = w[i]; SKM[o] = km[i]; SV[o] = v[i]; SKK[o] = kn; SB[o] = kn * a[i];
                if (lane == 0) BONUS[(t0 + tt + i) * 16 + h] = q2[i]; }
#pragma unroll
            for (int i = 0; i < GT; ++i) { xr[i] = nr[i]; xk[i] = nk[i]; xv[i] = nv[i]; lw[i] = nw[i]; la[i] = na[i]; }
        }
#undef PB_LOAD
    }
    if (F.gw < NH_M) { const int h = F.gw;
        const float* BCUM = WSP(float, WS_SMALL + SM_BCUM); const float* IG = WSP(float, WS_SMALL + SM_IG); const float* CHBL = WSP(float, WS_SMALL + SM_CHBL); const float* CHMD = WSP(float, WS_SMALL + SM_CHMD);
        float* MSEQ = WSP(float, WS_SMALL + SM_MSEQ); float* WCARRY = WSP(float, WS_SMALL + SM_WCARRY);
        const float bl0 = CHBL[h * 128 + lane], bl1 = CHBL[h * 128 + 64 + lane], md0 = CHMD[h * 128 + lane], md1 = CHMD[h * 128 + 64 + lane];
        float m = 0.f, mine_in0 = 0.f, mine_in1 = 0.f, mine_out0 = 0.f, mine_out1 = 0.f;
#pragma unroll
        for (int c = 0; c < 128; ++c) { const float bl = __shfl(c < 64 ? bl0 : bl1, c & 63), md = __shfl(c < 64 ? md0 : md1, c & 63);
            const float mn = fmaxf(bl + m, md);
            if ((c & 63) == lane) { if (c < 64) { mine_in0 = m; mine_out0 = mn; } else { mine_in1 = m; mine_out1 = mn; } }
            m = mn; }
        MSEQ[h * 128 + lane] = mine_in0; MSEQ[h * 128 + 64 + lane] = mine_in1;
        WCARRY[h * 128 + lane] = __expf(bl0 + mine_in0 - mine_out0); WCARRY[h * 128 + 64 + lane] = __expf(bl1 + mine_in1 - mine_out1);
        float* MOUT = WSP(float, WS_SMALL + SM_MOUT); MOUT[h * 128 + lane] = mine_out0; MOUT[h * 128 + 64 + lane] = mine_out1;
    }
}

__device__ __forceinline__ void p_mlstm_pass2(const Frame& F, bool mine, int hh) {
    const int lane = F.lane;
    if (mine) { const int h = hh;
        const float* CHBL = WSP(float, WS_SMALL + SM_CHBL); const float* CHMD = WSP(float, WS_SMALL + SM_CHMD);
        float* MSEQ = WSP(float, WS_SMALL + SM_MSEQ); float* WCARRY = WSP(float, WS_SMALL + SM_WCARRY);
        const float bl0 = CHBL[h * 128 + lane], bl1 = CHBL[h * 128 + 64 + lane], md0 = CHMD[h * 128 + lane], md1 = CHMD[h * 128 + 64 + lane];
        float m = 0.f, mine_in0 = 0.f, mine_in1 = 0.f, mine_out0 = 0.f, mine_out1 = 0.f;
#pragma unroll
        for (int c = 0; c < 128; ++c) { const float bl = __shfl(c < 64 ? bl0 : bl1, c & 63), md = __shfl(c < 64 ? md0 : md1, c & 63);
            const float mn = fmaxf(bl + m, md);
            if ((c & 63) == lane) { if (c < 64) { mine_in0 = m; mine_out0 = mn; } else { mine_in1 = m; mine_out1 = mn; } }
            m = mn; }
        MSEQ[h * 128 + lane] = mine_in0; MSEQ[h * 128 + 64 + lane] = mine_in1;
        WCARRY[h * 128 + lane] = __expf(bl0 + mine_in0 - mine_out0); WCARRY[h * 128 + 64 + lane] = __expf(bl1 + mine_in1 - mine_out1);
        float* MOUT = WSP(float, WS_SMALL + SM_MOUT); MOUT[h * 128 + lane] = mine_out0; MOUT[h * 128 + 64 + lane] = mine_out1;
    }
}

__device__ __forceinline__ float row16_sum(float x) {
    x += __builtin_bit_cast(float, __builtin_amdgcn_update_dpp(0, __builtin_bit_cast(int, x), 0xB1, 0xF, 0xF, true));
    x += __builtin_bit_cast(float, __builtin_amdgcn_update_dpp(0, __builtin_bit_cast(int, x), 0x4E, 0xF, 0xF, true));
    x += __builtin_bit_cast(float, __builtin_amdgcn_update_dpp(0, __builtin_bit_cast(int, x), 0x141, 0xF, 0xF, true));
    x += __builtin_bit_cast(float, __builtin_amdgcn_update_dpp(0, __builtin_bit_cast(int, x), 0x140, 0xF, 0xF, true));
    return x;
}
__device__ __forceinline__ void row16_sum2(float& a, float& b) {
#define DPPF(x, ctrl) __builtin_bit_cast(float, __builtin_amdgcn_update_dpp(0, __builtin_bit_cast(int, x), ctrl, 0xF, 0xF, true))
    a += DPPF(a, 0xB1); b += DPPF(b, 0xB1); a += DPPF(a, 0x4E); b += DPPF(b, 0x4E); a += DPPF(a, 0x141); b += DPPF(b, 0x141); a += DPPF(a, 0x140); b += DPPF(b, 0x140);
#undef DPPF
}
constexpr int SCH = 8;
constexpr int SC_VEC = SCH * 256;
constexpr int SC_BUF = 5 * SC_VEC + 1024;
constexpr int SC_NBUF = 3, SC_NSEG = 4;
constexpr int SC_LDS = SC_NSEG * SC_NBUF * SC_BUF;
constexpr int SC_PROG_OFF = SC_LDS;
constexpr int SC_TOUCH_AHEAD = 12;
__device__ __forceinline__ void row16_sum4(float& a, float& b, float& c, float& d) {
#define DPPF(x, ctrl) __builtin_bit_cast(float, __builtin_amdgcn_update_dpp(0, __builtin_bit_cast(int, x), ctrl, 0xF, 0xF, true))
    a += DPPF(a, 0xB1); b += DPPF(b, 0xB1); c += DPPF(c, 0xB1); d += DPPF(d, 0xB1); a += DPPF(a, 0x4E); b += DPPF(b, 0x4E); c += DPPF(c, 0x4E); d += DPPF(d, 0x4E);
    a += DPPF(a, 0x141); b += DPPF(b, 0x141); c += DPPF(c, 0x141); d += DPPF(d, 0x141); a += DPPF(a, 0x140); b += DPPF(b, 0x140); c += DPPF(c, 0x140); d += DPPF(d, 0x140);
#undef DPPF
}
__host__ __device__ constexpr int sc_len(int s) { return s == 0 ? 3328 : (s == 3 ? 1664 : 1600); }
__host__ __device__ constexpr int sc_tb(int s) { return s == 0 ? 0 : 3328 + (s - 1) * 1600; }
static_assert(sc_tb(3) + sc_len(3) == T, "segments cover the sequence");
__device__ __forceinline__ int sc_seg_of(int t) { return t < 3328 ? 0 : (t < 4928 ? 1 : (t < 6528 ? 2 : 3)); }
template <int SEGI>
__device__ __forceinline__ void p_scan(const Frame& F) {
    constexpr bool TR = SEGI >= 1; constexpr int TB = sc_tb(SEGI), SC_SEG = sc_len(SEGI), SC_SEG0 = sc_len(0);
    const int b = blockIdx.x, head = (b & 7) * 2 + ((b >> 3) & 1), rg = b >> 4, lane = F.lane, row = lane >> 4, j = lane & 15;
    const float* SR = WSP(float, R_SC); const float* SW = WSP(float, R_SC + SC_STRIDE); const float* SKM = WSP(float, R_SC + 2 * SC_STRIDE); const float* SV = WSP(float, R_SC + 3 * SC_STRIDE);
    const float* SKK = WSP(float, R_SC + 4 * SC_STRIDE); const float* SB = WSP(float, R_SC + 5 * SC_STRIDE);
    float* Yo = WSP(float, R_Y) + (size_t)TB * 1024; float* Zo = WSP(float, R_Z) + (size_t)(TR ? TB - SC_SEG0 : 0) * 1024;
    LAS unsigned char* lds = F.lds + RING_OFF + SEGI * SC_NBUF * SC_BUF;
    volatile LAS int* prog = (volatile LAS int*)(F.lds + RING_OFF + SC_PROG_OFF);
    const size_t goff = (size_t)TB * 1024 + (size_t)(lane >> 4) * 1024 + head * 64 + (lane & 15) * 4;
    f32x2 L0 = {0.f, 0.f}, L1 = {0.f, 0.f}, T0 = {0.f, 0.f}, T1 = {0.f, 0.f};
    if (TR) { const int i = rg * 4 + row; if ((i >> 2) == j) { const int e = i & 3; T0[0] = e == 0 ? 1.f : 0.f; T0[1] = e == 1 ? 1.f : 0.f; T1[0] = e == 2 ? 1.f : 0.f; T1[1] = e == 3 ? 1.f : 0.f; } }
#define SC_ISSUE(c_, buf_) do { const size_t t0_ = (size_t)(c_) * SCH * 1024; LAS unsigned char* d_ = lds + (buf_) * SC_BUF; \
        _Pragma("unroll") for (int q = 0; q < SCH / 4; ++q) { const size_t o_ = t0_ + (size_t)q * 4096 + goff; \
            __builtin_amdgcn_global_load_lds((const unsigned*)(SKK + o_), (LAS unsigned*)(d_ + 0 * SC_VEC + q * 1024), 16, 0, 0); \
            __builtin_amdgcn_global_load_lds((const unsigned*)(SW  + o_), (LAS unsigned*)(d_ + 1 * SC_VEC + q * 1024), 16, 0, 0); \
            __builtin_amdgcn_global_load_lds((const unsigned*)(SB  + o_), (LAS unsigned*)(d_ + 2 * SC_VEC + q * 1024), 16, 0, 0); \
            __builtin_amdgcn_global_load_lds((const unsigned*)(SR  + o_), (LAS unsigned*)(d_ + 3 * SC_VEC + q * 1024), 16, 0, 0); \
            __builtin_amdgcn_global_load_lds((const unsigned*)(SKM + o_), (LAS unsigned*)(d_ + 4 * SC_VEC + q * 1024), 16, 0, 0); } \
        { int ts_ = TB + (c_) * SCH + lane; ts_ = ts_ < T ? ts_ : T - 1; \
          __builtin_amdgcn_global_load_lds((const unsigned*)(SV + (size_t)ts_ * 1024 + head * 64 + rg * 4), (LAS unsigned*)(d_ + 5 * SC_VEC), 16, 0, 0); } } while (0)
    __builtin_amdgcn_s_setprio(3);
    constexpr int NCH = SC_SEG / SCH;
    static_assert(NCH % 2 == 0 && SC_NBUF == 3, "three-buffer pipeline, 11 loads per chunk");
    SC_ISSUE(0, 0); SC_ISSUE(1, 1);
    int buf = 0; float ykL = 0.f, ykT = 0.f; f32x2 rp0 = {0.f, 0.f}, rp1 = {0.f, 0.f};
    for (int c = 0; c < NCH; ++c) {
        if (c < NCH - 1) asm volatile("s_waitcnt vmcnt(11)" ::: "memory"); else asm volatile("s_waitcnt vmcnt(0)" ::: "memory");
        if (c + 2 < NCH) { const int nb = buf >= 1 ? buf - 1 : buf + 2; SC_ISSUE(c + 2, nb); }
        if (SEGI == 0 && lane == 0) *prog = c;
        const LAS unsigned char* d = lds + buf * SC_BUF + j * 16;
        const LAS unsigned char* dv = lds + buf * SC_BUF + 5 * SC_VEC + row * 4;
        const int jb = (c & 1) * SCH;
        f32x2 kkA, kkB, wA, wB, bA, bB, kmA, kmB, rA, rB; float vv;
#define SC_LOAD(s_) do { const f32x4 kk_ = *(const LAS f32x4*)(d + 0 * SC_VEC + (s_) * 256), w_ = *(const LAS f32x4*)(d + 1 * SC_VEC + (s_) * 256), b_ = *(const LAS f32x4*)(d + 2 * SC_VEC + (s_) * 256); \
        const f32x4 r_ = *(const LAS f32x4*)(d + 3 * SC_VEC + (s_) * 256), km_ = *(const LAS f32x4*)(d + 4 * SC_VEC + (s_) * 256); vv = *(const LAS float*)(dv + (s_) * 16); \
        kkA = (f32x2){kk_[0], kk_[1]}; kkB = (f32x2){kk_[2], kk_[3]}; wA = (f32x2){w_[0], w_[1]}; wB = (f32x2){w_[2], w_[3]}; bA = (f32x2){b_[0], b_[1]}; bB = (f32x2){b_[2], b_[3]}; \
        rA = (f32x2){r_[0], r_[1]}; rB = (f32x2){r_[2], r_[3]}; kmA = (f32x2){km_[0], km_[1]}; kmB = (f32x2){km_[2], km_[3]}; } while (0)
        SC_LOAD(0);
#pragma unroll
        for (int s = 0; s < SCH; ++s) {
            f32x2 kk0 = kkA, kk1 = kkB, w0 = wA, w1 = wB, b0 = bA, b1 = bB, r0 = rA, r1 = rB, km0 = kmA, km1 = kmB; float v_ = vv;
            asm volatile("" : "+v"(kk0), "+v"(kk1), "+v"(w0), "+v"(w1), "+v"(b0), "+v"(b1), "+v"(r0), "+v"(r1), "+v"(km0), "+v"(km1), "+v"(v_));
            if (s + 1 < SCH) { SC_LOAD(s + 1); }
            __builtin_amdgcn_sched_barrier(0);
            const int keep = (jb + s + 15) & 15;
            if (TR) {
                f32x2 tl = L0 * kk0, ul = L0 * rp0, tt = T0 * kk0, ut = T0 * rp0; tl = L1 * kk1 + tl; ul = L1 * rp1 + ul; tt = T1 * kk1 + tt; ut = T1 * rp1 + ut;
                float sl = tl[0] + tl[1], yl = ul[0] + ul[1], st = tt[0] + tt[1], yt = ut[0] + ut[1];
                row16_sum4(sl, st, yl, yt);
                ykL = (j == keep) ? yl : ykL; ykT = (j == keep) ? yt : ykT;
                if (s == 0 && jb == 0 && c >= 2) { const size_t o = (size_t)((c - 2) * SCH + j) * 1024 + head * 64 + rg * 4 + row; Yo[o] = ykL; Zo[o] = ykT; }
                L0 = L0 * w0 + (km0 * v_ - b0 * sl); L1 = L1 * w1 + (km1 * v_ - b1 * sl); T0 = T0 * w0 - b0 * st; T1 = T1 * w1 - b1 * st;
            } else {
                f32x2 tl = L0 * kk0, ul = L0 * rp0; tl = L1 * kk1 + tl; ul = L1 * rp1 + ul;
                float sl = tl[0] + tl[1], yl = ul[0] + ul[1];
                row16_sum2(sl, yl);
                ykL = (j == keep) ? yl : ykL;
                if (s == 0 && jb == 0 && c >= 2) Yo[(size_t)((c - 2) * SCH + j) * 1024 + head * 64 + rg * 4 + row] = ykL;
                L0 = L0 * w0 + (km0 * v_ - b0 * sl); L1 = L1 * w1 + (km1 * v_ - b1 * sl);
            }
            rp0 = r0; rp1 = r1;
            __builtin_amdgcn_sched_barrier(0);
        }
#undef SC_LOAD
        buf = buf == SC_NBUF - 1 ? 0 : buf + 1;
    }
    { const size_t o = (size_t)(SC_SEG - 16 + j) * 1024 + head * 64 + rg * 4 + row;
      f32x2 u = L0 * rp0; u = L1 * rp1 + u; const float us = row16_sum(u[0] + u[1]); ykL = (j == 15) ? us : ykL; Yo[o] = ykL;
      if (TR) { f32x2 ut = T0 * rp0; ut = T1 * rp1 + ut; const float ut_ = row16_sum(ut[0] + ut[1]); ykT = (j == 15) ? ut_ : ykT; Zo[o] = ykT; } }
    if (SEGI < SC_NSEG - 1) { float* p = WSP(float, WS_SMALL + SM_SLOC) + (((size_t)SEGI * 16 + head) * 64 + rg * 4 + row) * 64 + 4 * j; *(f32x4*)p = (f32x4){L0[0], L0[1], L1[0], L1[1]}; }
    if (TR && SEGI < SC_NSEG - 1) { float* p = WSP(float, WS_SMALL + SM_PEND) + (((size_t)SEGI * 16 + head) * 64 + rg * 4 + row) * 64 + 4 * j; *(f32x4*)p = (f32x4){T0[0], T0[1], T1[0], T1[1]}; }
    asm volatile("s_waitcnt vmcnt(0)" ::: "memory");
    __builtin_amdgcn_s_setprio(0);
#undef SC_ISSUE
}
__device__ __forceinline__ void p_scan_touch(const Frame& F) {
    const int b = blockIdx.x, head = (b & 7) * 2 + ((b >> 3) & 1), lane = F.lane;
    const char* base = (const char*)WSP(float, R_SC); volatile LAS int* prog = (volatile LAS int*)(F.lds + RING_OFF + SC_PROG_OFF);
    constexpr int NCH0 = sc_len(0) / SCH, LPS = SCH * 12;
    unsigned dummy = 0;
    for (int c = 0; c < NCH0; ++c) {
        for (int spin = 0; spin < (1 << 16) && c > *prog + SC_TOUCH_AHEAD; ++spin) __builtin_amdgcn_s_sleep(8);
#pragma unroll
        for (int q = 0; q < 2; ++q) { const int x = q * 64 + lane; if (x < LPS) { const int step = x / 12, arr = (x % 12) >> 1, half = x & 1;
            const char* p = base + (size_t)arr * SC_STRIDE + ((size_t)(c * SCH + step) * 1024 + head * 64 + half * 32) * 4;
            asm volatile("global_load_dword %0, %1, off" : "+v"(dummy) : "v"(p) : "memory"); } }
        if ((c & 1) == 0) { const int c2 = c >> 1;
#pragma unroll
            for (int q = 0; q < 5; ++q) { const int x = q * 64 + lane; if (x < 3 * LPS) { const int seg = 1 + x / LPS, y = x % LPS, step = y / 12, arr = (y % 12) >> 1, half = y & 1;
                if (c2 * SCH < sc_len(seg)) { const char* p = base + (size_t)arr * SC_STRIDE + ((size_t)(sc_tb(seg) + c2 * SCH + step) * 1024 + head * 64 + half * 32) * 4;
                    asm volatile("global_load_dword %0, %1, off" : "+v"(dummy) : "v"(p) : "memory"); } } } }
    }
    asm volatile("s_waitcnt vmcnt(0)" : "+v"(dummy) :: "memory");
}
__device__ __forceinline__ void p_scomb(const Frame& F) {
    const float* SLOC = WSP(float, WS_SMALL + SM_SLOC); const float* PEND = WSP(float, WS_SMALL + SM_PEND); float* SIN = WSP(float, WS_SMALL + SM_SIN); const int lane = F.lane;
    for (int u = F.gw; u < 16 * 64; u += F.NGW) { const int h = u >> 6, v = u & 63;
        float sv = SLOC[((size_t)(0 * 16 + h) * 64 + v) * 64 + lane];
        SIN[((size_t)(1 * 16 + h) * 64 + v) * 64 + lane] = sv;
#pragma unroll
        for (int s = 2; s < SC_NSEG; ++s) { float acc = SLOC[((size_t)((s - 1) * 16 + h) * 64 + v) * 64 + lane]; const float* P = PEND + ((size_t)((s - 1) * 16 + h) * 64) * 64 + lane;
#pragma unroll 8
            for (int i = 0; i < 64; ++i) acc += __builtin_bit_cast(float, __builtin_amdgcn_readlane(__builtin_bit_cast(int, sv), i)) * P[(size_t)i * 64];
            sv = acc; SIN[((size_t)(s * 16 + h) * 64 + v) * 64 + lane] = sv; } }
}

__device__ __forceinline__ void p_rwkv_post(const Frame& F, const Args& A) {
    const float* Y = WSP(float, R_Y); const float* SV = WSP(float, R_SV); const float* LOUT = WSP(float, R_LORAOUT); const float* BONUS = WSP(float, WS_SMALL + SM_BONUS);
    const float* lng = A.in[I_RWLNG]; const float* lnb = A.in[I_RWLNB]; bf16* YCAT = WSP(bf16, R_YCAT); const int lane = F.lane;
    const float* SIN = WSP(float, WS_SMALL + SM_SIN); const float* Z = WSP(float, R_Z);
    for (int u = F.gw; u < NH_R * (T / 64); u += F.NGW) { const int h = u & 15, tb = u >> 4, c = 64 * h + lane, t0 = 64 * tb; const float lg = lng[c], lb = lnb[c];
        const int seg = 0; const bool seg1 = false; float sm[64];
        if (seg1) {
#pragma unroll
            for (int q = 0; q < 16; ++q) { const f32x4 x = *(const f32x4*)(SIN + ((size_t)(seg * 16 + h) * 64 + lane) * 64 + 4 * q); sm[4 * q] = x[0]; sm[4 * q + 1] = x[1]; sm[4 * q + 2] = x[2]; sm[4 * q + 3] = x[3]; } }
        constexpr int GT = 4;
        float y[GT], sv[GT], g[GT], bo[GT], z[GT], ny[GT], nsv[GT], ng[GT], nbo[GT], nz[GT], d[GT];
#define PP_LOAD(dy, dsv, dg, dbo, dz, tt_) do { _Pragma("unroll") for (int i = 0; i < GT; ++i) { const size_t t = t0 + (tt_) + i; dy[i] = Y[t * 1024 + c]; dsv[i] = SV[t * 1024 + c]; dg[i] = LOUT[t * 3072 + 2048 + c]; dbo[i] = BONUS[t * 16 + h]; \
            dz[i] = seg1 ? Z[(t - sc_len(0)) * 1024 + c] : 0.f; } } while (0)
        PP_LOAD(y, sv, g, bo, z, 0);
        for (int tt = 0; tt < 64; tt += GT) {
            if (tt + GT < 64) PP_LOAD(ny, nsv, ng, nbo, nz, tt + GT);
            if (seg1) {
#pragma unroll
                for (int q = 0; q < 64; ++q) {
#pragma unroll
                    for (int i = 0; i < GT; ++i) y[i] += sm[q] * __builtin_bit_cast(float, __builtin_amdgcn_readlane(__builtin_bit_cast(int, z[i]), q)); } }
#pragma unroll
            for (int i = 0; i < GT; ++i) d[i] = wave_sum_dpp(y[i]);
#pragma unroll
            for (int i = 0; i < GT; ++i) { y[i] -= d[i] * (1.0f / 64.0f); d[i] = y[i] * y[i]; }
#pragma unroll
            for (int i = 0; i < GT; ++i) d[i] = wave_sum_dpp(d[i]);
#pragma unroll
            for (int i = 0; i < GT; ++i) { const float o = (y[i] * (1.0f / sqrtf(d[i] * (1.0f / 64.0f) + 64e-5f)) * lg + lb + bo[i] * sv[i]) * g[i];
                YCAT[(size_t)(t0 + tt + i) * D + c] = f2bf(o); }
#pragma unroll
            for (int i = 0; i < GT; ++i) { y[i] = ny[i]; sv[i] = nsv[i]; g[i] = ng[i]; bo[i] = nbo[i]; z[i] = nz[i]; }
        }
#undef PP_LOAD
    }
}

constexpr int CK = 16, NCK = T / CK;
constexpr int CK_NFR = 19;
constexpr int CKP = 65;
__device__ __forceinline__ void ck_kpos(int k, int& g, int& kq, int& j) { g = k >> 5; const int kl = k & 31; if (kl < 16) { kq = kl >> 2; j = kl & 3; } else { kq = (kl - 16) >> 2; j = 4 + (kl & 3); } }

__device__ __forceinline__ void p_rwkv_chunk(const Frame& F, const Args& A) {
    const bf16* PROJ = WSP(bf16, R_PROJ); const float* LOUT = WSP(float, R_LORAOUT); const float* mu = A.in[I_ABMU];
    const float* w0 = A.in[I_RWW0]; const float* a0 = A.in[I_RWA0]; const float* kk_ = A.in[I_RWKK]; const float* ka_ = A.in[I_RWKA]; const float* rk_ = A.in[I_RWRK];
    float* SV = WSP(float, R_SV); float* BONUS = WSP(float, WS_SMALL + SM_BONUS); unsigned char* FR = WSP(unsigned char, R_FR);
    LAS float* L = (LAS float*)(F.lds + RING_OFF);
    LAS float* sA = L; LAS float* sP = L + 16 * CKP; LAS float* sB = L + 2 * 16 * CKP; LAS float* sKM = L + 3 * 16 * CKP; LAS float* sRH = L + 4 * 16 * CKP;
    LAS float* sCS = L + 5 * 16 * CKP; LAS float* sDM = L + 6 * 16 * CKP; LAS float* sCL = L + 7 * 16 * CKP; LAS float* sDL = L + 8 * 16 * CKP; LAS float* sV = L + 9 * 16 * CKP;
    LAS float* sAn = L + 10 * 16 * CKP; LAS float* sRn = L + 11 * 16 * CKP;
    LAS float* sU = L + 12 * 16 * CKP;
    LAS float* sAP = sU + 4 * 16 * 17;
    LAS float* sDP = sAP + 64 * 17;
    LAS float* sPL = sDP + 16 * 17;
    LAS bf16* sFR = (LAS bf16*)(sPL + 64);
    static_assert(((12 * 16 * CKP + 4 * 16 * 17 + 64 * 17 + 16 * 17 + 64) * 4) % 16 == 0, "fragment image alignment");
    const int tid = F.tid, lane = F.lane, wave = F.wave;
    for (int i = tid; i < CK_NFR * 512; i += NWAVES * 64) sFR[i] = 0;
    __syncthreads();
    const int upb = (NH_R * NCK) / F.G;
    const int r32 = lane & 31, hg = lane >> 5;
    float xr[3], xk[3], xv[3], lw[2], la[2], pm[8];
#define CK_LOAD(u_) do { const int c_ = (u_) >> 4, h_ = (u_) & 15, ch_ = 64 * h_ + lane, ta_ = c_ * CK + 2 * wave; \
        pm[0] = mu[ch_]; pm[1] = mu[1024 + ch_]; pm[2] = mu[2048 + ch_]; pm[3] = w0[ch_]; pm[4] = a0[ch_]; pm[5] = kk_[ch_]; pm[6] = ka_[ch_]; pm[7] = rk_[ch_]; \
        if (ta_ > 0) { const bf16* pp = PROJ + (size_t)(ta_ - 1) * AB_PAD; xr[0] = bf2f(pp[ch_]); xk[0] = bf2f(pp[1024 + ch_]); xv[0] = bf2f(pp[2048 + ch_]); } else { xr[0] = 0.f; xk[0] = 0.f; xv[0] = 0.f; } \
        _Pragma("unroll") for (int i = 0; i < 2; ++i) { const bf16* p0 = PROJ + (size_t)(ta_ + i) * AB_PAD; const float* lo = LOUT + (size_t)(ta_ + i) * 3072; \
            xr[1 + i] = bf2f(p0[ch_]); xk[1 + i] = bf2f(p0[1024 + ch_]); xv[1 + i] = bf2f(p0[2048 + ch_]); lw[i] = lo[ch_]; la[i] = lo[1024 + ch_]; } } while (0)
    CK_LOAD(F.vcu * upb);
    for (int ui = 0; ui < upb; ++ui) { const int u = F.vcu * upb + ui, c = u >> 4, h = u & 15, t0 = c * CK;
        { const int ch = 64 * h + lane; const int ta = t0 + 2 * wave; float pr = xr[0], pk = xk[0], pv = xv[0];
#pragma unroll
          for (int i = 0; i < 2; ++i) { const int t = ta + i, tl = 2 * wave + i;
              const float r = xr[1 + i] + (pr - xr[1 + i]) * pm[0], k = xk[1 + i] + (pk - xk[1 + i]) * pm[1], v = xv[1 + i] + (pv - xv[1 + i]) * pm[2]; pr = xr[1 + i]; pk = xk[1 + i]; pv = xv[1 + i];
              const float w = __expf(-0.6065306597126334f * sigmoidf_(lw[i] + pm[3])), a = sigmoidf_(pm[4] + la[i]);
              float kk = k * pm[5]; const float km = k * (1.0f + (a - 1.0f) * pm[6]);
              const float q1 = wave_sum_dpp(kk * kk), q2 = wave_sum_dpp(r * km * pm[7]);
              kk = kk / fmaxf(sqrtf(q1), 1e-12f);
              sA[tl * CKP + lane] = kk; sP[tl * CKP + lane] = w; sB[tl * CKP + lane] = kk * a; sKM[tl * CKP + lane] = km; sRH[tl * CKP + lane] = r; sV[tl * CKP + lane] = v;
              SV[(size_t)t * 1024 + ch] = v; if (lane == 0) BONUS[t * 16 + h] = q2; } }
        if (ui + 1 < upb) CK_LOAD(u + 1);
        __syncthreads();
        { const int k = tid & 63;
#pragma unroll
          for (int q = 0; q < 2; ++q) { const int t = (tid >> 6) * 2 + q; float Pp = 1.f, P = 1.f, PL = 1.f;
#pragma unroll
              for (int i = 0; i < CK; ++i) { const float wv = sP[i * CKP + k]; PL *= wv; if (i < t) Pp *= wv; if (i <= t) P *= wv; }
              const float inv = 1.0f / P, ratio = PL * inv, kkv = sA[t * CKP + k], bv = sB[t * CKP + k], kmv = sKM[t * CKP + k], rv = sRH[t * CKP + k];
              sCS[t * CKP + k] = bv * inv; sDM[t * CKP + k] = kmv * inv; sCL[t * CKP + k] = bv * ratio; sDL[t * CKP + k] = kmv * ratio;
              sAn[t * CKP + k] = Pp * kkv; sRn[t * CKP + k] = P * rv; if (t == 0) sPL[k] = PL; } }
        if (tid >= 64 && tid < 64 + 128) { const int x = tid - 64, vq = x >> 5, ln = x & 31, n = ln & 15, kq = ln >> 4; u32x4 o; float vv[8];
#pragma unroll
            for (int j = 0; j < 8; ++j) vv[j] = sV[(8 * kq + j) * CKP + 16 * vq + n];
            o.x = cvt_pk_bf16(vv[0], vv[1]); o.y = cvt_pk_bf16(vv[2], vv[3]); o.z = cvt_pk_bf16(vv[4], vv[5]); o.w = cvt_pk_bf16(vv[6], vv[7]);
            *(LAS u32x4*)(sFR + (15 + vq) * 512 + (n + 16 * kq) * 8) = o; }
        __syncthreads();
        if (wave == 0) { const LAS float* ar = (r32 < 16 ? sCS + r32 * CKP : sDM + (r32 - 16) * CKP); const LAS float* br = (r32 < 16 ? sAn + r32 * CKP : sRn + (r32 - 16) * CKP); f32x16 acc = f32x16{};
#pragma unroll
            for (int ks = 0; ks < 4; ++ks) { float av[8], bv[8];
#pragma unroll
                for (int j = 0; j < 8; ++j) { av[j] = ar[16 * ks + 8 * hg + j]; bv[j] = br[16 * ks + 8 * hg + j]; }
                u32x4 pa, pb; pa.x = cvt_pk_bf16(av[0], av[1]); pa.y = cvt_pk_bf16(av[2], av[3]); pa.z = cvt_pk_bf16(av[4], av[5]); pa.w = cvt_pk_bf16(av[6], av[7]);
                pb.x = cvt_pk_bf16(bv[0], bv[1]); pb.y = cvt_pk_bf16(bv[2], bv[3]); pb.z = cvt_pk_bf16(bv[4], bv[5]); pb.w = cvt_pk_bf16(bv[6], bv[7]);
                acc = __builtin_amdgcn_mfma_f32_32x32x16_bf16(__builtin_bit_cast(bf16x8, pa), __builtin_bit_cast(bf16x8, pb), acc, 0, 0, 0); }
#pragma unroll
            for (int q = 0; q < 16; ++q) { const int row = (q & 3) + 8 * (q >> 2) + 4 * hg, col = r32, mat = (row >> 4) + 2 * (col >> 4), i = row & 15, t = col & 15;
                const bool keep = (mat & 2) ? (i <= t) : (i < t); sU[mat * 16 * 17 + i * 17 + t] = keep ? acc[q] : 0.f; } }
        __syncthreads();
        if (tid < 80) { float x[CK]; const bool isA = tid < 64; const int ri = isA ? tid : tid - 64;
#pragma unroll
            for (int t = 0; t < CK; ++t) x[t] = isA ? sAn[t * CKP + ri] : sU[1 * 16 * 17 + ri * 17 + t];
#pragma unroll
            for (int jx = 0; jx < CK - 1; ++jx) { float urow[CK];
#pragma unroll
                for (int t = 0; t < CK; ++t) if (t > jx) urow[t] = sU[jx * 17 + t];
#pragma unroll
                for (int t = 0; t < CK; ++t) if (t > jx) x[t] -= x[jx] * urow[t]; }
            LAS float* dst = isA ? sAP + ri * 17 : sDP + ri * 17;
#pragma unroll
            for (int t = 0; t < CK; ++t) dst[t] = x[t]; }
        __syncthreads();
        {
#define CK_PACK(v_) ({ u32x4 p_; p_.x = cvt_pk_bf16(v_[0], v_[1]); p_.y = cvt_pk_bf16(v_[2], v_[3]); p_.z = cvt_pk_bf16(v_[4], v_[5]); p_.w = cvt_pk_bf16(v_[6], v_[7]); __builtin_bit_cast(bf16x8, p_); })
          if (wave < 4) {
              const int kr = 32 * (wave >> 1) + r32, kc = 32 * (wave & 1) + r32; float av[8], bv[8];
#pragma unroll
              for (int j = 0; j < 8; ++j) { av[j] = sAP[kr * 17 + 8 * hg + j]; bv[j] = sCL[(8 * hg + j) * CKP + kc]; }
              f32x16 acc = __builtin_amdgcn_mfma_f32_32x32x16_bf16(CK_PACK(av), CK_PACK(bv), f32x16{}, 0, 0, 0);
              const float pl = sPL[kc]; const int ktp = kc >> 4, ii = kc & 15;
#pragma unroll
              for (int q = 0; q < 16; ++q) { const int k = 32 * (wave >> 1) + (q & 3) + 8 * (q >> 2) + 4 * hg; const float m = ((k == kc) ? pl : 0.f) - acc[q];
                  int g, kq, j; ck_kpos(k, g, kq, j); sFR[(ktp * 2 + g) * 512 + (ii + 16 * kq) * 8 + j] = f2bf(m); }
          } else if (wave < 6) {
              const int kc = 32 * (wave - 4) + r32; float av[8], bv[8];
#pragma unroll
              for (int j = 0; j < 8; ++j) { av[j] = r32 < 16 ? sDP[r32 * 17 + 8 * hg + j] : 0.f; bv[j] = sCL[(8 * hg + j) * CKP + kc]; }
              f32x16 acc = __builtin_amdgcn_mfma_f32_32x32x16_bf16(CK_PACK(av), CK_PACK(bv), f32x16{}, 0, 0, 0);
              const int ktp = kc >> 4, ii = kc & 15;
#pragma unroll
              for (int q = 0; q < 8; ++q) { const int t = (q & 3) + 8 * (q >> 2) + 4 * hg; const float nv = sDL[t * CKP + kc] - acc[q];
                  sFR[(8 + ktp) * 512 + (ii + 16 * (t >> 3)) * 8 + (t & 7)] = f2bf(nv); }
          } else {
              const int kr = 32 * (wave - 6) + r32; float av[8], bv[8];
#pragma unroll
              for (int j = 0; j < 8; ++j) { av[j] = sAP[kr * 17 + 8 * hg + j]; bv[j] = r32 < 16 ? sU[2 * 16 * 17 + (8 * hg + j) * 17 + r32] : 0.f; }
              f32x16 acc = __builtin_amdgcn_mfma_f32_32x32x16_bf16(CK_PACK(av), CK_PACK(bv), f32x16{}, 0, 0, 0);
              if (r32 < 16) { const int t = r32;
#pragma unroll
                  for (int q = 0; q < 16; ++q) { const int k = 32 * (wave - 6) + (q & 3) + 8 * (q >> 2) + 4 * hg; const float rv = sRn[t * CKP + k] - acc[q];
                      int g, kq, j; ck_kpos(k, g, kq, j); sFR[(12 + g) * 512 + (t + 16 * kq) * 8 + j] = f2bf(rv); } }
              if (wave == 7) {
                  float ev[8];
#pragma unroll
                  for (int j = 0; j < 8; ++j) ev[j] = r32 < 16 ? sDP[r32 * 17 + 8 * hg + j] : 0.f;
                  f32x16 ae = __builtin_amdgcn_mfma_f32_32x32x16_bf16(CK_PACK(ev), CK_PACK(bv), f32x16{}, 0, 0, 0);
                  if (r32 < 16) { const int t = r32;
#pragma unroll
                      for (int q = 0; q < 8; ++q) { const int i = (q & 3) + 8 * (q >> 2) + 4 * hg; const float e = sU[3 * 16 * 17 + i * 17 + t] - ae[q];
                          sFR[14 * 512 + (t + 16 * (i >> 3)) * 8 + (i & 7)] = f2bf(e); } } } }
#undef CK_PACK
        }
        __syncthreads();
        { u32x4* dst = (u32x4*)(FR + ((size_t)(h * NCK + c) * CK_NFR) * 1024); const LAS u32x4* src = (const LAS u32x4*)sFR;
          for (int i = tid; i < CK_NFR * 64; i += NWAVES * 64) dst[i] = src[i]; }
        __syncthreads();
    }
#undef CK_LOAD
}

constexpr int CK2_FLOATS = 9 * 16 * CKP + 4 * 16 * 17 + 64 * 17 + 16 * 17 + 64;
constexpr int CK2_BYTES = CK2_FLOATS * 4 + CK_NFR * 1024;
static_assert((CK2_FLOATS * 4) % 16 == 0 && CK2_BYTES % 16 == 0 && 2 * CK2_BYTES <= RING_BYTES, "two pre-pass groups fit the LDS ring");
__device__ __forceinline__ void p_rwkv_chunk2(const Frame& F, const Args& A, int pw, int NPW) {
    const bf16* PROJ = WSP(bf16, R_PROJ); const float* LOUT = WSP(float, R_LORAOUT); const float* mu = A.in[I_ABMU];
    const float* w0 = A.in[I_RWW0]; const float* a0 = A.in[I_RWA0]; const float* kk_ = A.in[I_RWKK]; const float* ka_ = A.in[I_RWKA]; const float* rk_ = A.in[I_RWRK];
    float* SV = WSP(float, R_SV); float* BONUS = WSP(float, WS_SMALL + SM_BONUS); unsigned char* FR = WSP(unsigned char, R_FR);
    const int tid = F.tid, lane = F.lane, grp = F.wave >> 2, wl = F.wave & 3, ltid = tid & 255, r32 = lane & 31, hg = lane >> 5;
    LAS float* L = (LAS float*)(F.lds + RING_OFF + grp * CK2_BYTES);
    LAS float* sA = L; LAS float* sP = L + 16 * CKP; LAS float* sB = L + 2 * 16 * CKP; LAS float* sKM = L + 3 * 16 * CKP; LAS float* sRH = L + 4 * 16 * CKP;
    LAS float* sCS = L + 5 * 16 * CKP; LAS float* sDM = L + 6 * 16 * CKP; LAS float* sCL = L + 7 * 16 * CKP; LAS float* sDL = L + 8 * 16 * CKP;
    LAS float* sU = L + 9 * 16 * CKP; LAS float* sAP = sU + 4 * 16 * 17; LAS float* sDP = sAP + 64 * 17; LAS float* sPL = sDP + 16 * 17; LAS bf16* sFR = (LAS bf16*)(sPL + 64);
    for (int i = ltid; i < CK_NFR * 512; i += 256) sFR[i] = 0;
    __syncthreads();
    unsigned* FLAG = (unsigned*)(F.ws + WS_CTL + CTL_FRFLAG); constexpr int NPAIR = NH_R * NCK / 2;
    float xr[5], xk[5], xv[5], lw[4], la[4], pm[8];
#define CK_LOAD(u_) do { const int c_ = (u_) >> 4, h_ = (u_) & 15, ch_ = 64 * h_ + lane, ta_ = c_ * CK + 4 * wl; \
        pm[0] = mu[ch_]; pm[1] = mu[1024 + ch_]; pm[2] = mu[2048 + ch_]; pm[3] = w0[ch_]; pm[4] = a0[ch_]; pm[5] = kk_[ch_]; pm[6] = ka_[ch_]; pm[7] = rk_[ch_]; \
        if (ta_ > 0) { const bf16* pp = PROJ + (size_t)(ta_ - 1) * AB_PAD; xr[0] = bf2f(pp[ch_]); xk[0] = bf2f(pp[1024 + ch_]); xv[0] = bf2f(pp[2048 + ch_]); } else { xr[0] = 0.f; xk[0] = 0.f; xv[0] = 0.f; } \
        _Pragma("unroll") for (int i = 0; i < 4; ++i) { const bf16* p0 = PROJ + (size_t)(ta_ + i) * AB_PAD; const float* lo = LOUT + (size_t)(ta_ + i) * 3072; \
            xr[1 + i] = bf2f(p0[ch_]); xk[1 + i] = bf2f(p0[1024 + ch_]); xv[1 + i] = bf2f(p0[2048 + ch_]); lw[i] = lo[ch_]; la[i] = lo[1024 + ch_]; } } while (0)
#define CK_PACK(v_) ({ u32x4 p_; p_.x = cvt_pk_bf16(v_[0], v_[1]); p_.y = cvt_pk_bf16(v_[2], v_[3]); p_.z = cvt_pk_bf16(v_[4], v_[5]); p_.w = cvt_pk_bf16(v_[6], v_[7]); __builtin_bit_cast(bf16x8, p_); })
    if (pw < NPAIR) CK_LOAD(2 * pw + grp);
    for (int pair = pw; pair < NPAIR; pair += NPW) { const int u = 2 * pair + grp, c = u >> 4, h = u & 15, t0 = c * CK;
        { const int ch = 64 * h + lane; const int ta = t0 + 4 * wl; float pr = xr[0], pk = xk[0], pv = xv[0];
#pragma unroll
          for (int i = 0; i < 4; ++i) { const int t = ta + i, tl = 4 * wl + i;
              const float r = xr[1 + i] + (pr - xr[1 + i]) * pm[0], k = xk[1 + i] + (pk - xk[1 + i]) * pm[1], v = xv[1 + i] + (pv - xv[1 + i]) * pm[2]; pr = xr[1 + i]; pk = xk[1 + i]; pv = xv[1 + i];
              const float w = __expf(-0.6065306597126334f * sigmoidf_(lw[i] + pm[3])), a = sigmoidf_(pm[4] + la[i]);
              float kk = k * pm[5]; const float km = k * (1.0f + (a - 1.0f) * pm[6]);
              const float q1 = wave_sum_dpp(kk * kk), q2 = wave_sum_dpp(r * km * pm[7]);
              kk = kk / fmaxf(sqrtf(q1), 1e-12f);
              sA[tl * CKP + lane] = kk; sP[tl * CKP + lane] = w; sB[tl * CKP + lane] = kk * a; sKM[tl * CKP + lane] = km; sRH[tl * CKP + lane] = r;
              sFR[(15 + (lane >> 4)) * 512 + ((lane & 15) + 16 * (tl >> 3)) * 8 + (tl & 7)] = f2bf(v);
              SV[(size_t)t * 1024 + ch] = v; if (lane == 0) BONUS[t * 16 + h] = q2; } }
        if (pair + NPW < NPAIR) CK_LOAD(u + 2 * NPW);
        __syncthreads();
        { const int k = ltid & 63;
#pragma unroll
          for (int q = 0; q < 4; ++q) { const int t = (ltid >> 6) * 4 + q; float Pp = 1.f, P = 1.f, PL = 1.f;
#pragma unroll
              for (int i = 0; i < CK; ++i) { const float wv = sP[i * CKP + k]; PL *= wv; if (i < t) Pp *= wv; if (i <= t) P *= wv; }
              const float inv = 1.0f / P, ratio = PL * inv, kkv = sA[t * CKP + k], bv = sB[t * CKP + k], kmv = sKM[t * CKP + k], rv = sRH[t * CKP + k];
              sCS[t * CKP + k] = bv * inv; sDM[t * CKP + k] = kmv * inv; sCL[t * CKP + k] = bv * ratio; sDL[t * CKP + k] = kmv * ratio;
              sA[t * CKP + k] = Pp * kkv; sRH[t * CKP + k] = P * rv; if (t == 0) sPL[k] = PL; } }
        __syncthreads();
        if (wl == 0) { const LAS float* ar = (r32 < 16 ? sCS + r32 * CKP : sDM + (r32 - 16) * CKP); const LAS float* br = (r32 < 16 ? sA + r32 * CKP : sRH + (r32 - 16) * CKP); f32x16 acc = f32x16{};
#pragma unroll
            for (int ks = 0; ks < 4; ++ks) { float av[8], bv[8];
#pragma unroll
                for (int j = 0; j < 8; ++j) { av[j] = ar[16 * ks + 8 * hg + j]; bv[j] = br[16 * ks + 8 * hg + j]; }
                acc = __builtin_amdgcn_mfma_f32_32x32x16_bf16(CK_PACK(av), CK_PACK(bv), acc, 0, 0, 0); }
#pragma unroll
            for (int q = 0; q < 16; ++q) { const int row = (q & 3) + 8 * (q >> 2) + 4 * hg, col = r32, mat = (row >> 4) + 2 * (col >> 4), i = row & 15, t = col & 15;
                const bool keep = (mat & 2) ? (i <= t) : (i < t); sU[mat * 16 * 17 + i * 17 + t] = keep ? acc[q] : 0.f; } }
        __syncthreads();
        if (ltid < 80) { float x[CK]; const bool isA = ltid < 64; const int ri = isA ? ltid : ltid - 64;
#pragma unroll
            for (int t = 0; t < CK; ++t) x[t] = isA ? sA[t * CKP + ri] : sU[1 * 16 * 17 + ri * 17 + t];
#pragma unroll
            for (int jx = 0; jx < CK - 1; ++jx) { float urow[CK];
#pragma unroll
                for (int t = 0; t < CK; ++t) if (t > jx) urow[t] = sU[jx * 17 + t];
#pragma unroll
                for (int t = 0; t < CK; ++t) if (t > jx) x[t] -= x[jx] * urow[t]; }
            LAS float* dst = isA ? sAP + ri * 17 : sDP + ri * 17;
#pragma unroll
            for (int t = 0; t < CK; ++t) dst[t] = x[t]; }
        __syncthreads();
        { { const int kr = 32 * (wl >> 1) + r32, kc = 32 * (wl & 1) + r32; float av[8], bv[8];
#pragma unroll
            for (int j = 0; j < 8; ++j) { av[j] = sAP[kr * 17 + 8 * hg + j]; bv[j] = sCL[(8 * hg + j) * CKP + kc]; }
            const f32x16 acc = __builtin_amdgcn_mfma_f32_32x32x16_bf16(CK_PACK(av), CK_PACK(bv), f32x16{}, 0, 0, 0);
            const float pl = sPL[kc]; const int ktp = kc >> 4, ii = kc & 15;
#pragma unroll
            for (int q = 0; q < 16; ++q) { const int k = 32 * (wl >> 1) + (q & 3) + 8 * (q >> 2) + 4 * hg; const float m = ((k == kc) ? pl : 0.f) - acc[q];
                int g, kq, j; ck_kpos(k, g, kq, j); sFR[(ktp * 2 + g) * 512 + (ii + 16 * kq) * 8 + j] = f2bf(m); } }
          if (wl < 2) {
              const int kc = 32 * wl + r32; float av[8], bv[8];
#pragma unroll
              for (int j = 0; j < 8; ++j) { av[j] = r32 < 16 ? sDP[r32 * 17 + 8 * hg + j] : 0.f; bv[j] = sCL[(8 * hg + j) * CKP + kc]; }
              const f32x16 acc = __builtin_amdgcn_mfma_f32_32x32x16_bf16(CK_PACK(av), CK_PACK(bv), f32x16{}, 0, 0, 0);
              const int ktp = kc >> 4, ii = kc & 15;
#pragma unroll
              for (int q = 0; q < 8; ++q) { const int t = (q & 3) + 8 * (q >> 2) + 4 * hg; const float nv = sDL[t * CKP + kc] - acc[q];
                  sFR[(8 + ktp) * 512 + (ii + 16 * (t >> 3)) * 8 + (t & 7)] = f2bf(nv); }
          } else {
              const int kr = 32 * (wl - 2) + r32; float av[8], bv[8];
#pragma unroll
              for (int j = 0; j < 8; ++j) { av[j] = sAP[kr * 17 + 8 * hg + j]; bv[j] = r32 < 16 ? sU[2 * 16 * 17 + (8 * hg + j) * 17 + r32] : 0.f; }
              const f32x16 acc = __builtin_amdgcn_mfma_f32_32x32x16_bf16(CK_PACK(av), CK_PACK(bv), f32x16{}, 0, 0, 0);
              if (r32 < 16) { const int t = r32;
#pragma unroll
                  for (int q = 0; q < 16; ++q) { const int k = 32 * (wl - 2) + (q & 3) + 8 * (q >> 2) + 4 * hg; const float rv = sRH[t * CKP + k] - acc[q];
                      int g, kq, j; ck_kpos(k, g, kq, j); sFR[(12 + g) * 512 + (t + 16 * kq) * 8 + j] = f2bf(rv); } }
              if (wl == 3) {
                  float ev[8];
#pragma unroll
                  for (int j = 0; j < 8; ++j) ev[j] = r32 < 16 ? sDP[r32 * 17 + 8 * hg + j] : 0.f;
                  const f32x16 ae = __builtin_amdgcn_mfma_f32_32x32x16_bf16(CK_PACK(ev), CK_PACK(bv), f32x16{}, 0, 0, 0);
                  if (r32 < 16) { const int t = r32;
#pragma unroll
                      for (int q = 0; q < 8; ++q) { const int i = (q & 3) + 8 * (q >> 2) + 4 * hg; const float e = sU[3 * 16 * 17 + i * 17 + t] - ae[q];
                          sFR[14 * 512 + (t + 16 * (i >> 3)) * 8 + (i & 7)] = f2bf(e); } } } } }
        __syncthreads();
        { unsigned char* dst = FR + ((size_t)(h * NCK + c) * CK_NFR) * 1024; const LAS u32x4* src = (const LAS u32x4*)sFR;
          for (int i = ltid; i < CK_NFR * 64; i += 256) { const u32x4 v = src[i]; asm volatile("global_store_dwordx4 %0, %1, off sc1" :: "v"(dst + (size_t)i * 16), "v"(v) : "memory"); } }
        asm volatile("s_waitcnt vmcnt(0)" ::: "memory");
        __syncthreads();
        if (ltid == 0) __hip_atomic_store(FLAG + h * NCK + c, 1u, __ATOMIC_RELAXED, __HIP_MEMORY_SCOPE_AGENT);
    }
#undef CK_LOAD
#undef CK_PACK
}

constexpr int SQ_SLOT = CK_NFR * 1024, SQ_NSLOT = 7, SQ_AHEAD = 6, SQ_TOUCH = 24;
constexpr bool SQ_TOUCH_ON = false;
static_assert(SQ_SLOT * SQ_NSLOT <= RING_BYTES, "fragment ring fits the LDS ring");
__device__ __forceinline__ void p_rwkv_seq(const Frame& F) {
    const int head = blockIdx.x, vq = F.wave & 3, lane = F.lane, n = lane & 15, q = lane >> 4; const bool worker = F.wave < 4;
    const unsigned char* FRh = WSP(unsigned char, R_FR) + (size_t)head * NCK * CK_NFR * 1024 + lane * 16; float* Y = WSP(float, R_Y) + head * 64 + vq * 16 + n;
    LAS unsigned char* lds = F.lds + RING_OFF;
    const unsigned* FLG = (const unsigned*)(F.ws + WS_CTL + CTL_FRFLAG) + head * NCK; int ready = 0;
#define SQ_NEED(c_) do { while (ready <= (c_)) { const int i_ = ready + lane; unsigned f_ = 0u; if (i_ < NCK) f_ = __hip_atomic_load(FLG + i_, __ATOMIC_RELAXED, __HIP_MEMORY_SCOPE_AGENT); \
        const unsigned long long b_ = __ballot(f_ != 0u); const int n_ = (b_ == ~0ull) ? 64 : (int)__builtin_ctzll(~b_); ready = __builtin_amdgcn_readfirstlane(ready + n_); \
        if (n_ == 0) __builtin_amdgcn_s_sleep(16); else __builtin_amdgcn_fence(__ATOMIC_ACQUIRE, "agent"); } } while (0)
#define SQ_ISSUE(c_, s_) do { const unsigned char* g_ = FRh + (size_t)(c_) * CK_NFR * 1024; LAS unsigned char* d_ = lds + (s_) * SQ_SLOT; \
        _Pragma("unroll") for (int f = 0; f < 5; ++f) if (vq + 4 * f < CK_NFR) __builtin_amdgcn_global_load_lds((const unsigned*)(g_ + (vq + 4 * f) * 1024), (LAS unsigned*)(d_ + (vq + 4 * f) * 1024), 16, 0, 0); } while (0)
#define SQ_READ(dst, s_) do { const LAS unsigned char* d_ = lds + (s_) * SQ_SLOT + lane * 16; _Pragma("unroll") for (int f = 0; f < 15; ++f) dst[f] = *(const LAS bf16x8*)(d_ + f * 1024); \
        dst[15] = *(const LAS bf16x8*)(d_ + (15 + vq) * 1024); } while (0)
#define SQ_STEP(cur, nxt, c_) do { \
        if (worker) { if ((c_) + SQ_AHEAD >= NCK) asm volatile("s_waitcnt vmcnt(0)" ::: "memory"); else if (vq == 3) asm volatile("s_waitcnt vmcnt(36)" ::: "memory"); else asm volatile("s_waitcnt vmcnt(40)" ::: "memory"); }     \
        else if (SQ_TOUCH_ON && F.wave == 4 && (c_) + SQ_TOUCH < NCK) { const unsigned char* g_ = FRh - lane * 16 + (size_t)((c_) + SQ_TOUCH) * CK_NFR * 1024 + lane * 128; \
            _Pragma("unroll") for (int i_ = 0; i_ < 3; ++i_) if (i_ * 64 + lane < CK_NFR * 8) asm volatile("global_load_dword %0, %1, off" : "+v"(dummy) : "v"(g_ + i_ * 8192) : "memory"); }     \
        __builtin_amdgcn_s_barrier();                                                       \
        if (worker) { \
            if ((c_) + SQ_AHEAD < NCK) { SQ_NEED((c_) + SQ_AHEAD); SQ_ISSUE((c_) + SQ_AHEAD, sl_free); } \
            if ((c_) + 1 < NCK) SQ_READ(nxt, sl_next); \
            bf16x8 xb[2]; \
            _Pragma("unroll") for (int g = 0; g < 2; ++g) { u32x4 p; p.x = cvt_pk_bf16(X[2 * g][0], X[2 * g][1]); p.y = cvt_pk_bf16(X[2 * g][2], X[2 * g][3]); p.z = cvt_pk_bf16(X[2 * g + 1][0], X[2 * g + 1][1]); p.w = cvt_pk_bf16(X[2 * g + 1][2], X[2 * g + 1][3]); \
                xb[g] = __builtin_bit_cast(bf16x8, p); } \
            f32x4 y = (f32x4){0.f, 0.f, 0.f, 0.f}; \
            y = __builtin_amdgcn_mfma_f32_16x16x32_bf16(cur[14], cur[15], y, 0, 0, 0); \
            y = __builtin_amdgcn_mfma_f32_16x16x32_bf16(cur[12], xb[0], y, 0, 0, 0); \
            y = __builtin_amdgcn_mfma_f32_16x16x32_bf16(cur[13], xb[1], y, 0, 0, 0); \
            f32x4 Xn[4]; \
            _Pragma("unroll") for (int kt = 0; kt < 4; ++kt) { f32x4 a = (f32x4){0.f, 0.f, 0.f, 0.f}; \
                a = __builtin_amdgcn_mfma_f32_16x16x32_bf16(cur[8 + kt], cur[15], a, 0, 0, 0); \
                a = __builtin_amdgcn_mfma_f32_16x16x32_bf16(cur[2 * kt], xb[0], a, 0, 0, 0); \
                a = __builtin_amdgcn_mfma_f32_16x16x32_bf16(cur[2 * kt + 1], xb[1], a, 0, 0, 0); \
                Xn[kt] = a; } \
            _Pragma("unroll") for (int r = 0; r < 4; ++r) Y[(size_t)((c_) * CK + 4 * q + r) * 1024] = y[r]; \
            _Pragma("unroll") for (int kt = 0; kt < 4; ++kt) X[kt] = Xn[kt]; } \
        sl_free = sl_free == SQ_NSLOT - 1 ? 0 : sl_free + 1; sl_next = sl_next == SQ_NSLOT - 1 ? 0 : sl_next + 1; } while (0)
    f32x4 X[4]; unsigned dummy = 0;
#pragma unroll
    for (int i = 0; i < 4; ++i) X[i] = (f32x4){0.f, 0.f, 0.f, 0.f};
    bf16x8 fa[16], fb[16];
    if (worker) { SQ_NEED(SQ_AHEAD - 1);
#pragma unroll
        for (int c = 0; c < SQ_AHEAD; ++c) SQ_ISSUE(c, c); }
    asm volatile("s_waitcnt vmcnt(0)" ::: "memory");
    __builtin_amdgcn_s_barrier();
    if (worker) SQ_READ(fa, 0);
    int sl_free = SQ_AHEAD, sl_next = 1;
    for (int c = 0; c < NCK; c += 2) { SQ_STEP(fa, fb, c); SQ_STEP(fb, fa, c + 1); }
    asm volatile("s_waitcnt vmcnt(0)" : "+v"(dummy) :: "memory");
#undef SQ_NEED
#undef SQ_ISSUE
#undef SQ_READ
#undef SQ_STEP
}

constexpr int ML_P = 264;
__device__ __forceinline__ void ml_stage_chunk(const Frame& F, const bf16* src  , int h, int c, LAS bf16* dst) {
    for (int i = F.tid; i < 64 * 32; i += NWAVES * 64) { const int s = i >> 5, ch = i & 31;
        *(LAS u32x4*)(dst + s * ML_P + 8 * ch) = *(const u32x4*)(src + (size_t)(64 * c + s) * 1024 + 256 * h + 8 * ch); }
}
__device__ __forceinline__ void p_mlu(const Frame& F, int first, int stride) {
    const bf16* KB = WSP(bf16, R_KB); const bf16* VB = WSP(bf16, R_VB); const float* BCUM = WSP(float, WS_SMALL + SM_BCUM); const float* IG = WSP(float, WS_SMALL + SM_IG);
    const float* CHBL = WSP(float, WS_SMALL + SM_CHBL); const float* MOUT = WSP(float, WS_SMALL + SM_MOUT);
    bf16* U = WSP(bf16, R_U); float* NU = WSP(float, WS_SMALL + SM_NU);
    LAS bf16* Ks = (LAS bf16*)(F.lds + RING_OFF); LAS bf16* Vs = Ks + 64 * ML_P; LAS float* wst = (LAS float*)(Vs + 64 * ML_P);
    const int lane = F.lane, r = lane & 31, hg = lane >> 5, w = F.wave;
    for (int L = first; L < NH_M * 128; L += stride) { const int h = L >> 7, c = L & 127;
        __syncthreads();
        ml_stage_chunk(F, KB, h, c, Ks); ml_stage_chunk(F, VB, h, c, Vs);
        if (F.tid < 64) wst[F.tid] = __expf(CHBL[h * 128 + c] - BCUM[h * T + 64 * c + F.tid] + IG[h * T + 64 * c + F.tid] - MOUT[h * 128 + c]);
        __syncthreads();
        f32x16 acc[8];
#pragma unroll
        for (int nt = 0; nt < 8; ++nt) acc[nt] = f32x16{};
#pragma unroll
        for (int ks = 0; ks < 4; ++ks) { bf16x8 a; float av[8];
#pragma unroll
            for (int jj = 0; jj < 8; ++jj) { const int s = 16 * ks + 8 * hg + jj; av[jj] = bf2f(Vs[s * ML_P + 32 * w + r]) * wst[s]; }
            { u32x4 p; p.x = cvt_pk_bf16(av[0], av[1]); p.y = cvt_pk_bf16(av[2], av[3]); p.z = cvt_pk_bf16(av[4], av[5]); p.w = cvt_pk_bf16(av[6], av[7]); a = __builtin_bit_cast(bf16x8, p); }
#pragma unroll
            for (int nt = 0; nt < 8; ++nt) { bf16x8 b;
#pragma unroll
                for (int jj = 0; jj < 8; ++jj) b[jj] = (short)Ks[(16 * ks + 8 * hg + jj) * ML_P + 32 * nt + r];
                acc[nt] = __builtin_amdgcn_mfma_f32_32x32x16_bf16(a, b, acc[nt], 0, 0, 0); } }
        bf16* Uo = U + ((size_t)(h * 128 + c) * 256 + 32 * w) * 256;
#pragma unroll
        for (int nt = 0; nt < 8; ++nt)
#pragma unroll
            for (int q = 0; q < 16; ++q) { const int vl = (q & 3) + 8 * (q >> 2) + 4 * hg; Uo[(size_t)vl * 256 + 32 * nt + r] = f2bf(acc[nt][q]); }
        if (F.tid < 256) { float s = 0.f;
            for (int ss = 0; ss < 64; ++ss) s += wst[ss] * bf2f(Ks[ss * ML_P + F.tid]);
            NU[(size_t)(h * 128 + c) * 256 + F.tid] = s; }
    }
}
__device__ __forceinline__ void p_mlscan(const Frame& F) {
    bf16* U = WSP(bf16, R_U); float* NU = WSP(float, WS_SMALL + SM_NU); const float* WCARRY = WSP(float, WS_SMALL + SM_WCARRY);
    const int gt = F.gw * 64 + F.lane, NGT = F.NGW * 64;
    for (int it = gt; it < NH_M * 65536 / 4; it += NGT) { const int h = it >> 14, e = (it & 16383) * 4;
        float C0 = 0.f, C1 = 0.f, C2 = 0.f, C3 = 0.f; bf16* p = U + (size_t)h * 128 * 65536 + e;
#pragma unroll 4
        for (int c = 0; c < 128; ++c) { const u32x2 u = *(const u32x2*)(p + (size_t)c * 65536); const float wc = WCARRY[h * 128 + c];
            u32x2 o; o.x = cvt_pk_bf16(C0, C1); o.y = cvt_pk_bf16(C2, C3); *(u32x2*)(p + (size_t)c * 65536) = o;
            C0 = wc * C0 + bf2f(u.x & 0xffffu); C1 = wc * C1 + bf2f(u.x >> 16); C2 = wc * C2 + bf2f(u.y & 0xffffu); C3 = wc * C3 + bf2f(u.y >> 16); } }
    for (int it = gt; it < NH_M * 256; it += NGT) { const int h = it >> 8, k = it & 255; float n = 0.f; float* p = NU + (size_t)h * 128 * 256 + k;
        for (int c = 0; c < 128; ++c) { const float u = p[c * 256]; p[c * 256] = n; n = WCARRY[h * 128 + c] * n + u; } }
}
__device__ __forceinline__ void p_mlout(const Frame& F, const Args& A) {
    const bf16* QB = WSP(bf16, R_QB); const bf16* KB = WSP(bf16, R_KB); const bf16* VB = WSP(bf16, R_VB); const bf16* CS = WSP(bf16, R_U); const float* NC = WSP(float, WS_SMALL + SM_NU);
    const float* BCUM = WSP(float, WS_SMALL + SM_BCUM); const float* IG = WSP(float, WS_SMALL + SM_IG); const float* MSEQ = WSP(float, WS_SMALL + SM_MSEQ);
    const bf16* PROJ = WSP(bf16, R_PROJ); const float* mhg = A.in[I_MLNG]; bf16* YCAT = WSP(bf16, R_YCAT);
    LAS bf16* Qs = (LAS bf16*)(F.lds + RING_OFF); LAS bf16* Ks = Qs + 64 * ML_P; LAS bf16* Vs = Ks + 64 * ML_P; LAS bf16* Ss = Vs + 64 * ML_P;
    LAS float* fa = (LAS float*)(Ss + 64 * 72); LAS float* bch = fa; LAS float* ich = fa + 64; LAS float* mrow = fa + 128; LAS float* wint = fa + 192; LAS float* rsum = fa + 256  ;
    LAS float* nq = fa + 384; LAS float* nvec = fa + 448  ; LAS float* Hs = (LAS float*)(F.lds + RING_OFF);
    const int lane = F.lane, r = lane & 31, hg = lane >> 5, w = F.wave;
    for (int L = F.vcu; L < NH_M * 128; L += F.G) { const int h = L >> 7, c = L & 127;
        __syncthreads();
        ml_stage_chunk(F, QB, h, c, Qs); ml_stage_chunk(F, KB, h, c, Ks); ml_stage_chunk(F, VB, h, c, Vs);
        if (F.tid < 64) { bch[F.tid] = BCUM[h * T + 64 * c + F.tid]; ich[F.tid] = IG[h * T + 64 * c + F.tid]; }
        if (F.tid < 256) nvec[F.tid] = NC[(size_t)(h * 128 + c) * 256 + F.tid];
        const float mc = MSEQ[h * 128 + c];
        __syncthreads();
        if (w == 0) { float g = ich[lane] - bch[lane];
#pragma unroll
            for (int o = 1; o < 64; o <<= 1) { const float x = __shfl_up(g, o); if (lane >= o) g = fmaxf(g, x); }
            const float mr = bch[lane] + fmaxf(mc, g); mrow[lane] = mr; wint[lane] = __expf(bch[lane] + mc - mr); }
        if (w == 1) { float s = 0.f;
            for (int k = 0; k < 256; ++k) s += nvec[k] * bf2f(Qs[lane * ML_P + k]);
            nq[lane] = s; }
        __syncthreads();
        if (w < 4) { const int st = w & 1, lt = w >> 1; f32x16 acc = f32x16{};
#pragma unroll
            for (int ks = 0; ks < 16; ++ks) { const bf16x8 a = *(const LAS bf16x8*)(Ks + (32 * st + r) * ML_P + 16 * ks + 8 * hg), b = *(const LAS bf16x8*)(Qs + (32 * lt + r) * ML_P + 16 * ks + 8 * hg);
                acc = __builtin_amdgcn_mfma_f32_32x32x16_bf16(a, b, acc, 0, 0, 0); }
            const int l = 32 * lt + r; const float bl_ = bch[l], mr = mrow[l]; float rs = 0.f;
#pragma unroll
            for (int g4 = 0; g4 < 4; ++g4) { float v4[4];
#pragma unroll
                for (int i = 0; i < 4; ++i) { const int s = 32 * st + 8 * g4 + 4 * hg + i; const float d = bl_ - bch[s] + ich[s] - mr;
                    v4[i] = (s <= l) ? acc[4 * g4 + i] * __expf(d) : 0.f; rs += v4[i]; }
                u32x2 p; p.x = cvt_pk_bf16(v4[0], v4[1]); p.y = cvt_pk_bf16(v4[2], v4[3]);
                *(LAS u32x2*)(Ss + l * 72 + 32 * st + 8 * g4 + 4 * hg) = p; }
            rs += __shfl_xor(rs, 32);
            if (hg == 0) rsum[st * 64 + l] = rs; }
        __syncthreads();
        const int lt = w & 1, vg = w >> 1; f32x16 ai[2], aa[2]; ai[0] = f32x16{}; ai[1] = f32x16{}; aa[0] = f32x16{}; aa[1] = f32x16{};
        const bf16* Cb = CS + (size_t)(h * 128 + c) * 65536;
#pragma unroll 4
        for (int ks = 0; ks < 16; ++ks) { const bf16x8 a = *(const LAS bf16x8*)(Qs + (32 * lt + r) * ML_P + 16 * ks + 8 * hg);
#pragma unroll
            for (int jt = 0; jt < 2; ++jt) { const bf16x8 b = *(const bf16x8*)(Cb + (size_t)(64 * vg + 32 * jt + r) * 256 + 16 * ks + 8 * hg);
                ai[jt] = __builtin_amdgcn_mfma_f32_32x32x16_bf16(a, b, ai[jt], 0, 0, 0); } }
#pragma unroll
        for (int ks = 0; ks < 4; ++ks) { const bf16x8 a = *(const LAS bf16x8*)(Ss + (32 * lt + r) * 72 + 16 * ks + 8 * hg);
#pragma unroll
            for (int jt = 0; jt < 2; ++jt) { bf16x8 b;
#pragma unroll
                for (int jj = 0; jj < 8; ++jj) b[jj] = (short)Vs[(16 * ks + 8 * hg + jj) * ML_P + 64 * vg + 32 * jt + r];
                aa[jt] = __builtin_amdgcn_mfma_f32_32x32x16_bf16(a, b, aa[jt], 0, 0, 0); } }
        __syncthreads();
#pragma unroll
        for (int q = 0; q < 16; ++q) { const int l = 32 * lt + (q & 3) + 8 * (q >> 2) + 4 * hg; const float wi = wint[l];
            const float den = rsum[l] + rsum[64 + l] + wi * nq[l]; const float dn = 1.0f / fmaxf(fabsf(den), __expf(-mrow[l]));
#pragma unroll
            for (int jt = 0; jt < 2; ++jt) Hs[l * 260 + 64 * vg + 32 * jt + r] = (aa[jt][q] + wi * ai[jt][q]) * dn; }
        __syncthreads();
        for (int i = 0; i < 8; ++i) { const int l = 8 * w + i, t = 64 * c + l; const f32x4 hv = *(const LAS f32x4*)(Hs + l * 260 + 4 * lane);
            const float ss = wave_sum((hv[0] * hv[0] + hv[1] * hv[1]) + (hv[2] * hv[2] + hv[3] * hv[3])); const float rn = 1.0f / sqrtf(ss * (1.0f / 256.0f) + 1e-6f);
            const f32x4 g = *(const f32x4*)(mhg + 256 * h + 4 * lane); const u32x2 ob = *(const u32x2*)(PROJ + (size_t)t * AB_PAD + 6592 + 256 * h + 4 * lane);
            const float o0 = hv[0] * rn * g[0] * sigmoidf_(bf2f(ob.x & 0xffffu)), o1 = hv[1] * rn * g[1] * sigmoidf_(bf2f(ob.x >> 16));
            const float o2 = hv[2] * rn * g[2] * sigmoidf_(bf2f(ob.y & 0xffffu)), o3 = hv[3] * rn * g[3] * sigmoidf_(bf2f(ob.y >> 16));
            u32x2 p; p.x = cvt_pk_bf16(o0, o1); p.y = cvt_pk_bf16(o2, o3);
            *(u32x2*)(YCAT + (size_t)t * D + 1024 + 256 * h + 4 * lane) = p; }
    }
}

struct XsOrder {
    const bf16* XQ; const bf16* KM; int G, c;
    __device__ __forceinline__ bool next(int i, pg8::Unit& u) const {
        const int L = i * G + c; if (L >= 32 * 4) return false;
        const int pm = L >> 2, hd = L & 3; u.pm = pm; u.pn = 0; u.aux = hd; u.pad = 0;
        u.a = (const char*)(XQ + (size_t)pm * 256 * D + 512 * hd); u.b = (const char*)(KM + 512 * hd); return true;
    }
};
struct XpvOrder {
    const bf16* XP; const bf16* VT; int G, c;
    __device__ __forceinline__ bool next(int i, pg8::Unit& u) const {
        int pm, pn; if (!pg8::static_tile(i, G, c, 32, 8, pm, pn)) return false;
        u.pm = pm; u.pn = pn; u.aux = 0; u.pad = 0;
        u.a = (const char*)(XP + (size_t)pm * 256 * 1024 + 256 * (pn >> 1)); u.b = (const char*)(VT + (size_t)pn * 256 * NMEM); return true;
    }
};
__device__ __forceinline__ void p_xsoftmax(const Frame& F) {
    const float* XS = WSP(float, R_XS); bf16* XP = WSP(bf16, R_XP); const int lane = F.lane;
    for (int t = F.gw; t < T; t += F.NGW)
#pragma unroll
        for (int hd = 0; hd < 4; ++hd) { const f32x4 s = *(const f32x4*)(XS + (size_t)t * 1024 + 256 * hd + 4 * lane);
            const float m = wave_max(fmaxf(fmaxf(s[0], s[1]), fmaxf(s[2], s[3])));
            const float e0 = __expf(s[0] - m), e1 = __expf(s[1] - m), e2 = __expf(s[2] - m), e3 = __expf(s[3] - m);
            const float inv = 1.0f / wave_sum((e0 + e1) + (e2 + e3));
            u32x2 p; p.x = cvt_pk_bf16(e0 * inv, e1 * inv); p.y = cvt_pk_bf16(e2 * inv, e3 * inv);
            *(u32x2*)(XP + (size_t)t * 1024 + 256 * hd + 4 * lane) = p; }
}

__device__ __forceinline__ void p_norm_fpre(const Frame& F, const Args& A) {
    LAS float* Ws = (LAS float*)(F.lds + RING_OFF);
    stage_skinny<16>(F, A.in[I_FOXWIN], FOX_LD, 8192, Ws);
    __syncthreads();
    const float* X = WSP(float, WS_X); bf16* XN = WSP(bf16, WS_XN); float* FPRE = WSP(float, WS_SMALL + SM_FPRE); const float* g = A.in[I_NMIXG] + D;
    for (int t = F.gw; t < T; t += F.NGW) { f32x4 y[8]; rms_row(X + (size_t)t * D, g, XN + (size_t)t * D, F.lane, y);
        float o[16]; skinny_dot<16>(y, Ws, F.lane, o);
        if (F.lane < 16) { float v = o[0];
#pragma unroll
            for (int c = 1; c < 16; ++c) v = (F.lane == c) ? o[c] : v;
            FPRE[t * 16 + F.lane] = v; } }
    __syncthreads();
}
__device__ __forceinline__ void p_foxprep(const Frame& F, const Args& A) {
    bf16* QKVG = WSP(bf16, R_QKVG); const float* qg = A.in[I_FOXQG]; const float* kg = A.in[I_FOXKG]; const int lane = F.lane;
    for (int it = F.gw; it < 2 * T; it += F.NGW) { const int t = it >> 1, sec = it & 1; const float* gg = sec ? kg : qg; const float g0 = gg[2 * lane], g1 = gg[2 * lane + 1];
        unsigned* row = (unsigned*)(QKVG + (size_t)t * 8192 + sec * 2048) + lane;
#pragma unroll 4
        for (int h = 0; h < NH_F; ++h) { const unsigned u = row[64 * h]; const float a = bf2f(u & 0xffffu), b = bf2f(u >> 16);
            const float rn = 1.0f / sqrtf(wave_sum(a * a + b * b) * (1.0f / 128.0f) + 1e-6f);
            row[64 * h] = cvt_pk_bf16(a * rn * g0, b * rn * g1); } }
    if (F.gw < NH_F) { const int h = F.gw; const float* FPRE = WSP(float, WS_SMALL + SM_FPRE); float* BL = WSP(float, WS_SMALL + SM_BIASL2); const float bf = A.in[I_FOXBF][h];
        float carry = 0.f;
        for (int c0 = 0; c0 < 128; c0 += 16) { float v[16];
#pragma unroll
            for (int i = 0; i < 16; ++i) v[i] = FPRE[(size_t)(64 * (c0 + i) + lane) * 16 + h];
#pragma unroll
            for (int i = 0; i < 16; ++i) { float b = logsigmoidf_(v[i] + bf);
#pragma unroll
                for (int o = 1; o < 64; o <<= 1) { const float x = __shfl_up(b, o); if (lane >= o) b += x; }
                b += carry; BL[h * T + 64 * (c0 + i) + lane] = -1.4426950408889634f * b; carry = __shfl(b, 63); } } }
}
__device__ __forceinline__ void p_foxattn(const Frame& F) {
    const bf16* QKVG = WSP(bf16, R_QKVG); bf16* ATTO = WSP(bf16, R_ATTO); const float* BL = WSP(float, WS_SMALL + SM_BIASL2);
    char* lds = (char*)F.ldsg + RING_OFF;
    for (int L = F.vcu; L < 256; L += F.G) { const int h = L >> 4, x = L & 15;
        __syncthreads();
        { float* bl = (float*)(lds + fox::BIAS_OFF); for (int i = F.tid; i < T / 4; i += NWAVES * 64) *(f32x4*)(bl + 4 * i) = *(const f32x4*)(BL + (size_t)h * T + 4 * i); }
        fox::BlockRef b0, b1; const int q0 = x, q1 = 31 - x;
        b0.Q = QKVG + (size_t)q0 * 256 * 8192 + 128 * h; b0.K = QKVG + 2048 + 128 * h; b0.V = QKVG + 4096 + 128 * h; b0.G = QKVG + (size_t)q0 * 256 * 8192 + 6144 + 128 * h;
        b0.O = ATTO + (size_t)q0 * 256 * D + 128 * h; b0.P0 = q0 * 256;
        b1 = b0; b1.Q = QKVG + (size_t)q1 * 256 * 8192 + 128 * h; b1.G = QKVG + (size_t)q1 * 256 * 8192 + 6144 + 128 * h; b1.O = ATTO + (size_t)q1 * 256 * D + 128 * h; b1.P0 = q1 * 256;
        fox::Seam S;
        fox::prime(b0, lds, S);
#ifdef FOX_LOOP
        for (int pass = 0; pass < 2; ++pass) { fox::block(b0, b1, lds, S); b0 = b1; }
#else
        fox::block(b0, b1, lds, S);
        fox::block(b1, b1, lds, S);
#endif
    }
}

__device__ __forceinline__ void p_norm_route(const Frame& F, const Args& A) {
    LAS float* Ws = (LAS float*)(F.lds + RING_OFF); LAS int* cnt = (LAS int*)(F.lds + RING_OFF + 8 * D * 4);
    stage_skinny<8>(F, A.in[I_ROUTER], NEXP, 0, Ws);
    if (F.tid < 8) cnt[F.tid] = 0;
    __syncthreads();
    const float* X = WSP(float, WS_X); bf16* XN = WSP(bf16, WS_XN); const float* g = A.in[I_NFFNG] + D;
    int* TOPI = WSP(int, WS_SMALL + SM_TOPI); float* TOPG = WSP(float, WS_SMALL + SM_TOPG); int* BLKCNT = WSP(int, WS_SMALL + SM_BLKCNT);
    const int b = blockIdx.x;
    for (int i = 0; i < 4; ++i) { const int t = 32 * b + 4 * F.wave + i; f32x4 y[8]; rms_row(X + (size_t)t * D, g, XN + (size_t)t * D, F.lane, y);
        float o[8]; skinny_dot<8>(y, Ws, F.lane, o);
        int i1 = 0; float v1 = o[0];
#pragma unroll
        for (int e = 1; e < 8; ++e) if (o[e] > v1) { v1 = o[e]; i1 = e; }
        int i2 = -1; float v2 = -__builtin_inff();
#pragma unroll
        for (int e = 0; e < 8; ++e) if (e != i1 && o[e] > v2) { v2 = o[e]; i2 = e; }
        const float e2 = __expf(v2 - v1), g1 = 1.0f / (1.0f + e2), g2 = e2 * g1;
        if (F.lane == 0) { TOPI[2 * t] = i1; TOPI[2 * t + 1] = i2; TOPG[2 * t] = g1; TOPG[2 * t + 1] = g2; __hip_atomic_fetch_add(&cnt[i1], 1, __ATOMIC_RELAXED, __HIP_MEMORY_SCOPE_WORKGROUP); __hip_atomic_fetch_add(&cnt[i2], 1, __ATOMIC_RELAXED, __HIP_MEMORY_SCOPE_WORKGROUP); } }
    __syncthreads();
    if (F.tid < 8) BLKCNT[b * 8 + F.tid] = cnt[F.tid];
}
__device__ __forceinline__ void p_route2(const Frame& F) {
    LAS int* sh = (LAS int*)(F.lds + RING_OFF);
    const int* BLKCNT = WSP(int, WS_SMALL + SM_BLKCNT); const int* TOPI = WSP(int, WS_SMALL + SM_TOPI); int* SLOT = WSP(int, WS_SMALL + SM_SLOT); int* TILEE = WSP(int, WS_SMALL + SM_TILEE);
    const bf16* XN = WSP(bf16, WS_XN); bf16* AG = WSP(bf16, R_AG); const int b = blockIdx.x;
    __syncthreads();
    if (F.tid < 8) { int tot = 0, pre = 0; for (int bb = 0; bb < 256; ++bb) { const int v = BLKCNT[bb * 8 + F.tid]; if (bb < b) pre += v; tot += v; } sh[F.tid] = tot; sh[8 + F.tid] = pre; }
    __syncthreads();
    if (F.tid == 0) { int off = 0, nt = 0; for (int e = 0; e < 8; ++e) { sh[16 + e] = off; const int n = (sh[e] + 255) >> 8; if (b == 0) for (int i = 0; i < n; ++i) TILEE[1 + nt + i] = e; nt += n; off += n * 256; } if (b == 0) TILEE[0] = nt; }
    __syncthreads();
    if (F.wave == 0) { const int t = 32 * b + (F.lane >> 1), e = TOPI[2 * t + (F.lane & 1)]; int rank = 0;
#pragma unroll
        for (int ee = 0; ee < 8; ++ee) { const unsigned long long m = __ballot(e == ee); if (e == ee) rank = __popcll(m & ((1ull << F.lane) - 1ull)); }
        const int slot = sh[16 + e] + sh[8 + e] + rank; SLOT[2 * t + (F.lane & 1)] = slot; sh[32 + F.lane] = slot; }
    __syncthreads();
    for (int p = F.wave; p < 64; p += NWAVES) { const int t = 32 * b + (p >> 1), slot = sh[32 + p]; const u32x4* src = (const u32x4*)(XN + (size_t)t * D); u32x4* dst = (u32x4*)(AG + (size_t)slot * D);
#pragma unroll
        for (int j = 0; j < 4; ++j) dst[F.lane + 64 * j] = src[F.lane + 64 * j]; }
}
struct MoeOrder {
    const bf16* Arows; const bf16* W; const int* tilee; int lda, nN; size_t wstride; int G, c; bool whole_rounds;
    __device__ __forceinline__ bool next(int i, pg8::Unit& u) const {
        const int nt = tilee[0]; const long L = (long)i * G + c; long nu = (long)nt * nN; if (whole_rounds) nu = (nu / G) * G; if (L >= nu) return false;
        const int ti = (int)(L / nN), pn = (int)(L % nN), e = tilee[1 + ti];
        u.pm = ti; u.pn = pn; u.aux = e; u.pad = 0; u.a = (const char*)(Arows + (size_t)ti * 256 * lda); u.b = (const char*)(W + (size_t)e * wstride + (size_t)pn * 256 * lda); return true;
    }
};
constexpr int MOE_KSPLIT = 4;
struct MoeSplitOrder {
    const bf16* Arows; const bf16* W; const int* tilee; int lda, nN, kslice; size_t wstride; int G, c;
    __device__ __forceinline__ bool next(int i, pg8::Unit& u) const {
        const int nt = tilee[0]; const long nu = (long)nt * nN, nfull = (nu / G) * G; const long L = (long)i * G + c; if (L >= (nu - nfull) * MOE_KSPLIT) return false;
        const long j = nfull + L / MOE_KSPLIT; const int kq = (int)(L % MOE_KSPLIT); const int ti = (int)(j / nN), pn = (int)(j % nN), e = tilee[1 + ti];
        u.pm = ti; u.pn = pn; u.aux = kq; u.pad = 0; u.a = (const char*)(Arows + (size_t)ti * 256 * lda + (size_t)kq * kslice); u.b = (const char*)(W + (size_t)e * wstride + (size_t)pn * 256 * lda + (size_t)kq * kslice); return true;
    }
};
__device__ __forceinline__ void p_final(const Frame& F, const Args& A) {
    const float* X = WSP(float, WS_X); const float* YG = WSP(float, R_YG); const float* YS = WSP(float, R_YSIDE); const int* SLOT = WSP(int, WS_SMALL + SM_SLOT); const float* TOPG = WSP(float, WS_SMALL + SM_TOPG);
    const float* g = A.in[I_FING]; const int lane = F.lane;
    const int nt = WSP(int, WS_SMALL + SM_TILEE)[0]; const int srow0 = (((nt * 8) / F.G) * F.G / 8) * 256;
    for (int t = F.gw; t < T; t += F.NGW) { const int s1 = SLOT[2 * t], s2 = SLOT[2 * t + 1]; const float g1 = TOPG[2 * t], g2 = TOPG[2 * t + 1];
        const f32x4* xr = (const f32x4*)(X + (size_t)t * D) + lane; const f32x4* y1 = (const f32x4*)(YG + (size_t)s1 * D) + lane; const f32x4* y2 = (const f32x4*)(YG + (size_t)s2 * D) + lane;
        f32x4 v[8]; float s = 0.f;
#pragma unroll
        for (int j = 0; j < 8; ++j) { f32x4 a = y1[64 * j], b = y2[64 * j];
            if (s1 >= srow0) { const f32x4* p = (const f32x4*)(YS + (size_t)(s1 - srow0) * D) + lane + 64 * j; a = a + ((p[0] + p[YSIDE_STRIDE / 4]) + p[2 * (YSIDE_STRIDE / 4)]); }
            if (s2 >= srow0) { const f32x4* p = (const f32x4*)(YS + (size_t)(s2 - srow0) * D) + lane + 64 * j; b = b + ((p[0] + p[YSIDE_STRIDE / 4]) + p[2 * (YSIDE_STRIDE / 4)]); }
            v[j] = xr[64 * j] + (a * g1 + b * g2); s += (v[j][0] * v[j][0] + v[j][1] * v[j][1]) + (v[j][2] * v[j][2] + v[j][3] * v[j][3]); }
        const float r = 1.0f / sqrtf(wave_sum(s) * (1.0f / D) + 1e-6f); f32x4* o = (f32x4*)(A.out + (size_t)t * D) + lane;
#pragma unroll
        for (int j = 0; j < 8; ++j) o[64 * j] = v[j] * r * ((const f32x4*)g)[lane + 64 * j]; }
}

enum Phase { PH_CONV = 0, PH_INPROJ0, PH_PREPA, PH_LORA, PH_SCAN, PH_MLSCAN, PH_MLOUT, PH_OUTPROJ0,
             PH_NORMX0, PH_XQ0, PH_XS0, PH_XPV0, PH_XO0, PH_NORMF0, PH_FFNGU, PH_FFND,
             PH_NORMM1, PH_FOXIN, PH_FOXPREP, PH_FOXATT, PH_FOXOUT,
             PH_NORMX1, PH_XQ1, PH_XS1, PH_XPV1, PH_XO1, PH_NORMF1, PH_ROUTE2, PH_MOEGU, PH_MOED, PH_FINAL, N_PHASES };

__global__ void __launch_bounds__(NWAVES * 64, 2) trunk_fwd(Args A) {
    extern __shared__ __attribute__((aligned(16))) unsigned char lds[];
    Frame F;
    F.lds = (LAS unsigned char*)lds; F.ldsg = lds; F.ws = A.ws;
    F.tid = threadIdx.x; F.lane = F.tid & 63; F.wave = __builtin_amdgcn_readfirstlane(F.tid >> 6);
    F.G = gridDim.x; { const int bx = blockIdx.x; F.vcu = (F.G % 8 == 0) ? (bx % 8) * (F.G / 8) + bx / 8 : bx; }
    F.gw = F.vcu * NWAVES + F.wave; F.NGW = F.G * NWAVES;
    volatile LAS unsigned* MISC = (volatile LAS unsigned*)(F.lds + MISC_OFF);
    for (int u = F.tid; u < (LDS_BYTES - LDSCTL_OFF) / 4; u += NWAVES * 64) ((LAS unsigned*)(F.lds + LDSCTL_OFF))[u] = 0u;
    __syncthreads();
    const int lo = A.ph_lo, hi = A.ph_hi;
    const bool multi = (hi - lo) > 1;
    XcdBarrier bar; bar.bar = (unsigned*)(A.ws + WS_CTL) + CW_BAR; bar.x = 0; bar.st = nullptr;
    if (multi) bar = xcd_barrier_post((unsigned*)(A.ws + WS_CTL) + CW_BAR, MISC + 8);
#ifndef PH_ENABLE
#define PH_ENABLE 0xFFFFFFFFFFFFFFFFull
#endif
#define IN(k) ((((PH_ENABLE) >> (k)) & 1ull) && lo <= (k) && (k) < hi)
#ifndef PROBE_DUP
#define PROBE_DUP 0ull
#endif
#define DUP(k) if ((((PROBE_DUP) >> (k)) & 1ull) != 0ull)
#define SEAM(k) do { if (IN(k) && IN((k) + 1)) xcd_barrier(bar); } while (0)
    LAS unsigned char* ring = F.lds + RING_OFF;
    const int cb = (int)blockIdx.x;
    float* const SSQ = (float*)(A.ws + WS_CTL + CTL_SSQ);

    constexpr int MOE_E_TAIL = 1;
    constexpr int MOE_E_EARLY = 0;
    if (IN(PH_CONV)) { p_convert_early(F, A); if (MOE_E_EARLY > 0) p_convert_late(F, A, F.gw, F.NGW, (LAS float*)(F.lds + RING_OFF + F.wave * 16384), false, 0, MOE_E_EARLY); } SEAM(PH_CONV);
    if (IN(PH_INPROJ0)) { InprojKvOrder S{WSP(bf16, WS_XN), WSP(bf16, WS_W_ABIN), WSP(bf16, WS_MEMN), WSP(bf16, WS_W_XKV), F.G, cb};
        EpiInprojKv E{WSP(bf16, R_PROJ), WSP(float, R_GATES32), WSP(bf16, WS_KMEM), WSP(bf16, WS_VTMEM)};
        pg8::gemm_phase<EpiInprojKv, InprojKvOrder, true>(ring, pg8::Gemm{D, D, D}, S, E); } SEAM(PH_INPROJ0);
    if (IN(PH_PREPA)) { p_prepa(F, A); DUP(PH_PREPA) { __syncthreads(); p_prepa(F, A); } } SEAM(PH_PREPA);
    if (IN(PH_LORA)) { pg8::PlainOrder S{WSP(bf16, R_LORAIN), WSP(bf16, WS_W_LORA), 512, 512, 32, 12, F.G, cb}; pg8::EpiF32 E{WSP(float, R_LORAOUT), 3072, 0, 1.0f};
        pg8::gemm_phase<pg8::EpiF32, pg8::PlainOrder, true>(ring, pg8::Gemm{512, 512, 512}, S, E);
        p_mlstm_pass2(F, cb == (int)F.G - 1 && F.wave < NH_M, F.wave); } SEAM(PH_LORA);
    if (IN(PH_SCAN)) {
        constexpr int RW_NP = 128;
        if (cb < 16) p_rwkv_seq(F);
        else if (cb < 16 + RW_NP) { p_rwkv_chunk2(F, A, cb - 16, RW_NP); __syncthreads(); p_mlu(F, cb - 16, RW_NP); }
        else p_convert_late(F, A, (cb - 16 - RW_NP) * NWAVES + F.wave, (F.G - 16 - RW_NP) * NWAVES, (LAS float*)(F.lds + RING_OFF + F.wave * 16384), true, MOE_E_EARLY, NEXP - MOE_E_TAIL);
    } SEAM(PH_SCAN);
    if (IN(PH_MLSCAN)) { p_mlscan(F); p_rwkv_post(F, A); DUP(PH_MLSCAN) { __syncthreads(); p_rwkv_post(F, A); } } SEAM(PH_MLSCAN);
    if (IN(PH_MLOUT)) { p_mlout(F, A); DUP(PH_MLOUT) { __syncthreads(); p_mlout(F, A); } } SEAM(PH_MLOUT);
    if (IN(PH_OUTPROJ0)) { pg8::PlainOrder S{WSP(bf16, R_YCAT), WSP(bf16, WS_W_ABOUT), D, D, 32, 8, F.G, cb}; pg8::EpiResid E{A.in[I_X], WSP(float, WS_X), D, nullptr, nullptr, nullptr};
        pg8::gemm_phase<pg8::EpiResid, pg8::PlainOrder, false>(ring, pg8::Gemm{D, D, D}, S, E); } SEAM(PH_OUTPROJ0);
#define XATTN(l, P_NORM, P_Q, P_S, P_PV, P_O, SSQ_IN, XN_OUT, G_OUT, SSQ_OUT) \
    if (IN(P_NORM)) { norm_phase(F, WSP(float, WS_X), A.in[I_NXAG] + (l) * D, WSP(bf16, WS_XN), T); } SEAM(P_NORM); \
    if (IN(P_Q)) { pg8::PlainOrder S{WSP(bf16, WS_XN), WSP(bf16, WS_W_XQ) + (size_t)(l) * D * D, D, D, 32, 8, F.G, cb}; pg8::EpiBf16 E{WSP(bf16, R_XQ), D, nullptr, -1, SSQ_IN}; \
        pg8::gemm_phase<pg8::EpiBf16, pg8::PlainOrder, false>(ring, pg8::Gemm{D, D, D}, S, E); } SEAM(P_Q); \
    if (IN(P_S)) { XsOrder S{WSP(bf16, R_XQ), WSP(bf16, WS_KMEM) + (size_t)(l) * NMEM * D, F.G, cb}; pg8::EpiSoftmaxBf16 E{WSP(bf16, R_XP), 1024, 256, 0.044194173824159216f}; \
        pg8::gemm_phase<pg8::EpiSoftmaxBf16, XsOrder, false>(ring, pg8::Gemm{D, D, 512}, S, E); } SEAM(P_S); \
    if (IN(P_PV)) { XpvOrder S{WSP(bf16, R_XP), WSP(bf16, WS_VTMEM) + (size_t)(l) * D * NMEM, F.G, cb}; pg8::EpiBf16 E{WSP(bf16, R_XO), D, nullptr, -1, nullptr}; \
        pg8::gemm_phase<pg8::EpiBf16, XpvOrder, false>(ring, pg8::Gemm{1024, NMEM, 256}, S, E); } SEAM(P_PV); \
    if (IN(P_O)) { pg8::PlainOrder S{WSP(bf16, R_XO), WSP(bf16, WS_W_XO) + (size_t)(l) * D * D, D, D, 32, 8, F.G, cb}; pg8::EpiResid E{WSP(float, WS_X), WSP(float, WS_X), D, XN_OUT, G_OUT, SSQ_OUT}; \
        pg8::gemm_phase<pg8::EpiResid, pg8::PlainOrder, false>(ring, pg8::Gemm{D, D, D}, S, E); } SEAM(P_O);

    XATTN(0, PH_NORMX0, PH_XQ0, PH_XS0, PH_XPV0, PH_XO0, (const float*)nullptr, (bf16*)nullptr, (const float*)nullptr, (float*)nullptr)
    if (IN(PH_NORMF0)) { norm_phase(F, WSP(float, WS_X), A.in[I_NFFNG], WSP(bf16, WS_XN), T); } SEAM(PH_NORMF0);
    if (IN(PH_FFNGU)) { pg8::PlainOrder S{WSP(bf16, WS_XN), WSP(bf16, WS_W_FFNGU), D, D, 32, 44, F.G, cb}; pg8::EpiSwiGLU E{WSP(bf16, R_ACT), DFF, nullptr};
        pg8::gemm_phase<pg8::EpiSwiGLU, pg8::PlainOrder, true>(ring, pg8::Gemm{D, D, D}, S, E); DUP(PH_FFNGU) { pg8::gemm_phase<pg8::EpiSwiGLU, pg8::PlainOrder, true>(ring, pg8::Gemm{D, D, D}, S, E); }
        if (MOE_E_TAIL > 0 && cb >= 128) p_convert_late(F, A, (cb - 128) * NWAVES + F.wave, (F.G - 128) * NWAVES, (LAS float*)(F.lds + RING_OFF + F.wave * 16384), false, NEXP - MOE_E_TAIL, NEXP); } SEAM(PH_FFNGU);
    if (IN(PH_FFND)) { pg8::PlainOrder S{WSP(bf16, R_ACT), WSP(bf16, WS_W_FFND), DFF, DFF, 32, 8, F.G, cb}; pg8::EpiResid E{WSP(float, WS_X), WSP(float, WS_X), D, nullptr, nullptr, nullptr};
        pg8::gemm_phase<pg8::EpiResid, pg8::PlainOrder, false>(ring, pg8::Gemm{DFF, DFF, DFF}, S, E); } SEAM(PH_FFND);
    if (IN(PH_NORMM1)) { p_norm_fpre(F, A); DUP(PH_NORMM1) { p_norm_fpre(F, A); } } SEAM(PH_NORMM1);
    if (IN(PH_FOXIN)) { pg8::PlainOrder S{WSP(bf16, WS_XN), WSP(bf16, WS_W_FOXIN), D, D, 32, 32, F.G, cb}; pg8::EpiBf16 E{WSP(bf16, R_QKVG), 8192, nullptr, -1, nullptr};
        pg8::gemm_phase<pg8::EpiBf16, pg8::PlainOrder, true>(ring, pg8::Gemm{D, D, D}, S, E); DUP(PH_FOXIN) { pg8::gemm_phase<pg8::EpiBf16, pg8::PlainOrder, true>(ring, pg8::Gemm{D, D, D}, S, E); } } SEAM(PH_FOXIN);
    if (IN(PH_FOXPREP)) { p_foxprep(F, A); } SEAM(PH_FOXPREP);
    if (IN(PH_FOXATT)) { p_foxattn(F); DUP(PH_FOXATT) { __syncthreads(); p_foxattn(F); } } SEAM(PH_FOXATT);
    if (IN(PH_FOXOUT)) { pg8::PlainOrder S{WSP(bf16, R_ATTO), WSP(bf16, WS_W_FOXOUT), D, D, 32, 8, F.G, cb}; pg8::EpiResid E{WSP(float, WS_X), WSP(float, WS_X), D, nullptr, nullptr, nullptr};
        pg8::gemm_phase<pg8::EpiResid, pg8::PlainOrder, false>(ring, pg8::Gemm{D, D, D}, S, E); } SEAM(PH_FOXOUT);
    XATTN(1, PH_NORMX1, PH_XQ1, PH_XS1, PH_XPV1, PH_XO1, (const float*)nullptr, (bf16*)nullptr, (const float*)nullptr, (float*)nullptr)
    if (IN(PH_NORMF1)) { p_norm_route(F, A); } SEAM(PH_NORMF1);
    if (IN(PH_ROUTE2)) { p_route2(F); } SEAM(PH_ROUTE2);
    if (IN(PH_MOEGU)) { MoeOrder S{WSP(bf16, R_AG), WSP(bf16, WS_W_MOEGU), WSP(int, WS_SMALL + SM_TILEE), D, 44, (size_t)2 * DFF * D, F.G, cb, false}; pg8::EpiSwiGLU E{WSP(bf16, R_ACTG), DFF, nullptr};
        pg8::gemm_phase<pg8::EpiSwiGLU, MoeOrder, true>(ring, pg8::Gemm{D, D, D}, S, E); } SEAM(PH_MOEGU);
    if (IN(PH_MOED)) {
        { MoeOrder S{WSP(bf16, R_ACTG), WSP(bf16, WS_W_MOED), WSP(int, WS_SMALL + SM_TILEE), DFF, 8, (size_t)D * DFF, F.G, cb, true}; pg8::EpiF32 E{WSP(float, R_YG), D, 0, 1.0f};
          pg8::gemm_phase<pg8::EpiF32, MoeOrder, true>(ring, pg8::Gemm{DFF, DFF, DFF}, S, E); }
        { MoeSplitOrder S{WSP(bf16, R_ACTG), WSP(bf16, WS_W_MOED), WSP(int, WS_SMALL + SM_TILEE), DFF, 8, DFF / MOE_KSPLIT, (size_t)D * DFF, F.G, cb}; const int nt_ = WSP(int, WS_SMALL + SM_TILEE)[0]; pg8::EpiF32Split E{WSP(float, R_YG), WSP(float, R_YSIDE), YSIDE_STRIDE, D, ((nt_ * 8) / F.G) * F.G / 8};
          pg8::gemm_phase<pg8::EpiF32Split, MoeSplitOrder, false>(ring, pg8::Gemm{DFF, DFF, DFF / MOE_KSPLIT}, S, E); } } SEAM(PH_MOED);
    if (IN(PH_FINAL)) { p_final(F, A); }
#undef XATTN
#undef IN
#undef SEAM
}

#ifndef MK_ONE_LAUNCH
#define MK_ONE_LAUNCH 1
#endif
extern "C" void kernel_launch(void* const* d_in, const int* in_sizes, int n_in, void* d_out, int out_size, void* d_ws, size_t ws_size, hipStream_t stream) {
    static int ready = 0;
    if (ready == 0) {
        if (n_in != N_IN || in_sizes[0] != T * D || out_size != T * D || ws_size < WS_END) {
            fprintf(stderr, "kernel_launch: built for %d inputs, x/out of %d floats, >= %zu bytes of workspace; got n_in %d, in0 %d, out %d, ws %zu; nothing launched\n", N_IN, T * D, (size_t)WS_END, n_in, n_in > 0 ? in_sizes[0] : -1, out_size, ws_size);
            ready = -1; return; }
        if (hipFuncSetAttribute((const void*)trunk_fwd, hipFuncAttributeMaxDynamicSharedMemorySize, LDS_BYTES) != hipSuccess) { fprintf(stderr, "kernel_launch: hipFuncSetAttribute failed\n"); ready = -1; return; }
        int per_cu = 0;
        if (hipOccupancyMaxActiveBlocksPerMultiprocessor(&per_cu, (const void*)trunk_fwd, NWAVES * 64, LDS_BYTES) != hipSuccess || per_cu < 1)
            fprintf(stderr, "kernel_launch: note: occupancy query reports %d workgroups per CU\n", per_cu);
        (void)hipGetLastError();
        ready = 1;
    }
    if (ready < 0) return;
    const int grid = 256;
    if (hipMemsetAsync((char*)d_ws + WS_CTL, 0, CTL_ZERO_BYTES, stream) != hipSuccess) { fprintf(stderr, "kernel_launch: hipMemsetAsync failed\n"); return; }
    Args a{};
    for (int i = 0; i < N_IN; ++i) a.in[i] = (const float*)d_in[i];
    a.out = (float*)d_out; a.ws = (unsigned char*)d_ws;
#if MK_ONE_LAUNCH
    a.ph_lo = 0; a.ph_hi = N_PHASES;
    hipLaunchKernelGGL(trunk_fwd, dim3(grid), dim3(NWAVES * 64), LDS_BYTES, stream, a);
#else
    for (int p = 0; p < N_PHASES; ++p) { a.ph_lo = p; a.ph_hi = p + 1;
        hipLaunchKernelGGL(trunk_fwd, dim3(grid), dim3(NWAVES * 64), LDS_BYTES, stream, a); }
#endif
    const hipError_t le = hipPeekAtLastError();
    if (le != hipSuccess) fprintf(stderr, "kernel_launch: launch failed: %s\n", hipGetErrorName(le));
}
```

```cpp
#include <hip/hip_runtime.h>
#include <cstdio>
#include <cstdint>

#define GAS __attribute__((address_space(1)))
#define LAS __attribute__((address_space(3)))
typedef unsigned short bf16;
typedef short bf16x8 __attribute__((ext_vector_type(8)));
typedef short s16x4 __attribute__((ext_vector_type(4)));
typedef float f32x2 __attribute__((ext_vector_type(2)));
typedef float f32x4 __attribute__((ext_vector_type(4)));
typedef float f32x16 __attribute__((ext_vector_type(16)));
typedef unsigned u32x2 __attribute__((ext_vector_type(2)));
typedef unsigned u32x4 __attribute__((ext_vector_type(4)));

constexpr int T = 8192, D = 2048, NMEM = 256, DFF = 5632, NEXP = 8;
constexpr int A_COLS = 3520, AB_COLS = 7624, AB_PAD = 7680;
constexpr int FOX_LD = 8208;
constexpr int NH_R = 16, NH_M = 4, NH_F = 16;
constexpr int MOE_ROWS = 72 * 256;

__device__ __forceinline__ float bf2f(unsigned b) { return __uint_as_float(b << 16); }
__device__ __forceinline__ unsigned cvt_pk_bf16(float lo, float hi) { unsigned r; asm volatile("v_cvt_pk_bf16_f32 %0, %1, %2" : "=v"(r) : "v"(lo), "v"(hi)); return r; }
__device__ __forceinline__ bf16 f2bf(float f) { return (bf16)(cvt_pk_bf16(f, 0.f) & 0xffffu); }
__device__ __forceinline__ float wave_sum(float v) {
#pragma unroll
    for (int o = 1; o < 64; o <<= 1) v += __shfl_xor(v, o);
    return v;
}
__device__ __forceinline__ float wave_max(float v) {
#pragma unroll
    for (int o = 1; o < 64; o <<= 1) v = fmaxf(v, __shfl_xor(v, o));
    return v;
}
__device__ __forceinline__ float wave_sum_dpp(float x) {
#define DPPF_(v, ctrl) __builtin_bit_cast(float, __builtin_amdgcn_update_dpp(0, __builtin_bit_cast(int, v), ctrl, 0xF, 0xF, true))
    x += DPPF_(x, 0xB1); x += DPPF_(x, 0x4E); x += DPPF_(x, 0x141); x += DPPF_(x, 0x140);
#undef DPPF_
    const float a = __builtin_bit_cast(float, __builtin_amdgcn_readlane(__builtin_bit_cast(int, x), 0)), b = __builtin_bit_cast(float, __builtin_amdgcn_readlane(__builtin_bit_cast(int, x), 16));
    const float c = __builtin_bit_cast(float, __builtin_amdgcn_readlane(__builtin_bit_cast(int, x), 32)), d = __builtin_bit_cast(float, __builtin_amdgcn_readlane(__builtin_bit_cast(int, x), 48));
    return (a + b) + (c + d);
}
__device__ __forceinline__ float wave_scan_dpp(float x) {
#define DPPS_(v, ctrl, rmask, bc) __builtin_bit_cast(float, __builtin_amdgcn_update_dpp(0, __builtin_bit_cast(int, v), ctrl, rmask, 0xF, bc))
    x += DPPS_(x, 0x111, 0xF, true); x += DPPS_(x, 0x112, 0xF, true); x += DPPS_(x, 0x114, 0xF, true); x += DPPS_(x, 0x118, 0xF, true);
    x += DPPS_(x, 0x142, 0xA, false); x += DPPS_(x, 0x143, 0xC, false);
#undef DPPS_
    return x;
}
__device__ __forceinline__ float sigmoidf_(float x) { return 1.0f / (1.0f + __expf(-x)); }
__device__ __forceinline__ float logsigmoidf_(float x) { return fminf(x, 0.f) - log1pf(__expf(-fabsf(x))); }

namespace pg8 {
#define PG8_LAS __attribute__((address_space(3)))
typedef unsigned short bf16_t;
constexpr int BM = 256, BK = 64, HALF = 128, HTB = HALF * BK * 2  , STAGE_BYTES = 8 * HTB, NXCD = 8, WGM = 8;

__host__ __device__ __forceinline__ int lds_byte(int r, int c) { const int st = (r >> 4) * 2 + (c >> 5), rr = r & 15, cc = c & 31, ob = rr * 64 + cc * 2; return st * 1024 + (ob ^ (((ob >> 9) & 1) << 5)); }
__host__ __device__ __forceinline__ void stage_rc(int b, int& R, int& C) { const int st = b / 1024, sb = b % 1024, swz = sb ^ (((sb >> 9) & 1) << 5); R = (st >> 1) * 16 + swz / 64; C = (st & 1) * 32 + (swz % 64) / 2; }
__host__ __device__ __forceinline__ int perm32(int rho) { const int n = rho >> 4, i = rho & 15; return 8 * (i >> 2) + 4 * n + (i & 3); }

struct Unit { const char* a; const char* b; int pm, pn, aux, pad; };
struct Gemm { int lda, ldb, K; };

__device__ __forceinline__ bool static_tile(int i, int G, int c, int nM, int nN, int& pm, int& pn) {
    const int nwg = nM * nN; const long L = (long)i * G + c; if (L >= nwg) return false;
    int wgid = (int)L; { const int q = nwg / NXCD, r = nwg % NXCD, xcd = wgid % NXCD, off = wgid / NXCD; wgid = (xcd < r ? xcd * (q + 1) : r * (q + 1) + (xcd - r) * q) + off; }
    const int nig = WGM * nN, gid = wgid / nig, fm = gid * WGM, gsz = (nM - fm) < WGM ? (nM - fm) : WGM;
    pm = fm + ((wgid % nig) % gsz); pn = (wgid % nig) / gsz; return true;
}
struct PlainOrder {
    const bf16_t* A; const bf16_t* Bt; int lda, ldb, nM, nN, G, c;
    __device__ __forceinline__ bool next(int i, Unit& u) const {
        int pm, pn; if (!static_tile(i, G, c, nM, nN, pm, pn)) return false;
        u.pm = pm; u.pn = pn; u.aux = 0; u.pad = 0; u.a = (const char*)(A + (size_t)pm * BM * lda); u.b = (const char*)(Bt + (size_t)pn * BM * ldb); return true;
    }
};

#ifndef PG8_WT
#define PG8_WT 0
#endif
template <class V> __device__ __forceinline__ void st16(void* p, const V v) {
    if (PG8_WT) asm volatile("global_store_dwordx4 %0, %1, off sc1\n\ts_nop 1" :: "v"(p), "v"(v)); else *(V*)p = v; }
template <class V> __device__ __forceinline__ void st8(void* p, const V v) {
    if (PG8_WT) asm volatile("global_store_dwordx2 %0, %1, off sc1" :: "v"(p), "v"(v)); else *(V*)p = v; }
struct EpiF32 {
    static constexpr bool PERM = false;
    float* C; int ldc; int aux_cols; float scale;
    __device__ __forceinline__ void operator()(const f32x4 (&acc)[2][2][4][2], const Unit& u, int wr, int wc, int fr, int fq) const {
        const int row0 = u.pm * BM + wr * 64 + fr, col0 = u.pn * BM + u.aux * aux_cols + wc * 32 + 4 * fq;
#pragma unroll
        for (int ai = 0; ai < 2; ++ai)
#pragma unroll
            for (int m = 0; m < 4; ++m) { float* rowp = C + (size_t)(row0 + ai * HALF + m * 16) * ldc + col0;
#pragma unroll
                for (int bj = 0; bj < 2; ++bj)
#pragma unroll
                    for (int n = 0; n < 2; ++n) st16(rowp + bj * HALF + n * 16, (f32x4)(acc[ai][bj][m][n] * scale)); }
    }
};
struct EpiBf16N {
    static constexpr bool PERM = false;
    bf16_t* O; int ldc;
    __device__ __forceinline__ void operator()(const f32x4 (&acc)[2][2][4][2], const Unit& u, int wr, int wc, int fr, int fq) const {
        const int row0 = u.pm * BM + wr * 64 + fr, col0 = u.pn * BM + wc * 32 + 4 * fq;
#pragma unroll
        for (int ai = 0; ai < 2; ++ai)
#pragma unroll
            for (int m = 0; m < 4; ++m) { bf16_t* rowp = O + (size_t)(row0 + ai * HALF + m * 16) * ldc + col0;
#pragma unroll
                for (int bj = 0; bj < 2; ++bj)
#pragma unroll
                    for (int n = 0; n < 2; ++n) { const f32x4 x = acc[ai][bj][m][n]; u32x2 w; w.x = cvt_pk_bf16(x[0], x[1]); w.y = cvt_pk_bf16(x[2], x[3]); st8(rowp + bj * HALF + n * 16, w); } }
    }
};
struct EpiF32Split {
    static constexpr bool PERM = false;
    bf16_t* C; float* side; size_t side_stride; int ldc; int pm0;
    __device__ __forceinline__ void operator()(const f32x4 (&acc)[2][2][4][2], const Unit& u, int wr, int wc, int fr, int fq) const {
        const int row0 = wr * 64 + fr, col0 = u.pn * BM + wc * 32 + 4 * fq; const bool first = u.aux == 0;
        bf16_t* cb = C + (size_t)u.pm * BM * ldc; float* sb = side + (size_t)(first ? 0 : u.aux - 1) * side_stride + (size_t)(u.pm - pm0) * BM * ldc;
#pragma unroll
        for (int ai = 0; ai < 2; ++ai)
#pragma unroll
            for (int m = 0; m < 4; ++m) { const size_t ro = (size_t)(row0 + ai * HALF + m * 16) * ldc + col0;
#pragma unroll
                for (int bj = 0; bj < 2; ++bj)
#pragma unroll
                    for (int n = 0; n < 2; ++n) { const f32x4 x = acc[ai][bj][m][n];
                        if (first) { u32x2 w; w.x = cvt_pk_bf16(x[0], x[1]); w.y = cvt_pk_bf16(x[2], x[3]); st8(cb + ro + bj * HALF + n * 16, w); }
                        else st16(sb + ro + bj * HALF + n * 16, x); } }
    }
};
struct EpiResid {
    static constexpr bool PERM = false;
    const float* base; float* out; int ldc; bf16_t* xn; const float* gn; float* ssq;
    __device__ __forceinline__ void operator()(const f32x4 (&acc)[2][2][4][2], const Unit& u, int wr, int wc, int fr, int fq) const {
        const int row0 = u.pm * BM + wr * 64 + fr, col0 = u.pn * BM + wc * 32 + 4 * fq;
        f32x4 gv[2][2];
        if (xn) {
#pragma unroll
            for (int bj = 0; bj < 2; ++bj)
#pragma unroll
                for (int n = 0; n < 2; ++n) gv[bj][n] = *(const f32x4*)(gn + col0 + bj * HALF + n * 16); }
#pragma unroll
        for (int ai = 0; ai < 2; ++ai)
#pragma unroll
            for (int m = 0; m < 4; ++m) { const int row = row0 + ai * HALF + m * 16; const size_t off = (size_t)row * ldc + col0; float ss = 0.f;
#pragma unroll
                for (int bj = 0; bj < 2; ++bj)
#pragma unroll
                    for (int n = 0; n < 2; ++n) { const f32x4 b = *(const f32x4*)(base + off + bj * HALF + n * 16); const f32x4 x = b + acc[ai][bj][m][n]; st16(out + off + bj * HALF + n * 16, x);
                        if (xn) { ss += (x[0] * x[0] + x[1] * x[1]) + (x[2] * x[2] + x[3] * x[3]); const f32x4 y = x * gv[bj][n];
                            u32x2 w; w.x = cvt_pk_bf16(y[0], y[1]); w.y = cvt_pk_bf16(y[2], y[3]); *(u32x2*)(xn + off + bj * HALF + n * 16) = w; } }
                if (xn) { ss += __shfl_xor(ss, 16); ss += __shfl_xor(ss, 32); if (fq == 0) __hip_atomic_fetch_add(ssq + row, ss, __ATOMIC_RELAXED, __HIP_MEMORY_SCOPE_AGENT); } }
    }
};
struct EpiBf16 {
    static constexpr bool PERM = true;
    bf16_t* O; int ldc; float* side; int side_pn; const float* ssq;
    __device__ __forceinline__ void operator()(const f32x4 (&acc)[2][2][4][2], const Unit& u, int wr, int wc, int fr, int fq) const {
        const int row0 = u.pm * BM + wr * 64 + fr, col0 = u.pn * BM + wc * 32 + 8 * fq;
#pragma unroll
        for (int ai = 0; ai < 2; ++ai)
#pragma unroll
            for (int m = 0; m < 4; ++m) { bf16_t* rowp = O + (size_t)(row0 + ai * HALF + m * 16) * ldc + col0;
                const float rs = ssq ? 1.0f / sqrtf(ssq[row0 + ai * HALF + m * 16] * (1.0f / 2048.0f) + 1e-6f) : 1.0f;
#pragma unroll
                for (int bj = 0; bj < 2; ++bj) { const f32x4 v0 = acc[ai][bj][m][0] * rs, v1 = acc[ai][bj][m][1] * rs;
                    u32x4 w; w.x = cvt_pk_bf16(v0[0], v0[1]); w.y = cvt_pk_bf16(v0[2], v0[3]); w.z = cvt_pk_bf16(v1[0], v1[1]); w.w = cvt_pk_bf16(v1[2], v1[3]);
                    st16(rowp + bj * HALF, w); } }
        if (side != nullptr && u.pn == side_pn) {
#pragma unroll
            for (int ai = 0; ai < 2; ++ai)
#pragma unroll
                for (int m = 0; m < 4; ++m) { float* rowp = side + (size_t)(row0 + ai * HALF + m * 16) * 256 + wc * 32 + 8 * fq;
#pragma unroll
                    for (int bj = 0; bj < 2; ++bj) { st16(rowp + bj * HALF, acc[ai][bj][m][0]); st16(rowp + bj * HALF + 4, acc[ai][bj][m][1]); } }
        }
    }
};
struct EpiSwiGLU {
    static constexpr bool PERM = true;
    bf16_t* O; int ldc; const float* ssq;
    __device__ __forceinline__ void operator()(const f32x4 (&acc)[2][2][4][2], const Unit& u, int wr, int wc, int fr, int fq) const {
        const int row0 = u.pm * BM + wr * 64 + fr, col0 = u.pn * HALF + wc * 32 + 8 * fq;
#pragma unroll
        for (int ai = 0; ai < 2; ++ai)
#pragma unroll
            for (int m = 0; m < 4; ++m) { bf16_t* rowp = O + (size_t)(row0 + ai * HALF + m * 16) * ldc + col0;
                const float rs = ssq ? 1.0f / sqrtf(ssq[row0 + ai * HALF + m * 16] * (1.0f / 2048.0f) + 1e-6f) : 1.0f;
                float o[8];
#pragma unroll
                for (int n = 0; n < 2; ++n)
#pragma unroll
                    for (int j = 0; j < 4; ++j) { const float g = acc[ai][0][m][n][j] * rs, up = acc[ai][1][m][n][j] * rs;
                        o[n * 4 + j] = g * __builtin_amdgcn_rcpf(1.0f + __builtin_amdgcn_exp2f(-1.4426950408889634f * g)) * up; }
                u32x4 w; w.x = cvt_pk_bf16(o[0], o[1]); w.y = cvt_pk_bf16(o[2], o[3]); w.z = cvt_pk_bf16(o[4], o[5]); w.w = cvt_pk_bf16(o[6], o[7]);
                st16(rowp, w); }
    }
};

template <class E, class = void> struct epi_after_drain { static constexpr bool value = false; };
template <class E> struct epi_after_drain<E, decltype((void)E::AFTER_DRAIN)> { static constexpr bool value = E::AFTER_DRAIN; };
struct EpiSoftmaxBf16 {
    static constexpr bool PERM = false, AFTER_DRAIN = true;
    bf16_t* P; int ldc; int aux_cols; float scale;
    __device__ __forceinline__ void fused(f32x4 (&acc)[2][2][4][2], const Unit& u, int wr, int wc, int fr, int fq, PG8_LAS unsigned char* lds) const {
        PG8_LAS float* pm = (PG8_LAS float*)lds;
        PG8_LAS float* ps = pm + 1024;
        float mx[2][4];
#pragma unroll
        for (int ai = 0; ai < 2; ++ai)
#pragma unroll
            for (int m = 0; m < 4; ++m) { float v = -3.0e38f;
#pragma unroll
                for (int bj = 0; bj < 2; ++bj)
#pragma unroll
                    for (int n = 0; n < 2; ++n) { acc[ai][bj][m][n] = acc[ai][bj][m][n] * scale; const f32x4 x = acc[ai][bj][m][n]; v = fmaxf(v, fmaxf(fmaxf(x[0], x[1]), fmaxf(x[2], x[3]))); }
                v = fmaxf(v, __shfl_xor(v, 16)); v = fmaxf(v, __shfl_xor(v, 32)); mx[ai][m] = v;
                if (fq == 0) pm[(ai * HALF + wr * 64 + m * 16 + fr) * 4 + wc] = v; }
        asm volatile("s_waitcnt lgkmcnt(0)" ::: "memory"); __builtin_amdgcn_s_barrier(); asm volatile("" ::: "memory");
        float sm[2][4];
#pragma unroll
        for (int ai = 0; ai < 2; ++ai)
#pragma unroll
            for (int m = 0; m < 4; ++m) { const f32x4 p4 = *(const PG8_LAS f32x4*)(pm + (ai * HALF + wr * 64 + m * 16 + fr) * 4); const float mr = fmaxf(fmaxf(p4[0], p4[1]), fmaxf(p4[2], p4[3])); float s = 0.f;
#pragma unroll
                for (int bj = 0; bj < 2; ++bj)
#pragma unroll
                    for (int n = 0; n < 2; ++n) { f32x4 x = acc[ai][bj][m][n];
#pragma unroll
                        for (int j = 0; j < 4; ++j) { x[j] = __expf(x[j] - mr); s += x[j]; }
                        acc[ai][bj][m][n] = x; }
                s += __shfl_xor(s, 16); s += __shfl_xor(s, 32); sm[ai][m] = s;
                if (fq == 0) ps[(ai * HALF + wr * 64 + m * 16 + fr) * 4 + wc] = s; }
        asm volatile("s_waitcnt lgkmcnt(0)" ::: "memory"); __builtin_amdgcn_s_barrier(); asm volatile("" ::: "memory");
        const int row0 = u.pm * BM + wr * 64 + fr, col0 = u.pn * BM + u.aux * aux_cols + wc * 32 + 4 * fq;
#pragma unroll
        for (int ai = 0; ai < 2; ++ai)
#pragma unroll
            for (int m = 0; m < 4; ++m) { const f32x4 s4 = *(const PG8_LAS f32x4*)(ps + (ai * HALF + wr * 64 + m * 16 + fr) * 4); const float inv = 1.0f / ((s4[0] + s4[1]) + (s4[2] + s4[3]));
                bf16_t* rowp = P + (size_t)(row0 + ai * HALF + m * 16) * ldc + col0;
#pragma unroll
                for (int bj = 0; bj < 2; ++bj)
#pragma unroll
                    for (int n = 0; n < 2; ++n) { const f32x4 x = acc[ai][bj][m][n] * inv; u32x2 w; w.x = cvt_pk_bf16(x[0], x[1]); w.y = cvt_pk_bf16(x[2], x[3]); st8(rowp + bj * HALF + n * 16, w); } }
        (void)mx; (void)sm;
    }
};

template <class Epi, class Sched, bool ALIGN_EPI>
__device__ __forceinline__ void gemm_phase(PG8_LAS unsigned char* lds, const Gemm g, const Sched& S, const Epi& E) {
    const int tid = threadIdx.x, wid = __builtin_amdgcn_readfirstlane(tid >> 6), lane = tid & 63, wr = wid >> 2, wc = wid & 3, fr = lane & 15, fq = lane >> 4;
    const int K = g.K, nt = K / BK;
    unsigned voffA[2], voffB[2];
#pragma unroll
    for (int i = 0; i < 2; ++i) { int R, C; stage_rc(tid * 16 + i * 8192, R, C); const int Rb = Epi::PERM ? ((R & ~31) + perm32(R & 31)) : R;
        voffA[i] = (unsigned)(R * g.lda + C) * 2u; voffB[i] = (unsigned)(Rb * g.ldb + C) * 2u; }
    const size_t kstep = (size_t)(BK * 2);
    const size_t hstepA = (size_t)HALF * g.lda * 2, hstepB = (size_t)HALF * g.ldb * 2;
    const unsigned ldsw = (unsigned)wid * 1024u;
    const int aoff = lds_byte(wr * 64 + fr, fq * 8), boff = lds_byte(wc * 32 + fr, fq * 8);
#define PG8_SA(b, h) (((b) * 2 + (h)) * HTB)
#define PG8_SB(b, h) ((4 + (b) * 2 + (h)) * HTB)
#define PG8_STAGE(bufoff, gbase, voff) do { _Pragma("unroll") for (int _i = 0; _i < 2; ++_i) \
        __builtin_amdgcn_global_load_lds((const unsigned*)((const char*)(gbase) + (voff)[_i]), (PG8_LAS unsigned*)(lds + (bufoff) + ldsw + _i * 8192), 16, 0, 0); } while (0)
#define PG8_LDA(dst, b, h) do { _Pragma("unroll") for (int m = 0; m < 4; ++m) _Pragma("unroll") for (int k = 0; k < 2; ++k) dst[m][k] = *(const PG8_LAS bf16x8*)(lds + PG8_SA(b, h) + aoff + m * 2048 + k * 1024); } while (0)
#define PG8_LDB(dst, b, h) do { _Pragma("unroll") for (int n = 0; n < 2; ++n) _Pragma("unroll") for (int k = 0; k < 2; ++k) dst[n][k] = *(const PG8_LAS bf16x8*)(lds + PG8_SB(b, h) + boff + n * 2048 + k * 1024); } while (0)
#define PG8_MMA(ai, bj, At, Bt) do { __builtin_amdgcn_s_setprio(1); _Pragma("unroll") for (int m = 0; m < 4; ++m) _Pragma("unroll") for (int n = 0; n < 2; ++n) _Pragma("unroll") for (int k = 0; k < 2; ++k) \
        acc[ai][bj][m][n] = __builtin_amdgcn_mfma_f32_16x16x32_bf16(Bt[n][k], At[m][k], acc[ai][bj][m][n], 0, 0, 0); __builtin_amdgcn_s_setprio(0); } while (0)
#define PG8_WAIT_V(n) asm volatile("s_waitcnt vmcnt(" #n ")" ::: "memory")
#define PG8_WAIT_L(n) asm volatile("s_waitcnt lgkmcnt(" #n ")" ::: "memory")
#define PG8_BAR __builtin_amdgcn_s_barrier()
#define PG8_SCHED __builtin_amdgcn_sched_barrier(0)
    Unit cur, nxt; int ui = 0;
    if (!S.next(0, cur)) return;
    f32x4 acc[2][2][4][2];
#pragma unroll
    for (int a = 0; a < 2; ++a)
#pragma unroll
        for (int b = 0; b < 2; ++b)
#pragma unroll
            for (int m = 0; m < 4; ++m)
#pragma unroll
                for (int n = 0; n < 2; ++n) acc[a][b][m][n] = (f32x4){0.f, 0.f, 0.f, 0.f};
    bf16x8 At[4][2], B0[2][2], B1[2][2];
    const char* cA = cur.a; const char* cB = cur.b;
    PG8_STAGE(PG8_SB(0, 0), cB, voffB); PG8_STAGE(PG8_SB(0, 1), cB + hstepB, voffB); PG8_STAGE(PG8_SA(0, 0), cA, voffA); PG8_STAGE(PG8_SA(0, 1), cA + hstepA, voffA);
    if (wr == 1) PG8_BAR;
    PG8_WAIT_V(2); PG8_BAR;
    PG8_STAGE(PG8_SB(1, 0), cB + kstep, voffB); PG8_STAGE(PG8_SA(1, 0), cA + kstep, voffA); PG8_STAGE(PG8_SB(1, 1), cB + hstepB + kstep, voffB);
    PG8_WAIT_V(6); PG8_BAR;
    for (;;) {
        const bool has_next = S.next(ui + 1, nxt);
        const char* nA = has_next ? nxt.a : cA; const char* nB = has_next ? nxt.b : cB;
        for (int t = 0; t < nt; t += 2) {
            const bool last = (t == nt - 2);
            const char* a1 = cA + (size_t)(t + 1) * kstep;
            const char* a2 = last ? nA : cA + (size_t)(t + 2) * kstep; const char* b2 = last ? nB : cB + (size_t)(t + 2) * kstep;
            const char* a3 = a2 + kstep; const char* b3 = b2 + kstep;
            PG8_LDB(B0, 0, 0); PG8_LDB(B1, 0, 1); PG8_SCHED; PG8_LDA(At, 0, 0); PG8_STAGE(PG8_SA(1, 1), a1 + hstepA, voffA);
            PG8_WAIT_V(8); PG8_WAIT_L(0); PG8_BAR; PG8_MMA(0, 0, At, B0); PG8_MMA(0, 1, At, B1); PG8_BAR; PG8_SCHED;
            PG8_LDA(At, 0, 1); PG8_STAGE(PG8_SB(0, 0), b2, voffB); PG8_STAGE(PG8_SB(0, 1), b2 + hstepB, voffB); PG8_STAGE(PG8_SA(0, 0), a2, voffA);
            PG8_WAIT_V(8); PG8_WAIT_L(0); PG8_BAR; PG8_MMA(1, 0, At, B0); PG8_MMA(1, 1, At, B1); PG8_BAR; PG8_SCHED;
            PG8_LDB(B0, 1, 0); PG8_LDB(B1, 1, 1); PG8_SCHED; PG8_LDA(At, 1, 0); PG8_STAGE(PG8_SA(0, 1), a2 + hstepA, voffA);
            PG8_WAIT_V(8); PG8_WAIT_L(0); PG8_BAR; PG8_MMA(0, 0, At, B0); PG8_MMA(0, 1, At, B1); PG8_BAR; PG8_SCHED;
            PG8_LDA(At, 1, 1); PG8_STAGE(PG8_SB(1, 0), b3, voffB); PG8_STAGE(PG8_SB(1, 1), b3 + hstepB, voffB); PG8_STAGE(PG8_SA(1, 0), a3, voffA);
            PG8_WAIT_V(8); PG8_WAIT_L(0); PG8_BAR; PG8_MMA(1, 0, At, B0); PG8_MMA(1, 1, At, B1); PG8_BAR; PG8_SCHED;
        }
        if constexpr (ALIGN_EPI) { if (wr == 0) PG8_BAR; }
        if constexpr (!epi_after_drain<Epi>::value) E(acc, cur, wr, wc, fr, fq);
        if (!has_next) break;
#pragma unroll
        for (int a = 0; a < 2; ++a)
#pragma unroll
            for (int b = 0; b < 2; ++b)
#pragma unroll
                for (int m = 0; m < 4; ++m)
#pragma unroll
                    for (int n = 0; n < 2; ++n) acc[a][b][m][n] = (f32x4){0.f, 0.f, 0.f, 0.f};
        cur = nxt; cA = nA; cB = nB; ++ui;
        if constexpr (ALIGN_EPI) { if (wr == 1) PG8_BAR; }
    }
    PG8_WAIT_V(0);
    if constexpr (!ALIGN_EPI) { if (wr == 0) PG8_BAR; }
    PG8_BAR;
    if constexpr (epi_after_drain<Epi>::value) E.fused(acc, cur, wr, wc, fr, fq, lds);
#undef PG8_SA
#undef PG8_SB
#undef PG8_STAGE
#undef PG8_LDA
#undef PG8_LDB
#undef PG8_MMA
#undef PG8_WAIT_V
#undef PG8_WAIT_L
#undef PG8_BAR
#undef PG8_SCHED
}
}

namespace fox {
constexpr int D = 128, LDQ = 8192, LDO = 2048;
constexpr float SCALE = 0.08838834764831845f;
constexpr float THR2 = 8.f * 1.4426950408889634f;
constexpr int NW = 8, QBLK = 32, KVBLK = 64, QB = NW * QBLK;
constexpr int SHM_V = KVBLK * D * 2, SHM_K = KVBLK * D * 2;
constexpr int BIAS_OFF = 2 * SHM_V + 2 * SHM_K + NW * 64 * 4;
constexpr int LDS_BYTES = BIAS_OFF + 8192 * 4;

#define KSWZ(row, colB) ((row) * 256 + ((colB) ^ (((row) & 7) << 4)))
#define SBAR() __builtin_amdgcn_sched_barrier(0)
__device__ __forceinline__ int v_st(int k, int c) { const int kk = (k & ~0xC) | ((k & 4) << 1) | ((k & 8) >> 1); return ((kk >> 3) * 4 + (c >> 5)) * 512 + ((kk & 7) * 32 + (c & 31)) * 2; }
__device__ __forceinline__ int v_rd_base(int lane) { return ((lane & 3) << 3) | (((lane >> 2) & 3) << 6) | (((lane >> 4) & 1) << 5) | (((lane >> 5) & 1) << 8); }
constexpr int v_rd_off(int d0, int ks, int half) { return d0 * 512 + ks * 4096 + half * 2048; }
__device__ __forceinline__ int crow(int r, int hi) { return (r & 3) + 8 * (r >> 2) + 4 * hi; }
__device__ __forceinline__ unsigned cvtpk(float lo, float hi) { unsigned r; asm volatile("v_cvt_pk_bf16_f32 %0, %1, %2" : "=v"(r) : "v"(lo), "v"(hi)); return r; }
__device__ __forceinline__ bf16x8 load8(const bf16* p) { return *reinterpret_cast<const bf16x8*>(p); }
__device__ __forceinline__ void mask_tile(f32x16& p0, f32x16& p1, int dq) {
    const float NEG = -__builtin_inff();
#pragma unroll
    for (int r = 0; r < 16; ++r) {
        const int c = (r & 3) + 8 * (r >> 2);
        if (dq - c < 0) p0[r] = NEG;
        if (dq - c - 32 < 0) p1[r] = NEG;
    }
}
__device__ __forceinline__ void partialSM(f32x16& p0, f32x16& p1, float& m_reg, float& mn, float& alpha, const float* bl) {
    constexpr float C2 = 1.4426950408889634f * SCALE;
#pragma unroll
    for (int a = 0; a < 4; ++a) {
#ifdef FOX_NOBIAS
        const f32x4 b0 = {0,0,0,0}, b1 = {0,0,0,0};
#else
        const f32x4 b0 = *(const f32x4*)(bl + 8 * a), b1 = *(const f32x4*)(bl + 32 + 8 * a);
#endif

#pragma unroll
        for (int i = 0; i < 4; ++i) { p0[4 * a + i] = fmaf(p0[4 * a + i], C2, b0[i]); p1[4 * a + i] = fmaf(p1[4 * a + i], C2, b1[i]); }
        SBAR(); }
    float pmax = p0[0]; for (int r = 1; r < 16; ++r) pmax = fmaxf(pmax, p0[r]); for (int r = 0; r < 16; ++r) pmax = fmaxf(pmax, p1[r]);
    { auto rr = __builtin_amdgcn_permlane32_swap(__float_as_uint(pmax), __float_as_uint(pmax), false, false);
      pmax = fmaxf(__uint_as_float(rr[0]), __uint_as_float(rr[1])); }
    if (__builtin_expect(__all((pmax - m_reg) <= THR2), 1)) { mn = m_reg; alpha = 1.f; }
    else { mn = fmaxf(m_reg, pmax); alpha = __builtin_amdgcn_exp2f(m_reg - mn); m_reg = mn; }
    for (int r = 0; r < 16; ++r) p0[r] = p0[r] - mn; for (int r = 0; r < 16; ++r) p1[r] = p1[r] - mn;
    for (int r = 0; r < 16; ++r) p0[r] = __builtin_amdgcn_exp2f(p0[r]);
}
__device__ __forceinline__ void finishSM(f32x16& p0, f32x16& p1, float alpha, float& l_reg, bf16x8& pa0, bf16x8& pa1, bf16x8& pa2, bf16x8& pa3) {
    for (int r = 0; r < 16; ++r) p1[r] = __builtin_amdgcn_exp2f(p1[r]);
    float ps = 0; for (int r = 0; r < 16; ++r) ps += p0[r]; for (int r = 0; r < 16; ++r) ps += p1[r];
    { auto rr = __builtin_amdgcn_permlane32_swap(__float_as_uint(ps), __float_as_uint(ps), false, false);
      ps = __uint_as_float(rr[0]) + __uint_as_float(rr[1]); }
    l_reg = l_reg * alpha + ps;
#define PK4(P, B_, OUT) do { unsigned a0 = cvtpk(P[B_+0], P[B_+1]), a1 = cvtpk(P[B_+2], P[B_+3]);                          \
        unsigned b0 = cvtpk(P[B_+4], P[B_+5]), b1 = cvtpk(P[B_+6], P[B_+7]);                                             \
        auto r0 = __builtin_amdgcn_permlane32_swap(a0, b0, false, false); auto r1 = __builtin_amdgcn_permlane32_swap(a1, b1, false, false); \
        u32x4 w = {r0[0], r1[0], r0[1], r1[1]}; OUT = *reinterpret_cast<bf16x8*>(&w); } while (0)
    PK4(p0, 0, pa0); PK4(p0, 8, pa1); PK4(p1, 0, pa2); PK4(p1, 8, pa3);
#undef PK4
}
template <int KB>
__device__ __forceinline__ void qkt(f32x16& p0, f32x16& p1, const char* K_lds, int r32, int hi, const bf16x8* qr) {
    p0 = f32x16{}; p1 = f32x16{};
    const char* kb[4];
#pragma unroll
    for (int dd = 0; dd < 4; ++dd) kb[dd] = K_lds + KB * SHM_K + KSWZ(r32, (dd * 16 + hi * 8) * 2);
#pragma unroll
    for (int d0 = 0; d0 < 8; ++d0) { const char* a = kb[d0 & 3] + (d0 >> 2) * 128;
        bf16x8 b0 = *reinterpret_cast<const bf16x8*>(a);
        bf16x8 b1 = *reinterpret_cast<const bf16x8*>(a + 32 * 256);
        p0 = __builtin_amdgcn_mfma_f32_32x32x16_bf16(b0, qr[d0], p0, 0, 0, 0);
        p1 = __builtin_amdgcn_mfma_f32_32x32x16_bf16(b1, qr[d0], p1, 0, 0, 0); }
}
template <int VB>
__device__ __forceinline__ void pv_tile(f32x16* o, int vb0, bf16x8 pa0, bf16x8 pa1, bf16x8 pa2, bf16x8 pa3) {
#define TRRD(dst, off) asm volatile("ds_read_b64_tr_b16 %0, %1 offset:%2" : "=&v"(dst) : "v"(vb0), "i"(off) : "memory")
#define PV_D0(d0) do { s16x4 l0, l1, l2, l3, h0, h1, h2, h3; constexpr int b_ = VB * SHM_V + v_rd_off(d0, 0, 0); \
        TRRD(l0, b_); TRRD(h0, b_ + 2048); TRRD(l1, b_ + 4096); TRRD(h1, b_ + 6144); TRRD(l2, b_ + 8192); TRRD(h2, b_ + 10240); TRRD(l3, b_ + 12288); TRRD(h3, b_ + 14336); \
        asm volatile("s_waitcnt lgkmcnt(0)" ::: "memory"); SBAR();   \
        o[d0] = __builtin_amdgcn_mfma_f32_32x32x16_bf16(pa0, (bf16x8){l0[0], l0[1], l0[2], l0[3], h0[0], h0[1], h0[2], h0[3]}, o[d0], 0, 0, 0);   \
        o[d0] = __builtin_amdgcn_mfma_f32_32x32x16_bf16(pa1, (bf16x8){l1[0], l1[1], l1[2], l1[3], h1[0], h1[1], h1[2], h1[3]}, o[d0], 0, 0, 0);   \
        o[d0] = __builtin_amdgcn_mfma_f32_32x32x16_bf16(pa2, (bf16x8){l2[0], l2[1], l2[2], l2[3], h2[0], h2[1], h2[2], h2[3]}, o[d0], 0, 0, 0);   \
        o[d0] = __builtin_amdgcn_mfma_f32_32x32x16_bf16(pa3, (bf16x8){l3[0], l3[1], l3[2], l3[3], h3[0], h3[1], h3[2], h3[3]}, o[d0], 0, 0, 0); } while (0)
    PV_D0(0); PV_D0(1); PV_D0(2); PV_D0(3);
#undef PV_D0
#undef TRRD
}

struct BlockRef { const bf16* Q; const bf16* K; const bf16* V; const bf16* G; bf16* O; int P0; };
struct Seam { bf16x8 qr[8]; bf16x8 st_v0, st_v1, st_k0, st_k1; };
#define LD8(base, boff) (*reinterpret_cast<const bf16x8*>((const char*)(base) + (boff)))
#define VMW() asm volatile("s_waitcnt vmcnt(0)" ::: "memory")
#define VMWN(n) asm volatile("s_waitcnt vmcnt(%0)" :: "i"(n) : "memory")
#define SLOAD_H(Kp, Vp, k0) do { const char* kb__ = (const char*)(Kp) + (size_t)(k0) * (LDQ * 2); const char* vb__ = (const char*)(Vp) + (size_t)(k0) * (LDQ * 2); \
                         S.st_v0 = LD8(vb__, kvoff); S.st_v1 = LD8(vb__, kvoff + 32u * LDQ * 2u);              \
                         S.st_k0 = LD8(kb__, kvoff); S.st_k1 = LD8(kb__, kvoff + 32u * LDQ * 2u); } while (0)
#define SWRITE_HK(bf) do { *(bf16x8*)(K_lds + (bf) * SHM_K + kws) = S.st_k0; *(bf16x8*)(K_lds + (bf) * SHM_K + kws + 32 * 256) = S.st_k1; } while (0)
#define SWRITE_HV(bf) do { *(bf16x8*)(V_lds + (bf) * SHM_V + vst0) = S.st_v0; *(bf16x8*)(V_lds + (bf) * SHM_V + vst1) = S.st_v1; } while (0)
#define SWRITE_H(bf) do { SWRITE_HV(bf); SWRITE_HK(bf); } while (0)
__device__ __forceinline__ void prime(const BlockRef& cur, char* lds, Seam& S) {
    const int tid = threadIdx.x, wid = __builtin_amdgcn_readfirstlane(tid >> 6), lane = tid & 63, r32 = lane & 31, hi = lane >> 5;
    const int sr = tid >> 4, sc = (tid & 15) * 8, kws = KSWZ(sr, sc * 2); char* K_lds = lds + 2 * SHM_V;
    const unsigned kvoff = (unsigned)(sr * LDQ + sc) * 2u, qoff = (unsigned)((wid * QBLK + r32) * LDQ + hi * 8) * 2u;
    for (int d0 = 0; d0 < 8; ++d0) S.qr[d0] = LD8(cur.Q, qoff + d0 * 32);
    SLOAD_H(cur.K, cur.V, 0); VMW(); SWRITE_HK(0);
    __syncthreads();
}
__device__ __forceinline__ void block(const BlockRef& cur, const BlockRef& nxt, char* lds, Seam& S) {
    const int tid = threadIdx.x, wid = __builtin_amdgcn_readfirstlane(tid >> 6), lane = tid & 63, r32 = lane & 31, hi = lane >> 5;
    const int NT = (cur.P0 + QB - 1) / KVBLK + 1;
    const int qlo = cur.P0 + wid * QBLK, qm = qlo + r32 - 4 * hi;
    char* V_lds = lds; char* K_lds = lds + 2 * SHM_V;
    float* ws = (float*)(lds + 2 * SHM_V + 2 * SHM_K) + wid * 64; float* li_l = ws, * al_l = ws + 32;
    const float* biasl = (const float*)(lds + BIAS_OFF) + 4 * hi;
    float m_reg = -1e30f, l_reg = 0; f32x16 o[4] = {};
    const int sr = tid >> 4, sc = (tid & 15) * 8, vst0 = v_st(sr, sc), vst1 = v_st(32 + sr, sc), kws = KSWZ(sr, sc * 2);
    const unsigned kvoff = (unsigned)(sr * LDQ + sc) * 2u;
    const int vb0 = (int)(uintptr_t)V_lds + v_rd_base(lane);
    const bf16* Kh = cur.K; const bf16* Vh = cur.V;
#define RESC(a) do { if (__any((a) < 1.f)) { if (hi == 0) al_l[r32] = (a); asm volatile("s_waitcnt lgkmcnt(0)" ::: "memory");              \
                     for (int d_ = 0; d_ < 4; ++d_) for (int r = 0; r < 16; ++r) o[d_][r] *= al_l[crow(r, hi)]; } } while (0)
#define KBASE(t) ((t) * KVBLK)
#define MASKT(P0_, P1_, t) do { const int kb_ = KBASE(t); if (kb_ + KVBLK - 1 > qlo) mask_tile(P0_, P1_, qm - kb_); } while (0)
    constexpr int NQL = 8;
#define SEAM_K0() do { VMWN(NQL); SWRITE_HK(0); SBAR(); } while (0)
    f32x16 pA0, pA1, pB0, pB1; float mnA, mnB, alA, alB; bf16x8 pa0, pa1, pa2, pa3;
    SWRITE_HV(0); SBAR();
    if (NT > 1) { SLOAD_H(Kh, Vh, KBASE(1)); }
    SBAR(); qkt<0>(pA0, pA1, K_lds, r32, hi, S.qr);
    MASKT(pA0, pA1, 0); partialSM(pA0, pA1, m_reg, mnA, alA, biasl + KBASE(0));
    if (NT > 1) { VMW(); SWRITE_H(1); }
    __syncthreads();
#define HALF_STEP(PX0, PX1, mnX, alX, PY0, PY1, alY, t, KB, VB, SB) do {                                                      \
        SBAR(); qkt<KB>(PX0, PX1, K_lds, r32, hi, S.qr);                                                                      \
        finishSM(PY0, PY1, alY, l_reg, pa0, pa1, pa2, pa3); SBAR();                                                           \
        if ((t) + 1 < NT) { SLOAD_H(Kh, Vh, KBASE((t) + 1)); SBAR(); }                                                        \
        pv_tile<VB>(o, vb0, pa0, pa1, pa2, pa3); MASKT(PX0, PX1, (t)); partialSM(PX0, PX1, m_reg, mnX, alX, biasl + KBASE(t)); \
        __syncthreads();                                                                                                      \
        if ((t) + 1 < NT) { VMW(); SWRITE_H(SB); }                                                                            \
        RESC(alX); __syncthreads(); } while (0)
    for (int t = 1; t + 1 < NT; t += 2) {
        HALF_STEP(pB0, pB1, mnB, alB, pA0, pA1, alA, t, 1, 0, 0);
        HALF_STEP(pA0, pA1, mnA, alA, pB0, pB1, alB, t + 1, 0, 1, 1);
    }
    const bool even = (NT & 1) == 0;
    if (even) { SBAR(); qkt<1>(pB0, pB1, K_lds, r32, hi, S.qr); SBAR(); }
    SLOAD_H(nxt.K, nxt.V, 0); SBAR();
    { unsigned qoff = (unsigned)((wid * QBLK + r32) * LDQ + hi * 8) * 2u; asm volatile("" : "+v"(qoff));
#pragma unroll
      for (int d0 = 0; d0 < 8; ++d0) S.qr[d0] = LD8(nxt.Q, qoff + d0 * 32); }
    SBAR();
    finishSM(pA0, pA1, alA, l_reg, pa0, pa1, pa2, pa3); SBAR();
    pv_tile<0>(o, vb0, pa0, pa1, pa2, pa3);
    if (even) { MASKT(pB0, pB1, NT - 1); partialSM(pB0, pB1, m_reg, mnB, alB, biasl + KBASE(NT - 1)); __syncthreads(); RESC(alB);
        finishSM(pB0, pB1, alB, l_reg, pa0, pa1, pa2, pa3); SBAR(); pv_tile<1>(o, vb0, pa0, pa1, pa2, pa3); }
    SBAR(); SEAM_K0();
    if (hi == 0) li_l[r32] = l_reg; asm volatile("s_waitcnt lgkmcnt(0)" ::: "memory");
    float rli[16];
#pragma unroll
    for (int r = 0; r < 16; ++r) rli[r] = __builtin_amdgcn_rcpf(li_l[crow(r, hi)]);
    unsigned ooff = (unsigned)((wid * QBLK + 4 * hi) * LDO + r32) * 2u, goff = (unsigned)((wid * QBLK + 4 * hi) * LDQ + r32) * 2u;
    asm volatile("" : "+v"(ooff), "+v"(goff));
#pragma unroll
    for (int r = 0; r < 16; ++r) { const unsigned rr = (unsigned)((r & 3) + 8 * (r >> 2));
#pragma unroll
        for (int d0 = 0; d0 < 4; ++d0) {
#ifdef FOX_NOGATE
            const float gv = 0.f;
#else
            const float gv = bf2f(*(const bf16*)((const char*)cur.G + (goff + rr * (LDQ * 2u) + d0 * 64u)));
#endif

            const float v = o[d0][r] * rli[r] * (1.0f / (1.0f + __expf(-gv)));
            const float vn = __shfl_xor(v, 1);
            if ((r32 & 1) == 0) *(unsigned*)((char*)cur.O + (ooff + rr * (LDO * 2u) + d0 * 64u)) = cvtpk(v, vn); } }
    __syncthreads();
#undef RESC
#undef KBASE
#undef MASKT
#undef SEAM_K0
#undef HALF_STEP
}
#undef LD8
#undef VMW
#undef VMWN
#undef SLOAD_H
#undef SWRITE_HK
#undef SWRITE_HV
#undef SWRITE_H
#undef KSWZ
#undef SBAR
}

constexpr int NWAVES = 8;
constexpr size_t MiB = 1u << 20;
constexpr size_t WS_CTL = 0, CTL_ZERO_BYTES = 1 * MiB;
constexpr size_t WS_MEMN = 1 * MiB;
constexpr size_t WS_KMEM = 2 * MiB;
constexpr size_t WS_VTMEM = 4 * MiB;
constexpr size_t WS_SMALL = 6 * MiB;
constexpr size_t SM_BONUS = 0;
constexpr size_t SM_FPRE = 512 * 1024;
constexpr size_t SM_BIASL2 = 1024 * 1024;
constexpr size_t SM_BCUM = 1536 * 1024;
constexpr size_t SM_IG = SM_BCUM + 128 * 1024;
constexpr size_t SM_WSTATE = SM_IG + 128 * 1024;
constexpr size_t SM_CHBL = SM_WSTATE + 128 * 1024;
constexpr size_t SM_CHMD = SM_CHBL + 4096;
constexpr size_t SM_MSEQ = SM_CHMD + 4096;
constexpr size_t SM_WCARRY = SM_MSEQ + 4096;
constexpr size_t SM_MOUT = SM_WCARRY + 4096;
constexpr size_t SM_TOPI = 2048 * 1024;
constexpr size_t SM_TOPG = SM_TOPI + 64 * 1024;
constexpr size_t SM_SLOT = SM_TOPG + 64 * 1024;
constexpr size_t SM_BLKCNT = SM_SLOT + 64 * 1024;
constexpr size_t SM_TILEE = SM_BLKCNT + 8192;
constexpr size_t SM_NU = 3 * 1024 * 1024;
constexpr size_t SM_SLOC = 4 * 1024 * 1024;
constexpr size_t SM_PEND = 5 * 1024 * 1024;
constexpr size_t SM_SIN = 6 * 1024 * 1024;
constexpr size_t WS_X = 16 * MiB;
constexpr size_t WS_XN = 80 * MiB;
constexpr size_t WS_W_XQ = 112 * MiB, WS_W_XKV = 128 * MiB, WS_W_XO = 160 * MiB, WS_W_ABIN = 176 * MiB, WS_W_LORA = 206 * MiB, WS_W_ABOUT = 209 * MiB,
                 WS_W_FFNGU = 217 * MiB, WS_W_FFND = 261 * MiB, WS_W_FOXIN = 283 * MiB, WS_W_FOXOUT = 315 * MiB, WS_W_MOEGU = 323 * MiB, WS_W_MOED = 675 * MiB;
constexpr size_t WS_R = 851 * MiB;
constexpr size_t R_PROJ = WS_R + 0 * MiB;
constexpr size_t R_GATES32 = WS_R + 120 * MiB;
constexpr size_t R_LORAIN = WS_R + 128 * MiB;
constexpr size_t R_LORAOUT = WS_R + 136 * MiB;
constexpr size_t R_SC = WS_R + 232 * MiB;
constexpr size_t SC_STRIDE = 32 * MiB;
constexpr size_t R_FR = WS_R + 232 * MiB;
constexpr size_t R_SV = WS_R + 392 * MiB;
constexpr size_t R_Y = WS_R + 424 * MiB;
constexpr size_t R_QB = WS_R + 456 * MiB, R_KB = WS_R + 472 * MiB, R_VB = WS_R + 488 * MiB;
constexpr size_t R_U = WS_R + 504 * MiB;
constexpr size_t R_YCAT = WS_R + 568 * MiB;
constexpr size_t R_XQ = WS_R + 0 * MiB;
constexpr size_t R_XS = WS_R + 32 * MiB;
constexpr size_t R_XP = WS_R + 64 * MiB;
constexpr size_t R_XO = WS_R + 80 * MiB;
constexpr size_t R_ACT = WS_R + 112 * MiB;
constexpr size_t R_QKVG = WS_R + 200 * MiB;
constexpr size_t R_ATTO = WS_R + 328 * MiB;
constexpr size_t R_AG = WS_R + 0 * MiB;
constexpr size_t R_ACTG = WS_R + 72 * MiB;
constexpr size_t R_YG = WS_R + 270 * MiB;
constexpr size_t R_YSIDE = WS_R + 416 * MiB;
constexpr size_t YSIDE_STRIDE = (size_t)8 * 256 * D;
constexpr size_t R_KQ = WS_R + 600 * MiB;
constexpr size_t R_VWT = WS_R + 608 * MiB;
constexpr size_t R_Z = WS_R + 616 * MiB;
constexpr size_t WS_END = WS_R + 624 * MiB;
static_assert(R_YG + (size_t)MOE_ROWS * D * 4 <= WS_END && R_ACTG + (size_t)MOE_ROWS * DFF * 2 <= R_YG && R_YCAT + (size_t)T * D * 2 <= WS_END, "ws map");
static_assert(WS_W_MOED + (size_t)NEXP * D * DFF * 2 <= WS_R && WS_W_MOEGU + (size_t)NEXP * 2 * DFF * D * 2 <= WS_W_MOED, "ws map (weights)");
constexpr int CW_BAR = 4096;
constexpr size_t CTL_FRFLAG = 262144;
constexpr size_t CTL_SSQ = 65536;

constexpr int RING_OFF = 0, RING_BYTES = 155648;
constexpr int LDSCTL_OFF = RING_BYTES, MISC_OFF = LDSCTL_OFF + 320;
constexpr int LDS_BYTES = RING_BYTES + 4096;

typedef GAS unsigned gu32;
#define RLX_AGENT __ATOMIC_RELAXED, __HIP_MEMORY_SCOPE_AGENT
#define LDS_WAIT() asm volatile("s_waitcnt lgkmcnt(0)" ::: "memory")
#define VM_WAIT() asm volatile("s_waitcnt vmcnt(0)" ::: "memory")

#define XB_TMO      128
#define XB_XCNT(j)  (256  + 64 * (j))
#define XB_XSUB(j)  (1280 + 64 * (j))
#define XB_XGEN(j)  (2304 + 64 * (j))
#define XB_TOP      3328
#define XB_TOPGEN   3392
#define XCD_BAR_WORDS 3456
#define XB_SPIN_CAP (1u << 18)
__device__ __forceinline__ unsigned xb_ld(unsigned* p)              { return __hip_atomic_load(p, __ATOMIC_RELAXED, __HIP_MEMORY_SCOPE_AGENT); }
__device__ __forceinline__ unsigned xb_add(unsigned* p, unsigned v) { return __hip_atomic_fetch_add(p, v, __ATOMIC_RELAXED, __HIP_MEMORY_SCOPE_AGENT); }
__device__ __forceinline__ unsigned xb_xcc_id() { return (unsigned)__builtin_amdgcn_s_getreg((3 << 11) | 20) & 0xFu; }
#define XB_SPIN(cond, bar) do { unsigned _sp = 0; while (cond) { __builtin_amdgcn_s_sleep(1); \
    if ((++_sp & 255u) == 0u) { if (xb_ld(&(bar)[XB_TMO])) break; if (_sp > XB_SPIN_CAP) { atomicAdd(&(bar)[XB_TMO], 1u); break; } } } } while (0)
struct XcdBarrier { unsigned* bar; unsigned x; volatile LAS unsigned* st; };
__device__ __forceinline__ XcdBarrier xcd_barrier_post(unsigned* bar, volatile LAS unsigned* st) {
    XcdBarrier b; b.bar = bar; b.x = xb_xcc_id(); b.st = st;
    if (threadIdx.x == 0) (void)xb_add(&bar[XB_XCNT(b.x)], 1u);
    return b;
}
__device__ __forceinline__ void xcd_barrier_complete(unsigned* bar, unsigned x, unsigned& nloc, unsigned& nx) {
    const unsigned G = gridDim.x * gridDim.y * gridDim.z;
    unsigned sum, cnt, mine, sp = 0u;
    for (;;) {
        sum = 0u; cnt = 0u; mine = 0u;
#pragma unroll
        for (unsigned j = 0; j < 16; ++j) { const unsigned c = xb_ld(&bar[XB_XCNT(j)]); sum += c; cnt += (c > 0u) ? 1u : 0u; mine = (j == x) ? c : mine; }
        if (sum == G) break;
        __builtin_amdgcn_s_sleep(1);
        if ((++sp & 255u) == 0u) { if (xb_ld(&bar[XB_TMO])) break; if (sp > XB_SPIN_CAP) { atomicAdd(&bar[XB_TMO], 1u); break; } }
    }
    nloc = mine > 0u ? mine : 1u; nx = cnt > 0u ? cnt : 1u;
}
__device__ __forceinline__ void xcd_barrier(const XcdBarrier& b) {
    asm volatile("s_waitcnt vmcnt(0)" ::: "memory");
    __syncthreads();
    if (threadIdx.x == 0) {
        unsigned* bar = b.bar;
        __builtin_amdgcn_s_waitcnt(0);
        unsigned nloc = b.st[0], nx = b.st[1];
        if (nloc == 0u) { xcd_barrier_complete(bar, b.x, nloc, nx); b.st[0] = nloc; b.st[1] = nx; }
        const unsigned old = xb_add(&bar[XB_XSUB(b.x)], 1u);
        const unsigned gen = old / nloc;
        if (old + 1u == (gen + 1u) * nloc) {
            __builtin_amdgcn_fence(__ATOMIC_RELEASE, "agent");
            asm volatile("s_waitcnt vmcnt(0)" ::: "memory");
            const unsigned og = xb_add(&bar[XB_TOP], 1u);
            const unsigned tg = og / nx;
            if (og + 1u == (tg + 1u) * nx) xb_add(&bar[XB_TOPGEN], 1u);
            else XB_SPIN(xb_ld(&bar[XB_TOPGEN]) == tg, bar);
            __builtin_amdgcn_fence(__ATOMIC_ACQUIRE, "agent");
            xb_add(&bar[XB_XGEN(b.x)], 1u);
            asm volatile("s_waitcnt vmcnt(0)" ::: "memory");
        } else {
            XB_SPIN(xb_ld(&bar[XB_XGEN(b.x)]) == gen, bar);
            __builtin_amdgcn_fence(__ATOMIC_ACQUIRE, "agent");
            asm volatile("s_waitcnt vmcnt(0)" ::: "memory");
        }
    }
    __syncthreads();
}

struct Frame {
    LAS unsigned char* lds; unsigned char* ldsg;
    unsigned char* ws; const float* const* in; float* out;
    int tid, lane, wave, vcu, G, gw, NGW;
};

enum InIdx { I_X = 0, I_MEM, I_MEMG, I_FING, I_NMIXG, I_NXAG, I_NFFNG, I_XWQ, I_XWKV, I_XWO, I_ABWIN, I_ABMU, I_RWW0, I_RWWUP, I_RWA0, I_RWAUP, I_RWGUP, I_RWKK, I_RWKA, I_RWRK,
             I_RWLNG, I_RWLNB, I_MLCONV, I_MLBIF, I_MLNG, I_ABWOUT, I_FFG, I_FFU, I_FFD, I_FOXWIN, I_FOXBF, I_FOXQG, I_FOXKG, I_FOXWOUT, I_ROUTER, I_MOEG, I_MOEU, I_MOED, N_IN };
struct Args { const float* in[N_IN]; float* out; unsigned char* ws; int ph_lo, ph_hi; };
static_assert(sizeof(Args) == (N_IN + 2) * 8 + 8, "Args has no padding");

#define WSP(T_, off) ((T_*)(F.ws + (off)))

__device__ __forceinline__ void rms_row(const float* xrow, const float* g, bf16* orow, int lane, f32x4 (&y)[8]) {
    const f32x4* xr = (const f32x4*)xrow + lane; const f32x4* gr = (const f32x4*)g + lane;
    float s = 0.f;
#pragma unroll
    for (int j = 0; j < 8; ++j) { y[j] = xr[64 * j]; s += (y[j][0] * y[j][0] + y[j][1] * y[j][1]) + (y[j][2] * y[j][2] + y[j][3] * y[j][3]); }
    const float r = 1.0f / sqrtf(wave_sum(s) * (1.0f / D) + 1e-6f);
#pragma unroll
    for (int j = 0; j < 8; ++j) { const f32x4 gv = gr[64 * j]; y[j] = y[j] * r * gv; }
    if (orow) { u32x2* o8 = (u32x2*)orow + lane;
#pragma unroll
        for (int j = 0; j < 8; ++j) { u32x2 w; w.x = cvt_pk_bf16(y[j][0], y[j][1]); w.y = cvt_pk_bf16(y[j][2], y[j][3]); o8[64 * j] = w; } }
}
__device__ __forceinline__ void rms_load(const float* xrow, int lane, f32x4 (&x)[8]) {
    const f32x4* xr = (const f32x4*)xrow + lane;
#pragma unroll
    for (int j = 0; j < 8; ++j) x[j] = xr[64 * j];
}
__device__ __forceinline__ void rms_fin(f32x4 (&y)[8], const f32x4 (&gv)[8], bf16* orow, int lane) {
    float s = 0.f;
#pragma unroll
    for (int j = 0; j < 8; ++j) s += (y[j][0] * y[j][0] + y[j][1] * y[j][1]) + (y[j][2] * y[j][2] + y[j][3] * y[j][3]);
    const float r = 1.0f / sqrtf(wave_sum_dpp(s) * (1.0f / D) + 1e-6f);
    u32x2* o8 = (u32x2*)orow + lane;
#pragma unroll
    for (int j = 0; j < 8; ++j) { y[j] = y[j] * r * gv[j]; u32x2 w; w.x = cvt_pk_bf16(y[j][0], y[j][1]); w.y = cvt_pk_bf16(y[j][2], y[j][3]); o8[64 * j] = w; }
}
template <class Body>
__device__ __forceinline__ void rms_rows4(const float* X, const float* g, bf16* XN, int lane, int t0, int t1, int t2, int t3, Body body) {
    f32x4 gv[8], xa[8], xb[8];
#pragma unroll
    for (int j = 0; j < 8; ++j) gv[j] = ((const f32x4*)g + lane)[64 * j];
#define RR_SB() __builtin_amdgcn_sched_barrier(0)
    rms_load(X + (size_t)t0 * D, lane, xa); RR_SB(); rms_load(X + (size_t)t1 * D, lane, xb); RR_SB();
    rms_fin(xa, gv, XN + (size_t)t0 * D, lane); body(t0, xa); RR_SB(); rms_load(X + (size_t)t2 * D, lane, xa); RR_SB();
    rms_fin(xb, gv, XN + (size_t)t1 * D, lane); body(t1, xb); RR_SB(); rms_load(X + (size_t)t3 * D, lane, xb); RR_SB();
    rms_fin(xa, gv, XN + (size_t)t2 * D, lane); body(t2, xa); RR_SB();
    rms_fin(xb, gv, XN + (size_t)t3 * D, lane); body(t3, xb);
#undef RR_SB
}
__device__ __forceinline__ void norm_phase(const Frame& F, const float* X, const float* g, bf16* XN, int nrows) {
    if (nrows == 4 * F.NGW) { rms_rows4(X, g, XN, F.lane, F.gw, F.gw + F.NGW, F.gw + 2 * F.NGW, F.gw + 3 * F.NGW, [](int, f32x4 (&)[8]) {}); return; }
    for (int t = F.gw; t < nrows; t += F.NGW) { f32x4 y[8]; rms_row(X + (size_t)t * D, g, XN + (size_t)t * D, F.lane, y); }
}
template <int NC>
__device__ __forceinline__ void stage_skinny(const Frame& F, const float* W, int ldw, int c0, LAS float* Ws) {
    constexpr int Q = NC / 4, PER = D * Q / (NWAVES * 64);
    f32x4 r[PER];
#pragma unroll
    for (int k = 0; k < PER; ++k) { const int idx = F.tid + NWAVES * 64 * k, e = idx / Q, q = idx % Q; r[k] = *(const f32x4*)(W + (size_t)e * ldw + c0 + 4 * q); }
#pragma unroll
    for (int k = 0; k < PER; ++k) { const int idx = F.tid + NWAVES * 64 * k, e = idx / Q, q = idx % Q;
#pragma unroll
        for (int j = 0; j < 4; ++j) Ws[(4 * q + j) * D + e] = r[k][j]; }
}
template <int NC>
__device__ __forceinline__ void skinny_dot(const f32x4 (&y)[8], const LAS float* Ws, int lane, float (&out)[NC]) {
#pragma unroll
    for (int c = 0; c < NC; ++c) { float s = 0.f;
#pragma unroll
        for (int j = 0; j < 8; ++j) { const f32x4 w = *(const LAS f32x4*)(Ws + c * D + 256 * j + 4 * lane); s += (y[j][0] * w[0] + y[j][1] * w[1]) + (y[j][2] * w[2] + y[j][3] * w[3]); }
        out[c] = wave_sum_dpp(s); }
}

constexpr int TD_OFF = RING_OFF + 8 * 16384, TD_WORDS = 10, TD_MAX = 48;
struct TStream { LAS int* tab; int n, items; };
__device__ __forceinline__ TStream ts_begin(const Frame& F) { TStream S; S.tab = (LAS int*)(F.lds + TD_OFF); S.n = 0; S.items = 0; return S; }
__device__ __forceinline__ void ts_add(const Frame& F, TStream& S, const float* W, int ldw, int K, int N, bf16* WT, int mode) {
    const int nblk = (N + 31) / 32;
    if (F.tid == 0) { LAS int* d = S.tab + S.n * TD_WORDS; const unsigned long long w = (unsigned long long)W, t = (unsigned long long)WT;
        d[0] = (int)(unsigned)w; d[1] = (int)(unsigned)(w >> 32); d[2] = (int)(unsigned)t; d[3] = (int)(unsigned)(t >> 32); d[4] = ldw; d[5] = K; d[6] = N; d[7] = mode; d[8] = nblk; d[9] = S.items; }
    S.items += (K / 64) * nblk; ++S.n;
}
__device__ __forceinline__ int ts_u(const LAS int* p) { return __builtin_amdgcn_readfirstlane(*p); }
#define TS_GAS __attribute__((address_space(1)))
struct TItem { TS_GAS bf16* dst; int K, nvalid; };
__device__ __forceinline__ void ts_load(const LAS int* tab, int& m, int r, int lane, f32x4 (&v)[8], TItem& it) {
    while (r >= ts_u(tab + (m + 1) * TD_WORDS + 9)) ++m;
    const LAS int* d = tab + m * TD_WORDS;
    const int local = r - ts_u(d + 9), nblk = ts_u(d + 8), kb = local / nblk, n0 = 32 * (local - kb * nblk), N = ts_u(d + 6), K = ts_u(d + 5), ldw = ts_u(d + 4), mode = ts_u(d + 7);
    const TS_GAS float* W = (const TS_GAS float*)(((unsigned long long)(unsigned)ts_u(d + 1) << 32) | (unsigned long long)(unsigned)ts_u(d + 0));
    TS_GAS bf16* WT = (TS_GAS bf16*)(((unsigned long long)(unsigned)ts_u(d + 3) << 32) | (unsigned long long)(unsigned)ts_u(d + 2));
    const int nvalid = (N - n0) < 32 ? (N - n0) : 32, drow = mode == 0 ? n0 : ((n0 >> 7) * 256 + (n0 & 127) + (mode == 2 ? 128 : 0));
    it.dst = WT + (size_t)drow * K + 64 * kb; it.K = K; it.nvalid = nvalid;
    const TS_GAS float* p = W + (size_t)(64 * kb + (lane >> 3)) * ldw + n0 + 4 * (lane & 7); const bool ok = 4 * (lane & 7) < nvalid;
#pragma unroll
    for (int i = 0; i < 8; ++i) v[i] = ok ? __builtin_nontemporal_load((const TS_GAS f32x4*)(p + (size_t)(8 * i) * ldw)) : (f32x4){0.f, 0.f, 0.f, 0.f};
}
__device__ __forceinline__ void ts_finish(const f32x4 (&v)[8], const TItem& it, LAS float* scr, int lane) {
    { LAS float* w = scr + (lane >> 3) * 33 + 4 * (lane & 7);
#pragma unroll
      for (int i = 0; i < 8; ++i)
#pragma unroll
          for (int j = 0; j < 4; ++j) w[(8 * i) * 33 + j] = v[i][j]; }
    LDS_WAIT(); asm volatile("" ::: "memory");
    const int c = lane >> 3; float t[32];
#pragma unroll
    for (int j = 0; j < 4; ++j)
#pragma unroll
        for (int q = 0; q < 8; ++q) t[8 * j + q] = scr[(8 * c + q) * 33 + (lane & 7) + 8 * j];
    LDS_WAIT(); asm volatile("" ::: "memory"); __builtin_amdgcn_sched_barrier(0);
#pragma unroll
    for (int j = 0; j < 4; ++j) { const int n = (lane & 7) + 8 * j;
        u32x4 o; o.x = cvt_pk_bf16(t[8 * j], t[8 * j + 1]); o.y = cvt_pk_bf16(t[8 * j + 2], t[8 * j + 3]); o.z = cvt_pk_bf16(t[8 * j + 4], t[8 * j + 5]); o.w = cvt_pk_bf16(t[8 * j + 6], t[8 * j + 7]);
        if (n < it.nvalid) __builtin_nontemporal_store(o, (TS_GAS u32x4*)(it.dst + (size_t)n * it.K + 8 * c)); }
}
__device__ __forceinline__ void ts_run(const Frame& F, TStream& S, int gw, int NGW, LAS float* scr) {
    if (F.tid == 0) S.tab[S.n * TD_WORDS + 9] = S.items;
    __syncthreads();
    const LAS int* tab = S.tab; const int nitems = S.items, lane = F.lane;
    if (gw < nitems) {
        const int n_my = (nitems - gw + NGW - 1) / NGW; int m = 0, i = 0;
        f32x4 va[8], vb[8], vc[8]; TItem ia, ib, ic;
#define TS_LOAD(v_, it_, i_) ts_load(tab, m, gw + (i_) * NGW, lane, v_, it_)
        TS_LOAD(va, ia, 0); if (n_my > 1) TS_LOAD(vb, ib, 1);
        for (; i + 4 < n_my; i += 3) {
            TS_LOAD(vc, ic, i + 2); ts_finish(va, ia, scr, lane);
            TS_LOAD(va, ia, i + 3); ts_finish(vb, ib, scr, lane);
            TS_LOAD(vb, ib, i + 4); ts_finish(vc, ic, scr, lane);
        }
        if (i + 2 < n_my) TS_LOAD(vc, ic, i + 2);
        ts_finish(va, ia, scr, lane);
        if (i + 1 < n_my) { if (i + 3 < n_my) TS_LOAD(va, ia, i + 3); ts_finish(vb, ib, scr, lane); }
        if (i + 2 < n_my) ts_finish(vc, ic, scr, lane);
        if (i + 3 < n_my) ts_finish(va, ia, scr, lane);
#undef TS_LOAD
    }
    __syncthreads();
}
__device__ __forceinline__ void p_convert_early(const Frame& F, const Args& A) {
    LAS float* scr = (LAS float*)(F.lds + RING_OFF + F.wave * 16384);
    TStream TS = ts_begin(F);
    for (int l = 0; l < 2; ++l)
        ts_add(F, TS, A.in[I_XWKV] + (size_t)l * D * 2 * D, 2 * D, D, 2 * D, WSP(bf16, WS_W_XKV) + (size_t)l * 2 * D * D, 0);
    ts_add(F, TS, A.in[I_ABWIN], AB_COLS, D, AB_COLS, WSP(bf16, WS_W_ABIN), 0);
    for (int l = 0; l < 2; ++l) ts_add(F, TS, A.in[I_XWO] + (size_t)l * D * D, D, D, D, WSP(bf16, WS_W_XO) + (size_t)l * D * D, 0);
    ts_run(F, TS, F.gw, F.NGW, scr);
    { const f32x4* wq = (const f32x4*)A.in[I_XWQ]; u32x4* wqp = (u32x4*)WSP(bf16, WS_W_XQ); const int gt_ = F.gw * 64 + F.lane, NGT_ = F.NGW * 64;
      for (int i = gt_; i < 2 * D * D / 8; i += NGT_) { const f32x4 a = wq[2 * i], b = wq[2 * i + 1]; u32x4 o; o.x = cvt_pk_bf16(a[0], a[1]); o.y = cvt_pk_bf16(a[2], a[3]); o.z = cvt_pk_bf16(b[0], b[1]); o.w = cvt_pk_bf16(b[2], b[3]); wqp[i] = o; } }
    const int gt = F.gw * 64 + F.lane, NGT = F.NGW * 64;
    { u32x4* z = (u32x4*)(WSP(bf16, WS_W_ABIN) + (size_t)AB_COLS * D); const int n16 = (AB_PAD - AB_COLS) * D * 2 / 16;
      for (int i = gt; i < n16; i += NGT) z[i] = (u32x4){0u, 0u, 0u, 0u}; }
    { bf16* WL = WSP(bf16, WS_W_LORA); const float* wup = A.in[I_RWWUP]; const float* aup = A.in[I_RWAUP]; const float* gup = A.in[I_RWGUP];
      for (int i = gt; i < 3072 * 64; i += NGT) { const int n = i >> 6, k8 = (i & 63) * 8; const int sec = n >> 10, nn = n & 1023; float v[8];
#pragma unroll
          for (int j = 0; j < 8; ++j) { const int k = k8 + j; float x = 0.f;
              if (sec == 0) { if (k < 96) x = wup[(size_t)k * 1024 + nn]; }
              else if (sec == 1) { if (k >= 96 && k < 192) x = aup[(size_t)(k - 96) * 1024 + nn]; }
              else { if (k >= 192 && k < 448) x = gup[(size_t)(k - 192) * 1024 + nn]; }
              v[j] = x; }
          u32x4 o; o.x = cvt_pk_bf16(v[0], v[1]); o.y = cvt_pk_bf16(v[2], v[3]); o.z = cvt_pk_bf16(v[4], v[5]); o.w = cvt_pk_bf16(v[6], v[7]);
          *(u32x4*)(WL + (size_t)n * 512 + k8) = o; } }
    norm_phase(F, A.in[I_MEM], A.in[I_MEMG], WSP(bf16, WS_MEMN), NMEM);
    norm_phase(F, A.in[I_X], A.in[I_NMIXG], WSP(bf16, WS_XN), T);
}
__device__ __forceinline__ void p_convert_late(const Frame& F, const Args& A, int gw, int NGW, LAS float* scr, bool with_dense, int e_lo, int e_hi) {
    TStream TS = ts_begin(F);
    if (with_dense) {
        ts_add(F, TS, A.in[I_ABWOUT], D, D, D, WSP(bf16, WS_W_ABOUT), 0);
        ts_add(F, TS, A.in[I_FFG], DFF, D, DFF, WSP(bf16, WS_W_FFNGU), 1);
        ts_add(F, TS, A.in[I_FFU], DFF, D, DFF, WSP(bf16, WS_W_FFNGU), 2);
        ts_add(F, TS, A.in[I_FFD], D, DFF, D, WSP(bf16, WS_W_FFND), 0);
        ts_add(F, TS, A.in[I_FOXWIN], FOX_LD, D, 8192, WSP(bf16, WS_W_FOXIN), 0);
        ts_add(F, TS, A.in[I_FOXWOUT], D, D, D, WSP(bf16, WS_W_FOXOUT), 0);
    }
    for (int e = e_lo; e < e_hi; ++e) {
        ts_add(F, TS, A.in[I_MOEG] + (size_t)e * D * DFF, DFF, D, DFF, WSP(bf16, WS_W_MOEGU) + (size_t)e * 2 * DFF * D, 1);
        ts_add(F, TS, A.in[I_MOEU] + (size_t)e * D * DFF, DFF, D, DFF, WSP(bf16, WS_W_MOEGU) + (size_t)e * 2 * DFF * D, 2);
        ts_add(F, TS, A.in[I_MOED] + (size_t)e * DFF * D, D, DFF, D, WSP(bf16, WS_W_MOED) + (size_t)e * D * DFF, 0);
    }
    ts_run(F, TS, gw, NGW, scr);
}

struct InprojKvOrder {
    const bf16* xn; const bf16* wabin; const bf16* memn; const bf16* wkv; int G, c;
    __device__ __forceinline__ bool next(int i, pg8::Unit& u) const {
        const int L = i * G + c; u.pad = 0;
        if (L < 32 * (AB_PAD / 256)) { int pm, pn; pg8::static_tile(i, G, c, 32, AB_PAD / 256, pm, pn); u.pm = pm; u.pn = pn; u.aux = -1;
            u.a = (const char*)(xn + (size_t)pm * 256 * D); u.b = (const char*)(wabin + (size_t)pn * 256 * D); return true; }
        const int j = L - 32 * (AB_PAD / 256); if (j >= 32) return false;
        const int l = j >> 4, kind = (j >> 3) & 1, idx = j & 7; const bf16* w = wkv + (size_t)l * 2 * D * D;
        if (kind == 0) { u.a = (const char*)memn; u.b = (const char*)(w + (size_t)idx * 256 * D); u.pm = 0; u.pn = idx; }
        else { u.a = (const char*)memn; u.b = (const char*)(w + (size_t)(D + idx * 256) * D); u.pm = 0; u.pn = idx; }
        u.aux = l * 2 + kind; return true;
    }
};
struct EpiInprojKv {
    static constexpr bool PERM = true;
    bf16* proj; float* gates32; bf16* kmem; bf16* vtmem;
    __device__ __forceinline__ void operator()(const f32x4 (&acc)[2][2][4][2], const pg8::Unit& u, int wr, int wc, int fr, int fq) const {
        if (u.aux < 0) { pg8::EpiBf16 E{proj, AB_PAD, gates32, 29, nullptr}; E(acc, u, wr, wc, fr, fq); }
        else { const int l = u.aux >> 1, kind = u.aux & 1;
            pg8::EpiBf16 E{(kind == 0 ? kmem : vtmem) + (size_t)l * NMEM * D, D, nullptr, -1, nullptr};
            E(acc, u, wr, wc, fr, fq); }
    }
};

__device__ __forceinline__ void p_prepa(const Frame& F, const Args& A) {
    const bf16* PROJ = WSP(bf16, R_PROJ); const float* mu = A.in[I_ABMU]; const float* convw = A.in[I_MLCONV];
    bf16* LIN = WSP(bf16, R_LORAIN); bf16* QB = WSP(bf16, R_QB); bf16* KB = WSP(bf16, R_KB); bf16* VB = WSP(bf16, R_VB);
    const int lane = F.lane;
    for (int t0 = 4 * F.gw; t0 < T; t0 += 4 * F.NGW) {
        bf16x8 cr[4][7], lr[5]; u32x4 vr[4][2]; const bf16x8 zero8 = {0, 0, 0, 0, 0, 0, 0, 0};
#pragma unroll
        for (int i = 0; i < 4; ++i)
#pragma unroll
            for (int k = 0; k < 7; ++k) { const int tt = t0 - 3 + k; cr[i][k] = tt >= 0 ? *(const bf16x8*)(PROJ + (size_t)tt * AB_PAD + A_COLS + 8 * lane + 512 * i) : zero8; }
#pragma unroll
        for (int k = 0; k < 5; ++k) { const int tt = t0 - 1 + k; lr[k] = (tt >= 0 && lane < 56) ? *(const bf16x8*)(PROJ + (size_t)tt * AB_PAD + 3072 + 8 * lane) : zero8; }
#pragma unroll
        for (int k = 0; k < 4; ++k)
#pragma unroll
            for (int i = 0; i < 2; ++i) vr[k][i] = *(const u32x4*)(PROJ + (size_t)(t0 + k) * AB_PAD + 5568 + 8 * lane + 512 * i);
        __builtin_amdgcn_sched_barrier(0);
#pragma unroll
        for (int k = 0; k < 4; ++k)
#pragma unroll
            for (int i = 0; i < 2; ++i) *(u32x4*)(VB + (size_t)(t0 + k) * 1024 + 8 * lane + 512 * i) = vr[k][i];
        if (lane < 56) { const int cc = 8 * lane; float m[8];
            { const f32x4 m0 = *(const f32x4*)(mu + 3072 + cc), m1 = *(const f32x4*)(mu + 3072 + cc + 4); m[0] = m0[0]; m[1] = m0[1]; m[2] = m0[2]; m[3] = m0[3]; m[4] = m1[0]; m[5] = m1[1]; m[6] = m1[2]; m[7] = m1[3]; }
#pragma unroll
            for (int k = 0; k < 4; ++k) { float o[8];
#pragma unroll
                for (int j = 0; j < 8; ++j) { const float pv = bf2f((unsigned short)lr[k + 1][j]), pp = bf2f((unsigned short)lr[k][j]); const float sv = pv + (pp - pv) * m[j];
                    o[j] = cc < 96 ? tanhf(sv) : (cc < 192 ? sv : sigmoidf_(sv)); }
                u32x4 w; w.x = cvt_pk_bf16(o[0], o[1]); w.y = cvt_pk_bf16(o[2], o[3]); w.z = cvt_pk_bf16(o[4], o[5]); w.w = cvt_pk_bf16(o[6], o[7]);
                *(u32x4*)(LIN + (size_t)(t0 + k) * 512 + cc) = w; } }
        else {
#pragma unroll
            for (int k = 0; k < 4; ++k) *(u32x4*)(LIN + (size_t)(t0 + k) * 512 + 448 + 8 * (lane - 56)) = (u32x4){0u, 0u, 0u, 0u}; }
#pragma unroll
        for (int i = 0; i < 4; ++i) { const int c = 8 * lane + 512 * i; f32x4 w0[4], w1[4];
#pragma unroll
            for (int tap = 0; tap < 4; ++tap) { w0[tap] = *(const f32x4*)(convw + tap * 2048 + c); w1[tap] = *(const f32x4*)(convw + tap * 2048 + c + 4); }
            const float sc = c < 1024 ? 0.0625f : 1.0f;
#pragma unroll
            for (int k = 0; k < 4; ++k) { float acc[8];
#pragma unroll
                for (int j = 0; j < 8; ++j) acc[j] = 0.f;
#pragma unroll
                for (int tap = 0; tap < 4; ++tap)
#pragma unroll
                    for (int j = 0; j < 4; ++j) { acc[j] += bf2f((unsigned short)cr[i][k + tap][j]) * w0[tap][j]; acc[4 + j] += bf2f((unsigned short)cr[i][k + tap][4 + j]) * w1[tap][j]; }
                float o[8];
#pragma unroll
                for (int j = 0; j < 8; ++j) o[j] = acc[j] * sigmoidf_(acc[j]) * sc;
                u32x4 w; w.x = cvt_pk_bf16(o[0], o[1]); w.y = cvt_pk_bf16(o[2], o[3]); w.z = cvt_pk_bf16(o[4], o[5]); w.w = cvt_pk_bf16(o[6], o[7]);
                if (c < 1024) *(u32x4*)(QB + (size_t)(t0 + k) * 1024 + c) = w; else *(u32x4*)(KB + (size_t)(t0 + k) * 1024 + c - 1024) = w; } }
    }
    const float* G32 = WSP(float, R_GATES32); const float* bif = A.in[I_MLBIF];
    float* BCUM = WSP(float, WS_SMALL + SM_BCUM); float* IG = WSP(float, WS_SMALL + SM_IG); float* CHBL = WSP(float, WS_SMALL + SM_CHBL); float* CHMD = WSP(float, WS_SMALL + SM_CHMD);
    for (int u = F.gw; u < NH_M * 128; u += F.NGW) { const int h = u >> 7, c = u & 127, t = 64 * c + lane;
        const float ig = G32[(size_t)t * 256 + 192 + h] + bif[h], fg = G32[(size_t)t * 256 + 196 + h] + bif[4 + h];
        float b = logsigmoidf_(fg);
#pragma unroll
        for (int o = 1; o < 64; o <<= 1) { const float x = __shfl_up(b, o); if (lane >= o) b += x; }
        const float bl = __shfl(b, 63); const float md = wave_max(bl - b + ig);
        BCUM[h * T + t] = b; IG[h * T + t] = ig;
        if (lane == 0) { CHBL[u] = bl; CHMD[u] = md; } }
}

__device__ __forceinline__ void p_prepb(const Frame& F, const Args& A) {
    const bf16* PROJ = WSP(bf16, R_PROJ); const float* LOUT = WSP(float, R_LORAOUT); const float* mu = A.in[I_ABMU];
    const float* w0 = A.in[I_RWW0]; const float* a0 = A.in[I_RWA0]; const float* kk_ = A.in[I_RWKK]; const float* ka_ = A.in[I_RWKA]; const float* rk_ = A.in[I_RWRK];
    float* SR = WSP(float, R_SC); float* SW = WSP(float, R_SC + SC_STRIDE); float* SKM = WSP(float, R_SC + 2 * SC_STRIDE); float* SV = WSP(float, R_SC + 3 * SC_STRIDE);
    float* SKK = WSP(float, R_SC + 4 * SC_STRIDE); float* SB = WSP(float, R_SC + 5 * SC_STRIDE); float* BONUS = WSP(float, WS_SMALL + SM_BONUS);
    const int lane = F.lane;
    for (int u = F.gw; u < NH_R * (T / 64); u += F.NGW) { const int h = u & 15, tb = u >> 4, c = 64 * h + lane, t0 = 64 * tb;
        const float mur = mu[c], muk = mu[1024 + c], muv = mu[2048 + c], w0c = w0[c], a0c = a0[c], kkc = kk_[c], kac = ka_[c], rkc = rk_[c];
        float pr = 0.f, pk = 0.f, pv = 0.f;
        if (t0 > 0) { const bf16* pp = PROJ + (size_t)(t0 - 1) * AB_PAD; pr = bf2f(pp[c]); pk = bf2f(pp[1024 + c]); pv = bf2f(pp[2048 + c]); }
        constexpr int GT = 4;
        float xr[GT], xk[GT], xv[GT], lw[GT], la[GT], nr[GT], nk[GT], nv[GT], nw[GT], na[GT];
#define PB_LOAD(dr, dk, dv, dw, da, tt_) do { _Pragma("unroll") for (int i = 0; i < GT; ++i) { const bf16* p0 = PROJ + (size_t)(t0 + (tt_) + i) * AB_PAD; const float* lo = LOUT + (size_t)(t0 + (tt_) + i) * 3072; \
            dr[i] = bf2f(p0[c]); dk[i] = bf2f(p0[1024 + c]); dv[i] = bf2f(p0[2048 + c]); dw[i] = lo[c]; da[i] = lo[1024 + c]; } } while (0)
        PB_LOAD(xr, xk, xv, lw, la, 0);
        for (int tt = 0; tt < 64; tt += GT) {
            if (tt + GT < 64) PB_LOAD(nr, nk, nv, nw, na, tt + GT);
            float kk[GT], km[GT], r[GT], v[GT], a[GT], w[GT], q1[GT], q2[GT];
#pragma unroll
            for (int i = 0; i < GT; ++i) { r[i] = xr[i] + (pr - xr[i]) * mur; const float k = xk[i] + (pk - xk[i]) * muk; v[i] = xv[i] + (pv - xv[i]) * muv; pr = xr[i]; pk = xk[i]; pv = xv[i];
                w[i] = __expf(-0.6065306597126334f * sigmoidf_(lw[i] + w0c)); a[i] = sigmoidf_(a0c + la[i]);
                kk[i] = k * kkc; km[i] = k * (1.0f + (a[i] - 1.0f) * kac); q1[i] = kk[i] * kk[i]; q2[i] = r[i] * km[i] * rkc; }
#pragma unroll
            for (int i = 0; i < GT; ++i) { q1[i] = wave_sum_dpp(q1[i]); q2[i] = wave_sum_dpp(q2[i]); }
#pragma unroll
            for (int i = 0; i < GT; ++i) { const float kn = kk[i] / fmaxf(sqrtf(q1[i]), 1e-12f); const size_t o = (size_t)(t0 + tt + i) * 1024 + c;
                SR[o] = r[i]; SW[o] = w[i]; SKM[o] = km[i]; SV[o] = v[i]; SKK[o] = kn; SB[o] = kn * a[i];
                if (lane == 0) BONUS[(t0 + tt + i) * 16 + h] = q2[i]; }
#pragma unroll
            for (int i = 0; i < GT; ++i) { xr[i] = nr[i]; xk[i] = nk[i]; xv[i] = nv[i]; lw[i] = nw[i]; la[i] = na[i]; }
        }
#undef PB_LOAD
    }
    if (F.gw < NH_M) { const int h = F.gw;
        const float* BCUM = WSP(float, WS_SMALL + SM_BCUM); const float* IG = WSP(float, WS_SMALL + SM_IG); const float* CHBL = WSP(float, WS_SMALL + SM_CHBL); const float* CHMD = WSP(float, WS_SMALL + SM_CHMD);
        float* MSEQ = WSP(float, WS_SMALL + SM_MSEQ); float* WCARRY = WSP(float, WS_SMALL + SM_WCARRY);
        const float bl0 = CHBL[h * 128 + lane], bl1 = CHBL[h * 128 + 64 + lane], md0 = CHMD[h * 128 + lane], md1 = CHMD[h * 128 + 64 + lane];
        float m = 0.f, mine_in0 = 0.f, mine_in1 = 0.f, mine_out0 = 0.f, mine_out1 = 0.f;
#pragma unroll
        for (int c = 0; c < 128; ++c) { const float bl = __shfl(c < 64 ? bl0 : bl1, c & 63), md = __shfl(c < 64 ? md0 : md1, c & 63);
            const float mn = fmaxf(bl + m, md);
            if ((c & 63) == lane) { if (c < 64) { mine_in0 = m; mine_out0 = mn; } else { mine_in1 = m; mine_out1 = mn; } }
            m = mn; }
        MSEQ[h * 128 + lane] = mine_in0; MSEQ[h * 128 + 64 + lane] = mine_in1;
        WCARRY[h * 128 + lane] = __expf(bl0 + mine_in0 - mine_out0); WCARRY[h * 128 + 64 + lane] = __expf(bl1 + mine_in1 - mine_out1);
        float* MOUT = WSP(float, WS_SMALL + SM_MOUT); MOUT[h * 128 + lane] = mine_out0; MOUT[h * 128 + 64 + lane] = mine_out1;
    }
}

__device__ __forceinline__ void p_mlstm_pass2(const Frame& F, bool mine, int hh) {
    const int lane = F.lane;
    if (mine) { const int h = hh;
        const float* CHBL = WSP(float, WS_SMALL + SM_CHBL); const float* CHMD = WSP(float, WS_SMALL + SM_CHMD);
        float* MSEQ = WSP(float, WS_SMALL + SM_MSEQ); float* WCARRY = WSP(float, WS_SMALL + SM_WCARRY);
        const float bl0 = CHBL[h * 128 + lane], bl1 = CHBL[h * 128 + 64 + lane], md0 = CHMD[h * 128 + lane], md1 = CHMD[h * 128 + 64 + lane];
        float m = 0.f, mine_in0 = 0.f, mine_in1 = 0.f, mine_out0 = 0.f, mine_out1 = 0.f;
#pragma unroll
        for (int c = 0; c < 128; ++c) { const float bl = __builtin_bit_cast(float, __builtin_amdgcn_readlane(__builtin_bit_cast(int, c < 64 ? bl0 : bl1), c & 63)), md = __builtin_bit_cast(float, __builtin_amdgcn_readlane(__builtin_bit_cast(int, c < 64 ? md0 : md1), c & 63));
            const float mn = fmaxf(bl + m, md);
            if ((c & 63) == lane) { if (c < 64) { mine_in0 = m; mine_out0 = mn; } else { mine_in1 = m; mine_out1 = mn; } }
            m = mn; }
        MSEQ[h * 128 + lane] = mine_in0; MSEQ[h * 128 + 64 + lane] = mine_in1;
        WCARRY[h * 128 + lane] = __expf(bl0 + mine_in0 - mine_out0); WCARRY[h * 128 + 64 + lane] = __expf(bl1 + mine_in1 - mine_out1);
        float* MOUT = WSP(float, WS_SMALL + SM_MOUT); MOUT[h * 128 + lane] = mine_out0; MOUT[h * 128 + 64 + lane] = mine_out1;
    }
}

__device__ __forceinline__ float row16_sum(float x) {
    x += __builtin_bit_cast(float, __builtin_amdgcn_update_dpp(0, __builtin_bit_cast(int, x), 0xB1, 0xF, 0xF, true));
    x += __builtin_bit_cast(float, __builtin_amdgcn_update_dpp(0, __builtin_bit_cast(int, x), 0x4E, 0xF, 0xF, true));
    x += __builtin_bit_cast(float, __builtin_amdgcn_update_dpp(0, __builtin_bit_cast(int, x), 0x141, 0xF, 0xF, true));
    x += __builtin_bit_cast(float, __builtin_amdgcn_update_dpp(0, __builtin_bit_cast(int, x), 0x140, 0xF, 0xF, true));
    return x;
}
__device__ __forceinline__ void row16_sum2(float& a, float& b) {
#define DPPF(x, ctrl) __builtin_bit_cast(float, __builtin_amdgcn_update_dpp(0, __builtin_bit_cast(int, x), ctrl, 0xF, 0xF, true))
    a += DPPF(a, 0xB1); b += DPPF(b, 0xB1); a += DPPF(a, 0x4E); b += DPPF(b, 0x4E); a += DPPF(a, 0x141); b += DPPF(b, 0x141); a += DPPF(a, 0x140); b += DPPF(b, 0x140);
#undef DPPF
}
constexpr int SCH = 8;
constexpr int SC_VEC = SCH * 256;
constexpr int SC_BUF = 5 * SC_VEC + 1024;
constexpr int SC_NBUF = 3, SC_NSEG = 4;
constexpr int SC_LDS = SC_NSEG * SC_NBUF * SC_BUF;
constexpr int SC_PROG_OFF = SC_LDS;
constexpr int SC_TOUCH_AHEAD = 12;
__device__ __forceinline__ void row16_sum4(float& a, float& b, float& c, float& d) {
#define DPPF(x, ctrl) __builtin_bit_cast(float, __builtin_amdgcn_update_dpp(0, __builtin_bit_cast(int, x), ctrl, 0xF, 0xF, true))
    a += DPPF(a, 0xB1); b += DPPF(b, 0xB1); c += DPPF(c, 0xB1); d += DPPF(d, 0xB1); a += DPPF(a, 0x4E); b += DPPF(b, 0x4E); c += DPPF(c, 0x4E); d += DPPF(d, 0x4E);
    a += DPPF(a, 0x141); b += DPPF(b, 0x141); c += DPPF(c, 0x141); d += DPPF(d, 0x141); a += DPPF(a, 0x140); b += DPPF(b, 0x140); c += DPPF(c, 0x140); d += DPPF(d, 0x140);
#undef DPPF
}
__host__ __device__ constexpr int sc_len(int s) { return s == 0 ? 3328 : (s == 3 ? 1664 : 1600); }
__host__ __device__ constexpr int sc_tb(int s) { return s == 0 ? 0 : 3328 + (s - 1) * 1600; }
static_assert(sc_tb(3) + sc_len(3) == T, "segments cover the sequence");
__device__ __forceinline__ int sc_seg_of(int t) { return t < 3328 ? 0 : (t < 4928 ? 1 : (t < 6528 ? 2 : 3)); }
template <int SEGI>
__device__ __forceinline__ void p_scan(const Frame& F) {
    constexpr bool TR = SEGI >= 1; constexpr int TB = sc_tb(SEGI), SC_SEG = sc_len(SEGI), SC_SEG0 = sc_len(0);
    const int b = blockIdx.x, head = (b & 7) * 2 + ((b >> 3) & 1), rg = b >> 4, lane = F.lane, row = lane >> 4, j = lane & 15;
    const float* SR = WSP(float, R_SC); const float* SW = WSP(float, R_SC + SC_STRIDE); const float* SKM = WSP(float, R_SC + 2 * SC_STRIDE); const float* SV = WSP(float, R_SC + 3 * SC_STRIDE);
    const float* SKK = WSP(float, R_SC + 4 * SC_STRIDE); const float* SB = WSP(float, R_SC + 5 * SC_STRIDE);
    float* Yo = WSP(float, R_Y) + (size_t)TB * 1024; float* Zo = WSP(float, R_Z) + (size_t)(TR ? TB - SC_SEG0 : 0) * 1024;
    LAS unsigned char* lds = F.lds + RING_OFF + SEGI * SC_NBUF * SC_BUF;
    volatile LAS int* prog = (volatile LAS int*)(F.lds + RING_OFF + SC_PROG_OFF);
    const size_t goff = (size_t)TB * 1024 + (size_t)(lane >> 4) * 1024 + head * 64 + (lane & 15) * 4;
    f32x2 L0 = {0.f, 0.f}, L1 = {0.f, 0.f}, T0 = {0.f, 0.f}, T1 = {0.f, 0.f};
    if (TR) { const int i = rg * 4 + row; if ((i >> 2) == j) { const int e = i & 3; T0[0] = e == 0 ? 1.f : 0.f; T0[1] = e == 1 ? 1.f : 0.f; T1[0] = e == 2 ? 1.f : 0.f; T1[1] = e == 3 ? 1.f : 0.f; } }
#define SC_ISSUE(c_, buf_) do { const size_t t0_ = (size_t)(c_) * SCH * 1024; LAS unsigned char* d_ = lds + (buf_) * SC_BUF; \
        _Pragma("unroll") for (int q = 0; q < SCH / 4; ++q) { const size_t o_ = t0_ + (size_t)q * 4096 + goff; \
            __builtin_amdgcn_global_load_lds((const unsigned*)(SKK + o_), (LAS unsigned*)(d_ + 0 * SC_VEC + q * 1024), 16, 0, 0); \
            __builtin_amdgcn_global_load_lds((const unsigned*)(SW  + o_), (LAS unsigned*)(d_ + 1 * SC_VEC + q * 1024), 16, 0, 0); \
            __builtin_amdgcn_global_load_lds((const unsigned*)(SB  + o_), (LAS unsigned*)(d_ + 2 * SC_VEC + q * 1024), 16, 0, 0); \
            __builtin_amdgcn_global_load_lds((const unsigned*)(SR  + o_), (LAS unsigned*)(d_ + 3 * SC_VEC + q * 1024), 16, 0, 0); \
            __builtin_amdgcn_global_load_lds((const unsigned*)(SKM + o_), (LAS unsigned*)(d_ + 4 * SC_VEC + q * 1024), 16, 0, 0); } \
        { int ts_ = TB + (c_) * SCH + lane; ts_ = ts_ < T ? ts_ : T - 1; \
          __builtin_amdgcn_global_load_lds((const unsigned*)(SV + (size_t)ts_ * 1024 + head * 64 + rg * 4), (LAS unsigned*)(d_ + 5 * SC_VEC), 16, 0, 0); } } while (0)
    __builtin_amdgcn_s_setprio(3);
    constexpr int NCH = SC_SEG / SCH;
    static_assert(NCH % 2 == 0 && SC_NBUF == 3, "three-buffer pipeline, 11 loads per chunk");
    SC_ISSUE(0, 0); SC_ISSUE(1, 1);
    int buf = 0; float ykL = 0.f, ykT = 0.f; f32x2 rp0 = {0.f, 0.f}, rp1 = {0.f, 0.f};
    for (int c = 0; c < NCH; ++c) {
        if (c < NCH - 1) asm volatile("s_waitcnt vmcnt(11)" ::: "memory"); else asm volatile("s_waitcnt vmcnt(0)" ::: "memory");
        if (c + 2 < NCH) { const int nb = buf >= 1 ? buf - 1 : buf + 2; SC_ISSUE(c + 2, nb); }
        if (SEGI == 0 && lane == 0) *prog = c;
        const LAS unsigned char* d = lds + buf * SC_BUF + j * 16;
        const LAS unsigned char* dv = lds + buf * SC_BUF + 5 * SC_VEC + row * 4;
        const int jb = (c & 1) * SCH;
        f32x2 kkA, kkB, wA, wB, bA, bB, kmA, kmB, rA, rB; float vv;
#define SC_LOAD(s_) do { const f32x4 kk_ = *(const LAS f32x4*)(d + 0 * SC_VEC + (s_) * 256), w_ = *(const LAS f32x4*)(d + 1 * SC_VEC + (s_) * 256), b_ = *(const LAS f32x4*)(d + 2 * SC_VEC + (s_) * 256); \
        const f32x4 r_ = *(const LAS f32x4*)(d + 3 * SC_VEC + (s_) * 256), km_ = *(const LAS f32x4*)(d + 4 * SC_VEC + (s_) * 256); vv = *(const LAS float*)(dv + (s_) * 16); \
        kkA = (f32x2){kk_[0], kk_[1]}; kkB = (f32x2){kk_[2], kk_[3]}; wA = (f32x2){w_[0], w_[1]}; wB = (f32x2){w_[2], w_[3]}; bA = (f32x2){b_[0], b_[1]}; bB = (f32x2){b_[2], b_[3]}; \
        rA = (f32x2){r_[0], r_[1]}; rB = (f32x2){r_[2], r_[3]}; kmA = (f32x2){km_[0], km_[1]}; kmB = (f32x2){km_[2], km_[3]}; } while (0)
        SC_LOAD(0);
#pragma unroll
        for (int s = 0; s < SCH; ++s) {
            f32x2 kk0 = kkA, kk1 = kkB, w0 = wA, w1 = wB, b0 = bA, b1 = bB, r0 = rA, r1 = rB, km0 = kmA, km1 = kmB; float v_ = vv;
            asm volatile("" : "+v"(kk0), "+v"(kk1), "+v"(w0), "+v"(w1), "+v"(b0), "+v"(b1), "+v"(r0), "+v"(r1), "+v"(km0), "+v"(km1), "+v"(v_));
            if (s + 1 < SCH) { SC_LOAD(s + 1); }
            __builtin_amdgcn_sched_barrier(0);
            const int keep = (jb + s + 15) & 15;
            if (TR) {
                f32x2 tl = L0 * kk0, ul = L0 * rp0, tt = T0 * kk0, ut = T0 * rp0; tl = L1 * kk1 + tl; ul = L1 * rp1 + ul; tt = T1 * kk1 + tt; ut = T1 * rp1 + ut;
                float sl = tl[0] + tl[1], yl = ul[0] + ul[1], st = tt[0] + tt[1], yt = ut[0] + ut[1];
                row16_sum4(sl, st, yl, yt);
                ykL = (j == keep) ? yl : ykL; ykT = (j == keep) ? yt : ykT;
                if (s == 0 && jb == 0 && c >= 2) { const size_t o = (size_t)((c - 2) * SCH + j) * 1024 + head * 64 + rg * 4 + row; Yo[o] = ykL; Zo[o] = ykT; }
                L0 = L0 * w0 + (km0 * v_ - b0 * sl); L1 = L1 * w1 + (km1 * v_ - b1 * sl); T0 = T0 * w0 - b0 * st; T1 = T1 * w1 - b1 * st;
            } else {
                f32x2 tl = L0 * kk0, ul = L0 * rp0; tl = L1 * kk1 + tl; ul = L1 * rp1 + ul;
                float sl = tl[0] + tl[1], yl = ul[0] + ul[1];
                row16_sum2(sl, yl);
                ykL = (j == keep) ? yl : ykL;
                if (s == 0 && jb == 0 && c >= 2) Yo[(size_t)((c - 2) * SCH + j) * 1024 + head * 64 + rg * 4 + row] = ykL;
                L0 = L0 * w0 + (km0 * v_ - b0 * sl); L1 = L1 * w1 + (km1 * v_ - b1 * sl);
            }
            rp0 = r0; rp1 = r1;
            __builtin_amdgcn_sched_barrier(0);
        }
#undef SC_LOAD
        buf = buf == SC_NBUF - 1 ? 0 : buf + 1;
    }
    { const size_t o = (size_t)(SC_SEG - 16 + j) * 1024 + head * 64 + rg * 4 + row;
      f32x2 u = L0 * rp0; u = L1 * rp1 + u; const float us = row16_sum(u[0] + u[1]); ykL = (j == 15) ? us : ykL; Yo[o] = ykL;
      if (TR) { f32x2 ut = T0 * rp0; ut = T1 * rp1 + ut; const float ut_ = row16_sum(ut[0] + ut[1]); ykT = (j == 15) ? ut_ : ykT; Zo[o] = ykT; } }
    if (SEGI < SC_NSEG - 1) { float* p = WSP(float, WS_SMALL + SM_SLOC) + (((size_t)SEGI * 16 + head) * 64 + rg * 4 + row) * 64 + 4 * j; *(f32x4*)p = (f32x4){L0[0], L0[1], L1[0], L1[1]}; }
    if (TR && SEGI < SC_NSEG - 1) { float* p = WSP(float, WS_SMALL + SM_PEND) + (((size_t)SEGI * 16 + head) * 64 + rg * 4 + row) * 64 + 4 * j; *(f32x4*)p = (f32x4){T0[0], T0[1], T1[0], T1[1]}; }
    asm volatile("s_waitcnt vmcnt(0)" ::: "memory");
    __builtin_amdgcn_s_setprio(0);
#undef SC_ISSUE
}
__device__ __forceinline__ void p_scan_touch(const Frame& F) {
    const int b = blockIdx.x, head = (b & 7) * 2 + ((b >> 3) & 1), lane = F.lane;
    const char* base = (const char*)WSP(float, R_SC); volatile LAS int* prog = (volatile LAS int*)(F.lds + RING_OFF + SC_PROG_OFF);
    constexpr int NCH0 = sc_len(0) / SCH, LPS = SCH * 12;
    unsigned dummy = 0;
    for (int c = 0; c < NCH0; ++c) {
        for (int spin = 0; spin < (1 << 16) && c > *prog + SC_TOUCH_AHEAD; ++spin) __builtin_amdgcn_s_sleep(8);
#pragma unroll
        for (int q = 0; q < 2; ++q) { const int x = q * 64 + lane; if (x < LPS) { const int step = x / 12, arr = (x % 12) >> 1, half = x & 1;
            const char* p = base + (size_t)arr * SC_STRIDE + ((size_t)(c * SCH + step) * 1024 + head * 64 + half * 32) * 4;
            asm volatile("global_load_dword %0, %1, off" : "+v"(dummy) : "v"(p) : "memory"); } }
        if ((c & 1) == 0) { const int c2 = c >> 1;
#pragma unroll
            for (int q = 0; q < 5; ++q) { const int x = q * 64 + lane; if (x < 3 * LPS) { const int seg = 1 + x / LPS, y = x % LPS, step = y / 12, arr = (y % 12) >> 1, half = y & 1;
                if (c2 * SCH < sc_len(seg)) { const char* p = base + (size_t)arr * SC_STRIDE + ((size_t)(sc_tb(seg) + c2 * SCH + step) * 1024 + head * 64 + half * 32) * 4;
                    asm volatile("global_load_dword %0, %1, off" : "+v"(dummy) : "v"(p) : "memory"); } } } }
    }
    asm volatile("s_waitcnt vmcnt(0)" : "+v"(dummy) :: "memory");
}
__device__ __forceinline__ void p_scomb(const Frame& F) {
    const float* SLOC = WSP(float, WS_SMALL + SM_SLOC); const float* PEND = WSP(float, WS_SMALL + SM_PEND); float* SIN = WSP(float, WS_SMALL + SM_SIN); const int lane = F.lane;
    for (int u = F.gw; u < 16 * 64; u += F.NGW) { const int h = u >> 6, v = u & 63;
        float sv = SLOC[((size_t)(0 * 16 + h) * 64 + v) * 64 + lane];
        SIN[((size_t)(1 * 16 + h) * 64 + v) * 64 + lane] = sv;
#pragma unroll
        for (int s = 2; s < SC_NSEG; ++s) { float acc = SLOC[((size_t)((s - 1) * 16 + h) * 64 + v) * 64 + lane]; const float* P = PEND + ((size_t)((s - 1) * 16 + h) * 64) * 64 + lane;
#pragma unroll 8
            for (int i = 0; i < 64; ++i) acc += __builtin_bit_cast(float, __builtin_amdgcn_readlane(__builtin_bit_cast(int, sv), i)) * P[(size_t)i * 64];
            sv = acc; SIN[((size_t)(s * 16 + h) * 64 + v) * 64 + lane] = sv; } }
}

__device__ __forceinline__ void p_rwkv_post(const Frame& F, const Args& A) {
    const float* Y = WSP(float, R_Y); const float* SV = WSP(float, R_SV); const float* LOUT = WSP(float, R_LORAOUT); const float* BONUS = WSP(float, WS_SMALL + SM_BONUS);
    const float* lng = A.in[I_RWLNG]; const float* lnb = A.in[I_RWLNB]; bf16* YCAT = WSP(bf16, R_YCAT); const int lane = F.lane, ts = lane >> 4, cq = lane & 15;
    for (int u = F.gw; u < NH_R * (T / 64); u += F.NGW) { const int h = u & 15, tb = u >> 4, c = 64 * h + 4 * cq, t0 = 64 * tb;
        const f32x4 lg = *(const f32x4*)(lng + c), lb = *(const f32x4*)(lnb + c);
        f32x4 yA[4], sA[4], gA[4], yB[4], sB[4], gB[4]; float bA[4], bB[4];
#define PP_LOAD(y_, s_, g_, b_, grp_) do { _Pragma("unroll") for (int k = 0; k < 4; ++k) { const size_t t = t0 + 16 * (grp_) + 4 * k + ts; \
            y_[k] = *(const f32x4*)(Y + t * 1024 + c); s_[k] = *(const f32x4*)(SV + t * 1024 + c); g_[k] = *(const f32x4*)(LOUT + t * 3072 + 2048 + c); b_[k] = BONUS[t * 16 + h]; } } while (0)
#define PP_PROC(y_, s_, g_, b_, grp_) do { float m0 = (y_[0][0] + y_[0][1]) + (y_[0][2] + y_[0][3]), m1 = (y_[1][0] + y_[1][1]) + (y_[1][2] + y_[1][3]), \
                  m2 = (y_[2][0] + y_[2][1]) + (y_[2][2] + y_[2][3]), m3 = (y_[3][0] + y_[3][1]) + (y_[3][2] + y_[3][3]); \
            row16_sum4(m0, m1, m2, m3); \
            y_[0] = y_[0] - m0 * (1.0f / 64.0f); y_[1] = y_[1] - m1 * (1.0f / 64.0f); y_[2] = y_[2] - m2 * (1.0f / 64.0f); y_[3] = y_[3] - m3 * (1.0f / 64.0f); \
            float q0 = (y_[0][0] * y_[0][0] + y_[0][1] * y_[0][1]) + (y_[0][2] * y_[0][2] + y_[0][3] * y_[0][3]), q1 = (y_[1][0] * y_[1][0] + y_[1][1] * y_[1][1]) + (y_[1][2] * y_[1][2] + y_[1][3] * y_[1][3]), \
                  q2 = (y_[2][0] * y_[2][0] + y_[2][1] * y_[2][1]) + (y_[2][2] * y_[2][2] + y_[2][3] * y_[2][3]), q3 = (y_[3][0] * y_[3][0] + y_[3][1] * y_[3][1]) + (y_[3][2] * y_[3][2] + y_[3][3] * y_[3][3]); \
            row16_sum4(q0, q1, q2, q3); \
            const float rs_[4] = {1.0f / sqrtf(q0 * (1.0f / 64.0f) + 64e-5f), 1.0f / sqrtf(q1 * (1.0f / 64.0f) + 64e-5f), 1.0f / sqrtf(q2 * (1.0f / 64.0f) + 64e-5f), 1.0f / sqrtf(q3 * (1.0f / 64.0f) + 64e-5f)}; \
            _Pragma("unroll") for (int k = 0; k < 4; ++k) { const f32x4 o = (y_[k] * rs_[k] * lg + lb + s_[k] * b_[k]) * g_[k]; \
                u32x2 w; w.x = cvt_pk_bf16(o[0], o[1]); w.y = cvt_pk_bf16(o[2], o[3]); *(u32x2*)(YCAT + (size_t)(t0 + 16 * (grp_) + 4 * k + ts) * D + c) = w; } } while (0)
#define PP_SB() __builtin_amdgcn_sched_barrier(0)
        PP_LOAD(yA, sA, gA, bA, 0); PP_SB(); PP_LOAD(yB, sB, gB, bB, 1); PP_SB();
        PP_PROC(yA, sA, gA, bA, 0); PP_SB(); PP_LOAD(yA, sA, gA, bA, 2); PP_SB();
        PP_PROC(yB, sB, gB, bB, 1); PP_SB(); PP_LOAD(yB, sB, gB, bB, 3); PP_SB();
        PP_PROC(yA, sA, gA, bA, 2); PP_SB(); PP_PROC(yB, sB, gB, bB, 3); PP_SB();
#undef PP_SB
#undef PP_LOAD
#undef PP_PROC
    }
}

constexpr int CK = 16, NCK = T / CK;
constexpr int CK_NFR = 19;
constexpr int CKP = 65;
__device__ __forceinline__ void ck_kpos(int k, int& g, int& kq, int& j) { g = k >> 5; const int kl = k & 31; if (kl < 16) { kq = kl >> 2; j = kl & 3; } else { kq = (kl - 16) >> 2; j = 4 + (kl & 3); } }

__device__ __forceinline__ void p_rwkv_chunk(const Frame& F, const Args& A) {
    const bf16* PROJ = WSP(bf16, R_PROJ); const float* LOUT = WSP(float, R_LORAOUT); const float* mu = A.in[I_ABMU];
    const float* w0 = A.in[I_RWW0]; const float* a0 = A.in[I_RWA0]; const float* kk_ = A.in[I_RWKK]; const float* ka_ = A.in[I_RWKA]; const float* rk_ = A.in[I_RWRK];
    float* SV = WSP(float, R_SV); float* BONUS = WSP(float, WS_SMALL + SM_BONUS); unsigned char* FR = WSP(unsigned char, R_FR);
    LAS float* L = (LAS float*)(F.lds + RING_OFF);
    LAS float* sA = L; LAS float* sP = L + 16 * CKP; LAS float* sB = L + 2 * 16 * CKP; LAS float* sKM = L + 3 * 16 * CKP; LAS float* sRH = L + 4 * 16 * CKP;
    LAS float* sCS = L + 5 * 16 * CKP; LAS float* sDM = L + 6 * 16 * CKP; LAS float* sCL = L + 7 * 16 * CKP; LAS float* sDL = L + 8 * 16 * CKP; LAS float* sV = L + 9 * 16 * CKP;
    LAS float* sAn = L + 10 * 16 * CKP; LAS float* sRn = L + 11 * 16 * CKP;
    LAS float* sU = L + 12 * 16 * CKP;
    LAS float* sAP = sU + 4 * 16 * 17;
    LAS float* sDP = sAP + 64 * 17;
    LAS float* sPL = sDP + 16 * 17;
    LAS bf16* sFR = (LAS bf16*)(sPL + 64);
    static_assert(((12 * 16 * CKP + 4 * 16 * 17 + 64 * 17 + 16 * 17 + 64) * 4) % 16 == 0, "fragment image alignment");
    const int tid = F.tid, lane = F.lane, wave = F.wave;
    for (int i = tid; i < CK_NFR * 512; i += NWAVES * 64) sFR[i] = 0;
    __syncthreads();
    const int upb = (NH_R * NCK) / F.G;
    const int r32 = lane & 31, hg = lane >> 5;
    float xr[3], xk[3], xv[3], lw[2], la[2], pm[8];
#define CK_LOAD(u_) do { const int c_ = (u_) >> 4, h_ = (u_) & 15, ch_ = 64 * h_ + lane, ta_ = c_ * CK + 2 * wave; \
        pm[0] = mu[ch_]; pm[1] = mu[1024 + ch_]; pm[2] = mu[2048 + ch_]; pm[3] = w0[ch_]; pm[4] = a0[ch_]; pm[5] = kk_[ch_]; pm[6] = ka_[ch_]; pm[7] = rk_[ch_]; \
        if (ta_ > 0) { const bf16* pp = PROJ + (size_t)(ta_ - 1) * AB_PAD; xr[0] = bf2f(pp[ch_]); xk[0] = bf2f(pp[1024 + ch_]); xv[0] = bf2f(pp[2048 + ch_]); } else { xr[0] = 0.f; xk[0] = 0.f; xv[0] = 0.f; } \
        _Pragma("unroll") for (int i = 0; i < 2; ++i) { const bf16* p0 = PROJ + (size_t)(ta_ + i) * AB_PAD; const float* lo = LOUT + (size_t)(ta_ + i) * 3072; \
            xr[1 + i] = bf2f(p0[ch_]); xk[1 + i] = bf2f(p0[1024 + ch_]); xv[1 + i] = bf2f(p0[2048 + ch_]); lw[i] = lo[ch_]; la[i] = lo[1024 + ch_]; } } while (0)
    CK_LOAD(F.vcu * upb);
    for (int ui = 0; ui < upb; ++ui) { const int u = F.vcu * upb + ui, c = u >> 4, h = u & 15, t0 = c * CK;
        { const int ch = 64 * h + lane; const int ta = t0 + 2 * wave; float pr = xr[0], pk = xk[0], pv = xv[0];
#pragma unroll
          for (int i = 0; i < 2; ++i) { const int t = ta + i, tl = 2 * wave + i;
              const float r = xr[1 + i] + (pr - xr[1 + i]) * pm[0], k = xk[1 + i] + (pk - xk[1 + i]) * pm[1], v = xv[1 + i] + (pv - xv[1 + i]) * pm[2]; pr = xr[1 + i]; pk = xk[1 + i]; pv = xv[1 + i];
              const float w = __expf(-0.6065306597126334f * sigmoidf_(lw[i] + pm[3])), a = sigmoidf_(pm[4] + la[i]);
              float kk = k * pm[5]; const float km = k * (1.0f + (a - 1.0f) * pm[6]);
              const float q1 = wave_sum_dpp(kk * kk), q2 = wave_sum_dpp(r * km * pm[7]);
              kk = kk / fmaxf(sqrtf(q1), 1e-12f);
              sA[tl * CKP + lane] = kk; sP[tl * CKP + lane] = w; sB[tl * CKP + lane] = kk * a; sKM[tl * CKP + lane] = km; sRH[tl * CKP + lane] = r; sV[tl * CKP + lane] = v;
              SV[(size_t)t * 1024 + ch] = v; if (lane == 0) BONUS[t * 16 + h] = q2; } }
        if (ui + 1 < upb) CK_LOAD(u + 1);
        __syncthreads();
        { const int k = tid & 63;
#pragma unroll
          for (int q = 0; q < 2; ++q) { const int t = (tid >> 6) * 2 + q; float Pp = 1.f, P = 1.f, PL = 1.f;
#pragma unroll
              for (int i = 0; i < CK; ++i) { const float wv = sP[i * CKP + k]; PL *= wv; if (i < t) Pp *= wv; if (i <= t) P *= wv; }
              const float inv = 1.0f / P, ratio = PL * inv, kkv = sA[t * CKP + k], bv = sB[t * CKP + k], kmv = sKM[t * CKP + k], rv = sRH[t * CKP + k];
              sCS[t * CKP + k] = bv * inv; sDM[t * CKP + k] = kmv * inv; sCL[t * CKP + k] = bv * ratio; sDL[t * CKP + k] = kmv * ratio;
              sAn[t * CKP + k] = Pp * kkv; sRn[t * CKP + k] = P * rv; if (t == 0) sPL[k] = PL; } }
        if (tid >= 64 && tid < 64 + 128) { const int x = tid - 64, vq = x >> 5, ln = x & 31, n = ln & 15, kq = ln >> 4; u32x4 o; float vv[8];
#pragma unroll
            for (int j = 0; j < 8; ++j) vv[j] = sV[(8 * kq + j) * CKP + 16 * vq + n];
            o.x = cvt_pk_bf16(vv[0], vv[1]); o.y = cvt_pk_bf16(vv[2], vv[3]); o.z = cvt_pk_bf16(vv[4], vv[5]); o.w = cvt_pk_bf16(vv[6], vv[7]);
            *(LAS u32x4*)(sFR + (15 + vq) * 512 + (n + 16 * kq) * 8) = o; }
        __syncthreads();
        if (wave == 0) { const LAS float* ar = (r32 < 16 ? sCS + r32 * CKP : sDM + (r32 - 16) * CKP); const LAS float* br = (r32 < 16 ? sAn + r32 * CKP : sRn + (r32 - 16) * CKP); f32x16 acc = f32x16{};
#pragma unroll
            for (int ks = 0; ks < 4; ++ks) { float av[8], bv[8];
#pragma unroll
                for (int j = 0; j < 8; ++j) { av[j] = ar[16 * ks + 8 * hg + j]; bv[j] = br[16 * ks + 8 * hg + j]; }
                u32x4 pa, pb; pa.x = cvt_pk_bf16(av[0], av[1]); pa.y = cvt_pk_bf16(av[2], av[3]); pa.z = cvt_pk_bf16(av[4], av[5]); pa.w = cvt_pk_bf16(av[6], av[7]);
                pb.x = cvt_pk_bf16(bv[0], bv[1]); pb.y = cvt_pk_bf16(bv[2], bv[3]); pb.z = cvt_pk_bf16(bv[4], bv[5]); pb.w = cvt_pk_bf16(bv[6], bv[7]);
                acc = __builtin_amdgcn_mfma_f32_32x32x16_bf16(__builtin_bit_cast(bf16x8, pa), __builtin_bit_cast(bf16x8, pb), acc, 0, 0, 0); }
#pragma unroll
            for (int q = 0; q < 16; ++q) { const int row = (q & 3) + 8 * (q >> 2) + 4 * hg, col = r32, mat = (row >> 4) + 2 * (col >> 4), i = row & 15, t = col & 15;
                const bool keep = (mat & 2) ? (i <= t) : (i < t); sU[mat * 16 * 17 + i * 17 + t] = keep ? acc[q] : 0.f; } }
        __syncthreads();
        if (tid < 80) { float x[CK]; const bool isA = tid < 64; const int ri = isA ? tid : tid - 64;
#pragma unroll
            for (int t = 0; t < CK; ++t) x[t] = isA ? sAn[t * CKP + ri] : sU[1 * 16 * 17 + ri * 17 + t];
#pragma unroll
            for (int jx = 0; jx < CK - 1; ++jx) { float urow[CK];
#pragma unroll
                for (int t = 0; t < CK; ++t) if (t > jx) urow[t] = sU[jx * 17 + t];
#pragma unroll
                for (int t = 0; t < CK; ++t) if (t > jx) x[t] -= x[jx] * urow[t]; }
            LAS float* dst = isA ? sAP + ri * 17 : sDP + ri * 17;
#pragma unroll
            for (int t = 0; t < CK; ++t) dst[t] = x[t]; }
        __syncthreads();
        {
#define CK_PACK(v_) ({ u32x4 p_; p_.x = cvt_pk_bf16(v_[0], v_[1]); p_.y = cvt_pk_bf16(v_[2], v_[3]); p_.z = cvt_pk_bf16(v_[4], v_[5]); p_.w = cvt_pk_bf16(v_[6], v_[7]); __builtin_bit_cast(bf16x8, p_); })
          if (wave < 4) {
              const int kr = 32 * (wave >> 1) + r32, kc = 32 * (wave & 1) + r32; float av[8], bv[8];
#pragma unroll
              for (int j = 0; j < 8; ++j) { av[j] = sAP[kr * 17 + 8 * hg + j]; bv[j] = sCL[(8 * hg + j) * CKP + kc]; }
              f32x16 acc = __builtin_amdgcn_mfma_f32_32x32x16_bf16(CK_PACK(av), CK_PACK(bv), f32x16{}, 0, 0, 0);
              const float pl = sPL[kc]; const int ktp = kc >> 4, ii = kc & 15;
#pragma unroll
              for (int q = 0; q < 16; ++q) { const int k = 32 * (wave >> 1) + (q & 3) + 8 * (q >> 2) + 4 * hg; const float m = ((k == kc) ? pl : 0.f) - acc[q];
                  int g, kq, j; ck_kpos(k, g, kq, j); sFR[(ktp * 2 + g) * 512 + (ii + 16 * kq) * 8 + j] = f2bf(m); }
          } else if (wave < 6) {
              const int kc = 32 * (wave - 4) + r32; float av[8], bv[8];
#pragma unroll
              for (int j = 0; j < 8; ++j) { av[j] = r32 < 16 ? sDP[r32 * 17 + 8 * hg + j] : 0.f; bv[j] = sCL[(8 * hg + j) * CKP + kc]; }
              f32x16 acc = __builtin_amdgcn_mfma_f32_32x32x16_bf16(CK_PACK(av), CK_PACK(bv), f32x16{}, 0, 0, 0);
              const int ktp = kc >> 4, ii = kc & 15;
#pragma unroll
              for (int q = 0; q < 8; ++q) { const int t = (q & 3) + 8 * (q >> 2) + 4 * hg; const float nv = sDL[t * CKP + kc] - acc[q];
                  sFR[(8 + ktp) * 512 + (ii + 16 * (t >> 3)) * 8 + (t & 7)] = f2bf(nv); }
          } else {
              const int kr = 32 * (wave - 6) + r32; float av[8], bv[8];
#pragma unroll
              for (int j = 0; j < 8; ++j) { av[j] = sAP[kr * 17 + 8 * hg + j]; bv[j] = r32 < 16 ? sU[2 * 16 * 17 + (8 * hg + j) * 17 + r32] : 0.f; }
              f32x16 acc = __builtin_amdgcn_mfma_f32_32x32x16_bf16(CK_PACK(av), CK_PACK(bv), f32x16{}, 0, 0, 0);
              if (r32 < 16) { const int t = r32;
#pragma unroll
                  for (int q = 0; q < 16; ++q) { const int k = 32 * (wave - 6) + (q & 3) + 8 * (q >> 2) + 4 * hg; const float rv = sRn[t * CKP + k] - acc[q];
                      int g, kq, j; ck_kpos(k, g, kq, j); sFR[(12 + g) * 512 + (t + 16 * kq) * 8 + j] = f2bf(rv); } }
              if (wave == 7) {
                  float ev[8];
#pragma unroll
                  for (int j = 0; j < 8; ++j) ev[j] = r32 < 16 ? sDP[r32 * 17 + 8 * hg + j] : 0.f;
                  f32x16 ae = __builtin_amdgcn_mfma_f32_32x32x16_bf16(CK_PACK(ev), CK_PACK(bv), f32x16{}, 0, 0, 0);
                  if (r32 < 16) { const int t = r32;
#pragma unroll
                      for (int q = 0; q < 8; ++q) { const int i = (q & 3) + 8 * (q >> 2) + 4 * hg; const float e = sU[3 * 16 * 17 + i * 17 + t] - ae[q];
                          sFR[14 * 512 + (t + 16 * (i >> 3)) * 8 + (i & 7)] = f2bf(e); } } } }
#undef CK_PACK
        }
        __syncthreads();
        { u32x4* dst = (u32x4*)(FR + ((size_t)(h * NCK + c) * CK_NFR) * 1024); const LAS u32x4* src = (const LAS u32x4*)sFR;
          for (int i = tid; i < CK_NFR * 64; i += NWAVES * 64) dst[i] = src[i]; }
        __syncthreads();
    }
#undef CK_LOAD
}

constexpr int CK2_FLOATS = 9 * 16 * CKP + 4 * 16 * 17 + 64 * 17 + 16 * 17 + 64;
constexpr int CK2_BYTES = CK2_FLOATS * 4 + CK_NFR * 1024;
static_assert((CK2_FLOATS * 4) % 16 == 0 && CK2_BYTES % 16 == 0 && 2 * CK2_BYTES <= RING_BYTES, "two pre-pass groups fit the LDS ring");
__device__ __forceinline__ void p_rwkv_chunk2(const Frame& F, const Args& A, int pw, int NPW) {
    const bf16* PROJ = WSP(bf16, R_PROJ); const float* LOUT = WSP(float, R_LORAOUT); const float* mu = A.in[I_ABMU];
    const float* w0 = A.in[I_RWW0]; const float* a0 = A.in[I_RWA0]; const float* kk_ = A.in[I_RWKK]; const float* ka_ = A.in[I_RWKA]; const float* rk_ = A.in[I_RWRK];
    float* SV = WSP(float, R_SV); float* BONUS = WSP(float, WS_SMALL + SM_BONUS); unsigned char* FR = WSP(unsigned char, R_FR);
    const int tid = F.tid, lane = F.lane, grp = F.wave >> 2, wl = F.wave & 3, ltid = tid & 255, r32 = lane & 31, hg = lane >> 5;
    LAS float* L = (LAS float*)(F.lds + RING_OFF + grp * CK2_BYTES);
    LAS float* sA = L; LAS float* sP = L + 16 * CKP; LAS float* sB = L + 2 * 16 * CKP; LAS float* sKM = L + 3 * 16 * CKP; LAS float* sRH = L + 4 * 16 * CKP;
    LAS float* sCS = L + 5 * 16 * CKP; LAS float* sDM = L + 6 * 16 * CKP; LAS float* sCL = L + 7 * 16 * CKP; LAS float* sDL = L + 8 * 16 * CKP;
    LAS float* sU = L + 9 * 16 * CKP; LAS float* sAP = sU + 4 * 16 * 17; LAS float* sDP = sAP + 64 * 17; LAS float* sPL = sDP + 16 * 17; LAS bf16* sFR = (LAS bf16*)(sPL + 64);
    for (int i = ltid; i < CK_NFR * 512; i += 256) sFR[i] = 0;
    __syncthreads();
    unsigned* FLAG = (unsigned*)(F.ws + WS_CTL + CTL_FRFLAG); constexpr int NPAIR = NH_R * NCK / 2;
    float xr[5], xk[5], xv[5], lw[4], la[4], pm[8];
#define CK_LOAD(u_) do { const int c_ = (u_) >> 4, h_ = (u_) & 15, ch_ = 64 * h_ + lane, ta_ = c_ * CK + 4 * wl; \
        pm[0] = mu[ch_]; pm[1] = mu[1024 + ch_]; pm[2] = mu[2048 + ch_]; pm[3] = w0[ch_]; pm[4] = a0[ch_]; pm[5] = kk_[ch_]; pm[6] = ka_[ch_]; pm[7] = rk_[ch_]; \
        if (ta_ > 0) { const bf16* pp = PROJ + (size_t)(ta_ - 1) * AB_PAD; xr[0] = bf2f(pp[ch_]); xk[0] = bf2f(pp[1024 + ch_]); xv[0] = bf2f(pp[2048 + ch_]); } else { xr[0] = 0.f; xk[0] = 0.f; xv[0] = 0.f; } \
        _Pragma("unroll") for (int i = 0; i < 4; ++i) { const bf16* p0 = PROJ + (size_t)(ta_ + i) * AB_PAD; const float* lo = LOUT + (size_t)(ta_ + i) * 3072; \
            xr[1 + i] = bf2f(p0[ch_]); xk[1 + i] = bf2f(p0[1024 + ch_]); xv[1 + i] = bf2f(p0[2048 + ch_]); lw[i] = lo[ch_]; la[i] = lo[1024 + ch_]; } } while (0)
#define CK_PACK(v_) ({ u32x4 p_; p_.x = cvt_pk_bf16(v_[0], v_[1]); p_.y = cvt_pk_bf16(v_[2], v_[3]); p_.z = cvt_pk_bf16(v_[4], v_[5]); p_.w = cvt_pk_bf16(v_[6], v_[7]); __builtin_bit_cast(bf16x8, p_); })
    if (pw < NPAIR) CK_LOAD(2 * pw + grp);
    for (int pair = pw; pair < NPAIR; pair += NPW) { const int u = 2 * pair + grp, c = u >> 4, h = u & 15, t0 = c * CK;
        { const int ch = 64 * h + lane; const int ta = t0 + 4 * wl; float pr = xr[0], pk = xk[0], pv = xv[0];
#pragma unroll
          for (int i = 0; i < 4; ++i) { const int t = ta + i, tl = 4 * wl + i;
              const float r = xr[1 + i] + (pr - xr[1 + i]) * pm[0], k = xk[1 + i] + (pk - xk[1 + i]) * pm[1], v = xv[1 + i] + (pv - xv[1 + i]) * pm[2]; pr = xr[1 + i]; pk = xk[1 + i]; pv = xv[1 + i];
              const float w = __expf(-0.6065306597126334f * sigmoidf_(lw[i] + pm[3])), a = sigmoidf_(pm[4] + la[i]);
              float kk = k * pm[5]; const float km = k * (1.0f + (a - 1.0f) * pm[6]);
              const float q1 = wave_sum_dpp(kk * kk), q2 = wave_sum_dpp(r * km * pm[7]);
              kk = kk / fmaxf(sqrtf(q1), 1e-12f);
              sA[tl * CKP + lane] = kk; sP[tl * CKP + lane] = w; sB[tl * CKP + lane] = kk * a; sKM[tl * CKP + lane] = km; sRH[tl * CKP + lane] = r;
              sFR[(15 + (lane >> 4)) * 512 + ((lane & 15) + 16 * (tl >> 3)) * 8 + (tl & 7)] = f2bf(v);
              SV[(size_t)t * 1024 + ch] = v; if (lane == 0) BONUS[t * 16 + h] = q2; } }
        if (pair + NPW < NPAIR) CK_LOAD(u + 2 * NPW);
        __syncthreads();
        { const int k = ltid & 63;
#pragma unroll
          for (int q = 0; q < 4; ++q) { const int t = (ltid >> 6) * 4 + q; float Pp = 1.f, P = 1.f, PL = 1.f;
#pragma unroll
              for (int i = 0; i < CK; ++i) { const float wv = sP[i * CKP + k]; PL *= wv; if (i < t) Pp *= wv; if (i <= t) P *= wv; }
              const float inv = 1.0f / P, ratio = PL * inv, kkv = sA[t * CKP + k], bv = sB[t * CKP + k], kmv = sKM[t * CKP + k], rv = sRH[t * CKP + k];
              sCS[t * CKP + k] = bv * inv; sDM[t * CKP + k] = kmv * inv; sCL[t * CKP + k] = bv * ratio; sDL[t * CKP + k] = kmv * ratio;
              sA[t * CKP + k] = Pp * kkv; sRH[t * CKP + k] = P * rv; if (t == 0) sPL[k] = PL; } }
        __syncthreads();
        if (wl == 0) { const LAS float* ar = (r32 < 16 ? sCS + r32 * CKP : sDM + (r32 - 16) * CKP); const LAS float* br = (r32 < 16 ? sA + r32 * CKP : sRH + (r32 - 16) * CKP); f32x16 acc = f32x16{};
#pragma unroll
            for (int ks = 0; ks < 4; ++ks) { float av[8], bv[8];
#pragma unroll
                for (int j = 0; j < 8; ++j) { av[j] = ar[16 * ks + 8 * hg + j]; bv[j] = br[16 * ks + 8 * hg + j]; }
                acc = __builtin_amdgcn_mfma_f32_32x32x16_bf16(CK_PACK(av), CK_PACK(bv), acc, 0, 0, 0); }
#pragma unroll
            for (int q = 0; q < 16; ++q) { const int row = (q & 3) + 8 * (q >> 2) + 4 * hg, col = r32, mat = (row >> 4) + 2 * (col >> 4), i = row & 15, t = col & 15;
                const bool keep = (mat & 2) ? (i <= t) : (i < t); sU[mat * 16 * 17 + i * 17 + t] = keep ? acc[q] : 0.f; } }
        __syncthreads();
        if (ltid < 80) { float x[CK]; const bool isA = ltid < 64; const int ri = isA ? ltid : ltid - 64;
#pragma unroll
            for (int t = 0; t < CK; ++t) x[t] = isA ? sA[t * CKP + ri] : sU[1 * 16 * 17 + ri * 17 + t];
#pragma unroll
            for (int jx = 0; jx < CK - 1; ++jx) { float urow[CK];
#pragma unroll
                for (int t = 0; t < CK; ++t) if (t > jx) urow[t] = sU[jx * 17 + t];
#pragma unroll
                for (int t = 0; t < CK; ++t) if (t > jx) x[t] -= x[jx] * urow[t]; }
            LAS float* dst = isA ? sAP + ri * 17 : sDP + ri * 17;
#pragma unroll
            for (int t = 0; t < CK; ++t) dst[t] = x[t]; }
        __syncthreads();
        { { const int kr = 32 * (wl >> 1) + r32, kc = 32 * (wl & 1) + r32; float av[8], bv[8];
#pragma unroll
            for (int j = 0; j < 8; ++j) { av[j] = sAP[kr * 17 + 8 * hg + j]; bv[j] = sCL[(8 * hg + j) * CKP + kc]; }
            const f32x16 acc = __builtin_amdgcn_mfma_f32_32x32x16_bf16(CK_PACK(av), CK_PACK(bv), f32x16{}, 0, 0, 0);
            const float pl = sPL[kc]; const int ktp = kc >> 4, ii = kc & 15;
#pragma unroll
            for (int q = 0; q < 16; ++q) { const int k = 32 * (wl >> 1) + (q & 3) + 8 * (q >> 2) + 4 * hg; const float m = ((k == kc) ? pl : 0.f) - acc[q];
                int g, kq, j; ck_kpos(k, g, kq, j); sFR[(ktp * 2 + g) * 512 + (ii + 16 * kq) * 8 + j] = f2bf(m); } }
          if (wl < 2) {
              const int kc = 32 * wl + r32; float av[8], bv[8];
#pragma unroll
              for (int j = 0; j < 8; ++j) { av[j] = r32 < 16 ? sDP[r32 * 17 + 8 * hg + j] : 0.f; bv[j] = sCL[(8 * hg + j) * CKP + kc]; }
              const f32x16 acc = __builtin_amdgcn_mfma_f32_32x32x16_bf16(CK_PACK(av), CK_PACK(bv), f32x16{}, 0, 0, 0);
              const int ktp = kc >> 4, ii = kc & 15;
#pragma unroll
              for (int q = 0; q < 8; ++q) { const int t = (q & 3) + 8 * (q >> 2) + 4 * hg; const float nv = sDL[t * CKP + kc] - acc[q];
                  sFR[(8 + ktp) * 512 + (ii + 16 * (t >> 3)) * 8 + (t & 7)] = f2bf(nv); }
          } else {
              const int kr = 32 * (wl - 2) + r32; float av[8], bv[8];
#pragma unroll
              for (int j = 0; j < 8; ++j) { av[j] = sAP[kr * 17 + 8 * hg + j]; bv[j] = r32 < 16 ? sU[2 * 16 * 17 + (8 * hg + j) * 17 + r32] : 0.f; }
              const f32x16 acc = __builtin_amdgcn_mfma_f32_32x32x16_bf16(CK_PACK(av), CK_PACK(bv), f32x16{}, 0, 0, 0);
              if (r32 < 16) { const int t = r32;
#pragma unroll
                  for (int q = 0; q < 16; ++q) { const int k = 32 * (wl - 2) + (q & 3) + 8 * (q >> 2) + 4 * hg; const float rv = sRH[t * CKP + k] - acc[q];
                      int g, kq, j; ck_kpos(k, g, kq, j); sFR[(12 + g) * 512 + (t + 16 * kq) * 8 + j] = f2bf(rv); } }
              if (wl == 3) {
                  float ev[8];
#pragma unroll
                  for (int j = 0; j < 8; ++j) ev[j] = r32 < 16 ? sDP[r32 * 17 + 8 * hg + j] : 0.f;
                  const f32x16 ae = __builtin_amdgcn_mfma_f32_32x32x16_bf16(CK_PACK(ev), CK_PACK(bv), f32x16{}, 0, 0, 0);
                  if (r32 < 16) { const int t = r32;
#pragma unroll
                      for (int q = 0; q < 8; ++q) { const int i = (q & 3) + 8 * (q >> 2) + 4 * hg; const float e = sU[3 * 16 * 17 + i * 17 + t] - ae[q];
                          sFR[14 * 512 + (t + 16 * (i >> 3)) * 8 + (i & 7)] = f2bf(e); } } } } }
        __syncthreads();
        { unsigned char* dst = FR + ((size_t)(h * NCK + c) * CK_NFR) * 1024; const LAS u32x4* src = (const LAS u32x4*)sFR;
          for (int i = ltid; i < CK_NFR * 64; i += 256) { const u32x4 v = src[i]; asm volatile("global_store_dwordx4 %0, %1, off sc1\n\ts_nop 1" :: "v"(dst + (size_t)i * 16), "v"(v) : "memory"); } }
        asm volatile("s_waitcnt vmcnt(0)" ::: "memory");
        __syncthreads();
        if (ltid == 0) __hip_atomic_store(FLAG + h * NCK + c, 1u, __ATOMIC_RELAXED, __HIP_MEMORY_SCOPE_AGENT);
    }
#undef CK_LOAD
#undef CK_PACK
}

constexpr int SQ_SLOT = CK_NFR * 1024, SQ_NSLOT = 8, SQ_AHEAD = 7, SQ_TOUCH = 24;
constexpr bool SQ_TOUCH_ON = false;
static_assert(SQ_SLOT * SQ_NSLOT <= RING_BYTES, "fragment ring fits the LDS ring");
__device__ __forceinline__ void p_rwkv_seq(const Frame& F) {
    const int head = blockIdx.x, vq = F.wave & 3, lane = F.lane, n = lane & 15, q = lane >> 4; const bool worker = F.wave < 4;
    const unsigned char* FRh = WSP(unsigned char, R_FR) + (size_t)head * NCK * CK_NFR * 1024 + lane * 16; float* Y = WSP(float, R_Y) + head * 64 + vq * 16 + n;
    LAS unsigned char* lds = F.lds + RING_OFF;
    const unsigned* FLG = (const unsigned*)(F.ws + WS_CTL + CTL_FRFLAG) + head * NCK; int ready = 0;
#define SQ_NEED(c_) do { while (ready <= (c_)) { const int i_ = ready + lane; unsigned f_ = 0u; if (i_ < NCK) f_ = __hip_atomic_load(FLG + i_, __ATOMIC_RELAXED, __HIP_MEMORY_SCOPE_AGENT); \
        const unsigned long long b_ = __ballot(f_ != 0u); const int n_ = (b_ == ~0ull) ? 64 : (int)__builtin_ctzll(~b_); ready = __builtin_amdgcn_readfirstlane(ready + n_); \
        if (n_ == 0) __builtin_amdgcn_s_sleep(16); else __builtin_amdgcn_fence(__ATOMIC_ACQUIRE, "agent"); } } while (0)
#define SQ_ISSUE(c_, s_) do { const unsigned char* g_ = FRh + (size_t)(c_) * CK_NFR * 1024; LAS unsigned char* d_ = lds + (s_) * SQ_SLOT; \
        _Pragma("unroll") for (int f = 0; f < 5; ++f) if (vq + 4 * f < CK_NFR) __builtin_amdgcn_global_load_lds((const unsigned*)(g_ + (vq + 4 * f) * 1024), (LAS unsigned*)(d_ + (vq + 4 * f) * 1024), 16, 0, 0); } while (0)
#define SQ_READ(dst, s_) do { const LAS unsigned char* d_ = lds + (s_) * SQ_SLOT + lane * 16; _Pragma("unroll") for (int f = 0; f < 15; ++f) dst[f] = *(const LAS bf16x8*)(d_ + f * 1024); \
        dst[15] = *(const LAS bf16x8*)(d_ + (15 + vq) * 1024); } while (0)
#define SQ_STEP(cur, nxt, c_) do { \
        if (worker) { if ((c_) + SQ_AHEAD >= NCK) asm volatile("s_waitcnt vmcnt(0)" ::: "memory"); else if (vq == 3) asm volatile("s_waitcnt vmcnt(44)" ::: "memory"); else asm volatile("s_waitcnt vmcnt(49)" ::: "memory"); }     \
        else if (SQ_TOUCH_ON && F.wave == 4 && (c_) + SQ_TOUCH < NCK) { const unsigned char* g_ = FRh - lane * 16 + (size_t)((c_) + SQ_TOUCH) * CK_NFR * 1024 + lane * 128; \
            _Pragma("unroll") for (int i_ = 0; i_ < 3; ++i_) if (i_ * 64 + lane < CK_NFR * 8) asm volatile("global_load_dword %0, %1, off" : "+v"(dummy) : "v"(g_ + i_ * 8192) : "memory"); }     \
        __builtin_amdgcn_s_barrier();                                                       \
        if (worker) { \
            if ((c_) + SQ_AHEAD < NCK) { SQ_NEED((c_) + SQ_AHEAD); SQ_ISSUE((c_) + SQ_AHEAD, sl_free); } \
            if ((c_) + 1 < NCK) SQ_READ(nxt, sl_next); \
            bf16x8 xb[2]; \
            _Pragma("unroll") for (int g = 0; g < 2; ++g) { u32x4 p; p.x = cvt_pk_bf16(X[2 * g][0], X[2 * g][1]); p.y = cvt_pk_bf16(X[2 * g][2], X[2 * g][3]); p.z = cvt_pk_bf16(X[2 * g + 1][0], X[2 * g + 1][1]); p.w = cvt_pk_bf16(X[2 * g + 1][2], X[2 * g + 1][3]); \
                xb[g] = __builtin_bit_cast(bf16x8, p); } \
            f32x4 y = (f32x4){0.f, 0.f, 0.f, 0.f}; \
            y = __builtin_amdgcn_mfma_f32_16x16x32_bf16(cur[14], cur[15], y, 0, 0, 0); \
            y = __builtin_amdgcn_mfma_f32_16x16x32_bf16(cur[12], xb[0], y, 0, 0, 0); \
            y = __builtin_amdgcn_mfma_f32_16x16x32_bf16(cur[13], xb[1], y, 0, 0, 0); \
            f32x4 Xn[4]; \
            _Pragma("unroll") for (int kt = 0; kt < 4; ++kt) { f32x4 a = (f32x4){0.f, 0.f, 0.f, 0.f}; \
                a = __builtin_amdgcn_mfma_f32_16x16x32_bf16(cur[8 + kt], cur[15], a, 0, 0, 0); \
                a = __builtin_amdgcn_mfma_f32_16x16x32_bf16(cur[2 * kt], xb[0], a, 0, 0, 0); \
                a = __builtin_amdgcn_mfma_f32_16x16x32_bf16(cur[2 * kt + 1], xb[1], a, 0, 0, 0); \
                Xn[kt] = a; } \
            _Pragma("unroll") for (int r = 0; r < 4; ++r) Y[(size_t)((c_) * CK + 4 * q + r) * 1024] = y[r]; \
            _Pragma("unroll") for (int kt = 0; kt < 4; ++kt) X[kt] = Xn[kt]; } \
        sl_free = sl_free == SQ_NSLOT - 1 ? 0 : sl_free + 1; sl_next = sl_next == SQ_NSLOT - 1 ? 0 : sl_next + 1; } while (0)
    f32x4 X[4]; unsigned dummy = 0;
#pragma unroll
    for (int i = 0; i < 4; ++i) X[i] = (f32x4){0.f, 0.f, 0.f, 0.f};
    bf16x8 fa[16], fb[16];
    if (worker) { SQ_NEED(SQ_AHEAD - 1);
#pragma unroll
        for (int c = 0; c < SQ_AHEAD; ++c) SQ_ISSUE(c, c); }
    asm volatile("s_waitcnt vmcnt(0)" ::: "memory");
    __builtin_amdgcn_s_barrier();
    if (worker) SQ_READ(fa, 0);
    int sl_free = SQ_AHEAD, sl_next = 1;
    for (int c = 0; c < NCK; c += 2) { SQ_STEP(fa, fb, c); SQ_STEP(fb, fa, c + 1); }
    asm volatile("s_waitcnt vmcnt(0)" : "+v"(dummy) :: "memory");
#undef SQ_NEED
#undef SQ_ISSUE
#undef SQ_READ
#undef SQ_STEP
}

constexpr int ML_P = 264;
__device__ __forceinline__ void ml_stage_chunk(const Frame& F, const bf16* src  , int h, int c, LAS bf16* dst) {
    for (int i = F.tid; i < 64 * 32; i += NWAVES * 64) { const int s = i >> 5, ch = i & 31;
        *(LAS u32x4*)(dst + s * ML_P + 8 * ch) = *(const u32x4*)(src + (size_t)(64 * c + s) * 1024 + 256 * h + 8 * ch); }
}
template <int NA>
__device__ __forceinline__ void ml_stage_chunks(const Frame& F, const bf16* const (&src)[NA], int h, int c, LAS bf16* const (&dst)[NA]) {
    u32x4 r[NA][4];
#pragma unroll
    for (int a = 0; a < NA; ++a)
#pragma unroll
        for (int k = 0; k < 4; ++k) { const int i = F.tid + NWAVES * 64 * k, s = i >> 5, ch = i & 31; r[a][k] = *(const u32x4*)(src[a] + (size_t)(64 * c + s) * 1024 + 256 * h + 8 * ch); }
#pragma unroll
    for (int a = 0; a < NA; ++a)
#pragma unroll
        for (int k = 0; k < 4; ++k) { const int i = F.tid + NWAVES * 64 * k, s = i >> 5, ch = i & 31; *(LAS u32x4*)(dst[a] + s * ML_P + 8 * ch) = r[a][k]; }
}
__device__ __forceinline__ void p_mlu(const Frame& F, int first, int stride) {
    const bf16* KB = WSP(bf16, R_KB); const bf16* VB = WSP(bf16, R_VB); const float* BCUM = WSP(float, WS_SMALL + SM_BCUM); const float* IG = WSP(float, WS_SMALL + SM_IG);
    const float* CHBL = WSP(float, WS_SMALL + SM_CHBL); const float* MOUT = WSP(float, WS_SMALL + SM_MOUT);
    bf16* U = WSP(bf16, R_U); float* NU = WSP(float, WS_SMALL + SM_NU);
    LAS bf16* Ks = (LAS bf16*)(F.lds + RING_OFF); LAS bf16* Vs = Ks + 64 * ML_P; LAS float* wst = (LAS float*)(Vs + 64 * ML_P);
    const int lane = F.lane, r = lane & 31, hg = lane >> 5, w = F.wave;
    for (int L = first; L < NH_M * 128; L += stride) { const int h = L >> 7, c = L & 127;
        __syncthreads();
        { const bf16* const srcs[2] = {KB, VB}; LAS bf16* const dsts[2] = {Ks, Vs}; ml_stage_chunks<2>(F, srcs, h, c, dsts); }
        if (F.tid < 64) wst[F.tid] = __expf(CHBL[h * 128 + c] - BCUM[h * T + 64 * c + F.tid] + IG[h * T + 64 * c + F.tid] - MOUT[h * 128 + c]);
        __syncthreads();
        f32x16 acc[8];
#pragma unroll
        for (int nt = 0; nt < 8; ++nt) acc[nt] = f32x16{};
#pragma unroll
        for (int ks = 0; ks < 4; ++ks) { bf16x8 a; float av[8];
#pragma unroll
            for (int jj = 0; jj < 8; ++jj) { const int s = 16 * ks + 8 * hg + jj; av[jj] = bf2f(Vs[s * ML_P + 32 * w + r]) * wst[s]; }
            { u32x4 p; p.x = cvt_pk_bf16(av[0], av[1]); p.y = cvt_pk_bf16(av[2], av[3]); p.z = cvt_pk_bf16(av[4], av[5]); p.w = cvt_pk_bf16(av[6], av[7]); a = __builtin_bit_cast(bf16x8, p); }
#pragma unroll
            for (int nt = 0; nt < 8; ++nt) { bf16x8 b;
#pragma unroll
                for (int jj = 0; jj < 8; ++jj) b[jj] = (short)Ks[(16 * ks + 8 * hg + jj) * ML_P + 32 * nt + r];
                acc[nt] = __builtin_amdgcn_mfma_f32_32x32x16_bf16(a, b, acc[nt], 0, 0, 0); } }
        bf16* Uo = U + ((size_t)(h * 128 + c) * 256 + 32 * w) * 256;
#pragma unroll
        for (int nt = 0; nt < 8; ++nt)
#pragma unroll
            for (int q = 0; q < 16; ++q) { const int vl = (q & 3) + 8 * (q >> 2) + 4 * hg; Uo[(size_t)vl * 256 + 32 * nt + r] = f2bf(acc[nt][q]); }
        if (F.tid < 256) { float s = 0.f;
            for (int ss = 0; ss < 64; ++ss) s += wst[ss] * bf2f(Ks[ss * ML_P + F.tid]);
            NU[(size_t)(h * 128 + c) * 256 + F.tid] = s; }
    }
}
__device__ __forceinline__ void p_mlscan(const Frame& F) {
    bf16* U = WSP(bf16, R_U); float* NU = WSP(float, WS_SMALL + SM_NU); const float* WCARRY = WSP(float, WS_SMALL + SM_WCARRY);
    const int gt = F.gw * 64 + F.lane, NGT = F.NGW * 64;
    for (int it = gt; it < NH_M * 65536 / 4; it += NGT) { const int h = it >> 14, e = (it & 16383) * 4;
        float C0 = 0.f, C1 = 0.f, C2 = 0.f, C3 = 0.f; bf16* p = U + (size_t)h * 128 * 65536 + e;
#pragma unroll 32
        for (int c = 0; c < 128; ++c) { const u32x2 u = *(const u32x2*)(p + (size_t)c * 65536); const float wc = WCARRY[h * 128 + c];
            u32x2 o; o.x = cvt_pk_bf16(C0, C1); o.y = cvt_pk_bf16(C2, C3); *(u32x2*)(p + (size_t)c * 65536) = o;
            C0 = wc * C0 + bf2f(u.x & 0xffffu); C1 = wc * C1 + bf2f(u.x >> 16); C2 = wc * C2 + bf2f(u.y & 0xffffu); C3 = wc * C3 + bf2f(u.y >> 16); } }
    const int gt2 = gt - (NGT / 2);
    for (int it = gt2; it >= 0 && it < NH_M * 256; it += NGT) { const int h = it >> 8, k = it & 255; float n = 0.f; float* p = NU + (size_t)h * 128 * 256 + k;
#pragma unroll 16
        for (int c = 0; c < 128; ++c) { const float u = p[c * 256]; p[c * 256] = n; n = WCARRY[h * 128 + c] * n + u; } }
}
__device__ __forceinline__ void p_mlout(const Frame& F, const Args& A) {
    const bf16* QB = WSP(bf16, R_QB); const bf16* KB = WSP(bf16, R_KB); const bf16* VB = WSP(bf16, R_VB); const bf16* CS = WSP(bf16, R_U); const float* NC = WSP(float, WS_SMALL + SM_NU);
    const float* BCUM = WSP(float, WS_SMALL + SM_BCUM); const float* IG = WSP(float, WS_SMALL + SM_IG); const float* MSEQ = WSP(float, WS_SMALL + SM_MSEQ);
    const bf16* PROJ = WSP(bf16, R_PROJ); const float* mhg = A.in[I_MLNG]; bf16* YCAT = WSP(bf16, R_YCAT);
    LAS bf16* Qs = (LAS bf16*)(F.lds + RING_OFF); LAS bf16* Ks = Qs + 64 * ML_P; LAS bf16* Vs = Ks + 64 * ML_P; LAS bf16* Ss = Vs + 64 * ML_P;
    LAS float* fa = (LAS float*)(Ss + 64 * 72); LAS float* bch = fa; LAS float* ich = fa + 64; LAS float* mrow = fa + 128; LAS float* wint = fa + 192; LAS float* rsum = fa + 256  ;
    LAS float* nq = fa + 384; LAS float* nvec = fa + 448  ; LAS float* Hs = (LAS float*)(F.lds + RING_OFF);
    const int lane = F.lane, r = lane & 31, hg = lane >> 5, w = F.wave;
    for (int L = F.vcu; L < NH_M * 128; L += F.G) { const int h = L >> 7, c = L & 127;
        __syncthreads();
        { const bf16* const srcs[3] = {QB, KB, VB}; LAS bf16* const dsts[3] = {Qs, Ks, Vs}; ml_stage_chunks<3>(F, srcs, h, c, dsts); }
        if (F.tid < 64) { bch[F.tid] = BCUM[h * T + 64 * c + F.tid]; ich[F.tid] = IG[h * T + 64 * c + F.tid]; }
        if (F.tid < 256) nvec[F.tid] = NC[(size_t)(h * 128 + c) * 256 + F.tid];
        const float mc = MSEQ[h * 128 + c];
        __syncthreads();
        if (w == 0) { float g = ich[lane] - bch[lane];
#pragma unroll
            for (int o = 1; o < 64; o <<= 1) { const float x = __shfl_up(g, o); if (lane >= o) g = fmaxf(g, x); }
            const float mr = bch[lane] + fmaxf(mc, g); mrow[lane] = mr; wint[lane] = __expf(bch[lane] + mc - mr); }
        if (w == 1) { float s = 0.f;
            for (int k = 0; k < 256; ++k) s += nvec[k] * bf2f(Qs[lane * ML_P + k]);
            nq[lane] = s; }
        __syncthreads();
        if (w < 4) { const int st = w & 1, lt = w >> 1; f32x16 acc = f32x16{};
#pragma unroll
            for (int ks = 0; ks < 16; ++ks) { const bf16x8 a = *(const LAS bf16x8*)(Ks + (32 * st + r) * ML_P + 16 * ks + 8 * hg), b = *(const LAS bf16x8*)(Qs + (32 * lt + r) * ML_P + 16 * ks + 8 * hg);
                acc = __builtin_amdgcn_mfma_f32_32x32x16_bf16(a, b, acc, 0, 0, 0); }
            const int l = 32 * lt + r; const float bl_ = bch[l], mr = mrow[l]; float rs = 0.f;
#pragma unroll
            for (int g4 = 0; g4 < 4; ++g4) { float v4[4];
#pragma unroll
                for (int i = 0; i < 4; ++i) { const int s = 32 * st + 8 * g4 + 4 * hg + i; const float d = bl_ - bch[s] + ich[s] - mr;
                    v4[i] = (s <= l) ? acc[4 * g4 + i] * __expf(d) : 0.f; rs += v4[i]; }
                u32x2 p; p.x = cvt_pk_bf16(v4[0], v4[1]); p.y = cvt_pk_bf16(v4[2], v4[3]);
                *(LAS u32x2*)(Ss + l * 72 + 32 * st + 8 * g4 + 4 * hg) = p; }
            rs += __shfl_xor(rs, 32);
            if (hg == 0) rsum[st * 64 + l] = rs; }
        __syncthreads();
        const int lt = w & 1, vg = w >> 1; f32x16 ai[2], aa[2]; ai[0] = f32x16{}; ai[1] = f32x16{}; aa[0] = f32x16{}; aa[1] = f32x16{};
        const bf16* Cb = CS + (size_t)(h * 128 + c) * 65536;
#pragma unroll 8
        for (int ks = 0; ks < 16; ++ks) { const bf16x8 a = *(const LAS bf16x8*)(Qs + (32 * lt + r) * ML_P + 16 * ks + 8 * hg);
#pragma unroll
            for (int jt = 0; jt < 2; ++jt) { const bf16x8 b = *(const bf16x8*)(Cb + (size_t)(64 * vg + 32 * jt + r) * 256 + 16 * ks + 8 * hg);
                ai[jt] = __builtin_amdgcn_mfma_f32_32x32x16_bf16(a, b, ai[jt], 0, 0, 0); } }
#pragma unroll
        for (int ks = 0; ks < 4; ++ks) { const bf16x8 a = *(const LAS bf16x8*)(Ss + (32 * lt + r) * 72 + 16 * ks + 8 * hg);
#pragma unroll
            for (int jt = 0; jt < 2; ++jt) { bf16x8 b;
#pragma unroll
                for (int jj = 0; jj < 8; ++jj) b[jj] = (short)Vs[(16 * ks + 8 * hg + jj) * ML_P + 64 * vg + 32 * jt + r];
                aa[jt] = __builtin_amdgcn_mfma_f32_32x32x16_bf16(a, b, aa[jt], 0, 0, 0); } }
        __syncthreads();
#pragma unroll
        for (int q = 0; q < 16; ++q) { const int l = 32 * lt + (q & 3) + 8 * (q >> 2) + 4 * hg; const float wi = wint[l];
            const float den = rsum[l] + rsum[64 + l] + wi * nq[l]; const float dn = 1.0f / fmaxf(fabsf(den), __expf(-mrow[l]));
#pragma unroll
            for (int jt = 0; jt < 2; ++jt) Hs[l * 260 + 64 * vg + 32 * jt + r] = (aa[jt][q] + wi * ai[jt][q]) * dn; }
        __syncthreads();
        { const f32x4 g = *(const f32x4*)(mhg + 256 * h + 4 * lane); u32x2 ob[8]; f32x4 hv[8]; float ss[8];
#pragma unroll
          for (int i = 0; i < 8; ++i) ob[i] = *(const u32x2*)(PROJ + (size_t)(64 * c + 8 * w + i) * AB_PAD + 6592 + 256 * h + 4 * lane);
#pragma unroll
          for (int i = 0; i < 8; ++i) { hv[i] = *(const LAS f32x4*)(Hs + (8 * w + i) * 260 + 4 * lane); ss[i] = (hv[i][0] * hv[i][0] + hv[i][1] * hv[i][1]) + (hv[i][2] * hv[i][2] + hv[i][3] * hv[i][3]); }
#pragma unroll
          for (int i = 0; i < 8; ++i) ss[i] = wave_sum_dpp(ss[i]);
#pragma unroll
          for (int i = 0; i < 8; ++i) { const int t = 64 * c + 8 * w + i; const float rn = 1.0f / sqrtf(ss[i] * (1.0f / 256.0f) + 1e-6f);
            const float o0 = hv[i][0] * rn * g[0] * sigmoidf_(bf2f(ob[i].x & 0xffffu)), o1 = hv[i][1] * rn * g[1] * sigmoidf_(bf2f(ob[i].x >> 16));
            const float o2 = hv[i][2] * rn * g[2] * sigmoidf_(bf2f(ob[i].y & 0xffffu)), o3 = hv[i][3] * rn * g[3] * sigmoidf_(bf2f(ob[i].y >> 16));
            u32x2 p; p.x = cvt_pk_bf16(o0, o1); p.y = cvt_pk_bf16(o2, o3);
            *(u32x2*)(YCAT + (size_t)t * D + 1024 + 256 * h + 4 * lane) = p; } }
    }
}

struct XsOrder {
    const bf16* XQ; const bf16* KM; int G, c;
    __device__ __forceinline__ bool next(int i, pg8::Unit& u) const {
        const int L = i * G + c; if (L >= 32 * 4) return false;
        const int pm = L >> 2, hd = L & 3; u.pm = pm; u.pn = 0; u.aux = hd; u.pad = 0;
        u.a = (const char*)(XQ + (size_t)pm * 256 * D + 512 * hd); u.b = (const char*)(KM + 512 * hd); return true;
    }
};
struct XpreOrder {
    const bf16* kmem; const bf16* vmem; const bf16* wqp; const bf16* wot; int G, c;
    __device__ __forceinline__ bool next(int i, pg8::Unit& u) const {
        if (c < 0) return false; const int L = i * G + c; if (L >= 128) return false;
        const int l = L >> 6, kind = (L >> 5) & 1, hd = (L >> 3) & 3, idx = L & 7; u.pad = 0; u.aux = L >> 3;
        if (kind == 0) { u.a = (const char*)(kmem + (size_t)l * NMEM * D + 512 * hd); u.b = (const char*)(wqp + (size_t)l * D * D + (size_t)idx * 256 * D + 512 * hd); u.pm = 0; u.pn = idx; }
        else { u.a = (const char*)(wot + (size_t)l * D * D + (size_t)idx * 256 * D + 512 * hd); u.b = (const char*)(vmem + (size_t)l * NMEM * D + 512 * hd); u.pm = idx; u.pn = 0; }
        return true;
    }
};
struct EpiXpre {
    static constexpr bool PERM = true;
    bf16* kq; bf16* vwt;
    __device__ __forceinline__ void operator()(const f32x4 (&acc)[2][2][4][2], const pg8::Unit& u, int wr, int wc, int fr, int fq) const {
        const int l = u.aux >> 3, kind = (u.aux >> 2) & 1, hd = u.aux & 3;
        pg8::EpiBf16 E{kind == 0 ? kq + (size_t)((l * 4 + hd) * 256) * D : vwt + (size_t)l * D * 1024 + 256 * hd, kind == 0 ? D : 1024, nullptr, -1, nullptr};
        E(acc, u, wr, wc, fr, fq);
    }
};
struct XkqOrder {
    const bf16* XN; const bf16* KQ; int G, c;
    __device__ __forceinline__ bool next(int i, pg8::Unit& u) const {
        const int L = i * G + c; if (L >= 32 * 4) return false;
        const int pm = L >> 2, hd = L & 3; u.pm = pm; u.pn = 0; u.aux = hd; u.pad = 0;
        u.a = (const char*)(XN + (size_t)pm * 256 * D); u.b = (const char*)(KQ + (size_t)hd * 256 * D); return true;
    }
};
struct XpvOrder {
    const bf16* XP; const bf16* VT; int G, c;
    __device__ __forceinline__ bool next(int i, pg8::Unit& u) const {
        int pm, pn; if (!pg8::static_tile(i, G, c, 32, 8, pm, pn)) return false;
        u.pm = pm; u.pn = pn; u.aux = 0; u.pad = 0;
        u.a = (const char*)(XP + (size_t)pm * 256 * 1024 + 256 * (pn >> 1)); u.b = (const char*)(VT + (size_t)pn * 256 * NMEM); return true;
    }
};
__device__ __forceinline__ void p_xsoftmax(const Frame& F) {
    const float* XS = WSP(float, R_XS); bf16* XP = WSP(bf16, R_XP); const int lane = F.lane;
    for (int t = F.gw; t < T; t += F.NGW)
#pragma unroll
        for (int hd = 0; hd < 4; ++hd) { const f32x4 s = *(const f32x4*)(XS + (size_t)t * 1024 + 256 * hd + 4 * lane);
            const float m = wave_max(fmaxf(fmaxf(s[0], s[1]), fmaxf(s[2], s[3])));
            const float e0 = __expf(s[0] - m), e1 = __expf(s[1] - m), e2 = __expf(s[2] - m), e3 = __expf(s[3] - m);
            const float inv = 1.0f / wave_sum((e0 + e1) + (e2 + e3));
            u32x2 p; p.x = cvt_pk_bf16(e0 * inv, e1 * inv); p.y = cvt_pk_bf16(e2 * inv, e3 * inv);
            *(u32x2*)(XP + (size_t)t * 1024 + 256 * hd + 4 * lane) = p; }
}

__device__ __forceinline__ void p_norm_fpre(const Frame& F, const Args& A) {
    LAS float* Ws = (LAS float*)(F.lds + RING_OFF);
    stage_skinny<16>(F, A.in[I_FOXWIN], FOX_LD, 8192, Ws);
    __syncthreads();
    const float* X = WSP(float, WS_X); bf16* XN = WSP(bf16, WS_XN); float* FPRE = WSP(float, WS_SMALL + SM_FPRE); const float* g = A.in[I_NMIXG] + D;
    const float bfh = A.in[I_FOXBF][F.lane & 15];
    auto body = [&](int t, f32x4 (&y)[8]) { float o[16]; skinny_dot<16>(y, Ws, F.lane, o);
        if (F.lane < 16) { float v = o[0];
#pragma unroll
            for (int c = 1; c < 16; ++c) v = (F.lane == c) ? o[c] : v;
            FPRE[t * 16 + F.lane] = logsigmoidf_(v + bfh); } };
    if (T == 4 * F.NGW) rms_rows4(X, g, XN, F.lane, F.gw, F.gw + F.NGW, F.gw + 2 * F.NGW, F.gw + 3 * F.NGW, body);
    else for (int t = F.gw; t < T; t += F.NGW) { f32x4 y[8]; rms_row(X + (size_t)t * D, g, XN + (size_t)t * D, F.lane, y); body(t, y); }
    __syncthreads();
}
__device__ __forceinline__ void p_foxprep(const Frame& F, const Args& A) {
    bf16* QKVG = WSP(bf16, R_QKVG); const float* qg = A.in[I_FOXQG]; const float* kg = A.in[I_FOXKG]; const int lane = F.lane;
    if (2 * T == 8 * F.NGW) { const int hd = lane >> 2, qt = lane & 3, sec = F.gw & 1; const float* gg = (sec ? kg : qg) + 32 * qt; f32x4 gv[8]; bf16x8 x[8][4];
#pragma unroll
        for (int j = 0; j < 8; ++j) gv[j] = *(const f32x4*)(gg + 4 * j);
#pragma unroll
        for (int i = 0; i < 8; ++i) { const int t = (F.gw + i * F.NGW) >> 1; const bf16* row = QKVG + (size_t)t * 8192 + sec * 2048 + 128 * hd + 32 * qt;
#pragma unroll
            for (int j = 0; j < 4; ++j) x[i][j] = *(const bf16x8*)(row + 8 * j); }
        __builtin_amdgcn_sched_barrier(0);
#define FP_DPP(v_, ctrl) __builtin_bit_cast(float, __builtin_amdgcn_update_dpp(0, __builtin_bit_cast(int, v_), ctrl, 0xF, 0xF, true))
#pragma unroll
        for (int i = 0; i < 8; ++i) { const int t = (F.gw + i * F.NGW) >> 1; bf16* row = QKVG + (size_t)t * 8192 + sec * 2048 + 128 * hd + 32 * qt; float v[32]; float ss = 0.f;
#pragma unroll
            for (int j = 0; j < 4; ++j)
#pragma unroll
                for (int e = 0; e < 8; ++e) { v[8 * j + e] = bf2f((unsigned short)x[i][j][e]); ss += v[8 * j + e] * v[8 * j + e]; }
            ss += FP_DPP(ss, 0xB1); ss += FP_DPP(ss, 0x4E);
            const float rn = 1.0f / sqrtf(ss * (1.0f / 128.0f) + 1e-6f);
#pragma unroll
            for (int j = 0; j < 4; ++j) { u32x4 w; const f32x4 g0 = gv[2 * j], g1 = gv[2 * j + 1];
                w.x = cvt_pk_bf16(v[8 * j] * rn * g0[0], v[8 * j + 1] * rn * g0[1]); w.y = cvt_pk_bf16(v[8 * j + 2] * rn * g0[2], v[8 * j + 3] * rn * g0[3]);
                w.z = cvt_pk_bf16(v[8 * j + 4] * rn * g1[0], v[8 * j + 5] * rn * g1[1]); w.w = cvt_pk_bf16(v[8 * j + 6] * rn * g1[2], v[8 * j + 7] * rn * g1[3]);
                *(u32x4*)(row + 8 * j) = w; } }
#undef FP_DPP
    } else
    for (int it = F.gw; it < 2 * T; it += F.NGW) { const int t = it >> 1, sec = it & 1; const float* gg = sec ? kg : qg; const float g0 = gg[2 * lane], g1 = gg[2 * lane + 1];
        unsigned* row = (unsigned*)(QKVG + (size_t)t * 8192 + sec * 2048) + lane;
#pragma unroll 4
        for (int h = 0; h < NH_F; ++h) { const unsigned u = row[64 * h]; const float a = bf2f(u & 0xffffu), b = bf2f(u >> 16);
            const float rn = 1.0f / sqrtf(wave_sum(a * a + b * b) * (1.0f / 128.0f) + 1e-6f);
            row[64 * h] = cvt_pk_bf16(a * rn * g0, b * rn * g1); } }
    if (F.gw < NH_F) { const int h = F.gw; const float* FPRE = WSP(float, WS_SMALL + SM_FPRE); float* BL = WSP(float, WS_SMALL + SM_BIASL2); const float bf = A.in[I_FOXBF][h];
        float carry = 0.f; float va[16], vb[16];
#define FC_LOAD(v_, c0_) do { _Pragma("unroll") for (int i = 0; i < 16; ++i) v_[i] = FPRE[(size_t)(64 * ((c0_) + i) + lane) * 16 + h]; } while (0)
#define FC_PROC(v_, c0_) do { _Pragma("unroll") for (int i = 0; i < 16; ++i) v_[i] = wave_scan_dpp(v_[i]); \
            _Pragma("unroll") for (int i = 0; i < 16; ++i) { const float tot = __builtin_bit_cast(float, __builtin_amdgcn_readlane(__builtin_bit_cast(int, v_[i]), 63)); const float b = v_[i] + carry; BL[h * T + 64 * ((c0_) + i) + lane] = -1.4426950408889634f * b; carry = tot + carry; } } while (0)
        FC_LOAD(va, 0);
        for (int c0 = 0; c0 < 128; c0 += 32) { FC_LOAD(vb, c0 + 16); __builtin_amdgcn_sched_barrier(0); FC_PROC(va, c0); __builtin_amdgcn_sched_barrier(0);
            if (c0 + 32 < 128) FC_LOAD(va, c0 + 32); __builtin_amdgcn_sched_barrier(0); FC_PROC(vb, c0 + 16); __builtin_amdgcn_sched_barrier(0); }
#undef FC_LOAD
#undef FC_PROC
    }
}
__device__ __forceinline__ void p_foxattn(const Frame& F) {
    const bf16* QKVG = WSP(bf16, R_QKVG); bf16* ATTO = WSP(bf16, R_ATTO); const float* BL = WSP(float, WS_SMALL + SM_BIASL2);
    char* lds = (char*)F.ldsg + RING_OFF;
    for (int L = F.vcu; L < 256; L += F.G) { const int h = L >> 4, x = L & 15;
        __syncthreads();
        { float* bl = (float*)(lds + fox::BIAS_OFF); for (int i = F.tid; i < T / 4; i += NWAVES * 64) *(f32x4*)(bl + 4 * i) = *(const f32x4*)(BL + (size_t)h * T + 4 * i); }
        fox::BlockRef b0, b1; const int q0 = x, q1 = 31 - x;
        b0.Q = QKVG + (size_t)q0 * 256 * 8192 + 128 * h; b0.K = QKVG + 2048 + 128 * h; b0.V = QKVG + 4096 + 128 * h; b0.G = QKVG + (size_t)q0 * 256 * 8192 + 6144 + 128 * h;
        b0.O = ATTO + (size_t)q0 * 256 * D + 128 * h; b0.P0 = q0 * 256;
        b1 = b0; b1.Q = QKVG + (size_t)q1 * 256 * 8192 + 128 * h; b1.G = QKVG + (size_t)q1 * 256 * 8192 + 6144 + 128 * h; b1.O = ATTO + (size_t)q1 * 256 * D + 128 * h; b1.P0 = q1 * 256;
        fox::Seam S;
        fox::prime(b0, lds, S);
#ifdef FOX_LOOP
        for (int pass = 0; pass < 2; ++pass) { fox::block(b0, b1, lds, S); b0 = b1; }
#else
        fox::block(b0, b1, lds, S);
        fox::block(b1, b1, lds, S);
#endif
    }
}

__device__ __forceinline__ void p_norm_route(const Frame& F, const Args& A) {
    LAS float* Ws = (LAS float*)(F.lds + RING_OFF); LAS int* cnt = (LAS int*)(F.lds + RING_OFF + 8 * D * 4);
    stage_skinny<8>(F, A.in[I_ROUTER], NEXP, 0, Ws);
    if (F.tid < 8) cnt[F.tid] = 0;
    __syncthreads();
    const float* X = WSP(float, WS_X); bf16* XN = WSP(bf16, WS_XN); const float* g = A.in[I_NFFNG] + D;
    int* TOPI = WSP(int, WS_SMALL + SM_TOPI); float* TOPG = WSP(float, WS_SMALL + SM_TOPG); int* BLKCNT = WSP(int, WS_SMALL + SM_BLKCNT);
    const int b = blockIdx.x;
    auto body = [&](int t, f32x4 (&y)[8]) {
        float o[8]; skinny_dot<8>(y, Ws, F.lane, o);
        int i1 = 0; float v1 = o[0];
#pragma unroll
        for (int e = 1; e < 8; ++e) if (o[e] > v1) { v1 = o[e]; i1 = e; }
        int i2 = -1; float v2 = -__builtin_inff();
#pragma unroll
        for (int e = 0; e < 8; ++e) if (e != i1 && o[e] > v2) { v2 = o[e]; i2 = e; }
        const float e2 = __expf(v2 - v1), g1 = 1.0f / (1.0f + e2), g2 = e2 * g1;
        if (F.lane == 0) { TOPI[2 * t] = i1; TOPI[2 * t + 1] = i2; TOPG[2 * t] = g1; TOPG[2 * t + 1] = g2; __hip_atomic_fetch_add(&cnt[i1], 1, __ATOMIC_RELAXED, __HIP_MEMORY_SCOPE_WORKGROUP); __hip_atomic_fetch_add(&cnt[i2], 1, __ATOMIC_RELAXED, __HIP_MEMORY_SCOPE_WORKGROUP); } };
    { const int tb = 32 * b + 4 * F.wave; rms_rows4(X, g, XN, F.lane, tb, tb + 1, tb + 2, tb + 3, body); }
    __syncthreads();
    if (F.tid < 8) BLKCNT[b * 8 + F.tid] = cnt[F.tid];
}
__device__ __forceinline__ void p_route2(const Frame& F) {
    LAS int* sh = (LAS int*)(F.lds + RING_OFF);
    const int* BLKCNT = WSP(int, WS_SMALL + SM_BLKCNT); const int* TOPI = WSP(int, WS_SMALL + SM_TOPI); int* SLOT = WSP(int, WS_SMALL + SM_SLOT); int* TILEE = WSP(int, WS_SMALL + SM_TILEE);
    const bf16* XN = WSP(bf16, WS_XN); bf16* AG = WSP(bf16, R_AG); const int b = blockIdx.x;
    __syncthreads();
    { LAS int* cn = sh + 128;
      if (F.tid < 256) { const u32x4 c0 = *(const u32x4*)(BLKCNT + F.tid * 8), c1 = *(const u32x4*)(BLKCNT + F.tid * 8 + 4); *(LAS u32x4*)(cn + F.tid * 8) = c0; *(LAS u32x4*)(cn + F.tid * 8 + 4) = c1; }
      __syncthreads();
      if (F.tid < 8) { int tot = 0, pre = 0; for (int bb = 0; bb < 256; ++bb) { const int v = cn[bb * 8 + F.tid]; if (bb < b) pre += v; tot += v; } sh[F.tid] = tot; sh[8 + F.tid] = pre; } }
    __syncthreads();
    if (F.tid == 0) { int off = 0, nt = 0; for (int e = 0; e < 8; ++e) { sh[16 + e] = off; const int n = (sh[e] + 255) >> 8; if (b == 0) for (int i = 0; i < n; ++i) TILEE[1 + nt + i] = e; nt += n; off += n * 256; } if (b == 0) TILEE[0] = nt; }
    __syncthreads();
    if (F.wave == 0) { const int t = 32 * b + (F.lane >> 1), e = TOPI[2 * t + (F.lane & 1)]; int rank = 0;
#pragma unroll
        for (int ee = 0; ee < 8; ++ee) { const unsigned long long m = __ballot(e == ee); if (e == ee) rank = __popcll(m & ((1ull << F.lane) - 1ull)); }
        const int slot = sh[16 + e] + sh[8 + e] + rank; SLOT[2 * t + (F.lane & 1)] = slot; sh[32 + F.lane] = slot; }
    __syncthreads();
    { u32x4 rr[8][4];
#pragma unroll
      for (int i = 0; i < 8; ++i) { const int p = F.wave + NWAVES * i, t = 32 * b + (p >> 1); const u32x4* src = (const u32x4*)(XN + (size_t)t * D);
#pragma unroll
          for (int j = 0; j < 4; ++j) rr[i][j] = src[F.lane + 64 * j]; }
      __builtin_amdgcn_sched_barrier(0);
#pragma unroll
      for (int i = 0; i < 8; ++i) { const int p = F.wave + NWAVES * i, slot = sh[32 + p]; u32x4* dst = (u32x4*)(AG + (size_t)slot * D);
#pragma unroll
          for (int j = 0; j < 4; ++j) dst[F.lane + 64 * j] = rr[i][j]; } }
}
struct MoeOrder {
    const bf16* Arows; const bf16* W; const int* tilee; int lda, nN; size_t wstride; int G, c; bool whole_rounds;
    __device__ __forceinline__ bool next(int i, pg8::Unit& u) const {
        const int nt = tilee[0]; const long L = (long)i * G + c; long nu = (long)nt * nN; if (whole_rounds) nu = (nu / G) * G; if (L >= nu) return false;
        const int ti = (int)(L / nN), pn = (int)(L % nN), e = tilee[1 + ti];
        u.pm = ti; u.pn = pn; u.aux = e; u.pad = 0; u.a = (const char*)(Arows + (size_t)ti * 256 * lda); u.b = (const char*)(W + (size_t)e * wstride + (size_t)pn * 256 * lda); return true;
    }
};
constexpr int MOE_KSPLIT = 4;
struct MoeSplitOrder {
    const bf16* Arows; const bf16* W; const int* tilee; int lda, nN, kslice; size_t wstride; int G, c;
    __device__ __forceinline__ bool next(int i, pg8::Unit& u) const {
        const int nt = tilee[0]; const long nu = (long)nt * nN, nfull = (nu / G) * G; const long L = (long)i * G + c; if (L >= (nu - nfull) * MOE_KSPLIT) return false;
        const long j = nfull + L / MOE_KSPLIT; const int kq = (int)(L % MOE_KSPLIT); const int ti = (int)(j / nN), pn = (int)(j % nN), e = tilee[1 + ti];
        u.pm = ti; u.pn = pn; u.aux = kq; u.pad = 0; u.a = (const char*)(Arows + (size_t)ti * 256 * lda + (size_t)kq * kslice); u.b = (const char*)(W + (size_t)e * wstride + (size_t)pn * 256 * lda + (size_t)kq * kslice); return true;
    }
};
__device__ __forceinline__ void p_final(const Frame& F, const Args& A) {
    const float* X = WSP(float, WS_X); const bf16* YG = WSP(bf16, R_YG); const float* YS = WSP(float, R_YSIDE); const int* SLOT = WSP(int, WS_SMALL + SM_SLOT); const float* TOPG = WSP(float, WS_SMALL + SM_TOPG);
    const float* g = A.in[I_FING]; const int lane = F.lane;
    const int nt = WSP(int, WS_SMALL + SM_TILEE)[0]; const int srow0 = (((nt * 8) / F.G) * F.G / 8) * 256;
    for (int t = F.gw; t < T; t += F.NGW) { const int s1 = SLOT[2 * t], s2 = SLOT[2 * t + 1]; const float g1 = TOPG[2 * t], g2 = TOPG[2 * t + 1];
        const f32x4* xr = (const f32x4*)(X + (size_t)t * D) + lane; const u32x2* y1 = (const u32x2*)(YG + (size_t)s1 * D) + lane; const u32x2* y2 = (const u32x2*)(YG + (size_t)s2 * D) + lane;
        f32x4 v[8]; float s = 0.f;
#pragma unroll
        for (int j = 0; j < 8; ++j) { const u32x2 ua = y1[64 * j], ub = y2[64 * j]; f32x4 a = {bf2f(ua.x & 0xffffu), bf2f(ua.x >> 16), bf2f(ua.y & 0xffffu), bf2f(ua.y >> 16)}, b = {bf2f(ub.x & 0xffffu), bf2f(ub.x >> 16), bf2f(ub.y & 0xffffu), bf2f(ub.y >> 16)};
            if (s1 >= srow0) { const f32x4* p = (const f32x4*)(YS + (size_t)(s1 - srow0) * D) + lane + 64 * j; a = a + ((p[0] + p[YSIDE_STRIDE / 4]) + p[2 * (YSIDE_STRIDE / 4)]); }
            if (s2 >= srow0) { const f32x4* p = (const f32x4*)(YS + (size_t)(s2 - srow0) * D) + lane + 64 * j; b = b + ((p[0] + p[YSIDE_STRIDE / 4]) + p[2 * (YSIDE_STRIDE / 4)]); }
            v[j] = xr[64 * j] + (a * g1 + b * g2); s += (v[j][0] * v[j][0] + v[j][1] * v[j][1]) + (v[j][2] * v[j][2] + v[j][3] * v[j][3]); }
        const float r = 1.0f / sqrtf(wave_sum(s) * (1.0f / D) + 1e-6f); f32x4* o = (f32x4*)(A.out + (size_t)t * D) + lane;
#pragma unroll
        for (int j = 0; j < 8; ++j) o[64 * j] = v[j] * r * ((const f32x4*)g)[lane + 64 * j]; }
}

enum Phase { PH_CONV = 0, PH_INPROJ0, PH_PREPA, PH_LORA, PH_SCAN, PH_MLSCAN, PH_MLOUT, PH_OUTPROJ0,
             PH_NORMX0, PH_XS0, PH_XO0, PH_NORMF0, PH_FFNGU, PH_FFND,
             PH_NORMM1, PH_FOXIN, PH_FOXPREP, PH_FOXATT, PH_FOXOUT,
             PH_NORMX1, PH_XS1, PH_XO1, PH_NORMF1, PH_ROUTE2, PH_MOEGU, PH_MOED, PH_FINAL, N_PHASES };

__global__ void __launch_bounds__(NWAVES * 64, 2) trunk_fwd(Args A) {
    extern __shared__ __attribute__((aligned(16))) unsigned char lds[];
    Frame F;
    F.lds = (LAS unsigned char*)lds; F.ldsg = lds; F.ws = A.ws;
    F.tid = threadIdx.x; F.lane = F.tid & 63; F.wave = __builtin_amdgcn_readfirstlane(F.tid >> 6);
    F.G = gridDim.x; { const int bx = blockIdx.x; F.vcu = (F.G % 8 == 0) ? (bx % 8) * (F.G / 8) + bx / 8 : bx; }
    F.gw = F.vcu * NWAVES + F.wave; F.NGW = F.G * NWAVES;
    volatile LAS unsigned* MISC = (volatile LAS unsigned*)(F.lds + MISC_OFF);
    for (int u = F.tid; u < (LDS_BYTES - LDSCTL_OFF) / 4; u += NWAVES * 64) ((LAS unsigned*)(F.lds + LDSCTL_OFF))[u] = 0u;
    __syncthreads();
    const int lo = A.ph_lo, hi = A.ph_hi;
    const bool multi = (hi - lo) > 1;
    XcdBarrier bar; bar.bar = (unsigned*)(A.ws + WS_CTL) + CW_BAR; bar.x = 0; bar.st = nullptr;
    if (multi) bar = xcd_barrier_post((unsigned*)(A.ws + WS_CTL) + CW_BAR, MISC + 8);
#ifndef PH_ENABLE
#define PH_ENABLE 0xFFFFFFFFFFFFFFFFull
#endif
#define IN(k) ((((PH_ENABLE) >> (k)) & 1ull) && lo <= (k) && (k) < hi)
#ifndef PROBE_DUP
#define PROBE_DUP 0ull
#endif
#define DUP(k) if ((((PROBE_DUP) >> (k)) & 1ull) != 0ull)
#ifndef PROBE_PHASE
#define PROBE_PHASE (-1)
#endif
    long long tph_ = 0;
#define SEAM(k) do { if (PROBE_PHASE == (k)) { __syncthreads(); const long long t1_ = wall_clock64(); while (wall_clock64() - t1_ < t1_ - tph_) __builtin_amdgcn_s_sleep(32); } \
        if (IN(k) && IN((k) + 1)) xcd_barrier(bar); if (PROBE_PHASE == (k) + 1) tph_ = wall_clock64(); } while (0)
    LAS unsigned char* ring = F.lds + RING_OFF;
    const int cb = (int)blockIdx.x;
    float* const SSQ = (float*)(A.ws + WS_CTL + CTL_SSQ);

    constexpr int MOE_E_TAIL = 1;
    constexpr int MOE_E_EARLY = 0;
    if (IN(PH_CONV)) { p_convert_early(F, A); if (MOE_E_EARLY > 0) p_convert_late(F, A, F.gw, F.NGW, (LAS float*)(F.lds + RING_OFF + F.wave * 16384), false, 0, MOE_E_EARLY); } SEAM(PH_CONV);
    if (IN(PH_INPROJ0)) { InprojKvOrder S{WSP(bf16, WS_XN), WSP(bf16, WS_W_ABIN), WSP(bf16, WS_MEMN), WSP(bf16, WS_W_XKV), F.G, cb};
        EpiInprojKv E{WSP(bf16, R_PROJ), WSP(float, R_GATES32), WSP(bf16, WS_KMEM), WSP(bf16, WS_VTMEM)};
        pg8::gemm_phase<EpiInprojKv, InprojKvOrder, true>(ring, pg8::Gemm{D, D, D}, S, E); } SEAM(PH_INPROJ0);
    if (IN(PH_PREPA)) { p_prepa(F, A); DUP(PH_PREPA) { __syncthreads(); p_prepa(F, A); } } SEAM(PH_PREPA);
    if (IN(PH_LORA)) { pg8::PlainOrder S{WSP(bf16, R_LORAIN), WSP(bf16, WS_W_LORA), 512, 512, 32, 12, F.G, cb}; pg8::EpiF32 E{WSP(float, R_LORAOUT), 3072, 0, 1.0f};
        pg8::gemm_phase<pg8::EpiF32, pg8::PlainOrder, true>(ring, pg8::Gemm{512, 512, 512}, S, E);
        { XpreOrder S2{WSP(bf16, WS_KMEM), WSP(bf16, WS_VTMEM), WSP(bf16, WS_W_XQ), WSP(bf16, WS_W_XO), 128, cb - 128}; EpiXpre E2{WSP(bf16, R_KQ), WSP(bf16, R_VWT)};
          pg8::gemm_phase<EpiXpre, XpreOrder, false>(ring, pg8::Gemm{D, D, 512}, S2, E2); }
        p_mlstm_pass2(F, cb == (int)F.G - 1 && F.wave < NH_M, F.wave); } SEAM(PH_LORA);
    if (IN(PH_SCAN)) {
        constexpr int RW_NP = 143;
#ifndef PROBE_ROLE
#define PROBE_ROLE 0
#endif
        const long long t0_ = PROBE_ROLE ? wall_clock64() : 0;
        const int role_ = cb < 16 ? 1 : (cb < 16 + RW_NP ? 2 : 3);
        if (cb < 16) p_rwkv_seq(F);
        else if (cb < 16 + RW_NP) { p_rwkv_chunk2(F, A, cb - 16, RW_NP); __syncthreads(); p_mlu(F, cb - 16, RW_NP); }
        else p_convert_late(F, A, (cb - 16 - RW_NP) * NWAVES + F.wave, (F.G - 16 - RW_NP) * NWAVES, (LAS float*)(F.lds + RING_OFF + F.wave * 16384), true, MOE_E_EARLY, NEXP - MOE_E_TAIL - 2);
        if (PROBE_ROLE && role_ == PROBE_ROLE) { __syncthreads(); const long long t1_ = wall_clock64(); while (wall_clock64() - t1_ < t1_ - t0_) __builtin_amdgcn_s_sleep(32); }
    } SEAM(PH_SCAN);
    if (IN(PH_MLSCAN)) { p_mlscan(F); p_rwkv_post(F, A); DUP(PH_MLSCAN) { __syncthreads(); p_rwkv_post(F, A); } } SEAM(PH_MLSCAN);
    if (IN(PH_MLOUT)) { p_mlout(F, A); DUP(PH_MLOUT) { __syncthreads(); p_mlout(F, A); } } SEAM(PH_MLOUT);
    if (IN(PH_OUTPROJ0)) { pg8::PlainOrder S{WSP(bf16, R_YCAT), WSP(bf16, WS_W_ABOUT), D, D, 32, 8, F.G, cb}; pg8::EpiResid E{A.in[I_X], WSP(float, WS_X), D, nullptr, nullptr, nullptr};
        pg8::gemm_phase<pg8::EpiResid, pg8::PlainOrder, false>(ring, pg8::Gemm{D, D, D}, S, E); } SEAM(PH_OUTPROJ0);
#define XATTN(l, P_NORM, P_S, P_O, XN_OUT, G_OUT, SSQ_OUT) \
    if (IN(P_NORM)) { norm_phase(F, WSP(float, WS_X), A.in[I_NXAG] + (l) * D, WSP(bf16, WS_XN), T); } SEAM(P_NORM); \
    if (IN(P_S)) { XkqOrder S{WSP(bf16, WS_XN), WSP(bf16, R_KQ) + (size_t)(l) * 4 * 256 * D, F.G, cb}; pg8::EpiSoftmaxBf16 E{WSP(bf16, R_XP), 1024, 256, 0.044194173824159216f}; \
        pg8::gemm_phase<pg8::EpiSoftmaxBf16, XkqOrder, false>(ring, pg8::Gemm{D, D, D}, S, E); \
        if (cb >= 128) p_convert_late(F, A, (cb - 128) * NWAVES + F.wave, (F.G - 128) * NWAVES, (LAS float*)(F.lds + RING_OFF + F.wave * 16384), false, NEXP - 3 + (l), NEXP - 2 + (l)); } SEAM(P_S);     \
    if (IN(P_O)) { pg8::PlainOrder S{WSP(bf16, R_XP), WSP(bf16, R_VWT) + (size_t)(l) * D * 1024, 1024, 1024, 32, 8, F.G, cb}; pg8::EpiResid E{WSP(float, WS_X), WSP(float, WS_X), D, XN_OUT, G_OUT, SSQ_OUT}; \
        pg8::gemm_phase<pg8::EpiResid, pg8::PlainOrder, false>(ring, pg8::Gemm{1024, 1024, 1024}, S, E); } SEAM(P_O);

    XATTN(0, PH_NORMX0, PH_XS0, PH_XO0, (bf16*)nullptr, (const float*)nullptr, (float*)nullptr)
    if (IN(PH_NORMF0)) { norm_phase(F, WSP(float, WS_X), A.in[I_NFFNG], WSP(bf16, WS_XN), T); } SEAM(PH_NORMF0);
    if (IN(PH_FFNGU)) {
        constexpr int GF = 236;
        if (MOE_E_TAIL == 0 || cb < GF) { pg8::PlainOrder S{WSP(bf16, WS_XN), WSP(bf16, WS_W_FFNGU), D, D, 32, 44, MOE_E_TAIL == 0 ? (int)F.G : GF, cb}; pg8::EpiSwiGLU E{WSP(bf16, R_ACT), DFF, nullptr};
            pg8::gemm_phase<pg8::EpiSwiGLU, pg8::PlainOrder, true>(ring, pg8::Gemm{D, D, D}, S, E); }
        else { const long long tq0_ = (PROBE_ROLE == 4) ? wall_clock64() : 0;
            p_convert_late(F, A, (cb - GF) * NWAVES + F.wave, (F.G - GF) * NWAVES, (LAS float*)(F.lds + RING_OFF + F.wave * 16384), false, NEXP - MOE_E_TAIL, NEXP);
            if (PROBE_ROLE == 4) { const long long tq1_ = wall_clock64(); while (wall_clock64() - tq1_ < tq1_ - tq0_) __builtin_amdgcn_s_sleep(32); } } } SEAM(PH_FFNGU);
    if (IN(PH_FFND)) { pg8::PlainOrder S{WSP(bf16, R_ACT), WSP(bf16, WS_W_FFND), DFF, DFF, 32, 8, F.G, cb}; pg8::EpiResid E{WSP(float, WS_X), WSP(float, WS_X), D, nullptr, nullptr, nullptr};
        pg8::gemm_phase<pg8::EpiResid, pg8::PlainOrder, false>(ring, pg8::Gemm{DFF, DFF, DFF}, S, E); } SEAM(PH_FFND);
    if (IN(PH_NORMM1)) { p_norm_fpre(F, A); DUP(PH_NORMM1) { p_norm_fpre(F, A); } } SEAM(PH_NORMM1);
    if (IN(PH_FOXIN)) { pg8::PlainOrder S{WSP(bf16, WS_XN), WSP(bf16, WS_W_FOXIN), D, D, 32, 32, F.G, cb}; pg8::EpiBf16 E{WSP(bf16, R_QKVG), 8192, nullptr, -1, nullptr};
        pg8::gemm_phase<pg8::EpiBf16, pg8::PlainOrder, true>(ring, pg8::Gemm{D, D, D}, S, E); DUP(PH_FOXIN) { pg8::gemm_phase<pg8::EpiBf16, pg8::PlainOrder, true>(ring, pg8::Gemm{D, D, D}, S, E); } } SEAM(PH_FOXIN);
    if (IN(PH_FOXPREP)) { p_foxprep(F, A); } SEAM(PH_FOXPREP);
    if (IN(PH_FOXATT)) { p_foxattn(F); DUP(PH_FOXATT) { __syncthreads(); p_foxattn(F); } } SEAM(PH_FOXATT);
    if (IN(PH_FOXOUT)) { pg8::PlainOrder S{WSP(bf16, R_ATTO), WSP(bf16, WS_W_FOXOUT), D, D, 32, 8, F.G, cb}; pg8::EpiResid E{WSP(float, WS_X), WSP(float, WS_X), D, nullptr, nullptr, nullptr};
        pg8::gemm_phase<pg8::EpiResid, pg8::PlainOrder, false>(ring, pg8::Gemm{D, D, D}, S, E); } SEAM(PH_FOXOUT);
    XATTN(1, PH_NORMX1, PH_XS1, PH_XO1, (bf16*)nullptr, (const float*)nullptr, (float*)nullptr)
    if (IN(PH_NORMF1)) { p_norm_route(F, A); } SEAM(PH_NORMF1);
    if (IN(PH_ROUTE2)) { p_route2(F); } SEAM(PH_ROUTE2);
    if (IN(PH_MOEGU)) { MoeOrder S{WSP(bf16, R_AG), WSP(bf16, WS_W_MOEGU), WSP(int, WS_SMALL + SM_TILEE), D, 44, (size_t)2 * DFF * D, F.G, cb, false}; pg8::EpiSwiGLU E{WSP(bf16, R_ACTG), DFF, nullptr};
        pg8::gemm_phase<pg8::EpiSwiGLU, MoeOrder, true>(ring, pg8::Gemm{D, D, D}, S, E); } SEAM(PH_MOEGU);
    if (IN(PH_MOED)) {
        { MoeOrder S{WSP(bf16, R_ACTG), WSP(bf16, WS_W_MOED), WSP(int, WS_SMALL + SM_TILEE), DFF, 8, (size_t)D * DFF, F.G, cb, true}; pg8::EpiBf16N E{WSP(bf16, R_YG), D};
          pg8::gemm_phase<pg8::EpiBf16N, MoeOrder, true>(ring, pg8::Gemm{DFF, DFF, DFF}, S, E); }
        { MoeSplitOrder S{WSP(bf16, R_ACTG), WSP(bf16, WS_W_MOED), WSP(int, WS_SMALL + SM_TILEE), DFF, 8, DFF / MOE_KSPLIT, (size_t)D * DFF, F.G, cb}; const int nt_ = WSP(int, WS_SMALL + SM_TILEE)[0]; pg8::EpiF32Split E{WSP(bf16, R_YG), WSP(float, R_YSIDE), YSIDE_STRIDE, D, ((nt_ * 8) / F.G) * F.G / 8};
          pg8::gemm_phase<pg8::EpiF32Split, MoeSplitOrder, false>(ring, pg8::Gemm{DFF, DFF, DFF / MOE_KSPLIT}, S, E); } } SEAM(PH_MOED);
    if (IN(PH_FINAL)) { p_final(F, A); }
#undef XATTN
#undef IN
#undef SEAM
}

#ifndef MK_ONE_LAUNCH
#define MK_ONE_LAUNCH 1
#endif
extern "C" void kernel_launch(void* const* d_in, const int* in_sizes, int n_in, void* d_out, int out_size, void* d_ws, size_t ws_size, hipStream_t stream) {
    static int ready = 0;
    if (ready == 0) {
        if (n_in != N_IN || in_sizes[0] != T * D || out_size != T * D || ws_size < WS_END) {
            fprintf(stderr, "kernel_launch: built for %d inputs, x/out of %d floats, >= %zu bytes of workspace; got n_in %d, in0 %d, out %d, ws %zu; nothing launched\n", N_IN, T * D, (size_t)WS_END, n_in, n_in > 0 ? in_sizes[0] : -1, out_size, ws_size);
            ready = -1; return; }
        if (hipFuncSetAttribute((const void*)trunk_fwd, hipFuncAttributeMaxDynamicSharedMemorySize, LDS_BYTES) != hipSuccess) { fprintf(stderr, "kernel_launch: hipFuncSetAttribute failed\n"); ready = -1; return; }
        int per_cu = 0;
        if (hipOccupancyMaxActiveBlocksPerMultiprocessor(&per_cu, (const void*)trunk_fwd, NWAVES * 64, LDS_BYTES) != hipSuccess || per_cu < 1)
            fprintf(stderr, "kernel_launch: note: occupancy query reports %d workgroups per CU\n", per_cu);
        (void)hipGetLastError();
        ready = 1;
    }
    if (ready < 0) return;
    const int grid = 256;
    if (hipMemsetAsync((char*)d_ws + WS_CTL, 0, CTL_ZERO_BYTES, stream) != hipSuccess) { fprintf(stderr, "kernel_launch: hipMemsetAsync failed\n"); return; }
    Args a{};
    for (int i = 0; i < N_IN; ++i) a.in[i] = (const float*)d_in[i];
    a.out = (float*)d_out; a.ws = (unsigned char*)d_ws;
#if MK_ONE_LAUNCH
    a.ph_lo = 0; a.ph_hi = N_PHASES;
    hipLaunchKernelGGL(trunk_fwd, dim3(grid), dim3(NWAVES * 64), LDS_BYTES, stream, a);
#else
    for (int p = 0; p < N_PHASES; ++p) { a.ph_lo = p; a.ph_hi = p + 1;
        hipLaunchKernelGGL(trunk_fwd, dim3(grid), dim3(NWAVES * 64), LDS_BYTES, stream, a); }
#endif
    const hipError_t le = hipPeekAtLastError();
    if (le != hipSuccess) fprintf(stderr, "kernel_launch: launch failed: %s\n", hipGetErrorName(le));
}
```

```cpp
#include <hip/hip_runtime.h>
#include <cstdio>
#include <cstdint>

#define GAS __attribute__((address_space(1)))
#define LAS __attribute__((address_space(3)))
typedef unsigned short bf16;
typedef short bf16x8 __attribute__((ext_vector_type(8)));
typedef short s16x4 __attribute__((ext_vector_type(4)));
typedef float f32x2 __attribute__((ext_vector_type(2)));
typedef float f32x4 __attribute__((ext_vector_type(4)));
typedef float f32x16 __attribute__((ext_vector_type(16)));
typedef unsigned u32x2 __attribute__((ext_vector_type(2)));
typedef unsigned u32x4 __attribute__((ext_vector_type(4)));

constexpr int T = 8192, D = 2048, NMEM = 256, DFF = 5632, NEXP = 8;
constexpr int A_COLS = 3520, AB_COLS = 7624, AB_PAD = 7680;
constexpr int FOX_LD = 8208;
constexpr int NH_R = 16, NH_M = 4, NH_F = 16;
constexpr int MOE_ROWS = 72 * 256;

__device__ __forceinline__ float bf2f(unsigned b) { return __uint_as_float(b << 16); }
__device__ __forceinline__ unsigned cvt_pk_bf16(float lo, float hi) { unsigned r; asm volatile("v_cvt_pk_bf16_f32 %0, %1, %2" : "=v"(r) : "v"(lo), "v"(hi)); return r; }
__device__ __forceinline__ bf16 f2bf(float f) { return (bf16)(cvt_pk_bf16(f, 0.f) & 0xffffu); }
__device__ __forceinline__ float wave_sum(float v) {
#pragma unroll
    for (int o = 1; o < 64; o <<= 1) v += __shfl_xor(v, o);
    return v;
}
__device__ __forceinline__ float wave_max(float v) {
#pragma unroll
    for (int o = 1; o < 64; o <<= 1) v = fmaxf(v, __shfl_xor(v, o));
    return v;
}
__device__ __forceinline__ float wave_sum_dpp(float x) {
#define DPPF_(v, ctrl) __builtin_bit_cast(float, __builtin_amdgcn_update_dpp(0, __builtin_bit_cast(int, v), ctrl, 0xF, 0xF, true))
    x += DPPF_(x, 0xB1); x += DPPF_(x, 0x4E); x += DPPF_(x, 0x141); x += DPPF_(x, 0x140);
#undef DPPF_
    const float a = __builtin_bit_cast(float, __builtin_amdgcn_readlane(__builtin_bit_cast(int, x), 0)), b = __builtin_bit_cast(float, __builtin_amdgcn_readlane(__builtin_bit_cast(int, x), 16));
    const float c = __builtin_bit_cast(float, __builtin_amdgcn_readlane(__builtin_bit_cast(int, x), 32)), d = __builtin_bit_cast(float, __builtin_amdgcn_readlane(__builtin_bit_cast(int, x), 48));
    return (a + b) + (c + d);
}
__device__ __forceinline__ float wave_scan_dpp(float x) {
#define DPPS_(v, ctrl, rmask, bc) __builtin_bit_cast(float, __builtin_amdgcn_update_dpp(0, __builtin_bit_cast(int, v), ctrl, rmask, 0xF, bc))
    x += DPPS_(x, 0x111, 0xF, true); x += DPPS_(x, 0x112, 0xF, true); x += DPPS_(x, 0x114, 0xF, true); x += DPPS_(x, 0x118, 0xF, true);
    x += DPPS_(x, 0x142, 0xA, false); x += DPPS_(x, 0x143, 0xC, false);
#undef DPPS_
    return x;
}
__device__ __forceinline__ float sigmoidf_(float x) { return __builtin_amdgcn_rcpf(1.0f + __expf(-x)); }
__device__ __forceinline__ float logsigmoidf_(float x) { return fminf(x, 0.f) - log1pf(__expf(-fabsf(x))); }

namespace pg8 {
#define PG8_LAS __attribute__((address_space(3)))
typedef unsigned short bf16_t;
constexpr int BM = 256, BK = 64, HALF = 128, HTB = HALF * BK * 2  , STAGE_BYTES = 8 * HTB, NXCD = 8, WGM = 8;

__host__ __device__ __forceinline__ int lds_byte(int r, int c) { const int st = (r >> 4) * 2 + (c >> 5), rr = r & 15, cc = c & 31, ob = rr * 64 + cc * 2; return st * 1024 + (ob ^ (((ob >> 9) & 1) << 5)); }
__host__ __device__ __forceinline__ void stage_rc(int b, int& R, int& C) { const int st = b / 1024, sb = b % 1024, swz = sb ^ (((sb >> 9) & 1) << 5); R = (st >> 1) * 16 + swz / 64; C = (st & 1) * 32 + (swz % 64) / 2; }
__host__ __device__ __forceinline__ int perm32(int rho) { const int n = rho >> 4, i = rho & 15; return 8 * (i >> 2) + 4 * n + (i & 3); }

struct Unit { const char* a; const char* b; int pm, pn, aux, pad; };
struct Gemm { int lda, ldb, K; };

__device__ __forceinline__ bool static_tile(int i, int G, int c, int nM, int nN, int& pm, int& pn) {
    const int nwg = nM * nN; const long L = (long)i * G + c; if (L >= nwg) return false;
    int wgid = (int)L; { const int q = nwg / NXCD, r = nwg % NXCD, xcd = wgid % NXCD, off = wgid / NXCD; wgid = (xcd < r ? xcd * (q + 1) : r * (q + 1) + (xcd - r) * q) + off; }
    const int nig = WGM * nN, gid = wgid / nig, fm = gid * WGM, gsz = (nM - fm) < WGM ? (nM - fm) : WGM;
    pm = fm + ((wgid % nig) % gsz); pn = (wgid % nig) / gsz; return true;
}
struct PlainOrder {
    const bf16_t* A; const bf16_t* Bt; int lda, ldb, nM, nN, G, c;
    __device__ __forceinline__ bool next(int i, Unit& u) const {
        int pm, pn; if (!static_tile(i, G, c, nM, nN, pm, pn)) return false;
        u.pm = pm; u.pn = pn; u.aux = 0; u.pad = 0; u.a = (const char*)(A + (size_t)pm * BM * lda); u.b = (const char*)(Bt + (size_t)pn * BM * ldb); return true;
    }
};

#ifndef PG8_WT
#define PG8_WT 0
#endif
template <class V> __device__ __forceinline__ void st16(void* p, const V v) {
    if (PG8_WT) asm volatile("global_store_dwordx4 %0, %1, off sc1\n\ts_nop 1" :: "v"(p), "v"(v)); else *(V*)p = v; }
template <class V> __device__ __forceinline__ void st8(void* p, const V v) {
    if (PG8_WT) asm volatile("global_store_dwordx2 %0, %1, off sc1" :: "v"(p), "v"(v)); else *(V*)p = v; }
struct EpiF32 {
    static constexpr bool PERM = false;
    float* C; int ldc; int aux_cols; float scale;
    __device__ __forceinline__ void operator()(const f32x4 (&acc)[2][2][4][2], const Unit& u, int wr, int wc, int fr, int fq) const {
        const int row0 = u.pm * BM + wr * 64 + fr, col0 = u.pn * BM + u.aux * aux_cols + wc * 32 + 4 * fq;
#pragma unroll
        for (int ai = 0; ai < 2; ++ai)
#pragma unroll
            for (int m = 0; m < 4; ++m) { float* rowp = C + (size_t)(row0 + ai * HALF + m * 16) * ldc + col0;
#pragma unroll
                for (int bj = 0; bj < 2; ++bj)
#pragma unroll
                    for (int n = 0; n < 2; ++n) st16(rowp + bj * HALF + n * 16, (f32x4)(acc[ai][bj][m][n] * scale)); }
    }
};
struct EpiBf16N {
    static constexpr bool PERM = false;
    bf16_t* O; int ldc;
    __device__ __forceinline__ void operator()(const f32x4 (&acc)[2][2][4][2], const Unit& u, int wr, int wc, int fr, int fq) const {
        const int row0 = u.pm * BM + wr * 64 + fr, col0 = u.pn * BM + wc * 32 + 4 * fq;
#pragma unroll
        for (int ai = 0; ai < 2; ++ai)
#pragma unroll
            for (int m = 0; m < 4; ++m) { bf16_t* rowp = O + (size_t)(row0 + ai * HALF + m * 16) * ldc + col0;
#pragma unroll
                for (int bj = 0; bj < 2; ++bj)
#pragma unroll
                    for (int n = 0; n < 2; ++n) { const f32x4 x = acc[ai][bj][m][n]; u32x2 w; w.x = cvt_pk_bf16(x[0], x[1]); w.y = cvt_pk_bf16(x[2], x[3]); st8(rowp + bj * HALF + n * 16, w); } }
    }
};
struct EpiF32Split {
    static constexpr bool PERM = false;
    bf16_t* C; float* side; size_t side_stride; int ldc; int pm0;
    __device__ __forceinline__ void operator()(const f32x4 (&acc)[2][2][4][2], const Unit& u, int wr, int wc, int fr, int fq) const {
        const int row0 = wr * 64 + fr, col0 = u.pn * BM + wc * 32 + 4 * fq; const bool first = u.aux == 0;
        bf16_t* cb = C + (size_t)u.pm * BM * ldc; float* sb = side + (size_t)(first ? 0 : u.aux - 1) * side_stride + (size_t)(u.pm - pm0) * BM * ldc;
#pragma unroll
        for (int ai = 0; ai < 2; ++ai)
#pragma unroll
            for (int m = 0; m < 4; ++m) { const size_t ro = (size_t)(row0 + ai * HALF + m * 16) * ldc + col0;
#pragma unroll
                for (int bj = 0; bj < 2; ++bj)
#pragma unroll
                    for (int n = 0; n < 2; ++n) { const f32x4 x = acc[ai][bj][m][n];
                        if (first) { u32x2 w; w.x = cvt_pk_bf16(x[0], x[1]); w.y = cvt_pk_bf16(x[2], x[3]); st8(cb + ro + bj * HALF + n * 16, w); }
                        else st16(sb + ro + bj * HALF + n * 16, x); } }
    }
};
struct EpiResid {
    static constexpr bool PERM = false;
    const float* base; float* out; int ldc; bf16_t* xn; const float* gn; float* ssq;
    __device__ __forceinline__ void operator()(const f32x4 (&acc)[2][2][4][2], const Unit& u, int wr, int wc, int fr, int fq) const {
        const int row0 = u.pm * BM + wr * 64 + fr, col0 = u.pn * BM + wc * 32 + 4 * fq;
        f32x4 gv[2][2];
        if (xn) {
#pragma unroll
            for (int bj = 0; bj < 2; ++bj)
#pragma unroll
                for (int n = 0; n < 2; ++n) gv[bj][n] = *(const f32x4*)(gn + col0 + bj * HALF + n * 16); }
#pragma unroll
        for (int ai = 0; ai < 2; ++ai)
#pragma unroll
            for (int m = 0; m < 4; ++m) { const int row = row0 + ai * HALF + m * 16; const size_t off = (size_t)row * ldc + col0; float ss = 0.f;
#pragma unroll
                for (int bj = 0; bj < 2; ++bj)
#pragma unroll
                    for (int n = 0; n < 2; ++n) { const f32x4 b = *(const f32x4*)(base + off + bj * HALF + n * 16); const f32x4 x = b + acc[ai][bj][m][n]; st16(out + off + bj * HALF + n * 16, x);
                        if (xn) { ss += (x[0] * x[0] + x[1] * x[1]) + (x[2] * x[2] + x[3] * x[3]); const f32x4 y = x * gv[bj][n];
                            u32x2 w; w.x = cvt_pk_bf16(y[0], y[1]); w.y = cvt_pk_bf16(y[2], y[3]); *(u32x2*)(xn + off + bj * HALF + n * 16) = w; } }
                if (xn) { ss += __shfl_xor(ss, 16); ss += __shfl_xor(ss, 32); if (fq == 0) __hip_atomic_fetch_add(ssq + row, ss, __ATOMIC_RELAXED, __HIP_MEMORY_SCOPE_AGENT); } }
    }
};
struct EpiBf16 {
    static constexpr bool PERM = true;
    bf16_t* O; int ldc; float* side; int side_pn; const float* ssq;
    __device__ __forceinline__ void operator()(const f32x4 (&acc)[2][2][4][2], const Unit& u, int wr, int wc, int fr, int fq) const {
        const int row0 = u.pm * BM + wr * 64 + fr, col0 = u.pn * BM + wc * 32 + 8 * fq;
#pragma unroll
        for (int ai = 0; ai < 2; ++ai)
#pragma unroll
            for (int m = 0; m < 4; ++m) { bf16_t* rowp = O + (size_t)(row0 + ai * HALF + m * 16) * ldc + col0;
                const float rs = ssq ? 1.0f / sqrtf(ssq[row0 + ai * HALF + m * 16] * (1.0f / 2048.0f) + 1e-6f) : 1.0f;
#pragma unroll
                for (int bj = 0; bj < 2; ++bj) { const f32x4 v0 = acc[ai][bj][m][0] * rs, v1 = acc[ai][bj][m][1] * rs;
                    u32x4 w; w.x = cvt_pk_bf16(v0[0], v0[1]); w.y = cvt_pk_bf16(v0[2], v0[3]); w.z = cvt_pk_bf16(v1[0], v1[1]); w.w = cvt_pk_bf16(v1[2], v1[3]);
                    st16(rowp + bj * HALF, w); } }
        if (side != nullptr && u.pn == side_pn) {
#pragma unroll
            for (int ai = 0; ai < 2; ++ai)
#pragma unroll
                for (int m = 0; m < 4; ++m) { float* rowp = side + (size_t)(row0 + ai * HALF + m * 16) * 256 + wc * 32 + 8 * fq;
#pragma unroll
                    for (int bj = 0; bj < 2; ++bj) { st16(rowp + bj * HALF, acc[ai][bj][m][0]); st16(rowp + bj * HALF + 4, acc[ai][bj][m][1]); } }
        }
    }
};
struct EpiSwiGLU {
    static constexpr bool PERM = true;
    bf16_t* O; int ldc; const float* ssq;
    __device__ __forceinline__ void operator()(const f32x4 (&acc)[2][2][4][2], const Unit& u, int wr, int wc, int fr, int fq) const {
        const int row0 = u.pm * BM + wr * 64 + fr, col0 = u.pn * HALF + wc * 32 + 8 * fq;
#pragma unroll
        for (int ai = 0; ai < 2; ++ai)
#pragma unroll
            for (int m = 0; m < 4; ++m) { bf16_t* rowp = O + (size_t)(row0 + ai * HALF + m * 16) * ldc + col0;
                const float rs = ssq ? 1.0f / sqrtf(ssq[row0 + ai * HALF + m * 16] * (1.0f / 2048.0f) + 1e-6f) : 1.0f;
                float o[8];
#pragma unroll
                for (int n = 0; n < 2; ++n)
#pragma unroll
                    for (int j = 0; j < 4; ++j) { const float g = acc[ai][0][m][n][j] * rs, up = acc[ai][1][m][n][j] * rs;
                        o[n * 4 + j] = g * __builtin_amdgcn_rcpf(1.0f + __builtin_amdgcn_exp2f(-1.4426950408889634f * g)) * up; }
                u32x4 w; w.x = cvt_pk_bf16(o[0], o[1]); w.y = cvt_pk_bf16(o[2], o[3]); w.z = cvt_pk_bf16(o[4], o[5]); w.w = cvt_pk_bf16(o[6], o[7]);
                st16(rowp, w); }
    }
};

template <class E, class = void> struct epi_after_drain { static constexpr bool value = false; };
template <class E> struct epi_after_drain<E, decltype((void)E::AFTER_DRAIN)> { static constexpr bool value = E::AFTER_DRAIN; };
struct EpiSoftmaxBf16 {
    static constexpr bool PERM = false, AFTER_DRAIN = true;
    bf16_t* P; int ldc; int aux_cols; float scale;
    __device__ __forceinline__ void fused(f32x4 (&acc)[2][2][4][2], const Unit& u, int wr, int wc, int fr, int fq, PG8_LAS unsigned char* lds) const {
        PG8_LAS float* pm = (PG8_LAS float*)lds;
        PG8_LAS float* ps = pm + 1024;
        float mx[2][4];
#pragma unroll
        for (int ai = 0; ai < 2; ++ai)
#pragma unroll
            for (int m = 0; m < 4; ++m) { float v = -3.0e38f;
#pragma unroll
                for (int bj = 0; bj < 2; ++bj)
#pragma unroll
                    for (int n = 0; n < 2; ++n) { acc[ai][bj][m][n] = acc[ai][bj][m][n] * scale; const f32x4 x = acc[ai][bj][m][n]; v = fmaxf(v, fmaxf(fmaxf(x[0], x[1]), fmaxf(x[2], x[3]))); }
                v = fmaxf(v, __shfl_xor(v, 16)); v = fmaxf(v, __shfl_xor(v, 32)); mx[ai][m] = v;
                if (fq == 0) pm[(ai * HALF + wr * 64 + m * 16 + fr) * 4 + wc] = v; }
        asm volatile("s_waitcnt lgkmcnt(0)" ::: "memory"); __builtin_amdgcn_s_barrier(); asm volatile("" ::: "memory");
        float sm[2][4];
#pragma unroll
        for (int ai = 0; ai < 2; ++ai)
#pragma unroll
            for (int m = 0; m < 4; ++m) { const f32x4 p4 = *(const PG8_LAS f32x4*)(pm + (ai * HALF + wr * 64 + m * 16 + fr) * 4); const float mr = fmaxf(fmaxf(p4[0], p4[1]), fmaxf(p4[2], p4[3])); float s = 0.f;
#pragma unroll
                for (int bj = 0; bj < 2; ++bj)
#pragma unroll
                    for (int n = 0; n < 2; ++n) { f32x4 x = acc[ai][bj][m][n];
#pragma unroll
                        for (int j = 0; j < 4; ++j) { x[j] = __expf(x[j] - mr); s += x[j]; }
                        acc[ai][bj][m][n] = x; }
                s += __shfl_xor(s, 16); s += __shfl_xor(s, 32); sm[ai][m] = s;
                if (fq == 0) ps[(ai * HALF + wr * 64 + m * 16 + fr) * 4 + wc] = s; }
        asm volatile("s_waitcnt lgkmcnt(0)" ::: "memory"); __builtin_amdgcn_s_barrier(); asm volatile("" ::: "memory");
        const int row0 = u.pm * BM + wr * 64 + fr, col0 = u.pn * BM + u.aux * aux_cols + wc * 32 + 4 * fq;
#pragma unroll
        for (int ai = 0; ai < 2; ++ai)
#pragma unroll
            for (int m = 0; m < 4; ++m) { const f32x4 s4 = *(const PG8_LAS f32x4*)(ps + (ai * HALF + wr * 64 + m * 16 + fr) * 4); const float inv = 1.0f / ((s4[0] + s4[1]) + (s4[2] + s4[3]));
                bf16_t* rowp = P + (size_t)(row0 + ai * HALF + m * 16) * ldc + col0;
#pragma unroll
                for (int bj = 0; bj < 2; ++bj)
#pragma unroll
                    for (int n = 0; n < 2; ++n) { const f32x4 x = acc[ai][bj][m][n] * inv; u32x2 w; w.x = cvt_pk_bf16(x[0], x[1]); w.y = cvt_pk_bf16(x[2], x[3]); st8(rowp + bj * HALF + n * 16, w); } }
        (void)mx; (void)sm;
    }
};

template <class Epi, class Sched, bool ALIGN_EPI>
__device__ __forceinline__ void gemm_phase(PG8_LAS unsigned char* lds, const Gemm g, const Sched& S, const Epi& E) {
    const int tid = threadIdx.x, wid = __builtin_amdgcn_readfirstlane(tid >> 6), lane = tid & 63, wr = wid >> 2, wc = wid & 3, fr = lane & 15, fq = lane >> 4;
    const int K = g.K, nt = K / BK;
    unsigned voffA[2], voffB[2];
#pragma unroll
    for (int i = 0; i < 2; ++i) { int R, C; stage_rc(tid * 16 + i * 8192, R, C); const int Rb = Epi::PERM ? ((R & ~31) + perm32(R & 31)) : R;
        voffA[i] = (unsigned)(R * g.lda + C) * 2u; voffB[i] = (unsigned)(Rb * g.ldb + C) * 2u; }
    const size_t kstep = (size_t)(BK * 2);
    const size_t hstepA = (size_t)HALF * g.lda * 2, hstepB = (size_t)HALF * g.ldb * 2;
    const unsigned ldsw = (unsigned)wid * 1024u;
    const int aoff = lds_byte(wr * 64 + fr, fq * 8), boff = lds_byte(wc * 32 + fr, fq * 8);
#define PG8_SA(b, h) (((b) * 2 + (h)) * HTB)
#define PG8_SB(b, h) ((4 + (b) * 2 + (h)) * HTB)
#define PG8_STAGE(bufoff, gbase, voff) do { _Pragma("unroll") for (int _i = 0; _i < 2; ++_i) \
        __builtin_amdgcn_global_load_lds((const unsigned*)((const char*)(gbase) + (voff)[_i]), (PG8_LAS unsigned*)(lds + (bufoff) + ldsw + _i * 8192), 16, 0, 0); } while (0)
#define PG8_LDA(dst, b, h) do { _Pragma("unroll") for (int m = 0; m < 4; ++m) _Pragma("unroll") for (int k = 0; k < 2; ++k) dst[m][k] = *(const PG8_LAS bf16x8*)(lds + PG8_SA(b, h) + aoff + m * 2048 + k * 1024); } while (0)
#define PG8_LDB(dst, b, h) do { _Pragma("unroll") for (int n = 0; n < 2; ++n) _Pragma("unroll") for (int k = 0; k < 2; ++k) dst[n][k] = *(const PG8_LAS bf16x8*)(lds + PG8_SB(b, h) + boff + n * 2048 + k * 1024); } while (0)
#define PG8_MMA(ai, bj, At, Bt) do { __builtin_amdgcn_s_setprio(1); _Pragma("unroll") for (int m = 0; m < 4; ++m) _Pragma("unroll") for (int n = 0; n < 2; ++n) _Pragma("unroll") for (int k = 0; k < 2; ++k) \
        acc[ai][bj][m][n] = __builtin_amdgcn_mfma_f32_16x16x32_bf16(Bt[n][k], At[m][k], acc[ai][bj][m][n], 0, 0, 0); __builtin_amdgcn_s_setprio(0); } while (0)
#define PG8_WAIT_V(n) asm volatile("s_waitcnt vmcnt(" #n ")" ::: "memory")
#define PG8_WAIT_L(n) asm volatile("s_waitcnt lgkmcnt(" #n ")" ::: "memory")
#define PG8_BAR __builtin_amdgcn_s_barrier()
#define PG8_SCHED __builtin_amdgcn_sched_barrier(0)
    Unit cur, nxt; int ui = 0;
    if (!S.next(0, cur)) return;
    f32x4 acc[2][2][4][2];
#pragma unroll
    for (int a = 0; a < 2; ++a)
#pragma unroll
        for (int b = 0; b < 2; ++b)
#pragma unroll
            for (int m = 0; m < 4; ++m)
#pragma unroll
                for (int n = 0; n < 2; ++n) acc[a][b][m][n] = (f32x4){0.f, 0.f, 0.f, 0.f};
    bf16x8 At[4][2], B0[2][2], B1[2][2];
    const char* cA = cur.a; const char* cB = cur.b;
    PG8_STAGE(PG8_SB(0, 0), cB, voffB); PG8_STAGE(PG8_SB(0, 1), cB + hstepB, voffB); PG8_STAGE(PG8_SA(0, 0), cA, voffA); PG8_STAGE(PG8_SA(0, 1), cA + hstepA, voffA);
    if (wr == 1) PG8_BAR;
    PG8_WAIT_V(2); PG8_BAR;
    PG8_STAGE(PG8_SB(1, 0), cB + kstep, voffB); PG8_STAGE(PG8_SA(1, 0), cA + kstep, voffA); PG8_STAGE(PG8_SB(1, 1), cB + hstepB + kstep, voffB);
    PG8_WAIT_V(6); PG8_BAR;
    for (;;) {
        const bool has_next = S.next(ui + 1, nxt);
        const char* nA = has_next ? nxt.a : cA; const char* nB = has_next ? nxt.b : cB;
        for (int t = 0; t < nt; t += 2) {
            const bool last = (t == nt - 2);
            const char* a1 = cA + (size_t)(t + 1) * kstep;
            const char* a2 = last ? nA : cA + (size_t)(t + 2) * kstep; const char* b2 = last ? nB : cB + (size_t)(t + 2) * kstep;
            const char* a3 = a2 + kstep; const char* b3 = b2 + kstep;
            PG8_LDB(B0, 0, 0); PG8_LDB(B1, 0, 1); PG8_SCHED; PG8_LDA(At, 0, 0); PG8_STAGE(PG8_SA(1, 1), a1 + hstepA, voffA);
            PG8_WAIT_V(8); PG8_WAIT_L(0); PG8_BAR; PG8_MMA(0, 0, At, B0); PG8_MMA(0, 1, At, B1); PG8_BAR; PG8_SCHED;
            PG8_LDA(At, 0, 1); PG8_STAGE(PG8_SB(0, 0), b2, voffB); PG8_STAGE(PG8_SB(0, 1), b2 + hstepB, voffB); PG8_STAGE(PG8_SA(0, 0), a2, voffA);
            PG8_WAIT_V(8); PG8_WAIT_L(0); PG8_BAR; PG8_MMA(1, 0, At, B0); PG8_MMA(1, 1, At, B1); PG8_BAR; PG8_SCHED;
            PG8_LDB(B0, 1, 0); PG8_LDB(B1, 1, 1); PG8_SCHED; PG8_LDA(At, 1, 0); PG8_STAGE(PG8_SA(0, 1), a2 + hstepA, voffA);
            PG8_WAIT_V(8); PG8_WAIT_L(0); PG8_BAR; PG8_MMA(0, 0, At, B0); PG8_MMA(0, 1, At, B1); PG8_BAR; PG8_SCHED;
            PG8_LDA(At, 1, 1); PG8_STAGE(PG8_SB(1, 0), b3, voffB); PG8_STAGE(PG8_SB(1, 1), b3 + hstepB, voffB); PG8_STAGE(PG8_SA(1, 0), a3, voffA);
            PG8_WAIT_V(8); PG8_WAIT_L(0); PG8_BAR; PG8_MMA(1, 0, At, B0); PG8_MMA(1, 1, At, B1); PG8_BAR; PG8_SCHED;
        }
        if constexpr (ALIGN_EPI) { if (wr == 0) PG8_BAR; }
        if constexpr (!epi_after_drain<Epi>::value) E(acc, cur, wr, wc, fr, fq);
        if (!has_next) break;
#pragma unroll
        for (int a = 0; a < 2; ++a)
#pragma unroll
            for (int b = 0; b < 2; ++b)
#pragma unroll
                for (int m = 0; m < 4; ++m)
#pragma unroll
                    for (int n = 0; n < 2; ++n) acc[a][b][m][n] = (f32x4){0.f, 0.f, 0.f, 0.f};
        cur = nxt; cA = nA; cB = nB; ++ui;
        if constexpr (ALIGN_EPI) { if (wr == 1) PG8_BAR; }
    }
    PG8_WAIT_V(0);
    if constexpr (!ALIGN_EPI) { if (wr == 0) PG8_BAR; }
    PG8_BAR;
    if constexpr (epi_after_drain<Epi>::value) E.fused(acc, cur, wr, wc, fr, fq, lds);
#undef PG8_SA
#undef PG8_SB
#undef PG8_STAGE
#undef PG8_LDA
#undef PG8_LDB
#undef PG8_MMA
#undef PG8_WAIT_V
#undef PG8_WAIT_L
#undef PG8_BAR
#undef PG8_SCHED
}
}

namespace fox {
constexpr int D = 128, LDQ = 8192, LDO = 2048;
constexpr float SCALE = 0.08838834764831845f;
constexpr float THR2 = 8.f * 1.4426950408889634f;
constexpr int NW = 8, QBLK = 32, KVBLK = 64, QB = NW * QBLK;
constexpr int SHM_V = KVBLK * D * 2, SHM_K = KVBLK * D * 2;
constexpr int BIAS_OFF = 2 * SHM_V + 2 * SHM_K + NW * 64 * 4;
constexpr int LDS_BYTES = BIAS_OFF + 8192 * 4;

#define KSWZ(row, colB) ((row) * 256 + ((colB) ^ (((row) & 7) << 4)))
#define SBAR() __builtin_amdgcn_sched_barrier(0)
__device__ __forceinline__ int v_st(int k, int c) { const int kk = (k & ~0xC) | ((k & 4) << 1) | ((k & 8) >> 1); return ((kk >> 3) * 4 + (c >> 5)) * 512 + ((kk & 7) * 32 + (c & 31)) * 2; }
__device__ __forceinline__ int v_rd_base(int lane) { return ((lane & 3) << 3) | (((lane >> 2) & 3) << 6) | (((lane >> 4) & 1) << 5) | (((lane >> 5) & 1) << 8); }
constexpr int v_rd_off(int d0, int ks, int half) { return d0 * 512 + ks * 4096 + half * 2048; }
__device__ __forceinline__ int crow(int r, int hi) { return (r & 3) + 8 * (r >> 2) + 4 * hi; }
__device__ __forceinline__ unsigned cvtpk(float lo, float hi) { unsigned r; asm volatile("v_cvt_pk_bf16_f32 %0, %1, %2" : "=v"(r) : "v"(lo), "v"(hi)); return r; }
__device__ __forceinline__ bf16x8 load8(const bf16* p) { return *reinterpret_cast<const bf16x8*>(p); }
__device__ __forceinline__ void mask_tile(f32x16& p0, f32x16& p1, int dq) {
    const float NEG = -__builtin_inff();
#pragma unroll
    for (int r = 0; r < 16; ++r) {
        const int c = (r & 3) + 8 * (r >> 2);
        if (dq - c < 0) p0[r] = NEG;
        if (dq - c - 32 < 0) p1[r] = NEG;
    }
}
__device__ __forceinline__ void partialSM(f32x16& p0, f32x16& p1, float& m_reg, float& mn, float& alpha, const float* bl) {
    constexpr float C2 = 1.4426950408889634f * SCALE;
#pragma unroll
    for (int a = 0; a < 4; ++a) {
#ifdef FOX_NOBIAS
        const f32x4 b0 = {0,0,0,0}, b1 = {0,0,0,0};
#else
        const f32x4 b0 = *(const f32x4*)(bl + 8 * a), b1 = *(const f32x4*)(bl + 32 + 8 * a);
#endif

#pragma unroll
        for (int i = 0; i < 4; ++i) { p0[4 * a + i] = fmaf(p0[4 * a + i], C2, b0[i]); p1[4 * a + i] = fmaf(p1[4 * a + i], C2, b1[i]); }
        SBAR(); }
    float pmax = p0[0]; for (int r = 1; r < 16; ++r) pmax = fmaxf(pmax, p0[r]); for (int r = 0; r < 16; ++r) pmax = fmaxf(pmax, p1[r]);
    { auto rr = __builtin_amdgcn_permlane32_swap(__float_as_uint(pmax), __float_as_uint(pmax), false, false);
      pmax = fmaxf(__uint_as_float(rr[0]), __uint_as_float(rr[1])); }
    if (__builtin_expect(__all((pmax - m_reg) <= THR2), 1)) { mn = m_reg; alpha = 1.f; }
    else { mn = fmaxf(m_reg, pmax); alpha = __builtin_amdgcn_exp2f(m_reg - mn); m_reg = mn; }
    for (int r = 0; r < 16; ++r) p0[r] = p0[r] - mn; for (int r = 0; r < 16; ++r) p1[r] = p1[r] - mn;
    for (int r = 0; r < 16; ++r) p0[r] = __builtin_amdgcn_exp2f(p0[r]);
}
__device__ __forceinline__ void finishSM(f32x16& p0, f32x16& p1, float alpha, float& l_reg, bf16x8& pa0, bf16x8& pa1, bf16x8& pa2, bf16x8& pa3) {
    for (int r = 0; r < 16; ++r) p1[r] = __builtin_amdgcn_exp2f(p1[r]);
    float ps = 0; for (int r = 0; r < 16; ++r) ps += p0[r]; for (int r = 0; r < 16; ++r) ps += p1[r];
    { auto rr = __builtin_amdgcn_permlane32_swap(__float_as_uint(ps), __float_as_uint(ps), false, false);
      ps = __uint_as_float(rr[0]) + __uint_as_float(rr[1]); }
    l_reg = l_reg * alpha + ps;
#define PK4(P, B_, OUT) do { unsigned a0 = cvtpk(P[B_+0], P[B_+1]), a1 = cvtpk(P[B_+2], P[B_+3]);                          \
        unsigned b0 = cvtpk(P[B_+4], P[B_+5]), b1 = cvtpk(P[B_+6], P[B_+7]);                                             \
        auto r0 = __builtin_amdgcn_permlane32_swap(a0, b0, false, false); auto r1 = __builtin_amdgcn_permlane32_swap(a1, b1, false, false); \
        u32x4 w = {r0[0], r1[0], r0[1], r1[1]}; OUT = *reinterpret_cast<bf16x8*>(&w); } while (0)
    PK4(p0, 0, pa0); PK4(p0, 8, pa1); PK4(p1, 0, pa2); PK4(p1, 8, pa3);
#undef PK4
}
template <int KB>
__device__ __forceinline__ void qkt(f32x16& p0, f32x16& p1, const char* K_lds, int r32, int hi, const bf16x8* qr) {
    p0 = f32x16{}; p1 = f32x16{};
    const char* kb[4];
#pragma unroll
    for (int dd = 0; dd < 4; ++dd) kb[dd] = K_lds + KB * SHM_K + KSWZ(r32, (dd * 16 + hi * 8) * 2);
#pragma unroll
    for (int d0 = 0; d0 < 8; ++d0) { const char* a = kb[d0 & 3] + (d0 >> 2) * 128;
        bf16x8 b0 = *reinterpret_cast<const bf16x8*>(a);
        bf16x8 b1 = *reinterpret_cast<const bf16x8*>(a + 32 * 256);
        p0 = __builtin_amdgcn_mfma_f32_32x32x16_bf16(b0, qr[d0], p0, 0, 0, 0);
        p1 = __builtin_amdgcn_mfma_f32_32x32x16_bf16(b1, qr[d0], p1, 0, 0, 0); }
}
template <int VB>
__device__ __forceinline__ void pv_tile(f32x16* o, int vb0, bf16x8 pa0, bf16x8 pa1, bf16x8 pa2, bf16x8 pa3) {
#define TRRD(dst, off) asm volatile("ds_read_b64_tr_b16 %0, %1 offset:%2" : "=&v"(dst) : "v"(vb0), "i"(off) : "memory")
#define PV_D0(d0) do { s16x4 l0, l1, l2, l3, h0, h1, h2, h3; constexpr int b_ = VB * SHM_V + v_rd_off(d0, 0, 0); \
        TRRD(l0, b_); TRRD(h0, b_ + 2048); TRRD(l1, b_ + 4096); TRRD(h1, b_ + 6144); TRRD(l2, b_ + 8192); TRRD(h2, b_ + 10240); TRRD(l3, b_ + 12288); TRRD(h3, b_ + 14336); \
        asm volatile("s_waitcnt lgkmcnt(0)" ::: "memory"); SBAR();   \
        o[d0] = __builtin_amdgcn_mfma_f32_32x32x16_bf16(pa0, (bf16x8){l0[0], l0[1], l0[2], l0[3], h0[0], h0[1], h0[2], h0[3]}, o[d0], 0, 0, 0);   \
        o[d0] = __builtin_amdgcn_mfma_f32_32x32x16_bf16(pa1, (bf16x8){l1[0], l1[1], l1[2], l1[3], h1[0], h1[1], h1[2], h1[3]}, o[d0], 0, 0, 0);   \
        o[d0] = __builtin_amdgcn_mfma_f32_32x32x16_bf16(pa2, (bf16x8){l2[0], l2[1], l2[2], l2[3], h2[0], h2[1], h2[2], h2[3]}, o[d0], 0, 0, 0);   \
        o[d0] = __builtin_amdgcn_mfma_f32_32x32x16_bf16(pa3, (bf16x8){l3[0], l3[1], l3[2], l3[3], h3[0], h3[1], h3[2], h3[3]}, o[d0], 0, 0, 0); } while (0)
    PV_D0(0); PV_D0(1); PV_D0(2); PV_D0(3);
#undef PV_D0
#undef TRRD
}

struct BlockRef { const bf16* Q; const bf16* K; const bf16* V; const bf16* G; bf16* O; int P0; };
struct Seam { bf16x8 qr[8]; bf16x8 st_v0, st_v1, st_k0, st_k1; };
#define LD8(base, boff) (*reinterpret_cast<const bf16x8*>((const char*)(base) + (boff)))
#define VMW() asm volatile("s_waitcnt vmcnt(0)" ::: "memory")
#define VMWN(n) asm volatile("s_waitcnt vmcnt(%0)" :: "i"(n) : "memory")
#define SLOAD_H(Kp, Vp, k0) do { const char* kb__ = (const char*)(Kp) + (size_t)(k0) * (LDQ * 2); const char* vb__ = (const char*)(Vp) + (size_t)(k0) * (LDQ * 2); \
                         S.st_v0 = LD8(vb__, kvoff); S.st_v1 = LD8(vb__, kvoff + 32u * LDQ * 2u);              \
                         S.st_k0 = LD8(kb__, kvoff); S.st_k1 = LD8(kb__, kvoff + 32u * LDQ * 2u); } while (0)
#define SWRITE_HK(bf) do { *(bf16x8*)(K_lds + (bf) * SHM_K + kws) = S.st_k0; *(bf16x8*)(K_lds + (bf) * SHM_K + kws + 32 * 256) = S.st_k1; } while (0)
#define SWRITE_HV(bf) do { *(bf16x8*)(V_lds + (bf) * SHM_V + vst0) = S.st_v0; *(bf16x8*)(V_lds + (bf) * SHM_V + vst1) = S.st_v1; } while (0)
#define SWRITE_H(bf) do { SWRITE_HV(bf); SWRITE_HK(bf); } while (0)
__device__ __forceinline__ void prime(const BlockRef& cur, char* lds, Seam& S) {
    const int tid = threadIdx.x, wid = __builtin_amdgcn_readfirstlane(tid >> 6), lane = tid & 63, r32 = lane & 31, hi = lane >> 5;
    const int sr = tid >> 4, sc = (tid & 15) * 8, kws = KSWZ(sr, sc * 2); char* K_lds = lds + 2 * SHM_V;
    const unsigned kvoff = (unsigned)(sr * LDQ + sc) * 2u, qoff = (unsigned)((wid * QBLK + r32) * LDQ + hi * 8) * 2u;
    for (int d0 = 0; d0 < 8; ++d0) S.qr[d0] = LD8(cur.Q, qoff + d0 * 32);
    SLOAD_H(cur.K, cur.V, 0); VMW(); SWRITE_HK(0);
    __syncthreads();
}
__device__ __forceinline__ void block(const BlockRef& cur, const BlockRef& nxt, char* lds, Seam& S) {
    const int tid = threadIdx.x, wid = __builtin_amdgcn_readfirstlane(tid >> 6), lane = tid & 63, r32 = lane & 31, hi = lane >> 5;
    const int NT = (cur.P0 + QB - 1) / KVBLK + 1;
    const int qlo = cur.P0 + wid * QBLK, qm = qlo + r32 - 4 * hi;
    char* V_lds = lds; char* K_lds = lds + 2 * SHM_V;
    float* ws = (float*)(lds + 2 * SHM_V + 2 * SHM_K) + wid * 64; float* li_l = ws, * al_l = ws + 32;
    const float* biasl = (const float*)(lds + BIAS_OFF) + 4 * hi;
    float m_reg = -1e30f, l_reg = 0; f32x16 o[4] = {};
    const int sr = tid >> 4, sc = (tid & 15) * 8, vst0 = v_st(sr, sc), vst1 = v_st(32 + sr, sc), kws = KSWZ(sr, sc * 2);
    const unsigned kvoff = (unsigned)(sr * LDQ + sc) * 2u;
    const int vb0 = (int)(uintptr_t)V_lds + v_rd_base(lane);
    const bf16* Kh = cur.K; const bf16* Vh = cur.V;
#define RESC(a) do { if (__any((a) < 1.f)) { if (hi == 0) al_l[r32] = (a); asm volatile("s_waitcnt lgkmcnt(0)" ::: "memory");              \
                     for (int d_ = 0; d_ < 4; ++d_) for (int r = 0; r < 16; ++r) o[d_][r] *= al_l[crow(r, hi)]; } } while (0)
#define KBASE(t) ((t) * KVBLK)
#define MASKT(P0_, P1_, t) do { const int kb_ = KBASE(t); if (kb_ + KVBLK - 1 > qlo) mask_tile(P0_, P1_, qm - kb_); } while (0)
    constexpr int NQL = 8;
#define SEAM_K0() do { VMWN(NQL); SWRITE_HK(0); SBAR(); } while (0)
    f32x16 pA0, pA1, pB0, pB1; float mnA, mnB, alA, alB; bf16x8 pa0, pa1, pa2, pa3;
    SWRITE_HV(0); SBAR();
    if (NT > 1) { SLOAD_H(Kh, Vh, KBASE(1)); }
    SBAR(); qkt<0>(pA0, pA1, K_lds, r32, hi, S.qr);
    MASKT(pA0, pA1, 0); partialSM(pA0, pA1, m_reg, mnA, alA, biasl + KBASE(0));
    if (NT > 1) { VMW(); SWRITE_H(1); }
    __syncthreads();
#define HALF_STEP(PX0, PX1, mnX, alX, PY0, PY1, alY, t, KB, VB, SB) do {                                                      \
        SBAR(); qkt<KB>(PX0, PX1, K_lds, r32, hi, S.qr);                                                                      \
        finishSM(PY0, PY1, alY, l_reg, pa0, pa1, pa2, pa3); SBAR();                                                           \
        if ((t) + 1 < NT) { SLOAD_H(Kh, Vh, KBASE((t) + 1)); SBAR(); }                                                        \
        pv_tile<VB>(o, vb0, pa0, pa1, pa2, pa3); MASKT(PX0, PX1, (t)); partialSM(PX0, PX1, m_reg, mnX, alX, biasl + KBASE(t)); \
        __syncthreads();                                                                                                      \
        if ((t) + 1 < NT) { VMW(); SWRITE_H(SB); }                                                                            \
        RESC(alX); __syncthreads(); } while (0)
    for (int t = 1; t + 1 < NT; t += 2) {
        HALF_STEP(pB0, pB1, mnB, alB, pA0, pA1, alA, t, 1, 0, 0);
        HALF_STEP(pA0, pA1, mnA, alA, pB0, pB1, alB, t + 1, 0, 1, 1);
    }
    const bool even = (NT & 1) == 0;
    if (even) { SBAR(); qkt<1>(pB0, pB1, K_lds, r32, hi, S.qr); SBAR(); }
    SLOAD_H(nxt.K, nxt.V, 0); SBAR();
    { unsigned qoff = (unsigned)((wid * QBLK + r32) * LDQ + hi * 8) * 2u; asm volatile("" : "+v"(qoff));
#pragma unroll
      for (int d0 = 0; d0 < 8; ++d0) S.qr[d0] = LD8(nxt.Q, qoff + d0 * 32); }
    SBAR();
    finishSM(pA0, pA1, alA, l_reg, pa0, pa1, pa2, pa3); SBAR();
    pv_tile<0>(o, vb0, pa0, pa1, pa2, pa3);
    if (even) { MASKT(pB0, pB1, NT - 1); partialSM(pB0, pB1, m_reg, mnB, alB, biasl + KBASE(NT - 1)); __syncthreads(); RESC(alB);
        finishSM(pB0, pB1, alB, l_reg, pa0, pa1, pa2, pa3); SBAR(); pv_tile<1>(o, vb0, pa0, pa1, pa2, pa3); }
    SBAR(); SEAM_K0();
    if (hi == 0) li_l[r32] = l_reg; asm volatile("s_waitcnt lgkmcnt(0)" ::: "memory");
    float rli[16];
#pragma unroll
    for (int r = 0; r < 16; ++r) rli[r] = __builtin_amdgcn_rcpf(li_l[crow(r, hi)]);
    unsigned ooff = (unsigned)((wid * QBLK + 4 * hi) * LDO + r32) * 2u, goff = (unsigned)((wid * QBLK + 4 * hi) * LDQ + r32) * 2u;
    asm volatile("" : "+v"(ooff), "+v"(goff));
#pragma unroll
    for (int r = 0; r < 16; ++r) { const unsigned rr = (unsigned)((r & 3) + 8 * (r >> 2));
#pragma unroll
        for (int d0 = 0; d0 < 4; ++d0) {
#ifdef FOX_NOGATE
            const float gv = 0.f;
#else
            const float gv = bf2f(*(const bf16*)((const char*)cur.G + (goff + rr * (LDQ * 2u) + d0 * 64u)));
#endif

            const float v = o[d0][r] * rli[r] * __builtin_amdgcn_rcpf(1.0f + __expf(-gv));
            const float vn = __shfl_xor(v, 1);
            if ((r32 & 1) == 0) *(unsigned*)((char*)cur.O + (ooff + rr * (LDO * 2u) + d0 * 64u)) = cvtpk(v, vn); } }
    __syncthreads();
#undef RESC
#undef KBASE
#undef MASKT
#undef SEAM_K0
#undef HALF_STEP
}
#undef LD8
#undef VMW
#undef VMWN
#undef SLOAD_H
#undef SWRITE_HK
#undef SWRITE_HV
#undef SWRITE_H
#undef KSWZ
#undef SBAR
}

constexpr int NWAVES = 8;
constexpr size_t MiB = 1u << 20;
constexpr size_t WS_CTL = 0, CTL_ZERO_BYTES = 1 * MiB;
constexpr size_t WS_MEMN = 1 * MiB;
constexpr size_t WS_KMEM = 2 * MiB;
constexpr size_t WS_VTMEM = 4 * MiB;
constexpr size_t WS_SMALL = 6 * MiB;
constexpr size_t SM_BONUS = 0;
constexpr size_t SM_FPRE = 512 * 1024;
constexpr size_t SM_BIASL2 = 1024 * 1024;
constexpr size_t SM_BCUM = 1536 * 1024;
constexpr size_t SM_IG = SM_BCUM + 128 * 1024;
constexpr size_t SM_WSTATE = SM_IG + 128 * 1024;
constexpr size_t SM_CHBL = SM_WSTATE + 128 * 1024;
constexpr size_t SM_CHMD = SM_CHBL + 4096;
constexpr size_t SM_MSEQ = SM_CHMD + 4096;
constexpr size_t SM_WCARRY = SM_MSEQ + 4096;
constexpr size_t SM_MOUT = SM_WCARRY + 4096;
constexpr size_t SM_TOPI = 2048 * 1024;
constexpr size_t SM_TOPG = SM_TOPI + 64 * 1024;
constexpr size_t SM_SLOT = SM_TOPG + 64 * 1024;
constexpr size_t SM_BLKCNT = SM_SLOT + 64 * 1024;
constexpr size_t SM_TILEE = SM_BLKCNT + 8192;
constexpr size_t SM_NU = 3 * 1024 * 1024;
constexpr size_t SM_SLOC = 4 * 1024 * 1024;
constexpr size_t SM_PEND = 5 * 1024 * 1024;
constexpr size_t SM_SIN = 6 * 1024 * 1024;
constexpr size_t WS_X = 16 * MiB;
constexpr size_t WS_XN = 80 * MiB;
constexpr size_t WS_W_XQ = 112 * MiB, WS_W_XKV = 128 * MiB, WS_W_XO = 160 * MiB, WS_W_ABIN = 176 * MiB, WS_W_LORA = 206 * MiB, WS_W_ABOUT = 209 * MiB,
                 WS_W_FFNGU = 217 * MiB, WS_W_FFND = 261 * MiB, WS_W_FOXIN = 283 * MiB, WS_W_FOXOUT = 315 * MiB, WS_W_MOEGU = 323 * MiB, WS_W_MOED = 675 * MiB;
constexpr size_t WS_R = 851 * MiB;
constexpr size_t R_PROJ = WS_R + 0 * MiB;
constexpr size_t R_GATES32 = WS_R + 120 * MiB;
constexpr size_t R_LORAIN = WS_R + 128 * MiB;
constexpr size_t R_LORAOUT = WS_R + 136 * MiB;
constexpr size_t R_SC = WS_R + 232 * MiB;
constexpr size_t SC_STRIDE = 32 * MiB;
constexpr size_t R_FR = WS_R + 232 * MiB;
constexpr size_t R_SV = WS_R + 392 * MiB;
constexpr size_t R_Y = WS_R + 424 * MiB;
constexpr size_t R_QB = WS_R + 456 * MiB, R_KB = WS_R + 472 * MiB, R_VB = WS_R + 488 * MiB;
constexpr size_t R_U = WS_R + 504 * MiB;
constexpr size_t R_YCAT = WS_R + 568 * MiB;
constexpr size_t R_XQ = WS_R + 0 * MiB;
constexpr size_t R_XS = WS_R + 32 * MiB;
constexpr size_t R_XP = WS_R + 64 * MiB;
constexpr size_t R_XO = WS_R + 80 * MiB;
constexpr size_t R_ACT = WS_R + 112 * MiB;
constexpr size_t R_QKVG = WS_R + 200 * MiB;
constexpr size_t R_ATTO = WS_R + 328 * MiB;
constexpr size_t R_AG = WS_R + 0 * MiB;
constexpr size_t R_ACTG = WS_R + 72 * MiB;
constexpr size_t R_YG = WS_R + 270 * MiB;
constexpr size_t R_YSIDE = WS_R + 416 * MiB;
constexpr size_t YSIDE_STRIDE = (size_t)8 * 256 * D;
constexpr size_t R_KQ = WS_R + 600 * MiB;
constexpr size_t R_VWT = WS_R + 608 * MiB;
constexpr size_t R_Z = WS_R + 616 * MiB;
constexpr size_t WS_END = WS_R + 624 * MiB;
static_assert(R_YG + (size_t)MOE_ROWS * D * 4 <= WS_END && R_ACTG + (size_t)MOE_ROWS * DFF * 2 <= R_YG && R_YCAT + (size_t)T * D * 2 <= WS_END, "ws map");
static_assert(WS_W_MOED + (size_t)NEXP * D * DFF * 2 <= WS_R && WS_W_MOEGU + (size_t)NEXP * 2 * DFF * D * 2 <= WS_W_MOED, "ws map (weights)");
constexpr int CW_BAR = 4096;
constexpr size_t CTL_FRFLAG = 262144;
constexpr size_t CTL_SSQ = 65536;

constexpr int RING_OFF = 0, RING_BYTES = 155648;
constexpr int LDSCTL_OFF = RING_BYTES, MISC_OFF = LDSCTL_OFF + 320;
constexpr int LDS_BYTES = RING_BYTES + 4096;

typedef GAS unsigned gu32;
#define RLX_AGENT __ATOMIC_RELAXED, __HIP_MEMORY_SCOPE_AGENT
#define LDS_WAIT() asm volatile("s_waitcnt lgkmcnt(0)" ::: "memory")
#define VM_WAIT() asm volatile("s_waitcnt vmcnt(0)" ::: "memory")

#define XB_TMO      128
#define XB_XCNT(j)  (256  + 64 * (j))
#define XB_XSUB(j)  (1280 + 64 * (j))
#define XB_XGEN(j)  (2304 + 64 * (j))
#define XB_TOP      3328
#define XB_TOPGEN   3392
#define XCD_BAR_WORDS 3456
#define XB_SPIN_CAP (1u << 18)
__device__ __forceinline__ unsigned xb_ld(unsigned* p)              { return __hip_atomic_load(p, __ATOMIC_RELAXED, __HIP_MEMORY_SCOPE_AGENT); }
__device__ __forceinline__ unsigned xb_add(unsigned* p, unsigned v) { return __hip_atomic_fetch_add(p, v, __ATOMIC_RELAXED, __HIP_MEMORY_SCOPE_AGENT); }
__device__ __forceinline__ unsigned xb_xcc_id() { return (unsigned)__builtin_amdgcn_s_getreg((3 << 11) | 20) & 0xFu; }
#define XB_SPIN(cond, bar) do { unsigned _sp = 0; while (cond) { __builtin_amdgcn_s_sleep(1); \
    if ((++_sp & 255u) == 0u) { if (xb_ld(&(bar)[XB_TMO])) break; if (_sp > XB_SPIN_CAP) { atomicAdd(&(bar)[XB_TMO], 1u); break; } } } } while (0)
struct XcdBarrier { unsigned* bar; unsigned x; volatile LAS unsigned* st; };
__device__ __forceinline__ XcdBarrier xcd_barrier_post(unsigned* bar, volatile LAS unsigned* st) {
    XcdBarrier b; b.bar = bar; b.x = xb_xcc_id(); b.st = st;
    if (threadIdx.x == 0) (void)xb_add(&bar[XB_XCNT(b.x)], 1u);
    return b;
}
__device__ __forceinline__ void xcd_barrier_complete(unsigned* bar, unsigned x, unsigned& nloc, unsigned& nx) {
    const unsigned G = gridDim.x * gridDim.y * gridDim.z;
    unsigned sum, cnt, mine, sp = 0u;
    for (;;) {
        sum = 0u; cnt = 0u; mine = 0u;
#pragma unroll
        for (unsigned j = 0; j < 16; ++j) { const unsigned c = xb_ld(&bar[XB_XCNT(j)]); sum += c; cnt += (c > 0u) ? 1u : 0u; mine = (j == x) ? c : mine; }
        if (sum == G) break;
        __builtin_amdgcn_s_sleep(1);
        if ((++sp & 255u) == 0u) { if (xb_ld(&bar[XB_TMO])) break; if (sp > XB_SPIN_CAP) { atomicAdd(&bar[XB_TMO], 1u); break; } }
    }
    nloc = mine > 0u ? mine : 1u; nx = cnt > 0u ? cnt : 1u;
}
__device__ __forceinline__ void xcd_barrier(const XcdBarrier& b) {
    asm volatile("s_waitcnt vmcnt(0)" ::: "memory");
    __syncthreads();
    if (threadIdx.x == 0) {
        unsigned* bar = b.bar;
        __builtin_amdgcn_s_waitcnt(0);
        unsigned nloc = b.st[0], nx = b.st[1];
        if (nloc == 0u) { xcd_barrier_complete(bar, b.x, nloc, nx); b.st[0] = nloc; b.st[1] = nx; }
        const unsigned old = xb_add(&bar[XB_XSUB(b.x)], 1u);
        const unsigned gen = old / nloc;
        if (old + 1u == (gen + 1u) * nloc) {
            __builtin_amdgcn_fence(__ATOMIC_RELEASE, "agent");
            asm volatile("s_waitcnt vmcnt(0)" ::: "memory");
            const unsigned og = xb_add(&bar[XB_TOP], 1u);
            const unsigned tg = og / nx;
            if (og + 1u == (tg + 1u) * nx) xb_add(&bar[XB_TOPGEN], 1u);
            else XB_SPIN(xb_ld(&bar[XB_TOPGEN]) == tg, bar);
            __builtin_amdgcn_fence(__ATOMIC_ACQUIRE, "agent");
            xb_add(&bar[XB_XGEN(b.x)], 1u);
            asm volatile("s_waitcnt vmcnt(0)" ::: "memory");
        } else {
            XB_SPIN(xb_ld(&bar[XB_XGEN(b.x)]) == gen, bar);
            __builtin_amdgcn_fence(__ATOMIC_ACQUIRE, "agent");
            asm volatile("s_waitcnt vmcnt(0)" ::: "memory");
        }
    }
    __syncthreads();
}

struct Frame {
    LAS unsigned char* lds; unsigned char* ldsg;
    unsigned char* ws; const float* const* in; float* out;
    int tid, lane, wave, vcu, G, gw, NGW;
};

enum InIdx { I_X = 0, I_MEM, I_MEMG, I_FING, I_NMIXG, I_NXAG, I_NFFNG, I_XWQ, I_XWKV, I_XWO, I_ABWIN, I_ABMU, I_RWW0, I_RWWUP, I_RWA0, I_RWAUP, I_RWGUP, I_RWKK, I_RWKA, I_RWRK,
             I_RWLNG, I_RWLNB, I_MLCONV, I_MLBIF, I_MLNG, I_ABWOUT, I_FFG, I_FFU, I_FFD, I_FOXWIN, I_FOXBF, I_FOXQG, I_FOXKG, I_FOXWOUT, I_ROUTER, I_MOEG, I_MOEU, I_MOED, N_IN };
struct Args { const float* in[N_IN]; float* out; unsigned char* ws; int ph_lo, ph_hi; };
static_assert(sizeof(Args) == (N_IN + 2) * 8 + 8, "Args has no padding");

#define WSP(T_, off) ((T_*)(F.ws + (off)))

__device__ __forceinline__ void rms_row(const float* xrow, const float* g, bf16* orow, int lane, f32x4 (&y)[8]) {
    const f32x4* xr = (const f32x4*)xrow + lane; const f32x4* gr = (const f32x4*)g + lane;
    float s = 0.f;
#pragma unroll
    for (int j = 0; j < 8; ++j) { y[j] = xr[64 * j]; s += (y[j][0] * y[j][0] + y[j][1] * y[j][1]) + (y[j][2] * y[j][2] + y[j][3] * y[j][3]); }
    const float r = 1.0f / sqrtf(wave_sum(s) * (1.0f / D) + 1e-6f);
#pragma unroll
    for (int j = 0; j < 8; ++j) { const f32x4 gv = gr[64 * j]; y[j] = y[j] * r * gv; }
    if (orow) { u32x2* o8 = (u32x2*)orow + lane;
#pragma unroll
        for (int j = 0; j < 8; ++j) { u32x2 w; w.x = cvt_pk_bf16(y[j][0], y[j][1]); w.y = cvt_pk_bf16(y[j][2], y[j][3]); o8[64 * j] = w; } }
}
__device__ __forceinline__ void rms_load(const float* xrow, int lane, f32x4 (&x)[8]) {
    const f32x4* xr = (const f32x4*)xrow + lane;
#pragma unroll
    for (int j = 0; j < 8; ++j) x[j] = xr[64 * j];
}
__device__ __forceinline__ void rms_fin(f32x4 (&y)[8], const f32x4 (&gv)[8], bf16* orow, int lane) {
    float s = 0.f;
#pragma unroll
    for (int j = 0; j < 8; ++j) s += (y[j][0] * y[j][0] + y[j][1] * y[j][1]) + (y[j][2] * y[j][2] + y[j][3] * y[j][3]);
    const float r = 1.0f / sqrtf(wave_sum_dpp(s) * (1.0f / D) + 1e-6f);
    u32x2* o8 = (u32x2*)orow + lane;
#pragma unroll
    for (int j = 0; j < 8; ++j) { y[j] = y[j] * r * gv[j]; u32x2 w; w.x = cvt_pk_bf16(y[j][0], y[j][1]); w.y = cvt_pk_bf16(y[j][2], y[j][3]); o8[64 * j] = w; }
}
template <class Body>
__device__ __forceinline__ void rms_rows4(const float* X, const float* g, bf16* XN, int lane, int t0, int t1, int t2, int t3, Body body) {
    f32x4 gv[8], xa[8], xb[8];
#pragma unroll
    for (int j = 0; j < 8; ++j) gv[j] = ((const f32x4*)g + lane)[64 * j];
#define RR_SB() __builtin_amdgcn_sched_barrier(0)
    rms_load(X + (size_t)t0 * D, lane, xa); RR_SB(); rms_load(X + (size_t)t1 * D, lane, xb); RR_SB();
    rms_fin(xa, gv, XN + (size_t)t0 * D, lane); body(t0, xa); RR_SB(); rms_load(X + (size_t)t2 * D, lane, xa); RR_SB();
    rms_fin(xb, gv, XN + (size_t)t1 * D, lane); body(t1, xb); RR_SB(); rms_load(X + (size_t)t3 * D, lane, xb); RR_SB();
    rms_fin(xa, gv, XN + (size_t)t2 * D, lane); body(t2, xa); RR_SB();
    rms_fin(xb, gv, XN + (size_t)t3 * D, lane); body(t3, xb);
#undef RR_SB
}
__device__ __forceinline__ void norm_phase(const Frame& F, const float* X, const float* g, bf16* XN, int nrows) {
    if (nrows == 4 * F.NGW) { rms_rows4(X, g, XN, F.lane, F.gw, F.gw + F.NGW, F.gw + 2 * F.NGW, F.gw + 3 * F.NGW, [](int, f32x4 (&)[8]) {}); return; }
    for (int t = F.gw; t < nrows; t += F.NGW) { f32x4 y[8]; rms_row(X + (size_t)t * D, g, XN + (size_t)t * D, F.lane, y); }
}
template <int NC>
__device__ __forceinline__ void stage_skinny(const Frame& F, const float* W, int ldw, int c0, LAS float* Ws) {
    constexpr int Q = NC / 4, PER = D * Q / (NWAVES * 64);
    f32x4 r[PER];
#pragma unroll
    for (int k = 0; k < PER; ++k) { const int idx = F.tid + NWAVES * 64 * k, e = idx / Q, q = idx % Q; r[k] = *(const f32x4*)(W + (size_t)e * ldw + c0 + 4 * q); }
#pragma unroll
    for (int k = 0; k < PER; ++k) { const int idx = F.tid + NWAVES * 64 * k, e = idx / Q, q = idx % Q;
#pragma unroll
        for (int j = 0; j < 4; ++j) Ws[(4 * q + j) * D + e] = r[k][j]; }
}
__device__ __forceinline__ void rms_fin_g(f32x4 (&y)[8], const float* g, bf16* orow, int lane) {
    float s = 0.f;
#pragma unroll
    for (int j = 0; j < 8; ++j) s += (y[j][0] * y[j][0] + y[j][1] * y[j][1]) + (y[j][2] * y[j][2] + y[j][3] * y[j][3]);
    const float r = 1.0f / sqrtf(wave_sum_dpp(s) * (1.0f / D) + 1e-6f);
    u32x2* o8 = (u32x2*)orow + lane;
#pragma unroll
    for (int j = 0; j < 8; ++j) { const f32x4 gv = ((const f32x4*)g + lane)[64 * j]; y[j] = y[j] * r * gv; u32x2 w; w.x = cvt_pk_bf16(y[j][0], y[j][1]); w.y = cvt_pk_bf16(y[j][2], y[j][3]); o8[64 * j] = w; }
}
template <int NC>
__device__ __forceinline__ void rms_rows4_dots(const float* X, const float* g, bf16* XN, int lane, int t0, int t1, int t2, int t3, const LAS float* Ws, float (&oa)[NC], float (&ob)[NC], float (&oc)[NC], float (&od)[NC]) {
    f32x4 ya[8], yb[8], yc[8], yd[8];
    rms_load(X + (size_t)t0 * D, lane, ya); rms_load(X + (size_t)t1 * D, lane, yb); rms_load(X + (size_t)t2 * D, lane, yc); rms_load(X + (size_t)t3 * D, lane, yd);
    __builtin_amdgcn_sched_barrier(0);
#define RD_PAIR(p_, q_, tp_, tq_, o0, o1) do { rms_fin_g(p_, g, XN + (size_t)(tp_) * D, lane); rms_fin_g(q_, g, XN + (size_t)(tq_) * D, lane); \
        _Pragma("unroll") for (int c = 0; c < NC; ++c) { float s0 = 0.f, s1 = 0.f; \
            _Pragma("unroll") for (int j = 0; j < 8; ++j) { const f32x4 w = *(const LAS f32x4*)(Ws + c * D + 256 * j + 4 * lane); const f32x4 a = p_[j], b = q_[j]; \
                s0 += (a[0] * w[0] + a[1] * w[1]) + (a[2] * w[2] + a[3] * w[3]); s1 += (b[0] * w[0] + b[1] * w[1]) + (b[2] * w[2] + b[3] * w[3]); } \
            o0[c] = wave_sum_dpp(s0); o1[c] = wave_sum_dpp(s1); } } while (0)
    RD_PAIR(ya, yb, t0, t1, oa, ob); __builtin_amdgcn_sched_barrier(0); RD_PAIR(yc, yd, t2, t3, oc, od);
#undef RD_PAIR
}
template <int NC>
__device__ __forceinline__ void skinny_dot(const f32x4 (&y)[8], const LAS float* Ws, int lane, float (&out)[NC]) {
#pragma unroll
    for (int c = 0; c < NC; ++c) { float s = 0.f;
#pragma unroll
        for (int j = 0; j < 8; ++j) { const f32x4 w = *(const LAS f32x4*)(Ws + c * D + 256 * j + 4 * lane); s += (y[j][0] * w[0] + y[j][1] * w[1]) + (y[j][2] * w[2] + y[j][3] * w[3]); }
        out[c] = wave_sum_dpp(s); }
}

constexpr int TD_OFF = RING_OFF + 8 * 16384, TD_WORDS = 10, TD_MAX = 48;
struct TStream { LAS int* tab; int n, items; };
__device__ __forceinline__ TStream ts_begin(const Frame& F) { TStream S; S.tab = (LAS int*)(F.lds + TD_OFF); S.n = 0; S.items = 0; return S; }
__device__ __forceinline__ void ts_add(const Frame& F, TStream& S, const float* W, int ldw, int K, int N, bf16* WT, int mode) {
    const int nblk = (N + 31) / 32;
    if (F.tid == 0) { LAS int* d = S.tab + S.n * TD_WORDS; const unsigned long long w = (unsigned long long)W, t = (unsigned long long)WT;
        d[0] = (int)(unsigned)w; d[1] = (int)(unsigned)(w >> 32); d[2] = (int)(unsigned)t; d[3] = (int)(unsigned)(t >> 32); d[4] = ldw; d[5] = K; d[6] = N; d[7] = mode; d[8] = nblk; d[9] = S.items; }
    S.items += (K / 64) * nblk; ++S.n;
}
__device__ __forceinline__ int ts_u(const LAS int* p) { return __builtin_amdgcn_readfirstlane(*p); }
#define TS_GAS __attribute__((address_space(1)))
struct TItem { TS_GAS bf16* dst; int K, nvalid; };
__device__ __forceinline__ void ts_load(const LAS int* tab, int& m, int r, int lane, f32x4 (&v)[8], TItem& it) {
    while (r >= ts_u(tab + (m + 1) * TD_WORDS + 9)) ++m;
    const LAS int* d = tab + m * TD_WORDS;
    const int local = r - ts_u(d + 9), nblk = ts_u(d + 8), kb = local / nblk, n0 = 32 * (local - kb * nblk), N = ts_u(d + 6), K = ts_u(d + 5), ldw = ts_u(d + 4), mode = ts_u(d + 7);
    const TS_GAS float* W = (const TS_GAS float*)(((unsigned long long)(unsigned)ts_u(d + 1) << 32) | (unsigned long long)(unsigned)ts_u(d + 0));
    TS_GAS bf16* WT = (TS_GAS bf16*)(((unsigned long long)(unsigned)ts_u(d + 3) << 32) | (unsigned long long)(unsigned)ts_u(d + 2));
    const int nvalid = (N - n0) < 32 ? (N - n0) : 32, drow = mode == 0 ? n0 : ((n0 >> 7) * 256 + (n0 & 127) + (mode == 2 ? 128 : 0));
    it.dst = WT + (size_t)drow * K + 64 * kb; it.K = K; it.nvalid = nvalid;
    const TS_GAS float* p = W + (size_t)(64 * kb + (lane >> 3)) * ldw + n0 + 4 * (lane & 7); const bool ok = 4 * (lane & 7) < nvalid;
#pragma unroll
    for (int i = 0; i < 8; ++i) v[i] = ok ? __builtin_nontemporal_load((const TS_GAS f32x4*)(p + (size_t)(8 * i) * ldw)) : (f32x4){0.f, 0.f, 0.f, 0.f};
}
__device__ __forceinline__ void ts_finish(const f32x4 (&v)[8], const TItem& it, LAS float* scr, int lane) {
    { LAS float* w = scr + (lane >> 3) * 33 + 4 * (lane & 7);
#pragma unroll
      for (int i = 0; i < 8; ++i)
#pragma unroll
          for (int j = 0; j < 4; ++j) w[(8 * i) * 33 + j] = v[i][j]; }
    LDS_WAIT(); asm volatile("" ::: "memory");
    const int c = lane >> 3; float t[32];
#pragma unroll
    for (int j = 0; j < 4; ++j)
#pragma unroll
        for (int q = 0; q < 8; ++q) t[8 * j + q] = scr[(8 * c + q) * 33 + (lane & 7) + 8 * j];
    LDS_WAIT(); asm volatile("" ::: "memory"); __builtin_amdgcn_sched_barrier(0);
#pragma unroll
    for (int j = 0; j < 4; ++j) { const int n = (lane & 7) + 8 * j;
        u32x4 o; o.x = cvt_pk_bf16(t[8 * j], t[8 * j + 1]); o.y = cvt_pk_bf16(t[8 * j + 2], t[8 * j + 3]); o.z = cvt_pk_bf16(t[8 * j + 4], t[8 * j + 5]); o.w = cvt_pk_bf16(t[8 * j + 6], t[8 * j + 7]);
        if (n < it.nvalid) __builtin_nontemporal_store(o, (TS_GAS u32x4*)(it.dst + (size_t)n * it.K + 8 * c)); }
}
__device__ __forceinline__ void ts_run(const Frame& F, TStream& S, int gw, int NGW, LAS float* scr) {
    if (F.tid == 0) S.tab[S.n * TD_WORDS + 9] = S.items;
    __syncthreads();
    const LAS int* tab = S.tab; const int nitems = S.items, lane = F.lane;
    if (gw < nitems) {
        const int n_my = (nitems - gw + NGW - 1) / NGW; int m = 0, i = 0;
        f32x4 va[8], vb[8], vc[8]; TItem ia, ib, ic;
#define TS_LOAD(v_, it_, i_) ts_load(tab, m, gw + (i_) * NGW, lane, v_, it_)
        TS_LOAD(va, ia, 0); if (n_my > 1) TS_LOAD(vb, ib, 1);
        for (; i + 4 < n_my; i += 3) {
            TS_LOAD(vc, ic, i + 2); ts_finish(va, ia, scr, lane);
            TS_LOAD(va, ia, i + 3); ts_finish(vb, ib, scr, lane);
            TS_LOAD(vb, ib, i + 4); ts_finish(vc, ic, scr, lane);
        }
        if (i + 2 < n_my) TS_LOAD(vc, ic, i + 2);
        ts_finish(va, ia, scr, lane);
        if (i + 1 < n_my) { if (i + 3 < n_my) TS_LOAD(va, ia, i + 3); ts_finish(vb, ib, scr, lane); }
        if (i + 2 < n_my) ts_finish(vc, ic, scr, lane);
        if (i + 3 < n_my) ts_finish(va, ia, scr, lane);
#undef TS_LOAD
    }
    __syncthreads();
}
__device__ __forceinline__ void p_wq_copy(const Frame& F, const Args& A, int gt, int NGT) {
    const f32x4* wq = (const f32x4*)A.in[I_XWQ]; u32x4* wqp = (u32x4*)WSP(bf16, WS_W_XQ); constexpr int N8 = 2 * D * D / 8;
    for (int i0 = gt; i0 < N8; i0 += 4 * NGT) { f32x4 a[4], b[4];
#pragma unroll
        for (int k = 0; k < 4; ++k) { const int i = i0 + k * NGT; if (i < N8) { a[k] = __builtin_nontemporal_load(wq + 2 * i); b[k] = __builtin_nontemporal_load(wq + 2 * i + 1); } }
#pragma unroll
        for (int k = 0; k < 4; ++k) { const int i = i0 + k * NGT; if (i < N8) { u32x4 o; o.x = cvt_pk_bf16(a[k][0], a[k][1]); o.y = cvt_pk_bf16(a[k][2], a[k][3]); o.z = cvt_pk_bf16(b[k][0], b[k][1]); o.w = cvt_pk_bf16(b[k][2], b[k][3]); wqp[i] = o; } } }
}
__device__ __forceinline__ void p_convert_early(const Frame& F, const Args& A) {
    LAS float* scr = (LAS float*)(F.lds + RING_OFF + F.wave * 16384);
    TStream TS = ts_begin(F);
    for (int l = 0; l < 2; ++l)
        ts_add(F, TS, A.in[I_XWKV] + (size_t)l * D * 2 * D, 2 * D, D, 2 * D, WSP(bf16, WS_W_XKV) + (size_t)l * 2 * D * D, 0);
    ts_add(F, TS, A.in[I_ABWIN], AB_COLS, D, AB_COLS, WSP(bf16, WS_W_ABIN), 0);
    for (int l = 0; l < 2; ++l) ts_add(F, TS, A.in[I_XWO] + (size_t)l * D * D, D, D, D, WSP(bf16, WS_W_XO) + (size_t)l * D * D, 0);
    ts_run(F, TS, F.gw, F.NGW, scr);
    const int gt = F.gw * 64 + F.lane, NGT = F.NGW * 64;
    { u32x4* z = (u32x4*)(WSP(bf16, WS_W_ABIN) + (size_t)AB_COLS * D); const int n16 = (AB_PAD - AB_COLS) * D * 2 / 16;
      for (int i = gt; i < n16; i += NGT) z[i] = (u32x4){0u, 0u, 0u, 0u}; }
    { bf16* WL = WSP(bf16, WS_W_LORA); const float* wup = A.in[I_RWWUP]; const float* aup = A.in[I_RWAUP]; const float* gup = A.in[I_RWGUP];
      for (int i = gt; i < 3072 * 64; i += NGT) { const int n = i >> 6, k8 = (i & 63) * 8; const int sec = n >> 10, nn = n & 1023; float v[8];
#pragma unroll
          for (int j = 0; j < 8; ++j) { const int k = k8 + j; float x = 0.f;
              if (sec == 0) { if (k < 96) x = wup[(size_t)k * 1024 + nn]; }
              else if (sec == 1) { if (k >= 96 && k < 192) x = aup[(size_t)(k - 96) * 1024 + nn]; }
              else { if (k >= 192 && k < 448) x = gup[(size_t)(k - 192) * 1024 + nn]; }
              v[j] = x; }
          u32x4 o; o.x = cvt_pk_bf16(v[0], v[1]); o.y = cvt_pk_bf16(v[2], v[3]); o.z = cvt_pk_bf16(v[4], v[5]); o.w = cvt_pk_bf16(v[6], v[7]);
          *(u32x4*)(WL + (size_t)n * 512 + k8) = o; } }
    norm_phase(F, A.in[I_MEM], A.in[I_MEMG], WSP(bf16, WS_MEMN), NMEM);
    norm_phase(F, A.in[I_X], A.in[I_NMIXG], WSP(bf16, WS_XN), T);
}
__device__ __forceinline__ void p_convert_late(const Frame& F, const Args& A, int gw, int NGW, LAS float* scr, bool with_dense, int e_lo, int e_hi) {
    TStream TS = ts_begin(F);
    if (with_dense) {
        ts_add(F, TS, A.in[I_ABWOUT], D, D, D, WSP(bf16, WS_W_ABOUT), 0);
        ts_add(F, TS, A.in[I_FFG], DFF, D, DFF, WSP(bf16, WS_W_FFNGU), 1);
        ts_add(F, TS, A.in[I_FFU], DFF, D, DFF, WSP(bf16, WS_W_FFNGU), 2);
        ts_add(F, TS, A.in[I_FFD], D, DFF, D, WSP(bf16, WS_W_FFND), 0);
        ts_add(F, TS, A.in[I_FOXWIN], FOX_LD, D, 8192, WSP(bf16, WS_W_FOXIN), 0);
        ts_add(F, TS, A.in[I_FOXWOUT], D, D, D, WSP(bf16, WS_W_FOXOUT), 0);
    }
    for (int e = e_lo; e < e_hi; ++e) {
        ts_add(F, TS, A.in[I_MOEG] + (size_t)e * D * DFF, DFF, D, DFF, WSP(bf16, WS_W_MOEGU) + (size_t)e * 2 * DFF * D, 1);
        ts_add(F, TS, A.in[I_MOEU] + (size_t)e * D * DFF, DFF, D, DFF, WSP(bf16, WS_W_MOEGU) + (size_t)e * 2 * DFF * D, 2);
        ts_add(F, TS, A.in[I_MOED] + (size_t)e * DFF * D, D, DFF, D, WSP(bf16, WS_W_MOED) + (size_t)e * D * DFF, 0);
    }
    ts_run(F, TS, gw, NGW, scr);
}

struct InprojKvOrder {
    const bf16* xn; const bf16* wabin; const bf16* memn; const bf16* wkv; int G, c;
    __device__ __forceinline__ bool next(int i, pg8::Unit& u) const {
        const int L = i * G + c; u.pad = 0;
        if (L < 32 * (AB_PAD / 256)) { int pm, pn; pg8::static_tile(i, G, c, 32, AB_PAD / 256, pm, pn); u.pm = pm; u.pn = pn; u.aux = -1;
            u.a = (const char*)(xn + (size_t)pm * 256 * D); u.b = (const char*)(wabin + (size_t)pn * 256 * D); return true; }
        const int j = L - 32 * (AB_PAD / 256); if (j >= 32) return false;
        const int l = j >> 4, kind = (j >> 3) & 1, idx = j & 7; const bf16* w = wkv + (size_t)l * 2 * D * D;
        if (kind == 0) { u.a = (const char*)memn; u.b = (const char*)(w + (size_t)idx * 256 * D); u.pm = 0; u.pn = idx; }
        else { u.a = (const char*)memn; u.b = (const char*)(w + (size_t)(D + idx * 256) * D); u.pm = 0; u.pn = idx; }
        u.aux = l * 2 + kind; return true;
    }
};
struct EpiInprojKv {
    static constexpr bool PERM = true;
    bf16* proj; float* gates32; bf16* kmem; bf16* vtmem;
    __device__ __forceinline__ void operator()(const f32x4 (&acc)[2][2][4][2], const pg8::Unit& u, int wr, int wc, int fr, int fq) const {
        if (u.aux < 0) { pg8::EpiBf16 E{proj, AB_PAD, gates32, 29, nullptr}; E(acc, u, wr, wc, fr, fq); }
        else { const int l = u.aux >> 1, kind = u.aux & 1;
            pg8::EpiBf16 E{(kind == 0 ? kmem : vtmem) + (size_t)l * NMEM * D, D, nullptr, -1, nullptr};
            E(acc, u, wr, wc, fr, fq); }
    }
};

__device__ __forceinline__ void p_prepa(const Frame& F, const Args& A) {
    const bf16* PROJ = WSP(bf16, R_PROJ); const float* mu = A.in[I_ABMU]; const float* convw = A.in[I_MLCONV];
    bf16* LIN = WSP(bf16, R_LORAIN); bf16* QB = WSP(bf16, R_QB); bf16* KB = WSP(bf16, R_KB);
    const int lane = F.lane;
    for (int t0 = 4 * F.gw; t0 < T; t0 += 4 * F.NGW) {
        bf16x8 cr[4][7], lr[5]; const bf16x8 zero8 = {0, 0, 0, 0, 0, 0, 0, 0};
#pragma unroll
        for (int i = 0; i < 4; ++i)
#pragma unroll
            for (int k = 0; k < 7; ++k) { const int tt = t0 - 3 + k; cr[i][k] = tt >= 0 ? *(const bf16x8*)(PROJ + (size_t)tt * AB_PAD + A_COLS + 8 * lane + 512 * i) : zero8; }
#pragma unroll
        for (int k = 0; k < 5; ++k) { const int tt = t0 - 1 + k; lr[k] = (tt >= 0 && lane < 56) ? *(const bf16x8*)(PROJ + (size_t)tt * AB_PAD + 3072 + 8 * lane) : zero8; }
        __builtin_amdgcn_sched_barrier(0);
        if (lane < 56) { const int cc = 8 * lane; float m[8];
            { const f32x4 m0 = *(const f32x4*)(mu + 3072 + cc), m1 = *(const f32x4*)(mu + 3072 + cc + 4); m[0] = m0[0]; m[1] = m0[1]; m[2] = m0[2]; m[3] = m0[3]; m[4] = m1[0]; m[5] = m1[1]; m[6] = m1[2]; m[7] = m1[3]; }
#pragma unroll
            for (int k = 0; k < 4; ++k) { float o[8];
#pragma unroll
                for (int j = 0; j < 8; ++j) { const float pv = bf2f((unsigned short)lr[k + 1][j]), pp = bf2f((unsigned short)lr[k][j]); const float sv = pv + (pp - pv) * m[j];
                    o[j] = cc < 96 ? (1.0f - 2.0f * __builtin_amdgcn_rcpf(__expf(2.0f * sv) + 1.0f)) : (cc < 192 ? sv : sigmoidf_(sv)); }
                u32x4 w; w.x = cvt_pk_bf16(o[0], o[1]); w.y = cvt_pk_bf16(o[2], o[3]); w.z = cvt_pk_bf16(o[4], o[5]); w.w = cvt_pk_bf16(o[6], o[7]);
                *(u32x4*)(LIN + (size_t)(t0 + k) * 512 + cc) = w; } }
        else {
#pragma unroll
            for (int k = 0; k < 4; ++k) *(u32x4*)(LIN + (size_t)(t0 + k) * 512 + 448 + 8 * (lane - 56)) = (u32x4){0u, 0u, 0u, 0u}; }
#pragma unroll
        for (int i = 0; i < 4; ++i) { const int c = 8 * lane + 512 * i; f32x4 w0[4], w1[4];
#pragma unroll
            for (int tap = 0; tap < 4; ++tap) { w0[tap] = *(const f32x4*)(convw + tap * 2048 + c); w1[tap] = *(const f32x4*)(convw + tap * 2048 + c + 4); }
            const float sc = c < 1024 ? 0.0625f : 1.0f;
#pragma unroll
            for (int k = 0; k < 4; ++k) { float acc[8];
#pragma unroll
                for (int j = 0; j < 8; ++j) acc[j] = 0.f;
#pragma unroll
                for (int tap = 0; tap < 4; ++tap)
#pragma unroll
                    for (int j = 0; j < 4; ++j) { acc[j] += bf2f((unsigned short)cr[i][k + tap][j]) * w0[tap][j]; acc[4 + j] += bf2f((unsigned short)cr[i][k + tap][4 + j]) * w1[tap][j]; }
                float o[8];
#pragma unroll
                for (int j = 0; j < 8; ++j) o[j] = acc[j] * sigmoidf_(acc[j]) * sc;
                u32x4 w; w.x = cvt_pk_bf16(o[0], o[1]); w.y = cvt_pk_bf16(o[2], o[3]); w.z = cvt_pk_bf16(o[4], o[5]); w.w = cvt_pk_bf16(o[6], o[7]);
                if (c < 1024) *(u32x4*)(QB + (size_t)(t0 + k) * 1024 + c) = w; else *(u32x4*)(KB + (size_t)(t0 + k) * 1024 + c - 1024) = w; } }
    }
    const float* G32 = WSP(float, R_GATES32); const float* bif = A.in[I_MLBIF];
    float* BCUM = WSP(float, WS_SMALL + SM_BCUM); float* IG = WSP(float, WS_SMALL + SM_IG); float* CHBL = WSP(float, WS_SMALL + SM_CHBL); float* CHMD = WSP(float, WS_SMALL + SM_CHMD);
    for (int u = F.gw; u < NH_M * 128; u += F.NGW) { const int h = u >> 7, c = u & 127, t = 64 * c + lane;
        const float ig = G32[(size_t)t * 256 + 192 + h] + bif[h], fg = G32[(size_t)t * 256 + 196 + h] + bif[4 + h];
        float b = logsigmoidf_(fg);
#pragma unroll
        for (int o = 1; o < 64; o <<= 1) { const float x = __shfl_up(b, o); if (lane >= o) b += x; }
        const float bl = __shfl(b, 63); const float md = wave_max(bl - b + ig);
        BCUM[h * T + t] = b; IG[h * T + t] = ig;
        if (lane == 0) { CHBL[u] = bl; CHMD[u] = md; } }
}

__device__ __forceinline__ void p_prepb(const Frame& F, const Args& A) {
    const bf16* PROJ = WSP(bf16, R_PROJ); const float* LOUT = WSP(float, R_LORAOUT); const float* mu = A.in[I_ABMU];
    const float* w0 = A.in[I_RWW0]; const float* a0 = A.in[I_RWA0]; const float* kk_ = A.in[I_RWKK]; const float* ka_ = A.in[I_RWKA]; const float* rk_ = A.in[I_RWRK];
    float* SR = WSP(float, R_SC); float* SW = WSP(float, R_SC + SC_STRIDE); float* SKM = WSP(float, R_SC + 2 * SC_STRIDE); float* SV = WSP(float, R_SC + 3 * SC_STRIDE);
    float* SKK = WSP(float, R_SC + 4 * SC_STRIDE); float* SB = WSP(float, R_SC + 5 * SC_STRIDE); float* BONUS = WSP(float, WS_SMALL + SM_BONUS);
    const int lane = F.lane;
    for (int u = F.gw; u < NH_R * (T / 64); u += F.NGW) { const int h = u & 15, tb = u >> 4, c = 64 * h + lane, t0 = 64 * tb;
        const float mur = mu[c], muk = mu[1024 + c], muv = mu[2048 + c], w0c = w0[c], a0c = a0[c], kkc = kk_[c], kac = ka_[c], rkc = rk_[c];
        float pr = 0.f, pk = 0.f, pv = 0.f;
        if (t0 > 0) { const bf16* pp = PROJ + (size_t)(t0 - 1) * AB_PAD; pr = bf2f(pp[c]); pk = bf2f(pp[1024 + c]); pv = bf2f(pp[2048 + c]); }
        constexpr int GT = 4;
        float xr[GT], xk[GT], xv[GT], lw[GT], la[GT], nr[GT], nk[GT], nv[GT], nw[GT], na[GT];
#define PB_LOAD(dr, dk, dv, dw, da, tt_) do { _Pragma("unroll") for (int i = 0; i < GT; ++i) { const bf16* p0 = PROJ + (size_t)(t0 + (tt_) + i) * AB_PAD; const float* lo = LOUT + (size_t)(t0 + (tt_) + i) * 3072; \
            dr[i] = bf2f(p0[c]); dk[i] = bf2f(p0[1024 + c]); dv[i] = bf2f(p0[2048 + c]); dw[i] = lo[c]; da[i] = lo[1024 + c]; } } while (0)
        PB_LOAD(xr, xk, xv, lw, la, 0);
        for (int tt = 0; tt < 64; tt += GT) {
            if (tt + GT < 64) PB_LOAD(nr, nk, nv, nw, na, tt + GT);
            float kk[GT], km[GT], r[GT], v[GT], a[GT], w[GT], q1[GT], q2[GT];
#pragma unroll
            for (int i = 0; i < GT; ++i) { r[i] = xr[i] + (pr - xr[i]) * mur; const float k = xk[i] + (pk - xk[i]) * muk; v[i] = xv[i] + (pv - xv[i]) * muv; pr = xr[i]; pk = xk[i]; pv = xv[i];
                w[i] = __expf(-0.6065306597126334f * sigmoidf_(lw[i] + w0c)); a[i] = sigmoidf_(a0c + la[i]);
                kk[i] = k * kkc; km[i] = k * (1.0f + (a[i] - 1.0f) * kac); q1[i] = kk[i] * kk[i]; q2[i] = r[i] * km[i] * rkc; }
#pragma unroll
            for (int i = 0; i < GT; ++i) { q1[i] = wave_sum_dpp(q1[i]); q2[i] = wave_sum_dpp(q2[i]); }
#pragma unroll
            for (int i = 0; i < GT; ++i) { const float kn = kk[i] / fmaxf(sqrtf(q1[i]), 1e-12f); const size_t o = (size_t)(t0 + tt + i) * 1024 + c;
                SR[o] = r[i]; SW[o] = w[i]; SKM[o] = km[i]; SV[o] = v[i]; SKK[o] = kn; SB[o] = kn * a[i];
                if (lane == 0) BONUS[(t0 + tt + i) * 16 + h] = q2[i]; }
#pragma unroll
            for (int i = 0; i < GT; ++i) { xr[i] = nr[i]; xk[i] = nk[i]; xv[i] = nv[i]; lw[i] = nw[i]; la[i] = na[i]; }
        }
#undef PB_LOAD
    }
    if (F.gw < NH_M) { const int h = F.gw;
        const float* BCUM = WSP(float, WS_SMALL + SM_BCUM); const float* IG = WSP(float, WS_SMALL + SM_IG); const float* CHBL = WSP(float, WS_SMALL + SM_CHBL); const float* CHMD = WSP(float, WS_SMALL + SM_CHMD);
        float* MSEQ = WSP(float, WS_SMALL + SM_MSEQ); float* WCARRY = WSP(float, WS_SMALL + SM_WCARRY);
        const float bl0 = CHBL[h * 128 + lane], bl1 = CHBL[h * 128 + 64 + lane], md0 = CHMD[h * 128 + lane], md1 = CHMD[h * 128 + 64 + lane];
        float m = 0.f, mine_in0 = 0.f, mine_in1 = 0.f, mine_out0 = 0.f, mine_out1 = 0.f;
#pragma unroll
        for (int c = 0; c < 128; ++c) { const float bl = __shfl(c < 64 ? bl0 : bl1, c & 63), md = __shfl(c < 64 ? md0 : md1, c & 63);
            const float mn = fmaxf(bl + m, md);
            if ((c & 63) == lane) { if (c < 64) { mine_in0 = m; mine_out0 = mn; } else { mine_in1 = m; mine_out1 = mn; } }
            m = mn; }
        MSEQ[h * 128 + lane] = mine_in0; MSEQ[h * 128 + 64 + lane] = mine_in1;
        WCARRY[h * 128 + lane] = __expf(bl0 + mine_in0 - mine_out0); WCARRY[h * 128 + 64 + lane] = __expf(bl1 + mine_in1 - mine_out1);
        float* MOUT = WSP(float, WS_SMALL + SM_MOUT); MOUT[h * 128 + lane] = mine_out0; MOUT[h * 128 + 64 + lane] = mine_out1;
    }
}

__device__ __forceinline__ void p_mlstm_pass2(const Frame& F, bool mine, int hh) {
    const int lane = F.lane;
    if (mine) { const int h = hh;
        const float* CHBL = WSP(float, WS_SMALL + SM_CHBL); const float* CHMD = WSP(float, WS_SMALL + SM_CHMD);
        float* MSEQ = WSP(float, WS_SMALL + SM_MSEQ); float* WCARRY = WSP(float, WS_SMALL + SM_WCARRY);
        const float bl0 = CHBL[h * 128 + lane], bl1 = CHBL[h * 128 + 64 + lane], md0 = CHMD[h * 128 + lane], md1 = CHMD[h * 128 + 64 + lane];
        float m = 0.f, mine_in0 = 0.f, mine_in1 = 0.f, mine_out0 = 0.f, mine_out1 = 0.f;
#pragma unroll
        for (int c = 0; c < 128; ++c) { const float bl = __builtin_bit_cast(float, __builtin_amdgcn_readlane(__builtin_bit_cast(int, c < 64 ? bl0 : bl1), c & 63)), md = __builtin_bit_cast(float, __builtin_amdgcn_readlane(__builtin_bit_cast(int, c < 64 ? md0 : md1), c & 63));
            const float mn = fmaxf(bl + m, md);
            if ((c & 63) == lane) { if (c < 64) { mine_in0 = m; mine_out0 = mn; } else { mine_in1 = m; mine_out1 = mn; } }
            m = mn; }
        MSEQ[h * 128 + lane] = mine_in0; MSEQ[h * 128 + 64 + lane] = mine_in1;
        WCARRY[h * 128 + lane] = __expf(bl0 + mine_in0 - mine_out0); WCARRY[h * 128 + 64 + lane] = __expf(bl1 + mine_in1 - mine_out1);
        float* MOUT = WSP(float, WS_SMALL + SM_MOUT); MOUT[h * 128 + lane] = mine_out0; MOUT[h * 128 + 64 + lane] = mine_out1;
    }
}

__device__ __forceinline__ float row16_sum(float x) {
    x += __builtin_bit_cast(float, __builtin_amdgcn_update_dpp(0, __builtin_bit_cast(int, x), 0xB1, 0xF, 0xF, true));
    x += __builtin_bit_cast(float, __builtin_amdgcn_update_dpp(0, __builtin_bit_cast(int, x), 0x4E, 0xF, 0xF, true));
    x += __builtin_bit_cast(float, __builtin_amdgcn_update_dpp(0, __builtin_bit_cast(int, x), 0x141, 0xF, 0xF, true));
    x += __builtin_bit_cast(float, __builtin_amdgcn_update_dpp(0, __builtin_bit_cast(int, x), 0x140, 0xF, 0xF, true));
    return x;
}
__device__ __forceinline__ void row16_sum2(float& a, float& b) {
#define DPPF(x, ctrl) __builtin_bit_cast(float, __builtin_amdgcn_update_dpp(0, __builtin_bit_cast(int, x), ctrl, 0xF, 0xF, true))
    a += DPPF(a, 0xB1); b += DPPF(b, 0xB1); a += DPPF(a, 0x4E); b += DPPF(b, 0x4E); a += DPPF(a, 0x141); b += DPPF(b, 0x141); a += DPPF(a, 0x140); b += DPPF(b, 0x140);
#undef DPPF
}
constexpr int SCH = 8;
constexpr int SC_VEC = SCH * 256;
constexpr int SC_BUF = 5 * SC_VEC + 1024;
constexpr int SC_NBUF = 3, SC_NSEG = 4;
constexpr int SC_LDS = SC_NSEG * SC_NBUF * SC_BUF;
constexpr int SC_PROG_OFF = SC_LDS;
constexpr int SC_TOUCH_AHEAD = 12;
__device__ __forceinline__ void row16_sum4(float& a, float& b, float& c, float& d) {
#define DPPF(x, ctrl) __builtin_bit_cast(float, __builtin_amdgcn_update_dpp(0, __builtin_bit_cast(int, x), ctrl, 0xF, 0xF, true))
    a += DPPF(a, 0xB1); b += DPPF(b, 0xB1); c += DPPF(c, 0xB1); d += DPPF(d, 0xB1); a += DPPF(a, 0x4E); b += DPPF(b, 0x4E); c += DPPF(c, 0x4E); d += DPPF(d, 0x4E);
    a += DPPF(a, 0x141); b += DPPF(b, 0x141); c += DPPF(c, 0x141); d += DPPF(d, 0x141); a += DPPF(a, 0x140); b += DPPF(b, 0x140); c += DPPF(c, 0x140); d += DPPF(d, 0x140);
#undef DPPF
}
__host__ __device__ constexpr int sc_len(int s) { return s == 0 ? 3328 : (s == 3 ? 1664 : 1600); }
__host__ __device__ constexpr int sc_tb(int s) { return s == 0 ? 0 : 3328 + (s - 1) * 1600; }
static_assert(sc_tb(3) + sc_len(3) == T, "segments cover the sequence");
__device__ __forceinline__ int sc_seg_of(int t) { return t < 3328 ? 0 : (t < 4928 ? 1 : (t < 6528 ? 2 : 3)); }
template <int SEGI>
__device__ __forceinline__ void p_scan(const Frame& F) {
    constexpr bool TR = SEGI >= 1; constexpr int TB = sc_tb(SEGI), SC_SEG = sc_len(SEGI), SC_SEG0 = sc_len(0);
    const int b = blockIdx.x, head = (b & 7) * 2 + ((b >> 3) & 1), rg = b >> 4, lane = F.lane, row = lane >> 4, j = lane & 15;
    const float* SR = WSP(float, R_SC); const float* SW = WSP(float, R_SC + SC_STRIDE); const float* SKM = WSP(float, R_SC + 2 * SC_STRIDE); const float* SV = WSP(float, R_SC + 3 * SC_STRIDE);
    const float* SKK = WSP(float, R_SC + 4 * SC_STRIDE); const float* SB = WSP(float, R_SC + 5 * SC_STRIDE);
    float* Yo = WSP(float, R_Y) + (size_t)TB * 1024; float* Zo = WSP(float, R_Z) + (size_t)(TR ? TB - SC_SEG0 : 0) * 1024;
    LAS unsigned char* lds = F.lds + RING_OFF + SEGI * SC_NBUF * SC_BUF;
    volatile LAS int* prog = (volatile LAS int*)(F.lds + RING_OFF + SC_PROG_OFF);
    const size_t goff = (size_t)TB * 1024 + (size_t)(lane >> 4) * 1024 + head * 64 + (lane & 15) * 4;
    f32x2 L0 = {0.f, 0.f}, L1 = {0.f, 0.f}, T0 = {0.f, 0.f}, T1 = {0.f, 0.f};
    if (TR) { const int i = rg * 4 + row; if ((i >> 2) == j) { const int e = i & 3; T0[0] = e == 0 ? 1.f : 0.f; T0[1] = e == 1 ? 1.f : 0.f; T1[0] = e == 2 ? 1.f : 0.f; T1[1] = e == 3 ? 1.f : 0.f; } }
#define SC_ISSUE(c_, buf_) do { const size_t t0_ = (size_t)(c_) * SCH * 1024; LAS unsigned char* d_ = lds + (buf_) * SC_BUF; \
        _Pragma("unroll") for (int q = 0; q < SCH / 4; ++q) { const size_t o_ = t0_ + (size_t)q * 4096 + goff; \
            __builtin_amdgcn_global_load_lds((const unsigned*)(SKK + o_), (LAS unsigned*)(d_ + 0 * SC_VEC + q * 1024), 16, 0, 0); \
            __builtin_amdgcn_global_load_lds((const unsigned*)(SW  + o_), (LAS unsigned*)(d_ + 1 * SC_VEC + q * 1024), 16, 0, 0); \
            __builtin_amdgcn_global_load_lds((const unsigned*)(SB  + o_), (LAS unsigned*)(d_ + 2 * SC_VEC + q * 1024), 16, 0, 0); \
            __builtin_amdgcn_global_load_lds((const unsigned*)(SR  + o_), (LAS unsigned*)(d_ + 3 * SC_VEC + q * 1024), 16, 0, 0); \
            __builtin_amdgcn_global_load_lds((const unsigned*)(SKM + o_), (LAS unsigned*)(d_ + 4 * SC_VEC + q * 1024), 16, 0, 0); } \
        { int ts_ = TB + (c_) * SCH + lane; ts_ = ts_ < T ? ts_ : T - 1; \
          __builtin_amdgcn_global_load_lds((const unsigned*)(SV + (size_t)ts_ * 1024 + head * 64 + rg * 4), (LAS unsigned*)(d_ + 5 * SC_VEC), 16, 0, 0); } } while (0)
    __builtin_amdgcn_s_setprio(3);
    constexpr int NCH = SC_SEG / SCH;
    static_assert(NCH % 2 == 0 && SC_NBUF == 3, "three-buffer pipeline, 11 loads per chunk");
    SC_ISSUE(0, 0); SC_ISSUE(1, 1);
    int buf = 0; float ykL = 0.f, ykT = 0.f; f32x2 rp0 = {0.f, 0.f}, rp1 = {0.f, 0.f};
    for (int c = 0; c < NCH; ++c) {
        if (c < NCH - 1) asm volatile("s_waitcnt vmcnt(11)" ::: "memory"); else asm volatile("s_waitcnt vmcnt(0)" ::: "memory");
        if (c + 2 < NCH) { const int nb = buf >= 1 ? buf - 1 : buf + 2; SC_ISSUE(c + 2, nb); }
        if (SEGI == 0 && lane == 0) *prog = c;
        const LAS unsigned char* d = lds + buf * SC_BUF + j * 16;
        const LAS unsigned char* dv = lds + buf * SC_BUF + 5 * SC_VEC + row * 4;
        const int jb = (c & 1) * SCH;
        f32x2 kkA, kkB, wA, wB, bA, bB, kmA, kmB, rA, rB; float vv;
#define SC_LOAD(s_) do { const f32x4 kk_ = *(const LAS f32x4*)(d + 0 * SC_VEC + (s_) * 256), w_ = *(const LAS f32x4*)(d + 1 * SC_VEC + (s_) * 256), b_ = *(const LAS f32x4*)(d + 2 * SC_VEC + (s_) * 256); \
        const f32x4 r_ = *(const LAS f32x4*)(d + 3 * SC_VEC + (s_) * 256), km_ = *(const LAS f32x4*)(d + 4 * SC_VEC + (s_) * 256); vv = *(const LAS float*)(dv + (s_) * 16); \
        kkA = (f32x2){kk_[0], kk_[1]}; kkB = (f32x2){kk_[2], kk_[3]}; wA = (f32x2){w_[0], w_[1]}; wB = (f32x2){w_[2], w_[3]}; bA = (f32x2){b_[0], b_[1]}; bB = (f32x2){b_[2], b_[3]}; \
        rA = (f32x2){r_[0], r_[1]}; rB = (f32x2){r_[2], r_[3]}; kmA = (f32x2){km_[0], km_[1]}; kmB = (f32x2){km_[2], km_[3]}; } while (0)
        SC_LOAD(0);
#pragma unroll
        for (int s = 0; s < SCH; ++s) {
            f32x2 kk0 = kkA, kk1 = kkB, w0 = wA, w1 = wB, b0 = bA, b1 = bB, r0 = rA, r1 = rB, km0 = kmA, km1 = kmB; float v_ = vv;
            asm volatile("" : "+v"(kk0), "+v"(kk1), "+v"(w0), "+v"(w1), "+v"(b0), "+v"(b1), "+v"(r0), "+v"(r1), "+v"(km0), "+v"(km1), "+v"(v_));
            if (s + 1 < SCH) { SC_LOAD(s + 1); }
            __builtin_amdgcn_sched_barrier(0);
            const int keep = (jb + s + 15) & 15;
            if (TR) {
                f32x2 tl = L0 * kk0, ul = L0 * rp0, tt = T0 * kk0, ut = T0 * rp0; tl = L1 * kk1 + tl; ul = L1 * rp1 + ul; tt = T1 * kk1 + tt; ut = T1 * rp1 + ut;
                float sl = tl[0] + tl[1], yl = ul[0] + ul[1], st = tt[0] + tt[1], yt = ut[0] + ut[1];
                row16_sum4(sl, st, yl, yt);
                ykL = (j == keep) ? yl : ykL; ykT = (j == keep) ? yt : ykT;
                if (s == 0 && jb == 0 && c >= 2) { const size_t o = (size_t)((c - 2) * SCH + j) * 1024 + head * 64 + rg * 4 + row; Yo[o] = ykL; Zo[o] = ykT; }
                L0 = L0 * w0 + (km0 * v_ - b0 * sl); L1 = L1 * w1 + (km1 * v_ - b1 * sl); T0 = T0 * w0 - b0 * st; T1 = T1 * w1 - b1 * st;
            } else {
                f32x2 tl = L0 * kk0, ul = L0 * rp0; tl = L1 * kk1 + tl; ul = L1 * rp1 + ul;
                float sl = tl[0] + tl[1], yl = ul[0] + ul[1];
                row16_sum2(sl, yl);
                ykL = (j == keep) ? yl : ykL;
                if (s == 0 && jb == 0 && c >= 2) Yo[(size_t)((c - 2) * SCH + j) * 1024 + head * 64 + rg * 4 + row] = ykL;
                L0 = L0 * w0 + (km0 * v_ - b0 * sl); L1 = L1 * w1 + (km1 * v_ - b1 * sl);
            }
            rp0 = r0; rp1 = r1;
            __builtin_amdgcn_sched_barrier(0);
        }
#undef SC_LOAD
        buf = buf == SC_NBUF - 1 ? 0 : buf + 1;
    }
    { const size_t o = (size_t)(SC_SEG - 16 + j) * 1024 + head * 64 + rg * 4 + row;
      f32x2 u = L0 * rp0; u = L1 * rp1 + u; const float us = row16_sum(u[0] + u[1]); ykL = (j == 15) ? us : ykL; Yo[o] = ykL;
      if (TR) { f32x2 ut = T0 * rp0; ut = T1 * rp1 + ut; const float ut_ = row16_sum(ut[0] + ut[1]); ykT = (j == 15) ? ut_ : ykT; Zo[o] = ykT; } }
    if (SEGI < SC_NSEG - 1) { float* p = WSP(float, WS_SMALL + SM_SLOC) + (((size_t)SEGI * 16 + head) * 64 + rg * 4 + row) * 64 + 4 * j; *(f32x4*)p = (f32x4){L0[0], L0[1], L1[0], L1[1]}; }
    if (TR && SEGI < SC_NSEG - 1) { float* p = WSP(float, WS_SMALL + SM_PEND) + (((size_t)SEGI * 16 + head) * 64 + rg * 4 + row) * 64 + 4 * j; *(f32x4*)p = (f32x4){T0[0], T0[1], T1[0], T1[1]}; }
    asm volatile("s_waitcnt vmcnt(0)" ::: "memory");
    __builtin_amdgcn_s_setprio(0);
#undef SC_ISSUE
}
__device__ __forceinline__ void p_scan_touch(const Frame& F) {
    const int b = blockIdx.x, head = (b & 7) * 2 + ((b >> 3) & 1), lane = F.lane;
    const char* base = (const char*)WSP(float, R_SC); volatile LAS int* prog = (volatile LAS int*)(F.lds + RING_OFF + SC_PROG_OFF);
    constexpr int NCH0 = sc_len(0) / SCH, LPS = SCH * 12;
    unsigned dummy = 0;
    for (int c = 0; c < NCH0; ++c) {
        for (int spin = 0; spin < (1 << 16) && c > *prog + SC_TOUCH_AHEAD; ++spin) __builtin_amdgcn_s_sleep(8);
#pragma unroll
        for (int q = 0; q < 2; ++q) { const int x = q * 64 + lane; if (x < LPS) { const int step = x / 12, arr = (x % 12) >> 1, half = x & 1;
            const char* p = base + (size_t)arr * SC_STRIDE + ((size_t)(c * SCH + step) * 1024 + head * 64 + half * 32) * 4;
            asm volatile("global_load_dword %0, %1, off" : "+v"(dummy) : "v"(p) : "memory"); } }
        if ((c & 1) == 0) { const int c2 = c >> 1;
#pragma unroll
            for (int q = 0; q < 5; ++q) { const int x = q * 64 + lane; if (x < 3 * LPS) { const int seg = 1 + x / LPS, y = x % LPS, step = y / 12, arr = (y % 12) >> 1, half = y & 1;
                if (c2 * SCH < sc_len(seg)) { const char* p = base + (size_t)arr * SC_STRIDE + ((size_t)(sc_tb(seg) + c2 * SCH + step) * 1024 + head * 64 + half * 32) * 4;
                    asm volatile("global_load_dword %0, %1, off" : "+v"(dummy) : "v"(p) : "memory"); } } } }
    }
    asm volatile("s_waitcnt vmcnt(0)" : "+v"(dummy) :: "memory");
}
__device__ __forceinline__ void p_scomb(const Frame& F) {
    const float* SLOC = WSP(float, WS_SMALL + SM_SLOC); const float* PEND = WSP(float, WS_SMALL + SM_PEND); float* SIN = WSP(float, WS_SMALL + SM_SIN); const int lane = F.lane;
    for (int u = F.gw; u < 16 * 64; u += F.NGW) { const int h = u >> 6, v = u & 63;
        float sv = SLOC[((size_t)(0 * 16 + h) * 64 + v) * 64 + lane];
        SIN[((size_t)(1 * 16 + h) * 64 + v) * 64 + lane] = sv;
#pragma unroll
        for (int s = 2; s < SC_NSEG; ++s) { float acc = SLOC[((size_t)((s - 1) * 16 + h) * 64 + v) * 64 + lane]; const float* P = PEND + ((size_t)((s - 1) * 16 + h) * 64) * 64 + lane;
#pragma unroll 8
            for (int i = 0; i < 64; ++i) acc += __builtin_bit_cast(float, __builtin_amdgcn_readlane(__builtin_bit_cast(int, sv), i)) * P[(size_t)i * 64];
            sv = acc; SIN[((size_t)(s * 16 + h) * 64 + v) * 64 + lane] = sv; } }
}

__device__ __forceinline__ void p_rwkv_post(const Frame& F, const Args& A) {
    const float* Y = WSP(float, R_Y); const bf16* PROJ = WSP(bf16, R_PROJ); const float* LOUT = WSP(float, R_LORAOUT); const float* BONUS = WSP(float, WS_SMALL + SM_BONUS);
    const float* lng = A.in[I_RWLNG]; const float* lnb = A.in[I_RWLNB]; bf16* YCAT = WSP(bf16, R_YCAT); const int lane = F.lane, ts = lane >> 4, cq = lane & 15;
    for (int u = F.gw; u < NH_R * (T / 64); u += F.NGW) { const int h = u & 15, tb = u >> 4, c = 64 * h + 4 * cq, t0 = 64 * tb;
        const f32x4 lg = *(const f32x4*)(lng + c), lb = *(const f32x4*)(lnb + c); const f32x4 muv = *(const f32x4*)(A.in[I_ABMU] + 2048 + c);
        f32x4 yA[4], sA[4], gA[4], yB[4], sB[4], gB[4]; float bA[4], bB[4];
#define PP_LOAD(y_, s_, g_, b_, grp_) do { _Pragma("unroll") for (int k = 0; k < 4; ++k) { const size_t t = t0 + 16 * (grp_) + 4 * k + ts; \
            y_[k] = *(const f32x4*)(Y + t * 1024 + c); g_[k] = *(const f32x4*)(LOUT + t * 3072 + 2048 + c); b_[k] = BONUS[t * 16 + h]; \
            const u32x2 v1_ = *(const u32x2*)(PROJ + t * AB_PAD + 2048 + c); u32x2 v0_ = {0u, 0u}; if (t > 0) v0_ = *(const u32x2*)(PROJ + (t - 1) * AB_PAD + 2048 + c); \
            const f32x4 xv_ = {bf2f(v1_.x & 0xffffu), bf2f(v1_.x >> 16), bf2f(v1_.y & 0xffffu), bf2f(v1_.y >> 16)}, pv_ = {bf2f(v0_.x & 0xffffu), bf2f(v0_.x >> 16), bf2f(v0_.y & 0xffffu), bf2f(v0_.y >> 16)}; \
            s_[k] = xv_ + (pv_ - xv_) * muv; } } while (0)
#define PP_PROC(y_, s_, g_, b_, grp_) do { float m0 = (y_[0][0] + y_[0][1]) + (y_[0][2] + y_[0][3]), m1 = (y_[1][0] + y_[1][1]) + (y_[1][2] + y_[1][3]), \
                  m2 = (y_[2][0] + y_[2][1]) + (y_[2][2] + y_[2][3]), m3 = (y_[3][0] + y_[3][1]) + (y_[3][2] + y_[3][3]); \
            row16_sum4(m0, m1, m2, m3); \
            y_[0] = y_[0] - m0 * (1.0f / 64.0f); y_[1] = y_[1] - m1 * (1.0f / 64.0f); y_[2] = y_[2] - m2 * (1.0f / 64.0f); y_[3] = y_[3] - m3 * (1.0f / 64.0f); \
            float q0 = (y_[0][0] * y_[0][0] + y_[0][1] * y_[0][1]) + (y_[0][2] * y_[0][2] + y_[0][3] * y_[0][3]), q1 = (y_[1][0] * y_[1][0] + y_[1][1] * y_[1][1]) + (y_[1][2] * y_[1][2] + y_[1][3] * y_[1][3]), \
                  q2 = (y_[2][0] * y_[2][0] + y_[2][1] * y_[2][1]) + (y_[2][2] * y_[2][2] + y_[2][3] * y_[2][3]), q3 = (y_[3][0] * y_[3][0] + y_[3][1] * y_[3][1]) + (y_[3][2] * y_[3][2] + y_[3][3] * y_[3][3]); \
            row16_sum4(q0, q1, q2, q3); \
            const float rs_[4] = {__builtin_amdgcn_rsqf(q0 * (1.0f / 64.0f) + 64e-5f), __builtin_amdgcn_rsqf(q1 * (1.0f / 64.0f) + 64e-5f), __builtin_amdgcn_rsqf(q2 * (1.0f / 64.0f) + 64e-5f), __builtin_amdgcn_rsqf(q3 * (1.0f / 64.0f) + 64e-5f)}; \
            _Pragma("unroll") for (int k = 0; k < 4; ++k) { const f32x4 o = (y_[k] * rs_[k] * lg + lb + s_[k] * b_[k]) * g_[k]; \
                u32x2 w; w.x = cvt_pk_bf16(o[0], o[1]); w.y = cvt_pk_bf16(o[2], o[3]); *(u32x2*)(YCAT + (size_t)(t0 + 16 * (grp_) + 4 * k + ts) * D + c) = w; } } while (0)
#define PP_SB() __builtin_amdgcn_sched_barrier(0)
        PP_LOAD(yA, sA, gA, bA, 0); PP_SB(); PP_LOAD(yB, sB, gB, bB, 1); PP_SB();
        PP_PROC(yA, sA, gA, bA, 0); PP_SB(); PP_LOAD(yA, sA, gA, bA, 2); PP_SB();
        PP_PROC(yB, sB, gB, bB, 1); PP_SB(); PP_LOAD(yB, sB, gB, bB, 3); PP_SB();
        PP_PROC(yA, sA, gA, bA, 2); PP_SB(); PP_PROC(yB, sB, gB, bB, 3); PP_SB();
#undef PP_SB
#undef PP_LOAD
#undef PP_PROC
    }
}

constexpr int CK = 16, NCK = T / CK;
constexpr int CK_NFR = 19;
constexpr int CKP = 65;
__device__ __forceinline__ void ck_kpos(int k, int& g, int& kq, int& j) { g = k >> 5; const int kl = k & 31; if (kl < 16) { kq = kl >> 2; j = kl & 3; } else { kq = (kl - 16) >> 2; j = 4 + (kl & 3); } }

__device__ __forceinline__ void p_rwkv_chunk(const Frame& F, const Args& A) {
    const bf16* PROJ = WSP(bf16, R_PROJ); const float* LOUT = WSP(float, R_LORAOUT); const float* mu = A.in[I_ABMU];
    const float* w0 = A.in[I_RWW0]; const float* a0 = A.in[I_RWA0]; const float* kk_ = A.in[I_RWKK]; const float* ka_ = A.in[I_RWKA]; const float* rk_ = A.in[I_RWRK];
    float* SV = WSP(float, R_SV); float* BONUS = WSP(float, WS_SMALL + SM_BONUS); unsigned char* FR = WSP(unsigned char, R_FR);
    LAS float* L = (LAS float*)(F.lds + RING_OFF);
    LAS float* sA = L; LAS float* sP = L + 16 * CKP; LAS float* sB = L + 2 * 16 * CKP; LAS float* sKM = L + 3 * 16 * CKP; LAS float* sRH = L + 4 * 16 * CKP;
    LAS float* sCS = L + 5 * 16 * CKP; LAS float* sDM = L + 6 * 16 * CKP; LAS float* sCL = L + 7 * 16 * CKP; LAS float* sDL = L + 8 * 16 * CKP; LAS float* sV = L + 9 * 16 * CKP;
    LAS float* sAn = L + 10 * 16 * CKP; LAS float* sRn = L + 11 * 16 * CKP;
    LAS float* sU = L + 12 * 16 * CKP;
    LAS float* sAP = sU + 4 * 16 * 17;
    LAS float* sDP = sAP + 64 * 17;
    LAS float* sPL = sDP + 16 * 17;
    LAS bf16* sFR = (LAS bf16*)(sPL + 64);
    static_assert(((12 * 16 * CKP + 4 * 16 * 17 + 64 * 17 + 16 * 17 + 64) * 4) % 16 == 0, "fragment image alignment");
    const int tid = F.tid, lane = F.lane, wave = F.wave;
    for (int i = tid; i < CK_NFR * 512; i += NWAVES * 64) sFR[i] = 0;
    __syncthreads();
    const int upb = (NH_R * NCK) / F.G;
    const int r32 = lane & 31, hg = lane >> 5;
    float xr[3], xk[3], xv[3], lw[2], la[2], pm[8];
#define CK_LOAD(u_) do { const int c_ = (u_) >> 4, h_ = (u_) & 15, ch_ = 64 * h_ + lane, ta_ = c_ * CK + 2 * wave; \
        pm[0] = mu[ch_]; pm[1] = mu[1024 + ch_]; pm[2] = mu[2048 + ch_]; pm[3] = w0[ch_]; pm[4] = a0[ch_]; pm[5] = kk_[ch_]; pm[6] = ka_[ch_]; pm[7] = rk_[ch_]; \
        if (ta_ > 0) { const bf16* pp = PROJ + (size_t)(ta_ - 1) * AB_PAD; xr[0] = bf2f(pp[ch_]); xk[0] = bf2f(pp[1024 + ch_]); xv[0] = bf2f(pp[2048 + ch_]); } else { xr[0] = 0.f; xk[0] = 0.f; xv[0] = 0.f; } \
        _Pragma("unroll") for (int i = 0; i < 2; ++i) { const bf16* p0 = PROJ + (size_t)(ta_ + i) * AB_PAD; const float* lo = LOUT + (size_t)(ta_ + i) * 3072; \
            xr[1 + i] = bf2f(p0[ch_]); xk[1 + i] = bf2f(p0[1024 + ch_]); xv[1 + i] = bf2f(p0[2048 + ch_]); lw[i] = lo[ch_]; la[i] = lo[1024 + ch_]; } } while (0)
    CK_LOAD(F.vcu * upb);
    for (int ui = 0; ui < upb; ++ui) { const int u = F.vcu * upb + ui, c = u >> 4, h = u & 15, t0 = c * CK;
        { const int ch = 64 * h + lane; const int ta = t0 + 2 * wave; float pr = xr[0], pk = xk[0], pv = xv[0];
#pragma unroll
          for (int i = 0; i < 2; ++i) { const int t = ta + i, tl = 2 * wave + i;
              const float r = xr[1 + i] + (pr - xr[1 + i]) * pm[0], k = xk[1 + i] + (pk - xk[1 + i]) * pm[1], v = xv[1 + i] + (pv - xv[1 + i]) * pm[2]; pr = xr[1 + i]; pk = xk[1 + i]; pv = xv[1 + i];
              const float w = __expf(-0.6065306597126334f * sigmoidf_(lw[i] + pm[3])), a = sigmoidf_(pm[4] + la[i]);
              float kk = k * pm[5]; const float km = k * (1.0f + (a - 1.0f) * pm[6]);
              const float q1 = wave_sum_dpp(kk * kk), q2 = wave_sum_dpp(r * km * pm[7]);
              kk = kk / fmaxf(sqrtf(q1), 1e-12f);
              sA[tl * CKP + lane] = kk; sP[tl * CKP + lane] = w; sB[tl * CKP + lane] = kk * a; sKM[tl * CKP + lane] = km; sRH[tl * CKP + lane] = r; sV[tl * CKP + lane] = v;
              SV[(size_t)t * 1024 + ch] = v; if (lane == 0) BONUS[t * 16 + h] = q2; } }
        if (ui + 1 < upb) CK_LOAD(u + 1);
        __syncthreads();
        { const int k = tid & 63;
#pragma unroll
          for (int q = 0; q < 2; ++q) { const int t = (tid >> 6) * 2 + q; float Pp = 1.f, P = 1.f, PL = 1.f;
#pragma unroll
              for (int i = 0; i < CK; ++i) { const float wv = sP[i * CKP + k]; PL *= wv; if (i < t) Pp *= wv; if (i <= t) P *= wv; }
              const float inv = 1.0f / P, ratio = PL * inv, kkv = sA[t * CKP + k], bv = sB[t * CKP + k], kmv = sKM[t * CKP + k], rv = sRH[t * CKP + k];
              sCS[t * CKP + k] = bv * inv; sDM[t * CKP + k] = kmv * inv; sCL[t * CKP + k] = bv * ratio; sDL[t * CKP + k] = kmv * ratio;
              sAn[t * CKP + k] = Pp * kkv; sRn[t * CKP + k] = P * rv; if (t == 0) sPL[k] = PL; } }
        if (tid >= 64 && tid < 64 + 128) { const int x = tid - 64, vq = x >> 5, ln = x & 31, n = ln & 15, kq = ln >> 4; u32x4 o; float vv[8];
#pragma unroll
            for (int j = 0; j < 8; ++j) vv[j] = sV[(8 * kq + j) * CKP + 16 * vq + n];
            o.x = cvt_pk_bf16(vv[0], vv[1]); o.y = cvt_pk_bf16(vv[2], vv[3]); o.z = cvt_pk_bf16(vv[4], vv[5]); o.w = cvt_pk_bf16(vv[6], vv[7]);
            *(LAS u32x4*)(sFR + (15 + vq) * 512 + (n + 16 * kq) * 8) = o; }
        __syncthreads();
        if (wave == 0) { const LAS float* ar = (r32 < 16 ? sCS + r32 * CKP : sDM + (r32 - 16) * CKP); const LAS float* br = (r32 < 16 ? sAn + r32 * CKP : sRn + (r32 - 16) * CKP); f32x16 acc = f32x16{};
#pragma unroll
            for (int ks = 0; ks < 4; ++ks) { float av[8], bv[8];
#pragma unroll
                for (int j = 0; j < 8; ++j) { av[j] = ar[16 * ks + 8 * hg + j]; bv[j] = br[16 * ks + 8 * hg + j]; }
                u32x4 pa, pb; pa.x = cvt_pk_bf16(av[0], av[1]); pa.y = cvt_pk_bf16(av[2], av[3]); pa.z = cvt_pk_bf16(av[4], av[5]); pa.w = cvt_pk_bf16(av[6], av[7]);
                pb.x = cvt_pk_bf16(bv[0], bv[1]); pb.y = cvt_pk_bf16(bv[2], bv[3]); pb.z = cvt_pk_bf16(bv[4], bv[5]); pb.w = cvt_pk_bf16(bv[6], bv[7]);
                acc = __builtin_amdgcn_mfma_f32_32x32x16_bf16(__builtin_bit_cast(bf16x8, pa), __builtin_bit_cast(bf16x8, pb), acc, 0, 0, 0); }
#pragma unroll
            for (int q = 0; q < 16; ++q) { const int row = (q & 3) + 8 * (q >> 2) + 4 * hg, col = r32, mat = (row >> 4) + 2 * (col >> 4), i = row & 15, t = col & 15;
                const bool keep = (mat & 2) ? (i <= t) : (i < t); sU[mat * 16 * 17 + i * 17 + t] = keep ? acc[q] : 0.f; } }
        __syncthreads();
        if (tid < 80) { float x[CK]; const bool isA = tid < 64; const int ri = isA ? tid : tid - 64;
#pragma unroll
            for (int t = 0; t < CK; ++t) x[t] = isA ? sAn[t * CKP + ri] : sU[1 * 16 * 17 + ri * 17 + t];
#pragma unroll
            for (int jx = 0; jx < CK - 1; ++jx) { float urow[CK];
#pragma unroll
                for (int t = 0; t < CK; ++t) if (t > jx) urow[t] = sU[jx * 17 + t];
#pragma unroll
                for (int t = 0; t < CK; ++t) if (t > jx) x[t] -= x[jx] * urow[t]; }
            LAS float* dst = isA ? sAP + ri * 17 : sDP + ri * 17;
#pragma unroll
            for (int t = 0; t < CK; ++t) dst[t] = x[t]; }
        __syncthreads();
        {
#define CK_PACK(v_) ({ u32x4 p_; p_.x = cvt_pk_bf16(v_[0], v_[1]); p_.y = cvt_pk_bf16(v_[2], v_[3]); p_.z = cvt_pk_bf16(v_[4], v_[5]); p_.w = cvt_pk_bf16(v_[6], v_[7]); __builtin_bit_cast(bf16x8, p_); })
          if (wave < 4) {
              const int kr = 32 * (wave >> 1) + r32, kc = 32 * (wave & 1) + r32; float av[8], bv[8];
#pragma unroll
              for (int j = 0; j < 8; ++j) { av[j] = sAP[kr * 17 + 8 * hg + j]; bv[j] = sCL[(8 * hg + j) * CKP + kc]; }
              f32x16 acc = __builtin_amdgcn_mfma_f32_32x32x16_bf16(CK_PACK(av), CK_PACK(bv), f32x16{}, 0, 0, 0);
              const float pl = sPL[kc]; const int ktp = kc >> 4, ii = kc & 15;
#pragma unroll
              for (int q = 0; q < 16; ++q) { const int k = 32 * (wave >> 1) + (q & 3) + 8 * (q >> 2) + 4 * hg; const float m = ((k == kc) ? pl : 0.f) - acc[q];
                  int g, kq, j; ck_kpos(k, g, kq, j); sFR[(ktp * 2 + g) * 512 + (ii + 16 * kq) * 8 + j] = f2bf(m); }
          } else if (wave < 6) {
              const int kc = 32 * (wave - 4) + r32; float av[8], bv[8];
#pragma unroll
              for (int j = 0; j < 8; ++j) { av[j] = r32 < 16 ? sDP[r32 * 17 + 8 * hg + j] : 0.f; bv[j] = sCL[(8 * hg + j) * CKP + kc]; }
              f32x16 acc = __builtin_amdgcn_mfma_f32_32x32x16_bf16(CK_PACK(av), CK_PACK(bv), f32x16{}, 0, 0, 0);
              const int ktp = kc >> 4, ii = kc & 15;
#pragma unroll
              for (int q = 0; q < 8; ++q) { const int t = (q & 3) + 8 * (q >> 2) + 4 * hg; const float nv = sDL[t * CKP + kc] - acc[q];
                  sFR[(8 + ktp) * 512 + (ii + 16 * (t >> 3)) * 8 + (t & 7)] = f2bf(nv); }
          } else {
              const int kr = 32 * (wave - 6) + r32; float av[8], bv[8];
#pragma unroll
              for (int j = 0; j < 8; ++j) { av[j] = sAP[kr * 17 + 8 * hg + j]; bv[j] = r32 < 16 ? sU[2 * 16 * 17 + (8 * hg + j) * 17 + r32] : 0.f; }
              f32x16 acc = __builtin_amdgcn_mfma_f32_32x32x16_bf16(CK_PACK(av), CK_PACK(bv), f32x16{}, 0, 0, 0);
              if (r32 < 16) { const int t = r32;
#pragma unroll
                  for (int q = 0; q < 16; ++q) { const int k = 32 * (wave - 6) + (q & 3) + 8 * (q >> 2) + 4 * hg; const float rv = sRn[t * CKP + k] - acc[q];
                      int g, kq, j; ck_kpos(k, g, kq, j); sFR[(12 + g) * 512 + (t + 16 * kq) * 8 + j] = f2bf(rv); } }
              if (wave == 7) {
                  float ev[8];
#pragma unroll
                  for (int j = 0; j < 8; ++j) ev[j] = r32 < 16 ? sDP[r32 * 17 + 8 * hg + j] : 0.f;
                  f32x16 ae = __builtin_amdgcn_mfma_f32_32x32x16_bf16(CK_PACK(ev), CK_PACK(bv), f32x16{}, 0, 0, 0);
                  if (r32 < 16) { const int t = r32;
#pragma unroll
                      for (int q = 0; q < 8; ++q) { const int i = (q & 3) + 8 * (q >> 2) + 4 * hg; const float e = sU[3 * 16 * 17 + i * 17 + t] - ae[q];
                          sFR[14 * 512 + (t + 16 * (i >> 3)) * 8 + (i & 7)] = f2bf(e); } } } }
#undef CK_PACK
        }
        __syncthreads();
        { u32x4* dst = (u32x4*)(FR + ((size_t)(h * NCK + c) * CK_NFR) * 1024); const LAS u32x4* src = (const LAS u32x4*)sFR;
          for (int i = tid; i < CK_NFR * 64; i += NWAVES * 64) dst[i] = src[i]; }
        __syncthreads();
    }
#undef CK_LOAD
}

constexpr int CK2_FLOATS = 9 * 16 * CKP + 4 * 16 * 17 + 64 * 17 + 16 * 17 + 64;
constexpr int CK2_BYTES = CK2_FLOATS * 4 + CK_NFR * 1024;
static_assert((CK2_FLOATS * 4) % 16 == 0 && CK2_BYTES % 16 == 0 && 2 * CK2_BYTES <= RING_BYTES, "two pre-pass groups fit the LDS ring");
__device__ __forceinline__ void p_rwkv_chunk2(const Frame& F, const Args& A, int pw, int NPW) {
    const bf16* PROJ = WSP(bf16, R_PROJ); const float* LOUT = WSP(float, R_LORAOUT); const float* mu = A.in[I_ABMU];
    const float* w0 = A.in[I_RWW0]; const float* a0 = A.in[I_RWA0]; const float* kk_ = A.in[I_RWKK]; const float* ka_ = A.in[I_RWKA]; const float* rk_ = A.in[I_RWRK];
    float* SV = WSP(float, R_SV); float* BONUS = WSP(float, WS_SMALL + SM_BONUS); unsigned char* FR = WSP(unsigned char, R_FR);
    const int tid = F.tid, lane = F.lane, grp = F.wave >> 2, wl = F.wave & 3, ltid = tid & 255, r32 = lane & 31, hg = lane >> 5;
    LAS float* L = (LAS float*)(F.lds + RING_OFF + grp * CK2_BYTES);
    LAS float* sA = L; LAS float* sP = L + 16 * CKP; LAS float* sB = L + 2 * 16 * CKP; LAS float* sKM = L + 3 * 16 * CKP; LAS float* sRH = L + 4 * 16 * CKP;
    LAS float* sCS = L + 5 * 16 * CKP; LAS float* sDM = L + 6 * 16 * CKP; LAS float* sCL = L + 7 * 16 * CKP; LAS float* sDL = L + 8 * 16 * CKP;
    LAS float* sU = L + 9 * 16 * CKP; LAS float* sAP = sU + 4 * 16 * 17; LAS float* sDP = sAP + 64 * 17; LAS float* sPL = sDP + 16 * 17; LAS bf16* sFR = (LAS bf16*)(sPL + 64);
    for (int i = ltid; i < CK_NFR * 512; i += 256) sFR[i] = 0;
    __syncthreads();
    unsigned* FLAG = (unsigned*)(F.ws + WS_CTL + CTL_FRFLAG); constexpr int NPAIR = NH_R * NCK / 2;
    float xr[5], xk[5], xv[5], lw[4], la[4], pm[8];
#define CK_LOAD(u_) do { const int c_ = (u_) >> 4, h_ = (u_) & 15, ch_ = 64 * h_ + lane, ta_ = c_ * CK + 4 * wl; \
        pm[0] = mu[ch_]; pm[1] = mu[1024 + ch_]; pm[2] = mu[2048 + ch_]; pm[3] = w0[ch_]; pm[4] = a0[ch_]; pm[5] = kk_[ch_]; pm[6] = ka_[ch_]; pm[7] = rk_[ch_]; \
        if (ta_ > 0) { const bf16* pp = PROJ + (size_t)(ta_ - 1) * AB_PAD; xr[0] = bf2f(pp[ch_]); xk[0] = bf2f(pp[1024 + ch_]); xv[0] = bf2f(pp[2048 + ch_]); } else { xr[0] = 0.f; xk[0] = 0.f; xv[0] = 0.f; } \
        _Pragma("unroll") for (int i = 0; i < 4; ++i) { const bf16* p0 = PROJ + (size_t)(ta_ + i) * AB_PAD; const float* lo = LOUT + (size_t)(ta_ + i) * 3072; \
            xr[1 + i] = bf2f(p0[ch_]); xk[1 + i] = bf2f(p0[1024 + ch_]); xv[1 + i] = bf2f(p0[2048 + ch_]); lw[i] = lo[ch_]; la[i] = lo[1024 + ch_]; } } while (0)
#define CK_PACK(v_) ({ u32x4 p_; p_.x = cvt_pk_bf16(v_[0], v_[1]); p_.y = cvt_pk_bf16(v_[2], v_[3]); p_.z = cvt_pk_bf16(v_[4], v_[5]); p_.w = cvt_pk_bf16(v_[6], v_[7]); __builtin_bit_cast(bf16x8, p_); })
    if (pw < NPAIR) CK_LOAD(2 * pw + grp);
    for (int pair = pw; pair < NPAIR; pair += NPW) { const int u = 2 * pair + grp, c = u >> 4, h = u & 15, t0 = c * CK;
        { const int ch = 64 * h + lane; const int ta = t0 + 4 * wl; float pr = xr[0], pk = xk[0], pv = xv[0];
#pragma unroll
          for (int i = 0; i < 4; ++i) { const int t = ta + i, tl = 4 * wl + i;
              const float r = xr[1 + i] + (pr - xr[1 + i]) * pm[0], k = xk[1 + i] + (pk - xk[1 + i]) * pm[1], v = xv[1 + i] + (pv - xv[1 + i]) * pm[2]; pr = xr[1 + i]; pk = xk[1 + i]; pv = xv[1 + i];
              const float w = __expf(-0.6065306597126334f * sigmoidf_(lw[i] + pm[3])), a = sigmoidf_(pm[4] + la[i]);
              float kk = k * pm[5]; const float km = k * (1.0f + (a - 1.0f) * pm[6]);
              const float q1 = wave_sum_dpp(kk * kk), q2 = wave_sum_dpp(r * km * pm[7]);
              kk = kk * __builtin_amdgcn_rsqf(fmaxf(q1, 1e-24f));
              sA[tl * CKP + lane] = kk; sP[tl * CKP + lane] = w; sB[tl * CKP + lane] = kk * a; sKM[tl * CKP + lane] = km; sRH[tl * CKP + lane] = r;
              sFR[(15 + (lane >> 4)) * 512 + ((lane & 15) + 16 * (tl >> 3)) * 8 + (tl & 7)] = f2bf(v);
              if (lane == 0) BONUS[t * 16 + h] = q2; } }
        if (pair + NPW < NPAIR) CK_LOAD(u + 2 * NPW);
        __syncthreads();
        { const int k = ltid & 63;
#pragma unroll
          for (int q = 0; q < 4; ++q) { const int t = (ltid >> 6) * 4 + q; float Pp = 1.f, P = 1.f, PL = 1.f;
#pragma unroll
              for (int i = 0; i < CK; ++i) { const float wv = sP[i * CKP + k]; PL *= wv; if (i < t) Pp *= wv; if (i <= t) P *= wv; }
              const float inv = __builtin_amdgcn_rcpf(P), ratio = PL * inv, kkv = sA[t * CKP + k], bv = sB[t * CKP + k], kmv = sKM[t * CKP + k], rv = sRH[t * CKP + k];
              sCS[t * CKP + k] = bv * inv; sDM[t * CKP + k] = kmv * inv; sCL[t * CKP + k] = bv * ratio; sDL[t * CKP + k] = kmv * ratio;
              sA[t * CKP + k] = Pp * kkv; sRH[t * CKP + k] = P * rv; if (t == 0) sPL[k] = PL; } }
        __syncthreads();
        if (wl == 0) { const LAS float* ar = (r32 < 16 ? sCS + r32 * CKP : sDM + (r32 - 16) * CKP); const LAS float* br = (r32 < 16 ? sA + r32 * CKP : sRH + (r32 - 16) * CKP); f32x16 acc = f32x16{};
#pragma unroll
            for (int ks = 0; ks < 4; ++ks) { float av[8], bv[8];
#pragma unroll
                for (int j = 0; j < 8; ++j) { av[j] = ar[16 * ks + 8 * hg + j]; bv[j] = br[16 * ks + 8 * hg + j]; }
                acc = __builtin_amdgcn_mfma_f32_32x32x16_bf16(CK_PACK(av), CK_PACK(bv), acc, 0, 0, 0); }
#pragma unroll
            for (int q = 0; q < 16; ++q) { const int row = (q & 3) + 8 * (q >> 2) + 4 * hg, col = r32, mat = (row >> 4) + 2 * (col >> 4), i = row & 15, t = col & 15;
                const bool keep = (mat & 2) ? (i <= t) : (i < t); sU[mat * 16 * 17 + i * 17 + t] = keep ? acc[q] : 0.f; } }
        __syncthreads();
        if (ltid < 80) { float x[CK]; const bool isA = ltid < 64; const int ri = isA ? ltid : ltid - 64;
#pragma unroll
            for (int t = 0; t < CK; ++t) x[t] = isA ? sA[t * CKP + ri] : sU[1 * 16 * 17 + ri * 17 + t];
#pragma unroll
            for (int jx = 0; jx < CK - 1; ++jx) { float urow[CK];
#pragma unroll
                for (int t = 0; t < CK; ++t) if (t > jx) urow[t] = sU[jx * 17 + t];
#pragma unroll
                for (int t = 0; t < CK; ++t) if (t > jx) x[t] -= x[jx] * urow[t]; }
            LAS float* dst = isA ? sAP + ri * 17 : sDP + ri * 17;
#pragma unroll
            for (int t = 0; t < CK; ++t) dst[t] = x[t]; }
        __syncthreads();
        { { const int kr = 32 * (wl >> 1) + r32, kc = 32 * (wl & 1) + r32; float av[8], bv[8];
#pragma unroll
            for (int j = 0; j < 8; ++j) { av[j] = sAP[kr * 17 + 8 * hg + j]; bv[j] = sCL[(8 * hg + j) * CKP + kc]; }
            const f32x16 acc = __builtin_amdgcn_mfma_f32_32x32x16_bf16(CK_PACK(av), CK_PACK(bv), f32x16{}, 0, 0, 0);
            const float pl = sPL[kc]; const int ktp = kc >> 4, ii = kc & 15;
#pragma unroll
            for (int q = 0; q < 16; ++q) { const int k = 32 * (wl >> 1) + (q & 3) + 8 * (q >> 2) + 4 * hg; const float m = ((k == kc) ? pl : 0.f) - acc[q];
                int g, kq, j; ck_kpos(k, g, kq, j); sFR[(ktp * 2 + g) * 512 + (ii + 16 * kq) * 8 + j] = f2bf(m); } }
          if (wl < 2) {
              const int kc = 32 * wl + r32; float av[8], bv[8];
#pragma unroll
              for (int j = 0; j < 8; ++j) { av[j] = r32 < 16 ? sDP[r32 * 17 + 8 * hg + j] : 0.f; bv[j] = sCL[(8 * hg + j) * CKP + kc]; }
              const f32x16 acc = __builtin_amdgcn_mfma_f32_32x32x16_bf16(CK_PACK(av), CK_PACK(bv), f32x16{}, 0, 0, 0);
              const int ktp = kc >> 4, ii = kc & 15;
#pragma unroll
              for (int q = 0; q < 8; ++q) { const int t = (q & 3) + 8 * (q >> 2) + 4 * hg; const float nv = sDL[t * CKP + kc] - acc[q];
                  sFR[(8 + ktp) * 512 + (ii + 16 * (t >> 3)) * 8 + (t & 7)] = f2bf(nv); }
          } else {
              const int kr = 32 * (wl - 2) + r32; float av[8], bv[8];
#pragma unroll
              for (int j = 0; j < 8; ++j) { av[j] = sAP[kr * 17 + 8 * hg + j]; bv[j] = r32 < 16 ? sU[2 * 16 * 17 + (8 * hg + j) * 17 + r32] : 0.f; }
              const f32x16 acc = __builtin_amdgcn_mfma_f32_32x32x16_bf16(CK_PACK(av), CK_PACK(bv), f32x16{}, 0, 0, 0);
              if (r32 < 16) { const int t = r32;
#pragma unroll
                  for (int q = 0; q < 16; ++q) { const int k = 32 * (wl - 2) + (q & 3) + 8 * (q >> 2) + 4 * hg; const float rv = sRH[t * CKP + k] - acc[q];
                      int g, kq, j; ck_kpos(k, g, kq, j); sFR[(12 + g) * 512 + (t + 16 * kq) * 8 + j] = f2bf(rv); } }
              if (wl == 3) {
                  float ev[8];
#pragma unroll
                  for (int j = 0; j < 8; ++j) ev[j] = r32 < 16 ? sDP[r32 * 17 + 8 * hg + j] : 0.f;
                  const f32x16 ae = __builtin_amdgcn_mfma_f32_32x32x16_bf16(CK_PACK(ev), CK_PACK(bv), f32x16{}, 0, 0, 0);
                  if (r32 < 16) { const int t = r32;
#pragma unroll
                      for (int q = 0; q < 8; ++q) { const int i = (q & 3) + 8 * (q >> 2) + 4 * hg; const float e = sU[3 * 16 * 17 + i * 17 + t] - ae[q];
                          sFR[14 * 512 + (t + 16 * (i >> 3)) * 8 + (i & 7)] = f2bf(e); } } } } }
        __syncthreads();
        { unsigned char* dst = FR + ((size_t)(h * NCK + c) * CK_NFR) * 1024; const LAS u32x4* src = (const LAS u32x4*)sFR;
          for (int i = ltid; i < CK_NFR * 64; i += 256) { const u32x4 v = src[i]; asm volatile("global_store_dwordx4 %0, %1, off sc1\n\ts_nop 1" :: "v"(dst + (size_t)i * 16), "v"(v) : "memory"); } }
        asm volatile("s_waitcnt vmcnt(0)" ::: "memory");
        __syncthreads();
        if (ltid == 0) __hip_atomic_store(FLAG + h * NCK + c, 1u, __ATOMIC_RELAXED, __HIP_MEMORY_SCOPE_AGENT);
    }
#undef CK_LOAD
#undef CK_PACK
}

constexpr int SQ_SLOT = CK_NFR * 1024, SQ_NSLOT = 8, SQ_AHEAD = 7, SQ_TOUCH = 24;
constexpr bool SQ_TOUCH_ON = false;
static_assert(SQ_SLOT * SQ_NSLOT <= RING_BYTES, "fragment ring fits the LDS ring");
__device__ __forceinline__ void p_rwkv_seq(const Frame& F) {
    const int head = blockIdx.x, vq = F.wave & 3, lane = F.lane, n = lane & 15, q = lane >> 4; const bool worker = F.wave < 4;
    const unsigned char* FRh = WSP(unsigned char, R_FR) + (size_t)head * NCK * CK_NFR * 1024 + lane * 16; float* Y = WSP(float, R_Y) + head * 64 + vq * 16 + n;
    LAS unsigned char* lds = F.lds + RING_OFF;
    const unsigned* FLG = (const unsigned*)(F.ws + WS_CTL + CTL_FRFLAG) + head * NCK; int ready = 0;
#define SQ_NEED(c_) do { while (ready <= (c_)) { const int i_ = ready + lane; unsigned f_ = 0u; if (i_ < NCK) f_ = __hip_atomic_load(FLG + i_, __ATOMIC_RELAXED, __HIP_MEMORY_SCOPE_AGENT); \
        const unsigned long long b_ = __ballot(f_ != 0u); const int n_ = (b_ == ~0ull) ? 64 : (int)__builtin_ctzll(~b_); ready = __builtin_amdgcn_readfirstlane(ready + n_); \
        if (n_ == 0) __builtin_amdgcn_s_sleep(16); else __builtin_amdgcn_fence(__ATOMIC_ACQUIRE, "agent"); } } while (0)
#define SQ_ISSUE(c_, s_) do { const unsigned char* g_ = FRh + (size_t)(c_) * CK_NFR * 1024; LAS unsigned char* d_ = lds + (s_) * SQ_SLOT; \
        _Pragma("unroll") for (int f = 0; f < 5; ++f) if (vq + 4 * f < CK_NFR) __builtin_amdgcn_global_load_lds((const unsigned*)(g_ + (vq + 4 * f) * 1024), (LAS unsigned*)(d_ + (vq + 4 * f) * 1024), 16, 0, 0); } while (0)
#define SQ_READ(dst, s_) do { const LAS unsigned char* d_ = lds + (s_) * SQ_SLOT + lane * 16; _Pragma("unroll") for (int f = 0; f < 15; ++f) dst[f] = *(const LAS bf16x8*)(d_ + f * 1024); \
        dst[15] = *(const LAS bf16x8*)(d_ + (15 + vq) * 1024); } while (0)
#define SQ_STEP(cur, nxt, c_) do { \
        if (worker) { if ((c_) + SQ_AHEAD >= NCK) asm volatile("s_waitcnt vmcnt(0)" ::: "memory"); else if (vq == 3) asm volatile("s_waitcnt vmcnt(44)" ::: "memory"); else asm volatile("s_waitcnt vmcnt(49)" ::: "memory"); }     \
        else if (SQ_TOUCH_ON && F.wave == 4 && (c_) + SQ_TOUCH < NCK) { const unsigned char* g_ = FRh - lane * 16 + (size_t)((c_) + SQ_TOUCH) * CK_NFR * 1024 + lane * 128; \
            _Pragma("unroll") for (int i_ = 0; i_ < 3; ++i_) if (i_ * 64 + lane < CK_NFR * 8) asm volatile("global_load_dword %0, %1, off" : "+v"(dummy) : "v"(g_ + i_ * 8192) : "memory"); }     \
        __builtin_amdgcn_s_barrier();                                                       \
        if (worker) { \
            if ((c_) + SQ_AHEAD < NCK) { SQ_NEED((c_) + SQ_AHEAD); SQ_ISSUE((c_) + SQ_AHEAD, sl_free); } \
            if ((c_) + 1 < NCK) SQ_READ(nxt, sl_next); \
            bf16x8 xb[2]; \
            _Pragma("unroll") for (int g = 0; g < 2; ++g) { u32x4 p; p.x = cvt_pk_bf16(X[2 * g][0], X[2 * g][1]); p.y = cvt_pk_bf16(X[2 * g][2], X[2 * g][3]); p.z = cvt_pk_bf16(X[2 * g + 1][0], X[2 * g + 1][1]); p.w = cvt_pk_bf16(X[2 * g + 1][2], X[2 * g + 1][3]); \
                xb[g] = __builtin_bit_cast(bf16x8, p); } \
            f32x4 y = (f32x4){0.f, 0.f, 0.f, 0.f}; \
            y = __builtin_amdgcn_mfma_f32_16x16x32_bf16(cur[14], cur[15], y, 0, 0, 0); \
            y = __builtin_amdgcn_mfma_f32_16x16x32_bf16(cur[12], xb[0], y, 0, 0, 0); \
            y = __builtin_amdgcn_mfma_f32_16x16x32_bf16(cur[13], xb[1], y, 0, 0, 0); \
            f32x4 Xn[4]; \
            _Pragma("unroll") for (int kt = 0; kt < 4; ++kt) { f32x4 a = (f32x4){0.f, 0.f, 0.f, 0.f}; \
                a = __builtin_amdgcn_mfma_f32_16x16x32_bf16(cur[8 + kt], cur[15], a, 0, 0, 0); \
                a = __builtin_amdgcn_mfma_f32_16x16x32_bf16(cur[2 * kt], xb[0], a, 0, 0, 0); \
                a = __builtin_amdgcn_mfma_f32_16x16x32_bf16(cur[2 * kt + 1], xb[1], a, 0, 0, 0); \
                Xn[kt] = a; } \
            _Pragma("unroll") for (int r = 0; r < 4; ++r) Y[(size_t)((c_) * CK + 4 * q + r) * 1024] = y[r]; \
            _Pragma("unroll") for (int kt = 0; kt < 4; ++kt) X[kt] = Xn[kt]; } \
        sl_free = sl_free == SQ_NSLOT - 1 ? 0 : sl_free + 1; sl_next = sl_next == SQ_NSLOT - 1 ? 0 : sl_next + 1; } while (0)
    f32x4 X[4]; unsigned dummy = 0;
#pragma unroll
    for (int i = 0; i < 4; ++i) X[i] = (f32x4){0.f, 0.f, 0.f, 0.f};
    bf16x8 fa[16], fb[16];
    if (worker) { SQ_NEED(SQ_AHEAD - 1);
#pragma unroll
        for (int c = 0; c < SQ_AHEAD; ++c) SQ_ISSUE(c, c); }
    asm volatile("s_waitcnt vmcnt(0)" ::: "memory");
    __builtin_amdgcn_s_barrier();
    if (worker) SQ_READ(fa, 0);
    int sl_free = SQ_AHEAD, sl_next = 1;
    for (int c = 0; c < NCK; c += 2) { SQ_STEP(fa, fb, c); SQ_STEP(fb, fa, c + 1); }
    asm volatile("s_waitcnt vmcnt(0)" : "+v"(dummy) :: "memory");
#undef SQ_NEED
#undef SQ_ISSUE
#undef SQ_READ
#undef SQ_STEP
}

constexpr int ML_P = 264;
__device__ __forceinline__ void ml_stage_chunk(const Frame& F, const bf16* src  , int h, int c, LAS bf16* dst) {
    for (int i = F.tid; i < 64 * 32; i += NWAVES * 64) { const int s = i >> 5, ch = i & 31;
        *(LAS u32x4*)(dst + s * ML_P + 8 * ch) = *(const u32x4*)(src + (size_t)(64 * c + s) * 1024 + 256 * h + 8 * ch); }
}
template <int NA>
__device__ __forceinline__ void ml_stage_chunks(const Frame& F, const bf16* const (&src)[NA], const int (&pitch)[NA], int h, int c, LAS bf16* const (&dst)[NA]) {
    u32x4 r[NA][4];
#pragma unroll
    for (int a = 0; a < NA; ++a)
#pragma unroll
        for (int k = 0; k < 4; ++k) { const int i = F.tid + NWAVES * 64 * k, s = i >> 5, ch = i & 31; r[a][k] = *(const u32x4*)(src[a] + (size_t)(64 * c + s) * pitch[a] + 256 * h + 8 * ch); }
#pragma unroll
    for (int a = 0; a < NA; ++a)
#pragma unroll
        for (int k = 0; k < 4; ++k) { const int i = F.tid + NWAVES * 64 * k, s = i >> 5, ch = i & 31; *(LAS u32x4*)(dst[a] + s * ML_P + 8 * ch) = r[a][k]; }
}
__device__ __forceinline__ void p_mlu(const Frame& F, int first, int stride) {
    const bf16* KB = WSP(bf16, R_KB); const bf16* VB = WSP(bf16, R_PROJ) + 5568;     const float* BCUM = WSP(float, WS_SMALL + SM_BCUM); const float* IG = WSP(float, WS_SMALL + SM_IG);
    const float* CHBL = WSP(float, WS_SMALL + SM_CHBL); const float* MOUT = WSP(float, WS_SMALL + SM_MOUT);
    bf16* U = WSP(bf16, R_U); float* NU = WSP(float, WS_SMALL + SM_NU);
    LAS bf16* Ks = (LAS bf16*)(F.lds + RING_OFF); LAS bf16* Vs = Ks + 64 * ML_P; LAS float* wst = (LAS float*)(Vs + 64 * ML_P);
    const int lane = F.lane, r = lane & 31, hg = lane >> 5, w = F.wave;
    for (int L = first; L < NH_M * 128; L += stride) { const int h = L >> 7, c = L & 127;
        __syncthreads();
        { const bf16* const srcs[2] = {KB, VB}; const int pit[2] = {1024, AB_PAD}; LAS bf16* const dsts[2] = {Ks, Vs}; ml_stage_chunks<2>(F, srcs, pit, h, c, dsts); }
        if (F.tid < 64) wst[F.tid] = __expf(CHBL[h * 128 + c] - BCUM[h * T + 64 * c + F.tid] + IG[h * T + 64 * c + F.tid] - MOUT[h * 128 + c]);
        __syncthreads();
        f32x16 acc[8];
#pragma unroll
        for (int nt = 0; nt < 8; ++nt) acc[nt] = f32x16{};
#pragma unroll
        for (int ks = 0; ks < 4; ++ks) { bf16x8 a; float av[8];
#pragma unroll
            for (int jj = 0; jj < 8; ++jj) { const int s = 16 * ks + 8 * hg + jj; av[jj] = bf2f(Vs[s * ML_P + 32 * w + r]) * wst[s]; }
            { u32x4 p; p.x = cvt_pk_bf16(av[0], av[1]); p.y = cvt_pk_bf16(av[2], av[3]); p.z = cvt_pk_bf16(av[4], av[5]); p.w = cvt_pk_bf16(av[6], av[7]); a = __builtin_bit_cast(bf16x8, p); }
#pragma unroll
            for (int nt = 0; nt < 8; ++nt) { bf16x8 b;
#pragma unroll
                for (int jj = 0; jj < 8; ++jj) b[jj] = (short)Ks[(16 * ks + 8 * hg + jj) * ML_P + 32 * nt + r];
                acc[nt] = __builtin_amdgcn_mfma_f32_32x32x16_bf16(a, b, acc[nt], 0, 0, 0); } }
        bf16* Uo = U + ((size_t)(h * 128 + c) * 256 + 32 * w) * 256;
#pragma unroll
        for (int nt = 0; nt < 8; ++nt)
#pragma unroll
            for (int q = 0; q < 16; ++q) { const int vl = (q & 3) + 8 * (q >> 2) + 4 * hg; Uo[(size_t)vl * 256 + 32 * nt + r] = f2bf(acc[nt][q]); }
        if (F.tid < 256) { float s = 0.f;
            for (int ss = 0; ss < 64; ++ss) s += wst[ss] * bf2f(Ks[ss * ML_P + F.tid]);
            NU[(size_t)(h * 128 + c) * 256 + F.tid] = s; }
    }
}
__device__ __forceinline__ void p_mlscan(const Frame& F) {
    bf16* U = WSP(bf16, R_U); float* NU = WSP(float, WS_SMALL + SM_NU); const float* WCARRY = WSP(float, WS_SMALL + SM_WCARRY);
    const int gt = F.gw * 64 + F.lane, NGT = F.NGW * 64;
    for (int it = gt; it < NH_M * 65536 / 4; it += NGT) { const int h = it >> 14, e = (it & 16383) * 4;
        float C0 = 0.f, C1 = 0.f, C2 = 0.f, C3 = 0.f; bf16* p = U + (size_t)h * 128 * 65536 + e;
#pragma unroll 32
        for (int c = 0; c < 128; ++c) { const u32x2 u = *(const u32x2*)(p + (size_t)c * 65536); const float wc = WCARRY[h * 128 + c];
            u32x2 o; o.x = cvt_pk_bf16(C0, C1); o.y = cvt_pk_bf16(C2, C3); *(u32x2*)(p + (size_t)c * 65536) = o;
            C0 = wc * C0 + bf2f(u.x & 0xffffu); C1 = wc * C1 + bf2f(u.x >> 16); C2 = wc * C2 + bf2f(u.y & 0xffffu); C3 = wc * C3 + bf2f(u.y >> 16); } }
    const int gt2 = gt - (NGT / 2);
    for (int it = gt2; it >= 0 && it < NH_M * 256; it += NGT) { const int h = it >> 8, k = it & 255; float n = 0.f; float* p = NU + (size_t)h * 128 * 256 + k;
#pragma unroll 16
        for (int c = 0; c < 128; ++c) { const float u = p[c * 256]; p[c * 256] = n; n = WCARRY[h * 128 + c] * n + u; } }
}
__device__ __forceinline__ void p_mlout(const Frame& F, const Args& A) {
    const bf16* QB = WSP(bf16, R_QB); const bf16* KB = WSP(bf16, R_KB); const bf16* VB = WSP(bf16, R_PROJ) + 5568;     const bf16* CS = WSP(bf16, R_U); const float* NC = WSP(float, WS_SMALL + SM_NU);
    const float* BCUM = WSP(float, WS_SMALL + SM_BCUM); const float* IG = WSP(float, WS_SMALL + SM_IG); const float* MSEQ = WSP(float, WS_SMALL + SM_MSEQ);
    const bf16* PROJ = WSP(bf16, R_PROJ); const float* mhg = A.in[I_MLNG]; bf16* YCAT = WSP(bf16, R_YCAT);
    LAS bf16* Qs = (LAS bf16*)(F.lds + RING_OFF); LAS bf16* Ks = Qs + 64 * ML_P; LAS bf16* Vs = Ks + 64 * ML_P; LAS bf16* Ss = Vs + 64 * ML_P;
    LAS float* fa = (LAS float*)(Ss + 64 * 72); LAS float* bch = fa; LAS float* ich = fa + 64; LAS float* mrow = fa + 128; LAS float* wint = fa + 192; LAS float* rsum = fa + 256  ;
    LAS float* nq = fa + 384; LAS float* nvec = fa + 448  ; LAS float* Hs = (LAS float*)(F.lds + RING_OFF);
    const int lane = F.lane, r = lane & 31, hg = lane >> 5, w = F.wave;
    for (int L = F.vcu; L < NH_M * 128; L += F.G) { const int h = L >> 7, c = L & 127;
        __syncthreads();
        { const bf16* const srcs[3] = {QB, KB, VB}; const int pit[3] = {1024, 1024, AB_PAD}; LAS bf16* const dsts[3] = {Qs, Ks, Vs}; ml_stage_chunks<3>(F, srcs, pit, h, c, dsts); }
        if (F.tid < 64) { bch[F.tid] = BCUM[h * T + 64 * c + F.tid]; ich[F.tid] = IG[h * T + 64 * c + F.tid]; }
        if (F.tid < 256) nvec[F.tid] = NC[(size_t)(h * 128 + c) * 256 + F.tid];
        const float mc = MSEQ[h * 128 + c];
        __syncthreads();
        if (w == 0) { float g = ich[lane] - bch[lane];
#pragma unroll
            for (int o = 1; o < 64; o <<= 1) { const float x = __shfl_up(g, o); if (lane >= o) g = fmaxf(g, x); }
            const float mr = bch[lane] + fmaxf(mc, g); mrow[lane] = mr; wint[lane] = __expf(bch[lane] + mc - mr); }
        if (w == 1) { float s = 0.f;
            for (int k = 0; k < 256; ++k) s += nvec[k] * bf2f(Qs[lane * ML_P + k]);
            nq[lane] = s; }
        __syncthreads();
        if (w < 4) { const int st = w & 1, lt = w >> 1; f32x16 acc = f32x16{};
#pragma unroll
            for (int ks = 0; ks < 16; ++ks) { const bf16x8 a = *(const LAS bf16x8*)(Ks + (32 * st + r) * ML_P + 16 * ks + 8 * hg), b = *(const LAS bf16x8*)(Qs + (32 * lt + r) * ML_P + 16 * ks + 8 * hg);
                acc = __builtin_amdgcn_mfma_f32_32x32x16_bf16(a, b, acc, 0, 0, 0); }
            const int l = 32 * lt + r; const float bl_ = bch[l], mr = mrow[l]; float rs = 0.f;
#pragma unroll
            for (int g4 = 0; g4 < 4; ++g4) { float v4[4];
#pragma unroll
                for (int i = 0; i < 4; ++i) { const int s = 32 * st + 8 * g4 + 4 * hg + i; const float d = bl_ - bch[s] + ich[s] - mr;
                    v4[i] = (s <= l) ? acc[4 * g4 + i] * __expf(d) : 0.f; rs += v4[i]; }
                u32x2 p; p.x = cvt_pk_bf16(v4[0], v4[1]); p.y = cvt_pk_bf16(v4[2], v4[3]);
                *(LAS u32x2*)(Ss + l * 72 + 32 * st + 8 * g4 + 4 * hg) = p; }
            rs += __shfl_xor(rs, 32);
            if (hg == 0) rsum[st * 64 + l] = rs; }
        __syncthreads();
        const int lt = w & 1, vg = w >> 1; f32x16 ai[2], aa[2]; ai[0] = f32x16{}; ai[1] = f32x16{}; aa[0] = f32x16{}; aa[1] = f32x16{};
        const bf16* Cb = CS + (size_t)(h * 128 + c) * 65536;
#pragma unroll 8
        for (int ks = 0; ks < 16; ++ks) { const bf16x8 a = *(const LAS bf16x8*)(Qs + (32 * lt + r) * ML_P + 16 * ks + 8 * hg);
#pragma unroll
            for (int jt = 0; jt < 2; ++jt) { const bf16x8 b = *(const bf16x8*)(Cb + (size_t)(64 * vg + 32 * jt + r) * 256 + 16 * ks + 8 * hg);
                ai[jt] = __builtin_amdgcn_mfma_f32_32x32x16_bf16(a, b, ai[jt], 0, 0, 0); } }
#pragma unroll
        for (int ks = 0; ks < 4; ++ks) { const bf16x8 a = *(const LAS bf16x8*)(Ss + (32 * lt + r) * 72 + 16 * ks + 8 * hg);
#pragma unroll
            for (int jt = 0; jt < 2; ++jt) { bf16x8 b;
#pragma unroll
                for (int jj = 0; jj < 8; ++jj) b[jj] = (short)Vs[(16 * ks + 8 * hg + jj) * ML_P + 64 * vg + 32 * jt + r];
                aa[jt] = __builtin_amdgcn_mfma_f32_32x32x16_bf16(a, b, aa[jt], 0, 0, 0); } }
        __syncthreads();
#pragma unroll
        for (int q = 0; q < 16; ++q) { const int l = 32 * lt + (q & 3) + 8 * (q >> 2) + 4 * hg; const float wi = wint[l];
            const float den = rsum[l] + rsum[64 + l] + wi * nq[l]; const float dn = __builtin_amdgcn_rcpf(fmaxf(fabsf(den), __expf(-mrow[l])));
#pragma unroll
            for (int jt = 0; jt < 2; ++jt) Hs[l * 260 + 64 * vg + 32 * jt + r] = (aa[jt][q] + wi * ai[jt][q]) * dn; }
        __syncthreads();
        { const f32x4 g = *(const f32x4*)(mhg + 256 * h + 4 * lane); u32x2 ob[8]; f32x4 hv[8]; float ss[8];
#pragma unroll
          for (int i = 0; i < 8; ++i) ob[i] = *(const u32x2*)(PROJ + (size_t)(64 * c + 8 * w + i) * AB_PAD + 6592 + 256 * h + 4 * lane);
#pragma unroll
          for (int i = 0; i < 8; ++i) { hv[i] = *(const LAS f32x4*)(Hs + (8 * w + i) * 260 + 4 * lane); ss[i] = (hv[i][0] * hv[i][0] + hv[i][1] * hv[i][1]) + (hv[i][2] * hv[i][2] + hv[i][3] * hv[i][3]); }
#pragma unroll
          for (int i = 0; i < 8; ++i) ss[i] = wave_sum_dpp(ss[i]);
#pragma unroll
          for (int i = 0; i < 8; ++i) { const int t = 64 * c + 8 * w + i; const float rn = __builtin_amdgcn_rsqf(ss[i] * (1.0f / 256.0f) + 1e-6f);
            const float o0 = hv[i][0] * rn * g[0] * sigmoidf_(bf2f(ob[i].x & 0xffffu)), o1 = hv[i][1] * rn * g[1] * sigmoidf_(bf2f(ob[i].x >> 16));
            const float o2 = hv[i][2] * rn * g[2] * sigmoidf_(bf2f(ob[i].y & 0xffffu)), o3 = hv[i][3] * rn * g[3] * sigmoidf_(bf2f(ob[i].y >> 16));
            u32x2 p; p.x = cvt_pk_bf16(o0, o1); p.y = cvt_pk_bf16(o2, o3);
            *(u32x2*)(YCAT + (size_t)t * D + 1024 + 256 * h + 4 * lane) = p; } }
    }
}

struct XsOrder {
    const bf16* XQ; const bf16* KM; int G, c;
    __device__ __forceinline__ bool next(int i, pg8::Unit& u) const {
        const int L = i * G + c; if (L >= 32 * 4) return false;
        const int pm = L >> 2, hd = L & 3; u.pm = pm; u.pn = 0; u.aux = hd; u.pad = 0;
        u.a = (const char*)(XQ + (size_t)pm * 256 * D + 512 * hd); u.b = (const char*)(KM + 512 * hd); return true;
    }
};
struct XpreOrder {
    const bf16* kmem; const bf16* vmem; const bf16* wqp; const bf16* wot; int G, c;
    __device__ __forceinline__ bool next(int i, pg8::Unit& u) const {
        if (c < 0) return false; const int L = i * G + c; if (L >= 128) return false;
        const int l = L >> 6, kind = (L >> 5) & 1, hd = (L >> 3) & 3, idx = L & 7; u.pad = 0; u.aux = L >> 3;
        if (kind == 0) { u.a = (const char*)(kmem + (size_t)l * NMEM * D + 512 * hd); u.b = (const char*)(wqp + (size_t)l * D * D + (size_t)idx * 256 * D + 512 * hd); u.pm = 0; u.pn = idx; }
        else { u.a = (const char*)(wot + (size_t)l * D * D + (size_t)idx * 256 * D + 512 * hd); u.b = (const char*)(vmem + (size_t)l * NMEM * D + 512 * hd); u.pm = idx; u.pn = 0; }
        return true;
    }
};
struct EpiXpre {
    static constexpr bool PERM = true;
    bf16* kq; bf16* vwt;
    __device__ __forceinline__ void operator()(const f32x4 (&acc)[2][2][4][2], const pg8::Unit& u, int wr, int wc, int fr, int fq) const {
        const int l = u.aux >> 3, kind = (u.aux >> 2) & 1, hd = u.aux & 3;
        pg8::EpiBf16 E{kind == 0 ? kq + (size_t)((l * 4 + hd) * 256) * D : vwt + (size_t)l * D * 1024 + 256 * hd, kind == 0 ? D : 1024, nullptr, -1, nullptr};
        E(acc, u, wr, wc, fr, fq);
    }
};
struct XkqOrder {
    const bf16* XN; const bf16* KQ; int G, c;
    __device__ __forceinline__ bool next(int i, pg8::Unit& u) const {
        const int L = i * G + c; if (L >= 32 * 4) return false;
        const int pm = L >> 2, hd = L & 3; u.pm = pm; u.pn = 0; u.aux = hd; u.pad = 0;
        u.a = (const char*)(XN + (size_t)pm * 256 * D); u.b = (const char*)(KQ + (size_t)hd * 256 * D); return true;
    }
};
struct XpvOrder {
    const bf16* XP; const bf16* VT; int G, c;
    __device__ __forceinline__ bool next(int i, pg8::Unit& u) const {
        int pm, pn; if (!pg8::static_tile(i, G, c, 32, 8, pm, pn)) return false;
        u.pm = pm; u.pn = pn; u.aux = 0; u.pad = 0;
        u.a = (const char*)(XP + (size_t)pm * 256 * 1024 + 256 * (pn >> 1)); u.b = (const char*)(VT + (size_t)pn * 256 * NMEM); return true;
    }
};
__device__ __forceinline__ void p_xsoftmax(const Frame& F) {
    const float* XS = WSP(float, R_XS); bf16* XP = WSP(bf16, R_XP); const int lane = F.lane;
    for (int t = F.gw; t < T; t += F.NGW)
#pragma unroll
        for (int hd = 0; hd < 4; ++hd) { const f32x4 s = *(const f32x4*)(XS + (size_t)t * 1024 + 256 * hd + 4 * lane);
            const float m = wave_max(fmaxf(fmaxf(s[0], s[1]), fmaxf(s[2], s[3])));
            const float e0 = __expf(s[0] - m), e1 = __expf(s[1] - m), e2 = __expf(s[2] - m), e3 = __expf(s[3] - m);
            const float inv = 1.0f / wave_sum((e0 + e1) + (e2 + e3));
            u32x2 p; p.x = cvt_pk_bf16(e0 * inv, e1 * inv); p.y = cvt_pk_bf16(e2 * inv, e3 * inv);
            *(u32x2*)(XP + (size_t)t * 1024 + 256 * hd + 4 * lane) = p; }
}

__device__ __forceinline__ void p_norm_fpre(const Frame& F, const Args& A) {
    LAS float* Ws = (LAS float*)(F.lds + RING_OFF);
    stage_skinny<16>(F, A.in[I_FOXWIN], FOX_LD, 8192, Ws);
    __syncthreads();
    const float* X = WSP(float, WS_X); bf16* XN = WSP(bf16, WS_XN); float* FPRE = WSP(float, WS_SMALL + SM_FPRE); const float* g = A.in[I_NMIXG] + D;
    const float bfh = A.in[I_FOXBF][F.lane & 15];
#define FP_EMIT(t_, o_) do { if (F.lane < 16) { float v_ = o_[0]; _Pragma("unroll") for (int c = 1; c < 16; ++c) v_ = (F.lane == c) ? o_[c] : v_; \
        FPRE[(t_) * 16 + F.lane] = logsigmoidf_(v_ + bfh); } } while (0)
    if (T == 4 * F.NGW) { float oa[16], ob[16], oc[16], od[16]; rms_rows4_dots<16>(X, g, XN, F.lane, F.gw, F.gw + F.NGW, F.gw + 2 * F.NGW, F.gw + 3 * F.NGW, Ws, oa, ob, oc, od);
        FP_EMIT(F.gw, oa); FP_EMIT(F.gw + F.NGW, ob); FP_EMIT(F.gw + 2 * F.NGW, oc); FP_EMIT(F.gw + 3 * F.NGW, od); }
    else for (int t = F.gw; t < T; t += F.NGW) { f32x4 y[8]; rms_row(X + (size_t)t * D, g, XN + (size_t)t * D, F.lane, y); float o[16]; skinny_dot<16>(y, Ws, F.lane, o); FP_EMIT(t, o); }
#undef FP_EMIT
    __syncthreads();
}
__device__ __forceinline__ void p_foxprep(const Frame& F, const Args& A) {
    bf16* QKVG = WSP(bf16, R_QKVG); const float* qg = A.in[I_FOXQG]; const float* kg = A.in[I_FOXKG]; const int lane = F.lane;
    if (2 * T == 8 * F.NGW) { const int hd = lane >> 2, qt = lane & 3, sec = F.gw & 1; const float* gg = (sec ? kg : qg) + 32 * qt; f32x4 gv[8]; bf16x8 x[8][4];
#pragma unroll
        for (int j = 0; j < 8; ++j) gv[j] = *(const f32x4*)(gg + 4 * j);
#pragma unroll
        for (int i = 0; i < 8; ++i) { const int t = (F.gw + i * F.NGW) >> 1; const bf16* row = QKVG + (size_t)t * 8192 + sec * 2048 + 128 * hd + 32 * qt;
#pragma unroll
            for (int j = 0; j < 4; ++j) x[i][j] = *(const bf16x8*)(row + 8 * j); }
        __builtin_amdgcn_sched_barrier(0);
#define FP_DPP(v_, ctrl) __builtin_bit_cast(float, __builtin_amdgcn_update_dpp(0, __builtin_bit_cast(int, v_), ctrl, 0xF, 0xF, true))
#pragma unroll
        for (int i = 0; i < 8; ++i) { const int t = (F.gw + i * F.NGW) >> 1; bf16* row = QKVG + (size_t)t * 8192 + sec * 2048 + 128 * hd + 32 * qt; float v[32]; float ss = 0.f;
#pragma unroll
            for (int j = 0; j < 4; ++j)
#pragma unroll
                for (int e = 0; e < 8; ++e) { v[8 * j + e] = bf2f((unsigned short)x[i][j][e]); ss += v[8 * j + e] * v[8 * j + e]; }
            ss += FP_DPP(ss, 0xB1); ss += FP_DPP(ss, 0x4E);
            const float rn = __builtin_amdgcn_rsqf(ss * (1.0f / 128.0f) + 1e-6f);
#pragma unroll
            for (int j = 0; j < 4; ++j) { u32x4 w; const f32x4 g0 = gv[2 * j], g1 = gv[2 * j + 1];
                w.x = cvt_pk_bf16(v[8 * j] * rn * g0[0], v[8 * j + 1] * rn * g0[1]); w.y = cvt_pk_bf16(v[8 * j + 2] * rn * g0[2], v[8 * j + 3] * rn * g0[3]);
                w.z = cvt_pk_bf16(v[8 * j + 4] * rn * g1[0], v[8 * j + 5] * rn * g1[1]); w.w = cvt_pk_bf16(v[8 * j + 6] * rn * g1[2], v[8 * j + 7] * rn * g1[3]);
                *(u32x4*)(row + 8 * j) = w; } }
#undef FP_DPP
    } else
    for (int it = F.gw; it < 2 * T; it += F.NGW) { const int t = it >> 1, sec = it & 1; const float* gg = sec ? kg : qg; const float g0 = gg[2 * lane], g1 = gg[2 * lane + 1];
        unsigned* row = (unsigned*)(QKVG + (size_t)t * 8192 + sec * 2048) + lane;
#pragma unroll 4
        for (int h = 0; h < NH_F; ++h) { const unsigned u = row[64 * h]; const float a = bf2f(u & 0xffffu), b = bf2f(u >> 16);
            const float rn = 1.0f / sqrtf(wave_sum(a * a + b * b) * (1.0f / 128.0f) + 1e-6f);
            row[64 * h] = cvt_pk_bf16(a * rn * g0, b * rn * g1); } }
    if (F.gw < NH_F) { const int h = F.gw; const float* FPRE = WSP(float, WS_SMALL + SM_FPRE); float* BL = WSP(float, WS_SMALL + SM_BIASL2); const float bf = A.in[I_FOXBF][h];
        float carry = 0.f; float va[16], vb[16];
#define FC_LOAD(v_, c0_) do { _Pragma("unroll") for (int i = 0; i < 16; ++i) v_[i] = FPRE[(size_t)(64 * ((c0_) + i) + lane) * 16 + h]; } while (0)
#define FC_PROC(v_, c0_) do { _Pragma("unroll") for (int i = 0; i < 16; ++i) v_[i] = wave_scan_dpp(v_[i]); \
            _Pragma("unroll") for (int i = 0; i < 16; ++i) { const float tot = __builtin_bit_cast(float, __builtin_amdgcn_readlane(__builtin_bit_cast(int, v_[i]), 63)); const float b = v_[i] + carry; BL[h * T + 64 * ((c0_) + i) + lane] = -1.4426950408889634f * b; carry = tot + carry; } } while (0)
        FC_LOAD(va, 0);
        for (int c0 = 0; c0 < 128; c0 += 32) { FC_LOAD(vb, c0 + 16); __builtin_amdgcn_sched_barrier(0); FC_PROC(va, c0); __builtin_amdgcn_sched_barrier(0);
            if (c0 + 32 < 128) FC_LOAD(va, c0 + 32); __builtin_amdgcn_sched_barrier(0); FC_PROC(vb, c0 + 16); __builtin_amdgcn_sched_barrier(0); }
#undef FC_LOAD
#undef FC_PROC
    }
}
__device__ __forceinline__ void p_foxattn(const Frame& F) {
    const bf16* QKVG = WSP(bf16, R_QKVG); bf16* ATTO = WSP(bf16, R_ATTO); const float* BL = WSP(float, WS_SMALL + SM_BIASL2);
    char* lds = (char*)F.ldsg + RING_OFF;
    for (int L = F.vcu; L < 256; L += F.G) { const int h = L >> 4, x = L & 15;
        __syncthreads();
        { float* bl = (float*)(lds + fox::BIAS_OFF); for (int i = F.tid; i < T / 4; i += NWAVES * 64) *(f32x4*)(bl + 4 * i) = *(const f32x4*)(BL + (size_t)h * T + 4 * i); }
        fox::BlockRef b0, b1; const int q0 = x, q1 = 31 - x;
        b0.Q = QKVG + (size_t)q0 * 256 * 8192 + 128 * h; b0.K = QKVG + 2048 + 128 * h; b0.V = QKVG + 4096 + 128 * h; b0.G = QKVG + (size_t)q0 * 256 * 8192 + 6144 + 128 * h;
        b0.O = ATTO + (size_t)q0 * 256 * D + 128 * h; b0.P0 = q0 * 256;
        b1 = b0; b1.Q = QKVG + (size_t)q1 * 256 * 8192 + 128 * h; b1.G = QKVG + (size_t)q1 * 256 * 8192 + 6144 + 128 * h; b1.O = ATTO + (size_t)q1 * 256 * D + 128 * h; b1.P0 = q1 * 256;
        fox::Seam S;
        fox::prime(b0, lds, S);
#ifdef FOX_LOOP
        for (int pass = 0; pass < 2; ++pass) { fox::block(b0, b1, lds, S); b0 = b1; }
#else
        fox::block(b0, b1, lds, S);
        fox::block(b1, b1, lds, S);
#endif
    }
}

__device__ __forceinline__ void p_norm_route(const Frame& F, const Args& A) {
    LAS float* Ws = (LAS float*)(F.lds + RING_OFF); LAS int* cnt = (LAS int*)(F.lds + RING_OFF + 8 * D * 4);
    stage_skinny<8>(F, A.in[I_ROUTER], NEXP, 0, Ws);
    if (F.tid < 8) cnt[F.tid] = 0;
    __syncthreads();
    const float* X = WSP(float, WS_X); bf16* XN = WSP(bf16, WS_XN); const float* g = A.in[I_NFFNG] + D;
    int* TOPI = WSP(int, WS_SMALL + SM_TOPI); float* TOPG = WSP(float, WS_SMALL + SM_TOPG); int* BLKCNT = WSP(int, WS_SMALL + SM_BLKCNT);
    const int b = blockIdx.x;
#define RT_EMIT(t_, o_) do { const int t = (t_);         int i1 = 0; float v1 = o_[0]; \
_Pragma("unroll")         for (int e = 1; e < 8; ++e) if (o_[e] > v1) { v1 = o_[e]; i1 = e; } \
        int i2 = -1; float v2 = -__builtin_inff(); \
_Pragma("unroll")         for (int e = 0; e < 8; ++e) if (e != i1 && o_[e] > v2) { v2 = o_[e]; i2 = e; } \
        const float e2 = __expf(v2 - v1), g1 = 1.0f / (1.0f + e2), g2 = e2 * g1; \
        if (F.lane == 0) { TOPI[2 * t] = i1; TOPI[2 * t + 1] = i2; TOPG[2 * t] = g1; TOPG[2 * t + 1] = g2; __hip_atomic_fetch_add(&cnt[i1], 1, __ATOMIC_RELAXED, __HIP_MEMORY_SCOPE_WORKGROUP); __hip_atomic_fetch_add(&cnt[i2], 1, __ATOMIC_RELAXED, __HIP_MEMORY_SCOPE_WORKGROUP); }  } while (0)

    { const int tb = 32 * b + 4 * F.wave; float oa[8], ob[8], oc[8], od[8]; rms_rows4_dots<8>(X, g, XN, F.lane, tb, tb + 1, tb + 2, tb + 3, Ws, oa, ob, oc, od);
      RT_EMIT(tb, oa); RT_EMIT(tb + 1, ob); RT_EMIT(tb + 2, oc); RT_EMIT(tb + 3, od); }
#undef RT_EMIT
    __syncthreads();
    if (F.tid < 8) BLKCNT[b * 8 + F.tid] = cnt[F.tid];
}
__device__ __forceinline__ void p_route2(const Frame& F) {
    LAS int* sh = (LAS int*)(F.lds + RING_OFF);
    const int* BLKCNT = WSP(int, WS_SMALL + SM_BLKCNT); const int* TOPI = WSP(int, WS_SMALL + SM_TOPI); int* SLOT = WSP(int, WS_SMALL + SM_SLOT); int* TILEE = WSP(int, WS_SMALL + SM_TILEE);
    const bf16* XN = WSP(bf16, WS_XN); bf16* AG = WSP(bf16, R_AG); const int b = blockIdx.x;
    __syncthreads();
    { LAS int* cn = sh + 128;
      if (F.tid < 256) { const u32x4 c0 = *(const u32x4*)(BLKCNT + F.tid * 8), c1 = *(const u32x4*)(BLKCNT + F.tid * 8 + 4); *(LAS u32x4*)(cn + F.tid * 8) = c0; *(LAS u32x4*)(cn + F.tid * 8 + 4) = c1; }
      __syncthreads();
      if (F.tid < 8) { int tot = 0, pre = 0; for (int bb = 0; bb < 256; ++bb) { const int v = cn[bb * 8 + F.tid]; if (bb < b) pre += v; tot += v; } sh[F.tid] = tot; sh[8 + F.tid] = pre; } }
    __syncthreads();
    if (F.tid == 0) { int off = 0, nt = 0; for (int e = 0; e < 8; ++e) { sh[16 + e] = off; const int n = (sh[e] + 255) >> 8; if (b == 0) for (int i = 0; i < n; ++i) TILEE[1 + nt + i] = e; nt += n; off += n * 256; } if (b == 0) TILEE[0] = nt; }
    __syncthreads();
    if (F.wave == 0) { const int t = 32 * b + (F.lane >> 1), e = TOPI[2 * t + (F.lane & 1)]; int rank = 0;
#pragma unroll
        for (int ee = 0; ee < 8; ++ee) { const unsigned long long m = __ballot(e == ee); if (e == ee) rank = __popcll(m & ((1ull << F.lane) - 1ull)); }
        const int slot = sh[16 + e] + sh[8 + e] + rank; SLOT[2 * t + (F.lane & 1)] = slot; sh[32 + F.lane] = slot; }
    __syncthreads();
    { u32x4 rr[8][4];
#pragma unroll
      for (int i = 0; i < 8; ++i) { const int p = F.wave + NWAVES * i, t = 32 * b + (p >> 1); const u32x4* src = (const u32x4*)(XN + (size_t)t * D);
#pragma unroll
          for (int j = 0; j < 4; ++j) rr[i][j] = src[F.lane + 64 * j]; }
      __builtin_amdgcn_sched_barrier(0);
#pragma unroll
      for (int i = 0; i < 8; ++i) { const int p = F.wave + NWAVES * i, slot = sh[32 + p]; u32x4* dst = (u32x4*)(AG + (size_t)slot * D);
#pragma unroll
          for (int j = 0; j < 4; ++j) dst[F.lane + 64 * j] = rr[i][j]; } }
}
struct MoeOrder {
    const bf16* Arows; const bf16* W; const int* tilee; int lda, nN; size_t wstride; int G, c; bool whole_rounds;
    __device__ __forceinline__ bool next(int i, pg8::Unit& u) const {
        const int nt = tilee[0]; const long L = (long)i * G + c; long nu = (long)nt * nN; if (whole_rounds) nu = (nu / G) * G; if (L >= nu) return false;
        const int ti = (int)(L / nN), pn = (int)(L % nN), e = tilee[1 + ti];
        u.pm = ti; u.pn = pn; u.aux = e; u.pad = 0; u.a = (const char*)(Arows + (size_t)ti * 256 * lda); u.b = (const char*)(W + (size_t)e * wstride + (size_t)pn * 256 * lda); return true;
    }
};
constexpr int MOE_KSPLIT = 4;
struct MoeSplitOrder {
    const bf16* Arows; const bf16* W; const int* tilee; int lda, nN, kslice; size_t wstride; int G, c;
    __device__ __forceinline__ bool next(int i, pg8::Unit& u) const {
        const int nt = tilee[0]; const long nu = (long)nt * nN, nfull = (nu / G) * G; const long L = (long)i * G + c; if (L >= (nu - nfull) * MOE_KSPLIT) return false;
        const long j = nfull + L / MOE_KSPLIT; const int kq = (int)(L % MOE_KSPLIT); const int ti = (int)(j / nN), pn = (int)(j % nN), e = tilee[1 + ti];
        u.pm = ti; u.pn = pn; u.aux = kq; u.pad = 0; u.a = (const char*)(Arows + (size_t)ti * 256 * lda + (size_t)kq * kslice); u.b = (const char*)(W + (size_t)e * wstride + (size_t)pn * 256 * lda + (size_t)kq * kslice); return true;
    }
};
__device__ __forceinline__ void p_final(const Frame& F, const Args& A) {
    const float* X = WSP(float, WS_X); const bf16* YG = WSP(bf16, R_YG); const float* YS = WSP(float, R_YSIDE); const int* SLOT = WSP(int, WS_SMALL + SM_SLOT); const float* TOPG = WSP(float, WS_SMALL + SM_TOPG);
    const float* g = A.in[I_FING]; const int lane = F.lane;
    const int nt = WSP(int, WS_SMALL + SM_TILEE)[0]; const int srow0 = (((nt * 8) / F.G) * F.G / 8) * 256;
    for (int t = F.gw; t < T; t += F.NGW) { const int s1 = SLOT[2 * t], s2 = SLOT[2 * t + 1]; const float g1 = TOPG[2 * t], g2 = TOPG[2 * t + 1];
        const f32x4* xr = (const f32x4*)(X + (size_t)t * D) + lane; const u32x2* y1 = (const u32x2*)(YG + (size_t)s1 * D) + lane; const u32x2* y2 = (const u32x2*)(YG + (size_t)s2 * D) + lane;
        f32x4 v[8]; float s = 0.f;
#pragma unroll
        for (int j = 0; j < 8; ++j) { const u32x2 ua = y1[64 * j], ub = y2[64 * j]; f32x4 a = {bf2f(ua.x & 0xffffu), bf2f(ua.x >> 16), bf2f(ua.y & 0xffffu), bf2f(ua.y >> 16)}, b = {bf2f(ub.x & 0xffffu), bf2f(ub.x >> 16), bf2f(ub.y & 0xffffu), bf2f(ub.y >> 16)};
            if (s1 >= srow0) { const f32x4* p = (const f32x4*)(YS + (size_t)(s1 - srow0) * D) + lane + 64 * j; a = a + ((p[0] + p[YSIDE_STRIDE / 4]) + p[2 * (YSIDE_STRIDE / 4)]); }
            if (s2 >= srow0) { const f32x4* p = (const f32x4*)(YS + (size_t)(s2 - srow0) * D) + lane + 64 * j; b = b + ((p[0] + p[YSIDE_STRIDE / 4]) + p[2 * (YSIDE_STRIDE / 4)]); }
            v[j] = xr[64 * j] + (a * g1 + b * g2); s += (v[j][0] * v[j][0] + v[j][1] * v[j][1]) + (v[j][2] * v[j][2] + v[j][3] * v[j][3]); }
        const float r = 1.0f / sqrtf(wave_sum(s) * (1.0f / D) + 1e-6f); f32x4* o = (f32x4*)(A.out + (size_t)t * D) + lane;
#pragma unroll
        for (int j = 0; j < 8; ++j) o[64 * j] = v[j] * r * ((const f32x4*)g)[lane + 64 * j]; }
}

enum Phase { PH_CONV = 0, PH_INPROJ0, PH_PREPA, PH_LORA, PH_SCAN, PH_MLSCAN, PH_MLOUT, PH_OUTPROJ0,
             PH_NORMX0, PH_XS0, PH_XO0, PH_NORMF0, PH_FFNGU, PH_FFND,
             PH_NORMM1, PH_FOXIN, PH_FOXPREP, PH_FOXATT, PH_FOXOUT,
             PH_NORMX1, PH_XS1, PH_XO1, PH_NORMF1, PH_ROUTE2, PH_MOEGU, PH_MOED, PH_FINAL, N_PHASES };

__global__ void __launch_bounds__(NWAVES * 64, 2) trunk_fwd(Args A) {
    extern __shared__ __attribute__((aligned(16))) unsigned char lds[];
    Frame F;
    F.lds = (LAS unsigned char*)lds; F.ldsg = lds; F.ws = A.ws;
    F.tid = threadIdx.x; F.lane = F.tid & 63; F.wave = __builtin_amdgcn_readfirstlane(F.tid >> 6);
    F.G = gridDim.x; { const int bx = blockIdx.x; F.vcu = (F.G % 8 == 0) ? (bx % 8) * (F.G / 8) + bx / 8 : bx; }
    F.gw = F.vcu * NWAVES + F.wave; F.NGW = F.G * NWAVES;
    volatile LAS unsigned* MISC = (volatile LAS unsigned*)(F.lds + MISC_OFF);
    for (int u = F.tid; u < (LDS_BYTES - LDSCTL_OFF) / 4; u += NWAVES * 64) ((LAS unsigned*)(F.lds + LDSCTL_OFF))[u] = 0u;
    __syncthreads();
    const int lo = A.ph_lo, hi = A.ph_hi;
    const bool multi = (hi - lo) > 1;
    XcdBarrier bar; bar.bar = (unsigned*)(A.ws + WS_CTL) + CW_BAR; bar.x = 0; bar.st = nullptr;
    if (multi) bar = xcd_barrier_post((unsigned*)(A.ws + WS_CTL) + CW_BAR, MISC + 8);
#ifndef PH_ENABLE
#define PH_ENABLE 0xFFFFFFFFFFFFFFFFull
#endif
#define IN(k) ((((PH_ENABLE) >> (k)) & 1ull) && lo <= (k) && (k) < hi)
#ifndef PROBE_DUP
#define PROBE_DUP 0ull
#endif
#define DUP(k) if ((((PROBE_DUP) >> (k)) & 1ull) != 0ull)
#ifndef PROBE_PHASE
#define PROBE_PHASE (-1)
#endif
    long long tph_ = 0;
#define SEAM(k) do { if (PROBE_PHASE == (k)) { __syncthreads(); const long long t1_ = wall_clock64(); while (wall_clock64() - t1_ < t1_ - tph_) __builtin_amdgcn_s_sleep(32); } \
        if (IN(k) && IN((k) + 1)) xcd_barrier(bar); if (PROBE_PHASE == (k) + 1) tph_ = wall_clock64(); } while (0)
    LAS unsigned char* ring = F.lds + RING_OFF;
    const int cb = (int)blockIdx.x;
    float* const SSQ = (float*)(A.ws + WS_CTL + CTL_SSQ);

    constexpr int MOE_E_TAIL = 1;
    constexpr int MOE_E_EARLY = 0;
    if (IN(PH_CONV)) { p_convert_early(F, A); if (MOE_E_EARLY > 0) p_convert_late(F, A, F.gw, F.NGW, (LAS float*)(F.lds + RING_OFF + F.wave * 16384), false, 0, MOE_E_EARLY); } SEAM(PH_CONV);
    if (IN(PH_INPROJ0)) { constexpr int GI = 248;
        if (cb < GI) { InprojKvOrder S{WSP(bf16, WS_XN), WSP(bf16, WS_W_ABIN), WSP(bf16, WS_MEMN), WSP(bf16, WS_W_XKV), GI, cb};
            EpiInprojKv E{WSP(bf16, R_PROJ), WSP(float, R_GATES32), WSP(bf16, WS_KMEM), WSP(bf16, WS_VTMEM)};
            pg8::gemm_phase<EpiInprojKv, InprojKvOrder, true>(ring, pg8::Gemm{D, D, D}, S, E); }
        else p_wq_copy(F, A, (cb - GI) * NWAVES * 64 + F.tid, ((int)F.G - GI) * NWAVES * 64); } SEAM(PH_INPROJ0);
    if (IN(PH_PREPA)) { p_prepa(F, A); DUP(PH_PREPA) { __syncthreads(); p_prepa(F, A); } } SEAM(PH_PREPA);
    if (IN(PH_LORA)) { pg8::PlainOrder S{WSP(bf16, R_LORAIN), WSP(bf16, WS_W_LORA), 512, 512, 32, 12, F.G, cb}; pg8::EpiF32 E{WSP(float, R_LORAOUT), 3072, 0, 1.0f};
        pg8::gemm_phase<pg8::EpiF32, pg8::PlainOrder, true>(ring, pg8::Gemm{512, 512, 512}, S, E);
        { XpreOrder S2{WSP(bf16, WS_KMEM), WSP(bf16, WS_VTMEM), WSP(bf16, WS_W_XQ), WSP(bf16, WS_W_XO), 128, cb - 128}; EpiXpre E2{WSP(bf16, R_KQ), WSP(bf16, R_VWT)};
          pg8::gemm_phase<EpiXpre, XpreOrder, false>(ring, pg8::Gemm{D, D, 512}, S2, E2); }
        p_mlstm_pass2(F, cb == (int)F.G - 1 && F.wave < NH_M, F.wave); } SEAM(PH_LORA);
    if (IN(PH_SCAN)) {
        constexpr int RW_NP = 143;
#ifndef PROBE_ROLE
#define PROBE_ROLE 0
#endif
        const long long t0_ = PROBE_ROLE ? wall_clock64() : 0;
        const int role_ = cb < 16 ? 1 : (cb < 16 + RW_NP ? 2 : 3);
        if (cb < 16) p_rwkv_seq(F);
        else if (cb < 16 + RW_NP) { p_rwkv_chunk2(F, A, cb - 16, RW_NP); __syncthreads(); p_mlu(F, cb - 16, RW_NP); }
        else p_convert_late(F, A, (cb - 16 - RW_NP) * NWAVES + F.wave, (F.G - 16 - RW_NP) * NWAVES, (LAS float*)(F.lds + RING_OFF + F.wave * 16384), true, MOE_E_EARLY, NEXP - MOE_E_TAIL - 2);
        if (PROBE_ROLE && role_ == PROBE_ROLE) { __syncthreads(); const long long t1_ = wall_clock64(); while (wall_clock64() - t1_ < t1_ - t0_) __builtin_amdgcn_s_sleep(32); }
    } SEAM(PH_SCAN);
    if (IN(PH_MLSCAN)) { p_mlscan(F); p_rwkv_post(F, A); DUP(PH_MLSCAN) { __syncthreads(); p_rwkv_post(F, A); } } SEAM(PH_MLSCAN);
    if (IN(PH_MLOUT)) { p_mlout(F, A); DUP(PH_MLOUT) { __syncthreads(); p_mlout(F, A); } } SEAM(PH_MLOUT);
    if (IN(PH_OUTPROJ0)) { pg8::PlainOrder S{WSP(bf16, R_YCAT), WSP(bf16, WS_W_ABOUT), D, D, 32, 8, F.G, cb}; pg8::EpiResid E{A.in[I_X], WSP(float, WS_X), D, nullptr, nullptr, nullptr};
        pg8::gemm_phase<pg8::EpiResid, pg8::PlainOrder, false>(ring, pg8::Gemm{D, D, D}, S, E); } SEAM(PH_OUTPROJ0);
#define XATTN(l, P_NORM, P_S, P_O, XN_OUT, G_OUT, SSQ_OUT) \
    if (IN(P_NORM)) { norm_phase(F, WSP(float, WS_X), A.in[I_NXAG] + (l) * D, WSP(bf16, WS_XN), T); } SEAM(P_NORM); \
    if (IN(P_S)) { XkqOrder S{WSP(bf16, WS_XN), WSP(bf16, R_KQ) + (size_t)(l) * 4 * 256 * D, F.G, cb}; pg8::EpiSoftmaxBf16 E{WSP(bf16, R_XP), 1024, 256, 0.044194173824159216f}; \
        pg8::gemm_phase<pg8::EpiSoftmaxBf16, XkqOrder, false>(ring, pg8::Gemm{D, D, D}, S, E); \
        if (cb >= 128) p_convert_late(F, A, (cb - 128) * NWAVES + F.wave, (F.G - 128) * NWAVES, (LAS float*)(F.lds + RING_OFF + F.wave * 16384), false, NEXP - 3 + (l), NEXP - 2 + (l)); } SEAM(P_S);     \
    if (IN(P_O)) { pg8::PlainOrder S{WSP(bf16, R_XP), WSP(bf16, R_VWT) + (size_t)(l) * D * 1024, 1024, 1024, 32, 8, F.G, cb}; pg8::EpiResid E{WSP(float, WS_X), WSP(float, WS_X), D, XN_OUT, G_OUT, SSQ_OUT}; \
        pg8::gemm_phase<pg8::EpiResid, pg8::PlainOrder, false>(ring, pg8::Gemm{1024, 1024, 1024}, S, E); } SEAM(P_O);

    XATTN(0, PH_NORMX0, PH_XS0, PH_XO0, (bf16*)nullptr, (const float*)nullptr, (float*)nullptr)
    if (IN(PH_NORMF0)) { norm_phase(F, WSP(float, WS_X), A.in[I_NFFNG], WSP(bf16, WS_XN), T); } SEAM(PH_NORMF0);
    if (IN(PH_FFNGU)) {
        constexpr int GF = 236;
        if (MOE_E_TAIL == 0 || cb < GF) { pg8::PlainOrder S{WSP(bf16, WS_XN), WSP(bf16, WS_W_FFNGU), D, D, 32, 44, MOE_E_TAIL == 0 ? (int)F.G : GF, cb}; pg8::EpiSwiGLU E{WSP(bf16, R_ACT), DFF, nullptr};
            pg8::gemm_phase<pg8::EpiSwiGLU, pg8::PlainOrder, true>(ring, pg8::Gemm{D, D, D}, S, E); }
        else { const long long tq0_ = (PROBE_ROLE == 4) ? wall_clock64() : 0;
            p_convert_late(F, A, (cb - GF) * NWAVES + F.wave, (F.G - GF) * NWAVES, (LAS float*)(F.lds + RING_OFF + F.wave * 16384), false, NEXP - MOE_E_TAIL, NEXP);
            if (PROBE_ROLE == 4) { const long long tq1_ = wall_clock64(); while (wall_clock64() - tq1_ < tq1_ - tq0_) __builtin_amdgcn_s_sleep(32); } } } SEAM(PH_FFNGU);
    if (IN(PH_FFND)) { pg8::PlainOrder S{WSP(bf16, R_ACT), WSP(bf16, WS_W_FFND), DFF, DFF, 32, 8, F.G, cb}; pg8::EpiResid E{WSP(float, WS_X), WSP(float, WS_X), D, nullptr, nullptr, nullptr};
        pg8::gemm_phase<pg8::EpiResid, pg8::PlainOrder, false>(ring, pg8::Gemm{DFF, DFF, DFF}, S, E); } SEAM(PH_FFND);
    if (IN(PH_NORMM1)) { p_norm_fpre(F, A); DUP(PH_NORMM1) { p_norm_fpre(F, A); } } SEAM(PH_NORMM1);
    if (IN(PH_FOXIN)) { pg8::PlainOrder S{WSP(bf16, WS_XN), WSP(bf16, WS_W_FOXIN), D, D, 32, 32, F.G, cb}; pg8::EpiBf16 E{WSP(bf16, R_QKVG), 8192, nullptr, -1, nullptr};
        pg8::gemm_phase<pg8::EpiBf16, pg8::PlainOrder, true>(ring, pg8::Gemm{D, D, D}, S, E); DUP(PH_FOXIN) { pg8::gemm_phase<pg8::EpiBf16, pg8::PlainOrder, true>(ring, pg8::Gemm{D, D, D}, S, E); } } SEAM(PH_FOXIN);
    if (IN(PH_FOXPREP)) { p_foxprep(F, A); } SEAM(PH_FOXPREP);
    if (IN(PH_FOXATT)) { p_foxattn(F); DUP(PH_FOXATT) { __syncthreads(); p_foxattn(F); } } SEAM(PH_FOXATT);
    if (IN(PH_FOXOUT)) { pg8::PlainOrder S{WSP(bf16, R_ATTO), WSP(bf16, WS_W_FOXOUT), D, D, 32, 8, F.G, cb}; pg8::EpiResid E{WSP(float, WS_X), WSP(float, WS_X), D, nullptr, nullptr, nullptr};
        pg8::gemm_phase<pg8::EpiResid, pg8::PlainOrder, false>(ring, pg8::Gemm{D, D, D}, S, E); } SEAM(PH_FOXOUT);
    XATTN(1, PH_NORMX1, PH_XS1, PH_XO1, (bf16*)nullptr, (const float*)nullptr, (float*)nullptr)
    if (IN(PH_NORMF1)) { p_norm_route(F, A); } SEAM(PH_NORMF1);
    if (IN(PH_ROUTE2)) { p_route2(F); } SEAM(PH_ROUTE2);
    if (IN(PH_MOEGU)) { MoeOrder S{WSP(bf16, R_AG), WSP(bf16, WS_W_MOEGU), WSP(int, WS_SMALL + SM_TILEE), D, 44, (size_t)2 * DFF * D, F.G, cb, false}; pg8::EpiSwiGLU E{WSP(bf16, R_ACTG), DFF, nullptr};
        pg8::gemm_phase<pg8::EpiSwiGLU, MoeOrder, true>(ring, pg8::Gemm{D, D, D}, S, E); } SEAM(PH_MOEGU);
    if (IN(PH_MOED)) {
        { MoeOrder S{WSP(bf16, R_ACTG), WSP(bf16, WS_W_MOED), WSP(int, WS_SMALL + SM_TILEE), DFF, 8, (size_t)D * DFF, F.G, cb, true}; pg8::EpiBf16N E{WSP(bf16, R_YG), D};
          pg8::gemm_phase<pg8::EpiBf16N, MoeOrder, true>(ring, pg8::Gemm{DFF, DFF, DFF}, S, E); }
        { MoeSplitOrder S{WSP(bf16, R_ACTG), WSP(bf16, WS_W_MOED), WSP(int, WS_SMALL + SM_TILEE), DFF, 8, DFF / MOE_KSPLIT, (size_t)D * DFF, F.G, cb}; const int nt_ = WSP(int, WS_SMALL + SM_TILEE)[0]; pg8::EpiF32Split E{WSP(bf16, R_YG), WSP(float, R_YSIDE), YSIDE_STRIDE, D, ((nt_ * 8) / F.G) * F.G / 8};
          pg8::gemm_phase<pg8::EpiF32Split, MoeSplitOrder, false>(ring, pg8::Gemm{DFF, DFF, DFF / MOE_KSPLIT}, S, E); } } SEAM(PH_MOED);
    if (IN(PH_FINAL)) { p_final(F, A); }
#undef XATTN
#undef IN
#undef SEAM
}

#ifndef MK_ONE_LAUNCH
#define MK_ONE_LAUNCH 1
#endif
extern "C" void kernel_launch(void* const* d_in, const int* in_sizes, int n_in, void* d_out, int out_size, void* d_ws, size_t ws_size, hipStream_t stream) {
    static int ready = 0;
    if (ready == 0) {
        if (n_in != N_IN || in_sizes[0] != T * D || out_size != T * D || ws_size < WS_END) {
            fprintf(stderr, "kernel_launch: built for %d inputs, x/out of %d floats, >= %zu bytes of workspace; got n_in %d, in0 %d, out %d, ws %zu; nothing launched\n", N_IN, T * D, (size_t)WS_END, n_in, n_in > 0 ? in_sizes[0] : -1, out_size, ws_size);
            ready = -1; return; }
        if (hipFuncSetAttribute((const void*)trunk_fwd, hipFuncAttributeMaxDynamicSharedMemorySize, LDS_BYTES) != hipSuccess) { fprintf(stderr, "kernel_launch: hipFuncSetAttribute failed\n"); ready = -1; return; }
        int per_cu = 0;
        if (hipOccupancyMaxActiveBlocksPerMultiprocessor(&per_cu, (const void*)trunk_fwd, NWAVES * 64, LDS_BYTES) != hipSuccess || per_cu < 1)
            fprintf(stderr, "kernel_launch: note: occupancy query reports %d workgroups per CU\n", per_cu);
        (void)hipGetLastError();
        ready = 1;
    }
    if (ready < 0) return;
    const int grid = 256;
    if (hipMemsetAsync((char*)d_ws + WS_CTL, 0, CTL_ZERO_BYTES, stream) != hipSuccess) { fprintf(stderr, "kernel_launch: hipMemsetAsync failed\n"); return; }
    Args a{};
    for (int i = 0; i < N_IN; ++i) a.in[i] = (const float*)d_in[i];
    a.out = (float*)d_out; a.ws = (unsigned char*)d_ws;
#if MK_ONE_LAUNCH
    a.ph_lo = 0; a.ph_hi = N_PHASES;
    hipLaunchKernelGGL(trunk_fwd, dim3(grid), dim3(NWAVES * 64), LDS_BYTES, stream, a);
#else
    for (int p = 0; p < N_PHASES; ++p) { a.ph_lo = p; a.ph_hi = p + 1;
        hipLaunchKernelGGL(trunk_fwd, dim3(grid), dim3(NWAVES * 64), LDS_BYTES, stream, a); }
#endif
    const hipError_t le = hipPeekAtLastError();
    if (le != hipSuccess) fprintf(stderr, "kernel_launch: launch failed: %s\n", hipGetErrorName(le));
}
```
